# Optimizing an MI355X kernel written in HIP

```python
import jax, jax.numpy as jnp
from jax import lax
import numpy as np

D_MODEL = 1024
BATCH = 2
SEQ = 8192
DEPTH = 1

CHUNK = 64
Q_BLOCK = 128
ROPE_THETA = 500000.0
EPS = 1e-6
NEG = -1e30

MLA_HEADS = 8
MLA_Q_LORA = 384
MLA_KV_LORA = 256
MLA_NOPE = 64
MLA_ROPE = 32
MLA_V = 64

DSA_HEADS = 8
DSA_HEAD_DIM = 64
DSA_ROT = DSA_HEAD_DIM // 4
IDX_HEADS = 8
IDX_DIM = 64
IDX_ROT = IDX_DIM // 4
DSA_TOPK_MAX = 256

N_GROUPS = 8
EXPERTS_PER_GROUP = 4
N_EXPERTS = N_GROUPS * EXPERTS_PER_GROUP
EXPERT_FF = 256
TOPK_IN_GROUP = 2

IN_SIZES = (
    MLA_Q_LORA,
    MLA_KV_LORA,
    MLA_ROPE,
    DSA_HEADS * DSA_HEAD_DIM,
    DSA_HEADS * DSA_HEAD_DIM,
    DSA_HEADS * DSA_HEAD_DIM,
    IDX_HEADS * IDX_DIM,
    IDX_DIM,
    IDX_HEADS,
    D_MODEL,
    D_MODEL,
)
IN_WIDTH = sum(IN_SIZES)

kernel_name = 'hybrid_mla_dsa_hier_moe_block'


def rmsnorm(x, g):
    xf = x.astype(jnp.float32)
    y = xf * lax.rsqrt(jnp.mean(xf * xf, axis=-1, keepdims=True) + EPS)
    return (y * g.astype(jnp.float32)).astype(x.dtype)


def rope(x, pos, rot_dim):
    half = rot_dim // 2
    inv_freq = ROPE_THETA ** (-jnp.arange(half, dtype=jnp.float32) * 2.0 / rot_dim)
    ang = pos.astype(jnp.float32)[:, None] * inv_freq[None, :]
    cos = jnp.cos(ang)[:, None, :]
    sin = jnp.sin(ang)[:, None, :]
    xr = x[..., :rot_dim].astype(jnp.float32)
    x1, x2 = xr[..., :half], xr[..., half:]
    rot = jnp.concatenate([x1 * cos - x2 * sin, x2 * cos + x1 * sin], axis=-1).astype(x.dtype)
    return jnp.concatenate([rot, x[..., rot_dim:]], axis=-1)


def _to_blocks(a):
    b, s = a.shape[0], a.shape[1]
    return a.reshape(b, s // Q_BLOCK, Q_BLOCK, *a.shape[2:]).swapaxes(0, 1)


def _from_blocks(a):
    a = a.swapaxes(0, 1)
    return a.reshape(a.shape[0], a.shape[1] * a.shape[2], *a.shape[3:])


def chunk_causal_attention(q, k, v, scale):
    s_len = q.shape[1]
    nb = s_len // Q_BLOCK
    key_chunk = jnp.arange(s_len) // CHUNK

    def one_block(args):
        qi, bi = args
        q_chunk = (bi * Q_BLOCK + jnp.arange(Q_BLOCK)) // CHUNK
        mask = key_chunk[None, :] <= q_chunk[:, None]
        s = jnp.einsum('bqhd,bkhd->bhqk', qi, k).astype(jnp.float32) * scale
        s = jnp.where(mask[None, None], s, NEG)
        p = jax.nn.softmax(s, axis=-1).astype(v.dtype)
        return jnp.einsum('bhqk,bkhd->bqhd', p, v)

    out = lax.map(one_block, (_to_blocks(q), jnp.arange(nb)))
    return _from_blocks(out)


def indexed_sparse_attention(q, k, v, q_idx, k_idx, w_idx, top_k):
    s_len = q.shape[1]
    nb = s_len // Q_BLOCK
    key_chunk = jnp.arange(s_len) // CHUNK
    gather = jax.vmap(lambda a, i: a[i])

    def one_block(args):
        qi, qii, wi, bi = args
        q_chunk = (bi * Q_BLOCK + jnp.arange(Q_BLOCK)) // CHUNK
        adm = key_chunk[None, :] <= q_chunk[:, None]
        logits = jnp.einsum('bqhd,bkd->bqhk', qii, k_idx).astype(jnp.float32) * (IDX_DIM ** -0.5)
        score = jnp.einsum('bqh,bqhk->bqk', wi.astype(jnp.float32), jax.nn.relu(logits))
        score = jnp.where(adm[None], score, -jnp.inf)
        _, sel = lax.top_k(score, top_k)
        sel_ok = (sel // CHUNK) <= q_chunk[None, :, None]
        k_sel = gather(k, sel)
        v_sel = gather(v, sel)
        s = jnp.einsum('bqhd,bqkhd->bhqk', qi, k_sel).astype(jnp.float32) * (DSA_HEAD_DIM ** -0.5)
        s = jnp.where(sel_ok[:, None], s, NEG)
        p = jax.nn.softmax(s, axis=-1).astype(v.dtype)
        return jnp.einsum('bhqk,bqkhd->bqhd', p, v_sel)

    out = lax.map(one_block, (_to_blocks(q), _to_blocks(q_idx), _to_blocks(w_idx), jnp.arange(nb)))
    return _from_blocks(out)


def hierarchical_moe(h, w_router_group, b_router_group, w_router_expert, b_router_expert,
                     w_gate, w_up, w_down):
    t = h.shape[0]
    group_logits = jnp.matmul(h, w_router_group).astype(jnp.float32) + b_router_group.astype(jnp.float32)
    p_group = jax.nn.softmax(group_logits, axis=-1)
    g_sel = jnp.argmax(group_logits, axis=-1)
    w_grp = jnp.take_along_axis(p_group, g_sel[:, None], axis=-1)
    exp_logits = (jnp.matmul(h, w_router_expert).astype(jnp.float32)
                  + b_router_expert.astype(jnp.float32)).reshape(t, N_GROUPS, EXPERTS_PER_GROUP)
    in_group = jnp.take_along_axis(exp_logits, g_sel[:, None, None], axis=1)[:, 0]
    top_vals, top_idx = lax.top_k(in_group, TOPK_IN_GROUP)
    w_top = jax.nn.softmax(top_vals, axis=-1) * w_grp
    expert_id = g_sel[:, None] * EXPERTS_PER_GROUP + top_idx
    combine = jnp.sum(jax.nn.one_hot(expert_id, N_EXPERTS, dtype=jnp.float32) * w_top[..., None],
                      axis=1).astype(h.dtype)
    out = jnp.zeros_like(h)
    for e in range(N_EXPERTS):
        hid = jax.nn.silu(jnp.matmul(h, w_gate[e])) * jnp.matmul(h, w_up[e])
        out = out + jnp.matmul(hid, w_down[e]) * combine[:, e:e + 1]
    return out


def hybrid_layer(x, pos, norm_mix_g, w_in, mla_q_norm_g, w_uq, mla_kv_norm_g, w_uk, w_uv,
                 w_o_a, w_o_b, w_out, norm_ffn_g, w_router_group, b_router_group,
                 w_router_expert, b_router_expert, w_gate, w_up, w_down):
    b, s, d = x.shape
    h = rmsnorm(x, norm_mix_g)
    proj = jnp.einsum('bsd,de->bse', h, w_in)
    splits = np.cumsum(IN_SIZES)[:-1].tolist()
    (c_q, c_kv, k_r, q_b, k_b, v_b, q_i, k_i, w_i, g_a, g_b) = jnp.split(proj, splits, axis=-1)

    c_q = rmsnorm(c_q, mla_q_norm_g)
    q_a = jnp.einsum('bsr,re->bse', c_q, w_uq).reshape(b, s, MLA_HEADS, MLA_NOPE + MLA_ROPE)
    q_a = jnp.concatenate([q_a[..., :MLA_NOPE], rope(q_a[..., MLA_NOPE:], pos, MLA_ROPE)], axis=-1)
    c_kv = rmsnorm(c_kv, mla_kv_norm_g)
    k_nope = jnp.einsum('bsr,re->bse', c_kv, w_uk).reshape(b, s, MLA_HEADS, MLA_NOPE)
    v_a = jnp.einsum('bsr,re->bse', c_kv, w_uv).reshape(b, s, MLA_HEADS, MLA_V)
    k_pe = rope(k_r[:, :, None, :], pos, MLA_ROPE)
    k_a = jnp.concatenate([k_nope, jnp.broadcast_to(k_pe, (b, s, MLA_HEADS, MLA_ROPE))], axis=-1)
    o_a = chunk_causal_attention(q_a, k_a, v_a, (MLA_NOPE + MLA_ROPE) ** -0.5)
    y_a = jnp.einsum('bse,ed->bsd', o_a.reshape(b, s, MLA_HEADS * MLA_V), w_o_a)

    q_b = rope(q_b.reshape(b, s, DSA_HEADS, DSA_HEAD_DIM), pos, DSA_ROT)
    k_b = rope(k_b.reshape(b, s, DSA_HEADS, DSA_HEAD_DIM), pos, DSA_ROT)
    v_b = v_b.reshape(b, s, DSA_HEADS, DSA_HEAD_DIM)
    q_i = rope(q_i.reshape(b, s, IDX_HEADS, IDX_DIM), pos, IDX_ROT)
    k_i = rope(k_i[:, :, None, :], pos, IDX_ROT)[:, :, 0, :]
    top_k = min(DSA_TOPK_MAX, s // 4)
    o_b = indexed_sparse_attention(q_b, k_b, v_b, q_i, k_i, w_i * (IDX_HEADS ** -0.5), top_k)
    y_b = jnp.einsum('bse,ed->bsd', o_b.reshape(b, s, DSA_HEADS * DSA_HEAD_DIM), w_o_b)

    y = jax.nn.sigmoid(g_a) * y_a + jax.nn.sigmoid(g_b) * y_b
    x = x + jnp.einsum('bsd,de->bse', y, w_out)

    h2 = rmsnorm(x, norm_ffn_g).reshape(b * s, d)
    m = hierarchical_moe(h2, w_router_group, b_router_group, w_router_expert, b_router_expert,
                         w_gate, w_up, w_down)
    return x + m.reshape(b, s, d)


def setup_inputs(seed: int = 0) -> dict:
    key = jax.random.key(seed)
    ks = jax.random.split(key, 20)
    f32 = jnp.float32
    L = DEPTH

    def dense(k, shape, fan_in):
        return jax.random.normal(k, shape, f32) * (fan_in ** -0.5)

    def gain(k, shape):
        return 1.0 + 0.05 * jax.random.normal(k, shape, f32)

    return {
        'x': jax.random.normal(ks[0], (BATCH, SEQ, D_MODEL), f32),
        'norm_mix_g': gain(ks[1], (L, D_MODEL)),
        'w_in': dense(ks[2], (L, D_MODEL, IN_WIDTH), D_MODEL),
        'mla_q_norm_g': gain(ks[3], (L, MLA_Q_LORA)),
        'w_uq': dense(ks[4], (L, MLA_Q_LORA, MLA_HEADS * (MLA_NOPE + MLA_ROPE)), MLA_Q_LORA),
        'mla_kv_norm_g': gain(ks[5], (L, MLA_KV_LORA)),
        'w_uk': dense(ks[6], (L, MLA_KV_LORA, MLA_HEADS * MLA_NOPE), MLA_KV_LORA),
        'w_uv': dense(ks[7], (L, MLA_KV_LORA, MLA_HEADS * MLA_V), MLA_KV_LORA),
        'w_o_a': dense(ks[8], (L, MLA_HEADS * MLA_V, D_MODEL), MLA_HEADS * MLA_V),
        'w_o_b': dense(ks[9], (L, DSA_HEADS * DSA_HEAD_DIM, D_MODEL), DSA_HEADS * DSA_HEAD_DIM),
        'w_out': dense(ks[10], (L, D_MODEL, D_MODEL), D_MODEL),
        'norm_ffn_g': gain(ks[11], (L, D_MODEL)),
        'w_router_group': dense(ks[12], (L, D_MODEL, N_GROUPS), D_MODEL),
        'b_router_group': 0.01 * jax.random.normal(ks[13], (L, N_GROUPS), f32),
        'w_router_expert': dense(ks[14], (L, D_MODEL, N_EXPERTS), D_MODEL),
        'b_router_expert': 0.01 * jax.random.normal(ks[15], (L, N_EXPERTS), f32),
        'w_gate': dense(ks[16], (L, N_EXPERTS, D_MODEL, EXPERT_FF), D_MODEL),
        'w_up': dense(ks[17], (L, N_EXPERTS, D_MODEL, EXPERT_FF), D_MODEL),
        'w_down': dense(ks[18], (L, N_EXPERTS, EXPERT_FF, D_MODEL), EXPERT_FF),
        'final_norm_g': gain(ks[19], (D_MODEL,)),
    }


def reference(x, norm_mix_g, w_in, mla_q_norm_g, w_uq, mla_kv_norm_g, w_uk, w_uv, w_o_a, w_o_b,
              w_out, norm_ffn_g, w_router_group, b_router_group, w_router_expert, b_router_expert,
              w_gate, w_up, w_down, final_norm_g):
    pos = jnp.arange(x.shape[1], dtype=jnp.int32)
    for l in range(DEPTH):
        x = hybrid_layer(x, pos, norm_mix_g[l], w_in[l], mla_q_norm_g[l], w_uq[l], mla_kv_norm_g[l],
                         w_uk[l], w_uv[l], w_o_a[l], w_o_b[l], w_out[l], norm_ffn_g[l],
                         w_router_group[l], b_router_group[l], w_router_expert[l],
                         b_router_expert[l], w_gate[l], w_up[l], w_down[l])
    return rmsnorm(x, final_norm_g)
```

```cpp
#include <hip/hip_runtime.h>
#include <cstdio>
#include <cstdint>

#define GAS __attribute__((address_space(1)))
#define LAS __attribute__((address_space(3)))
typedef unsigned short bf16;
typedef unsigned v4u __attribute__((ext_vector_type(4)));
typedef unsigned v2u __attribute__((ext_vector_type(2)));
typedef float f32x4 __attribute__((ext_vector_type(4)));
typedef float f32x2 __attribute__((ext_vector_type(2)));
typedef float f32x16 __attribute__((ext_vector_type(16)));
typedef short bf16x8 __attribute__((ext_vector_type(8)));
typedef short s16x4 __attribute__((ext_vector_type(4)));
typedef __bf16 bf16x2_t __attribute__((ext_vector_type(2)));
typedef GAS unsigned gu32;
#define RLX_AGENT __ATOMIC_RELAXED, __HIP_MEMORY_SCOPE_AGENT
#define LDS_WAIT() asm volatile("s_waitcnt lgkmcnt(0)" ::: "memory")
#define VM_WAIT() asm volatile("s_waitcnt vmcnt(0)" ::: "memory")

constexpr int NWAVES = 8, NTHR = NWAVES * 64;
constexpr int BATCH = 2, SEQ = 8192, D = 1024, T = BATCH * SEQ;
constexpr float EPS = 1e-6f;
constexpr int NIN = 4864, NIN_SRC = 4840;
constexpr int C_CQ = 0, C_CKV = 384, C_QB = 640, C_KB = 1152, C_VB = 1664, C_QI = 2176, C_KR = 2688, C_KI = 2720, C_WI = 2784, C_GA = 2816, C_GB = 3840;
constexpr int NEXP = 32, FF = 256;
constexpr int SORT_ROWS = 2 * T + NEXP * 256;
constexpr float LOG2E = 1.4426950408889634f;
constexpr float C2A = 0.10206207261596575f * LOG2E;
constexpr float C2B = 0.125f * LOG2E;
constexpr float WI_SCALE = 0.35355339059327373f * 0.125f;

constexpr size_t MiB = 1u << 20, KiB = 1u << 10;
constexpr size_t WS_CTL = 0, CTL_ZERO_BYTES = 1 * MiB;
constexpr size_t WS_ROPE = 1 * MiB;
constexpr size_t WS_WI = 2 * MiB;
constexpr size_t WS_TOKE = 2 * MiB + 512 * KiB;
constexpr size_t WS_TOKW = WS_TOKE + 128 * KiB;
constexpr size_t WS_RSTD2 = WS_TOKW + 128 * KiB;
constexpr size_t WS_SSLOT = 3 * MiB + 512 * KiB;
constexpr size_t WS_SW = WS_SSLOT + 192 * KiB;
constexpr size_t WS_T2E = WS_SW + 192 * KiB;
constexpr size_t WS_WIN = 4 * MiB, WS_WUQ = 14 * MiB, WS_WUKV = 15 * MiB, WS_WOA = 16 * MiB, WS_WOB = 17 * MiB, WS_WOUT = 18 * MiB, WS_WGU = 20 * MiB, WS_WD = 52 * MiB;
constexpr size_t WS_H = 68 * MiB, WS_OA = 68 * MiB, WS_OB = 84 * MiB;
constexpr size_t WS_QA = 100 * MiB, WS_KN = 124 * MiB, WS_VA = 140 * MiB, WS_Y = 100 * MiB;
constexpr size_t WS_QB = 156 * MiB, WS_KB = 172 * MiB, WS_VB = 188 * MiB;
constexpr size_t WS_CQ = 204 * MiB, WS_CKV = 216 * MiB, WS_BM = 204 * MiB;
constexpr size_t WS_QI = 224 * MiB, WS_KI = 240 * MiB, WS_KR = 242 * MiB;
constexpr size_t WS_ASORT = 68 * MiB, WS_SLOTS = 156 * MiB, WS_HID = 220 * MiB;
constexpr size_t WS_END = 256 * MiB;
constexpr int CW_BAR = 4096;
constexpr int CW_Q1 = 64, CW_Q2 = 128;
constexpr int CW_CNT = 256, CW_FILL = 320;

constexpr int LDS_BYTES = 147456;
constexpr int MISC_OFF = 147456 - 512;

__device__ __forceinline__ unsigned f2bf(float f) { unsigned u = __builtin_bit_cast(unsigned, f); return (u + 0x7fffu + ((u >> 16) & 1u)) >> 16; }
__device__ __forceinline__ unsigned pk2(float lo, float hi) { f32x2 v = {lo, hi}; bf16x2_t b = __builtin_convertvector(v, bf16x2_t); return __builtin_bit_cast(unsigned, b); }
__device__ __forceinline__ float bflo(unsigned w) { return __builtin_bit_cast(float, w << 16); }
__device__ __forceinline__ float bfhi(unsigned w) { return __builtin_bit_cast(float, w & 0xffff0000u); }

#define XB_TMO      128
#define XB_XCNT(j)  (256  + 64 * (j))
#define XB_XSUB(j)  (1280 + 64 * (j))
#define XB_XGEN(j)  (2304 + 64 * (j))
#define XB_TOP      3328
#define XB_TOPGEN   3392
#define XCD_BAR_WORDS 3456
#define XB_SPIN_CAP (1u << 22)
__device__ __forceinline__ unsigned xb_ld(unsigned* p)              { return __hip_atomic_load(p, __ATOMIC_RELAXED, __HIP_MEMORY_SCOPE_AGENT); }
__device__ __forceinline__ unsigned xb_add(unsigned* p, unsigned v) { return __hip_atomic_fetch_add(p, v, __ATOMIC_RELAXED, __HIP_MEMORY_SCOPE_AGENT); }
__device__ __forceinline__ unsigned xb_xcc_id() { return (unsigned)__builtin_amdgcn_s_getreg((3 << 11) | 20) & 0xFu; }
#define XB_SPIN(cond, bar) do { unsigned _sp = 0; while (cond) { __builtin_amdgcn_s_sleep(1); \
    if ((++_sp & 255u) == 0u) { if (xb_ld(&(bar)[XB_TMO])) break; if (_sp > XB_SPIN_CAP) { atomicAdd(&(bar)[XB_TMO], 1u); break; } } } } while (0)
struct XcdBarrier { unsigned* bar; unsigned x; volatile LAS unsigned* st; };
__device__ __forceinline__ XcdBarrier xcd_barrier_post(unsigned* bar, volatile LAS unsigned* st) {
    XcdBarrier b; b.bar = bar; b.x = xb_xcc_id(); b.st = st;
    if (threadIdx.x == 0) (void)xb_add(&bar[XB_XCNT(b.x)], 1u);
    return b;
}
__device__ __forceinline__ void xcd_barrier_complete(unsigned* bar, unsigned x, unsigned& nloc, unsigned& nx) {
    const unsigned G = gridDim.x * gridDim.y * gridDim.z;
    unsigned sum, cnt, mine, sp = 0u;
    for (;;) {
        sum = 0u; cnt = 0u; mine = 0u;
#pragma unroll
        for (unsigned j = 0; j < 16; ++j) { const unsigned c = xb_ld(&bar[XB_XCNT(j)]); sum += c; cnt += (c > 0u) ? 1u : 0u; mine = (j == x) ? c : mine; }
        if (sum == G) break;
        __builtin_amdgcn_s_sleep(1);
        if ((++sp & 255u) == 0u) { if (xb_ld(&bar[XB_TMO])) break; if (sp > XB_SPIN_CAP) { atomicAdd(&bar[XB_TMO], 1u); break; } }
    }
    nloc = mine > 0u ? mine : 1u; nx = cnt > 0u ? cnt : 1u;
}
__device__ __forceinline__ void xcd_barrier(const XcdBarrier& b) {
    asm volatile("s_waitcnt vmcnt(0)" ::: "memory");
    __syncthreads();
    if (threadIdx.x == 0) {
        unsigned* bar = b.bar;
        __builtin_amdgcn_s_waitcnt(0);
        unsigned nloc = b.st[0], nx = b.st[1];
        if (nloc == 0u) { xcd_barrier_complete(bar, b.x, nloc, nx); b.st[0] = nloc; b.st[1] = nx; }
        const unsigned old = xb_add(&bar[XB_XSUB(b.x)], 1u);
        const unsigned gen = old / nloc;
        if (old + 1u == (gen + 1u) * nloc) {
            __builtin_amdgcn_fence(__ATOMIC_RELEASE, "agent");
            asm volatile("s_waitcnt vmcnt(0)" ::: "memory");
            const unsigned og = xb_add(&bar[XB_TOP], 1u);
            const unsigned tg = og / nx;
            if (og + 1u == (tg + 1u) * nx) xb_add(&bar[XB_TOPGEN], 1u);
            else XB_SPIN(xb_ld(&bar[XB_TOPGEN]) == tg, bar);
            __builtin_amdgcn_fence(__ATOMIC_ACQUIRE, "agent");
            xb_add(&bar[XB_XGEN(b.x)], 1u);
            asm volatile("s_waitcnt vmcnt(0)" ::: "memory");
        } else {
            XB_SPIN(xb_ld(&bar[XB_XGEN(b.x)]) == gen, bar);
            __builtin_amdgcn_fence(__ATOMIC_ACQUIRE, "agent");
            asm volatile("s_waitcnt vmcnt(0)" ::: "memory");
        }
    }
    __syncthreads();
}

__device__ __forceinline__ float wave_sum(float v) {
#pragma unroll
    for (int o = 1; o < 64; o <<= 1) v += __shfl_xor(v, o);
    return v;
}

namespace pg8 {
#define PG8_LAS __attribute__((address_space(3)))
typedef unsigned short bf16_t;
typedef unsigned u32x4 __attribute__((ext_vector_type(4)));
constexpr int BM = 256, BK = 64, HALF = 128, HTB = HALF * BK * 2, STAGE_BYTES = 8 * HTB, NXCD = 8, WGM = 8;
__host__ __device__ __forceinline__ int lds_byte(int r, int c) { const int st = (r >> 4) * 2 + (c >> 5), rr = r & 15, cc = c & 31, ob = rr * 64 + cc * 2; return st * 1024 + (ob ^ (((ob >> 9) & 1) << 5)); }
__host__ __device__ __forceinline__ void stage_rc(int b, int& R, int& C) { const int st = b / 1024, sb = b % 1024, swz = sb ^ (((sb >> 9) & 1) << 5); R = (st >> 1) * 16 + swz / 64; C = (st & 1) * 32 + (swz % 64) / 2; }
__host__ __device__ __forceinline__ int perm32(int rho) { const int n = rho >> 4, i = rho & 15; return 8 * (i >> 2) + 4 * n + (i & 3); }

struct Unit { int pm, pn, e; };
struct Gemm { const bf16_t* A; const bf16_t* Bt; int M, N, K; size_t estride; };

struct StaticOrder {
    int nM, nN, nwg, G, c;
    __host__ __device__ void init(int M, int N, int G_, int c_) { nM = M / BM; nN = N / BM; nwg = nM * nN; G = G_; c = c_; }
    __host__ __device__ bool next(int i, Unit& u) const {
        const long L = (long)i * G + c; if (L >= nwg) return false;
        int wgid = (int)L; { const int q = nwg / NXCD, r = nwg % NXCD, xcd = wgid % NXCD, off = wgid / NXCD; wgid = (xcd < r ? xcd * (q + 1) : r * (q + 1) + (xcd - r) * q) + off; }
        const int nig = WGM * nN, gid = wgid / nig, fm = gid * WGM, gsz = (nM - fm) < WGM ? (nM - fm) : WGM;
        u.pm = fm + ((wgid % nig) % gsz); u.pn = (wgid % nig) / gsz; u.e = 0; return true;
    }
    __device__ __forceinline__ void a_ready(const Unit&) const {}
    __device__ __forceinline__ void done(const Unit&) const {}
};
struct GroupOrder {
    int nN, total, G, c; const int* t2e;
    __device__ void init(int nTiles, int nN_, int G_, int c_, const int* t2e_) { nN = nN_; total = nTiles * nN_; G = G_; c = c_; t2e = t2e_; }
    __device__ bool next(int i, Unit& u) const {
        const long L = (long)i * G + c; if (L >= total) return false;
        u.pm = (int)(L / nN); u.pn = (int)(L % nN); u.e = __builtin_amdgcn_readfirstlane(t2e[u.pm]); return true;
    }
    __device__ __forceinline__ void a_ready(const Unit&) const {}
    __device__ __forceinline__ void done(const Unit&) const {}
};

__device__ __forceinline__ void st8(bf16_t* p, f32x4 v0, f32x4 v1) { u32x4 w; w.x = pk2(v0[0], v0[1]); w.y = pk2(v0[2], v0[3]); w.z = pk2(v1[0], v1[1]); w.w = pk2(v1[2], v1[3]); *(u32x4*)p = w; }
__device__ __forceinline__ void ld8(const bf16_t* p, f32x4& v0, f32x4& v1) { const u32x4 w = *(const u32x4*)p; v0 = (f32x4){bflo(w.x), bfhi(w.x), bflo(w.y), bfhi(w.y)}; v1 = (f32x4){bflo(w.z), bfhi(w.z), bflo(w.w), bfhi(w.w)}; }

__device__ __forceinline__ void rope16(f32x4& v0, f32x4& v1, int row, int fq, const f32x2* rope) {
    const f32x2* rp = rope + (size_t)(row & (SEQ - 1)) * 16;
    f32x4 p0, p1;
#pragma unroll
    for (int e = 0; e < 4; ++e) { p0[e] = __shfl_xor(v0[e], 16); p1[e] = __shfl_xor(v1[e], 16); }
    if (fq < 2) {
        const float sg = fq == 0 ? -1.f : 1.f;
#pragma unroll
        for (int e = 0; e < 4; ++e) { const f32x2 a = rp[2 * e], b = rp[2 * (4 + e)];
            v0[e] = v0[e] * a.x + sg * p0[e] * a.y; v1[e] = v1[e] * b.x + sg * p1[e] * b.y; }
    }
}
__device__ __forceinline__ void rope32(f32x4& v0, f32x4& v1, int row, int fq, const f32x2* rope) {
    const f32x2* rp = rope + (size_t)(row & (SEQ - 1)) * 16 + 8 * (fq & 1);
    const float sg = fq < 2 ? -1.f : 1.f;
#pragma unroll
    for (int e = 0; e < 4; ++e) { const float p0 = __shfl_xor(v0[e], 32), p1 = __shfl_xor(v1[e], 32); const f32x2 a = rp[e], b = rp[4 + e];
        v0[e] = v0[e] * a.x + sg * p0 * a.y; v1[e] = v1[e] * b.x + sg * p1 * b.y; }
}
__device__ __forceinline__ float sigmoidf_(float x) { return 1.f / (1.f + __expf(-x)); }

struct EpiIn {
    static constexpr bool PERM = true, AFTER_DRAIN = false;
    bf16_t *CQ, *CKV, *QB, *KB, *VB, *QI, *KI, *KR, *GA, *GB; float* WI; const f32x2* rope;
    __device__ __forceinline__ void operator()(const f32x4 (&acc)[2][2][4][2], const Unit& u, int wr, int wc, int fr, int fq) const {
        const int row0 = u.pm * BM + wr * 64 + fr;
#pragma unroll
        for (int bj = 0; bj < 2; ++bj) {
            const int cg = u.pn * BM + bj * HALF + wc * 32;
            bf16_t* base = nullptr; int pitch = 0, cc = 0, mode = 0; float sc = 1.f;
            if (cg < C_CKV) { base = CQ; pitch = 384; cc = cg; }
            else if (cg < C_QB) { base = CKV; pitch = 256; cc = cg - C_CKV; }
            else if (cg < C_KB) { base = QB; pitch = 512; cc = cg - C_QB; mode = ((cc >> 5) & 1) == 0 ? 1 : 0; sc = C2B; }
            else if (cg < C_VB) { base = KB; pitch = 512; cc = cg - C_KB; mode = ((cc >> 5) & 1) == 0 ? 1 : 0; }
            else if (cg < C_QI) { base = VB; pitch = 512; cc = cg - C_VB; }
            else if (cg < C_KR) { base = QI; pitch = 512; cc = cg - C_QI; mode = ((cc >> 5) & 1) == 0 ? 1 : 0; }
            else if (cg < C_KI) { base = KR; pitch = 32; cc = 0; mode = 2; }
            else if (cg < C_WI) { base = KI; pitch = 64; cc = cg - C_KI; mode = (cc == 0) ? 1 : 0; }
            else if (cg < C_GA) { mode = 4; }
            else if (cg < C_GB) { base = GA; pitch = 1024; cc = cg - C_GA; mode = 3; }
            else { base = GB; pitch = 1024; cc = cg - C_GB; mode = 3; }
#pragma unroll
            for (int ai = 0; ai < 2; ++ai)
#pragma unroll
                for (int m = 0; m < 4; ++m) {
                    const int row = row0 + ai * HALF + m * 16;
                    f32x4 v0 = acc[ai][bj][m][0], v1 = acc[ai][bj][m][1];
                    if (mode == 1) rope16(v0, v1, row, fq, rope);
                    else if (mode == 2) rope32(v0, v1, row, fq, rope);
                    else if (mode == 3) {
#pragma unroll
                        for (int e = 0; e < 4; ++e) { v0[e] = sigmoidf_(v0[e]); v1[e] = sigmoidf_(v1[e]); } }
                    if (mode == 4) { if (fq == 0) { *(f32x4*)(WI + (size_t)row * 8) = v0 * WI_SCALE; *(f32x4*)(WI + (size_t)row * 8 + 4) = v1 * WI_SCALE; } }
                    else { v0 = v0 * sc; v1 = v1 * sc; st8(base + (size_t)row * pitch + cc + 8 * fq, v0, v1); }
                }
        }
    }
};
struct EpiQA {
    static constexpr bool PERM = true, AFTER_DRAIN = false;
    bf16_t* QA; const f32x2* rope;
    __device__ __forceinline__ void operator()(const f32x4 (&acc)[2][2][4][2], const Unit& u, int wr, int wc, int fr, int fq) const {
        const int row0 = u.pm * BM + wr * 64 + fr;
#pragma unroll
        for (int bj = 0; bj < 2; ++bj) {
            const int cg = u.pn * BM + bj * HALF + wc * 32; const bool rot = ((cg >> 5) % 3) == 2;
#pragma unroll
            for (int ai = 0; ai < 2; ++ai)
#pragma unroll
                for (int m = 0; m < 4; ++m) {
                    const int row = row0 + ai * HALF + m * 16;
                    f32x4 v0 = acc[ai][bj][m][0], v1 = acc[ai][bj][m][1];
                    if (rot) rope32(v0, v1, row, fq, rope);
                    v0 = v0 * C2A; v1 = v1 * C2A; st8(QA + (size_t)row * 768 + cg + 8 * fq, v0, v1);
                }
        }
    }
};
struct EpiKV {
    static constexpr bool PERM = true, AFTER_DRAIN = false;
    bf16_t *KN, *VA;
    __device__ __forceinline__ void operator()(const f32x4 (&acc)[2][2][4][2], const Unit& u, int wr, int wc, int fr, int fq) const {
        const int row0 = u.pm * BM + wr * 64 + fr;
#pragma unroll
        for (int bj = 0; bj < 2; ++bj) {
            const int cg = u.pn * BM + bj * HALF + wc * 32; bf16_t* base = cg < 512 ? KN : VA; const int cc = (cg & 511) + 8 * fq;
#pragma unroll
            for (int ai = 0; ai < 2; ++ai)
#pragma unroll
                for (int m = 0; m < 4; ++m) { const int row = row0 + ai * HALF + m * 16; st8(base + (size_t)row * 512 + cc, acc[ai][bj][m][0], acc[ai][bj][m][1]); }
        }
    }
};
template <int ADD> struct EpiY {
    static constexpr bool PERM = true, AFTER_DRAIN = false;
    bf16_t* Y; const bf16_t* Gt;
    __device__ __forceinline__ void operator()(const f32x4 (&acc)[2][2][4][2], const Unit& u, int wr, int wc, int fr, int fq) const {
        const int row0 = u.pm * BM + wr * 64 + fr;
#pragma unroll
        for (int bj = 0; bj < 2; ++bj) {
            const int c0 = u.pn * BM + bj * HALF + wc * 32 + 8 * fq;
#pragma unroll
            for (int ai = 0; ai < 2; ++ai)
#pragma unroll
                for (int m = 0; m < 4; ++m) { const size_t off = (size_t)(row0 + ai * HALF + m * 16) * 1024 + c0;
                    f32x4 g0, g1; ld8(Gt + off, g0, g1);
                    f32x4 v0 = acc[ai][bj][m][0] * g0, v1 = acc[ai][bj][m][1] * g1;
                    if (ADD) { f32x4 o0, o1; ld8(Y + off, o0, o1); v0 = v0 + o0; v1 = v1 + o1; }
                    st8(Y + off, v0, v1); }
        }
    }
};
struct EpiX1 {
    static constexpr bool PERM = false, AFTER_DRAIN = false;
    const float* X; float* O;
    __device__ __forceinline__ void operator()(const f32x4 (&acc)[2][2][4][2], const Unit& u, int wr, int wc, int fr, int fq) const {
        const int row0 = u.pm * BM + wr * 64 + fr, col0 = u.pn * BM + wc * 32 + 4 * fq;
#pragma unroll
        for (int ai = 0; ai < 2; ++ai)
#pragma unroll
            for (int m = 0; m < 4; ++m) { const size_t off = (size_t)(row0 + ai * HALF + m * 16) * 1024 + col0;
#pragma unroll
                for (int bj = 0; bj < 2; ++bj)
#pragma unroll
                    for (int n = 0; n < 2; ++n) { const f32x4 xv = *(const f32x4*)(X + off + bj * HALF + n * 16); *(f32x4*)(O + off + bj * HALF + n * 16) = xv + acc[ai][bj][m][n]; } }
    }
};
struct EpiHid {
    static constexpr bool PERM = true, AFTER_DRAIN = false;
    bf16_t* HID;
    __device__ __forceinline__ void operator()(const f32x4 (&acc)[2][2][4][2], const Unit& u, int wr, int wc, int fr, int fq) const {
        const int row0 = u.pm * BM + wr * 64 + fr, c0 = u.pn * 128 + wc * 32 + 8 * fq;
#pragma unroll
        for (int ai = 0; ai < 2; ++ai)
#pragma unroll
            for (int m = 0; m < 4; ++m) { f32x4 h0, h1;
#pragma unroll
                for (int e = 0; e < 4; ++e) { const float g0 = acc[ai][0][m][0][e], g1 = acc[ai][0][m][1][e];
                    h0[e] = g0 * sigmoidf_(g0) * acc[ai][1][m][0][e]; h1[e] = g1 * sigmoidf_(g1) * acc[ai][1][m][1][e]; }
                st8(HID + (size_t)(row0 + ai * HALF + m * 16) * 256 + c0, h0, h1); }
    }
};
struct EpiDown {
    static constexpr bool PERM = true, AFTER_DRAIN = false;
    bf16_t* SL; const int* sslot; const float* sw;
    __device__ __forceinline__ void operator()(const f32x4 (&acc)[2][2][4][2], const Unit& u, int wr, int wc, int fr, int fq) const {
        const int row0 = u.pm * BM + wr * 64 + fr;
#pragma unroll
        for (int ai = 0; ai < 2; ++ai)
#pragma unroll
            for (int m = 0; m < 4; ++m) { const int r = row0 + ai * HALF + m * 16; const int slot = sslot[r]; const float w = sw[r];
                if (slot >= 0) {
#pragma unroll
                    for (int bj = 0; bj < 2; ++bj) st8(SL + (size_t)slot * 1024 + u.pn * BM + bj * HALF + wc * 32 + 8 * fq, acc[ai][bj][m][0] * w, acc[ai][bj][m][1] * w); } }
    }
};
template <class Epi, class Sched, bool ALIGN_EPI = false, bool SP2 = false>
__device__ __forceinline__ void gemm_phase(PG8_LAS unsigned char* lds, const Gemm g, const Sched& S, const Epi& E) {
    const int tid = threadIdx.x, wid = __builtin_amdgcn_readfirstlane(tid >> 6), lane = tid & 63, wr = wid >> 2, wc = wid & 3, fr = lane & 15, fq = lane >> 4;
    const int K = g.K, nt = K / BK;
    unsigned voffA[2], voffB[2];
#pragma unroll
    for (int i = 0; i < 2; ++i) { int R, C; stage_rc(tid * 16 + i * 8192, R, C); const int Rb = Epi::PERM ? ((R & ~31) + perm32(R & 31)) : R;
        voffA[i] = (unsigned)(R * K + C) * 2u; voffB[i] = (unsigned)(Rb * K + C) * 2u; }
    const size_t kstep = (size_t)(BK * 2);
    const size_t hstep = (size_t)HALF * K * 2;
    const size_t tstep = 2 * hstep;
    const unsigned ldsw = (unsigned)wid * 1024u;
    const int aoff = lds_byte(wr * 64 + fr, fq * 8), boff = lds_byte(wc * 32 + fr, fq * 8);
#define PG8_SA(b, h) (((b) * 2 + (h)) * HTB)
#define PG8_SB(b, h) ((4 + (b) * 2 + (h)) * HTB)
#define PG8_STAGE(bufoff, gbase, voff) do { _Pragma("unroll") for (int _i = 0; _i < 2; ++_i) \
        __builtin_amdgcn_global_load_lds((const unsigned*)((const char*)(gbase) + (voff)[_i]), (PG8_LAS unsigned*)(lds + (bufoff) + ldsw + _i * 8192), 16, 0, 0); } while (0)
#define PG8_LDA(dst, b, h) do { _Pragma("unroll") for (int m = 0; m < 4; ++m) _Pragma("unroll") for (int k = 0; k < 2; ++k) dst[m][k] = *(const PG8_LAS bf16x8*)(lds + PG8_SA(b, h) + aoff + m * 2048 + k * 1024); } while (0)
#define PG8_LDB(dst, b, h) do { _Pragma("unroll") for (int n = 0; n < 2; ++n) _Pragma("unroll") for (int k = 0; k < 2; ++k) dst[n][k] = *(const PG8_LAS bf16x8*)(lds + PG8_SB(b, h) + boff + n * 2048 + k * 1024); } while (0)
#define PG8_MMA(ai, bj, At, Bt) do { __builtin_amdgcn_s_setprio(1); _Pragma("unroll") for (int m = 0; m < 4; ++m) _Pragma("unroll") for (int n = 0; n < 2; ++n) _Pragma("unroll") for (int k = 0; k < 2; ++k) \
        acc[ai][bj][m][n] = __builtin_amdgcn_mfma_f32_16x16x32_bf16(Bt[n][k], At[m][k], acc[ai][bj][m][n], 0, 0, 0); __builtin_amdgcn_s_setprio(0); } while (0)
#define PG8_WAIT_V(n) asm volatile("s_waitcnt vmcnt(" #n ")" ::: "memory")
#define PG8_WAIT_L(n) asm volatile("s_waitcnt lgkmcnt(" #n ")" ::: "memory")
#define PG8_BAR __builtin_amdgcn_s_barrier()
#define PG8_SCHED __builtin_amdgcn_sched_barrier(0)
    Unit cur, nxt; int ui = 0;
    if (!S.next(0, cur)) return;
    f32x4 acc[2][2][4][2];
#pragma unroll
    for (int a = 0; a < 2; ++a)
#pragma unroll
        for (int b = 0; b < 2; ++b)
#pragma unroll
            for (int m = 0; m < 4; ++m)
#pragma unroll
                for (int n = 0; n < 2; ++n) acc[a][b][m][n] = (f32x4){0.f, 0.f, 0.f, 0.f};
    bf16x8 At[4][2], B0[2][2], B1[2][2];
    const char* cA = (const char*)g.A + (size_t)cur.pm * tstep; const char* cB = (const char*)g.Bt + (size_t)cur.e * g.estride + (size_t)cur.pn * tstep;
    S.a_ready(cur);
    if constexpr (SP2) {
        PG8_STAGE(PG8_SB(0, 0), cB, voffB); PG8_STAGE(PG8_SB(0, 1), cB + hstep, voffB); PG8_STAGE(PG8_SA(0, 0), cA, voffA); PG8_STAGE(PG8_SA(0, 1), cA + hstep, voffA);
        if (wr == 1) PG8_BAR;
        PG8_WAIT_V(2); PG8_BAR;
        PG8_STAGE(PG8_SB(1, 0), cB + kstep, voffB); PG8_STAGE(PG8_SA(1, 0), cA + kstep, voffA); PG8_STAGE(PG8_SB(1, 1), cB + hstep + kstep, voffB);
        PG8_WAIT_V(6); PG8_BAR;
    } else {
        PG8_STAGE(PG8_SB(0, 0), cB, voffB); PG8_STAGE(PG8_SA(0, 0), cA, voffA); PG8_STAGE(PG8_SB(0, 1), cB + hstep, voffB); PG8_STAGE(PG8_SA(0, 1), cA + hstep, voffA);
        if (wr == 1) PG8_BAR;
        PG8_WAIT_V(4); PG8_BAR;
        PG8_STAGE(PG8_SB(1, 0), cB + kstep, voffB); PG8_STAGE(PG8_SA(1, 0), cA + kstep, voffA); PG8_STAGE(PG8_SB(1, 1), cB + hstep + kstep, voffB);
        PG8_WAIT_V(6); PG8_BAR;
    }
    for (;;) {
        const bool has_next = S.next(ui + 1, nxt);
        const char* nA = has_next ? (const char*)g.A + (size_t)nxt.pm * tstep : cA; const char* nB = has_next ? (const char*)g.Bt + (size_t)nxt.e * g.estride + (size_t)nxt.pn * tstep : cB;
#pragma nounroll
        for (int t = 0; t < nt; t += 2) {
            const bool last = (t == nt - 2);
            const char* a1 = cA + (size_t)(t + 1) * kstep;
            const char* a2 = last ? nA : cA + (size_t)(t + 2) * kstep; const char* b2 = last ? nB : cB + (size_t)(t + 2) * kstep;
            const char* a3 = a2 + kstep; const char* b3 = b2 + kstep;
            if (last && has_next) S.a_ready(nxt);
            if constexpr (SP2) {
            PG8_LDB(B0, 0, 0); PG8_LDB(B1, 0, 1); PG8_SCHED; PG8_LDA(At, 0, 0); PG8_STAGE(PG8_SA(1, 1), a1 + hstep, voffA);
            PG8_WAIT_V(8); PG8_WAIT_L(0); PG8_BAR; PG8_MMA(0, 0, At, B0); PG8_MMA(0, 1, At, B1); PG8_BAR; PG8_SCHED;
            PG8_LDA(At, 0, 1); PG8_STAGE(PG8_SB(0, 0), b2, voffB); PG8_STAGE(PG8_SB(0, 1), b2 + hstep, voffB); PG8_STAGE(PG8_SA(0, 0), a2, voffA);
            PG8_WAIT_V(8); PG8_WAIT_L(0); PG8_BAR; PG8_MMA(1, 0, At, B0); PG8_MMA(1, 1, At, B1); PG8_BAR; PG8_SCHED;
            PG8_LDB(B0, 1, 0); PG8_LDB(B1, 1, 1); PG8_SCHED; PG8_LDA(At, 1, 0); PG8_STAGE(PG8_SA(0, 1), a2 + hstep, voffA);
            PG8_WAIT_V(8); PG8_WAIT_L(0); PG8_BAR; PG8_MMA(0, 0, At, B0); PG8_MMA(0, 1, At, B1); PG8_BAR; PG8_SCHED;
            PG8_LDA(At, 1, 1); PG8_STAGE(PG8_SB(1, 0), b3, voffB); PG8_STAGE(PG8_SB(1, 1), b3 + hstep, voffB); PG8_STAGE(PG8_SA(1, 0), a3, voffA);
            PG8_WAIT_V(8); PG8_WAIT_L(0); PG8_BAR; PG8_MMA(1, 0, At, B0); PG8_MMA(1, 1, At, B1); PG8_BAR; PG8_SCHED;
            } else {
            PG8_LDB(B0, 0, 0); PG8_SCHED; PG8_LDA(At, 0, 0); PG8_STAGE(PG8_SA(1, 1), a1 + hstep, voffA);
            PG8_WAIT_L(8); PG8_BAR; PG8_WAIT_L(0); PG8_MMA(0, 0, At, B0); PG8_BAR; PG8_SCHED;
            PG8_LDB(B1, 0, 1); PG8_STAGE(PG8_SB(0, 0), b2, voffB);
            PG8_BAR; PG8_WAIT_L(0); PG8_MMA(0, 1, At, B1); PG8_BAR;
            PG8_LDA(At, 0, 1); PG8_STAGE(PG8_SA(0, 0), a2, voffA);
            PG8_BAR; PG8_WAIT_L(0); PG8_MMA(1, 0, At, B0); PG8_BAR; PG8_SCHED;
            PG8_STAGE(PG8_SB(0, 1), b2 + hstep, voffB);
            PG8_WAIT_V(6); PG8_BAR; PG8_MMA(1, 1, At, B1); PG8_BAR;
            PG8_LDB(B0, 1, 0); PG8_SCHED; PG8_LDA(At, 1, 0); PG8_STAGE(PG8_SA(0, 1), a2 + hstep, voffA);
            PG8_WAIT_L(8); PG8_BAR; PG8_WAIT_L(0); PG8_MMA(0, 0, At, B0); PG8_BAR; PG8_SCHED;
            PG8_LDB(B1, 1, 1); PG8_STAGE(PG8_SB(1, 0), b3, voffB);
            PG8_BAR; PG8_WAIT_L(0); PG8_MMA(0, 1, At, B1); PG8_BAR;
            PG8_LDA(At, 1, 1); PG8_STAGE(PG8_SA(1, 0), a3, voffA);
            PG8_BAR; PG8_WAIT_L(0); PG8_MMA(1, 0, At, B0); PG8_BAR; PG8_SCHED;
            PG8_STAGE(PG8_SB(1, 1), b3 + hstep, voffB);
            PG8_WAIT_V(6); PG8_BAR; PG8_MMA(1, 1, At, B1); PG8_BAR;
            }
        }
        if constexpr (ALIGN_EPI) { if (wr == 0) PG8_BAR; }
        if constexpr (!Epi::AFTER_DRAIN) { E(acc, cur, wr, wc, fr, fq); S.done(cur); }
        if (!has_next) break;
#pragma unroll
        for (int a = 0; a < 2; ++a)
#pragma unroll
            for (int b = 0; b < 2; ++b)
#pragma unroll
                for (int m = 0; m < 4; ++m)
#pragma unroll
                    for (int n = 0; n < 2; ++n) acc[a][b][m][n] = (f32x4){0.f, 0.f, 0.f, 0.f};
        cur = nxt; cA = nA; cB = nB; ++ui;
        if constexpr (ALIGN_EPI) { if (wr == 1) PG8_BAR; }
    }
    PG8_WAIT_V(0);
    if constexpr (!ALIGN_EPI) { if (wr == 0) PG8_BAR; }
    PG8_BAR;
    if constexpr (Epi::AFTER_DRAIN) { E.fused(acc, cur, wr, wc, fr, fq, lds, wid, lane); S.done(cur); }
#undef PG8_SA
#undef PG8_SB
#undef PG8_STAGE
#undef PG8_LDA
#undef PG8_LDB
#undef PG8_MMA
#undef PG8_WAIT_V
#undef PG8_WAIT_L
#undef PG8_BAR
#undef PG8_SCHED
}
}

struct Args { const float* in[20]; float* out; unsigned char* ws; int ph_lo, ph_hi; };
struct Frame {
    LAS unsigned char* lds; volatile LAS unsigned* MISC; gu32* ctl; unsigned char* ws;
    int vcu, G;
};
#define F_TID ((int)threadIdx.x)
#define F_LANE ((int)(threadIdx.x & 63))
#define F_WAVE (__builtin_amdgcn_readfirstlane((int)(threadIdx.x >> 6)))

__device__ __forceinline__ int in_src_col(int n) {
    if (n < 640) return n;
    if (n < 2688) return n + 32;
    if (n < 2720) return n - 2688 + 640;
    if (n < 2792) return n;
    if (n < 2816) return -1;
    return n - 24;
}
__device__ __forceinline__ void tr_item(const float* colptr, int ld, int k0, bf16* WT, int Kd, int destrow0, LAS float* scr, int lane) {
#pragma unroll 8
    for (int i = 0; i < 32; ++i) { const int kk = 2 * i + (lane >> 5); scr[kk * 33 + (lane & 31)] = colptr ? colptr[(size_t)(k0 + kk) * ld] : 0.f; }
    LDS_WAIT(); asm volatile("" ::: "memory");
    const int c = lane & 7;
#pragma unroll
    for (int j = 0; j < 4; ++j) { const int n = (lane >> 3) + 8 * j; const LAS float* s = scr + (8 * c) * 33 + n;
        v4u o; o.x = pk2(s[0 * 33], s[1 * 33]); o.y = pk2(s[2 * 33], s[3 * 33]); o.z = pk2(s[4 * 33], s[5 * 33]); o.w = pk2(s[6 * 33], s[7 * 33]);
        *(GAS v4u*)(WT + (size_t)(destrow0 + n) * Kd + k0 + 8 * c) = o; }
    LDS_WAIT(); asm volatile("" ::: "memory");
}
__device__ __forceinline__ void p0_prologue(Frame& F, const Args& A) {
    LAS float* scr = (LAS float*)(F.lds + F_WAVE * 16384);
    const int gw = F.vcu * NWAVES + F_WAVE, NGW = F.G * NWAVES, lane = F_LANE;
    unsigned char* ws = F.ws;
    constexpr int I0 = 16 * 152, I1 = 6 * 24, I2 = 4 * 32, I3 = 8 * 32, I4 = 8 * 32, I5 = 16 * 32, I6 = 32 * 16 * 16, I7 = 32 * 4 * 32;
    constexpr int NITEMS = I0 + I1 + I2 + I3 + I4 + I5 + I6 + I7;
    for (int it = gw; it < NITEMS; it += NGW) {
        int r = it;
        if (r < I0) { const int kb = r / 152, nb = r % 152; const int col = in_src_col(32 * nb + (lane & 31));
            tr_item(col >= 0 ? A.in[2] + col : nullptr, NIN_SRC, 64 * kb, (bf16*)(ws + WS_WIN), 1024, 32 * nb, scr, lane); continue; } r -= I0;
        if (r < I1) { const int kb = r / 24, nb = r % 24; tr_item(A.in[4] + 32 * nb + (lane & 31), 768, 64 * kb, (bf16*)(ws + WS_WUQ), 384, 32 * nb, scr, lane); continue; } r -= I1;
        if (r < I2) { const int kb = r / 32, nb = r % 32; const int n = 32 * nb + (lane & 31);
            tr_item(n < 512 ? A.in[6] + n : A.in[7] + (n - 512), 512, 64 * kb, (bf16*)(ws + WS_WUKV), 256, 32 * nb, scr, lane); continue; } r -= I2;
        if (r < I3) { const int kb = r / 32, nb = r % 32; tr_item(A.in[8] + 32 * nb + (lane & 31), 1024, 64 * kb, (bf16*)(ws + WS_WOA), 512, 32 * nb, scr, lane); continue; } r -= I3;
        if (r < I4) { const int kb = r / 32, nb = r % 32; tr_item(A.in[9] + 32 * nb + (lane & 31), 1024, 64 * kb, (bf16*)(ws + WS_WOB), 512, 32 * nb, scr, lane); continue; } r -= I4;
        if (r < I5) { const int kb = r / 32, nb = r % 32; tr_item(A.in[10] + 32 * nb + (lane & 31), 1024, 64 * kb, (bf16*)(ws + WS_WOUT), 1024, 32 * nb, scr, lane); continue; } r -= I5;
        if (r < I6) { const int e = r / 256, rr = r % 256, kb = rr / 16, nb = rr % 16; const int n = 32 * nb + (lane & 31), pn = n >> 8, c = n & 255, col = 128 * pn + (c & 127);
            const float* src = ((c >> 7) ? A.in[17] : A.in[16]) + (size_t)e * 1024 * 256 + col;
            tr_item(src, 256, 64 * kb, (bf16*)(ws + WS_WGU) + (size_t)e * 512 * 1024, 1024, 32 * nb, scr, lane); continue; } r -= I6;
        { const int e = r / 128, rr = r % 128, kb = rr / 32, nb = rr % 32;
            tr_item(A.in[18] + (size_t)e * 256 * 1024 + 32 * nb + (lane & 31), 1024, 64 * kb, (bf16*)(ws + WS_WD) + (size_t)e * 1024 * 256, 256, 32 * nb, scr, lane); }
    }
    const float* x = A.in[0]; const float* g1 = A.in[1]; bf16* H = (bf16*)(ws + WS_H);
    for (int m = gw; m < T; m += NGW) {
        const GAS f32x4* xr = (const GAS f32x4*)(x + (size_t)m * D) + lane;
        f32x4 v[4]; float s = 0.f;
#pragma unroll
        for (int j = 0; j < 4; ++j) { v[j] = xr[64 * j]; s += (v[j].x * v[j].x + v[j].y * v[j].y) + (v[j].z * v[j].z + v[j].w * v[j].w); }
        const float rstd = 1.f / sqrtf(wave_sum(s) * (1.f / D) + EPS);
        GAS v2u* o8 = (GAS v2u*)(H + (size_t)m * D) + lane;
#pragma unroll
        for (int j = 0; j < 4; ++j) { const f32x4 g = *((const GAS f32x4*)g1 + lane + 64 * j); const f32x4 y = v[j] * rstd * g; v2u w; w.x = pk2(y.x, y.y); w.y = pk2(y.z, y.w); o8[64 * j] = w; }
    }
    f32x2* rope = (f32x2*)(ws + WS_ROPE);
    for (int idx = (F.vcu * NTHR + F_TID); idx < SEQ * 16; idx += F.G * NTHR) {
        const int pos = idx >> 4, i = idx & 15;
        const double REV[16] = {0.15915494309189535, 0.0700865215877985, 0.03086376340470123, 0.013591370636193905, 0.005985185712713705, 0.002635675898667414, 0.001160663641240061, 0.0005111175045375439,
                                0.00022507907903927653, 9.911730936901935e-05, 4.364795279280289e-05, 1.9221100684944863e-05, 8.464330808241401e-06, 3.727408601915352e-06, 1.6414262627950345e-06, 7.228293068832865e-07};
        double rv = 0.0;
#pragma unroll
        for (int k = 0; k < 16; ++k) rv = (i == k) ? REV[k] : rv;
        double t = (double)pos * rv; t -= __builtin_floor(t);
        const float tf = (float)t;
        rope[idx] = (f32x2){__builtin_amdgcn_cosf(tf), __builtin_amdgcn_sinf(tf)};
    }
}

__device__ __forceinline__ void p2a_norms(Frame& F, const Args& A) {
    const int gw = F.vcu * NWAVES + F_WAVE, NGW = F.G * NWAVES, lane = F_LANE;
    bf16* CQ = (bf16*)(F.ws + WS_CQ); bf16* CKV = (bf16*)(F.ws + WS_CKV);
    const float* gq = A.in[3]; const float* gkv = A.in[5];
    for (int m = gw; m < T; m += NGW) {
        {
            GAS unsigned* p = (GAS unsigned*)(CQ + (size_t)m * 384) + lane; unsigned w[3]; float s = 0.f;
#pragma unroll
            for (int j = 0; j < 3; ++j) { w[j] = p[64 * j]; const float a = bflo(w[j]), b = bfhi(w[j]); s += a * a + b * b; }
            const float rstd = 1.f / sqrtf(wave_sum(s) * (1.f / 384.f) + EPS);
#pragma unroll
            for (int j = 0; j < 3; ++j) { const f32x2 g = *((const GAS f32x2*)gq + lane + 64 * j); p[64 * j] = pk2(bflo(w[j]) * rstd * g.x, bfhi(w[j]) * rstd * g.y); }
        }
        {
            GAS v2u* p = (GAS v2u*)(CKV + (size_t)m * 256) + lane; const v2u w = *p;
            const float a = bflo(w.x), b = bfhi(w.x), c = bflo(w.y), d = bfhi(w.y);
            const float rstd = 1.f / sqrtf(wave_sum(a * a + b * b + c * c + d * d) * (1.f / 256.f) + EPS);
            const f32x4 g = *((const GAS f32x4*)gkv + lane); v2u o; o.x = pk2(a * rstd * g.x, b * rstd * g.y); o.y = pk2(c * rstd * g.z, d * rstd * g.w); *p = o;
        }
    }
}

__device__ __forceinline__ constexpr int crow(int r, int hi) { return (r & 3) + 8 * (r >> 2) + 4 * hi; }
struct AttnP { const bf16 *Q, *K, *K2, *V; bf16* O; const unsigned* BM; };
template <bool MLA> __device__ __forceinline__ void attn_unit(LAS unsigned char* L, int b, int h, int qb, const AttnP& P, int tid, int lane, int wave) {
    constexpr int DK = MLA ? 96 : 64, KP = DK * 2 + 16, NS = DK / 16, CPR = DK / 8;
    constexpr int QPITCH = MLA ? 768 : 512, VP = 192, KBUF = 64 * KP, VBUF = 64 * VP;
    const int r32 = lane & 31, hi = lane >> 5;
    const size_t rowb = (size_t)b * SEQ;
    const int qrow = qb * 256 + wave * 32 + r32;
    bf16x8 qf[NS];
    { const bf16* qp = P.Q + (rowb + qrow) * QPITCH + h * DK;
#pragma unroll
      for (int s = 0; s < NS; ++s) qf[s] = *(const bf16x8*)(qp + 16 * s + 8 * hi); }
    const int NT = 4 * qb + 4, my_nt = 4 * qb + (wave >> 1) + 1;
    const int kid0 = tid, kid1 = tid + NTHR;
    const int kr0 = kid0 / CPR, kc0 = kid0 % CPR, kr1 = kid1 / CPR, kc1 = kid1 % CPR; const bool has1 = MLA && (kid1 < 64 * CPR);
    const int vr = tid >> 3, vc = tid & 7;
    v4u kreg0, kreg1 = (v4u){0u, 0u, 0u, 0u}, vreg;
#define ATT_KSRC(t, kr, kc) (MLA ? ((kc) < 8 ? (const v4u*)(P.K + (rowb + 64 * (t) + (kr)) * 512 + h * 64 + 8 * (kc)) : (const v4u*)(P.K2 + (rowb + 64 * (t) + (kr)) * 32 + 8 * ((kc) - 8))) \
                                 : (const v4u*)(P.K + (rowb + 64 * (t) + (kr)) * 512 + h * 64 + 8 * (kc)))
#define ATT_LOAD(t) do { kreg0 = *ATT_KSRC(t, kr0, kc0); if (has1) kreg1 = *ATT_KSRC(t, kr1, kc1); vreg = *(const v4u*)(P.V + (rowb + 64 * (t) + vr) * 512 + h * 64 + 8 * vc); } while (0)
#define ATT_WRITE(buf) do { *(LAS v4u*)(L + (buf) * KBUF + kr0 * KP + kc0 * 16) = kreg0; if (has1) *(LAS v4u*)(L + (buf) * KBUF + kr1 * KP + kc1 * 16) = kreg1; \
                            *(LAS v4u*)(L + 2 * KBUF + (buf) * VBUF + vr * VP + vc * 16) = vreg; } while (0)
    float m = -1e30f, l = 0.f; f32x16 o0, o1;
#pragma unroll
    for (int i = 0; i < 16; ++i) { o0[i] = 0.f; o1[i] = 0.f; }
    const int g16 = lane >> 4, qq = (lane & 15) >> 2, pp = lane & 3;
    const int vlane = (4 * hi + qq) * VP + (16 * (g16 & 1) + 4 * pp) * 2;
    ATT_LOAD(0); ATT_WRITE(0); __syncthreads();
    for (int t = 0; t < NT; ++t) {
        const int buf = t & 1;
        if (t + 1 < NT) ATT_LOAD(t + 1);
        if (t < my_nt) {
            const LAS unsigned char* Kb = L + buf * KBUF; const LAS unsigned char* Vb = L + 2 * KBUF + buf * VBUF;
            f32x16 s0, s1;
#pragma unroll
            for (int i = 0; i < 16; ++i) { s0[i] = 0.f; s1[i] = 0.f; }
#pragma unroll
            for (int s = 0; s < NS; ++s) {
                const bf16x8 a0 = *(const LAS bf16x8*)(Kb + r32 * KP + s * 32 + hi * 16);
                const bf16x8 a1 = *(const LAS bf16x8*)(Kb + (32 + r32) * KP + s * 32 + hi * 16);
                s0 = __builtin_amdgcn_mfma_f32_32x32x16_bf16(a0, qf[s], s0, 0, 0, 0);
                s1 = __builtin_amdgcn_mfma_f32_32x32x16_bf16(a1, qf[s], s1, 0, 0, 0);
            }
            unsigned w0 = 0xffffffffu, w1 = 0xffffffffu;
            if (!MLA) { const unsigned* bp = P.BM + ((size_t)b * 256 + 2 * t) * SEQ + qrow; w0 = bp[0] >> (4 * hi); w1 = bp[SEQ] >> (4 * hi);
#pragma unroll
                for (int i = 0; i < 16; ++i) { if (!((w0 >> crow(i, 0)) & 1u)) s0[i] = -1e30f; if (!((w1 >> crow(i, 0)) & 1u)) s1[i] = -1e30f; } }
            float mx = s0[0];
#pragma unroll
            for (int i = 1; i < 16; ++i) mx = fmaxf(mx, s0[i]);
#pragma unroll
            for (int i = 0; i < 16; ++i) mx = fmaxf(mx, s1[i]);
            mx = fmaxf(mx, __shfl_xor(mx, 32));
            const float mn = fmaxf(m, mx), alpha = __builtin_amdgcn_exp2f(m - mn); m = mn;
            float rs = 0.f;
#pragma unroll
            for (int i = 0; i < 16; ++i) {
                float p0 = __builtin_amdgcn_exp2f(s0[i] - m), p1 = __builtin_amdgcn_exp2f(s1[i] - m);
                if (!MLA) { if (!((w0 >> crow(i, 0)) & 1u)) p0 = 0.f; if (!((w1 >> crow(i, 0)) & 1u)) p1 = 0.f; }
                s0[i] = p0; s1[i] = p1; rs += p0 + p1; }
            l = l * alpha + rs;
#pragma unroll
            for (int i = 0; i < 16; ++i) { o0[i] *= alpha; o1[i] *= alpha; }
            bf16x8 pf[4];
#pragma unroll
            for (int ks = 0; ks < 4; ++ks) { v4u w;
#pragma unroll
                for (int j = 0; j < 4; ++j) { const float a = (ks < 2) ? s0[8 * (ks & 1) + 2 * j] : s1[8 * (ks & 1) + 2 * j], c = (ks < 2) ? s0[8 * (ks & 1) + 2 * j + 1] : s1[8 * (ks & 1) + 2 * j + 1]; w[j] = pk2(a, c); }
                pf[ks] = __builtin_bit_cast(bf16x8, w); }
#pragma unroll
            for (int ks = 0; ks < 4; ++ks) {
                const LAS unsigned char* vp = Vb + ks * 16 * VP + vlane;
                const s16x4 a00 = __builtin_bit_cast(s16x4, __builtin_amdgcn_ds_read_tr16_b64_v4i16((LAS s16x4*)(vp)));
                const s16x4 a01 = __builtin_bit_cast(s16x4, __builtin_amdgcn_ds_read_tr16_b64_v4i16((LAS s16x4*)(vp + 8 * VP)));
                const s16x4 a10 = __builtin_bit_cast(s16x4, __builtin_amdgcn_ds_read_tr16_b64_v4i16((LAS s16x4*)(vp + 64)));
                const s16x4 a11 = __builtin_bit_cast(s16x4, __builtin_amdgcn_ds_read_tr16_b64_v4i16((LAS s16x4*)(vp + 8 * VP + 64)));
                const bf16x8 A0 = (bf16x8){a00[0], a00[1], a00[2], a00[3], a01[0], a01[1], a01[2], a01[3]};
                const bf16x8 A1 = (bf16x8){a10[0], a10[1], a10[2], a10[3], a11[0], a11[1], a11[2], a11[3]};
                o0 = __builtin_amdgcn_mfma_f32_32x32x16_bf16(A0, pf[ks], o0, 0, 0, 0);
                o1 = __builtin_amdgcn_mfma_f32_32x32x16_bf16(A1, pf[ks], o1, 0, 0, 0);
            }
        }
        if (t + 1 < NT) ATT_WRITE(buf ^ 1);
        __syncthreads();
    }
    l += __shfl_xor(l, 32);
    const float inv = 1.f / l;
    bf16* op = P.O + (rowb + qrow) * 512 + h * 64 + 4 * hi;
#pragma unroll
    for (int g = 0; g < 4; ++g) {
        v2u w; w.x = pk2(o0[4 * g] * inv, o0[4 * g + 1] * inv); w.y = pk2(o0[4 * g + 2] * inv, o0[4 * g + 3] * inv); *(v2u*)(op + 8 * g) = w;
        v2u z; z.x = pk2(o1[4 * g] * inv, o1[4 * g + 1] * inv); z.y = pk2(o1[4 * g + 2] * inv, o1[4 * g + 3] * inv); *(v2u*)(op + 32 + 8 * g) = z;
    }
#undef ATT_KSRC
#undef ATT_LOAD
#undef ATT_WRITE
}

constexpr int CAND_CAP = 128;
struct IdxP { const bf16 *QI, *KI; const float* WI; unsigned* BM; };
__device__ __forceinline__ unsigned mono_key(float s) { unsigned u = __builtin_bit_cast(unsigned, s); if (u == 0x80000000u) u = 0u; return (u >> 31) ? ~u : (u | 0x80000000u); }
__device__ __forceinline__ void idx_item(LAS unsigned char* L, int b, int j, const IdxP& P, int tid, int lane, int wave) {
    LAS unsigned* hist = (LAS unsigned*)L;
    LAS unsigned* img = (LAS unsigned*)(L + 65536);
    LAS unsigned* st = (LAS unsigned*)(L + 98304);
    LAS unsigned* cand = hist;
    const int r32 = lane & 31, hi = lane >> 5;
    const int q0 = 32 * j, ntile = 2 * (j / 2 + 1);
    const size_t rowb = (size_t)b * SEQ;
    if (ntile <= 8) {
        for (int idx = tid; idx < ntile * 32; idx += NTHR) P.BM[((size_t)b * 256 + (idx >> 5)) * SEQ + q0 + (idx & 31)] = 0xffffffffu;
        return;
    }
    float wq[8];
    LAS unsigned char* Qs = L + 99328;
    { for (int c = tid; c < 32 * 64; c += NTHR) { const int rr = c >> 6, ch = c & 63; *(LAS v4u*)(Qs + rr * 1040 + ch * 16) = *(const v4u*)(P.QI + (rowb + q0 + rr) * 512 + ch * 8); }
      const float* wp = P.WI + (rowb + q0 + r32) * 8;
#pragma unroll
      for (int h = 0; h < 8; ++h) wq[h] = wp[h]; }
    const LAS unsigned char* qlane = Qs + r32 * 1040 + hi * 16;
    if (tid < 32) { st[tid] = 0u; st[32 + tid] = 256u; st[64 + tid] = 0u; st[96 + tid] = 0u; }
    int level = 0;
#define IDX_SCORES(t) \
        bf16x8 kf[4]; { const bf16* kp = P.KI + (rowb + 32 * (t) + r32) * 64 + 8 * hi; _Pragma("unroll") for (int s = 0; s < 4; ++s) kf[s] = *(const bf16x8*)(kp + 16 * s); } \
        f32x16 sc; _Pragma("unroll") for (int i = 0; i < 16; ++i) sc[i] = 0.f; \
        _Pragma("unroll") for (int h = 0; h < 8; ++h) { f32x16 a; _Pragma("unroll") for (int i = 0; i < 16; ++i) a[i] = 0.f; \
            _Pragma("unroll") for (int s = 0; s < 4; ++s) a = __builtin_amdgcn_mfma_f32_32x32x16_bf16(kf[s], *(const LAS bf16x8*)(qlane + h * 128 + s * 32), a, 0, 0, 0); \
            _Pragma("unroll") for (int i = 0; i < 16; ++i) { sc[i] = __builtin_fmaf(wq[h], fmaxf(a[i], 0.f), sc[i]); asm volatile("" : "+v"(sc[i])); } }
    for (;;) {
        ++level;
        for (int u = tid; u < 32 * 512; u += NTHR) hist[u] = 0u;
        if (tid == 0) st[128] = 0u;
        __syncthreads();
        {
            const unsigned pfx = st[r32];
            const int shp = 32 - 10 * (level - 1), shb = level < 4 ? 32 - 10 * level : 0; const unsigned msk = level < 4 ? 1023u : 3u;
            for (int t = wave; t < ntile; t += NWAVES) {
                IDX_SCORES(t)
#pragma unroll
                for (int i = 0; i < 16; ++i) { const unsigned key = mono_key(sc[i]);
                    const bool inr = (level == 1) || ((key >> shp) == pfx);
                    const unsigned bin = (key >> shb) & msk;
                    if (inr) __hip_atomic_fetch_add(&hist[r32 * 512 + (bin >> 1)], 1u << (16 * (bin & 1)), __ATOMIC_RELAXED, __HIP_MEMORY_SCOPE_WORKGROUP); }
            }
        }
        __syncthreads();
        {
            const int q = tid >> 4, seg = tid & 15;
            unsigned segsum = 0u;
            for (int wi = 0; wi < 32; ++wi) { const unsigned w = hist[q * 512 + seg * 32 + wi]; segsum += (w & 0xffffu) + (w >> 16); }
            unsigned S = segsum;
#pragma unroll
            for (int off = 1; off < 16; off <<= 1) { const unsigned o = __shfl_down(S, off, 16); if (seg + off < 16) S += o; }
            const unsigned above = S - segsum, need = st[32 + q];
            if (above < need && need <= above + segsum) {
                unsigned cum = above, fbin = 0u, fneed = 1u, fcnt = 0u; bool found = false;
                for (int wi = 31; wi >= 0; --wi) { const unsigned w = hist[q * 512 + seg * 32 + wi];
                    const unsigned ch = w >> 16, cl = w & 0xffffu;
                    if (!found && cum + ch >= need) { found = true; fbin = 64 * seg + 2 * wi + 1; fneed = need - cum; fcnt = ch; } if (!found) cum += ch;
                    if (!found && cum + cl >= need) { found = true; fbin = 64 * seg + 2 * wi; fneed = need - cum; fcnt = cl; } if (!found) cum += cl; }
                st[q] = (level < 4) ? ((st[q] << 10) | fbin) : ((st[q] << 2) | fbin);
                st[32 + q] = fneed; st[64 + q] = fcnt;
                if (fcnt > (unsigned)CAND_CAP) st[128] = 1u;
            }
        }
        __syncthreads();
        const bool more = (st[128] != 0u) && (level < 4);
        __syncthreads();
        if (!more) break;
    }
    {
        const unsigned pfx = st[r32]; const int sh = level < 4 ? 32 - 10 * level : 0;
        for (int t = wave; t < ntile; t += NWAVES) {
            IDX_SCORES(t)
            unsigned bits = 0u;
#pragma unroll
            for (int i = 0; i < 16; ++i) { const unsigned key = mono_key(sc[i]); const unsigned hp = key >> sh;
                if (hp > pfx) bits |= 1u << crow(i, 0);
                else if (hp == pfx) { const unsigned pos = __hip_atomic_fetch_add(&st[96 + r32], 1u, __ATOMIC_RELAXED, __HIP_MEMORY_SCOPE_WORKGROUP);
                    if (pos < (unsigned)CAND_CAP) { cand[(r32 * CAND_CAP + pos) * 2] = key; cand[(r32 * CAND_CAP + pos) * 2 + 1] = (unsigned)(32 * t + crow(i, hi)); } } }
            bits <<= 4 * hi;
            bits |= __shfl_xor(bits, 32);
            if (hi == 0) img[t * 32 + r32] = bits;
        }
    }
    __syncthreads();
    {
        const int q = tid >> 4; const unsigned n = min(st[96 + q], (unsigned)CAND_CAP), need = st[32 + q];
        for (unsigned c = tid & 15; c < n; c += 16) { const unsigned key = cand[(q * CAND_CAP + c) * 2], idx = cand[(q * CAND_CAP + c) * 2 + 1]; unsigned rank = 0u;
            for (unsigned o = 0; o < n; ++o) { const unsigned k2 = cand[(q * CAND_CAP + o) * 2], i2 = cand[(q * CAND_CAP + o) * 2 + 1]; rank += (k2 > key || (k2 == key && i2 < idx)) ? 1u : 0u; }
            if (rank < need) __hip_atomic_fetch_or(&img[(idx >> 5) * 32 + q], 1u << (idx & 31), __ATOMIC_RELAXED, __HIP_MEMORY_SCOPE_WORKGROUP); }
    }
    __syncthreads();
    for (int idx = tid; idx < ntile * 32; idx += NTHR) P.BM[((size_t)b * 256 + (idx >> 5)) * SEQ + q0 + (idx & 31)] = img[idx];
    __syncthreads();
#undef IDX_SCORES
}

__device__ __forceinline__ int wq_next(Frame& F, int cw) {
    __syncthreads();
    if (F_TID == 0) F.MISC[0] = __hip_atomic_fetch_add((unsigned*)(F.ctl + cw), 1u, RLX_AGENT);
    __syncthreads();
    return (int)F.MISC[0];
}

__device__ __forceinline__ void p5a_route(Frame& F, const Args& A) {
    const int lane = F_LANE;
    const float* x1 = A.out; const float* g2 = A.in[11];
    const float* wrg = A.in[12]; const float* brg = A.in[13]; const float* wre = A.in[14]; const float* bre = A.in[15];
    int* toke = (int*)(F.ws + WS_TOKE); float* tokw = (float*)(F.ws + WS_TOKW); float* rstd2 = (float*)(F.ws + WS_RSTD2);
    int* sslot = (int*)(F.ws + WS_SSLOT);
    LAS unsigned* lcnt = (LAS unsigned*)F.lds;
    for (int i = F.vcu * NTHR + F_TID; i < SORT_ROWS; i += F.G * NTHR) sslot[i] = -1;
    if (F_TID < NEXP) lcnt[F_TID] = 0u;
    __syncthreads();
    const int gw = F.vcu * NWAVES + F_WAVE, NGW = F.G * NWAVES;
    for (int m = gw; m < T; m += NGW) {
        const GAS f32x4* xr = (const GAS f32x4*)(x1 + (size_t)m * D) + lane;
        f32x4 v[4]; float s = 0.f;
#pragma unroll
        for (int j = 0; j < 4; ++j) { v[j] = xr[64 * j]; s += (v[j].x * v[j].x + v[j].y * v[j].y) + (v[j].z * v[j].z + v[j].w * v[j].w); }
        const float rstd = 1.f / sqrtf(wave_sum(s) * (1.f / D) + EPS);
        float lg[40];
#pragma unroll
        for (int k = 0; k < 40; ++k) lg[k] = 0.f;
#pragma unroll
        for (int j = 0; j < 4; ++j) { const f32x4 g = *((const GAS f32x4*)g2 + lane + 64 * j); const f32x4 hv = v[j] * rstd * g;
#pragma unroll
            for (int e = 0; e < 4; ++e) { const int d = 4 * lane + 256 * j + e; const float hd = hv[e];
                const GAS f32x4* pg = (const GAS f32x4*)(wrg + (size_t)d * 8); const GAS f32x4* pe = (const GAS f32x4*)(wre + (size_t)d * 32);
#pragma unroll
                for (int k4 = 0; k4 < 2; ++k4) { const f32x4 w = pg[k4];
#pragma unroll
                    for (int c = 0; c < 4; ++c) lg[4 * k4 + c] = __builtin_fmaf(hd, w[c], lg[4 * k4 + c]); }
#pragma unroll
                for (int k4 = 0; k4 < 8; ++k4) { const f32x4 w = pe[k4];
#pragma unroll
                    for (int c = 0; c < 4; ++c) lg[8 + 4 * k4 + c] = __builtin_fmaf(hd, w[c], lg[8 + 4 * k4 + c]); } } }
#pragma unroll
        for (int k = 0; k < 40; ++k) lg[k] = wave_sum(lg[k]);
        float gl[8];
#pragma unroll
        for (int k = 0; k < 8; ++k) gl[k] = lg[k] + brg[k];
        int gs = 0; float gm = gl[0];
#pragma unroll
        for (int k = 1; k < 8; ++k) if (gl[k] > gm) { gm = gl[k]; gs = k; }
        float den = 0.f;
#pragma unroll
        for (int k = 0; k < 8; ++k) den += __expf(gl[k] - gm);
        const float wgrp = 1.f / den;
        float el[4];
#pragma unroll
        for (int c = 0; c < 4; ++c) { float a = 0.f;
#pragma unroll
            for (int k = 0; k < 8; ++k) a = (gs == k) ? lg[8 + 4 * k + c] + bre[4 * k + c] : a;
            el[c] = a; }
        int i1 = 0; float v1 = el[0];
#pragma unroll
        for (int c = 1; c < 4; ++c) if (el[c] > v1) { v1 = el[c]; i1 = c; }
        int i2 = -1; float v2 = 0.f;
#pragma unroll
        for (int c = 0; c < 4; ++c) if (c != i1 && (i2 < 0 || el[c] > v2)) { v2 = el[c]; i2 = c; }
        const float e2 = __expf(v2 - v1), w1 = 1.f / (1.f + e2), w2 = e2 / (1.f + e2);
        if (lane == 0) {
            toke[2 * m] = gs * 4 + i1; toke[2 * m + 1] = gs * 4 + i2; tokw[2 * m] = w1 * wgrp; tokw[2 * m + 1] = w2 * wgrp; rstd2[m] = rstd;
            __hip_atomic_fetch_add(&lcnt[gs * 4 + i1], 1u, __ATOMIC_RELAXED, __HIP_MEMORY_SCOPE_WORKGROUP);
            __hip_atomic_fetch_add(&lcnt[gs * 4 + i2], 1u, __ATOMIC_RELAXED, __HIP_MEMORY_SCOPE_WORKGROUP);
        }
    }
    __syncthreads();
    if (F_TID < NEXP && lcnt[F_TID]) __hip_atomic_fetch_add((unsigned*)(F.ctl + CW_CNT + F_TID), lcnt[F_TID], RLX_AGENT);
}

__device__ __forceinline__ void p5a2_scatter(Frame& F, const Args& A) {
    const int lane = F_LANE, tid = F_TID;
    const float* x1 = A.out; const float* g2 = A.in[11];
    const int* toke = (const int*)(F.ws + WS_TOKE); const float* tokw = (const float*)(F.ws + WS_TOKW); const float* rstd2 = (const float*)(F.ws + WS_RSTD2);
    int* sslot = (int*)(F.ws + WS_SSLOT); float* sw = (float*)(F.ws + WS_SW); int* t2e = (int*)(F.ws + WS_T2E);
    bf16* AS = (bf16*)(F.ws + WS_ASORT);
    LAS unsigned* sh = (LAS unsigned*)F.lds;
    if (tid == 0) { unsigned acc = 0u;
        for (int e = 0; e < NEXP; ++e) { const unsigned c = __hip_atomic_load((unsigned*)(F.ctl + CW_CNT + e), RLX_AGENT); sh[e] = acc; const unsigned nt = (c + 255u) / 256u;
            if (blockIdx.x == 0) for (unsigned i = 0; i < nt; ++i) t2e[acc / 256u + i] = e;
            acc += nt * 256u; }
        if (blockIdx.x == 0) t2e[255] = (int)(acc / 256u); }
    const int per = T / F.G;
    for (int t0 = F.vcu * per; t0 < (F.vcu + 1) * per; t0 += 64) {
        if (tid < NEXP) sh[32 + tid] = 0u;
        __syncthreads();
        int e = 0; unsigned lpos = 0u;
        if (tid < 128) { e = toke[2 * t0 + tid]; lpos = __hip_atomic_fetch_add(&sh[32 + e], 1u, __ATOMIC_RELAXED, __HIP_MEMORY_SCOPE_WORKGROUP); }
        __syncthreads();
        if (tid < NEXP) sh[64 + tid] = sh[tid] + (sh[32 + tid] ? __hip_atomic_fetch_add((unsigned*)(F.ctl + CW_FILL + tid), sh[32 + tid], RLX_AGENT) : 0u);
        __syncthreads();
        if (tid < 128) { const unsigned pos = sh[64 + e] + lpos; sh[96 + tid] = pos; sslot[pos] = 2 * t0 + tid; sw[pos] = tokw[2 * t0 + tid]; }
        __syncthreads();
        for (int tk = F_WAVE; tk < 64; tk += NWAVES) { const int m = t0 + tk;
            const GAS f32x4* xr = (const GAS f32x4*)(x1 + (size_t)m * D) + lane; const float rstd = rstd2[m];
            const unsigned p0 = sh[96 + 2 * tk], p1 = sh[96 + 2 * tk + 1];
#pragma unroll
            for (int j = 0; j < 4; ++j) { const f32x4 g = *((const GAS f32x4*)g2 + lane + 64 * j); const f32x4 y = xr[64 * j] * rstd * g; v2u w; w.x = pk2(y.x, y.y); w.y = pk2(y.z, y.w);
                *((GAS v2u*)(AS + (size_t)p0 * D) + lane + 64 * j) = w; *((GAS v2u*)(AS + (size_t)p1 * D) + lane + 64 * j) = w; } }
        __syncthreads();
    }
}

__device__ __forceinline__ void p6_final(Frame& F, const Args& A) {
    const int gw = F.vcu * NWAVES + F_WAVE, NGW = F.G * NWAVES, lane = F_LANE;
    const float* gf = A.in[19]; float* out = A.out; const bf16* SL = (const bf16*)(F.ws + WS_SLOTS);
    for (int m = gw; m < T; m += NGW) {
        GAS f32x4* xr = (GAS f32x4*)(out + (size_t)m * D) + lane;
        const GAS v2u* s0 = (const GAS v2u*)(SL + (size_t)(2 * m) * D) + lane; const GAS v2u* s1 = (const GAS v2u*)(SL + (size_t)(2 * m + 1) * D) + lane;
        f32x4 v[4]; float s = 0.f;
#pragma unroll
        for (int j = 0; j < 4; ++j) { const v2u a = s0[64 * j], c = s1[64 * j]; v[j] = xr[64 * j];
            v[j].x += bflo(a.x) + bflo(c.x); v[j].y += bfhi(a.x) + bfhi(c.x); v[j].z += bflo(a.y) + bflo(c.y); v[j].w += bfhi(a.y) + bfhi(c.y);
            s += (v[j].x * v[j].x + v[j].y * v[j].y) + (v[j].z * v[j].z + v[j].w * v[j].w); }
        const float rstd = 1.f / sqrtf(wave_sum(s) * (1.f / D) + EPS);
#pragma unroll
        for (int j = 0; j < 4; ++j) { const f32x4 g = *((const GAS f32x4*)gf + lane + 64 * j); xr[64 * j] = v[j] * rstd * g; }
    }
}

constexpr int NPHASE = 13;
__global__ void __launch_bounds__(NTHR, 2) mk_fwd(Args args) {
    extern __shared__ __attribute__((aligned(16))) unsigned char lds[];
    Frame F;
    F.lds = (LAS unsigned char*)lds; F.MISC = (volatile LAS unsigned*)(F.lds + MISC_OFF);
        F.G = gridDim.x; { const int bx = blockIdx.x; F.vcu = (F.G % 8 == 0) ? (bx % 8) * (F.G / 8) + bx / 8 : bx; }
    F.ws = args.ws; F.ctl = (gu32*)(args.ws + WS_CTL);
    unsigned char* ws = args.ws;
    if (F_TID < 128) F.MISC[F_TID] = 0u;
    __syncthreads();
    const bool single = (args.ph_hi - args.ph_lo) > 1;
    XcdBarrier bar; bar.bar = (unsigned*)(F.ctl + CW_BAR); bar.x = 0; bar.st = nullptr;
    if (single) bar = xcd_barrier_post((unsigned*)(F.ctl + CW_BAR), F.MISC + 8);
    const int lo = args.ph_lo, hi = args.ph_hi;
#ifdef ONLY
#define IN(k) ((k) == ONLY && lo <= (k) && (k) < hi)
#else
#define IN(k) (lo <= (k) && (k) < hi)
#endif
#define SEAM(k) do { if (IN((k) + 1)) xcd_barrier(bar); } while (0)
    const f32x2* rope = (const f32x2*)(ws + WS_ROPE);
    bf16* GA = (bf16*)args.out; bf16* GB = (bf16*)args.out + (size_t)T * 1024;

    if (IN(0)) { p0_prologue(F, args); SEAM(0); }
    if (IN(1)) {
        pg8::Gemm g{(const bf16*)(ws + WS_H), (const bf16*)(ws + WS_WIN), T, NIN, D, 0}; pg8::StaticOrder S; S.init(T, NIN, F.G, (int)blockIdx.x);
        pg8::EpiIn E{(bf16*)(ws + WS_CQ), (bf16*)(ws + WS_CKV), (bf16*)(ws + WS_QB), (bf16*)(ws + WS_KB), (bf16*)(ws + WS_VB), (bf16*)(ws + WS_QI), (bf16*)(ws + WS_KI), (bf16*)(ws + WS_KR), GA, GB, (float*)(ws + WS_WI), rope};
        pg8::gemm_phase<pg8::EpiIn, pg8::StaticOrder, true, true>(F.lds, g, S, E);
        SEAM(1);
    }
    if (IN(2)) { p2a_norms(F, args); SEAM(2); }
    if (IN(3)) {
#ifndef NO3A
        { pg8::Gemm g{(const bf16*)(ws + WS_CQ), (const bf16*)(ws + WS_WUQ), T, 768, 384, 0}; pg8::StaticOrder S; S.init(T, 768, F.G, (int)blockIdx.x);
          pg8::EpiQA E{(bf16*)(ws + WS_QA), rope}; pg8::gemm_phase<pg8::EpiQA, pg8::StaticOrder, true, true>(F.lds, g, S, E); }
#endif
#ifndef NO3B
        { pg8::Gemm g{(const bf16*)(ws + WS_CKV), (const bf16*)(ws + WS_WUKV), T, 1024, 256, 0}; pg8::StaticOrder S; S.init(T, 1024, F.G, (int)blockIdx.x);
          pg8::EpiKV E{(bf16*)(ws + WS_KN), (bf16*)(ws + WS_VA)}; pg8::gemm_phase<pg8::EpiKV, pg8::StaticOrder, true, true>(F.lds, g, S, E); }
#endif
        SEAM(3);
    }
    if (IN(4)) {
        const AttnP AP{(const bf16*)(ws + WS_QA), (const bf16*)(ws + WS_KN), (const bf16*)(ws + WS_KR), (const bf16*)(ws + WS_VA), (bf16*)(ws + WS_OA), nullptr};
        const IdxP IP{(const bf16*)(ws + WS_QI), (const bf16*)(ws + WS_KI), (const float*)(ws + WS_WI), (unsigned*)(ws + WS_BM)};
        for (;;) { const int k = wq_next(F, CW_Q1); if (k >= 1024) break;
            const int u = k >> 1;
            int ltid = threadIdx.x; asm volatile("" : "+v"(ltid));
#ifndef NOIDX
            if (k & 1) idx_item(F.lds, u & 1, 255 - (u >> 1), IP, ltid, ltid & 63, __builtin_amdgcn_readfirstlane(ltid >> 6));
#endif
#ifndef NOMLA
            if (!(k & 1)) attn_unit<true>(F.lds, (u & 15) >> 3, u & 7, 31 - (u >> 4), AP, ltid, ltid & 63, __builtin_amdgcn_readfirstlane(ltid >> 6));
#endif
        }
        SEAM(4);
    }
    if (IN(5)) {
        const AttnP AP{(const bf16*)(ws + WS_QB), (const bf16*)(ws + WS_KB), nullptr, (const bf16*)(ws + WS_VB), (bf16*)(ws + WS_OB), (const unsigned*)(ws + WS_BM)};
        for (;;) { const int u = wq_next(F, CW_Q2); if (u >= 512) break;
            int ltid = threadIdx.x; asm volatile("" : "+v"(ltid));
            attn_unit<false>(F.lds, (u & 15) >> 3, u & 7, 31 - (u >> 4), AP, ltid, ltid & 63, __builtin_amdgcn_readfirstlane(ltid >> 6)); }
        SEAM(5);
    }
    if (IN(6)) {
        { pg8::Gemm g{(const bf16*)(ws + WS_OA), (const bf16*)(ws + WS_WOA), T, 1024, 512, 0}; pg8::StaticOrder S; S.init(T, 1024, F.G, (int)blockIdx.x);
          pg8::EpiY<0> E{(bf16*)(ws + WS_Y), GA}; pg8::gemm_phase<pg8::EpiY<0>, pg8::StaticOrder, true, true>(F.lds, g, S, E); }
        { pg8::Gemm g{(const bf16*)(ws + WS_OB), (const bf16*)(ws + WS_WOB), T, 1024, 512, 0}; pg8::StaticOrder S; S.init(T, 1024, F.G, (int)blockIdx.x);
          pg8::EpiY<1> E{(bf16*)(ws + WS_Y), GB}; pg8::gemm_phase<pg8::EpiY<1>, pg8::StaticOrder, true, true>(F.lds, g, S, E); }
        SEAM(6);
    }
    if (IN(7)) {
        pg8::Gemm g{(const bf16*)(ws + WS_Y), (const bf16*)(ws + WS_WOUT), T, 1024, 1024, 0}; pg8::StaticOrder S; S.init(T, 1024, F.G, (int)blockIdx.x);
        pg8::EpiX1 E{args.in[0], args.out}; pg8::gemm_phase<pg8::EpiX1, pg8::StaticOrder, true, true>(F.lds, g, S, E);
        SEAM(7);
    }
    if (IN(8)) { p5a_route(F, args); SEAM(8); }
    if (IN(9)) { p5a2_scatter(F, args); SEAM(9); }
    if (IN(10)) {
        const int* t2e = (const int*)(ws + WS_T2E); const int ntl = t2e[255];
        pg8::Gemm g{(const bf16*)(ws + WS_ASORT), (const bf16*)(ws + WS_WGU), SORT_ROWS, 512, 1024, (size_t)512 * 1024 * 2}; pg8::GroupOrder S; S.init(ntl, 2, F.G, (int)blockIdx.x, t2e);
        pg8::EpiHid E{(bf16*)(ws + WS_HID)}; pg8::gemm_phase<pg8::EpiHid, pg8::GroupOrder, true, true>(F.lds, g, S, E);
        SEAM(10);
    }
    if (IN(11)) {
        const int* t2e = (const int*)(ws + WS_T2E); const int ntl = t2e[255];
        pg8::Gemm g{(const bf16*)(ws + WS_HID), (const bf16*)(ws + WS_WD), SORT_ROWS, 1024, 256, (size_t)1024 * 256 * 2}; pg8::GroupOrder S; S.init(ntl, 4, F.G, (int)blockIdx.x, t2e);
        pg8::EpiDown E{(bf16*)(ws + WS_SLOTS), (const int*)(ws + WS_SSLOT), (const float*)(ws + WS_SW)}; pg8::gemm_phase<pg8::EpiDown, pg8::GroupOrder, true, true>(F.lds, g, S, E);
        SEAM(11);
    }
    if (IN(12)) { p6_final(F, args); }
#undef IN
#undef SEAM
}

#ifndef MK_MULTI
#define MK_MULTI 0
#endif
extern "C" void kernel_launch(void* const* d_in, const int* in_sizes, int n_in, void* d_out, int out_size, void* d_ws, size_t ws_size, hipStream_t stream) {
    static int grid = 0;
    if (grid == 0) {
        if (n_in != 20 || in_sizes[0] != T * D || out_size != T * D || ws_size < WS_END) { fprintf(stderr, "kernel_launch: unexpected shapes n_in %d in0 %d out %d ws %zu\n", n_in, n_in > 0 ? in_sizes[0] : -1, out_size, ws_size); grid = -1; return; }
        int dev = 0, cus = 0;
        if (hipGetDevice(&dev) != hipSuccess || hipDeviceGetAttribute(&cus, hipDeviceAttributeMultiprocessorCount, dev) != hipSuccess) { grid = -1; return; }
        if (hipFuncSetAttribute((const void*)mk_fwd, hipFuncAttributeMaxDynamicSharedMemorySize, LDS_BYTES) != hipSuccess) { fprintf(stderr, "kernel_launch: hipFuncSetAttribute failed\n"); grid = -1; return; }
        (void)hipGetLastError();
        grid = cus;
    }
    if (grid < 0) return;
    if (hipMemsetAsync((char*)d_ws + WS_CTL, 0, CTL_ZERO_BYTES, stream) != hipSuccess) return;
    Args a{};
    for (int i = 0; i < 20; ++i) a.in[i] = (const float*)d_in[i];
    a.out = (float*)d_out; a.ws = (unsigned char*)d_ws;
#if MK_MULTI
    for (int p = 0; p < NPHASE; ++p) { a.ph_lo = p; a.ph_hi = p + 1; hipLaunchKernelGGL(mk_fwd, dim3(grid), dim3(NTHR), LDS_BYTES, stream, a); }
#else
    a.ph_lo = 0; a.ph_hi = NPHASE;
    hipLaunchKernelGGL(mk_fwd, dim3(grid), dim3(NTHR), LDS_BYTES, stream, a);
#endif
}
```

```cpp
#include <hip/hip_runtime.h>
#include <cstdio>
#include <cstdint>

#define GAS __attribute__((address_space(1)))
#define LAS __attribute__((address_space(3)))
typedef unsigned short bf16;
typedef unsigned v4u __attribute__((ext_vector_type(4)));
typedef unsigned v2u __attribute__((ext_vector_type(2)));
typedef float f32x4 __attribute__((ext_vector_type(4)));
typedef float f32x2 __attribute__((ext_vector_type(2)));
typedef float f32x16 __attribute__((ext_vector_type(16)));
typedef short bf16x8 __attribute__((ext_vector_type(8)));
typedef short s16x4 __attribute__((ext_vector_type(4)));
typedef __bf16 bf16x2_t __attribute__((ext_vector_type(2)));
typedef GAS unsigned gu32;
#define RLX_AGENT __ATOMIC_RELAXED, __HIP_MEMORY_SCOPE_AGENT
#define LDS_WAIT() asm volatile("s_waitcnt lgkmcnt(0)" ::: "memory")
#define VM_WAIT() asm volatile("s_waitcnt vmcnt(0)" ::: "memory")

constexpr int NWAVES = 8, NTHR = NWAVES * 64;
constexpr int BATCH = 2, SEQ = 8192, D = 1024, T = BATCH * SEQ;
constexpr float EPS = 1e-6f;
constexpr int NIN = 4864, NIN_SRC = 4840;
constexpr int C_CQ = 0, C_CKV = 384, C_QB = 640, C_KB = 1152, C_VB = 1664, C_QI = 2176, C_KR = 2688, C_KI = 2720, C_WI = 2784, C_GA = 2816, C_GB = 3840;
constexpr int NEXP = 32, FF = 256;
constexpr int SORT_ROWS = 2 * T + NEXP * 256;
constexpr float LOG2E = 1.4426950408889634f;
constexpr float C2A = 0.10206207261596575f * LOG2E;
constexpr float C2B = 0.125f * LOG2E;
constexpr float WI_SCALE = 0.35355339059327373f * 0.125f;

constexpr size_t MiB = 1u << 20, KiB = 1u << 10;
constexpr size_t WS_CTL = 0, CTL_ZERO_BYTES = 1 * MiB;
constexpr size_t WS_ROPE = 1 * MiB;
constexpr size_t WS_WI = 2 * MiB;
constexpr size_t WS_TOKE = 2 * MiB + 512 * KiB;
constexpr size_t WS_TOKW = WS_TOKE + 128 * KiB;
constexpr size_t WS_RSTD2 = WS_TOKW + 128 * KiB;
constexpr size_t WS_SSLOT = 3 * MiB + 512 * KiB;
constexpr size_t WS_SW = WS_SSLOT + 192 * KiB;
constexpr size_t WS_T2E = WS_SW + 192 * KiB;
constexpr size_t WS_WIN = 4 * MiB, WS_WUQ = 14 * MiB, WS_WUKV = 15 * MiB, WS_WOA = 16 * MiB, WS_WOB = 17 * MiB, WS_WOUT = 18 * MiB, WS_WGU = 20 * MiB, WS_WD = 52 * MiB;
constexpr size_t WS_H = 68 * MiB, WS_OA = 68 * MiB, WS_OB = 84 * MiB;
constexpr size_t WS_QA = 100 * MiB, WS_KN = 124 * MiB, WS_VA = 140 * MiB, WS_Y = 100 * MiB;
constexpr size_t WS_QB = 156 * MiB, WS_KB = 172 * MiB, WS_VB = 188 * MiB;
constexpr size_t WS_CQ = 204 * MiB, WS_CKV = 216 * MiB, WS_BM = 204 * MiB;
constexpr size_t WS_QI = 224 * MiB, WS_KI = 240 * MiB, WS_KR = 242 * MiB;
constexpr size_t WS_ASORT = 68 * MiB, WS_SLOTS = 156 * MiB, WS_HID = 220 * MiB;
constexpr size_t WS_END = 256 * MiB;
constexpr int CW_BAR = 4096;
constexpr int CW_Q1 = 64, CW_Q2 = 128;
constexpr int CW_CNT = 256, CW_FILL = 320;

constexpr int LDS_BYTES = 147456;
constexpr int MISC_OFF = 147456 - 512;

__device__ __forceinline__ unsigned f2bf(float f) { unsigned u = __builtin_bit_cast(unsigned, f); return (u + 0x7fffu + ((u >> 16) & 1u)) >> 16; }
__device__ __forceinline__ unsigned pk2(float lo, float hi) { f32x2 v = {lo, hi}; bf16x2_t b = __builtin_convertvector(v, bf16x2_t); return __builtin_bit_cast(unsigned, b); }
__device__ __forceinline__ float bflo(unsigned w) { return __builtin_bit_cast(float, w << 16); }
__device__ __forceinline__ float bfhi(unsigned w) { return __builtin_bit_cast(float, w & 0xffff0000u); }

#define XB_TMO      128
#define XB_XCNT(j)  (256  + 64 * (j))
#define XB_XSUB(j)  (1280 + 64 * (j))
#define XB_XGEN(j)  (2304 + 64 * (j))
#define XB_TOP      3328
#define XB_TOPGEN   3392
#define XCD_BAR_WORDS 3456
#define XB_SPIN_CAP (1u << 22)
__device__ __forceinline__ unsigned xb_ld(unsigned* p)              { return __hip_atomic_load(p, __ATOMIC_RELAXED, __HIP_MEMORY_SCOPE_AGENT); }
__device__ __forceinline__ unsigned xb_add(unsigned* p, unsigned v) { return __hip_atomic_fetch_add(p, v, __ATOMIC_RELAXED, __HIP_MEMORY_SCOPE_AGENT); }
__device__ __forceinline__ unsigned xb_xcc_id() { return (unsigned)__builtin_amdgcn_s_getreg((3 << 11) | 20) & 0xFu; }
#define XB_SPIN(cond, bar) do { unsigned _sp = 0; while (cond) { __builtin_amdgcn_s_sleep(1); \
    if ((++_sp & 255u) == 0u) { if (xb_ld(&(bar)[XB_TMO])) break; if (_sp > XB_SPIN_CAP) { atomicAdd(&(bar)[XB_TMO], 1u); break; } } } } while (0)
struct XcdBarrier { unsigned* bar; unsigned x; volatile LAS unsigned* st; };
__device__ __forceinline__ XcdBarrier xcd_barrier_post(unsigned* bar, volatile LAS unsigned* st) {
    XcdBarrier b; b.bar = bar; b.x = xb_xcc_id(); b.st = st;
    if (threadIdx.x == 0) (void)xb_add(&bar[XB_XCNT(b.x)], 1u);
    return b;
}
__device__ __forceinline__ void xcd_barrier_complete(unsigned* bar, unsigned x, unsigned& nloc, unsigned& nx) {
    const unsigned G = gridDim.x * gridDim.y * gridDim.z;
    unsigned sum, cnt, mine, sp = 0u;
    for (;;) {
        sum = 0u; cnt = 0u; mine = 0u;
#pragma unroll
        for (unsigned j = 0; j < 16; ++j) { const unsigned c = xb_ld(&bar[XB_XCNT(j)]); sum += c; cnt += (c > 0u) ? 1u : 0u; mine = (j == x) ? c : mine; }
        if (sum == G) break;
        __builtin_amdgcn_s_sleep(1);
        if ((++sp & 255u) == 0u) { if (xb_ld(&bar[XB_TMO])) break; if (sp > XB_SPIN_CAP) { atomicAdd(&bar[XB_TMO], 1u); break; } }
    }
    nloc = mine > 0u ? mine : 1u; nx = cnt > 0u ? cnt : 1u;
}
__device__ __forceinline__ void xcd_barrier(const XcdBarrier& b) {
    asm volatile("s_waitcnt vmcnt(0)" ::: "memory");
    __syncthreads();
    if (threadIdx.x == 0) {
        unsigned* bar = b.bar;
        __builtin_amdgcn_s_waitcnt(0);
        unsigned nloc = b.st[0], nx = b.st[1];
        if (nloc == 0u) { xcd_barrier_complete(bar, b.x, nloc, nx); b.st[0] = nloc; b.st[1] = nx; }
        const unsigned old = xb_add(&bar[XB_XSUB(b.x)], 1u);
        const unsigned gen = old / nloc;
        if (old + 1u == (gen + 1u) * nloc) {
            __builtin_amdgcn_fence(__ATOMIC_RELEASE, "agent");
            asm volatile("s_waitcnt vmcnt(0)" ::: "memory");
            const unsigned og = xb_add(&bar[XB_TOP], 1u);
            const unsigned tg = og / nx;
            if (og + 1u == (tg + 1u) * nx) xb_add(&bar[XB_TOPGEN], 1u);
            else XB_SPIN(xb_ld(&bar[XB_TOPGEN]) == tg, bar);
            __builtin_amdgcn_fence(__ATOMIC_ACQUIRE, "agent");
            xb_add(&bar[XB_XGEN(b.x)], 1u);
            asm volatile("s_waitcnt vmcnt(0)" ::: "memory");
        } else {
            XB_SPIN(xb_ld(&bar[XB_XGEN(b.x)]) == gen, bar);
            __builtin_amdgcn_fence(__ATOMIC_ACQUIRE, "agent");
            asm volatile("s_waitcnt vmcnt(0)" ::: "memory");
        }
    }
    __syncthreads();
}

__device__ __forceinline__ float wave_sum(float v) {
#pragma unroll
    for (int o = 1; o < 64; o <<= 1) v += __shfl_xor(v, o);
    return v;
}

namespace pg8 {
#define PG8_LAS __attribute__((address_space(3)))
typedef unsigned short bf16_t;
typedef unsigned u32x4 __attribute__((ext_vector_type(4)));
constexpr int BM = 256, BK = 64, HALF = 128, HTB = HALF * BK * 2, STAGE_BYTES = 8 * HTB, NXCD = 8, WGM = 8;
__host__ __device__ __forceinline__ int lds_byte(int r, int c) { const int st = (r >> 4) * 2 + (c >> 5), rr = r & 15, cc = c & 31, ob = rr * 64 + cc * 2; return st * 1024 + (ob ^ (((ob >> 9) & 1) << 5)); }
__host__ __device__ __forceinline__ void stage_rc(int b, int& R, int& C) { const int st = b / 1024, sb = b % 1024, swz = sb ^ (((sb >> 9) & 1) << 5); R = (st >> 1) * 16 + swz / 64; C = (st & 1) * 32 + (swz % 64) / 2; }
__host__ __device__ __forceinline__ int perm32(int rho) { const int n = rho >> 4, i = rho & 15; return 8 * (i >> 2) + 4 * n + (i & 3); }

struct Unit { int pm, pn, e; };
struct Gemm { const bf16_t* A; const bf16_t* Bt; int M, N, K; size_t estride; };

struct StaticOrder {
    int nM, nN, nwg, G, c;
    __host__ __device__ void init(int M, int N, int G_, int c_) { nM = M / BM; nN = N / BM; nwg = nM * nN; G = G_; c = c_; }
    __host__ __device__ bool next(int i, Unit& u) const {
        const long L = (long)i * G + c; if (L >= nwg) return false;
        int wgid = (int)L; { const int q = nwg / NXCD, r = nwg % NXCD, xcd = wgid % NXCD, off = wgid / NXCD; wgid = (xcd < r ? xcd * (q + 1) : r * (q + 1) + (xcd - r) * q) + off; }
        const int nig = WGM * nN, gid = wgid / nig, fm = gid * WGM, gsz = (nM - fm) < WGM ? (nM - fm) : WGM;
        u.pm = fm + ((wgid % nig) % gsz); u.pn = (wgid % nig) / gsz; u.e = 0; return true;
    }
    __device__ __forceinline__ void a_ready(const Unit&) const {}
    __device__ __forceinline__ void done(const Unit&) const {}
};
struct GroupOrder {
    int nN, total, G, c; const int* t2e;
    __device__ void init(int nTiles, int nN_, int G_, int c_, const int* t2e_) { nN = nN_; total = nTiles * nN_; G = G_; c = c_; t2e = t2e_; }
    __device__ bool next(int i, Unit& u) const {
        const long L = (long)i * G + c; if (L >= total) return false;
        u.pm = (int)(L / nN); u.pn = (int)(L % nN); u.e = __builtin_amdgcn_readfirstlane(t2e[u.pm]); return true;
    }
    __device__ __forceinline__ void a_ready(const Unit&) const {}
    __device__ __forceinline__ void done(const Unit&) const {}
};

__device__ __forceinline__ void st8(bf16_t* p, f32x4 v0, f32x4 v1) { u32x4 w; w.x = pk2(v0[0], v0[1]); w.y = pk2(v0[2], v0[3]); w.z = pk2(v1[0], v1[1]); w.w = pk2(v1[2], v1[3]); *(u32x4*)p = w; }
__device__ __forceinline__ void ld8(const bf16_t* p, f32x4& v0, f32x4& v1) { const u32x4 w = *(const u32x4*)p; v0 = (f32x4){bflo(w.x), bfhi(w.x), bflo(w.y), bfhi(w.y)}; v1 = (f32x4){bflo(w.z), bfhi(w.z), bflo(w.w), bfhi(w.w)}; }

__device__ __forceinline__ void rope16(f32x4& v0, f32x4& v1, int row, int fq, const f32x2* rope) {
    const f32x2* rp = rope + (size_t)(row & (SEQ - 1)) * 16;
    f32x4 p0, p1;
#pragma unroll
    for (int e = 0; e < 4; ++e) { p0[e] = __shfl_xor(v0[e], 16); p1[e] = __shfl_xor(v1[e], 16); }
    if (fq < 2) {
        const float sg = fq == 0 ? -1.f : 1.f;
#pragma unroll
        for (int e = 0; e < 4; ++e) { const f32x2 a = rp[2 * e], b = rp[2 * (4 + e)];
            v0[e] = v0[e] * a.x + sg * p0[e] * a.y; v1[e] = v1[e] * b.x + sg * p1[e] * b.y; }
    }
}
__device__ __forceinline__ void rope32(f32x4& v0, f32x4& v1, int row, int fq, const f32x2* rope) {
    const f32x2* rp = rope + (size_t)(row & (SEQ - 1)) * 16 + 8 * (fq & 1);
    const float sg = fq < 2 ? -1.f : 1.f;
#pragma unroll
    for (int e = 0; e < 4; ++e) { const float p0 = __shfl_xor(v0[e], 32), p1 = __shfl_xor(v1[e], 32); const f32x2 a = rp[e], b = rp[4 + e];
        v0[e] = v0[e] * a.x + sg * p0 * a.y; v1[e] = v1[e] * b.x + sg * p1 * b.y; }
}
__device__ __forceinline__ float sigmoidf_(float x) { return 1.f / (1.f + __expf(-x)); }

struct EpiIn {
    static constexpr bool PERM = true, AFTER_DRAIN = false;
    bf16_t *CQ, *CKV, *QB, *KB, *VB, *QI, *KI, *KR, *GA, *GB; float* WI; const f32x2* rope;
    __device__ __forceinline__ void operator()(const f32x4 (&acc)[2][2][4][2], const Unit& u, int wr, int wc, int fr, int fq) const {
        const int row0 = u.pm * BM + wr * 64 + fr;
#pragma unroll
        for (int bj = 0; bj < 2; ++bj) {
            const int cg = u.pn * BM + bj * HALF + wc * 32;
            bf16_t* base = nullptr; int pitch = 0, cc = 0, mode = 0; float sc = 1.f;
            if (cg < C_CKV) { base = CQ; pitch = 384; cc = cg; }
            else if (cg < C_QB) { base = CKV; pitch = 256; cc = cg - C_CKV; }
            else if (cg < C_KB) { base = QB; pitch = 512; cc = cg - C_QB; mode = ((cc >> 5) & 1) == 0 ? 1 : 0; sc = C2B; }
            else if (cg < C_VB) { base = KB; pitch = 512; cc = cg - C_KB; mode = ((cc >> 5) & 1) == 0 ? 1 : 0; }
            else if (cg < C_QI) { base = VB; pitch = 512; cc = cg - C_VB; }
            else if (cg < C_KR) { base = QI; pitch = 512; cc = cg - C_QI; mode = ((cc >> 5) & 1) == 0 ? 1 : 0; }
            else if (cg < C_KI) { base = KR; pitch = 32; cc = 0; mode = 2; }
            else if (cg < C_WI) { base = KI; pitch = 64; cc = cg - C_KI; mode = (cc == 0) ? 1 : 0; }
            else if (cg < C_GA) { mode = 4; }
            else if (cg < C_GB) { base = GA; pitch = 1024; cc = cg - C_GA; mode = 3; }
            else { base = GB; pitch = 1024; cc = cg - C_GB; mode = 3; }
#pragma unroll
            for (int ai = 0; ai < 2; ++ai)
#pragma unroll
                for (int m = 0; m < 4; ++m) {
                    const int row = row0 + ai * HALF + m * 16;
                    f32x4 v0 = acc[ai][bj][m][0], v1 = acc[ai][bj][m][1];
                    if (mode == 1) rope16(v0, v1, row, fq, rope);
                    else if (mode == 2) rope32(v0, v1, row, fq, rope);
                    else if (mode == 3) {
#pragma unroll
                        for (int e = 0; e < 4; ++e) { v0[e] = sigmoidf_(v0[e]); v1[e] = sigmoidf_(v1[e]); } }
                    if (mode == 4) { if (fq == 0) { *(f32x4*)(WI + (size_t)row * 8) = v0 * WI_SCALE; *(f32x4*)(WI + (size_t)row * 8 + 4) = v1 * WI_SCALE; } }
                    else { v0 = v0 * sc; v1 = v1 * sc; st8(base + (size_t)row * pitch + cc + 8 * fq, v0, v1); }
                }
        }
    }
};
struct EpiQA {
    static constexpr bool PERM = true, AFTER_DRAIN = false;
    bf16_t* QA; const f32x2* rope;
    __device__ __forceinline__ void operator()(const f32x4 (&acc)[2][2][4][2], const Unit& u, int wr, int wc, int fr, int fq) const {
        const int row0 = u.pm * BM + wr * 64 + fr;
#pragma unroll
        for (int bj = 0; bj < 2; ++bj) {
            const int cg = u.pn * BM + bj * HALF + wc * 32; const bool rot = ((cg >> 5) % 3) == 2;
#pragma unroll
            for (int ai = 0; ai < 2; ++ai)
#pragma unroll
                for (int m = 0; m < 4; ++m) {
                    const int row = row0 + ai * HALF + m * 16;
                    f32x4 v0 = acc[ai][bj][m][0], v1 = acc[ai][bj][m][1];
                    if (rot) rope32(v0, v1, row, fq, rope);
                    v0 = v0 * C2A; v1 = v1 * C2A; st8(QA + (size_t)row * 768 + cg + 8 * fq, v0, v1);
                }
        }
    }
};
struct EpiKV {
    static constexpr bool PERM = true, AFTER_DRAIN = false;
    bf16_t *KN, *VA;
    __device__ __forceinline__ void operator()(const f32x4 (&acc)[2][2][4][2], const Unit& u, int wr, int wc, int fr, int fq) const {
        const int row0 = u.pm * BM + wr * 64 + fr;
#pragma unroll
        for (int bj = 0; bj < 2; ++bj) {
            const int cg = u.pn * BM + bj * HALF + wc * 32; bf16_t* base = cg < 512 ? KN : VA; const int cc = (cg & 511) + 8 * fq;
#pragma unroll
            for (int ai = 0; ai < 2; ++ai)
#pragma unroll
                for (int m = 0; m < 4; ++m) { const int row = row0 + ai * HALF + m * 16; st8(base + (size_t)row * 512 + cc, acc[ai][bj][m][0], acc[ai][bj][m][1]); }
        }
    }
};
template <int ADD> struct EpiY {
    static constexpr bool PERM = true, AFTER_DRAIN = false;
    bf16_t* Y; const bf16_t* Gt;
    __device__ __forceinline__ void operator()(const f32x4 (&acc)[2][2][4][2], const Unit& u, int wr, int wc, int fr, int fq) const {
        const int row0 = u.pm * BM + wr * 64 + fr;
#pragma unroll
        for (int bj = 0; bj < 2; ++bj) {
            const int c0 = u.pn * BM + bj * HALF + wc * 32 + 8 * fq;
#pragma unroll
            for (int ai = 0; ai < 2; ++ai)
#pragma unroll
                for (int m = 0; m < 4; ++m) { const size_t off = (size_t)(row0 + ai * HALF + m * 16) * 1024 + c0;
                    f32x4 g0, g1; ld8(Gt + off, g0, g1);
                    f32x4 v0 = acc[ai][bj][m][0] * g0, v1 = acc[ai][bj][m][1] * g1;
                    if (ADD) { f32x4 o0, o1; ld8(Y + off, o0, o1); v0 = v0 + o0; v1 = v1 + o1; }
                    st8(Y + off, v0, v1); }
        }
    }
};
struct EpiX1 {
    static constexpr bool PERM = false, AFTER_DRAIN = false;
    const float* X; float* O;
    __device__ __forceinline__ void operator()(const f32x4 (&acc)[2][2][4][2], const Unit& u, int wr, int wc, int fr, int fq) const {
        const int row0 = u.pm * BM + wr * 64 + fr, col0 = u.pn * BM + wc * 32 + 4 * fq;
#pragma unroll
        for (int ai = 0; ai < 2; ++ai)
#pragma unroll
            for (int m = 0; m < 4; ++m) { const size_t off = (size_t)(row0 + ai * HALF + m * 16) * 1024 + col0;
#pragma unroll
                for (int bj = 0; bj < 2; ++bj)
#pragma unroll
                    for (int n = 0; n < 2; ++n) { const f32x4 xv = *(const f32x4*)(X + off + bj * HALF + n * 16); *(f32x4*)(O + off + bj * HALF + n * 16) = xv + acc[ai][bj][m][n]; } }
    }
};
struct EpiHid {
    static constexpr bool PERM = true, AFTER_DRAIN = false;
    bf16_t* HID;
    __device__ __forceinline__ void operator()(const f32x4 (&acc)[2][2][4][2], const Unit& u, int wr, int wc, int fr, int fq) const {
        const int row0 = u.pm * BM + wr * 64 + fr, c0 = u.pn * 128 + wc * 32 + 8 * fq;
#pragma unroll
        for (int ai = 0; ai < 2; ++ai)
#pragma unroll
            for (int m = 0; m < 4; ++m) { f32x4 h0, h1;
#pragma unroll
                for (int e = 0; e < 4; ++e) { const float g0 = acc[ai][0][m][0][e], g1 = acc[ai][0][m][1][e];
                    h0[e] = g0 * sigmoidf_(g0) * acc[ai][1][m][0][e]; h1[e] = g1 * sigmoidf_(g1) * acc[ai][1][m][1][e]; }
                st8(HID + (size_t)(row0 + ai * HALF + m * 16) * 256 + c0, h0, h1); }
    }
};
struct EpiDown {
    static constexpr bool PERM = true, AFTER_DRAIN = false;
    bf16_t* SL; const int* sslot; const float* sw;
    __device__ __forceinline__ void operator()(const f32x4 (&acc)[2][2][4][2], const Unit& u, int wr, int wc, int fr, int fq) const {
        const int row0 = u.pm * BM + wr * 64 + fr;
#pragma unroll
        for (int ai = 0; ai < 2; ++ai)
#pragma unroll
            for (int m = 0; m < 4; ++m) { const int r = row0 + ai * HALF + m * 16; const int slot = sslot[r]; const float w = sw[r];
                if (slot >= 0) {
#pragma unroll
                    for (int bj = 0; bj < 2; ++bj) st8(SL + (size_t)slot * 1024 + u.pn * BM + bj * HALF + wc * 32 + 8 * fq, acc[ai][bj][m][0] * w, acc[ai][bj][m][1] * w); } }
    }
};
template <class Epi, class Sched, bool ALIGN_EPI = false, bool SP2 = false>
__device__ __forceinline__ void gemm_phase(PG8_LAS unsigned char* lds, const Gemm g, const Sched& S, const Epi& E) {
    const int tid = threadIdx.x, wid = __builtin_amdgcn_readfirstlane(tid >> 6), lane = tid & 63, wr = wid >> 2, wc = wid & 3, fr = lane & 15, fq = lane >> 4;
    const int K = g.K, nt = K / BK;
    unsigned voffA[2], voffB[2];
#pragma unroll
    for (int i = 0; i < 2; ++i) { int R, C; stage_rc(tid * 16 + i * 8192, R, C); const int Rb = Epi::PERM ? ((R & ~31) + perm32(R & 31)) : R;
        voffA[i] = (unsigned)(R * K + C) * 2u; voffB[i] = (unsigned)(Rb * K + C) * 2u; }
    const size_t kstep = (size_t)(BK * 2);
    const size_t hstep = (size_t)HALF * K * 2;
    const size_t tstep = 2 * hstep;
    const unsigned ldsw = (unsigned)wid * 1024u;
    const int aoff = lds_byte(wr * 64 + fr, fq * 8), boff = lds_byte(wc * 32 + fr, fq * 8);
#define PG8_SA(b, h) (((b) * 2 + (h)) * HTB)
#define PG8_SB(b, h) ((4 + (b) * 2 + (h)) * HTB)
#define PG8_STAGE(bufoff, gbase, voff) do { _Pragma("unroll") for (int _i = 0; _i < 2; ++_i) \
        __builtin_amdgcn_global_load_lds((const unsigned*)((const char*)(gbase) + (voff)[_i]), (PG8_LAS unsigned*)(lds + (bufoff) + ldsw + _i * 8192), 16, 0, 0); } while (0)
#define PG8_LDA(dst, b, h) do { _Pragma("unroll") for (int m = 0; m < 4; ++m) _Pragma("unroll") for (int k = 0; k < 2; ++k) dst[m][k] = *(const PG8_LAS bf16x8*)(lds + PG8_SA(b, h) + aoff + m * 2048 + k * 1024); } while (0)
#define PG8_LDB(dst, b, h) do { _Pragma("unroll") for (int n = 0; n < 2; ++n) _Pragma("unroll") for (int k = 0; k < 2; ++k) dst[n][k] = *(const PG8_LAS bf16x8*)(lds + PG8_SB(b, h) + boff + n * 2048 + k * 1024); } while (0)
#define PG8_MMA(ai, bj, At, Bt) do { __builtin_amdgcn_s_setprio(1); _Pragma("unroll") for (int m = 0; m < 4; ++m) _Pragma("unroll") for (int n = 0; n < 2; ++n) _Pragma("unroll") for (int k = 0; k < 2; ++k) \
        acc[ai][bj][m][n] = __builtin_amdgcn_mfma_f32_16x16x32_bf16(Bt[n][k], At[m][k], acc[ai][bj][m][n], 0, 0, 0); __builtin_amdgcn_s_setprio(0); } while (0)
#define PG8_WAIT_V(n) asm volatile("s_waitcnt vmcnt(" #n ")" ::: "memory")
#define PG8_WAIT_L(n) asm volatile("s_waitcnt lgkmcnt(" #n ")" ::: "memory")
#define PG8_BAR __builtin_amdgcn_s_barrier()
#define PG8_SCHED __builtin_amdgcn_sched_barrier(0)
    Unit cur, nxt; int ui = 0;
    if (!S.next(0, cur)) return;
    f32x4 acc[2][2][4][2];
#pragma unroll
    for (int a = 0; a < 2; ++a)
#pragma unroll
        for (int b = 0; b < 2; ++b)
#pragma unroll
            for (int m = 0; m < 4; ++m)
#pragma unroll
                for (int n = 0; n < 2; ++n) acc[a][b][m][n] = (f32x4){0.f, 0.f, 0.f, 0.f};
    bf16x8 At[4][2], B0[2][2], B1[2][2];
    const char* cA = (const char*)g.A + (size_t)cur.pm * tstep; const char* cB = (const char*)g.Bt + (size_t)cur.e * g.estride + (size_t)cur.pn * tstep;
    S.a_ready(cur);
    if constexpr (SP2) {
        PG8_STAGE(PG8_SB(0, 0), cB, voffB); PG8_STAGE(PG8_SB(0, 1), cB + hstep, voffB); PG8_STAGE(PG8_SA(0, 0), cA, voffA); PG8_STAGE(PG8_SA(0, 1), cA + hstep, voffA);
        if (wr == 1) PG8_BAR;
        PG8_WAIT_V(2); PG8_BAR;
        PG8_STAGE(PG8_SB(1, 0), cB + kstep, voffB); PG8_STAGE(PG8_SA(1, 0), cA + kstep, voffA); PG8_STAGE(PG8_SB(1, 1), cB + hstep + kstep, voffB);
        PG8_WAIT_V(6); PG8_BAR;
    } else {
        PG8_STAGE(PG8_SB(0, 0), cB, voffB); PG8_STAGE(PG8_SA(0, 0), cA, voffA); PG8_STAGE(PG8_SB(0, 1), cB + hstep, voffB); PG8_STAGE(PG8_SA(0, 1), cA + hstep, voffA);
        if (wr == 1) PG8_BAR;
        PG8_WAIT_V(4); PG8_BAR;
        PG8_STAGE(PG8_SB(1, 0), cB + kstep, voffB); PG8_STAGE(PG8_SA(1, 0), cA + kstep, voffA); PG8_STAGE(PG8_SB(1, 1), cB + hstep + kstep, voffB);
        PG8_WAIT_V(6); PG8_BAR;
    }
    for (;;) {
        const bool has_next = S.next(ui + 1, nxt);
        const char* nA = has_next ? (const char*)g.A + (size_t)nxt.pm * tstep : cA; const char* nB = has_next ? (const char*)g.Bt + (size_t)nxt.e * g.estride + (size_t)nxt.pn * tstep : cB;
#pragma nounroll
        for (int t = 0; t < nt; t += 2) {
            const bool last = (t == nt - 2);
            const char* a1 = cA + (size_t)(t + 1) * kstep;
            const char* a2 = last ? nA : cA + (size_t)(t + 2) * kstep; const char* b2 = last ? nB : cB + (size_t)(t + 2) * kstep;
            const char* a3 = a2 + kstep; const char* b3 = b2 + kstep;
            if (last && has_next) S.a_ready(nxt);
            if constexpr (SP2) {
            PG8_LDB(B0, 0, 0); PG8_LDB(B1, 0, 1); PG8_SCHED; PG8_LDA(At, 0, 0); PG8_STAGE(PG8_SA(1, 1), a1 + hstep, voffA);
            PG8_WAIT_V(8); PG8_WAIT_L(0); PG8_BAR; PG8_MMA(0, 0, At, B0); PG8_MMA(0, 1, At, B1); PG8_BAR; PG8_SCHED;
            PG8_LDA(At, 0, 1); PG8_STAGE(PG8_SB(0, 0), b2, voffB); PG8_STAGE(PG8_SB(0, 1), b2 + hstep, voffB); PG8_STAGE(PG8_SA(0, 0), a2, voffA);
            PG8_WAIT_V(8); PG8_WAIT_L(0); PG8_BAR; PG8_MMA(1, 0, At, B0); PG8_MMA(1, 1, At, B1); PG8_BAR; PG8_SCHED;
            PG8_LDB(B0, 1, 0); PG8_LDB(B1, 1, 1); PG8_SCHED; PG8_LDA(At, 1, 0); PG8_STAGE(PG8_SA(0, 1), a2 + hstep, voffA);
            PG8_WAIT_V(8); PG8_WAIT_L(0); PG8_BAR; PG8_MMA(0, 0, At, B0); PG8_MMA(0, 1, At, B1); PG8_BAR; PG8_SCHED;
            PG8_LDA(At, 1, 1); PG8_STAGE(PG8_SB(1, 0), b3, voffB); PG8_STAGE(PG8_SB(1, 1), b3 + hstep, voffB); PG8_STAGE(PG8_SA(1, 0), a3, voffA);
            PG8_WAIT_V(8); PG8_WAIT_L(0); PG8_BAR; PG8_MMA(1, 0, At, B0); PG8_MMA(1, 1, At, B1); PG8_BAR; PG8_SCHED;
            } else {
            PG8_LDB(B0, 0, 0); PG8_SCHED; PG8_LDA(At, 0, 0); PG8_STAGE(PG8_SA(1, 1), a1 + hstep, voffA);
            PG8_WAIT_L(8); PG8_BAR; PG8_WAIT_L(0); PG8_MMA(0, 0, At, B0); PG8_BAR; PG8_SCHED;
            PG8_LDB(B1, 0, 1); PG8_STAGE(PG8_SB(0, 0), b2, voffB);
            PG8_BAR; PG8_WAIT_L(0); PG8_MMA(0, 1, At, B1); PG8_BAR;
            PG8_LDA(At, 0, 1); PG8_STAGE(PG8_SA(0, 0), a2, voffA);
            PG8_BAR; PG8_WAIT_L(0); PG8_MMA(1, 0, At, B0); PG8_BAR; PG8_SCHED;
            PG8_STAGE(PG8_SB(0, 1), b2 + hstep, voffB);
            PG8_WAIT_V(6); PG8_BAR; PG8_MMA(1, 1, At, B1); PG8_BAR;
            PG8_LDB(B0, 1, 0); PG8_SCHED; PG8_LDA(At, 1, 0); PG8_STAGE(PG8_SA(0, 1), a2 + hstep, voffA);
            PG8_WAIT_L(8); PG8_BAR; PG8_WAIT_L(0); PG8_MMA(0, 0, At, B0); PG8_BAR; PG8_SCHED;
            PG8_LDB(B1, 1, 1); PG8_STAGE(PG8_SB(1, 0), b3, voffB);
            PG8_BAR; PG8_WAIT_L(0); PG8_MMA(0, 1, At, B1); PG8_BAR;
            PG8_LDA(At, 1, 1); PG8_STAGE(PG8_SA(1, 0), a3, voffA);
            PG8_BAR; PG8_WAIT_L(0); PG8_MMA(1, 0, At, B0); PG8_BAR; PG8_SCHED;
            PG8_STAGE(PG8_SB(1, 1), b3 + hstep, voffB);
            PG8_WAIT_V(6); PG8_BAR; PG8_MMA(1, 1, At, B1); PG8_BAR;
            }
        }
        if constexpr (ALIGN_EPI) { if (wr == 0) PG8_BAR; }
        if constexpr (!Epi::AFTER_DRAIN) { E(acc, cur, wr, wc, fr, fq); S.done(cur); }
        if (!has_next) break;
#pragma unroll
        for (int a = 0; a < 2; ++a)
#pragma unroll
            for (int b = 0; b < 2; ++b)
#pragma unroll
                for (int m = 0; m < 4; ++m)
#pragma unroll
                    for (int n = 0; n < 2; ++n) acc[a][b][m][n] = (f32x4){0.f, 0.f, 0.f, 0.f};
        cur = nxt; cA = nA; cB = nB; ++ui;
        if constexpr (ALIGN_EPI) { if (wr == 1) PG8_BAR; }
    }
    PG8_WAIT_V(0);
    if constexpr (!ALIGN_EPI) { if (wr == 0) PG8_BAR; }
    PG8_BAR;
    if constexpr (Epi::AFTER_DRAIN) { E.fused(acc, cur, wr, wc, fr, fq, lds, wid, lane); S.done(cur); }
#undef PG8_SA
#undef PG8_SB
#undef PG8_STAGE
#undef PG8_LDA
#undef PG8_LDB
#undef PG8_MMA
#undef PG8_WAIT_V
#undef PG8_WAIT_L
#undef PG8_BAR
#undef PG8_SCHED
}
}

struct Args { const float* in[20]; float* out; unsigned char* ws; int ph_lo, ph_hi; };
struct Frame {
    LAS unsigned char* lds; volatile LAS unsigned* MISC; gu32* ctl; unsigned char* ws;
    int vcu, G;
};
#define F_TID ((int)threadIdx.x)
#define F_LANE ((int)(threadIdx.x & 63))
#define F_WAVE (__builtin_amdgcn_readfirstlane((int)(threadIdx.x >> 6)))

__device__ __forceinline__ int in_src_col(int n) {
    if (n < 640) return n;
    if (n < 2688) return n + 32;
    if (n < 2720) return n - 2688 + 640;
    if (n < 2792) return n;
    if (n < 2816) return -1;
    return n - 24;
}
__device__ __forceinline__ void tr_item(const float* colptr, int ld, int k0, bf16* WT, int Kd, int destrow0, LAS float* scr, int lane) {
    const int nq = lane & 15, kr = lane >> 4;
#pragma unroll 8
    for (int it = 0; it < 16; ++it) { const int kk = 4 * it + kr; f32x4 v = (f32x4){0.f, 0.f, 0.f, 0.f}; if (colptr) v = *(const GAS f32x4*)(colptr + (size_t)(k0 + kk) * ld);
        LAS float* d = scr + kk * 65 + 4 * nq; d[0] = v.x; d[1] = v.y; d[2] = v.z; d[3] = v.w; }
    LDS_WAIT(); asm volatile("" ::: "memory");
    const int c = lane & 7;
#pragma unroll
    for (int j = 0; j < 8; ++j) { const int n = (lane >> 3) + 8 * j; const LAS float* q = scr + (8 * c) * 65 + n;
        v4u o; o.x = pk2(q[0 * 65], q[1 * 65]); o.y = pk2(q[2 * 65], q[3 * 65]); o.z = pk2(q[4 * 65], q[5 * 65]); o.w = pk2(q[6 * 65], q[7 * 65]);
        *(GAS v4u*)(WT + (size_t)(destrow0 + n) * Kd + k0 + 8 * c) = o; }
    LDS_WAIT(); asm volatile("" ::: "memory");
}
__device__ __forceinline__ void p0_prologue(Frame& F, const Args& A) {
    LAS float* scr = (LAS float*)(F.lds + F_WAVE * 16640);
    const int gw = F.vcu * NWAVES + F_WAVE, NGW = F.G * NWAVES, lane = F_LANE;
    unsigned char* ws = F.ws;
    constexpr int I0 = 16 * 76, I1 = 6 * 12, I2 = 4 * 16, I3 = 8 * 16, I4 = 8 * 16, I5 = 16 * 16, I6 = 32 * 16 * 8, I7 = 32 * 4 * 16;
    constexpr int NITEMS = I0 + I1 + I2 + I3 + I4 + I5 + I6 + I7;
    const int n4 = 4 * (lane & 15);
    for (int it = gw; it < NITEMS; it += NGW) {
        int r = it;
        if (r < I0) { const int kb = r / 76, nb = r % 76; const int col = in_src_col(64 * nb + n4);
            tr_item(col >= 0 ? A.in[2] + col : nullptr, NIN_SRC, 64 * kb, (bf16*)(ws + WS_WIN), 1024, 64 * nb, scr, lane); continue; } r -= I0;
        if (r < I1) { const int kb = r / 12, nb = r % 12; tr_item(A.in[4] + 64 * nb + n4, 768, 64 * kb, (bf16*)(ws + WS_WUQ), 384, 64 * nb, scr, lane); continue; } r -= I1;
        if (r < I2) { const int kb = r / 16, nb = r % 16; const int n = 64 * nb + n4;
            tr_item(n < 512 ? A.in[6] + n : A.in[7] + (n - 512), 512, 64 * kb, (bf16*)(ws + WS_WUKV), 256, 64 * nb, scr, lane); continue; } r -= I2;
        if (r < I3) { const int kb = r / 16, nb = r % 16; tr_item(A.in[8] + 64 * nb + n4, 1024, 64 * kb, (bf16*)(ws + WS_WOA), 512, 64 * nb, scr, lane); continue; } r -= I3;
        if (r < I4) { const int kb = r / 16, nb = r % 16; tr_item(A.in[9] + 64 * nb + n4, 1024, 64 * kb, (bf16*)(ws + WS_WOB), 512, 64 * nb, scr, lane); continue; } r -= I4;
        if (r < I5) { const int kb = r / 16, nb = r % 16; tr_item(A.in[10] + 64 * nb + n4, 1024, 64 * kb, (bf16*)(ws + WS_WOUT), 1024, 64 * nb, scr, lane); continue; } r -= I5;
        if (r < I6) { const int e = r / 128, rr = r % 128, kb = rr / 8, nb = rr % 8; const int n = 64 * nb + n4, pn = n >> 8, c = n & 255, col = 128 * pn + (c & 127);
            const float* src = ((c >> 7) ? A.in[17] : A.in[16]) + (size_t)e * 1024 * 256 + col;
            tr_item(src, 256, 64 * kb, (bf16*)(ws + WS_WGU) + (size_t)e * 512 * 1024, 1024, 64 * nb, scr, lane); continue; } r -= I6;
        { const int e = r / 64, rr = r % 64, kb = rr / 16, nb = rr % 16;
            tr_item(A.in[18] + (size_t)e * 256 * 1024 + 64 * nb + n4, 1024, 64 * kb, (bf16*)(ws + WS_WD) + (size_t)e * 1024 * 256, 256, 64 * nb, scr, lane); }
    }
    const float* x = A.in[0]; const float* g1 = A.in[1]; bf16* H = (bf16*)(ws + WS_H);
    for (int m = gw; m < T; m += NGW) {
        const GAS f32x4* xr = (const GAS f32x4*)(x + (size_t)m * D) + lane;
        f32x4 v[4]; float s = 0.f;
#pragma unroll
        for (int j = 0; j < 4; ++j) { v[j] = xr[64 * j]; s += (v[j].x * v[j].x + v[j].y * v[j].y) + (v[j].z * v[j].z + v[j].w * v[j].w); }
        const float rstd = 1.f / sqrtf(wave_sum(s) * (1.f / D) + EPS);
        GAS v2u* o8 = (GAS v2u*)(H + (size_t)m * D) + lane;
#pragma unroll
        for (int j = 0; j < 4; ++j) { const f32x4 g = *((const GAS f32x4*)g1 + lane + 64 * j); const f32x4 y = v[j] * rstd * g; v2u w; w.x = pk2(y.x, y.y); w.y = pk2(y.z, y.w); o8[64 * j] = w; }
    }
    f32x2* rope = (f32x2*)(ws + WS_ROPE);
    for (int idx = (F.vcu * NTHR + F_TID); idx < SEQ * 16; idx += F.G * NTHR) {
        const int pos = idx >> 4, i = idx & 15;
        const double REV[16] = {0.15915494309189535, 0.0700865215877985, 0.03086376340470123, 0.013591370636193905, 0.005985185712713705, 0.002635675898667414, 0.001160663641240061, 0.0005111175045375439,
                                0.00022507907903927653, 9.911730936901935e-05, 4.364795279280289e-05, 1.9221100684944863e-05, 8.464330808241401e-06, 3.727408601915352e-06, 1.6414262627950345e-06, 7.228293068832865e-07};
        double rv = 0.0;
#pragma unroll
        for (int k = 0; k < 16; ++k) rv = (i == k) ? REV[k] : rv;
        double t = (double)pos * rv; t -= __builtin_floor(t);
        const float tf = (float)t;
        rope[idx] = (f32x2){__builtin_amdgcn_cosf(tf), __builtin_amdgcn_sinf(tf)};
    }
}

__device__ __forceinline__ void p2a_norms(Frame& F, const Args& A) {
    const int gw = F.vcu * NWAVES + F_WAVE, NGW = F.G * NWAVES, lane = F_LANE;
    bf16* CQ = (bf16*)(F.ws + WS_CQ); bf16* CKV = (bf16*)(F.ws + WS_CKV);
    const float* gq = A.in[3]; const float* gkv = A.in[5];
    for (int m = gw; m < T; m += NGW) {
        {
            GAS unsigned* p = (GAS unsigned*)(CQ + (size_t)m * 384) + lane; unsigned w[3]; float s = 0.f;
#pragma unroll
            for (int j = 0; j < 3; ++j) { w[j] = p[64 * j]; const float a = bflo(w[j]), b = bfhi(w[j]); s += a * a + b * b; }
            const float rstd = 1.f / sqrtf(wave_sum(s) * (1.f / 384.f) + EPS);
#pragma unroll
            for (int j = 0; j < 3; ++j) { const f32x2 g = *((const GAS f32x2*)gq + lane + 64 * j); p[64 * j] = pk2(bflo(w[j]) * rstd * g.x, bfhi(w[j]) * rstd * g.y); }
        }
        {
            GAS v2u* p = (GAS v2u*)(CKV + (size_t)m * 256) + lane; const v2u w = *p;
            const float a = bflo(w.x), b = bfhi(w.x), c = bflo(w.y), d = bfhi(w.y);
            const float rstd = 1.f / sqrtf(wave_sum(a * a + b * b + c * c + d * d) * (1.f / 256.f) + EPS);
            const f32x4 g = *((const GAS f32x4*)gkv + lane); v2u o; o.x = pk2(a * rstd * g.x, b * rstd * g.y); o.y = pk2(c * rstd * g.z, d * rstd * g.w); *p = o;
        }
    }
}

__device__ __forceinline__ constexpr int crow(int r, int hi) { return (r & 3) + 8 * (r >> 2) + 4 * hi; }
struct AttnP { const bf16 *Q, *K, *K2, *V; bf16* O; const unsigned* BM; };
template <bool MLA> __device__ __forceinline__ void attn_unit(LAS unsigned char* L, int b, int h, int qb, const AttnP& P, int tid, int lane, int wave) {
    constexpr int DK = MLA ? 96 : 64, KP = DK * 2 + 16, NS = DK / 16, CPR = DK / 8;
    constexpr int QPITCH = MLA ? 768 : 512, VP = 192, KBUF = 64 * KP, VBUF = 64 * VP;
    const int r32 = lane & 31, hi = lane >> 5;
    const size_t rowb = (size_t)b * SEQ;
    const int qrow = qb * 256 + wave * 32 + r32;
    bf16x8 qf[NS];
    { const bf16* qp = P.Q + (rowb + qrow) * QPITCH + h * DK;
#pragma unroll
      for (int s = 0; s < NS; ++s) qf[s] = *(const bf16x8*)(qp + 16 * s + 8 * hi); }
    const int NT = 4 * qb + 4, my_nt = 4 * qb + (wave >> 1) + 1;
    const int kid0 = tid, kid1 = tid + NTHR;
    const int kr0 = kid0 / CPR, kc0 = kid0 % CPR, kr1 = kid1 / CPR, kc1 = kid1 % CPR; const bool has1 = MLA && (kid1 < 64 * CPR);
    const int vr = tid >> 3, vc = tid & 7;
    v4u kreg0, kreg1 = (v4u){0u, 0u, 0u, 0u}, vreg;
#define ATT_KSRC(t, kr, kc) (MLA ? ((kc) < 8 ? (const v4u*)(P.K + (rowb + 64 * (t) + (kr)) * 512 + h * 64 + 8 * (kc)) : (const v4u*)(P.K2 + (rowb + 64 * (t) + (kr)) * 32 + 8 * ((kc) - 8))) \
                                 : (const v4u*)(P.K + (rowb + 64 * (t) + (kr)) * 512 + h * 64 + 8 * (kc)))
#define ATT_LOAD(t) do { kreg0 = *ATT_KSRC(t, kr0, kc0); if (has1) kreg1 = *ATT_KSRC(t, kr1, kc1); vreg = *(const v4u*)(P.V + (rowb + 64 * (t) + vr) * 512 + h * 64 + 8 * vc); } while (0)
#define ATT_WRITE(buf) do { *(LAS v4u*)(L + (buf) * KBUF + kr0 * KP + kc0 * 16) = kreg0; if (has1) *(LAS v4u*)(L + (buf) * KBUF + kr1 * KP + kc1 * 16) = kreg1; \
                            *(LAS v4u*)(L + 2 * KBUF + (buf) * VBUF + vr * VP + vc * 16) = vreg; } while (0)
    float m = -1e30f, l = 0.f; f32x16 o0, o1;
#pragma unroll
    for (int i = 0; i < 16; ++i) { o0[i] = 0.f; o1[i] = 0.f; }
    const int g16 = lane >> 4, qq = (lane & 15) >> 2, pp = lane & 3;
    const int vlane = (4 * hi + qq) * VP + (16 * (g16 & 1) + 4 * pp) * 2;
    ATT_LOAD(0); ATT_WRITE(0); __syncthreads();
    for (int t = 0; t < NT; ++t) {
        const int buf = t & 1;
        if (t + 1 < NT) ATT_LOAD(t + 1);
        if (t < my_nt) {
            const LAS unsigned char* Kb = L + buf * KBUF; const LAS unsigned char* Vb = L + 2 * KBUF + buf * VBUF;
            f32x16 s0, s1;
#pragma unroll
            for (int i = 0; i < 16; ++i) { s0[i] = 0.f; s1[i] = 0.f; }
#pragma unroll
            for (int s = 0; s < NS; ++s) {
                const bf16x8 a0 = *(const LAS bf16x8*)(Kb + r32 * KP + s * 32 + hi * 16);
                const bf16x8 a1 = *(const LAS bf16x8*)(Kb + (32 + r32) * KP + s * 32 + hi * 16);
                s0 = __builtin_amdgcn_mfma_f32_32x32x16_bf16(a0, qf[s], s0, 0, 0, 0);
                s1 = __builtin_amdgcn_mfma_f32_32x32x16_bf16(a1, qf[s], s1, 0, 0, 0);
            }
            unsigned w0 = 0xffffffffu, w1 = 0xffffffffu;
            if (!MLA) { const unsigned* bp = P.BM + ((size_t)b * 256 + 2 * t) * SEQ + qrow; w0 = bp[0] >> (4 * hi); w1 = bp[SEQ] >> (4 * hi); }
            float mx = fmaxf(fmaxf(s0[0], s0[1]), s1[0]);
#pragma unroll
            for (int i = 2; i < 16; i += 2) mx = fmaxf(fmaxf(mx, s0[i]), s0[i + 1]);
#pragma unroll
            for (int i = 1; i < 15; i += 2) mx = fmaxf(fmaxf(mx, s1[i]), s1[i + 1]);
            mx = fmaxf(mx, s1[15]);
            mx = fmaxf(mx, __shfl_xor(mx, 32));
            if (__any(mx > m)) {
                const float mn = fmaxf(m, mx), alpha = __builtin_amdgcn_exp2f(m - mn); m = mn;
                l *= alpha;
#pragma unroll
                for (int i = 0; i < 16; ++i) { o0[i] *= alpha; o1[i] *= alpha; }
            }
            float rs = 0.f;
#pragma unroll
            for (int i = 0; i < 16; ++i) {
                float p0 = __builtin_amdgcn_exp2f(s0[i] - m), p1 = __builtin_amdgcn_exp2f(s1[i] - m);
                if (!MLA) { p0 = __builtin_bit_cast(float, __builtin_bit_cast(unsigned, p0) & (unsigned)((int)(w0 << (31 - crow(i, 0))) >> 31));
                            p1 = __builtin_bit_cast(float, __builtin_bit_cast(unsigned, p1) & (unsigned)((int)(w1 << (31 - crow(i, 0))) >> 31)); }
                s0[i] = p0; s1[i] = p1; rs += p0 + p1; }
            l += rs;
            bf16x8 pf[4];
#pragma unroll
            for (int ks = 0; ks < 4; ++ks) { v4u w;
#pragma unroll
                for (int j = 0; j < 4; ++j) { const float a = (ks < 2) ? s0[8 * (ks & 1) + 2 * j] : s1[8 * (ks & 1) + 2 * j], c = (ks < 2) ? s0[8 * (ks & 1) + 2 * j + 1] : s1[8 * (ks & 1) + 2 * j + 1]; w[j] = pk2(a, c); }
                pf[ks] = __builtin_bit_cast(bf16x8, w); }
#pragma unroll
            for (int ks = 0; ks < 4; ++ks) {
                const LAS unsigned char* vp = Vb + ks * 16 * VP + vlane;
                const s16x4 a00 = __builtin_bit_cast(s16x4, __builtin_amdgcn_ds_read_tr16_b64_v4i16((LAS s16x4*)(vp)));
                const s16x4 a01 = __builtin_bit_cast(s16x4, __builtin_amdgcn_ds_read_tr16_b64_v4i16((LAS s16x4*)(vp + 8 * VP)));
                const s16x4 a10 = __builtin_bit_cast(s16x4, __builtin_amdgcn_ds_read_tr16_b64_v4i16((LAS s16x4*)(vp + 64)));
                const s16x4 a11 = __builtin_bit_cast(s16x4, __builtin_amdgcn_ds_read_tr16_b64_v4i16((LAS s16x4*)(vp + 8 * VP + 64)));
                const bf16x8 A0 = (bf16x8){a00[0], a00[1], a00[2], a00[3], a01[0], a01[1], a01[2], a01[3]};
                const bf16x8 A1 = (bf16x8){a10[0], a10[1], a10[2], a10[3], a11[0], a11[1], a11[2], a11[3]};
                o0 = __builtin_amdgcn_mfma_f32_32x32x16_bf16(A0, pf[ks], o0, 0, 0, 0);
                o1 = __builtin_amdgcn_mfma_f32_32x32x16_bf16(A1, pf[ks], o1, 0, 0, 0);
            }
        }
        if (t + 1 < NT) ATT_WRITE(buf ^ 1);
        __syncthreads();
    }
    l += __shfl_xor(l, 32);
    const float inv = 1.f / l;
    bf16* op = P.O + (rowb + qrow) * 512 + h * 64 + 4 * hi;
#pragma unroll
    for (int g = 0; g < 4; ++g) {
        v2u w; w.x = pk2(o0[4 * g] * inv, o0[4 * g + 1] * inv); w.y = pk2(o0[4 * g + 2] * inv, o0[4 * g + 3] * inv); *(v2u*)(op + 8 * g) = w;
        v2u z; z.x = pk2(o1[4 * g] * inv, o1[4 * g + 1] * inv); z.y = pk2(o1[4 * g + 2] * inv, o1[4 * g + 3] * inv); *(v2u*)(op + 32 + 8 * g) = z;
    }
#undef ATT_KSRC
#undef ATT_LOAD
#undef ATT_WRITE
}

constexpr int CAND_CAP = 128, QIP = 1296, HS = 513;
struct IdxP { const bf16 *QI, *KI; const float* WI; unsigned* BM; };
__device__ __forceinline__ unsigned mono_key(float s) { const unsigned u = __builtin_bit_cast(unsigned, s + 0.0f); return u ^ ((unsigned)((int)u >> 31) | 0x80000000u); }
__device__ __forceinline__ void idx_scores2(const bf16x8 (&kf)[2][4], const LAS unsigned char* qlane, const float (&wq)[8], f32x16& sc0, f32x16& sc1) {
    bf16x8 qv[4], qn[4];
#pragma unroll
    for (int s = 0; s < 4; ++s) qv[s] = *(const LAS bf16x8*)(qlane + 8 * 128 + s * 32);
#pragma unroll
    for (int i = 0; i < 16; ++i) { sc0[i] = 0.f; sc1[i] = 0.f; }
    f32x16 ap0, ap1;
#pragma unroll
    for (int i = 0; i < 16; ++i) { ap0[i] = 0.f; ap1[i] = 0.f; }
#pragma unroll
    for (int n = 0; n < 10; ++n) {
        const int nh = (n + 1 < 2) ? 9 : (n + 1 - 2);
        if (n + 1 < 10) {
#pragma unroll
            for (int s = 0; s < 4; ++s) qn[s] = *(const LAS bf16x8*)(qlane + nh * 128 + s * 32); }
        f32x16 a0, a1;
        if (n < 2) {
#pragma unroll
            for (int s = 0; s < 4; ++s) { sc0 = __builtin_amdgcn_mfma_f32_32x32x16_bf16(kf[0][s], qv[s], sc0, 0, 0, 0); sc1 = __builtin_amdgcn_mfma_f32_32x32x16_bf16(kf[1][s], qv[s], sc1, 0, 0, 0); }
        } else {
#pragma unroll
            for (int i = 0; i < 16; ++i) { a0[i] = 0.f; a1[i] = 0.f; }
#pragma unroll
            for (int s = 0; s < 4; ++s) { a0 = __builtin_amdgcn_mfma_f32_32x32x16_bf16(kf[0][s], qv[s], a0, 0, 0, 0); a1 = __builtin_amdgcn_mfma_f32_32x32x16_bf16(kf[1][s], qv[s], a1, 0, 0, 0); }
        }
        if (n >= 3) {
            const float w = wq[n - 3];
#pragma unroll
            for (int i = 0; i < 16; ++i) { sc0[i] = __builtin_fmaf(w, __builtin_fabsf(ap0[i]), sc0[i]); sc1[i] = __builtin_fmaf(w, __builtin_fabsf(ap1[i]), sc1[i]); }
#pragma unroll
            for (int g = 0; g < 8; ++g) { __builtin_amdgcn_sched_group_barrier(0x008, 1, 0); __builtin_amdgcn_sched_group_barrier(0x002, 4, 0); }
        }
        if (n >= 2) { ap0 = a0; ap1 = a1; }
#pragma unroll
        for (int s = 0; s < 4; ++s) qv[s] = qn[s];
    }
    { const float w = wq[7];
#pragma unroll
      for (int i = 0; i < 16; ++i) { sc0[i] = __builtin_fmaf(w, __builtin_fabsf(ap0[i]), sc0[i]); sc1[i] = __builtin_fmaf(w, __builtin_fabsf(ap1[i]), sc1[i]); } }
#pragma unroll
    for (int i = 0; i < 16; ++i) asm volatile("" : "+v"(sc0[i]), "+v"(sc1[i]));
}
__device__ __forceinline__ void idx_item(LAS unsigned char* L, int b, int j, const IdxP& P, int tid, int lane, int wave) {
    LAS unsigned* hist = (LAS unsigned*)L;
    LAS unsigned* img = (LAS unsigned*)(L + 66048);
    LAS unsigned* st = (LAS unsigned*)(L + 98816);
    LAS unsigned* cand = hist;
    LAS unsigned char* Qs = L + 100864;
    const int r32 = lane & 31, hi = lane >> 5;
    const int q0 = 32 * j, ntile = 2 * (j / 2 + 1);
    const size_t rowb = (size_t)b * SEQ;
    if (ntile <= 8) {
        for (int idx = tid; idx < ntile * 32; idx += NTHR) P.BM[((size_t)b * 256 + (idx >> 5)) * SEQ + q0 + (idx & 31)] = 0xffffffffu;
        return;
    }
    float wq[8];
    { for (int c = tid; c < 32 * 64; c += NTHR) { const int rr = c >> 6, ch = c & 63; *(LAS v4u*)(Qs + rr * QIP + ch * 16) = *(const v4u*)(P.QI + (rowb + q0 + rr) * 512 + ch * 8); }
      const float* wp = P.WI + (rowb + q0 + r32) * 8;
#pragma unroll
      for (int h = 0; h < 8; ++h) wq[h] = 0.5f * wp[h]; }
    if (tid < 32) { st[32 + tid] = 256u; st[64 + tid] = 0u; st[96 + tid] = 0u; }
    if (tid == 0) st[129] = 0u;
    __syncthreads();
    {
        const int r = tid >> 4, part = tid & 15;
        const float* wp = P.WI + (rowb + q0 + r) * 8;
        float qb[4] = {0.f, 0.f, 0.f, 0.f}; float rsum = 0.f;
#pragma unroll
        for (int h = 0; h < 8; ++h) { const float w = wp[h]; const v2u raw = *(const LAS v2u*)(Qs + r * QIP + h * 128 + part * 8);
            const float f0 = bflo(raw.x), f1 = bfhi(raw.x), f2 = bflo(raw.y), f3 = bfhi(raw.y);
            float nsq = (f0 * f0 + f1 * f1) + (f2 * f2 + f3 * f3);
#pragma unroll
            for (int o = 1; o < 16; o <<= 1) nsq += __shfl_xor(nsq, o);
            rsum += fabsf(w) * sqrtf(nsq);
            qb[0] += 0.5f * w * f0; qb[1] += 0.5f * w * f1; qb[2] += 0.5f * w * f2; qb[3] += 0.5f * w * f3; }
        v2u hw, lw;
        { const unsigned h01 = pk2(qb[0], qb[1]), h23 = pk2(qb[2], qb[3]); hw.x = h01; hw.y = h23;
          lw.x = pk2(qb[0] - bflo(h01), qb[1] - bfhi(h01)); lw.y = pk2(qb[2] - bflo(h23), qb[3] - bfhi(h23)); }
        *(LAS v2u*)(Qs + r * QIP + 8 * 128 + part * 8) = hw; *(LAS v2u*)(Qs + r * QIP + 9 * 128 + part * 8) = lw;
        { const v2u kw = *(const v2u*)(P.KI + (rowb + r) * 64 + part * 4); const float f0 = bflo(kw.x), f1 = bfhi(kw.x), f2 = bflo(kw.y), f3 = bfhi(kw.y);
          float ksq = (f0 * f0 + f1 * f1) + (f2 * f2 + f3 * f3);
#pragma unroll
          for (int o = 1; o < 16; o <<= 1) ksq += __shfl_xor(ksq, o);
          if (part == 0) { __hip_atomic_fetch_max(&st[129], __builtin_bit_cast(unsigned, ksq), __ATOMIC_RELAXED, __HIP_MEMORY_SCOPE_WORKGROUP); st[224 + r] = __builtin_bit_cast(unsigned, rsum); } }
    }
    __syncthreads();
    if (tid < 32) { const float R = 0.25f * sqrtf(__builtin_bit_cast(float, st[129])) * __builtin_bit_cast(float, st[224 + tid]);
        st[160 + tid] = (0x80000000u | __builtin_bit_cast(unsigned, R)) - 511u * 131072u; st[tid] = 0u; st[192 + tid] = 0u; }
    const LAS unsigned char* qlane = Qs + r32 * QIP + hi * 16;
    int level = 0;
    const int npair = ntile >> 1;
#define IDX_KLOAD2(tp) { const bf16* kp = P.KI + (rowb + 64 * (tp) + r32) * 64 + 8 * hi; _Pragma("unroll") for (int s = 0; s < 4; ++s) { kn[0][s] = *(const bf16x8*)(kp + 16 * s); kn[1][s] = *(const bf16x8*)(kp + 32 * 64 + 16 * s); } }
#define IDX_SCORES2(tp) \
        bf16x8 kf[2][4]; _Pragma("unroll") for (int s = 0; s < 4; ++s) { kf[0][s] = kn[0][s]; kf[1][s] = kn[1][s]; } \
        if ((tp) + NWAVES < npair) { IDX_KLOAD2((tp) + NWAVES) } \
        f32x16 sc0, sc1; idx_scores2(kf, qlane, wq, sc0, sc1);
    for (;;) {
        ++level;
        for (int u = tid; u < 32 * HS; u += NTHR) hist[u] = 0u;
        if (tid == 0) st[128] = 0u;
        __syncthreads();
        {
            const unsigned qa = st[r32], qlen = st[192 + r32], base1 = st[160 + r32];
            const int sh = (level > 1 && qlen > 512u) ? (32 - __builtin_clz(qlen - 1u)) - 9 : 0;
            LAS unsigned* hrow = hist + r32 * HS;
            bf16x8 kn[2][4]; if (wave < npair) { IDX_KLOAD2(wave) }
            for (int tp = wave; tp < npair; tp += NWAVES) {
                IDX_SCORES2(tp)
                if (level == 1) {
#pragma unroll
                    for (int i = 0; i < 16; ++i) { const unsigned k0 = mono_key(sc0[i]), k1 = mono_key(sc1[i]);
                        const unsigned b0 = min((max(k0, base1) - base1) >> 17, 511u), b1 = min((max(k1, base1) - base1) >> 17, 511u);
                        __hip_atomic_fetch_add(&hrow[b0], 1u, __ATOMIC_RELAXED, __HIP_MEMORY_SCOPE_WORKGROUP); __hip_atomic_fetch_add(&hrow[b1], 1u, __ATOMIC_RELAXED, __HIP_MEMORY_SCOPE_WORKGROUP); }
                } else {
#pragma unroll
                    for (int i = 0; i < 16; ++i) { const unsigned o0 = mono_key(sc0[i]) - qa, o1 = mono_key(sc1[i]) - qa;
                        if (o0 < qlen) __hip_atomic_fetch_add(&hrow[o0 >> sh], 1u, __ATOMIC_RELAXED, __HIP_MEMORY_SCOPE_WORKGROUP);
                        if (o1 < qlen) __hip_atomic_fetch_add(&hrow[o1 >> sh], 1u, __ATOMIC_RELAXED, __HIP_MEMORY_SCOPE_WORKGROUP); }
                }
            }
        }
        __syncthreads();
        {
            const int q = tid >> 4, seg = tid & 15;
            unsigned segsum = 0u;
            for (int wi = 0; wi < 32; ++wi) segsum += hist[q * HS + seg * 32 + wi];
            unsigned S = segsum;
#pragma unroll
            for (int off = 1; off < 16; off <<= 1) { const unsigned o = __shfl_down(S, off, 16); if (seg + off < 16) S += o; }
            const unsigned above = S - segsum, need = st[32 + q];
            if (above < need && need <= above + segsum) {
                unsigned cum = above, fbin = 0u, fneed = 1u, fcnt = 0u; bool found = false;
                for (int wi = 31; wi >= 0; --wi) { const unsigned c = hist[q * HS + seg * 32 + wi];
                    if (!found && cum + c >= need) { found = true; fbin = 32 * seg + wi; fneed = need - cum; fcnt = c; } if (!found) cum += c; }
                unsigned na, nlen;
                if (level == 1) { const unsigned base1 = st[160 + q];
                    if (fbin == 0u) { na = 0u; nlen = base1 + 131072u; } else if (fbin == 511u) { na = base1 + 511u * 131072u; nlen = 0u - na; } else { na = base1 + fbin * 131072u; nlen = 131072u; } }
                else { const unsigned qa = st[q], qlen = st[192 + q]; const int sh = qlen > 512u ? (32 - __builtin_clz(qlen - 1u)) - 9 : 0;
                    na = qa + (fbin << sh); nlen = min(1u << sh, qlen - (fbin << sh)); }
                st[q] = na; st[192 + q] = nlen; st[32 + q] = fneed; st[64 + q] = fcnt;
                if (fcnt > (unsigned)CAND_CAP && nlen > 1u) st[128] = 1u;
            }
        }
        __syncthreads();
#ifndef MAXLVL
#define MAXLVL 8
#endif
        const bool more = (st[128] != 0u) && (level < MAXLVL);
        __syncthreads();
        if (!more) break;
    }
    {
        const unsigned qa = st[r32], qlen = st[192 + r32];
        bf16x8 kn[2][4]; if (wave < npair) { IDX_KLOAD2(wave) }
        for (int tp = wave; tp < npair; tp += NWAVES) {
            IDX_SCORES2(tp)
#define IDX_COLLECT_ELEMS(SC, T) { unsigned bits = 0u; _Pragma("unroll") for (int i = 0; i < 16; ++i) { const unsigned key = mono_key(SC[i]); \
                if (key >= qa) { const unsigned off = key - qa; \
                    if (off >= qlen) bits |= 1u << crow(i, 0); \
                    else { const unsigned pos = __hip_atomic_fetch_add(&st[96 + r32], 1u, __ATOMIC_RELAXED, __HIP_MEMORY_SCOPE_WORKGROUP); \
                        if (pos < (unsigned)CAND_CAP) { cand[(r32 * CAND_CAP + pos) * 2] = key; cand[(r32 * CAND_CAP + pos) * 2 + 1] = (unsigned)(32 * (T) + crow(i, hi)); } } } } \
            bits <<= 4 * hi; bits |= __shfl_xor(bits, 32); if (hi == 0) img[(T) * 32 + r32] = bits; }
            IDX_COLLECT_ELEMS(sc0, 2 * tp)
            IDX_COLLECT_ELEMS(sc1, 2 * tp + 1)
#undef IDX_COLLECT_ELEMS
        }
    }
#undef IDX_SCORES2
#undef IDX_KLOAD2
    __syncthreads();
    {
        const int q = tid >> 4; const unsigned n = min(st[96 + q], (unsigned)CAND_CAP), need = st[32 + q];
        for (unsigned c = tid & 15; c < n; c += 16) { const unsigned key = cand[(q * CAND_CAP + c) * 2], idx = cand[(q * CAND_CAP + c) * 2 + 1]; unsigned rank = 0u;
            for (unsigned o = 0; o < n; ++o) { const unsigned k2 = cand[(q * CAND_CAP + o) * 2], i2 = cand[(q * CAND_CAP + o) * 2 + 1]; rank += (k2 > key || (k2 == key && i2 < idx)) ? 1u : 0u; }
            if (rank < need) __hip_atomic_fetch_or(&img[(idx >> 5) * 32 + q], 1u << (idx & 31), __ATOMIC_RELAXED, __HIP_MEMORY_SCOPE_WORKGROUP); }
    }
    __syncthreads();
    for (int idx = tid; idx < ntile * 32; idx += NTHR) P.BM[((size_t)b * 256 + (idx >> 5)) * SEQ + q0 + (idx & 31)] = img[idx];
    __syncthreads();
}

__device__ __forceinline__ int wq_next(Frame& F, int cw) {
    __syncthreads();
    if (F_TID == 0) F.MISC[0] = __hip_atomic_fetch_add((unsigned*)(F.ctl + cw), 1u, RLX_AGENT);
    __syncthreads();
    return (int)F.MISC[0];
}

__device__ __forceinline__ void p5a_route(Frame& F, const Args& A) {
    const int lane = F_LANE, tid = F_TID, wave = F_WAVE;
    const float* x1 = A.out; const float* g2 = A.in[11];
    const float* wrg = A.in[12]; const float* brg = A.in[13]; const float* wre = A.in[14]; const float* bre = A.in[15];
    int* toke = (int*)(F.ws + WS_TOKE); float* tokw = (float*)(F.ws + WS_TOKW); float* rstd2 = (float*)(F.ws + WS_RSTD2);
    int* sslot = (int*)(F.ws + WS_SSLOT);
    LAS unsigned* lcnt = (LAS unsigned*)F.lds;
    LAS float* lgs = (LAS float*)(F.lds + 1024) + wave * 704;
    for (int i = F.vcu * NTHR + tid; i < SORT_ROWS; i += F.G * NTHR) sslot[i] = -1;
    if (tid < NEXP) lcnt[tid] = 0u;
    __syncthreads();
    const int gw = F.vcu * NWAVES + wave, NGW = F.G * NWAVES;
    const int i16 = lane & 15, kq = lane >> 4;
    for (int tile = gw; tile < T / 16; tile += NGW) {
        const int m0 = tile * 16;
        const float* xr = x1 + (size_t)(m0 + i16) * D + 4 * kq;
        f32x4 aE0 = (f32x4){0.f, 0.f, 0.f, 0.f}, aE1 = aE0, aG = aE0; float ss = 0.f;
#pragma unroll 4
        for (int s = 0; s < 64; ++s) {
            const f32x4 a4 = *(const GAS f32x4*)(xr + 16 * s);
            const f32x4 g4 = *(const GAS f32x4*)(g2 + 16 * s + 4 * kq);
            ss += (a4.x * a4.x + a4.y * a4.y) + (a4.z * a4.z + a4.w * a4.w);
#pragma unroll
            for (int c = 0; c < 4; ++c) { const int k = 16 * s + 4 * kq + c; const float a = a4[c] * g4[c];
                const float b0 = wre[(size_t)k * 32 + i16], b1 = wre[(size_t)k * 32 + 16 + i16]; const float bg = wrg[(size_t)k * 8 + (i16 & 7)];
                aE0 = __builtin_amdgcn_mfma_f32_16x16x4f32(a, b0, aE0, 0, 0, 0);
                aE1 = __builtin_amdgcn_mfma_f32_16x16x4f32(a, b1, aE1, 0, 0, 0);
                aG = __builtin_amdgcn_mfma_f32_16x16x4f32(a, bg, aG, 0, 0, 0); }
        }
        ss += __shfl_xor(ss, 16); ss += __shfl_xor(ss, 32);
        const float rstd_i = 1.f / sqrtf(ss * (1.f / D) + EPS);
#pragma unroll
        for (int r = 0; r < 4; ++r) { const int tk = 4 * kq + r; lgs[tk * 40 + 8 + i16] = aE0[r]; lgs[tk * 40 + 24 + i16] = aE1[r]; if (i16 < 8) lgs[tk * 40 + i16] = aG[r]; }
        if (kq == 0) lgs[640 + i16] = rstd_i;
        LDS_WAIT(); asm volatile("" ::: "memory");
        if (lane < 16) {
            const int m = m0 + lane; const float rstd = lgs[640 + lane]; const LAS float* lg = lgs + lane * 40;
            float gl[8];
#pragma unroll
            for (int k = 0; k < 8; ++k) gl[k] = lg[k] * rstd + brg[k];
            int gs = 0; float gm = gl[0];
#pragma unroll
            for (int k = 1; k < 8; ++k) if (gl[k] > gm) { gm = gl[k]; gs = k; }
            float den = 0.f;
#pragma unroll
            for (int k = 0; k < 8; ++k) den += __expf(gl[k] - gm);
            const float wgrp = 1.f / den;
            float el[4];
#pragma unroll
            for (int c = 0; c < 4; ++c) el[c] = lg[8 + 4 * gs + c] * rstd + bre[4 * gs + c];
            int i1 = 0; float v1 = el[0];
#pragma unroll
            for (int c = 1; c < 4; ++c) if (el[c] > v1) { v1 = el[c]; i1 = c; }
            int i2 = -1; float v2 = 0.f;
#pragma unroll
            for (int c = 0; c < 4; ++c) if (c != i1 && (i2 < 0 || el[c] > v2)) { v2 = el[c]; i2 = c; }
            const float e2 = __expf(v2 - v1), w1 = 1.f / (1.f + e2), w2 = e2 / (1.f + e2);
            toke[2 * m] = gs * 4 + i1; toke[2 * m + 1] = gs * 4 + i2; tokw[2 * m] = w1 * wgrp; tokw[2 * m + 1] = w2 * wgrp; rstd2[m] = rstd;
            __hip_atomic_fetch_add(&lcnt[gs * 4 + i1], 1u, __ATOMIC_RELAXED, __HIP_MEMORY_SCOPE_WORKGROUP);
            __hip_atomic_fetch_add(&lcnt[gs * 4 + i2], 1u, __ATOMIC_RELAXED, __HIP_MEMORY_SCOPE_WORKGROUP);
        }
        LDS_WAIT(); asm volatile("" ::: "memory");
    }
    __syncthreads();
    if (tid < NEXP && lcnt[tid]) __hip_atomic_fetch_add((unsigned*)(F.ctl + CW_CNT + tid), lcnt[tid], RLX_AGENT);
}

__device__ __forceinline__ void p5a2_scatter(Frame& F, const Args& A) {
    const int lane = F_LANE, tid = F_TID;
    const float* x1 = A.out; const float* g2 = A.in[11];
    const int* toke = (const int*)(F.ws + WS_TOKE); const float* tokw = (const float*)(F.ws + WS_TOKW); const float* rstd2 = (const float*)(F.ws + WS_RSTD2);
    int* sslot = (int*)(F.ws + WS_SSLOT); float* sw = (float*)(F.ws + WS_SW); int* t2e = (int*)(F.ws + WS_T2E);
    bf16* AS = (bf16*)(F.ws + WS_ASORT);
    LAS unsigned* sh = (LAS unsigned*)F.lds;
    if (tid < NEXP) sh[256 + tid] = __hip_atomic_load((unsigned*)(F.ctl + CW_CNT + tid), RLX_AGENT);
    __syncthreads();
    if (tid == 0) { unsigned acc = 0u;
        for (int e = 0; e < NEXP; ++e) { const unsigned c = sh[256 + e]; sh[e] = acc; const unsigned nt = (c + 255u) / 256u;
            if (blockIdx.x == 0) for (unsigned i = 0; i < nt; ++i) t2e[acc / 256u + i] = e;
            acc += nt * 256u; }
        if (blockIdx.x == 0) t2e[255] = (int)(acc / 256u); }
    const int per = T / F.G;
    for (int t0 = F.vcu * per; t0 < (F.vcu + 1) * per; t0 += 64) {
        if (tid < NEXP) sh[32 + tid] = 0u;
        __syncthreads();
        int e = 0; unsigned lpos = 0u;
        if (tid < 128) { e = toke[2 * t0 + tid]; lpos = __hip_atomic_fetch_add(&sh[32 + e], 1u, __ATOMIC_RELAXED, __HIP_MEMORY_SCOPE_WORKGROUP); }
        __syncthreads();
        if (tid < NEXP) sh[64 + tid] = sh[tid] + (sh[32 + tid] ? __hip_atomic_fetch_add((unsigned*)(F.ctl + CW_FILL + tid), sh[32 + tid], RLX_AGENT) : 0u);
        __syncthreads();
        if (tid < 128) { const unsigned pos = sh[64 + e] + lpos; sh[96 + tid] = pos; sslot[pos] = 2 * t0 + tid; sw[pos] = tokw[2 * t0 + tid]; }
        __syncthreads();
        for (int tk = F_WAVE; tk < 64; tk += NWAVES) { const int m = t0 + tk;
            const GAS f32x4* xr = (const GAS f32x4*)(x1 + (size_t)m * D) + lane; const float rstd = rstd2[m];
            const unsigned p0 = sh[96 + 2 * tk], p1 = sh[96 + 2 * tk + 1];
#pragma unroll
            for (int j = 0; j < 4; ++j) { const f32x4 g = *((const GAS f32x4*)g2 + lane + 64 * j); const f32x4 y = xr[64 * j] * rstd * g; v2u w; w.x = pk2(y.x, y.y); w.y = pk2(y.z, y.w);
                *((GAS v2u*)(AS + (size_t)p0 * D) + lane + 64 * j) = w; *((GAS v2u*)(AS + (size_t)p1 * D) + lane + 64 * j) = w; } }
        __syncthreads();
    }
}

__device__ __forceinline__ void p6_final(Frame& F, const Args& A) {
    const int gw = F.vcu * NWAVES + F_WAVE, NGW = F.G * NWAVES, lane = F_LANE;
    const float* gf = A.in[19]; float* out = A.out; const bf16* SL = (const bf16*)(F.ws + WS_SLOTS);
    for (int m = gw; m < T; m += NGW) {
        GAS f32x4* xr = (GAS f32x4*)(out + (size_t)m * D) + lane;
        const GAS v2u* s0 = (const GAS v2u*)(SL + (size_t)(2 * m) * D) + lane; const GAS v2u* s1 = (const GAS v2u*)(SL + (size_t)(2 * m + 1) * D) + lane;
        f32x4 v[4]; float s = 0.f;
#pragma unroll
        for (int j = 0; j < 4; ++j) { const v2u a = s0[64 * j], c = s1[64 * j]; v[j] = xr[64 * j];
            v[j].x += bflo(a.x) + bflo(c.x); v[j].y += bfhi(a.x) + bfhi(c.x); v[j].z += bflo(a.y) + bflo(c.y); v[j].w += bfhi(a.y) + bfhi(c.y);
            s += (v[j].x * v[j].x + v[j].y * v[j].y) + (v[j].z * v[j].z + v[j].w * v[j].w); }
        const float rstd = 1.f / sqrtf(wave_sum(s) * (1.f / D) + EPS);
#pragma unroll
        for (int j = 0; j < 4; ++j) { const f32x4 g = *((const GAS f32x4*)gf + lane + 64 * j); xr[64 * j] = v[j] * rstd * g; }
    }
}

constexpr int NPHASE = 13;
__global__ void __launch_bounds__(NTHR, 2) mk_fwd(Args args) {
    extern __shared__ __attribute__((aligned(16))) unsigned char lds[];
    Frame F;
    F.lds = (LAS unsigned char*)lds; F.MISC = (volatile LAS unsigned*)(F.lds + MISC_OFF);
        F.G = gridDim.x; { const int bx = blockIdx.x; F.vcu = (F.G % 8 == 0) ? (bx % 8) * (F.G / 8) + bx / 8 : bx; }
    F.ws = args.ws; F.ctl = (gu32*)(args.ws + WS_CTL);
    unsigned char* ws = args.ws;
    if (F_TID < 128) F.MISC[F_TID] = 0u;
    __syncthreads();
    const bool single = (args.ph_hi - args.ph_lo) > 1;
    XcdBarrier bar; bar.bar = (unsigned*)(F.ctl + CW_BAR); bar.x = 0; bar.st = nullptr;
    if (single) bar = xcd_barrier_post((unsigned*)(F.ctl + CW_BAR), F.MISC + 8);
    const int lo = args.ph_lo, hi = args.ph_hi;
#ifdef ONLY
#define IN(k) ((k) == ONLY && lo <= (k) && (k) < hi)
#else
#define IN(k) (lo <= (k) && (k) < hi)
#endif
#define SEAM(k) do { if (IN((k) + 1)) xcd_barrier(bar); } while (0)
    const f32x2* rope = (const f32x2*)(ws + WS_ROPE);
    bf16* GA = (bf16*)args.out; bf16* GB = (bf16*)args.out + (size_t)T * 1024;

    if (IN(0)) { p0_prologue(F, args);
#ifdef REP_P0
        p0_prologue(F, args);
#endif
        SEAM(0); }
    if (IN(1)) {
        pg8::Gemm g{(const bf16*)(ws + WS_H), (const bf16*)(ws + WS_WIN), T, NIN, D, 0}; pg8::StaticOrder S; S.init(T, NIN, F.G, (int)blockIdx.x);
        pg8::EpiIn E{(bf16*)(ws + WS_CQ), (bf16*)(ws + WS_CKV), (bf16*)(ws + WS_QB), (bf16*)(ws + WS_KB), (bf16*)(ws + WS_VB), (bf16*)(ws + WS_QI), (bf16*)(ws + WS_KI), (bf16*)(ws + WS_KR), GA, GB, (float*)(ws + WS_WI), rope};
        pg8::gemm_phase<pg8::EpiIn, pg8::StaticOrder, true, true>(F.lds, g, S, E);
#ifdef REP_P1
        pg8::gemm_phase<pg8::EpiIn, pg8::StaticOrder, true, true>(F.lds, g, S, E);
#endif
        SEAM(1);
    }
    if (IN(2)) { p2a_norms(F, args); SEAM(2); }
    if (IN(3)) {
#ifdef REP_P3
      for (int rep = 0; rep < 2; ++rep) {
#else
      {
#endif
#ifndef NO3A
        { pg8::Gemm g{(const bf16*)(ws + WS_CQ), (const bf16*)(ws + WS_WUQ), T, 768, 384, 0}; pg8::StaticOrder S; S.init(T, 768, F.G, (int)blockIdx.x);
          pg8::EpiQA E{(bf16*)(ws + WS_QA), rope}; pg8::gemm_phase<pg8::EpiQA, pg8::StaticOrder, true, true>(F.lds, g, S, E); }
#endif
#ifndef NO3B
        { pg8::Gemm g{(const bf16*)(ws + WS_CKV), (const bf16*)(ws + WS_WUKV), T, 1024, 256, 0}; pg8::StaticOrder S; S.init(T, 1024, F.G, (int)blockIdx.x);
          pg8::EpiKV E{(bf16*)(ws + WS_KN), (bf16*)(ws + WS_VA)}; pg8::gemm_phase<pg8::EpiKV, pg8::StaticOrder, true, true>(F.lds, g, S, E); }
#endif
      }
        SEAM(3);
    }
    if (IN(4)) {
        const AttnP AP{(const bf16*)(ws + WS_QA), (const bf16*)(ws + WS_KN), (const bf16*)(ws + WS_KR), (const bf16*)(ws + WS_VA), (bf16*)(ws + WS_OA), nullptr};
        const IdxP IP{(const bf16*)(ws + WS_QI), (const bf16*)(ws + WS_KI), (const float*)(ws + WS_WI), (unsigned*)(ws + WS_BM)};
#ifdef REP_A
        for (int rep = 0; rep < 2; ++rep) { if (rep) xcd_barrier(bar);
        for (;;) { const int v = wq_next(F, rep ? CW_Q1 + 16 : CW_Q1); if (v >= 512) break;
#else
        {
        for (;;) { int v = wq_next(F, CW_Q1);
#ifdef REP_IDX2
            if (v >= 1024) break; v &= 511;
#else
            if (v >= 512) break;
#endif
#endif
            int ltid = threadIdx.x; asm volatile("" : "+v"(ltid));
            idx_item(F.lds, v & 1, 255 - (v >> 1), IP, ltid, ltid & 63, __builtin_amdgcn_readfirstlane(ltid >> 6)); }
        }
#ifdef REP_B
        for (int rep = 0; rep < 2; ++rep) { if (rep) xcd_barrier(bar);
        for (;;) { const int u = wq_next(F, rep ? CW_Q1 + 48 : CW_Q1 + 32); if (u >= 512) break;
#else
        {
        for (;;) { const int u = wq_next(F, CW_Q1 + 32); if (u >= 512) break;
#endif
            int ltid = threadIdx.x; asm volatile("" : "+v"(ltid));
            attn_unit<true>(F.lds, (u & 15) >> 3, u & 7, 31 - (u >> 4), AP, ltid, ltid & 63, __builtin_amdgcn_readfirstlane(ltid >> 6)); }
        }
        SEAM(4);
    }
    if (IN(5)) {
        const AttnP AP{(const bf16*)(ws + WS_QB), (const bf16*)(ws + WS_KB), nullptr, (const bf16*)(ws + WS_VB), (bf16*)(ws + WS_OB), (const unsigned*)(ws + WS_BM)};
#ifdef REP_PH5
      for (int rep = 0; rep < 2; ++rep) { if (rep) xcd_barrier(bar);
        for (;;) { int u = wq_next(F, rep ? CW_Q2 + 16 : CW_Q2);
#else
      {
        for (;;) { int u = wq_next(F, CW_Q2);
#endif
#ifdef REP_DSA
            if (u >= 1024) break; u &= 511;
#else
            if (u >= 512) break;
#endif
            int ltid = threadIdx.x; asm volatile("" : "+v"(ltid));
            attn_unit<false>(F.lds, (u & 15) >> 3, u & 7, 31 - (u >> 4), AP, ltid, ltid & 63, __builtin_amdgcn_readfirstlane(ltid >> 6)); }
      }
        SEAM(5);
    }
    if (IN(6)) {
#ifdef REP_P6
      for (int rep = 0; rep < 2; ++rep) {
#else
      {
#endif
        { pg8::Gemm g{(const bf16*)(ws + WS_OA), (const bf16*)(ws + WS_WOA), T, 1024, 512, 0}; pg8::StaticOrder S; S.init(T, 1024, F.G, (int)blockIdx.x);
          pg8::EpiY<0> E{(bf16*)(ws + WS_Y), GA}; pg8::gemm_phase<pg8::EpiY<0>, pg8::StaticOrder, true, true>(F.lds, g, S, E); }
        { pg8::Gemm g{(const bf16*)(ws + WS_OB), (const bf16*)(ws + WS_WOB), T, 1024, 512, 0}; pg8::StaticOrder S; S.init(T, 1024, F.G, (int)blockIdx.x);
          pg8::EpiY<1> E{(bf16*)(ws + WS_Y), GB}; pg8::gemm_phase<pg8::EpiY<1>, pg8::StaticOrder, true, true>(F.lds, g, S, E); }
      }
        SEAM(6);
    }
    if (IN(7)) {
        pg8::Gemm g{(const bf16*)(ws + WS_Y), (const bf16*)(ws + WS_WOUT), T, 1024, 1024, 0}; pg8::StaticOrder S; S.init(T, 1024, F.G, (int)blockIdx.x);
        pg8::EpiX1 E{args.in[0], args.out}; pg8::gemm_phase<pg8::EpiX1, pg8::StaticOrder, true, true>(F.lds, g, S, E);
#ifdef REP_P7
        pg8::gemm_phase<pg8::EpiX1, pg8::StaticOrder, true, true>(F.lds, g, S, E);
#endif
        SEAM(7);
    }
    if (IN(8)) { p5a_route(F, args); SEAM(8); }
    if (IN(9)) { p5a2_scatter(F, args); SEAM(9); }
    if (IN(10)) {
        const int* t2e = (const int*)(ws + WS_T2E); const int ntl = t2e[255];
        pg8::Gemm g{(const bf16*)(ws + WS_ASORT), (const bf16*)(ws + WS_WGU), SORT_ROWS, 512, 1024, (size_t)512 * 1024 * 2}; pg8::GroupOrder S; S.init(ntl, 2, F.G, (int)blockIdx.x, t2e);
        pg8::EpiHid E{(bf16*)(ws + WS_HID)}; pg8::gemm_phase<pg8::EpiHid, pg8::GroupOrder, true, true>(F.lds, g, S, E);
#ifdef REP_P10
        pg8::gemm_phase<pg8::EpiHid, pg8::GroupOrder, true, true>(F.lds, g, S, E);
#endif
        SEAM(10);
    }
    if (IN(11)) {
        const int* t2e = (const int*)(ws + WS_T2E); const int ntl = t2e[255];
        pg8::Gemm g{(const bf16*)(ws + WS_HID), (const bf16*)(ws + WS_WD), SORT_ROWS, 1024, 256, (size_t)1024 * 256 * 2}; pg8::GroupOrder S; S.init(ntl, 4, F.G, (int)blockIdx.x, t2e);
        pg8::EpiDown E{(bf16*)(ws + WS_SLOTS), (const int*)(ws + WS_SSLOT), (const float*)(ws + WS_SW)}; pg8::gemm_phase<pg8::EpiDown, pg8::GroupOrder, true, true>(F.lds, g, S, E);
#ifdef REP_P11
        pg8::gemm_phase<pg8::EpiDown, pg8::GroupOrder, true, true>(F.lds, g, S, E);
#endif
        SEAM(11);
    }
    if (IN(12)) { p6_final(F, args); }
#undef IN
#undef SEAM
}

#ifndef MK_MULTI
#define MK_MULTI 0
#endif
extern "C" void kernel_launch(void* const* d_in, const int* in_sizes, int n_in, void* d_out, int out_size, void* d_ws, size_t ws_size, hipStream_t stream) {
    static int grid = 0;
    if (grid == 0) {
        if (n_in != 20 || in_sizes[0] != T * D || out_size != T * D || ws_size < WS_END) { fprintf(stderr, "kernel_launch: unexpected shapes n_in %d in0 %d out %d ws %zu\n", n_in, n_in > 0 ? in_sizes[0] : -1, out_size, ws_size); grid = -1; return; }
        int dev = 0, cus = 0;
        if (hipGetDevice(&dev) != hipSuccess || hipDeviceGetAttribute(&cus, hipDeviceAttributeMultiprocessorCount, dev) != hipSuccess) { grid = -1; return; }
        if (hipFuncSetAttribute((const void*)mk_fwd, hipFuncAttributeMaxDynamicSharedMemorySize, LDS_BYTES) != hipSuccess) { fprintf(stderr, "kernel_launch: hipFuncSetAttribute failed\n"); grid = -1; return; }
        (void)hipGetLastError();
        grid = cus;
    }
    if (grid < 0) return;
    if (hipMemsetAsync((char*)d_ws + WS_CTL, 0, CTL_ZERO_BYTES, stream) != hipSuccess) return;
    Args a{};
    for (int i = 0; i < 20; ++i) a.in[i] = (const float*)d_in[i];
    a.out = (float*)d_out; a.ws = (unsigned char*)d_ws;
#if MK_MULTI
    for (int p = 0; p < NPHASE; ++p) { a.ph_lo = p; a.ph_hi = p + 1; hipLaunchKernelGGL(mk_fwd, dim3(grid), dim3(NTHR), LDS_BYTES, stream, a); }
#else
    a.ph_lo = 0; a.ph_hi = NPHASE;
    hipLaunchKernelGGL(mk_fwd, dim3(grid), dim3(NTHR), LDS_BYTES, stream, a);
#endif
}
```

```cpp
#include <hip/hip_runtime.h>
#include <cstdio>
#include <cstdint>

#define GAS __attribute__((address_space(1)))
#define LAS __attribute__((address_space(3)))
typedef unsigned short bf16;
typedef unsigned v4u __attribute__((ext_vector_type(4)));
typedef unsigned v2u __attribute__((ext_vector_type(2)));
typedef float f32x4 __attribute__((ext_vector_type(4)));
typedef float f32x2 __attribute__((ext_vector_type(2)));
typedef float f32x16 __attribute__((ext_vector_type(16)));
typedef short bf16x8 __attribute__((ext_vector_type(8)));
typedef short s16x4 __attribute__((ext_vector_type(4)));
typedef __bf16 bf16x2_t __attribute__((ext_vector_type(2)));
typedef GAS unsigned gu32;
#define RLX_AGENT __ATOMIC_RELAXED, __HIP_MEMORY_SCOPE_AGENT
#define LDS_WAIT() asm volatile("s_waitcnt lgkmcnt(0)" ::: "memory")
#define VM_WAIT() asm volatile("s_waitcnt vmcnt(0)" ::: "memory")

constexpr int NWAVES = 8, NTHR = NWAVES * 64;
constexpr int BATCH = 2, SEQ = 8192, D = 1024, T = BATCH * SEQ;
constexpr float EPS = 1e-6f;
constexpr int NIN = 4864, NIN_SRC = 4840;
constexpr int C_CQ = 0, C_CKV = 384, C_QB = 640, C_KB = 1152, C_VB = 1664, C_QI = 2176, C_KR = 2688, C_KI = 2720, C_WI = 2784, C_GA = 2816, C_GB = 3840;
constexpr int NEXP = 32, FF = 256;
constexpr int SORT_ROWS = 2 * T + NEXP * 256;
constexpr float LOG2E = 1.4426950408889634f;
constexpr float C2A = 0.10206207261596575f * LOG2E;
constexpr float C2B = 0.125f * LOG2E;
constexpr float WI_SCALE = 0.35355339059327373f * 0.125f;

constexpr size_t MiB = 1u << 20, KiB = 1u << 10;
constexpr size_t WS_CTL = 0, CTL_ZERO_BYTES = 1 * MiB;
constexpr size_t WS_ROPE = 1 * MiB;
constexpr size_t WS_WI = 2 * MiB;
constexpr size_t WS_TOKE = 2 * MiB + 512 * KiB;
constexpr size_t WS_TOKW = WS_TOKE + 128 * KiB;
constexpr size_t WS_RSTD2 = WS_TOKW + 128 * KiB;
constexpr size_t WS_SSLOT = 3 * MiB + 512 * KiB;
constexpr size_t WS_SW = WS_SSLOT + 192 * KiB;
constexpr size_t WS_T2E = WS_SW + 192 * KiB;
constexpr size_t WS_WIN = 4 * MiB, WS_WUQ = 14 * MiB, WS_WUKV = 15 * MiB, WS_WOA = 16 * MiB, WS_WOB = 17 * MiB, WS_WOUT = 18 * MiB, WS_WGU = 20 * MiB, WS_WD = 52 * MiB;
constexpr size_t WS_H = 68 * MiB, WS_OA = 68 * MiB, WS_OB = 84 * MiB;
constexpr size_t WS_QA = 100 * MiB, WS_KN = 124 * MiB, WS_VA = 140 * MiB, WS_Y = 100 * MiB;
constexpr size_t WS_QB = 156 * MiB, WS_KB = 172 * MiB, WS_VB = 188 * MiB;
constexpr size_t WS_CQ = 204 * MiB, WS_CKV = 216 * MiB, WS_BM = 204 * MiB;
constexpr size_t WS_QI = 224 * MiB, WS_KI = 240 * MiB, WS_KR = 242 * MiB;
constexpr size_t WS_ASORT = 68 * MiB, WS_SLOTS = 156 * MiB, WS_HID = 220 * MiB;
constexpr size_t WS_END = 256 * MiB;
constexpr int CW_BAR = 4096;
constexpr int CW_Q1 = 64, CW_Q2 = 128;
constexpr int CW_CNT = 256, CW_FILL = 320;
constexpr int CW_RDY = 8192;

constexpr int LDS_BYTES = 147456;
constexpr int MISC_OFF = 147456 - 512;

__device__ __forceinline__ unsigned f2bf(float f) { unsigned u = __builtin_bit_cast(unsigned, f); return (u + 0x7fffu + ((u >> 16) & 1u)) >> 16; }
__device__ __forceinline__ unsigned pk2(float lo, float hi) { f32x2 v = {lo, hi}; bf16x2_t b = __builtin_convertvector(v, bf16x2_t); return __builtin_bit_cast(unsigned, b); }
__device__ __forceinline__ float bflo(unsigned w) { return __builtin_bit_cast(float, w << 16); }
__device__ __forceinline__ float bfhi(unsigned w) { return __builtin_bit_cast(float, w & 0xffff0000u); }

#define XB_TMO      128
#define XB_XCNT(j)  (256  + 64 * (j))
#define XB_XSUB(j)  (1280 + 64 * (j))
#define XB_XGEN(j)  (2304 + 64 * (j))
#define XB_TOP      3328
#define XB_TOPGEN   3392
#define XCD_BAR_WORDS 3456
#define XB_SPIN_CAP (1u << 22)
__device__ __forceinline__ unsigned xb_ld(unsigned* p)              { return __hip_atomic_load(p, __ATOMIC_RELAXED, __HIP_MEMORY_SCOPE_AGENT); }
__device__ __forceinline__ unsigned xb_add(unsigned* p, unsigned v) { return __hip_atomic_fetch_add(p, v, __ATOMIC_RELAXED, __HIP_MEMORY_SCOPE_AGENT); }
__device__ __forceinline__ unsigned xb_xcc_id() { return (unsigned)__builtin_amdgcn_s_getreg((3 << 11) | 20) & 0xFu; }
#define XB_SPIN(cond, bar) do { unsigned _sp = 0; while (cond) { __builtin_amdgcn_s_sleep(1); \
    if ((++_sp & 255u) == 0u) { if (xb_ld(&(bar)[XB_TMO])) break; if (_sp > XB_SPIN_CAP) { atomicAdd(&(bar)[XB_TMO], 1u); break; } } } } while (0)
struct XcdBarrier { unsigned* bar; unsigned x; volatile LAS unsigned* st; };
__device__ __forceinline__ XcdBarrier xcd_barrier_post(unsigned* bar, volatile LAS unsigned* st) {
    XcdBarrier b; b.bar = bar; b.x = xb_xcc_id(); b.st = st;
    if (threadIdx.x == 0) (void)xb_add(&bar[XB_XCNT(b.x)], 1u);
    return b;
}
__device__ __forceinline__ void xcd_barrier_complete(unsigned* bar, unsigned x, unsigned& nloc, unsigned& nx) {
    const unsigned G = gridDim.x * gridDim.y * gridDim.z;
    unsigned sum, cnt, mine, sp = 0u;
    for (;;) {
        sum = 0u; cnt = 0u; mine = 0u;
#pragma unroll
        for (unsigned j = 0; j < 16; ++j) { const unsigned c = xb_ld(&bar[XB_XCNT(j)]); sum += c; cnt += (c > 0u) ? 1u : 0u; mine = (j == x) ? c : mine; }
        if (sum == G) break;
        __builtin_amdgcn_s_sleep(1);
        if ((++sp & 255u) == 0u) { if (xb_ld(&bar[XB_TMO])) break; if (sp > XB_SPIN_CAP) { atomicAdd(&bar[XB_TMO], 1u); break; } }
    }
    nloc = mine > 0u ? mine : 1u; nx = cnt > 0u ? cnt : 1u;
}
__device__ __forceinline__ void xcd_barrier(const XcdBarrier& b) {
    asm volatile("s_waitcnt vmcnt(0)" ::: "memory");
    __syncthreads();
    if (threadIdx.x == 0) {
        unsigned* bar = b.bar;
        __builtin_amdgcn_s_waitcnt(0);
        unsigned nloc = b.st[0], nx = b.st[1];
        if (nloc == 0u) { xcd_barrier_complete(bar, b.x, nloc, nx); b.st[0] = nloc; b.st[1] = nx; }
        const unsigned old = xb_add(&bar[XB_XSUB(b.x)], 1u);
        const unsigned gen = old / nloc;
        if (old + 1u == (gen + 1u) * nloc) {
            __builtin_amdgcn_fence(__ATOMIC_RELEASE, "agent");
            asm volatile("s_waitcnt vmcnt(0)" ::: "memory");
            const unsigned og = xb_add(&bar[XB_TOP], 1u);
            const unsigned tg = og / nx;
            if (og + 1u == (tg + 1u) * nx) xb_add(&bar[XB_TOPGEN], 1u);
            else XB_SPIN(xb_ld(&bar[XB_TOPGEN]) == tg, bar);
            __builtin_amdgcn_fence(__ATOMIC_ACQUIRE, "agent");
            xb_add(&bar[XB_XGEN(b.x)], 1u);
            asm volatile("s_waitcnt vmcnt(0)" ::: "memory");
        } else {
            XB_SPIN(xb_ld(&bar[XB_XGEN(b.x)]) == gen, bar);
            __builtin_amdgcn_fence(__ATOMIC_ACQUIRE, "agent");
            asm volatile("s_waitcnt vmcnt(0)" ::: "memory");
        }
    }
    __syncthreads();
}

__device__ __forceinline__ float wave_sum(float v) {
#pragma unroll
    for (int o = 1; o < 64; o <<= 1) v += __shfl_xor(v, o);
    return v;
}

namespace pg8 {
#define PG8_LAS __attribute__((address_space(3)))
typedef unsigned short bf16_t;
typedef unsigned u32x4 __attribute__((ext_vector_type(4)));
constexpr int BM = 256, BK = 64, HALF = 128, HTB = HALF * BK * 2, STAGE_BYTES = 8 * HTB, NXCD = 8, WGM = 8;
__host__ __device__ __forceinline__ int lds_byte(int r, int c) { const int st = (r >> 4) * 2 + (c >> 5), rr = r & 15, cc = c & 31, ob = rr * 64 + cc * 2; return st * 1024 + (ob ^ (((ob >> 9) & 1) << 5)); }
__host__ __device__ __forceinline__ void stage_rc(int b, int& R, int& C) { const int st = b / 1024, sb = b % 1024, swz = sb ^ (((sb >> 9) & 1) << 5); R = (st >> 1) * 16 + swz / 64; C = (st & 1) * 32 + (swz % 64) / 2; }
__host__ __device__ __forceinline__ int perm32(int rho) { const int n = rho >> 4, i = rho & 15; return 8 * (i >> 2) + 4 * n + (i & 3); }

struct Unit { int pm, pn, e; };
struct Gemm { const bf16_t* A; const bf16_t* Bt; int M, N, K; size_t estride; };

struct StaticOrder {
    int nM, nN, nwg, G, c;
    __host__ __device__ void init(int M, int N, int G_, int c_) { nM = M / BM; nN = N / BM; nwg = nM * nN; G = G_; c = c_; }
    __host__ __device__ bool next(int i, Unit& u) const {
        const long L = (long)i * G + c; if (L >= nwg) return false;
        int wgid = (int)L; { const int q = nwg / NXCD, r = nwg % NXCD, xcd = wgid % NXCD, off = wgid / NXCD; wgid = (xcd < r ? xcd * (q + 1) : r * (q + 1) + (xcd - r) * q) + off; }
        const int nig = WGM * nN, gid = wgid / nig, fm = gid * WGM, gsz = (nM - fm) < WGM ? (nM - fm) : WGM;
        u.pm = fm + ((wgid % nig) % gsz); u.pn = (wgid % nig) / gsz; u.e = 0; return true;
    }
    __device__ __forceinline__ void a_ready(const Unit&) const {}
    __device__ __forceinline__ void done(const Unit&) const {}
};
struct GroupOrder {
    int nN, total, G, c; const int* t2e;
    __device__ void init(int nTiles, int nN_, int G_, int c_, const int* t2e_) { nN = nN_; total = nTiles * nN_; G = G_; c = c_; t2e = t2e_; }
    __device__ bool next(int i, Unit& u) const {
        const long L = (long)i * G + c; if (L >= total) return false;
        u.pm = (int)(L / nN); u.pn = (int)(L % nN); u.e = __builtin_amdgcn_readfirstlane(t2e[u.pm]); return true;
    }
    __device__ __forceinline__ void a_ready(const Unit&) const {}
    __device__ __forceinline__ void done(const Unit&) const {}
};

__device__ __forceinline__ void st8(bf16_t* p, f32x4 v0, f32x4 v1) { u32x4 w; w.x = pk2(v0[0], v0[1]); w.y = pk2(v0[2], v0[3]); w.z = pk2(v1[0], v1[1]); w.w = pk2(v1[2], v1[3]); *(u32x4*)p = w; }
__device__ __forceinline__ void ld8(const bf16_t* p, f32x4& v0, f32x4& v1) { const u32x4 w = *(const u32x4*)p; v0 = (f32x4){bflo(w.x), bfhi(w.x), bflo(w.y), bfhi(w.y)}; v1 = (f32x4){bflo(w.z), bfhi(w.z), bflo(w.w), bfhi(w.w)}; }

__device__ __forceinline__ void rope16(f32x4& v0, f32x4& v1, int row, int fq, const f32x2* rope) {
    const f32x2* rp = rope + (size_t)(row & (SEQ - 1)) * 16;
    f32x4 p0, p1;
#pragma unroll
    for (int e = 0; e < 4; ++e) { p0[e] = __shfl_xor(v0[e], 16); p1[e] = __shfl_xor(v1[e], 16); }
    if (fq < 2) {
        const float sg = fq == 0 ? -1.f : 1.f;
#pragma unroll
        for (int e = 0; e < 4; ++e) { const f32x2 a = rp[2 * e], b = rp[2 * (4 + e)];
            v0[e] = v0[e] * a.x + sg * p0[e] * a.y; v1[e] = v1[e] * b.x + sg * p1[e] * b.y; }
    }
}
__device__ __forceinline__ void rope32(f32x4& v0, f32x4& v1, int row, int fq, const f32x2* rope) {
    const f32x2* rp = rope + (size_t)(row & (SEQ - 1)) * 16 + 8 * (fq & 1);
    const float sg = fq < 2 ? -1.f : 1.f;
#pragma unroll
    for (int e = 0; e < 4; ++e) { const float p0 = __shfl_xor(v0[e], 32), p1 = __shfl_xor(v1[e], 32); const f32x2 a = rp[e], b = rp[4 + e];
        v0[e] = v0[e] * a.x + sg * p0 * a.y; v1[e] = v1[e] * b.x + sg * p1 * b.y; }
}
__device__ __forceinline__ float sigmoidf_(float x) { return __builtin_amdgcn_rcpf(1.f + __builtin_amdgcn_exp2f(-1.4426950408889634f * x)); }

struct EpiIn {
    static constexpr bool PERM = true, AFTER_DRAIN = false;
    bf16_t *CQ, *CKV, *QB, *KB, *VB, *QI, *KI, *KR, *GA, *GB; float* WI; const f32x2* rope;
    __device__ __forceinline__ void operator()(const f32x4 (&acc)[2][2][4][2], const Unit& u, int wr, int wc, int fr, int fq) const {
        const int row0 = u.pm * BM + wr * 64 + fr;
#pragma unroll
        for (int bj = 0; bj < 2; ++bj) {
            const int cg = u.pn * BM + bj * HALF + wc * 32;
            bf16_t* base = nullptr; int pitch = 0, cc = 0, mode = 0; float sc = 1.f;
            if (cg < C_CKV) { base = CQ; pitch = 384; cc = cg; }
            else if (cg < C_QB) { base = CKV; pitch = 256; cc = cg - C_CKV; }
            else if (cg < C_KB) { base = QB; pitch = 512; cc = cg - C_QB; mode = ((cc >> 5) & 1) == 0 ? 1 : 0; sc = C2B; }
            else if (cg < C_VB) { base = KB; pitch = 512; cc = cg - C_KB; mode = ((cc >> 5) & 1) == 0 ? 1 : 0; }
            else if (cg < C_QI) { base = VB; pitch = 512; cc = cg - C_VB; }
            else if (cg < C_KR) { base = QI; pitch = 512; cc = cg - C_QI; mode = ((cc >> 5) & 1) == 0 ? 1 : 0; }
            else if (cg < C_KI) { base = KR; pitch = 32; cc = 0; mode = 2; }
            else if (cg < C_WI) { base = KI; pitch = 64; cc = cg - C_KI; mode = (cc == 0) ? 1 : 0; }
            else if (cg < C_GA) { mode = 4; }
            else if (cg < C_GB) { base = GA; pitch = 1024; cc = cg - C_GA; mode = 3; }
            else { base = GB; pitch = 1024; cc = cg - C_GB; mode = 3; }
#pragma unroll
            for (int ai = 0; ai < 2; ++ai)
#pragma unroll
                for (int m = 0; m < 4; ++m) {
                    const int row = row0 + ai * HALF + m * 16;
                    f32x4 v0 = acc[ai][bj][m][0], v1 = acc[ai][bj][m][1];
                    if (mode == 1) rope16(v0, v1, row, fq, rope);
                    else if (mode == 2) rope32(v0, v1, row, fq, rope);
                    else if (mode == 3) {
#pragma unroll
                        for (int e = 0; e < 4; ++e) { v0[e] = sigmoidf_(v0[e]); v1[e] = sigmoidf_(v1[e]); } }
                    if (mode == 4) { if (fq == 0) { *(f32x4*)(WI + (size_t)row * 8) = v0 * WI_SCALE; *(f32x4*)(WI + (size_t)row * 8 + 4) = v1 * WI_SCALE; } }
                    else { v0 = v0 * sc; v1 = v1 * sc; st8(base + (size_t)row * pitch + cc + 8 * fq, v0, v1); }
                }
        }
    }
};
struct EpiQA {
    static constexpr bool PERM = true, AFTER_DRAIN = false;
    bf16_t* QA; const f32x2* rope;
    __device__ __forceinline__ void operator()(const f32x4 (&acc)[2][2][4][2], const Unit& u, int wr, int wc, int fr, int fq) const {
        const int row0 = u.pm * BM + wr * 64 + fr;
#pragma unroll
        for (int bj = 0; bj < 2; ++bj) {
            const int cg = u.pn * BM + bj * HALF + wc * 32; const bool rot = ((cg >> 5) % 3) == 2;
#pragma unroll
            for (int ai = 0; ai < 2; ++ai)
#pragma unroll
                for (int m = 0; m < 4; ++m) {
                    const int row = row0 + ai * HALF + m * 16;
                    f32x4 v0 = acc[ai][bj][m][0], v1 = acc[ai][bj][m][1];
                    if (rot) rope32(v0, v1, row, fq, rope);
                    v0 = v0 * C2A; v1 = v1 * C2A; st8(QA + (size_t)row * 768 + cg + 8 * fq, v0, v1);
                }
        }
    }
};
struct EpiKV {
    static constexpr bool PERM = true, AFTER_DRAIN = false;
    bf16_t *KN, *VA;
    __device__ __forceinline__ void operator()(const f32x4 (&acc)[2][2][4][2], const Unit& u, int wr, int wc, int fr, int fq) const {
        const int row0 = u.pm * BM + wr * 64 + fr;
#pragma unroll
        for (int bj = 0; bj < 2; ++bj) {
            const int cg = u.pn * BM + bj * HALF + wc * 32; bf16_t* base = cg < 512 ? KN : VA; const int cc = (cg & 511) + 8 * fq;
#pragma unroll
            for (int ai = 0; ai < 2; ++ai)
#pragma unroll
                for (int m = 0; m < 4; ++m) { const int row = row0 + ai * HALF + m * 16; st8(base + (size_t)row * 512 + cc, acc[ai][bj][m][0], acc[ai][bj][m][1]); }
        }
    }
};
template <int ADD> struct EpiY {
    static constexpr bool PERM = true, AFTER_DRAIN = false;
    bf16_t* Y; const bf16_t* Gt;
    __device__ __forceinline__ void operator()(const f32x4 (&acc)[2][2][4][2], const Unit& u, int wr, int wc, int fr, int fq) const {
        const int row0 = u.pm * BM + wr * 64 + fr;
#pragma unroll
        for (int bj = 0; bj < 2; ++bj) {
            const int c0 = u.pn * BM + bj * HALF + wc * 32 + 8 * fq;
#pragma unroll
            for (int ai = 0; ai < 2; ++ai)
#pragma unroll
                for (int m = 0; m < 4; ++m) { const size_t off = (size_t)(row0 + ai * HALF + m * 16) * 1024 + c0;
                    f32x4 g0, g1; ld8(Gt + off, g0, g1);
                    f32x4 v0 = acc[ai][bj][m][0] * g0, v1 = acc[ai][bj][m][1] * g1;
                    if (ADD) { f32x4 o0, o1; ld8(Y + off, o0, o1); v0 = v0 + o0; v1 = v1 + o1; }
                    st8(Y + off, v0, v1); }
        }
    }
};
struct EpiX1 {
    static constexpr bool PERM = false, AFTER_DRAIN = false;
    const float* X; float* O;
    __device__ __forceinline__ void operator()(const f32x4 (&acc)[2][2][4][2], const Unit& u, int wr, int wc, int fr, int fq) const {
        const int row0 = u.pm * BM + wr * 64 + fr, col0 = u.pn * BM + wc * 32 + 4 * fq;
#pragma unroll
        for (int ai = 0; ai < 2; ++ai)
#pragma unroll
            for (int m = 0; m < 4; ++m) { const size_t off = (size_t)(row0 + ai * HALF + m * 16) * 1024 + col0;
#pragma unroll
                for (int bj = 0; bj < 2; ++bj)
#pragma unroll
                    for (int n = 0; n < 2; ++n) { const f32x4 xv = *(const f32x4*)(X + off + bj * HALF + n * 16); *(f32x4*)(O + off + bj * HALF + n * 16) = xv + acc[ai][bj][m][n]; } }
    }
};
struct EpiHid {
    static constexpr bool PERM = true, AFTER_DRAIN = false;
    bf16_t* HID;
    __device__ __forceinline__ void operator()(const f32x4 (&acc)[2][2][4][2], const Unit& u, int wr, int wc, int fr, int fq) const {
        const int row0 = u.pm * BM + wr * 64 + fr, c0 = u.pn * 128 + wc * 32 + 8 * fq;
#pragma unroll
        for (int ai = 0; ai < 2; ++ai)
#pragma unroll
            for (int m = 0; m < 4; ++m) { f32x4 h0, h1;
#pragma unroll
                for (int e = 0; e < 4; ++e) { const float g0 = acc[ai][0][m][0][e], g1 = acc[ai][0][m][1][e];
                    h0[e] = g0 * sigmoidf_(g0) * acc[ai][1][m][0][e]; h1[e] = g1 * sigmoidf_(g1) * acc[ai][1][m][1][e]; }
                st8(HID + (size_t)(row0 + ai * HALF + m * 16) * 256 + c0, h0, h1); }
    }
};
struct EpiDown {
    static constexpr bool PERM = true, AFTER_DRAIN = false;
    bf16_t* SL; const int* sslot; const float* sw;
    __device__ __forceinline__ void operator()(const f32x4 (&acc)[2][2][4][2], const Unit& u, int wr, int wc, int fr, int fq) const {
        const int row0 = u.pm * BM + wr * 64 + fr;
#pragma unroll
        for (int ai = 0; ai < 2; ++ai)
#pragma unroll
            for (int m = 0; m < 4; ++m) { const int r = row0 + ai * HALF + m * 16; const int slot = sslot[r]; const float w = sw[r];
                if (slot >= 0) {
#pragma unroll
                    for (int bj = 0; bj < 2; ++bj) st8(SL + (size_t)slot * 1024 + u.pn * BM + bj * HALF + wc * 32 + 8 * fq, acc[ai][bj][m][0] * w, acc[ai][bj][m][1] * w); } }
    }
};
template <class Epi, class Sched, bool ALIGN_EPI = false, bool SP2 = false>
__device__ __forceinline__ void gemm_phase(PG8_LAS unsigned char* lds, const Gemm g, const Sched& S, const Epi& E) {
    const int tid = threadIdx.x, wid = __builtin_amdgcn_readfirstlane(tid >> 6), lane = tid & 63, wr = wid >> 2, wc = wid & 3, fr = lane & 15, fq = lane >> 4;
    const int K = g.K, nt = K / BK;
    unsigned voffA[2], voffB[2];
#pragma unroll
    for (int i = 0; i < 2; ++i) { int R, C; stage_rc(tid * 16 + i * 8192, R, C); const int Rb = Epi::PERM ? ((R & ~31) + perm32(R & 31)) : R;
        voffA[i] = (unsigned)(R * K + C) * 2u; voffB[i] = (unsigned)(Rb * K + C) * 2u; }
    const size_t kstep = (size_t)(BK * 2);
    const size_t hstep = (size_t)HALF * K * 2;
    const size_t tstep = 2 * hstep;
    const unsigned ldsw = (unsigned)wid * 1024u;
    const int aoff = lds_byte(wr * 64 + fr, fq * 8), boff = lds_byte(wc * 32 + fr, fq * 8);
#define PG8_SA(b, h) (((b) * 2 + (h)) * HTB)
#define PG8_SB(b, h) ((4 + (b) * 2 + (h)) * HTB)
#define PG8_STAGE(bufoff, gbase, voff) do { _Pragma("unroll") for (int _i = 0; _i < 2; ++_i) \
        __builtin_amdgcn_global_load_lds((const unsigned*)((const char*)(gbase) + (voff)[_i]), (PG8_LAS unsigned*)(lds + (bufoff) + ldsw + _i * 8192), 16, 0, 0); } while (0)
#define PG8_LDA(dst, b, h) do { _Pragma("unroll") for (int m = 0; m < 4; ++m) _Pragma("unroll") for (int k = 0; k < 2; ++k) dst[m][k] = *(const PG8_LAS bf16x8*)(lds + PG8_SA(b, h) + aoff + m * 2048 + k * 1024); } while (0)
#define PG8_LDB(dst, b, h) do { _Pragma("unroll") for (int n = 0; n < 2; ++n) _Pragma("unroll") for (int k = 0; k < 2; ++k) dst[n][k] = *(const PG8_LAS bf16x8*)(lds + PG8_SB(b, h) + boff + n * 2048 + k * 1024); } while (0)
#define PG8_MMA(ai, bj, At, Bt) do { __builtin_amdgcn_s_setprio(1); _Pragma("unroll") for (int m = 0; m < 4; ++m) _Pragma("unroll") for (int n = 0; n < 2; ++n) _Pragma("unroll") for (int k = 0; k < 2; ++k) \
        acc[ai][bj][m][n] = __builtin_amdgcn_mfma_f32_16x16x32_bf16(Bt[n][k], At[m][k], acc[ai][bj][m][n], 0, 0, 0); __builtin_amdgcn_s_setprio(0); } while (0)
#define PG8_WAIT_V(n) asm volatile("s_waitcnt vmcnt(" #n ")" ::: "memory")
#define PG8_WAIT_L(n) asm volatile("s_waitcnt lgkmcnt(" #n ")" ::: "memory")
#define PG8_BAR __builtin_amdgcn_s_barrier()
#define PG8_SCHED __builtin_amdgcn_sched_barrier(0)
    Unit cur, nxt; int ui = 0;
    if (!S.next(0, cur)) return;
    f32x4 acc[2][2][4][2];
#pragma unroll
    for (int a = 0; a < 2; ++a)
#pragma unroll
        for (int b = 0; b < 2; ++b)
#pragma unroll
            for (int m = 0; m < 4; ++m)
#pragma unroll
                for (int n = 0; n < 2; ++n) acc[a][b][m][n] = (f32x4){0.f, 0.f, 0.f, 0.f};
    bf16x8 At[4][2], B0[2][2], B1[2][2];
    const char* cA = (const char*)g.A + (size_t)cur.pm * tstep; const char* cB = (const char*)g.Bt + (size_t)cur.e * g.estride + (size_t)cur.pn * tstep;
    S.a_ready(cur);
    if constexpr (SP2) {
        PG8_STAGE(PG8_SB(0, 0), cB, voffB); PG8_STAGE(PG8_SB(0, 1), cB + hstep, voffB); PG8_STAGE(PG8_SA(0, 0), cA, voffA); PG8_STAGE(PG8_SA(0, 1), cA + hstep, voffA);
        if (wr == 1) PG8_BAR;
        PG8_WAIT_V(2); PG8_BAR;
        PG8_STAGE(PG8_SB(1, 0), cB + kstep, voffB); PG8_STAGE(PG8_SA(1, 0), cA + kstep, voffA); PG8_STAGE(PG8_SB(1, 1), cB + hstep + kstep, voffB);
        PG8_WAIT_V(6); PG8_BAR;
    } else {
        PG8_STAGE(PG8_SB(0, 0), cB, voffB); PG8_STAGE(PG8_SA(0, 0), cA, voffA); PG8_STAGE(PG8_SB(0, 1), cB + hstep, voffB); PG8_STAGE(PG8_SA(0, 1), cA + hstep, voffA);
        if (wr == 1) PG8_BAR;
        PG8_WAIT_V(4); PG8_BAR;
        PG8_STAGE(PG8_SB(1, 0), cB + kstep, voffB); PG8_STAGE(PG8_SA(1, 0), cA + kstep, voffA); PG8_STAGE(PG8_SB(1, 1), cB + hstep + kstep, voffB);
        PG8_WAIT_V(6); PG8_BAR;
    }
    for (;;) {
        const bool has_next = S.next(ui + 1, nxt);
        const char* nA = has_next ? (const char*)g.A + (size_t)nxt.pm * tstep : cA; const char* nB = has_next ? (const char*)g.Bt + (size_t)nxt.e * g.estride + (size_t)nxt.pn * tstep : cB;
#pragma nounroll
        for (int t = 0; t < nt; t += 2) {
            const bool last = (t == nt - 2);
            const char* a1 = cA + (size_t)(t + 1) * kstep;
            const char* a2 = last ? nA : cA + (size_t)(t + 2) * kstep; const char* b2 = last ? nB : cB + (size_t)(t + 2) * kstep;
            const char* a3 = a2 + kstep; const char* b3 = b2 + kstep;
            if (last && has_next) S.a_ready(nxt);
            if constexpr (SP2) {
            PG8_LDB(B0, 0, 0); PG8_LDB(B1, 0, 1); PG8_SCHED; PG8_LDA(At, 0, 0); PG8_STAGE(PG8_SA(1, 1), a1 + hstep, voffA);
            PG8_WAIT_V(8); PG8_WAIT_L(0); PG8_BAR; PG8_MMA(0, 0, At, B0); PG8_MMA(0, 1, At, B1); PG8_BAR; PG8_SCHED;
            PG8_LDA(At, 0, 1); PG8_STAGE(PG8_SB(0, 0), b2, voffB); PG8_STAGE(PG8_SB(0, 1), b2 + hstep, voffB); PG8_STAGE(PG8_SA(0, 0), a2, voffA);
            PG8_WAIT_V(8); PG8_WAIT_L(0); PG8_BAR; PG8_MMA(1, 0, At, B0); PG8_MMA(1, 1, At, B1); PG8_BAR; PG8_SCHED;
            PG8_LDB(B0, 1, 0); PG8_LDB(B1, 1, 1); PG8_SCHED; PG8_LDA(At, 1, 0); PG8_STAGE(PG8_SA(0, 1), a2 + hstep, voffA);
            PG8_WAIT_V(8); PG8_WAIT_L(0); PG8_BAR; PG8_MMA(0, 0, At, B0); PG8_MMA(0, 1, At, B1); PG8_BAR; PG8_SCHED;
            PG8_LDA(At, 1, 1); PG8_STAGE(PG8_SB(1, 0), b3, voffB); PG8_STAGE(PG8_SB(1, 1), b3 + hstep, voffB); PG8_STAGE(PG8_SA(1, 0), a3, voffA);
            PG8_WAIT_V(8); PG8_WAIT_L(0); PG8_BAR; PG8_MMA(1, 0, At, B0); PG8_MMA(1, 1, At, B1); PG8_BAR; PG8_SCHED;
            } else {
            PG8_LDB(B0, 0, 0); PG8_SCHED; PG8_LDA(At, 0, 0); PG8_STAGE(PG8_SA(1, 1), a1 + hstep, voffA);
            PG8_WAIT_L(8); PG8_BAR; PG8_WAIT_L(0); PG8_MMA(0, 0, At, B0); PG8_BAR; PG8_SCHED;
            PG8_LDB(B1, 0, 1); PG8_STAGE(PG8_SB(0, 0), b2, voffB);
            PG8_BAR; PG8_WAIT_L(0); PG8_MMA(0, 1, At, B1); PG8_BAR;
            PG8_LDA(At, 0, 1); PG8_STAGE(PG8_SA(0, 0), a2, voffA);
            PG8_BAR; PG8_WAIT_L(0); PG8_MMA(1, 0, At, B0); PG8_BAR; PG8_SCHED;
            PG8_STAGE(PG8_SB(0, 1), b2 + hstep, voffB);
            PG8_WAIT_V(6); PG8_BAR; PG8_MMA(1, 1, At, B1); PG8_BAR;
            PG8_LDB(B0, 1, 0); PG8_SCHED; PG8_LDA(At, 1, 0); PG8_STAGE(PG8_SA(0, 1), a2 + hstep, voffA);
            PG8_WAIT_L(8); PG8_BAR; PG8_WAIT_L(0); PG8_MMA(0, 0, At, B0); PG8_BAR; PG8_SCHED;
            PG8_LDB(B1, 1, 1); PG8_STAGE(PG8_SB(1, 0), b3, voffB);
            PG8_BAR; PG8_WAIT_L(0); PG8_MMA(0, 1, At, B1); PG8_BAR;
            PG8_LDA(At, 1, 1); PG8_STAGE(PG8_SA(1, 0), a3, voffA);
            PG8_BAR; PG8_WAIT_L(0); PG8_MMA(1, 0, At, B0); PG8_BAR; PG8_SCHED;
            PG8_STAGE(PG8_SB(1, 1), b3 + hstep, voffB);
            PG8_WAIT_V(6); PG8_BAR; PG8_MMA(1, 1, At, B1); PG8_BAR;
            }
        }
        if constexpr (ALIGN_EPI) { if (wr == 0) PG8_BAR; }
        if constexpr (!Epi::AFTER_DRAIN) { E(acc, cur, wr, wc, fr, fq); S.done(cur); }
        if (!has_next) break;
#pragma unroll
        for (int a = 0; a < 2; ++a)
#pragma unroll
            for (int b = 0; b < 2; ++b)
#pragma unroll
                for (int m = 0; m < 4; ++m)
#pragma unroll
                    for (int n = 0; n < 2; ++n) acc[a][b][m][n] = (f32x4){0.f, 0.f, 0.f, 0.f};
        cur = nxt; cA = nA; cB = nB; ++ui;
        if constexpr (ALIGN_EPI) { if (wr == 1) PG8_BAR; }
    }
    PG8_WAIT_V(0);
    if constexpr (!ALIGN_EPI) { if (wr == 0) PG8_BAR; }
    PG8_BAR;
    if constexpr (Epi::AFTER_DRAIN) { E.fused(acc, cur, wr, wc, fr, fq, lds, wid, lane); S.done(cur); }
#undef PG8_SA
#undef PG8_SB
#undef PG8_STAGE
#undef PG8_LDA
#undef PG8_LDB
#undef PG8_MMA
#undef PG8_WAIT_V
#undef PG8_WAIT_L
#undef PG8_BAR
#undef PG8_SCHED
}
}

struct Args { const float* in[20]; float* out; unsigned char* ws; int ph_lo, ph_hi; };
struct Frame {
    LAS unsigned char* lds; volatile LAS unsigned* MISC; gu32* ctl; unsigned char* ws;
    int vcu, G;
};
#define F_TID ((int)threadIdx.x)
#define F_LANE ((int)(threadIdx.x & 63))
#define F_WAVE (__builtin_amdgcn_readfirstlane((int)(threadIdx.x >> 6)))

__device__ __forceinline__ int in_src_col(int n) {
    if (n < 640) return n;
    if (n < 2688) return n + 32;
    if (n < 2720) return n - 2688 + 640;
    if (n < 2792) return n;
    if (n < 2816) return -1;
    return n - 24;
}
__device__ __forceinline__ void tr_item(const float* colptr, int ld, int k0, bf16* WT, int Kd, int destrow0, LAS float* scr, int lane) {
    const int nq = lane & 15, kr = lane >> 4;
#pragma unroll 8
    for (int it = 0; it < 16; ++it) { const int kk = 4 * it + kr; f32x4 v = (f32x4){0.f, 0.f, 0.f, 0.f}; if (colptr) v = *(const GAS f32x4*)(colptr + (size_t)(k0 + kk) * ld);
        LAS float* d = scr + kk * 65 + 4 * nq; d[0] = v.x; d[1] = v.y; d[2] = v.z; d[3] = v.w; }
    LDS_WAIT(); asm volatile("" ::: "memory");
    const int c = lane & 7;
#pragma unroll
    for (int j = 0; j < 8; ++j) { const int n = (lane >> 3) + 8 * j; const LAS float* q = scr + (8 * c) * 65 + n;
        v4u o; o.x = pk2(q[0 * 65], q[1 * 65]); o.y = pk2(q[2 * 65], q[3 * 65]); o.z = pk2(q[4 * 65], q[5 * 65]); o.w = pk2(q[6 * 65], q[7 * 65]);
        *(GAS v4u*)(WT + (size_t)(destrow0 + n) * Kd + k0 + 8 * c) = o; }
    LDS_WAIT(); asm volatile("" ::: "memory");
}
__device__ __forceinline__ void p0_prologue(Frame& F, const Args& A) {
    LAS float* scr = (LAS float*)(F.lds + F_WAVE * 16640);
    const int gw = F.vcu * NWAVES + F_WAVE, NGW = F.G * NWAVES, lane = F_LANE;
    unsigned char* ws = F.ws;
    constexpr int I0 = 16 * 76, I1 = 6 * 12, I2 = 4 * 16, I3 = 8 * 16, I4 = 8 * 16, I5 = 16 * 16, I6 = 32 * 16 * 8, I7 = 32 * 4 * 16;
    constexpr int NITEMS = I0 + I1 + I2 + I3 + I4 + I5 + I6 + I7;
    const int n4 = 4 * (lane & 15);
    for (int it = gw; it < NITEMS; it += NGW) {
        int r = it;
        if (r < I0) { const int kb = r / 76, nb = r % 76; const int col = in_src_col(64 * nb + n4);
            tr_item(col >= 0 ? A.in[2] + col : nullptr, NIN_SRC, 64 * kb, (bf16*)(ws + WS_WIN), 1024, 64 * nb, scr, lane); continue; } r -= I0;
        if (r < I1) { const int kb = r / 12, nb = r % 12; tr_item(A.in[4] + 64 * nb + n4, 768, 64 * kb, (bf16*)(ws + WS_WUQ), 384, 64 * nb, scr, lane); continue; } r -= I1;
        if (r < I2) { const int kb = r / 16, nb = r % 16; const int n = 64 * nb + n4;
            tr_item(n < 512 ? A.in[6] + n : A.in[7] + (n - 512), 512, 64 * kb, (bf16*)(ws + WS_WUKV), 256, 64 * nb, scr, lane); continue; } r -= I2;
        if (r < I3) { const int kb = r / 16, nb = r % 16; tr_item(A.in[8] + 64 * nb + n4, 1024, 64 * kb, (bf16*)(ws + WS_WOA), 512, 64 * nb, scr, lane); continue; } r -= I3;
        if (r < I4) { const int kb = r / 16, nb = r % 16; tr_item(A.in[9] + 64 * nb + n4, 1024, 64 * kb, (bf16*)(ws + WS_WOB), 512, 64 * nb, scr, lane); continue; } r -= I4;
        if (r < I5) { const int kb = r / 16, nb = r % 16; tr_item(A.in[10] + 64 * nb + n4, 1024, 64 * kb, (bf16*)(ws + WS_WOUT), 1024, 64 * nb, scr, lane); continue; } r -= I5;
        if (r < I6) { const int e = r / 128, rr = r % 128, kb = rr / 8, nb = rr % 8; const int n = 64 * nb + n4, pn = n >> 8, c = n & 255, col = 128 * pn + (c & 127);
            const float* src = ((c >> 7) ? A.in[17] : A.in[16]) + (size_t)e * 1024 * 256 + col;
            tr_item(src, 256, 64 * kb, (bf16*)(ws + WS_WGU) + (size_t)e * 512 * 1024, 1024, 64 * nb, scr, lane); continue; } r -= I6;
        { const int e = r / 64, rr = r % 64, kb = rr / 16, nb = rr % 16;
            tr_item(A.in[18] + (size_t)e * 256 * 1024 + 64 * nb + n4, 1024, 64 * kb, (bf16*)(ws + WS_WD) + (size_t)e * 1024 * 256, 256, 64 * nb, scr, lane); }
    }
    const float* x = A.in[0]; const float* g1 = A.in[1]; bf16* H = (bf16*)(ws + WS_H);
    for (int m0 = gw; m0 < T; m0 += 4 * NGW) {
        f32x4 v[4][4];
#pragma unroll
        for (int r = 0; r < 4; ++r) { const int m = min(m0 + r * NGW, T - 1); const GAS f32x4* xr = (const GAS f32x4*)(x + (size_t)m * D) + lane;
#pragma unroll
            for (int j = 0; j < 4; ++j) v[r][j] = xr[64 * j]; }
#pragma unroll
        for (int r = 0; r < 4; ++r) { const int m = m0 + r * NGW; float s = 0.f;
#pragma unroll
            for (int j = 0; j < 4; ++j) s += (v[r][j].x * v[r][j].x + v[r][j].y * v[r][j].y) + (v[r][j].z * v[r][j].z + v[r][j].w * v[r][j].w);
            const float rstd = 1.f / sqrtf(wave_sum(s) * (1.f / D) + EPS);
            if (m < T) { GAS v2u* o8 = (GAS v2u*)(H + (size_t)m * D) + lane;
#pragma unroll
                for (int j = 0; j < 4; ++j) { const f32x4 g = *((const GAS f32x4*)g1 + lane + 64 * j); const f32x4 y = v[r][j] * rstd * g; v2u w; w.x = pk2(y.x, y.y); w.y = pk2(y.z, y.w); o8[64 * j] = w; } } }
    }
    f32x2* rope = (f32x2*)(ws + WS_ROPE);
    for (int idx = (F.vcu * NTHR + F_TID); idx < SEQ * 16; idx += F.G * NTHR) {
        const int pos = idx >> 4, i = idx & 15;
        const double REV[16] = {0.15915494309189535, 0.0700865215877985, 0.03086376340470123, 0.013591370636193905, 0.005985185712713705, 0.002635675898667414, 0.001160663641240061, 0.0005111175045375439,
                                0.00022507907903927653, 9.911730936901935e-05, 4.364795279280289e-05, 1.9221100684944863e-05, 8.464330808241401e-06, 3.727408601915352e-06, 1.6414262627950345e-06, 7.228293068832865e-07};
        double rv = 0.0;
#pragma unroll
        for (int k = 0; k < 16; ++k) rv = (i == k) ? REV[k] : rv;
        double t = (double)pos * rv; t -= __builtin_floor(t);
        const float tf = (float)t;
        rope[idx] = (f32x2){__builtin_amdgcn_cosf(tf), __builtin_amdgcn_sinf(tf)};
    }
}

__device__ __forceinline__ void p2a_norms(Frame& F, const Args& A) {
    const int gw = F.vcu * NWAVES + F_WAVE, NGW = F.G * NWAVES, lane = F_LANE;
    bf16* CQ = (bf16*)(F.ws + WS_CQ); bf16* CKV = (bf16*)(F.ws + WS_CKV);
    const float* gq = A.in[3]; const float* gkv = A.in[5];
    for (int m = gw; m < T; m += NGW) {
        {
            GAS unsigned* p = (GAS unsigned*)(CQ + (size_t)m * 384) + lane; unsigned w[3]; float s = 0.f;
#pragma unroll
            for (int j = 0; j < 3; ++j) { w[j] = p[64 * j]; const float a = bflo(w[j]), b = bfhi(w[j]); s += a * a + b * b; }
            const float rstd = 1.f / sqrtf(wave_sum(s) * (1.f / 384.f) + EPS);
#pragma unroll
            for (int j = 0; j < 3; ++j) { const f32x2 g = *((const GAS f32x2*)gq + lane + 64 * j); p[64 * j] = pk2(bflo(w[j]) * rstd * g.x, bfhi(w[j]) * rstd * g.y); }
        }
        {
            GAS v2u* p = (GAS v2u*)(CKV + (size_t)m * 256) + lane; const v2u w = *p;
            const float a = bflo(w.x), b = bfhi(w.x), c = bflo(w.y), d = bfhi(w.y);
            const float rstd = 1.f / sqrtf(wave_sum(a * a + b * b + c * c + d * d) * (1.f / 256.f) + EPS);
            const f32x4 g = *((const GAS f32x4*)gkv + lane); v2u o; o.x = pk2(a * rstd * g.x, b * rstd * g.y); o.y = pk2(c * rstd * g.z, d * rstd * g.w); *p = o;
        }
    }
}

__device__ __forceinline__ constexpr int crow(int r, int hi) { return (r & 3) + 8 * (r >> 2) + 4 * hi; }
constexpr float ATT_THR = 8.f;
__device__ __forceinline__ float att_mask(float p, unsigned w, int bit) { int mk; unsigned r;
    asm("v_bfe_i32 %0, %1, %2, 1" : "=v"(mk) : "v"(w), "i"(bit)); r = __builtin_bit_cast(unsigned, p) & (unsigned)mk; return __builtin_bit_cast(float, r); }
struct AttnP { const bf16 *Q, *K, *K2, *V; bf16* O; const unsigned* BM; };
template <bool MLA> __device__ __forceinline__ void attn_unit(LAS unsigned char* L, int b, int h, int qb, const AttnP& P, int tid, int lane, int wave) {
    constexpr int DK = MLA ? 96 : 64, KP = DK * 2 + 16, NS = DK / 16, CPR = DK / 8;
    constexpr int QPITCH = MLA ? 768 : 512, VP = 192, KBUF = 64 * KP, VBUF = 64 * VP;
    const int r32 = lane & 31, hi = lane >> 5;
    const size_t rowb = (size_t)b * SEQ;
    const int qrow = qb * 256 + wave * 32 + r32;
    bf16x8 qf[NS];
    { const bf16* qp = P.Q + (rowb + qrow) * QPITCH + h * DK;
#pragma unroll
      for (int s = 0; s < NS; ++s) qf[s] = *(const bf16x8*)(qp + 16 * s + 8 * hi); }
    const int NT = 4 * qb + 4, my_nt = 4 * qb + (wave >> 1) + 1;
    const int kid0 = tid, kid1 = tid + NTHR;
    const int kr0 = kid0 / CPR, kc0 = kid0 % CPR, kr1 = kid1 / CPR, kc1 = kid1 % CPR; const bool has1 = MLA && (kid1 < 64 * CPR);
    const int vr = tid >> 3, vc = tid & 7;
    v4u kreg0, kreg1 = (v4u){0u, 0u, 0u, 0u}, vreg;
#define ATT_KSRC(t, kr, kc) (MLA ? ((kc) < 8 ? (const v4u*)(P.K + (rowb + 64 * (t) + (kr)) * 512 + h * 64 + 8 * (kc)) : (const v4u*)(P.K2 + (rowb + 64 * (t) + (kr)) * 32 + 8 * ((kc) - 8))) \
                                 : (const v4u*)(P.K + (rowb + 64 * (t) + (kr)) * 512 + h * 64 + 8 * (kc)))
#define ATT_LOAD(t) do { kreg0 = *ATT_KSRC(t, kr0, kc0); if (has1) kreg1 = *ATT_KSRC(t, kr1, kc1); vreg = *(const v4u*)(P.V + (rowb + 64 * (t) + vr) * 512 + h * 64 + 8 * vc); } while (0)
#define ATT_WRITE(buf) do { *(LAS v4u*)(L + (buf) * KBUF + kr0 * KP + kc0 * 16) = kreg0; if (has1) *(LAS v4u*)(L + (buf) * KBUF + kr1 * KP + kc1 * 16) = kreg1; \
                            *(LAS v4u*)(L + 2 * KBUF + (buf) * VBUF + vr * VP + vc * 16) = vreg; } while (0)
    float mhat = 0.f, l = 0.f; f32x16 o0, o1, negm;
#pragma unroll
    for (int i = 0; i < 16; ++i) { o0[i] = 0.f; o1[i] = 0.f; negm[i] = 0.f; }
    const int g16 = lane >> 4, qq = (lane & 15) >> 2, pp = lane & 3;
    const int vlane = (4 * hi + qq) * VP + (16 * (g16 & 1) + 4 * pp) * 2;
    ATT_LOAD(0); ATT_WRITE(0); __syncthreads();
    unsigned wn0 = 0xffffffffu, wn1 = 0xffffffffu;
    const unsigned* bmq = MLA ? nullptr : P.BM + (size_t)b * 256 * SEQ + qrow;
    if (!MLA) { wn0 = bmq[0]; wn1 = bmq[SEQ]; }
    for (int t = 0; t < NT; ++t) {
        const int buf = t & 1;
        unsigned w0 = wn0 >> (4 * hi), w1 = wn1 >> (4 * hi);
        if (t + 1 < NT) { ATT_LOAD(t + 1); if (!MLA) { wn0 = bmq[(size_t)(2 * t + 2) * SEQ]; wn1 = bmq[(size_t)(2 * t + 3) * SEQ]; } }
        if (t < my_nt) {
            const LAS unsigned char* Kb = L + buf * KBUF; const LAS unsigned char* Vb = L + 2 * KBUF + buf * VBUF;
            f32x16 s0, s1;
            bf16x8 ka[NS][2];
#pragma unroll
            for (int s = 0; s < NS; ++s) { ka[s][0] = *(const LAS bf16x8*)(Kb + r32 * KP + s * 32 + hi * 16); ka[s][1] = *(const LAS bf16x8*)(Kb + (32 + r32) * KP + s * 32 + hi * 16); }
            __builtin_amdgcn_sched_barrier(0);
#pragma unroll
            for (int s = 0; s < NS; ++s) {
                s0 = __builtin_amdgcn_mfma_f32_32x32x16_bf16(ka[s][0], qf[s], s == 0 ? negm : s0, 0, 0, 0);
                s1 = __builtin_amdgcn_mfma_f32_32x32x16_bf16(ka[s][1], qf[s], s == 0 ? negm : s1, 0, 0, 0);
            }
            s16x4 vf[4][4];
#pragma unroll
            for (int ks = 0; ks < 4; ++ks) { const LAS unsigned char* vp = Vb + ks * 16 * VP + vlane;
                vf[ks][0] = __builtin_bit_cast(s16x4, __builtin_amdgcn_ds_read_tr16_b64_v4i16((LAS s16x4*)(vp)));
                vf[ks][1] = __builtin_bit_cast(s16x4, __builtin_amdgcn_ds_read_tr16_b64_v4i16((LAS s16x4*)(vp + 8 * VP)));
                vf[ks][2] = __builtin_bit_cast(s16x4, __builtin_amdgcn_ds_read_tr16_b64_v4i16((LAS s16x4*)(vp + 64)));
                vf[ks][3] = __builtin_bit_cast(s16x4, __builtin_amdgcn_ds_read_tr16_b64_v4i16((LAS s16x4*)(vp + 8 * VP + 64))); }
            __builtin_amdgcn_sched_barrier(0);
            float mx = fmaxf(fmaxf(s0[0], s0[1]), s1[0]);
#pragma unroll
            for (int i = 2; i < 16; i += 2) mx = fmaxf(fmaxf(mx, s0[i]), s0[i + 1]);
#pragma unroll
            for (int i = 1; i < 15; i += 2) mx = fmaxf(fmaxf(mx, s1[i]), s1[i + 1]);
            mx = fmaxf(mx, s1[15]);
            mx = fmaxf(mx, __shfl_xor(mx, 32));
            if (t == 0 || __any(mx > ATT_THR)) {
                const float dl = (t == 0) ? mx : fmaxf(mx, 0.f), f = (t == 0) ? 1.f : __builtin_amdgcn_exp2f(-dl);
                mhat += dl; l *= f;
#pragma unroll
                for (int i = 0; i < 16; ++i) { s0[i] -= dl; s1[i] -= dl; o0[i] *= f; o1[i] *= f; negm[i] = -mhat; }
            }
            float rs = 0.f;
#pragma unroll
            for (int i = 0; i < 16; ++i) {
                float p0 = __builtin_amdgcn_exp2f(s0[i]), p1 = __builtin_amdgcn_exp2f(s1[i]);
                if (!MLA) { p0 = att_mask(p0, w0, crow(i, 0)); p1 = att_mask(p1, w1, crow(i, 0)); }
                s0[i] = p0; s1[i] = p1; rs += p0 + p1; }
            l += rs;
            bf16x8 pf[4];
#pragma unroll
            for (int ks = 0; ks < 4; ++ks) { v4u w;
#pragma unroll
                for (int j = 0; j < 4; ++j) { const float a = (ks < 2) ? s0[8 * (ks & 1) + 2 * j] : s1[8 * (ks & 1) + 2 * j], c = (ks < 2) ? s0[8 * (ks & 1) + 2 * j + 1] : s1[8 * (ks & 1) + 2 * j + 1]; w[j] = pk2(a, c); }
                pf[ks] = __builtin_bit_cast(bf16x8, w); }
#pragma unroll
            for (int ks = 0; ks < 4; ++ks) {
                const bf16x8 A0 = __builtin_shufflevector(vf[ks][0], vf[ks][1], 0, 1, 2, 3, 4, 5, 6, 7);
                const bf16x8 A1 = __builtin_shufflevector(vf[ks][2], vf[ks][3], 0, 1, 2, 3, 4, 5, 6, 7);
                o0 = __builtin_amdgcn_mfma_f32_32x32x16_bf16(A0, pf[ks], o0, 0, 0, 0);
                o1 = __builtin_amdgcn_mfma_f32_32x32x16_bf16(A1, pf[ks], o1, 0, 0, 0);
            }
        }
        if (t + 1 < NT) ATT_WRITE(buf ^ 1);
        __syncthreads();
    }
    l += __shfl_xor(l, 32);
    const float inv = 1.f / l;
    bf16* op = P.O + (rowb + qrow) * 512 + h * 64 + 4 * hi;
#pragma unroll
    for (int g = 0; g < 4; ++g) {
        v2u w; w.x = pk2(o0[4 * g] * inv, o0[4 * g + 1] * inv); w.y = pk2(o0[4 * g + 2] * inv, o0[4 * g + 3] * inv); *(v2u*)(op + 8 * g) = w;
        v2u z; z.x = pk2(o1[4 * g] * inv, o1[4 * g + 1] * inv); z.y = pk2(o1[4 * g + 2] * inv, o1[4 * g + 3] * inv); *(v2u*)(op + 32 + 8 * g) = z;
    }
#undef ATT_KSRC
#undef ATT_LOAD
#undef ATT_WRITE
}

constexpr int CAND_CAP = 128, QIP = 1296, HS = 513;
struct IdxP { const bf16 *QI, *KI; const float* WI; unsigned* BM; };
__device__ __forceinline__ unsigned mono_key(float s) { const unsigned u = __builtin_bit_cast(unsigned, s + 0.0f); return u ^ ((unsigned)((int)u >> 31) | 0x80000000u); }
__device__ __forceinline__ void idx_scores2(const bf16x8 (&kf)[2][4], const LAS unsigned char* qlane, const float (&wq)[8], f32x16& sc0, f32x16& sc1) {
    bf16x8 qv[4], qn[4];
#pragma unroll
    for (int s = 0; s < 4; ++s) qv[s] = *(const LAS bf16x8*)(qlane + 8 * 128 + s * 32);
#pragma unroll
    for (int i = 0; i < 16; ++i) { sc0[i] = 0.f; sc1[i] = 0.f; }
    f32x16 ap0, ap1;
#pragma unroll
    for (int i = 0; i < 16; ++i) { ap0[i] = 0.f; ap1[i] = 0.f; }
#pragma unroll
    for (int n = 0; n < 10; ++n) {
        const int nh = (n + 1 < 2) ? 9 : (n + 1 - 2);
        if (n + 1 < 10) {
#pragma unroll
            for (int s = 0; s < 4; ++s) qn[s] = *(const LAS bf16x8*)(qlane + nh * 128 + s * 32); }
        f32x16 a0, a1;
        if (n < 2) {
#pragma unroll
            for (int s = 0; s < 4; ++s) { sc0 = __builtin_amdgcn_mfma_f32_32x32x16_bf16(kf[0][s], qv[s], sc0, 0, 0, 0); sc1 = __builtin_amdgcn_mfma_f32_32x32x16_bf16(kf[1][s], qv[s], sc1, 0, 0, 0); }
        } else {
#pragma unroll
            for (int i = 0; i < 16; ++i) { a0[i] = 0.f; a1[i] = 0.f; }
#pragma unroll
            for (int s = 0; s < 4; ++s) { a0 = __builtin_amdgcn_mfma_f32_32x32x16_bf16(kf[0][s], qv[s], a0, 0, 0, 0); a1 = __builtin_amdgcn_mfma_f32_32x32x16_bf16(kf[1][s], qv[s], a1, 0, 0, 0); }
        }
        if (n >= 3) {
            const float w = wq[n - 3];
#pragma unroll
            for (int i = 0; i < 16; ++i) { sc0[i] = __builtin_fmaf(w, __builtin_fabsf(ap0[i]), sc0[i]); sc1[i] = __builtin_fmaf(w, __builtin_fabsf(ap1[i]), sc1[i]); }
#pragma unroll
            for (int g = 0; g < 8; ++g) { __builtin_amdgcn_sched_group_barrier(0x008, 1, 0); __builtin_amdgcn_sched_group_barrier(0x002, 4, 0); }
        }
        if (n >= 2) { ap0 = a0; ap1 = a1; }
#pragma unroll
        for (int s = 0; s < 4; ++s) qv[s] = qn[s];
    }
    { const float w = wq[7];
#pragma unroll
      for (int i = 0; i < 16; ++i) { sc0[i] = __builtin_fmaf(w, __builtin_fabsf(ap0[i]), sc0[i]); sc1[i] = __builtin_fmaf(w, __builtin_fabsf(ap1[i]), sc1[i]); } }
#pragma unroll
    for (int i = 0; i < 16; ++i) asm volatile("" : "+v"(sc0[i]), "+v"(sc1[i]));
}
__device__ __forceinline__ void idx_item(LAS unsigned char* L, int b, int j, const IdxP& P, int tid, int lane, int wave) {
    LAS unsigned* hist = (LAS unsigned*)L;
    LAS unsigned* img = (LAS unsigned*)(L + 66048);
    LAS unsigned* st = (LAS unsigned*)(L + 98816);
    LAS unsigned* cand = hist;
    LAS unsigned char* Qs = L + 100864;
    const int r32 = lane & 31, hi = lane >> 5;
    const int q0 = 32 * j, ntile = 2 * (j / 2 + 1);
    const size_t rowb = (size_t)b * SEQ;
    if (ntile <= 8) {
        for (int idx = tid; idx < ntile * 32; idx += NTHR) P.BM[((size_t)b * 256 + (idx >> 5)) * SEQ + q0 + (idx & 31)] = 0xffffffffu;
        return;
    }
    float wq[8];
    { for (int c = tid; c < 32 * 64; c += NTHR) { const int rr = c >> 6, ch = c & 63; *(LAS v4u*)(Qs + rr * QIP + ch * 16) = *(const v4u*)(P.QI + (rowb + q0 + rr) * 512 + ch * 8); }
      const float* wp = P.WI + (rowb + q0 + r32) * 8;
#pragma unroll
      for (int h = 0; h < 8; ++h) wq[h] = 0.5f * wp[h]; }
    if (tid < 32) { st[32 + tid] = 256u; st[64 + tid] = 0u; st[96 + tid] = 0u; }
    if (tid == 0) st[129] = 0u;
    __syncthreads();
    {
        const int r = tid >> 4, part = tid & 15;
        const float* wp = P.WI + (rowb + q0 + r) * 8;
        float qb[4] = {0.f, 0.f, 0.f, 0.f}; float rsum = 0.f;
#pragma unroll
        for (int h = 0; h < 8; ++h) { const float w = wp[h]; const v2u raw = *(const LAS v2u*)(Qs + r * QIP + h * 128 + part * 8);
            const float f0 = bflo(raw.x), f1 = bfhi(raw.x), f2 = bflo(raw.y), f3 = bfhi(raw.y);
            float nsq = (f0 * f0 + f1 * f1) + (f2 * f2 + f3 * f3);
#pragma unroll
            for (int o = 1; o < 16; o <<= 1) nsq += __shfl_xor(nsq, o);
            rsum += fabsf(w) * sqrtf(nsq);
            qb[0] += 0.5f * w * f0; qb[1] += 0.5f * w * f1; qb[2] += 0.5f * w * f2; qb[3] += 0.5f * w * f3; }
        v2u hw, lw;
        { const unsigned h01 = pk2(qb[0], qb[1]), h23 = pk2(qb[2], qb[3]); hw.x = h01; hw.y = h23;
          lw.x = pk2(qb[0] - bflo(h01), qb[1] - bfhi(h01)); lw.y = pk2(qb[2] - bflo(h23), qb[3] - bfhi(h23)); }
        *(LAS v2u*)(Qs + r * QIP + 8 * 128 + part * 8) = hw; *(LAS v2u*)(Qs + r * QIP + 9 * 128 + part * 8) = lw;
        { const v2u kw = *(const v2u*)(P.KI + (rowb + r) * 64 + part * 4); const float f0 = bflo(kw.x), f1 = bfhi(kw.x), f2 = bflo(kw.y), f3 = bfhi(kw.y);
          float ksq = (f0 * f0 + f1 * f1) + (f2 * f2 + f3 * f3);
#pragma unroll
          for (int o = 1; o < 16; o <<= 1) ksq += __shfl_xor(ksq, o);
          if (part == 0) { __hip_atomic_fetch_max(&st[129], __builtin_bit_cast(unsigned, ksq), __ATOMIC_RELAXED, __HIP_MEMORY_SCOPE_WORKGROUP); st[224 + r] = __builtin_bit_cast(unsigned, rsum); } }
    }
    __syncthreads();
    if (tid < 32) { const float R = 0.25f * sqrtf(__builtin_bit_cast(float, st[129])) * __builtin_bit_cast(float, st[224 + tid]);
        const float C = 0.125f * R;
        st[160 + tid] = (0x80000000u | __builtin_bit_cast(unsigned, R + C)) - 511u * 131072u; st[224 + tid] = __builtin_bit_cast(unsigned, C); st[tid] = 0u; st[192 + tid] = 0u; }
    const LAS unsigned char* qlane = Qs + r32 * QIP + hi * 16;
    int level = 0;
    const int npair = ntile >> 1;
#define IDX_KLOAD2(tp) { const bf16* kp = P.KI + (rowb + 64 * (tp) + r32) * 64 + 8 * hi; _Pragma("unroll") for (int s = 0; s < 4; ++s) { kn[0][s] = *(const bf16x8*)(kp + 16 * s); kn[1][s] = *(const bf16x8*)(kp + 32 * 64 + 16 * s); } }
#define IDX_SCORES2(tp) \
        bf16x8 kf[2][4]; _Pragma("unroll") for (int s = 0; s < 4; ++s) { kf[0][s] = kn[0][s]; kf[1][s] = kn[1][s]; } \
        f32x16 sc0, sc1; idx_scores2(kf, qlane, wq, sc0, sc1); \
        if ((tp) + NWAVES < npair) { IDX_KLOAD2((tp) + NWAVES) }
    for (;;) {
        ++level;
        for (int u = tid; u < 32 * HS; u += NTHR) hist[u] = 0u;
        if (tid == 0) st[128] = 0u;
        __syncthreads();
        {
            const unsigned qa = st[r32], qlen = st[192 + r32], base1 = st[160 + r32]; const float cq = __builtin_bit_cast(float, st[224 + r32]);
            const int sh = (level > 1 && qlen > 512u) ? (32 - __builtin_clz(qlen - 1u)) - 9 : 0;
            LAS unsigned* hrow = hist + r32 * HS;
            bf16x8 kn[2][4]; if (wave < npair) { IDX_KLOAD2(wave) }
            for (int tp = wave; tp < npair; tp += NWAVES) {
                IDX_SCORES2(tp)
                if (level == 1) {
#pragma unroll
                    for (int i = 0; i < 16; ++i) { const unsigned k0 = mono_key(sc0[i] + cq), k1 = mono_key(sc1[i] + cq);
                        const unsigned b0 = min((max(k0, base1) - base1) >> 17, 511u), b1 = min((max(k1, base1) - base1) >> 17, 511u);
                        __hip_atomic_fetch_add(&hrow[b0], 1u, __ATOMIC_RELAXED, __HIP_MEMORY_SCOPE_WORKGROUP); __hip_atomic_fetch_add(&hrow[b1], 1u, __ATOMIC_RELAXED, __HIP_MEMORY_SCOPE_WORKGROUP); }
                } else {
#pragma unroll
                    for (int i = 0; i < 16; ++i) { const unsigned o0 = mono_key(sc0[i] + cq) - qa, o1 = mono_key(sc1[i] + cq) - qa;
                        if (o0 < qlen) __hip_atomic_fetch_add(&hrow[o0 >> sh], 1u, __ATOMIC_RELAXED, __HIP_MEMORY_SCOPE_WORKGROUP);
                        if (o1 < qlen) __hip_atomic_fetch_add(&hrow[o1 >> sh], 1u, __ATOMIC_RELAXED, __HIP_MEMORY_SCOPE_WORKGROUP); }
                }
            }
        }
        __syncthreads();
        {
            const int q = tid >> 4, seg = tid & 15;
            unsigned segsum = 0u;
            for (int wi = 0; wi < 32; ++wi) segsum += hist[q * HS + seg * 32 + wi];
            unsigned S = segsum;
#pragma unroll
            for (int off = 1; off < 16; off <<= 1) { const unsigned o = __shfl_down(S, off, 16); if (seg + off < 16) S += o; }
            const unsigned above = S - segsum, need = st[32 + q];
            if (above < need && need <= above + segsum) {
                unsigned cum = above, fbin = 0u, fneed = 1u, fcnt = 0u; bool found = false;
                for (int wi = 31; wi >= 0; --wi) { const unsigned c = hist[q * HS + seg * 32 + wi];
                    if (!found && cum + c >= need) { found = true; fbin = 32 * seg + wi; fneed = need - cum; fcnt = c; } if (!found) cum += c; }
                unsigned na, nlen;
                if (level == 1) { const unsigned base1 = st[160 + q];
                    if (fbin == 0u) { na = 0u; nlen = base1 + 131072u; } else if (fbin == 511u) { na = base1 + 511u * 131072u; nlen = 0u - na; } else { na = base1 + fbin * 131072u; nlen = 131072u; } }
                else { const unsigned qa = st[q], qlen = st[192 + q]; const int sh = qlen > 512u ? (32 - __builtin_clz(qlen - 1u)) - 9 : 0;
                    na = qa + (fbin << sh); nlen = min(1u << sh, qlen - (fbin << sh)); }
                st[q] = na; st[192 + q] = nlen; st[32 + q] = fneed; st[64 + q] = fcnt;
                if (fcnt > (unsigned)CAND_CAP && nlen > 1u) st[128] = 1u;
            }
        }
        __syncthreads();
#ifndef MAXLVL
#define MAXLVL 8
#endif
        const bool more = (st[128] != 0u) && (level < MAXLVL);
        __syncthreads();
        if (!more) break;
    }
    {
        const unsigned qa = st[r32], qlen = st[192 + r32]; const float cq = __builtin_bit_cast(float, st[224 + r32]);
        const unsigned Hk = qa + qlen - 1u;
        unsigned hb = (Hk & 0x80000000u) ? (Hk ^ 0x80000000u) : ~Hk;
        if (hb == 0x80000000u) hb = 0x80000001u;
        const float fH = __builtin_bit_cast(float, hb);
        const unsigned ab_ = (qa & 0x80000000u) ? (qa ^ 0x80000000u) : ~qa;
        const float fA = (qa < 0x00800000u) ? -__builtin_inff() : __builtin_bit_cast(float, ab_);
        bf16x8 kn[2][4]; if (wave < npair) { IDX_KLOAD2(wave) }
        for (int tp = wave; tp < npair; tp += NWAVES) {
            IDX_SCORES2(tp)
#define IDX_COLLECT_ELEMS(SC, T) { unsigned v = 0u; _Pragma("unroll") for (int i = 15; i >= 0; --i) { const float ts = SC[i] + cq; const bool ab = ts > fH; v = v + v + (ab ? 1u : 0u); \
                if (!ab && ts >= fA) { const unsigned key = mono_key(ts); \
                    const unsigned pos = __hip_atomic_fetch_add(&st[96 + r32], 1u, __ATOMIC_RELAXED, __HIP_MEMORY_SCOPE_WORKGROUP); \
                    if (pos < (unsigned)CAND_CAP) { cand[(r32 * CAND_CAP + pos) * 2] = key; cand[(r32 * CAND_CAP + pos) * 2 + 1] = (unsigned)(32 * (T) + crow(i, hi)); } } } \
            unsigned bits = (v & 0xfu) | ((v & 0xf0u) << 4) | ((v & 0xf00u) << 8) | ((v & 0xf000u) << 12);     \
            bits <<= 4 * hi; bits |= __shfl_xor(bits, 32); if (hi == 0) img[(T) * 32 + r32] = bits; }
            IDX_COLLECT_ELEMS(sc0, 2 * tp)
            IDX_COLLECT_ELEMS(sc1, 2 * tp + 1)
#undef IDX_COLLECT_ELEMS
        }
    }
#undef IDX_SCORES2
#undef IDX_KLOAD2
    __syncthreads();
    {
        const int q = tid >> 4; const unsigned n = min(st[96 + q], (unsigned)CAND_CAP), need = st[32 + q];
        for (unsigned c = tid & 15; c < n; c += 16) { const unsigned key = cand[(q * CAND_CAP + c) * 2], idx = cand[(q * CAND_CAP + c) * 2 + 1]; unsigned rank = 0u;
            for (unsigned o = 0; o < n; ++o) { const unsigned k2 = cand[(q * CAND_CAP + o) * 2], i2 = cand[(q * CAND_CAP + o) * 2 + 1]; rank += (k2 > key || (k2 == key && i2 < idx)) ? 1u : 0u; }
            if (rank < need) __hip_atomic_fetch_or(&img[(idx >> 5) * 32 + q], 1u << (idx & 31), __ATOMIC_RELAXED, __HIP_MEMORY_SCOPE_WORKGROUP); }
    }
    __syncthreads();
    for (int idx = tid; idx < ntile * 32; idx += NTHR) P.BM[((size_t)b * 256 + (idx >> 5)) * SEQ + q0 + (idx & 31)] = img[idx];
    __syncthreads();
}

__device__ __forceinline__ int wq_next(Frame& F, int cw) {
    __syncthreads();
    if (F_TID == 0) F.MISC[0] = __hip_atomic_fetch_add((unsigned*)(F.ctl + cw), 1u, RLX_AGENT);
    __syncthreads();
    return (int)F.MISC[0];
}

__device__ __forceinline__ void p5a_route(Frame& F, const Args& A) {
    const int lane = F_LANE, tid = F_TID, wave = F_WAVE;
    const float* x1 = A.out; const float* g2 = A.in[11];
    const float* wrg = A.in[12]; const float* brg = A.in[13]; const float* wre = A.in[14]; const float* bre = A.in[15];
    int* toke = (int*)(F.ws + WS_TOKE); float* tokw = (float*)(F.ws + WS_TOKW); float* rstd2 = (float*)(F.ws + WS_RSTD2);
    int* sslot = (int*)(F.ws + WS_SSLOT);
    constexpr int WST = 44, WCH = 256 * WST * 4;
    LAS float* wl = (LAS float*)F.lds;
    LAS unsigned* lcnt = (LAS unsigned*)(F.lds + 2 * WCH);
    LAS float* lgs = (LAS float*)(F.lds + 2 * WCH + 256);
    for (int i = F.vcu * NTHR + tid; i < SORT_ROWS; i += F.G * NTHR) sslot[i] = -1;
    if (tid < NEXP) lcnt[tid] = 0u;
    const int i16 = lane & 15, kq = lane >> 4, tile = wave & 3, half = wave >> 2;
    const int per = T / F.G;
    for (int t0 = F.vcu * per; t0 < (F.vcu + 1) * per; t0 += 64) {
        const float* xr = x1 + (size_t)(t0 + 16 * tile + i16) * D + 4 * kq;
        f32x4 acc0 = (f32x4){0.f, 0.f, 0.f, 0.f}, acc1 = acc0; float ss = 0.f;
        f32x4 se[4], sg; float gk[5];
#define RT_LOAD(c) do { _Pragma("unroll") for (int q = 0; q < 4; ++q) { const int f = tid + 512 * q, k = f >> 3; se[q] = *(const GAS f32x4*)(wre + (size_t)(256 * (c) + k) * 32 + 4 * (f & 7)); gk[q] = g2[256 * (c) + k]; } \
            { const int k = tid >> 1; sg = *(const GAS f32x4*)(wrg + (size_t)(256 * (c) + k) * 8 + 4 * (tid & 1)); gk[4] = g2[256 * (c) + k]; } } while (0)
#define RT_WRITE(bf) do { LAS float* wb = wl + (bf) * (WCH / 4); _Pragma("unroll") for (int q = 0; q < 4; ++q) { const int f = tid + 512 * q, k = f >> 3; *(LAS f32x4*)(wb + k * WST + 4 * (f & 7)) = se[q] * gk[q]; } \
            { const int k = tid >> 1; *(LAS f32x4*)(wb + k * WST + 32 + 4 * (tid & 1)) = sg * gk[4]; } } while (0)
        RT_LOAD(0); RT_WRITE(0); __syncthreads();
        for (int c = 0; c < 4; ++c) {
            if (c + 1 < 4) RT_LOAD(c + 1);
            const LAS float* wb = wl + (c & 1) * (WCH / 4) + 4 * kq * WST + i16 + 16 * half;
#pragma unroll 4
            for (int s = 0; s < 16; ++s) {
                const f32x4 a4 = *(const GAS f32x4*)(xr + 256 * c + 16 * s);
                if (half == 0) ss += (a4.x * a4.x + a4.y * a4.y) + (a4.z * a4.z + a4.w * a4.w);
#pragma unroll
                for (int cc = 0; cc < 4; ++cc) { const LAS float* wp = wb + (16 * s + cc) * WST;
                    acc0 = __builtin_amdgcn_mfma_f32_16x16x4f32(a4[cc], wp[0], acc0, 0, 0, 0);
                    if (half == 0) acc1 = __builtin_amdgcn_mfma_f32_16x16x4f32(a4[cc], wp[32 - (i16 & 8)], acc1, 0, 0, 0); }
            }
            if (c + 1 < 4) RT_WRITE((c + 1) & 1);
            __syncthreads();
        }
#undef RT_LOAD
#undef RT_WRITE
        LAS float* lt = lgs + tile * 640;
#pragma unroll
        for (int r = 0; r < 4; ++r) { const int tk = 4 * kq + r; lt[tk * 40 + 8 + 16 * half + i16] = acc0[r]; if (half == 0 && i16 < 8) lt[tk * 40 + i16] = acc1[r]; }
        if (half == 0) { ss += __shfl_xor(ss, 16); ss += __shfl_xor(ss, 32); if (kq == 0) lgs[2560 + 16 * tile + i16] = 1.f / sqrtf(ss * (1.f / D) + EPS); }
        __syncthreads();
        if (half == 0 && lane < 16) {
            const int m = t0 + 16 * tile + lane; const float rstd = lgs[2560 + 16 * tile + lane]; const LAS float* lg = lt + lane * 40;
            float gl[8];
#pragma unroll
            for (int k = 0; k < 8; ++k) gl[k] = lg[k] * rstd + brg[k];
            int gs = 0; float gm = gl[0];
#pragma unroll
            for (int k = 1; k < 8; ++k) if (gl[k] > gm) { gm = gl[k]; gs = k; }
            float den = 0.f;
#pragma unroll
            for (int k = 0; k < 8; ++k) den += __expf(gl[k] - gm);
            const float wgrp = 1.f / den;
            float el[4];
#pragma unroll
            for (int cc = 0; cc < 4; ++cc) el[cc] = lg[8 + 4 * gs + cc] * rstd + bre[4 * gs + cc];
            int i1 = 0; float v1 = el[0];
#pragma unroll
            for (int cc = 1; cc < 4; ++cc) if (el[cc] > v1) { v1 = el[cc]; i1 = cc; }
            int i2 = -1; float v2 = 0.f;
#pragma unroll
            for (int cc = 0; cc < 4; ++cc) if (cc != i1 && (i2 < 0 || el[cc] > v2)) { v2 = el[cc]; i2 = cc; }
            const float e2 = __expf(v2 - v1), w1 = 1.f / (1.f + e2), w2 = e2 / (1.f + e2);
            toke[2 * m] = gs * 4 + i1; toke[2 * m + 1] = gs * 4 + i2; tokw[2 * m] = w1 * wgrp; tokw[2 * m + 1] = w2 * wgrp; rstd2[m] = rstd;
            __hip_atomic_fetch_add(&lcnt[gs * 4 + i1], 1u, __ATOMIC_RELAXED, __HIP_MEMORY_SCOPE_WORKGROUP);
            __hip_atomic_fetch_add(&lcnt[gs * 4 + i2], 1u, __ATOMIC_RELAXED, __HIP_MEMORY_SCOPE_WORKGROUP);
        }
        __syncthreads();
    }
    if (tid < NEXP && lcnt[tid]) __hip_atomic_fetch_add((unsigned*)(F.ctl + CW_CNT + tid), lcnt[tid], RLX_AGENT);
}

__device__ __forceinline__ void p5a2_scatter(Frame& F, const Args& A) {
    const int lane = F_LANE, tid = F_TID;
    const float* x1 = A.out; const float* g2 = A.in[11];
    const int* toke = (const int*)(F.ws + WS_TOKE); const float* tokw = (const float*)(F.ws + WS_TOKW); const float* rstd2 = (const float*)(F.ws + WS_RSTD2);
    int* sslot = (int*)(F.ws + WS_SSLOT); float* sw = (float*)(F.ws + WS_SW); int* t2e = (int*)(F.ws + WS_T2E);
    bf16* AS = (bf16*)(F.ws + WS_ASORT);
    LAS unsigned* sh = (LAS unsigned*)F.lds;
    if (tid < NEXP) sh[256 + tid] = __hip_atomic_load((unsigned*)(F.ctl + CW_CNT + tid), RLX_AGENT);
    __syncthreads();
    if (tid == 0) { unsigned acc = 0u;
        for (int e = 0; e < NEXP; ++e) { const unsigned c = sh[256 + e]; sh[e] = acc; const unsigned nt = (c + 255u) / 256u;
            if (blockIdx.x == 0) for (unsigned i = 0; i < nt; ++i) t2e[acc / 256u + i] = e;
            acc += nt * 256u; }
        if (blockIdx.x == 0) t2e[255] = (int)(acc / 256u); }
    const int per = T / F.G;
    for (int t0 = F.vcu * per; t0 < (F.vcu + 1) * per; t0 += 64) {
        if (tid < NEXP) sh[32 + tid] = 0u;
        __syncthreads();
        int e = 0; unsigned lpos = 0u;
        if (tid < 128) { e = toke[2 * t0 + tid]; lpos = __hip_atomic_fetch_add(&sh[32 + e], 1u, __ATOMIC_RELAXED, __HIP_MEMORY_SCOPE_WORKGROUP); }
        __syncthreads();
        if (tid < NEXP) sh[64 + tid] = sh[tid] + (sh[32 + tid] ? __hip_atomic_fetch_add((unsigned*)(F.ctl + CW_FILL + tid), sh[32 + tid], RLX_AGENT) : 0u);
        __syncthreads();
        if (tid < 128) { const unsigned pos = sh[64 + e] + lpos; sh[96 + tid] = pos; sslot[pos] = 2 * t0 + tid; sw[pos] = tokw[2 * t0 + tid]; }
        __syncthreads();
        for (int tk0 = F_WAVE; tk0 < 64; tk0 += 4 * NWAVES) {
            f32x4 xv[4][4];
#pragma unroll
            for (int r = 0; r < 4; ++r) { const GAS f32x4* xr = (const GAS f32x4*)(x1 + (size_t)(t0 + tk0 + r * NWAVES) * D) + lane;
#pragma unroll
                for (int j = 0; j < 4; ++j) xv[r][j] = xr[64 * j]; }
#pragma unroll
            for (int r = 0; r < 4; ++r) { const int tk = tk0 + r * NWAVES, m = t0 + tk; const float rstd = rstd2[m];
                const unsigned p0 = sh[96 + 2 * tk], p1 = sh[96 + 2 * tk + 1];
#pragma unroll
                for (int j = 0; j < 4; ++j) { const f32x4 g = *((const GAS f32x4*)g2 + lane + 64 * j); const f32x4 y = xv[r][j] * rstd * g; v2u w; w.x = pk2(y.x, y.y); w.y = pk2(y.z, y.w);
                    *((GAS v2u*)(AS + (size_t)p0 * D) + lane + 64 * j) = w; *((GAS v2u*)(AS + (size_t)p1 * D) + lane + 64 * j) = w; } } }
        __syncthreads();
    }
}

__device__ __forceinline__ void p6_final(Frame& F, const Args& A) {
    const int gw = F.vcu * NWAVES + F_WAVE, NGW = F.G * NWAVES, lane = F_LANE;
    const float* gf = A.in[19]; float* out = A.out; const bf16* SL = (const bf16*)(F.ws + WS_SLOTS);
    for (int m0 = gw; m0 < T; m0 += 2 * NGW) {
        f32x4 v[2][4]; v2u a[2][4], c[2][4];
#pragma unroll
        for (int r = 0; r < 2; ++r) { const int m = min(m0 + r * NGW, T - 1); const GAS f32x4* xr = (const GAS f32x4*)(out + (size_t)m * D) + lane;
            const GAS v2u* s0 = (const GAS v2u*)(SL + (size_t)(2 * m) * D) + lane; const GAS v2u* s1 = (const GAS v2u*)(SL + (size_t)(2 * m + 1) * D) + lane;
#pragma unroll
            for (int j = 0; j < 4; ++j) { v[r][j] = xr[64 * j]; a[r][j] = s0[64 * j]; c[r][j] = s1[64 * j]; } }
#pragma unroll
        for (int r = 0; r < 2; ++r) { const int m = m0 + r * NGW; float s = 0.f;
#pragma unroll
            for (int j = 0; j < 4; ++j) { f32x4& w = v[r][j];
                w.x += bflo(a[r][j].x) + bflo(c[r][j].x); w.y += bfhi(a[r][j].x) + bfhi(c[r][j].x); w.z += bflo(a[r][j].y) + bflo(c[r][j].y); w.w += bfhi(a[r][j].y) + bfhi(c[r][j].y);
                s += (w.x * w.x + w.y * w.y) + (w.z * w.z + w.w * w.w); }
            const float rstd = 1.f / sqrtf(wave_sum(s) * (1.f / D) + EPS);
            if (m < T) { GAS f32x4* xo = (GAS f32x4*)(out + (size_t)m * D) + lane;
#pragma unroll
                for (int j = 0; j < 4; ++j) { const f32x4 g = *((const GAS f32x4*)gf + lane + 64 * j); xo[64 * j] = v[r][j] * rstd * g; } } }
    }
}

constexpr int NPHASE = 13;
__global__ void __launch_bounds__(NTHR, 2) mk_fwd(Args args) {
    extern __shared__ __attribute__((aligned(16))) unsigned char lds[];
    Frame F;
    F.lds = (LAS unsigned char*)lds; F.MISC = (volatile LAS unsigned*)(F.lds + MISC_OFF);
        F.G = gridDim.x; { const int bx = blockIdx.x; F.vcu = (F.G % 8 == 0) ? (bx % 8) * (F.G / 8) + bx / 8 : bx; }
    F.ws = args.ws; F.ctl = (gu32*)(args.ws + WS_CTL);
    unsigned char* ws = args.ws;
    if (F_TID < 128) F.MISC[F_TID] = 0u;
    __syncthreads();
    const bool single = (args.ph_hi - args.ph_lo) > 1;
    XcdBarrier bar; bar.bar = (unsigned*)(F.ctl + CW_BAR); bar.x = 0; bar.st = nullptr;
    if (single) bar = xcd_barrier_post((unsigned*)(F.ctl + CW_BAR), F.MISC + 8);
    const int lo = args.ph_lo, hi = args.ph_hi;
#ifdef ONLY
#define IN(k) ((k) == ONLY && lo <= (k) && (k) < hi)
#else
#define IN(k) (lo <= (k) && (k) < hi)
#endif
#ifdef TS_A
#define STAMP(k) do { if (blockIdx.x == 0 && threadIdx.x == 0) ((unsigned long long*)(ws + WS_CTL + 8192))[(k) + 1] = __builtin_amdgcn_s_memrealtime(); } while (0)
#else
#define STAMP(k) do { } while (0)
#endif
#define SEAM(k) do { if (IN((k) + 1)) xcd_barrier(bar); STAMP(k); } while (0)
    const f32x2* rope = (const f32x2*)(ws + WS_ROPE);
    bf16* GA = (bf16*)args.out; bf16* GB = (bf16*)args.out + (size_t)T * 1024;

    STAMP(-1);
    if (IN(0)) { p0_prologue(F, args);
#ifdef REP_P0
        p0_prologue(F, args);
#endif
        SEAM(0); }
    if (IN(1)) {
        pg8::Gemm g{(const bf16*)(ws + WS_H), (const bf16*)(ws + WS_WIN), T, NIN, D, 0}; pg8::StaticOrder S; S.init(T, NIN, F.G, (int)blockIdx.x);
        pg8::EpiIn E{(bf16*)(ws + WS_CQ), (bf16*)(ws + WS_CKV), (bf16*)(ws + WS_QB), (bf16*)(ws + WS_KB), (bf16*)(ws + WS_VB), (bf16*)(ws + WS_QI), (bf16*)(ws + WS_KI), (bf16*)(ws + WS_KR), GA, GB, (float*)(ws + WS_WI), rope};
        pg8::gemm_phase<pg8::EpiIn, pg8::StaticOrder, true, true>(F.lds, g, S, E);
#ifdef REP_P1
        pg8::gemm_phase<pg8::EpiIn, pg8::StaticOrder, true, true>(F.lds, g, S, E);
#endif
        SEAM(1);
    }
    if (IN(2)) { p2a_norms(F, args); SEAM(2); }
    if (IN(3)) {
#ifdef REP_P3
      for (int rep = 0; rep < 2; ++rep) {
#else
      {
#endif
#ifndef NO3A
        { pg8::Gemm g{(const bf16*)(ws + WS_CQ), (const bf16*)(ws + WS_WUQ), T, 768, 384, 0}; pg8::StaticOrder S; S.init(T, 768, F.G, (int)blockIdx.x);
          pg8::EpiQA E{(bf16*)(ws + WS_QA), rope}; pg8::gemm_phase<pg8::EpiQA, pg8::StaticOrder, true, true>(F.lds, g, S, E); }
#endif
#ifndef NO3B
        { pg8::Gemm g{(const bf16*)(ws + WS_CKV), (const bf16*)(ws + WS_WUKV), T, 1024, 256, 0}; pg8::StaticOrder S; S.init(T, 1024, F.G, (int)blockIdx.x);
          pg8::EpiKV E{(bf16*)(ws + WS_KN), (bf16*)(ws + WS_VA)}; pg8::gemm_phase<pg8::EpiKV, pg8::StaticOrder, true, true>(F.lds, g, S, E); }
#endif
      }
        SEAM(3);
    }
    if (IN(4)) {
        unsigned* rdy = (unsigned*)(F.ctl + CW_RDY);
        for (;;) { const int k = wq_next(F, CW_Q1); if (k >= 1536) break;
            int ltid = threadIdx.x; asm volatile("" : "+v"(ltid));
            const int lw = __builtin_amdgcn_readfirstlane(ltid >> 6);
            if (k < 512) { const int ib = k & 1, ij = 255 - (k >> 1);
                const IdxP IP{(const bf16*)(ws + WS_QI), (const bf16*)(ws + WS_KI), (const float*)(ws + WS_WI), (unsigned*)(ws + WS_BM)};
                idx_item(F.lds, ib, ij, IP, ltid, ltid & 63, lw);
                VM_WAIT(); __syncthreads();
                if (ltid == 0) { __builtin_amdgcn_fence(__ATOMIC_RELEASE, "agent"); VM_WAIT(); __hip_atomic_fetch_add(rdy + 64 * (ib * 32 + (ij >> 3)), 1u, RLX_AGENT); }
            } else { const int u = (k - 512) >> 1, ub = (u & 15) >> 3, uh = u & 7, uq = 31 - (u >> 4);
                if (k & 1) { const AttnP APA{(const bf16*)(ws + WS_QA), (const bf16*)(ws + WS_KN), (const bf16*)(ws + WS_KR), (const bf16*)(ws + WS_VA), (bf16*)(ws + WS_OA), nullptr};
                    attn_unit<true>(F.lds, ub, uh, uq, APA, ltid, ltid & 63, lw); }
                else { const AttnP APB{(const bf16*)(ws + WS_QB), (const bf16*)(ws + WS_KB), nullptr, (const bf16*)(ws + WS_VB), (bf16*)(ws + WS_OB), (const unsigned*)(ws + WS_BM)};
                    if (ltid == 0) { unsigned sp = 0u; while (__hip_atomic_load(rdy + 64 * (ub * 32 + uq), RLX_AGENT) < 8u) { __builtin_amdgcn_s_sleep(8); if (++sp > (1u << 22)) break; }
                        __builtin_amdgcn_fence(__ATOMIC_ACQUIRE, "agent"); VM_WAIT(); }
                    __syncthreads();
                    attn_unit<false>(F.lds, ub, uh, uq, APB, ltid, ltid & 63, lw); } }
        }
    }
    if (IN(5)) { SEAM(5); }
    if (IN(6)) {
#ifdef REP_P6
      for (int rep = 0; rep < 2; ++rep) {
#else
      {
#endif
        { pg8::Gemm g{(const bf16*)(ws + WS_OA), (const bf16*)(ws + WS_WOA), T, 1024, 512, 0}; pg8::StaticOrder S; S.init(T, 1024, F.G, (int)blockIdx.x);
          pg8::EpiY<0> E{(bf16*)(ws + WS_Y), GA}; pg8::gemm_phase<pg8::EpiY<0>, pg8::StaticOrder, true, true>(F.lds, g, S, E); }
        { pg8::Gemm g{(const bf16*)(ws + WS_OB), (const bf16*)(ws + WS_WOB), T, 1024, 512, 0}; pg8::StaticOrder S; S.init(T, 1024, F.G, (int)blockIdx.x);
          pg8::EpiY<1> E{(bf16*)(ws + WS_Y), GB}; pg8::gemm_phase<pg8::EpiY<1>, pg8::StaticOrder, true, true>(F.lds, g, S, E); }
      }
        SEAM(6);
    }
    if (IN(7)) {
        pg8::Gemm g{(const bf16*)(ws + WS_Y), (const bf16*)(ws + WS_WOUT), T, 1024, 1024, 0}; pg8::StaticOrder S; S.init(T, 1024, F.G, (int)blockIdx.x);
        pg8::EpiX1 E{args.in[0], args.out}; pg8::gemm_phase<pg8::EpiX1, pg8::StaticOrder, true, true>(F.lds, g, S, E);
#ifdef REP_P7
        pg8::gemm_phase<pg8::EpiX1, pg8::StaticOrder, true, true>(F.lds, g, S, E);
#endif
        SEAM(7);
    }
    if (IN(8)) { p5a_route(F, args); SEAM(8); }
    if (IN(9)) { p5a2_scatter(F, args); SEAM(9); }
    if (IN(10)) {
        const int* t2e = (const int*)(ws + WS_T2E); const int ntl = t2e[255];
        pg8::Gemm g{(const bf16*)(ws + WS_ASORT), (const bf16*)(ws + WS_WGU), SORT_ROWS, 512, 1024, (size_t)512 * 1024 * 2}; pg8::GroupOrder S; S.init(ntl, 2, F.G, (int)blockIdx.x, t2e);
        pg8::EpiHid E{(bf16*)(ws + WS_HID)}; pg8::gemm_phase<pg8::EpiHid, pg8::GroupOrder, true, true>(F.lds, g, S, E);
#ifdef REP_P10
        pg8::gemm_phase<pg8::EpiHid, pg8::GroupOrder, true, true>(F.lds, g, S, E);
#endif
        SEAM(10);
    }
    if (IN(11)) {
        const int* t2e = (const int*)(ws + WS_T2E); const int ntl = t2e[255];
        pg8::Gemm g{(const bf16*)(ws + WS_HID), (const bf16*)(ws + WS_WD), SORT_ROWS, 1024, 256, (size_t)1024 * 256 * 2}; pg8::GroupOrder S; S.init(ntl, 4, F.G, (int)blockIdx.x, t2e);
        pg8::EpiDown E{(bf16*)(ws + WS_SLOTS), (const int*)(ws + WS_SSLOT), (const float*)(ws + WS_SW)}; pg8::gemm_phase<pg8::EpiDown, pg8::GroupOrder, true, true>(F.lds, g, S, E);
#ifdef REP_P11
        pg8::gemm_phase<pg8::EpiDown, pg8::GroupOrder, true, true>(F.lds, g, S, E);
#endif
        SEAM(11);
    }
    if (IN(12)) { p6_final(F, args); }
#ifdef TS_A
    if (blockIdx.x == 0 && threadIdx.x == 0) { STAMP(12); __builtin_amdgcn_s_waitcnt(0);
        const unsigned long long* tsp = (const unsigned long long*)(ws + WS_CTL + 8192);
        const unsigned long long ta = __hip_atomic_load(tsp + (TS_A) + 1, RLX_AGENT), tb = __hip_atomic_load(tsp + (TS_B) + 1, RLX_AGENT);
        const unsigned long long t0 = __builtin_amdgcn_s_memrealtime(), wait = 4ull * (tb - ta);
        while (__builtin_amdgcn_s_memrealtime() - t0 < wait) __builtin_amdgcn_s_sleep(16); }
#endif
#undef IN
#undef SEAM
}

#ifndef MK_MULTI
#define MK_MULTI 0
#endif
extern "C" void kernel_launch(void* const* d_in, const int* in_sizes, int n_in, void* d_out, int out_size, void* d_ws, size_t ws_size, hipStream_t stream) {
    static int grid = 0;
    if (grid == 0) {
        if (n_in != 20 || in_sizes[0] != T * D || out_size != T * D || ws_size < WS_END) { fprintf(stderr, "kernel_launch: unexpected shapes n_in %d in0 %d out %d ws %zu\n", n_in, n_in > 0 ? in_sizes[0] : -1, out_size, ws_size); grid = -1; return; }
        int dev = 0, cus = 0;
        if (hipGetDevice(&dev) != hipSuccess || hipDeviceGetAttribute(&cus, hipDeviceAttributeMultiprocessorCount, dev) != hipSuccess) { grid = -1; return; }
        if (hipFuncSetAttribute((const void*)mk_fwd, hipFuncAttributeMaxDynamicSharedMemorySize, LDS_BYTES) != hipSuccess) { fprintf(stderr, "kernel_launch: hipFuncSetAttribute failed\n"); grid = -1; return; }
        (void)hipGetLastError();
        grid = cus;
    }
    if (grid < 0) return;
    if (hipMemsetAsync((char*)d_ws + WS_CTL, 0, CTL_ZERO_BYTES, stream) != hipSuccess) return;
    Args a{};
    for (int i = 0; i < 20; ++i) a.in[i] = (const float*)d_in[i];
    a.out = (float*)d_out; a.ws = (unsigned char*)d_ws;
#if MK_MULTI
    for (int p = 0; p < NPHASE; ++p) { a.ph_lo = p; a.ph_hi = p + 1; hipLaunchKernelGGL(mk_fwd, dim3(grid), dim3(NTHR), LDS_BYTES, stream, a); }
#else
    a.ph_lo = 0; a.ph_hi = NPHASE;
    hipLaunchKernelGGL(mk_fwd, dim3(grid), dim3(NTHR), LDS_BYTES, stream, a);
#endif
}
```

```cpp
#include <hip/hip_runtime.h>
#include <cstdio>
#include <cstdint>

#define GAS __attribute__((address_space(1)))
#define LAS __attribute__((address_space(3)))
typedef unsigned short bf16;
typedef unsigned v4u __attribute__((ext_vector_type(4)));
typedef unsigned v2u __attribute__((ext_vector_type(2)));
typedef float f32x4 __attribute__((ext_vector_type(4)));
typedef float f32x2 __attribute__((ext_vector_type(2)));
typedef float f32x16 __attribute__((ext_vector_type(16)));
typedef short bf16x8 __attribute__((ext_vector_type(8)));
typedef short s16x4 __attribute__((ext_vector_type(4)));
typedef __bf16 bf16x2_t __attribute__((ext_vector_type(2)));
typedef GAS unsigned gu32;
#define RLX_AGENT __ATOMIC_RELAXED, __HIP_MEMORY_SCOPE_AGENT
#define LDS_WAIT() asm volatile("s_waitcnt lgkmcnt(0)" ::: "memory")
#define VM_WAIT() asm volatile("s_waitcnt vmcnt(0)" ::: "memory")

constexpr int NWAVES = 8, NTHR = NWAVES * 64;
constexpr int BATCH = 2, SEQ = 8192, D = 1024, T = BATCH * SEQ;
constexpr float EPS = 1e-6f;
constexpr int NIN = 4864, NIN_SRC = 4840;
constexpr int C_CQ = 0, C_CKV = 384, C_QB = 640, C_KB = 1152, C_VB = 1664, C_QI = 2176, C_KR = 2688, C_KI = 2720, C_WI = 2784, C_GA = 2816, C_GB = 3840;
constexpr int NEXP = 32, FF = 256;
constexpr int SORT_ROWS = 2 * T + NEXP * 256;
constexpr float LOG2E = 1.4426950408889634f;
constexpr float C2A = 0.10206207261596575f * LOG2E;
constexpr float C2B = 0.125f * LOG2E;
constexpr float WI_SCALE = 0.35355339059327373f * 0.125f;

constexpr size_t MiB = 1u << 20, KiB = 1u << 10;
constexpr size_t WS_CTL = 0, CTL_ZERO_BYTES = 1 * MiB;
constexpr size_t WS_ROPE = 1 * MiB;
constexpr size_t WS_WI = 2 * MiB;
constexpr size_t WS_TOKE = 2 * MiB + 512 * KiB;
constexpr size_t WS_TOKW = WS_TOKE + 128 * KiB;
constexpr size_t WS_RSTD2 = WS_TOKW + 128 * KiB;
constexpr size_t WS_SSLOT = 3 * MiB + 512 * KiB;
constexpr size_t WS_SW = WS_SSLOT + 192 * KiB;
constexpr size_t WS_T2E = WS_SW + 192 * KiB;
constexpr size_t WS_WIN = 4 * MiB, WS_WUQ = 14 * MiB, WS_WUKV = 15 * MiB, WS_WOA = 16 * MiB, WS_WOB = 17 * MiB, WS_WOUT = 18 * MiB, WS_WGU = 20 * MiB, WS_WD = 52 * MiB;
constexpr size_t WS_H = 68 * MiB, WS_OA = 68 * MiB, WS_OB = 84 * MiB;
constexpr size_t WS_QA = 100 * MiB, WS_KN = 124 * MiB, WS_VA = 140 * MiB, WS_Y = 100 * MiB;
constexpr size_t WS_QB = 156 * MiB, WS_KB = 172 * MiB, WS_VB = 188 * MiB;
constexpr size_t WS_CQ = 204 * MiB, WS_CKV = 216 * MiB, WS_BM = 204 * MiB;
constexpr size_t WS_QI = 224 * MiB, WS_KI = 240 * MiB, WS_KR = 242 * MiB;
constexpr size_t WS_ASORT = 68 * MiB, WS_SLOTS = 156 * MiB, WS_HID = 220 * MiB;
constexpr size_t WS_END = 256 * MiB;
constexpr int CW_BAR = 4096;
constexpr int CW_Q1 = 64, CW_Q2 = 128;
constexpr int CW_CNT = 256, CW_FILL = 320;
constexpr int CW_RDY = 8192;

constexpr int LDS_BYTES = 147456;
constexpr int MISC_OFF = 147456 - 512;

__device__ __forceinline__ unsigned f2bf(float f) { unsigned u = __builtin_bit_cast(unsigned, f); return (u + 0x7fffu + ((u >> 16) & 1u)) >> 16; }
__device__ __forceinline__ unsigned pk2(float lo, float hi) { f32x2 v = {lo, hi}; bf16x2_t b = __builtin_convertvector(v, bf16x2_t); return __builtin_bit_cast(unsigned, b); }
__device__ __forceinline__ float bflo(unsigned w) { return __builtin_bit_cast(float, w << 16); }
__device__ __forceinline__ float bfhi(unsigned w) { return __builtin_bit_cast(float, w & 0xffff0000u); }

#define XB_TMO      128
#define XB_XCNT(j)  (256  + 64 * (j))
#define XB_XSUB(j)  (1280 + 64 * (j))
#define XB_XGEN(j)  (2304 + 64 * (j))
#define XB_TOP      3328
#define XB_TOPGEN   3392
#define XCD_BAR_WORDS 3456
#define XB_SPIN_CAP (1u << 22)
__device__ __forceinline__ unsigned xb_ld(unsigned* p)              { return __hip_atomic_load(p, __ATOMIC_RELAXED, __HIP_MEMORY_SCOPE_AGENT); }
__device__ __forceinline__ unsigned xb_add(unsigned* p, unsigned v) { return __hip_atomic_fetch_add(p, v, __ATOMIC_RELAXED, __HIP_MEMORY_SCOPE_AGENT); }
__device__ __forceinline__ unsigned xb_xcc_id() { return (unsigned)__builtin_amdgcn_s_getreg((3 << 11) | 20) & 0xFu; }
#define XB_SPIN(cond, bar) do { unsigned _sp = 0; while (cond) { __builtin_amdgcn_s_sleep(1); \
    if ((++_sp & 255u) == 0u) { if (xb_ld(&(bar)[XB_TMO])) break; if (_sp > XB_SPIN_CAP) { atomicAdd(&(bar)[XB_TMO], 1u); break; } } } } while (0)
struct XcdBarrier { unsigned* bar; unsigned x; volatile LAS unsigned* st; };
__device__ __forceinline__ XcdBarrier xcd_barrier_post(unsigned* bar, volatile LAS unsigned* st) {
    XcdBarrier b; b.bar = bar; b.x = xb_xcc_id(); b.st = st;
    if (threadIdx.x == 0) (void)xb_add(&bar[XB_XCNT(b.x)], 1u);
    return b;
}
__device__ __forceinline__ void xcd_barrier_complete(unsigned* bar, unsigned x, unsigned& nloc, unsigned& nx) {
    const unsigned G = gridDim.x * gridDim.y * gridDim.z;
    unsigned sum, cnt, mine, sp = 0u;
    for (;;) {
        sum = 0u; cnt = 0u; mine = 0u;
#pragma unroll
        for (unsigned j = 0; j < 16; ++j) { const unsigned c = xb_ld(&bar[XB_XCNT(j)]); sum += c; cnt += (c > 0u) ? 1u : 0u; mine = (j == x) ? c : mine; }
        if (sum == G) break;
        __builtin_amdgcn_s_sleep(1);
        if ((++sp & 255u) == 0u) { if (xb_ld(&bar[XB_TMO])) break; if (sp > XB_SPIN_CAP) { atomicAdd(&bar[XB_TMO], 1u); break; } }
    }
    nloc = mine > 0u ? mine : 1u; nx = cnt > 0u ? cnt : 1u;
}
__device__ __forceinline__ void xcd_barrier(const XcdBarrier& b) {
    asm volatile("s_waitcnt vmcnt(0)" ::: "memory");
    __syncthreads();
    if (threadIdx.x == 0) {
        unsigned* bar = b.bar;
        __builtin_amdgcn_s_waitcnt(0);
        unsigned nloc = b.st[0], nx = b.st[1];
        if (nloc == 0u) { xcd_barrier_complete(bar, b.x, nloc, nx); b.st[0] = nloc; b.st[1] = nx; }
        const unsigned old = xb_add(&bar[XB_XSUB(b.x)], 1u);
        const unsigned gen = old / nloc;
        if (old + 1u == (gen + 1u) * nloc) {
            __builtin_amdgcn_fence(__ATOMIC_RELEASE, "agent");
            asm volatile("s_waitcnt vmcnt(0)" ::: "memory");
            const unsigned og = xb_add(&bar[XB_TOP], 1u);
            const unsigned tg = og / nx;
            if (og + 1u == (tg + 1u) * nx) xb_add(&bar[XB_TOPGEN], 1u);
            else XB_SPIN(xb_ld(&bar[XB_TOPGEN]) == tg, bar);
            __builtin_amdgcn_fence(__ATOMIC_ACQUIRE, "agent");
            xb_add(&bar[XB_XGEN(b.x)], 1u);
            asm volatile("s_waitcnt vmcnt(0)" ::: "memory");
        } else {
            XB_SPIN(xb_ld(&bar[XB_XGEN(b.x)]) == gen, bar);
            __builtin_amdgcn_fence(__ATOMIC_ACQUIRE, "agent");
            asm volatile("s_waitcnt vmcnt(0)" ::: "memory");
        }
    }
    __syncthreads();
}

__device__ __forceinline__ float wave_sum(float v) {
#pragma unroll
    for (int o = 1; o < 64; o <<= 1) v += __shfl_xor(v, o);
    return v;
}

namespace pg8 {
#define PG8_LAS __attribute__((address_space(3)))
typedef unsigned short bf16_t;
typedef unsigned u32x4 __attribute__((ext_vector_type(4)));
constexpr int BM = 256, BK = 64, HALF = 128, HTB = HALF * BK * 2, STAGE_BYTES = 8 * HTB, NXCD = 8, WGM = 8;
__host__ __device__ __forceinline__ int lds_byte(int r, int c) { const int st = (r >> 4) * 2 + (c >> 5), rr = r & 15, cc = c & 31, ob = rr * 64 + cc * 2; return st * 1024 + (ob ^ (((ob >> 9) & 1) << 5)); }
__host__ __device__ __forceinline__ void stage_rc(int b, int& R, int& C) { const int st = b / 1024, sb = b % 1024, swz = sb ^ (((sb >> 9) & 1) << 5); R = (st >> 1) * 16 + swz / 64; C = (st & 1) * 32 + (swz % 64) / 2; }
__host__ __device__ __forceinline__ int perm32(int rho) { const int n = rho >> 4, i = rho & 15; return 8 * (i >> 2) + 4 * n + (i & 3); }

struct Unit { int pm, pn, e; };
struct Gemm { const bf16_t* A; const bf16_t* Bt; int M, N, K; size_t estride; };

struct StaticOrder {
    int nM, nN, nwg, G, c;
    __host__ __device__ void init(int M, int N, int G_, int c_) { nM = M / BM; nN = N / BM; nwg = nM * nN; G = G_; c = c_; }
    __host__ __device__ bool next(int i, Unit& u) const {
        const long L = (long)i * G + c; if (L >= nwg) return false;
        int wgid = (int)L; { const int q = nwg / NXCD, r = nwg % NXCD, xcd = wgid % NXCD, off = wgid / NXCD; wgid = (xcd < r ? xcd * (q + 1) : r * (q + 1) + (xcd - r) * q) + off; }
        const int nig = WGM * nN, gid = wgid / nig, fm = gid * WGM, gsz = (nM - fm) < WGM ? (nM - fm) : WGM;
        u.pm = fm + ((wgid % nig) % gsz); u.pn = (wgid % nig) / gsz; u.e = 0; return true;
    }
    __device__ __forceinline__ void a_ready(const Unit&) const {}
    __device__ __forceinline__ void done(const Unit&) const {}
};
struct GroupOrder {
    int nN, total, G, c; const int* t2e;
    __device__ void init(int nTiles, int nN_, int G_, int c_, const int* t2e_) { nN = nN_; total = nTiles * nN_; G = G_; c = c_; t2e = t2e_; }
    __device__ bool next(int i, Unit& u) const {
        const long L = (long)i * G + c; if (L >= total) return false;
        u.pm = (int)(L / nN); u.pn = (int)(L % nN); u.e = __builtin_amdgcn_readfirstlane(t2e[u.pm]); return true;
    }
    __device__ __forceinline__ void a_ready(const Unit&) const {}
    __device__ __forceinline__ void done(const Unit&) const {}
};

__device__ __forceinline__ void st8(bf16_t* p, f32x4 v0, f32x4 v1) { u32x4 w; w.x = pk2(v0[0], v0[1]); w.y = pk2(v0[2], v0[3]); w.z = pk2(v1[0], v1[1]); w.w = pk2(v1[2], v1[3]); *(u32x4*)p = w; }
__device__ __forceinline__ void ld8(const bf16_t* p, f32x4& v0, f32x4& v1) { const u32x4 w = *(const u32x4*)p; v0 = (f32x4){bflo(w.x), bfhi(w.x), bflo(w.y), bfhi(w.y)}; v1 = (f32x4){bflo(w.z), bfhi(w.z), bflo(w.w), bfhi(w.w)}; }

__device__ __forceinline__ void rope16(f32x4& v0, f32x4& v1, int row, int fq, const f32x2* rope) {
    const f32x2* rp = rope + (size_t)(row & (SEQ - 1)) * 16;
    f32x4 p0, p1;
#pragma unroll
    for (int e = 0; e < 4; ++e) { p0[e] = __shfl_xor(v0[e], 16); p1[e] = __shfl_xor(v1[e], 16); }
    if (fq < 2) {
        const float sg = fq == 0 ? -1.f : 1.f;
#pragma unroll
        for (int e = 0; e < 4; ++e) { const f32x2 a = rp[2 * e], b = rp[2 * (4 + e)];
            v0[e] = v0[e] * a.x + sg * p0[e] * a.y; v1[e] = v1[e] * b.x + sg * p1[e] * b.y; }
    }
}
__device__ __forceinline__ void rope32(f32x4& v0, f32x4& v1, int row, int fq, const f32x2* rope) {
    const f32x2* rp = rope + (size_t)(row & (SEQ - 1)) * 16 + 8 * (fq & 1);
    const float sg = fq < 2 ? -1.f : 1.f;
#pragma unroll
    for (int e = 0; e < 4; ++e) { const float p0 = __shfl_xor(v0[e], 32), p1 = __shfl_xor(v1[e], 32); const f32x2 a = rp[e], b = rp[4 + e];
        v0[e] = v0[e] * a.x + sg * p0 * a.y; v1[e] = v1[e] * b.x + sg * p1 * b.y; }
}
__device__ __forceinline__ float sigmoidf_(float x) { return __builtin_amdgcn_rcpf(1.f + __builtin_amdgcn_exp2f(-1.4426950408889634f * x)); }

struct EpiIn {
    static constexpr bool PERM = true, AFTER_DRAIN = false;
    bf16_t *CQ, *CKV, *QB, *KB, *VB, *QI, *KI, *KR, *GA, *GB; float* WI; const f32x2* rope;
    __device__ __forceinline__ void operator()(const f32x4 (&acc)[2][2][4][2], const Unit& u, int wr, int wc, int fr, int fq) const {
        const int row0 = u.pm * BM + wr * 64 + fr;
#pragma unroll
        for (int bj = 0; bj < 2; ++bj) {
            const int cg = u.pn * BM + bj * HALF + wc * 32;
            bf16_t* base = nullptr; int pitch = 0, cc = 0, mode = 0; float sc = 1.f;
            if (cg < C_CKV) { base = CQ; pitch = 384; cc = cg; }
            else if (cg < C_QB) { base = CKV; pitch = 256; cc = cg - C_CKV; }
            else if (cg < C_KB) { base = QB; pitch = 512; cc = cg - C_QB; mode = ((cc >> 5) & 1) == 0 ? 1 : 0; sc = C2B; }
            else if (cg < C_VB) { base = KB; pitch = 512; cc = cg - C_KB; mode = ((cc >> 5) & 1) == 0 ? 1 : 0; }
            else if (cg < C_QI) { base = VB; pitch = 512; cc = cg - C_VB; }
            else if (cg < C_KR) { base = QI; pitch = 512; cc = cg - C_QI; mode = ((cc >> 5) & 1) == 0 ? 1 : 0; }
            else if (cg < C_KI) { base = KR; pitch = 32; cc = 0; mode = 2; }
            else if (cg < C_WI) { base = KI; pitch = 64; cc = cg - C_KI; mode = (cc == 0) ? 1 : 0; }
            else if (cg < C_GA) { mode = 4; }
            else if (cg < C_GB) { base = GA; pitch = 1024; cc = cg - C_GA; mode = 3; }
            else { base = GB; pitch = 1024; cc = cg - C_GB; mode = 3; }
#pragma unroll
            for (int ai = 0; ai < 2; ++ai)
#pragma unroll
                for (int m = 0; m < 4; ++m) {
                    const int row = row0 + ai * HALF + m * 16;
                    f32x4 v0 = acc[ai][bj][m][0], v1 = acc[ai][bj][m][1];
                    if (mode == 1) rope16(v0, v1, row, fq, rope);
                    else if (mode == 2) rope32(v0, v1, row, fq, rope);
                    else if (mode == 3) {
#pragma unroll
                        for (int e = 0; e < 4; ++e) { v0[e] = sigmoidf_(v0[e]); v1[e] = sigmoidf_(v1[e]); } }
                    if (mode == 4) { if (fq == 0) { *(f32x4*)(WI + (size_t)row * 8) = v0 * WI_SCALE; *(f32x4*)(WI + (size_t)row * 8 + 4) = v1 * WI_SCALE; } }
                    else { v0 = v0 * sc; v1 = v1 * sc; st8(base + (size_t)row * pitch + cc + 8 * fq, v0, v1); }
                }
        }
    }
};
struct EpiQA {
    static constexpr bool PERM = true, AFTER_DRAIN = false;
    bf16_t* QA; const f32x2* rope;
    __device__ __forceinline__ void operator()(const f32x4 (&acc)[2][2][4][2], const Unit& u, int wr, int wc, int fr, int fq) const {
        const int row0 = u.pm * BM + wr * 64 + fr;
#pragma unroll
        for (int bj = 0; bj < 2; ++bj) {
            const int cg = u.pn * BM + bj * HALF + wc * 32; const bool rot = ((cg >> 5) % 3) == 2;
#pragma unroll
            for (int ai = 0; ai < 2; ++ai)
#pragma unroll
                for (int m = 0; m < 4; ++m) {
                    const int row = row0 + ai * HALF + m * 16;
                    f32x4 v0 = acc[ai][bj][m][0], v1 = acc[ai][bj][m][1];
                    if (rot) rope32(v0, v1, row, fq, rope);
                    v0 = v0 * C2A; v1 = v1 * C2A; st8(QA + (size_t)row * 768 + cg + 8 * fq, v0, v1);
                }
        }
    }
};
struct EpiKV {
    static constexpr bool PERM = true, AFTER_DRAIN = false;
    bf16_t *KN, *VA;
    __device__ __forceinline__ void operator()(const f32x4 (&acc)[2][2][4][2], const Unit& u, int wr, int wc, int fr, int fq) const {
        const int row0 = u.pm * BM + wr * 64 + fr;
#pragma unroll
        for (int bj = 0; bj < 2; ++bj) {
            const int cg = u.pn * BM + bj * HALF + wc * 32; bf16_t* base = cg < 512 ? KN : VA; const int cc = (cg & 511) + 8 * fq;
#pragma unroll
            for (int ai = 0; ai < 2; ++ai)
#pragma unroll
                for (int m = 0; m < 4; ++m) { const int row = row0 + ai * HALF + m * 16; st8(base + (size_t)row * 512 + cc, acc[ai][bj][m][0], acc[ai][bj][m][1]); }
        }
    }
};
template <int ADD> struct EpiY {
    static constexpr bool PERM = true, AFTER_DRAIN = false;
    bf16_t* Y; const bf16_t* Gt;
    __device__ __forceinline__ void operator()(const f32x4 (&acc)[2][2][4][2], const Unit& u, int wr, int wc, int fr, int fq) const {
        const int row0 = u.pm * BM + wr * 64 + fr;
#pragma unroll
        for (int bj = 0; bj < 2; ++bj) {
            const int c0 = u.pn * BM + bj * HALF + wc * 32 + 8 * fq;
#pragma unroll
            for (int ai = 0; ai < 2; ++ai)
#pragma unroll
                for (int m = 0; m < 4; ++m) { const size_t off = (size_t)(row0 + ai * HALF + m * 16) * 1024 + c0;
                    f32x4 g0, g1; ld8(Gt + off, g0, g1);
                    f32x4 v0 = acc[ai][bj][m][0] * g0, v1 = acc[ai][bj][m][1] * g1;
                    if (ADD) { f32x4 o0, o1; ld8(Y + off, o0, o1); v0 = v0 + o0; v1 = v1 + o1; }
                    st8(Y + off, v0, v1); }
        }
    }
};
struct EpiX1 {
    static constexpr bool PERM = false, AFTER_DRAIN = false;
    const float* X; float* O;
    __device__ __forceinline__ void operator()(const f32x4 (&acc)[2][2][4][2], const Unit& u, int wr, int wc, int fr, int fq) const {
        const int row0 = u.pm * BM + wr * 64 + fr, col0 = u.pn * BM + wc * 32 + 4 * fq;
#pragma unroll
        for (int ai = 0; ai < 2; ++ai)
#pragma unroll
            for (int m = 0; m < 4; ++m) { const size_t off = (size_t)(row0 + ai * HALF + m * 16) * 1024 + col0;
#pragma unroll
                for (int bj = 0; bj < 2; ++bj)
#pragma unroll
                    for (int n = 0; n < 2; ++n) { const f32x4 xv = *(const f32x4*)(X + off + bj * HALF + n * 16); *(f32x4*)(O + off + bj * HALF + n * 16) = xv + acc[ai][bj][m][n]; } }
    }
};
struct EpiHid {
    static constexpr bool PERM = true, AFTER_DRAIN = false;
    bf16_t* HID;
    __device__ __forceinline__ void operator()(const f32x4 (&acc)[2][2][4][2], const Unit& u, int wr, int wc, int fr, int fq) const {
        const int row0 = u.pm * BM + wr * 64 + fr, c0 = u.pn * 128 + wc * 32 + 8 * fq;
#pragma unroll
        for (int ai = 0; ai < 2; ++ai)
#pragma unroll
            for (int m = 0; m < 4; ++m) { f32x4 h0, h1;
#pragma unroll
                for (int e = 0; e < 4; ++e) { const float g0 = acc[ai][0][m][0][e], g1 = acc[ai][0][m][1][e];
                    h0[e] = g0 * sigmoidf_(g0) * acc[ai][1][m][0][e]; h1[e] = g1 * sigmoidf_(g1) * acc[ai][1][m][1][e]; }
                st8(HID + (size_t)(row0 + ai * HALF + m * 16) * 256 + c0, h0, h1); }
    }
};
struct EpiDown {
    static constexpr bool PERM = true, AFTER_DRAIN = false;
    bf16_t* SL; const int* sslot; const float* sw;
    __device__ __forceinline__ void operator()(const f32x4 (&acc)[2][2][4][2], const Unit& u, int wr, int wc, int fr, int fq) const {
        const int row0 = u.pm * BM + wr * 64 + fr;
#pragma unroll
        for (int ai = 0; ai < 2; ++ai)
#pragma unroll
            for (int m = 0; m < 4; ++m) { const int r = row0 + ai * HALF + m * 16; const int slot = sslot[r]; const float w = sw[r];
                if (slot >= 0) {
#pragma unroll
                    for (int bj = 0; bj < 2; ++bj) st8(SL + (size_t)slot * 1024 + u.pn * BM + bj * HALF + wc * 32 + 8 * fq, acc[ai][bj][m][0] * w, acc[ai][bj][m][1] * w); } }
    }
};
template <class Epi, class Sched, bool ALIGN_EPI = false, bool SP2 = false>
__device__ __forceinline__ void gemm_phase(PG8_LAS unsigned char* lds, const Gemm g, const Sched& S, const Epi& E) {
    const int tid = threadIdx.x, wid = __builtin_amdgcn_readfirstlane(tid >> 6), lane = tid & 63, wr = wid >> 2, wc = wid & 3, fr = lane & 15, fq = lane >> 4;
    const int K = g.K, nt = K / BK;
    unsigned voffA[2], voffB[2];
#pragma unroll
    for (int i = 0; i < 2; ++i) { int R, C; stage_rc(tid * 16 + i * 8192, R, C); const int Rb = Epi::PERM ? ((R & ~31) + perm32(R & 31)) : R;
        voffA[i] = (unsigned)(R * K + C) * 2u; voffB[i] = (unsigned)(Rb * K + C) * 2u; }
    const size_t kstep = (size_t)(BK * 2);
    const size_t hstep = (size_t)HALF * K * 2;
    const size_t tstep = 2 * hstep;
    const unsigned ldsw = (unsigned)wid * 1024u;
    const int aoff = lds_byte(wr * 64 + fr, fq * 8), boff = lds_byte(wc * 32 + fr, fq * 8);
#define PG8_SA(b, h) (((b) * 2 + (h)) * HTB)
#define PG8_SB(b, h) ((4 + (b) * 2 + (h)) * HTB)
#define PG8_STAGE(bufoff, gbase, voff) do { _Pragma("unroll") for (int _i = 0; _i < 2; ++_i) \
        __builtin_amdgcn_global_load_lds((const unsigned*)((const char*)(gbase) + (voff)[_i]), (PG8_LAS unsigned*)(lds + (bufoff) + ldsw + _i * 8192), 16, 0, 0); } while (0)
#define PG8_LDA(dst, b, h) do { _Pragma("unroll") for (int m = 0; m < 4; ++m) _Pragma("unroll") for (int k = 0; k < 2; ++k) dst[m][k] = *(const PG8_LAS bf16x8*)(lds + PG8_SA(b, h) + aoff + m * 2048 + k * 1024); } while (0)
#define PG8_LDB(dst, b, h) do { _Pragma("unroll") for (int n = 0; n < 2; ++n) _Pragma("unroll") for (int k = 0; k < 2; ++k) dst[n][k] = *(const PG8_LAS bf16x8*)(lds + PG8_SB(b, h) + boff + n * 2048 + k * 1024); } while (0)
#define PG8_MMA(ai, bj, At, Bt) do { __builtin_amdgcn_s_setprio(1); _Pragma("unroll") for (int m = 0; m < 4; ++m) _Pragma("unroll") for (int n = 0; n < 2; ++n) _Pragma("unroll") for (int k = 0; k < 2; ++k) \
        acc[ai][bj][m][n] = __builtin_amdgcn_mfma_f32_16x16x32_bf16(Bt[n][k], At[m][k], acc[ai][bj][m][n], 0, 0, 0); __builtin_amdgcn_s_setprio(0); } while (0)
#define PG8_WAIT_V(n) asm volatile("s_waitcnt vmcnt(" #n ")" ::: "memory")
#define PG8_WAIT_L(n) asm volatile("s_waitcnt lgkmcnt(" #n ")" ::: "memory")
#define PG8_BAR __builtin_amdgcn_s_barrier()
#define PG8_SCHED __builtin_amdgcn_sched_barrier(0)
    Unit cur, nxt; int ui = 0;
    if (!S.next(0, cur)) return;
    f32x4 acc[2][2][4][2];
#pragma unroll
    for (int a = 0; a < 2; ++a)
#pragma unroll
        for (int b = 0; b < 2; ++b)
#pragma unroll
            for (int m = 0; m < 4; ++m)
#pragma unroll
                for (int n = 0; n < 2; ++n) acc[a][b][m][n] = (f32x4){0.f, 0.f, 0.f, 0.f};
    bf16x8 At[4][2], B0[2][2], B1[2][2];
    const char* cA = (const char*)g.A + (size_t)cur.pm * tstep; const char* cB = (const char*)g.Bt + (size_t)cur.e * g.estride + (size_t)cur.pn * tstep;
    S.a_ready(cur);
    if constexpr (SP2) {
        PG8_STAGE(PG8_SB(0, 0), cB, voffB); PG8_STAGE(PG8_SB(0, 1), cB + hstep, voffB); PG8_STAGE(PG8_SA(0, 0), cA, voffA); PG8_STAGE(PG8_SA(0, 1), cA + hstep, voffA);
        if (wr == 1) PG8_BAR;
        PG8_WAIT_V(2); PG8_BAR;
        PG8_STAGE(PG8_SB(1, 0), cB + kstep, voffB); PG8_STAGE(PG8_SA(1, 0), cA + kstep, voffA); PG8_STAGE(PG8_SB(1, 1), cB + hstep + kstep, voffB);
        PG8_WAIT_V(6); PG8_BAR;
    } else {
        PG8_STAGE(PG8_SB(0, 0), cB, voffB); PG8_STAGE(PG8_SA(0, 0), cA, voffA); PG8_STAGE(PG8_SB(0, 1), cB + hstep, voffB); PG8_STAGE(PG8_SA(0, 1), cA + hstep, voffA);
        if (wr == 1) PG8_BAR;
        PG8_WAIT_V(4); PG8_BAR;
        PG8_STAGE(PG8_SB(1, 0), cB + kstep, voffB); PG8_STAGE(PG8_SA(1, 0), cA + kstep, voffA); PG8_STAGE(PG8_SB(1, 1), cB + hstep + kstep, voffB);
        PG8_WAIT_V(6); PG8_BAR;
    }
    for (;;) {
        const bool has_next = S.next(ui + 1, nxt);
        const char* nA = has_next ? (const char*)g.A + (size_t)nxt.pm * tstep : cA; const char* nB = has_next ? (const char*)g.Bt + (size_t)nxt.e * g.estride + (size_t)nxt.pn * tstep : cB;
#pragma nounroll
        for (int t = 0; t < nt; t += 2) {
            const bool last = (t == nt - 2);
            const char* a1 = cA + (size_t)(t + 1) * kstep;
            const char* a2 = last ? nA : cA + (size_t)(t + 2) * kstep; const char* b2 = last ? nB : cB + (size_t)(t + 2) * kstep;
            const char* a3 = a2 + kstep; const char* b3 = b2 + kstep;
            if (last && has_next) S.a_ready(nxt);
            if constexpr (SP2) {
            PG8_LDB(B0, 0, 0); PG8_LDB(B1, 0, 1); PG8_SCHED; PG8_LDA(At, 0, 0); PG8_STAGE(PG8_SA(1, 1), a1 + hstep, voffA);
            PG8_WAIT_V(8); PG8_WAIT_L(0); PG8_BAR; PG8_MMA(0, 0, At, B0); PG8_MMA(0, 1, At, B1); PG8_BAR; PG8_SCHED;
            PG8_LDA(At, 0, 1); PG8_STAGE(PG8_SB(0, 0), b2, voffB); PG8_STAGE(PG8_SB(0, 1), b2 + hstep, voffB); PG8_STAGE(PG8_SA(0, 0), a2, voffA);
            PG8_WAIT_V(8); PG8_WAIT_L(0); PG8_BAR; PG8_MMA(1, 0, At, B0); PG8_MMA(1, 1, At, B1); PG8_BAR; PG8_SCHED;
            PG8_LDB(B0, 1, 0); PG8_LDB(B1, 1, 1); PG8_SCHED; PG8_LDA(At, 1, 0); PG8_STAGE(PG8_SA(0, 1), a2 + hstep, voffA);
            PG8_WAIT_V(8); PG8_WAIT_L(0); PG8_BAR; PG8_MMA(0, 0, At, B0); PG8_MMA(0, 1, At, B1); PG8_BAR; PG8_SCHED;
            PG8_LDA(At, 1, 1); PG8_STAGE(PG8_SB(1, 0), b3, voffB); PG8_STAGE(PG8_SB(1, 1), b3 + hstep, voffB); PG8_STAGE(PG8_SA(1, 0), a3, voffA);
            PG8_WAIT_V(8); PG8_WAIT_L(0); PG8_BAR; PG8_MMA(1, 0, At, B0); PG8_MMA(1, 1, At, B1); PG8_BAR; PG8_SCHED;
            } else {
            PG8_LDB(B0, 0, 0); PG8_SCHED; PG8_LDA(At, 0, 0); PG8_STAGE(PG8_SA(1, 1), a1 + hstep, voffA);
            PG8_WAIT_L(8); PG8_BAR; PG8_WAIT_L(0); PG8_MMA(0, 0, At, B0); PG8_BAR; PG8_SCHED;
            PG8_LDB(B1, 0, 1); PG8_STAGE(PG8_SB(0, 0), b2, voffB);
            PG8_BAR; PG8_WAIT_L(0); PG8_MMA(0, 1, At, B1); PG8_BAR;
            PG8_LDA(At, 0, 1); PG8_STAGE(PG8_SA(0, 0), a2, voffA);
            PG8_BAR; PG8_WAIT_L(0); PG8_MMA(1, 0, At, B0); PG8_BAR; PG8_SCHED;
            PG8_STAGE(PG8_SB(0, 1), b2 + hstep, voffB);
            PG8_WAIT_V(6); PG8_BAR; PG8_MMA(1, 1, At, B1); PG8_BAR;
            PG8_LDB(B0, 1, 0); PG8_SCHED; PG8_LDA(At, 1, 0); PG8_STAGE(PG8_SA(0, 1), a2 + hstep, voffA);
            PG8_WAIT_L(8); PG8_BAR; PG8_WAIT_L(0); PG8_MMA(0, 0, At, B0); PG8_BAR; PG8_SCHED;
            PG8_LDB(B1, 1, 1); PG8_STAGE(PG8_SB(1, 0), b3, voffB);
            PG8_BAR; PG8_WAIT_L(0); PG8_MMA(0, 1, At, B1); PG8_BAR;
            PG8_LDA(At, 1, 1); PG8_STAGE(PG8_SA(1, 0), a3, voffA);
            PG8_BAR; PG8_WAIT_L(0); PG8_MMA(1, 0, At, B0); PG8_BAR; PG8_SCHED;
            PG8_STAGE(PG8_SB(1, 1), b3 + hstep, voffB);
            PG8_WAIT_V(6); PG8_BAR; PG8_MMA(1, 1, At, B1); PG8_BAR;
            }
        }
        if constexpr (ALIGN_EPI) { if (wr == 0) PG8_BAR; }
        if constexpr (!Epi::AFTER_DRAIN) { E(acc, cur, wr, wc, fr, fq); S.done(cur); }
        if (!has_next) break;
#pragma unroll
        for (int a = 0; a < 2; ++a)
#pragma unroll
            for (int b = 0; b < 2; ++b)
#pragma unroll
                for (int m = 0; m < 4; ++m)
#pragma unroll
                    for (int n = 0; n < 2; ++n) acc[a][b][m][n] = (f32x4){0.f, 0.f, 0.f, 0.f};
        cur = nxt; cA = nA; cB = nB; ++ui;
        if constexpr (ALIGN_EPI) { if (wr == 1) PG8_BAR; }
    }
    PG8_WAIT_V(0);
    if constexpr (!ALIGN_EPI) { if (wr == 0) PG8_BAR; }
    PG8_BAR;
    if constexpr (Epi::AFTER_DRAIN) { E.fused(acc, cur, wr, wc, fr, fq, lds, wid, lane); S.done(cur); }
#undef PG8_SA
#undef PG8_SB
#undef PG8_STAGE
#undef PG8_LDA
#undef PG8_LDB
#undef PG8_MMA
#undef PG8_WAIT_V
#undef PG8_WAIT_L
#undef PG8_BAR
#undef PG8_SCHED
}
}

struct Args { const float* in[20]; float* out; unsigned char* ws; int ph_lo, ph_hi; };
struct Frame {
    LAS unsigned char* lds; volatile LAS unsigned* MISC; gu32* ctl; unsigned char* ws;
    int vcu, G;
};
#define F_TID ((int)threadIdx.x)
#define F_LANE ((int)(threadIdx.x & 63))
#define F_WAVE (__builtin_amdgcn_readfirstlane((int)(threadIdx.x >> 6)))

__device__ __forceinline__ int in_src_col(int n) {
    if (n < 640) return n;
    if (n < 2688) return n + 32;
    if (n < 2720) return n - 2688 + 640;
    if (n < 2792) return n;
    if (n < 2816) return -1;
    return n - 24;
}
__device__ __forceinline__ void tr_item(const float* colptr, int ld, int k0, bf16* WT, int Kd, int destrow0, LAS float* scr, int lane) {
    const int nq = lane & 15, kr = lane >> 4;
#pragma unroll 8
    for (int it = 0; it < 16; ++it) { const int kk = 4 * it + kr; f32x4 v = (f32x4){0.f, 0.f, 0.f, 0.f}; if (colptr) v = *(const GAS f32x4*)(colptr + (size_t)(k0 + kk) * ld);
        LAS float* d = scr + kk * 65 + 4 * nq; d[0] = v.x; d[1] = v.y; d[2] = v.z; d[3] = v.w; }
    LDS_WAIT(); asm volatile("" ::: "memory");
    const int c = lane & 7;
#pragma unroll
    for (int j = 0; j < 8; ++j) { const int n = (lane >> 3) + 8 * j; const LAS float* q = scr + (8 * c) * 65 + n;
        v4u o; o.x = pk2(q[0 * 65], q[1 * 65]); o.y = pk2(q[2 * 65], q[3 * 65]); o.z = pk2(q[4 * 65], q[5 * 65]); o.w = pk2(q[6 * 65], q[7 * 65]);
        *(GAS v4u*)(WT + (size_t)(destrow0 + n) * Kd + k0 + 8 * c) = o; }
    LDS_WAIT(); asm volatile("" ::: "memory");
}
constexpr int CV_I0 = 16 * 76, CV_I1 = 6 * 12, CV_I2 = 4 * 16, CV_I3 = 8 * 16, CV_I4 = 8 * 16, CV_I5 = 16 * 16, CV_I6 = 32 * 16 * 8, CV_I7 = 32 * 4 * 16;
constexpr int CV_EARLY = CV_I0 + CV_I1 + CV_I2, CV_LATE = CV_I3 + CV_I4 + CV_I5 + CV_I6 + CV_I7, CV_QITEMS = CV_LATE / 16;
static_assert(CV_LATE % 16 == 0, "late conversion tiles come in queue items of 16");
__device__ __forceinline__ void conv_tile(const Args& A, unsigned char* ws, int it, LAS float* scr, int lane) {
    const int n4 = 4 * (lane & 15);
    int r = it;
    if (r < CV_I0) { const int kb = r / 76, nb = r % 76; const int col = in_src_col(64 * nb + n4);
        tr_item(col >= 0 ? A.in[2] + col : nullptr, NIN_SRC, 64 * kb, (bf16*)(ws + WS_WIN), 1024, 64 * nb, scr, lane); return; } r -= CV_I0;
    if (r < CV_I1) { const int kb = r / 12, nb = r % 12; tr_item(A.in[4] + 64 * nb + n4, 768, 64 * kb, (bf16*)(ws + WS_WUQ), 384, 64 * nb, scr, lane); return; } r -= CV_I1;
    if (r < CV_I2) { const int kb = r / 16, nb = r % 16; const int n = 64 * nb + n4;
        tr_item(n < 512 ? A.in[6] + n : A.in[7] + (n - 512), 512, 64 * kb, (bf16*)(ws + WS_WUKV), 256, 64 * nb, scr, lane); return; } r -= CV_I2;
    if (r < CV_I3) { const int kb = r / 16, nb = r % 16; tr_item(A.in[8] + 64 * nb + n4, 1024, 64 * kb, (bf16*)(ws + WS_WOA), 512, 64 * nb, scr, lane); return; } r -= CV_I3;
    if (r < CV_I4) { const int kb = r / 16, nb = r % 16; tr_item(A.in[9] + 64 * nb + n4, 1024, 64 * kb, (bf16*)(ws + WS_WOB), 512, 64 * nb, scr, lane); return; } r -= CV_I4;
    if (r < CV_I5) { const int kb = r / 16, nb = r % 16; tr_item(A.in[10] + 64 * nb + n4, 1024, 64 * kb, (bf16*)(ws + WS_WOUT), 1024, 64 * nb, scr, lane); return; } r -= CV_I5;
    if (r < CV_I6) { const int e = r / 128, rr = r % 128, kb = rr / 8, nb = rr % 8; const int n = 64 * nb + n4, pn = n >> 8, c = n & 255, col = 128 * pn + (c & 127);
        const float* src = ((c >> 7) ? A.in[17] : A.in[16]) + (size_t)e * 1024 * 256 + col;
        tr_item(src, 256, 64 * kb, (bf16*)(ws + WS_WGU) + (size_t)e * 512 * 1024, 1024, 64 * nb, scr, lane); return; } r -= CV_I6;
    { const int e = r / 64, rr = r % 64, kb = rr / 16, nb = rr % 16;
        tr_item(A.in[18] + (size_t)e * 256 * 1024 + 64 * nb + n4, 1024, 64 * kb, (bf16*)(ws + WS_WD) + (size_t)e * 1024 * 256, 256, 64 * nb, scr, lane); }
}
__device__ __forceinline__ void p0_prologue(Frame& F, const Args& A) {
    LAS float* scr = (LAS float*)(F.lds + F_WAVE * 16640);
    const int gw = F.vcu * NWAVES + F_WAVE, NGW = F.G * NWAVES, lane = F_LANE;
    unsigned char* ws = F.ws;
#ifdef CONV_IN_P0
    for (int it = gw; it < CV_EARLY + CV_LATE; it += NGW) conv_tile(A, ws, it, scr, lane);
#else
    for (int it = gw; it < CV_EARLY; it += NGW) conv_tile(A, ws, it, scr, lane);
#endif
    const float* x = A.in[0]; const float* g1 = A.in[1]; bf16* H = (bf16*)(ws + WS_H);
    for (int m0 = gw; m0 < T; m0 += 4 * NGW) {
        f32x4 v[4][4];
#pragma unroll
        for (int r = 0; r < 4; ++r) { const int m = min(m0 + r * NGW, T - 1); const GAS f32x4* xr = (const GAS f32x4*)(x + (size_t)m * D) + lane;
#pragma unroll
            for (int j = 0; j < 4; ++j) v[r][j] = xr[64 * j]; }
#pragma unroll
        for (int r = 0; r < 4; ++r) { const int m = m0 + r * NGW; float s = 0.f;
#pragma unroll
            for (int j = 0; j < 4; ++j) s += (v[r][j].x * v[r][j].x + v[r][j].y * v[r][j].y) + (v[r][j].z * v[r][j].z + v[r][j].w * v[r][j].w);
            const float rstd = 1.f / sqrtf(wave_sum(s) * (1.f / D) + EPS);
            if (m < T) { GAS v2u* o8 = (GAS v2u*)(H + (size_t)m * D) + lane;
#pragma unroll
                for (int j = 0; j < 4; ++j) { const f32x4 g = *((const GAS f32x4*)g1 + lane + 64 * j); const f32x4 y = v[r][j] * rstd * g; v2u w; w.x = pk2(y.x, y.y); w.y = pk2(y.z, y.w); o8[64 * j] = w; } } }
    }
    f32x2* rope = (f32x2*)(ws + WS_ROPE);
    for (int idx = (F.vcu * NTHR + F_TID); idx < SEQ * 16; idx += F.G * NTHR) {
        const int pos = idx >> 4, i = idx & 15;
        const double REV[16] = {0.15915494309189535, 0.0700865215877985, 0.03086376340470123, 0.013591370636193905, 0.005985185712713705, 0.002635675898667414, 0.001160663641240061, 0.0005111175045375439,
                                0.00022507907903927653, 9.911730936901935e-05, 4.364795279280289e-05, 1.9221100684944863e-05, 8.464330808241401e-06, 3.727408601915352e-06, 1.6414262627950345e-06, 7.228293068832865e-07};
        double rv = 0.0;
#pragma unroll
        for (int k = 0; k < 16; ++k) rv = (i == k) ? REV[k] : rv;
        double t = (double)pos * rv; t -= __builtin_floor(t);
        const float tf = (float)t;
        rope[idx] = (f32x2){__builtin_amdgcn_cosf(tf), __builtin_amdgcn_sinf(tf)};
    }
}

__device__ __forceinline__ void p2a_norms(Frame& F, const Args& A) {
    const int gw = F.vcu * NWAVES + F_WAVE, NGW = F.G * NWAVES, lane = F_LANE;
    bf16* CQ = (bf16*)(F.ws + WS_CQ); bf16* CKV = (bf16*)(F.ws + WS_CKV);
    const float* gq = A.in[3]; const float* gkv = A.in[5];
    for (int m = gw; m < T; m += NGW) {
        {
            GAS unsigned* p = (GAS unsigned*)(CQ + (size_t)m * 384) + lane; unsigned w[3]; float s = 0.f;
#pragma unroll
            for (int j = 0; j < 3; ++j) { w[j] = p[64 * j]; const float a = bflo(w[j]), b = bfhi(w[j]); s += a * a + b * b; }
            const float rstd = 1.f / sqrtf(wave_sum(s) * (1.f / 384.f) + EPS);
#pragma unroll
            for (int j = 0; j < 3; ++j) { const f32x2 g = *((const GAS f32x2*)gq + lane + 64 * j); p[64 * j] = pk2(bflo(w[j]) * rstd * g.x, bfhi(w[j]) * rstd * g.y); }
        }
        {
            GAS v2u* p = (GAS v2u*)(CKV + (size_t)m * 256) + lane; const v2u w = *p;
            const float a = bflo(w.x), b = bfhi(w.x), c = bflo(w.y), d = bfhi(w.y);
            const float rstd = 1.f / sqrtf(wave_sum(a * a + b * b + c * c + d * d) * (1.f / 256.f) + EPS);
            const f32x4 g = *((const GAS f32x4*)gkv + lane); v2u o; o.x = pk2(a * rstd * g.x, b * rstd * g.y); o.y = pk2(c * rstd * g.z, d * rstd * g.w); *p = o;
        }
    }
}

__device__ __forceinline__ constexpr int crow(int r, int hi) { return (r & 3) + 8 * (r >> 2) + 4 * hi; }
constexpr float ATT_THR = 8.f;
__device__ __forceinline__ float att_mask(float p, unsigned w, int bit) { int mk; unsigned r;
    asm("v_bfe_i32 %0, %1, %2, 1" : "=v"(mk) : "v"(w), "i"(bit)); r = __builtin_bit_cast(unsigned, p) & (unsigned)mk; return __builtin_bit_cast(float, r); }
struct AttnP { const bf16 *Q, *K, *K2, *V; bf16* O; const unsigned* BM; };
template <bool MLA> __device__ __forceinline__ void attn_unit(LAS unsigned char* L, int b, int h, int qb, const AttnP& P, int tid, int lane, int wave) {
    constexpr int DK = MLA ? 96 : 64, KP = DK * 2 + 16, NS = DK / 16, CPR = DK / 8;
    constexpr int QPITCH = MLA ? 768 : 512, VP = 192, KBUF = 64 * KP, VBUF = 64 * VP;
    const int r32 = lane & 31, hi = lane >> 5;
    const size_t rowb = (size_t)b * SEQ;
    const int qrow = qb * 256 + wave * 32 + r32;
    bf16x8 qf[NS];
    { const bf16* qp = P.Q + (rowb + qrow) * QPITCH + h * DK;
#pragma unroll
      for (int s = 0; s < NS; ++s) qf[s] = *(const bf16x8*)(qp + 16 * s + 8 * hi); }
    const int NT = 4 * qb + 4, my_nt = 4 * qb + (wave >> 1) + 1;
    const int kid0 = tid, kid1 = tid + NTHR;
    const int kr0 = kid0 / CPR, kc0 = kid0 % CPR, kr1 = kid1 / CPR, kc1 = kid1 % CPR; const bool has1 = MLA && (kid1 < 64 * CPR);
    const int vr = tid >> 3, vc = tid & 7;
    v4u kreg0, kreg1 = (v4u){0u, 0u, 0u, 0u}, vreg;
#define ATT_KSRC(t, kr, kc) (MLA ? ((kc) < 8 ? (const v4u*)(P.K + (rowb + 64 * (t) + (kr)) * 512 + h * 64 + 8 * (kc)) : (const v4u*)(P.K2 + (rowb + 64 * (t) + (kr)) * 32 + 8 * ((kc) - 8))) \
                                 : (const v4u*)(P.K + (rowb + 64 * (t) + (kr)) * 512 + h * 64 + 8 * (kc)))
#define ATT_LOAD(t) do { kreg0 = *ATT_KSRC(t, kr0, kc0); if (has1) kreg1 = *ATT_KSRC(t, kr1, kc1); vreg = *(const v4u*)(P.V + (rowb + 64 * (t) + vr) * 512 + h * 64 + 8 * vc); } while (0)
#define ATT_WRITE(buf) do { *(LAS v4u*)(L + (buf) * KBUF + kr0 * KP + kc0 * 16) = kreg0; if (has1) *(LAS v4u*)(L + (buf) * KBUF + kr1 * KP + kc1 * 16) = kreg1; \
                            *(LAS v4u*)(L + 2 * KBUF + (buf) * VBUF + vr * VP + vc * 16) = vreg; } while (0)
    float mhat = 0.f, l = 0.f; f32x16 o0, o1, negm;
#pragma unroll
    for (int i = 0; i < 16; ++i) { o0[i] = 0.f; o1[i] = 0.f; negm[i] = 0.f; }
    const int g16 = lane >> 4, qq = (lane & 15) >> 2, pp = lane & 3;
    const int vlane = (4 * hi + qq) * VP + (16 * (g16 & 1) + 4 * pp) * 2;
    ATT_LOAD(0); ATT_WRITE(0); __syncthreads();
    unsigned wn0 = 0xffffffffu, wn1 = 0xffffffffu;
    const unsigned* bmq = MLA ? nullptr : P.BM + (size_t)b * 256 * SEQ + qrow;
    if (!MLA) { wn0 = bmq[0]; wn1 = bmq[SEQ]; }
    for (int t = 0; t < NT; ++t) {
        const int buf = t & 1;
        unsigned w0 = wn0 >> (4 * hi), w1 = wn1 >> (4 * hi);
        if (t + 1 < NT) { ATT_LOAD(t + 1); if (!MLA) { wn0 = bmq[(size_t)(2 * t + 2) * SEQ]; wn1 = bmq[(size_t)(2 * t + 3) * SEQ]; } }
        if (t < my_nt) {
            const LAS unsigned char* Kb = L + buf * KBUF; const LAS unsigned char* Vb = L + 2 * KBUF + buf * VBUF;
            f32x16 s0, s1;
            bf16x8 ka[NS][2];
#pragma unroll
            for (int s = 0; s < NS; ++s) { ka[s][0] = *(const LAS bf16x8*)(Kb + r32 * KP + s * 32 + hi * 16); ka[s][1] = *(const LAS bf16x8*)(Kb + (32 + r32) * KP + s * 32 + hi * 16); }
            __builtin_amdgcn_sched_barrier(0);
#pragma unroll
            for (int s = 0; s < NS; ++s) {
                s0 = __builtin_amdgcn_mfma_f32_32x32x16_bf16(ka[s][0], qf[s], s == 0 ? negm : s0, 0, 0, 0);
                s1 = __builtin_amdgcn_mfma_f32_32x32x16_bf16(ka[s][1], qf[s], s == 0 ? negm : s1, 0, 0, 0);
            }
            s16x4 vf[4][4];
#pragma unroll
            for (int ks = 0; ks < 4; ++ks) { const LAS unsigned char* vp = Vb + ks * 16 * VP + vlane;
                vf[ks][0] = __builtin_bit_cast(s16x4, __builtin_amdgcn_ds_read_tr16_b64_v4i16((LAS s16x4*)(vp)));
                vf[ks][1] = __builtin_bit_cast(s16x4, __builtin_amdgcn_ds_read_tr16_b64_v4i16((LAS s16x4*)(vp + 8 * VP)));
                vf[ks][2] = __builtin_bit_cast(s16x4, __builtin_amdgcn_ds_read_tr16_b64_v4i16((LAS s16x4*)(vp + 64)));
                vf[ks][3] = __builtin_bit_cast(s16x4, __builtin_amdgcn_ds_read_tr16_b64_v4i16((LAS s16x4*)(vp + 8 * VP + 64))); }
            __builtin_amdgcn_sched_barrier(0);
            float mx = fmaxf(fmaxf(s0[0], s0[1]), s1[0]);
#pragma unroll
            for (int i = 2; i < 16; i += 2) mx = fmaxf(fmaxf(mx, s0[i]), s0[i + 1]);
#pragma unroll
            for (int i = 1; i < 15; i += 2) mx = fmaxf(fmaxf(mx, s1[i]), s1[i + 1]);
            mx = fmaxf(mx, s1[15]);
            mx = fmaxf(mx, __shfl_xor(mx, 32));
            if (t == 0 || __any(mx > ATT_THR)) {
                const float dl = (t == 0) ? mx : fmaxf(mx, 0.f), f = (t == 0) ? 1.f : __builtin_amdgcn_exp2f(-dl);
                mhat += dl; l *= f;
#pragma unroll
                for (int i = 0; i < 16; ++i) { s0[i] -= dl; s1[i] -= dl; o0[i] *= f; o1[i] *= f; negm[i] = -mhat; }
            }
            float rs = 0.f;
#pragma unroll
            for (int i = 0; i < 16; ++i) {
                float p0 = __builtin_amdgcn_exp2f(s0[i]), p1 = __builtin_amdgcn_exp2f(s1[i]);
                if (!MLA) { p0 = att_mask(p0, w0, crow(i, 0)); p1 = att_mask(p1, w1, crow(i, 0)); }
                s0[i] = p0; s1[i] = p1; rs += p0 + p1; }
            l += rs;
            bf16x8 pf[4];
#pragma unroll
            for (int ks = 0; ks < 4; ++ks) { v4u w;
#pragma unroll
                for (int j = 0; j < 4; ++j) { const float a = (ks < 2) ? s0[8 * (ks & 1) + 2 * j] : s1[8 * (ks & 1) + 2 * j], c = (ks < 2) ? s0[8 * (ks & 1) + 2 * j + 1] : s1[8 * (ks & 1) + 2 * j + 1]; w[j] = pk2(a, c); }
                pf[ks] = __builtin_bit_cast(bf16x8, w); }
#pragma unroll
            for (int ks = 0; ks < 4; ++ks) {
                const bf16x8 A0 = __builtin_shufflevector(vf[ks][0], vf[ks][1], 0, 1, 2, 3, 4, 5, 6, 7);
                const bf16x8 A1 = __builtin_shufflevector(vf[ks][2], vf[ks][3], 0, 1, 2, 3, 4, 5, 6, 7);
                o0 = __builtin_amdgcn_mfma_f32_32x32x16_bf16(A0, pf[ks], o0, 0, 0, 0);
                o1 = __builtin_amdgcn_mfma_f32_32x32x16_bf16(A1, pf[ks], o1, 0, 0, 0);
            }
        }
        if (t + 1 < NT) ATT_WRITE(buf ^ 1);
        __syncthreads();
    }
    l += __shfl_xor(l, 32);
    const float inv = 1.f / l;
    bf16* op = P.O + (rowb + qrow) * 512 + h * 64 + 4 * hi;
#pragma unroll
    for (int g = 0; g < 4; ++g) {
        v2u w; w.x = pk2(o0[4 * g] * inv, o0[4 * g + 1] * inv); w.y = pk2(o0[4 * g + 2] * inv, o0[4 * g + 3] * inv); *(v2u*)(op + 8 * g) = w;
        v2u z; z.x = pk2(o1[4 * g] * inv, o1[4 * g + 1] * inv); z.y = pk2(o1[4 * g + 2] * inv, o1[4 * g + 3] * inv); *(v2u*)(op + 32 + 8 * g) = z;
    }
#undef ATT_KSRC
#undef ATT_LOAD
#undef ATT_WRITE
}

constexpr int CAND_CAP = 128, QIP = 1296, HS = 513;
struct IdxP { const bf16 *QI, *KI; const float* WI; unsigned* BM; };
__device__ __forceinline__ unsigned mono_key(float s) { const unsigned u = __builtin_bit_cast(unsigned, s + 0.0f); return u ^ ((unsigned)((int)u >> 31) | 0x80000000u); }
__device__ __forceinline__ void idx_scores2(const bf16x8 (&kf)[2][4], const LAS unsigned char* qlane, const float (&wq)[8], f32x16& sc0, f32x16& sc1) {
    bf16x8 qv[4], qn[4];
#pragma unroll
    for (int s = 0; s < 4; ++s) qv[s] = *(const LAS bf16x8*)(qlane + 8 * 128 + s * 32);
#pragma unroll
    for (int i = 0; i < 16; ++i) { sc0[i] = 0.f; sc1[i] = 0.f; }
    f32x16 ap0, ap1;
#pragma unroll
    for (int i = 0; i < 16; ++i) { ap0[i] = 0.f; ap1[i] = 0.f; }
#pragma unroll
    for (int n = 0; n < 10; ++n) {
        const int nh = (n + 1 < 2) ? 9 : (n + 1 - 2);
        if (n + 1 < 10) {
#pragma unroll
            for (int s = 0; s < 4; ++s) qn[s] = *(const LAS bf16x8*)(qlane + nh * 128 + s * 32); }
        f32x16 a0, a1;
        if (n < 2) {
#pragma unroll
            for (int s = 0; s < 4; ++s) { sc0 = __builtin_amdgcn_mfma_f32_32x32x16_bf16(kf[0][s], qv[s], sc0, 0, 0, 0); sc1 = __builtin_amdgcn_mfma_f32_32x32x16_bf16(kf[1][s], qv[s], sc1, 0, 0, 0); }
        } else {
#pragma unroll
            for (int i = 0; i < 16; ++i) { a0[i] = 0.f; a1[i] = 0.f; }
#pragma unroll
            for (int s = 0; s < 4; ++s) { a0 = __builtin_amdgcn_mfma_f32_32x32x16_bf16(kf[0][s], qv[s], a0, 0, 0, 0); a1 = __builtin_amdgcn_mfma_f32_32x32x16_bf16(kf[1][s], qv[s], a1, 0, 0, 0); }
        }
        if (n >= 3) {
            const float w = wq[n - 3];
#pragma unroll
            for (int i = 0; i < 16; ++i) { sc0[i] = __builtin_fmaf(w, __builtin_fabsf(ap0[i]), sc0[i]); sc1[i] = __builtin_fmaf(w, __builtin_fabsf(ap1[i]), sc1[i]); }
#pragma unroll
            for (int g = 0; g < 8; ++g) { __builtin_amdgcn_sched_group_barrier(0x008, 1, 0); __builtin_amdgcn_sched_group_barrier(0x002, 4, 0); }
        }
        if (n >= 2) { ap0 = a0; ap1 = a1; }
#pragma unroll
        for (int s = 0; s < 4; ++s) qv[s] = qn[s];
    }
    { const float w = wq[7];
#pragma unroll
      for (int i = 0; i < 16; ++i) { sc0[i] = __builtin_fmaf(w, __builtin_fabsf(ap0[i]), sc0[i]); sc1[i] = __builtin_fmaf(w, __builtin_fabsf(ap1[i]), sc1[i]); } }
#pragma unroll
    for (int i = 0; i < 16; ++i) asm volatile("" : "+v"(sc0[i]), "+v"(sc1[i]));
}
__device__ __forceinline__ void idx_item(LAS unsigned char* L, int b, int j, const IdxP& P, int tid, int lane, int wave) {
    LAS unsigned* hist = (LAS unsigned*)L;
    LAS unsigned* img = (LAS unsigned*)(L + 66048);
    LAS unsigned* st = (LAS unsigned*)(L + 98816);
    LAS unsigned* cand = hist;
    LAS unsigned char* Qs = L + 100864;
    const int r32 = lane & 31, hi = lane >> 5;
    const int q0 = 32 * j, ntile = 2 * (j / 2 + 1);
    const size_t rowb = (size_t)b * SEQ;
    if (ntile <= 8) {
        for (int idx = tid; idx < ntile * 32; idx += NTHR) P.BM[((size_t)b * 256 + (idx >> 5)) * SEQ + q0 + (idx & 31)] = 0xffffffffu;
        return;
    }
    float wq[8];
    { for (int c = tid; c < 32 * 64; c += NTHR) { const int rr = c >> 6, ch = c & 63; *(LAS v4u*)(Qs + rr * QIP + ch * 16) = *(const v4u*)(P.QI + (rowb + q0 + rr) * 512 + ch * 8); }
      const float* wp = P.WI + (rowb + q0 + r32) * 8;
#pragma unroll
      for (int h = 0; h < 8; ++h) wq[h] = 0.5f * wp[h]; }
    if (tid < 32) { st[32 + tid] = 256u; st[64 + tid] = 0u; st[96 + tid] = 0u; }
    if (tid == 0) st[129] = 0u;
    __syncthreads();
    {
        const int r = tid >> 4, part = tid & 15;
        const float* wp = P.WI + (rowb + q0 + r) * 8;
        float qb[4] = {0.f, 0.f, 0.f, 0.f}; float rsum = 0.f;
#pragma unroll
        for (int h = 0; h < 8; ++h) { const float w = wp[h]; const v2u raw = *(const LAS v2u*)(Qs + r * QIP + h * 128 + part * 8);
            const float f0 = bflo(raw.x), f1 = bfhi(raw.x), f2 = bflo(raw.y), f3 = bfhi(raw.y);
            float nsq = (f0 * f0 + f1 * f1) + (f2 * f2 + f3 * f3);
#pragma unroll
            for (int o = 1; o < 16; o <<= 1) nsq += __shfl_xor(nsq, o);
            rsum += fabsf(w) * sqrtf(nsq);
            qb[0] += 0.5f * w * f0; qb[1] += 0.5f * w * f1; qb[2] += 0.5f * w * f2; qb[3] += 0.5f * w * f3; }
        v2u hw, lw;
        { const unsigned h01 = pk2(qb[0], qb[1]), h23 = pk2(qb[2], qb[3]); hw.x = h01; hw.y = h23;
          lw.x = pk2(qb[0] - bflo(h01), qb[1] - bfhi(h01)); lw.y = pk2(qb[2] - bflo(h23), qb[3] - bfhi(h23)); }
        *(LAS v2u*)(Qs + r * QIP + 8 * 128 + part * 8) = hw; *(LAS v2u*)(Qs + r * QIP + 9 * 128 + part * 8) = lw;
        { const v2u kw = *(const v2u*)(P.KI + (rowb + r) * 64 + part * 4); const float f0 = bflo(kw.x), f1 = bfhi(kw.x), f2 = bflo(kw.y), f3 = bfhi(kw.y);
          float ksq = (f0 * f0 + f1 * f1) + (f2 * f2 + f3 * f3);
#pragma unroll
          for (int o = 1; o < 16; o <<= 1) ksq += __shfl_xor(ksq, o);
          if (part == 0) { __hip_atomic_fetch_max(&st[129], __builtin_bit_cast(unsigned, ksq), __ATOMIC_RELAXED, __HIP_MEMORY_SCOPE_WORKGROUP); st[224 + r] = __builtin_bit_cast(unsigned, rsum); } }
    }
    __syncthreads();
    if (tid < 32) { const float R = 0.25f * sqrtf(__builtin_bit_cast(float, st[129])) * __builtin_bit_cast(float, st[224 + tid]);
        const float C = 0.125f * R;
        st[160 + tid] = (0x80000000u | __builtin_bit_cast(unsigned, R + C)) - 511u * 131072u; st[224 + tid] = __builtin_bit_cast(unsigned, C); st[tid] = 0u; st[192 + tid] = 0u; }
    const LAS unsigned char* qlane = Qs + r32 * QIP + hi * 16;
    int level = 0;
    const int npair = ntile >> 1;
#define IDX_KLOAD2(tp) { const bf16* kp = P.KI + (rowb + 64 * (tp) + r32) * 64 + 8 * hi; _Pragma("unroll") for (int s = 0; s < 4; ++s) { kn[0][s] = *(const bf16x8*)(kp + 16 * s); kn[1][s] = *(const bf16x8*)(kp + 32 * 64 + 16 * s); } }
#define IDX_SCORES2(tp) \
        bf16x8 kf[2][4]; _Pragma("unroll") for (int s = 0; s < 4; ++s) { kf[0][s] = kn[0][s]; kf[1][s] = kn[1][s]; } \
        f32x16 sc0, sc1; idx_scores2(kf, qlane, wq, sc0, sc1); \
        if ((tp) + NWAVES < npair) { IDX_KLOAD2((tp) + NWAVES) }
    for (;;) {
        ++level;
        for (int u = tid; u < 32 * HS; u += NTHR) hist[u] = 0u;
        if (tid == 0) st[128] = 0u;
        __syncthreads();
        {
            const unsigned qa = st[r32], qlen = st[192 + r32], base1 = st[160 + r32]; const float cq = __builtin_bit_cast(float, st[224 + r32]);
            const int sh = (level > 1 && qlen > 512u) ? (32 - __builtin_clz(qlen - 1u)) - 9 : 0;
            LAS unsigned* hrow = hist + r32 * HS;
            bf16x8 kn[2][4]; if (wave < npair) { IDX_KLOAD2(wave) }
            for (int tp = wave; tp < npair; tp += NWAVES) {
                IDX_SCORES2(tp)
                if (level == 1) {
#pragma unroll
                    for (int i = 0; i < 16; ++i) { const unsigned k0 = mono_key(sc0[i] + cq), k1 = mono_key(sc1[i] + cq);
                        const unsigned b0 = min((max(k0, base1) - base1) >> 17, 511u), b1 = min((max(k1, base1) - base1) >> 17, 511u);
                        __hip_atomic_fetch_add(&hrow[b0], 1u, __ATOMIC_RELAXED, __HIP_MEMORY_SCOPE_WORKGROUP); __hip_atomic_fetch_add(&hrow[b1], 1u, __ATOMIC_RELAXED, __HIP_MEMORY_SCOPE_WORKGROUP); }
                } else {
#pragma unroll
                    for (int i = 0; i < 16; ++i) { const unsigned o0 = mono_key(sc0[i] + cq) - qa, o1 = mono_key(sc1[i] + cq) - qa;
                        if (o0 < qlen) __hip_atomic_fetch_add(&hrow[o0 >> sh], 1u, __ATOMIC_RELAXED, __HIP_MEMORY_SCOPE_WORKGROUP);
                        if (o1 < qlen) __hip_atomic_fetch_add(&hrow[o1 >> sh], 1u, __ATOMIC_RELAXED, __HIP_MEMORY_SCOPE_WORKGROUP); }
                }
            }
        }
        __syncthreads();
        {
            const int q = tid >> 4, seg = tid & 15;
            unsigned segsum = 0u;
            for (int wi = 0; wi < 32; ++wi) segsum += hist[q * HS + seg * 32 + wi];
            unsigned S = segsum;
#pragma unroll
            for (int off = 1; off < 16; off <<= 1) { const unsigned o = __shfl_down(S, off, 16); if (seg + off < 16) S += o; }
            const unsigned above = S - segsum, need = st[32 + q];
            if (above < need && need <= above + segsum) {
                unsigned cum = above, fbin = 0u, fneed = 1u, fcnt = 0u; bool found = false;
                for (int wi = 31; wi >= 0; --wi) { const unsigned c = hist[q * HS + seg * 32 + wi];
                    if (!found && cum + c >= need) { found = true; fbin = 32 * seg + wi; fneed = need - cum; fcnt = c; } if (!found) cum += c; }
                unsigned na, nlen;
                if (level == 1) { const unsigned base1 = st[160 + q];
                    if (fbin == 0u) { na = 0u; nlen = base1 + 131072u; } else if (fbin == 511u) { na = base1 + 511u * 131072u; nlen = 0u - na; } else { na = base1 + fbin * 131072u; nlen = 131072u; } }
                else { const unsigned qa = st[q], qlen = st[192 + q]; const int sh = qlen > 512u ? (32 - __builtin_clz(qlen - 1u)) - 9 : 0;
                    na = qa + (fbin << sh); nlen = min(1u << sh, qlen - (fbin << sh)); }
                st[q] = na; st[192 + q] = nlen; st[32 + q] = fneed; st[64 + q] = fcnt;
                if (fcnt > (unsigned)CAND_CAP && nlen > 1u) st[128] = 1u;
            }
        }
        __syncthreads();
#ifndef MAXLVL
#define MAXLVL 8
#endif
        const bool more = (st[128] != 0u) && (level < MAXLVL);
        __syncthreads();
        if (!more) break;
    }
    {
        const unsigned qa = st[r32], qlen = st[192 + r32]; const float cq = __builtin_bit_cast(float, st[224 + r32]);
        const unsigned Hk = qa + qlen - 1u;
        unsigned hb = (Hk & 0x80000000u) ? (Hk ^ 0x80000000u) : ~Hk;
        if (hb == 0x80000000u) hb = 0x80000001u;
        const float fH = __builtin_bit_cast(float, hb);
        const unsigned ab_ = (qa & 0x80000000u) ? (qa ^ 0x80000000u) : ~qa;
        const float fA = (qa < 0x00800000u) ? -__builtin_inff() : __builtin_bit_cast(float, ab_);
        bf16x8 kn[2][4]; if (wave < npair) { IDX_KLOAD2(wave) }
        for (int tp = wave; tp < npair; tp += NWAVES) {
            IDX_SCORES2(tp)
#define IDX_COLLECT_ELEMS(SC, T) { unsigned v = 0u; _Pragma("unroll") for (int i = 15; i >= 0; --i) { const float ts = SC[i] + cq; const bool ab = ts > fH; v = v + v + (ab ? 1u : 0u); \
                if (!ab && ts >= fA) { const unsigned key = mono_key(ts); \
                    const unsigned pos = __hip_atomic_fetch_add(&st[96 + r32], 1u, __ATOMIC_RELAXED, __HIP_MEMORY_SCOPE_WORKGROUP); \
                    if (pos < (unsigned)CAND_CAP) { cand[(r32 * CAND_CAP + pos) * 2] = key; cand[(r32 * CAND_CAP + pos) * 2 + 1] = (unsigned)(32 * (T) + crow(i, hi)); } } } \
            unsigned bits = (v & 0xfu) | ((v & 0xf0u) << 4) | ((v & 0xf00u) << 8) | ((v & 0xf000u) << 12);     \
            bits <<= 4 * hi; bits |= __shfl_xor(bits, 32); if (hi == 0) img[(T) * 32 + r32] = bits; }
            IDX_COLLECT_ELEMS(sc0, 2 * tp)
            IDX_COLLECT_ELEMS(sc1, 2 * tp + 1)
#undef IDX_COLLECT_ELEMS
        }
    }
#undef IDX_SCORES2
#undef IDX_KLOAD2
    __syncthreads();
    {
        const int q = tid >> 4; const unsigned n = min(st[96 + q], (unsigned)CAND_CAP), need = st[32 + q];
        for (unsigned c = tid & 15; c < n; c += 16) { const unsigned key = cand[(q * CAND_CAP + c) * 2], idx = cand[(q * CAND_CAP + c) * 2 + 1]; unsigned rank = 0u;
            for (unsigned o = 0; o < n; ++o) { const unsigned k2 = cand[(q * CAND_CAP + o) * 2], i2 = cand[(q * CAND_CAP + o) * 2 + 1]; rank += (k2 > key || (k2 == key && i2 < idx)) ? 1u : 0u; }
            if (rank < need) __hip_atomic_fetch_or(&img[(idx >> 5) * 32 + q], 1u << (idx & 31), __ATOMIC_RELAXED, __HIP_MEMORY_SCOPE_WORKGROUP); }
    }
    __syncthreads();
    for (int idx = tid; idx < ntile * 32; idx += NTHR) P.BM[((size_t)b * 256 + (idx >> 5)) * SEQ + q0 + (idx & 31)] = img[idx];
    __syncthreads();
}

__device__ __forceinline__ int wq_next(Frame& F, int cw) {
    __syncthreads();
    if (F_TID == 0) F.MISC[0] = __hip_atomic_fetch_add((unsigned*)(F.ctl + cw), 1u, RLX_AGENT);
    __syncthreads();
    return (int)F.MISC[0];
}

__device__ __forceinline__ void p5a_route(Frame& F, const Args& A) {
    const int lane = F_LANE, tid = F_TID, wave = F_WAVE;
    const float* x1 = A.out; const float* g2 = A.in[11];
    const float* wrg = A.in[12]; const float* brg = A.in[13]; const float* wre = A.in[14]; const float* bre = A.in[15];
    int* toke = (int*)(F.ws + WS_TOKE); float* tokw = (float*)(F.ws + WS_TOKW); float* rstd2 = (float*)(F.ws + WS_RSTD2);
    int* sslot = (int*)(F.ws + WS_SSLOT);
    constexpr int WST = 44, WCH = 256 * WST * 4;
    LAS float* wl = (LAS float*)F.lds;
    LAS unsigned* lcnt = (LAS unsigned*)(F.lds + 2 * WCH);
    LAS float* lgs = (LAS float*)(F.lds + 2 * WCH + 256);
    for (int i = F.vcu * NTHR + tid; i < SORT_ROWS; i += F.G * NTHR) sslot[i] = -1;
    if (tid < NEXP) lcnt[tid] = 0u;
    const int i16 = lane & 15, kq = lane >> 4, tile = wave & 3, half = wave >> 2;
    const int per = T / F.G;
    for (int t0 = F.vcu * per; t0 < (F.vcu + 1) * per; t0 += 64) {
        const float* xr = x1 + (size_t)(t0 + 16 * tile + i16) * D + 4 * kq;
        f32x4 acc0 = (f32x4){0.f, 0.f, 0.f, 0.f}, acc1 = acc0; float ss = 0.f;
        f32x4 se[4], sg; float gk[5];
#define RT_LOAD(c) do { _Pragma("unroll") for (int q = 0; q < 4; ++q) { const int f = tid + 512 * q, k = f >> 3; se[q] = *(const GAS f32x4*)(wre + (size_t)(256 * (c) + k) * 32 + 4 * (f & 7)); gk[q] = g2[256 * (c) + k]; } \
            { const int k = tid >> 1; sg = *(const GAS f32x4*)(wrg + (size_t)(256 * (c) + k) * 8 + 4 * (tid & 1)); gk[4] = g2[256 * (c) + k]; } } while (0)
#define RT_WRITE(bf) do { LAS float* wb = wl + (bf) * (WCH / 4); _Pragma("unroll") for (int q = 0; q < 4; ++q) { const int f = tid + 512 * q, k = f >> 3; *(LAS f32x4*)(wb + k * WST + 4 * (f & 7)) = se[q] * gk[q]; } \
            { const int k = tid >> 1; *(LAS f32x4*)(wb + k * WST + 32 + 4 * (tid & 1)) = sg * gk[4]; } } while (0)
        RT_LOAD(0); RT_WRITE(0); __syncthreads();
        for (int c = 0; c < 4; ++c) {
            if (c + 1 < 4) RT_LOAD(c + 1);
            const LAS float* wb = wl + (c & 1) * (WCH / 4) + 4 * kq * WST + i16 + 16 * half;
#pragma unroll 4
            for (int s = 0; s < 16; ++s) {
                const f32x4 a4 = *(const GAS f32x4*)(xr + 256 * c + 16 * s);
                if (half == 0) ss += (a4.x * a4.x + a4.y * a4.y) + (a4.z * a4.z + a4.w * a4.w);
#pragma unroll
                for (int cc = 0; cc < 4; ++cc) { const LAS float* wp = wb + (16 * s + cc) * WST;
                    acc0 = __builtin_amdgcn_mfma_f32_16x16x4f32(a4[cc], wp[0], acc0, 0, 0, 0);
                    if (half == 0) acc1 = __builtin_amdgcn_mfma_f32_16x16x4f32(a4[cc], wp[32 - (i16 & 8)], acc1, 0, 0, 0); }
            }
            if (c + 1 < 4) RT_WRITE((c + 1) & 1);
            __syncthreads();
        }
#undef RT_LOAD
#undef RT_WRITE
        LAS float* lt = lgs + tile * 640;
#pragma unroll
        for (int r = 0; r < 4; ++r) { const int tk = 4 * kq + r; lt[tk * 40 + 8 + 16 * half + i16] = acc0[r]; if (half == 0 && i16 < 8) lt[tk * 40 + i16] = acc1[r]; }
        if (half == 0) { ss += __shfl_xor(ss, 16); ss += __shfl_xor(ss, 32); if (kq == 0) lgs[2560 + 16 * tile + i16] = 1.f / sqrtf(ss * (1.f / D) + EPS); }
        __syncthreads();
        if (half == 0 && lane < 16) {
            const int m = t0 + 16 * tile + lane; const float rstd = lgs[2560 + 16 * tile + lane]; const LAS float* lg = lt + lane * 40;
            float gl[8];
#pragma unroll
            for (int k = 0; k < 8; ++k) gl[k] = lg[k] * rstd + brg[k];
            int gs = 0; float gm = gl[0];
#pragma unroll
            for (int k = 1; k < 8; ++k) if (gl[k] > gm) { gm = gl[k]; gs = k; }
            float den = 0.f;
#pragma unroll
            for (int k = 0; k < 8; ++k) den += __expf(gl[k] - gm);
            const float wgrp = 1.f / den;
            float el[4];
#pragma unroll
            for (int cc = 0; cc < 4; ++cc) el[cc] = lg[8 + 4 * gs + cc] * rstd + bre[4 * gs + cc];
            int i1 = 0; float v1 = el[0];
#pragma unroll
            for (int cc = 1; cc < 4; ++cc) if (el[cc] > v1) { v1 = el[cc]; i1 = cc; }
            int i2 = -1; float v2 = 0.f;
#pragma unroll
            for (int cc = 0; cc < 4; ++cc) if (cc != i1 && (i2 < 0 || el[cc] > v2)) { v2 = el[cc]; i2 = cc; }
            const float e2 = __expf(v2 - v1), w1 = 1.f / (1.f + e2), w2 = e2 / (1.f + e2);
            toke[2 * m] = gs * 4 + i1; toke[2 * m + 1] = gs * 4 + i2; tokw[2 * m] = w1 * wgrp; tokw[2 * m + 1] = w2 * wgrp; rstd2[m] = rstd;
            __hip_atomic_fetch_add(&lcnt[gs * 4 + i1], 1u, __ATOMIC_RELAXED, __HIP_MEMORY_SCOPE_WORKGROUP);
            __hip_atomic_fetch_add(&lcnt[gs * 4 + i2], 1u, __ATOMIC_RELAXED, __HIP_MEMORY_SCOPE_WORKGROUP);
        }
        __syncthreads();
    }
    if (tid < NEXP && lcnt[tid]) __hip_atomic_fetch_add((unsigned*)(F.ctl + CW_CNT + tid), lcnt[tid], RLX_AGENT);
}

__device__ __forceinline__ void p5a2_scatter(Frame& F, const Args& A) {
    const int lane = F_LANE, tid = F_TID;
    const float* x1 = A.out; const float* g2 = A.in[11];
    const int* toke = (const int*)(F.ws + WS_TOKE); const float* tokw = (const float*)(F.ws + WS_TOKW); const float* rstd2 = (const float*)(F.ws + WS_RSTD2);
    int* sslot = (int*)(F.ws + WS_SSLOT); float* sw = (float*)(F.ws + WS_SW); int* t2e = (int*)(F.ws + WS_T2E);
    bf16* AS = (bf16*)(F.ws + WS_ASORT);
    LAS unsigned* sh = (LAS unsigned*)F.lds;
    if (tid < NEXP) sh[256 + tid] = __hip_atomic_load((unsigned*)(F.ctl + CW_CNT + tid), RLX_AGENT);
    __syncthreads();
    if (tid == 0) { unsigned acc = 0u;
        for (int e = 0; e < NEXP; ++e) { const unsigned c = sh[256 + e]; sh[e] = acc; const unsigned nt = (c + 255u) / 256u;
            if (blockIdx.x == 0) for (unsigned i = 0; i < nt; ++i) t2e[acc / 256u + i] = e;
            acc += nt * 256u; }
        if (blockIdx.x == 0) t2e[255] = (int)(acc / 256u); }
    const int per = T / F.G;
    for (int t0 = F.vcu * per; t0 < (F.vcu + 1) * per; t0 += 64) {
        if (tid < NEXP) sh[32 + tid] = 0u;
        __syncthreads();
        int e = 0; unsigned lpos = 0u;
        if (tid < 128) { e = toke[2 * t0 + tid]; lpos = __hip_atomic_fetch_add(&sh[32 + e], 1u, __ATOMIC_RELAXED, __HIP_MEMORY_SCOPE_WORKGROUP); }
        __syncthreads();
        if (tid < NEXP) sh[64 + tid] = sh[tid] + (sh[32 + tid] ? __hip_atomic_fetch_add((unsigned*)(F.ctl + CW_FILL + tid), sh[32 + tid], RLX_AGENT) : 0u);
        __syncthreads();
        if (tid < 128) { const unsigned pos = sh[64 + e] + lpos; sh[96 + tid] = pos; sslot[pos] = 2 * t0 + tid; sw[pos] = tokw[2 * t0 + tid]; }
        __syncthreads();
        for (int tk0 = F_WAVE; tk0 < 64; tk0 += 4 * NWAVES) {
            f32x4 xv[4][4];
#pragma unroll
            for (int r = 0; r < 4; ++r) { const GAS f32x4* xr = (const GAS f32x4*)(x1 + (size_t)(t0 + tk0 + r * NWAVES) * D) + lane;
#pragma unroll
                for (int j = 0; j < 4; ++j) xv[r][j] = xr[64 * j]; }
#pragma unroll
            for (int r = 0; r < 4; ++r) { const int tk = tk0 + r * NWAVES, m = t0 + tk; const float rstd = rstd2[m];
                const unsigned p0 = sh[96 + 2 * tk], p1 = sh[96 + 2 * tk + 1];
#pragma unroll
                for (int j = 0; j < 4; ++j) { const f32x4 g = *((const GAS f32x4*)g2 + lane + 64 * j); const f32x4 y = xv[r][j] * rstd * g; v2u w; w.x = pk2(y.x, y.y); w.y = pk2(y.z, y.w);
                    *((GAS v2u*)(AS + (size_t)p0 * D) + lane + 64 * j) = w; *((GAS v2u*)(AS + (size_t)p1 * D) + lane + 64 * j) = w; } } }
        __syncthreads();
    }
}

__device__ __forceinline__ void p6_final(Frame& F, const Args& A) {
    const int gw = F.vcu * NWAVES + F_WAVE, NGW = F.G * NWAVES, lane = F_LANE;
    const float* gf = A.in[19]; float* out = A.out; const bf16* SL = (const bf16*)(F.ws + WS_SLOTS);
    for (int m0 = gw; m0 < T; m0 += 2 * NGW) {
        f32x4 v[2][4]; v2u a[2][4], c[2][4];
#pragma unroll
        for (int r = 0; r < 2; ++r) { const int m = min(m0 + r * NGW, T - 1); const GAS f32x4* xr = (const GAS f32x4*)(out + (size_t)m * D) + lane;
            const GAS v2u* s0 = (const GAS v2u*)(SL + (size_t)(2 * m) * D) + lane; const GAS v2u* s1 = (const GAS v2u*)(SL + (size_t)(2 * m + 1) * D) + lane;
#pragma unroll
            for (int j = 0; j < 4; ++j) { v[r][j] = xr[64 * j]; a[r][j] = s0[64 * j]; c[r][j] = s1[64 * j]; } }
#pragma unroll
        for (int r = 0; r < 2; ++r) { const int m = m0 + r * NGW; float s = 0.f;
#pragma unroll
            for (int j = 0; j < 4; ++j) { f32x4& w = v[r][j];
                w.x += bflo(a[r][j].x) + bflo(c[r][j].x); w.y += bfhi(a[r][j].x) + bfhi(c[r][j].x); w.z += bflo(a[r][j].y) + bflo(c[r][j].y); w.w += bfhi(a[r][j].y) + bfhi(c[r][j].y);
                s += (w.x * w.x + w.y * w.y) + (w.z * w.z + w.w * w.w); }
            const float rstd = 1.f / sqrtf(wave_sum(s) * (1.f / D) + EPS);
            if (m < T) { GAS f32x4* xo = (GAS f32x4*)(out + (size_t)m * D) + lane;
#pragma unroll
                for (int j = 0; j < 4; ++j) { const f32x4 g = *((const GAS f32x4*)gf + lane + 64 * j); xo[64 * j] = v[r][j] * rstd * g; } } }
    }
}

constexpr int NPHASE = 13;
__global__ void __launch_bounds__(NTHR, 2) mk_fwd(Args args) {
    extern __shared__ __attribute__((aligned(16))) unsigned char lds[];
    Frame F;
    F.lds = (LAS unsigned char*)lds; F.MISC = (volatile LAS unsigned*)(F.lds + MISC_OFF);
        F.G = gridDim.x; { const int bx = blockIdx.x; F.vcu = (F.G % 8 == 0) ? (bx % 8) * (F.G / 8) + bx / 8 : bx; }
    F.ws = args.ws; F.ctl = (gu32*)(args.ws + WS_CTL);
    unsigned char* ws = args.ws;
    if (F_TID < 128) F.MISC[F_TID] = 0u;
    __syncthreads();
    const bool single = (args.ph_hi - args.ph_lo) > 1;
    XcdBarrier bar; bar.bar = (unsigned*)(F.ctl + CW_BAR); bar.x = 0; bar.st = nullptr;
    if (single) bar = xcd_barrier_post((unsigned*)(F.ctl + CW_BAR), F.MISC + 8);
    const int lo = args.ph_lo, hi = args.ph_hi;
#ifdef ONLY
#define IN(k) ((k) == ONLY && lo <= (k) && (k) < hi)
#else
#define IN(k) (lo <= (k) && (k) < hi)
#endif
#ifdef TS_A
#define STAMP(k) do { if (blockIdx.x == 0 && threadIdx.x == 0) ((unsigned long long*)(ws + WS_CTL + 8192))[(k) + 1] = __builtin_amdgcn_s_memrealtime(); } while (0)
#else
#define STAMP(k) do { } while (0)
#endif
#define SEAM(k) do { if (IN((k) + 1)) xcd_barrier(bar); STAMP(k); } while (0)
    const f32x2* rope = (const f32x2*)(ws + WS_ROPE);
    bf16* GA = (bf16*)args.out; bf16* GB = (bf16*)args.out + (size_t)T * 1024;

    STAMP(-1);
    if (IN(0)) { p0_prologue(F, args);
#ifdef REP_P0
        p0_prologue(F, args);
#endif
        SEAM(0); }
    if (IN(1)) {
        pg8::Gemm g{(const bf16*)(ws + WS_H), (const bf16*)(ws + WS_WIN), T, NIN, D, 0}; pg8::StaticOrder S; S.init(T, NIN, F.G, (int)blockIdx.x);
        pg8::EpiIn E{(bf16*)(ws + WS_CQ), (bf16*)(ws + WS_CKV), (bf16*)(ws + WS_QB), (bf16*)(ws + WS_KB), (bf16*)(ws + WS_VB), (bf16*)(ws + WS_QI), (bf16*)(ws + WS_KI), (bf16*)(ws + WS_KR), GA, GB, (float*)(ws + WS_WI), rope};
        pg8::gemm_phase<pg8::EpiIn, pg8::StaticOrder, true, true>(F.lds, g, S, E);
#ifdef REP_P1
        pg8::gemm_phase<pg8::EpiIn, pg8::StaticOrder, true, true>(F.lds, g, S, E);
#endif
        SEAM(1);
    }
    if (IN(2)) { p2a_norms(F, args); SEAM(2); }
    if (IN(3)) {
#ifdef REP_P3
      for (int rep = 0; rep < 2; ++rep) {
#else
      {
#endif
#ifndef NO3A
        { pg8::Gemm g{(const bf16*)(ws + WS_CQ), (const bf16*)(ws + WS_WUQ), T, 768, 384, 0}; pg8::StaticOrder S; S.init(T, 768, F.G, (int)blockIdx.x);
          pg8::EpiQA E{(bf16*)(ws + WS_QA), rope}; pg8::gemm_phase<pg8::EpiQA, pg8::StaticOrder, true, true>(F.lds, g, S, E); }
#endif
#ifndef NO3B
        { pg8::Gemm g{(const bf16*)(ws + WS_CKV), (const bf16*)(ws + WS_WUKV), T, 1024, 256, 0}; pg8::StaticOrder S; S.init(T, 1024, F.G, (int)blockIdx.x);
          pg8::EpiKV E{(bf16*)(ws + WS_KN), (bf16*)(ws + WS_VA)}; pg8::gemm_phase<pg8::EpiKV, pg8::StaticOrder, true, true>(F.lds, g, S, E); }
#endif
      }
        SEAM(3);
    }
    if (IN(4)) {
        unsigned* rdy = (unsigned*)(F.ctl + CW_RDY);
        for (;;) { const int k = wq_next(F, CW_Q1); if (k >= 1536 + CV_QITEMS) break;
            int ltid = threadIdx.x; asm volatile("" : "+v"(ltid));
            const int lw = __builtin_amdgcn_readfirstlane(ltid >> 6);
            if (k < 512) { const int ib = k & 1, ij = 255 - (k >> 1);
                const IdxP IP{(const bf16*)(ws + WS_QI), (const bf16*)(ws + WS_KI), (const float*)(ws + WS_WI), (unsigned*)(ws + WS_BM)};
                idx_item(F.lds, ib, ij, IP, ltid, ltid & 63, lw);
                VM_WAIT(); __syncthreads();
                if (ltid == 0) { __builtin_amdgcn_fence(__ATOMIC_RELEASE, "agent"); VM_WAIT(); __hip_atomic_fetch_add(rdy + 64 * (ib * 32 + (ij >> 3)), 1u, RLX_AGENT); }
                continue; }
            const int j = k - 512; int a;
            if (j < 3 * CV_QITEMS) { const int q3 = j / 3, r3 = j - 3 * q3; a = (r3 == 2) ? -1 - q3 : 2 * q3 + r3; } else a = j - CV_QITEMS;
            if (a < 0) { const int c = -1 - a; LAS float* scr = (LAS float*)(F.lds + lw * 16640);
                conv_tile(args, ws, CV_EARLY + 16 * c + lw, scr, ltid & 63); conv_tile(args, ws, CV_EARLY + 16 * c + 8 + lw, scr, ltid & 63);
                continue; }
            { const int u = a >> 1, ub = (u & 15) >> 3, uh = u & 7, uq = 31 - (u >> 4);
                if (a & 1) { const AttnP APA{(const bf16*)(ws + WS_QA), (const bf16*)(ws + WS_KN), (const bf16*)(ws + WS_KR), (const bf16*)(ws + WS_VA), (bf16*)(ws + WS_OA), nullptr};
                    attn_unit<true>(F.lds, ub, uh, uq, APA, ltid, ltid & 63, lw); }
                else { const AttnP APB{(const bf16*)(ws + WS_QB), (const bf16*)(ws + WS_KB), nullptr, (const bf16*)(ws + WS_VB), (bf16*)(ws + WS_OB), (const unsigned*)(ws + WS_BM)};
                    if (ltid == 0) { unsigned sp = 0u; while (__hip_atomic_load(rdy + 64 * (ub * 32 + uq), RLX_AGENT) < 8u) { __builtin_amdgcn_s_sleep(8); if (++sp > (1u << 22)) break; }
                        __builtin_amdgcn_fence(__ATOMIC_ACQUIRE, "agent"); VM_WAIT(); }
                    __syncthreads();
                    attn_unit<false>(F.lds, ub, uh, uq, APB, ltid, ltid & 63, lw); } }
        }
    }
    if (IN(5)) { SEAM(5); }
    if (IN(6)) {
#ifdef REP_P6
      for (int rep = 0; rep < 2; ++rep) {
#else
      {
#endif
        { pg8::Gemm g{(const bf16*)(ws + WS_OA), (const bf16*)(ws + WS_WOA), T, 1024, 512, 0}; pg8::StaticOrder S; S.init(T, 1024, F.G, (int)blockIdx.x);
          pg8::EpiY<0> E{(bf16*)(ws + WS_Y), GA}; pg8::gemm_phase<pg8::EpiY<0>, pg8::StaticOrder, true, true>(F.lds, g, S, E); }
        { pg8::Gemm g{(const bf16*)(ws + WS_OB), (const bf16*)(ws + WS_WOB), T, 1024, 512, 0}; pg8::StaticOrder S; S.init(T, 1024, F.G, (int)blockIdx.x);
          pg8::EpiY<1> E{(bf16*)(ws + WS_Y), GB}; pg8::gemm_phase<pg8::EpiY<1>, pg8::StaticOrder, true, true>(F.lds, g, S, E); }
      }
        SEAM(6);
    }
    if (IN(7)) {
        pg8::Gemm g{(const bf16*)(ws + WS_Y), (const bf16*)(ws + WS_WOUT), T, 1024, 1024, 0}; pg8::StaticOrder S; S.init(T, 1024, F.G, (int)blockIdx.x);
        pg8::EpiX1 E{args.in[0], args.out}; pg8::gemm_phase<pg8::EpiX1, pg8::StaticOrder, true, true>(F.lds, g, S, E);
#ifdef REP_P7
        pg8::gemm_phase<pg8::EpiX1, pg8::StaticOrder, true, true>(F.lds, g, S, E);
#endif
        SEAM(7);
    }
    if (IN(8)) { p5a_route(F, args); SEAM(8); }
    if (IN(9)) { p5a2_scatter(F, args); SEAM(9); }
    if (IN(10)) {
        const int* t2e = (const int*)(ws + WS_T2E); const int ntl = t2e[255];
        pg8::Gemm g{(const bf16*)(ws + WS_ASORT), (const bf16*)(ws + WS_WGU), SORT_ROWS, 512, 1024, (size_t)512 * 1024 * 2}; pg8::GroupOrder S; S.init(ntl, 2, F.G, (int)blockIdx.x, t2e);
        pg8::EpiHid E{(bf16*)(ws + WS_HID)}; pg8::gemm_phase<pg8::EpiHid, pg8::GroupOrder, true, true>(F.lds, g, S, E);
#ifdef REP_P10
        pg8::gemm_phase<pg8::EpiHid, pg8::GroupOrder, true, true>(F.lds, g, S, E);
#endif
        SEAM(10);
    }
    if (IN(11)) {
        const int* t2e = (const int*)(ws + WS_T2E); const int ntl = t2e[255];
        pg8::Gemm g{(const bf16*)(ws + WS_HID), (const bf16*)(ws + WS_WD), SORT_ROWS, 1024, 256, (size_t)1024 * 256 * 2}; pg8::GroupOrder S; S.init(ntl, 4, F.G, (int)blockIdx.x, t2e);
        pg8::EpiDown E{(bf16*)(ws + WS_SLOTS), (const int*)(ws + WS_SSLOT), (const float*)(ws + WS_SW)}; pg8::gemm_phase<pg8::EpiDown, pg8::GroupOrder, true, true>(F.lds, g, S, E);
#ifdef REP_P11
        pg8::gemm_phase<pg8::EpiDown, pg8::GroupOrder, true, true>(F.lds, g, S, E);
#endif
        SEAM(11);
    }
    if (IN(12)) { p6_final(F, args); }
#ifdef TS_A
    if (blockIdx.x == 0 && threadIdx.x == 0) { STAMP(12); __builtin_amdgcn_s_waitcnt(0);
        const unsigned long long* tsp = (const unsigned long long*)(ws + WS_CTL + 8192);
        const unsigned long long ta = __hip_atomic_load(tsp + (TS_A) + 1, RLX_AGENT), tb = __hip_atomic_load(tsp + (TS_B) + 1, RLX_AGENT);
        const unsigned long long t0 = __builtin_amdgcn_s_memrealtime(), wait = 4ull * (tb - ta);
        while (__builtin_amdgcn_s_memrealtime() - t0 < wait) __builtin_amdgcn_s_sleep(16); }
#endif
#undef IN
#undef SEAM
}

#ifndef MK_MULTI
#define MK_MULTI 0
#endif
extern "C" void kernel_launch(void* const* d_in, const int* in_sizes, int n_in, void* d_out, int out_size, void* d_ws, size_t ws_size, hipStream_t stream) {
    static int grid = 0;
    if (grid == 0) {
        if (n_in != 20 || in_sizes[0] != T * D || out_size != T * D || ws_size < WS_END) { fprintf(stderr, "kernel_launch: unexpected shapes n_in %d in0 %d out %d ws %zu\n", n_in, n_in > 0 ? in_sizes[0] : -1, out_size, ws_size); grid = -1; return; }
        int dev = 0, cus = 0;
        if (hipGetDevice(&dev) != hipSuccess || hipDeviceGetAttribute(&cus, hipDeviceAttributeMultiprocessorCount, dev) != hipSuccess) { grid = -1; return; }
        if (hipFuncSetAttribute((const void*)mk_fwd, hipFuncAttributeMaxDynamicSharedMemorySize, LDS_BYTES) != hipSuccess) { fprintf(stderr, "kernel_launch: hipFuncSetAttribute failed\n"); grid = -1; return; }
        (void)hipGetLastError();
        grid = cus;
    }
    if (grid < 0) return;
    if (hipMemsetAsync((char*)d_ws + WS_CTL, 0, CTL_ZERO_BYTES, stream) != hipSuccess) return;
    Args a{};
    for (int i = 0; i < 20; ++i) a.in[i] = (const float*)d_in[i];
    a.out = (float*)d_out; a.ws = (unsigned char*)d_ws;
#if MK_MULTI
    for (int p = 0; p < NPHASE; ++p) { a.ph_lo = p; a.ph_hi = p + 1; hipLaunchKernelGGL(mk_fwd, dim3(grid), dim3(NTHR), LDS_BYTES, stream, a); }
#else
    a.ph_lo = 0; a.ph_hi = NPHASE;
    hipLaunchKernelGGL(mk_fwd, dim3(grid), dim3(NTHR), LDS_BYTES, stream, a);
#endif
}
```

```cpp
#include <hip/hip_runtime.h>
#include <cstdio>
#include <cstdint>

#define GAS __attribute__((address_space(1)))
#define LAS __attribute__((address_space(3)))
typedef unsigned short bf16;
typedef unsigned v4u __attribute__((ext_vector_type(4)));
typedef unsigned v2u __attribute__((ext_vector_type(2)));
typedef float f32x4 __attribute__((ext_vector_type(4)));
typedef float f32x2 __attribute__((ext_vector_type(2)));
typedef float f32x16 __attribute__((ext_vector_type(16)));
typedef short bf16x8 __attribute__((ext_vector_type(8)));
typedef short s16x4 __attribute__((ext_vector_type(4)));
typedef __bf16 bf16x2_t __attribute__((ext_vector_type(2)));
typedef GAS unsigned gu32;
#define RLX_AGENT __ATOMIC_RELAXED, __HIP_MEMORY_SCOPE_AGENT
#define LDS_WAIT() asm volatile("s_waitcnt lgkmcnt(0)" ::: "memory")
#define VM_WAIT() asm volatile("s_waitcnt vmcnt(0)" ::: "memory")

constexpr int NWAVES = 8, NTHR = NWAVES * 64;
constexpr int BATCH = 2, SEQ = 8192, D = 1024, T = BATCH * SEQ;
constexpr float EPS = 1e-6f;
constexpr int NIN = 4864, NIN_SRC = 4840;
constexpr int C_CQ = 0, C_CKV = 384, C_QB = 640, C_KB = 1152, C_VB = 1664, C_QI = 2176, C_KR = 2688, C_KI = 2720, C_WI = 2784, C_GA = 2816, C_GB = 3840;
constexpr int NEXP = 32, FF = 256;
constexpr int SORT_ROWS = 2 * T + NEXP * 256;
constexpr float LOG2E = 1.4426950408889634f;
constexpr float C2A = 0.10206207261596575f * LOG2E;
constexpr float C2B = 0.125f * LOG2E;
constexpr float WI_SCALE = 0.35355339059327373f * 0.125f;

constexpr size_t MiB = 1u << 20, KiB = 1u << 10;
constexpr size_t WS_CTL = 0, CTL_ZERO_BYTES = 1 * MiB;
constexpr size_t WS_ROPE = 1 * MiB;
constexpr size_t WS_WI = 2 * MiB;
constexpr size_t WS_TOKE = 2 * MiB + 512 * KiB;
constexpr size_t WS_TOKW = WS_TOKE + 128 * KiB;
constexpr size_t WS_RSTD2 = WS_TOKW + 128 * KiB;
constexpr size_t WS_SSLOT = 3 * MiB + 512 * KiB;
constexpr size_t WS_SW = WS_SSLOT + 192 * KiB;
constexpr size_t WS_T2E = WS_SW + 192 * KiB;
constexpr size_t WS_WIN = 4 * MiB, WS_WUQ = 14 * MiB, WS_WUKV = 15 * MiB, WS_WOA = 16 * MiB, WS_WOB = 17 * MiB, WS_WOUT = 18 * MiB, WS_WGU = 20 * MiB, WS_WD = 52 * MiB;
constexpr size_t WS_H = 68 * MiB, WS_OA = 68 * MiB, WS_OB = 84 * MiB;
constexpr size_t WS_QA = 100 * MiB, WS_KN = 124 * MiB, WS_VA = 140 * MiB, WS_Y = 100 * MiB;
constexpr size_t WS_QB = 156 * MiB, WS_KB = 172 * MiB, WS_VB = 188 * MiB;
constexpr size_t WS_CQ = 204 * MiB, WS_CKV = 216 * MiB, WS_BM = 204 * MiB;
constexpr size_t WS_QI = 224 * MiB, WS_KI = 240 * MiB, WS_KR = 242 * MiB;
constexpr size_t WS_ASORT = 68 * MiB, WS_SLOTS = 156 * MiB, WS_HID = 220 * MiB;
constexpr size_t WS_END = 256 * MiB;
constexpr int CW_BAR = 4096;
constexpr int CW_Q1 = 64, CW_Q2 = 128;
constexpr int CW_CNT = 256, CW_FILL = 320;
constexpr int CW_RDY = 8192;

constexpr int LDS_BYTES = 147456;
constexpr int MISC_OFF = 147456 - 512;

__device__ __forceinline__ unsigned f2bf(float f) { unsigned u = __builtin_bit_cast(unsigned, f); return (u + 0x7fffu + ((u >> 16) & 1u)) >> 16; }
__device__ __forceinline__ unsigned pk2(float lo, float hi) { f32x2 v = {lo, hi}; bf16x2_t b = __builtin_convertvector(v, bf16x2_t); return __builtin_bit_cast(unsigned, b); }
__device__ __forceinline__ float bflo(unsigned w) { return __builtin_bit_cast(float, w << 16); }
__device__ __forceinline__ float bfhi(unsigned w) { return __builtin_bit_cast(float, w & 0xffff0000u); }

#define XB_TMO      128
#define XB_XCNT(j)  (256  + 64 * (j))
#define XB_XSUB(j)  (1280 + 64 * (j))
#define XB_XGEN(j)  (2304 + 64 * (j))
#define XB_TOP      3328
#define XB_TOPGEN   3392
#define XCD_BAR_WORDS 3456
#define XB_SPIN_CAP (1u << 22)
__device__ __forceinline__ unsigned xb_ld(unsigned* p)              { return __hip_atomic_load(p, __ATOMIC_RELAXED, __HIP_MEMORY_SCOPE_AGENT); }
__device__ __forceinline__ unsigned xb_add(unsigned* p, unsigned v) { return __hip_atomic_fetch_add(p, v, __ATOMIC_RELAXED, __HIP_MEMORY_SCOPE_AGENT); }
__device__ __forceinline__ unsigned xb_xcc_id() { return (unsigned)__builtin_amdgcn_s_getreg((3 << 11) | 20) & 0xFu; }
#define XB_SPIN(cond, bar) do { unsigned _sp = 0; while (cond) { __builtin_amdgcn_s_sleep(1); \
    if ((++_sp & 255u) == 0u) { if (xb_ld(&(bar)[XB_TMO])) break; if (_sp > XB_SPIN_CAP) { atomicAdd(&(bar)[XB_TMO], 1u); break; } } } } while (0)
struct XcdBarrier { unsigned* bar; unsigned x; volatile LAS unsigned* st; };
__device__ __forceinline__ XcdBarrier xcd_barrier_post(unsigned* bar, volatile LAS unsigned* st) {
    XcdBarrier b; b.bar = bar; b.x = xb_xcc_id(); b.st = st;
    if (threadIdx.x == 0) (void)xb_add(&bar[XB_XCNT(b.x)], 1u);
    return b;
}
__device__ __forceinline__ void xcd_barrier_complete(unsigned* bar, unsigned x, unsigned& nloc, unsigned& nx) {
    const unsigned G = gridDim.x * gridDim.y * gridDim.z;
    unsigned sum, cnt, mine, sp = 0u;
    for (;;) {
        sum = 0u; cnt = 0u; mine = 0u;
#pragma unroll
        for (unsigned j = 0; j < 16; ++j) { const unsigned c = xb_ld(&bar[XB_XCNT(j)]); sum += c; cnt += (c > 0u) ? 1u : 0u; mine = (j == x) ? c : mine; }
        if (sum == G) break;
        __builtin_amdgcn_s_sleep(1);
        if ((++sp & 255u) == 0u) { if (xb_ld(&bar[XB_TMO])) break; if (sp > XB_SPIN_CAP) { atomicAdd(&bar[XB_TMO], 1u); break; } }
    }
    nloc = mine > 0u ? mine : 1u; nx = cnt > 0u ? cnt : 1u;
}
__device__ __forceinline__ void xcd_barrier(const XcdBarrier& b) {
    asm volatile("s_waitcnt vmcnt(0)" ::: "memory");
    __syncthreads();
    if (threadIdx.x == 0) {
        unsigned* bar = b.bar;
        __builtin_amdgcn_s_waitcnt(0);
        unsigned nloc = b.st[0], nx = b.st[1];
        if (nloc == 0u) { xcd_barrier_complete(bar, b.x, nloc, nx); b.st[0] = nloc; b.st[1] = nx; }
        const unsigned old = xb_add(&bar[XB_XSUB(b.x)], 1u);
        const unsigned gen = old / nloc;
        if (old + 1u == (gen + 1u) * nloc) {
            __builtin_amdgcn_fence(__ATOMIC_RELEASE, "agent");
            asm volatile("s_waitcnt vmcnt(0)" ::: "memory");
            const unsigned og = xb_add(&bar[XB_TOP], 1u);
            const unsigned tg = og / nx;
            if (og + 1u == (tg + 1u) * nx) xb_add(&bar[XB_TOPGEN], 1u);
            else XB_SPIN(xb_ld(&bar[XB_TOPGEN]) == tg, bar);
            __builtin_amdgcn_fence(__ATOMIC_ACQUIRE, "agent");
            xb_add(&bar[XB_XGEN(b.x)], 1u);
            asm volatile("s_waitcnt vmcnt(0)" ::: "memory");
        } else {
            XB_SPIN(xb_ld(&bar[XB_XGEN(b.x)]) == gen, bar);
            __builtin_amdgcn_fence(__ATOMIC_ACQUIRE, "agent");
            asm volatile("s_waitcnt vmcnt(0)" ::: "memory");
        }
    }
    __syncthreads();
}

__device__ __forceinline__ float wave_sum(float v) {
#pragma unroll
    for (int o = 1; o < 64; o <<= 1) v += __shfl_xor(v, o);
    return v;
}

namespace pg8 {
#define PG8_LAS __attribute__((address_space(3)))
typedef unsigned short bf16_t;
typedef unsigned u32x4 __attribute__((ext_vector_type(4)));
constexpr int BM = 256, BK = 64, HALF = 128, HTB = HALF * BK * 2, STAGE_BYTES = 8 * HTB, NXCD = 8, WGM = 8;
__host__ __device__ __forceinline__ int lds_byte(int r, int c) { const int st = (r >> 4) * 2 + (c >> 5), rr = r & 15, cc = c & 31, ob = rr * 64 + cc * 2; return st * 1024 + (ob ^ (((ob >> 9) & 1) << 5)); }
__host__ __device__ __forceinline__ void stage_rc(int b, int& R, int& C) { const int st = b / 1024, sb = b % 1024, swz = sb ^ (((sb >> 9) & 1) << 5); R = (st >> 1) * 16 + swz / 64; C = (st & 1) * 32 + (swz % 64) / 2; }
__host__ __device__ __forceinline__ int perm32(int rho) { const int n = rho >> 4, i = rho & 15; return 8 * (i >> 2) + 4 * n + (i & 3); }

struct Unit { int pm, pn, e; };
struct Gemm { const bf16_t* A; const bf16_t* Bt; int M, N, K; size_t estride; };

struct StaticOrder {
    int nM, nN, nwg, G, c;
    __host__ __device__ void init(int M, int N, int G_, int c_) { nM = M / BM; nN = N / BM; nwg = nM * nN; G = G_; c = c_; }
    __host__ __device__ bool next(int i, Unit& u) const {
        const long L = (long)i * G + c; if (L >= nwg) return false;
        int wgid = (int)L; { const int q = nwg / NXCD, r = nwg % NXCD, xcd = wgid % NXCD, off = wgid / NXCD; wgid = (xcd < r ? xcd * (q + 1) : r * (q + 1) + (xcd - r) * q) + off; }
        const int nig = WGM * nN, gid = wgid / nig, fm = gid * WGM, gsz = (nM - fm) < WGM ? (nM - fm) : WGM;
        u.pm = fm + ((wgid % nig) % gsz); u.pn = (wgid % nig) / gsz; u.e = 0; return true;
    }
    __device__ __forceinline__ void a_ready(const Unit&) const {}
    __device__ __forceinline__ void done(const Unit&) const {}
};
struct GroupOrder {
    int nN, total, G, c; const int* t2e;
    __device__ void init(int nTiles, int nN_, int G_, int c_, const int* t2e_) { nN = nN_; total = nTiles * nN_; G = G_; c = c_; t2e = t2e_; }
    __device__ bool next(int i, Unit& u) const {
        const long L = (long)i * G + c; if (L >= total) return false;
        u.pm = (int)(L / nN); u.pn = (int)(L % nN); u.e = __builtin_amdgcn_readfirstlane(t2e[u.pm]); return true;
    }
    __device__ __forceinline__ void a_ready(const Unit&) const {}
    __device__ __forceinline__ void done(const Unit&) const {}
};

__device__ __forceinline__ void st8(bf16_t* p, f32x4 v0, f32x4 v1) { u32x4 w; w.x = pk2(v0[0], v0[1]); w.y = pk2(v0[2], v0[3]); w.z = pk2(v1[0], v1[1]); w.w = pk2(v1[2], v1[3]); *(u32x4*)p = w; }
__device__ __forceinline__ void ld8(const bf16_t* p, f32x4& v0, f32x4& v1) { const u32x4 w = *(const u32x4*)p; v0 = (f32x4){bflo(w.x), bfhi(w.x), bflo(w.y), bfhi(w.y)}; v1 = (f32x4){bflo(w.z), bfhi(w.z), bflo(w.w), bfhi(w.w)}; }

__device__ __forceinline__ void rope16(f32x4& v0, f32x4& v1, int row, int fq, const f32x2* rope) {
    const f32x2* rp = rope + (size_t)(row & (SEQ - 1)) * 16;
    f32x4 p0, p1;
#pragma unroll
    for (int e = 0; e < 4; ++e) { p0[e] = __shfl_xor(v0[e], 16); p1[e] = __shfl_xor(v1[e], 16); }
    if (fq < 2) {
        const float sg = fq == 0 ? -1.f : 1.f;
#pragma unroll
        for (int e = 0; e < 4; ++e) { const f32x2 a = rp[2 * e], b = rp[2 * (4 + e)];
            v0[e] = v0[e] * a.x + sg * p0[e] * a.y; v1[e] = v1[e] * b.x + sg * p1[e] * b.y; }
    }
}
__device__ __forceinline__ void rope32(f32x4& v0, f32x4& v1, int row, int fq, const f32x2* rope) {
    const f32x2* rp = rope + (size_t)(row & (SEQ - 1)) * 16 + 8 * (fq & 1);
    const float sg = fq < 2 ? -1.f : 1.f;
#pragma unroll
    for (int e = 0; e < 4; ++e) { const float p0 = __shfl_xor(v0[e], 32), p1 = __shfl_xor(v1[e], 32); const f32x2 a = rp[e], b = rp[4 + e];
        v0[e] = v0[e] * a.x + sg * p0 * a.y; v1[e] = v1[e] * b.x + sg * p1 * b.y; }
}
__device__ __forceinline__ float sigmoidf_(float x) { return __builtin_amdgcn_rcpf(1.f + __builtin_amdgcn_exp2f(-1.4426950408889634f * x)); }

struct EpiIn {
    static constexpr bool PERM = true, AFTER_DRAIN = false;
    bf16_t *CQ, *CKV, *QB, *KB, *VB, *QI, *KI, *KR, *GA, *GB; float* WI; const f32x2* rope;
    __device__ __forceinline__ void operator()(const f32x4 (&acc)[2][2][4][2], const Unit& u, int wr, int wc, int fr, int fq) const {
        const int row0 = u.pm * BM + wr * 64 + fr;
#pragma unroll
        for (int bj = 0; bj < 2; ++bj) {
            const int cg = u.pn * BM + bj * HALF + wc * 32;
            bf16_t* base = nullptr; int pitch = 0, cc = 0, mode = 0; float sc = 1.f;
            if (cg < C_CKV) { base = CQ; pitch = 384; cc = cg; }
            else if (cg < C_QB) { base = CKV; pitch = 256; cc = cg - C_CKV; }
            else if (cg < C_KB) { base = QB; pitch = 512; cc = cg - C_QB; mode = ((cc >> 5) & 1) == 0 ? 1 : 0; sc = C2B; }
            else if (cg < C_VB) { base = KB; pitch = 512; cc = cg - C_KB; mode = ((cc >> 5) & 1) == 0 ? 1 : 0; }
            else if (cg < C_QI) { base = VB; pitch = 512; cc = cg - C_VB; }
            else if (cg < C_KR) { base = QI; pitch = 512; cc = cg - C_QI; mode = ((cc >> 5) & 1) == 0 ? 1 : 0; }
            else if (cg < C_KI) { base = KR; pitch = 32; cc = 0; mode = 2; }
            else if (cg < C_WI) { base = KI; pitch = 64; cc = cg - C_KI; mode = (cc == 0) ? 1 : 0; }
            else if (cg < C_GA) { mode = 4; }
            else if (cg < C_GB) { base = GA; pitch = 1024; cc = cg - C_GA; mode = 3; }
            else { base = GB; pitch = 1024; cc = cg - C_GB; mode = 3; }
#pragma unroll
            for (int ai = 0; ai < 2; ++ai)
#pragma unroll
                for (int m = 0; m < 4; ++m) {
                    const int row = row0 + ai * HALF + m * 16;
                    f32x4 v0 = acc[ai][bj][m][0], v1 = acc[ai][bj][m][1];
                    if (mode == 1) rope16(v0, v1, row, fq, rope);
                    else if (mode == 2) rope32(v0, v1, row, fq, rope);
                    else if (mode == 3) {
#pragma unroll
                        for (int e = 0; e < 4; ++e) { v0[e] = sigmoidf_(v0[e]); v1[e] = sigmoidf_(v1[e]); } }
                    if (mode == 4) { if (fq == 0) { *(f32x4*)(WI + (size_t)row * 8) = v0 * WI_SCALE; *(f32x4*)(WI + (size_t)row * 8 + 4) = v1 * WI_SCALE; } }
                    else { v0 = v0 * sc; v1 = v1 * sc; st8(base + (size_t)row * pitch + cc + 8 * fq, v0, v1); }
                }
        }
    }
};
struct EpiQA {
    static constexpr bool PERM = true, AFTER_DRAIN = false;
    bf16_t* QA; const f32x2* rope;
    __device__ __forceinline__ void operator()(const f32x4 (&acc)[2][2][4][2], const Unit& u, int wr, int wc, int fr, int fq) const {
        const int row0 = u.pm * BM + wr * 64 + fr;
#pragma unroll
        for (int bj = 0; bj < 2; ++bj) {
            const int cg = u.pn * BM + bj * HALF + wc * 32; const bool rot = ((cg >> 5) % 3) == 2;
#pragma unroll
            for (int ai = 0; ai < 2; ++ai)
#pragma unroll
                for (int m = 0; m < 4; ++m) {
                    const int row = row0 + ai * HALF + m * 16;
                    f32x4 v0 = acc[ai][bj][m][0], v1 = acc[ai][bj][m][1];
                    if (rot) rope32(v0, v1, row, fq, rope);
                    v0 = v0 * C2A; v1 = v1 * C2A; st8(QA + (size_t)row * 768 + cg + 8 * fq, v0, v1);
                }
        }
    }
};
struct EpiKV {
    static constexpr bool PERM = true, AFTER_DRAIN = false;
    bf16_t *KN, *VA;
    __device__ __forceinline__ void operator()(const f32x4 (&acc)[2][2][4][2], const Unit& u, int wr, int wc, int fr, int fq) const {
        const int row0 = u.pm * BM + wr * 64 + fr;
#pragma unroll
        for (int bj = 0; bj < 2; ++bj) {
            const int cg = u.pn * BM + bj * HALF + wc * 32; bf16_t* base = cg < 512 ? KN : VA; const int cc = (cg & 511) + 8 * fq;
#pragma unroll
            for (int ai = 0; ai < 2; ++ai)
#pragma unroll
                for (int m = 0; m < 4; ++m) { const int row = row0 + ai * HALF + m * 16; st8(base + (size_t)row * 512 + cc, acc[ai][bj][m][0], acc[ai][bj][m][1]); }
        }
    }
};
template <int ADD> struct EpiY {
    static constexpr bool PERM = true, AFTER_DRAIN = false;
    bf16_t* Y; const bf16_t* Gt;
    __device__ __forceinline__ void operator()(const f32x4 (&acc)[2][2][4][2], const Unit& u, int wr, int wc, int fr, int fq) const {
        const int row0 = u.pm * BM + wr * 64 + fr;
#pragma unroll
        for (int bj = 0; bj < 2; ++bj) {
            const int c0 = u.pn * BM + bj * HALF + wc * 32 + 8 * fq;
#pragma unroll
            for (int ai = 0; ai < 2; ++ai)
#pragma unroll
                for (int m = 0; m < 4; ++m) { const size_t off = (size_t)(row0 + ai * HALF + m * 16) * 1024 + c0;
                    f32x4 g0, g1; ld8(Gt + off, g0, g1);
                    f32x4 v0 = acc[ai][bj][m][0] * g0, v1 = acc[ai][bj][m][1] * g1;
                    if (ADD) { f32x4 o0, o1; ld8(Y + off, o0, o1); v0 = v0 + o0; v1 = v1 + o1; }
                    st8(Y + off, v0, v1); }
        }
    }
};
struct EpiX1 {
    static constexpr bool PERM = false, AFTER_DRAIN = false;
    const float* X; float* O;
    __device__ __forceinline__ void operator()(const f32x4 (&acc)[2][2][4][2], const Unit& u, int wr, int wc, int fr, int fq) const {
        const int row0 = u.pm * BM + wr * 64 + fr, col0 = u.pn * BM + wc * 32 + 4 * fq;
#pragma unroll
        for (int ai = 0; ai < 2; ++ai)
#pragma unroll
            for (int m = 0; m < 4; ++m) { const size_t off = (size_t)(row0 + ai * HALF + m * 16) * 1024 + col0;
#pragma unroll
                for (int bj = 0; bj < 2; ++bj)
#pragma unroll
                    for (int n = 0; n < 2; ++n) { const f32x4 xv = *(const f32x4*)(X + off + bj * HALF + n * 16); *(f32x4*)(O + off + bj * HALF + n * 16) = xv + acc[ai][bj][m][n]; } }
    }
};
struct EpiHid {
    static constexpr bool PERM = true, AFTER_DRAIN = false;
    bf16_t* HID;
    __device__ __forceinline__ void operator()(const f32x4 (&acc)[2][2][4][2], const Unit& u, int wr, int wc, int fr, int fq) const {
        const int row0 = u.pm * BM + wr * 64 + fr, c0 = u.pn * 128 + wc * 32 + 8 * fq;
#pragma unroll
        for (int ai = 0; ai < 2; ++ai)
#pragma unroll
            for (int m = 0; m < 4; ++m) { f32x4 h0, h1;
#pragma unroll
                for (int e = 0; e < 4; ++e) { const float g0 = acc[ai][0][m][0][e], g1 = acc[ai][0][m][1][e];
                    h0[e] = g0 * sigmoidf_(g0) * acc[ai][1][m][0][e]; h1[e] = g1 * sigmoidf_(g1) * acc[ai][1][m][1][e]; }
                st8(HID + (size_t)(row0 + ai * HALF + m * 16) * 256 + c0, h0, h1); }
    }
};
struct EpiDown {
    static constexpr bool PERM = true, AFTER_DRAIN = false;
    bf16_t* SL; const int* sslot; const float* sw;
    __device__ __forceinline__ void operator()(const f32x4 (&acc)[2][2][4][2], const Unit& u, int wr, int wc, int fr, int fq) const {
        const int row0 = u.pm * BM + wr * 64 + fr;
#pragma unroll
        for (int ai = 0; ai < 2; ++ai)
#pragma unroll
            for (int m = 0; m < 4; ++m) { const int r = row0 + ai * HALF + m * 16; const int slot = sslot[r]; const float w = sw[r];
                if (slot >= 0) {
#pragma unroll
                    for (int bj = 0; bj < 2; ++bj) st8(SL + (size_t)slot * 1024 + u.pn * BM + bj * HALF + wc * 32 + 8 * fq, acc[ai][bj][m][0] * w, acc[ai][bj][m][1] * w); } }
    }
};
template <class Epi, class Sched, bool ALIGN_EPI = false, bool SP2 = false>
__device__ __forceinline__ void gemm_phase(PG8_LAS unsigned char* lds, const Gemm g, const Sched& S, const Epi& E) {
    const int tid = threadIdx.x, wid = __builtin_amdgcn_readfirstlane(tid >> 6), lane = tid & 63, wr = wid >> 2, wc = wid & 3, fr = lane & 15, fq = lane >> 4;
    const int K = g.K, nt = K / BK;
    unsigned voffA[2], voffB[2];
#pragma unroll
    for (int i = 0; i < 2; ++i) { int R, C; stage_rc(tid * 16 + i * 8192, R, C); const int Rb = Epi::PERM ? ((R & ~31) + perm32(R & 31)) : R;
        voffA[i] = (unsigned)(R * K + C) * 2u; voffB[i] = (unsigned)(Rb * K + C) * 2u; }
    const size_t kstep = (size_t)(BK * 2);
    const size_t hstep = (size_t)HALF * K * 2;
    const size_t tstep = 2 * hstep;
    const unsigned ldsw = (unsigned)wid * 1024u;
    const int aoff = lds_byte(wr * 64 + fr, fq * 8), boff = lds_byte(wc * 32 + fr, fq * 8);
#define PG8_SA(b, h) (((b) * 2 + (h)) * HTB)
#define PG8_SB(b, h) ((4 + (b) * 2 + (h)) * HTB)
#define PG8_STAGE(bufoff, gbase, voff) do { _Pragma("unroll") for (int _i = 0; _i < 2; ++_i) \
        __builtin_amdgcn_global_load_lds((const unsigned*)((const char*)(gbase) + (voff)[_i]), (PG8_LAS unsigned*)(lds + (bufoff) + ldsw + _i * 8192), 16, 0, 0); } while (0)
#define PG8_LDA(dst, b, h) do { _Pragma("unroll") for (int m = 0; m < 4; ++m) _Pragma("unroll") for (int k = 0; k < 2; ++k) dst[m][k] = *(const PG8_LAS bf16x8*)(lds + PG8_SA(b, h) + aoff + m * 2048 + k * 1024); } while (0)
#define PG8_LDB(dst, b, h) do { _Pragma("unroll") for (int n = 0; n < 2; ++n) _Pragma("unroll") for (int k = 0; k < 2; ++k) dst[n][k] = *(const PG8_LAS bf16x8*)(lds + PG8_SB(b, h) + boff + n * 2048 + k * 1024); } while (0)
#define PG8_MMA(ai, bj, At, Bt) do { __builtin_amdgcn_s_setprio(1); _Pragma("unroll") for (int m = 0; m < 4; ++m) _Pragma("unroll") for (int n = 0; n < 2; ++n) _Pragma("unroll") for (int k = 0; k < 2; ++k) \
        acc[ai][bj][m][n] = __builtin_amdgcn_mfma_f32_16x16x32_bf16(Bt[n][k], At[m][k], acc[ai][bj][m][n], 0, 0, 0); __builtin_amdgcn_s_setprio(0); } while (0)
#define PG8_WAIT_V(n) asm volatile("s_waitcnt vmcnt(" #n ")" ::: "memory")
#define PG8_WAIT_L(n) asm volatile("s_waitcnt lgkmcnt(" #n ")" ::: "memory")
#define PG8_BAR __builtin_amdgcn_s_barrier()
#define PG8_SCHED __builtin_amdgcn_sched_barrier(0)
    Unit cur, nxt; int ui = 0;
    if (!S.next(0, cur)) return;
    f32x4 acc[2][2][4][2];
#pragma unroll
    for (int a = 0; a < 2; ++a)
#pragma unroll
        for (int b = 0; b < 2; ++b)
#pragma unroll
            for (int m = 0; m < 4; ++m)
#pragma unroll
                for (int n = 0; n < 2; ++n) acc[a][b][m][n] = (f32x4){0.f, 0.f, 0.f, 0.f};
    bf16x8 At[4][2], B0[2][2], B1[2][2];
    const char* cA = (const char*)g.A + (size_t)cur.pm * tstep; const char* cB = (const char*)g.Bt + (size_t)cur.e * g.estride + (size_t)cur.pn * tstep;
    S.a_ready(cur);
    if constexpr (SP2) {
        PG8_STAGE(PG8_SB(0, 0), cB, voffB); PG8_STAGE(PG8_SB(0, 1), cB + hstep, voffB); PG8_STAGE(PG8_SA(0, 0), cA, voffA); PG8_STAGE(PG8_SA(0, 1), cA + hstep, voffA);
        if (wr == 1) PG8_BAR;
        PG8_WAIT_V(2); PG8_BAR;
        PG8_STAGE(PG8_SB(1, 0), cB + kstep, voffB); PG8_STAGE(PG8_SA(1, 0), cA + kstep, voffA); PG8_STAGE(PG8_SB(1, 1), cB + hstep + kstep, voffB);
        PG8_WAIT_V(6); PG8_BAR;
    } else {
        PG8_STAGE(PG8_SB(0, 0), cB, voffB); PG8_STAGE(PG8_SA(0, 0), cA, voffA); PG8_STAGE(PG8_SB(0, 1), cB + hstep, voffB); PG8_STAGE(PG8_SA(0, 1), cA + hstep, voffA);
        if (wr == 1) PG8_BAR;
        PG8_WAIT_V(4); PG8_BAR;
        PG8_STAGE(PG8_SB(1, 0), cB + kstep, voffB); PG8_STAGE(PG8_SA(1, 0), cA + kstep, voffA); PG8_STAGE(PG8_SB(1, 1), cB + hstep + kstep, voffB);
        PG8_WAIT_V(6); PG8_BAR;
    }
    for (;;) {
        const bool has_next = S.next(ui + 1, nxt);
        const char* nA = has_next ? (const char*)g.A + (size_t)nxt.pm * tstep : cA; const char* nB = has_next ? (const char*)g.Bt + (size_t)nxt.e * g.estride + (size_t)nxt.pn * tstep : cB;
#pragma nounroll
        for (int t = 0; t < nt; t += 2) {
            const bool last = (t == nt - 2);
            const char* a1 = cA + (size_t)(t + 1) * kstep;
            const char* a2 = last ? nA : cA + (size_t)(t + 2) * kstep; const char* b2 = last ? nB : cB + (size_t)(t + 2) * kstep;
            const char* a3 = a2 + kstep; const char* b3 = b2 + kstep;
            if (last && has_next) S.a_ready(nxt);
            if constexpr (SP2) {
            PG8_LDB(B0, 0, 0); PG8_LDB(B1, 0, 1); PG8_SCHED; PG8_LDA(At, 0, 0); PG8_STAGE(PG8_SA(1, 1), a1 + hstep, voffA);
            PG8_WAIT_V(8); PG8_WAIT_L(0); PG8_BAR; PG8_MMA(0, 0, At, B0); PG8_MMA(0, 1, At, B1); PG8_BAR; PG8_SCHED;
            PG8_LDA(At, 0, 1); PG8_STAGE(PG8_SB(0, 0), b2, voffB); PG8_STAGE(PG8_SB(0, 1), b2 + hstep, voffB); PG8_STAGE(PG8_SA(0, 0), a2, voffA);
            PG8_WAIT_V(8); PG8_WAIT_L(0); PG8_BAR; PG8_MMA(1, 0, At, B0); PG8_MMA(1, 1, At, B1); PG8_BAR; PG8_SCHED;
            PG8_LDB(B0, 1, 0); PG8_LDB(B1, 1, 1); PG8_SCHED; PG8_LDA(At, 1, 0); PG8_STAGE(PG8_SA(0, 1), a2 + hstep, voffA);
            PG8_WAIT_V(8); PG8_WAIT_L(0); PG8_BAR; PG8_MMA(0, 0, At, B0); PG8_MMA(0, 1, At, B1); PG8_BAR; PG8_SCHED;
            PG8_LDA(At, 1, 1); PG8_STAGE(PG8_SB(1, 0), b3, voffB); PG8_STAGE(PG8_SB(1, 1), b3 + hstep, voffB); PG8_STAGE(PG8_SA(1, 0), a3, voffA);
            PG8_WAIT_V(8); PG8_WAIT_L(0); PG8_BAR; PG8_MMA(1, 0, At, B0); PG8_MMA(1, 1, At, B1); PG8_BAR; PG8_SCHED;
            } else {
            PG8_LDB(B0, 0, 0); PG8_SCHED; PG8_LDA(At, 0, 0); PG8_STAGE(PG8_SA(1, 1), a1 + hstep, voffA);
            PG8_WAIT_L(8); PG8_BAR; PG8_WAIT_L(0); PG8_MMA(0, 0, At, B0); PG8_BAR; PG8_SCHED;
            PG8_LDB(B1, 0, 1); PG8_STAGE(PG8_SB(0, 0), b2, voffB);
            PG8_BAR; PG8_WAIT_L(0); PG8_MMA(0, 1, At, B1); PG8_BAR;
            PG8_LDA(At, 0, 1); PG8_STAGE(PG8_SA(0, 0), a2, voffA);
            PG8_BAR; PG8_WAIT_L(0); PG8_MMA(1, 0, At, B0); PG8_BAR; PG8_SCHED;
            PG8_STAGE(PG8_SB(0, 1), b2 + hstep, voffB);
            PG8_WAIT_V(6); PG8_BAR; PG8_MMA(1, 1, At, B1); PG8_BAR;
            PG8_LDB(B0, 1, 0); PG8_SCHED; PG8_LDA(At, 1, 0); PG8_STAGE(PG8_SA(0, 1), a2 + hstep, voffA);
            PG8_WAIT_L(8); PG8_BAR; PG8_WAIT_L(0); PG8_MMA(0, 0, At, B0); PG8_BAR; PG8_SCHED;
            PG8_LDB(B1, 1, 1); PG8_STAGE(PG8_SB(1, 0), b3, voffB);
            PG8_BAR; PG8_WAIT_L(0); PG8_MMA(0, 1, At, B1); PG8_BAR;
            PG8_LDA(At, 1, 1); PG8_STAGE(PG8_SA(1, 0), a3, voffA);
            PG8_BAR; PG8_WAIT_L(0); PG8_MMA(1, 0, At, B0); PG8_BAR; PG8_SCHED;
            PG8_STAGE(PG8_SB(1, 1), b3 + hstep, voffB);
            PG8_WAIT_V(6); PG8_BAR; PG8_MMA(1, 1, At, B1); PG8_BAR;
            }
        }
        if constexpr (ALIGN_EPI) { if (wr == 0) PG8_BAR; }
        if constexpr (!Epi::AFTER_DRAIN) { E(acc, cur, wr, wc, fr, fq); S.done(cur); }
        if (!has_next) break;
#pragma unroll
        for (int a = 0; a < 2; ++a)
#pragma unroll
            for (int b = 0; b < 2; ++b)
#pragma unroll
                for (int m = 0; m < 4; ++m)
#pragma unroll
                    for (int n = 0; n < 2; ++n) acc[a][b][m][n] = (f32x4){0.f, 0.f, 0.f, 0.f};
        cur = nxt; cA = nA; cB = nB; ++ui;
        if constexpr (ALIGN_EPI) { if (wr == 1) PG8_BAR; }
    }
    PG8_WAIT_V(0);
    if constexpr (!ALIGN_EPI) { if (wr == 0) PG8_BAR; }
    PG8_BAR;
    if constexpr (Epi::AFTER_DRAIN) { E.fused(acc, cur, wr, wc, fr, fq, lds, wid, lane); S.done(cur); }
#undef PG8_SA
#undef PG8_SB
#undef PG8_STAGE
#undef PG8_LDA
#undef PG8_LDB
#undef PG8_MMA
#undef PG8_WAIT_V
#undef PG8_WAIT_L
#undef PG8_BAR
#undef PG8_SCHED
}
}

struct Args { const float* in[20]; float* out; unsigned char* ws; int ph_lo, ph_hi; };
struct Frame {
    LAS unsigned char* lds; volatile LAS unsigned* MISC; gu32* ctl; unsigned char* ws;
    int vcu, G;
};
#define F_TID ((int)threadIdx.x)
#define F_LANE ((int)(threadIdx.x & 63))
#define F_WAVE (__builtin_amdgcn_readfirstlane((int)(threadIdx.x >> 6)))

__device__ __forceinline__ int in_src_col(int n) {
    if (n < 640) return n;
    if (n < 2688) return n + 32;
    if (n < 2720) return n - 2688 + 640;
    if (n < 2792) return n;
    if (n < 2816) return -1;
    return n - 24;
}
struct TrDesc { const float* colptr; int ld, k0; bf16* WT; int Kd, destrow0; };
__device__ __forceinline__ void tr_load(const TrDesc& d, int lane, f32x4 (&v)[16]) {
    const int kr = lane >> 4;
#pragma unroll
    for (int it = 0; it < 16; ++it) { const int kk = 4 * it + kr; v[it] = (f32x4){0.f, 0.f, 0.f, 0.f}; if (d.colptr) v[it] = *(const GAS f32x4*)(d.colptr + (size_t)(d.k0 + kk) * d.ld); }
}
__device__ __forceinline__ void tr_store(const TrDesc& d, int lane, const f32x4 (&v)[16], LAS float* scr) {
    const int nq = lane & 15, kr = lane >> 4;
#pragma unroll
    for (int it = 0; it < 16; ++it) { const int kk = 4 * it + kr; LAS float* q = scr + kk * 65 + 4 * nq; q[0] = v[it].x; q[1] = v[it].y; q[2] = v[it].z; q[3] = v[it].w; }
    LDS_WAIT(); asm volatile("" ::: "memory");
    const int c = lane & 7;
#pragma unroll
    for (int j = 0; j < 8; ++j) { const int n = (lane >> 3) + 8 * j; const LAS float* q = scr + (8 * c) * 65 + n;
        v4u o; o.x = pk2(q[0 * 65], q[1 * 65]); o.y = pk2(q[2 * 65], q[3 * 65]); o.z = pk2(q[4 * 65], q[5 * 65]); o.w = pk2(q[6 * 65], q[7 * 65]);
        *(GAS v4u*)(d.WT + (size_t)(d.destrow0 + n) * d.Kd + d.k0 + 8 * c) = o; }
    LDS_WAIT(); asm volatile("" ::: "memory");
}
constexpr int CV_I0 = 16 * 76, CV_I1 = 6 * 12, CV_I2 = 4 * 16, CV_I3 = 8 * 16, CV_I4 = 8 * 16, CV_I5 = 16 * 16, CV_I6 = 32 * 16 * 8, CV_I7 = 32 * 4 * 16;
constexpr int CV_EARLY = CV_I0 + CV_I1 + CV_I2, CV_LATE = CV_I3 + CV_I4 + CV_I5 + CV_I6 + CV_I7, CV_QITEMS = CV_LATE / 16;
static_assert(CV_LATE % 16 == 0, "late conversion tiles come in queue items of 16");
__device__ __forceinline__ TrDesc conv_desc(const Args& A, unsigned char* ws, int it, int lane) {
    const int n4 = 4 * (lane & 15);
    int r = it;
    if (r < CV_I0) { const int kb = r / 76, nb = r % 76; const int col = in_src_col(64 * nb + n4);
        return TrDesc{col >= 0 ? A.in[2] + col : nullptr, NIN_SRC, 64 * kb, (bf16*)(ws + WS_WIN), 1024, 64 * nb}; } r -= CV_I0;
    if (r < CV_I1) { const int kb = r / 12, nb = r % 12; return TrDesc{A.in[4] + 64 * nb + n4, 768, 64 * kb, (bf16*)(ws + WS_WUQ), 384, 64 * nb}; } r -= CV_I1;
    if (r < CV_I2) { const int kb = r / 16, nb = r % 16; const int n = 64 * nb + n4;
        return TrDesc{n < 512 ? A.in[6] + n : A.in[7] + (n - 512), 512, 64 * kb, (bf16*)(ws + WS_WUKV), 256, 64 * nb}; } r -= CV_I2;
    if (r < CV_I3) { const int kb = r / 16, nb = r % 16; return TrDesc{A.in[8] + 64 * nb + n4, 1024, 64 * kb, (bf16*)(ws + WS_WOA), 512, 64 * nb}; } r -= CV_I3;
    if (r < CV_I4) { const int kb = r / 16, nb = r % 16; return TrDesc{A.in[9] + 64 * nb + n4, 1024, 64 * kb, (bf16*)(ws + WS_WOB), 512, 64 * nb}; } r -= CV_I4;
    if (r < CV_I5) { const int kb = r / 16, nb = r % 16; return TrDesc{A.in[10] + 64 * nb + n4, 1024, 64 * kb, (bf16*)(ws + WS_WOUT), 1024, 64 * nb}; } r -= CV_I5;
    if (r < CV_I6) { const int e = r / 128, rr = r % 128, kb = rr / 8, nb = rr % 8; const int n = 64 * nb + n4, pn = n >> 8, c = n & 255, col = 128 * pn + (c & 127);
        const float* src = ((c >> 7) ? A.in[17] : A.in[16]) + (size_t)e * 1024 * 256 + col;
        return TrDesc{src, 256, 64 * kb, (bf16*)(ws + WS_WGU) + (size_t)e * 512 * 1024, 1024, 64 * nb}; } r -= CV_I6;
    { const int e = r / 64, rr = r % 64, kb = rr / 16, nb = rr % 16;
        return TrDesc{A.in[18] + (size_t)e * 256 * 1024 + 64 * nb + n4, 1024, 64 * kb, (bf16*)(ws + WS_WD) + (size_t)e * 1024 * 256, 256, 64 * nb}; }
}
__device__ __forceinline__ void conv_tile(const Args& A, unsigned char* ws, int it, LAS float* scr, int lane) {
    const TrDesc d = conv_desc(A, ws, it, lane); f32x4 v[16]; tr_load(d, lane, v); tr_store(d, lane, v, scr);
}
__device__ __forceinline__ void conv_tile2(const Args& A, unsigned char* ws, int it0, int it1, LAS float* scr, int lane) {
    const TrDesc d0 = conv_desc(A, ws, it0, lane), d1 = conv_desc(A, ws, it1, lane); f32x4 v0[16], v1[16];
    tr_load(d0, lane, v0); tr_load(d1, lane, v1); tr_store(d0, lane, v0, scr); tr_store(d1, lane, v1, scr);
}
__device__ __forceinline__ void p0_prologue(Frame& F, const Args& A) {
    LAS float* scr = (LAS float*)(F.lds + F_WAVE * 16640);
    const int gw = F.vcu * NWAVES + F_WAVE, NGW = F.G * NWAVES, lane = F_LANE;
    unsigned char* ws = F.ws;
#ifdef CONV_IN_P0
    for (int it = gw; it < CV_EARLY + CV_LATE; it += NGW) conv_tile(A, ws, it, scr, lane);
#else
    for (int it = gw; it < CV_EARLY; it += NGW) conv_tile(A, ws, it, scr, lane);
#endif
    const float* x = A.in[0]; const float* g1 = A.in[1]; bf16* H = (bf16*)(ws + WS_H);
    for (int m0 = gw; m0 < T; m0 += 4 * NGW) {
        f32x4 v[4][4];
#pragma unroll
        for (int r = 0; r < 4; ++r) { const int m = min(m0 + r * NGW, T - 1); const GAS f32x4* xr = (const GAS f32x4*)(x + (size_t)m * D) + lane;
#pragma unroll
            for (int j = 0; j < 4; ++j) v[r][j] = xr[64 * j]; }
#pragma unroll
        for (int r = 0; r < 4; ++r) { const int m = m0 + r * NGW; float s = 0.f;
#pragma unroll
            for (int j = 0; j < 4; ++j) s += (v[r][j].x * v[r][j].x + v[r][j].y * v[r][j].y) + (v[r][j].z * v[r][j].z + v[r][j].w * v[r][j].w);
            const float rstd = 1.f / sqrtf(wave_sum(s) * (1.f / D) + EPS);
            if (m < T) { GAS v2u* o8 = (GAS v2u*)(H + (size_t)m * D) + lane;
#pragma unroll
                for (int j = 0; j < 4; ++j) { const f32x4 g = *((const GAS f32x4*)g1 + lane + 64 * j); const f32x4 y = v[r][j] * rstd * g; v2u w; w.x = pk2(y.x, y.y); w.y = pk2(y.z, y.w); o8[64 * j] = w; } } }
    }
    f32x2* rope = (f32x2*)(ws + WS_ROPE);
    for (int idx = (F.vcu * NTHR + F_TID); idx < SEQ * 16; idx += F.G * NTHR) {
        const int pos = idx >> 4, i = idx & 15;
        const double REV[16] = {0.15915494309189535, 0.0700865215877985, 0.03086376340470123, 0.013591370636193905, 0.005985185712713705, 0.002635675898667414, 0.001160663641240061, 0.0005111175045375439,
                                0.00022507907903927653, 9.911730936901935e-05, 4.364795279280289e-05, 1.9221100684944863e-05, 8.464330808241401e-06, 3.727408601915352e-06, 1.6414262627950345e-06, 7.228293068832865e-07};
        double rv = 0.0;
#pragma unroll
        for (int k = 0; k < 16; ++k) rv = (i == k) ? REV[k] : rv;
        double t = (double)pos * rv; t -= __builtin_floor(t);
        const float tf = (float)t;
        rope[idx] = (f32x2){__builtin_amdgcn_cosf(tf), __builtin_amdgcn_sinf(tf)};
    }
}

__device__ __forceinline__ void p2a_norms(Frame& F, const Args& A) {
    const int gw = F.vcu * NWAVES + F_WAVE, NGW = F.G * NWAVES, lane = F_LANE;
    bf16* CQ = (bf16*)(F.ws + WS_CQ); bf16* CKV = (bf16*)(F.ws + WS_CKV);
    const float* gq = A.in[3]; const float* gkv = A.in[5];
    for (int m = gw; m < T; m += NGW) {
        {
            GAS unsigned* p = (GAS unsigned*)(CQ + (size_t)m * 384) + lane; unsigned w[3]; float s = 0.f;
#pragma unroll
            for (int j = 0; j < 3; ++j) { w[j] = p[64 * j]; const float a = bflo(w[j]), b = bfhi(w[j]); s += a * a + b * b; }
            const float rstd = 1.f / sqrtf(wave_sum(s) * (1.f / 384.f) + EPS);
#pragma unroll
            for (int j = 0; j < 3; ++j) { const f32x2 g = *((const GAS f32x2*)gq + lane + 64 * j); p[64 * j] = pk2(bflo(w[j]) * rstd * g.x, bfhi(w[j]) * rstd * g.y); }
        }
        {
            GAS v2u* p = (GAS v2u*)(CKV + (size_t)m * 256) + lane; const v2u w = *p;
            const float a = bflo(w.x), b = bfhi(w.x), c = bflo(w.y), d = bfhi(w.y);
            const float rstd = 1.f / sqrtf(wave_sum(a * a + b * b + c * c + d * d) * (1.f / 256.f) + EPS);
            const f32x4 g = *((const GAS f32x4*)gkv + lane); v2u o; o.x = pk2(a * rstd * g.x, b * rstd * g.y); o.y = pk2(c * rstd * g.z, d * rstd * g.w); *p = o;
        }
    }
}

__device__ __forceinline__ constexpr int crow(int r, int hi) { return (r & 3) + 8 * (r >> 2) + 4 * hi; }
constexpr float ATT_THR = 8.f;
__device__ __forceinline__ float att_mask(float p, unsigned w, int bit) { int mk; unsigned r;
    asm("v_bfe_i32 %0, %1, %2, 1" : "=v"(mk) : "v"(w), "i"(bit)); r = __builtin_bit_cast(unsigned, p) & (unsigned)mk; return __builtin_bit_cast(float, r); }
struct AttnP { const bf16 *Q, *K, *K2, *V; bf16* O; const unsigned* BM; };
template <bool MLA> __device__ __forceinline__ void attn_unit(LAS unsigned char* L, int b, int h, int qb, const AttnP& P, int tid, int lane, int wave) {
    constexpr int DK = MLA ? 96 : 64, KP = DK * 2 + 16, NS = DK / 16, CPR = DK / 8;
    constexpr int QPITCH = MLA ? 768 : 512, VP = 192, KBUF = 64 * KP, VBUF = 64 * VP;
    const int r32 = lane & 31, hi = lane >> 5;
    const size_t rowb = (size_t)b * SEQ;
    const int qrow = qb * 256 + wave * 32 + r32;
    bf16x8 qf[NS];
    { const bf16* qp = P.Q + (rowb + qrow) * QPITCH + h * DK;
#pragma unroll
      for (int s = 0; s < NS; ++s) qf[s] = *(const bf16x8*)(qp + 16 * s + 8 * hi); }
    const int NT = 4 * qb + 4, my_nt = 4 * qb + (wave >> 1) + 1;
    const int kid0 = tid, kid1 = tid + NTHR;
    const int kr0 = kid0 / CPR, kc0 = kid0 % CPR, kr1 = kid1 / CPR, kc1 = kid1 % CPR; const bool has1 = MLA && (kid1 < 64 * CPR);
    const int vr = tid >> 3, vc = tid & 7;
    v4u kreg0, kreg1 = (v4u){0u, 0u, 0u, 0u}, vreg;
#define ATT_KSRC(t, kr, kc) (MLA ? ((kc) < 8 ? (const v4u*)(P.K + (rowb + 64 * (t) + (kr)) * 512 + h * 64 + 8 * (kc)) : (const v4u*)(P.K2 + (rowb + 64 * (t) + (kr)) * 32 + 8 * ((kc) - 8))) \
                                 : (const v4u*)(P.K + (rowb + 64 * (t) + (kr)) * 512 + h * 64 + 8 * (kc)))
#define ATT_LOAD(t) do { kreg0 = *ATT_KSRC(t, kr0, kc0); if (has1) kreg1 = *ATT_KSRC(t, kr1, kc1); vreg = *(const v4u*)(P.V + (rowb + 64 * (t) + vr) * 512 + h * 64 + 8 * vc); } while (0)
#define ATT_WRITE(buf) do { *(LAS v4u*)(L + (buf) * KBUF + kr0 * KP + kc0 * 16) = kreg0; if (has1) *(LAS v4u*)(L + (buf) * KBUF + kr1 * KP + kc1 * 16) = kreg1; \
                            *(LAS v4u*)(L + 2 * KBUF + (buf) * VBUF + vr * VP + vc * 16) = vreg; } while (0)
    float mhat = 0.f, l = 0.f; f32x16 o0, o1, negm;
#pragma unroll
    for (int i = 0; i < 16; ++i) { o0[i] = 0.f; o1[i] = 0.f; negm[i] = 0.f; }
    const int g16 = lane >> 4, qq = (lane & 15) >> 2, pp = lane & 3;
    const int vlane = (4 * hi + qq) * VP + (16 * (g16 & 1) + 4 * pp) * 2;
    ATT_LOAD(0); ATT_WRITE(0); __syncthreads();
    unsigned wn0 = 0xffffffffu, wn1 = 0xffffffffu;
    const unsigned* bmq = MLA ? nullptr : P.BM + (size_t)b * 256 * SEQ + qrow;
    if (!MLA) { wn0 = bmq[0]; wn1 = bmq[SEQ]; }
    for (int t = 0; t < NT; ++t) {
        const int buf = t & 1;
        unsigned w0 = wn0 >> (4 * hi), w1 = wn1 >> (4 * hi);
        if (t + 1 < NT) { ATT_LOAD(t + 1); if (!MLA) { wn0 = bmq[(size_t)(2 * t + 2) * SEQ]; wn1 = bmq[(size_t)(2 * t + 3) * SEQ]; } }
        if (t < my_nt) {
            const LAS unsigned char* Kb = L + buf * KBUF; const LAS unsigned char* Vb = L + 2 * KBUF + buf * VBUF;
            f32x16 s0, s1;
            bf16x8 ka[NS][2];
#pragma unroll
            for (int s = 0; s < NS; ++s) { ka[s][0] = *(const LAS bf16x8*)(Kb + r32 * KP + s * 32 + hi * 16); ka[s][1] = *(const LAS bf16x8*)(Kb + (32 + r32) * KP + s * 32 + hi * 16); }
            __builtin_amdgcn_sched_barrier(0);
#pragma unroll
            for (int s = 0; s < NS; ++s) {
                s0 = __builtin_amdgcn_mfma_f32_32x32x16_bf16(ka[s][0], qf[s], s == 0 ? negm : s0, 0, 0, 0);
                s1 = __builtin_amdgcn_mfma_f32_32x32x16_bf16(ka[s][1], qf[s], s == 0 ? negm : s1, 0, 0, 0);
            }
            s16x4 vf[4][4];
#pragma unroll
            for (int ks = 0; ks < 4; ++ks) { const LAS unsigned char* vp = Vb + ks * 16 * VP + vlane;
                vf[ks][0] = __builtin_bit_cast(s16x4, __builtin_amdgcn_ds_read_tr16_b64_v4i16((LAS s16x4*)(vp)));
                vf[ks][1] = __builtin_bit_cast(s16x4, __builtin_amdgcn_ds_read_tr16_b64_v4i16((LAS s16x4*)(vp + 8 * VP)));
                vf[ks][2] = __builtin_bit_cast(s16x4, __builtin_amdgcn_ds_read_tr16_b64_v4i16((LAS s16x4*)(vp + 64)));
                vf[ks][3] = __builtin_bit_cast(s16x4, __builtin_amdgcn_ds_read_tr16_b64_v4i16((LAS s16x4*)(vp + 8 * VP + 64))); }
            __builtin_amdgcn_sched_barrier(0);
            float mx = fmaxf(fmaxf(s0[0], s0[1]), s1[0]);
#pragma unroll
            for (int i = 2; i < 16; i += 2) mx = fmaxf(fmaxf(mx, s0[i]), s0[i + 1]);
#pragma unroll
            for (int i = 1; i < 15; i += 2) mx = fmaxf(fmaxf(mx, s1[i]), s1[i + 1]);
            mx = fmaxf(mx, s1[15]);
            mx = fmaxf(mx, __shfl_xor(mx, 32));
            if (t == 0 || __any(mx > ATT_THR)) {
                const float dl = (t == 0) ? mx : fmaxf(mx, 0.f), f = (t == 0) ? 1.f : __builtin_amdgcn_exp2f(-dl);
                mhat += dl; l *= f;
#pragma unroll
                for (int i = 0; i < 16; ++i) { s0[i] -= dl; s1[i] -= dl; o0[i] *= f; o1[i] *= f; negm[i] = -mhat; }
            }
            float rs = 0.f;
#pragma unroll
            for (int i = 0; i < 16; ++i) {
                float p0 = __builtin_amdgcn_exp2f(s0[i]), p1 = __builtin_amdgcn_exp2f(s1[i]);
                if (!MLA) { p0 = att_mask(p0, w0, crow(i, 0)); p1 = att_mask(p1, w1, crow(i, 0)); }
                s0[i] = p0; s1[i] = p1; rs += p0 + p1; }
            l += rs;
            bf16x8 pf[4];
#pragma unroll
            for (int ks = 0; ks < 4; ++ks) { v4u w;
#pragma unroll
                for (int j = 0; j < 4; ++j) { const float a = (ks < 2) ? s0[8 * (ks & 1) + 2 * j] : s1[8 * (ks & 1) + 2 * j], c = (ks < 2) ? s0[8 * (ks & 1) + 2 * j + 1] : s1[8 * (ks & 1) + 2 * j + 1]; w[j] = pk2(a, c); }
                pf[ks] = __builtin_bit_cast(bf16x8, w); }
#pragma unroll
            for (int ks = 0; ks < 4; ++ks) {
                const bf16x8 A0 = __builtin_shufflevector(vf[ks][0], vf[ks][1], 0, 1, 2, 3, 4, 5, 6, 7);
                const bf16x8 A1 = __builtin_shufflevector(vf[ks][2], vf[ks][3], 0, 1, 2, 3, 4, 5, 6, 7);
                o0 = __builtin_amdgcn_mfma_f32_32x32x16_bf16(A0, pf[ks], o0, 0, 0, 0);
                o1 = __builtin_amdgcn_mfma_f32_32x32x16_bf16(A1, pf[ks], o1, 0, 0, 0);
            }
        }
        if (t + 1 < NT) ATT_WRITE(buf ^ 1);
        __syncthreads();
    }
    l += __shfl_xor(l, 32);
    const float inv = 1.f / l;
    bf16* op = P.O + (rowb + qrow) * 512 + h * 64 + 4 * hi;
#pragma unroll
    for (int g = 0; g < 4; ++g) {
        v2u w; w.x = pk2(o0[4 * g] * inv, o0[4 * g + 1] * inv); w.y = pk2(o0[4 * g + 2] * inv, o0[4 * g + 3] * inv); *(v2u*)(op + 8 * g) = w;
        v2u z; z.x = pk2(o1[4 * g] * inv, o1[4 * g + 1] * inv); z.y = pk2(o1[4 * g + 2] * inv, o1[4 * g + 3] * inv); *(v2u*)(op + 32 + 8 * g) = z;
    }
#undef ATT_KSRC
#undef ATT_LOAD
#undef ATT_WRITE
}

constexpr int CAND_CAP = 128, QIP = 1296, HS = 513;
struct IdxP { const bf16 *QI, *KI; const float* WI; unsigned* BM; };
__device__ __forceinline__ unsigned mono_key(float s) { const unsigned u = __builtin_bit_cast(unsigned, s + 0.0f); return u ^ ((unsigned)((int)u >> 31) | 0x80000000u); }
__device__ __forceinline__ void idx_scores2(const bf16x8 (&kf)[2][4], const LAS unsigned char* qlane, const float (&wq)[8], f32x16& sc0, f32x16& sc1) {
    bf16x8 qv[4], qn[4];
#pragma unroll
    for (int s = 0; s < 4; ++s) qv[s] = *(const LAS bf16x8*)(qlane + 8 * 128 + s * 32);
#pragma unroll
    for (int i = 0; i < 16; ++i) { sc0[i] = 0.f; sc1[i] = 0.f; }
    f32x16 ap0, ap1;
#pragma unroll
    for (int i = 0; i < 16; ++i) { ap0[i] = 0.f; ap1[i] = 0.f; }
#pragma unroll
    for (int n = 0; n < 10; ++n) {
        const int nh = (n + 1 < 2) ? 9 : (n + 1 - 2);
        if (n + 1 < 10) {
#pragma unroll
            for (int s = 0; s < 4; ++s) qn[s] = *(const LAS bf16x8*)(qlane + nh * 128 + s * 32); }
        f32x16 a0, a1;
        if (n < 2) {
#pragma unroll
            for (int s = 0; s < 4; ++s) { sc0 = __builtin_amdgcn_mfma_f32_32x32x16_bf16(kf[0][s], qv[s], sc0, 0, 0, 0); sc1 = __builtin_amdgcn_mfma_f32_32x32x16_bf16(kf[1][s], qv[s], sc1, 0, 0, 0); }
        } else {
#pragma unroll
            for (int i = 0; i < 16; ++i) { a0[i] = 0.f; a1[i] = 0.f; }
#pragma unroll
            for (int s = 0; s < 4; ++s) { a0 = __builtin_amdgcn_mfma_f32_32x32x16_bf16(kf[0][s], qv[s], a0, 0, 0, 0); a1 = __builtin_amdgcn_mfma_f32_32x32x16_bf16(kf[1][s], qv[s], a1, 0, 0, 0); }
        }
        if (n >= 3) {
            const float w = wq[n - 3];
#pragma unroll
            for (int i = 0; i < 16; ++i) { sc0[i] = __builtin_fmaf(w, __builtin_fabsf(ap0[i]), sc0[i]); sc1[i] = __builtin_fmaf(w, __builtin_fabsf(ap1[i]), sc1[i]); }
#pragma unroll
            for (int g = 0; g < 8; ++g) { __builtin_amdgcn_sched_group_barrier(0x008, 1, 0); __builtin_amdgcn_sched_group_barrier(0x002, 4, 0); }
        }
        if (n >= 2) { ap0 = a0; ap1 = a1; }
#pragma unroll
        for (int s = 0; s < 4; ++s) qv[s] = qn[s];
    }
    { const float w = wq[7];
#pragma unroll
      for (int i = 0; i < 16; ++i) { sc0[i] = __builtin_fmaf(w, __builtin_fabsf(ap0[i]), sc0[i]); sc1[i] = __builtin_fmaf(w, __builtin_fabsf(ap1[i]), sc1[i]); } }
#pragma unroll
    for (int i = 0; i < 16; ++i) asm volatile("" : "+v"(sc0[i]), "+v"(sc1[i]));
}
__device__ __forceinline__ void idx_item(LAS unsigned char* L, int b, int j, const IdxP& P, int tid, int lane, int wave) {
    LAS unsigned* hist = (LAS unsigned*)L;
    LAS unsigned* img = (LAS unsigned*)(L + 66048);
    LAS unsigned* st = (LAS unsigned*)(L + 98816);
    LAS unsigned* cand = hist;
    LAS unsigned char* Qs = L + 100864;
    const int r32 = lane & 31, hi = lane >> 5;
    const int q0 = 32 * j, ntile = 2 * (j / 2 + 1);
    const size_t rowb = (size_t)b * SEQ;
    if (ntile <= 8) {
        for (int idx = tid; idx < ntile * 32; idx += NTHR) P.BM[((size_t)b * 256 + (idx >> 5)) * SEQ + q0 + (idx & 31)] = 0xffffffffu;
        return;
    }
    float wq[8];
    { for (int c = tid; c < 32 * 64; c += NTHR) { const int rr = c >> 6, ch = c & 63; *(LAS v4u*)(Qs + rr * QIP + ch * 16) = *(const v4u*)(P.QI + (rowb + q0 + rr) * 512 + ch * 8); }
      const float* wp = P.WI + (rowb + q0 + r32) * 8;
#pragma unroll
      for (int h = 0; h < 8; ++h) wq[h] = 0.5f * wp[h]; }
    if (tid < 32) { st[32 + tid] = 256u; st[64 + tid] = 0u; st[96 + tid] = 0u; }
    if (tid == 0) st[129] = 0u;
    __syncthreads();
    {
        const int r = tid >> 4, part = tid & 15;
        const float* wp = P.WI + (rowb + q0 + r) * 8;
        float qb[4] = {0.f, 0.f, 0.f, 0.f}; float rsum = 0.f;
#pragma unroll
        for (int h = 0; h < 8; ++h) { const float w = wp[h]; const v2u raw = *(const LAS v2u*)(Qs + r * QIP + h * 128 + part * 8);
            const float f0 = bflo(raw.x), f1 = bfhi(raw.x), f2 = bflo(raw.y), f3 = bfhi(raw.y);
            float nsq = (f0 * f0 + f1 * f1) + (f2 * f2 + f3 * f3);
#pragma unroll
            for (int o = 1; o < 16; o <<= 1) nsq += __shfl_xor(nsq, o);
            rsum += fabsf(w) * sqrtf(nsq);
            qb[0] += 0.5f * w * f0; qb[1] += 0.5f * w * f1; qb[2] += 0.5f * w * f2; qb[3] += 0.5f * w * f3; }
        v2u hw, lw;
        { const unsigned h01 = pk2(qb[0], qb[1]), h23 = pk2(qb[2], qb[3]); hw.x = h01; hw.y = h23;
          lw.x = pk2(qb[0] - bflo(h01), qb[1] - bfhi(h01)); lw.y = pk2(qb[2] - bflo(h23), qb[3] - bfhi(h23)); }
        *(LAS v2u*)(Qs + r * QIP + 8 * 128 + part * 8) = hw; *(LAS v2u*)(Qs + r * QIP + 9 * 128 + part * 8) = lw;
        { const v2u kw = *(const v2u*)(P.KI + (rowb + r) * 64 + part * 4); const float f0 = bflo(kw.x), f1 = bfhi(kw.x), f2 = bflo(kw.y), f3 = bfhi(kw.y);
          float ksq = (f0 * f0 + f1 * f1) + (f2 * f2 + f3 * f3);
#pragma unroll
          for (int o = 1; o < 16; o <<= 1) ksq += __shfl_xor(ksq, o);
          if (part == 0) { __hip_atomic_fetch_max(&st[129], __builtin_bit_cast(unsigned, ksq), __ATOMIC_RELAXED, __HIP_MEMORY_SCOPE_WORKGROUP); st[224 + r] = __builtin_bit_cast(unsigned, rsum); } }
    }
    __syncthreads();
    if (tid < 32) { const float R = 0.25f * sqrtf(__builtin_bit_cast(float, st[129])) * __builtin_bit_cast(float, st[224 + tid]);
        const float C = 0.125f * R;
        st[160 + tid] = (0x80000000u | __builtin_bit_cast(unsigned, R + C)) - 511u * 131072u; st[224 + tid] = __builtin_bit_cast(unsigned, C); st[tid] = 0u; st[192 + tid] = 0u; }
    const LAS unsigned char* qlane = Qs + r32 * QIP + hi * 16;
    int level = 0;
    const int npair = ntile >> 1;
#define IDX_KLOAD2(tp) { const bf16* kp = P.KI + (rowb + 64 * (tp) + r32) * 64 + 8 * hi; _Pragma("unroll") for (int s = 0; s < 4; ++s) { kn[0][s] = *(const bf16x8*)(kp + 16 * s); kn[1][s] = *(const bf16x8*)(kp + 32 * 64 + 16 * s); } }
#define IDX_SCORES2(tp) \
        bf16x8 kf[2][4]; _Pragma("unroll") for (int s = 0; s < 4; ++s) { kf[0][s] = kn[0][s]; kf[1][s] = kn[1][s]; } \
        f32x16 sc0, sc1; idx_scores2(kf, qlane, wq, sc0, sc1); \
        if ((tp) + NWAVES < npair) { IDX_KLOAD2((tp) + NWAVES) }
    for (;;) {
        ++level;
        for (int u = tid; u < 32 * HS; u += NTHR) hist[u] = 0u;
        if (tid == 0) st[128] = 0u;
        __syncthreads();
        {
            const unsigned qa = st[r32], qlen = st[192 + r32], base1 = st[160 + r32]; const float cq = __builtin_bit_cast(float, st[224 + r32]);
            const int sh = (level > 1 && qlen > 512u) ? (32 - __builtin_clz(qlen - 1u)) - 9 : 0;
            LAS unsigned* hrow = hist + r32 * HS;
            bf16x8 kn[2][4]; if (wave < npair) { IDX_KLOAD2(wave) }
            for (int tp = wave; tp < npair; tp += NWAVES) {
                IDX_SCORES2(tp)
                if (level == 1) {
#pragma unroll
                    for (int i = 0; i < 16; ++i) { const unsigned k0 = mono_key(sc0[i] + cq), k1 = mono_key(sc1[i] + cq);
                        const unsigned b0 = min((max(k0, base1) - base1) >> 17, 511u), b1 = min((max(k1, base1) - base1) >> 17, 511u);
                        __hip_atomic_fetch_add(&hrow[b0], 1u, __ATOMIC_RELAXED, __HIP_MEMORY_SCOPE_WORKGROUP); __hip_atomic_fetch_add(&hrow[b1], 1u, __ATOMIC_RELAXED, __HIP_MEMORY_SCOPE_WORKGROUP); }
                } else {
#pragma unroll
                    for (int i = 0; i < 16; ++i) { const unsigned o0 = mono_key(sc0[i] + cq) - qa, o1 = mono_key(sc1[i] + cq) - qa;
                        if (o0 < qlen) __hip_atomic_fetch_add(&hrow[o0 >> sh], 1u, __ATOMIC_RELAXED, __HIP_MEMORY_SCOPE_WORKGROUP);
                        if (o1 < qlen) __hip_atomic_fetch_add(&hrow[o1 >> sh], 1u, __ATOMIC_RELAXED, __HIP_MEMORY_SCOPE_WORKGROUP); }
                }
            }
        }
        __syncthreads();
        {
            const int q = tid >> 4, seg = tid & 15;
            unsigned segsum = 0u;
            for (int wi = 0; wi < 32; ++wi) segsum += hist[q * HS + seg * 32 + wi];
            unsigned S = segsum;
#pragma unroll
            for (int off = 1; off < 16; off <<= 1) { const unsigned o = __shfl_down(S, off, 16); if (seg + off < 16) S += o; }
            const unsigned above = S - segsum, need = st[32 + q];
            if (above < need && need <= above + segsum) {
                unsigned cum = above, fbin = 0u, fneed = 1u, fcnt = 0u; bool found = false;
                for (int wi = 31; wi >= 0; --wi) { const unsigned c = hist[q * HS + seg * 32 + wi];
                    if (!found && cum + c >= need) { found = true; fbin = 32 * seg + wi; fneed = need - cum; fcnt = c; } if (!found) cum += c; }
                unsigned na, nlen;
                if (level == 1) { const unsigned base1 = st[160 + q];
                    if (fbin == 0u) { na = 0u; nlen = base1 + 131072u; } else if (fbin == 511u) { na = base1 + 511u * 131072u; nlen = 0u - na; } else { na = base1 + fbin * 131072u; nlen = 131072u; } }
                else { const unsigned qa = st[q], qlen = st[192 + q]; const int sh = qlen > 512u ? (32 - __builtin_clz(qlen - 1u)) - 9 : 0;
                    na = qa + (fbin << sh); nlen = min(1u << sh, qlen - (fbin << sh)); }
                st[q] = na; st[192 + q] = nlen; st[32 + q] = fneed; st[64 + q] = fcnt;
                if (fcnt > (unsigned)CAND_CAP && nlen > 1u) st[128] = 1u;
            }
        }
        __syncthreads();
#ifndef MAXLVL
#define MAXLVL 8
#endif
        const bool more = (st[128] != 0u) && (level < MAXLVL);
        __syncthreads();
        if (!more) break;
    }
    {
        const unsigned qa = st[r32], qlen = st[192 + r32]; const float cq = __builtin_bit_cast(float, st[224 + r32]);
        const unsigned Hk = qa + qlen - 1u;
        unsigned hb = (Hk & 0x80000000u) ? (Hk ^ 0x80000000u) : ~Hk;
        if (hb == 0x80000000u) hb = 0x80000001u;
        const float fH = __builtin_bit_cast(float, hb);
        const unsigned ab_ = (qa & 0x80000000u) ? (qa ^ 0x80000000u) : ~qa;
        const float fA = (qa < 0x00800000u) ? -__builtin_inff() : __builtin_bit_cast(float, ab_);
        bf16x8 kn[2][4]; if (wave < npair) { IDX_KLOAD2(wave) }
        for (int tp = wave; tp < npair; tp += NWAVES) {
            IDX_SCORES2(tp)
#define IDX_COLLECT_ELEMS(SC, T) { unsigned v = 0u; _Pragma("unroll") for (int i = 15; i >= 0; --i) { const float ts = SC[i] + cq; const bool ab = ts > fH; v = v + v + (ab ? 1u : 0u); \
                if (!ab && ts >= fA) { const unsigned key = mono_key(ts); \
                    const unsigned pos = __hip_atomic_fetch_add(&st[96 + r32], 1u, __ATOMIC_RELAXED, __HIP_MEMORY_SCOPE_WORKGROUP); \
                    if (pos < (unsigned)CAND_CAP) { cand[(r32 * CAND_CAP + pos) * 2] = key; cand[(r32 * CAND_CAP + pos) * 2 + 1] = (unsigned)(32 * (T) + crow(i, hi)); } } } \
            unsigned bits = (v & 0xfu) | ((v & 0xf0u) << 4) | ((v & 0xf00u) << 8) | ((v & 0xf000u) << 12);     \
            bits <<= 4 * hi; bits |= __shfl_xor(bits, 32); if (hi == 0) img[(T) * 32 + r32] = bits; }
            IDX_COLLECT_ELEMS(sc0, 2 * tp)
            IDX_COLLECT_ELEMS(sc1, 2 * tp + 1)
#undef IDX_COLLECT_ELEMS
        }
    }
#undef IDX_SCORES2
#undef IDX_KLOAD2
    __syncthreads();
    {
        const int q = tid >> 4; const unsigned n = min(st[96 + q], (unsigned)CAND_CAP), need = st[32 + q];
        for (unsigned c = tid & 15; c < n; c += 16) { const unsigned key = cand[(q * CAND_CAP + c) * 2], idx = cand[(q * CAND_CAP + c) * 2 + 1]; unsigned rank = 0u;
            for (unsigned o = 0; o < n; ++o) { const unsigned k2 = cand[(q * CAND_CAP + o) * 2], i2 = cand[(q * CAND_CAP + o) * 2 + 1]; rank += (k2 > key || (k2 == key && i2 < idx)) ? 1u : 0u; }
            if (rank < need) __hip_atomic_fetch_or(&img[(idx >> 5) * 32 + q], 1u << (idx & 31), __ATOMIC_RELAXED, __HIP_MEMORY_SCOPE_WORKGROUP); }
    }
    __syncthreads();
    for (int idx = tid; idx < ntile * 32; idx += NTHR) P.BM[((size_t)b * 256 + (idx >> 5)) * SEQ + q0 + (idx & 31)] = img[idx];
    __syncthreads();
}

__device__ __forceinline__ int wq_next(Frame& F, int cw) {
    __syncthreads();
    if (F_TID == 0) F.MISC[0] = __hip_atomic_fetch_add((unsigned*)(F.ctl + cw), 1u, RLX_AGENT);
    __syncthreads();
    return (int)F.MISC[0];
}

__device__ __forceinline__ void p5a_route(Frame& F, const Args& A) {
    const int lane = F_LANE, tid = F_TID, wave = F_WAVE;
    const float* x1 = A.out; const float* g2 = A.in[11];
    const float* wrg = A.in[12]; const float* brg = A.in[13]; const float* wre = A.in[14]; const float* bre = A.in[15];
    int* toke = (int*)(F.ws + WS_TOKE); float* tokw = (float*)(F.ws + WS_TOKW); float* rstd2 = (float*)(F.ws + WS_RSTD2);
    int* sslot = (int*)(F.ws + WS_SSLOT);
    constexpr int WST = 44, WCH = 256 * WST * 4;
    LAS float* wl = (LAS float*)F.lds;
    LAS unsigned* lcnt = (LAS unsigned*)(F.lds + 2 * WCH);
    LAS float* lgs = (LAS float*)(F.lds + 2 * WCH + 256);
    for (int i = F.vcu * NTHR + tid; i < SORT_ROWS; i += F.G * NTHR) sslot[i] = -1;
    if (tid < NEXP) lcnt[tid] = 0u;
    const int i16 = lane & 15, kq = lane >> 4, tile = wave & 3, half = wave >> 2;
    const int per = T / F.G;
    for (int t0 = F.vcu * per; t0 < (F.vcu + 1) * per; t0 += 64) {
        const float* xr = x1 + (size_t)(t0 + 16 * tile + i16) * D + 4 * kq;
        f32x4 acc0 = (f32x4){0.f, 0.f, 0.f, 0.f}, acc1 = acc0; float ss = 0.f;
        f32x4 se[4], sg; float gk[5];
#define RT_LOAD(c) do { _Pragma("unroll") for (int q = 0; q < 4; ++q) { const int f = tid + 512 * q, k = f >> 3; se[q] = *(const GAS f32x4*)(wre + (size_t)(256 * (c) + k) * 32 + 4 * (f & 7)); gk[q] = g2[256 * (c) + k]; } \
            { const int k = tid >> 1; sg = *(const GAS f32x4*)(wrg + (size_t)(256 * (c) + k) * 8 + 4 * (tid & 1)); gk[4] = g2[256 * (c) + k]; } } while (0)
#define RT_WRITE(bf) do { LAS float* wb = wl + (bf) * (WCH / 4); _Pragma("unroll") for (int q = 0; q < 4; ++q) { const int f = tid + 512 * q, k = f >> 3; *(LAS f32x4*)(wb + k * WST + 4 * (f & 7)) = se[q] * gk[q]; } \
            { const int k = tid >> 1; *(LAS f32x4*)(wb + k * WST + 32 + 4 * (tid & 1)) = sg * gk[4]; } } while (0)
        RT_LOAD(0); RT_WRITE(0); __syncthreads();
        for (int c = 0; c < 4; ++c) {
            if (c + 1 < 4) RT_LOAD(c + 1);
            const LAS float* wb = wl + (c & 1) * (WCH / 4) + 4 * kq * WST + i16 + 16 * half;
#pragma unroll 4
            for (int s = 0; s < 16; ++s) {
                const f32x4 a4 = *(const GAS f32x4*)(xr + 256 * c + 16 * s);
                if (half == 0) ss += (a4.x * a4.x + a4.y * a4.y) + (a4.z * a4.z + a4.w * a4.w);
#pragma unroll
                for (int cc = 0; cc < 4; ++cc) { const LAS float* wp = wb + (16 * s + cc) * WST;
                    acc0 = __builtin_amdgcn_mfma_f32_16x16x4f32(a4[cc], wp[0], acc0, 0, 0, 0);
                    if (half == 0) acc1 = __builtin_amdgcn_mfma_f32_16x16x4f32(a4[cc], wp[32 - (i16 & 8)], acc1, 0, 0, 0); }
            }
            if (c + 1 < 4) RT_WRITE((c + 1) & 1);
            __syncthreads();
        }
#undef RT_LOAD
#undef RT_WRITE
        LAS float* lt = lgs + tile * 640;
#pragma unroll
        for (int r = 0; r < 4; ++r) { const int tk = 4 * kq + r; lt[tk * 40 + 8 + 16 * half + i16] = acc0[r]; if (half == 0 && i16 < 8) lt[tk * 40 + i16] = acc1[r]; }
        if (half == 0) { ss += __shfl_xor(ss, 16); ss += __shfl_xor(ss, 32); if (kq == 0) lgs[2560 + 16 * tile + i16] = 1.f / sqrtf(ss * (1.f / D) + EPS); }
        __syncthreads();
        if (half == 0 && lane < 16) {
            const int m = t0 + 16 * tile + lane; const float rstd = lgs[2560 + 16 * tile + lane]; const LAS float* lg = lt + lane * 40;
            float gl[8];
#pragma unroll
            for (int k = 0; k < 8; ++k) gl[k] = lg[k] * rstd + brg[k];
            int gs = 0; float gm = gl[0];
#pragma unroll
            for (int k = 1; k < 8; ++k) if (gl[k] > gm) { gm = gl[k]; gs = k; }
            float den = 0.f;
#pragma unroll
            for (int k = 0; k < 8; ++k) den += __expf(gl[k] - gm);
            const float wgrp = 1.f / den;
            float el[4];
#pragma unroll
            for (int cc = 0; cc < 4; ++cc) el[cc] = lg[8 + 4 * gs + cc] * rstd + bre[4 * gs + cc];
            int i1 = 0; float v1 = el[0];
#pragma unroll
            for (int cc = 1; cc < 4; ++cc) if (el[cc] > v1) { v1 = el[cc]; i1 = cc; }
            int i2 = -1; float v2 = 0.f;
#pragma unroll
            for (int cc = 0; cc < 4; ++cc) if (cc != i1 && (i2 < 0 || el[cc] > v2)) { v2 = el[cc]; i2 = cc; }
            const float e2 = __expf(v2 - v1), w1 = 1.f / (1.f + e2), w2 = e2 / (1.f + e2);
            toke[2 * m] = gs * 4 + i1; toke[2 * m + 1] = gs * 4 + i2; tokw[2 * m] = w1 * wgrp; tokw[2 * m + 1] = w2 * wgrp; rstd2[m] = rstd;
            __hip_atomic_fetch_add(&lcnt[gs * 4 + i1], 1u, __ATOMIC_RELAXED, __HIP_MEMORY_SCOPE_WORKGROUP);
            __hip_atomic_fetch_add(&lcnt[gs * 4 + i2], 1u, __ATOMIC_RELAXED, __HIP_MEMORY_SCOPE_WORKGROUP);
        }
        __syncthreads();
    }
    if (tid < NEXP && lcnt[tid]) __hip_atomic_fetch_add((unsigned*)(F.ctl + CW_CNT + tid), lcnt[tid], RLX_AGENT);
}

__device__ __forceinline__ void p5a2_scatter(Frame& F, const Args& A) {
    const int lane = F_LANE, tid = F_TID;
    const float* x1 = A.out; const float* g2 = A.in[11];
    const int* toke = (const int*)(F.ws + WS_TOKE); const float* tokw = (const float*)(F.ws + WS_TOKW); const float* rstd2 = (const float*)(F.ws + WS_RSTD2);
    int* sslot = (int*)(F.ws + WS_SSLOT); float* sw = (float*)(F.ws + WS_SW); int* t2e = (int*)(F.ws + WS_T2E);
    bf16* AS = (bf16*)(F.ws + WS_ASORT);
    LAS unsigned* sh = (LAS unsigned*)F.lds;
    if (tid < NEXP) sh[256 + tid] = __hip_atomic_load((unsigned*)(F.ctl + CW_CNT + tid), RLX_AGENT);
    __syncthreads();
    if (tid == 0) { unsigned acc = 0u;
        for (int e = 0; e < NEXP; ++e) { const unsigned c = sh[256 + e]; sh[e] = acc; const unsigned nt = (c + 255u) / 256u;
            if (blockIdx.x == 0) for (unsigned i = 0; i < nt; ++i) t2e[acc / 256u + i] = e;
            acc += nt * 256u; }
        if (blockIdx.x == 0) t2e[255] = (int)(acc / 256u); }
    const int per = T / F.G;
    for (int t0 = F.vcu * per; t0 < (F.vcu + 1) * per; t0 += 64) {
        if (tid < NEXP) sh[32 + tid] = 0u;
        __syncthreads();
        int e = 0; unsigned lpos = 0u;
        if (tid < 128) { e = toke[2 * t0 + tid]; lpos = __hip_atomic_fetch_add(&sh[32 + e], 1u, __ATOMIC_RELAXED, __HIP_MEMORY_SCOPE_WORKGROUP); }
        __syncthreads();
        if (tid < NEXP) sh[64 + tid] = sh[tid] + (sh[32 + tid] ? __hip_atomic_fetch_add((unsigned*)(F.ctl + CW_FILL + tid), sh[32 + tid], RLX_AGENT) : 0u);
        __syncthreads();
        if (tid < 128) { const unsigned pos = sh[64 + e] + lpos; sh[96 + tid] = pos; sslot[pos] = 2 * t0 + tid; sw[pos] = tokw[2 * t0 + tid]; }
        __syncthreads();
        for (int tk0 = F_WAVE; tk0 < 64; tk0 += 4 * NWAVES) {
            f32x4 xv[4][4];
#pragma unroll
            for (int r = 0; r < 4; ++r) { const GAS f32x4* xr = (const GAS f32x4*)(x1 + (size_t)(t0 + tk0 + r * NWAVES) * D) + lane;
#pragma unroll
                for (int j = 0; j < 4; ++j) xv[r][j] = xr[64 * j]; }
#pragma unroll
            for (int r = 0; r < 4; ++r) { const int tk = tk0 + r * NWAVES, m = t0 + tk; const float rstd = rstd2[m];
                const unsigned p0 = sh[96 + 2 * tk], p1 = sh[96 + 2 * tk + 1];
#pragma unroll
                for (int j = 0; j < 4; ++j) { const f32x4 g = *((const GAS f32x4*)g2 + lane + 64 * j); const f32x4 y = xv[r][j] * rstd * g; v2u w; w.x = pk2(y.x, y.y); w.y = pk2(y.z, y.w);
                    *((GAS v2u*)(AS + (size_t)p0 * D) + lane + 64 * j) = w; *((GAS v2u*)(AS + (size_t)p1 * D) + lane + 64 * j) = w; } } }
        __syncthreads();
    }
}

__device__ __forceinline__ void p6_final(Frame& F, const Args& A) {
    const int gw = F.vcu * NWAVES + F_WAVE, NGW = F.G * NWAVES, lane = F_LANE;
    const float* gf = A.in[19]; float* out = A.out; const bf16* SL = (const bf16*)(F.ws + WS_SLOTS);
    for (int m0 = gw; m0 < T; m0 += 2 * NGW) {
        f32x4 v[2][4]; v2u a[2][4], c[2][4];
#pragma unroll
        for (int r = 0; r < 2; ++r) { const int m = min(m0 + r * NGW, T - 1); const GAS f32x4* xr = (const GAS f32x4*)(out + (size_t)m * D) + lane;
            const GAS v2u* s0 = (const GAS v2u*)(SL + (size_t)(2 * m) * D) + lane; const GAS v2u* s1 = (const GAS v2u*)(SL + (size_t)(2 * m + 1) * D) + lane;
#pragma unroll
            for (int j = 0; j < 4; ++j) { v[r][j] = xr[64 * j]; a[r][j] = s0[64 * j]; c[r][j] = s1[64 * j]; } }
#pragma unroll
        for (int r = 0; r < 2; ++r) { const int m = m0 + r * NGW; float s = 0.f;
#pragma unroll
            for (int j = 0; j < 4; ++j) { f32x4& w = v[r][j];
                w.x += bflo(a[r][j].x) + bflo(c[r][j].x); w.y += bfhi(a[r][j].x) + bfhi(c[r][j].x); w.z += bflo(a[r][j].y) + bflo(c[r][j].y); w.w += bfhi(a[r][j].y) + bfhi(c[r][j].y);
                s += (w.x * w.x + w.y * w.y) + (w.z * w.z + w.w * w.w); }
            const float rstd = 1.f / sqrtf(wave_sum(s) * (1.f / D) + EPS);
            if (m < T) { GAS f32x4* xo = (GAS f32x4*)(out + (size_t)m * D) + lane;
#pragma unroll
                for (int j = 0; j < 4; ++j) { const f32x4 g = *((const GAS f32x4*)gf + lane + 64 * j); xo[64 * j] = v[r][j] * rstd * g; } } }
    }
}

constexpr int NPHASE = 13;
__global__ void __launch_bounds__(NTHR, 2) mk_fwd(Args args) {
    extern __shared__ __attribute__((aligned(16))) unsigned char lds[];
    Frame F;
    F.lds = (LAS unsigned char*)lds; F.MISC = (volatile LAS unsigned*)(F.lds + MISC_OFF);
        F.G = gridDim.x; { const int bx = blockIdx.x; F.vcu = (F.G % 8 == 0) ? (bx % 8) * (F.G / 8) + bx / 8 : bx; }
    F.ws = args.ws; F.ctl = (gu32*)(args.ws + WS_CTL);
    unsigned char* ws = args.ws;
    if (F_TID < 128) F.MISC[F_TID] = 0u;
    __syncthreads();
    const bool single = (args.ph_hi - args.ph_lo) > 1;
    XcdBarrier bar; bar.bar = (unsigned*)(F.ctl + CW_BAR); bar.x = 0; bar.st = nullptr;
    if (single) bar = xcd_barrier_post((unsigned*)(F.ctl + CW_BAR), F.MISC + 8);
    const int lo = args.ph_lo, hi = args.ph_hi;
#ifdef ONLY
#define IN(k) ((k) == ONLY && lo <= (k) && (k) < hi)
#else
#define IN(k) (lo <= (k) && (k) < hi)
#endif
#ifdef TS_A
#define STAMP(k) do { if (blockIdx.x == 0 && threadIdx.x == 0) ((unsigned long long*)(ws + WS_CTL + 8192))[(k) + 1] = __builtin_amdgcn_s_memrealtime(); } while (0)
#else
#define STAMP(k) do { } while (0)
#endif
#define SEAM(k) do { if (IN((k) + 1)) xcd_barrier(bar); STAMP(k); } while (0)
    const f32x2* rope = (const f32x2*)(ws + WS_ROPE);
    bf16* GA = (bf16*)args.out; bf16* GB = (bf16*)args.out + (size_t)T * 1024;

    STAMP(-1);
    if (IN(0)) { p0_prologue(F, args);
#ifdef REP_P0
        p0_prologue(F, args);
#endif
        SEAM(0); }
    if (IN(1)) {
        pg8::Gemm g{(const bf16*)(ws + WS_H), (const bf16*)(ws + WS_WIN), T, NIN, D, 0}; pg8::StaticOrder S; S.init(T, NIN, F.G, (int)blockIdx.x);
        pg8::EpiIn E{(bf16*)(ws + WS_CQ), (bf16*)(ws + WS_CKV), (bf16*)(ws + WS_QB), (bf16*)(ws + WS_KB), (bf16*)(ws + WS_VB), (bf16*)(ws + WS_QI), (bf16*)(ws + WS_KI), (bf16*)(ws + WS_KR), GA, GB, (float*)(ws + WS_WI), rope};
        pg8::gemm_phase<pg8::EpiIn, pg8::StaticOrder, true, true>(F.lds, g, S, E);
#ifdef REP_P1
        pg8::gemm_phase<pg8::EpiIn, pg8::StaticOrder, true, true>(F.lds, g, S, E);
#endif
        SEAM(1);
    }
    if (IN(2)) { p2a_norms(F, args); SEAM(2); }
    if (IN(3)) {
#ifdef REP_P3
      for (int rep = 0; rep < 2; ++rep) {
#else
      {
#endif
#ifndef NO3A
        { pg8::Gemm g{(const bf16*)(ws + WS_CQ), (const bf16*)(ws + WS_WUQ), T, 768, 384, 0}; pg8::StaticOrder S; S.init(T, 768, F.G, (int)blockIdx.x);
          pg8::EpiQA E{(bf16*)(ws + WS_QA), rope}; pg8::gemm_phase<pg8::EpiQA, pg8::StaticOrder, true, true>(F.lds, g, S, E); }
#endif
#ifndef NO3B
        { pg8::Gemm g{(const bf16*)(ws + WS_CKV), (const bf16*)(ws + WS_WUKV), T, 1024, 256, 0}; pg8::StaticOrder S; S.init(T, 1024, F.G, (int)blockIdx.x);
          pg8::EpiKV E{(bf16*)(ws + WS_KN), (bf16*)(ws + WS_VA)}; pg8::gemm_phase<pg8::EpiKV, pg8::StaticOrder, true, true>(F.lds, g, S, E); }
#endif
      }
        SEAM(3);
    }
    if (IN(4)) {
        unsigned* rdy = (unsigned*)(F.ctl + CW_RDY);
        for (;;) { const int k = wq_next(F, CW_Q1); if (k >= 1536 + CV_QITEMS) break;
            int ltid = threadIdx.x; asm volatile("" : "+v"(ltid));
            const int lw = __builtin_amdgcn_readfirstlane(ltid >> 6);
            if (k < 512) { const int ib = k & 1, ij = 255 - (k >> 1);
                const IdxP IP{(const bf16*)(ws + WS_QI), (const bf16*)(ws + WS_KI), (const float*)(ws + WS_WI), (unsigned*)(ws + WS_BM)};
                idx_item(F.lds, ib, ij, IP, ltid, ltid & 63, lw);
                VM_WAIT(); __syncthreads();
                if (ltid == 0) { __builtin_amdgcn_fence(__ATOMIC_RELEASE, "agent"); VM_WAIT(); __hip_atomic_fetch_add(rdy + 64 * (ib * 32 + (ij >> 3)), 1u, RLX_AGENT); }
                continue; }
            const int j = k - 512; int a;
            if (j < 3 * CV_QITEMS) { const int q3 = j / 3, r3 = j - 3 * q3; a = (r3 == 2) ? -1 - q3 : 2 * q3 + r3; } else a = j - CV_QITEMS;
            if (a < 0) { const int c = -1 - a; LAS float* scr = (LAS float*)(F.lds + lw * 16640);
                conv_tile2(args, ws, CV_EARLY + 16 * c + lw, CV_EARLY + 16 * c + 8 + lw, scr, ltid & 63);
                continue; }
            { const int u = a >> 1, ub = (u & 15) >> 3, uh = u & 7, uq = 31 - (u >> 4);
                if (a & 1) { const AttnP APA{(const bf16*)(ws + WS_QA), (const bf16*)(ws + WS_KN), (const bf16*)(ws + WS_KR), (const bf16*)(ws + WS_VA), (bf16*)(ws + WS_OA), nullptr};
                    attn_unit<true>(F.lds, ub, uh, uq, APA, ltid, ltid & 63, lw); }
                else { const AttnP APB{(const bf16*)(ws + WS_QB), (const bf16*)(ws + WS_KB), nullptr, (const bf16*)(ws + WS_VB), (bf16*)(ws + WS_OB), (const unsigned*)(ws + WS_BM)};
                    if (ltid == 0) { unsigned sp = 0u; while (__hip_atomic_load(rdy + 64 * (ub * 32 + uq), RLX_AGENT) < 8u) { __builtin_amdgcn_s_sleep(8); if (++sp > (1u << 22)) break; }
                        __builtin_amdgcn_fence(__ATOMIC_ACQUIRE, "agent"); VM_WAIT(); }
                    __syncthreads();
                    attn_unit<false>(F.lds, ub, uh, uq, APB, ltid, ltid & 63, lw); } }
        }
    }
    if (IN(5)) { SEAM(5); }
    if (IN(6)) {
#ifdef REP_P6
      for (int rep = 0; rep < 2; ++rep) {
#else
      {
#endif
        { pg8::Gemm g{(const bf16*)(ws + WS_OA), (const bf16*)(ws + WS_WOA), T, 1024, 512, 0}; pg8::StaticOrder S; S.init(T, 1024, F.G, (int)blockIdx.x);
          pg8::EpiY<0> E{(bf16*)(ws + WS_Y), GA}; pg8::gemm_phase<pg8::EpiY<0>, pg8::StaticOrder, true, true>(F.lds, g, S, E); }
        { pg8::Gemm g{(const bf16*)(ws + WS_OB), (const bf16*)(ws + WS_WOB), T, 1024, 512, 0}; pg8::StaticOrder S; S.init(T, 1024, F.G, (int)blockIdx.x);
          pg8::EpiY<1> E{(bf16*)(ws + WS_Y), GB}; pg8::gemm_phase<pg8::EpiY<1>, pg8::StaticOrder, true, true>(F.lds, g, S, E); }
      }
        SEAM(6);
    }
    if (IN(7)) {
        pg8::Gemm g{(const bf16*)(ws + WS_Y), (const bf16*)(ws + WS_WOUT), T, 1024, 1024, 0}; pg8::StaticOrder S; S.init(T, 1024, F.G, (int)blockIdx.x);
        pg8::EpiX1 E{args.in[0], args.out}; pg8::gemm_phase<pg8::EpiX1, pg8::StaticOrder, true, true>(F.lds, g, S, E);
#ifdef REP_P7
        pg8::gemm_phase<pg8::EpiX1, pg8::StaticOrder, true, true>(F.lds, g, S, E);
#endif
        SEAM(7);
    }
    if (IN(8)) { p5a_route(F, args); SEAM(8); }
    if (IN(9)) { p5a2_scatter(F, args); SEAM(9); }
    if (IN(10)) {
        const int* t2e = (const int*)(ws + WS_T2E); const int ntl = t2e[255];
        pg8::Gemm g{(const bf16*)(ws + WS_ASORT), (const bf16*)(ws + WS_WGU), SORT_ROWS, 512, 1024, (size_t)512 * 1024 * 2}; pg8::GroupOrder S; S.init(ntl, 2, F.G, (int)blockIdx.x, t2e);
        pg8::EpiHid E{(bf16*)(ws + WS_HID)}; pg8::gemm_phase<pg8::EpiHid, pg8::GroupOrder, true, true>(F.lds, g, S, E);
#ifdef REP_P10
        pg8::gemm_phase<pg8::EpiHid, pg8::GroupOrder, true, true>(F.lds, g, S, E);
#endif
        SEAM(10);
    }
    if (IN(11)) {
        const int* t2e = (const int*)(ws + WS_T2E); const int ntl = t2e[255];
        pg8::Gemm g{(const bf16*)(ws + WS_HID), (const bf16*)(ws + WS_WD), SORT_ROWS, 1024, 256, (size_t)1024 * 256 * 2}; pg8::GroupOrder S; S.init(ntl, 4, F.G, (int)blockIdx.x, t2e);
        pg8::EpiDown E{(bf16*)(ws + WS_SLOTS), (const int*)(ws + WS_SSLOT), (const float*)(ws + WS_SW)}; pg8::gemm_phase<pg8::EpiDown, pg8::GroupOrder, true, true>(F.lds, g, S, E);
#ifdef REP_P11
        pg8::gemm_phase<pg8::EpiDown, pg8::GroupOrder, true, true>(F.lds, g, S, E);
#endif
        SEAM(11);
    }
    if (IN(12)) { p6_final(F, args); }
#ifdef TS_A
    if (blockIdx.x == 0 && threadIdx.x == 0) { STAMP(12); __builtin_amdgcn_s_waitcnt(0);
        const unsigned long long* tsp = (const unsigned long long*)(ws + WS_CTL + 8192);
        const unsigned long long ta = __hip_atomic_load(tsp + (TS_A) + 1, RLX_AGENT), tb = __hip_atomic_load(tsp + (TS_B) + 1, RLX_AGENT);
        const unsigned long long t0 = __builtin_amdgcn_s_memrealtime(), wait = 4ull * (tb - ta);
        while (__builtin_amdgcn_s_memrealtime() - t0 < wait) __builtin_amdgcn_s_sleep(16); }
#endif
#undef IN
#undef SEAM
}

#ifndef MK_MULTI
#define MK_MULTI 0
#endif
extern "C" void kernel_launch(void* const* d_in, const int* in_sizes, int n_in, void* d_out, int out_size, void* d_ws, size_t ws_size, hipStream_t stream) {
    static int grid = 0;
    if (grid == 0) {
        if (n_in != 20 || in_sizes[0] != T * D || out_size != T * D || ws_size < WS_END) { fprintf(stderr, "kernel_launch: unexpected shapes n_in %d in0 %d out %d ws %zu\n", n_in, n_in > 0 ? in_sizes[0] : -1, out_size, ws_size); grid = -1; return; }
        int dev = 0, cus = 0;
        if (hipGetDevice(&dev) != hipSuccess || hipDeviceGetAttribute(&cus, hipDeviceAttributeMultiprocessorCount, dev) != hipSuccess) { grid = -1; return; }
        if (hipFuncSetAttribute((const void*)mk_fwd, hipFuncAttributeMaxDynamicSharedMemorySize, LDS_BYTES) != hipSuccess) { fprintf(stderr, "kernel_launch: hipFuncSetAttribute failed\n"); grid = -1; return; }
        (void)hipGetLastError();
        grid = cus;
    }
    if (grid < 0) return;
    if (hipMemsetAsync((char*)d_ws + WS_CTL, 0, CTL_ZERO_BYTES, stream) != hipSuccess) return;
    Args a{};
    for (int i = 0; i < 20; ++i) a.in[i] = (const float*)d_in[i];
    a.out = (float*)d_out; a.ws = (unsigned char*)d_ws;
#if MK_MULTI
    for (int p = 0; p < NPHASE; ++p) { a.ph_lo = p; a.ph_hi = p + 1; hipLaunchKernelGGL(mk_fwd, dim3(grid), dim3(NTHR), LDS_BYTES, stream, a); }
#else
    a.ph_lo = 0; a.ph_hi = NPHASE;
    hipLaunchKernelGGL(mk_fwd, dim3(grid), dim3(NTHR), LDS_BYTES, stream, a);
#endif
}
```

```cpp
#include <hip/hip_runtime.h>
#include <cstdio>
#include <cstdint>

#define GAS __attribute__((address_space(1)))
#define LAS __attribute__((address_space(3)))
typedef unsigned short bf16;
typedef unsigned v4u __attribute__((ext_vector_type(4)));
typedef unsigned v2u __attribute__((ext_vector_type(2)));
typedef float f32x4 __attribute__((ext_vector_type(4)));
typedef float f32x2 __attribute__((ext_vector_type(2)));
typedef float f32x16 __attribute__((ext_vector_type(16)));
typedef short bf16x8 __attribute__((ext_vector_type(8)));
typedef short s16x4 __attribute__((ext_vector_type(4)));
typedef __bf16 bf16x2_t __attribute__((ext_vector_type(2)));
typedef GAS unsigned gu32;
#define RLX_AGENT __ATOMIC_RELAXED, __HIP_MEMORY_SCOPE_AGENT
#define LDS_WAIT() asm volatile("s_waitcnt lgkmcnt(0)" ::: "memory")
#define VM_WAIT() asm volatile("s_waitcnt vmcnt(0)" ::: "memory")

constexpr int NWAVES = 8, NTHR = NWAVES * 64;
constexpr int BATCH = 2, SEQ = 8192, D = 1024, T = BATCH * SEQ;
constexpr float EPS = 1e-6f;
constexpr int NIN = 4864, NIN_SRC = 4840;
constexpr int C_CQ = 0, C_CKV = 384, C_QB = 640, C_KB = 1152, C_VB = 1664, C_QI = 2176, C_KR = 2688, C_KI = 2720, C_WI = 2784, C_GA = 2816, C_GB = 3840;
constexpr int NEXP = 32, FF = 256;
constexpr int SORT_ROWS = 2 * T + NEXP * 256;
constexpr float LOG2E = 1.4426950408889634f;
constexpr float C2A = 0.10206207261596575f * LOG2E;
constexpr float C2B = 0.125f * LOG2E;
constexpr float WI_SCALE = 0.35355339059327373f * 0.125f;

constexpr size_t MiB = 1u << 20, KiB = 1u << 10;
constexpr size_t WS_CTL = 0, CTL_ZERO_BYTES = 1 * MiB;
constexpr size_t WS_ROPE = 1 * MiB;
constexpr size_t WS_WI = 2 * MiB;
constexpr size_t WS_TOKE = 2 * MiB + 512 * KiB;
constexpr size_t WS_TOKW = WS_TOKE + 128 * KiB;
constexpr size_t WS_RSTD2 = WS_TOKW + 128 * KiB;
constexpr size_t WS_SSLOT = 3 * MiB + 512 * KiB;
constexpr size_t WS_SW = WS_SSLOT + 192 * KiB;
constexpr size_t WS_T2E = WS_SW + 192 * KiB;
constexpr size_t WS_WIN = 4 * MiB, WS_WUQ = 14 * MiB, WS_WUKV = 15 * MiB, WS_WOA = 16 * MiB, WS_WOB = 17 * MiB, WS_WOUT = 18 * MiB, WS_WGU = 20 * MiB, WS_WD = 52 * MiB;
constexpr size_t WS_H = 68 * MiB, WS_OA = 68 * MiB, WS_OB = 84 * MiB;
constexpr size_t WS_QA = 100 * MiB, WS_KN = 124 * MiB, WS_VA = 140 * MiB, WS_Y = 100 * MiB;
constexpr size_t WS_QB = 156 * MiB, WS_KB = 172 * MiB, WS_VB = 188 * MiB;
constexpr size_t WS_CQ = 204 * MiB, WS_CKV = 216 * MiB, WS_BM = 204 * MiB;
constexpr size_t WS_QI = 224 * MiB, WS_KI = 240 * MiB, WS_KR = 242 * MiB;
constexpr size_t WS_ASORT = 68 * MiB, WS_SLOTS = 156 * MiB, WS_HID = 220 * MiB;
constexpr size_t WS_END = 256 * MiB;
constexpr int CW_BAR = 4096;
constexpr int CW_Q1 = 64, CW_Q2 = 128;
constexpr int CW_CNT = 256, CW_FILL = 320;
constexpr int CW_RDY = 8192;

constexpr int LDS_BYTES = 147456;
constexpr int MISC_OFF = 147456 - 512;

__device__ __forceinline__ unsigned f2bf(float f) { unsigned u = __builtin_bit_cast(unsigned, f); return (u + 0x7fffu + ((u >> 16) & 1u)) >> 16; }
__device__ __forceinline__ unsigned pk2(float lo, float hi) { f32x2 v = {lo, hi}; bf16x2_t b = __builtin_convertvector(v, bf16x2_t); return __builtin_bit_cast(unsigned, b); }
__device__ __forceinline__ float bflo(unsigned w) { return __builtin_bit_cast(float, w << 16); }
__device__ __forceinline__ float bfhi(unsigned w) { return __builtin_bit_cast(float, w & 0xffff0000u); }

#define XB_TMO      128
#define XB_XCNT(j)  (256  + 64 * (j))
#define XB_XSUB(j)  (1280 + 64 * (j))
#define XB_XGEN(j)  (2304 + 64 * (j))
#define XB_TOP      3328
#define XB_TOPGEN   3392
#define XCD_BAR_WORDS 3456
#define XB_SPIN_CAP (1u << 22)
__device__ __forceinline__ unsigned xb_ld(unsigned* p)              { return __hip_atomic_load(p, __ATOMIC_RELAXED, __HIP_MEMORY_SCOPE_AGENT); }
__device__ __forceinline__ unsigned xb_add(unsigned* p, unsigned v) { return __hip_atomic_fetch_add(p, v, __ATOMIC_RELAXED, __HIP_MEMORY_SCOPE_AGENT); }
__device__ __forceinline__ unsigned xb_xcc_id() { return (unsigned)__builtin_amdgcn_s_getreg((3 << 11) | 20) & 0xFu; }
#define XB_SPIN(cond, bar) do { unsigned _sp = 0; while (cond) { __builtin_amdgcn_s_sleep(1); \
    if ((++_sp & 255u) == 0u) { if (xb_ld(&(bar)[XB_TMO])) break; if (_sp > XB_SPIN_CAP) { atomicAdd(&(bar)[XB_TMO], 1u); break; } } } } while (0)
struct XcdBarrier { unsigned* bar; unsigned x; volatile LAS unsigned* st; };
__device__ __forceinline__ XcdBarrier xcd_barrier_post(unsigned* bar, volatile LAS unsigned* st) {
    XcdBarrier b; b.bar = bar; b.x = xb_xcc_id(); b.st = st;
    if (threadIdx.x == 0) (void)xb_add(&bar[XB_XCNT(b.x)], 1u);
    return b;
}
__device__ __forceinline__ void xcd_barrier_complete(unsigned* bar, unsigned x, unsigned& nloc, unsigned& nx) {
    const unsigned G = gridDim.x * gridDim.y * gridDim.z;
    unsigned sum, cnt, mine, sp = 0u;
    for (;;) {
        sum = 0u; cnt = 0u; mine = 0u;
#pragma unroll
        for (unsigned j = 0; j < 16; ++j) { const unsigned c = xb_ld(&bar[XB_XCNT(j)]); sum += c; cnt += (c > 0u) ? 1u : 0u; mine = (j == x) ? c : mine; }
        if (sum == G) break;
        __builtin_amdgcn_s_sleep(1);
        if ((++sp & 255u) == 0u) { if (xb_ld(&bar[XB_TMO])) break; if (sp > XB_SPIN_CAP) { atomicAdd(&bar[XB_TMO], 1u); break; } }
    }
    nloc = mine > 0u ? mine : 1u; nx = cnt > 0u ? cnt : 1u;
}
__device__ __forceinline__ void xcd_barrier(const XcdBarrier& b) {
    asm volatile("s_waitcnt vmcnt(0)" ::: "memory");
    __syncthreads();
    if (threadIdx.x == 0) {
        unsigned* bar = b.bar;
        __builtin_amdgcn_s_waitcnt(0);
        unsigned nloc = b.st[0], nx = b.st[1];
        if (nloc == 0u) { xcd_barrier_complete(bar, b.x, nloc, nx); b.st[0] = nloc; b.st[1] = nx; }
        const unsigned old = xb_add(&bar[XB_XSUB(b.x)], 1u);
        const unsigned gen = old / nloc;
        if (old + 1u == (gen + 1u) * nloc) {
            __builtin_amdgcn_fence(__ATOMIC_RELEASE, "agent");
            asm volatile("s_waitcnt vmcnt(0)" ::: "memory");
            const unsigned og = xb_add(&bar[XB_TOP], 1u);
            const unsigned tg = og / nx;
            if (og + 1u == (tg + 1u) * nx) xb_add(&bar[XB_TOPGEN], 1u);
            else XB_SPIN(xb_ld(&bar[XB_TOPGEN]) == tg, bar);
            __builtin_amdgcn_fence(__ATOMIC_ACQUIRE, "agent");
            xb_add(&bar[XB_XGEN(b.x)], 1u);
            asm volatile("s_waitcnt vmcnt(0)" ::: "memory");
        } else {
            XB_SPIN(xb_ld(&bar[XB_XGEN(b.x)]) == gen, bar);
            __builtin_amdgcn_fence(__ATOMIC_ACQUIRE, "agent");
            asm volatile("s_waitcnt vmcnt(0)" ::: "memory");
        }
    }
    __syncthreads();
}

__device__ __forceinline__ float wave_sum(float v) {
#pragma unroll
    for (int o = 1; o < 64; o <<= 1) v += __shfl_xor(v, o);
    return v;
}

namespace pg8 {
#define PG8_LAS __attribute__((address_space(3)))
typedef unsigned short bf16_t;
typedef unsigned u32x4 __attribute__((ext_vector_type(4)));
constexpr int BM = 256, BK = 64, HALF = 128, HTB = HALF * BK * 2, STAGE_BYTES = 8 * HTB, NXCD = 8, WGM = 8;
__host__ __device__ __forceinline__ int lds_byte(int r, int c) { const int st = (r >> 4) * 2 + (c >> 5), rr = r & 15, cc = c & 31, ob = rr * 64 + cc * 2; return st * 1024 + (ob ^ (((ob >> 9) & 1) << 5)); }
__host__ __device__ __forceinline__ void stage_rc(int b, int& R, int& C) { const int st = b / 1024, sb = b % 1024, swz = sb ^ (((sb >> 9) & 1) << 5); R = (st >> 1) * 16 + swz / 64; C = (st & 1) * 32 + (swz % 64) / 2; }
__host__ __device__ __forceinline__ int perm32(int rho) { const int n = rho >> 4, i = rho & 15; return 8 * (i >> 2) + 4 * n + (i & 3); }

struct Unit { int pm, pn, e; };
struct Gemm { const bf16_t* A; const bf16_t* Bt; int M, N, K; size_t estride; };

struct StaticOrder {
    int nM, nN, nwg, G, c;
    __host__ __device__ void init(int M, int N, int G_, int c_) { nM = M / BM; nN = N / BM; nwg = nM * nN; G = G_; c = c_; }
    __host__ __device__ bool next(int i, Unit& u) const {
        const long L = (long)i * G + c; if (L >= nwg) return false;
        int wgid = (int)L; { const int q = nwg / NXCD, r = nwg % NXCD, xcd = wgid % NXCD, off = wgid / NXCD; wgid = (xcd < r ? xcd * (q + 1) : r * (q + 1) + (xcd - r) * q) + off; }
        const int nig = WGM * nN, gid = wgid / nig, fm = gid * WGM, gsz = (nM - fm) < WGM ? (nM - fm) : WGM;
        u.pm = fm + ((wgid % nig) % gsz); u.pn = (wgid % nig) / gsz; u.e = 0; return true;
    }
    __device__ __forceinline__ void a_ready(const Unit&) const {}
    __device__ __forceinline__ void done(const Unit&) const {}
};
struct GroupOrder {
    int nN, total, G, c; const int* t2e;
    __device__ void init(int nTiles, int nN_, int G_, int c_, const int* t2e_) { nN = nN_; total = nTiles * nN_; G = G_; c = c_; t2e = t2e_; }
    __device__ bool next(int i, Unit& u) const {
        const long L = (long)i * G + c; if (L >= total) return false;
        u.pm = (int)(L / nN); u.pn = (int)(L % nN); u.e = __builtin_amdgcn_readfirstlane(t2e[u.pm]); return true;
    }
    __device__ __forceinline__ void a_ready(const Unit&) const {}
    __device__ __forceinline__ void done(const Unit&) const {}
};

__device__ __forceinline__ void st8(bf16_t* p, f32x4 v0, f32x4 v1) { u32x4 w; w.x = pk2(v0[0], v0[1]); w.y = pk2(v0[2], v0[3]); w.z = pk2(v1[0], v1[1]); w.w = pk2(v1[2], v1[3]); *(u32x4*)p = w; }
__device__ __forceinline__ void ld8(const bf16_t* p, f32x4& v0, f32x4& v1) { const u32x4 w = *(const u32x4*)p; v0 = (f32x4){bflo(w.x), bfhi(w.x), bflo(w.y), bfhi(w.y)}; v1 = (f32x4){bflo(w.z), bfhi(w.z), bflo(w.w), bfhi(w.w)}; }

__device__ __forceinline__ void rope16(f32x4& v0, f32x4& v1, int row, int fq, const f32x2* rope) {
    const f32x2* rp = rope + (size_t)(row & (SEQ - 1)) * 16;
    f32x4 p0, p1;
#pragma unroll
    for (int e = 0; e < 4; ++e) { p0[e] = __shfl_xor(v0[e], 16); p1[e] = __shfl_xor(v1[e], 16); }
    if (fq < 2) {
        const float sg = fq == 0 ? -1.f : 1.f;
#pragma unroll
        for (int e = 0; e < 4; ++e) { const f32x2 a = rp[2 * e], b = rp[2 * (4 + e)];
            v0[e] = v0[e] * a.x + sg * p0[e] * a.y; v1[e] = v1[e] * b.x + sg * p1[e] * b.y; }
    }
}
__device__ __forceinline__ void rope32(f32x4& v0, f32x4& v1, int row, int fq, const f32x2* rope) {
    const f32x2* rp = rope + (size_t)(row & (SEQ - 1)) * 16 + 8 * (fq & 1);
    const float sg = fq < 2 ? -1.f : 1.f;
#pragma unroll
    for (int e = 0; e < 4; ++e) { const float p0 = __shfl_xor(v0[e], 32), p1 = __shfl_xor(v1[e], 32); const f32x2 a = rp[e], b = rp[4 + e];
        v0[e] = v0[e] * a.x + sg * p0 * a.y; v1[e] = v1[e] * b.x + sg * p1 * b.y; }
}
__device__ __forceinline__ float sigmoidf_(float x) { return __builtin_amdgcn_rcpf(1.f + __builtin_amdgcn_exp2f(-1.4426950408889634f * x)); }

struct EpiIn {
    static constexpr bool PERM = true, AFTER_DRAIN = false;
    bf16_t *CQ, *CKV, *QB, *KB, *VB, *QI, *KI, *KR, *GA, *GB; float* WI; const f32x2* rope;
    __device__ __forceinline__ void operator()(const f32x4 (&acc)[2][2][4][2], const Unit& u, int wr, int wc, int fr, int fq) const {
        const int row0 = u.pm * BM + wr * 64 + fr;
#pragma unroll
        for (int bj = 0; bj < 2; ++bj) {
            const int cg = u.pn * BM + bj * HALF + wc * 32;
            bf16_t* base = nullptr; int pitch = 0, cc = 0, mode = 0; float sc = 1.f;
            if (cg < C_CKV) { base = CQ; pitch = 384; cc = cg; }
            else if (cg < C_QB) { base = CKV; pitch = 256; cc = cg - C_CKV; }
            else if (cg < C_KB) { base = QB; pitch = 512; cc = cg - C_QB; mode = ((cc >> 5) & 1) == 0 ? 1 : 0; sc = C2B; }
            else if (cg < C_VB) { base = KB; pitch = 512; cc = cg - C_KB; mode = ((cc >> 5) & 1) == 0 ? 1 : 0; }
            else if (cg < C_QI) { base = VB; pitch = 512; cc = cg - C_VB; }
            else if (cg < C_KR) { base = QI; pitch = 512; cc = cg - C_QI; mode = ((cc >> 5) & 1) == 0 ? 1 : 0; }
            else if (cg < C_KI) { base = KR; pitch = 32; cc = 0; mode = 2; }
            else if (cg < C_WI) { base = KI; pitch = 64; cc = cg - C_KI; mode = (cc == 0) ? 1 : 0; }
            else if (cg < C_GA) { mode = 4; }
            else if (cg < C_GB) { base = GA; pitch = 1024; cc = cg - C_GA; mode = 3; }
            else { base = GB; pitch = 1024; cc = cg - C_GB; mode = 3; }
#pragma unroll
            for (int ai = 0; ai < 2; ++ai)
#pragma unroll
                for (int m = 0; m < 4; ++m) {
                    const int row = row0 + ai * HALF + m * 16;
                    f32x4 v0 = acc[ai][bj][m][0], v1 = acc[ai][bj][m][1];
                    if (mode == 1) rope16(v0, v1, row, fq, rope);
                    else if (mode == 2) rope32(v0, v1, row, fq, rope);
                    else if (mode == 3) {
#pragma unroll
                        for (int e = 0; e < 4; ++e) { v0[e] = sigmoidf_(v0[e]); v1[e] = sigmoidf_(v1[e]); } }
                    if (mode == 4) { if (fq == 0) { *(f32x4*)(WI + (size_t)row * 8) = v0 * WI_SCALE; *(f32x4*)(WI + (size_t)row * 8 + 4) = v1 * WI_SCALE; } }
                    else { v0 = v0 * sc; v1 = v1 * sc; st8(base + (size_t)row * pitch + cc + 8 * fq, v0, v1); }
                }
        }
    }
};
struct EpiQA {
    static constexpr bool PERM = true, AFTER_DRAIN = false;
    bf16_t* QA; const f32x2* rope;
    __device__ __forceinline__ void operator()(const f32x4 (&acc)[2][2][4][2], const Unit& u, int wr, int wc, int fr, int fq) const {
        const int row0 = u.pm * BM + wr * 64 + fr;
#pragma unroll
        for (int bj = 0; bj < 2; ++bj) {
            const int cg = u.pn * BM + bj * HALF + wc * 32; const bool rot = ((cg >> 5) % 3) == 2;
#pragma unroll
            for (int ai = 0; ai < 2; ++ai)
#pragma unroll
                for (int m = 0; m < 4; ++m) {
                    const int row = row0 + ai * HALF + m * 16;
                    f32x4 v0 = acc[ai][bj][m][0], v1 = acc[ai][bj][m][1];
                    if (rot) rope32(v0, v1, row, fq, rope);
                    v0 = v0 * C2A; v1 = v1 * C2A; st8(QA + (size_t)row * 768 + cg + 8 * fq, v0, v1);
                }
        }
    }
};
struct EpiKV {
    static constexpr bool PERM = true, AFTER_DRAIN = false;
    bf16_t *KN, *VA;
    __device__ __forceinline__ void operator()(const f32x4 (&acc)[2][2][4][2], const Unit& u, int wr, int wc, int fr, int fq) const {
        const int row0 = u.pm * BM + wr * 64 + fr;
#pragma unroll
        for (int bj = 0; bj < 2; ++bj) {
            const int cg = u.pn * BM + bj * HALF + wc * 32; bf16_t* base = cg < 512 ? KN : VA; const int cc = (cg & 511) + 8 * fq;
#pragma unroll
            for (int ai = 0; ai < 2; ++ai)
#pragma unroll
                for (int m = 0; m < 4; ++m) { const int row = row0 + ai * HALF + m * 16; st8(base + (size_t)row * 512 + cc, acc[ai][bj][m][0], acc[ai][bj][m][1]); }
        }
    }
};
template <int ADD> struct EpiY {
    static constexpr bool PERM = true, AFTER_DRAIN = false;
    bf16_t* Y; const bf16_t* Gt;
    __device__ __forceinline__ void operator()(const f32x4 (&acc)[2][2][4][2], const Unit& u, int wr, int wc, int fr, int fq) const {
        const int row0 = u.pm * BM + wr * 64 + fr;
#pragma unroll
        for (int bj = 0; bj < 2; ++bj) {
            const int c0 = u.pn * BM + bj * HALF + wc * 32 + 8 * fq;
#pragma unroll
            for (int ai = 0; ai < 2; ++ai)
#pragma unroll
                for (int m = 0; m < 4; ++m) { const size_t off = (size_t)(row0 + ai * HALF + m * 16) * 1024 + c0;
                    f32x4 g0, g1; ld8(Gt + off, g0, g1);
                    f32x4 v0 = acc[ai][bj][m][0] * g0, v1 = acc[ai][bj][m][1] * g1;
                    if (ADD) { f32x4 o0, o1; ld8(Y + off, o0, o1); v0 = v0 + o0; v1 = v1 + o1; }
                    st8(Y + off, v0, v1); }
        }
    }
};
struct EpiX1 {
    static constexpr bool PERM = false, AFTER_DRAIN = false;
    const float* X; float* O;
    __device__ __forceinline__ void operator()(const f32x4 (&acc)[2][2][4][2], const Unit& u, int wr, int wc, int fr, int fq) const {
        const int row0 = u.pm * BM + wr * 64 + fr, col0 = u.pn * BM + wc * 32 + 4 * fq;
#pragma unroll
        for (int ai = 0; ai < 2; ++ai)
#pragma unroll
            for (int m = 0; m < 4; ++m) { const size_t off = (size_t)(row0 + ai * HALF + m * 16) * 1024 + col0;
#pragma unroll
                for (int bj = 0; bj < 2; ++bj)
#pragma unroll
                    for (int n = 0; n < 2; ++n) { const f32x4 xv = *(const f32x4*)(X + off + bj * HALF + n * 16); *(f32x4*)(O + off + bj * HALF + n * 16) = xv + acc[ai][bj][m][n]; } }
    }
};
struct EpiHid {
    static constexpr bool PERM = true, AFTER_DRAIN = false;
    bf16_t* HID;
    __device__ __forceinline__ void operator()(const f32x4 (&acc)[2][2][4][2], const Unit& u, int wr, int wc, int fr, int fq) const {
        const int row0 = u.pm * BM + wr * 64 + fr, c0 = u.pn * 128 + wc * 32 + 8 * fq;
#pragma unroll
        for (int ai = 0; ai < 2; ++ai)
#pragma unroll
            for (int m = 0; m < 4; ++m) { f32x4 h0, h1;
#pragma unroll
                for (int e = 0; e < 4; ++e) { const float g0 = acc[ai][0][m][0][e], g1 = acc[ai][0][m][1][e];
                    h0[e] = g0 * sigmoidf_(g0) * acc[ai][1][m][0][e]; h1[e] = g1 * sigmoidf_(g1) * acc[ai][1][m][1][e]; }
                st8(HID + (size_t)(row0 + ai * HALF + m * 16) * 256 + c0, h0, h1); }
    }
};
struct EpiDown {
    static constexpr bool PERM = true, AFTER_DRAIN = false;
    bf16_t* SL; const int* sslot; const float* sw;
    __device__ __forceinline__ void operator()(const f32x4 (&acc)[2][2][4][2], const Unit& u, int wr, int wc, int fr, int fq) const {
        const int row0 = u.pm * BM + wr * 64 + fr;
#pragma unroll
        for (int ai = 0; ai < 2; ++ai)
#pragma unroll
            for (int m = 0; m < 4; ++m) { const int r = row0 + ai * HALF + m * 16; const int slot = sslot[r]; const float w = sw[r];
                if (slot >= 0) {
#pragma unroll
                    for (int bj = 0; bj < 2; ++bj) st8(SL + (size_t)slot * 1024 + u.pn * BM + bj * HALF + wc * 32 + 8 * fq, acc[ai][bj][m][0] * w, acc[ai][bj][m][1] * w); } }
    }
};
template <class Epi, class Sched, bool ALIGN_EPI = false, bool SP2 = false>
__device__ __forceinline__ void gemm_phase(PG8_LAS unsigned char* lds, const Gemm g, const Sched& S, const Epi& E) {
    const int tid = threadIdx.x, wid = __builtin_amdgcn_readfirstlane(tid >> 6), lane = tid & 63, wr = wid >> 2, wc = wid & 3, fr = lane & 15, fq = lane >> 4;
    const int K = g.K, nt = K / BK;
    unsigned voffA[2], voffB[2];
#pragma unroll
    for (int i = 0; i < 2; ++i) { int R, C; stage_rc(tid * 16 + i * 8192, R, C); const int Rb = Epi::PERM ? ((R & ~31) + perm32(R & 31)) : R;
        voffA[i] = (unsigned)(R * K + C) * 2u; voffB[i] = (unsigned)(Rb * K + C) * 2u; }
    const size_t kstep = (size_t)(BK * 2);
    const size_t hstep = (size_t)HALF * K * 2;
    const size_t tstep = 2 * hstep;
    const unsigned ldsw = (unsigned)wid * 1024u;
    const int aoff = lds_byte(wr * 64 + fr, fq * 8), boff = lds_byte(wc * 32 + fr, fq * 8);
#define PG8_SA(b, h) (((b) * 2 + (h)) * HTB)
#define PG8_SB(b, h) ((4 + (b) * 2 + (h)) * HTB)
#define PG8_STAGE(bufoff, gbase, voff) do { _Pragma("unroll") for (int _i = 0; _i < 2; ++_i) \
        __builtin_amdgcn_global_load_lds((const unsigned*)((const char*)(gbase) + (voff)[_i]), (PG8_LAS unsigned*)(lds + (bufoff) + ldsw + _i * 8192), 16, 0, 0); } while (0)
#define PG8_LDA(dst, b, h) do { _Pragma("unroll") for (int m = 0; m < 4; ++m) _Pragma("unroll") for (int k = 0; k < 2; ++k) dst[m][k] = *(const PG8_LAS bf16x8*)(lds + PG8_SA(b, h) + aoff + m * 2048 + k * 1024); } while (0)
#define PG8_LDB(dst, b, h) do { _Pragma("unroll") for (int n = 0; n < 2; ++n) _Pragma("unroll") for (int k = 0; k < 2; ++k) dst[n][k] = *(const PG8_LAS bf16x8*)(lds + PG8_SB(b, h) + boff + n * 2048 + k * 1024); } while (0)
#define PG8_MMA(ai, bj, At, Bt) do { __builtin_amdgcn_s_setprio(1); _Pragma("unroll") for (int m = 0; m < 4; ++m) _Pragma("unroll") for (int n = 0; n < 2; ++n) _Pragma("unroll") for (int k = 0; k < 2; ++k) \
        acc[ai][bj][m][n] = __builtin_amdgcn_mfma_f32_16x16x32_bf16(Bt[n][k], At[m][k], acc[ai][bj][m][n], 0, 0, 0); __builtin_amdgcn_s_setprio(0); } while (0)
#define PG8_WAIT_V(n) asm volatile("s_waitcnt vmcnt(" #n ")" ::: "memory")
#define PG8_WAIT_L(n) asm volatile("s_waitcnt lgkmcnt(" #n ")" ::: "memory")
#define PG8_BAR __builtin_amdgcn_s_barrier()
#define PG8_SCHED __builtin_amdgcn_sched_barrier(0)
    Unit cur, nxt; int ui = 0;
    if (!S.next(0, cur)) return;
    f32x4 acc[2][2][4][2];
#pragma unroll
    for (int a = 0; a < 2; ++a)
#pragma unroll
        for (int b = 0; b < 2; ++b)
#pragma unroll
            for (int m = 0; m < 4; ++m)
#pragma unroll
                for (int n = 0; n < 2; ++n) acc[a][b][m][n] = (f32x4){0.f, 0.f, 0.f, 0.f};
    bf16x8 At[4][2], B0[2][2], B1[2][2];
    const char* cA = (const char*)g.A + (size_t)cur.pm * tstep; const char* cB = (const char*)g.Bt + (size_t)cur.e * g.estride + (size_t)cur.pn * tstep;
    S.a_ready(cur);
    if constexpr (SP2) {
        PG8_STAGE(PG8_SB(0, 0), cB, voffB); PG8_STAGE(PG8_SB(0, 1), cB + hstep, voffB); PG8_STAGE(PG8_SA(0, 0), cA, voffA); PG8_STAGE(PG8_SA(0, 1), cA + hstep, voffA);
        if (wr == 1) PG8_BAR;
        PG8_WAIT_V(2); PG8_BAR;
        PG8_STAGE(PG8_SB(1, 0), cB + kstep, voffB); PG8_STAGE(PG8_SA(1, 0), cA + kstep, voffA); PG8_STAGE(PG8_SB(1, 1), cB + hstep + kstep, voffB);
        PG8_WAIT_V(6); PG8_BAR;
    } else {
        PG8_STAGE(PG8_SB(0, 0), cB, voffB); PG8_STAGE(PG8_SA(0, 0), cA, voffA); PG8_STAGE(PG8_SB(0, 1), cB + hstep, voffB); PG8_STAGE(PG8_SA(0, 1), cA + hstep, voffA);
        if (wr == 1) PG8_BAR;
        PG8_WAIT_V(4); PG8_BAR;
        PG8_STAGE(PG8_SB(1, 0), cB + kstep, voffB); PG8_STAGE(PG8_SA(1, 0), cA + kstep, voffA); PG8_STAGE(PG8_SB(1, 1), cB + hstep + kstep, voffB);
        PG8_WAIT_V(6); PG8_BAR;
    }
    for (;;) {
        const bool has_next = S.next(ui + 1, nxt);
        const char* nA = has_next ? (const char*)g.A + (size_t)nxt.pm * tstep : cA; const char* nB = has_next ? (const char*)g.Bt + (size_t)nxt.e * g.estride + (size_t)nxt.pn * tstep : cB;
#pragma nounroll
        for (int t = 0; t < nt; t += 2) {
            const bool last = (t == nt - 2);
            const char* a1 = cA + (size_t)(t + 1) * kstep;
            const char* a2 = last ? nA : cA + (size_t)(t + 2) * kstep; const char* b2 = last ? nB : cB + (size_t)(t + 2) * kstep;
            const char* a3 = a2 + kstep; const char* b3 = b2 + kstep;
            if (last && has_next) S.a_ready(nxt);
            if constexpr (SP2) {
            PG8_LDB(B0, 0, 0); PG8_LDB(B1, 0, 1); PG8_SCHED; PG8_LDA(At, 0, 0); PG8_STAGE(PG8_SA(1, 1), a1 + hstep, voffA);
            PG8_WAIT_V(8); PG8_WAIT_L(0); PG8_BAR; PG8_MMA(0, 0, At, B0); PG8_MMA(0, 1, At, B1); PG8_BAR; PG8_SCHED;
            PG8_LDA(At, 0, 1); PG8_STAGE(PG8_SB(0, 0), b2, voffB); PG8_STAGE(PG8_SB(0, 1), b2 + hstep, voffB); PG8_STAGE(PG8_SA(0, 0), a2, voffA);
            PG8_WAIT_V(8); PG8_WAIT_L(0); PG8_BAR; PG8_MMA(1, 0, At, B0); PG8_MMA(1, 1, At, B1); PG8_BAR; PG8_SCHED;
            PG8_LDB(B0, 1, 0); PG8_LDB(B1, 1, 1); PG8_SCHED; PG8_LDA(At, 1, 0); PG8_STAGE(PG8_SA(0, 1), a2 + hstep, voffA);
            PG8_WAIT_V(8); PG8_WAIT_L(0); PG8_BAR; PG8_MMA(0, 0, At, B0); PG8_MMA(0, 1, At, B1); PG8_BAR; PG8_SCHED;
            PG8_LDA(At, 1, 1); PG8_STAGE(PG8_SB(1, 0), b3, voffB); PG8_STAGE(PG8_SB(1, 1), b3 + hstep, voffB); PG8_STAGE(PG8_SA(1, 0), a3, voffA);
            PG8_WAIT_V(8); PG8_WAIT_L(0); PG8_BAR; PG8_MMA(1, 0, At, B0); PG8_MMA(1, 1, At, B1); PG8_BAR; PG8_SCHED;
            } else {
            PG8_LDB(B0, 0, 0); PG8_SCHED; PG8_LDA(At, 0, 0); PG8_STAGE(PG8_SA(1, 1), a1 + hstep, voffA);
            PG8_WAIT_L(8); PG8_BAR; PG8_WAIT_L(0); PG8_MMA(0, 0, At, B0); PG8_BAR; PG8_SCHED;
            PG8_LDB(B1, 0, 1); PG8_STAGE(PG8_SB(0, 0), b2, voffB);
            PG8_BAR; PG8_WAIT_L(0); PG8_MMA(0, 1, At, B1); PG8_BAR;
            PG8_LDA(At, 0, 1); PG8_STAGE(PG8_SA(0, 0), a2, voffA);
            PG8_BAR; PG8_WAIT_L(0); PG8_MMA(1, 0, At, B0); PG8_BAR; PG8_SCHED;
            PG8_STAGE(PG8_SB(0, 1), b2 + hstep, voffB);
            PG8_WAIT_V(6); PG8_BAR; PG8_MMA(1, 1, At, B1); PG8_BAR;
            PG8_LDB(B0, 1, 0); PG8_SCHED; PG8_LDA(At, 1, 0); PG8_STAGE(PG8_SA(0, 1), a2 + hstep, voffA);
            PG8_WAIT_L(8); PG8_BAR; PG8_WAIT_L(0); PG8_MMA(0, 0, At, B0); PG8_BAR; PG8_SCHED;
            PG8_LDB(B1, 1, 1); PG8_STAGE(PG8_SB(1, 0), b3, voffB);
            PG8_BAR; PG8_WAIT_L(0); PG8_MMA(0, 1, At, B1); PG8_BAR;
            PG8_LDA(At, 1, 1); PG8_STAGE(PG8_SA(1, 0), a3, voffA);
            PG8_BAR; PG8_WAIT_L(0); PG8_MMA(1, 0, At, B0); PG8_BAR; PG8_SCHED;
            PG8_STAGE(PG8_SB(1, 1), b3 + hstep, voffB);
            PG8_WAIT_V(6); PG8_BAR; PG8_MMA(1, 1, At, B1); PG8_BAR;
            }
        }
        if constexpr (ALIGN_EPI) { if (wr == 0) PG8_BAR; }
        if constexpr (!Epi::AFTER_DRAIN) { E(acc, cur, wr, wc, fr, fq); S.done(cur); }
        if (!has_next) break;
#pragma unroll
        for (int a = 0; a < 2; ++a)
#pragma unroll
            for (int b = 0; b < 2; ++b)
#pragma unroll
                for (int m = 0; m < 4; ++m)
#pragma unroll
                    for (int n = 0; n < 2; ++n) acc[a][b][m][n] = (f32x4){0.f, 0.f, 0.f, 0.f};
        cur = nxt; cA = nA; cB = nB; ++ui;
        if constexpr (ALIGN_EPI) { if (wr == 1) PG8_BAR; }
    }
    PG8_WAIT_V(0);
    if constexpr (!ALIGN_EPI) { if (wr == 0) PG8_BAR; }
    PG8_BAR;
    if constexpr (Epi::AFTER_DRAIN) { E.fused(acc, cur, wr, wc, fr, fq, lds, wid, lane); S.done(cur); }
#undef PG8_SA
#undef PG8_SB
#undef PG8_STAGE
#undef PG8_LDA
#undef PG8_LDB
#undef PG8_MMA
#undef PG8_WAIT_V
#undef PG8_WAIT_L
#undef PG8_BAR
#undef PG8_SCHED
}
}

struct Args { const float* in[20]; float* out; unsigned char* ws; int ph_lo, ph_hi; };
struct Frame {
    LAS unsigned char* lds; volatile LAS unsigned* MISC; gu32* ctl; unsigned char* ws;
    int vcu, G;
};
#define F_TID ((int)threadIdx.x)
#define F_LANE ((int)(threadIdx.x & 63))
#define F_WAVE (__builtin_amdgcn_readfirstlane((int)(threadIdx.x >> 6)))

__device__ __forceinline__ int in_src_col(int n) {
    if (n < 640) return n;
    if (n < 2688) return n + 32;
    if (n < 2720) return n - 2688 + 640;
    if (n < 2792) return n;
    if (n < 2816) return -1;
    return n - 24;
}
struct TrDesc { const float* colptr; int ld, k0; bf16* WT; int Kd, destrow0; };
__device__ __forceinline__ void tr_load(const TrDesc& d, int lane, f32x4 (&v)[16]) {
    const int kr = lane >> 4;
#pragma unroll
    for (int it = 0; it < 16; ++it) { const int kk = 4 * it + kr; v[it] = (f32x4){0.f, 0.f, 0.f, 0.f}; if (d.colptr) v[it] = *(const GAS f32x4*)(d.colptr + (size_t)(d.k0 + kk) * d.ld); }
}
__device__ __forceinline__ void tr_store(const TrDesc& d, int lane, const f32x4 (&v)[16], LAS float* scr) {
    const int nq = lane & 15, kr = lane >> 4;
#pragma unroll
    for (int it = 0; it < 16; ++it) { const int kk = 4 * it + kr; LAS float* q = scr + kk * 65 + 4 * nq; q[0] = v[it].x; q[1] = v[it].y; q[2] = v[it].z; q[3] = v[it].w; }
    LDS_WAIT(); asm volatile("" ::: "memory");
    const int c = lane & 7;
#pragma unroll
    for (int j = 0; j < 8; ++j) { const int n = (lane >> 3) + 8 * j; const LAS float* q = scr + (8 * c) * 65 + n;
        v4u o; o.x = pk2(q[0 * 65], q[1 * 65]); o.y = pk2(q[2 * 65], q[3 * 65]); o.z = pk2(q[4 * 65], q[5 * 65]); o.w = pk2(q[6 * 65], q[7 * 65]);
        *(GAS v4u*)(d.WT + (size_t)(d.destrow0 + n) * d.Kd + d.k0 + 8 * c) = o; }
    LDS_WAIT(); asm volatile("" ::: "memory");
}
constexpr int CV_I0 = 16 * 76, CV_I1 = 6 * 12, CV_I2 = 4 * 16, CV_I3 = 8 * 16, CV_I4 = 8 * 16, CV_I5 = 16 * 16, CV_I6 = 32 * 16 * 8, CV_I7 = 32 * 4 * 16;
constexpr int CV_EARLY = CV_I0 + CV_I1 + CV_I2, CV_LATE = CV_I3 + CV_I4 + CV_I5 + CV_I6 + CV_I7, CV_QITEMS = CV_LATE / 16;
static_assert(CV_LATE % 16 == 0, "late conversion tiles come in queue items of 16");
__device__ __forceinline__ TrDesc conv_desc(const Args& A, unsigned char* ws, int it, int lane) {
    const int n4 = 4 * (lane & 15);
    int r = it;
    if (r < CV_I0) { const int kb = r / 76, nb = r % 76; const int col = in_src_col(64 * nb + n4);
        return TrDesc{col >= 0 ? A.in[2] + col : nullptr, NIN_SRC, 64 * kb, (bf16*)(ws + WS_WIN), 1024, 64 * nb}; } r -= CV_I0;
    if (r < CV_I1) { const int kb = r / 12, nb = r % 12; return TrDesc{A.in[4] + 64 * nb + n4, 768, 64 * kb, (bf16*)(ws + WS_WUQ), 384, 64 * nb}; } r -= CV_I1;
    if (r < CV_I2) { const int kb = r / 16, nb = r % 16; const int n = 64 * nb + n4;
        return TrDesc{n < 512 ? A.in[6] + n : A.in[7] + (n - 512), 512, 64 * kb, (bf16*)(ws + WS_WUKV), 256, 64 * nb}; } r -= CV_I2;
    if (r < CV_I3) { const int kb = r / 16, nb = r % 16; return TrDesc{A.in[8] + 64 * nb + n4, 1024, 64 * kb, (bf16*)(ws + WS_WOA), 512, 64 * nb}; } r -= CV_I3;
    if (r < CV_I4) { const int kb = r / 16, nb = r % 16; return TrDesc{A.in[9] + 64 * nb + n4, 1024, 64 * kb, (bf16*)(ws + WS_WOB), 512, 64 * nb}; } r -= CV_I4;
    if (r < CV_I5) { const int kb = r / 16, nb = r % 16; return TrDesc{A.in[10] + 64 * nb + n4, 1024, 64 * kb, (bf16*)(ws + WS_WOUT), 1024, 64 * nb}; } r -= CV_I5;
    if (r < CV_I6) { const int e = r / 128, rr = r % 128, kb = rr / 8, nb = rr % 8; const int n = 64 * nb + n4, pn = n >> 8, c = n & 255, col = 128 * pn + (c & 127);
        const float* src = ((c >> 7) ? A.in[17] : A.in[16]) + (size_t)e * 1024 * 256 + col;
        return TrDesc{src, 256, 64 * kb, (bf16*)(ws + WS_WGU) + (size_t)e * 512 * 1024, 1024, 64 * nb}; } r -= CV_I6;
    { const int e = r / 64, rr = r % 64, kb = rr / 16, nb = rr % 16;
        return TrDesc{A.in[18] + (size_t)e * 256 * 1024 + 64 * nb + n4, 1024, 64 * kb, (bf16*)(ws + WS_WD) + (size_t)e * 1024 * 256, 256, 64 * nb}; }
}
__device__ __forceinline__ void conv_tile(const Args& A, unsigned char* ws, int it, LAS float* scr, int lane) {
    const TrDesc d = conv_desc(A, ws, it, lane); f32x4 v[16]; tr_load(d, lane, v); tr_store(d, lane, v, scr);
}
__device__ __forceinline__ void conv_tile2(const Args& A, unsigned char* ws, int it0, int it1, LAS float* scr, int lane) {
    const TrDesc d0 = conv_desc(A, ws, it0, lane), d1 = conv_desc(A, ws, it1, lane); f32x4 v0[16], v1[16];
    tr_load(d0, lane, v0); tr_load(d1, lane, v1); tr_store(d0, lane, v0, scr); tr_store(d1, lane, v1, scr);
}
__device__ __forceinline__ void p0_prologue(Frame& F, const Args& A) {
    LAS float* scr = (LAS float*)(F.lds + F_WAVE * 16640);
    const int gw = F.vcu * NWAVES + F_WAVE, NGW = F.G * NWAVES, lane = F_LANE;
    unsigned char* ws = F.ws;
#ifdef CONV_IN_P0
    for (int it = gw; it < CV_EARLY + CV_LATE; it += NGW) conv_tile(A, ws, it, scr, lane);
#else
    for (int it = gw; it < CV_EARLY; it += NGW) conv_tile(A, ws, it, scr, lane);
#endif
    const float* x = A.in[0]; const float* g1 = A.in[1]; bf16* H = (bf16*)(ws + WS_H);
    for (int m0 = gw; m0 < T; m0 += 4 * NGW) {
        f32x4 v[4][4];
#pragma unroll
        for (int r = 0; r < 4; ++r) { const int m = min(m0 + r * NGW, T - 1); const GAS f32x4* xr = (const GAS f32x4*)(x + (size_t)m * D) + lane;
#pragma unroll
            for (int j = 0; j < 4; ++j) v[r][j] = xr[64 * j]; }
#pragma unroll
        for (int r = 0; r < 4; ++r) { const int m = m0 + r * NGW; float s = 0.f;
#pragma unroll
            for (int j = 0; j < 4; ++j) s += (v[r][j].x * v[r][j].x + v[r][j].y * v[r][j].y) + (v[r][j].z * v[r][j].z + v[r][j].w * v[r][j].w);
            const float rstd = 1.f / sqrtf(wave_sum(s) * (1.f / D) + EPS);
            if (m < T) { GAS v2u* o8 = (GAS v2u*)(H + (size_t)m * D) + lane;
#pragma unroll
                for (int j = 0; j < 4; ++j) { const f32x4 g = *((const GAS f32x4*)g1 + lane + 64 * j); const f32x4 y = v[r][j] * rstd * g; v2u w; w.x = pk2(y.x, y.y); w.y = pk2(y.z, y.w); o8[64 * j] = w; } } }
    }
    f32x2* rope = (f32x2*)(ws + WS_ROPE);
    for (int idx = (F.vcu * NTHR + F_TID); idx < SEQ * 16; idx += F.G * NTHR) {
        const int pos = idx >> 4, i = idx & 15;
        const double REV[16] = {0.15915494309189535, 0.0700865215877985, 0.03086376340470123, 0.013591370636193905, 0.005985185712713705, 0.002635675898667414, 0.001160663641240061, 0.0005111175045375439,
                                0.00022507907903927653, 9.911730936901935e-05, 4.364795279280289e-05, 1.9221100684944863e-05, 8.464330808241401e-06, 3.727408601915352e-06, 1.6414262627950345e-06, 7.228293068832865e-07};
        double rv = 0.0;
#pragma unroll
        for (int k = 0; k < 16; ++k) rv = (i == k) ? REV[k] : rv;
        double t = (double)pos * rv; t -= __builtin_floor(t);
        const float tf = (float)t;
        rope[idx] = (f32x2){__builtin_amdgcn_cosf(tf), __builtin_amdgcn_sinf(tf)};
    }
}

__device__ __forceinline__ void p2a_norms(Frame& F, const Args& A) {
    const int gw = F.vcu * NWAVES + F_WAVE, NGW = F.G * NWAVES, lane = F_LANE;
    bf16* CQ = (bf16*)(F.ws + WS_CQ); bf16* CKV = (bf16*)(F.ws + WS_CKV);
    const float* gq = A.in[3]; const float* gkv = A.in[5];
    for (int m = gw; m < T; m += NGW) {
        {
            GAS unsigned* p = (GAS unsigned*)(CQ + (size_t)m * 384) + lane; unsigned w[3]; float s = 0.f;
#pragma unroll
            for (int j = 0; j < 3; ++j) { w[j] = p[64 * j]; const float a = bflo(w[j]), b = bfhi(w[j]); s += a * a + b * b; }
            const float rstd = 1.f / sqrtf(wave_sum(s) * (1.f / 384.f) + EPS);
#pragma unroll
            for (int j = 0; j < 3; ++j) { const f32x2 g = *((const GAS f32x2*)gq + lane + 64 * j); p[64 * j] = pk2(bflo(w[j]) * rstd * g.x, bfhi(w[j]) * rstd * g.y); }
        }
        {
            GAS v2u* p = (GAS v2u*)(CKV + (size_t)m * 256) + lane; const v2u w = *p;
            const float a = bflo(w.x), b = bfhi(w.x), c = bflo(w.y), d = bfhi(w.y);
            const float rstd = 1.f / sqrtf(wave_sum(a * a + b * b + c * c + d * d) * (1.f / 256.f) + EPS);
            const f32x4 g = *((const GAS f32x4*)gkv + lane); v2u o; o.x = pk2(a * rstd * g.x, b * rstd * g.y); o.y = pk2(c * rstd * g.z, d * rstd * g.w); *p = o;
        }
    }
}

__device__ __forceinline__ constexpr int crow(int r, int hi) { return (r & 3) + 8 * (r >> 2) + 4 * hi; }
constexpr float ATT_THR = 8.f;
__device__ __forceinline__ float att_mask(float p, unsigned w, int bit) { int mk; unsigned r;
    asm("v_bfe_i32 %0, %1, %2, 1" : "=v"(mk) : "v"(w), "i"(bit)); r = __builtin_bit_cast(unsigned, p) & (unsigned)mk; return __builtin_bit_cast(float, r); }
struct AttnP { const bf16 *Q, *K, *K2, *V; bf16* O; const unsigned* BM; };
template <bool MLA> __device__ __forceinline__ void attn_unit(LAS unsigned char* L, int b, int h, int qb, const AttnP& P, int tid, int lane, int wave) {
    constexpr int DK = MLA ? 96 : 64, KP = DK * 2 + 16, NS = DK / 16, CPR = DK / 8;
    constexpr int QPITCH = MLA ? 768 : 512, VP = 192, KBUF = 64 * KP, VBUF = 64 * VP;
    const int r32 = lane & 31, hi = lane >> 5;
    const size_t rowb = (size_t)b * SEQ;
    const int qrow = qb * 256 + wave * 32 + r32;
    bf16x8 qf[NS];
    { const bf16* qp = P.Q + (rowb + qrow) * QPITCH + h * DK;
#pragma unroll
      for (int s = 0; s < NS; ++s) qf[s] = *(const bf16x8*)(qp + 16 * s + 8 * hi); }
    const int NT = 4 * qb + 4, my_nt = 4 * qb + (wave >> 1) + 1;
    const int kid0 = tid, kid1 = tid + NTHR;
    const int kr0 = kid0 / CPR, kc0 = kid0 % CPR, kr1 = kid1 / CPR, kc1 = kid1 % CPR; const bool has1 = MLA && (kid1 < 64 * CPR);
    const int vr = tid >> 3, vc = tid & 7;
    v4u kreg0, kreg1 = (v4u){0u, 0u, 0u, 0u}, vreg;
#define ATT_KSRC(t, kr, kc) (MLA ? ((kc) < 8 ? (const v4u*)(P.K + (rowb + 64 * (t) + (kr)) * 512 + h * 64 + 8 * (kc)) : (const v4u*)(P.K2 + (rowb + 64 * (t) + (kr)) * 32 + 8 * ((kc) - 8))) \
                                 : (const v4u*)(P.K + (rowb + 64 * (t) + (kr)) * 512 + h * 64 + 8 * (kc)))
#define ATT_LOAD(t) do { kreg0 = *ATT_KSRC(t, kr0, kc0); if (has1) kreg1 = *ATT_KSRC(t, kr1, kc1); vreg = *(const v4u*)(P.V + (rowb + 64 * (t) + vr) * 512 + h * 64 + 8 * vc); } while (0)
#define ATT_WRITE(buf) do { *(LAS v4u*)(L + (buf) * KBUF + kr0 * KP + kc0 * 16) = kreg0; if (has1) *(LAS v4u*)(L + (buf) * KBUF + kr1 * KP + kc1 * 16) = kreg1; \
                            *(LAS v4u*)(L + 2 * KBUF + (buf) * VBUF + vr * VP + vc * 16) = vreg; } while (0)
    float mhat = 0.f, l = 0.f; f32x16 o0, o1, negm;
#pragma unroll
    for (int i = 0; i < 16; ++i) { o0[i] = 0.f; o1[i] = 0.f; negm[i] = 0.f; }
    const int g16 = lane >> 4, qq = (lane & 15) >> 2, pp = lane & 3;
    const int vlane = (4 * hi + qq) * VP + (16 * (g16 & 1) + 4 * pp) * 2;
    ATT_LOAD(0); ATT_WRITE(0); __syncthreads();
    unsigned wn0 = 0xffffffffu, wn1 = 0xffffffffu;
    const unsigned* bmq = MLA ? nullptr : P.BM + (size_t)b * 256 * SEQ + qrow;
    if (!MLA) { wn0 = bmq[0]; wn1 = bmq[SEQ]; }
    for (int t = 0; t < NT; ++t) {
        const int buf = t & 1;
        unsigned w0 = wn0 >> (4 * hi), w1 = wn1 >> (4 * hi);
        if (t + 1 < NT) { ATT_LOAD(t + 1); if (!MLA) { wn0 = bmq[(size_t)(2 * t + 2) * SEQ]; wn1 = bmq[(size_t)(2 * t + 3) * SEQ]; } }
        if (t < my_nt) {
            const LAS unsigned char* Kb = L + buf * KBUF; const LAS unsigned char* Vb = L + 2 * KBUF + buf * VBUF;
            f32x16 s0, s1;
            bf16x8 ka[NS][2];
#pragma unroll
            for (int s = 0; s < NS; ++s) { ka[s][0] = *(const LAS bf16x8*)(Kb + r32 * KP + s * 32 + hi * 16); ka[s][1] = *(const LAS bf16x8*)(Kb + (32 + r32) * KP + s * 32 + hi * 16); }
            __builtin_amdgcn_sched_barrier(0);
#pragma unroll
            for (int s = 0; s < NS; ++s) {
                s0 = __builtin_amdgcn_mfma_f32_32x32x16_bf16(ka[s][0], qf[s], s == 0 ? negm : s0, 0, 0, 0);
                s1 = __builtin_amdgcn_mfma_f32_32x32x16_bf16(ka[s][1], qf[s], s == 0 ? negm : s1, 0, 0, 0);
            }
            s16x4 vf[4][4];
#pragma unroll
            for (int ks = 0; ks < 4; ++ks) { const LAS unsigned char* vp = Vb + ks * 16 * VP + vlane;
                vf[ks][0] = __builtin_bit_cast(s16x4, __builtin_amdgcn_ds_read_tr16_b64_v4i16((LAS s16x4*)(vp)));
                vf[ks][1] = __builtin_bit_cast(s16x4, __builtin_amdgcn_ds_read_tr16_b64_v4i16((LAS s16x4*)(vp + 8 * VP)));
                vf[ks][2] = __builtin_bit_cast(s16x4, __builtin_amdgcn_ds_read_tr16_b64_v4i16((LAS s16x4*)(vp + 64)));
                vf[ks][3] = __builtin_bit_cast(s16x4, __builtin_amdgcn_ds_read_tr16_b64_v4i16((LAS s16x4*)(vp + 8 * VP + 64))); }
            __builtin_amdgcn_sched_barrier(0);
            float mx = fmaxf(fmaxf(s0[0], s0[1]), s1[0]);
#pragma unroll
            for (int i = 2; i < 16; i += 2) mx = fmaxf(fmaxf(mx, s0[i]), s0[i + 1]);
#pragma unroll
            for (int i = 1; i < 15; i += 2) mx = fmaxf(fmaxf(mx, s1[i]), s1[i + 1]);
            mx = fmaxf(mx, s1[15]);
            mx = fmaxf(mx, __shfl_xor(mx, 32));
            if (t == 0 || __any(mx > ATT_THR)) {
                const float dl = (t == 0) ? mx : fmaxf(mx, 0.f), f = (t == 0) ? 1.f : __builtin_amdgcn_exp2f(-dl);
                mhat += dl; l *= f;
#pragma unroll
                for (int i = 0; i < 16; ++i) { s0[i] -= dl; s1[i] -= dl; o0[i] *= f; o1[i] *= f; negm[i] = -mhat; }
            }
            float rs = 0.f;
#pragma unroll
            for (int i = 0; i < 16; ++i) {
                float p0 = __builtin_amdgcn_exp2f(s0[i]), p1 = __builtin_amdgcn_exp2f(s1[i]);
                if (!MLA) { p0 = att_mask(p0, w0, crow(i, 0)); p1 = att_mask(p1, w1, crow(i, 0)); }
                s0[i] = p0; s1[i] = p1; rs += p0 + p1; }
            l += rs;
            bf16x8 pf[4];
#pragma unroll
            for (int ks = 0; ks < 4; ++ks) { v4u w;
#pragma unroll
                for (int j = 0; j < 4; ++j) { const float a = (ks < 2) ? s0[8 * (ks & 1) + 2 * j] : s1[8 * (ks & 1) + 2 * j], c = (ks < 2) ? s0[8 * (ks & 1) + 2 * j + 1] : s1[8 * (ks & 1) + 2 * j + 1]; w[j] = pk2(a, c); }
                pf[ks] = __builtin_bit_cast(bf16x8, w); }
#pragma unroll
            for (int ks = 0; ks < 4; ++ks) {
                const bf16x8 A0 = __builtin_shufflevector(vf[ks][0], vf[ks][1], 0, 1, 2, 3, 4, 5, 6, 7);
                const bf16x8 A1 = __builtin_shufflevector(vf[ks][2], vf[ks][3], 0, 1, 2, 3, 4, 5, 6, 7);
                o0 = __builtin_amdgcn_mfma_f32_32x32x16_bf16(A0, pf[ks], o0, 0, 0, 0);
                o1 = __builtin_amdgcn_mfma_f32_32x32x16_bf16(A1, pf[ks], o1, 0, 0, 0);
            }
        }
        if (t + 1 < NT) ATT_WRITE(buf ^ 1);
        __syncthreads();
    }
    l += __shfl_xor(l, 32);
    const float inv = 1.f / l;
    bf16* op = P.O + (rowb + qrow) * 512 + h * 64 + 4 * hi;
#pragma unroll
    for (int g = 0; g < 4; ++g) {
        v2u w; w.x = pk2(o0[4 * g] * inv, o0[4 * g + 1] * inv); w.y = pk2(o0[4 * g + 2] * inv, o0[4 * g + 3] * inv); *(v2u*)(op + 8 * g) = w;
        v2u z; z.x = pk2(o1[4 * g] * inv, o1[4 * g + 1] * inv); z.y = pk2(o1[4 * g + 2] * inv, o1[4 * g + 3] * inv); *(v2u*)(op + 32 + 8 * g) = z;
    }
#undef ATT_KSRC
#undef ATT_LOAD
#undef ATT_WRITE
}

constexpr int CAND_CAP = 128, QIP = 1296, HS = 513, FAST_CAP = 512;
struct IdxP { const bf16 *QI, *KI; const float* WI; unsigned* BM; };
__device__ __forceinline__ unsigned mono_key(float s) { const unsigned u = __builtin_bit_cast(unsigned, s + 0.0f); return u ^ ((unsigned)((int)u >> 31) | 0x80000000u); }
__device__ __forceinline__ void idx_scores2(const bf16x8 (&kf)[2][4], const LAS unsigned char* qlane, const float (&wq)[8], f32x16& sc0, f32x16& sc1) {
    bf16x8 qv[4], qn[4];
#pragma unroll
    for (int s = 0; s < 4; ++s) qv[s] = *(const LAS bf16x8*)(qlane + 8 * 128 + s * 32);
#pragma unroll
    for (int i = 0; i < 16; ++i) { sc0[i] = 0.f; sc1[i] = 0.f; }
    f32x16 ap0, ap1;
#pragma unroll
    for (int i = 0; i < 16; ++i) { ap0[i] = 0.f; ap1[i] = 0.f; }
#pragma unroll
    for (int n = 0; n < 10; ++n) {
        const int nh = (n + 1 < 2) ? 9 : (n + 1 - 2);
        if (n + 1 < 10) {
#pragma unroll
            for (int s = 0; s < 4; ++s) qn[s] = *(const LAS bf16x8*)(qlane + nh * 128 + s * 32); }
        f32x16 a0, a1;
        if (n < 2) {
#pragma unroll
            for (int s = 0; s < 4; ++s) { sc0 = __builtin_amdgcn_mfma_f32_32x32x16_bf16(kf[0][s], qv[s], sc0, 0, 0, 0); sc1 = __builtin_amdgcn_mfma_f32_32x32x16_bf16(kf[1][s], qv[s], sc1, 0, 0, 0); }
        } else {
#pragma unroll
            for (int i = 0; i < 16; ++i) { a0[i] = 0.f; a1[i] = 0.f; }
#pragma unroll
            for (int s = 0; s < 4; ++s) { a0 = __builtin_amdgcn_mfma_f32_32x32x16_bf16(kf[0][s], qv[s], a0, 0, 0, 0); a1 = __builtin_amdgcn_mfma_f32_32x32x16_bf16(kf[1][s], qv[s], a1, 0, 0, 0); }
        }
        if (n >= 3) {
            const float w = wq[n - 3];
#pragma unroll
            for (int i = 0; i < 16; ++i) { sc0[i] = __builtin_fmaf(w, __builtin_fabsf(ap0[i]), sc0[i]); sc1[i] = __builtin_fmaf(w, __builtin_fabsf(ap1[i]), sc1[i]); }
#pragma unroll
            for (int g = 0; g < 8; ++g) { __builtin_amdgcn_sched_group_barrier(0x008, 1, 0); __builtin_amdgcn_sched_group_barrier(0x002, 4, 0); }
        }
        if (n >= 2) { ap0 = a0; ap1 = a1; }
#pragma unroll
        for (int s = 0; s < 4; ++s) qv[s] = qn[s];
    }
    { const float w = wq[7];
#pragma unroll
      for (int i = 0; i < 16; ++i) { sc0[i] = __builtin_fmaf(w, __builtin_fabsf(ap0[i]), sc0[i]); sc1[i] = __builtin_fmaf(w, __builtin_fabsf(ap1[i]), sc1[i]); } }
#pragma unroll
    for (int i = 0; i < 16; ++i) asm volatile("" : "+v"(sc0[i]), "+v"(sc1[i]));
}
__device__ __forceinline__ void idx_item(LAS unsigned char* L, int b, int j, const IdxP& P, int tid, int lane, int wave) {
    LAS unsigned* hist = (LAS unsigned*)L;
    LAS unsigned* img = (LAS unsigned*)(L + 66048);
    LAS unsigned* st = (LAS unsigned*)(L + 98816);
    LAS unsigned* cand = hist;
    LAS unsigned char* Qs = L + 100864;
    const int r32 = lane & 31, hi = lane >> 5;
    const int q0 = 32 * j, ntile = 2 * (j / 2 + 1);
    const size_t rowb = (size_t)b * SEQ;
    if (ntile <= 8) {
        for (int idx = tid; idx < ntile * 32; idx += NTHR) P.BM[((size_t)b * 256 + (idx >> 5)) * SEQ + q0 + (idx & 31)] = 0xffffffffu;
        return;
    }
    float wq[8];
    { for (int c = tid; c < 32 * 64; c += NTHR) { const int rr = c >> 6, ch = c & 63; *(LAS v4u*)(Qs + rr * QIP + ch * 16) = *(const v4u*)(P.QI + (rowb + q0 + rr) * 512 + ch * 8); }
      const float* wp = P.WI + (rowb + q0 + r32) * 8;
#pragma unroll
      for (int h = 0; h < 8; ++h) wq[h] = 0.5f * wp[h]; }
    if (tid < 32) { st[32 + tid] = 256u; st[64 + tid] = 0u; st[96 + tid] = 0u; }
    if (tid == 0) st[129] = 0u;
    __syncthreads();
    {
        const int r = tid >> 4, part = tid & 15;
        const float* wp = P.WI + (rowb + q0 + r) * 8;
        float qb[4] = {0.f, 0.f, 0.f, 0.f}; float rsum = 0.f;
#pragma unroll
        for (int h = 0; h < 8; ++h) { const float w = wp[h]; const v2u raw = *(const LAS v2u*)(Qs + r * QIP + h * 128 + part * 8);
            const float f0 = bflo(raw.x), f1 = bfhi(raw.x), f2 = bflo(raw.y), f3 = bfhi(raw.y);
            float nsq = (f0 * f0 + f1 * f1) + (f2 * f2 + f3 * f3);
#pragma unroll
            for (int o = 1; o < 16; o <<= 1) nsq += __shfl_xor(nsq, o);
            rsum += fabsf(w) * sqrtf(nsq);
            qb[0] += 0.5f * w * f0; qb[1] += 0.5f * w * f1; qb[2] += 0.5f * w * f2; qb[3] += 0.5f * w * f3; }
        v2u hw, lw;
        { const unsigned h01 = pk2(qb[0], qb[1]), h23 = pk2(qb[2], qb[3]); hw.x = h01; hw.y = h23;
          lw.x = pk2(qb[0] - bflo(h01), qb[1] - bfhi(h01)); lw.y = pk2(qb[2] - bflo(h23), qb[3] - bfhi(h23)); }
        *(LAS v2u*)(Qs + r * QIP + 8 * 128 + part * 8) = hw; *(LAS v2u*)(Qs + r * QIP + 9 * 128 + part * 8) = lw;
        { const v2u kw = *(const v2u*)(P.KI + (rowb + r) * 64 + part * 4); const float f0 = bflo(kw.x), f1 = bfhi(kw.x), f2 = bflo(kw.y), f3 = bfhi(kw.y);
          float ksq = (f0 * f0 + f1 * f1) + (f2 * f2 + f3 * f3);
#pragma unroll
          for (int o = 1; o < 16; o <<= 1) ksq += __shfl_xor(ksq, o);
          if (part == 0) { __hip_atomic_fetch_max(&st[129], __builtin_bit_cast(unsigned, ksq), __ATOMIC_RELAXED, __HIP_MEMORY_SCOPE_WORKGROUP); st[224 + r] = __builtin_bit_cast(unsigned, rsum); } }
    }
    __syncthreads();
    if (tid < 32) { const float R = 0.25f * sqrtf(__builtin_bit_cast(float, st[129])) * __builtin_bit_cast(float, st[224 + tid]);
        const float C = 0.125f * R;
        st[160 + tid] = (0x80000000u | __builtin_bit_cast(unsigned, R + C)) - 511u * 131072u; st[224 + tid] = __builtin_bit_cast(unsigned, C); st[tid] = 0u; st[192 + tid] = 0u;
        st[256 + tid] = __builtin_bit_cast(unsigned, R); st[288 + tid] = 511u; st[320 + tid] = 0u; }
    const LAS unsigned char* qlane = Qs + r32 * QIP + hi * 16;
    int level = 0;
    const int npair = ntile >> 1;
#define IDX_KLOAD2(tp) { const bf16* kp = P.KI + (rowb + 64 * (tp) + r32) * 64 + 8 * hi; _Pragma("unroll") for (int s = 0; s < 4; ++s) { kn[0][s] = *(const bf16x8*)(kp + 16 * s); kn[1][s] = *(const bf16x8*)(kp + 32 * 64 + 16 * s); } }
#define IDX_SCORES2(tp) \
        bf16x8 kf[2][4]; _Pragma("unroll") for (int s = 0; s < 4; ++s) { kf[0][s] = kn[0][s]; kf[1][s] = kn[1][s]; } \
        f32x16 sc0, sc1; idx_scores2(kf, qlane, wq, sc0, sc1); \
        if ((tp) + NWAVES < npair) { IDX_KLOAD2((tp) + NWAVES) }
    bool slow;
    {
        for (int u = tid; u < 32 * HS; u += NTHR) hist[u] = 0u;
        if (tid == 0) st[130] = 0u;
        __syncthreads();
        const float Rq = __builtin_bit_cast(float, st[256 + r32]);
        const int nsw = (npair + 63) >> 6, SP = min(npair, 8 * nsw);
        {   const float s1 = 256.f / Rq; LAS unsigned* hrow = hist + r32 * HS;
            for (int i = wave; i < SP; i += NWAVES) { const int tp = (i * npair) / SP;
                bf16x8 kn[2][4]; IDX_KLOAD2(tp)
                bf16x8 kf[2][4];
#pragma unroll
                for (int s = 0; s < 4; ++s) { kf[0][s] = kn[0][s]; kf[1][s] = kn[1][s]; }
                f32x16 sc0, sc1; idx_scores2(kf, qlane, wq, sc0, sc1);
#pragma unroll
                for (int e = 0; e < 16; ++e) { const int b0 = min(max((int)__builtin_fmaf(sc0[e], s1, 256.f), 0), 511), b1 = min(max((int)__builtin_fmaf(sc1[e], s1, 256.f), 0), 511);
                    __hip_atomic_fetch_add(&hrow[b0], 1u, __ATOMIC_RELAXED, __HIP_MEMORY_SCOPE_WORKGROUP); __hip_atomic_fetch_add(&hrow[b1], 1u, __ATOMIC_RELAXED, __HIP_MEMORY_SCOPE_WORKGROUP); }
            }
        }
        __syncthreads();
        {
            const int q = tid >> 4, seg = tid & 15; const LAS unsigned* hq = hist + q * HS + seg * 32;
            unsigned segsum = 0u;
            for (int wi = 0; wi < 32; ++wi) segsum += hq[wi];
            unsigned S = segsum;
#pragma unroll
            for (int off = 1; off < 16; off <<= 1) { const unsigned o = __shfl_down(S, off, 16); if (seg + off < 16) S += o; }
            const unsigned above = S - segsum, total = __shfl(S, 0, 16);
            const float f = (float)total / (float)(64 * npair), rs = 256.f * f, sg = 3.5f * sqrtf(rs * (1.f - f));
            const int rl = (int)floorf(rs - sg) - 1, rh = (int)ceilf(rs + sg) + 1;
            const unsigned tl = rl > 0 ? (unsigned)rl : 0u, th = (unsigned)rh;
            if (above < tl && tl <= above + segsum) { unsigned cum = above; int fb = 0; bool found = false;
                for (int wi = 31; wi >= 0; --wi) { const unsigned c = hq[wi]; if (!found && cum + c >= tl) { found = true; fb = wi; } if (!found) cum += c; }
                st[288 + q] = (unsigned)(32 * seg + fb); }
            if (above < th && th <= above + segsum) { unsigned cum = above; int fb = 0; bool found = false;
                for (int wi = 31; wi >= 0; --wi) { const unsigned c = hq[wi]; if (!found && cum + c >= th) { found = true; fb = wi; } if (!found) cum += c; }
                st[320 + q] = (unsigned)(32 * seg + fb); }
        }
        __syncthreads();
        {
            const float wbin = Rq * (1.f / 256.f), fH = __builtin_fmaf((float)(st[288 + r32] + 1u), wbin, -Rq), fA = __builtin_fmaf((float)st[320 + r32], wbin, -Rq), s2 = 524287.f / (fH - fA);
            bf16x8 kn[2][4]; if (wave < npair) { IDX_KLOAD2(wave) }
            for (int tp = wave; tp < npair; tp += NWAVES) {
                IDX_SCORES2(tp)
#define IDX_FAST_ELEMS(SC, T) { unsigned v = 0u, cm = 0u; _Pragma("unroll") for (int i = 15; i >= 0; --i) { const float ts = SC[i]; v = v + v + ((ts >= fH) ? 1u : 0u); cm = cm + cm + ((ts >= fA) ? 1u : 0u); } \
            cm &= ~v;                                                                                           \
            if (cm) { const unsigned pos0 = __hip_atomic_fetch_add(&st[96 + r32], (unsigned)__builtin_popcount(cm), __ATOMIC_RELAXED, __HIP_MEMORY_SCOPE_WORKGROUP);     \
                const unsigned rb = 8191u - (unsigned)(32 * (T)) - hi4; \
                _Pragma("unroll") for (int i = 0; i < 16; ++i) if (cm & (1u << i)) { const unsigned pos = pos0 + (unsigned)__builtin_popcount(cm & ((1u << i) - 1u)); \
                    if (pos < (unsigned)FAST_CAP) cand[r32 * FAST_CAP + pos] = (min((unsigned)((SC[i] - fA) * s2), 524287u) << 13) | (rb - (unsigned)((i & 3) + 8 * (i >> 2))); } } \
            unsigned bits = (v & 0xfu) | ((v & 0xf0u) << 4) | ((v & 0xf00u) << 8) | ((v & 0xf000u) << 12);     \
            bits <<= 4 * hi; bits |= __shfl_xor(bits, 32); if (hi == 0) img[(T) * 32 + r32] = bits; }
                unsigned hi4 = 4u * (unsigned)hi; asm volatile("" : "+v"(hi4));
                IDX_FAST_ELEMS(sc0, 2 * tp)
                IDX_FAST_ELEMS(sc1, 2 * tp + 1)
#undef IDX_FAST_ELEMS
            }
        }
        __syncthreads();
        {
            const int q = tid >> 4, l16 = tid & 15; unsigned above = 0u;
            for (int t = l16; t < ntile; t += 16) above += (unsigned)__builtin_popcount(img[t * 32 + q]);
#pragma unroll
            for (int o = 1; o < 16; o <<= 1) above += __shfl_xor(above, o);
            const unsigned n = st[96 + q];
            if (l16 == 0) { if (above >= 256u || 256u - above > n || n > (unsigned)FAST_CAP) st[130] = 1u; st[32 + q] = 256u - above; }
        }
        __syncthreads();
        slow = st[130] != 0u;
        if (!slow) {
            const int q = tid >> 4, l16 = tid & 15; const unsigned n = st[96 + q], need = st[32 + q];
            unsigned c[FAST_CAP / 16];
#pragma unroll
            for (int i = 0; i < FAST_CAP / 16; ++i) { const unsigned ci = (unsigned)(l16 + 16 * i); c[i] = ci < n ? cand[q * FAST_CAP + ci] : 0u; }
            unsigned Pv = 0u;
#pragma nounroll
            for (int bit = 31; bit >= 0; --bit) { const unsigned trial = Pv | (1u << bit); unsigned cnt = 0u;
#pragma unroll
                for (int i = 0; i < FAST_CAP / 16; ++i) cnt += (c[i] >= trial) ? 1u : 0u;
#pragma unroll
                for (int o = 1; o < 16; o <<= 1) cnt += __shfl_xor(cnt, o);
                if (cnt >= need) Pv = trial; }
#pragma unroll
            for (int i = 0; i < FAST_CAP / 16; ++i) if ((unsigned)(l16 + 16 * i) < n && c[i] >= Pv) { const unsigned kidx = 8191u - (c[i] & 8191u);
                __hip_atomic_fetch_or(&img[(kidx >> 5) * 32 + q], 1u << (kidx & 31), __ATOMIC_RELAXED, __HIP_MEMORY_SCOPE_WORKGROUP); }
        } else if (tid < 32) { st[32 + tid] = 256u; st[96 + tid] = 0u; }
        __syncthreads();
    }
    if (slow) {
    for (;;) {
        ++level;
        for (int u = tid; u < 32 * HS; u += NTHR) hist[u] = 0u;
        if (tid == 0) st[128] = 0u;
        __syncthreads();
        {
            const unsigned qa = st[r32], qlen = st[192 + r32], base1 = st[160 + r32]; const float cq = __builtin_bit_cast(float, st[224 + r32]);
            const int sh = (level > 1 && qlen > 512u) ? (32 - __builtin_clz(qlen - 1u)) - 9 : 0;
            LAS unsigned* hrow = hist + r32 * HS;
            bf16x8 kn[2][4]; if (wave < npair) { IDX_KLOAD2(wave) }
            for (int tp = wave; tp < npair; tp += NWAVES) {
                IDX_SCORES2(tp)
                if (level == 1) {
#pragma unroll
                    for (int i = 0; i < 16; ++i) { const unsigned k0 = mono_key(sc0[i] + cq), k1 = mono_key(sc1[i] + cq);
                        const unsigned b0 = min((max(k0, base1) - base1) >> 17, 511u), b1 = min((max(k1, base1) - base1) >> 17, 511u);
                        __hip_atomic_fetch_add(&hrow[b0], 1u, __ATOMIC_RELAXED, __HIP_MEMORY_SCOPE_WORKGROUP); __hip_atomic_fetch_add(&hrow[b1], 1u, __ATOMIC_RELAXED, __HIP_MEMORY_SCOPE_WORKGROUP); }
                } else {
#pragma unroll
                    for (int i = 0; i < 16; ++i) { const unsigned o0 = mono_key(sc0[i] + cq) - qa, o1 = mono_key(sc1[i] + cq) - qa;
                        if (o0 < qlen) __hip_atomic_fetch_add(&hrow[o0 >> sh], 1u, __ATOMIC_RELAXED, __HIP_MEMORY_SCOPE_WORKGROUP);
                        if (o1 < qlen) __hip_atomic_fetch_add(&hrow[o1 >> sh], 1u, __ATOMIC_RELAXED, __HIP_MEMORY_SCOPE_WORKGROUP); }
                }
            }
        }
        __syncthreads();
        {
            const int q = tid >> 4, seg = tid & 15;
            unsigned segsum = 0u;
            for (int wi = 0; wi < 32; ++wi) segsum += hist[q * HS + seg * 32 + wi];
            unsigned S = segsum;
#pragma unroll
            for (int off = 1; off < 16; off <<= 1) { const unsigned o = __shfl_down(S, off, 16); if (seg + off < 16) S += o; }
            const unsigned above = S - segsum, need = st[32 + q];
            if (above < need && need <= above + segsum) {
                unsigned cum = above, fbin = 0u, fneed = 1u, fcnt = 0u; bool found = false;
                for (int wi = 31; wi >= 0; --wi) { const unsigned c = hist[q * HS + seg * 32 + wi];
                    if (!found && cum + c >= need) { found = true; fbin = (unsigned)wi; fneed = need - cum; fcnt = c; } if (!found) cum += c; }
                fbin += 32u * (unsigned)seg;
                unsigned na, nlen;
                if (level == 1) { const unsigned base1 = st[160 + q];
                    if (fbin == 0u) { na = 0u; nlen = base1 + 131072u; } else if (fbin == 511u) { na = base1 + 511u * 131072u; nlen = 0u - na; } else { na = base1 + fbin * 131072u; nlen = 131072u; } }
                else { const unsigned qa = st[q], qlen = st[192 + q]; const int sh = qlen > 512u ? (32 - __builtin_clz(qlen - 1u)) - 9 : 0;
                    na = qa + (fbin << sh); nlen = min(1u << sh, qlen - (fbin << sh)); }
                st[q] = na; st[192 + q] = nlen; st[32 + q] = fneed; st[64 + q] = fcnt;
                if (fcnt > (unsigned)CAND_CAP && nlen > 1u) st[128] = 1u;
            }
        }
        __syncthreads();
#ifndef MAXLVL
#define MAXLVL 8
#endif
        const bool more = (st[128] != 0u) && (level < MAXLVL);
        __syncthreads();
        if (!more) break;
    }
    {
        const unsigned qa = st[r32], qlen = st[192 + r32]; const float cq = __builtin_bit_cast(float, st[224 + r32]);
        const unsigned Hk = qa + qlen - 1u;
        unsigned hb = (Hk & 0x80000000u) ? (Hk ^ 0x80000000u) : ~Hk;
        if (hb == 0x80000000u) hb = 0x80000001u;
        const float fH = __builtin_bit_cast(float, hb);
        const unsigned ab_ = (qa & 0x80000000u) ? (qa ^ 0x80000000u) : ~qa;
        const float fA = (qa < 0x00800000u) ? -__builtin_inff() : __builtin_bit_cast(float, ab_);
        bf16x8 kn[2][4]; if (wave < npair) { IDX_KLOAD2(wave) }
        for (int tp = wave; tp < npair; tp += NWAVES) {
            IDX_SCORES2(tp)
#define IDX_COLLECT_ELEMS(SC, T) { unsigned v = 0u; _Pragma("unroll") for (int i = 15; i >= 0; --i) { const float ts = SC[i] + cq; const bool ab = ts > fH; v = v + v + (ab ? 1u : 0u); \
                if (!ab && ts >= fA) { const unsigned key = mono_key(ts); \
                    const unsigned pos = __hip_atomic_fetch_add(&st[96 + r32], 1u, __ATOMIC_RELAXED, __HIP_MEMORY_SCOPE_WORKGROUP); \
                    if (pos < (unsigned)CAND_CAP) { cand[(r32 * CAND_CAP + pos) * 2] = key; cand[(r32 * CAND_CAP + pos) * 2 + 1] = (unsigned)(32 * (T) + crow(i, hi)); } } } \
            unsigned bits = (v & 0xfu) | ((v & 0xf0u) << 4) | ((v & 0xf00u) << 8) | ((v & 0xf000u) << 12);     \
            bits <<= 4 * hi; bits |= __shfl_xor(bits, 32); if (hi == 0) img[(T) * 32 + r32] = bits; }
            IDX_COLLECT_ELEMS(sc0, 2 * tp)
            IDX_COLLECT_ELEMS(sc1, 2 * tp + 1)
#undef IDX_COLLECT_ELEMS
        }
    }
#undef IDX_SCORES2
#undef IDX_KLOAD2
    __syncthreads();
    {
        const int q = tid >> 4; const unsigned n = min(st[96 + q], (unsigned)CAND_CAP), need = st[32 + q];
        for (unsigned c = tid & 15; c < n; c += 16) { const unsigned key = cand[(q * CAND_CAP + c) * 2], idx = cand[(q * CAND_CAP + c) * 2 + 1]; unsigned rank = 0u;
            for (unsigned o = 0; o < n; ++o) { const unsigned k2 = cand[(q * CAND_CAP + o) * 2], i2 = cand[(q * CAND_CAP + o) * 2 + 1]; rank += (k2 > key || (k2 == key && i2 < idx)) ? 1u : 0u; }
            if (rank < need) __hip_atomic_fetch_or(&img[(idx >> 5) * 32 + q], 1u << (idx & 31), __ATOMIC_RELAXED, __HIP_MEMORY_SCOPE_WORKGROUP); }
    }
    }
    __syncthreads();
    for (int idx = tid; idx < ntile * 32; idx += NTHR) P.BM[((size_t)b * 256 + (idx >> 5)) * SEQ + q0 + (idx & 31)] = img[idx];
    __syncthreads();
}

__device__ __forceinline__ int wq_next(Frame& F, int cw) {
    __syncthreads();
    if (F_TID == 0) F.MISC[0] = __hip_atomic_fetch_add((unsigned*)(F.ctl + cw), 1u, RLX_AGENT);
    __syncthreads();
    return (int)F.MISC[0];
}

__device__ __forceinline__ void p5a_route(Frame& F, const Args& A) {
    const int lane = F_LANE, tid = F_TID, wave = F_WAVE;
    const float* x1 = A.out; const float* g2 = A.in[11];
    const float* wrg = A.in[12]; const float* brg = A.in[13]; const float* wre = A.in[14]; const float* bre = A.in[15];
    int* toke = (int*)(F.ws + WS_TOKE); float* tokw = (float*)(F.ws + WS_TOKW); float* rstd2 = (float*)(F.ws + WS_RSTD2);
    int* sslot = (int*)(F.ws + WS_SSLOT);
    constexpr int WST = 44, WCH = 256 * WST * 4;
    LAS float* wl = (LAS float*)F.lds;
    LAS unsigned* lcnt = (LAS unsigned*)(F.lds + 2 * WCH);
    LAS float* lgs = (LAS float*)(F.lds + 2 * WCH + 256);
    for (int i = F.vcu * NTHR + tid; i < SORT_ROWS; i += F.G * NTHR) sslot[i] = -1;
    if (tid < NEXP) lcnt[tid] = 0u;
    const int i16 = lane & 15, kq = lane >> 4, tile = wave & 3, half = wave >> 2;
    const int per = T / F.G;
    for (int t0 = F.vcu * per; t0 < (F.vcu + 1) * per; t0 += 64) {
        const float* xr = x1 + (size_t)(t0 + 16 * tile + i16) * D + 4 * kq;
        f32x4 acc0 = (f32x4){0.f, 0.f, 0.f, 0.f}, acc1 = acc0; float ss = 0.f;
        f32x4 se[4], sg; float gk[5];
#define RT_LOAD(c) do { _Pragma("unroll") for (int q = 0; q < 4; ++q) { const int f = tid + 512 * q, k = f >> 3; se[q] = *(const GAS f32x4*)(wre + (size_t)(256 * (c) + k) * 32 + 4 * (f & 7)); gk[q] = g2[256 * (c) + k]; } \
            { const int k = tid >> 1; sg = *(const GAS f32x4*)(wrg + (size_t)(256 * (c) + k) * 8 + 4 * (tid & 1)); gk[4] = g2[256 * (c) + k]; } } while (0)
#define RT_WRITE(bf) do { LAS float* wb = wl + (bf) * (WCH / 4); _Pragma("unroll") for (int q = 0; q < 4; ++q) { const int f = tid + 512 * q, k = f >> 3; *(LAS f32x4*)(wb + k * WST + 4 * (f & 7)) = se[q] * gk[q]; } \
            { const int k = tid >> 1; *(LAS f32x4*)(wb + k * WST + 32 + 4 * (tid & 1)) = sg * gk[4]; } } while (0)
        RT_LOAD(0); RT_WRITE(0); __syncthreads();
        for (int c = 0; c < 4; ++c) {
            if (c + 1 < 4) RT_LOAD(c + 1);
            const LAS float* wb = wl + (c & 1) * (WCH / 4) + 4 * kq * WST + i16 + 16 * half;
#pragma unroll 4
            for (int s = 0; s < 16; ++s) {
                const f32x4 a4 = *(const GAS f32x4*)(xr + 256 * c + 16 * s);
                if (half == 0) ss += (a4.x * a4.x + a4.y * a4.y) + (a4.z * a4.z + a4.w * a4.w);
#pragma unroll
                for (int cc = 0; cc < 4; ++cc) { const LAS float* wp = wb + (16 * s + cc) * WST;
                    acc0 = __builtin_amdgcn_mfma_f32_16x16x4f32(a4[cc], wp[0], acc0, 0, 0, 0);
                    if (half == 0) acc1 = __builtin_amdgcn_mfma_f32_16x16x4f32(a4[cc], wp[32 - (i16 & 8)], acc1, 0, 0, 0); }
            }
            if (c + 1 < 4) RT_WRITE((c + 1) & 1);
            __syncthreads();
        }
#undef RT_LOAD
#undef RT_WRITE
        LAS float* lt = lgs + tile * 640;
#pragma unroll
        for (int r = 0; r < 4; ++r) { const int tk = 4 * kq + r; lt[tk * 40 + 8 + 16 * half + i16] = acc0[r]; if (half == 0 && i16 < 8) lt[tk * 40 + i16] = acc1[r]; }
        if (half == 0) { ss += __shfl_xor(ss, 16); ss += __shfl_xor(ss, 32); if (kq == 0) lgs[2560 + 16 * tile + i16] = 1.f / sqrtf(ss * (1.f / D) + EPS); }
        __syncthreads();
        if (half == 0 && lane < 16) {
            const int m = t0 + 16 * tile + lane; const float rstd = lgs[2560 + 16 * tile + lane]; const LAS float* lg = lt + lane * 40;
            float gl[8];
#pragma unroll
            for (int k = 0; k < 8; ++k) gl[k] = lg[k] * rstd + brg[k];
            int gs = 0; float gm = gl[0];
#pragma unroll
            for (int k = 1; k < 8; ++k) if (gl[k] > gm) { gm = gl[k]; gs = k; }
            float den = 0.f;
#pragma unroll
            for (int k = 0; k < 8; ++k) den += __expf(gl[k] - gm);
            const float wgrp = 1.f / den;
            float el[4];
#pragma unroll
            for (int cc = 0; cc < 4; ++cc) el[cc] = lg[8 + 4 * gs + cc] * rstd + bre[4 * gs + cc];
            int i1 = 0; float v1 = el[0];
#pragma unroll
            for (int cc = 1; cc < 4; ++cc) if (el[cc] > v1) { v1 = el[cc]; i1 = cc; }
            int i2 = -1; float v2 = 0.f;
#pragma unroll
            for (int cc = 0; cc < 4; ++cc) if (cc != i1 && (i2 < 0 || el[cc] > v2)) { v2 = el[cc]; i2 = cc; }
            const float e2 = __expf(v2 - v1), w1 = 1.f / (1.f + e2), w2 = e2 / (1.f + e2);
            toke[2 * m] = gs * 4 + i1; toke[2 * m + 1] = gs * 4 + i2; tokw[2 * m] = w1 * wgrp; tokw[2 * m + 1] = w2 * wgrp; rstd2[m] = rstd;
            __hip_atomic_fetch_add(&lcnt[gs * 4 + i1], 1u, __ATOMIC_RELAXED, __HIP_MEMORY_SCOPE_WORKGROUP);
            __hip_atomic_fetch_add(&lcnt[gs * 4 + i2], 1u, __ATOMIC_RELAXED, __HIP_MEMORY_SCOPE_WORKGROUP);
        }
        __syncthreads();
    }
    if (tid < NEXP && lcnt[tid]) __hip_atomic_fetch_add((unsigned*)(F.ctl + CW_CNT + tid), lcnt[tid], RLX_AGENT);
}

__device__ __forceinline__ void p5a2_scatter(Frame& F, const Args& A) {
    const int lane = F_LANE, tid = F_TID;
    const float* x1 = A.out; const float* g2 = A.in[11];
    const int* toke = (const int*)(F.ws + WS_TOKE); const float* tokw = (const float*)(F.ws + WS_TOKW); const float* rstd2 = (const float*)(F.ws + WS_RSTD2);
    int* sslot = (int*)(F.ws + WS_SSLOT); float* sw = (float*)(F.ws + WS_SW); int* t2e = (int*)(F.ws + WS_T2E);
    bf16* AS = (bf16*)(F.ws + WS_ASORT);
    LAS unsigned* sh = (LAS unsigned*)F.lds;
    if (tid < NEXP) sh[256 + tid] = __hip_atomic_load((unsigned*)(F.ctl + CW_CNT + tid), RLX_AGENT);
    __syncthreads();
    if (tid == 0) { unsigned acc = 0u;
        for (int e = 0; e < NEXP; ++e) { const unsigned c = sh[256 + e]; sh[e] = acc; const unsigned nt = (c + 255u) / 256u;
            if (blockIdx.x == 0) for (unsigned i = 0; i < nt; ++i) t2e[acc / 256u + i] = e;
            acc += nt * 256u; }
        if (blockIdx.x == 0) t2e[255] = (int)(acc / 256u); }
    const int per = T / F.G;
    for (int t0 = F.vcu * per; t0 < (F.vcu + 1) * per; t0 += 64) {
        if (tid < NEXP) sh[32 + tid] = 0u;
        __syncthreads();
        int e = 0; unsigned lpos = 0u;
        if (tid < 128) { e = toke[2 * t0 + tid]; lpos = __hip_atomic_fetch_add(&sh[32 + e], 1u, __ATOMIC_RELAXED, __HIP_MEMORY_SCOPE_WORKGROUP); }
        __syncthreads();
        if (tid < NEXP) sh[64 + tid] = sh[tid] + (sh[32 + tid] ? __hip_atomic_fetch_add((unsigned*)(F.ctl + CW_FILL + tid), sh[32 + tid], RLX_AGENT) : 0u);
        __syncthreads();
        if (tid < 128) { const unsigned pos = sh[64 + e] + lpos; sh[96 + tid] = pos; sslot[pos] = 2 * t0 + tid; sw[pos] = tokw[2 * t0 + tid]; }
        __syncthreads();
        for (int tk0 = F_WAVE; tk0 < 64; tk0 += 4 * NWAVES) {
            f32x4 xv[4][4];
#pragma unroll
            for (int r = 0; r < 4; ++r) { const GAS f32x4* xr = (const GAS f32x4*)(x1 + (size_t)(t0 + tk0 + r * NWAVES) * D) + lane;
#pragma unroll
                for (int j = 0; j < 4; ++j) xv[r][j] = xr[64 * j]; }
#pragma unroll
            for (int r = 0; r < 4; ++r) { const int tk = tk0 + r * NWAVES, m = t0 + tk; const float rstd = rstd2[m];
                const unsigned p0 = sh[96 + 2 * tk], p1 = sh[96 + 2 * tk + 1];
#pragma unroll
                for (int j = 0; j < 4; ++j) { const f32x4 g = *((const GAS f32x4*)g2 + lane + 64 * j); const f32x4 y = xv[r][j] * rstd * g; v2u w; w.x = pk2(y.x, y.y); w.y = pk2(y.z, y.w);
                    *((GAS v2u*)(AS + (size_t)p0 * D) + lane + 64 * j) = w; *((GAS v2u*)(AS + (size_t)p1 * D) + lane + 64 * j) = w; } } }
        __syncthreads();
    }
}

__device__ __forceinline__ void p6_final(Frame& F, const Args& A) {
    const int gw = F.vcu * NWAVES + F_WAVE, NGW = F.G * NWAVES, lane = F_LANE;
    const float* gf = A.in[19]; float* out = A.out; const bf16* SL = (const bf16*)(F.ws + WS_SLOTS);
    for (int m0 = gw; m0 < T; m0 += 2 * NGW) {
        f32x4 v[2][4]; v2u a[2][4], c[2][4];
#pragma unroll
        for (int r = 0; r < 2; ++r) { const int m = min(m0 + r * NGW, T - 1); const GAS f32x4* xr = (const GAS f32x4*)(out + (size_t)m * D) + lane;
            const GAS v2u* s0 = (const GAS v2u*)(SL + (size_t)(2 * m) * D) + lane; const GAS v2u* s1 = (const GAS v2u*)(SL + (size_t)(2 * m + 1) * D) + lane;
#pragma unroll
            for (int j = 0; j < 4; ++j) { v[r][j] = xr[64 * j]; a[r][j] = s0[64 * j]; c[r][j] = s1[64 * j]; } }
#pragma unroll
        for (int r = 0; r < 2; ++r) { const int m = m0 + r * NGW; float s = 0.f;
#pragma unroll
            for (int j = 0; j < 4; ++j) { f32x4& w = v[r][j];
                w.x += bflo(a[r][j].x) + bflo(c[r][j].x); w.y += bfhi(a[r][j].x) + bfhi(c[r][j].x); w.z += bflo(a[r][j].y) + bflo(c[r][j].y); w.w += bfhi(a[r][j].y) + bfhi(c[r][j].y);
                s += (w.x * w.x + w.y * w.y) + (w.z * w.z + w.w * w.w); }
            const float rstd = 1.f / sqrtf(wave_sum(s) * (1.f / D) + EPS);
            if (m < T) { GAS f32x4* xo = (GAS f32x4*)(out + (size_t)m * D) + lane;
#pragma unroll
                for (int j = 0; j < 4; ++j) { const f32x4 g = *((const GAS f32x4*)gf + lane + 64 * j); xo[64 * j] = v[r][j] * rstd * g; } } }
    }
}

constexpr int NPHASE = 13;
__global__ void __launch_bounds__(NTHR, 2) mk_fwd(Args args) {
    extern __shared__ __attribute__((aligned(16))) unsigned char lds[];
    Frame F;
    F.lds = (LAS unsigned char*)lds; F.MISC = (volatile LAS unsigned*)(F.lds + MISC_OFF);
        F.G = gridDim.x; { const int bx = blockIdx.x; F.vcu = (F.G % 8 == 0) ? (bx % 8) * (F.G / 8) + bx / 8 : bx; }
    F.ws = args.ws; F.ctl = (gu32*)(args.ws + WS_CTL);
    unsigned char* ws = args.ws;
    if (F_TID < 128) F.MISC[F_TID] = 0u;
    __syncthreads();
    const bool single = (args.ph_hi - args.ph_lo) > 1;
    XcdBarrier bar; bar.bar = (unsigned*)(F.ctl + CW_BAR); bar.x = 0; bar.st = nullptr;
    if (single) bar = xcd_barrier_post((unsigned*)(F.ctl + CW_BAR), F.MISC + 8);
    const int lo = args.ph_lo, hi = args.ph_hi;
#ifdef ONLY
#define IN(k) ((k) == ONLY && lo <= (k) && (k) < hi)
#else
#define IN(k) (lo <= (k) && (k) < hi)
#endif
#ifdef TS_A
#define STAMP(k) do { if (blockIdx.x == 0 && threadIdx.x == 0) ((unsigned long long*)(ws + WS_CTL + 8192))[(k) + 1] = __builtin_amdgcn_s_memrealtime(); } while (0)
#else
#define STAMP(k) do { } while (0)
#endif
#define SEAM(k) do { if (IN((k) + 1)) xcd_barrier(bar); STAMP(k); } while (0)
    const f32x2* rope = (const f32x2*)(ws + WS_ROPE);
    bf16* GA = (bf16*)args.out; bf16* GB = (bf16*)args.out + (size_t)T * 1024;

    STAMP(-1);
    if (IN(0)) { p0_prologue(F, args);
#ifdef REP_P0
        p0_prologue(F, args);
#endif
        SEAM(0); }
    if (IN(1)) {
        pg8::Gemm g{(const bf16*)(ws + WS_H), (const bf16*)(ws + WS_WIN), T, NIN, D, 0}; pg8::StaticOrder S; S.init(T, NIN, F.G, (int)blockIdx.x);
        pg8::EpiIn E{(bf16*)(ws + WS_CQ), (bf16*)(ws + WS_CKV), (bf16*)(ws + WS_QB), (bf16*)(ws + WS_KB), (bf16*)(ws + WS_VB), (bf16*)(ws + WS_QI), (bf16*)(ws + WS_KI), (bf16*)(ws + WS_KR), GA, GB, (float*)(ws + WS_WI), rope};
        pg8::gemm_phase<pg8::EpiIn, pg8::StaticOrder, true, true>(F.lds, g, S, E);
#ifdef REP_P1
        pg8::gemm_phase<pg8::EpiIn, pg8::StaticOrder, true, true>(F.lds, g, S, E);
#endif
        SEAM(1);
    }
    if (IN(2)) { p2a_norms(F, args); SEAM(2); }
    if (IN(3)) {
#ifdef REP_P3
      for (int rep = 0; rep < 2; ++rep) {
#else
      {
#endif
#ifndef NO3A
        { pg8::Gemm g{(const bf16*)(ws + WS_CQ), (const bf16*)(ws + WS_WUQ), T, 768, 384, 0}; pg8::StaticOrder S; S.init(T, 768, F.G, (int)blockIdx.x);
          pg8::EpiQA E{(bf16*)(ws + WS_QA), rope}; pg8::gemm_phase<pg8::EpiQA, pg8::StaticOrder, true, true>(F.lds, g, S, E); }
#endif
#ifndef NO3B
        { pg8::Gemm g{(const bf16*)(ws + WS_CKV), (const bf16*)(ws + WS_WUKV), T, 1024, 256, 0}; pg8::StaticOrder S; S.init(T, 1024, F.G, (int)blockIdx.x);
          pg8::EpiKV E{(bf16*)(ws + WS_KN), (bf16*)(ws + WS_VA)}; pg8::gemm_phase<pg8::EpiKV, pg8::StaticOrder, true, true>(F.lds, g, S, E); }
#endif
      }
        SEAM(3);
    }
    if (IN(4)) {
        unsigned* rdy = (unsigned*)(F.ctl + CW_RDY);
        for (;;) { const int k = wq_next(F, CW_Q1); if (k >= 1536 + CV_QITEMS) break;
            int ltid = threadIdx.x; asm volatile("" : "+v"(ltid));
            const int lw = __builtin_amdgcn_readfirstlane(ltid >> 6);
            if (k < 512) { const int ib = k & 1, ij = 255 - (k >> 1);
                const IdxP IP{(const bf16*)(ws + WS_QI), (const bf16*)(ws + WS_KI), (const float*)(ws + WS_WI), (unsigned*)(ws + WS_BM)};
                idx_item(F.lds, ib, ij, IP, ltid, ltid & 63, lw);
                VM_WAIT(); __syncthreads();
                if (ltid == 0) { __builtin_amdgcn_fence(__ATOMIC_RELEASE, "agent"); VM_WAIT(); __hip_atomic_fetch_add(rdy + 64 * (ib * 32 + (ij >> 3)), 1u, RLX_AGENT); }
                continue; }
            const int j = k - 512; int a;
            if (j < 3 * CV_QITEMS) { const int q3 = j / 3, r3 = j - 3 * q3; a = (r3 == 2) ? -1 - q3 : 2 * q3 + r3; } else a = j - CV_QITEMS;
            if (a < 0) { const int c = -1 - a; LAS float* scr = (LAS float*)(F.lds + lw * 16640);
                conv_tile2(args, ws, CV_EARLY + 16 * c + lw, CV_EARLY + 16 * c + 8 + lw, scr, ltid & 63);
                continue; }
            { const int u = a >> 1, ub = (u & 15) >> 3, uh = u & 7, uq = 31 - (u >> 4);
                if (a & 1) { const AttnP APA{(const bf16*)(ws + WS_QA), (const bf16*)(ws + WS_KN), (const bf16*)(ws + WS_KR), (const bf16*)(ws + WS_VA), (bf16*)(ws + WS_OA), nullptr};
                    attn_unit<true>(F.lds, ub, uh, uq, APA, ltid, ltid & 63, lw); }
                else { const AttnP APB{(const bf16*)(ws + WS_QB), (const bf16*)(ws + WS_KB), nullptr, (const bf16*)(ws + WS_VB), (bf16*)(ws + WS_OB), (const unsigned*)(ws + WS_BM)};
                    if (ltid == 0) { unsigned sp = 0u; while (__hip_atomic_load(rdy + 64 * (ub * 32 + uq), RLX_AGENT) < 8u) { __builtin_amdgcn_s_sleep(8); if (++sp > (1u << 22)) break; }
                        __builtin_amdgcn_fence(__ATOMIC_ACQUIRE, "agent"); VM_WAIT(); }
                    __syncthreads();
                    attn_unit<false>(F.lds, ub, uh, uq, APB, ltid, ltid & 63, lw); } }
        }
    }
    if (IN(5)) { SEAM(5); }
    if (IN(6)) {
#ifdef REP_P6
      for (int rep = 0; rep < 2; ++rep) {
#else
      {
#endif
        { pg8::Gemm g{(const bf16*)(ws + WS_OA), (const bf16*)(ws + WS_WOA), T, 1024, 512, 0}; pg8::StaticOrder S; S.init(T, 1024, F.G, (int)blockIdx.x);
          pg8::EpiY<0> E{(bf16*)(ws + WS_Y), GA}; pg8::gemm_phase<pg8::EpiY<0>, pg8::StaticOrder, true, true>(F.lds, g, S, E); }
        { pg8::Gemm g{(const bf16*)(ws + WS_OB), (const bf16*)(ws + WS_WOB), T, 1024, 512, 0}; pg8::StaticOrder S; S.init(T, 1024, F.G, (int)blockIdx.x);
          pg8::EpiY<1> E{(bf16*)(ws + WS_Y), GB}; pg8::gemm_phase<pg8::EpiY<1>, pg8::StaticOrder, true, true>(F.lds, g, S, E); }
      }
        SEAM(6);
    }
    if (IN(7)) {
        pg8::Gemm g{(const bf16*)(ws + WS_Y), (const bf16*)(ws + WS_WOUT), T, 1024, 1024, 0}; pg8::StaticOrder S; S.init(T, 1024, F.G, (int)blockIdx.x);
        pg8::EpiX1 E{args.in[0], args.out}; pg8::gemm_phase<pg8::EpiX1, pg8::StaticOrder, true, true>(F.lds, g, S, E);
#ifdef REP_P7
        pg8::gemm_phase<pg8::EpiX1, pg8::StaticOrder, true, true>(F.lds, g, S, E);
#endif
        SEAM(7);
    }
    if (IN(8)) { p5a_route(F, args); SEAM(8); }
    if (IN(9)) { p5a2_scatter(F, args); SEAM(9); }
    if (IN(10)) {
        const int* t2e = (const int*)(ws + WS_T2E); const int ntl = t2e[255];
        pg8::Gemm g{(const bf16*)(ws + WS_ASORT), (const bf16*)(ws + WS_WGU), SORT_ROWS, 512, 1024, (size_t)512 * 1024 * 2}; pg8::GroupOrder S; S.init(ntl, 2, F.G, (int)blockIdx.x, t2e);
        pg8::EpiHid E{(bf16*)(ws + WS_HID)}; pg8::gemm_phase<pg8::EpiHid, pg8::GroupOrder, true, true>(F.lds, g, S, E);
#ifdef REP_P10
        pg8::gemm_phase<pg8::EpiHid, pg8::GroupOrder, true, true>(F.lds, g, S, E);
#endif
        SEAM(10);
    }
    if (IN(11)) {
        const int* t2e = (const int*)(ws + WS_T2E); const int ntl = t2e[255];
        pg8::Gemm g{(const bf16*)(ws + WS_HID), (const bf16*)(ws + WS_WD), SORT_ROWS, 1024, 256, (size_t)1024 * 256 * 2}; pg8::GroupOrder S; S.init(ntl, 4, F.G, (int)blockIdx.x, t2e);
        pg8::EpiDown E{(bf16*)(ws + WS_SLOTS), (const int*)(ws + WS_SSLOT), (const float*)(ws + WS_SW)}; pg8::gemm_phase<pg8::EpiDown, pg8::GroupOrder, true, true>(F.lds, g, S, E);
#ifdef REP_P11
        pg8::gemm_phase<pg8::EpiDown, pg8::GroupOrder, true, true>(F.lds, g, S, E);
#endif
        SEAM(11);
    }
    if (IN(12)) { p6_final(F, args); }
#ifdef TS_A
    if (blockIdx.x == 0 && threadIdx.x == 0) { STAMP(12); __builtin_amdgcn_s_waitcnt(0);
        const unsigned long long* tsp = (const unsigned long long*)(ws + WS_CTL + 8192);
        const unsigned long long ta = __hip_atomic_load(tsp + (TS_A) + 1, RLX_AGENT), tb = __hip_atomic_load(tsp + (TS_B) + 1, RLX_AGENT);
        const unsigned long long t0 = __builtin_amdgcn_s_memrealtime(), wait = 4ull * (tb - ta);
        while (__builtin_amdgcn_s_memrealtime() - t0 < wait) __builtin_amdgcn_s_sleep(16); }
#endif
#undef IN
#undef SEAM
}

#ifndef MK_MULTI
#define MK_MULTI 0
#endif
extern "C" void kernel_launch(void* const* d_in, const int* in_sizes, int n_in, void* d_out, int out_size, void* d_ws, size_t ws_size, hipStream_t stream) {
    static int grid = 0;
    if (grid == 0) {
        if (n_in != 20 || in_sizes[0] != T * D || out_size != T * D || ws_size < WS_END) { fprintf(stderr, "kernel_launch: unexpected shapes n_in %d in0 %d out %d ws %zu\n", n_in, n_in > 0 ? in_sizes[0] : -1, out_size, ws_size); grid = -1; return; }
        int dev = 0, cus = 0;
        if (hipGetDevice(&dev) != hipSuccess || hipDeviceGetAttribute(&cus, hipDeviceAttributeMultiprocessorCount, dev) != hipSuccess) { grid = -1; return; }
        if (hipFuncSetAttribute((const void*)mk_fwd, hipFuncAttributeMaxDynamicSharedMemorySize, LDS_BYTES) != hipSuccess) { fprintf(stderr, "kernel_launch: hipFuncSetAttribute failed\n"); grid = -1; return; }
        (void)hipGetLastError();
        grid = cus;
    }
    if (grid < 0) return;
    if (hipMemsetAsync((char*)d_ws + WS_CTL, 0, CTL_ZERO_BYTES, stream) != hipSuccess) return;
    Args a{};
    for (int i = 0; i < 20; ++i) a.in[i] = (const float*)d_in[i];
    a.out = (float*)d_out; a.ws = (unsigned char*)d_ws;
#if MK_MULTI
    for (int p = 0; p < NPHASE; ++p) { a.ph_lo = p; a.ph_hi = p + 1; hipLaunchKernelGGL(mk_fwd, dim3(grid), dim3(NTHR), LDS_BYTES, stream, a); }
#else
    a.ph_lo = 0; a.ph_hi = NPHASE;
    hipLaunchKernelGGL(mk_fwd, dim3(grid), dim3(NTHR), LDS_BYTES, stream, a);
#endif
}
```

```cpp
#include <hip/hip_runtime.h>
#include <cstdio>
#include <cstdint>

#define GAS __attribute__((address_space(1)))
#define LAS __attribute__((address_space(3)))
typedef unsigned short bf16;
typedef unsigned v4u __attribute__((ext_vector_type(4)));
typedef unsigned v2u __attribute__((ext_vector_type(2)));
typedef float f32x4 __attribute__((ext_vector_type(4)));
typedef float f32x2 __attribute__((ext_vector_type(2)));
typedef float f32x16 __attribute__((ext_vector_type(16)));
typedef short bf16x8 __attribute__((ext_vector_type(8)));
typedef short s16x4 __attribute__((ext_vector_type(4)));
typedef __bf16 bf16x2_t __attribute__((ext_vector_type(2)));
typedef GAS unsigned gu32;
#define RLX_AGENT __ATOMIC_RELAXED, __HIP_MEMORY_SCOPE_AGENT
#define LDS_WAIT() asm volatile("s_waitcnt lgkmcnt(0)" ::: "memory")
#define VM_WAIT() asm volatile("s_waitcnt vmcnt(0)" ::: "memory")

constexpr int NWAVES = 8, NTHR = NWAVES * 64;
constexpr int BATCH = 2, SEQ = 8192, D = 1024, T = BATCH * SEQ;
constexpr float EPS = 1e-6f;
constexpr int NIN = 4864, NIN_SRC = 4840;
constexpr int C_CQ = 0, C_CKV = 384, C_QB = 640, C_KB = 1152, C_VB = 1664, C_QI = 2176, C_KR = 2688, C_KI = 2720, C_WI = 2784, C_GA = 2816, C_GB = 3840;
constexpr int NEXP = 32, FF = 256;
constexpr int SORT_ROWS = 2 * T + NEXP * 256;
constexpr float LOG2E = 1.4426950408889634f;
constexpr float C2A = 0.10206207261596575f * LOG2E;
constexpr float C2B = 0.125f * LOG2E;
constexpr float WI_SCALE = 0.35355339059327373f * 0.125f;

constexpr size_t MiB = 1u << 20, KiB = 1u << 10;
constexpr size_t WS_CTL = 0, CTL_ZERO_BYTES = 1 * MiB;
constexpr size_t WS_ROPE = 1 * MiB;
constexpr size_t WS_WI = 2 * MiB;
constexpr size_t WS_TOKE = 2 * MiB + 512 * KiB;
constexpr size_t WS_TOKW = WS_TOKE + 128 * KiB;
constexpr size_t WS_RSTD2 = WS_TOKW + 128 * KiB;
constexpr size_t WS_SSLOT = 3 * MiB + 512 * KiB;
constexpr size_t WS_SW = WS_SSLOT + 192 * KiB;
constexpr size_t WS_T2E = WS_SW + 192 * KiB;
constexpr size_t WS_WIN = 4 * MiB, WS_WUQ = 14 * MiB, WS_WUKV = 15 * MiB, WS_WOA = 16 * MiB, WS_WOB = 17 * MiB, WS_WOUT = 18 * MiB, WS_WGU = 20 * MiB, WS_WD = 52 * MiB;
constexpr size_t WS_H = 68 * MiB, WS_OA = 68 * MiB, WS_OB = 84 * MiB;
constexpr size_t WS_QA = 100 * MiB, WS_KN = 124 * MiB, WS_VA = 140 * MiB, WS_Y = 100 * MiB;
constexpr size_t WS_QB = 156 * MiB, WS_KB = 172 * MiB, WS_VB = 188 * MiB;
constexpr size_t WS_CQ = 204 * MiB, WS_CKV = 216 * MiB, WS_BM = 204 * MiB;
constexpr size_t WS_QI = 224 * MiB, WS_KI = 240 * MiB, WS_KR = 242 * MiB;
constexpr size_t WS_ASORT = 68 * MiB, WS_SLOTS = 156 * MiB, WS_HID = 220 * MiB;
constexpr size_t WS_END = 256 * MiB;
constexpr int CW_BAR = 4096;
constexpr int CW_Q1 = 64, CW_Q2 = 128;
constexpr int CW_CNT = 256, CW_FILL = 320;
constexpr int CW_RDY = 8192;

constexpr int LDS_BYTES = 147456;
constexpr int MISC_OFF = 147456 - 512;

__device__ __forceinline__ unsigned f2bf(float f) { unsigned u = __builtin_bit_cast(unsigned, f); return (u + 0x7fffu + ((u >> 16) & 1u)) >> 16; }
__device__ __forceinline__ unsigned pk2(float lo, float hi) { f32x2 v = {lo, hi}; bf16x2_t b = __builtin_convertvector(v, bf16x2_t); return __builtin_bit_cast(unsigned, b); }
__device__ __forceinline__ float bflo(unsigned w) { return __builtin_bit_cast(float, w << 16); }
__device__ __forceinline__ float bfhi(unsigned w) { return __builtin_bit_cast(float, w & 0xffff0000u); }

#define XB_TMO      128
#define XB_XCNT(j)  (256  + 64 * (j))
#define XB_XSUB(j)  (1280 + 64 * (j))
#define XB_XGEN(j)  (2304 + 64 * (j))
#define XB_TOP      3328
#define XB_TOPGEN   3392
#define XCD_BAR_WORDS 3456
#define XB_SPIN_CAP (1u << 22)
__device__ __forceinline__ unsigned xb_ld(unsigned* p)              { return __hip_atomic_load(p, __ATOMIC_RELAXED, __HIP_MEMORY_SCOPE_AGENT); }
__device__ __forceinline__ unsigned xb_add(unsigned* p, unsigned v) { return __hip_atomic_fetch_add(p, v, __ATOMIC_RELAXED, __HIP_MEMORY_SCOPE_AGENT); }
__device__ __forceinline__ unsigned xb_xcc_id() { return (unsigned)__builtin_amdgcn_s_getreg((3 << 11) | 20) & 0xFu; }
#define XB_SPIN(cond, bar) do { unsigned _sp = 0; while (cond) { __builtin_amdgcn_s_sleep(1); \
    if ((++_sp & 255u) == 0u) { if (xb_ld(&(bar)[XB_TMO])) break; if (_sp > XB_SPIN_CAP) { atomicAdd(&(bar)[XB_TMO], 1u); break; } } } } while (0)
struct XcdBarrier { unsigned* bar; unsigned x; volatile LAS unsigned* st; };
__device__ __forceinline__ XcdBarrier xcd_barrier_post(unsigned* bar, volatile LAS unsigned* st) {
    XcdBarrier b; b.bar = bar; b.x = xb_xcc_id(); b.st = st;
    if (threadIdx.x == 0) (void)xb_add(&bar[XB_XCNT(b.x)], 1u);
    return b;
}
__device__ __forceinline__ void xcd_barrier_complete(unsigned* bar, unsigned x, unsigned& nloc, unsigned& nx) {
    const unsigned G = gridDim.x * gridDim.y * gridDim.z;
    unsigned sum, cnt, mine, sp = 0u;
    for (;;) {
        sum = 0u; cnt = 0u; mine = 0u;
#pragma unroll
        for (unsigned j = 0; j < 16; ++j) { const unsigned c = xb_ld(&bar[XB_XCNT(j)]); sum += c; cnt += (c > 0u) ? 1u : 0u; mine = (j == x) ? c : mine; }
        if (sum == G) break;
        __builtin_amdgcn_s_sleep(1);
        if ((++sp & 255u) == 0u) { if (xb_ld(&bar[XB_TMO])) break; if (sp > XB_SPIN_CAP) { atomicAdd(&bar[XB_TMO], 1u); break; } }
    }
    nloc = mine > 0u ? mine : 1u; nx = cnt > 0u ? cnt : 1u;
}
__device__ __forceinline__ void xcd_barrier(const XcdBarrier& b) {
    asm volatile("s_waitcnt vmcnt(0)" ::: "memory");
    __syncthreads();
    if (threadIdx.x == 0) {
        unsigned* bar = b.bar;
        __builtin_amdgcn_s_waitcnt(0);
        unsigned nloc = b.st[0], nx = b.st[1];
        if (nloc == 0u) { xcd_barrier_complete(bar, b.x, nloc, nx); b.st[0] = nloc; b.st[1] = nx; }
        const unsigned old = xb_add(&bar[XB_XSUB(b.x)], 1u);
        const unsigned gen = old / nloc;
        if (old + 1u == (gen + 1u) * nloc) {
            __builtin_amdgcn_fence(__ATOMIC_RELEASE, "agent");
            asm volatile("s_waitcnt vmcnt(0)" ::: "memory");
            const unsigned og = xb_add(&bar[XB_TOP], 1u);
            const unsigned tg = og / nx;
            if (og + 1u == (tg + 1u) * nx) xb_add(&bar[XB_TOPGEN], 1u);
            else XB_SPIN(xb_ld(&bar[XB_TOPGEN]) == tg, bar);
            __builtin_amdgcn_fence(__ATOMIC_ACQUIRE, "agent");
            xb_add(&bar[XB_XGEN(b.x)], 1u);
            asm volatile("s_waitcnt vmcnt(0)" ::: "memory");
        } else {
            XB_SPIN(xb_ld(&bar[XB_XGEN(b.x)]) == gen, bar);
            __builtin_amdgcn_fence(__ATOMIC_ACQUIRE, "agent");
            asm volatile("s_waitcnt vmcnt(0)" ::: "memory");
        }
    }
    __syncthreads();
}

__device__ __forceinline__ float wave_sum(float v) {
#pragma unroll
    for (int o = 1; o < 64; o <<= 1) v += __shfl_xor(v, o);
    return v;
}

namespace pg8 {
#define PG8_LAS __attribute__((address_space(3)))
typedef unsigned short bf16_t;
typedef unsigned u32x4 __attribute__((ext_vector_type(4)));
constexpr int BM = 256, BK = 64, HALF = 128, HTB = HALF * BK * 2, STAGE_BYTES = 8 * HTB, NXCD = 8, WGM = 8;
__host__ __device__ __forceinline__ int lds_byte(int r, int c) { const int st = (r >> 4) * 2 + (c >> 5), rr = r & 15, cc = c & 31, ob = rr * 64 + cc * 2; return st * 1024 + (ob ^ (((ob >> 9) & 1) << 5)); }
__host__ __device__ __forceinline__ void stage_rc(int b, int& R, int& C) { const int st = b / 1024, sb = b % 1024, swz = sb ^ (((sb >> 9) & 1) << 5); R = (st >> 1) * 16 + swz / 64; C = (st & 1) * 32 + (swz % 64) / 2; }
__host__ __device__ __forceinline__ int perm32(int rho) { const int n = rho >> 4, i = rho & 15; return 8 * (i >> 2) + 4 * n + (i & 3); }

struct Unit { int pm, pn, e; };
struct Gemm { const bf16_t* A; const bf16_t* Bt; int M, N, K; size_t estride; };

struct StaticOrder {
    int nM, nN, nwg, G, c;
    __host__ __device__ void init(int M, int N, int G_, int c_) { nM = M / BM; nN = N / BM; nwg = nM * nN; G = G_; c = c_; }
    __host__ __device__ bool next(int i, Unit& u) const {
        const long L = (long)i * G + c; if (L >= nwg) return false;
        int wgid = (int)L; { const int q = nwg / NXCD, r = nwg % NXCD, xcd = wgid % NXCD, off = wgid / NXCD; wgid = (xcd < r ? xcd * (q + 1) : r * (q + 1) + (xcd - r) * q) + off; }
        const int nig = WGM * nN, gid = wgid / nig, fm = gid * WGM, gsz = (nM - fm) < WGM ? (nM - fm) : WGM;
        u.pm = fm + ((wgid % nig) % gsz); u.pn = (wgid % nig) / gsz; u.e = 0; return true;
    }
    __device__ __forceinline__ void a_ready(const Unit&) const {}
    __device__ __forceinline__ void done(const Unit&) const {}
};
struct GroupOrder {
    int nN, total, G, c; const int* t2e;
    __device__ void init(int nTiles, int nN_, int G_, int c_, const int* t2e_) { nN = nN_; total = nTiles * nN_; G = G_; c = c_; t2e = t2e_; }
    __device__ bool next(int i, Unit& u) const {
        const long L = (long)i * G + c; if (L >= total) return false;
        u.pm = (int)(L / nN); u.pn = (int)(L % nN); u.e = __builtin_amdgcn_readfirstlane(t2e[u.pm]); return true;
    }
    __device__ __forceinline__ void a_ready(const Unit&) const {}
    __device__ __forceinline__ void done(const Unit&) const {}
};

__device__ __forceinline__ void st8(bf16_t* p, f32x4 v0, f32x4 v1) { u32x4 w; w.x = pk2(v0[0], v0[1]); w.y = pk2(v0[2], v0[3]); w.z = pk2(v1[0], v1[1]); w.w = pk2(v1[2], v1[3]); *(u32x4*)p = w; }
__device__ __forceinline__ void ld8(const bf16_t* p, f32x4& v0, f32x4& v1) { const u32x4 w = *(const u32x4*)p; v0 = (f32x4){bflo(w.x), bfhi(w.x), bflo(w.y), bfhi(w.y)}; v1 = (f32x4){bflo(w.z), bfhi(w.z), bflo(w.w), bfhi(w.w)}; }

__device__ __forceinline__ void rope16(f32x4& v0, f32x4& v1, int row, int fq, const f32x2* rope) {
    const f32x2* rp = rope + (size_t)(row & (SEQ - 1)) * 16;
    f32x4 p0, p1;
#pragma unroll
    for (int e = 0; e < 4; ++e) { p0[e] = __shfl_xor(v0[e], 16); p1[e] = __shfl_xor(v1[e], 16); }
    if (fq < 2) {
        const float sg = fq == 0 ? -1.f : 1.f;
#pragma unroll
        for (int e = 0; e < 4; ++e) { const f32x2 a = rp[2 * e], b = rp[2 * (4 + e)];
            v0[e] = v0[e] * a.x + sg * p0[e] * a.y; v1[e] = v1[e] * b.x + sg * p1[e] * b.y; }
    }
}
__device__ __forceinline__ void rope32(f32x4& v0, f32x4& v1, int row, int fq, const f32x2* rope) {
    const f32x2* rp = rope + (size_t)(row & (SEQ - 1)) * 16 + 8 * (fq & 1);
    const float sg = fq < 2 ? -1.f : 1.f;
#pragma unroll
    for (int e = 0; e < 4; ++e) { const float p0 = __shfl_xor(v0[e], 32), p1 = __shfl_xor(v1[e], 32); const f32x2 a = rp[e], b = rp[4 + e];
        v0[e] = v0[e] * a.x + sg * p0 * a.y; v1[e] = v1[e] * b.x + sg * p1 * b.y; }
}
__device__ __forceinline__ float sigmoidf_(float x) { return __builtin_amdgcn_rcpf(1.f + __builtin_amdgcn_exp2f(-1.4426950408889634f * x)); }

struct EpiIn {
    static constexpr bool PERM = true, AFTER_DRAIN = false;
    bf16_t *CQ, *CKV, *QB, *KB, *VB, *QI, *KI, *KR, *GA, *GB; float* WI; const f32x2* rope;
    __device__ __forceinline__ void operator()(const f32x4 (&acc)[2][2][4][2], const Unit& u, int wr, int wc, int fr, int fq) const {
        const int row0 = u.pm * BM + wr * 64 + fr;
#pragma unroll
        for (int bj = 0; bj < 2; ++bj) {
            const int cg = u.pn * BM + bj * HALF + wc * 32;
            bf16_t* base = nullptr; int pitch = 0, cc = 0, mode = 0; float sc = 1.f;
            if (cg < C_CKV) { base = CQ; pitch = 384; cc = cg; }
            else if (cg < C_QB) { base = CKV; pitch = 256; cc = cg - C_CKV; }
            else if (cg < C_KB) { base = QB; pitch = 512; cc = cg - C_QB; mode = ((cc >> 5) & 1) == 0 ? 1 : 0; sc = C2B; }
            else if (cg < C_VB) { base = KB; pitch = 512; cc = cg - C_KB; mode = ((cc >> 5) & 1) == 0 ? 1 : 0; }
            else if (cg < C_QI) { base = VB; pitch = 512; cc = cg - C_VB; }
            else if (cg < C_KR) { base = QI; pitch = 512; cc = cg - C_QI; mode = ((cc >> 5) & 1) == 0 ? 1 : 0; }
            else if (cg < C_KI) { base = KR; pitch = 32; cc = 0; mode = 2; }
            else if (cg < C_WI) { base = KI; pitch = 64; cc = cg - C_KI; mode = (cc == 0) ? 1 : 0; }
            else if (cg < C_GA) { mode = 4; }
            else if (cg < C_GB) { base = GA; pitch = 1024; cc = cg - C_GA; mode = 3; }
            else { base = GB; pitch = 1024; cc = cg - C_GB; mode = 3; }
#pragma unroll
            for (int ai = 0; ai < 2; ++ai)
#pragma unroll
                for (int m = 0; m < 4; ++m) {
                    const int row = row0 + ai * HALF + m * 16;
                    f32x4 v0 = acc[ai][bj][m][0], v1 = acc[ai][bj][m][1];
                    if (mode == 1) rope16(v0, v1, row, fq, rope);
                    else if (mode == 2) rope32(v0, v1, row, fq, rope);
                    else if (mode == 3) {
#pragma unroll
                        for (int e = 0; e < 4; ++e) { v0[e] = sigmoidf_(v0[e]); v1[e] = sigmoidf_(v1[e]); } }
                    if (mode == 4) { if (fq == 0) { *(f32x4*)(WI + (size_t)row * 8) = v0 * WI_SCALE; *(f32x4*)(WI + (size_t)row * 8 + 4) = v1 * WI_SCALE; } }
                    else { v0 = v0 * sc; v1 = v1 * sc; st8(base + (size_t)row * pitch + cc + 8 * fq, v0, v1); }
                }
        }
    }
};
struct EpiQA {
    static constexpr bool PERM = true, AFTER_DRAIN = false;
    bf16_t* QA; const f32x2* rope;
    __device__ __forceinline__ void operator()(const f32x4 (&acc)[2][2][4][2], const Unit& u, int wr, int wc, int fr, int fq) const {
        const int row0 = u.pm * BM + wr * 64 + fr;
#pragma unroll
        for (int bj = 0; bj < 2; ++bj) {
            const int cg = u.pn * BM + bj * HALF + wc * 32; const bool rot = ((cg >> 5) % 3) == 2;
#pragma unroll
            for (int ai = 0; ai < 2; ++ai)
#pragma unroll
                for (int m = 0; m < 4; ++m) {
                    const int row = row0 + ai * HALF + m * 16;
                    f32x4 v0 = acc[ai][bj][m][0], v1 = acc[ai][bj][m][1];
                    if (rot) rope32(v0, v1, row, fq, rope);
                    v0 = v0 * C2A; v1 = v1 * C2A; st8(QA + (size_t)row * 768 + cg + 8 * fq, v0, v1);
                }
        }
    }
};
struct EpiKV {
    static constexpr bool PERM = true, AFTER_DRAIN = false;
    bf16_t *KN, *VA;
    __device__ __forceinline__ void operator()(const f32x4 (&acc)[2][2][4][2], const Unit& u, int wr, int wc, int fr, int fq) const {
        const int row0 = u.pm * BM + wr * 64 + fr;
#pragma unroll
        for (int bj = 0; bj < 2; ++bj) {
            const int cg = u.pn * BM + bj * HALF + wc * 32; bf16_t* base = cg < 512 ? KN : VA; const int cc = (cg & 511) + 8 * fq;
#pragma unroll
            for (int ai = 0; ai < 2; ++ai)
#pragma unroll
                for (int m = 0; m < 4; ++m) { const int row = row0 + ai * HALF + m * 16; st8(base + (size_t)row * 512 + cc, acc[ai][bj][m][0], acc[ai][bj][m][1]); }
        }
    }
};
template <int ADD> struct EpiY {
    static constexpr bool PERM = true, AFTER_DRAIN = false;
    bf16_t* Y; const bf16_t* Gt;
    __device__ __forceinline__ void operator()(const f32x4 (&acc)[2][2][4][2], const Unit& u, int wr, int wc, int fr, int fq) const {
        const int row0 = u.pm * BM + wr * 64 + fr;
#pragma unroll
        for (int bj = 0; bj < 2; ++bj) {
            const int c0 = u.pn * BM + bj * HALF + wc * 32 + 8 * fq;
#pragma unroll
            for (int ai = 0; ai < 2; ++ai)
#pragma unroll
                for (int m = 0; m < 4; ++m) { const size_t off = (size_t)(row0 + ai * HALF + m * 16) * 1024 + c0;
                    f32x4 g0, g1; ld8(Gt + off, g0, g1);
                    f32x4 v0 = acc[ai][bj][m][0] * g0, v1 = acc[ai][bj][m][1] * g1;
                    if (ADD) { f32x4 o0, o1; ld8(Y + off, o0, o1); v0 = v0 + o0; v1 = v1 + o1; }
                    st8(Y + off, v0, v1); }
        }
    }
};
struct EpiX1 {
    static constexpr bool PERM = false, AFTER_DRAIN = false;
    const float* X; float* O;
    __device__ __forceinline__ void operator()(const f32x4 (&acc)[2][2][4][2], const Unit& u, int wr, int wc, int fr, int fq) const {
        const int row0 = u.pm * BM + wr * 64 + fr, col0 = u.pn * BM + wc * 32 + 4 * fq;
#pragma unroll
        for (int ai = 0; ai < 2; ++ai)
#pragma unroll
            for (int m = 0; m < 4; ++m) { const size_t off = (size_t)(row0 + ai * HALF + m * 16) * 1024 + col0;
#pragma unroll
                for (int bj = 0; bj < 2; ++bj)
#pragma unroll
                    for (int n = 0; n < 2; ++n) { const f32x4 xv = *(const f32x4*)(X + off + bj * HALF + n * 16); *(f32x4*)(O + off + bj * HALF + n * 16) = xv + acc[ai][bj][m][n]; } }
    }
};
struct EpiHid {
    static constexpr bool PERM = true, AFTER_DRAIN = false;
    bf16_t* HID;
    __device__ __forceinline__ void operator()(const f32x4 (&acc)[2][2][4][2], const Unit& u, int wr, int wc, int fr, int fq) const {
        const int row0 = u.pm * BM + wr * 64 + fr, c0 = u.pn * 128 + wc * 32 + 8 * fq;
#pragma unroll
        for (int ai = 0; ai < 2; ++ai)
#pragma unroll
            for (int m = 0; m < 4; ++m) { f32x4 h0, h1;
#pragma unroll
                for (int e = 0; e < 4; ++e) { const float g0 = acc[ai][0][m][0][e], g1 = acc[ai][0][m][1][e];
                    h0[e] = g0 * sigmoidf_(g0) * acc[ai][1][m][0][e]; h1[e] = g1 * sigmoidf_(g1) * acc[ai][1][m][1][e]; }
                st8(HID + (size_t)(row0 + ai * HALF + m * 16) * 256 + c0, h0, h1); }
    }
};
struct EpiDown {
    static constexpr bool PERM = true, AFTER_DRAIN = false;
    bf16_t* SL; const int* sslot; const float* sw;
    __device__ __forceinline__ void operator()(const f32x4 (&acc)[2][2][4][2], const Unit& u, int wr, int wc, int fr, int fq) const {
        const int row0 = u.pm * BM + wr * 64 + fr;
#pragma unroll
        for (int ai = 0; ai < 2; ++ai)
#pragma unroll
            for (int m = 0; m < 4; ++m) { const int r = row0 + ai * HALF + m * 16; const int slot = sslot[r]; const float w = sw[r];
                if (slot >= 0) {
#pragma unroll
                    for (int bj = 0; bj < 2; ++bj) st8(SL + (size_t)slot * 1024 + u.pn * BM + bj * HALF + wc * 32 + 8 * fq, acc[ai][bj][m][0] * w, acc[ai][bj][m][1] * w); } }
    }
};
template <class Epi, class Sched, bool ALIGN_EPI = false, bool SP2 = false>
__device__ __forceinline__ void gemm_phase(PG8_LAS unsigned char* lds, const Gemm g, const Sched& S, const Epi& E) {
    const int tid = threadIdx.x, wid = __builtin_amdgcn_readfirstlane(tid >> 6), lane = tid & 63, wr = wid >> 2, wc = wid & 3, fr = lane & 15, fq = lane >> 4;
    const int K = g.K, nt = K / BK;
    unsigned voffA[2], voffB[2];
#pragma unroll
    for (int i = 0; i < 2; ++i) { int R, C; stage_rc(tid * 16 + i * 8192, R, C); const int Rb = Epi::PERM ? ((R & ~31) + perm32(R & 31)) : R;
        voffA[i] = (unsigned)(R * K + C) * 2u; voffB[i] = (unsigned)(Rb * K + C) * 2u; }
    const size_t kstep = (size_t)(BK * 2);
    const size_t hstep = (size_t)HALF * K * 2;
    const size_t tstep = 2 * hstep;
    const unsigned ldsw = (unsigned)wid * 1024u;
    const int aoff = lds_byte(wr * 64 + fr, fq * 8), boff = lds_byte(wc * 32 + fr, fq * 8);
#define PG8_SA(b, h) (((b) * 2 + (h)) * HTB)
#define PG8_SB(b, h) ((4 + (b) * 2 + (h)) * HTB)
#define PG8_STAGE(bufoff, gbase, voff) do { _Pragma("unroll") for (int _i = 0; _i < 2; ++_i) \
        __builtin_amdgcn_global_load_lds((const unsigned*)((const char*)(gbase) + (voff)[_i]), (PG8_LAS unsigned*)(lds + (bufoff) + ldsw + _i * 8192), 16, 0, 0); } while (0)
#define PG8_LDA(dst, b, h) do { _Pragma("unroll") for (int m = 0; m < 4; ++m) _Pragma("unroll") for (int k = 0; k < 2; ++k) dst[m][k] = *(const PG8_LAS bf16x8*)(lds + PG8_SA(b, h) + aoff + m * 2048 + k * 1024); } while (0)
#define PG8_LDB(dst, b, h) do { _Pragma("unroll") for (int n = 0; n < 2; ++n) _Pragma("unroll") for (int k = 0; k < 2; ++k) dst[n][k] = *(const PG8_LAS bf16x8*)(lds + PG8_SB(b, h) + boff + n * 2048 + k * 1024); } while (0)
#define PG8_MMA(ai, bj, At, Bt) do { __builtin_amdgcn_s_setprio(1); _Pragma("unroll") for (int m = 0; m < 4; ++m) _Pragma("unroll") for (int n = 0; n < 2; ++n) _Pragma("unroll") for (int k = 0; k < 2; ++k) \
        acc[ai][bj][m][n] = __builtin_amdgcn_mfma_f32_16x16x32_bf16(Bt[n][k], At[m][k], acc[ai][bj][m][n], 0, 0, 0); __builtin_amdgcn_s_setprio(0); } while (0)
#define PG8_WAIT_V(n) asm volatile("s_waitcnt vmcnt(" #n ")" ::: "memory")
#define PG8_WAIT_L(n) asm volatile("s_waitcnt lgkmcnt(" #n ")" ::: "memory")
#define PG8_BAR __builtin_amdgcn_s_barrier()
#define PG8_SCHED __builtin_amdgcn_sched_barrier(0)
    Unit cur, nxt; int ui = 0;
    if (!S.next(0, cur)) return;
    f32x4 acc[2][2][4][2];
#pragma unroll
    for (int a = 0; a < 2; ++a)
#pragma unroll
        for (int b = 0; b < 2; ++b)
#pragma unroll
            for (int m = 0; m < 4; ++m)
#pragma unroll
                for (int n = 0; n < 2; ++n) acc[a][b][m][n] = (f32x4){0.f, 0.f, 0.f, 0.f};
    bf16x8 At[4][2], B0[2][2], B1[2][2];
    const char* cA = (const char*)g.A + (size_t)cur.pm * tstep; const char* cB = (const char*)g.Bt + (size_t)cur.e * g.estride + (size_t)cur.pn * tstep;
    S.a_ready(cur);
    if constexpr (SP2) {
        PG8_STAGE(PG8_SB(0, 0), cB, voffB); PG8_STAGE(PG8_SB(0, 1), cB + hstep, voffB); PG8_STAGE(PG8_SA(0, 0), cA, voffA); PG8_STAGE(PG8_SA(0, 1), cA + hstep, voffA);
        if (wr == 1) PG8_BAR;
        PG8_WAIT_V(2); PG8_BAR;
        PG8_STAGE(PG8_SB(1, 0), cB + kstep, voffB); PG8_STAGE(PG8_SA(1, 0), cA + kstep, voffA); PG8_STAGE(PG8_SB(1, 1), cB + hstep + kstep, voffB);
        PG8_WAIT_V(6); PG8_BAR;
    } else {
        PG8_STAGE(PG8_SB(0, 0), cB, voffB); PG8_STAGE(PG8_SA(0, 0), cA, voffA); PG8_STAGE(PG8_SB(0, 1), cB + hstep, voffB); PG8_STAGE(PG8_SA(0, 1), cA + hstep, voffA);
        if (wr == 1) PG8_BAR;
        PG8_WAIT_V(4); PG8_BAR;
        PG8_STAGE(PG8_SB(1, 0), cB + kstep, voffB); PG8_STAGE(PG8_SA(1, 0), cA + kstep, voffA); PG8_STAGE(PG8_SB(1, 1), cB + hstep + kstep, voffB);
        PG8_WAIT_V(6); PG8_BAR;
    }
    for (;;) {
        const bool has_next = S.next(ui + 1, nxt);
        const char* nA = has_next ? (const char*)g.A + (size_t)nxt.pm * tstep : cA; const char* nB = has_next ? (const char*)g.Bt + (size_t)nxt.e * g.estride + (size_t)nxt.pn * tstep : cB;
#pragma nounroll
        for (int t = 0; t < nt; t += 2) {
            const bool last = (t == nt - 2);
            const char* a1 = cA + (size_t)(t + 1) * kstep;
            const char* a2 = last ? nA : cA + (size_t)(t + 2) * kstep; const char* b2 = last ? nB : cB + (size_t)(t + 2) * kstep;
            const char* a3 = a2 + kstep; const char* b3 = b2 + kstep;
            if (last && has_next) S.a_ready(nxt);
            if constexpr (SP2) {
            PG8_LDB(B0, 0, 0); PG8_LDB(B1, 0, 1); PG8_SCHED; PG8_LDA(At, 0, 0); PG8_STAGE(PG8_SA(1, 1), a1 + hstep, voffA);
            PG8_WAIT_V(8); PG8_WAIT_L(0); PG8_BAR; PG8_MMA(0, 0, At, B0); PG8_MMA(0, 1, At, B1); PG8_BAR; PG8_SCHED;
            PG8_LDA(At, 0, 1); PG8_STAGE(PG8_SB(0, 0), b2, voffB); PG8_STAGE(PG8_SB(0, 1), b2 + hstep, voffB); PG8_STAGE(PG8_SA(0, 0), a2, voffA);
            PG8_WAIT_V(8); PG8_WAIT_L(0); PG8_BAR; PG8_MMA(1, 0, At, B0); PG8_MMA(1, 1, At, B1); PG8_BAR; PG8_SCHED;
            PG8_LDB(B0, 1, 0); PG8_LDB(B1, 1, 1); PG8_SCHED; PG8_LDA(At, 1, 0); PG8_STAGE(PG8_SA(0, 1), a2 + hstep, voffA);
            PG8_WAIT_V(8); PG8_WAIT_L(0); PG8_BAR; PG8_MMA(0, 0, At, B0); PG8_MMA(0, 1, At, B1); PG8_BAR; PG8_SCHED;
            PG8_LDA(At, 1, 1); PG8_STAGE(PG8_SB(1, 0), b3, voffB); PG8_STAGE(PG8_SB(1, 1), b3 + hstep, voffB); PG8_STAGE(PG8_SA(1, 0), a3, voffA);
            PG8_WAIT_V(8); PG8_WAIT_L(0); PG8_BAR; PG8_MMA(1, 0, At, B0); PG8_MMA(1, 1, At, B1); PG8_BAR; PG8_SCHED;
            } else {
            PG8_LDB(B0, 0, 0); PG8_SCHED; PG8_LDA(At, 0, 0); PG8_STAGE(PG8_SA(1, 1), a1 + hstep, voffA);
            PG8_WAIT_L(8); PG8_BAR; PG8_WAIT_L(0); PG8_MMA(0, 0, At, B0); PG8_BAR; PG8_SCHED;
            PG8_LDB(B1, 0, 1); PG8_STAGE(PG8_SB(0, 0), b2, voffB);
            PG8_BAR; PG8_WAIT_L(0); PG8_MMA(0, 1, At, B1); PG8_BAR;
            PG8_LDA(At, 0, 1); PG8_STAGE(PG8_SA(0, 0), a2, voffA);
            PG8_BAR; PG8_WAIT_L(0); PG8_MMA(1, 0, At, B0); PG8_BAR; PG8_SCHED;
            PG8_STAGE(PG8_SB(0, 1), b2 + hstep, voffB);
            PG8_WAIT_V(6); PG8_BAR; PG8_MMA(1, 1, At, B1); PG8_BAR;
            PG8_LDB(B0, 1, 0); PG8_SCHED; PG8_LDA(At, 1, 0); PG8_STAGE(PG8_SA(0, 1), a2 + hstep, voffA);
            PG8_WAIT_L(8); PG8_BAR; PG8_WAIT_L(0); PG8_MMA(0, 0, At, B0); PG8_BAR; PG8_SCHED;
            PG8_LDB(B1, 1, 1); PG8_STAGE(PG8_SB(1, 0), b3, voffB);
            PG8_BAR; PG8_WAIT_L(0); PG8_MMA(0, 1, At, B1); PG8_BAR;
            PG8_LDA(At, 1, 1); PG8_STAGE(PG8_SA(1, 0), a3, voffA);
            PG8_BAR; PG8_WAIT_L(0); PG8_MMA(1, 0, At, B0); PG8_BAR; PG8_SCHED;
            PG8_STAGE(PG8_SB(1, 1), b3 + hstep, voffB);
            PG8_WAIT_V(6); PG8_BAR; PG8_MMA(1, 1, At, B1); PG8_BAR;
            }
        }
        if constexpr (ALIGN_EPI) { if (wr == 0) PG8_BAR; }
        if constexpr (!Epi::AFTER_DRAIN) { E(acc, cur, wr, wc, fr, fq); S.done(cur); }
        if (!has_next) break;
#pragma unroll
        for (int a = 0; a < 2; ++a)
#pragma unroll
            for (int b = 0; b < 2; ++b)
#pragma unroll
                for (int m = 0; m < 4; ++m)
#pragma unroll
                    for (int n = 0; n < 2; ++n) acc[a][b][m][n] = (f32x4){0.f, 0.f, 0.f, 0.f};
        cur = nxt; cA = nA; cB = nB; ++ui;
        if constexpr (ALIGN_EPI) { if (wr == 1) PG8_BAR; }
    }
    PG8_WAIT_V(0);
    if constexpr (!ALIGN_EPI) { if (wr == 0) PG8_BAR; }
    PG8_BAR;
    if constexpr (Epi::AFTER_DRAIN) { E.fused(acc, cur, wr, wc, fr, fq, lds, wid, lane); S.done(cur); }
#undef PG8_SA
#undef PG8_SB
#undef PG8_STAGE
#undef PG8_LDA
#undef PG8_LDB
#undef PG8_MMA
#undef PG8_WAIT_V
#undef PG8_WAIT_L
#undef PG8_BAR
#undef PG8_SCHED
}
}

struct Args { const float* in[20]; float* out; unsigned char* ws; int ph_lo, ph_hi; };
struct Frame {
    LAS unsigned char* lds; volatile LAS unsigned* MISC; gu32* ctl; unsigned char* ws;
    int vcu, G;
};
#define F_TID ((int)threadIdx.x)
#define F_LANE ((int)(threadIdx.x & 63))
#define F_WAVE (__builtin_amdgcn_readfirstlane((int)(threadIdx.x >> 6)))

__device__ __forceinline__ int in_src_col(int n) {
    if (n < 640) return n;
    if (n < 2688) return n + 32;
    if (n < 2720) return n - 2688 + 640;
    if (n < 2792) return n;
    if (n < 2816) return -1;
    return n - 24;
}
struct TrDesc { const float* colptr; int ld, k0; bf16* WT; int Kd, destrow0; };
__device__ __forceinline__ void tr_load(const TrDesc& d, int lane, f32x4 (&v)[16]) {
    const int kr = lane >> 4;
#pragma unroll
    for (int it = 0; it < 16; ++it) { const int kk = 4 * it + kr; v[it] = (f32x4){0.f, 0.f, 0.f, 0.f}; if (d.colptr) v[it] = *(const GAS f32x4*)(d.colptr + (size_t)(d.k0 + kk) * d.ld); }
}
__device__ __forceinline__ void tr_store(const TrDesc& d, int lane, const f32x4 (&v)[16], LAS float* scr) {
    const int nq = lane & 15, kr = lane >> 4;
#pragma unroll
    for (int it = 0; it < 16; ++it) { const int kk = 4 * it + kr; LAS float* q = scr + kk * 65 + 4 * nq; q[0] = v[it].x; q[1] = v[it].y; q[2] = v[it].z; q[3] = v[it].w; }
    LDS_WAIT(); asm volatile("" ::: "memory");
    const int c = lane & 7;
#pragma unroll
    for (int j = 0; j < 8; ++j) { const int n = (lane >> 3) + 8 * j; const LAS float* q = scr + (8 * c) * 65 + n;
        v4u o; o.x = pk2(q[0 * 65], q[1 * 65]); o.y = pk2(q[2 * 65], q[3 * 65]); o.z = pk2(q[4 * 65], q[5 * 65]); o.w = pk2(q[6 * 65], q[7 * 65]);
        *(GAS v4u*)(d.WT + (size_t)(d.destrow0 + n) * d.Kd + d.k0 + 8 * c) = o; }
    LDS_WAIT(); asm volatile("" ::: "memory");
}
constexpr int CV_I0 = 16 * 76, CV_I1 = 6 * 12, CV_I2 = 4 * 16, CV_I3 = 8 * 16, CV_I4 = 8 * 16, CV_I5 = 16 * 16, CV_I6 = 32 * 16 * 8, CV_I7 = 32 * 4 * 16;
constexpr int CV_EARLY = CV_I0 + CV_I1 + CV_I2, CV_LATE = CV_I3 + CV_I4 + CV_I5 + CV_I6 + CV_I7, CV_QITEMS = CV_LATE / 16;
static_assert(CV_LATE % 16 == 0, "late conversion tiles come in queue items of 16");
__device__ __forceinline__ TrDesc conv_desc(const Args& A, unsigned char* ws, int it, int lane) {
    const int n4 = 4 * (lane & 15);
    int r = it;
    if (r < CV_I0) { const int kb = r / 76, nb = r % 76; const int col = in_src_col(64 * nb + n4);
        return TrDesc{col >= 0 ? A.in[2] + col : nullptr, NIN_SRC, 64 * kb, (bf16*)(ws + WS_WIN), 1024, 64 * nb}; } r -= CV_I0;
    if (r < CV_I1) { const int kb = r / 12, nb = r % 12; return TrDesc{A.in[4] + 64 * nb + n4, 768, 64 * kb, (bf16*)(ws + WS_WUQ), 384, 64 * nb}; } r -= CV_I1;
    if (r < CV_I2) { const int kb = r / 16, nb = r % 16; const int n = 64 * nb + n4;
        return TrDesc{n < 512 ? A.in[6] + n : A.in[7] + (n - 512), 512, 64 * kb, (bf16*)(ws + WS_WUKV), 256, 64 * nb}; } r -= CV_I2;
    if (r < CV_I3) { const int kb = r / 16, nb = r % 16; return TrDesc{A.in[8] + 64 * nb + n4, 1024, 64 * kb, (bf16*)(ws + WS_WOA), 512, 64 * nb}; } r -= CV_I3;
    if (r < CV_I4) { const int kb = r / 16, nb = r % 16; return TrDesc{A.in[9] + 64 * nb + n4, 1024, 64 * kb, (bf16*)(ws + WS_WOB), 512, 64 * nb}; } r -= CV_I4;
    if (r < CV_I5) { const int kb = r / 16, nb = r % 16; return TrDesc{A.in[10] + 64 * nb + n4, 1024, 64 * kb, (bf16*)(ws + WS_WOUT), 1024, 64 * nb}; } r -= CV_I5;
    if (r < CV_I6) { const int e = r / 128, rr = r % 128, kb = rr / 8, nb = rr % 8; const int n = 64 * nb + n4, pn = n >> 8, c = n & 255, col = 128 * pn + (c & 127);
        const float* src = ((c >> 7) ? A.in[17] : A.in[16]) + (size_t)e * 1024 * 256 + col;
        return TrDesc{src, 256, 64 * kb, (bf16*)(ws + WS_WGU) + (size_t)e * 512 * 1024, 1024, 64 * nb}; } r -= CV_I6;
    { const int e = r / 64, rr = r % 64, kb = rr / 16, nb = rr % 16;
        return TrDesc{A.in[18] + (size_t)e * 256 * 1024 + 64 * nb + n4, 1024, 64 * kb, (bf16*)(ws + WS_WD) + (size_t)e * 1024 * 256, 256, 64 * nb}; }
}
__device__ __forceinline__ void conv_tile(const Args& A, unsigned char* ws, int it, LAS float* scr, int lane) {
    const TrDesc d = conv_desc(A, ws, it, lane); f32x4 v[16]; tr_load(d, lane, v); tr_store(d, lane, v, scr);
}
__device__ __forceinline__ void conv_tile2(const Args& A, unsigned char* ws, int it0, int it1, LAS float* scr, int lane) {
    const TrDesc d0 = conv_desc(A, ws, it0, lane), d1 = conv_desc(A, ws, it1, lane); f32x4 v0[16], v1[16];
    tr_load(d0, lane, v0); tr_load(d1, lane, v1); tr_store(d0, lane, v0, scr); tr_store(d1, lane, v1, scr);
}
__device__ __forceinline__ void p0_prologue(Frame& F, const Args& A) {
    LAS float* scr = (LAS float*)(F.lds + F_WAVE * 16640);
    const int gw = F.vcu * NWAVES + F_WAVE, NGW = F.G * NWAVES, lane = F_LANE;
    unsigned char* ws = F.ws;
#ifdef CONV_IN_P0
    for (int it = gw; it < CV_EARLY + CV_LATE; it += NGW) conv_tile(A, ws, it, scr, lane);
#else
    for (int it = gw; it < CV_EARLY; it += NGW) conv_tile(A, ws, it, scr, lane);
#endif
    const float* x = A.in[0]; const float* g1 = A.in[1]; bf16* H = (bf16*)(ws + WS_H);
    for (int m0 = gw; m0 < T; m0 += 4 * NGW) {
        f32x4 v[4][4];
#pragma unroll
        for (int r = 0; r < 4; ++r) { const int m = min(m0 + r * NGW, T - 1); const GAS f32x4* xr = (const GAS f32x4*)(x + (size_t)m * D) + lane;
#pragma unroll
            for (int j = 0; j < 4; ++j) v[r][j] = xr[64 * j]; }
#pragma unroll
        for (int r = 0; r < 4; ++r) { const int m = m0 + r * NGW; float s = 0.f;
#pragma unroll
            for (int j = 0; j < 4; ++j) s += (v[r][j].x * v[r][j].x + v[r][j].y * v[r][j].y) + (v[r][j].z * v[r][j].z + v[r][j].w * v[r][j].w);
            const float rstd = 1.f / sqrtf(wave_sum(s) * (1.f / D) + EPS);
            if (m < T) { GAS v2u* o8 = (GAS v2u*)(H + (size_t)m * D) + lane;
#pragma unroll
                for (int j = 0; j < 4; ++j) { const f32x4 g = *((const GAS f32x4*)g1 + lane + 64 * j); const f32x4 y = v[r][j] * rstd * g; v2u w; w.x = pk2(y.x, y.y); w.y = pk2(y.z, y.w); o8[64 * j] = w; } } }
    }
    f32x2* rope = (f32x2*)(ws + WS_ROPE);
    for (int idx = (F.vcu * NTHR + F_TID); idx < SEQ * 16; idx += F.G * NTHR) {
        const int pos = idx >> 4, i = idx & 15;
        const double REV[16] = {0.15915494309189535, 0.0700865215877985, 0.03086376340470123, 0.013591370636193905, 0.005985185712713705, 0.002635675898667414, 0.001160663641240061, 0.0005111175045375439,
                                0.00022507907903927653, 9.911730936901935e-05, 4.364795279280289e-05, 1.9221100684944863e-05, 8.464330808241401e-06, 3.727408601915352e-06, 1.6414262627950345e-06, 7.228293068832865e-07};
        double rv = 0.0;
#pragma unroll
        for (int k = 0; k < 16; ++k) rv = (i == k) ? REV[k] : rv;
        double t = (double)pos * rv; t -= __builtin_floor(t);
        const float tf = (float)t;
        rope[idx] = (f32x2){__builtin_amdgcn_cosf(tf), __builtin_amdgcn_sinf(tf)};
    }
}

__device__ __forceinline__ void p2a_norms(Frame& F, const Args& A) {
    const int gw = F.vcu * NWAVES + F_WAVE, NGW = F.G * NWAVES, lane = F_LANE;
    bf16* CQ = (bf16*)(F.ws + WS_CQ); bf16* CKV = (bf16*)(F.ws + WS_CKV);
    const float* gq = A.in[3]; const float* gkv = A.in[5];
    for (int m = gw; m < T; m += NGW) {
        {
            GAS unsigned* p = (GAS unsigned*)(CQ + (size_t)m * 384) + lane; unsigned w[3]; float s = 0.f;
#pragma unroll
            for (int j = 0; j < 3; ++j) { w[j] = p[64 * j]; const float a = bflo(w[j]), b = bfhi(w[j]); s += a * a + b * b; }
            const float rstd = 1.f / sqrtf(wave_sum(s) * (1.f / 384.f) + EPS);
#pragma unroll
            for (int j = 0; j < 3; ++j) { const f32x2 g = *((const GAS f32x2*)gq + lane + 64 * j); p[64 * j] = pk2(bflo(w[j]) * rstd * g.x, bfhi(w[j]) * rstd * g.y); }
        }
        {
            GAS v2u* p = (GAS v2u*)(CKV + (size_t)m * 256) + lane; const v2u w = *p;
            const float a = bflo(w.x), b = bfhi(w.x), c = bflo(w.y), d = bfhi(w.y);
            const float rstd = 1.f / sqrtf(wave_sum(a * a + b * b + c * c + d * d) * (1.f / 256.f) + EPS);
            const f32x4 g = *((const GAS f32x4*)gkv + lane); v2u o; o.x = pk2(a * rstd * g.x, b * rstd * g.y); o.y = pk2(c * rstd * g.z, d * rstd * g.w); *p = o;
        }
    }
}

__device__ __forceinline__ constexpr int crow(int r, int hi) { return (r & 3) + 8 * (r >> 2) + 4 * hi; }
constexpr float ATT_THR = 8.f;
__device__ __forceinline__ float att_mask(float p, unsigned w, int bit) { int mk; unsigned r;
    asm("v_bfe_i32 %0, %1, %2, 1" : "=v"(mk) : "v"(w), "i"(bit)); r = __builtin_bit_cast(unsigned, p) & (unsigned)mk; return __builtin_bit_cast(float, r); }
struct AttnP { const bf16 *Q, *K, *K2, *V; bf16* O; const unsigned* BM; };
template <bool MLA> __device__ __forceinline__ void attn_unit(LAS unsigned char* L, int b, int h, int qb, const AttnP& P, int tid, int lane, int wave) {
    constexpr int DK = MLA ? 96 : 64, KP = DK * 2 + 16, NS = DK / 16, CPR = DK / 8;
    constexpr int QPITCH = MLA ? 768 : 512, VP = 192, KBUF = 64 * KP, VBUF = 64 * VP;
    const int r32 = lane & 31, hi = lane >> 5;
    const size_t rowb = (size_t)b * SEQ;
    const int qrow = qb * 256 + wave * 32 + r32;
    bf16x8 qf[NS];
    { const bf16* qp = P.Q + (rowb + qrow) * QPITCH + h * DK;
#pragma unroll
      for (int s = 0; s < NS; ++s) qf[s] = *(const bf16x8*)(qp + 16 * s + 8 * hi); }
    const int NT = 4 * qb + 4, my_nt = 4 * qb + (wave >> 1) + 1;
    const int kid0 = tid, kid1 = tid + NTHR;
    const int kr0 = kid0 / CPR, kc0 = kid0 % CPR, kr1 = kid1 / CPR, kc1 = kid1 % CPR; const bool has1 = MLA && (kid1 < 64 * CPR);
    const int vr = tid >> 3, vc = tid & 7;
    v4u kreg0, kreg1 = (v4u){0u, 0u, 0u, 0u}, vreg;
#define ATT_KSRC(t, kr, kc) (MLA ? ((kc) < 8 ? (const v4u*)(P.K + (rowb + 64 * (t) + (kr)) * 512 + h * 64 + 8 * (kc)) : (const v4u*)(P.K2 + (rowb + 64 * (t) + (kr)) * 32 + 8 * ((kc) - 8))) \
                                 : (const v4u*)(P.K + (rowb + 64 * (t) + (kr)) * 512 + h * 64 + 8 * (kc)))
#define ATT_LOAD(t) do { kreg0 = *ATT_KSRC(t, kr0, kc0); if (has1) kreg1 = *ATT_KSRC(t, kr1, kc1); vreg = *(const v4u*)(P.V + (rowb + 64 * (t) + vr) * 512 + h * 64 + 8 * vc); } while (0)
#define ATT_WRITE(buf) do { *(LAS v4u*)(L + (buf) * KBUF + kr0 * KP + kc0 * 16) = kreg0; if (has1) *(LAS v4u*)(L + (buf) * KBUF + kr1 * KP + kc1 * 16) = kreg1; \
                            *(LAS v4u*)(L + 2 * KBUF + (buf) * VBUF + vr * VP + vc * 16) = vreg; } while (0)
    float mhat = 0.f, l = 0.f; f32x16 o0, o1, negm;
#pragma unroll
    for (int i = 0; i < 16; ++i) { o0[i] = 0.f; o1[i] = 0.f; negm[i] = 0.f; }
    const int g16 = lane >> 4, qq = (lane & 15) >> 2, pp = lane & 3;
    const int vlane = (4 * hi + qq) * VP + (16 * (g16 & 1) + 4 * pp) * 2;
    ATT_LOAD(0); ATT_WRITE(0); __syncthreads();
    unsigned wn0 = 0xffffffffu, wn1 = 0xffffffffu;
    const unsigned* bmq = MLA ? nullptr : P.BM + (size_t)b * 256 * SEQ + qrow;
    if (!MLA) { wn0 = bmq[0]; wn1 = bmq[SEQ]; }
    for (int t = 0; t < NT; ++t) {
        const int buf = t & 1;
        unsigned w0 = wn0 >> (4 * hi), w1 = wn1 >> (4 * hi);
        if (t + 1 < NT) { ATT_LOAD(t + 1); if (!MLA) { wn0 = bmq[(size_t)(2 * t + 2) * SEQ]; wn1 = bmq[(size_t)(2 * t + 3) * SEQ]; } }
        if (t < my_nt) {
            const LAS unsigned char* Kb = L + buf * KBUF; const LAS unsigned char* Vb = L + 2 * KBUF + buf * VBUF;
            f32x16 s0, s1;
            bf16x8 ka[NS][2];
#pragma unroll
            for (int s = 0; s < NS; ++s) { ka[s][0] = *(const LAS bf16x8*)(Kb + r32 * KP + s * 32 + hi * 16); ka[s][1] = *(const LAS bf16x8*)(Kb + (32 + r32) * KP + s * 32 + hi * 16); }
            __builtin_amdgcn_sched_barrier(0);
#pragma unroll
            for (int s = 0; s < NS; ++s) {
                s0 = __builtin_amdgcn_mfma_f32_32x32x16_bf16(ka[s][0], qf[s], s == 0 ? negm : s0, 0, 0, 0);
                s1 = __builtin_amdgcn_mfma_f32_32x32x16_bf16(ka[s][1], qf[s], s == 0 ? negm : s1, 0, 0, 0);
            }
            s16x4 vf[4][4];
#pragma unroll
            for (int ks = 0; ks < 4; ++ks) { const LAS unsigned char* vp = Vb + ks * 16 * VP + vlane;
                vf[ks][0] = __builtin_bit_cast(s16x4, __builtin_amdgcn_ds_read_tr16_b64_v4i16((LAS s16x4*)(vp)));
                vf[ks][1] = __builtin_bit_cast(s16x4, __builtin_amdgcn_ds_read_tr16_b64_v4i16((LAS s16x4*)(vp + 8 * VP)));
                vf[ks][2] = __builtin_bit_cast(s16x4, __builtin_amdgcn_ds_read_tr16_b64_v4i16((LAS s16x4*)(vp + 64)));
                vf[ks][3] = __builtin_bit_cast(s16x4, __builtin_amdgcn_ds_read_tr16_b64_v4i16((LAS s16x4*)(vp + 8 * VP + 64))); }
            __builtin_amdgcn_sched_barrier(0);
            float mx = fmaxf(fmaxf(s0[0], s0[1]), s1[0]);
#pragma unroll
            for (int i = 2; i < 16; i += 2) mx = fmaxf(fmaxf(mx, s0[i]), s0[i + 1]);
#pragma unroll
            for (int i = 1; i < 15; i += 2) mx = fmaxf(fmaxf(mx, s1[i]), s1[i + 1]);
            mx = fmaxf(mx, s1[15]);
            mx = fmaxf(mx, __shfl_xor(mx, 32));
            if (t == 0 || __any(mx > ATT_THR)) {
                const float dl = (t == 0) ? mx : fmaxf(mx, 0.f), f = (t == 0) ? 1.f : __builtin_amdgcn_exp2f(-dl);
                mhat += dl; l *= f;
#pragma unroll
                for (int i = 0; i < 16; ++i) { s0[i] -= dl; s1[i] -= dl; o0[i] *= f; o1[i] *= f; negm[i] = -mhat; }
            }
            float rs = 0.f;
#pragma unroll
            for (int i = 0; i < 16; ++i) {
                float p0 = __builtin_amdgcn_exp2f(s0[i]), p1 = __builtin_amdgcn_exp2f(s1[i]);
                if (!MLA) { p0 = att_mask(p0, w0, crow(i, 0)); p1 = att_mask(p1, w1, crow(i, 0)); }
                s0[i] = p0; s1[i] = p1; rs += p0 + p1; }
            l += rs;
            bf16x8 pf[4];
#pragma unroll
            for (int ks = 0; ks < 4; ++ks) { v4u w;
#pragma unroll
                for (int j = 0; j < 4; ++j) { const float a = (ks < 2) ? s0[8 * (ks & 1) + 2 * j] : s1[8 * (ks & 1) + 2 * j], c = (ks < 2) ? s0[8 * (ks & 1) + 2 * j + 1] : s1[8 * (ks & 1) + 2 * j + 1]; w[j] = pk2(a, c); }
                pf[ks] = __builtin_bit_cast(bf16x8, w); }
#pragma unroll
            for (int ks = 0; ks < 4; ++ks) {
                const bf16x8 A0 = __builtin_shufflevector(vf[ks][0], vf[ks][1], 0, 1, 2, 3, 4, 5, 6, 7);
                const bf16x8 A1 = __builtin_shufflevector(vf[ks][2], vf[ks][3], 0, 1, 2, 3, 4, 5, 6, 7);
                o0 = __builtin_amdgcn_mfma_f32_32x32x16_bf16(A0, pf[ks], o0, 0, 0, 0);
                o1 = __builtin_amdgcn_mfma_f32_32x32x16_bf16(A1, pf[ks], o1, 0, 0, 0);
            }
        }
        if (t + 1 < NT) ATT_WRITE(buf ^ 1);
        __syncthreads();
    }
    l += __shfl_xor(l, 32);
    const float inv = 1.f / l;
    bf16* op = P.O + (rowb + qrow) * 512 + h * 64 + 4 * hi;
#pragma unroll
    for (int g = 0; g < 4; ++g) {
        v2u w; w.x = pk2(o0[4 * g] * inv, o0[4 * g + 1] * inv); w.y = pk2(o0[4 * g + 2] * inv, o0[4 * g + 3] * inv); *(v2u*)(op + 8 * g) = w;
        v2u z; z.x = pk2(o1[4 * g] * inv, o1[4 * g + 1] * inv); z.y = pk2(o1[4 * g + 2] * inv, o1[4 * g + 3] * inv); *(v2u*)(op + 32 + 8 * g) = z;
    }
#undef ATT_KSRC
#undef ATT_LOAD
#undef ATT_WRITE
}

constexpr int CAND_CAP = 128, QIP = 1296, HS = 513, FAST_CAP = 512;
struct IdxP { const bf16 *QI, *KI; const float* WI; unsigned* BM; unsigned* dbg; };
__device__ __forceinline__ unsigned mono_key(float s) { const unsigned u = __builtin_bit_cast(unsigned, s + 0.0f); return u ^ ((unsigned)((int)u >> 31) | 0x80000000u); }
__device__ __forceinline__ void idx_scores2(const bf16x8 (&kf)[2][4], const LAS unsigned char* qlane, const float (&wq)[8], f32x16& sc0, f32x16& sc1) {
    bf16x8 qv[4], qn[4];
#pragma unroll
    for (int s = 0; s < 4; ++s) qv[s] = *(const LAS bf16x8*)(qlane + 8 * 128 + s * 32);
#pragma unroll
    for (int i = 0; i < 16; ++i) { sc0[i] = 0.f; sc1[i] = 0.f; }
    f32x16 ap0, ap1;
#pragma unroll
    for (int i = 0; i < 16; ++i) { ap0[i] = 0.f; ap1[i] = 0.f; }
#pragma unroll
    for (int n = 0; n < 10; ++n) {
        const int nh = (n + 1 < 2) ? 9 : (n + 1 - 2);
        if (n + 1 < 10) {
#pragma unroll
            for (int s = 0; s < 4; ++s) qn[s] = *(const LAS bf16x8*)(qlane + nh * 128 + s * 32); }
        f32x16 a0, a1;
        if (n < 2) {
#pragma unroll
            for (int s = 0; s < 4; ++s) { sc0 = __builtin_amdgcn_mfma_f32_32x32x16_bf16(kf[0][s], qv[s], sc0, 0, 0, 0); sc1 = __builtin_amdgcn_mfma_f32_32x32x16_bf16(kf[1][s], qv[s], sc1, 0, 0, 0); }
        } else {
#pragma unroll
            for (int i = 0; i < 16; ++i) { a0[i] = 0.f; a1[i] = 0.f; }
#pragma unroll
            for (int s = 0; s < 4; ++s) { a0 = __builtin_amdgcn_mfma_f32_32x32x16_bf16(kf[0][s], qv[s], a0, 0, 0, 0); a1 = __builtin_amdgcn_mfma_f32_32x32x16_bf16(kf[1][s], qv[s], a1, 0, 0, 0); }
        }
        if (n >= 3) {
            const float w = wq[n - 3];
#pragma unroll
            for (int i = 0; i < 16; ++i) { sc0[i] = __builtin_fmaf(w, __builtin_fabsf(ap0[i]), sc0[i]); sc1[i] = __builtin_fmaf(w, __builtin_fabsf(ap1[i]), sc1[i]); }
#pragma unroll
            for (int g = 0; g < 8; ++g) { __builtin_amdgcn_sched_group_barrier(0x008, 1, 0); __builtin_amdgcn_sched_group_barrier(0x002, 4, 0); }
        }
        if (n >= 2) { ap0 = a0; ap1 = a1; }
#pragma unroll
        for (int s = 0; s < 4; ++s) qv[s] = qn[s];
    }
    { const float w = wq[7];
#pragma unroll
      for (int i = 0; i < 16; ++i) { sc0[i] = __builtin_fmaf(w, __builtin_fabsf(ap0[i]), sc0[i]); sc1[i] = __builtin_fmaf(w, __builtin_fabsf(ap1[i]), sc1[i]); } }
#pragma unroll
    for (int i = 0; i < 16; ++i) asm volatile("" : "+v"(sc0[i]), "+v"(sc1[i]));
}
__device__ __forceinline__ void idx_item(LAS unsigned char* L, int b, int j, const IdxP& P, int tid, int lane, int wave) {
    LAS unsigned* hist = (LAS unsigned*)L;
    LAS unsigned* img = (LAS unsigned*)(L + 66048);
    LAS unsigned* st = (LAS unsigned*)(L + 98816);
    LAS unsigned* cand = hist;
    LAS unsigned char* Qs = L + 100864;
    const int r32 = lane & 31, hi = lane >> 5;
    const int q0 = 32 * j, ntile = 2 * (j / 2 + 1);
    const size_t rowb = (size_t)b * SEQ;
    if (ntile <= 8) {
        for (int idx = tid; idx < ntile * 32; idx += NTHR) P.BM[((size_t)b * 256 + (idx >> 5)) * SEQ + q0 + (idx & 31)] = 0xffffffffu;
        return;
    }
    float wq[8];
    { for (int c = tid; c < 32 * 64; c += NTHR) { const int rr = c >> 6, ch = c & 63; *(LAS v4u*)(Qs + rr * QIP + ch * 16) = *(const v4u*)(P.QI + (rowb + q0 + rr) * 512 + ch * 8); }
      const float* wp = P.WI + (rowb + q0 + r32) * 8;
#pragma unroll
      for (int h = 0; h < 8; ++h) wq[h] = 0.5f * wp[h]; }
    if (tid < 32) { st[32 + tid] = 256u; st[64 + tid] = 0u; st[96 + tid] = 0u; }
    if (tid == 0) st[129] = 0u;
    __syncthreads();
    {
        const int r = tid >> 4, part = tid & 15;
        const float* wp = P.WI + (rowb + q0 + r) * 8;
        float qb[4] = {0.f, 0.f, 0.f, 0.f}; float rsum = 0.f;
#pragma unroll
        for (int h = 0; h < 8; ++h) { const float w = wp[h]; const v2u raw = *(const LAS v2u*)(Qs + r * QIP + h * 128 + part * 8);
            const float f0 = bflo(raw.x), f1 = bfhi(raw.x), f2 = bflo(raw.y), f3 = bfhi(raw.y);
            float nsq = (f0 * f0 + f1 * f1) + (f2 * f2 + f3 * f3);
#pragma unroll
            for (int o = 1; o < 16; o <<= 1) nsq += __shfl_xor(nsq, o);
            rsum += fabsf(w) * sqrtf(nsq);
            qb[0] += 0.5f * w * f0; qb[1] += 0.5f * w * f1; qb[2] += 0.5f * w * f2; qb[3] += 0.5f * w * f3; }
        v2u hw, lw;
        { const unsigned h01 = pk2(qb[0], qb[1]), h23 = pk2(qb[2], qb[3]); hw.x = h01; hw.y = h23;
          lw.x = pk2(qb[0] - bflo(h01), qb[1] - bfhi(h01)); lw.y = pk2(qb[2] - bflo(h23), qb[3] - bfhi(h23)); }
        *(LAS v2u*)(Qs + r * QIP + 8 * 128 + part * 8) = hw; *(LAS v2u*)(Qs + r * QIP + 9 * 128 + part * 8) = lw;
        { const v2u kw = *(const v2u*)(P.KI + (rowb + r) * 64 + part * 4); const float f0 = bflo(kw.x), f1 = bfhi(kw.x), f2 = bflo(kw.y), f3 = bfhi(kw.y);
          float ksq = (f0 * f0 + f1 * f1) + (f2 * f2 + f3 * f3);
#pragma unroll
          for (int o = 1; o < 16; o <<= 1) ksq += __shfl_xor(ksq, o);
          if (part == 0) { __hip_atomic_fetch_max(&st[129], __builtin_bit_cast(unsigned, ksq), __ATOMIC_RELAXED, __HIP_MEMORY_SCOPE_WORKGROUP); st[224 + r] = __builtin_bit_cast(unsigned, rsum); } }
    }
    __syncthreads();
    if (tid < 32) { const float R = 0.25f * sqrtf(__builtin_bit_cast(float, st[129])) * __builtin_bit_cast(float, st[224 + tid]);
        const float C = 0.125f * R;
        st[160 + tid] = (0x80000000u | __builtin_bit_cast(unsigned, R + C)) - 511u * 131072u; st[224 + tid] = __builtin_bit_cast(unsigned, C); st[tid] = 0u; st[192 + tid] = 0u;
        st[256 + tid] = __builtin_bit_cast(unsigned, R); st[288 + tid] = 511u; st[320 + tid] = 0u; }
    const LAS unsigned char* qlane = Qs + r32 * QIP + hi * 16;
    int level = 0;
    const int npair = ntile >> 1;
#define IDX_KLOAD2(tp) { const bf16* kp = P.KI + (rowb + 64 * (tp) + r32) * 64 + 8 * hi; _Pragma("unroll") for (int s = 0; s < 4; ++s) { kn[0][s] = *(const bf16x8*)(kp + 16 * s); kn[1][s] = *(const bf16x8*)(kp + 32 * 64 + 16 * s); } }
#define IDX_SCORES2(tp) \
        bf16x8 kf[2][4]; _Pragma("unroll") for (int s = 0; s < 4; ++s) { kf[0][s] = kn[0][s]; kf[1][s] = kn[1][s]; } \
        f32x16 sc0, sc1; idx_scores2(kf, qlane, wq, sc0, sc1); \
        if ((tp) + NWAVES < npair) { IDX_KLOAD2((tp) + NWAVES) }
    bool slow;
    {
        for (int u = tid; u < 32 * HS; u += NTHR) hist[u] = 0u;
        if (tid == 0) st[130] = 0u;
        __syncthreads();
        const float Rq = __builtin_bit_cast(float, st[256 + r32]);
        const int nsw = (npair + 63) >> 6, SP = min(npair, 8 * nsw);
        {   const float s1 = 256.f / Rq; LAS unsigned* hrow = hist + r32 * HS;
            for (int i = wave; i < SP; i += NWAVES) { const int tp = (i * npair) / SP;
                bf16x8 kn[2][4]; IDX_KLOAD2(tp)
                bf16x8 kf[2][4];
#pragma unroll
                for (int s = 0; s < 4; ++s) { kf[0][s] = kn[0][s]; kf[1][s] = kn[1][s]; }
                f32x16 sc0, sc1; idx_scores2(kf, qlane, wq, sc0, sc1);
#pragma unroll
                for (int e = 0; e < 16; ++e) { const int b0 = min(max((int)__builtin_fmaf(sc0[e], s1, 256.f), 0), 511), b1 = min(max((int)__builtin_fmaf(sc1[e], s1, 256.f), 0), 511);
                    __hip_atomic_fetch_add(&hrow[b0], 1u, __ATOMIC_RELAXED, __HIP_MEMORY_SCOPE_WORKGROUP); __hip_atomic_fetch_add(&hrow[b1], 1u, __ATOMIC_RELAXED, __HIP_MEMORY_SCOPE_WORKGROUP); }
            }
        }
        __syncthreads();
        {
            const int q = tid >> 4, seg = tid & 15; const LAS unsigned* hq = hist + q * HS + seg * 32;
            unsigned segsum = 0u;
            for (int wi = 0; wi < 32; ++wi) segsum += hq[wi];
            unsigned S = segsum;
#pragma unroll
            for (int off = 1; off < 16; off <<= 1) { const unsigned o = __shfl_down(S, off, 16); if (seg + off < 16) S += o; }
            const unsigned above = S - segsum, total = __shfl(S, 0, 16);
            const float f = (float)total / (float)(64 * npair), rs = 256.f * f, sg = 3.5f * sqrtf(rs * (1.f - f));
            const int rl = (int)floorf(rs - sg) - 1, rh = (int)ceilf(rs + sg) + 1;
            const unsigned tl = rl > 0 ? (unsigned)rl : 0u, th = (unsigned)rh;
            if (above < tl && tl <= above + segsum) { unsigned cum = above; int fb = 0; bool found = false;
                for (int wi = 31; wi >= 0; --wi) { const unsigned c = hq[wi]; if (!found && cum + c >= tl) { found = true; fb = wi; } if (!found) cum += c; }
                st[288 + q] = (unsigned)(32 * seg + fb); }
            if (above < th && th <= above + segsum) { unsigned cum = above; int fb = 0; bool found = false;
                for (int wi = 31; wi >= 0; --wi) { const unsigned c = hq[wi]; if (!found && cum + c >= th) { found = true; fb = wi; } if (!found) cum += c; }
                st[320 + q] = (unsigned)(32 * seg + fb); }
        }
        __syncthreads();
#ifdef REP_PASS2
        for (int rep2 = 0; rep2 < 2; ++rep2) { if (rep2) { __syncthreads(); if (tid < 32) st[96 + tid] = 0u; __syncthreads(); }
#else
        {
#endif
            const float wbin = Rq * (1.f / 256.f), fH = __builtin_fmaf((float)(st[288 + r32] + 1u), wbin, -Rq), fA = __builtin_fmaf((float)st[320 + r32], wbin, -Rq), s2 = 524287.f / (fH - fA), nfa = -fA * s2;
            bf16x8 kn[2][4]; if (wave < npair) { IDX_KLOAD2(wave) }
            for (int tp = wave; tp < npair; tp += NWAVES) {
                IDX_SCORES2(tp)
#define IDX_FAST_ELEMS(SC, T) { unsigned v = 0u, cm = 0u; \
            _Pragma("unroll") for (int i = 15; i >= 0; --i) { v = __builtin_amdgcn_alignbit(v, __builtin_bit_cast(unsigned, SC[i] - fH), 31);        \
                                                              cm = __builtin_amdgcn_alignbit(cm, __builtin_bit_cast(unsigned, SC[i] - fA), 31); } \
            cm = v & ~cm & 0xffffu; v = ~v & 0xffffu;                                                           \
            if (cm) { const unsigned pos0 = __hip_atomic_fetch_add(&st[96 + r32], (unsigned)__builtin_popcount(cm), __ATOMIC_RELAXED, __HIP_MEMORY_SCOPE_WORKGROUP);     \
                const unsigned rb = 8191u - (unsigned)(32 * (T)) - hi4; \
                _Pragma("unroll") for (int i = 0; i < 16; ++i) if (cm & (1u << i)) { const unsigned pos = min(pos0 + (unsigned)__builtin_popcount(cm & ((1u << i) - 1u)), (unsigned)FAST_CAP - 1u); \
                    cand[r32 * FAST_CAP + pos] = (min((unsigned)__builtin_fmaf(SC[i], s2, nfa), 524287u) << 13) | (rb - (unsigned)((i & 3) + 8 * (i >> 2))); } } \
            unsigned bits = (v & 0xfu) | ((v & 0xf0u) << 4) | ((v & 0xf00u) << 8) | ((v & 0xf000u) << 12);     \
            bits <<= 4 * hi; bits |= __shfl_xor(bits, 32); if (hi == 0) img[(T) * 32 + r32] = bits; }
                unsigned hi4 = 4u * (unsigned)hi; asm volatile("" : "+v"(hi4));
                IDX_FAST_ELEMS(sc0, 2 * tp)
                IDX_FAST_ELEMS(sc1, 2 * tp + 1)
#undef IDX_FAST_ELEMS
            }
        }
        __syncthreads();
        {
            const int q = tid >> 4, l16 = tid & 15; unsigned above = 0u;
            for (int t = l16; t < ntile; t += 16) above += (unsigned)__builtin_popcount(img[t * 32 + q]);
#pragma unroll
            for (int o = 1; o < 16; o <<= 1) above += __shfl_xor(above, o);
            const unsigned n = st[96 + q];
            if (l16 == 0) { if (above >= 256u || 256u - above > n || n > (unsigned)FAST_CAP) st[130] = 1u; st[32 + q] = 256u - above; }
        }
        __syncthreads();
        slow = st[130] != 0u;
#ifdef REP_SEL
        for (int rep3 = 0; rep3 < 2; ++rep3)
#endif
        if (!slow) {
            const int q = tid >> 4, l16 = tid & 15; const unsigned n = st[96 + q], need = st[32 + q];
            unsigned c[FAST_CAP / 16];
#pragma unroll
            for (int i = 0; i < FAST_CAP / 16; ++i) { const unsigned ci = (unsigned)(l16 + 16 * i); c[i] = ci < n ? cand[q * FAST_CAP + ci] : 0u; }
            unsigned Pv = 0u; bool done = false;
#pragma nounroll
            for (int bit = 31; bit >= 0; --bit) { const unsigned trial = Pv | (1u << bit); unsigned cnt = 0u;
#pragma unroll
                for (int i = 0; i < FAST_CAP / 16; ++i) cnt += (c[i] >= trial) ? 1u : 0u;
#pragma unroll
                for (int o = 1; o < 16; o <<= 1) cnt += __shfl_xor(cnt, o);
                if (!done && cnt >= need) { Pv = trial; done = (cnt == need); }
                if (__all(done)) break; }
#pragma unroll
            for (int i = 0; i < FAST_CAP / 16; ++i) if ((unsigned)(l16 + 16 * i) < n && c[i] >= Pv) { const unsigned kidx = 8191u - (c[i] & 8191u);
                __hip_atomic_fetch_or(&img[(kidx >> 5) * 32 + q], 1u << (kidx & 31), __ATOMIC_RELAXED, __HIP_MEMORY_SCOPE_WORKGROUP); }
        } else if (tid < 32) { st[32 + tid] = 256u; st[96 + tid] = 0u; }
        __syncthreads();
    }
#ifdef DIAG_SLOW
    if (slow && tid == 0) __hip_atomic_fetch_add(P.dbg, 1u, RLX_AGENT);
#endif
    if (slow) {
    for (;;) {
        ++level;
        for (int u = tid; u < 32 * HS; u += NTHR) hist[u] = 0u;
        if (tid == 0) st[128] = 0u;
        __syncthreads();
        {
            const unsigned qa = st[r32], qlen = st[192 + r32], base1 = st[160 + r32]; const float cq = __builtin_bit_cast(float, st[224 + r32]);
            const int sh = (level > 1 && qlen > 512u) ? (32 - __builtin_clz(qlen - 1u)) - 9 : 0;
            LAS unsigned* hrow = hist + r32 * HS;
            bf16x8 kn[2][4]; if (wave < npair) { IDX_KLOAD2(wave) }
            for (int tp = wave; tp < npair; tp += NWAVES) {
                IDX_SCORES2(tp)
                if (level == 1) {
#pragma unroll
                    for (int i = 0; i < 16; ++i) { const unsigned k0 = mono_key(sc0[i] + cq), k1 = mono_key(sc1[i] + cq);
                        const unsigned b0 = min((max(k0, base1) - base1) >> 17, 511u), b1 = min((max(k1, base1) - base1) >> 17, 511u);
                        __hip_atomic_fetch_add(&hrow[b0], 1u, __ATOMIC_RELAXED, __HIP_MEMORY_SCOPE_WORKGROUP); __hip_atomic_fetch_add(&hrow[b1], 1u, __ATOMIC_RELAXED, __HIP_MEMORY_SCOPE_WORKGROUP); }
                } else {
#pragma unroll
                    for (int i = 0; i < 16; ++i) { const unsigned o0 = mono_key(sc0[i] + cq) - qa, o1 = mono_key(sc1[i] + cq) - qa;
                        if (o0 < qlen) __hip_atomic_fetch_add(&hrow[o0 >> sh], 1u, __ATOMIC_RELAXED, __HIP_MEMORY_SCOPE_WORKGROUP);
                        if (o1 < qlen) __hip_atomic_fetch_add(&hrow[o1 >> sh], 1u, __ATOMIC_RELAXED, __HIP_MEMORY_SCOPE_WORKGROUP); }
                }
            }
        }
        __syncthreads();
        {
            const int q = tid >> 4, seg = tid & 15;
            unsigned segsum = 0u;
            for (int wi = 0; wi < 32; ++wi) segsum += hist[q * HS + seg * 32 + wi];
            unsigned S = segsum;
#pragma unroll
            for (int off = 1; off < 16; off <<= 1) { const unsigned o = __shfl_down(S, off, 16); if (seg + off < 16) S += o; }
            const unsigned above = S - segsum, need = st[32 + q];
            if (above < need && need <= above + segsum) {
                unsigned cum = above, fbin = 0u, fneed = 1u, fcnt = 0u; bool found = false;
                for (int wi = 31; wi >= 0; --wi) { const unsigned c = hist[q * HS + seg * 32 + wi];
                    if (!found && cum + c >= need) { found = true; fbin = (unsigned)wi; fneed = need - cum; fcnt = c; } if (!found) cum += c; }
                fbin += 32u * (unsigned)seg;
                unsigned na, nlen;
                if (level == 1) { const unsigned base1 = st[160 + q];
                    if (fbin == 0u) { na = 0u; nlen = base1 + 131072u; } else if (fbin == 511u) { na = base1 + 511u * 131072u; nlen = 0u - na; } else { na = base1 + fbin * 131072u; nlen = 131072u; } }
                else { const unsigned qa = st[q], qlen = st[192 + q]; const int sh = qlen > 512u ? (32 - __builtin_clz(qlen - 1u)) - 9 : 0;
                    na = qa + (fbin << sh); nlen = min(1u << sh, qlen - (fbin << sh)); }
                st[q] = na; st[192 + q] = nlen; st[32 + q] = fneed; st[64 + q] = fcnt;
                if (fcnt > (unsigned)CAND_CAP && nlen > 1u) st[128] = 1u;
            }
        }
        __syncthreads();
#ifndef MAXLVL
#define MAXLVL 8
#endif
        const bool more = (st[128] != 0u) && (level < MAXLVL);
        __syncthreads();
        if (!more) break;
    }
    {
        const unsigned qa = st[r32], qlen = st[192 + r32]; const float cq = __builtin_bit_cast(float, st[224 + r32]);
        const unsigned Hk = qa + qlen - 1u;
        unsigned hb = (Hk & 0x80000000u) ? (Hk ^ 0x80000000u) : ~Hk;
        if (hb == 0x80000000u) hb = 0x80000001u;
        const float fH = __builtin_bit_cast(float, hb);
        const unsigned ab_ = (qa & 0x80000000u) ? (qa ^ 0x80000000u) : ~qa;
        const float fA = (qa < 0x00800000u) ? -__builtin_inff() : __builtin_bit_cast(float, ab_);
        bf16x8 kn[2][4]; if (wave < npair) { IDX_KLOAD2(wave) }
        for (int tp = wave; tp < npair; tp += NWAVES) {
            IDX_SCORES2(tp)
#define IDX_COLLECT_ELEMS(SC, T) { unsigned v = 0u; _Pragma("unroll") for (int i = 15; i >= 0; --i) { const float ts = SC[i] + cq; const bool ab = ts > fH; v = v + v + (ab ? 1u : 0u); \
                if (!ab && ts >= fA) { const unsigned key = mono_key(ts); \
                    const unsigned pos = __hip_atomic_fetch_add(&st[96 + r32], 1u, __ATOMIC_RELAXED, __HIP_MEMORY_SCOPE_WORKGROUP); \
                    if (pos < (unsigned)CAND_CAP) { cand[(r32 * CAND_CAP + pos) * 2] = key; cand[(r32 * CAND_CAP + pos) * 2 + 1] = (unsigned)(32 * (T) + crow(i, hi)); } } } \
            unsigned bits = (v & 0xfu) | ((v & 0xf0u) << 4) | ((v & 0xf00u) << 8) | ((v & 0xf000u) << 12);     \
            bits <<= 4 * hi; bits |= __shfl_xor(bits, 32); if (hi == 0) img[(T) * 32 + r32] = bits; }
            IDX_COLLECT_ELEMS(sc0, 2 * tp)
            IDX_COLLECT_ELEMS(sc1, 2 * tp + 1)
#undef IDX_COLLECT_ELEMS
        }
    }
#undef IDX_SCORES2
#undef IDX_KLOAD2
    __syncthreads();
    {
        const int q = tid >> 4; const unsigned n = min(st[96 + q], (unsigned)CAND_CAP), need = st[32 + q];
        for (unsigned c = tid & 15; c < n; c += 16) { const unsigned key = cand[(q * CAND_CAP + c) * 2], idx = cand[(q * CAND_CAP + c) * 2 + 1]; unsigned rank = 0u;
            for (unsigned o = 0; o < n; ++o) { const unsigned k2 = cand[(q * CAND_CAP + o) * 2], i2 = cand[(q * CAND_CAP + o) * 2 + 1]; rank += (k2 > key || (k2 == key && i2 < idx)) ? 1u : 0u; }
            if (rank < need) __hip_atomic_fetch_or(&img[(idx >> 5) * 32 + q], 1u << (idx & 31), __ATOMIC_RELAXED, __HIP_MEMORY_SCOPE_WORKGROUP); }
    }
    }
    __syncthreads();
    for (int idx = tid; idx < ntile * 32; idx += NTHR) P.BM[((size_t)b * 256 + (idx >> 5)) * SEQ + q0 + (idx & 31)] = img[idx];
    __syncthreads();
}

__device__ __forceinline__ int wq_next(Frame& F, int cw) {
    __syncthreads();
    if (F_TID == 0) F.MISC[0] = __hip_atomic_fetch_add((unsigned*)(F.ctl + cw), 1u, RLX_AGENT);
    __syncthreads();
    return (int)F.MISC[0];
}

__device__ __forceinline__ void p5a_route(Frame& F, const Args& A) {
    const int lane = F_LANE, tid = F_TID, wave = F_WAVE;
    const float* x1 = A.out; const float* g2 = A.in[11];
    const float* wrg = A.in[12]; const float* brg = A.in[13]; const float* wre = A.in[14]; const float* bre = A.in[15];
    int* toke = (int*)(F.ws + WS_TOKE); float* tokw = (float*)(F.ws + WS_TOKW); float* rstd2 = (float*)(F.ws + WS_RSTD2);
    int* sslot = (int*)(F.ws + WS_SSLOT);
    constexpr int WST = 44, WCH = 256 * WST * 4;
    LAS float* wl = (LAS float*)F.lds;
    LAS unsigned* lcnt = (LAS unsigned*)(F.lds + 2 * WCH);
    LAS float* lgs = (LAS float*)(F.lds + 2 * WCH + 256);
    for (int i = F.vcu * NTHR + tid; i < SORT_ROWS; i += F.G * NTHR) sslot[i] = -1;
    if (tid < NEXP) lcnt[tid] = 0u;
    const int i16 = lane & 15, kq = lane >> 4, tile = wave & 3, half = wave >> 2;
    const int per = T / F.G;
    for (int t0 = F.vcu * per; t0 < (F.vcu + 1) * per; t0 += 64) {
        const float* xr = x1 + (size_t)(t0 + 16 * tile + i16) * D + 4 * kq;
        f32x4 acc0 = (f32x4){0.f, 0.f, 0.f, 0.f}, acc1 = acc0; float ss = 0.f;
        f32x4 se[4], sg; float gk[5];
#define RT_LOAD(c) do { _Pragma("unroll") for (int q = 0; q < 4; ++q) { const int f = tid + 512 * q, k = f >> 3; se[q] = *(const GAS f32x4*)(wre + (size_t)(256 * (c) + k) * 32 + 4 * (f & 7)); gk[q] = g2[256 * (c) + k]; } \
            { const int k = tid >> 1; sg = *(const GAS f32x4*)(wrg + (size_t)(256 * (c) + k) * 8 + 4 * (tid & 1)); gk[4] = g2[256 * (c) + k]; } } while (0)
#define RT_WRITE(bf) do { LAS float* wb = wl + (bf) * (WCH / 4); _Pragma("unroll") for (int q = 0; q < 4; ++q) { const int f = tid + 512 * q, k = f >> 3; *(LAS f32x4*)(wb + k * WST + 4 * (f & 7)) = se[q] * gk[q]; } \
            { const int k = tid >> 1; *(LAS f32x4*)(wb + k * WST + 32 + 4 * (tid & 1)) = sg * gk[4]; } } while (0)
        RT_LOAD(0); RT_WRITE(0); __syncthreads();
        for (int c = 0; c < 4; ++c) {
            if (c + 1 < 4) RT_LOAD(c + 1);
            const LAS float* wb = wl + (c & 1) * (WCH / 4) + 4 * kq * WST + i16 + 16 * half;
#pragma unroll 4
            for (int s = 0; s < 16; ++s) {
                const f32x4 a4 = *(const GAS f32x4*)(xr + 256 * c + 16 * s);
                if (half == 0) ss += (a4.x * a4.x + a4.y * a4.y) + (a4.z * a4.z + a4.w * a4.w);
#pragma unroll
                for (int cc = 0; cc < 4; ++cc) { const LAS float* wp = wb + (16 * s + cc) * WST;
                    acc0 = __builtin_amdgcn_mfma_f32_16x16x4f32(a4[cc], wp[0], acc0, 0, 0, 0);
                    if (half == 0) acc1 = __builtin_amdgcn_mfma_f32_16x16x4f32(a4[cc], wp[32 - (i16 & 8)], acc1, 0, 0, 0); }
            }
            if (c + 1 < 4) RT_WRITE((c + 1) & 1);
            __syncthreads();
        }
#undef RT_LOAD
#undef RT_WRITE
        LAS float* lt = lgs + tile * 640;
#pragma unroll
        for (int r = 0; r < 4; ++r) { const int tk = 4 * kq + r; lt[tk * 40 + 8 + 16 * half + i16] = acc0[r]; if (half == 0 && i16 < 8) lt[tk * 40 + i16] = acc1[r]; }
        if (half == 0) { ss += __shfl_xor(ss, 16); ss += __shfl_xor(ss, 32); if (kq == 0) lgs[2560 + 16 * tile + i16] = 1.f / sqrtf(ss * (1.f / D) + EPS); }
        __syncthreads();
        if (half == 0 && lane < 16) {
            const int m = t0 + 16 * tile + lane; const float rstd = lgs[2560 + 16 * tile + lane]; const LAS float* lg = lt + lane * 40;
            float gl[8];
#pragma unroll
            for (int k = 0; k < 8; ++k) gl[k] = lg[k] * rstd + brg[k];
            int gs = 0; float gm = gl[0];
#pragma unroll
            for (int k = 1; k < 8; ++k) if (gl[k] > gm) { gm = gl[k]; gs = k; }
            float den = 0.f;
#pragma unroll
            for (int k = 0; k < 8; ++k) den += __expf(gl[k] - gm);
            const float wgrp = 1.f / den;
            float el[4];
#pragma unroll
            for (int cc = 0; cc < 4; ++cc) el[cc] = lg[8 + 4 * gs + cc] * rstd + bre[4 * gs + cc];
            int i1 = 0; float v1 = el[0];
#pragma unroll
            for (int cc = 1; cc < 4; ++cc) if (el[cc] > v1) { v1 = el[cc]; i1 = cc; }
            int i2 = -1; float v2 = 0.f;
#pragma unroll
            for (int cc = 0; cc < 4; ++cc) if (cc != i1 && (i2 < 0 || el[cc] > v2)) { v2 = el[cc]; i2 = cc; }
            const float e2 = __expf(v2 - v1), w1 = 1.f / (1.f + e2), w2 = e2 / (1.f + e2);
            toke[2 * m] = gs * 4 + i1; toke[2 * m + 1] = gs * 4 + i2; tokw[2 * m] = w1 * wgrp; tokw[2 * m + 1] = w2 * wgrp; rstd2[m] = rstd;
            __hip_atomic_fetch_add(&lcnt[gs * 4 + i1], 1u, __ATOMIC_RELAXED, __HIP_MEMORY_SCOPE_WORKGROUP);
            __hip_atomic_fetch_add(&lcnt[gs * 4 + i2], 1u, __ATOMIC_RELAXED, __HIP_MEMORY_SCOPE_WORKGROUP);
        }
        __syncthreads();
    }
    if (tid < NEXP && lcnt[tid]) __hip_atomic_fetch_add((unsigned*)(F.ctl + CW_CNT + tid), lcnt[tid], RLX_AGENT);
}

__device__ __forceinline__ void p5a2_scatter(Frame& F, const Args& A) {
    const int lane = F_LANE, tid = F_TID;
    const float* x1 = A.out; const float* g2 = A.in[11];
    const int* toke = (const int*)(F.ws + WS_TOKE); const float* tokw = (const float*)(F.ws + WS_TOKW); const float* rstd2 = (const float*)(F.ws + WS_RSTD2);
    int* sslot = (int*)(F.ws + WS_SSLOT); float* sw = (float*)(F.ws + WS_SW); int* t2e = (int*)(F.ws + WS_T2E);
    bf16* AS = (bf16*)(F.ws + WS_ASORT);
    LAS unsigned* sh = (LAS unsigned*)F.lds;
    if (tid < NEXP) sh[256 + tid] = __hip_atomic_load((unsigned*)(F.ctl + CW_CNT + tid), RLX_AGENT);
    __syncthreads();
    if (tid == 0) { unsigned acc = 0u;
        for (int e = 0; e < NEXP; ++e) { const unsigned c = sh[256 + e]; sh[e] = acc; const unsigned nt = (c + 255u) / 256u;
            if (blockIdx.x == 0) for (unsigned i = 0; i < nt; ++i) t2e[acc / 256u + i] = e;
            acc += nt * 256u; }
        if (blockIdx.x == 0) t2e[255] = (int)(acc / 256u); }
    const int per = T / F.G;
    for (int t0 = F.vcu * per; t0 < (F.vcu + 1) * per; t0 += 64) {
        if (tid < NEXP) sh[32 + tid] = 0u;
        __syncthreads();
        int e = 0; unsigned lpos = 0u;
        if (tid < 128) { e = toke[2 * t0 + tid]; lpos = __hip_atomic_fetch_add(&sh[32 + e], 1u, __ATOMIC_RELAXED, __HIP_MEMORY_SCOPE_WORKGROUP); }
        __syncthreads();
        if (tid < NEXP) sh[64 + tid] = sh[tid] + (sh[32 + tid] ? __hip_atomic_fetch_add((unsigned*)(F.ctl + CW_FILL + tid), sh[32 + tid], RLX_AGENT) : 0u);
        __syncthreads();
        if (tid < 128) { const unsigned pos = sh[64 + e] + lpos; sh[96 + tid] = pos; sslot[pos] = 2 * t0 + tid; sw[pos] = tokw[2 * t0 + tid]; }
        __syncthreads();
        for (int tk0 = F_WAVE; tk0 < 64; tk0 += 4 * NWAVES) {
            f32x4 xv[4][4];
#pragma unroll
            for (int r = 0; r < 4; ++r) { const GAS f32x4* xr = (const GAS f32x4*)(x1 + (size_t)(t0 + tk0 + r * NWAVES) * D) + lane;
#pragma unroll
                for (int j = 0; j < 4; ++j) xv[r][j] = xr[64 * j]; }
#pragma unroll
            for (int r = 0; r < 4; ++r) { const int tk = tk0 + r * NWAVES, m = t0 + tk; const float rstd = rstd2[m];
                const unsigned p0 = sh[96 + 2 * tk], p1 = sh[96 + 2 * tk + 1];
#pragma unroll
                for (int j = 0; j < 4; ++j) { const f32x4 g = *((const GAS f32x4*)g2 + lane + 64 * j); const f32x4 y = xv[r][j] * rstd * g; v2u w; w.x = pk2(y.x, y.y); w.y = pk2(y.z, y.w);
                    *((GAS v2u*)(AS + (size_t)p0 * D) + lane + 64 * j) = w; *((GAS v2u*)(AS + (size_t)p1 * D) + lane + 64 * j) = w; } } }
        __syncthreads();
    }
}

__device__ __forceinline__ void p6_final(Frame& F, const Args& A) {
    const int gw = F.vcu * NWAVES + F_WAVE, NGW = F.G * NWAVES, lane = F_LANE;
    const float* gf = A.in[19]; float* out = A.out; const bf16* SL = (const bf16*)(F.ws + WS_SLOTS);
    for (int m0 = gw; m0 < T; m0 += 2 * NGW) {
        f32x4 v[2][4]; v2u a[2][4], c[2][4];
#pragma unroll
        for (int r = 0; r < 2; ++r) { const int m = min(m0 + r * NGW, T - 1); const GAS f32x4* xr = (const GAS f32x4*)(out + (size_t)m * D) + lane;
            const GAS v2u* s0 = (const GAS v2u*)(SL + (size_t)(2 * m) * D) + lane; const GAS v2u* s1 = (const GAS v2u*)(SL + (size_t)(2 * m + 1) * D) + lane;
#pragma unroll
            for (int j = 0; j < 4; ++j) { v[r][j] = xr[64 * j]; a[r][j] = s0[64 * j]; c[r][j] = s1[64 * j]; } }
#pragma unroll
        for (int r = 0; r < 2; ++r) { const int m = m0 + r * NGW; float s = 0.f;
#pragma unroll
            for (int j = 0; j < 4; ++j) { f32x4& w = v[r][j];
                w.x += bflo(a[r][j].x) + bflo(c[r][j].x); w.y += bfhi(a[r][j].x) + bfhi(c[r][j].x); w.z += bflo(a[r][j].y) + bflo(c[r][j].y); w.w += bfhi(a[r][j].y) + bfhi(c[r][j].y);
                s += (w.x * w.x + w.y * w.y) + (w.z * w.z + w.w * w.w); }
            const float rstd = 1.f / sqrtf(wave_sum(s) * (1.f / D) + EPS);
            if (m < T) { GAS f32x4* xo = (GAS f32x4*)(out + (size_t)m * D) + lane;
#pragma unroll
                for (int j = 0; j < 4; ++j) { const f32x4 g = *((const GAS f32x4*)gf + lane + 64 * j); xo[64 * j] = v[r][j] * rstd * g; } } }
    }
}

constexpr int NPHASE = 13;
__global__ void __launch_bounds__(NTHR, 2) mk_fwd(Args args) {
    extern __shared__ __attribute__((aligned(16))) unsigned char lds[];
    Frame F;
    F.lds = (LAS unsigned char*)lds; F.MISC = (volatile LAS unsigned*)(F.lds + MISC_OFF);
        F.G = gridDim.x; { const int bx = blockIdx.x; F.vcu = (F.G % 8 == 0) ? (bx % 8) * (F.G / 8) + bx / 8 : bx; }
    F.ws = args.ws; F.ctl = (gu32*)(args.ws + WS_CTL);
    unsigned char* ws = args.ws;
    if (F_TID < 128) F.MISC[F_TID] = 0u;
    __syncthreads();
    const bool single = (args.ph_hi - args.ph_lo) > 1;
    XcdBarrier bar; bar.bar = (unsigned*)(F.ctl + CW_BAR); bar.x = 0; bar.st = nullptr;
    if (single) bar = xcd_barrier_post((unsigned*)(F.ctl + CW_BAR), F.MISC + 8);
    const int lo = args.ph_lo, hi = args.ph_hi;
#ifdef ONLY
#define IN(k) ((k) == ONLY && lo <= (k) && (k) < hi)
#else
#define IN(k) (lo <= (k) && (k) < hi)
#endif
#ifdef TS_A
#define STAMP(k) do { if (blockIdx.x == 0 && threadIdx.x == 0) ((unsigned long long*)(ws + WS_CTL + 8192))[(k) + 1] = __builtin_amdgcn_s_memrealtime(); } while (0)
#else
#define STAMP(k) do { } while (0)
#endif
#define SEAM(k) do { if (IN((k) + 1)) xcd_barrier(bar); STAMP(k); } while (0)
    const f32x2* rope = (const f32x2*)(ws + WS_ROPE);
    bf16* GA = (bf16*)args.out; bf16* GB = (bf16*)args.out + (size_t)T * 1024;

    STAMP(-1);
    if (IN(0)) { p0_prologue(F, args);
#ifdef REP_P0
        p0_prologue(F, args);
#endif
        SEAM(0); }
    if (IN(1)) {
        pg8::Gemm g{(const bf16*)(ws + WS_H), (const bf16*)(ws + WS_WIN), T, NIN, D, 0}; pg8::StaticOrder S; S.init(T, NIN, F.G, (int)blockIdx.x);
        pg8::EpiIn E{(bf16*)(ws + WS_CQ), (bf16*)(ws + WS_CKV), (bf16*)(ws + WS_QB), (bf16*)(ws + WS_KB), (bf16*)(ws + WS_VB), (bf16*)(ws + WS_QI), (bf16*)(ws + WS_KI), (bf16*)(ws + WS_KR), GA, GB, (float*)(ws + WS_WI), rope};
        pg8::gemm_phase<pg8::EpiIn, pg8::StaticOrder, true, true>(F.lds, g, S, E);
#ifdef REP_P1
        pg8::gemm_phase<pg8::EpiIn, pg8::StaticOrder, true, true>(F.lds, g, S, E);
#endif
        SEAM(1);
    }
    if (IN(2)) { p2a_norms(F, args); SEAM(2); }
    if (IN(3)) {
#ifdef REP_P3
      for (int rep = 0; rep < 2; ++rep) {
#else
      {
#endif
#ifndef NO3A
        { pg8::Gemm g{(const bf16*)(ws + WS_CQ), (const bf16*)(ws + WS_WUQ), T, 768, 384, 0}; pg8::StaticOrder S; S.init(T, 768, F.G, (int)blockIdx.x);
          pg8::EpiQA E{(bf16*)(ws + WS_QA), rope}; pg8::gemm_phase<pg8::EpiQA, pg8::StaticOrder, true, true>(F.lds, g, S, E); }
#endif
#ifndef NO3B
        { pg8::Gemm g{(const bf16*)(ws + WS_CKV), (const bf16*)(ws + WS_WUKV), T, 1024, 256, 0}; pg8::StaticOrder S; S.init(T, 1024, F.G, (int)blockIdx.x);
          pg8::EpiKV E{(bf16*)(ws + WS_KN), (bf16*)(ws + WS_VA)}; pg8::gemm_phase<pg8::EpiKV, pg8::StaticOrder, true, true>(F.lds, g, S, E); }
#endif
      }
        SEAM(3);
    }
    if (IN(4)) {
        unsigned* rdy = (unsigned*)(F.ctl + CW_RDY);
        for (;;) { const int k = wq_next(F, CW_Q1); if (k >= 1536 + CV_QITEMS) break;
            int ltid = threadIdx.x; asm volatile("" : "+v"(ltid));
            const int lw = __builtin_amdgcn_readfirstlane(ltid >> 6);
            if (k < 512) { const int ib = k & 1, ij = 255 - (k >> 1);
                const IdxP IP{(const bf16*)(ws + WS_QI), (const bf16*)(ws + WS_KI), (const float*)(ws + WS_WI), (unsigned*)(ws + WS_BM), (unsigned*)(F.ctl + 1024)};
                idx_item(F.lds, ib, ij, IP, ltid, ltid & 63, lw);
#ifdef REP_IDX
                __syncthreads(); idx_item(F.lds, ib, ij, IP, ltid, ltid & 63, lw);
#endif
                VM_WAIT(); __syncthreads();
                if (ltid == 0) { __builtin_amdgcn_fence(__ATOMIC_RELEASE, "agent"); VM_WAIT(); __hip_atomic_fetch_add(rdy + 64 * (ib * 32 + (ij >> 3)), 1u, RLX_AGENT); }
                continue; }
            const int j = k - 512; int a;
            if (j < 3 * CV_QITEMS) { const int q3 = j / 3, r3 = j - 3 * q3; a = (r3 == 2) ? -1 - q3 : 2 * q3 + r3; } else a = j - CV_QITEMS;
            if (a < 0) { const int c = -1 - a; LAS float* scr = (LAS float*)(F.lds + lw * 16640);
                conv_tile2(args, ws, CV_EARLY + 16 * c + lw, CV_EARLY + 16 * c + 8 + lw, scr, ltid & 63);
                continue; }
            { const int u = a >> 1, ub = (u & 15) >> 3, uh = u & 7, uq = 31 - (u >> 4);
                if (a & 1) { const AttnP APA{(const bf16*)(ws + WS_QA), (const bf16*)(ws + WS_KN), (const bf16*)(ws + WS_KR), (const bf16*)(ws + WS_VA), (bf16*)(ws + WS_OA), nullptr};
                    attn_unit<true>(F.lds, ub, uh, uq, APA, ltid, ltid & 63, lw); }
                else { const AttnP APB{(const bf16*)(ws + WS_QB), (const bf16*)(ws + WS_KB), nullptr, (const bf16*)(ws + WS_VB), (bf16*)(ws + WS_OB), (const unsigned*)(ws + WS_BM)};
                    if (ltid == 0) { unsigned sp = 0u; while (__hip_atomic_load(rdy + 64 * (ub * 32 + uq), RLX_AGENT) < 8u) { __builtin_amdgcn_s_sleep(8); if (++sp > (1u << 22)) break; }
                        __builtin_amdgcn_fence(__ATOMIC_ACQUIRE, "agent"); VM_WAIT(); }
                    __syncthreads();
                    attn_unit<false>(F.lds, ub, uh, uq, APB, ltid, ltid & 63, lw); } }
        }
    }
    if (IN(5)) { SEAM(5); }
    if (IN(6)) {
#ifdef REP_P6
      for (int rep = 0; rep < 2; ++rep) {
#else
      {
#endif
        { pg8::Gemm g{(const bf16*)(ws + WS_OA), (const bf16*)(ws + WS_WOA), T, 1024, 512, 0}; pg8::StaticOrder S; S.init(T, 1024, F.G, (int)blockIdx.x);
          pg8::EpiY<0> E{(bf16*)(ws + WS_Y), GA}; pg8::gemm_phase<pg8::EpiY<0>, pg8::StaticOrder, true, true>(F.lds, g, S, E); }
        { pg8::Gemm g{(const bf16*)(ws + WS_OB), (const bf16*)(ws + WS_WOB), T, 1024, 512, 0}; pg8::StaticOrder S; S.init(T, 1024, F.G, (int)blockIdx.x);
          pg8::EpiY<1> E{(bf16*)(ws + WS_Y), GB}; pg8::gemm_phase<pg8::EpiY<1>, pg8::StaticOrder, true, true>(F.lds, g, S, E); }
      }
        SEAM(6);
    }
    if (IN(7)) {
        pg8::Gemm g{(const bf16*)(ws + WS_Y), (const bf16*)(ws + WS_WOUT), T, 1024, 1024, 0}; pg8::StaticOrder S; S.init(T, 1024, F.G, (int)blockIdx.x);
        pg8::EpiX1 E{args.in[0], args.out}; pg8::gemm_phase<pg8::EpiX1, pg8::StaticOrder, true, true>(F.lds, g, S, E);
#ifdef REP_P7
        pg8::gemm_phase<pg8::EpiX1, pg8::StaticOrder, true, true>(F.lds, g, S, E);
#endif
        SEAM(7);
    }
    if (IN(8)) { p5a_route(F, args); SEAM(8); }
    if (IN(9)) { p5a2_scatter(F, args); SEAM(9); }
    if (IN(10)) {
        const int* t2e = (const int*)(ws + WS_T2E); const int ntl = t2e[255];
        pg8::Gemm g{(const bf16*)(ws + WS_ASORT), (const bf16*)(ws + WS_WGU), SORT_ROWS, 512, 1024, (size_t)512 * 1024 * 2}; pg8::GroupOrder S; S.init(ntl, 2, F.G, (int)blockIdx.x, t2e);
        pg8::EpiHid E{(bf16*)(ws + WS_HID)}; pg8::gemm_phase<pg8::EpiHid, pg8::GroupOrder, true, true>(F.lds, g, S, E);
#ifdef REP_P10
        pg8::gemm_phase<pg8::EpiHid, pg8::GroupOrder, true, true>(F.lds, g, S, E);
#endif
        SEAM(10);
    }
    if (IN(11)) {
        const int* t2e = (const int*)(ws + WS_T2E); const int ntl = t2e[255];
        pg8::Gemm g{(const bf16*)(ws + WS_HID), (const bf16*)(ws + WS_WD), SORT_ROWS, 1024, 256, (size_t)1024 * 256 * 2}; pg8::GroupOrder S; S.init(ntl, 4, F.G, (int)blockIdx.x, t2e);
        pg8::EpiDown E{(bf16*)(ws + WS_SLOTS), (const int*)(ws + WS_SSLOT), (const float*)(ws + WS_SW)}; pg8::gemm_phase<pg8::EpiDown, pg8::GroupOrder, true, true>(F.lds, g, S, E);
#ifdef REP_P11
        pg8::gemm_phase<pg8::EpiDown, pg8::GroupOrder, true, true>(F.lds, g, S, E);
#endif
        SEAM(11);
    }
    if (IN(12)) { p6_final(F, args); }
#ifdef DIAG_SLOW
    if (blockIdx.x == 0 && threadIdx.x == 0) { const unsigned long long t0 = __builtin_amdgcn_s_memrealtime(), wait = 100ull * __hip_atomic_load((unsigned*)(F.ctl + 1024), RLX_AGENT);
        while (__builtin_amdgcn_s_memrealtime() - t0 < wait) __builtin_amdgcn_s_sleep(16); }
#endif
#ifdef TS_A
    if (blockIdx.x == 0 && threadIdx.x == 0) { STAMP(12); __builtin_amdgcn_s_waitcnt(0);
        const unsigned long long* tsp = (const unsigned long long*)(ws + WS_CTL + 8192);
        const unsigned long long ta = __hip_atomic_load(tsp + (TS_A) + 1, RLX_AGENT), tb = __hip_atomic_load(tsp + (TS_B) + 1, RLX_AGENT);
        const unsigned long long t0 = __builtin_amdgcn_s_memrealtime(), wait = 4ull * (tb - ta);
        while (__builtin_amdgcn_s_memrealtime() - t0 < wait) __builtin_amdgcn_s_sleep(16); }
#endif
#undef IN
#undef SEAM
}

#ifndef MK_MULTI
#define MK_MULTI 0
#endif
extern "C" void kernel_launch(void* const* d_in, const int* in_sizes, int n_in, void* d_out, int out_size, void* d_ws, size_t ws_size, hipStream_t stream) {
    static int grid = 0;
    if (grid == 0) {
        if (n_in != 20 || in_sizes[0] != T * D || out_size != T * D || ws_size < WS_END) { fprintf(stderr, "kernel_launch: unexpected shapes n_in %d in0 %d out %d ws %zu\n", n_in, n_in > 0 ? in_sizes[0] : -1, out_size, ws_size); grid = -1; return; }
        int dev = 0, cus = 0;
        if (hipGetDevice(&dev) != hipSuccess || hipDeviceGetAttribute(&cus, hipDeviceAttributeMultiprocessorCount, dev) != hipSuccess) { grid = -1; return; }
        if (hipFuncSetAttribute((const void*)mk_fwd, hipFuncAttributeMaxDynamicSharedMemorySize, LDS_BYTES) != hipSuccess) { fprintf(stderr, "kernel_launch: hipFuncSetAttribute failed\n"); grid = -1; return; }
        (void)hipGetLastError();
        grid = cus;
    }
    if (grid < 0) return;
    if (hipMemsetAsync((char*)d_ws + WS_CTL, 0, CTL_ZERO_BYTES, stream) != hipSuccess) return;
    Args a{};
    for (int i = 0; i < 20; ++i) a.in[i] = (const float*)d_in[i];
    a.out = (float*)d_out; a.ws = (unsigned char*)d_ws;
#if MK_MULTI
    for (int p = 0; p < NPHASE; ++p) { a.ph_lo = p; a.ph_hi = p + 1; hipLaunchKernelGGL(mk_fwd, dim3(grid), dim3(NTHR), LDS_BYTES, stream, a); }
#else
    a.ph_lo = 0; a.ph_hi = NPHASE;
    hipLaunchKernelGGL(mk_fwd, dim3(grid), dim3(NTHR), LDS_BYTES, stream, a);
#endif
}
```

```cpp
#include <hip/hip_runtime.h>
#include <hip/hip_bf16.h>
#include <cstdio>
#include <cstdint>

#define GAS __attribute__((address_space(1)))
#define LAS __attribute__((address_space(3)))
typedef unsigned short bf16;
typedef unsigned v4u __attribute__((ext_vector_type(4)));
typedef unsigned v2u __attribute__((ext_vector_type(2)));
typedef float f32x4 __attribute__((ext_vector_type(4)));
typedef float f32x2 __attribute__((ext_vector_type(2)));
typedef float f32x16 __attribute__((ext_vector_type(16)));
typedef short bf16x8 __attribute__((ext_vector_type(8)));
typedef short s16x4 __attribute__((ext_vector_type(4)));
typedef __bf16 bf16x2_t __attribute__((ext_vector_type(2)));
typedef GAS unsigned gu32;
#define RLX_AGENT __ATOMIC_RELAXED, __HIP_MEMORY_SCOPE_AGENT
#define LDS_WAIT() asm volatile("s_waitcnt lgkmcnt(0)" ::: "memory")
#define VM_WAIT() asm volatile("s_waitcnt vmcnt(0)" ::: "memory")

constexpr int NWAVES = 8, NTHR = NWAVES * 64;
constexpr int BATCH = 2, SEQ = 8192, D = 1024, T = BATCH * SEQ;
constexpr float EPS = 1e-6f;
constexpr int NIN = 4864, NIN_SRC = 4840;
constexpr int C_CQ = 0, C_CKV = 384, C_QB = 640, C_KB = 1152, C_VB = 1664, C_QI = 2176, C_KR = 2688, C_KI = 2720, C_WI = 2784, C_GA = 2816, C_GB = 3840;
constexpr int NEXP = 32, FF = 256;
constexpr int SORT_ROWS = 2 * T + NEXP * 256;
constexpr float LOG2E = 1.4426950408889634f;
constexpr float C2A = 0.10206207261596575f * LOG2E;
constexpr float C2B = 0.125f * LOG2E;
constexpr float WI_SCALE = 0.35355339059327373f * 0.125f;

constexpr size_t MiB = 1u << 20, KiB = 1u << 10;
constexpr size_t WS_CTL = 0, CTL_ZERO_BYTES = 1 * MiB;
constexpr size_t WS_ROPE = 1 * MiB;
constexpr size_t WS_WI = 2 * MiB;
constexpr size_t WS_TOKE = 2 * MiB + 512 * KiB;
constexpr size_t WS_TOKW = WS_TOKE + 128 * KiB;
constexpr size_t WS_RSTD2 = WS_TOKW + 128 * KiB;
constexpr size_t WS_SSLOT = 3 * MiB + 512 * KiB;
constexpr size_t WS_SW = WS_SSLOT + 192 * KiB;
constexpr size_t WS_T2E = WS_SW + 192 * KiB;
constexpr size_t WS_WIN = 4 * MiB, WS_WUQ = 14 * MiB, WS_WUKV = 15 * MiB, WS_WOA = 16 * MiB, WS_WOB = 17 * MiB, WS_WOUT = 18 * MiB, WS_WGU = 20 * MiB, WS_WD = 52 * MiB;
constexpr size_t WS_H = 68 * MiB, WS_OA = 68 * MiB, WS_OB = 84 * MiB;
constexpr size_t WS_QA = 100 * MiB, WS_KN = 124 * MiB, WS_VA = 140 * MiB, WS_Y = 100 * MiB;
constexpr size_t WS_QB = 156 * MiB, WS_KB = 172 * MiB, WS_VB = 188 * MiB;
constexpr size_t WS_CQ = 204 * MiB, WS_CKV = 216 * MiB, WS_BM = 204 * MiB;
constexpr size_t WS_QI = 224 * MiB, WS_KI = 240 * MiB, WS_KR = 242 * MiB;
constexpr size_t WS_ASORT = 68 * MiB, WS_SLOTS = 156 * MiB, WS_HID = 220 * MiB;
constexpr size_t WS_END = 256 * MiB;
constexpr int CW_BAR = 4096;
constexpr int CW_Q1 = 64, CW_Q2 = 128;
constexpr int CW_CNT = 256, CW_FILL = 320;
constexpr int CW_RDY = 8192;

constexpr int LDS_BYTES = 147456;
constexpr int MISC_OFF = 147456 - 512;

__device__ __forceinline__ unsigned f2bf(float f) { unsigned u = __builtin_bit_cast(unsigned, f); return (u + 0x7fffu + ((u >> 16) & 1u)) >> 16; }
__device__ __forceinline__ unsigned pk2(float lo, float hi) { f32x2 v = {lo, hi}; bf16x2_t b = __builtin_convertvector(v, bf16x2_t); return __builtin_bit_cast(unsigned, b); }
__device__ __forceinline__ float bflo(unsigned w) { return __builtin_bit_cast(float, w << 16); }
__device__ __forceinline__ float bfhi(unsigned w) { return __builtin_bit_cast(float, w & 0xffff0000u); }

#define XB_TMO      128
#define XB_XCNT(j)  (256  + 64 * (j))
#define XB_XSUB(j)  (1280 + 64 * (j))
#define XB_XGEN(j)  (2304 + 64 * (j))
#define XB_TOP      3328
#define XB_TOPGEN   3392
#define XCD_BAR_WORDS 3456
#define XB_SPIN_CAP (1u << 22)
__device__ __forceinline__ unsigned xb_ld(unsigned* p)              { return __hip_atomic_load(p, __ATOMIC_RELAXED, __HIP_MEMORY_SCOPE_AGENT); }
__device__ __forceinline__ unsigned xb_add(unsigned* p, unsigned v) { return __hip_atomic_fetch_add(p, v, __ATOMIC_RELAXED, __HIP_MEMORY_SCOPE_AGENT); }
__device__ __forceinline__ unsigned xb_xcc_id() { return (unsigned)__builtin_amdgcn_s_getreg((3 << 11) | 20) & 0xFu; }
#define XB_SPIN(cond, bar) do { unsigned _sp = 0; while (cond) { __builtin_amdgcn_s_sleep(1); \
    if ((++_sp & 255u) == 0u) { if (xb_ld(&(bar)[XB_TMO])) break; if (_sp > XB_SPIN_CAP) { atomicAdd(&(bar)[XB_TMO], 1u); break; } } } } while (0)
struct XcdBarrier { unsigned* bar; unsigned x; volatile LAS unsigned* st; };
__device__ __forceinline__ XcdBarrier xcd_barrier_post(unsigned* bar, volatile LAS unsigned* st) {
    XcdBarrier b; b.bar = bar; b.x = xb_xcc_id(); b.st = st;
    if (threadIdx.x == 0) (void)xb_add(&bar[XB_XCNT(b.x)], 1u);
    return b;
}
__device__ __forceinline__ void xcd_barrier_complete(unsigned* bar, unsigned x, unsigned& nloc, unsigned& nx) {
    const unsigned G = gridDim.x * gridDim.y * gridDim.z;
    unsigned sum, cnt, mine, sp = 0u;
    for (;;) {
        sum = 0u; cnt = 0u; mine = 0u;
#pragma unroll
        for (unsigned j = 0; j < 16; ++j) { const unsigned c = xb_ld(&bar[XB_XCNT(j)]); sum += c; cnt += (c > 0u) ? 1u : 0u; mine = (j == x) ? c : mine; }
        if (sum == G) break;
        __builtin_amdgcn_s_sleep(1);
        if ((++sp & 255u) == 0u) { if (xb_ld(&bar[XB_TMO])) break; if (sp > XB_SPIN_CAP) { atomicAdd(&bar[XB_TMO], 1u); break; } }
    }
    nloc = mine > 0u ? mine : 1u; nx = cnt > 0u ? cnt : 1u;
}
__device__ __forceinline__ void xcd_barrier(const XcdBarrier& b) {
    asm volatile("s_waitcnt vmcnt(0)" ::: "memory");
    __syncthreads();
    if (threadIdx.x == 0) {
        unsigned* bar = b.bar;
        __builtin_amdgcn_s_waitcnt(0);
        unsigned nloc = b.st[0], nx = b.st[1];
        if (nloc == 0u) { xcd_barrier_complete(bar, b.x, nloc, nx); b.st[0] = nloc; b.st[1] = nx; }
        const unsigned old = xb_add(&bar[XB_XSUB(b.x)], 1u);
        const unsigned gen = old / nloc;
        if (old + 1u == (gen + 1u) * nloc) {
            __builtin_amdgcn_fence(__ATOMIC_RELEASE, "agent");
            asm volatile("s_waitcnt vmcnt(0)" ::: "memory");
            const unsigned og = xb_add(&bar[XB_TOP], 1u);
            const unsigned tg = og / nx;
            if (og + 1u == (tg + 1u) * nx) xb_add(&bar[XB_TOPGEN], 1u);
            else XB_SPIN(xb_ld(&bar[XB_TOPGEN]) == tg, bar);
            __builtin_amdgcn_fence(__ATOMIC_ACQUIRE, "agent");
            xb_add(&bar[XB_XGEN(b.x)], 1u);
            asm volatile("s_waitcnt vmcnt(0)" ::: "memory");
        } else {
            XB_SPIN(xb_ld(&bar[XB_XGEN(b.x)]) == gen, bar);
            __builtin_amdgcn_fence(__ATOMIC_ACQUIRE, "agent");
            asm volatile("s_waitcnt vmcnt(0)" ::: "memory");
        }
    }
    __syncthreads();
}

__device__ __forceinline__ float wave_sum(float v) {
#pragma unroll
    for (int o = 1; o < 64; o <<= 1) v += __shfl_xor(v, o);
    return v;
}

namespace pg8 {
#define PG8_LAS __attribute__((address_space(3)))
typedef unsigned short bf16_t;
typedef unsigned u32x4 __attribute__((ext_vector_type(4)));
constexpr int BM = 256, BK = 64, HALF = 128, HTB = HALF * BK * 2, STAGE_BYTES = 8 * HTB, NXCD = 8, WGM = 8;
__host__ __device__ __forceinline__ int lds_byte(int r, int c) { const int st = (r >> 4) * 2 + (c >> 5), rr = r & 15, cc = c & 31, ob = rr * 64 + cc * 2; return st * 1024 + (ob ^ (((ob >> 9) & 1) << 5)); }
__host__ __device__ __forceinline__ void stage_rc(int b, int& R, int& C) { const int st = b / 1024, sb = b % 1024, swz = sb ^ (((sb >> 9) & 1) << 5); R = (st >> 1) * 16 + swz / 64; C = (st & 1) * 32 + (swz % 64) / 2; }
__host__ __device__ __forceinline__ int perm32(int rho) { const int n = rho >> 4, i = rho & 15; return 8 * (i >> 2) + 4 * n + (i & 3); }

struct Unit { int pm, pn, e; };
struct Gemm { const bf16_t* A; const bf16_t* Bt; int M, N, K; size_t estride; };

struct StaticOrder {
    int nM, nN, nwg, G, c;
    __host__ __device__ void init(int M, int N, int G_, int c_) { nM = M / BM; nN = N / BM; nwg = nM * nN; G = G_; c = c_; }
    __host__ __device__ bool next(int i, Unit& u) const {
        const long L = (long)i * G + c; if (L >= nwg) return false;
        int wgid = (int)L; { const int q = nwg / NXCD, r = nwg % NXCD, xcd = wgid % NXCD, off = wgid / NXCD; wgid = (xcd < r ? xcd * (q + 1) : r * (q + 1) + (xcd - r) * q) + off; }
        const int nig = WGM * nN, gid = wgid / nig, fm = gid * WGM, gsz = (nM - fm) < WGM ? (nM - fm) : WGM;
        u.pm = fm + ((wgid % nig) % gsz); u.pn = (wgid % nig) / gsz; u.e = 0; return true;
    }
    __device__ __forceinline__ void a_ready(const Unit&) const {}
    __device__ __forceinline__ void done(const Unit&) const {}
};
struct GroupOrder {
    int nN, total, G, c; const int* t2e;
    __device__ void init(int nTiles, int nN_, int G_, int c_, const int* t2e_) { nN = nN_; total = nTiles * nN_; G = G_; c = c_; t2e = t2e_; }
    __device__ bool next(int i, Unit& u) const {
        const long L = (long)i * G + c; if (L >= total) return false;
        u.pm = (int)(L / nN); u.pn = (int)(L % nN); u.e = __builtin_amdgcn_readfirstlane(t2e[u.pm]); return true;
    }
    __device__ __forceinline__ void a_ready(const Unit&) const {}
    __device__ __forceinline__ void done(const Unit&) const {}
};

__device__ __forceinline__ void st8(bf16_t* p, f32x4 v0, f32x4 v1) { u32x4 w; w.x = pk2(v0[0], v0[1]); w.y = pk2(v0[2], v0[3]); w.z = pk2(v1[0], v1[1]); w.w = pk2(v1[2], v1[3]); *(u32x4*)p = w; }
__device__ __forceinline__ void ld8(const bf16_t* p, f32x4& v0, f32x4& v1) { const u32x4 w = *(const u32x4*)p; v0 = (f32x4){bflo(w.x), bfhi(w.x), bflo(w.y), bfhi(w.y)}; v1 = (f32x4){bflo(w.z), bfhi(w.z), bflo(w.w), bfhi(w.w)}; }

__device__ __forceinline__ void rope16(f32x4& v0, f32x4& v1, int row, int fq, const f32x2* rope) {
    const f32x2* rp = rope + (size_t)(row & (SEQ - 1)) * 16;
    f32x4 p0, p1;
#pragma unroll
    for (int e = 0; e < 4; ++e) { p0[e] = __shfl_xor(v0[e], 16); p1[e] = __shfl_xor(v1[e], 16); }
    if (fq < 2) {
        const float sg = fq == 0 ? -1.f : 1.f;
#pragma unroll
        for (int e = 0; e < 4; ++e) { const f32x2 a = rp[2 * e], b = rp[2 * (4 + e)];
            v0[e] = v0[e] * a.x + sg * p0[e] * a.y; v1[e] = v1[e] * b.x + sg * p1[e] * b.y; }
    }
}
__device__ __forceinline__ void rope32(f32x4& v0, f32x4& v1, int row, int fq, const f32x2* rope) {
    const f32x2* rp = rope + (size_t)(row & (SEQ - 1)) * 16 + 8 * (fq & 1);
    const float sg = fq < 2 ? -1.f : 1.f;
#pragma unroll
    for (int e = 0; e < 4; ++e) { const float p0 = __shfl_xor(v0[e], 32), p1 = __shfl_xor(v1[e], 32); const f32x2 a = rp[e], b = rp[4 + e];
        v0[e] = v0[e] * a.x + sg * p0 * a.y; v1[e] = v1[e] * b.x + sg * p1 * b.y; }
}
__device__ __forceinline__ float sigmoidf_(float x) { return __builtin_amdgcn_rcpf(1.f + __builtin_amdgcn_exp2f(-1.4426950408889634f * x)); }

struct EpiIn {
    static constexpr bool PERM = true, AFTER_DRAIN = false;
    bf16_t *CQ, *CKV, *QB, *KB, *VB, *QI, *KI, *KR, *GA, *GB; float* WI; const f32x2* rope;
    __device__ __forceinline__ void operator()(const f32x4 (&acc)[2][2][4][2], const Unit& u, int wr, int wc, int fr, int fq) const {
        const int row0 = u.pm * BM + wr * 64 + fr;
#pragma unroll
        for (int bj = 0; bj < 2; ++bj) {
            const int cg = u.pn * BM + bj * HALF + wc * 32;
            bf16_t* base = nullptr; int pitch = 0, cc = 0, mode = 0; float sc = 1.f;
            if (cg < C_CKV) { base = CQ; pitch = 384; cc = cg; }
            else if (cg < C_QB) { base = CKV; pitch = 256; cc = cg - C_CKV; }
            else if (cg < C_KB) { base = QB; pitch = 512; cc = cg - C_QB; mode = ((cc >> 5) & 1) == 0 ? 1 : 0; sc = C2B; }
            else if (cg < C_VB) { base = KB; pitch = 512; cc = cg - C_KB; mode = ((cc >> 5) & 1) == 0 ? 1 : 0; }
            else if (cg < C_QI) { base = VB; pitch = 512; cc = cg - C_VB; }
            else if (cg < C_KR) { base = QI; pitch = 512; cc = cg - C_QI; mode = ((cc >> 5) & 1) == 0 ? 1 : 0; }
            else if (cg < C_KI) { base = KR; pitch = 32; cc = 0; mode = 2; }
            else if (cg < C_WI) { base = KI; pitch = 64; cc = cg - C_KI; mode = (cc == 0) ? 1 : 0; }
            else if (cg < C_GA) { mode = 4; }
            else if (cg < C_GB) { base = GA; pitch = 1024; cc = cg - C_GA; mode = 3; }
            else { base = GB; pitch = 1024; cc = cg - C_GB; mode = 3; }
#pragma unroll
            for (int ai = 0; ai < 2; ++ai)
#pragma unroll
                for (int m = 0; m < 4; ++m) {
                    const int row = row0 + ai * HALF + m * 16;
                    f32x4 v0 = acc[ai][bj][m][0], v1 = acc[ai][bj][m][1];
                    if (mode == 1) rope16(v0, v1, row, fq, rope);
                    else if (mode == 2) rope32(v0, v1, row, fq, rope);
                    else if (mode == 3) {
#pragma unroll
                        for (int e = 0; e < 4; ++e) { v0[e] = sigmoidf_(v0[e]); v1[e] = sigmoidf_(v1[e]); } }
                    if (mode == 4) { if (fq == 0) { *(f32x4*)(WI + (size_t)row * 8) = v0 * WI_SCALE; *(f32x4*)(WI + (size_t)row * 8 + 4) = v1 * WI_SCALE; } }
                    else { v0 = v0 * sc; v1 = v1 * sc; st8(base + (size_t)row * pitch + cc + 8 * fq, v0, v1); }
                }
        }
    }
};
struct EpiQA {
    static constexpr bool PERM = true, AFTER_DRAIN = false;
    bf16_t* QA; const f32x2* rope;
    __device__ __forceinline__ void operator()(const f32x4 (&acc)[2][2][4][2], const Unit& u, int wr, int wc, int fr, int fq) const {
        const int row0 = u.pm * BM + wr * 64 + fr;
#pragma unroll
        for (int bj = 0; bj < 2; ++bj) {
            const int cg = u.pn * BM + bj * HALF + wc * 32; const bool rot = ((cg >> 5) % 3) == 2;
#pragma unroll
            for (int ai = 0; ai < 2; ++ai)
#pragma unroll
                for (int m = 0; m < 4; ++m) {
                    const int row = row0 + ai * HALF + m * 16;
                    f32x4 v0 = acc[ai][bj][m][0], v1 = acc[ai][bj][m][1];
                    if (rot) rope32(v0, v1, row, fq, rope);
                    v0 = v0 * C2A; v1 = v1 * C2A; st8(QA + (size_t)row * 768 + cg + 8 * fq, v0, v1);
                }
        }
    }
};
struct EpiKV {
    static constexpr bool PERM = true, AFTER_DRAIN = false;
    bf16_t *KN, *VA;
    __device__ __forceinline__ void operator()(const f32x4 (&acc)[2][2][4][2], const Unit& u, int wr, int wc, int fr, int fq) const {
        const int row0 = u.pm * BM + wr * 64 + fr;
#pragma unroll
        for (int bj = 0; bj < 2; ++bj) {
            const int cg = u.pn * BM + bj * HALF + wc * 32; bf16_t* base = cg < 512 ? KN : VA; const int cc = (cg & 511) + 8 * fq;
#pragma unroll
            for (int ai = 0; ai < 2; ++ai)
#pragma unroll
                for (int m = 0; m < 4; ++m) { const int row = row0 + ai * HALF + m * 16; st8(base + (size_t)row * 512 + cc, acc[ai][bj][m][0], acc[ai][bj][m][1]); }
        }
    }
};
template <int ADD> struct EpiY {
    static constexpr bool PERM = true, AFTER_DRAIN = false;
    bf16_t* Y; const bf16_t* Gt;
    __device__ __forceinline__ void operator()(const f32x4 (&acc)[2][2][4][2], const Unit& u, int wr, int wc, int fr, int fq) const {
        const int row0 = u.pm * BM + wr * 64 + fr;
#pragma unroll
        for (int bj = 0; bj < 2; ++bj) {
            const int c0 = u.pn * BM + bj * HALF + wc * 32 + 8 * fq;
#pragma unroll
            for (int ai = 0; ai < 2; ++ai)
#pragma unroll
                for (int m = 0; m < 4; ++m) { const size_t off = (size_t)(row0 + ai * HALF + m * 16) * 1024 + c0;
                    f32x4 g0, g1; ld8(Gt + off, g0, g1);
                    f32x4 v0 = acc[ai][bj][m][0] * g0, v1 = acc[ai][bj][m][1] * g1;
                    if (ADD) { f32x4 o0, o1; ld8(Y + off, o0, o1); v0 = v0 + o0; v1 = v1 + o1; }
                    st8(Y + off, v0, v1); }
        }
    }
};
struct EpiX1 {
    static constexpr bool PERM = false, AFTER_DRAIN = false;
    const float* X; float* O;
    __device__ __forceinline__ void operator()(const f32x4 (&acc)[2][2][4][2], const Unit& u, int wr, int wc, int fr, int fq) const {
        const int row0 = u.pm * BM + wr * 64 + fr, col0 = u.pn * BM + wc * 32 + 4 * fq;
#pragma unroll
        for (int ai = 0; ai < 2; ++ai)
#pragma unroll
            for (int m = 0; m < 4; ++m) { const size_t off = (size_t)(row0 + ai * HALF + m * 16) * 1024 + col0;
#pragma unroll
                for (int bj = 0; bj < 2; ++bj)
#pragma unroll
                    for (int n = 0; n < 2; ++n) { const f32x4 xv = *(const f32x4*)(X + off + bj * HALF + n * 16); *(f32x4*)(O + off + bj * HALF + n * 16) = xv + acc[ai][bj][m][n]; } }
    }
};
struct EpiHid {
    static constexpr bool PERM = true, AFTER_DRAIN = false;
    bf16_t* HID;
    __device__ __forceinline__ void operator()(const f32x4 (&acc)[2][2][4][2], const Unit& u, int wr, int wc, int fr, int fq) const {
        const int row0 = u.pm * BM + wr * 64 + fr, c0 = u.pn * 128 + wc * 32 + 8 * fq;
#pragma unroll
        for (int ai = 0; ai < 2; ++ai)
#pragma unroll
            for (int m = 0; m < 4; ++m) { f32x4 h0, h1;
#pragma unroll
                for (int e = 0; e < 4; ++e) { const float g0 = acc[ai][0][m][0][e], g1 = acc[ai][0][m][1][e];
                    h0[e] = g0 * sigmoidf_(g0) * acc[ai][1][m][0][e]; h1[e] = g1 * sigmoidf_(g1) * acc[ai][1][m][1][e]; }
                st8(HID + (size_t)(row0 + ai * HALF + m * 16) * 256 + c0, h0, h1); }
    }
};
struct EpiDown {
    static constexpr bool PERM = true, AFTER_DRAIN = false;
    bf16_t* SL; const int* sslot; const float* sw;
    __device__ __forceinline__ void operator()(const f32x4 (&acc)[2][2][4][2], const Unit& u, int wr, int wc, int fr, int fq) const {
        const int row0 = u.pm * BM + wr * 64 + fr;
#pragma unroll
        for (int ai = 0; ai < 2; ++ai)
#pragma unroll
            for (int m = 0; m < 4; ++m) { const int r = row0 + ai * HALF + m * 16; const int slot = sslot[r]; const float w = sw[r];
                if (slot >= 0) {
#pragma unroll
                    for (int bj = 0; bj < 2; ++bj) st8(SL + (size_t)slot * 1024 + u.pn * BM + bj * HALF + wc * 32 + 8 * fq, acc[ai][bj][m][0] * w, acc[ai][bj][m][1] * w); } }
    }
};
template <class Epi, class Sched, bool ALIGN_EPI = false, bool SP2 = false>
__device__ __forceinline__ void gemm_phase(PG8_LAS unsigned char* lds, const Gemm g, const Sched& S, const Epi& E) {
    const int tid = threadIdx.x, wid = __builtin_amdgcn_readfirstlane(tid >> 6), lane = tid & 63, wr = wid >> 2, wc = wid & 3, fr = lane & 15, fq = lane >> 4;
    const int K = g.K, nt = K / BK;
    unsigned voffA[2], voffB[2];
#pragma unroll
    for (int i = 0; i < 2; ++i) { int R, C; stage_rc(tid * 16 + i * 8192, R, C); const int Rb = Epi::PERM ? ((R & ~31) + perm32(R & 31)) : R;
        voffA[i] = (unsigned)(R * K + C) * 2u; voffB[i] = (unsigned)(Rb * K + C) * 2u; }
    const size_t kstep = (size_t)(BK * 2);
    const size_t hstep = (size_t)HALF * K * 2;
    const size_t tstep = 2 * hstep;
    const unsigned ldsw = (unsigned)wid * 1024u;
    const int aoff = lds_byte(wr * 64 + fr, fq * 8), boff = lds_byte(wc * 32 + fr, fq * 8);
#define PG8_SA(b, h) (((b) * 2 + (h)) * HTB)
#define PG8_SB(b, h) ((4 + (b) * 2 + (h)) * HTB)
#define PG8_STAGE(bufoff, gbase, voff) do { _Pragma("unroll") for (int _i = 0; _i < 2; ++_i) \
        __builtin_amdgcn_global_load_lds((const unsigned*)((const char*)(gbase) + (voff)[_i]), (PG8_LAS unsigned*)(lds + (bufoff) + ldsw + _i * 8192), 16, 0, 0); } while (0)
#define PG8_LDA(dst, b, h) do { _Pragma("unroll") for (int m = 0; m < 4; ++m) _Pragma("unroll") for (int k = 0; k < 2; ++k) dst[m][k] = *(const PG8_LAS bf16x8*)(lds + PG8_SA(b, h) + aoff + m * 2048 + k * 1024); } while (0)
#define PG8_LDB(dst, b, h) do { _Pragma("unroll") for (int n = 0; n < 2; ++n) _Pragma("unroll") for (int k = 0; k < 2; ++k) dst[n][k] = *(const PG8_LAS bf16x8*)(lds + PG8_SB(b, h) + boff + n * 2048 + k * 1024); } while (0)
#define PG8_MMA(ai, bj, At, Bt) do { __builtin_amdgcn_s_setprio(1); _Pragma("unroll") for (int m = 0; m < 4; ++m) _Pragma("unroll") for (int n = 0; n < 2; ++n) _Pragma("unroll") for (int k = 0; k < 2; ++k) \
        acc[ai][bj][m][n] = __builtin_amdgcn_mfma_f32_16x16x32_bf16(Bt[n][k], At[m][k], acc[ai][bj][m][n], 0, 0, 0); __builtin_amdgcn_s_setprio(0); } while (0)
#define PG8_WAIT_V(n) asm volatile("s_waitcnt vmcnt(" #n ")" ::: "memory")
#define PG8_WAIT_L(n) asm volatile("s_waitcnt lgkmcnt(" #n ")" ::: "memory")
#define PG8_BAR __builtin_amdgcn_s_barrier()
#define PG8_SCHED __builtin_amdgcn_sched_barrier(0)
    Unit cur, nxt; int ui = 0;
    if (!S.next(0, cur)) return;
    f32x4 acc[2][2][4][2];
#pragma unroll
    for (int a = 0; a < 2; ++a)
#pragma unroll
        for (int b = 0; b < 2; ++b)
#pragma unroll
            for (int m = 0; m < 4; ++m)
#pragma unroll
                for (int n = 0; n < 2; ++n) acc[a][b][m][n] = (f32x4){0.f, 0.f, 0.f, 0.f};
    bf16x8 At[4][2], B0[2][2], B1[2][2];
    const char* cA = (const char*)g.A + (size_t)cur.pm * tstep; const char* cB = (const char*)g.Bt + (size_t)cur.e * g.estride + (size_t)cur.pn * tstep;
    S.a_ready(cur);
    if constexpr (SP2) {
        PG8_STAGE(PG8_SB(0, 0), cB, voffB); PG8_STAGE(PG8_SB(0, 1), cB + hstep, voffB); PG8_STAGE(PG8_SA(0, 0), cA, voffA); PG8_STAGE(PG8_SA(0, 1), cA + hstep, voffA);
        if (wr == 1) PG8_BAR;
        PG8_WAIT_V(2); PG8_BAR;
        PG8_STAGE(PG8_SB(1, 0), cB + kstep, voffB); PG8_STAGE(PG8_SA(1, 0), cA + kstep, voffA); PG8_STAGE(PG8_SB(1, 1), cB + hstep + kstep, voffB);
        PG8_WAIT_V(6); PG8_BAR;
    } else {
        PG8_STAGE(PG8_SB(0, 0), cB, voffB); PG8_STAGE(PG8_SA(0, 0), cA, voffA); PG8_STAGE(PG8_SB(0, 1), cB + hstep, voffB); PG8_STAGE(PG8_SA(0, 1), cA + hstep, voffA);
        if (wr == 1) PG8_BAR;
        PG8_WAIT_V(4); PG8_BAR;
        PG8_STAGE(PG8_SB(1, 0), cB + kstep, voffB); PG8_STAGE(PG8_SA(1, 0), cA + kstep, voffA); PG8_STAGE(PG8_SB(1, 1), cB + hstep + kstep, voffB);
        PG8_WAIT_V(6); PG8_BAR;
    }
    for (;;) {
        const bool has_next = S.next(ui + 1, nxt);
        const char* nA = has_next ? (const char*)g.A + (size_t)nxt.pm * tstep : cA; const char* nB = has_next ? (const char*)g.Bt + (size_t)nxt.e * g.estride + (size_t)nxt.pn * tstep : cB;
#pragma nounroll
        for (int t = 0; t < nt; t += 2) {
            const bool last = (t == nt - 2);
            const char* a1 = cA + (size_t)(t + 1) * kstep;
            const char* a2 = last ? nA : cA + (size_t)(t + 2) * kstep; const char* b2 = last ? nB : cB + (size_t)(t + 2) * kstep;
            const char* a3 = a2 + kstep; const char* b3 = b2 + kstep;
            if (last && has_next) S.a_ready(nxt);
            if constexpr (SP2) {
            PG8_LDB(B0, 0, 0); PG8_LDB(B1, 0, 1); PG8_SCHED; PG8_LDA(At, 0, 0); PG8_STAGE(PG8_SA(1, 1), a1 + hstep, voffA);
            PG8_WAIT_V(8); PG8_WAIT_L(0); PG8_BAR; PG8_MMA(0, 0, At, B0); PG8_MMA(0, 1, At, B1); PG8_BAR; PG8_SCHED;
            PG8_LDA(At, 0, 1); PG8_STAGE(PG8_SB(0, 0), b2, voffB); PG8_STAGE(PG8_SB(0, 1), b2 + hstep, voffB); PG8_STAGE(PG8_SA(0, 0), a2, voffA);
            PG8_WAIT_V(8); PG8_WAIT_L(0); PG8_BAR; PG8_MMA(1, 0, At, B0); PG8_MMA(1, 1, At, B1); PG8_BAR; PG8_SCHED;
            PG8_LDB(B0, 1, 0); PG8_LDB(B1, 1, 1); PG8_SCHED; PG8_LDA(At, 1, 0); PG8_STAGE(PG8_SA(0, 1), a2 + hstep, voffA);
            PG8_WAIT_V(8); PG8_WAIT_L(0); PG8_BAR; PG8_MMA(0, 0, At, B0); PG8_MMA(0, 1, At, B1); PG8_BAR; PG8_SCHED;
            PG8_LDA(At, 1, 1); PG8_STAGE(PG8_SB(1, 0), b3, voffB); PG8_STAGE(PG8_SB(1, 1), b3 + hstep, voffB); PG8_STAGE(PG8_SA(1, 0), a3, voffA);
            PG8_WAIT_V(8); PG8_WAIT_L(0); PG8_BAR; PG8_MMA(1, 0, At, B0); PG8_MMA(1, 1, At, B1); PG8_BAR; PG8_SCHED;
            } else {
            PG8_LDB(B0, 0, 0); PG8_SCHED; PG8_LDA(At, 0, 0); PG8_STAGE(PG8_SA(1, 1), a1 + hstep, voffA);
            PG8_WAIT_L(8); PG8_BAR; PG8_WAIT_L(0); PG8_MMA(0, 0, At, B0); PG8_BAR; PG8_SCHED;
            PG8_LDB(B1, 0, 1); PG8_STAGE(PG8_SB(0, 0), b2, voffB);
            PG8_BAR; PG8_WAIT_L(0); PG8_MMA(0, 1, At, B1); PG8_BAR;
            PG8_LDA(At, 0, 1); PG8_STAGE(PG8_SA(0, 0), a2, voffA);
            PG8_BAR; PG8_WAIT_L(0); PG8_MMA(1, 0, At, B0); PG8_BAR; PG8_SCHED;
            PG8_STAGE(PG8_SB(0, 1), b2 + hstep, voffB);
            PG8_WAIT_V(6); PG8_BAR; PG8_MMA(1, 1, At, B1); PG8_BAR;
            PG8_LDB(B0, 1, 0); PG8_SCHED; PG8_LDA(At, 1, 0); PG8_STAGE(PG8_SA(0, 1), a2 + hstep, voffA);
            PG8_WAIT_L(8); PG8_BAR; PG8_WAIT_L(0); PG8_MMA(0, 0, At, B0); PG8_BAR; PG8_SCHED;
            PG8_LDB(B1, 1, 1); PG8_STAGE(PG8_SB(1, 0), b3, voffB);
            PG8_BAR; PG8_WAIT_L(0); PG8_MMA(0, 1, At, B1); PG8_BAR;
            PG8_LDA(At, 1, 1); PG8_STAGE(PG8_SA(1, 0), a3, voffA);
            PG8_BAR; PG8_WAIT_L(0); PG8_MMA(1, 0, At, B0); PG8_BAR; PG8_SCHED;
            PG8_STAGE(PG8_SB(1, 1), b3 + hstep, voffB);
            PG8_WAIT_V(6); PG8_BAR; PG8_MMA(1, 1, At, B1); PG8_BAR;
            }
        }
        if constexpr (ALIGN_EPI) { if (wr == 0) PG8_BAR; }
        if constexpr (!Epi::AFTER_DRAIN) { E(acc, cur, wr, wc, fr, fq); S.done(cur); }
        if (!has_next) break;
#pragma unroll
        for (int a = 0; a < 2; ++a)
#pragma unroll
            for (int b = 0; b < 2; ++b)
#pragma unroll
                for (int m = 0; m < 4; ++m)
#pragma unroll
                    for (int n = 0; n < 2; ++n) acc[a][b][m][n] = (f32x4){0.f, 0.f, 0.f, 0.f};
        cur = nxt; cA = nA; cB = nB; ++ui;
        if constexpr (ALIGN_EPI) { if (wr == 1) PG8_BAR; }
    }
    PG8_WAIT_V(0);
    if constexpr (!ALIGN_EPI) { if (wr == 0) PG8_BAR; }
    PG8_BAR;
    if constexpr (Epi::AFTER_DRAIN) { E.fused(acc, cur, wr, wc, fr, fq, lds, wid, lane); S.done(cur); }
#undef PG8_SA
#undef PG8_SB
#undef PG8_STAGE
#undef PG8_LDA
#undef PG8_LDB
#undef PG8_MMA
#undef PG8_WAIT_V
#undef PG8_WAIT_L
#undef PG8_BAR
#undef PG8_SCHED
}
}

struct Args { const float* in[20]; float* out; unsigned char* ws; int ph_lo, ph_hi; };
struct Frame {
    LAS unsigned char* lds; volatile LAS unsigned* MISC; gu32* ctl; unsigned char* ws;
    int vcu, G;
};
#define F_TID ((int)threadIdx.x)
#define F_LANE ((int)(threadIdx.x & 63))
#define F_WAVE (__builtin_amdgcn_readfirstlane((int)(threadIdx.x >> 6)))

__device__ __forceinline__ int in_src_col(int n) {
    if (n < 640) return n;
    if (n < 2688) return n + 32;
    if (n < 2720) return n - 2688 + 640;
    if (n < 2792) return n;
    if (n < 2816) return -1;
    return n - 24;
}
struct TrDesc { const float* colptr; int ld, k0; bf16* WT; int Kd, destrow0; };
__device__ __forceinline__ void tr_load(const TrDesc& d, int lane, f32x4 (&v)[16]) {
    const int kr = lane >> 4;
#pragma unroll
    for (int it = 0; it < 16; ++it) { const int kk = 4 * it + kr; v[it] = (f32x4){0.f, 0.f, 0.f, 0.f}; if (d.colptr) v[it] = *(const GAS f32x4*)(d.colptr + (size_t)(d.k0 + kk) * d.ld); }
}
__device__ __forceinline__ void tr_store(const TrDesc& d, int lane, const f32x4 (&v)[16], LAS float* scr) {
    const int nq = lane & 15, kr = lane >> 4;
#pragma unroll
    for (int it = 0; it < 16; ++it) { const int kk = 4 * it + kr; LAS float* q = scr + kk * 65 + 4 * nq; q[0] = v[it].x; q[1] = v[it].y; q[2] = v[it].z; q[3] = v[it].w; }
    LDS_WAIT(); asm volatile("" ::: "memory");
    const int c = lane & 7;
#pragma unroll
    for (int j = 0; j < 8; ++j) { const int n = (lane >> 3) + 8 * j; const LAS float* q = scr + (8 * c) * 65 + n;
        v4u o; o.x = pk2(q[0 * 65], q[1 * 65]); o.y = pk2(q[2 * 65], q[3 * 65]); o.z = pk2(q[4 * 65], q[5 * 65]); o.w = pk2(q[6 * 65], q[7 * 65]);
        *(GAS v4u*)(d.WT + (size_t)(d.destrow0 + n) * d.Kd + d.k0 + 8 * c) = o; }
    LDS_WAIT(); asm volatile("" ::: "memory");
}
constexpr int CV_I0 = 16 * 76, CV_I1 = 6 * 12, CV_I2 = 4 * 16, CV_I3 = 8 * 16, CV_I4 = 8 * 16, CV_I5 = 16 * 16, CV_I6 = 32 * 16 * 8, CV_I7 = 32 * 4 * 16;
constexpr int CV_EARLY = CV_I0 + CV_I1 + CV_I2, CV_LATE = CV_I3 + CV_I4 + CV_I5 + CV_I6 + CV_I7, CV_QITEMS = CV_LATE / 16;
static_assert(CV_LATE % 16 == 0, "late conversion tiles come in queue items of 16");
__device__ __forceinline__ TrDesc conv_desc(const Args& A, unsigned char* ws, int it, int lane) {
    const int n4 = 4 * (lane & 15);
    int r = it;
    if (r < CV_I0) { const int kb = r / 76, nb = r % 76; const int col = in_src_col(64 * nb + n4);
        return TrDesc{col >= 0 ? A.in[2] + col : nullptr, NIN_SRC, 64 * kb, (bf16*)(ws + WS_WIN), 1024, 64 * nb}; } r -= CV_I0;
    if (r < CV_I1) { const int kb = r / 12, nb = r % 12; return TrDesc{A.in[4] + 64 * nb + n4, 768, 64 * kb, (bf16*)(ws + WS_WUQ), 384, 64 * nb}; } r -= CV_I1;
    if (r < CV_I2) { const int kb = r / 16, nb = r % 16; const int n = 64 * nb + n4;
        return TrDesc{n < 512 ? A.in[6] + n : A.in[7] + (n - 512), 512, 64 * kb, (bf16*)(ws + WS_WUKV), 256, 64 * nb}; } r -= CV_I2;
    if (r < CV_I3) { const int kb = r / 16, nb = r % 16; return TrDesc{A.in[8] + 64 * nb + n4, 1024, 64 * kb, (bf16*)(ws + WS_WOA), 512, 64 * nb}; } r -= CV_I3;
    if (r < CV_I4) { const int kb = r / 16, nb = r % 16; return TrDesc{A.in[9] + 64 * nb + n4, 1024, 64 * kb, (bf16*)(ws + WS_WOB), 512, 64 * nb}; } r -= CV_I4;
    if (r < CV_I5) { const int kb = r / 16, nb = r % 16; return TrDesc{A.in[10] + 64 * nb + n4, 1024, 64 * kb, (bf16*)(ws + WS_WOUT), 1024, 64 * nb}; } r -= CV_I5;
    if (r < CV_I6) { const int e = r / 128, rr = r % 128, kb = rr / 8, nb = rr % 8; const int n = 64 * nb + n4, pn = n >> 8, c = n & 255, col = 128 * pn + (c & 127);
        const float* src = ((c >> 7) ? A.in[17] : A.in[16]) + (size_t)e * 1024 * 256 + col;
        return TrDesc{src, 256, 64 * kb, (bf16*)(ws + WS_WGU) + (size_t)e * 512 * 1024, 1024, 64 * nb}; } r -= CV_I6;
    { const int e = r / 64, rr = r % 64, kb = rr / 16, nb = rr % 16;
        return TrDesc{A.in[18] + (size_t)e * 256 * 1024 + 64 * nb + n4, 1024, 64 * kb, (bf16*)(ws + WS_WD) + (size_t)e * 1024 * 256, 256, 64 * nb}; }
}
__device__ __forceinline__ void conv_tile(const Args& A, unsigned char* ws, int it, LAS float* scr, int lane) {
    const TrDesc d = conv_desc(A, ws, it, lane); f32x4 v[16]; tr_load(d, lane, v); tr_store(d, lane, v, scr);
}
__device__ __forceinline__ void conv_tile2(const Args& A, unsigned char* ws, int it0, int it1, LAS float* scr, int lane) {
    const TrDesc d0 = conv_desc(A, ws, it0, lane), d1 = conv_desc(A, ws, it1, lane); f32x4 v0[16], v1[16];
    tr_load(d0, lane, v0); tr_load(d1, lane, v1); tr_store(d0, lane, v0, scr); tr_store(d1, lane, v1, scr);
}
__device__ __forceinline__ void p0_prologue(Frame& F, const Args& A) {
    LAS float* scr = (LAS float*)(F.lds + F_WAVE * 16640);
    const int gw = F.vcu * NWAVES + F_WAVE, NGW = F.G * NWAVES, lane = F_LANE;
    unsigned char* ws = F.ws;
#ifdef CONV_IN_P0
    for (int it = gw; it < CV_EARLY + CV_LATE; it += NGW) conv_tile(A, ws, it, scr, lane);
#else
    for (int it = gw; it < CV_EARLY; it += NGW) conv_tile(A, ws, it, scr, lane);
#endif
    const float* x = A.in[0]; const float* g1 = A.in[1]; bf16* H = (bf16*)(ws + WS_H);
    for (int m0 = gw; m0 < T; m0 += 4 * NGW) {
        f32x4 v[4][4];
#pragma unroll
        for (int r = 0; r < 4; ++r) { const int m = min(m0 + r * NGW, T - 1); const GAS f32x4* xr = (const GAS f32x4*)(x + (size_t)m * D) + lane;
#pragma unroll
            for (int j = 0; j < 4; ++j) v[r][j] = xr[64 * j]; }
#pragma unroll
        for (int r = 0; r < 4; ++r) { const int m = m0 + r * NGW; float s = 0.f;
#pragma unroll
            for (int j = 0; j < 4; ++j) s += (v[r][j].x * v[r][j].x + v[r][j].y * v[r][j].y) + (v[r][j].z * v[r][j].z + v[r][j].w * v[r][j].w);
            const float rstd = 1.f / sqrtf(wave_sum(s) * (1.f / D) + EPS);
            if (m < T) { GAS v2u* o8 = (GAS v2u*)(H + (size_t)m * D) + lane;
#pragma unroll
                for (int j = 0; j < 4; ++j) { const f32x4 g = *((const GAS f32x4*)g1 + lane + 64 * j); const f32x4 y = v[r][j] * rstd * g; v2u w; w.x = pk2(y.x, y.y); w.y = pk2(y.z, y.w); o8[64 * j] = w; } } }
    }
    f32x2* rope = (f32x2*)(ws + WS_ROPE);
    for (int idx = (F.vcu * NTHR + F_TID); idx < SEQ * 16; idx += F.G * NTHR) {
        const int pos = idx >> 4, i = idx & 15;
        const double REV[16] = {0.15915494309189535, 0.0700865215877985, 0.03086376340470123, 0.013591370636193905, 0.005985185712713705, 0.002635675898667414, 0.001160663641240061, 0.0005111175045375439,
                                0.00022507907903927653, 9.911730936901935e-05, 4.364795279280289e-05, 1.9221100684944863e-05, 8.464330808241401e-06, 3.727408601915352e-06, 1.6414262627950345e-06, 7.228293068832865e-07};
        double rv = 0.0;
#pragma unroll
        for (int k = 0; k < 16; ++k) rv = (i == k) ? REV[k] : rv;
        double t = (double)pos * rv; t -= __builtin_floor(t);
        const float tf = (float)t;
        rope[idx] = (f32x2){__builtin_amdgcn_cosf(tf), __builtin_amdgcn_sinf(tf)};
    }
}

__device__ __forceinline__ void p2a_norms(Frame& F, const Args& A) {
    const int gw = F.vcu * NWAVES + F_WAVE, NGW = F.G * NWAVES, lane = F_LANE;
    bf16* CQ = (bf16*)(F.ws + WS_CQ); bf16* CKV = (bf16*)(F.ws + WS_CKV);
    const float* gq = A.in[3]; const float* gkv = A.in[5];
    for (int m = gw; m < T; m += NGW) {
        {
            GAS unsigned* p = (GAS unsigned*)(CQ + (size_t)m * 384) + lane; unsigned w[3]; float s = 0.f;
#pragma unroll
            for (int j = 0; j < 3; ++j) { w[j] = p[64 * j]; const float a = bflo(w[j]), b = bfhi(w[j]); s += a * a + b * b; }
            const float rstd = 1.f / sqrtf(wave_sum(s) * (1.f / 384.f) + EPS);
#pragma unroll
            for (int j = 0; j < 3; ++j) { const f32x2 g = *((const GAS f32x2*)gq + lane + 64 * j); p[64 * j] = pk2(bflo(w[j]) * rstd * g.x, bfhi(w[j]) * rstd * g.y); }
        }
        {
            GAS v2u* p = (GAS v2u*)(CKV + (size_t)m * 256) + lane; const v2u w = *p;
            const float a = bflo(w.x), b = bfhi(w.x), c = bflo(w.y), d = bfhi(w.y);
            const float rstd = 1.f / sqrtf(wave_sum(a * a + b * b + c * c + d * d) * (1.f / 256.f) + EPS);
            const f32x4 g = *((const GAS f32x4*)gkv + lane); v2u o; o.x = pk2(a * rstd * g.x, b * rstd * g.y); o.y = pk2(c * rstd * g.z, d * rstd * g.w); *p = o;
        }
    }
}

__device__ __forceinline__ constexpr int crow(int r, int hi) { return (r & 3) + 8 * (r >> 2) + 4 * hi; }
constexpr float ATT_THR = 8.f;
__device__ __forceinline__ float att_mask(float p, unsigned w, int bit) { int mk; unsigned r;
    asm("v_bfe_i32 %0, %1, %2, 1" : "=v"(mk) : "v"(w), "i"(bit)); r = __builtin_bit_cast(unsigned, p) & (unsigned)mk; return __builtin_bit_cast(float, r); }
struct AttnP { const bf16 *Q, *K, *K2, *V; bf16* O; const unsigned* BM; };
template <bool MLA> __device__ __forceinline__ void attn_unit(LAS unsigned char* L, int b, int h, int qb, const AttnP& P, int tid, int lane, int wave) {
    constexpr int DK = MLA ? 96 : 64, KP = DK * 2 + 16, NS = DK / 16, CPR = DK / 8;
    constexpr int QPITCH = MLA ? 768 : 512, VP = 192, KBUF = 64 * KP, VBUF = 64 * VP;
    const int r32 = lane & 31, hi = lane >> 5;
    const size_t rowb = (size_t)b * SEQ;
    const int qrow = qb * 256 + wave * 32 + r32;
    bf16x8 qf[NS];
    { const bf16* qp = P.Q + (rowb + qrow) * QPITCH + h * DK;
#pragma unroll
      for (int s = 0; s < NS; ++s) qf[s] = *(const bf16x8*)(qp + 16 * s + 8 * hi); }
    const int NT = 4 * qb + 4, my_nt = 4 * qb + (wave >> 1) + 1;
    const int kid0 = tid, kid1 = tid + NTHR;
    const int kr0 = kid0 / CPR, kc0 = kid0 % CPR, kr1 = kid1 / CPR, kc1 = kid1 % CPR; const bool has1 = MLA && (kid1 < 64 * CPR);
    const int vr = tid >> 3, vc = tid & 7;
    v4u kreg0, kreg1 = (v4u){0u, 0u, 0u, 0u}, vreg;
#define ATT_KSRC(t, kr, kc) (MLA ? ((kc) < 8 ? (const v4u*)(P.K + (rowb + 64 * (t) + (kr)) * 512 + h * 64 + 8 * (kc)) : (const v4u*)(P.K2 + (rowb + 64 * (t) + (kr)) * 32 + 8 * ((kc) - 8))) \
                                 : (const v4u*)(P.K + (rowb + 64 * (t) + (kr)) * 512 + h * 64 + 8 * (kc)))
#define ATT_LOAD(t) do { kreg0 = *ATT_KSRC(t, kr0, kc0); if (has1) kreg1 = *ATT_KSRC(t, kr1, kc1); vreg = *(const v4u*)(P.V + (rowb + 64 * (t) + vr) * 512 + h * 64 + 8 * vc); } while (0)
#define ATT_WRITE(buf) do { *(LAS v4u*)(L + (buf) * KBUF + kr0 * KP + kc0 * 16) = kreg0; if (has1) *(LAS v4u*)(L + (buf) * KBUF + kr1 * KP + kc1 * 16) = kreg1; \
                            *(LAS v4u*)(L + 2 * KBUF + (buf) * VBUF + vr * VP + vc * 16) = vreg; } while (0)
    float mhat = 0.f, l = 0.f; f32x16 o0, o1, negm;
#pragma unroll
    for (int i = 0; i < 16; ++i) { o0[i] = 0.f; o1[i] = 0.f; negm[i] = 0.f; }
    const int g16 = lane >> 4, qq = (lane & 15) >> 2, pp = lane & 3;
    const int vlane = (4 * hi + qq) * VP + (16 * (g16 & 1) + 4 * pp) * 2;
    ATT_LOAD(0); ATT_WRITE(0); __syncthreads();
    unsigned wn0 = 0xffffffffu, wn1 = 0xffffffffu;
    const unsigned* bmq = MLA ? nullptr : P.BM + (size_t)b * 256 * SEQ + qrow;
    if (!MLA) { wn0 = bmq[0]; wn1 = bmq[SEQ]; }
    for (int t = 0; t < NT; ++t) {
        const int buf = t & 1;
        unsigned w0 = wn0 >> (4 * hi), w1 = wn1 >> (4 * hi);
        if (t + 1 < NT) { ATT_LOAD(t + 1); if (!MLA) { wn0 = bmq[(size_t)(2 * t + 2) * SEQ]; wn1 = bmq[(size_t)(2 * t + 3) * SEQ]; } }
        if (t < my_nt) {
            const LAS unsigned char* Kb = L + buf * KBUF; const LAS unsigned char* Vb = L + 2 * KBUF + buf * VBUF;
            f32x16 s0, s1;
            bf16x8 ka[NS][2];
#pragma unroll
            for (int s = 0; s < NS; ++s) { ka[s][0] = *(const LAS bf16x8*)(Kb + r32 * KP + s * 32 + hi * 16); ka[s][1] = *(const LAS bf16x8*)(Kb + (32 + r32) * KP + s * 32 + hi * 16); }
            __builtin_amdgcn_sched_barrier(0);
#pragma unroll
            for (int s = 0; s < NS; ++s) {
                s0 = __builtin_amdgcn_mfma_f32_32x32x16_bf16(ka[s][0], qf[s], s == 0 ? negm : s0, 0, 0, 0);
                s1 = __builtin_amdgcn_mfma_f32_32x32x16_bf16(ka[s][1], qf[s], s == 0 ? negm : s1, 0, 0, 0);
            }
            s16x4 vf[4][4];
#pragma unroll
            for (int ks = 0; ks < 4; ++ks) { const LAS unsigned char* vp = Vb + ks * 16 * VP + vlane;
                vf[ks][0] = __builtin_bit_cast(s16x4, __builtin_amdgcn_ds_read_tr16_b64_v4i16((LAS s16x4*)(vp)));
                vf[ks][1] = __builtin_bit_cast(s16x4, __builtin_amdgcn_ds_read_tr16_b64_v4i16((LAS s16x4*)(vp + 8 * VP)));
                vf[ks][2] = __builtin_bit_cast(s16x4, __builtin_amdgcn_ds_read_tr16_b64_v4i16((LAS s16x4*)(vp + 64)));
                vf[ks][3] = __builtin_bit_cast(s16x4, __builtin_amdgcn_ds_read_tr16_b64_v4i16((LAS s16x4*)(vp + 8 * VP + 64))); }
            __builtin_amdgcn_sched_barrier(0);
            float mx = fmaxf(fmaxf(s0[0], s0[1]), s1[0]);
#pragma unroll
            for (int i = 2; i < 16; i += 2) mx = fmaxf(fmaxf(mx, s0[i]), s0[i + 1]);
#pragma unroll
            for (int i = 1; i < 15; i += 2) mx = fmaxf(fmaxf(mx, s1[i]), s1[i + 1]);
            mx = fmaxf(mx, s1[15]);
            mx = fmaxf(mx, __shfl_xor(mx, 32));
            if (t == 0 || __any(mx > ATT_THR)) {
                const float dl = (t == 0) ? mx : fmaxf(mx, 0.f), f = (t == 0) ? 1.f : __builtin_amdgcn_exp2f(-dl);
                mhat += dl; l *= f;
#pragma unroll
                for (int i = 0; i < 16; ++i) { s0[i] -= dl; s1[i] -= dl; o0[i] *= f; o1[i] *= f; negm[i] = -mhat; }
            }
            float rs = 0.f;
#pragma unroll
            for (int i = 0; i < 16; ++i) {
                float p0 = __builtin_amdgcn_exp2f(s0[i]), p1 = __builtin_amdgcn_exp2f(s1[i]);
                if (!MLA) { p0 = att_mask(p0, w0, crow(i, 0)); p1 = att_mask(p1, w1, crow(i, 0)); }
                s0[i] = p0; s1[i] = p1; rs += p0 + p1; }
            l += rs;
            bf16x8 pf[4];
#pragma unroll
            for (int ks = 0; ks < 4; ++ks) { v4u w;
#pragma unroll
                for (int j = 0; j < 4; ++j) { const float a = (ks < 2) ? s0[8 * (ks & 1) + 2 * j] : s1[8 * (ks & 1) + 2 * j], c = (ks < 2) ? s0[8 * (ks & 1) + 2 * j + 1] : s1[8 * (ks & 1) + 2 * j + 1]; w[j] = pk2(a, c); }
                pf[ks] = __builtin_bit_cast(bf16x8, w); }
#pragma unroll
            for (int ks = 0; ks < 4; ++ks) {
                const bf16x8 A0 = __builtin_shufflevector(vf[ks][0], vf[ks][1], 0, 1, 2, 3, 4, 5, 6, 7);
                const bf16x8 A1 = __builtin_shufflevector(vf[ks][2], vf[ks][3], 0, 1, 2, 3, 4, 5, 6, 7);
                o0 = __builtin_amdgcn_mfma_f32_32x32x16_bf16(A0, pf[ks], o0, 0, 0, 0);
                o1 = __builtin_amdgcn_mfma_f32_32x32x16_bf16(A1, pf[ks], o1, 0, 0, 0);
            }
        }
        if (t + 1 < NT) ATT_WRITE(buf ^ 1);
        __syncthreads();
    }
    l += __shfl_xor(l, 32);
    const float inv = 1.f / l;
    bf16* op = P.O + (rowb + qrow) * 512 + h * 64 + 4 * hi;
#pragma unroll
    for (int g = 0; g < 4; ++g) {
        v2u w; w.x = pk2(o0[4 * g] * inv, o0[4 * g + 1] * inv); w.y = pk2(o0[4 * g + 2] * inv, o0[4 * g + 3] * inv); *(v2u*)(op + 8 * g) = w;
        v2u z; z.x = pk2(o1[4 * g] * inv, o1[4 * g + 1] * inv); z.y = pk2(o1[4 * g + 2] * inv, o1[4 * g + 3] * inv); *(v2u*)(op + 32 + 8 * g) = z;
    }
#undef ATT_KSRC
#undef ATT_LOAD
#undef ATT_WRITE
}

namespace attn_body {
using bf16=__hip_bfloat16;
using bf16x8=__attribute__((ext_vector_type(8)))short;
using s16x4=__attribute__((ext_vector_type(4)))short;
using f32x16=__attribute__((ext_vector_type(16)))float;
using u32x4=__attribute__((ext_vector_type(4)))unsigned;
constexpr int BATCH=2,NHEAD=8,SEQ=8192,D=64,DM=NHEAD*D;
constexpr int NW=8,QBLK=32,QB=QBLK*NW,KVBLK=64,NQB=SEQ/QB;
constexpr int ATTN_PITCH=DM, ATTN_UNIT_ROWS=QB;
__device__ __forceinline__ int crow(int r,int hi){return (r&3)+8*(r>>2)+4*hi;}
#define SBAR() __builtin_amdgcn_sched_barrier(0)
__device__ __forceinline__ void cmask(f32x16&p0,f32x16&p1,int jb,int wid){
  if(jb>(wid>>1)){
    #pragma unroll
    for(int r=0;r<16;++r){p0[r]=-INFINITY;p1[r]=-INFINITY;} }
}
__device__ __forceinline__ float amask(float p,unsigned w,int bit){ int mk; asm("v_bfe_i32 %0, %1, %2, 1":"=v"(mk):"v"(w),"i"(bit)); return __builtin_bit_cast(float,__builtin_bit_cast(unsigned,p)&(unsigned)mk); }
__device__ __forceinline__ void glds4(const void*gsrc,unsigned lds_dst){unsigned keep;
  asm volatile("s_mov_b32 %0, m0\n\ts_mov_b32 m0, %2\n\ts_nop 0\n\tglobal_load_lds_dword %1, off\n\ts_mov_b32 m0, %0":"=&s"(keep):"v"(gsrc),"s"(lds_dst):"memory");}

constexpr int NSLOT=3, SLOTB=8192;
constexpr int LDS_K=0, LDS_V=NSLOT*SLOTB, LDS_WS=2*NSLOT*SLOTB, LDS_OST=LDS_WS+NW*64*4, LDS_BM=LDS_OST+NW*4096, LDS_BYTES=LDS_BM+NW*512;
constexpr float C2=0.125f*1.4426950408889634f;
__device__ __forceinline__ void glds16(const void*gsrc,unsigned lds_dst){unsigned keep;
  asm volatile("s_mov_b32 %0, m0\n\ts_mov_b32 m0, %2\n\ts_nop 0\n\tglobal_load_lds_dwordx4 %1, off\n\ts_mov_b32 m0, %0":"=&s"(keep):"v"(gsrc),"s"(lds_dst):"memory");}
__device__ __forceinline__ float max3f(float a,float b,float c){float r;asm("v_max3_f32 %0, %1, %2, %3":"=v"(r):"v"(a),"v"(b),"v"(c));return r;}
__device__ __forceinline__ float max2f(float a,float b){float r;asm("v_max_f32_e32 %0, %1, %2":"=v"(r):"v"(a),"v"(b));return r;}
__device__ __forceinline__ float fadd_s(float a,float b){float r;asm("v_add_f32_e32 %0, %1, %2":"=v"(r):"v"(a),"v"(b));return r;}
__device__ __forceinline__ float fsub_s(float a,float b){float r;asm("v_sub_f32_e32 %0, %1, %2":"=v"(r):"v"(a),"v"(b));return r;}
typedef float f32x2_t __attribute__((ext_vector_type(2))); typedef __bf16 bf16x2_t __attribute__((ext_vector_type(2)));
__device__ __forceinline__ unsigned cvtpk_s(float lo,float hi){f32x2_t v={lo,hi};bf16x2_t b=__builtin_convertvector(v,bf16x2_t);return __builtin_bit_cast(unsigned,b);}
#define WAIT_BAR(N) asm volatile("s_waitcnt vmcnt(" #N ") lgkmcnt(0)\n\ts_barrier":::"memory")

__device__ __forceinline__ void qkt(f32x16&p0,f32x16&p1,const char*Kslot,const bf16x8*qr,const f32x16&negm,int r32,int hi){
  const char*kb=Kslot+hi*1024+r32*16;
  #pragma unroll
  for(int d0=0;d0<4;++d0){
    const bf16x8 b0=*reinterpret_cast<const bf16x8*>(kb+d0*2048);
    const bf16x8 b1=*reinterpret_cast<const bf16x8*>(kb+d0*2048+512);
    if(d0==0){p0=__builtin_amdgcn_mfma_f32_32x32x16_bf16(b0,qr[0],negm,0,0,0);p1=__builtin_amdgcn_mfma_f32_32x32x16_bf16(b1,qr[0],negm,0,0,0);}
    else{p0=__builtin_amdgcn_mfma_f32_32x32x16_bf16(b0,qr[d0],p0,0,0,0);p1=__builtin_amdgcn_mfma_f32_32x32x16_bf16(b1,qr[d0],p1,0,0,0);}}
}
typedef __attribute__((address_space(3))) const char* lds_cptr;
typedef short v4i16_t __attribute__((ext_vector_type(4)));
__device__ __forceinline__ void kload8(bf16x8*kf,lds_cptr kp){
  kf[0]=*(const __attribute__((address_space(3))) bf16x8*)(kp);      kf[1]=*(const __attribute__((address_space(3))) bf16x8*)(kp+512);
  kf[2]=*(const __attribute__((address_space(3))) bf16x8*)(kp+2048); kf[3]=*(const __attribute__((address_space(3))) bf16x8*)(kp+2560);
  kf[4]=*(const __attribute__((address_space(3))) bf16x8*)(kp+4096); kf[5]=*(const __attribute__((address_space(3))) bf16x8*)(kp+4608);
  kf[6]=*(const __attribute__((address_space(3))) bf16x8*)(kp+6144); kf[7]=*(const __attribute__((address_space(3))) bf16x8*)(kp+6656);
}
__device__ __forceinline__ void kload2(bf16x8*kf,lds_cptr kp,int j){ kf[2*j]=*(const __attribute__((address_space(3))) bf16x8*)(kp+j*2048); kf[2*j+1]=*(const __attribute__((address_space(3))) bf16x8*)(kp+j*2048+512); }
__device__ __forceinline__ s16x4 vtr(lds_cptr p){ return __builtin_bit_cast(s16x4,__builtin_amdgcn_ds_read_tr16_b64_v4i16((__attribute__((address_space(3))) v4i16_t*)p)); }
__device__ __forceinline__ float rowmax(const f32x16&p0,const f32x16&p1){
  float a=max3f(p0[0],p0[1],p1[0]),b=max3f(p0[2],p0[3],p1[1]);a=max3f(a,p1[2],p1[3]);
  #pragma unroll
  for(int r=4;r<16;r+=4){a=max3f(a,p0[r],p0[r+1]);b=max3f(b,p0[r+2],p0[r+3]);a=max3f(a,p1[r],p1[r+1]);b=max3f(b,p1[r+2],p1[r+3]);}
  const float m=max2f(a,b);
  auto rr=__builtin_amdgcn_permlane32_swap(__float_as_uint(m),__float_as_uint(m),false,false);
  return max2f(__uint_as_float(rr[0]),__uint_as_float(rr[1]));
}
__device__ __forceinline__ void pv(f32x16*o,int vb,bf16x8 pa0,bf16x8 pa1,bf16x8 pa2,bf16x8 pa3){
  #pragma unroll
  for(int d0=0;d0<2;++d0){s16x4 lo[4],hi[4];
    #pragma unroll
    for(int ks=0;ks<4;++ks){
      asm volatile("ds_read_b64_tr_b16 %0,%1 offset:%c2":"=&v"(lo[ks]):"v"(vb),"i"(d0*4096+ks*1024):"memory");
      asm volatile("ds_read_b64_tr_b16 %0,%1 offset:%c2":"=&v"(hi[ks]):"v"(vb),"i"(d0*4096+ks*1024+512):"memory");}
    asm volatile("s_waitcnt lgkmcnt(0)":::"memory");SBAR();
    #define PK(k) (bf16x8){lo[k][0],lo[k][1],lo[k][2],lo[k][3],hi[k][0],hi[k][1],hi[k][2],hi[k][3]}
    o[d0]=__builtin_amdgcn_mfma_f32_32x32x16_bf16(pa0,PK(0),o[d0],0,0,0);
    o[d0]=__builtin_amdgcn_mfma_f32_32x32x16_bf16(pa1,PK(1),o[d0],0,0,0);
    o[d0]=__builtin_amdgcn_mfma_f32_32x32x16_bf16(pa2,PK(2),o[d0],0,0,0);
    o[d0]=__builtin_amdgcn_mfma_f32_32x32x16_bf16(pa3,PK(3),o[d0],0,0,0);
    #undef PK
  }
}

#ifndef ATTN_STORE16
#define ATTN_STORE16(p,v) (*(u32x4*)(p)=(v))
#endif
template<int THRL> __device__ __forceinline__ void attn_unit(int b,int h,int qb,const bf16*Q,const bf16*__restrict__ K,const bf16*__restrict__ V,bf16*O,const unsigned*BMg,char*shm,int tid){
  const int lane=tid&63,r32=lane&31,hi=lane>>5; const int wid=__builtin_amdgcn_readfirstlane(tid>>6);
  const long rowbase=(long)b*SEQ; const int q0=qb*QB;
  const bf16*Qw=Q+(rowbase+q0+wid*QBLK)*DM+h*D;
  const bf16*Kh=K+rowbase*DM+h*D,*Vh=V+rowbase*DM+h*D;
  const unsigned lds0=(unsigned)(uintptr_t)shm;
  float*wsf=(float*)(shm+LDS_WS)+wid*64;
  const bf16*ksrc=Kh+(long)lane*DM+wid*8;
  const bf16*vsrc=Vh+(long)(16*(wid&3)+(lane>>2))*DM+(wid>>2)*32+(lane&3)*8;
  const unsigned kdst=lds0+LDS_K+wid*1024, vdst=lds0+LDS_V+wid*1024;
  #define DMA_K(t,slot) glds16(ksrc+(long)(t)*KVBLK*DM,(unsigned)__builtin_amdgcn_readfirstlane(kdst+(slot)))
  #define DMA_V(t,slot) glds16(vsrc+(long)(t)*KVBLK*DM,(unsigned)__builtin_amdgcn_readfirstlane(vdst+(slot)))
  const unsigned*bmsrc=BMg+(long)b*256*SEQ+(long)hi*SEQ+q0+wid*QBLK+r32; const unsigned bmdst=lds0+LDS_BM+wid*512;
  const __attribute__((address_space(3))) unsigned*bmw=(const __attribute__((address_space(3))) unsigned*)((lds_cptr)shm+LDS_BM+wid*512);
  #define DMA_BM(t) glds4(bmsrc+(long)(t)*2*SEQ,(unsigned)__builtin_amdgcn_readfirstlane(bmdst+((t)&1)*256))
  #define VMW(N) asm volatile("s_waitcnt vmcnt(" #N ")":::"memory")
  #define BMWAIT(t) do{ if((t)+3<NT){VMW(5);} else if((t)+2<NT){VMW(4);} else if((t)+1<NT){VMW(3);} else {VMW(1);} }while(0)
  const int vb0=(int)(lds0+LDS_V)+((lane>>4)&1)*32+(lane&3)*8+(4*hi+((lane&15)>>2))*64;
  const char*Kbase=shm+LDS_K; bf16x8 kf[8];
  const lds_cptr shm3=(lds_cptr)shm; const lds_cptr kp0=shm3+LDS_K+hi*1024+r32*16; const lds_cptr vp0=shm3+LDS_V+((lane>>4)&1)*32+(lane&3)*8+(4*hi+((lane&15)>>2))*64;
  const int NT=(q0+QB)/KVBLK;
  DMA_BM(0);DMA_K(0,0);DMA_V(0,0);DMA_K(1,SLOTB);
  bf16x8 qr[4];
  #pragma unroll
  for(int d0=0;d0<4;++d0)qr[d0]=*reinterpret_cast<const bf16x8*>(&Qw[(long)r32*DM+d0*16+hi*8]);
  float mhat=0.f,l_reg=0.f;f32x16 o[2];o[0]=f32x16{};o[1]=f32x16{};f32x16 negm=f32x16{};asm volatile("":"+v"(negm));
  const int qrel=wid*QBLK+r32;
  #define CMASK(P0,P1,t) do{int jb_=(t)-(NT-4); if(jb_>=0)cmask(P0,P1,jb_,wid);}while(0)
  bool resc=false;
  #define START(P0,P1) do{ const float rm=rowmax(P0,P1); resc=false; \
    { const float dl=rm; mhat=fadd_s(mhat,dl); \
      _Pragma("unroll") for(int r=0;r<16;++r){P0[r]=fsub_s(P0[r],dl);P1[r]=fsub_s(P1[r],dl);} \
      _Pragma("unroll") for(int r=0;r<16;++r)negm[r]=-mhat; asm volatile("":"+v"(negm)); } \
    _Pragma("unroll") for(int r=0;r<16;++r)P0[r]=__builtin_amdgcn_exp2f(P0[r]); }while(0)
  #define RESC() do{ if(resc){ asm volatile("s_waitcnt lgkmcnt(0)":::"memory"); \
      _Pragma("unroll") for(int d_=0;d_<2;++d_) _Pragma("unroll") for(int r=0;r<16;++r)o[d_][r]*=wsf[crow(r,hi)]; } }while(0)
  f32x16 pA0,pA1,pB0,pB1;
  int sl_prev=0,sl_cur=0,sl_next=SLOTB;
  #define ROT() do{sl_prev=sl_cur;sl_cur=sl_next;sl_next=(sl_next==(NSLOT-1)*SLOTB)?0:sl_next+SLOTB;}while(0)
  DMA_K(2,2*SLOTB);
  WAIT_BAR(3);
  qkt(pA0,pA1,Kbase,qr,negm,r32,hi);asm volatile("s_nop 15\n\ts_nop 7":"+v"(pA0),"+v"(pA1));CMASK(pA0,pA1,0);
  START(pA0,pA1);
  _Pragma("unroll") for(int r=0;r<16;++r)pA1[r]=__builtin_amdgcn_exp2f(pA1[r]);
  { const unsigned w0_=bmw[r32]>>(4*hi), w1_=bmw[32+r32]>>(4*hi);
    _Pragma("unroll") for(int r=0;r<16;++r){pA0[r]=amask(pA0[r],w0_,(r&3)+8*(r>>2));pA1[r]=amask(pA1[r],w1_,(r&3)+8*(r>>2));} }
  WAIT_BAR(0);
  DMA_BM(1);DMA_K(3,0);DMA_V(1,SLOTB);
  ROT();
  kload8(kf,kp0+sl_cur);
  WAIT_BAR(3);
  s16x4 vlo[8],vhi[8]; u32x4 pw0,pw1,pw2,pw3;
  #define PKW(P,B) cvtpk_s(P[B],P[B+1])
  #define PAF(k) __builtin_bit_cast(bf16x8,pw##k)
  #define VFR(i) (bf16x8){vlo[i][0],vlo[i][1],vlo[i][2],vlo[i][3],vhi[i][0],vhi[i][1],vhi[i][2],vhi[i][3]}
  #define PIN(x) asm volatile("":"+v"(x))
  #define MX3(a,b,c) __builtin_fmaxf(__builtin_fmaxf((a),(b)),(c))
  #define GAPA(MF,A0,A1,A2,A3,W0,W1,PW) do{ MF; sacc+=A0; sacc+=A1; sacc+=A2; sacc+=A3; PIN(sacc); W0; W1; PIN(PW); SBAR(); }while(0)
  #define EX(v) __builtin_amdgcn_exp2f(v)
  #define CR_(r) (((r)&3)+8*((r)>>2))
  #define GAPB(MF,X,B,W) do{ MF; X[B]=EX(X[B]); X[B+1]=EX(X[B+1]); X[B+2]=EX(X[B+2]); X[B+3]=EX(X[B+3]); \
    X[B]=amask(X[B],W,CR_(B)); X[B+1]=amask(X[B+1],W,CR_(B+1)); X[B+2]=amask(X[B+2],W,CR_(B+2)); X[B+3]=amask(X[B+3],W,CR_(B+3)); PIN(X); SBAR(); }while(0)
  #define VRD(i) do{ vlo[i]=vtr(vp_+(((i)>>2)*4096+((i)&3)*1024)); vhi[i]=vtr(vp_+(((i)>>2)*4096+((i)&3)*1024+512)); }while(0)
  #define KRD(G,j) do{ if(G){ kload2(kf,kp0+sl_next,j); SBAR(); } }while(0)
  #define STEP(C0,C1,P0,P1,t,GK,GV,GL) do{ SBAR(); \
    const lds_cptr vp_=vp0+sl_prev; \
    VRD(0); SBAR(); float sacc=(P0[0]+P0[1]); \
    GAPA(C0=__builtin_amdgcn_mfma_f32_32x32x16_bf16(kf[0],qr[0],negm,0,0,0), P0[2],P0[3],P0[4],P0[5],     pw0[0]=PKW(P0,0), pw0[1]=PKW(P0,2), pw0); \
    VRD(4); SBAR(); GAPA(C1=__builtin_amdgcn_mfma_f32_32x32x16_bf16(kf[1],qr[0],negm,0,0,0), P0[6],P0[7],P0[8],P0[9],     pw0[2]=PKW(P0,4), pw0[3]=PKW(P0,6), pw0); \
    VRD(1); SBAR(); GAPA(C0=__builtin_amdgcn_mfma_f32_32x32x16_bf16(kf[2],qr[1],C0,0,0,0),   P0[10],P0[11],P0[12],P0[13], pw1[0]=PKW(P0,8), pw1[1]=PKW(P0,10), pw1); \
    VRD(5); SBAR(); GAPA(C1=__builtin_amdgcn_mfma_f32_32x32x16_bf16(kf[3],qr[1],C1,0,0,0),   P0[14],P0[15],P1[0],P1[1],   pw1[2]=PKW(P0,12),pw1[3]=PKW(P0,14), pw1); \
    VRD(2); SBAR(); GAPA(C0=__builtin_amdgcn_mfma_f32_32x32x16_bf16(kf[4],qr[2],C0,0,0,0),   P1[2],P1[3],P1[4],P1[5],     pw2[0]=PKW(P1,0), pw2[1]=PKW(P1,2), pw2); \
    VRD(6); SBAR(); GAPA(C1=__builtin_amdgcn_mfma_f32_32x32x16_bf16(kf[5],qr[2],C1,0,0,0),   P1[6],P1[7],P1[8],P1[9],     pw2[2]=PKW(P1,4), pw2[3]=PKW(P1,6), pw2); \
    VRD(3); SBAR(); GAPA(C0=__builtin_amdgcn_mfma_f32_32x32x16_bf16(kf[6],qr[3],C0,0,0,0),   P1[10],P1[11],P1[12],P1[13], pw3[0]=PKW(P1,8), pw3[1]=PKW(P1,10), pw3); \
    VRD(7); SBAR(); GAPA(C1=__builtin_amdgcn_mfma_f32_32x32x16_bf16(kf[7],qr[3],C1,0,0,0),   P1[14],P1[15],0.f,0.f,       pw3[2]=PKW(P1,12),pw3[3]=PKW(P1,14), pw3); \
    l_reg+=sacc; \
    if(GV){DMA_BM((t)+1);} if(GK){DMA_K((t)+3,sl_cur);} if(GV){DMA_V((t)+1,sl_next);} \
    CMASK(C0,C1,t); \
    { float a=MX3(C0[0],C0[1],C1[0]),b=MX3(C0[2],C0[3],C1[1]); a=MX3(a,C1[2],C1[3]); \
      _Pragma("unroll") for(int r=4;r<16;r+=4){a=MX3(a,C0[r],C0[r+1]);b=MX3(b,C0[r+2],C0[r+3]);a=MX3(a,C1[r],C1[r+1]);b=MX3(b,C1[r+2],C1[r+3]);} \
      float rm=__builtin_fmaxf(a,b); { auto rr=__builtin_amdgcn_permlane32_swap(__float_as_uint(rm),__float_as_uint(rm),false,false); rm=__builtin_fmaxf(__uint_as_float(rr[0]),__uint_as_float(rr[1])); } \
      resc=false; \
      if(__builtin_expect(__any(rm>(float)THRL),0)){ const float dl=__builtin_fmaxf(rm,0.f); mhat+=dl; \
        _Pragma("unroll") for(int r=0;r<16;++r){C0[r]-=dl;C1[r]-=dl;} \
        _Pragma("unroll") for(int r=0;r<16;++r)negm[r]=-mhat; asm volatile("":"+v"(negm)); \
        const float f=__builtin_amdgcn_exp2f(-dl); l_reg*=f; if(hi==0)wsf[r32]=f; resc=true; } } \
    BMWAIT(t); const unsigned w0_=bmw[((t)&1)*64+r32]>>(4*hi), w1_=bmw[((t)&1)*64+32+r32]>>(4*hi); \
    SBAR(); \
    GAPB(o[0]=__builtin_amdgcn_mfma_f32_32x32x16_bf16(PAF(0),VFR(0),o[0],0,0,0), C0,0,w0_); \
    GAPB(o[1]=__builtin_amdgcn_mfma_f32_32x32x16_bf16(PAF(0),VFR(4),o[1],0,0,0), C0,4,w0_); \
    KRD(GL,0); GAPB(o[0]=__builtin_amdgcn_mfma_f32_32x32x16_bf16(PAF(1),VFR(1),o[0],0,0,0), C0,8,w0_); \
    KRD(GL,1); GAPB(o[1]=__builtin_amdgcn_mfma_f32_32x32x16_bf16(PAF(1),VFR(5),o[1],0,0,0), C0,12,w0_); \
    KRD(GL,2); GAPB(o[0]=__builtin_amdgcn_mfma_f32_32x32x16_bf16(PAF(2),VFR(2),o[0],0,0,0), C1,0,w1_); \
    KRD(GL,3); GAPB(o[1]=__builtin_amdgcn_mfma_f32_32x32x16_bf16(PAF(2),VFR(6),o[1],0,0,0), C1,4,w1_); \
    GAPB(o[0]=__builtin_amdgcn_mfma_f32_32x32x16_bf16(PAF(3),VFR(3),o[0],0,0,0), C1,8,w1_); \
    GAPB(o[1]=__builtin_amdgcn_mfma_f32_32x32x16_bf16(PAF(3),VFR(7),o[1],0,0,0), C1,12,w1_); \
    }while(0)
  int t=1;
  #undef CMASK
  #define CMASK(P0,P1,t) do{}while(0)
  for(;t+5<NT;t+=2){
    STEP(pB0,pB1,pA0,pA1,t,true,true,true);     WAIT_BAR(3); RESC(); ROT();
    STEP(pA0,pA1,pB0,pB1,t+1,true,true,true);   WAIT_BAR(3); RESC(); ROT();
  }
  #undef CMASK
  #define CMASK(P0,P1,t) do{int jb_=(t)-(NT-4); if(jb_>=0)cmask(P0,P1,jb_,wid);}while(0)
  #define ENDW(tt) do{ if((tt)+3<NT){WAIT_BAR(3);} else if((tt)+2<NT){WAIT_BAR(2);} else {WAIT_BAR(0);} }while(0)
  for(;t+1<NT;t+=2){
    STEP(pB0,pB1,pA0,pA1,t,(t+3<NT),(t+1<NT),(t+1<NT));       ENDW(t);   RESC(); ROT();
    STEP(pA0,pA1,pB0,pB1,t+1,(t+4<NT),(t+2<NT),(t+2<NT));     ENDW(t+1); RESC(); ROT();
  }
  STEP(pB0,pB1,pA0,pA1,NT-1,false,false,false); RESC();
  { float sacc=pB0[0]+pB0[1]; _Pragma("unroll") for(int r=2;r<16;++r)sacc+=pB0[r]; _Pragma("unroll") for(int r=0;r<16;++r)sacc+=pB1[r]; l_reg+=sacc;
    pw0=(u32x4){PKW(pB0,0),PKW(pB0,2),PKW(pB0,4),PKW(pB0,6)};pw1=(u32x4){PKW(pB0,8),PKW(pB0,10),PKW(pB0,12),PKW(pB0,14)};pw2=(u32x4){PKW(pB1,0),PKW(pB1,2),PKW(pB1,4),PKW(pB1,6)};pw3=(u32x4){PKW(pB1,8),PKW(pB1,10),PKW(pB1,12),PKW(pB1,14)};
    SBAR(); pv(o,vb0+sl_cur,PAF(0),PAF(1),PAF(2),PAF(3)); }
  #undef PKW
  #undef PAF
  #undef VFR
  #undef PIN
  #undef MX3
  #undef GAPA
  #undef GAPB
  #undef EX
  #undef VRD
  #undef KRD
  #undef STEP
  #undef ENDW
  {auto rr=__builtin_amdgcn_permlane32_swap(__float_as_uint(l_reg),__float_as_uint(l_reg),false,false);l_reg=__uint_as_float(rr[0])+__uint_as_float(rr[1]);}
  if(hi==0)wsf[32+r32]=l_reg;asm volatile("s_waitcnt lgkmcnt(0)":::"memory");
  float rli[16];
  #pragma unroll
  for(int r=0;r<16;++r)rli[r]=__builtin_amdgcn_rcpf(wsf[32+crow(r,hi)]);
  bf16*Ow=O+(rowbase+q0+wid*QBLK)*DM+h*D;
  { bf16*stg=(bf16*)(shm+LDS_OST)+wid*2048;
    #pragma unroll
    for(int r=0;r<16;++r){const int orow=crow(r,hi);
      #pragma unroll
      for(int d0=0;d0<2;++d0)stg[orow*64+d0*32+r32]=__float2bfloat16(o[d0][r]*rli[r]);}
    asm volatile("s_waitcnt lgkmcnt(0)":::"memory");
    #pragma unroll
    for(int i=0;i<4;++i){const int row=i*8+(lane>>3),ch=lane&7; const u32x4 v=*(const u32x4*)(stg+row*64+ch*8); ATTN_STORE16(Ow+(long)row*DM+ch*8,v);} }
  asm volatile("s_waitcnt lgkmcnt(0)\n\ts_barrier":::"memory");
  #undef DMA_K
  #undef DMA_BM
  #undef VMW
  #undef BMWAIT
  #undef CR_
  #undef DMA_V
  #undef CMASK
  #undef START
  #undef RESC
  #undef ROT
}
#undef SBAR
#undef WAIT_BAR
}
constexpr int CAND_CAP = 128, QIP = 1296, HS = 513, FAST_CAP = 512;
struct IdxP { const bf16 *QI, *KI; const float* WI; unsigned* BM; unsigned* dbg; };
__device__ __forceinline__ unsigned mono_key(float s) { const unsigned u = __builtin_bit_cast(unsigned, s + 0.0f); return u ^ ((unsigned)((int)u >> 31) | 0x80000000u); }
__device__ __forceinline__ void idx_scores2(const bf16x8 (&kf)[2][4], const LAS unsigned char* qlane, const float (&wq)[8], f32x16& sc0, f32x16& sc1) {
    bf16x8 qv[4], qn[4];
#pragma unroll
    for (int s = 0; s < 4; ++s) qv[s] = *(const LAS bf16x8*)(qlane + 8 * 128 + s * 32);
#pragma unroll
    for (int i = 0; i < 16; ++i) { sc0[i] = 0.f; sc1[i] = 0.f; }
    f32x16 ap0, ap1;
#pragma unroll
    for (int i = 0; i < 16; ++i) { ap0[i] = 0.f; ap1[i] = 0.f; }
#pragma unroll
    for (int n = 0; n < 10; ++n) {
        const int nh = (n + 1 < 2) ? 9 : (n + 1 - 2);
        if (n + 1 < 10) {
#pragma unroll
            for (int s = 0; s < 4; ++s) qn[s] = *(const LAS bf16x8*)(qlane + nh * 128 + s * 32); }
        f32x16 a0, a1;
        if (n < 2) {
#pragma unroll
            for (int s = 0; s < 4; ++s) { sc0 = __builtin_amdgcn_mfma_f32_32x32x16_bf16(kf[0][s], qv[s], sc0, 0, 0, 0); sc1 = __builtin_amdgcn_mfma_f32_32x32x16_bf16(kf[1][s], qv[s], sc1, 0, 0, 0); }
        } else {
#pragma unroll
            for (int i = 0; i < 16; ++i) { a0[i] = 0.f; a1[i] = 0.f; }
#pragma unroll
            for (int s = 0; s < 4; ++s) { a0 = __builtin_amdgcn_mfma_f32_32x32x16_bf16(kf[0][s], qv[s], a0, 0, 0, 0); a1 = __builtin_amdgcn_mfma_f32_32x32x16_bf16(kf[1][s], qv[s], a1, 0, 0, 0); }
        }
        if (n >= 3) {
            const float w = wq[n - 3];
#pragma unroll
            for (int i = 0; i < 16; ++i) { sc0[i] = __builtin_fmaf(w, __builtin_fabsf(ap0[i]), sc0[i]); sc1[i] = __builtin_fmaf(w, __builtin_fabsf(ap1[i]), sc1[i]); }
#pragma unroll
            for (int g = 0; g < 8; ++g) { __builtin_amdgcn_sched_group_barrier(0x008, 1, 0); __builtin_amdgcn_sched_group_barrier(0x002, 4, 0); }
        }
        if (n >= 2) { ap0 = a0; ap1 = a1; }
#pragma unroll
        for (int s = 0; s < 4; ++s) qv[s] = qn[s];
    }
    { const float w = wq[7];
#pragma unroll
      for (int i = 0; i < 16; ++i) { sc0[i] = __builtin_fmaf(w, __builtin_fabsf(ap0[i]), sc0[i]); sc1[i] = __builtin_fmaf(w, __builtin_fabsf(ap1[i]), sc1[i]); } }
#pragma unroll
    for (int i = 0; i < 16; ++i) asm volatile("" : "+v"(sc0[i]), "+v"(sc1[i]));
}
__device__ __forceinline__ void idx_item(LAS unsigned char* L, int b, int j, const IdxP& P, int tid, int lane, int wave) {
    LAS unsigned* hist = (LAS unsigned*)L;
    LAS unsigned* img = (LAS unsigned*)(L + 66048);
    LAS unsigned* st = (LAS unsigned*)(L + 98816);
    LAS unsigned* cand = hist;
    LAS unsigned char* Qs = L + 100864;
    const int r32 = lane & 31, hi = lane >> 5;
    const int q0 = 32 * j, ntile = 2 * (j / 2 + 1);
    const size_t rowb = (size_t)b * SEQ;
    if (ntile <= 8) {
        for (int idx = tid; idx < ntile * 32; idx += NTHR) P.BM[((size_t)b * 256 + (idx >> 5)) * SEQ + q0 + (idx & 31)] = 0xffffffffu;
        return;
    }
    float wq[8];
    { for (int c = tid; c < 32 * 64; c += NTHR) { const int rr = c >> 6, ch = c & 63; *(LAS v4u*)(Qs + rr * QIP + ch * 16) = *(const v4u*)(P.QI + (rowb + q0 + rr) * 512 + ch * 8); }
      const float* wp = P.WI + (rowb + q0 + r32) * 8;
#pragma unroll
      for (int h = 0; h < 8; ++h) wq[h] = 0.5f * wp[h]; }
    if (tid < 32) { st[32 + tid] = 256u; st[64 + tid] = 0u; st[96 + tid] = 0u; }
    if (tid == 0) st[129] = 0u;
    __syncthreads();
    {
        const int r = tid >> 4, part = tid & 15;
        const float* wp = P.WI + (rowb + q0 + r) * 8;
        float qb[4] = {0.f, 0.f, 0.f, 0.f}; float rsum = 0.f;
#pragma unroll
        for (int h = 0; h < 8; ++h) { const float w = wp[h]; const v2u raw = *(const LAS v2u*)(Qs + r * QIP + h * 128 + part * 8);
            const float f0 = bflo(raw.x), f1 = bfhi(raw.x), f2 = bflo(raw.y), f3 = bfhi(raw.y);
            float nsq = (f0 * f0 + f1 * f1) + (f2 * f2 + f3 * f3);
#pragma unroll
            for (int o = 1; o < 16; o <<= 1) nsq += __shfl_xor(nsq, o);
            rsum += fabsf(w) * sqrtf(nsq);
            qb[0] += 0.5f * w * f0; qb[1] += 0.5f * w * f1; qb[2] += 0.5f * w * f2; qb[3] += 0.5f * w * f3; }
        v2u hw, lw;
        { const unsigned h01 = pk2(qb[0], qb[1]), h23 = pk2(qb[2], qb[3]); hw.x = h01; hw.y = h23;
          lw.x = pk2(qb[0] - bflo(h01), qb[1] - bfhi(h01)); lw.y = pk2(qb[2] - bflo(h23), qb[3] - bfhi(h23)); }
        *(LAS v2u*)(Qs + r * QIP + 8 * 128 + part * 8) = hw; *(LAS v2u*)(Qs + r * QIP + 9 * 128 + part * 8) = lw;
        { const v2u kw = *(const v2u*)(P.KI + (rowb + r) * 64 + part * 4); const float f0 = bflo(kw.x), f1 = bfhi(kw.x), f2 = bflo(kw.y), f3 = bfhi(kw.y);
          float ksq = (f0 * f0 + f1 * f1) + (f2 * f2 + f3 * f3);
#pragma unroll
          for (int o = 1; o < 16; o <<= 1) ksq += __shfl_xor(ksq, o);
          if (part == 0) { __hip_atomic_fetch_max(&st[129], __builtin_bit_cast(unsigned, ksq), __ATOMIC_RELAXED, __HIP_MEMORY_SCOPE_WORKGROUP); st[224 + r] = __builtin_bit_cast(unsigned, rsum); } }
    }
    __syncthreads();
    if (tid < 32) { const float R = 0.25f * sqrtf(__builtin_bit_cast(float, st[129])) * __builtin_bit_cast(float, st[224 + tid]);
        const float C = 0.125f * R;
        st[160 + tid] = (0x80000000u | __builtin_bit_cast(unsigned, R + C)) - 511u * 131072u; st[224 + tid] = __builtin_bit_cast(unsigned, C); st[tid] = 0u; st[192 + tid] = 0u;
        st[256 + tid] = __builtin_bit_cast(unsigned, R); st[288 + tid] = 511u; st[320 + tid] = 0u; }
    const LAS unsigned char* qlane = Qs + r32 * QIP + hi * 16;
    int level = 0;
    const int npair = ntile >> 1;
#define IDX_KLOAD2(tp) { const bf16* kp = P.KI + (rowb + 64 * (tp) + r32) * 64 + 8 * hi; _Pragma("unroll") for (int s = 0; s < 4; ++s) { kn[0][s] = *(const bf16x8*)(kp + 16 * s); kn[1][s] = *(const bf16x8*)(kp + 32 * 64 + 16 * s); } }
#define IDX_SCORES2(tp) \
        bf16x8 kf[2][4]; _Pragma("unroll") for (int s = 0; s < 4; ++s) { kf[0][s] = kn[0][s]; kf[1][s] = kn[1][s]; } \
        f32x16 sc0, sc1; idx_scores2(kf, qlane, wq, sc0, sc1); \
        if ((tp) + NWAVES < npair) { IDX_KLOAD2((tp) + NWAVES) }
    bool slow;
    {
        for (int u = tid; u < 32 * HS; u += NTHR) hist[u] = 0u;
        if (tid == 0) st[130] = 0u;
        __syncthreads();
        const float Rq = __builtin_bit_cast(float, st[256 + r32]);
        const int nsw = (npair + 63) >> 6, SP = min(npair, 8 * nsw);
        {   const float s1 = 256.f / Rq; LAS unsigned* hrow = hist + r32 * HS;
            for (int i = wave; i < SP; i += NWAVES) { const int tp = (i * npair) / SP;
                bf16x8 kn[2][4]; IDX_KLOAD2(tp)
                bf16x8 kf[2][4];
#pragma unroll
                for (int s = 0; s < 4; ++s) { kf[0][s] = kn[0][s]; kf[1][s] = kn[1][s]; }
                f32x16 sc0, sc1; idx_scores2(kf, qlane, wq, sc0, sc1);
#pragma unroll
                for (int e = 0; e < 16; ++e) { const int b0 = min(max((int)__builtin_fmaf(sc0[e], s1, 256.f), 0), 511), b1 = min(max((int)__builtin_fmaf(sc1[e], s1, 256.f), 0), 511);
                    __hip_atomic_fetch_add(&hrow[b0], 1u, __ATOMIC_RELAXED, __HIP_MEMORY_SCOPE_WORKGROUP); __hip_atomic_fetch_add(&hrow[b1], 1u, __ATOMIC_RELAXED, __HIP_MEMORY_SCOPE_WORKGROUP); }
            }
        }
        __syncthreads();
        {
            const int q = tid >> 4, seg = tid & 15; const LAS unsigned* hq = hist + q * HS + seg * 32;
            unsigned segsum = 0u;
            for (int wi = 0; wi < 32; ++wi) segsum += hq[wi];
            unsigned S = segsum;
#pragma unroll
            for (int off = 1; off < 16; off <<= 1) { const unsigned o = __shfl_down(S, off, 16); if (seg + off < 16) S += o; }
            const unsigned above = S - segsum, total = __shfl(S, 0, 16);
            const float f = (float)total / (float)(64 * npair), rs = 256.f * f, sg = 3.5f * sqrtf(rs * (1.f - f));
            const int rl = (int)floorf(rs - sg) - 1, rh = (int)ceilf(rs + sg) + 1;
            const unsigned tl = rl > 0 ? (unsigned)rl : 0u, th = (unsigned)rh;
            if (above < tl && tl <= above + segsum) { unsigned cum = above; int fb = 0; bool found = false;
                for (int wi = 31; wi >= 0; --wi) { const unsigned c = hq[wi]; if (!found && cum + c >= tl) { found = true; fb = wi; } if (!found) cum += c; }
                st[288 + q] = (unsigned)(32 * seg + fb); }
            if (above < th && th <= above + segsum) { unsigned cum = above; int fb = 0; bool found = false;
                for (int wi = 31; wi >= 0; --wi) { const unsigned c = hq[wi]; if (!found && cum + c >= th) { found = true; fb = wi; } if (!found) cum += c; }
                st[320 + q] = (unsigned)(32 * seg + fb); }
        }
        __syncthreads();
#ifdef REP_PASS2
        for (int rep2 = 0; rep2 < 2; ++rep2) { if (rep2) { __syncthreads(); if (tid < 32) st[96 + tid] = 0u; __syncthreads(); }
#else
        {
#endif
            const float wbin = Rq * (1.f / 256.f), fH = __builtin_fmaf((float)(st[288 + r32] + 1u), wbin, -Rq), fA = __builtin_fmaf((float)st[320 + r32], wbin, -Rq), s2 = 524287.f / (fH - fA), nfa = -fA * s2;
            bf16x8 kn[2][4]; if (wave < npair) { IDX_KLOAD2(wave) }
            for (int tp = wave; tp < npair; tp += NWAVES) {
                IDX_SCORES2(tp)
#define IDX_FAST_ELEMS(SC, T) { unsigned v = 0u, cm = 0u; \
            _Pragma("unroll") for (int i = 15; i >= 0; --i) { v = __builtin_amdgcn_alignbit(v, __builtin_bit_cast(unsigned, SC[i] - fH), 31);        \
                                                              cm = __builtin_amdgcn_alignbit(cm, __builtin_bit_cast(unsigned, SC[i] - fA), 31); } \
            cm = v & ~cm & 0xffffu; v = ~v & 0xffffu;                                                           \
            if (cm) { const unsigned pos0 = __hip_atomic_fetch_add(&st[96 + r32], (unsigned)__builtin_popcount(cm), __ATOMIC_RELAXED, __HIP_MEMORY_SCOPE_WORKGROUP);     \
                const unsigned rb = 8191u - (unsigned)(32 * (T)) - hi4; \
                _Pragma("unroll") for (int i = 0; i < 16; ++i) if (cm & (1u << i)) { const unsigned pos = min(pos0 + (unsigned)__builtin_popcount(cm & ((1u << i) - 1u)), (unsigned)FAST_CAP - 1u); \
                    cand[r32 * FAST_CAP + pos] = (min((unsigned)__builtin_fmaf(SC[i], s2, nfa), 524287u) << 13) | (rb - (unsigned)((i & 3) + 8 * (i >> 2))); } } \
            unsigned bits = (v & 0xfu) | ((v & 0xf0u) << 4) | ((v & 0xf00u) << 8) | ((v & 0xf000u) << 12);     \
            bits <<= 4 * hi; bits |= __shfl_xor(bits, 32); if (hi == 0) img[(T) * 32 + r32] = bits; }
                unsigned hi4 = 4u * (unsigned)hi; asm volatile("" : "+v"(hi4));
                IDX_FAST_ELEMS(sc0, 2 * tp)
                IDX_FAST_ELEMS(sc1, 2 * tp + 1)
#undef IDX_FAST_ELEMS
            }
        }
        __syncthreads();
        {
            const int q = tid >> 4, l16 = tid & 15; unsigned above = 0u;
            for (int t = l16; t < ntile; t += 16) above += (unsigned)__builtin_popcount(img[t * 32 + q]);
#pragma unroll
            for (int o = 1; o < 16; o <<= 1) above += __shfl_xor(above, o);
            const unsigned n = st[96 + q];
            if (l16 == 0) { if (above >= 256u || 256u - above > n || n > (unsigned)FAST_CAP) st[130] = 1u; st[32 + q] = 256u - above; }
        }
        __syncthreads();
        slow = st[130] != 0u;
#ifdef REP_SEL
        for (int rep3 = 0; rep3 < 2; ++rep3)
#endif
        if (!slow) {
            const int q = tid >> 4, l16 = tid & 15; const unsigned n = st[96 + q], need = st[32 + q];
            unsigned c[FAST_CAP / 16];
#pragma unroll
            for (int i = 0; i < FAST_CAP / 16; ++i) { const unsigned ci = (unsigned)(l16 + 16 * i); c[i] = ci < n ? cand[q * FAST_CAP + ci] : 0u; }
            unsigned Pv = 0u; bool done = false;
#pragma nounroll
            for (int bit = 31; bit >= 0; --bit) { const unsigned trial = Pv | (1u << bit); unsigned cnt = 0u;
#pragma unroll
                for (int i = 0; i < FAST_CAP / 16; ++i) cnt += (c[i] >= trial) ? 1u : 0u;
#pragma unroll
                for (int o = 1; o < 16; o <<= 1) cnt += __shfl_xor(cnt, o);
                if (!done && cnt >= need) { Pv = trial; done = (cnt == need); }
                if (__all(done)) break; }
#pragma unroll
            for (int i = 0; i < FAST_CAP / 16; ++i) if ((unsigned)(l16 + 16 * i) < n && c[i] >= Pv) { const unsigned kidx = 8191u - (c[i] & 8191u);
                __hip_atomic_fetch_or(&img[(kidx >> 5) * 32 + q], 1u << (kidx & 31), __ATOMIC_RELAXED, __HIP_MEMORY_SCOPE_WORKGROUP); }
        } else if (tid < 32) { st[32 + tid] = 256u; st[96 + tid] = 0u; }
        __syncthreads();
    }
#ifdef DIAG_SLOW
    if (slow && tid == 0) __hip_atomic_fetch_add(P.dbg, 1u, RLX_AGENT);
#endif
    if (slow) {
    for (;;) {
        ++level;
        for (int u = tid; u < 32 * HS; u += NTHR) hist[u] = 0u;
        if (tid == 0) st[128] = 0u;
        __syncthreads();
        {
            const unsigned qa = st[r32], qlen = st[192 + r32], base1 = st[160 + r32]; const float cq = __builtin_bit_cast(float, st[224 + r32]);
            const int sh = (level > 1 && qlen > 512u) ? (32 - __builtin_clz(qlen - 1u)) - 9 : 0;
            LAS unsigned* hrow = hist + r32 * HS;
            bf16x8 kn[2][4]; if (wave < npair) { IDX_KLOAD2(wave) }
            for (int tp = wave; tp < npair; tp += NWAVES) {
                IDX_SCORES2(tp)
                if (level == 1) {
#pragma unroll
                    for (int i = 0; i < 16; ++i) { const unsigned k0 = mono_key(sc0[i] + cq), k1 = mono_key(sc1[i] + cq);
                        const unsigned b0 = min((max(k0, base1) - base1) >> 17, 511u), b1 = min((max(k1, base1) - base1) >> 17, 511u);
                        __hip_atomic_fetch_add(&hrow[b0], 1u, __ATOMIC_RELAXED, __HIP_MEMORY_SCOPE_WORKGROUP); __hip_atomic_fetch_add(&hrow[b1], 1u, __ATOMIC_RELAXED, __HIP_MEMORY_SCOPE_WORKGROUP); }
                } else {
#pragma unroll
                    for (int i = 0; i < 16; ++i) { const unsigned o0 = mono_key(sc0[i] + cq) - qa, o1 = mono_key(sc1[i] + cq) - qa;
                        if (o0 < qlen) __hip_atomic_fetch_add(&hrow[o0 >> sh], 1u, __ATOMIC_RELAXED, __HIP_MEMORY_SCOPE_WORKGROUP);
                        if (o1 < qlen) __hip_atomic_fetch_add(&hrow[o1 >> sh], 1u, __ATOMIC_RELAXED, __HIP_MEMORY_SCOPE_WORKGROUP); }
                }
            }
        }
        __syncthreads();
        {
            const int q = tid >> 4, seg = tid & 15;
            unsigned segsum = 0u;
            for (int wi = 0; wi < 32; ++wi) segsum += hist[q * HS + seg * 32 + wi];
            unsigned S = segsum;
#pragma unroll
            for (int off = 1; off < 16; off <<= 1) { const unsigned o = __shfl_down(S, off, 16); if (seg + off < 16) S += o; }
            const unsigned above = S - segsum, need = st[32 + q];
            if (above < need && need <= above + segsum) {
                unsigned cum = above, fbin = 0u, fneed = 1u, fcnt = 0u; bool found = false;
                for (int wi = 31; wi >= 0; --wi) { const unsigned c = hist[q * HS + seg * 32 + wi];
                    if (!found && cum + c >= need) { found = true; fbin = (unsigned)wi; fneed = need - cum; fcnt = c; } if (!found) cum += c; }
                fbin += 32u * (unsigned)seg;
                unsigned na, nlen;
                if (level == 1) { const unsigned base1 = st[160 + q];
                    if (fbin == 0u) { na = 0u; nlen = base1 + 131072u; } else if (fbin == 511u) { na = base1 + 511u * 131072u; nlen = 0u - na; } else { na = base1 + fbin * 131072u; nlen = 131072u; } }
                else { const unsigned qa = st[q], qlen = st[192 + q]; const int sh = qlen > 512u ? (32 - __builtin_clz(qlen - 1u)) - 9 : 0;
                    na = qa + (fbin << sh); nlen = min(1u << sh, qlen - (fbin << sh)); }
                st[q] = na; st[192 + q] = nlen; st[32 + q] = fneed; st[64 + q] = fcnt;
                if (fcnt > (unsigned)CAND_CAP && nlen > 1u) st[128] = 1u;
            }
        }
        __syncthreads();
#ifndef MAXLVL
#define MAXLVL 8
#endif
        const bool more = (st[128] != 0u) && (level < MAXLVL);
        __syncthreads();
        if (!more) break;
    }
    {
        const unsigned qa = st[r32], qlen = st[192 + r32]; const float cq = __builtin_bit_cast(float, st[224 + r32]);
        const unsigned Hk = qa + qlen - 1u;
        unsigned hb = (Hk & 0x80000000u) ? (Hk ^ 0x80000000u) : ~Hk;
        if (hb == 0x80000000u) hb = 0x80000001u;
        const float fH = __builtin_bit_cast(float, hb);
        const unsigned ab_ = (qa & 0x80000000u) ? (qa ^ 0x80000000u) : ~qa;
        const float fA = (qa < 0x00800000u) ? -__builtin_inff() : __builtin_bit_cast(float, ab_);
        bf16x8 kn[2][4]; if (wave < npair) { IDX_KLOAD2(wave) }
        for (int tp = wave; tp < npair; tp += NWAVES) {
            IDX_SCORES2(tp)
#define IDX_COLLECT_ELEMS(SC, T) { unsigned v = 0u; _Pragma("unroll") for (int i = 15; i >= 0; --i) { const float ts = SC[i] + cq; const bool ab = ts > fH; v = v + v + (ab ? 1u : 0u); \
                if (!ab && ts >= fA) { const unsigned key = mono_key(ts); \
                    const unsigned pos = __hip_atomic_fetch_add(&st[96 + r32], 1u, __ATOMIC_RELAXED, __HIP_MEMORY_SCOPE_WORKGROUP); \
                    if (pos < (unsigned)CAND_CAP) { cand[(r32 * CAND_CAP + pos) * 2] = key; cand[(r32 * CAND_CAP + pos) * 2 + 1] = (unsigned)(32 * (T) + crow(i, hi)); } } } \
            unsigned bits = (v & 0xfu) | ((v & 0xf0u) << 4) | ((v & 0xf00u) << 8) | ((v & 0xf000u) << 12);     \
            bits <<= 4 * hi; bits |= __shfl_xor(bits, 32); if (hi == 0) img[(T) * 32 + r32] = bits; }
            IDX_COLLECT_ELEMS(sc0, 2 * tp)
            IDX_COLLECT_ELEMS(sc1, 2 * tp + 1)
#undef IDX_COLLECT_ELEMS
        }
    }
#undef IDX_SCORES2
#undef IDX_KLOAD2
    __syncthreads();
    {
        const int q = tid >> 4; const unsigned n = min(st[96 + q], (unsigned)CAND_CAP), need = st[32 + q];
        for (unsigned c = tid & 15; c < n; c += 16) { const unsigned key = cand[(q * CAND_CAP + c) * 2], idx = cand[(q * CAND_CAP + c) * 2 + 1]; unsigned rank = 0u;
            for (unsigned o = 0; o < n; ++o) { const unsigned k2 = cand[(q * CAND_CAP + o) * 2], i2 = cand[(q * CAND_CAP + o) * 2 + 1]; rank += (k2 > key || (k2 == key && i2 < idx)) ? 1u : 0u; }
            if (rank < need) __hip_atomic_fetch_or(&img[(idx >> 5) * 32 + q], 1u << (idx & 31), __ATOMIC_RELAXED, __HIP_MEMORY_SCOPE_WORKGROUP); }
    }
    }
    __syncthreads();
    for (int idx = tid; idx < ntile * 32; idx += NTHR) P.BM[((size_t)b * 256 + (idx >> 5)) * SEQ + q0 + (idx & 31)] = img[idx];
    __syncthreads();
}

__device__ __forceinline__ int wq_next(Frame& F, int cw) {
    __syncthreads();
    if (F_TID == 0) F.MISC[0] = __hip_atomic_fetch_add((unsigned*)(F.ctl + cw), 1u, RLX_AGENT);
    __syncthreads();
    return (int)F.MISC[0];
}

__device__ __forceinline__ void p5a_route(Frame& F, const Args& A) {
    const int lane = F_LANE, tid = F_TID, wave = F_WAVE;
    const float* x1 = A.out; const float* g2 = A.in[11];
    const float* wrg = A.in[12]; const float* brg = A.in[13]; const float* wre = A.in[14]; const float* bre = A.in[15];
    int* toke = (int*)(F.ws + WS_TOKE); float* tokw = (float*)(F.ws + WS_TOKW); float* rstd2 = (float*)(F.ws + WS_RSTD2);
    int* sslot = (int*)(F.ws + WS_SSLOT);
    constexpr int WST = 44, WCH = 256 * WST * 4;
    LAS float* wl = (LAS float*)F.lds;
    LAS unsigned* lcnt = (LAS unsigned*)(F.lds + 2 * WCH);
    LAS float* lgs = (LAS float*)(F.lds + 2 * WCH + 256);
    for (int i = F.vcu * NTHR + tid; i < SORT_ROWS; i += F.G * NTHR) sslot[i] = -1;
    if (tid < NEXP) lcnt[tid] = 0u;
    const int i16 = lane & 15, kq = lane >> 4, tile = wave & 3, half = wave >> 2;
    const int per = T / F.G;
    for (int t0 = F.vcu * per; t0 < (F.vcu + 1) * per; t0 += 64) {
        const float* xr = x1 + (size_t)(t0 + 16 * tile + i16) * D + 4 * kq;
        f32x4 acc0 = (f32x4){0.f, 0.f, 0.f, 0.f}, acc1 = acc0; float ss = 0.f;
        f32x4 se[4], sg; float gk[5];
#define RT_LOAD(c) do { _Pragma("unroll") for (int q = 0; q < 4; ++q) { const int f = tid + 512 * q, k = f >> 3; se[q] = *(const GAS f32x4*)(wre + (size_t)(256 * (c) + k) * 32 + 4 * (f & 7)); gk[q] = g2[256 * (c) + k]; } \
            { const int k = tid >> 1; sg = *(const GAS f32x4*)(wrg + (size_t)(256 * (c) + k) * 8 + 4 * (tid & 1)); gk[4] = g2[256 * (c) + k]; } } while (0)
#define RT_WRITE(bf) do { LAS float* wb = wl + (bf) * (WCH / 4); _Pragma("unroll") for (int q = 0; q < 4; ++q) { const int f = tid + 512 * q, k = f >> 3; *(LAS f32x4*)(wb + k * WST + 4 * (f & 7)) = se[q] * gk[q]; } \
            { const int k = tid >> 1; *(LAS f32x4*)(wb + k * WST + 32 + 4 * (tid & 1)) = sg * gk[4]; } } while (0)
        RT_LOAD(0); RT_WRITE(0); __syncthreads();
        for (int c = 0; c < 4; ++c) {
            if (c + 1 < 4) RT_LOAD(c + 1);
            const LAS float* wb = wl + (c & 1) * (WCH / 4) + 4 * kq * WST + i16 + 16 * half;
#pragma unroll 4
            for (int s = 0; s < 16; ++s) {
                const f32x4 a4 = *(const GAS f32x4*)(xr + 256 * c + 16 * s);
                if (half == 0) ss += (a4.x * a4.x + a4.y * a4.y) + (a4.z * a4.z + a4.w * a4.w);
#pragma unroll
                for (int cc = 0; cc < 4; ++cc) { const LAS float* wp = wb + (16 * s + cc) * WST;
                    acc0 = __builtin_amdgcn_mfma_f32_16x16x4f32(a4[cc], wp[0], acc0, 0, 0, 0);
                    if (half == 0) acc1 = __builtin_amdgcn_mfma_f32_16x16x4f32(a4[cc], wp[32 - (i16 & 8)], acc1, 0, 0, 0); }
            }
            if (c + 1 < 4) RT_WRITE((c + 1) & 1);
            __syncthreads();
        }
#undef RT_LOAD
#undef RT_WRITE
        LAS float* lt = lgs + tile * 640;
#pragma unroll
        for (int r = 0; r < 4; ++r) { const int tk = 4 * kq + r; lt[tk * 40 + 8 + 16 * half + i16] = acc0[r]; if (half == 0 && i16 < 8) lt[tk * 40 + i16] = acc1[r]; }
        if (half == 0) { ss += __shfl_xor(ss, 16); ss += __shfl_xor(ss, 32); if (kq == 0) lgs[2560 + 16 * tile + i16] = 1.f / sqrtf(ss * (1.f / D) + EPS); }
        __syncthreads();
        if (half == 0 && lane < 16) {
            const int m = t0 + 16 * tile + lane; const float rstd = lgs[2560 + 16 * tile + lane]; const LAS float* lg = lt + lane * 40;
            float gl[8];
#pragma unroll
            for (int k = 0; k < 8; ++k) gl[k] = lg[k] * rstd + brg[k];
            int gs = 0; float gm = gl[0];
#pragma unroll
            for (int k = 1; k < 8; ++k) if (gl[k] > gm) { gm = gl[k]; gs = k; }
            float den = 0.f;
#pragma unroll
            for (int k = 0; k < 8; ++k) den += __expf(gl[k] - gm);
            const float wgrp = 1.f / den;
            float el[4];
#pragma unroll
            for (int cc = 0; cc < 4; ++cc) el[cc] = lg[8 + 4 * gs + cc] * rstd + bre[4 * gs + cc];
            int i1 = 0; float v1 = el[0];
#pragma unroll
            for (int cc = 1; cc < 4; ++cc) if (el[cc] > v1) { v1 = el[cc]; i1 = cc; }
            int i2 = -1; float v2 = 0.f;
#pragma unroll
            for (int cc = 0; cc < 4; ++cc) if (cc != i1 && (i2 < 0 || el[cc] > v2)) { v2 = el[cc]; i2 = cc; }
            const float e2 = __expf(v2 - v1), w1 = 1.f / (1.f + e2), w2 = e2 / (1.f + e2);
            toke[2 * m] = gs * 4 + i1; toke[2 * m + 1] = gs * 4 + i2; tokw[2 * m] = w1 * wgrp; tokw[2 * m + 1] = w2 * wgrp; rstd2[m] = rstd;
            __hip_atomic_fetch_add(&lcnt[gs * 4 + i1], 1u, __ATOMIC_RELAXED, __HIP_MEMORY_SCOPE_WORKGROUP);
            __hip_atomic_fetch_add(&lcnt[gs * 4 + i2], 1u, __ATOMIC_RELAXED, __HIP_MEMORY_SCOPE_WORKGROUP);
        }
        __syncthreads();
    }
    if (tid < NEXP && lcnt[tid]) __hip_atomic_fetch_add((unsigned*)(F.ctl + CW_CNT + tid), lcnt[tid], RLX_AGENT);
}

__device__ __forceinline__ void p5a2_scatter(Frame& F, const Args& A) {
    const int lane = F_LANE, tid = F_TID;
    const float* x1 = A.out; const float* g2 = A.in[11];
    const int* toke = (const int*)(F.ws + WS_TOKE); const float* tokw = (const float*)(F.ws + WS_TOKW); const float* rstd2 = (const float*)(F.ws + WS_RSTD2);
    int* sslot = (int*)(F.ws + WS_SSLOT); float* sw = (float*)(F.ws + WS_SW); int* t2e = (int*)(F.ws + WS_T2E);
    bf16* AS = (bf16*)(F.ws + WS_ASORT);
    LAS unsigned* sh = (LAS unsigned*)F.lds;
    if (tid < NEXP) sh[256 + tid] = __hip_atomic_load((unsigned*)(F.ctl + CW_CNT + tid), RLX_AGENT);
    __syncthreads();
    if (tid == 0) { unsigned acc = 0u;
        for (int e = 0; e < NEXP; ++e) { const unsigned c = sh[256 + e]; sh[e] = acc; const unsigned nt = (c + 255u) / 256u;
            if (blockIdx.x == 0) for (unsigned i = 0; i < nt; ++i) t2e[acc / 256u + i] = e;
            acc += nt * 256u; }
        if (blockIdx.x == 0) t2e[255] = (int)(acc / 256u); }
    const int per = T / F.G;
    for (int t0 = F.vcu * per; t0 < (F.vcu + 1) * per; t0 += 64) {
        if (tid < NEXP) sh[32 + tid] = 0u;
        __syncthreads();
        int e = 0; unsigned lpos = 0u;
        if (tid < 128) { e = toke[2 * t0 + tid]; lpos = __hip_atomic_fetch_add(&sh[32 + e], 1u, __ATOMIC_RELAXED, __HIP_MEMORY_SCOPE_WORKGROUP); }
        __syncthreads();
        if (tid < NEXP) sh[64 + tid] = sh[tid] + (sh[32 + tid] ? __hip_atomic_fetch_add((unsigned*)(F.ctl + CW_FILL + tid), sh[32 + tid], RLX_AGENT) : 0u);
        __syncthreads();
        if (tid < 128) { const unsigned pos = sh[64 + e] + lpos; sh[96 + tid] = pos; sslot[pos] = 2 * t0 + tid; sw[pos] = tokw[2 * t0 + tid]; }
        __syncthreads();
        for (int tk0 = F_WAVE; tk0 < 64; tk0 += 4 * NWAVES) {
            f32x4 xv[4][4];
#pragma unroll
            for (int r = 0; r < 4; ++r) { const GAS f32x4* xr = (const GAS f32x4*)(x1 + (size_t)(t0 + tk0 + r * NWAVES) * D) + lane;
#pragma unroll
                for (int j = 0; j < 4; ++j) xv[r][j] = xr[64 * j]; }
#pragma unroll
            for (int r = 0; r < 4; ++r) { const int tk = tk0 + r * NWAVES, m = t0 + tk; const float rstd = rstd2[m];
                const unsigned p0 = sh[96 + 2 * tk], p1 = sh[96 + 2 * tk + 1];
#pragma unroll
                for (int j = 0; j < 4; ++j) { const f32x4 g = *((const GAS f32x4*)g2 + lane + 64 * j); const f32x4 y = xv[r][j] * rstd * g; v2u w; w.x = pk2(y.x, y.y); w.y = pk2(y.z, y.w);
                    *((GAS v2u*)(AS + (size_t)p0 * D) + lane + 64 * j) = w; *((GAS v2u*)(AS + (size_t)p1 * D) + lane + 64 * j) = w; } } }
        __syncthreads();
    }
}

__device__ __forceinline__ void p6_final(Frame& F, const Args& A) {
    const int gw = F.vcu * NWAVES + F_WAVE, NGW = F.G * NWAVES, lane = F_LANE;
    const float* gf = A.in[19]; float* out = A.out; const bf16* SL = (const bf16*)(F.ws + WS_SLOTS);
    for (int m0 = gw; m0 < T; m0 += 2 * NGW) {
        f32x4 v[2][4]; v2u a[2][4], c[2][4];
#pragma unroll
        for (int r = 0; r < 2; ++r) { const int m = min(m0 + r * NGW, T - 1); const GAS f32x4* xr = (const GAS f32x4*)(out + (size_t)m * D) + lane;
            const GAS v2u* s0 = (const GAS v2u*)(SL + (size_t)(2 * m) * D) + lane; const GAS v2u* s1 = (const GAS v2u*)(SL + (size_t)(2 * m + 1) * D) + lane;
#pragma unroll
            for (int j = 0; j < 4; ++j) { v[r][j] = xr[64 * j]; a[r][j] = s0[64 * j]; c[r][j] = s1[64 * j]; } }
#pragma unroll
        for (int r = 0; r < 2; ++r) { const int m = m0 + r * NGW; float s = 0.f;
#pragma unroll
            for (int j = 0; j < 4; ++j) { f32x4& w = v[r][j];
                w.x += bflo(a[r][j].x) + bflo(c[r][j].x); w.y += bfhi(a[r][j].x) + bfhi(c[r][j].x); w.z += bflo(a[r][j].y) + bflo(c[r][j].y); w.w += bfhi(a[r][j].y) + bfhi(c[r][j].y);
                s += (w.x * w.x + w.y * w.y) + (w.z * w.z + w.w * w.w); }
            const float rstd = 1.f / sqrtf(wave_sum(s) * (1.f / D) + EPS);
            if (m < T) { GAS f32x4* xo = (GAS f32x4*)(out + (size_t)m * D) + lane;
#pragma unroll
                for (int j = 0; j < 4; ++j) { const f32x4 g = *((const GAS f32x4*)gf + lane + 64 * j); xo[64 * j] = v[r][j] * rstd * g; } } }
    }
}

constexpr int NPHASE = 13;
__global__ void __launch_bounds__(NTHR, 2) mk_fwd(Args args) {
    extern __shared__ __attribute__((aligned(16))) unsigned char lds[];
    Frame F;
    F.lds = (LAS unsigned char*)lds; F.MISC = (volatile LAS unsigned*)(F.lds + MISC_OFF);
        F.G = gridDim.x; { const int bx = blockIdx.x; F.vcu = (F.G % 8 == 0) ? (bx % 8) * (F.G / 8) + bx / 8 : bx; }
    F.ws = args.ws; F.ctl = (gu32*)(args.ws + WS_CTL);
    unsigned char* ws = args.ws;
    if (F_TID < 128) F.MISC[F_TID] = 0u;
    __syncthreads();
    const bool single = (args.ph_hi - args.ph_lo) > 1;
    XcdBarrier bar; bar.bar = (unsigned*)(F.ctl + CW_BAR); bar.x = 0; bar.st = nullptr;
    if (single) bar = xcd_barrier_post((unsigned*)(F.ctl + CW_BAR), F.MISC + 8);
    const int lo = args.ph_lo, hi = args.ph_hi;
#ifdef ONLY
#define IN(k) ((k) == ONLY && lo <= (k) && (k) < hi)
#else
#define IN(k) (lo <= (k) && (k) < hi)
#endif
#ifdef TS_A
#define STAMP(k) do { if (blockIdx.x == 0 && threadIdx.x == 0) ((unsigned long long*)(ws + WS_CTL + 8192))[(k) + 1] = __builtin_amdgcn_s_memrealtime(); } while (0)
#else
#define STAMP(k) do { } while (0)
#endif
#define SEAM(k) do { if (IN((k) + 1)) xcd_barrier(bar); STAMP(k); } while (0)
    const f32x2* rope = (const f32x2*)(ws + WS_ROPE);
    bf16* GA = (bf16*)args.out; bf16* GB = (bf16*)args.out + (size_t)T * 1024;

    STAMP(-1);
    if (IN(0)) { p0_prologue(F, args);
#ifdef REP_P0
        p0_prologue(F, args);
#endif
        SEAM(0); }
    if (IN(1)) {
        pg8::Gemm g{(const bf16*)(ws + WS_H), (const bf16*)(ws + WS_WIN), T, NIN, D, 0}; pg8::StaticOrder S; S.init(T, NIN, F.G, (int)blockIdx.x);
        pg8::EpiIn E{(bf16*)(ws + WS_CQ), (bf16*)(ws + WS_CKV), (bf16*)(ws + WS_QB), (bf16*)(ws + WS_KB), (bf16*)(ws + WS_VB), (bf16*)(ws + WS_QI), (bf16*)(ws + WS_KI), (bf16*)(ws + WS_KR), GA, GB, (float*)(ws + WS_WI), rope};
        pg8::gemm_phase<pg8::EpiIn, pg8::StaticOrder, true, true>(F.lds, g, S, E);
#ifdef REP_P1
        pg8::gemm_phase<pg8::EpiIn, pg8::StaticOrder, true, true>(F.lds, g, S, E);
#endif
        SEAM(1);
    }
    if (IN(2)) { p2a_norms(F, args); SEAM(2); }
    if (IN(3)) {
#ifdef REP_P3
      for (int rep = 0; rep < 2; ++rep) {
#else
      {
#endif
#ifndef NO3A
        { pg8::Gemm g{(const bf16*)(ws + WS_CQ), (const bf16*)(ws + WS_WUQ), T, 768, 384, 0}; pg8::StaticOrder S; S.init(T, 768, F.G, (int)blockIdx.x);
          pg8::EpiQA E{(bf16*)(ws + WS_QA), rope}; pg8::gemm_phase<pg8::EpiQA, pg8::StaticOrder, true, true>(F.lds, g, S, E); }
#endif
#ifndef NO3B
        { pg8::Gemm g{(const bf16*)(ws + WS_CKV), (const bf16*)(ws + WS_WUKV), T, 1024, 256, 0}; pg8::StaticOrder S; S.init(T, 1024, F.G, (int)blockIdx.x);
          pg8::EpiKV E{(bf16*)(ws + WS_KN), (bf16*)(ws + WS_VA)}; pg8::gemm_phase<pg8::EpiKV, pg8::StaticOrder, true, true>(F.lds, g, S, E); }
#endif
      }
        SEAM(3);
    }
    if (IN(4)) {
        unsigned* rdy = (unsigned*)(F.ctl + CW_RDY);
        for (;;) { const int k = wq_next(F, CW_Q1); if (k >= 1536 + CV_QITEMS) break;
            int ltid = threadIdx.x; asm volatile("" : "+v"(ltid));
            const int lw = __builtin_amdgcn_readfirstlane(ltid >> 6);
            if (k < 512) { const int ib = k & 1, ij = 255 - (k >> 1);
                const IdxP IP{(const bf16*)(ws + WS_QI), (const bf16*)(ws + WS_KI), (const float*)(ws + WS_WI), (unsigned*)(ws + WS_BM), (unsigned*)(F.ctl + 1024)};
                idx_item(F.lds, ib, ij, IP, ltid, ltid & 63, lw);
#ifdef REP_IDX
                __syncthreads(); idx_item(F.lds, ib, ij, IP, ltid, ltid & 63, lw);
#endif
                VM_WAIT(); __syncthreads();
                if (ltid == 0) { __builtin_amdgcn_fence(__ATOMIC_RELEASE, "agent"); VM_WAIT(); __hip_atomic_fetch_add(rdy + 64 * (ib * 32 + (ij >> 3)), 1u, RLX_AGENT); }
                continue; }
            const int j = k - 512; int a;
            if (j < 3 * CV_QITEMS) { const int q3 = j / 3, r3 = j - 3 * q3; a = (r3 == 2) ? -1 - q3 : 2 * q3 + r3; } else a = j - CV_QITEMS;
            if (a < 0) { const int c = -1 - a; LAS float* scr = (LAS float*)(F.lds + lw * 16640);
                conv_tile2(args, ws, CV_EARLY + 16 * c + lw, CV_EARLY + 16 * c + 8 + lw, scr, ltid & 63);
                continue; }
            { const int u = a >> 1, ub = (u & 15) >> 3, uh = u & 7, uq = 31 - (u >> 4);
                if (a & 1) { const AttnP APA{(const bf16*)(ws + WS_QA), (const bf16*)(ws + WS_KN), (const bf16*)(ws + WS_KR), (const bf16*)(ws + WS_VA), (bf16*)(ws + WS_OA), nullptr};
                    attn_unit<true>(F.lds, ub, uh, uq, APA, ltid, ltid & 63, lw); }
                else { const AttnP APB{(const bf16*)(ws + WS_QB), (const bf16*)(ws + WS_KB), nullptr, (const bf16*)(ws + WS_VB), (bf16*)(ws + WS_OB), (const unsigned*)(ws + WS_BM)};
                    if (ltid == 0) { unsigned sp = 0u; while (__hip_atomic_load(rdy + 64 * (ub * 32 + uq), RLX_AGENT) < 8u) { __builtin_amdgcn_s_sleep(8); if (++sp > (1u << 22)) break; }
                        __builtin_amdgcn_fence(__ATOMIC_ACQUIRE, "agent"); VM_WAIT(); }
                    __syncthreads();
#ifdef DSA_OLD
                    attn_unit<false>(F.lds, ub, uh, uq, APB, ltid, ltid & 63, lw); } }
#else
                    attn_body::attn_unit<8>(ub, uh, uq, (const attn_body::bf16*)APB.Q, (const attn_body::bf16*)APB.K, (const attn_body::bf16*)APB.V, (attn_body::bf16*)APB.O, APB.BM, (char*)F.lds, ltid); } }
#endif
        }
    }
    if (IN(5)) { SEAM(5); }
    if (IN(6)) {
#ifdef REP_P6
      for (int rep = 0; rep < 2; ++rep) {
#else
      {
#endif
        { pg8::Gemm g{(const bf16*)(ws + WS_OA), (const bf16*)(ws + WS_WOA), T, 1024, 512, 0}; pg8::StaticOrder S; S.init(T, 1024, F.G, (int)blockIdx.x);
          pg8::EpiY<0> E{(bf16*)(ws + WS_Y), GA}; pg8::gemm_phase<pg8::EpiY<0>, pg8::StaticOrder, true, true>(F.lds, g, S, E); }
        { pg8::Gemm g{(const bf16*)(ws + WS_OB), (const bf16*)(ws + WS_WOB), T, 1024, 512, 0}; pg8::StaticOrder S; S.init(T, 1024, F.G, (int)blockIdx.x);
          pg8::EpiY<1> E{(bf16*)(ws + WS_Y), GB}; pg8::gemm_phase<pg8::EpiY<1>, pg8::StaticOrder, true, true>(F.lds, g, S, E); }
      }
        SEAM(6);
    }
    if (IN(7)) {
        pg8::Gemm g{(const bf16*)(ws + WS_Y), (const bf16*)(ws + WS_WOUT), T, 1024, 1024, 0}; pg8::StaticOrder S; S.init(T, 1024, F.G, (int)blockIdx.x);
        pg8::EpiX1 E{args.in[0], args.out}; pg8::gemm_phase<pg8::EpiX1, pg8::StaticOrder, true, true>(F.lds, g, S, E);
#ifdef REP_P7
        pg8::gemm_phase<pg8::EpiX1, pg8::StaticOrder, true, true>(F.lds, g, S, E);
#endif
        SEAM(7);
    }
    if (IN(8)) { p5a_route(F, args); SEAM(8); }
    if (IN(9)) { p5a2_scatter(F, args); SEAM(9); }
    if (IN(10)) {
        const int* t2e = (const int*)(ws + WS_T2E); const int ntl = t2e[255];
        pg8::Gemm g{(const bf16*)(ws + WS_ASORT), (const bf16*)(ws + WS_WGU), SORT_ROWS, 512, 1024, (size_t)512 * 1024 * 2}; pg8::GroupOrder S; S.init(ntl, 2, F.G, (int)blockIdx.x, t2e);
        pg8::EpiHid E{(bf16*)(ws + WS_HID)}; pg8::gemm_phase<pg8::EpiHid, pg8::GroupOrder, true, true>(F.lds, g, S, E);
#ifdef REP_P10
        pg8::gemm_phase<pg8::EpiHid, pg8::GroupOrder, true, true>(F.lds, g, S, E);
#endif
        SEAM(10);
    }
    if (IN(11)) {
        const int* t2e = (const int*)(ws + WS_T2E); const int ntl = t2e[255];
        pg8::Gemm g{(const bf16*)(ws + WS_HID), (const bf16*)(ws + WS_WD), SORT_ROWS, 1024, 256, (size_t)1024 * 256 * 2}; pg8::GroupOrder S; S.init(ntl, 4, F.G, (int)blockIdx.x, t2e);
        pg8::EpiDown E{(bf16*)(ws + WS_SLOTS), (const int*)(ws + WS_SSLOT), (const float*)(ws + WS_SW)}; pg8::gemm_phase<pg8::EpiDown, pg8::GroupOrder, true, true>(F.lds, g, S, E);
#ifdef REP_P11
        pg8::gemm_phase<pg8::EpiDown, pg8::GroupOrder, true, true>(F.lds, g, S, E);
#endif
        SEAM(11);
    }
    if (IN(12)) { p6_final(F, args); }
#ifdef DIAG_SLOW
    if (blockIdx.x == 0 && threadIdx.x == 0) { const unsigned long long t0 = __builtin_amdgcn_s_memrealtime(), wait = 100ull * __hip_atomic_load((unsigned*)(F.ctl + 1024), RLX_AGENT);
        while (__builtin_amdgcn_s_memrealtime() - t0 < wait) __builtin_amdgcn_s_sleep(16); }
#endif
#ifdef TS_A
    if (blockIdx.x == 0 && threadIdx.x == 0) { STAMP(12); __builtin_amdgcn_s_waitcnt(0);
        const unsigned long long* tsp = (const unsigned long long*)(ws + WS_CTL + 8192);
        const unsigned long long ta = __hip_atomic_load(tsp + (TS_A) + 1, RLX_AGENT), tb = __hip_atomic_load(tsp + (TS_B) + 1, RLX_AGENT);
        const unsigned long long t0 = __builtin_amdgcn_s_memrealtime(), wait = 4ull * (tb - ta);
        while (__builtin_amdgcn_s_memrealtime() - t0 < wait) __builtin_amdgcn_s_sleep(16); }
#endif
#undef IN
#undef SEAM
}

#ifndef MK_MULTI
#define MK_MULTI 0
#endif
extern "C" void kernel_launch(void* const* d_in, const int* in_sizes, int n_in, void* d_out, int out_size, void* d_ws, size_t ws_size, hipStream_t stream) {
    static int grid = 0;
    if (grid == 0) {
        if (n_in != 20 || in_sizes[0] != T * D || out_size != T * D || ws_size < WS_END) { fprintf(stderr, "kernel_launch: unexpected shapes n_in %d in0 %d out %d ws %zu\n", n_in, n_in > 0 ? in_sizes[0] : -1, out_size, ws_size); grid = -1; return; }
        int dev = 0, cus = 0;
        if (hipGetDevice(&dev) != hipSuccess || hipDeviceGetAttribute(&cus, hipDeviceAttributeMultiprocessorCount, dev) != hipSuccess) { grid = -1; return; }
        if (hipFuncSetAttribute((const void*)mk_fwd, hipFuncAttributeMaxDynamicSharedMemorySize, LDS_BYTES) != hipSuccess) { fprintf(stderr, "kernel_launch: hipFuncSetAttribute failed\n"); grid = -1; return; }
        (void)hipGetLastError();
        grid = cus;
    }
    if (grid < 0) return;
    if (hipMemsetAsync((char*)d_ws + WS_CTL, 0, CTL_ZERO_BYTES, stream) != hipSuccess) return;
    Args a{};
    for (int i = 0; i < 20; ++i) a.in[i] = (const float*)d_in[i];
    a.out = (float*)d_out; a.ws = (unsigned char*)d_ws;
#if MK_MULTI
    for (int p = 0; p < NPHASE; ++p) { a.ph_lo = p; a.ph_hi = p + 1; hipLaunchKernelGGL(mk_fwd, dim3(grid), dim3(NTHR), LDS_BYTES, stream, a); }
#else
    a.ph_lo = 0; a.ph_hi = NPHASE;
    hipLaunchKernelGGL(mk_fwd, dim3(grid), dim3(NTHR), LDS_BYTES, stream, a);
#endif
}
```

```cpp
#include <hip/hip_runtime.h>
#include <hip/hip_bf16.h>
#include <cstdio>
#include <cstdint>

#define GAS __attribute__((address_space(1)))
#define LAS __attribute__((address_space(3)))
typedef unsigned short bf16;
typedef unsigned v4u __attribute__((ext_vector_type(4)));
typedef unsigned v2u __attribute__((ext_vector_type(2)));
typedef float f32x4 __attribute__((ext_vector_type(4)));
typedef float f32x2 __attribute__((ext_vector_type(2)));
typedef float f32x16 __attribute__((ext_vector_type(16)));
typedef short bf16x8 __attribute__((ext_vector_type(8)));
typedef short s16x4 __attribute__((ext_vector_type(4)));
typedef __bf16 bf16x2_t __attribute__((ext_vector_type(2)));
typedef GAS unsigned gu32;
#define RLX_AGENT __ATOMIC_RELAXED, __HIP_MEMORY_SCOPE_AGENT
#define LDS_WAIT() asm volatile("s_waitcnt lgkmcnt(0)" ::: "memory")
#define VM_WAIT() asm volatile("s_waitcnt vmcnt(0)" ::: "memory")

constexpr int NWAVES = 8, NTHR = NWAVES * 64;
constexpr int BATCH = 2, SEQ = 8192, D = 1024, T = BATCH * SEQ;
constexpr float EPS = 1e-6f;
constexpr int NIN = 4864, NIN_SRC = 4840;
constexpr int C_CQ = 0, C_CKV = 384, C_QB = 640, C_KB = 1152, C_VB = 1664, C_QI = 2176, C_KR = 2688, C_KI = 2720, C_WI = 2784, C_GA = 2816, C_GB = 3840;
constexpr int NEXP = 32, FF = 256;
constexpr int SORT_ROWS = 2 * T + NEXP * 256;
constexpr float LOG2E = 1.4426950408889634f;
constexpr float C2A = 0.10206207261596575f * LOG2E;
constexpr float C2B = 0.125f * LOG2E;
constexpr float WI_SCALE = 0.35355339059327373f * 0.125f;

constexpr size_t MiB = 1u << 20, KiB = 1u << 10;
constexpr size_t WS_CTL = 0, CTL_ZERO_BYTES = 1 * MiB;
constexpr size_t WS_ROPE = 1 * MiB;
constexpr size_t WS_WI = 2 * MiB;
constexpr size_t WS_TOKE = 2 * MiB + 512 * KiB;
constexpr size_t WS_TOKW = WS_TOKE + 128 * KiB;
constexpr size_t WS_RSTD2 = WS_TOKW + 128 * KiB;
constexpr size_t WS_SSLOT = 3 * MiB + 512 * KiB;
constexpr size_t WS_SW = WS_SSLOT + 192 * KiB;
constexpr size_t WS_T2E = WS_SW + 192 * KiB;
constexpr size_t WS_WIN = 4 * MiB, WS_WUQ = 14 * MiB, WS_WUKV = 15 * MiB, WS_WOA = 16 * MiB, WS_WOB = 17 * MiB, WS_WOUT = 18 * MiB, WS_WGU = 20 * MiB, WS_WD = 52 * MiB;
constexpr size_t WS_H = 68 * MiB, WS_OA = 68 * MiB, WS_OB = 84 * MiB;
constexpr size_t WS_QA = 100 * MiB, WS_KN = 124 * MiB, WS_VA = 140 * MiB, WS_Y = 100 * MiB;
constexpr size_t WS_QB = 156 * MiB, WS_KB = 172 * MiB, WS_VB = 188 * MiB;
constexpr size_t WS_CQ = 204 * MiB, WS_CKV = 216 * MiB, WS_BM = 204 * MiB;
constexpr size_t WS_QI = 224 * MiB, WS_KI = 240 * MiB, WS_KR = 242 * MiB;
constexpr size_t WS_ASORT = 68 * MiB, WS_SLOTS = 156 * MiB, WS_HID = 220 * MiB;
constexpr size_t WS_END = 256 * MiB;
constexpr int CW_BAR = 4096;
constexpr int CW_Q1 = 64, CW_Q2 = 128;
constexpr int CW_CNT = 256, CW_FILL = 320;
constexpr int CW_RDY = 8192;

constexpr int LDS_BYTES = 147456;
constexpr int MISC_OFF = 147456 - 512;

__device__ __forceinline__ unsigned f2bf(float f) { unsigned u = __builtin_bit_cast(unsigned, f); return (u + 0x7fffu + ((u >> 16) & 1u)) >> 16; }
__device__ __forceinline__ unsigned pk2(float lo, float hi) { f32x2 v = {lo, hi}; bf16x2_t b = __builtin_convertvector(v, bf16x2_t); return __builtin_bit_cast(unsigned, b); }
__device__ __forceinline__ float bflo(unsigned w) { return __builtin_bit_cast(float, w << 16); }
__device__ __forceinline__ float bfhi(unsigned w) { return __builtin_bit_cast(float, w & 0xffff0000u); }

#define XB_TMO      128
#define XB_XCNT(j)  (256  + 64 * (j))
#define XB_XSUB(j)  (1280 + 64 * (j))
#define XB_XGEN(j)  (2304 + 64 * (j))
#define XB_TOP      3328
#define XB_TOPGEN   3392
#define XCD_BAR_WORDS 3456
#define XB_SPIN_CAP (1u << 22)
__device__ __forceinline__ unsigned xb_ld(unsigned* p)              { return __hip_atomic_load(p, __ATOMIC_RELAXED, __HIP_MEMORY_SCOPE_AGENT); }
__device__ __forceinline__ unsigned xb_add(unsigned* p, unsigned v) { return __hip_atomic_fetch_add(p, v, __ATOMIC_RELAXED, __HIP_MEMORY_SCOPE_AGENT); }
__device__ __forceinline__ unsigned xb_xcc_id() { return (unsigned)__builtin_amdgcn_s_getreg((3 << 11) | 20) & 0xFu; }
#define XB_SPIN(cond, bar) do { unsigned _sp = 0; while (cond) { __builtin_amdgcn_s_sleep(1); \
    if ((++_sp & 255u) == 0u) { if (xb_ld(&(bar)[XB_TMO])) break; if (_sp > XB_SPIN_CAP) { atomicAdd(&(bar)[XB_TMO], 1u); break; } } } } while (0)
struct XcdBarrier { unsigned* bar; unsigned x; volatile LAS unsigned* st; };
__device__ __forceinline__ XcdBarrier xcd_barrier_post(unsigned* bar, volatile LAS unsigned* st) {
    XcdBarrier b; b.bar = bar; b.x = xb_xcc_id(); b.st = st;
    if (threadIdx.x == 0) (void)xb_add(&bar[XB_XCNT(b.x)], 1u);
    return b;
}
__device__ __forceinline__ void xcd_barrier_complete(unsigned* bar, unsigned x, unsigned& nloc, unsigned& nx) {
    const unsigned G = gridDim.x * gridDim.y * gridDim.z;
    unsigned sum, cnt, mine, sp = 0u;
    for (;;) {
        sum = 0u; cnt = 0u; mine = 0u;
#pragma unroll
        for (unsigned j = 0; j < 16; ++j) { const unsigned c = xb_ld(&bar[XB_XCNT(j)]); sum += c; cnt += (c > 0u) ? 1u : 0u; mine = (j == x) ? c : mine; }
        if (sum == G) break;
        __builtin_amdgcn_s_sleep(1);
        if ((++sp & 255u) == 0u) { if (xb_ld(&bar[XB_TMO])) break; if (sp > XB_SPIN_CAP) { atomicAdd(&bar[XB_TMO], 1u); break; } }
    }
    nloc = mine > 0u ? mine : 1u; nx = cnt > 0u ? cnt : 1u;
}
__device__ __forceinline__ void xcd_barrier(const XcdBarrier& b) {
    asm volatile("s_waitcnt vmcnt(0)" ::: "memory");
    __syncthreads();
    if (threadIdx.x == 0) {
        unsigned* bar = b.bar;
        __builtin_amdgcn_s_waitcnt(0);
        unsigned nloc = b.st[0], nx = b.st[1];
        if (nloc == 0u) { xcd_barrier_complete(bar, b.x, nloc, nx); b.st[0] = nloc; b.st[1] = nx; }
        const unsigned old = xb_add(&bar[XB_XSUB(b.x)], 1u);
        const unsigned gen = old / nloc;
        if (old + 1u == (gen + 1u) * nloc) {
            __builtin_amdgcn_fence(__ATOMIC_RELEASE, "agent");
            asm volatile("s_waitcnt vmcnt(0)" ::: "memory");
            const unsigned og = xb_add(&bar[XB_TOP], 1u);
            const unsigned tg = og / nx;
            if (og + 1u == (tg + 1u) * nx) xb_add(&bar[XB_TOPGEN], 1u);
            else XB_SPIN(xb_ld(&bar[XB_TOPGEN]) == tg, bar);
            __builtin_amdgcn_fence(__ATOMIC_ACQUIRE, "agent");
            xb_add(&bar[XB_XGEN(b.x)], 1u);
            asm volatile("s_waitcnt vmcnt(0)" ::: "memory");
        } else {
            XB_SPIN(xb_ld(&bar[XB_XGEN(b.x)]) == gen, bar);
            __builtin_amdgcn_fence(__ATOMIC_ACQUIRE, "agent");
            asm volatile("s_waitcnt vmcnt(0)" ::: "memory");
        }
    }
    __syncthreads();
}

__device__ __forceinline__ float wave_sum(float v) {
#pragma unroll
    for (int o = 1; o < 64; o <<= 1) v += __shfl_xor(v, o);
    return v;
}

namespace pg8 {
#define PG8_LAS __attribute__((address_space(3)))
typedef unsigned short bf16_t;
typedef unsigned u32x4 __attribute__((ext_vector_type(4)));
constexpr int BM = 256, BK = 64, HALF = 128, HTB = HALF * BK * 2, STAGE_BYTES = 8 * HTB, NXCD = 8, WGM = 8;
__host__ __device__ __forceinline__ int lds_byte(int r, int c) { const int st = (r >> 4) * 2 + (c >> 5), rr = r & 15, cc = c & 31, ob = rr * 64 + cc * 2; return st * 1024 + (ob ^ (((ob >> 9) & 1) << 5)); }
__host__ __device__ __forceinline__ void stage_rc(int b, int& R, int& C) { const int st = b / 1024, sb = b % 1024, swz = sb ^ (((sb >> 9) & 1) << 5); R = (st >> 1) * 16 + swz / 64; C = (st & 1) * 32 + (swz % 64) / 2; }
__host__ __device__ __forceinline__ int perm32(int rho) { const int n = rho >> 4, i = rho & 15; return 8 * (i >> 2) + 4 * n + (i & 3); }

struct Unit { int pm, pn, e; };
struct Gemm { const bf16_t* A; const bf16_t* Bt; int M, N, K; size_t estride; };

struct StaticOrder {
    int nM, nN, nwg, G, c;
    __host__ __device__ void init(int M, int N, int G_, int c_) { nM = M / BM; nN = N / BM; nwg = nM * nN; G = G_; c = c_; }
    __host__ __device__ bool next(int i, Unit& u) const {
        const long L = (long)i * G + c; if (L >= nwg) return false;
        int wgid = (int)L; { const int q = nwg / NXCD, r = nwg % NXCD, xcd = wgid % NXCD, off = wgid / NXCD; wgid = (xcd < r ? xcd * (q + 1) : r * (q + 1) + (xcd - r) * q) + off; }
        const int nig = WGM * nN, gid = wgid / nig, fm = gid * WGM, gsz = (nM - fm) < WGM ? (nM - fm) : WGM;
        u.pm = fm + ((wgid % nig) % gsz); u.pn = (wgid % nig) / gsz; u.e = 0; return true;
    }
    __device__ __forceinline__ void a_ready(const Unit&) const {}
    __device__ __forceinline__ void done(const Unit&) const {}
};
struct GroupOrder {
    int nN, total, G, c; const int* t2e;
    __device__ void init(int nTiles, int nN_, int G_, int c_, const int* t2e_) { nN = nN_; total = nTiles * nN_; G = G_; c = c_; t2e = t2e_; }
    __device__ bool next(int i, Unit& u) const {
        const long L = (long)i * G + c; if (L >= total) return false;
        u.pm = (int)(L / nN); u.pn = (int)(L % nN); u.e = __builtin_amdgcn_readfirstlane(t2e[u.pm]); return true;
    }
    __device__ __forceinline__ void a_ready(const Unit&) const {}
    __device__ __forceinline__ void done(const Unit&) const {}
};

__device__ __forceinline__ void st8(bf16_t* p, f32x4 v0, f32x4 v1) { u32x4 w; w.x = pk2(v0[0], v0[1]); w.y = pk2(v0[2], v0[3]); w.z = pk2(v1[0], v1[1]); w.w = pk2(v1[2], v1[3]); *(u32x4*)p = w; }
__device__ __forceinline__ void ld8(const bf16_t* p, f32x4& v0, f32x4& v1) { const u32x4 w = *(const u32x4*)p; v0 = (f32x4){bflo(w.x), bfhi(w.x), bflo(w.y), bfhi(w.y)}; v1 = (f32x4){bflo(w.z), bfhi(w.z), bflo(w.w), bfhi(w.w)}; }

__device__ __forceinline__ void rope16(f32x4& v0, f32x4& v1, int row, int fq, const f32x2* rope) {
    const f32x2* rp = rope + (size_t)(row & (SEQ - 1)) * 16;
    f32x4 p0, p1;
#pragma unroll
    for (int e = 0; e < 4; ++e) { p0[e] = __shfl_xor(v0[e], 16); p1[e] = __shfl_xor(v1[e], 16); }
    if (fq < 2) {
        const float sg = fq == 0 ? -1.f : 1.f;
#pragma unroll
        for (int e = 0; e < 4; ++e) { const f32x2 a = rp[2 * e], b = rp[2 * (4 + e)];
            v0[e] = v0[e] * a.x + sg * p0[e] * a.y; v1[e] = v1[e] * b.x + sg * p1[e] * b.y; }
    }
}
__device__ __forceinline__ void rope32(f32x4& v0, f32x4& v1, int row, int fq, const f32x2* rope) {
    const f32x2* rp = rope + (size_t)(row & (SEQ - 1)) * 16 + 8 * (fq & 1);
    const float sg = fq < 2 ? -1.f : 1.f;
#pragma unroll
    for (int e = 0; e < 4; ++e) { const float p0 = __shfl_xor(v0[e], 32), p1 = __shfl_xor(v1[e], 32); const f32x2 a = rp[e], b = rp[4 + e];
        v0[e] = v0[e] * a.x + sg * p0 * a.y; v1[e] = v1[e] * b.x + sg * p1 * b.y; }
}
__device__ __forceinline__ float sigmoidf_(float x) { return __builtin_amdgcn_rcpf(1.f + __builtin_amdgcn_exp2f(-1.4426950408889634f * x)); }

struct EpiIn {
    static constexpr bool PERM = true, AFTER_DRAIN = false;
    bf16_t *CQ, *CKV, *QB, *KB, *VB, *QI, *KI, *KR, *GA, *GB; float* WI; const f32x2* rope;
    __device__ __forceinline__ void operator()(const f32x4 (&acc)[2][2][4][2], const Unit& u, int wr, int wc, int fr, int fq) const {
        const int row0 = u.pm * BM + wr * 64 + fr;
#pragma unroll
        for (int bj = 0; bj < 2; ++bj) {
            const int cg = u.pn * BM + bj * HALF + wc * 32;
            bf16_t* base = nullptr; int pitch = 0, cc = 0, mode = 0; float sc = 1.f;
            if (cg < C_CKV) { base = CQ; pitch = 384; cc = cg; }
            else if (cg < C_QB) { base = CKV; pitch = 256; cc = cg - C_CKV; }
            else if (cg < C_KB) { base = QB; pitch = 512; cc = cg - C_QB; mode = ((cc >> 5) & 1) == 0 ? 1 : 0; sc = C2B; }
            else if (cg < C_VB) { base = KB; pitch = 512; cc = cg - C_KB; mode = ((cc >> 5) & 1) == 0 ? 1 : 0; }
            else if (cg < C_QI) { base = VB; pitch = 512; cc = cg - C_VB; }
            else if (cg < C_KR) { base = QI; pitch = 512; cc = cg - C_QI; mode = ((cc >> 5) & 1) == 0 ? 1 : 0; }
            else if (cg < C_KI) { base = KR; pitch = 32; cc = 0; mode = 2; }
            else if (cg < C_WI) { base = KI; pitch = 64; cc = cg - C_KI; mode = (cc == 0) ? 1 : 0; }
            else if (cg < C_GA) { mode = 4; }
            else if (cg < C_GB) { base = GA; pitch = 1024; cc = cg - C_GA; mode = 3; }
            else { base = GB; pitch = 1024; cc = cg - C_GB; mode = 3; }
#pragma unroll
            for (int ai = 0; ai < 2; ++ai)
#pragma unroll
                for (int m = 0; m < 4; ++m) {
                    const int row = row0 + ai * HALF + m * 16;
                    f32x4 v0 = acc[ai][bj][m][0], v1 = acc[ai][bj][m][1];
                    if (mode == 1) rope16(v0, v1, row, fq, rope);
                    else if (mode == 2) rope32(v0, v1, row, fq, rope);
                    else if (mode == 3) {
#pragma unroll
                        for (int e = 0; e < 4; ++e) { v0[e] = sigmoidf_(v0[e]); v1[e] = sigmoidf_(v1[e]); } }
                    if (mode == 4) { if (fq == 0) { *(f32x4*)(WI + (size_t)row * 8) = v0 * WI_SCALE; *(f32x4*)(WI + (size_t)row * 8 + 4) = v1 * WI_SCALE; } }
                    else { v0 = v0 * sc; v1 = v1 * sc; st8(base + (size_t)row * pitch + cc + 8 * fq, v0, v1); }
                }
        }
    }
};
struct EpiQA {
    static constexpr bool PERM = true, AFTER_DRAIN = false;
    bf16_t* QA; const f32x2* rope;
    __device__ __forceinline__ void operator()(const f32x4 (&acc)[2][2][4][2], const Unit& u, int wr, int wc, int fr, int fq) const {
        const int row0 = u.pm * BM + wr * 64 + fr;
#pragma unroll
        for (int bj = 0; bj < 2; ++bj) {
            const int cg = u.pn * BM + bj * HALF + wc * 32; const bool rot = ((cg >> 5) % 3) == 2;
#pragma unroll
            for (int ai = 0; ai < 2; ++ai)
#pragma unroll
                for (int m = 0; m < 4; ++m) {
                    const int row = row0 + ai * HALF + m * 16;
                    f32x4 v0 = acc[ai][bj][m][0], v1 = acc[ai][bj][m][1];
                    if (rot) rope32(v0, v1, row, fq, rope);
                    v0 = v0 * C2A; v1 = v1 * C2A; st8(QA + (size_t)row * 768 + cg + 8 * fq, v0, v1);
                }
        }
    }
};
struct EpiKV {
    static constexpr bool PERM = true, AFTER_DRAIN = false;
    bf16_t *KN, *VA;
    __device__ __forceinline__ void operator()(const f32x4 (&acc)[2][2][4][2], const Unit& u, int wr, int wc, int fr, int fq) const {
        const int row0 = u.pm * BM + wr * 64 + fr;
#pragma unroll
        for (int bj = 0; bj < 2; ++bj) {
            const int cg = u.pn * BM + bj * HALF + wc * 32; bf16_t* base = cg < 512 ? KN : VA; const int cc = (cg & 511) + 8 * fq;
#pragma unroll
            for (int ai = 0; ai < 2; ++ai)
#pragma unroll
                for (int m = 0; m < 4; ++m) { const int row = row0 + ai * HALF + m * 16; st8(base + (size_t)row * 512 + cc, acc[ai][bj][m][0], acc[ai][bj][m][1]); }
        }
    }
};
template <int ADD> struct EpiY {
    static constexpr bool PERM = true, AFTER_DRAIN = false;
    bf16_t* Y; const bf16_t* Gt;
    __device__ __forceinline__ void operator()(const f32x4 (&acc)[2][2][4][2], const Unit& u, int wr, int wc, int fr, int fq) const {
        const int row0 = u.pm * BM + wr * 64 + fr;
#pragma unroll
        for (int bj = 0; bj < 2; ++bj) {
            const int c0 = u.pn * BM + bj * HALF + wc * 32 + 8 * fq;
#pragma unroll
            for (int ai = 0; ai < 2; ++ai)
#pragma unroll
                for (int m = 0; m < 4; ++m) { const size_t off = (size_t)(row0 + ai * HALF + m * 16) * 1024 + c0;
                    f32x4 g0, g1; ld8(Gt + off, g0, g1);
                    f32x4 v0 = acc[ai][bj][m][0] * g0, v1 = acc[ai][bj][m][1] * g1;
                    if (ADD) { f32x4 o0, o1; ld8(Y + off, o0, o1); v0 = v0 + o0; v1 = v1 + o1; }
                    st8(Y + off, v0, v1); }
        }
    }
};
struct EpiX1 {
    static constexpr bool PERM = false, AFTER_DRAIN = false;
    const float* X; float* O;
    __device__ __forceinline__ void operator()(const f32x4 (&acc)[2][2][4][2], const Unit& u, int wr, int wc, int fr, int fq) const {
        const int row0 = u.pm * BM + wr * 64 + fr, col0 = u.pn * BM + wc * 32 + 4 * fq;
#pragma unroll
        for (int ai = 0; ai < 2; ++ai)
#pragma unroll
            for (int m = 0; m < 4; ++m) { const size_t off = (size_t)(row0 + ai * HALF + m * 16) * 1024 + col0;
#pragma unroll
                for (int bj = 0; bj < 2; ++bj)
#pragma unroll
                    for (int n = 0; n < 2; ++n) { const f32x4 xv = *(const f32x4*)(X + off + bj * HALF + n * 16); *(f32x4*)(O + off + bj * HALF + n * 16) = xv + acc[ai][bj][m][n]; } }
    }
};
struct EpiHid {
    static constexpr bool PERM = true, AFTER_DRAIN = false;
    bf16_t* HID;
    __device__ __forceinline__ void operator()(const f32x4 (&acc)[2][2][4][2], const Unit& u, int wr, int wc, int fr, int fq) const {
        const int row0 = u.pm * BM + wr * 64 + fr, c0 = u.pn * 128 + wc * 32 + 8 * fq;
#pragma unroll
        for (int ai = 0; ai < 2; ++ai)
#pragma unroll
            for (int m = 0; m < 4; ++m) { f32x4 h0, h1;
#pragma unroll
                for (int e = 0; e < 4; ++e) { const float g0 = acc[ai][0][m][0][e], g1 = acc[ai][0][m][1][e];
                    h0[e] = g0 * sigmoidf_(g0) * acc[ai][1][m][0][e]; h1[e] = g1 * sigmoidf_(g1) * acc[ai][1][m][1][e]; }
                st8(HID + (size_t)(row0 + ai * HALF + m * 16) * 256 + c0, h0, h1); }
    }
};
struct EpiDown {
    static constexpr bool PERM = true, AFTER_DRAIN = false;
    bf16_t* SL; const int* sslot; const float* sw;
    __device__ __forceinline__ void operator()(const f32x4 (&acc)[2][2][4][2], const Unit& u, int wr, int wc, int fr, int fq) const {
        const int row0 = u.pm * BM + wr * 64 + fr;
#pragma unroll
        for (int ai = 0; ai < 2; ++ai)
#pragma unroll
            for (int m = 0; m < 4; ++m) { const int r = row0 + ai * HALF + m * 16; const int slot = sslot[r]; const float w = sw[r];
                if (slot >= 0) {
#pragma unroll
                    for (int bj = 0; bj < 2; ++bj) st8(SL + (size_t)slot * 1024 + u.pn * BM + bj * HALF + wc * 32 + 8 * fq, acc[ai][bj][m][0] * w, acc[ai][bj][m][1] * w); } }
    }
};
template <class Epi, class Sched, bool ALIGN_EPI = false, bool SP2 = false>
__device__ __forceinline__ void gemm_phase(PG8_LAS unsigned char* lds, const Gemm g, const Sched& S, const Epi& E) {
    const int tid = threadIdx.x, wid = __builtin_amdgcn_readfirstlane(tid >> 6), lane = tid & 63, wr = wid >> 2, wc = wid & 3, fr = lane & 15, fq = lane >> 4;
    const int K = g.K, nt = K / BK;
    unsigned voffA[2], voffB[2];
#pragma unroll
    for (int i = 0; i < 2; ++i) { int R, C; stage_rc(tid * 16 + i * 8192, R, C); const int Rb = Epi::PERM ? ((R & ~31) + perm32(R & 31)) : R;
        voffA[i] = (unsigned)(R * K + C) * 2u; voffB[i] = (unsigned)(Rb * K + C) * 2u; }
    const size_t kstep = (size_t)(BK * 2);
    const size_t hstep = (size_t)HALF * K * 2;
    const size_t tstep = 2 * hstep;
    const unsigned ldsw = (unsigned)wid * 1024u;
    const int aoff = lds_byte(wr * 64 + fr, fq * 8), boff = lds_byte(wc * 32 + fr, fq * 8);
#define PG8_SA(b, h) (((b) * 2 + (h)) * HTB)
#define PG8_SB(b, h) ((4 + (b) * 2 + (h)) * HTB)
#define PG8_STAGE(bufoff, gbase, voff) do { _Pragma("unroll") for (int _i = 0; _i < 2; ++_i) \
        __builtin_amdgcn_global_load_lds((const unsigned*)((const char*)(gbase) + (voff)[_i]), (PG8_LAS unsigned*)(lds + (bufoff) + ldsw + _i * 8192), 16, 0, 0); } while (0)
#define PG8_LDA(dst, b, h) do { _Pragma("unroll") for (int m = 0; m < 4; ++m) _Pragma("unroll") for (int k = 0; k < 2; ++k) dst[m][k] = *(const PG8_LAS bf16x8*)(lds + PG8_SA(b, h) + aoff + m * 2048 + k * 1024); } while (0)
#define PG8_LDB(dst, b, h) do { _Pragma("unroll") for (int n = 0; n < 2; ++n) _Pragma("unroll") for (int k = 0; k < 2; ++k) dst[n][k] = *(const PG8_LAS bf16x8*)(lds + PG8_SB(b, h) + boff + n * 2048 + k * 1024); } while (0)
#define PG8_MMA(ai, bj, At, Bt) do { __builtin_amdgcn_s_setprio(1); _Pragma("unroll") for (int m = 0; m < 4; ++m) _Pragma("unroll") for (int n = 0; n < 2; ++n) _Pragma("unroll") for (int k = 0; k < 2; ++k) \
        acc[ai][bj][m][n] = __builtin_amdgcn_mfma_f32_16x16x32_bf16(Bt[n][k], At[m][k], acc[ai][bj][m][n], 0, 0, 0); __builtin_amdgcn_s_setprio(0); } while (0)
#define PG8_WAIT_V(n) asm volatile("s_waitcnt vmcnt(" #n ")" ::: "memory")
#define PG8_WAIT_L(n) asm volatile("s_waitcnt lgkmcnt(" #n ")" ::: "memory")
#define PG8_BAR __builtin_amdgcn_s_barrier()
#define PG8_SCHED __builtin_amdgcn_sched_barrier(0)
    Unit cur, nxt; int ui = 0;
    if (!S.next(0, cur)) return;
    f32x4 acc[2][2][4][2];
#pragma unroll
    for (int a = 0; a < 2; ++a)
#pragma unroll
        for (int b = 0; b < 2; ++b)
#pragma unroll
            for (int m = 0; m < 4; ++m)
#pragma unroll
                for (int n = 0; n < 2; ++n) acc[a][b][m][n] = (f32x4){0.f, 0.f, 0.f, 0.f};
    bf16x8 At[4][2], B0[2][2], B1[2][2];
    const char* cA = (const char*)g.A + (size_t)cur.pm * tstep; const char* cB = (const char*)g.Bt + (size_t)cur.e * g.estride + (size_t)cur.pn * tstep;
    S.a_ready(cur);
    if constexpr (SP2) {
        PG8_STAGE(PG8_SB(0, 0), cB, voffB); PG8_STAGE(PG8_SB(0, 1), cB + hstep, voffB); PG8_STAGE(PG8_SA(0, 0), cA, voffA); PG8_STAGE(PG8_SA(0, 1), cA + hstep, voffA);
        if (wr == 1) PG8_BAR;
        PG8_WAIT_V(2); PG8_BAR;
        PG8_STAGE(PG8_SB(1, 0), cB + kstep, voffB); PG8_STAGE(PG8_SA(1, 0), cA + kstep, voffA); PG8_STAGE(PG8_SB(1, 1), cB + hstep + kstep, voffB);
        PG8_WAIT_V(6); PG8_BAR;
    } else {
        PG8_STAGE(PG8_SB(0, 0), cB, voffB); PG8_STAGE(PG8_SA(0, 0), cA, voffA); PG8_STAGE(PG8_SB(0, 1), cB + hstep, voffB); PG8_STAGE(PG8_SA(0, 1), cA + hstep, voffA);
        if (wr == 1) PG8_BAR;
        PG8_WAIT_V(4); PG8_BAR;
        PG8_STAGE(PG8_SB(1, 0), cB + kstep, voffB); PG8_STAGE(PG8_SA(1, 0), cA + kstep, voffA); PG8_STAGE(PG8_SB(1, 1), cB + hstep + kstep, voffB);
        PG8_WAIT_V(6); PG8_BAR;
    }
    for (;;) {
        const bool has_next = S.next(ui + 1, nxt);
        const char* nA = has_next ? (const char*)g.A + (size_t)nxt.pm * tstep : cA; const char* nB = has_next ? (const char*)g.Bt + (size_t)nxt.e * g.estride + (size_t)nxt.pn * tstep : cB;
#pragma nounroll
        for (int t = 0; t < nt; t += 2) {
            const bool last = (t == nt - 2);
            const char* a1 = cA + (size_t)(t + 1) * kstep;
            const char* a2 = last ? nA : cA + (size_t)(t + 2) * kstep; const char* b2 = last ? nB : cB + (size_t)(t + 2) * kstep;
            const char* a3 = a2 + kstep; const char* b3 = b2 + kstep;
            if (last && has_next) S.a_ready(nxt);
            if constexpr (SP2) {
            PG8_LDB(B0, 0, 0); PG8_LDB(B1, 0, 1); PG8_SCHED; PG8_LDA(At, 0, 0); PG8_STAGE(PG8_SA(1, 1), a1 + hstep, voffA);
            PG8_WAIT_V(8); PG8_WAIT_L(0); PG8_BAR; PG8_MMA(0, 0, At, B0); PG8_MMA(0, 1, At, B1); PG8_BAR; PG8_SCHED;
            PG8_LDA(At, 0, 1); PG8_STAGE(PG8_SB(0, 0), b2, voffB); PG8_STAGE(PG8_SB(0, 1), b2 + hstep, voffB); PG8_STAGE(PG8_SA(0, 0), a2, voffA);
            PG8_WAIT_V(8); PG8_WAIT_L(0); PG8_BAR; PG8_MMA(1, 0, At, B0); PG8_MMA(1, 1, At, B1); PG8_BAR; PG8_SCHED;
            PG8_LDB(B0, 1, 0); PG8_LDB(B1, 1, 1); PG8_SCHED; PG8_LDA(At, 1, 0); PG8_STAGE(PG8_SA(0, 1), a2 + hstep, voffA);
            PG8_WAIT_V(8); PG8_WAIT_L(0); PG8_BAR; PG8_MMA(0, 0, At, B0); PG8_MMA(0, 1, At, B1); PG8_BAR; PG8_SCHED;
            PG8_LDA(At, 1, 1); PG8_STAGE(PG8_SB(1, 0), b3, voffB); PG8_STAGE(PG8_SB(1, 1), b3 + hstep, voffB); PG8_STAGE(PG8_SA(1, 0), a3, voffA);
            PG8_WAIT_V(8); PG8_WAIT_L(0); PG8_BAR; PG8_MMA(1, 0, At, B0); PG8_MMA(1, 1, At, B1); PG8_BAR; PG8_SCHED;
            } else {
            PG8_LDB(B0, 0, 0); PG8_SCHED; PG8_LDA(At, 0, 0); PG8_STAGE(PG8_SA(1, 1), a1 + hstep, voffA);
            PG8_WAIT_L(8); PG8_BAR; PG8_WAIT_L(0); PG8_MMA(0, 0, At, B0); PG8_BAR; PG8_SCHED;
            PG8_LDB(B1, 0, 1); PG8_STAGE(PG8_SB(0, 0), b2, voffB);
            PG8_BAR; PG8_WAIT_L(0); PG8_MMA(0, 1, At, B1); PG8_BAR;
            PG8_LDA(At, 0, 1); PG8_STAGE(PG8_SA(0, 0), a2, voffA);
            PG8_BAR; PG8_WAIT_L(0); PG8_MMA(1, 0, At, B0); PG8_BAR; PG8_SCHED;
            PG8_STAGE(PG8_SB(0, 1), b2 + hstep, voffB);
            PG8_WAIT_V(6); PG8_BAR; PG8_MMA(1, 1, At, B1); PG8_BAR;
            PG8_LDB(B0, 1, 0); PG8_SCHED; PG8_LDA(At, 1, 0); PG8_STAGE(PG8_SA(0, 1), a2 + hstep, voffA);
            PG8_WAIT_L(8); PG8_BAR; PG8_WAIT_L(0); PG8_MMA(0, 0, At, B0); PG8_BAR; PG8_SCHED;
            PG8_LDB(B1, 1, 1); PG8_STAGE(PG8_SB(1, 0), b3, voffB);
            PG8_BAR; PG8_WAIT_L(0); PG8_MMA(0, 1, At, B1); PG8_BAR;
            PG8_LDA(At, 1, 1); PG8_STAGE(PG8_SA(1, 0), a3, voffA);
            PG8_BAR; PG8_WAIT_L(0); PG8_MMA(1, 0, At, B0); PG8_BAR; PG8_SCHED;
            PG8_STAGE(PG8_SB(1, 1), b3 + hstep, voffB);
            PG8_WAIT_V(6); PG8_BAR; PG8_MMA(1, 1, At, B1); PG8_BAR;
            }
        }
        if constexpr (ALIGN_EPI) { if (wr == 0) PG8_BAR; }
        if constexpr (!Epi::AFTER_DRAIN) { E(acc, cur, wr, wc, fr, fq); S.done(cur); }
        if (!has_next) break;
#pragma unroll
        for (int a = 0; a < 2; ++a)
#pragma unroll
            for (int b = 0; b < 2; ++b)
#pragma unroll
                for (int m = 0; m < 4; ++m)
#pragma unroll
                    for (int n = 0; n < 2; ++n) acc[a][b][m][n] = (f32x4){0.f, 0.f, 0.f, 0.f};
        cur = nxt; cA = nA; cB = nB; ++ui;
        if constexpr (ALIGN_EPI) { if (wr == 1) PG8_BAR; }
    }
    PG8_WAIT_V(0);
    if constexpr (!ALIGN_EPI) { if (wr == 0) PG8_BAR; }
    PG8_BAR;
    if constexpr (Epi::AFTER_DRAIN) { E.fused(acc, cur, wr, wc, fr, fq, lds, wid, lane); S.done(cur); }
#undef PG8_SA
#undef PG8_SB
#undef PG8_STAGE
#undef PG8_LDA
#undef PG8_LDB
#undef PG8_MMA
#undef PG8_WAIT_V
#undef PG8_WAIT_L
#undef PG8_BAR
#undef PG8_SCHED
}
}

struct Args { const float* in[20]; float* out; unsigned char* ws; int ph_lo, ph_hi; };
struct Frame {
    LAS unsigned char* lds; volatile LAS unsigned* MISC; gu32* ctl; unsigned char* ws;
    int vcu, G;
};
#define F_TID ((int)threadIdx.x)
#define F_LANE ((int)(threadIdx.x & 63))
#define F_WAVE (__builtin_amdgcn_readfirstlane((int)(threadIdx.x >> 6)))

__device__ __forceinline__ int in_src_col(int n) {
    if (n < 640) return n;
    if (n < 2688) return n + 32;
    if (n < 2720) return n - 2688 + 640;
    if (n < 2792) return n;
    if (n < 2816) return -1;
    return n - 24;
}
struct TrDesc { const float* colptr; int ld, k0; bf16* WT; int Kd, destrow0; };
__device__ __forceinline__ void tr_load(const TrDesc& d, int lane, f32x4 (&v)[16]) {
    const int kr = lane >> 4;
#pragma unroll
    for (int it = 0; it < 16; ++it) { const int kk = 4 * it + kr; v[it] = (f32x4){0.f, 0.f, 0.f, 0.f}; if (d.colptr) v[it] = *(const GAS f32x4*)(d.colptr + (size_t)(d.k0 + kk) * d.ld); }
}
__device__ __forceinline__ void tr_store(const TrDesc& d, int lane, const f32x4 (&v)[16], LAS float* scr) {
    const int nq = lane & 15, kr = lane >> 4;
#pragma unroll
    for (int it = 0; it < 16; ++it) { const int kk = 4 * it + kr; LAS float* q = scr + kk * 65 + 4 * nq; q[0] = v[it].x; q[1] = v[it].y; q[2] = v[it].z; q[3] = v[it].w; }
    LDS_WAIT(); asm volatile("" ::: "memory");
    const int c = lane & 7;
#pragma unroll
    for (int j = 0; j < 8; ++j) { const int n = (lane >> 3) + 8 * j; const LAS float* q = scr + (8 * c) * 65 + n;
        v4u o; o.x = pk2(q[0 * 65], q[1 * 65]); o.y = pk2(q[2 * 65], q[3 * 65]); o.z = pk2(q[4 * 65], q[5 * 65]); o.w = pk2(q[6 * 65], q[7 * 65]);
        *(GAS v4u*)(d.WT + (size_t)(d.destrow0 + n) * d.Kd + d.k0 + 8 * c) = o; }
    LDS_WAIT(); asm volatile("" ::: "memory");
}
constexpr int CV_I0 = 16 * 76, CV_I1 = 6 * 12, CV_I2 = 4 * 16, CV_I3 = 8 * 16, CV_I4 = 8 * 16, CV_I5 = 16 * 16, CV_I6 = 32 * 16 * 8, CV_I7 = 32 * 4 * 16;
constexpr int CV_EARLY = CV_I0 + CV_I1 + CV_I2, CV_LATE = CV_I3 + CV_I4 + CV_I5 + CV_I6 + CV_I7, CV_QITEMS = CV_LATE / 16;
static_assert(CV_LATE % 16 == 0, "late conversion tiles come in queue items of 16");
__device__ __forceinline__ TrDesc conv_desc(const Args& A, unsigned char* ws, int it, int lane) {
    const int n4 = 4 * (lane & 15);
    int r = it;
    if (r < CV_I0) { const int kb = r / 76, nb = r % 76; const int col = in_src_col(64 * nb + n4);
        return TrDesc{col >= 0 ? A.in[2] + col : nullptr, NIN_SRC, 64 * kb, (bf16*)(ws + WS_WIN), 1024, 64 * nb}; } r -= CV_I0;
    if (r < CV_I1) { const int kb = r / 12, nb = r % 12; return TrDesc{A.in[4] + 64 * nb + n4, 768, 64 * kb, (bf16*)(ws + WS_WUQ), 384, 64 * nb}; } r -= CV_I1;
    if (r < CV_I2) { const int kb = r / 16, nb = r % 16; const int n = 64 * nb + n4;
        return TrDesc{n < 512 ? A.in[6] + n : A.in[7] + (n - 512), 512, 64 * kb, (bf16*)(ws + WS_WUKV), 256, 64 * nb}; } r -= CV_I2;
    if (r < CV_I3) { const int kb = r / 16, nb = r % 16; return TrDesc{A.in[8] + 64 * nb + n4, 1024, 64 * kb, (bf16*)(ws + WS_WOA), 512, 64 * nb}; } r -= CV_I3;
    if (r < CV_I4) { const int kb = r / 16, nb = r % 16; return TrDesc{A.in[9] + 64 * nb + n4, 1024, 64 * kb, (bf16*)(ws + WS_WOB), 512, 64 * nb}; } r -= CV_I4;
    if (r < CV_I5) { const int kb = r / 16, nb = r % 16; return TrDesc{A.in[10] + 64 * nb + n4, 1024, 64 * kb, (bf16*)(ws + WS_WOUT), 1024, 64 * nb}; } r -= CV_I5;
    if (r < CV_I6) { const int e = r / 128, rr = r % 128, kb = rr / 8, nb = rr % 8; const int n = 64 * nb + n4, pn = n >> 8, c = n & 255, col = 128 * pn + (c & 127);
        const float* src = ((c >> 7) ? A.in[17] : A.in[16]) + (size_t)e * 1024 * 256 + col;
        return TrDesc{src, 256, 64 * kb, (bf16*)(ws + WS_WGU) + (size_t)e * 512 * 1024, 1024, 64 * nb}; } r -= CV_I6;
    { const int e = r / 64, rr = r % 64, kb = rr / 16, nb = rr % 16;
        return TrDesc{A.in[18] + (size_t)e * 256 * 1024 + 64 * nb + n4, 1024, 64 * kb, (bf16*)(ws + WS_WD) + (size_t)e * 1024 * 256, 256, 64 * nb}; }
}
__device__ __forceinline__ void conv_tile(const Args& A, unsigned char* ws, int it, LAS float* scr, int lane) {
    const TrDesc d = conv_desc(A, ws, it, lane); f32x4 v[16]; tr_load(d, lane, v); tr_store(d, lane, v, scr);
}
__device__ __forceinline__ void conv_tile2(const Args& A, unsigned char* ws, int it0, int it1, LAS float* scr, int lane) {
    const TrDesc d0 = conv_desc(A, ws, it0, lane), d1 = conv_desc(A, ws, it1, lane); f32x4 v0[16], v1[16];
    tr_load(d0, lane, v0); tr_load(d1, lane, v1); tr_store(d0, lane, v0, scr); tr_store(d1, lane, v1, scr);
}
__device__ __forceinline__ void p0_prologue(Frame& F, const Args& A) {
    LAS float* scr = (LAS float*)(F.lds + F_WAVE * 16640);
    const int gw = F.vcu * NWAVES + F_WAVE, NGW = F.G * NWAVES, lane = F_LANE;
    unsigned char* ws = F.ws;
#ifdef CONV_IN_P0
    for (int it = gw; it < CV_EARLY + CV_LATE; it += NGW) conv_tile(A, ws, it, scr, lane);
#else
    for (int it = gw; it < CV_EARLY; it += NGW) conv_tile(A, ws, it, scr, lane);
#endif
    const float* x = A.in[0]; const float* g1 = A.in[1]; bf16* H = (bf16*)(ws + WS_H);
    for (int m0 = gw; m0 < T; m0 += 4 * NGW) {
        f32x4 v[4][4];
#pragma unroll
        for (int r = 0; r < 4; ++r) { const int m = min(m0 + r * NGW, T - 1); const GAS f32x4* xr = (const GAS f32x4*)(x + (size_t)m * D) + lane;
#pragma unroll
            for (int j = 0; j < 4; ++j) v[r][j] = xr[64 * j]; }
#pragma unroll
        for (int r = 0; r < 4; ++r) { const int m = m0 + r * NGW; float s = 0.f;
#pragma unroll
            for (int j = 0; j < 4; ++j) s += (v[r][j].x * v[r][j].x + v[r][j].y * v[r][j].y) + (v[r][j].z * v[r][j].z + v[r][j].w * v[r][j].w);
            const float rstd = 1.f / sqrtf(wave_sum(s) * (1.f / D) + EPS);
            if (m < T) { GAS v2u* o8 = (GAS v2u*)(H + (size_t)m * D) + lane;
#pragma unroll
                for (int j = 0; j < 4; ++j) { const f32x4 g = *((const GAS f32x4*)g1 + lane + 64 * j); const f32x4 y = v[r][j] * rstd * g; v2u w; w.x = pk2(y.x, y.y); w.y = pk2(y.z, y.w); o8[64 * j] = w; } } }
    }
    f32x2* rope = (f32x2*)(ws + WS_ROPE);
    for (int idx = (F.vcu * NTHR + F_TID); idx < SEQ * 16; idx += F.G * NTHR) {
        const int pos = idx >> 4, i = idx & 15;
        const double REV[16] = {0.15915494309189535, 0.0700865215877985, 0.03086376340470123, 0.013591370636193905, 0.005985185712713705, 0.002635675898667414, 0.001160663641240061, 0.0005111175045375439,
                                0.00022507907903927653, 9.911730936901935e-05, 4.364795279280289e-05, 1.9221100684944863e-05, 8.464330808241401e-06, 3.727408601915352e-06, 1.6414262627950345e-06, 7.228293068832865e-07};
        double rv = 0.0;
#pragma unroll
        for (int k = 0; k < 16; ++k) rv = (i == k) ? REV[k] : rv;
        double t = (double)pos * rv; t -= __builtin_floor(t);
        const float tf = (float)t;
        rope[idx] = (f32x2){__builtin_amdgcn_cosf(tf), __builtin_amdgcn_sinf(tf)};
    }
}

__device__ __forceinline__ void p2a_norms(Frame& F, const Args& A) {
    const int gw = F.vcu * NWAVES + F_WAVE, NGW = F.G * NWAVES, lane = F_LANE;
    bf16* CQ = (bf16*)(F.ws + WS_CQ); bf16* CKV = (bf16*)(F.ws + WS_CKV);
    const float* gq = A.in[3]; const float* gkv = A.in[5];
    for (int m = gw; m < T; m += NGW) {
        {
            GAS unsigned* p = (GAS unsigned*)(CQ + (size_t)m * 384) + lane; unsigned w[3]; float s = 0.f;
#pragma unroll
            for (int j = 0; j < 3; ++j) { w[j] = p[64 * j]; const float a = bflo(w[j]), b = bfhi(w[j]); s += a * a + b * b; }
            const float rstd = 1.f / sqrtf(wave_sum(s) * (1.f / 384.f) + EPS);
#pragma unroll
            for (int j = 0; j < 3; ++j) { const f32x2 g = *((const GAS f32x2*)gq + lane + 64 * j); p[64 * j] = pk2(bflo(w[j]) * rstd * g.x, bfhi(w[j]) * rstd * g.y); }
        }
        {
            GAS v2u* p = (GAS v2u*)(CKV + (size_t)m * 256) + lane; const v2u w = *p;
            const float a = bflo(w.x), b = bfhi(w.x), c = bflo(w.y), d = bfhi(w.y);
            const float rstd = 1.f / sqrtf(wave_sum(a * a + b * b + c * c + d * d) * (1.f / 256.f) + EPS);
            const f32x4 g = *((const GAS f32x4*)gkv + lane); v2u o; o.x = pk2(a * rstd * g.x, b * rstd * g.y); o.y = pk2(c * rstd * g.z, d * rstd * g.w); *p = o;
        }
    }
}

__device__ __forceinline__ constexpr int crow(int r, int hi) { return (r & 3) + 8 * (r >> 2) + 4 * hi; }
constexpr float ATT_THR = 8.f;
__device__ __forceinline__ float att_mask(float p, unsigned w, int bit) { int mk; unsigned r;
    asm("v_bfe_i32 %0, %1, %2, 1" : "=v"(mk) : "v"(w), "i"(bit)); r = __builtin_bit_cast(unsigned, p) & (unsigned)mk; return __builtin_bit_cast(float, r); }
struct AttnP { const bf16 *Q, *K, *K2, *V; bf16* O; const unsigned* BM; };
template <bool MLA> __device__ __forceinline__ void attn_unit(LAS unsigned char* L, int b, int h, int qb, const AttnP& P, int tid, int lane, int wave) {
    constexpr int DK = MLA ? 96 : 64, KP = DK * 2 + 16, NS = DK / 16, CPR = DK / 8;
    constexpr int QPITCH = MLA ? 768 : 512, VP = 192, KBUF = 64 * KP, VBUF = 64 * VP;
    const int r32 = lane & 31, hi = lane >> 5;
    const size_t rowb = (size_t)b * SEQ;
    const int qrow = qb * 256 + wave * 32 + r32;
    bf16x8 qf[NS];
    { const bf16* qp = P.Q + (rowb + qrow) * QPITCH + h * DK;
#pragma unroll
      for (int s = 0; s < NS; ++s) qf[s] = *(const bf16x8*)(qp + 16 * s + 8 * hi); }
    const int NT = 4 * qb + 4, my_nt = 4 * qb + (wave >> 1) + 1;
    const int kid0 = tid, kid1 = tid + NTHR;
    const int kr0 = kid0 / CPR, kc0 = kid0 % CPR, kr1 = kid1 / CPR, kc1 = kid1 % CPR; const bool has1 = MLA && (kid1 < 64 * CPR);
    const int vr = tid >> 3, vc = tid & 7;
    v4u kreg0, kreg1 = (v4u){0u, 0u, 0u, 0u}, vreg;
#define ATT_KSRC(t, kr, kc) (MLA ? ((kc) < 8 ? (const v4u*)(P.K + (rowb + 64 * (t) + (kr)) * 512 + h * 64 + 8 * (kc)) : (const v4u*)(P.K2 + (rowb + 64 * (t) + (kr)) * 32 + 8 * ((kc) - 8))) \
                                 : (const v4u*)(P.K + (rowb + 64 * (t) + (kr)) * 512 + h * 64 + 8 * (kc)))
#define ATT_LOAD(t) do { kreg0 = *ATT_KSRC(t, kr0, kc0); if (has1) kreg1 = *ATT_KSRC(t, kr1, kc1); vreg = *(const v4u*)(P.V + (rowb + 64 * (t) + vr) * 512 + h * 64 + 8 * vc); } while (0)
#define ATT_WRITE(buf) do { *(LAS v4u*)(L + (buf) * KBUF + kr0 * KP + kc0 * 16) = kreg0; if (has1) *(LAS v4u*)(L + (buf) * KBUF + kr1 * KP + kc1 * 16) = kreg1; \
                            *(LAS v4u*)(L + 2 * KBUF + (buf) * VBUF + vr * VP + vc * 16) = vreg; } while (0)
    float mhat = 0.f, l = 0.f; f32x16 o0, o1, negm;
#pragma unroll
    for (int i = 0; i < 16; ++i) { o0[i] = 0.f; o1[i] = 0.f; negm[i] = 0.f; }
    const int g16 = lane >> 4, qq = (lane & 15) >> 2, pp = lane & 3;
    const int vlane = (4 * hi + qq) * VP + (16 * (g16 & 1) + 4 * pp) * 2;
    ATT_LOAD(0); ATT_WRITE(0); __syncthreads();
    unsigned wn0 = 0xffffffffu, wn1 = 0xffffffffu;
    const unsigned* bmq = MLA ? nullptr : P.BM + (size_t)b * 256 * SEQ + qrow;
    if (!MLA) { wn0 = bmq[0]; wn1 = bmq[SEQ]; }
    for (int t = 0; t < NT; ++t) {
        const int buf = t & 1;
        unsigned w0 = wn0 >> (4 * hi), w1 = wn1 >> (4 * hi);
        if (t + 1 < NT) { ATT_LOAD(t + 1); if (!MLA) { wn0 = bmq[(size_t)(2 * t + 2) * SEQ]; wn1 = bmq[(size_t)(2 * t + 3) * SEQ]; } }
        if (t < my_nt) {
            const LAS unsigned char* Kb = L + buf * KBUF; const LAS unsigned char* Vb = L + 2 * KBUF + buf * VBUF;
            f32x16 s0, s1;
            bf16x8 ka[NS][2];
#pragma unroll
            for (int s = 0; s < NS; ++s) { ka[s][0] = *(const LAS bf16x8*)(Kb + r32 * KP + s * 32 + hi * 16); ka[s][1] = *(const LAS bf16x8*)(Kb + (32 + r32) * KP + s * 32 + hi * 16); }
            __builtin_amdgcn_sched_barrier(0);
#pragma unroll
            for (int s = 0; s < NS; ++s) {
                s0 = __builtin_amdgcn_mfma_f32_32x32x16_bf16(ka[s][0], qf[s], s == 0 ? negm : s0, 0, 0, 0);
                s1 = __builtin_amdgcn_mfma_f32_32x32x16_bf16(ka[s][1], qf[s], s == 0 ? negm : s1, 0, 0, 0);
            }
            s16x4 vf[4][4];
#pragma unroll
            for (int ks = 0; ks < 4; ++ks) { const LAS unsigned char* vp = Vb + ks * 16 * VP + vlane;
                vf[ks][0] = __builtin_bit_cast(s16x4, __builtin_amdgcn_ds_read_tr16_b64_v4i16((LAS s16x4*)(vp)));
                vf[ks][1] = __builtin_bit_cast(s16x4, __builtin_amdgcn_ds_read_tr16_b64_v4i16((LAS s16x4*)(vp + 8 * VP)));
                vf[ks][2] = __builtin_bit_cast(s16x4, __builtin_amdgcn_ds_read_tr16_b64_v4i16((LAS s16x4*)(vp + 64)));
                vf[ks][3] = __builtin_bit_cast(s16x4, __builtin_amdgcn_ds_read_tr16_b64_v4i16((LAS s16x4*)(vp + 8 * VP + 64))); }
            __builtin_amdgcn_sched_barrier(0);
            float mx = fmaxf(fmaxf(s0[0], s0[1]), s1[0]);
#pragma unroll
            for (int i = 2; i < 16; i += 2) mx = fmaxf(fmaxf(mx, s0[i]), s0[i + 1]);
#pragma unroll
            for (int i = 1; i < 15; i += 2) mx = fmaxf(fmaxf(mx, s1[i]), s1[i + 1]);
            mx = fmaxf(mx, s1[15]);
            mx = fmaxf(mx, __shfl_xor(mx, 32));
            if (t == 0 || __any(mx > ATT_THR)) {
                const float dl = (t == 0) ? mx : fmaxf(mx, 0.f), f = (t == 0) ? 1.f : __builtin_amdgcn_exp2f(-dl);
                mhat += dl; l *= f;
#pragma unroll
                for (int i = 0; i < 16; ++i) { s0[i] -= dl; s1[i] -= dl; o0[i] *= f; o1[i] *= f; negm[i] = -mhat; }
            }
            float rs = 0.f;
#pragma unroll
            for (int i = 0; i < 16; ++i) {
                float p0 = __builtin_amdgcn_exp2f(s0[i]), p1 = __builtin_amdgcn_exp2f(s1[i]);
                if (!MLA) { p0 = att_mask(p0, w0, crow(i, 0)); p1 = att_mask(p1, w1, crow(i, 0)); }
                s0[i] = p0; s1[i] = p1; rs += p0 + p1; }
            l += rs;
            bf16x8 pf[4];
#pragma unroll
            for (int ks = 0; ks < 4; ++ks) { v4u w;
#pragma unroll
                for (int j = 0; j < 4; ++j) { const float a = (ks < 2) ? s0[8 * (ks & 1) + 2 * j] : s1[8 * (ks & 1) + 2 * j], c = (ks < 2) ? s0[8 * (ks & 1) + 2 * j + 1] : s1[8 * (ks & 1) + 2 * j + 1]; w[j] = pk2(a, c); }
                pf[ks] = __builtin_bit_cast(bf16x8, w); }
#pragma unroll
            for (int ks = 0; ks < 4; ++ks) {
                const bf16x8 A0 = __builtin_shufflevector(vf[ks][0], vf[ks][1], 0, 1, 2, 3, 4, 5, 6, 7);
                const bf16x8 A1 = __builtin_shufflevector(vf[ks][2], vf[ks][3], 0, 1, 2, 3, 4, 5, 6, 7);
                o0 = __builtin_amdgcn_mfma_f32_32x32x16_bf16(A0, pf[ks], o0, 0, 0, 0);
                o1 = __builtin_amdgcn_mfma_f32_32x32x16_bf16(A1, pf[ks], o1, 0, 0, 0);
            }
        }
        if (t + 1 < NT) ATT_WRITE(buf ^ 1);
        __syncthreads();
    }
    l += __shfl_xor(l, 32);
    const float inv = 1.f / l;
    bf16* op = P.O + (rowb + qrow) * 512 + h * 64 + 4 * hi;
#pragma unroll
    for (int g = 0; g < 4; ++g) {
        v2u w; w.x = pk2(o0[4 * g] * inv, o0[4 * g + 1] * inv); w.y = pk2(o0[4 * g + 2] * inv, o0[4 * g + 3] * inv); *(v2u*)(op + 8 * g) = w;
        v2u z; z.x = pk2(o1[4 * g] * inv, o1[4 * g + 1] * inv); z.y = pk2(o1[4 * g + 2] * inv, o1[4 * g + 3] * inv); *(v2u*)(op + 32 + 8 * g) = z;
    }
#undef ATT_KSRC
#undef ATT_LOAD
#undef ATT_WRITE
}

namespace attn_body {
using bf16=__hip_bfloat16;
using bf16x8=__attribute__((ext_vector_type(8)))short;
using s16x4=__attribute__((ext_vector_type(4)))short;
using f32x16=__attribute__((ext_vector_type(16)))float;
using u32x4=__attribute__((ext_vector_type(4)))unsigned;
constexpr int BATCH=2,NHEAD=8,SEQ=8192,D=64,DM=NHEAD*D;
constexpr int NW=8,QBLK=32,QB=QBLK*NW,KVBLK=64,NQB=SEQ/QB;
constexpr int ATTN_PITCH=DM, ATTN_UNIT_ROWS=QB;
__device__ __forceinline__ int crow(int r,int hi){return (r&3)+8*(r>>2)+4*hi;}
#define SBAR() __builtin_amdgcn_sched_barrier(0)
__device__ __forceinline__ void cmask(f32x16&p0,f32x16&p1,int jb,int wid){
  if(jb>(wid>>1)){
    #pragma unroll
    for(int r=0;r<16;++r){p0[r]=-INFINITY;p1[r]=-INFINITY;} }
}
__device__ __forceinline__ float amask(float p,unsigned w,int bit){ int mk; asm("v_bfe_i32 %0, %1, %2, 1":"=v"(mk):"v"(w),"i"(bit)); return __builtin_bit_cast(float,__builtin_bit_cast(unsigned,p)&(unsigned)mk); }
__device__ __forceinline__ void glds4(const void*gsrc,unsigned lds_dst){unsigned keep;
  asm volatile("s_mov_b32 %0, m0\n\ts_mov_b32 m0, %2\n\ts_nop 0\n\tglobal_load_lds_dword %1, off\n\ts_mov_b32 m0, %0":"=&s"(keep):"v"(gsrc),"s"(lds_dst):"memory");}

constexpr int NSLOT=3, SLOTB=8192, KSLOTMAX=12288;
constexpr int LDS_K=0, LDS_V=NSLOT*KSLOTMAX, LDS_WS=LDS_V+NSLOT*SLOTB, LDS_OST=LDS_WS+NW*64*4, LDS_BM=LDS_OST+NW*4096, LDS_BYTES=LDS_BM+NW*512;
constexpr float C2=0.125f*1.4426950408889634f;
__device__ __forceinline__ void glds16(const void*gsrc,unsigned lds_dst){unsigned keep;
  asm volatile("s_mov_b32 %0, m0\n\ts_mov_b32 m0, %2\n\ts_nop 0\n\tglobal_load_lds_dwordx4 %1, off\n\ts_mov_b32 m0, %0":"=&s"(keep):"v"(gsrc),"s"(lds_dst):"memory");}
__device__ __forceinline__ float max3f(float a,float b,float c){float r;asm("v_max3_f32 %0, %1, %2, %3":"=v"(r):"v"(a),"v"(b),"v"(c));return r;}
__device__ __forceinline__ float max2f(float a,float b){float r;asm("v_max_f32_e32 %0, %1, %2":"=v"(r):"v"(a),"v"(b));return r;}
__device__ __forceinline__ float fadd_s(float a,float b){float r;asm("v_add_f32_e32 %0, %1, %2":"=v"(r):"v"(a),"v"(b));return r;}
__device__ __forceinline__ float fsub_s(float a,float b){float r;asm("v_sub_f32_e32 %0, %1, %2":"=v"(r):"v"(a),"v"(b));return r;}
typedef float f32x2_t __attribute__((ext_vector_type(2))); typedef __bf16 bf16x2_t __attribute__((ext_vector_type(2)));
__device__ __forceinline__ unsigned cvtpk_s(float lo,float hi){f32x2_t v={lo,hi};bf16x2_t b=__builtin_convertvector(v,bf16x2_t);return __builtin_bit_cast(unsigned,b);}
#define WAIT_BAR(N) asm volatile("s_waitcnt vmcnt(" #N ") lgkmcnt(0)\n\ts_barrier":::"memory")

template<int NKS> __device__ __forceinline__ void qkt(f32x16&p0,f32x16&p1,const char*Kslot,const bf16x8*qr,const f32x16&negm,int r32,int hi){
  const char*kb=Kslot+hi*1024+r32*16;
  #pragma unroll
  for(int d0=0;d0<NKS;++d0){
    const bf16x8 b0=*reinterpret_cast<const bf16x8*>(kb+d0*2048);
    const bf16x8 b1=*reinterpret_cast<const bf16x8*>(kb+d0*2048+512);
    if(d0==0){p0=__builtin_amdgcn_mfma_f32_32x32x16_bf16(b0,qr[0],negm,0,0,0);p1=__builtin_amdgcn_mfma_f32_32x32x16_bf16(b1,qr[0],negm,0,0,0);}
    else{p0=__builtin_amdgcn_mfma_f32_32x32x16_bf16(b0,qr[d0],p0,0,0,0);p1=__builtin_amdgcn_mfma_f32_32x32x16_bf16(b1,qr[d0],p1,0,0,0);}}
}
typedef __attribute__((address_space(3))) const char* lds_cptr;
typedef short v4i16_t __attribute__((ext_vector_type(4)));
__device__ __forceinline__ void kload8(bf16x8*kf,lds_cptr kp){
  kf[0]=*(const __attribute__((address_space(3))) bf16x8*)(kp);      kf[1]=*(const __attribute__((address_space(3))) bf16x8*)(kp+512);
  kf[2]=*(const __attribute__((address_space(3))) bf16x8*)(kp+2048); kf[3]=*(const __attribute__((address_space(3))) bf16x8*)(kp+2560);
  kf[4]=*(const __attribute__((address_space(3))) bf16x8*)(kp+4096); kf[5]=*(const __attribute__((address_space(3))) bf16x8*)(kp+4608);
  kf[6]=*(const __attribute__((address_space(3))) bf16x8*)(kp+6144); kf[7]=*(const __attribute__((address_space(3))) bf16x8*)(kp+6656);
}
__device__ __forceinline__ void kload2(bf16x8*kf,lds_cptr kp,int j){ kf[2*j]=*(const __attribute__((address_space(3))) bf16x8*)(kp+j*2048); kf[2*j+1]=*(const __attribute__((address_space(3))) bf16x8*)(kp+j*2048+512); }
__device__ __forceinline__ s16x4 vtr(lds_cptr p){ return __builtin_bit_cast(s16x4,__builtin_amdgcn_ds_read_tr16_b64_v4i16((__attribute__((address_space(3))) v4i16_t*)p)); }
__device__ __forceinline__ float rowmax(const f32x16&p0,const f32x16&p1){
  float a=max3f(p0[0],p0[1],p1[0]),b=max3f(p0[2],p0[3],p1[1]);a=max3f(a,p1[2],p1[3]);
  #pragma unroll
  for(int r=4;r<16;r+=4){a=max3f(a,p0[r],p0[r+1]);b=max3f(b,p0[r+2],p0[r+3]);a=max3f(a,p1[r],p1[r+1]);b=max3f(b,p1[r+2],p1[r+3]);}
  const float m=max2f(a,b);
  auto rr=__builtin_amdgcn_permlane32_swap(__float_as_uint(m),__float_as_uint(m),false,false);
  return max2f(__uint_as_float(rr[0]),__uint_as_float(rr[1]));
}
__device__ __forceinline__ void pv(f32x16*o,int vb,bf16x8 pa0,bf16x8 pa1,bf16x8 pa2,bf16x8 pa3){
  #pragma unroll
  for(int d0=0;d0<2;++d0){s16x4 lo[4],hi[4];
    #pragma unroll
    for(int ks=0;ks<4;++ks){
      asm volatile("ds_read_b64_tr_b16 %0,%1 offset:%c2":"=&v"(lo[ks]):"v"(vb),"i"(d0*4096+ks*1024):"memory");
      asm volatile("ds_read_b64_tr_b16 %0,%1 offset:%c2":"=&v"(hi[ks]):"v"(vb),"i"(d0*4096+ks*1024+512):"memory");}
    asm volatile("s_waitcnt lgkmcnt(0)":::"memory");SBAR();
    #define PK(k) (bf16x8){lo[k][0],lo[k][1],lo[k][2],lo[k][3],hi[k][0],hi[k][1],hi[k][2],hi[k][3]}
    o[d0]=__builtin_amdgcn_mfma_f32_32x32x16_bf16(pa0,PK(0),o[d0],0,0,0);
    o[d0]=__builtin_amdgcn_mfma_f32_32x32x16_bf16(pa1,PK(1),o[d0],0,0,0);
    o[d0]=__builtin_amdgcn_mfma_f32_32x32x16_bf16(pa2,PK(2),o[d0],0,0,0);
    o[d0]=__builtin_amdgcn_mfma_f32_32x32x16_bf16(pa3,PK(3),o[d0],0,0,0);
    #undef PK
  }
}

#ifndef ATTN_STORE16
#define ATTN_STORE16(p,v) (*(u32x4*)(p)=(v))
#endif
template<int THRL,bool MLA> __device__ __forceinline__ void attn_unit(int b,int h,int qb,const bf16*Q,const bf16*__restrict__ K,const bf16*__restrict__ K2,const bf16*__restrict__ V,bf16*O,const unsigned*BMg,char*shm,int tid){
  constexpr int NKS=MLA?6:4, QP=MLA?768:512, DQ=MLA?96:64;
  const int lane=tid&63,r32=lane&31,hi=lane>>5; const int wid=__builtin_amdgcn_readfirstlane(tid>>6);
  const long rowbase=(long)b*SEQ; const int q0=qb*QB;
  const bf16*Qw=Q+(rowbase+q0+wid*QBLK)*QP+h*DQ;
  const bf16*Kh=K+rowbase*DM+h*D,*Vh=V+rowbase*DM+h*D;
  const unsigned lds0=(unsigned)(uintptr_t)shm;
  float*wsf=(float*)(shm+LDS_WS)+wid*64;
  const bf16*ksrc=Kh+(long)lane*DM+wid*8;
  const bf16*vsrc=Vh+(long)(16*(wid&3)+(lane>>2))*DM+(wid>>2)*32+(lane&3)*8;
  const unsigned kdst=lds0+LDS_K+wid*1024, vdst=lds0+LDS_V+wid*1024;
  const bf16*ksrc2=MLA?K2+(rowbase+lane)*32+(wid&3)*8:nullptr; const unsigned kdst2=lds0+LDS_K+(8+(wid&3))*1024;
  #define KO(sl) (MLA?(sl)+((sl)>>1):(sl))
  #define DMA_K(t,slot) do{ glds16(ksrc+(long)(t)*KVBLK*DM,(unsigned)__builtin_amdgcn_readfirstlane(kdst+KO(slot))); \
    if constexpr(MLA) glds16(ksrc2+(long)(t)*KVBLK*32,(unsigned)__builtin_amdgcn_readfirstlane(kdst2+KO(slot))); }while(0)
  #define DMA_V(t,slot) glds16(vsrc+(long)(t)*KVBLK*DM,(unsigned)__builtin_amdgcn_readfirstlane(vdst+(slot)))
  const unsigned*bmsrc=BMg+(long)b*256*SEQ+(long)hi*SEQ+q0+wid*QBLK+r32; const unsigned bmdst=lds0+LDS_BM+wid*512;
  const __attribute__((address_space(3))) unsigned*bmw=(const __attribute__((address_space(3))) unsigned*)((lds_cptr)shm+LDS_BM+wid*512);
  #define DMA_BM(t) if constexpr(!MLA) glds4(bmsrc+(long)(t)*2*SEQ,(unsigned)__builtin_amdgcn_readfirstlane(bmdst+((t)&1)*256))
  #define VMW(N) asm volatile("s_waitcnt vmcnt(" #N ")":::"memory")
  #define BMWAIT(t) do{ if constexpr(!MLA){ if((t)+3<NT){VMW(5);} else if((t)+2<NT){VMW(4);} else if((t)+1<NT){VMW(3);} else {VMW(1);} } }while(0)
  const int vb0=(int)(lds0+LDS_V)+((lane>>4)&1)*32+(lane&3)*8+(4*hi+((lane&15)>>2))*64;
  const char*Kbase=shm+LDS_K; bf16x8 kf[2*NKS];
  const lds_cptr shm3=(lds_cptr)shm; const lds_cptr kp0=shm3+LDS_K+hi*1024+r32*16; const lds_cptr vp0=shm3+LDS_V+((lane>>4)&1)*32+(lane&3)*8+(4*hi+((lane&15)>>2))*64;
  const int NT=(q0+QB)/KVBLK;
  DMA_BM(0);DMA_K(0,0);DMA_V(0,0);DMA_K(1,SLOTB);
  bf16x8 qr[NKS];
  #pragma unroll
  for(int d0=0;d0<NKS;++d0)qr[d0]=*reinterpret_cast<const bf16x8*>(&Qw[(long)r32*QP+d0*16+hi*8]);
  float mhat=0.f,l_reg=0.f;f32x16 o[2];o[0]=f32x16{};o[1]=f32x16{};f32x16 negm=f32x16{};asm volatile("":"+v"(negm));
  const int qrel=wid*QBLK+r32;
  #define CMASK(P0,P1,t) do{int jb_=(t)-(NT-4); if(jb_>=0)cmask(P0,P1,jb_,wid);}while(0)
  bool resc=false;
  #define START(P0,P1) do{ const float rm=rowmax(P0,P1); resc=false; \
    { const float dl=rm; mhat=fadd_s(mhat,dl); \
      _Pragma("unroll") for(int r=0;r<16;++r){P0[r]=fsub_s(P0[r],dl);P1[r]=fsub_s(P1[r],dl);} \
      _Pragma("unroll") for(int r=0;r<16;++r)negm[r]=-mhat; asm volatile("":"+v"(negm)); } \
    _Pragma("unroll") for(int r=0;r<16;++r)P0[r]=__builtin_amdgcn_exp2f(P0[r]); }while(0)
  #define RESC() do{ if(resc){ asm volatile("s_waitcnt lgkmcnt(0)":::"memory"); \
      _Pragma("unroll") for(int d_=0;d_<2;++d_) _Pragma("unroll") for(int r=0;r<16;++r)o[d_][r]*=wsf[crow(r,hi)]; } }while(0)
  f32x16 pA0,pA1,pB0,pB1;
  int sl_prev=0,sl_cur=0,sl_next=SLOTB;
  #define ROT() do{sl_prev=sl_cur;sl_cur=sl_next;sl_next=(sl_next==(NSLOT-1)*SLOTB)?0:sl_next+SLOTB;}while(0)
  DMA_K(2,2*SLOTB);
  if constexpr(MLA){WAIT_BAR(5);}else{WAIT_BAR(3);}
  qkt<NKS>(pA0,pA1,Kbase,qr,negm,r32,hi);asm volatile("s_nop 15\n\ts_nop 7":"+v"(pA0),"+v"(pA1));CMASK(pA0,pA1,0);
  START(pA0,pA1);
  _Pragma("unroll") for(int r=0;r<16;++r)pA1[r]=__builtin_amdgcn_exp2f(pA1[r]);
  if constexpr(!MLA){ const unsigned w0_=bmw[r32]>>(4*hi), w1_=bmw[32+r32]>>(4*hi);
    _Pragma("unroll") for(int r=0;r<16;++r){pA0[r]=amask(pA0[r],w0_,(r&3)+8*(r>>2));pA1[r]=amask(pA1[r],w1_,(r&3)+8*(r>>2));} }
  WAIT_BAR(0);
  DMA_BM(1);DMA_K(3,0);DMA_V(1,SLOTB);
  ROT();
  _Pragma("unroll") for(int j=0;j<NKS;++j)kload2(kf,kp0+KO(sl_cur),j);
  WAIT_BAR(3);
  s16x4 vlo[8],vhi[8]; u32x4 pw0,pw1,pw2,pw3;
  #define PKW(P,B) cvtpk_s(P[B],P[B+1])
  #define PAF(k) __builtin_bit_cast(bf16x8,pw##k)
  #define VFR(i) (bf16x8){vlo[i][0],vlo[i][1],vlo[i][2],vlo[i][3],vhi[i][0],vhi[i][1],vhi[i][2],vhi[i][3]}
  #define PIN(x) asm volatile("":"+v"(x))
  #define MX3(a,b,c) __builtin_fmaxf(__builtin_fmaxf((a),(b)),(c))
  #define GAPA(MF,A0,A1,A2,A3,W0,W1,PW) do{ MF; sacc+=A0; sacc+=A1; sacc+=A2; sacc+=A3; PIN(sacc); W0; W1; PIN(PW); SBAR(); }while(0)
  #define EX(v) __builtin_amdgcn_exp2f(v)
  #define CR_(r) (((r)&3)+8*((r)>>2))
  #define GAPB(MF,X,B,W) do{ MF; X[B]=EX(X[B]); X[B+1]=EX(X[B+1]); X[B+2]=EX(X[B+2]); X[B+3]=EX(X[B+3]); \
    if constexpr(!MLA){ X[B]=amask(X[B],W,CR_(B)); X[B+1]=amask(X[B+1],W,CR_(B+1)); X[B+2]=amask(X[B+2],W,CR_(B+2)); X[B+3]=amask(X[B+3],W,CR_(B+3)); } PIN(X); SBAR(); }while(0)
  #define VRD(i) do{ vlo[i]=vtr(vp_+(((i)>>2)*4096+((i)&3)*1024)); vhi[i]=vtr(vp_+(((i)>>2)*4096+((i)&3)*1024+512)); }while(0)
  #define KRD(G,j) do{ if((j)<NKS){ if(G){ kload2(kf,kp0+KO(sl_next),j); SBAR(); } } }while(0)
  #define STEP(C0,C1,P0,P1,t,GK,GV,GL) do{ SBAR(); \
    const lds_cptr vp_=vp0+sl_prev; \
    VRD(0); SBAR(); float sacc=(P0[0]+P0[1]); \
    GAPA(C0=__builtin_amdgcn_mfma_f32_32x32x16_bf16(kf[0],qr[0],negm,0,0,0), P0[2],P0[3],P0[4],P0[5],     pw0[0]=PKW(P0,0), pw0[1]=PKW(P0,2), pw0); \
    VRD(4); SBAR(); GAPA(C1=__builtin_amdgcn_mfma_f32_32x32x16_bf16(kf[1],qr[0],negm,0,0,0), P0[6],P0[7],P0[8],P0[9],     pw0[2]=PKW(P0,4), pw0[3]=PKW(P0,6), pw0); \
    VRD(1); SBAR(); GAPA(C0=__builtin_amdgcn_mfma_f32_32x32x16_bf16(kf[2],qr[1],C0,0,0,0),   P0[10],P0[11],P0[12],P0[13], pw1[0]=PKW(P0,8), pw1[1]=PKW(P0,10), pw1); \
    VRD(5); SBAR(); GAPA(C1=__builtin_amdgcn_mfma_f32_32x32x16_bf16(kf[3],qr[1],C1,0,0,0),   P0[14],P0[15],P1[0],P1[1],   pw1[2]=PKW(P0,12),pw1[3]=PKW(P0,14), pw1); \
    VRD(2); SBAR(); GAPA(C0=__builtin_amdgcn_mfma_f32_32x32x16_bf16(kf[4],qr[2],C0,0,0,0),   P1[2],P1[3],P1[4],P1[5],     pw2[0]=PKW(P1,0), pw2[1]=PKW(P1,2), pw2); \
    VRD(6); SBAR(); GAPA(C1=__builtin_amdgcn_mfma_f32_32x32x16_bf16(kf[5],qr[2],C1,0,0,0),   P1[6],P1[7],P1[8],P1[9],     pw2[2]=PKW(P1,4), pw2[3]=PKW(P1,6), pw2); \
    VRD(3); SBAR(); GAPA(C0=__builtin_amdgcn_mfma_f32_32x32x16_bf16(kf[6],qr[3],C0,0,0,0),   P1[10],P1[11],P1[12],P1[13], pw3[0]=PKW(P1,8), pw3[1]=PKW(P1,10), pw3); \
    VRD(7); SBAR(); GAPA(C1=__builtin_amdgcn_mfma_f32_32x32x16_bf16(kf[7],qr[3],C1,0,0,0),   P1[14],P1[15],0.f,0.f,       pw3[2]=PKW(P1,12),pw3[3]=PKW(P1,14), pw3); \
    if constexpr(MLA){ C0=__builtin_amdgcn_mfma_f32_32x32x16_bf16(kf[8],qr[4],C0,0,0,0); C1=__builtin_amdgcn_mfma_f32_32x32x16_bf16(kf[9],qr[4],C1,0,0,0); \
      C0=__builtin_amdgcn_mfma_f32_32x32x16_bf16(kf[10],qr[5],C0,0,0,0); C1=__builtin_amdgcn_mfma_f32_32x32x16_bf16(kf[11],qr[5],C1,0,0,0); SBAR(); } \
    l_reg+=sacc; \
    if(GV){DMA_BM((t)+1);} if(GK){DMA_K((t)+3,sl_cur);} if(GV){DMA_V((t)+1,sl_next);} \
    CMASK(C0,C1,t); \
    { float a=MX3(C0[0],C0[1],C1[0]),b=MX3(C0[2],C0[3],C1[1]); a=MX3(a,C1[2],C1[3]); \
      _Pragma("unroll") for(int r=4;r<16;r+=4){a=MX3(a,C0[r],C0[r+1]);b=MX3(b,C0[r+2],C0[r+3]);a=MX3(a,C1[r],C1[r+1]);b=MX3(b,C1[r+2],C1[r+3]);} \
      float rm=__builtin_fmaxf(a,b); { auto rr=__builtin_amdgcn_permlane32_swap(__float_as_uint(rm),__float_as_uint(rm),false,false); rm=__builtin_fmaxf(__uint_as_float(rr[0]),__uint_as_float(rr[1])); } \
      resc=false; \
      if(__builtin_expect(__any(rm>(float)THRL),0)){ const float dl=__builtin_fmaxf(rm,0.f); mhat+=dl; \
        _Pragma("unroll") for(int r=0;r<16;++r){C0[r]-=dl;C1[r]-=dl;} \
        _Pragma("unroll") for(int r=0;r<16;++r)negm[r]=-mhat; asm volatile("":"+v"(negm)); \
        const float f=__builtin_amdgcn_exp2f(-dl); l_reg*=f; if(hi==0)wsf[r32]=f; resc=true; } } \
    BMWAIT(t); unsigned w0_=0u, w1_=0u; if constexpr(!MLA){ w0_=bmw[((t)&1)*64+r32]>>(4*hi); w1_=bmw[((t)&1)*64+32+r32]>>(4*hi); } \
    SBAR(); \
    GAPB(o[0]=__builtin_amdgcn_mfma_f32_32x32x16_bf16(PAF(0),VFR(0),o[0],0,0,0), C0,0,w0_); \
    KRD(GL,4); GAPB(o[1]=__builtin_amdgcn_mfma_f32_32x32x16_bf16(PAF(0),VFR(4),o[1],0,0,0), C0,4,w0_); \
    KRD(GL,0); GAPB(o[0]=__builtin_amdgcn_mfma_f32_32x32x16_bf16(PAF(1),VFR(1),o[0],0,0,0), C0,8,w0_); \
    KRD(GL,1); GAPB(o[1]=__builtin_amdgcn_mfma_f32_32x32x16_bf16(PAF(1),VFR(5),o[1],0,0,0), C0,12,w0_); \
    KRD(GL,2); GAPB(o[0]=__builtin_amdgcn_mfma_f32_32x32x16_bf16(PAF(2),VFR(2),o[0],0,0,0), C1,0,w1_); \
    KRD(GL,3); GAPB(o[1]=__builtin_amdgcn_mfma_f32_32x32x16_bf16(PAF(2),VFR(6),o[1],0,0,0), C1,4,w1_); \
    KRD(GL,5); GAPB(o[0]=__builtin_amdgcn_mfma_f32_32x32x16_bf16(PAF(3),VFR(3),o[0],0,0,0), C1,8,w1_); \
    GAPB(o[1]=__builtin_amdgcn_mfma_f32_32x32x16_bf16(PAF(3),VFR(7),o[1],0,0,0), C1,12,w1_); \
    }while(0)
  int t=1;
  #undef CMASK
  #define CMASK(P0,P1,t) do{}while(0)
  for(;t+5<NT;t+=2){
    STEP(pB0,pB1,pA0,pA1,t,true,true,true);     WAIT_BAR(3); RESC(); ROT();
    STEP(pA0,pA1,pB0,pB1,t+1,true,true,true);   WAIT_BAR(3); RESC(); ROT();
  }
  #undef CMASK
  #define CMASK(P0,P1,t) do{int jb_=(t)-(NT-4); if(jb_>=0)cmask(P0,P1,jb_,wid);}while(0)
  #define ENDW(tt) do{ if((tt)+3<NT){WAIT_BAR(3);} else if((tt)+2<NT){ if constexpr(MLA){WAIT_BAR(1);}else{WAIT_BAR(2);} } else {WAIT_BAR(0);} }while(0)
  for(;t+1<NT;t+=2){
    STEP(pB0,pB1,pA0,pA1,t,(t+3<NT),(t+1<NT),(t+1<NT));       ENDW(t);   RESC(); ROT();
    STEP(pA0,pA1,pB0,pB1,t+1,(t+4<NT),(t+2<NT),(t+2<NT));     ENDW(t+1); RESC(); ROT();
  }
  STEP(pB0,pB1,pA0,pA1,NT-1,false,false,false); RESC();
  { float sacc=pB0[0]+pB0[1]; _Pragma("unroll") for(int r=2;r<16;++r)sacc+=pB0[r]; _Pragma("unroll") for(int r=0;r<16;++r)sacc+=pB1[r]; l_reg+=sacc;
    pw0=(u32x4){PKW(pB0,0),PKW(pB0,2),PKW(pB0,4),PKW(pB0,6)};pw1=(u32x4){PKW(pB0,8),PKW(pB0,10),PKW(pB0,12),PKW(pB0,14)};pw2=(u32x4){PKW(pB1,0),PKW(pB1,2),PKW(pB1,4),PKW(pB1,6)};pw3=(u32x4){PKW(pB1,8),PKW(pB1,10),PKW(pB1,12),PKW(pB1,14)};
    SBAR(); pv(o,vb0+sl_cur,PAF(0),PAF(1),PAF(2),PAF(3)); }
  #undef PKW
  #undef PAF
  #undef VFR
  #undef PIN
  #undef MX3
  #undef GAPA
  #undef GAPB
  #undef EX
  #undef VRD
  #undef KRD
  #undef STEP
  #undef ENDW
  {auto rr=__builtin_amdgcn_permlane32_swap(__float_as_uint(l_reg),__float_as_uint(l_reg),false,false);l_reg=__uint_as_float(rr[0])+__uint_as_float(rr[1]);}
  if(hi==0)wsf[32+r32]=l_reg;asm volatile("s_waitcnt lgkmcnt(0)":::"memory");
  float rli[16];
  #pragma unroll
  for(int r=0;r<16;++r)rli[r]=__builtin_amdgcn_rcpf(wsf[32+crow(r,hi)]);
  bf16*Ow=O+(rowbase+q0+wid*QBLK)*DM+h*D;
  { bf16*stg=(bf16*)(shm+LDS_OST)+wid*2048;
    #pragma unroll
    for(int r=0;r<16;++r){const int orow=crow(r,hi);
      #pragma unroll
      for(int d0=0;d0<2;++d0)stg[orow*64+d0*32+r32]=__float2bfloat16(o[d0][r]*rli[r]);}
    asm volatile("s_waitcnt lgkmcnt(0)":::"memory");
    #pragma unroll
    for(int i=0;i<4;++i){const int row=i*8+(lane>>3),ch=lane&7; const u32x4 v=*(const u32x4*)(stg+row*64+ch*8); ATTN_STORE16(Ow+(long)row*DM+ch*8,v);} }
  asm volatile("s_waitcnt lgkmcnt(0)\n\ts_barrier":::"memory");
  #undef DMA_K
  #undef DMA_BM
  #undef KO
  #undef VMW
  #undef BMWAIT
  #undef CR_
  #undef DMA_V
  #undef CMASK
  #undef START
  #undef RESC
  #undef ROT
}
#undef SBAR
#undef WAIT_BAR
}
constexpr int CAND_CAP = 128, QIP = 1296, HS = 513, FAST_CAP = 512;
struct IdxP { const bf16 *QI, *KI; const float* WI; unsigned* BM; unsigned* dbg; };
__device__ __forceinline__ unsigned mono_key(float s) { const unsigned u = __builtin_bit_cast(unsigned, s + 0.0f); return u ^ ((unsigned)((int)u >> 31) | 0x80000000u); }
__device__ __forceinline__ void idx_scores2(const bf16x8 (&kf)[2][4], const LAS unsigned char* qlane, const float (&wq)[8], f32x16& sc0, f32x16& sc1) {
    bf16x8 qv[4], qn[4];
#pragma unroll
    for (int s = 0; s < 4; ++s) qv[s] = *(const LAS bf16x8*)(qlane + 8 * 128 + s * 32);
#pragma unroll
    for (int i = 0; i < 16; ++i) { sc0[i] = 0.f; sc1[i] = 0.f; }
    f32x16 ap0, ap1;
#pragma unroll
    for (int i = 0; i < 16; ++i) { ap0[i] = 0.f; ap1[i] = 0.f; }
#pragma unroll
    for (int n = 0; n < 10; ++n) {
        const int nh = (n + 1 < 2) ? 9 : (n + 1 - 2);
        if (n + 1 < 10) {
#pragma unroll
            for (int s = 0; s < 4; ++s) qn[s] = *(const LAS bf16x8*)(qlane + nh * 128 + s * 32); }
        f32x16 a0, a1;
        if (n < 2) {
#pragma unroll
            for (int s = 0; s < 4; ++s) { sc0 = __builtin_amdgcn_mfma_f32_32x32x16_bf16(kf[0][s], qv[s], sc0, 0, 0, 0); sc1 = __builtin_amdgcn_mfma_f32_32x32x16_bf16(kf[1][s], qv[s], sc1, 0, 0, 0); }
        } else {
#pragma unroll
            for (int i = 0; i < 16; ++i) { a0[i] = 0.f; a1[i] = 0.f; }
#pragma unroll
            for (int s = 0; s < 4; ++s) { a0 = __builtin_amdgcn_mfma_f32_32x32x16_bf16(kf[0][s], qv[s], a0, 0, 0, 0); a1 = __builtin_amdgcn_mfma_f32_32x32x16_bf16(kf[1][s], qv[s], a1, 0, 0, 0); }
        }
        if (n >= 3) {
            const float w = wq[n - 3];
#pragma unroll
            for (int i = 0; i < 16; ++i) { sc0[i] = __builtin_fmaf(w, __builtin_fabsf(ap0[i]), sc0[i]); sc1[i] = __builtin_fmaf(w, __builtin_fabsf(ap1[i]), sc1[i]); }
#pragma unroll
            for (int g = 0; g < 8; ++g) { __builtin_amdgcn_sched_group_barrier(0x008, 1, 0); __builtin_amdgcn_sched_group_barrier(0x002, 4, 0); }
        }
        if (n >= 2) { ap0 = a0; ap1 = a1; }
#pragma unroll
        for (int s = 0; s < 4; ++s) qv[s] = qn[s];
    }
    { const float w = wq[7];
#pragma unroll
      for (int i = 0; i < 16; ++i) { sc0[i] = __builtin_fmaf(w, __builtin_fabsf(ap0[i]), sc0[i]); sc1[i] = __builtin_fmaf(w, __builtin_fabsf(ap1[i]), sc1[i]); } }
#pragma unroll
    for (int i = 0; i < 16; ++i) asm volatile("" : "+v"(sc0[i]), "+v"(sc1[i]));
}
__device__ __forceinline__ void idx_item(LAS unsigned char* L, int b, int j, const IdxP& P, int tid, int lane, int wave) {
    LAS unsigned* hist = (LAS unsigned*)L;
    LAS unsigned* img = (LAS unsigned*)(L + 66048);
    LAS unsigned* st = (LAS unsigned*)(L + 98816);
    LAS unsigned* cand = hist;
    LAS unsigned char* Qs = L + 100864;
    const int r32 = lane & 31, hi = lane >> 5;
    const int q0 = 32 * j, ntile = 2 * (j / 2 + 1);
    const size_t rowb = (size_t)b * SEQ;
    if (ntile <= 8) {
        for (int idx = tid; idx < ntile * 32; idx += NTHR) P.BM[((size_t)b * 256 + (idx >> 5)) * SEQ + q0 + (idx & 31)] = 0xffffffffu;
        return;
    }
    float wq[8];
    { for (int c = tid; c < 32 * 64; c += NTHR) { const int rr = c >> 6, ch = c & 63; *(LAS v4u*)(Qs + rr * QIP + ch * 16) = *(const v4u*)(P.QI + (rowb + q0 + rr) * 512 + ch * 8); }
      const float* wp = P.WI + (rowb + q0 + r32) * 8;
#pragma unroll
      for (int h = 0; h < 8; ++h) wq[h] = 0.5f * wp[h]; }
    if (tid < 32) { st[32 + tid] = 256u; st[64 + tid] = 0u; st[96 + tid] = 0u; }
    if (tid == 0) st[129] = 0u;
    __syncthreads();
    {
        const int r = tid >> 4, part = tid & 15;
        const float* wp = P.WI + (rowb + q0 + r) * 8;
        float qb[4] = {0.f, 0.f, 0.f, 0.f}; float rsum = 0.f;
#pragma unroll
        for (int h = 0; h < 8; ++h) { const float w = wp[h]; const v2u raw = *(const LAS v2u*)(Qs + r * QIP + h * 128 + part * 8);
            const float f0 = bflo(raw.x), f1 = bfhi(raw.x), f2 = bflo(raw.y), f3 = bfhi(raw.y);
            float nsq = (f0 * f0 + f1 * f1) + (f2 * f2 + f3 * f3);
#pragma unroll
            for (int o = 1; o < 16; o <<= 1) nsq += __shfl_xor(nsq, o);
            rsum += fabsf(w) * sqrtf(nsq);
            qb[0] += 0.5f * w * f0; qb[1] += 0.5f * w * f1; qb[2] += 0.5f * w * f2; qb[3] += 0.5f * w * f3; }
        v2u hw, lw;
        { const unsigned h01 = pk2(qb[0], qb[1]), h23 = pk2(qb[2], qb[3]); hw.x = h01; hw.y = h23;
          lw.x = pk2(qb[0] - bflo(h01), qb[1] - bfhi(h01)); lw.y = pk2(qb[2] - bflo(h23), qb[3] - bfhi(h23)); }
        *(LAS v2u*)(Qs + r * QIP + 8 * 128 + part * 8) = hw; *(LAS v2u*)(Qs + r * QIP + 9 * 128 + part * 8) = lw;
        { const v2u kw = *(const v2u*)(P.KI + (rowb + r) * 64 + part * 4); const float f0 = bflo(kw.x), f1 = bfhi(kw.x), f2 = bflo(kw.y), f3 = bfhi(kw.y);
          float ksq = (f0 * f0 + f1 * f1) + (f2 * f2 + f3 * f3);
#pragma unroll
          for (int o = 1; o < 16; o <<= 1) ksq += __shfl_xor(ksq, o);
          if (part == 0) { __hip_atomic_fetch_max(&st[129], __builtin_bit_cast(unsigned, ksq), __ATOMIC_RELAXED, __HIP_MEMORY_SCOPE_WORKGROUP); st[224 + r] = __builtin_bit_cast(unsigned, rsum); } }
    }
    __syncthreads();
    if (tid < 32) { const float R = 0.25f * sqrtf(__builtin_bit_cast(float, st[129])) * __builtin_bit_cast(float, st[224 + tid]);
        const float C = 0.125f * R;
        st[160 + tid] = (0x80000000u | __builtin_bit_cast(unsigned, R + C)) - 511u * 131072u; st[224 + tid] = __builtin_bit_cast(unsigned, C); st[tid] = 0u; st[192 + tid] = 0u;
        st[256 + tid] = __builtin_bit_cast(unsigned, R); st[288 + tid] = 511u; st[320 + tid] = 0u; }
    const LAS unsigned char* qlane = Qs + r32 * QIP + hi * 16;
    int level = 0;
    const int npair = ntile >> 1;
#define IDX_KLOAD2(tp) { const bf16* kp = P.KI + (rowb + 64 * (tp) + r32) * 64 + 8 * hi; _Pragma("unroll") for (int s = 0; s < 4; ++s) { kn[0][s] = *(const bf16x8*)(kp + 16 * s); kn[1][s] = *(const bf16x8*)(kp + 32 * 64 + 16 * s); } }
#define IDX_SCORES2(tp) \
        bf16x8 kf[2][4]; _Pragma("unroll") for (int s = 0; s < 4; ++s) { kf[0][s] = kn[0][s]; kf[1][s] = kn[1][s]; } \
        f32x16 sc0, sc1; idx_scores2(kf, qlane, wq, sc0, sc1); \
        if ((tp) + NWAVES < npair) { IDX_KLOAD2((tp) + NWAVES) }
    bool slow;
    {
        for (int u = tid; u < 32 * HS; u += NTHR) hist[u] = 0u;
        if (tid == 0) st[130] = 0u;
        __syncthreads();
        const float Rq = __builtin_bit_cast(float, st[256 + r32]);
        const int nsw = (npair + 63) >> 6, SP = min(npair, 8 * nsw);
        {   const float s1 = 256.f / Rq; LAS unsigned* hrow = hist + r32 * HS;
            for (int i = wave; i < SP; i += NWAVES) { const int tp = (i * npair) / SP;
                bf16x8 kn[2][4]; IDX_KLOAD2(tp)
                bf16x8 kf[2][4];
#pragma unroll
                for (int s = 0; s < 4; ++s) { kf[0][s] = kn[0][s]; kf[1][s] = kn[1][s]; }
                f32x16 sc0, sc1; idx_scores2(kf, qlane, wq, sc0, sc1);
#pragma unroll
                for (int e = 0; e < 16; ++e) { const int b0 = min(max((int)__builtin_fmaf(sc0[e], s1, 256.f), 0), 511), b1 = min(max((int)__builtin_fmaf(sc1[e], s1, 256.f), 0), 511);
                    __hip_atomic_fetch_add(&hrow[b0], 1u, __ATOMIC_RELAXED, __HIP_MEMORY_SCOPE_WORKGROUP); __hip_atomic_fetch_add(&hrow[b1], 1u, __ATOMIC_RELAXED, __HIP_MEMORY_SCOPE_WORKGROUP); }
            }
        }
        __syncthreads();
        {
            const int q = tid >> 4, seg = tid & 15; const LAS unsigned* hq = hist + q * HS + seg * 32;
            unsigned segsum = 0u;
            for (int wi = 0; wi < 32; ++wi) segsum += hq[wi];
            unsigned S = segsum;
#pragma unroll
            for (int off = 1; off < 16; off <<= 1) { const unsigned o = __shfl_down(S, off, 16); if (seg + off < 16) S += o; }
            const unsigned above = S - segsum, total = __shfl(S, 0, 16);
            const float f = (float)total / (float)(64 * npair), rs = 256.f * f, sg = 3.5f * sqrtf(rs * (1.f - f));
            const int rl = (int)floorf(rs - sg) - 1, rh = (int)ceilf(rs + sg) + 1;
            const unsigned tl = rl > 0 ? (unsigned)rl : 0u, th = (unsigned)rh;
            if (above < tl && tl <= above + segsum) { unsigned cum = above; int fb = 0; bool found = false;
                for (int wi = 31; wi >= 0; --wi) { const unsigned c = hq[wi]; if (!found && cum + c >= tl) { found = true; fb = wi; } if (!found) cum += c; }
                st[288 + q] = (unsigned)(32 * seg + fb); }
            if (above < th && th <= above + segsum) { unsigned cum = above; int fb = 0; bool found = false;
                for (int wi = 31; wi >= 0; --wi) { const unsigned c = hq[wi]; if (!found && cum + c >= th) { found = true; fb = wi; } if (!found) cum += c; }
                st[320 + q] = (unsigned)(32 * seg + fb); }
        }
        __syncthreads();
#ifdef REP_PASS2
        for (int rep2 = 0; rep2 < 2; ++rep2) { if (rep2) { __syncthreads(); if (tid < 32) st[96 + tid] = 0u; __syncthreads(); }
#else
        {
#endif
            const float wbin = Rq * (1.f / 256.f), fH = __builtin_fmaf((float)(st[288 + r32] + 1u), wbin, -Rq), fA = __builtin_fmaf((float)st[320 + r32], wbin, -Rq), s2 = 524287.f / (fH - fA), nfa = -fA * s2;
            bf16x8 kn[2][4]; if (wave < npair) { IDX_KLOAD2(wave) }
            for (int tp = wave; tp < npair; tp += NWAVES) {
                IDX_SCORES2(tp)
#define IDX_FAST_ELEMS(SC, T) { unsigned v = 0u, cm = 0u; \
            _Pragma("unroll") for (int i = 15; i >= 0; --i) { v = __builtin_amdgcn_alignbit(v, __builtin_bit_cast(unsigned, SC[i] - fH), 31);        \
                                                              cm = __builtin_amdgcn_alignbit(cm, __builtin_bit_cast(unsigned, SC[i] - fA), 31); } \
            cm = v & ~cm & 0xffffu; v = ~v & 0xffffu;                                                           \
            if (cm) { const unsigned pos0 = __hip_atomic_fetch_add(&st[96 + r32], (unsigned)__builtin_popcount(cm), __ATOMIC_RELAXED, __HIP_MEMORY_SCOPE_WORKGROUP);     \
                const unsigned rb = 8191u - (unsigned)(32 * (T)) - hi4; \
                _Pragma("unroll") for (int i = 0; i < 16; ++i) if (cm & (1u << i)) { const unsigned pos = min(pos0 + (unsigned)__builtin_popcount(cm & ((1u << i) - 1u)), (unsigned)FAST_CAP - 1u); \
                    cand[r32 * FAST_CAP + pos] = (min((unsigned)__builtin_fmaf(SC[i], s2, nfa), 524287u) << 13) | (rb - (unsigned)((i & 3) + 8 * (i >> 2))); } } \
            unsigned bits = (v & 0xfu) | ((v & 0xf0u) << 4) | ((v & 0xf00u) << 8) | ((v & 0xf000u) << 12);     \
            bits <<= 4 * hi; bits |= __shfl_xor(bits, 32); if (hi == 0) img[(T) * 32 + r32] = bits; }
                unsigned hi4 = 4u * (unsigned)hi; asm volatile("" : "+v"(hi4));
                IDX_FAST_ELEMS(sc0, 2 * tp)
                IDX_FAST_ELEMS(sc1, 2 * tp + 1)
#undef IDX_FAST_ELEMS
            }
        }
        __syncthreads();
        {
            const int q = tid >> 4, l16 = tid & 15; unsigned above = 0u;
            for (int t = l16; t < ntile; t += 16) above += (unsigned)__builtin_popcount(img[t * 32 + q]);
#pragma unroll
            for (int o = 1; o < 16; o <<= 1) above += __shfl_xor(above, o);
            const unsigned n = st[96 + q];
            if (l16 == 0) { if (above >= 256u || 256u - above > n || n > (unsigned)FAST_CAP) st[130] = 1u; st[32 + q] = 256u - above; }
        }
        __syncthreads();
        slow = st[130] != 0u;
#ifdef REP_SEL
        for (int rep3 = 0; rep3 < 2; ++rep3)
#endif
        if (!slow) {
            const int q = tid >> 4, l16 = tid & 15; const unsigned n = st[96 + q], need = st[32 + q];
            unsigned c[FAST_CAP / 16];
#pragma unroll
            for (int i = 0; i < FAST_CAP / 16; ++i) { const unsigned ci = (unsigned)(l16 + 16 * i); c[i] = ci < n ? cand[q * FAST_CAP + ci] : 0u; }
            unsigned Pv = 0u; bool done = false;
#pragma nounroll
            for (int bit = 31; bit >= 0; --bit) { const unsigned trial = Pv | (1u << bit); unsigned cnt = 0u;
#pragma unroll
                for (int i = 0; i < FAST_CAP / 16; ++i) cnt += (c[i] >= trial) ? 1u : 0u;
#pragma unroll
                for (int o = 1; o < 16; o <<= 1) cnt += __shfl_xor(cnt, o);
                if (!done && cnt >= need) { Pv = trial; done = (cnt == need); }
                if (__all(done)) break; }
#pragma unroll
            for (int i = 0; i < FAST_CAP / 16; ++i) if ((unsigned)(l16 + 16 * i) < n && c[i] >= Pv) { const unsigned kidx = 8191u - (c[i] & 8191u);
                __hip_atomic_fetch_or(&img[(kidx >> 5) * 32 + q], 1u << (kidx & 31), __ATOMIC_RELAXED, __HIP_MEMORY_SCOPE_WORKGROUP); }
        } else if (tid < 32) { st[32 + tid] = 256u; st[96 + tid] = 0u; }
        __syncthreads();
    }
#ifdef DIAG_SLOW
    if (slow && tid == 0) __hip_atomic_fetch_add(P.dbg, 1u, RLX_AGENT);
#endif
    if (slow) {
    for (;;) {
        ++level;
        for (int u = tid; u < 32 * HS; u += NTHR) hist[u] = 0u;
        if (tid == 0) st[128] = 0u;
        __syncthreads();
        {
            const unsigned qa = st[r32], qlen = st[192 + r32], base1 = st[160 + r32]; const float cq = __builtin_bit_cast(float, st[224 + r32]);
            const int sh = (level > 1 && qlen > 512u) ? (32 - __builtin_clz(qlen - 1u)) - 9 : 0;
            LAS unsigned* hrow = hist + r32 * HS;
            bf16x8 kn[2][4]; if (wave < npair) { IDX_KLOAD2(wave) }
            for (int tp = wave; tp < npair; tp += NWAVES) {
                IDX_SCORES2(tp)
                if (level == 1) {
#pragma unroll
                    for (int i = 0; i < 16; ++i) { const unsigned k0 = mono_key(sc0[i] + cq), k1 = mono_key(sc1[i] + cq);
                        const unsigned b0 = min((max(k0, base1) - base1) >> 17, 511u), b1 = min((max(k1, base1) - base1) >> 17, 511u);
                        __hip_atomic_fetch_add(&hrow[b0], 1u, __ATOMIC_RELAXED, __HIP_MEMORY_SCOPE_WORKGROUP); __hip_atomic_fetch_add(&hrow[b1], 1u, __ATOMIC_RELAXED, __HIP_MEMORY_SCOPE_WORKGROUP); }
                } else {
#pragma unroll
                    for (int i = 0; i < 16; ++i) { const unsigned o0 = mono_key(sc0[i] + cq) - qa, o1 = mono_key(sc1[i] + cq) - qa;
                        if (o0 < qlen) __hip_atomic_fetch_add(&hrow[o0 >> sh], 1u, __ATOMIC_RELAXED, __HIP_MEMORY_SCOPE_WORKGROUP);
                        if (o1 < qlen) __hip_atomic_fetch_add(&hrow[o1 >> sh], 1u, __ATOMIC_RELAXED, __HIP_MEMORY_SCOPE_WORKGROUP); }
                }
            }
        }
        __syncthreads();
        {
            const int q = tid >> 4, seg = tid & 15;
            unsigned segsum = 0u;
            for (int wi = 0; wi < 32; ++wi) segsum += hist[q * HS + seg * 32 + wi];
            unsigned S = segsum;
#pragma unroll
            for (int off = 1; off < 16; off <<= 1) { const unsigned o = __shfl_down(S, off, 16); if (seg + off < 16) S += o; }
            const unsigned above = S - segsum, need = st[32 + q];
            if (above < need && need <= above + segsum) {
                unsigned cum = above, fbin = 0u, fneed = 1u, fcnt = 0u; bool found = false;
                for (int wi = 31; wi >= 0; --wi) { const unsigned c = hist[q * HS + seg * 32 + wi];
                    if (!found && cum + c >= need) { found = true; fbin = (unsigned)wi; fneed = need - cum; fcnt = c; } if (!found) cum += c; }
                fbin += 32u * (unsigned)seg;
                unsigned na, nlen;
                if (level == 1) { const unsigned base1 = st[160 + q];
                    if (fbin == 0u) { na = 0u; nlen = base1 + 131072u; } else if (fbin == 511u) { na = base1 + 511u * 131072u; nlen = 0u - na; } else { na = base1 + fbin * 131072u; nlen = 131072u; } }
                else { const unsigned qa = st[q], qlen = st[192 + q]; const int sh = qlen > 512u ? (32 - __builtin_clz(qlen - 1u)) - 9 : 0;
                    na = qa + (fbin << sh); nlen = min(1u << sh, qlen - (fbin << sh)); }
                st[q] = na; st[192 + q] = nlen; st[32 + q] = fneed; st[64 + q] = fcnt;
                if (fcnt > (unsigned)CAND_CAP && nlen > 1u) st[128] = 1u;
            }
        }
        __syncthreads();
#ifndef MAXLVL
#define MAXLVL 8
#endif
        const bool more = (st[128] != 0u) && (level < MAXLVL);
        __syncthreads();
        if (!more) break;
    }
    {
        const unsigned qa = st[r32], qlen = st[192 + r32]; const float cq = __builtin_bit_cast(float, st[224 + r32]);
        const unsigned Hk = qa + qlen - 1u;
        unsigned hb = (Hk & 0x80000000u) ? (Hk ^ 0x80000000u) : ~Hk;
        if (hb == 0x80000000u) hb = 0x80000001u;
        const float fH = __builtin_bit_cast(float, hb);
        const unsigned ab_ = (qa & 0x80000000u) ? (qa ^ 0x80000000u) : ~qa;
        const float fA = (qa < 0x00800000u) ? -__builtin_inff() : __builtin_bit_cast(float, ab_);
        bf16x8 kn[2][4]; if (wave < npair) { IDX_KLOAD2(wave) }
        for (int tp = wave; tp < npair; tp += NWAVES) {
            IDX_SCORES2(tp)
#define IDX_COLLECT_ELEMS(SC, T) { unsigned v = 0u; _Pragma("unroll") for (int i = 15; i >= 0; --i) { const float ts = SC[i] + cq; const bool ab = ts > fH; v = v + v + (ab ? 1u : 0u); \
                if (!ab && ts >= fA) { const unsigned key = mono_key(ts); \
                    const unsigned pos = __hip_atomic_fetch_add(&st[96 + r32], 1u, __ATOMIC_RELAXED, __HIP_MEMORY_SCOPE_WORKGROUP); \
                    if (pos < (unsigned)CAND_CAP) { cand[(r32 * CAND_CAP + pos) * 2] = key; cand[(r32 * CAND_CAP + pos) * 2 + 1] = (unsigned)(32 * (T) + crow(i, hi)); } } } \
            unsigned bits = (v & 0xfu) | ((v & 0xf0u) << 4) | ((v & 0xf00u) << 8) | ((v & 0xf000u) << 12);     \
            bits <<= 4 * hi; bits |= __shfl_xor(bits, 32); if (hi == 0) img[(T) * 32 + r32] = bits; }
            IDX_COLLECT_ELEMS(sc0, 2 * tp)
            IDX_COLLECT_ELEMS(sc1, 2 * tp + 1)
#undef IDX_COLLECT_ELEMS
        }
    }
#undef IDX_SCORES2
#undef IDX_KLOAD2
    __syncthreads();
    {
        const int q = tid >> 4; const unsigned n = min(st[96 + q], (unsigned)CAND_CAP), need = st[32 + q];
        for (unsigned c = tid & 15; c < n; c += 16) { const unsigned key = cand[(q * CAND_CAP + c) * 2], idx = cand[(q * CAND_CAP + c) * 2 + 1]; unsigned rank = 0u;
            for (unsigned o = 0; o < n; ++o) { const unsigned k2 = cand[(q * CAND_CAP + o) * 2], i2 = cand[(q * CAND_CAP + o) * 2 + 1]; rank += (k2 > key || (k2 == key && i2 < idx)) ? 1u : 0u; }
            if (rank < need) __hip_atomic_fetch_or(&img[(idx >> 5) * 32 + q], 1u << (idx & 31), __ATOMIC_RELAXED, __HIP_MEMORY_SCOPE_WORKGROUP); }
    }
    }
    __syncthreads();
    for (int idx = tid; idx < ntile * 32; idx += NTHR) P.BM[((size_t)b * 256 + (idx >> 5)) * SEQ + q0 + (idx & 31)] = img[idx];
    __syncthreads();
}

__device__ __forceinline__ int wq_next(Frame& F, int cw) {
    __syncthreads();
    if (F_TID == 0) F.MISC[0] = __hip_atomic_fetch_add((unsigned*)(F.ctl + cw), 1u, RLX_AGENT);
    __syncthreads();
    return (int)F.MISC[0];
}

__device__ __forceinline__ void p5a_route(Frame& F, const Args& A) {
    const int lane = F_LANE, tid = F_TID, wave = F_WAVE;
    const float* x1 = A.out; const float* g2 = A.in[11];
    const float* wrg = A.in[12]; const float* brg = A.in[13]; const float* wre = A.in[14]; const float* bre = A.in[15];
    int* toke = (int*)(F.ws + WS_TOKE); float* tokw = (float*)(F.ws + WS_TOKW); float* rstd2 = (float*)(F.ws + WS_RSTD2);
    int* sslot = (int*)(F.ws + WS_SSLOT);
    constexpr int WST = 44, WCH = 256 * WST * 4;
    LAS float* wl = (LAS float*)F.lds;
    LAS unsigned* lcnt = (LAS unsigned*)(F.lds + 2 * WCH);
    LAS float* lgs = (LAS float*)(F.lds + 2 * WCH + 256);
    for (int i = F.vcu * NTHR + tid; i < SORT_ROWS; i += F.G * NTHR) sslot[i] = -1;
    if (tid < NEXP) lcnt[tid] = 0u;
    const int i16 = lane & 15, kq = lane >> 4, tile = wave & 3, half = wave >> 2;
    const int per = T / F.G;
    for (int t0 = F.vcu * per; t0 < (F.vcu + 1) * per; t0 += 64) {
        const float* xr = x1 + (size_t)(t0 + 16 * tile + i16) * D + 4 * kq;
        f32x4 acc0 = (f32x4){0.f, 0.f, 0.f, 0.f}, acc1 = acc0; float ss = 0.f;
        f32x4 se[4], sg; float gk[5];
#define RT_LOAD(c) do { _Pragma("unroll") for (int q = 0; q < 4; ++q) { const int f = tid + 512 * q, k = f >> 3; se[q] = *(const GAS f32x4*)(wre + (size_t)(256 * (c) + k) * 32 + 4 * (f & 7)); gk[q] = g2[256 * (c) + k]; } \
            { const int k = tid >> 1; sg = *(const GAS f32x4*)(wrg + (size_t)(256 * (c) + k) * 8 + 4 * (tid & 1)); gk[4] = g2[256 * (c) + k]; } } while (0)
#define RT_WRITE(bf) do { LAS float* wb = wl + (bf) * (WCH / 4); _Pragma("unroll") for (int q = 0; q < 4; ++q) { const int f = tid + 512 * q, k = f >> 3; *(LAS f32x4*)(wb + k * WST + 4 * (f & 7)) = se[q] * gk[q]; } \
            { const int k = tid >> 1; *(LAS f32x4*)(wb + k * WST + 32 + 4 * (tid & 1)) = sg * gk[4]; } } while (0)
        RT_LOAD(0); RT_WRITE(0); __syncthreads();
        for (int c = 0; c < 4; ++c) {
            if (c + 1 < 4) RT_LOAD(c + 1);
            const LAS float* wb = wl + (c & 1) * (WCH / 4) + 4 * kq * WST + i16 + 16 * half;
#pragma unroll 4
            for (int s = 0; s < 16; ++s) {
                const f32x4 a4 = *(const GAS f32x4*)(xr + 256 * c + 16 * s);
                if (half == 0) ss += (a4.x * a4.x + a4.y * a4.y) + (a4.z * a4.z + a4.w * a4.w);
#pragma unroll
                for (int cc = 0; cc < 4; ++cc) { const LAS float* wp = wb + (16 * s + cc) * WST;
                    acc0 = __builtin_amdgcn_mfma_f32_16x16x4f32(a4[cc], wp[0], acc0, 0, 0, 0);
                    if (half == 0) acc1 = __builtin_amdgcn_mfma_f32_16x16x4f32(a4[cc], wp[32 - (i16 & 8)], acc1, 0, 0, 0); }
            }
            if (c + 1 < 4) RT_WRITE((c + 1) & 1);
            __syncthreads();
        }
#undef RT_LOAD
#undef RT_WRITE
        LAS float* lt = lgs + tile * 640;
#pragma unroll
        for (int r = 0; r < 4; ++r) { const int tk = 4 * kq + r; lt[tk * 40 + 8 + 16 * half + i16] = acc0[r]; if (half == 0 && i16 < 8) lt[tk * 40 + i16] = acc1[r]; }
        if (half == 0) { ss += __shfl_xor(ss, 16); ss += __shfl_xor(ss, 32); if (kq == 0) lgs[2560 + 16 * tile + i16] = 1.f / sqrtf(ss * (1.f / D) + EPS); }
        __syncthreads();
        if (half == 0 && lane < 16) {
            const int m = t0 + 16 * tile + lane; const float rstd = lgs[2560 + 16 * tile + lane]; const LAS float* lg = lt + lane * 40;
            float gl[8];
#pragma unroll
            for (int k = 0; k < 8; ++k) gl[k] = lg[k] * rstd + brg[k];
            int gs = 0; float gm = gl[0];
#pragma unroll
            for (int k = 1; k < 8; ++k) if (gl[k] > gm) { gm = gl[k]; gs = k; }
            float den = 0.f;
#pragma unroll
            for (int k = 0; k < 8; ++k) den += __expf(gl[k] - gm);
            const float wgrp = 1.f / den;
            float el[4];
#pragma unroll
            for (int cc = 0; cc < 4; ++cc) el[cc] = lg[8 + 4 * gs + cc] * rstd + bre[4 * gs + cc];
            int i1 = 0; float v1 = el[0];
#pragma unroll
            for (int cc = 1; cc < 4; ++cc) if (el[cc] > v1) { v1 = el[cc]; i1 = cc; }
            int i2 = -1; float v2 = 0.f;
#pragma unroll
            for (int cc = 0; cc < 4; ++cc) if (cc != i1 && (i2 < 0 || el[cc] > v2)) { v2 = el[cc]; i2 = cc; }
            const float e2 = __expf(v2 - v1), w1 = 1.f / (1.f + e2), w2 = e2 / (1.f + e2);
            toke[2 * m] = gs * 4 + i1; toke[2 * m + 1] = gs * 4 + i2; tokw[2 * m] = w1 * wgrp; tokw[2 * m + 1] = w2 * wgrp; rstd2[m] = rstd;
            __hip_atomic_fetch_add(&lcnt[gs * 4 + i1], 1u, __ATOMIC_RELAXED, __HIP_MEMORY_SCOPE_WORKGROUP);
            __hip_atomic_fetch_add(&lcnt[gs * 4 + i2], 1u, __ATOMIC_RELAXED, __HIP_MEMORY_SCOPE_WORKGROUP);
        }
        __syncthreads();
    }
    if (tid < NEXP && lcnt[tid]) __hip_atomic_fetch_add((unsigned*)(F.ctl + CW_CNT + tid), lcnt[tid], RLX_AGENT);
}

__device__ __forceinline__ void p5a2_scatter(Frame& F, const Args& A) {
    const int lane = F_LANE, tid = F_TID;
    const float* x1 = A.out; const float* g2 = A.in[11];
    const int* toke = (const int*)(F.ws + WS_TOKE); const float* tokw = (const float*)(F.ws + WS_TOKW); const float* rstd2 = (const float*)(F.ws + WS_RSTD2);
    int* sslot = (int*)(F.ws + WS_SSLOT); float* sw = (float*)(F.ws + WS_SW); int* t2e = (int*)(F.ws + WS_T2E);
    bf16* AS = (bf16*)(F.ws + WS_ASORT);
    LAS unsigned* sh = (LAS unsigned*)F.lds;
    if (tid < NEXP) sh[256 + tid] = __hip_atomic_load((unsigned*)(F.ctl + CW_CNT + tid), RLX_AGENT);
    __syncthreads();
    if (tid == 0) { unsigned acc = 0u;
        for (int e = 0; e < NEXP; ++e) { const unsigned c = sh[256 + e]; sh[e] = acc; const unsigned nt = (c + 255u) / 256u;
            if (blockIdx.x == 0) for (unsigned i = 0; i < nt; ++i) t2e[acc / 256u + i] = e;
            acc += nt * 256u; }
        if (blockIdx.x == 0) t2e[255] = (int)(acc / 256u); }
    const int per = T / F.G;
    for (int t0 = F.vcu * per; t0 < (F.vcu + 1) * per; t0 += 64) {
        if (tid < NEXP) sh[32 + tid] = 0u;
        __syncthreads();
        int e = 0; unsigned lpos = 0u;
        if (tid < 128) { e = toke[2 * t0 + tid]; lpos = __hip_atomic_fetch_add(&sh[32 + e], 1u, __ATOMIC_RELAXED, __HIP_MEMORY_SCOPE_WORKGROUP); }
        __syncthreads();
        if (tid < NEXP) sh[64 + tid] = sh[tid] + (sh[32 + tid] ? __hip_atomic_fetch_add((unsigned*)(F.ctl + CW_FILL + tid), sh[32 + tid], RLX_AGENT) : 0u);
        __syncthreads();
        if (tid < 128) { const unsigned pos = sh[64 + e] + lpos; sh[96 + tid] = pos; sslot[pos] = 2 * t0 + tid; sw[pos] = tokw[2 * t0 + tid]; }
        __syncthreads();
        for (int tk0 = F_WAVE; tk0 < 64; tk0 += 4 * NWAVES) {
            f32x4 xv[4][4];
#pragma unroll
            for (int r = 0; r < 4; ++r) { const GAS f32x4* xr = (const GAS f32x4*)(x1 + (size_t)(t0 + tk0 + r * NWAVES) * D) + lane;
#pragma unroll
                for (int j = 0; j < 4; ++j) xv[r][j] = xr[64 * j]; }
#pragma unroll
            for (int r = 0; r < 4; ++r) { const int tk = tk0 + r * NWAVES, m = t0 + tk; const float rstd = rstd2[m];
                const unsigned p0 = sh[96 + 2 * tk], p1 = sh[96 + 2 * tk + 1];
#pragma unroll
                for (int j = 0; j < 4; ++j) { const f32x4 g = *((const GAS f32x4*)g2 + lane + 64 * j); const f32x4 y = xv[r][j] * rstd * g; v2u w; w.x = pk2(y.x, y.y); w.y = pk2(y.z, y.w);
                    *((GAS v2u*)(AS + (size_t)p0 * D) + lane + 64 * j) = w; *((GAS v2u*)(AS + (size_t)p1 * D) + lane + 64 * j) = w; } } }
        __syncthreads();
    }
}

__device__ __forceinline__ void p6_final(Frame& F, const Args& A) {
    const int gw = F.vcu * NWAVES + F_WAVE, NGW = F.G * NWAVES, lane = F_LANE;
    const float* gf = A.in[19]; float* out = A.out; const bf16* SL = (const bf16*)(F.ws + WS_SLOTS);
    for (int m0 = gw; m0 < T; m0 += 2 * NGW) {
        f32x4 v[2][4]; v2u a[2][4], c[2][4];
#pragma unroll
        for (int r = 0; r < 2; ++r) { const int m = min(m0 + r * NGW, T - 1); const GAS f32x4* xr = (const GAS f32x4*)(out + (size_t)m * D) + lane;
            const GAS v2u* s0 = (const GAS v2u*)(SL + (size_t)(2 * m) * D) + lane; const GAS v2u* s1 = (const GAS v2u*)(SL + (size_t)(2 * m + 1) * D) + lane;
#pragma unroll
            for (int j = 0; j < 4; ++j) { v[r][j] = xr[64 * j]; a[r][j] = s0[64 * j]; c[r][j] = s1[64 * j]; } }
#pragma unroll
        for (int r = 0; r < 2; ++r) { const int m = m0 + r * NGW; float s = 0.f;
#pragma unroll
            for (int j = 0; j < 4; ++j) { f32x4& w = v[r][j];
                w.x += bflo(a[r][j].x) + bflo(c[r][j].x); w.y += bfhi(a[r][j].x) + bfhi(c[r][j].x); w.z += bflo(a[r][j].y) + bflo(c[r][j].y); w.w += bfhi(a[r][j].y) + bfhi(c[r][j].y);
                s += (w.x * w.x + w.y * w.y) + (w.z * w.z + w.w * w.w); }
            const float rstd = 1.f / sqrtf(wave_sum(s) * (1.f / D) + EPS);
            if (m < T) { GAS f32x4* xo = (GAS f32x4*)(out + (size_t)m * D) + lane;
#pragma unroll
                for (int j = 0; j < 4; ++j) { const f32x4 g = *((const GAS f32x4*)gf + lane + 64 * j); xo[64 * j] = v[r][j] * rstd * g; } } }
    }
}

constexpr int NPHASE = 13;
__global__ void __launch_bounds__(NTHR, 2) mk_fwd(Args args) {
    extern __shared__ __attribute__((aligned(16))) unsigned char lds[];
    Frame F;
    F.lds = (LAS unsigned char*)lds; F.MISC = (volatile LAS unsigned*)(F.lds + MISC_OFF);
        F.G = gridDim.x; { const int bx = blockIdx.x; F.vcu = (F.G % 8 == 0) ? (bx % 8) * (F.G / 8) + bx / 8 : bx; }
    F.ws = args.ws; F.ctl = (gu32*)(args.ws + WS_CTL);
    unsigned char* ws = args.ws;
    if (F_TID < 128) F.MISC[F_TID] = 0u;
    __syncthreads();
    const bool single = (args.ph_hi - args.ph_lo) > 1;
    XcdBarrier bar; bar.bar = (unsigned*)(F.ctl + CW_BAR); bar.x = 0; bar.st = nullptr;
    if (single) bar = xcd_barrier_post((unsigned*)(F.ctl + CW_BAR), F.MISC + 8);
    const int lo = args.ph_lo, hi = args.ph_hi;
#ifdef ONLY
#define IN(k) ((k) == ONLY && lo <= (k) && (k) < hi)
#else
#define IN(k) (lo <= (k) && (k) < hi)
#endif
#ifdef TS_A
#define STAMP(k) do { if (blockIdx.x == 0 && threadIdx.x == 0) ((unsigned long long*)(ws + WS_CTL + 8192))[(k) + 1] = __builtin_amdgcn_s_memrealtime(); } while (0)
#else
#define STAMP(k) do { } while (0)
#endif
#define SEAM(k) do { if (IN((k) + 1)) xcd_barrier(bar); STAMP(k); } while (0)
    const f32x2* rope = (const f32x2*)(ws + WS_ROPE);
    bf16* GA = (bf16*)args.out; bf16* GB = (bf16*)args.out + (size_t)T * 1024;

    STAMP(-1);
    if (IN(0)) { p0_prologue(F, args);
#ifdef REP_P0
        p0_prologue(F, args);
#endif
        SEAM(0); }
    if (IN(1)) {
        pg8::Gemm g{(const bf16*)(ws + WS_H), (const bf16*)(ws + WS_WIN), T, NIN, D, 0}; pg8::StaticOrder S; S.init(T, NIN, F.G, (int)blockIdx.x);
        pg8::EpiIn E{(bf16*)(ws + WS_CQ), (bf16*)(ws + WS_CKV), (bf16*)(ws + WS_QB), (bf16*)(ws + WS_KB), (bf16*)(ws + WS_VB), (bf16*)(ws + WS_QI), (bf16*)(ws + WS_KI), (bf16*)(ws + WS_KR), GA, GB, (float*)(ws + WS_WI), rope};
        pg8::gemm_phase<pg8::EpiIn, pg8::StaticOrder, true, true>(F.lds, g, S, E);
#ifdef REP_P1
        pg8::gemm_phase<pg8::EpiIn, pg8::StaticOrder, true, true>(F.lds, g, S, E);
#endif
        SEAM(1);
    }
    if (IN(2)) { p2a_norms(F, args); SEAM(2); }
    if (IN(3)) {
#ifdef REP_P3
      for (int rep = 0; rep < 2; ++rep) {
#else
      {
#endif
#ifndef NO3A
        { pg8::Gemm g{(const bf16*)(ws + WS_CQ), (const bf16*)(ws + WS_WUQ), T, 768, 384, 0}; pg8::StaticOrder S; S.init(T, 768, F.G, (int)blockIdx.x);
          pg8::EpiQA E{(bf16*)(ws + WS_QA), rope}; pg8::gemm_phase<pg8::EpiQA, pg8::StaticOrder, true, true>(F.lds, g, S, E); }
#endif
#ifndef NO3B
        { pg8::Gemm g{(const bf16*)(ws + WS_CKV), (const bf16*)(ws + WS_WUKV), T, 1024, 256, 0}; pg8::StaticOrder S; S.init(T, 1024, F.G, (int)blockIdx.x);
          pg8::EpiKV E{(bf16*)(ws + WS_KN), (bf16*)(ws + WS_VA)}; pg8::gemm_phase<pg8::EpiKV, pg8::StaticOrder, true, true>(F.lds, g, S, E); }
#endif
      }
        SEAM(3);
    }
    if (IN(4)) {
        unsigned* rdy = (unsigned*)(F.ctl + CW_RDY);
        for (;;) { const int k = wq_next(F, CW_Q1); if (k >= 1536 + CV_QITEMS) break;
            int ltid = threadIdx.x; asm volatile("" : "+v"(ltid));
            const int lw = __builtin_amdgcn_readfirstlane(ltid >> 6);
            if (k < 512) { const int ib = k & 1, ij = 255 - (k >> 1);
                const IdxP IP{(const bf16*)(ws + WS_QI), (const bf16*)(ws + WS_KI), (const float*)(ws + WS_WI), (unsigned*)(ws + WS_BM), (unsigned*)(F.ctl + 1024)};
                idx_item(F.lds, ib, ij, IP, ltid, ltid & 63, lw);
#ifdef REP_IDX
                __syncthreads(); idx_item(F.lds, ib, ij, IP, ltid, ltid & 63, lw);
#endif
                VM_WAIT(); __syncthreads();
                if (ltid == 0) { __builtin_amdgcn_fence(__ATOMIC_RELEASE, "agent"); VM_WAIT(); __hip_atomic_fetch_add(rdy + 64 * (ib * 32 + (ij >> 3)), 1u, RLX_AGENT); }
                continue; }
            const int j = k - 512; int a;
            if (j < 3 * CV_QITEMS) { const int q3 = j / 3, r3 = j - 3 * q3; a = (r3 == 2) ? -1 - q3 : 2 * q3 + r3; } else a = j - CV_QITEMS;
            if (a < 0) { const int c = -1 - a; LAS float* scr = (LAS float*)(F.lds + lw * 16640);
                conv_tile2(args, ws, CV_EARLY + 16 * c + lw, CV_EARLY + 16 * c + 8 + lw, scr, ltid & 63);
                continue; }
            { const int u = a >> 1, ub = (u & 15) >> 3, uh = u & 7, uq = 31 - (u >> 4);
                if (a & 1) { const AttnP APA{(const bf16*)(ws + WS_QA), (const bf16*)(ws + WS_KN), (const bf16*)(ws + WS_KR), (const bf16*)(ws + WS_VA), (bf16*)(ws + WS_OA), nullptr};
#ifdef MLA_OLD
                    attn_unit<true>(F.lds, ub, uh, uq, APA, ltid, ltid & 63, lw); }
#else
                    attn_body::attn_unit<8, true>(ub, uh, uq, (const attn_body::bf16*)APA.Q, (const attn_body::bf16*)APA.K, (const attn_body::bf16*)APA.K2, (const attn_body::bf16*)APA.V, (attn_body::bf16*)APA.O, nullptr, (char*)F.lds, ltid); }
#endif
                else { const AttnP APB{(const bf16*)(ws + WS_QB), (const bf16*)(ws + WS_KB), nullptr, (const bf16*)(ws + WS_VB), (bf16*)(ws + WS_OB), (const unsigned*)(ws + WS_BM)};
                    if (ltid == 0) { unsigned sp = 0u; while (__hip_atomic_load(rdy + 64 * (ub * 32 + uq), RLX_AGENT) < 8u) { __builtin_amdgcn_s_sleep(8); if (++sp > (1u << 22)) break; }
                        __builtin_amdgcn_fence(__ATOMIC_ACQUIRE, "agent"); VM_WAIT(); }
                    __syncthreads();
#ifdef DSA_OLD
                    attn_unit<false>(F.lds, ub, uh, uq, APB, ltid, ltid & 63, lw); } }
#else
                    attn_body::attn_unit<8, false>(ub, uh, uq, (const attn_body::bf16*)APB.Q, (const attn_body::bf16*)APB.K, nullptr, (const attn_body::bf16*)APB.V, (attn_body::bf16*)APB.O, APB.BM, (char*)F.lds, ltid); } }
#endif
        }
    }
    if (IN(5)) { SEAM(5); }
    if (IN(6)) {
#ifdef REP_P6
      for (int rep = 0; rep < 2; ++rep) {
#else
      {
#endif
        { pg8::Gemm g{(const bf16*)(ws + WS_OA), (const bf16*)(ws + WS_WOA), T, 1024, 512, 0}; pg8::StaticOrder S; S.init(T, 1024, F.G, (int)blockIdx.x);
          pg8::EpiY<0> E{(bf16*)(ws + WS_Y), GA}; pg8::gemm_phase<pg8::EpiY<0>, pg8::StaticOrder, true, true>(F.lds, g, S, E); }
        { pg8::Gemm g{(const bf16*)(ws + WS_OB), (const bf16*)(ws + WS_WOB), T, 1024, 512, 0}; pg8::StaticOrder S; S.init(T, 1024, F.G, (int)blockIdx.x);
          pg8::EpiY<1> E{(bf16*)(ws + WS_Y), GB}; pg8::gemm_phase<pg8::EpiY<1>, pg8::StaticOrder, true, true>(F.lds, g, S, E); }
      }
        SEAM(6);
    }
    if (IN(7)) {
        pg8::Gemm g{(const bf16*)(ws + WS_Y), (const bf16*)(ws + WS_WOUT), T, 1024, 1024, 0}; pg8::StaticOrder S; S.init(T, 1024, F.G, (int)blockIdx.x);
        pg8::EpiX1 E{args.in[0], args.out}; pg8::gemm_phase<pg8::EpiX1, pg8::StaticOrder, true, true>(F.lds, g, S, E);
#ifdef REP_P7
        pg8::gemm_phase<pg8::EpiX1, pg8::StaticOrder, true, true>(F.lds, g, S, E);
#endif
        SEAM(7);
    }
    if (IN(8)) { p5a_route(F, args); SEAM(8); }
    if (IN(9)) { p5a2_scatter(F, args); SEAM(9); }
    if (IN(10)) {
        const int* t2e = (const int*)(ws + WS_T2E); const int ntl = t2e[255];
        pg8::Gemm g{(const bf16*)(ws + WS_ASORT), (const bf16*)(ws + WS_WGU), SORT_ROWS, 512, 1024, (size_t)512 * 1024 * 2}; pg8::GroupOrder S; S.init(ntl, 2, F.G, (int)blockIdx.x, t2e);
        pg8::EpiHid E{(bf16*)(ws + WS_HID)}; pg8::gemm_phase<pg8::EpiHid, pg8::GroupOrder, true, true>(F.lds, g, S, E);
#ifdef REP_P10
        pg8::gemm_phase<pg8::EpiHid, pg8::GroupOrder, true, true>(F.lds, g, S, E);
#endif
        SEAM(10);
    }
    if (IN(11)) {
        const int* t2e = (const int*)(ws + WS_T2E); const int ntl = t2e[255];
        pg8::Gemm g{(const bf16*)(ws + WS_HID), (const bf16*)(ws + WS_WD), SORT_ROWS, 1024, 256, (size_t)1024 * 256 * 2}; pg8::GroupOrder S; S.init(ntl, 4, F.G, (int)blockIdx.x, t2e);
        pg8::EpiDown E{(bf16*)(ws + WS_SLOTS), (const int*)(ws + WS_SSLOT), (const float*)(ws + WS_SW)}; pg8::gemm_phase<pg8::EpiDown, pg8::GroupOrder, true, true>(F.lds, g, S, E);
#ifdef REP_P11
        pg8::gemm_phase<pg8::EpiDown, pg8::GroupOrder, true, true>(F.lds, g, S, E);
#endif
        SEAM(11);
    }
    if (IN(12)) { p6_final(F, args); }
#ifdef DIAG_SLOW
    if (blockIdx.x == 0 && threadIdx.x == 0) { const unsigned long long t0 = __builtin_amdgcn_s_memrealtime(), wait = 100ull * __hip_atomic_load((unsigned*)(F.ctl + 1024), RLX_AGENT);
        while (__builtin_amdgcn_s_memrealtime() - t0 < wait) __builtin_amdgcn_s_sleep(16); }
#endif
#ifdef TS_A
    if (blockIdx.x == 0 && threadIdx.x == 0) { STAMP(12); __builtin_amdgcn_s_waitcnt(0);
        const unsigned long long* tsp = (const unsigned long long*)(ws + WS_CTL + 8192);
        const unsigned long long ta = __hip_atomic_load(tsp + (TS_A) + 1, RLX_AGENT), tb = __hip_atomic_load(tsp + (TS_B) + 1, RLX_AGENT);
        const unsigned long long t0 = __builtin_amdgcn_s_memrealtime(), wait = 4ull * (tb - ta);
        while (__builtin_amdgcn_s_memrealtime() - t0 < wait) __builtin_amdgcn_s_sleep(16); }
#endif
#undef IN
#undef SEAM
}

#ifndef MK_MULTI
#define MK_MULTI 0
#endif
extern "C" void kernel_launch(void* const* d_in, const int* in_sizes, int n_in, void* d_out, int out_size, void* d_ws, size_t ws_size, hipStream_t stream) {
    static int grid = 0;
    if (grid == 0) {
        if (n_in != 20 || in_sizes[0] != T * D || out_size != T * D || ws_size < WS_END) { fprintf(stderr, "kernel_launch: unexpected shapes n_in %d in0 %d out %d ws %zu\n", n_in, n_in > 0 ? in_sizes[0] : -1, out_size, ws_size); grid = -1; return; }
        int dev = 0, cus = 0;
        if (hipGetDevice(&dev) != hipSuccess || hipDeviceGetAttribute(&cus, hipDeviceAttributeMultiprocessorCount, dev) != hipSuccess) { grid = -1; return; }
        if (hipFuncSetAttribute((const void*)mk_fwd, hipFuncAttributeMaxDynamicSharedMemorySize, LDS_BYTES) != hipSuccess) { fprintf(stderr, "kernel_launch: hipFuncSetAttribute failed\n"); grid = -1; return; }
        (void)hipGetLastError();
        grid = cus;
    }
    if (grid < 0) return;
    if (hipMemsetAsync((char*)d_ws + WS_CTL, 0, CTL_ZERO_BYTES, stream) != hipSuccess) return;
    Args a{};
    for (int i = 0; i < 20; ++i) a.in[i] = (const float*)d_in[i];
    a.out = (float*)d_out; a.ws = (unsigned char*)d_ws;
#if MK_MULTI
    for (int p = 0; p < NPHASE; ++p) { a.ph_lo = p; a.ph_hi = p + 1; hipLaunchKernelGGL(mk_fwd, dim3(grid), dim3(NTHR), LDS_BYTES, stream, a); }
#else
    a.ph_lo = 0; a.ph_hi = NPHASE;
    hipLaunchKernelGGL(mk_fwd, dim3(grid), dim3(NTHR), LDS_BYTES, stream, a);
#endif
}
```

```cpp
#include <hip/hip_runtime.h>
#include <hip/hip_bf16.h>
#include <cstdio>
#include <cstdint>

#define GAS __attribute__((address_space(1)))
#define LAS __attribute__((address_space(3)))
typedef unsigned short bf16;
typedef unsigned v4u __attribute__((ext_vector_type(4)));
typedef unsigned v2u __attribute__((ext_vector_type(2)));
typedef float f32x4 __attribute__((ext_vector_type(4)));
typedef float f32x2 __attribute__((ext_vector_type(2)));
typedef float f32x16 __attribute__((ext_vector_type(16)));
typedef short bf16x8 __attribute__((ext_vector_type(8)));
typedef short s16x4 __attribute__((ext_vector_type(4)));
typedef __bf16 bf16x2_t __attribute__((ext_vector_type(2)));
typedef GAS unsigned gu32;
#define RLX_AGENT __ATOMIC_RELAXED, __HIP_MEMORY_SCOPE_AGENT
#define LDS_WAIT() asm volatile("s_waitcnt lgkmcnt(0)" ::: "memory")
#define VM_WAIT() asm volatile("s_waitcnt vmcnt(0)" ::: "memory")

constexpr int NWAVES = 8, NTHR = NWAVES * 64;
constexpr int BATCH = 2, SEQ = 8192, D = 1024, T = BATCH * SEQ;
constexpr float EPS = 1e-6f;
constexpr int NIN = 4864, NIN_SRC = 4840;
constexpr int C_CQ = 0, C_CKV = 384, C_QB = 640, C_KB = 1152, C_VB = 1664, C_QI = 2176, C_KR = 2688, C_KI = 2720, C_WI = 2784, C_GA = 2816, C_GB = 3840;
constexpr int NEXP = 32, FF = 256;
constexpr int SORT_ROWS = 2 * T + NEXP * 256;
constexpr float LOG2E = 1.4426950408889634f;
constexpr float C2A = 0.10206207261596575f * LOG2E;
constexpr float C2B = 0.125f * LOG2E;
constexpr float WI_SCALE = 0.35355339059327373f * 0.125f;

constexpr size_t MiB = 1u << 20, KiB = 1u << 10;
constexpr size_t WS_CTL = 0, CTL_ZERO_BYTES = 1 * MiB;
constexpr size_t WS_ROPE = 1 * MiB;
constexpr size_t WS_WI = 2 * MiB;
constexpr size_t WS_TOKE = 2 * MiB + 512 * KiB;
constexpr size_t WS_TOKW = WS_TOKE + 128 * KiB;
constexpr size_t WS_RSTD2 = WS_TOKW + 128 * KiB;
constexpr size_t WS_SSLOT = 3 * MiB + 512 * KiB;
constexpr size_t WS_SW = WS_SSLOT + 192 * KiB;
constexpr size_t WS_T2E = WS_SW + 192 * KiB;
constexpr size_t WS_WIN = 4 * MiB, WS_WUQ = 14 * MiB, WS_WUKV = 15 * MiB, WS_WOA = 16 * MiB, WS_WOB = 17 * MiB, WS_WOUT = 18 * MiB, WS_WGU = 20 * MiB, WS_WD = 52 * MiB;
constexpr size_t WS_H = 68 * MiB, WS_OA = 68 * MiB, WS_OB = 84 * MiB;
constexpr size_t WS_QA = 100 * MiB, WS_KN = 124 * MiB, WS_VA = 140 * MiB, WS_Y = 100 * MiB;
constexpr size_t WS_QB = 156 * MiB, WS_KB = 172 * MiB, WS_VB = 188 * MiB;
constexpr size_t WS_CQ = 204 * MiB, WS_CKV = 216 * MiB, WS_BM = 204 * MiB;
constexpr size_t WS_QI = 224 * MiB, WS_KI = 240 * MiB, WS_KR = 242 * MiB;
constexpr size_t WS_ASORT = 68 * MiB, WS_SLOTS = 156 * MiB, WS_HID = 220 * MiB;
constexpr size_t WS_PART = 244 * MiB;
constexpr size_t WS_END = 256 * MiB;
constexpr int CW_BAR = 4096;
constexpr int CW_Q1 = 64, CW_Q2 = 128;
constexpr int CW_CNT = 256, CW_FILL = 320;
constexpr int CW_RDY = 8192;

constexpr int LDS_BYTES = 147456;
constexpr int MISC_OFF = 147456 - 512;

__device__ __forceinline__ unsigned f2bf(float f) { unsigned u = __builtin_bit_cast(unsigned, f); return (u + 0x7fffu + ((u >> 16) & 1u)) >> 16; }
__device__ __forceinline__ unsigned pk2(float lo, float hi) { f32x2 v = {lo, hi}; bf16x2_t b = __builtin_convertvector(v, bf16x2_t); return __builtin_bit_cast(unsigned, b); }
__device__ __forceinline__ float bflo(unsigned w) { return __builtin_bit_cast(float, w << 16); }
__device__ __forceinline__ float bfhi(unsigned w) { return __builtin_bit_cast(float, w & 0xffff0000u); }

#define XB_TMO      128
#define XB_XCNT(j)  (256  + 64 * (j))
#define XB_XSUB(j)  (1280 + 64 * (j))
#define XB_XGEN(j)  (2304 + 64 * (j))
#define XB_TOP      3328
#define XB_TOPGEN   3392
#define XCD_BAR_WORDS 3456
#define XB_SPIN_CAP (1u << 22)
__device__ __forceinline__ unsigned xb_ld(unsigned* p)              { return __hip_atomic_load(p, __ATOMIC_RELAXED, __HIP_MEMORY_SCOPE_AGENT); }
__device__ __forceinline__ unsigned xb_add(unsigned* p, unsigned v) { return __hip_atomic_fetch_add(p, v, __ATOMIC_RELAXED, __HIP_MEMORY_SCOPE_AGENT); }
__device__ __forceinline__ unsigned xb_xcc_id() { return (unsigned)__builtin_amdgcn_s_getreg((3 << 11) | 20) & 0xFu; }
#define XB_SPIN(cond, bar) do { unsigned _sp = 0; while (cond) { __builtin_amdgcn_s_sleep(1); \
    if ((++_sp & 255u) == 0u) { if (xb_ld(&(bar)[XB_TMO])) break; if (_sp > XB_SPIN_CAP) { atomicAdd(&(bar)[XB_TMO], 1u); break; } } } } while (0)
struct XcdBarrier { unsigned* bar; unsigned x; volatile LAS unsigned* st; };
__device__ __forceinline__ XcdBarrier xcd_barrier_post(unsigned* bar, volatile LAS unsigned* st) {
    XcdBarrier b; b.bar = bar; b.x = xb_xcc_id(); b.st = st;
    if (threadIdx.x == 0) (void)xb_add(&bar[XB_XCNT(b.x)], 1u);
    return b;
}
__device__ __forceinline__ void xcd_barrier_complete(unsigned* bar, unsigned x, unsigned& nloc, unsigned& nx) {
    const unsigned G = gridDim.x * gridDim.y * gridDim.z;
    unsigned sum, cnt, mine, sp = 0u;
    for (;;) {
        sum = 0u; cnt = 0u; mine = 0u;
#pragma unroll
        for (unsigned j = 0; j < 16; ++j) { const unsigned c = xb_ld(&bar[XB_XCNT(j)]); sum += c; cnt += (c > 0u) ? 1u : 0u; mine = (j == x) ? c : mine; }
        if (sum == G) break;
        __builtin_amdgcn_s_sleep(1);
        if ((++sp & 255u) == 0u) { if (xb_ld(&bar[XB_TMO])) break; if (sp > XB_SPIN_CAP) { atomicAdd(&bar[XB_TMO], 1u); break; } }
    }
    nloc = mine > 0u ? mine : 1u; nx = cnt > 0u ? cnt : 1u;
}
__device__ __forceinline__ void xcd_barrier(const XcdBarrier& b) {
    asm volatile("s_waitcnt vmcnt(0)" ::: "memory");
    __syncthreads();
    if (threadIdx.x == 0) {
        unsigned* bar = b.bar;
        __builtin_amdgcn_s_waitcnt(0);
        unsigned nloc = b.st[0], nx = b.st[1];
        if (nloc == 0u) { xcd_barrier_complete(bar, b.x, nloc, nx); b.st[0] = nloc; b.st[1] = nx; }
        const unsigned old = xb_add(&bar[XB_XSUB(b.x)], 1u);
        const unsigned gen = old / nloc;
        if (old + 1u == (gen + 1u) * nloc) {
            __builtin_amdgcn_fence(__ATOMIC_RELEASE, "agent");
            asm volatile("s_waitcnt vmcnt(0)" ::: "memory");
            const unsigned og = xb_add(&bar[XB_TOP], 1u);
            const unsigned tg = og / nx;
            if (og + 1u == (tg + 1u) * nx) xb_add(&bar[XB_TOPGEN], 1u);
            else XB_SPIN(xb_ld(&bar[XB_TOPGEN]) == tg, bar);
            __builtin_amdgcn_fence(__ATOMIC_ACQUIRE, "agent");
            xb_add(&bar[XB_XGEN(b.x)], 1u);
            asm volatile("s_waitcnt vmcnt(0)" ::: "memory");
        } else {
            XB_SPIN(xb_ld(&bar[XB_XGEN(b.x)]) == gen, bar);
            __builtin_amdgcn_fence(__ATOMIC_ACQUIRE, "agent");
            asm volatile("s_waitcnt vmcnt(0)" ::: "memory");
        }
    }
    __syncthreads();
}

__device__ __forceinline__ float wave_sum(float v) {
#pragma unroll
    for (int o = 1; o < 64; o <<= 1) v += __shfl_xor(v, o);
    return v;
}

namespace pg8 {
#define PG8_LAS __attribute__((address_space(3)))
typedef unsigned short bf16_t;
typedef unsigned u32x4 __attribute__((ext_vector_type(4)));
constexpr int BM = 256, BK = 64, HALF = 128, HTB = HALF * BK * 2, STAGE_BYTES = 8 * HTB, NXCD = 8, WGM = 8;
__host__ __device__ __forceinline__ int lds_byte(int r, int c) { const int st = (r >> 4) * 2 + (c >> 5), rr = r & 15, cc = c & 31, ob = rr * 64 + cc * 2; return st * 1024 + (ob ^ (((ob >> 9) & 1) << 5)); }
__host__ __device__ __forceinline__ void stage_rc(int b, int& R, int& C) { const int st = b / 1024, sb = b % 1024, swz = sb ^ (((sb >> 9) & 1) << 5); R = (st >> 1) * 16 + swz / 64; C = (st & 1) * 32 + (swz % 64) / 2; }
__host__ __device__ __forceinline__ int perm32(int rho) { const int n = rho >> 4, i = rho & 15; return 8 * (i >> 2) + 4 * n + (i & 3); }

struct Unit { int pm, pn, e; };
struct Gemm { const bf16_t* A; const bf16_t* Bt; int M, N, K; size_t estride; };

struct StaticOrder {
    int nM, nN, nwg, G, c;
    __host__ __device__ void init(int M, int N, int G_, int c_) { nM = M / BM; nN = N / BM; nwg = nM * nN; G = G_; c = c_; }
    __host__ __device__ __forceinline__ bool next(int i, Unit& u) const {
        const long L = (long)i * G + c; if (L >= nwg) return false;
        int wgid = (int)L; { const int q = nwg / NXCD, r = nwg % NXCD, xcd = wgid % NXCD, off = wgid / NXCD; wgid = (xcd < r ? xcd * (q + 1) : r * (q + 1) + (xcd - r) * q) + off; }
        const int nig = WGM * nN, gid = wgid / nig, fm = gid * WGM, gsz = (nM - fm) < WGM ? (nM - fm) : WGM;
        u.pm = fm + ((wgid % nig) % gsz); u.pn = (wgid % nig) / gsz; u.e = 0; return true;
    }
    __device__ __forceinline__ void a_ready(const Unit&) const {}
    __device__ __forceinline__ void done(const Unit&) const {}
};
struct GroupOrder {
    int nN, total, G, c; const int* t2e;
    __device__ void init(int nTiles, int nN_, int G_, int c_, const int* t2e_) { nN = nN_; total = nTiles * nN_; G = G_; c = c_; t2e = t2e_; }
    __device__ bool next(int i, Unit& u) const {
        const long L = (long)i * G + c; if (L >= total) return false;
        u.pm = (int)(L / nN); u.pn = (int)(L % nN); u.e = __builtin_amdgcn_readfirstlane(t2e[u.pm]); return true;
    }
    __device__ __forceinline__ void a_ready(const Unit&) const {}
    __device__ __forceinline__ void done(const Unit&) const {}
};

__device__ __forceinline__ void st8(bf16_t* p, f32x4 v0, f32x4 v1) { u32x4 w; w.x = pk2(v0[0], v0[1]); w.y = pk2(v0[2], v0[3]); w.z = pk2(v1[0], v1[1]); w.w = pk2(v1[2], v1[3]); *(u32x4*)p = w; }
__device__ __forceinline__ void ld8(const bf16_t* p, f32x4& v0, f32x4& v1) { const u32x4 w = *(const u32x4*)p; v0 = (f32x4){bflo(w.x), bfhi(w.x), bflo(w.y), bfhi(w.y)}; v1 = (f32x4){bflo(w.z), bfhi(w.z), bflo(w.w), bfhi(w.w)}; }

__device__ __forceinline__ void rope16(f32x4& v0, f32x4& v1, int row, int fq, const f32x2* rope) {
    const f32x2* rp = rope + (size_t)(row & (SEQ - 1)) * 16;
    f32x4 p0, p1;
#pragma unroll
    for (int e = 0; e < 4; ++e) { p0[e] = __shfl_xor(v0[e], 16); p1[e] = __shfl_xor(v1[e], 16); }
    if (fq < 2) {
        const float sg = fq == 0 ? -1.f : 1.f;
#pragma unroll
        for (int e = 0; e < 4; ++e) { const f32x2 a = rp[2 * e], b = rp[2 * (4 + e)];
            v0[e] = v0[e] * a.x + sg * p0[e] * a.y; v1[e] = v1[e] * b.x + sg * p1[e] * b.y; }
    }
}
__device__ __forceinline__ void rope32(f32x4& v0, f32x4& v1, int row, int fq, const f32x2* rope) {
    const f32x2* rp = rope + (size_t)(row & (SEQ - 1)) * 16 + 8 * (fq & 1);
    const float sg = fq < 2 ? -1.f : 1.f;
#pragma unroll
    for (int e = 0; e < 4; ++e) { const float p0 = __shfl_xor(v0[e], 32), p1 = __shfl_xor(v1[e], 32); const f32x2 a = rp[e], b = rp[4 + e];
        v0[e] = v0[e] * a.x + sg * p0 * a.y; v1[e] = v1[e] * b.x + sg * p1 * b.y; }
}
__device__ __forceinline__ float sigmoidf_(float x) { return __builtin_amdgcn_rcpf(1.f + __builtin_amdgcn_exp2f(-1.4426950408889634f * x)); }

struct EpiIn {
    static constexpr bool PERM = true, AFTER_DRAIN = false;
    bf16_t *CQ, *CKV, *QB, *KB, *VB, *QI, *KI, *KR, *GA, *GB; float* WI; const f32x2* rope; float* PART;
    __device__ __forceinline__ void operator()(const f32x4 (&acc)[2][2][4][2], const Unit& u, int wr, int wc, int fr, int fq) const {
        const int row0 = u.pm * BM + wr * 64 + fr;
#pragma unroll
        for (int bj = 0; bj < 2; ++bj) {
            const int cg = u.pn * BM + bj * HALF + wc * 32;
            bf16_t* base = nullptr; int pitch = 0, cc = 0, mode = 0; float sc = 1.f;
            if (cg < C_CKV) { base = CQ; pitch = 384; cc = cg; }
            else if (cg < C_QB) { base = CKV; pitch = 256; cc = cg - C_CKV; }
            else if (cg < C_KB) { base = QB; pitch = 512; cc = cg - C_QB; mode = ((cc >> 5) & 1) == 0 ? 1 : 0; sc = C2B; }
            else if (cg < C_VB) { base = KB; pitch = 512; cc = cg - C_KB; mode = ((cc >> 5) & 1) == 0 ? 1 : 0; }
            else if (cg < C_QI) { base = VB; pitch = 512; cc = cg - C_VB; }
            else if (cg < C_KR) { base = QI; pitch = 512; cc = cg - C_QI; mode = ((cc >> 5) & 1) == 0 ? 1 : 0; }
            else if (cg < C_KI) { base = KR; pitch = 32; cc = 0; mode = 2; }
            else if (cg < C_WI) { base = KI; pitch = 64; cc = cg - C_KI; mode = (cc == 0) ? 1 : 0; }
            else if (cg < C_GA) { mode = 4; }
            else if (cg < C_GB) { base = GA; pitch = 1024; cc = cg - C_GA; mode = 3; }
            else { base = GB; pitch = 1024; cc = cg - C_GB; mode = 3; }
#pragma unroll
            for (int ai = 0; ai < 2; ++ai)
#pragma unroll
                for (int m = 0; m < 4; ++m) {
                    const int row = row0 + ai * HALF + m * 16;
                    f32x4 v0 = acc[ai][bj][m][0], v1 = acc[ai][bj][m][1];
                    if (mode == 1) rope16(v0, v1, row, fq, rope);
                    else if (mode == 2) rope32(v0, v1, row, fq, rope);
                    else if (mode == 3) {
#pragma unroll
                        for (int e = 0; e < 4; ++e) { v0[e] = sigmoidf_(v0[e]); v1[e] = sigmoidf_(v1[e]); } }
                    if (cg < C_QB) {
                        float ss = ((v0[0] * v0[0] + v0[1] * v0[1]) + (v0[2] * v0[2] + v0[3] * v0[3])) + ((v1[0] * v1[0] + v1[1] * v1[1]) + (v1[2] * v1[2] + v1[3] * v1[3]));
                        ss += __shfl_xor(ss, 16); ss += __shfl_xor(ss, 32);
                        if (fq == 0) PART[(size_t)row * 20 + (cg >> 5)] = ss; }
                    if (mode == 4) { if (fq == 0) { *(f32x4*)(WI + (size_t)row * 8) = v0 * WI_SCALE; *(f32x4*)(WI + (size_t)row * 8 + 4) = v1 * WI_SCALE; } }
                    else { v0 = v0 * sc; v1 = v1 * sc; st8(base + (size_t)row * pitch + cc + 8 * fq, v0, v1); }
                }
        }
    }
};
struct EpiQA {
    static constexpr bool PERM = true, AFTER_DRAIN = false;
    bf16_t* QA; const f32x2* rope; const PG8_LAS float* RS;
    __device__ __forceinline__ void operator()(const f32x4 (&acc)[2][2][4][2], const Unit& u, int wr, int wc, int fr, int fq) const {
        const int row0 = u.pm * BM + wr * 64 + fr; const PG8_LAS float* rsp = RS + wr * 64 + fr;
#pragma unroll
        for (int bj = 0; bj < 2; ++bj) {
            const int cg = u.pn * BM + bj * HALF + wc * 32; const bool rot = ((cg >> 5) % 3) == 2;
#pragma unroll
            for (int ai = 0; ai < 2; ++ai)
#pragma unroll
                for (int m = 0; m < 4; ++m) {
                    const int row = row0 + ai * HALF + m * 16;
                    f32x4 v0 = acc[ai][bj][m][0], v1 = acc[ai][bj][m][1];
                    if (rot) rope32(v0, v1, row, fq, rope);
                    { const float rsv = rsp[ai * HALF + m * 16]; v0 = v0 * rsv; v1 = v1 * rsv; } st8(QA + (size_t)row * 768 + cg + 8 * fq, v0, v1);
                }
        }
    }
};
struct EpiKV {
    static constexpr bool PERM = true, AFTER_DRAIN = false;
    bf16_t *KN, *VA; const PG8_LAS float* RS;
    __device__ __forceinline__ void operator()(const f32x4 (&acc)[2][2][4][2], const Unit& u, int wr, int wc, int fr, int fq) const {
        const int row0 = u.pm * BM + wr * 64 + fr; const PG8_LAS float* rsp = RS + wr * 64 + fr;
#pragma unroll
        for (int bj = 0; bj < 2; ++bj) {
            const int cg = u.pn * BM + bj * HALF + wc * 32; bf16_t* base = cg < 512 ? KN : VA; const int cc = (cg & 511) + 8 * fq;
#pragma unroll
            for (int ai = 0; ai < 2; ++ai)
#pragma unroll
                for (int m = 0; m < 4; ++m) { const int row = row0 + ai * HALF + m * 16; const float rsv = rsp[ai * HALF + m * 16]; st8(base + (size_t)row * 512 + cc, acc[ai][bj][m][0] * rsv, acc[ai][bj][m][1] * rsv); }
        }
    }
};
template <int ADD> struct EpiY {
    static constexpr bool PERM = true, AFTER_DRAIN = false;
    bf16_t* Y; const bf16_t* Gt;
    __device__ __forceinline__ void operator()(const f32x4 (&acc)[2][2][4][2], const Unit& u, int wr, int wc, int fr, int fq) const {
        const int row0 = u.pm * BM + wr * 64 + fr;
#pragma unroll
        for (int bj = 0; bj < 2; ++bj) {
            const int c0 = u.pn * BM + bj * HALF + wc * 32 + 8 * fq;
#pragma unroll
            for (int ai = 0; ai < 2; ++ai)
#pragma unroll
                for (int m = 0; m < 4; ++m) { const size_t off = (size_t)(row0 + ai * HALF + m * 16) * 1024 + c0;
                    f32x4 g0, g1; ld8(Gt + off, g0, g1);
                    f32x4 v0 = acc[ai][bj][m][0] * g0, v1 = acc[ai][bj][m][1] * g1;
                    if (ADD) { f32x4 o0, o1; ld8(Y + off, o0, o1); v0 = v0 + o0; v1 = v1 + o1; }
                    st8(Y + off, v0, v1); }
        }
    }
};
struct EpiX1 {
    static constexpr bool PERM = false, AFTER_DRAIN = false;
    const float* X; float* O;
    __device__ __forceinline__ void operator()(const f32x4 (&acc)[2][2][4][2], const Unit& u, int wr, int wc, int fr, int fq) const {
        const int row0 = u.pm * BM + wr * 64 + fr, col0 = u.pn * BM + wc * 32 + 4 * fq;
#pragma unroll
        for (int ai = 0; ai < 2; ++ai)
#pragma unroll
            for (int m = 0; m < 4; ++m) { const size_t off = (size_t)(row0 + ai * HALF + m * 16) * 1024 + col0;
#pragma unroll
                for (int bj = 0; bj < 2; ++bj)
#pragma unroll
                    for (int n = 0; n < 2; ++n) { const f32x4 xv = *(const f32x4*)(X + off + bj * HALF + n * 16); *(f32x4*)(O + off + bj * HALF + n * 16) = xv + acc[ai][bj][m][n]; } }
    }
};
struct EpiHid {
    static constexpr bool PERM = true, AFTER_DRAIN = false;
    bf16_t* HID;
    __device__ __forceinline__ void operator()(const f32x4 (&acc)[2][2][4][2], const Unit& u, int wr, int wc, int fr, int fq) const {
        const int row0 = u.pm * BM + wr * 64 + fr, c0 = u.pn * 128 + wc * 32 + 8 * fq;
#pragma unroll
        for (int ai = 0; ai < 2; ++ai)
#pragma unroll
            for (int m = 0; m < 4; ++m) { f32x4 h0, h1;
#pragma unroll
                for (int e = 0; e < 4; ++e) { const float g0 = acc[ai][0][m][0][e], g1 = acc[ai][0][m][1][e];
                    h0[e] = g0 * sigmoidf_(g0) * acc[ai][1][m][0][e]; h1[e] = g1 * sigmoidf_(g1) * acc[ai][1][m][1][e]; }
                st8(HID + (size_t)(row0 + ai * HALF + m * 16) * 256 + c0, h0, h1); }
    }
};
struct EpiDown {
    static constexpr bool PERM = true, AFTER_DRAIN = false;
    bf16_t* SL; const int* sslot; const float* sw;
    __device__ __forceinline__ void operator()(const f32x4 (&acc)[2][2][4][2], const Unit& u, int wr, int wc, int fr, int fq) const {
        const int row0 = u.pm * BM + wr * 64 + fr;
#pragma unroll
        for (int ai = 0; ai < 2; ++ai)
#pragma unroll
            for (int m = 0; m < 4; ++m) { const int r = row0 + ai * HALF + m * 16; const int slot = sslot[r]; const float w = sw[r];
                if (slot >= 0) {
#pragma unroll
                    for (int bj = 0; bj < 2; ++bj) st8(SL + (size_t)slot * 1024 + u.pn * BM + bj * HALF + wc * 32 + 8 * fq, acc[ai][bj][m][0] * w, acc[ai][bj][m][1] * w); } }
    }
};
template <class Epi, class Sched, bool ALIGN_EPI = false, bool SP2 = false>
__device__ __forceinline__ void gemm_phase(PG8_LAS unsigned char* lds, const Gemm g, const Sched& S, const Epi& E) {
    const int tid = threadIdx.x, wid = __builtin_amdgcn_readfirstlane(tid >> 6), lane = tid & 63, wr = wid >> 2, wc = wid & 3, fr = lane & 15, fq = lane >> 4;
    const int K = g.K, nt = K / BK;
    unsigned voffA[2], voffB[2];
#pragma unroll
    for (int i = 0; i < 2; ++i) { int R, C; stage_rc(tid * 16 + i * 8192, R, C); const int Rb = Epi::PERM ? ((R & ~31) + perm32(R & 31)) : R;
        voffA[i] = (unsigned)(R * K + C) * 2u; voffB[i] = (unsigned)(Rb * K + C) * 2u; }
    const size_t kstep = (size_t)(BK * 2);
    const size_t hstep = (size_t)HALF * K * 2;
    const size_t tstep = 2 * hstep;
    const unsigned ldsw = (unsigned)wid * 1024u;
    const int aoff = lds_byte(wr * 64 + fr, fq * 8), boff = lds_byte(wc * 32 + fr, fq * 8);
#define PG8_SA(b, h) (((b) * 2 + (h)) * HTB)
#define PG8_SB(b, h) ((4 + (b) * 2 + (h)) * HTB)
#define PG8_STAGE(bufoff, gbase, voff) do { _Pragma("unroll") for (int _i = 0; _i < 2; ++_i) \
        __builtin_amdgcn_global_load_lds((const unsigned*)((const char*)(gbase) + (voff)[_i]), (PG8_LAS unsigned*)(lds + (bufoff) + ldsw + _i * 8192), 16, 0, 0); } while (0)
#define PG8_LDA(dst, b, h) do { _Pragma("unroll") for (int m = 0; m < 4; ++m) _Pragma("unroll") for (int k = 0; k < 2; ++k) dst[m][k] = *(const PG8_LAS bf16x8*)(lds + PG8_SA(b, h) + aoff + m * 2048 + k * 1024); } while (0)
#define PG8_LDB(dst, b, h) do { _Pragma("unroll") for (int n = 0; n < 2; ++n) _Pragma("unroll") for (int k = 0; k < 2; ++k) dst[n][k] = *(const PG8_LAS bf16x8*)(lds + PG8_SB(b, h) + boff + n * 2048 + k * 1024); } while (0)
#define PG8_MMA(ai, bj, At, Bt) do { __builtin_amdgcn_s_setprio(1); _Pragma("unroll") for (int m = 0; m < 4; ++m) _Pragma("unroll") for (int n = 0; n < 2; ++n) _Pragma("unroll") for (int k = 0; k < 2; ++k) \
        acc[ai][bj][m][n] = __builtin_amdgcn_mfma_f32_16x16x32_bf16(Bt[n][k], At[m][k], acc[ai][bj][m][n], 0, 0, 0); __builtin_amdgcn_s_setprio(0); } while (0)
#define PG8_WAIT_V(n) asm volatile("s_waitcnt vmcnt(" #n ")" ::: "memory")
#define PG8_WAIT_L(n) asm volatile("s_waitcnt lgkmcnt(" #n ")" ::: "memory")
#define PG8_BAR __builtin_amdgcn_s_barrier()
#define PG8_SCHED __builtin_amdgcn_sched_barrier(0)
    Unit cur, nxt; int ui = 0;
    if (!S.next(0, cur)) return;
    f32x4 acc[2][2][4][2];
#pragma unroll
    for (int a = 0; a < 2; ++a)
#pragma unroll
        for (int b = 0; b < 2; ++b)
#pragma unroll
            for (int m = 0; m < 4; ++m)
#pragma unroll
                for (int n = 0; n < 2; ++n) acc[a][b][m][n] = (f32x4){0.f, 0.f, 0.f, 0.f};
    bf16x8 At[4][2], B0[2][2], B1[2][2];
    const char* cA = (const char*)g.A + (size_t)cur.pm * tstep; const char* cB = (const char*)g.Bt + (size_t)cur.e * g.estride + (size_t)cur.pn * tstep;
    S.a_ready(cur);
    if constexpr (SP2) {
        PG8_STAGE(PG8_SB(0, 0), cB, voffB); PG8_STAGE(PG8_SB(0, 1), cB + hstep, voffB); PG8_STAGE(PG8_SA(0, 0), cA, voffA); PG8_STAGE(PG8_SA(0, 1), cA + hstep, voffA);
        if (wr == 1) PG8_BAR;
        PG8_WAIT_V(2); PG8_BAR;
        PG8_STAGE(PG8_SB(1, 0), cB + kstep, voffB); PG8_STAGE(PG8_SA(1, 0), cA + kstep, voffA); PG8_STAGE(PG8_SB(1, 1), cB + hstep + kstep, voffB);
        PG8_WAIT_V(6); PG8_BAR;
    } else {
        PG8_STAGE(PG8_SB(0, 0), cB, voffB); PG8_STAGE(PG8_SA(0, 0), cA, voffA); PG8_STAGE(PG8_SB(0, 1), cB + hstep, voffB); PG8_STAGE(PG8_SA(0, 1), cA + hstep, voffA);
        if (wr == 1) PG8_BAR;
        PG8_WAIT_V(4); PG8_BAR;
        PG8_STAGE(PG8_SB(1, 0), cB + kstep, voffB); PG8_STAGE(PG8_SA(1, 0), cA + kstep, voffA); PG8_STAGE(PG8_SB(1, 1), cB + hstep + kstep, voffB);
        PG8_WAIT_V(6); PG8_BAR;
    }
    for (;;) {
        const bool has_next = S.next(ui + 1, nxt);
        const char* nA = has_next ? (const char*)g.A + (size_t)nxt.pm * tstep : cA; const char* nB = has_next ? (const char*)g.Bt + (size_t)nxt.e * g.estride + (size_t)nxt.pn * tstep : cB;
#pragma nounroll
        for (int t = 0; t < nt; t += 2) {
            const bool last = (t == nt - 2);
            const char* a1 = cA + (size_t)(t + 1) * kstep;
            const char* a2 = last ? nA : cA + (size_t)(t + 2) * kstep; const char* b2 = last ? nB : cB + (size_t)(t + 2) * kstep;
            const char* a3 = a2 + kstep; const char* b3 = b2 + kstep;
            if (last && has_next) S.a_ready(nxt);
            if constexpr (SP2) {
            PG8_LDB(B0, 0, 0); PG8_LDB(B1, 0, 1); PG8_SCHED; PG8_LDA(At, 0, 0); PG8_STAGE(PG8_SA(1, 1), a1 + hstep, voffA);
            PG8_WAIT_V(8); PG8_WAIT_L(0); PG8_BAR; PG8_MMA(0, 0, At, B0); PG8_MMA(0, 1, At, B1); PG8_BAR; PG8_SCHED;
            PG8_LDA(At, 0, 1); PG8_STAGE(PG8_SB(0, 0), b2, voffB); PG8_STAGE(PG8_SB(0, 1), b2 + hstep, voffB); PG8_STAGE(PG8_SA(0, 0), a2, voffA);
            PG8_WAIT_V(8); PG8_WAIT_L(0); PG8_BAR; PG8_MMA(1, 0, At, B0); PG8_MMA(1, 1, At, B1); PG8_BAR; PG8_SCHED;
            PG8_LDB(B0, 1, 0); PG8_LDB(B1, 1, 1); PG8_SCHED; PG8_LDA(At, 1, 0); PG8_STAGE(PG8_SA(0, 1), a2 + hstep, voffA);
            PG8_WAIT_V(8); PG8_WAIT_L(0); PG8_BAR; PG8_MMA(0, 0, At, B0); PG8_MMA(0, 1, At, B1); PG8_BAR; PG8_SCHED;
            PG8_LDA(At, 1, 1); PG8_STAGE(PG8_SB(1, 0), b3, voffB); PG8_STAGE(PG8_SB(1, 1), b3 + hstep, voffB); PG8_STAGE(PG8_SA(1, 0), a3, voffA);
            PG8_WAIT_V(8); PG8_WAIT_L(0); PG8_BAR; PG8_MMA(1, 0, At, B0); PG8_MMA(1, 1, At, B1); PG8_BAR; PG8_SCHED;
            } else {
            PG8_LDB(B0, 0, 0); PG8_SCHED; PG8_LDA(At, 0, 0); PG8_STAGE(PG8_SA(1, 1), a1 + hstep, voffA);
            PG8_WAIT_L(8); PG8_BAR; PG8_WAIT_L(0); PG8_MMA(0, 0, At, B0); PG8_BAR; PG8_SCHED;
            PG8_LDB(B1, 0, 1); PG8_STAGE(PG8_SB(0, 0), b2, voffB);
            PG8_BAR; PG8_WAIT_L(0); PG8_MMA(0, 1, At, B1); PG8_BAR;
            PG8_LDA(At, 0, 1); PG8_STAGE(PG8_SA(0, 0), a2, voffA);
            PG8_BAR; PG8_WAIT_L(0); PG8_MMA(1, 0, At, B0); PG8_BAR; PG8_SCHED;
            PG8_STAGE(PG8_SB(0, 1), b2 + hstep, voffB);
            PG8_WAIT_V(6); PG8_BAR; PG8_MMA(1, 1, At, B1); PG8_BAR;
            PG8_LDB(B0, 1, 0); PG8_SCHED; PG8_LDA(At, 1, 0); PG8_STAGE(PG8_SA(0, 1), a2 + hstep, voffA);
            PG8_WAIT_L(8); PG8_BAR; PG8_WAIT_L(0); PG8_MMA(0, 0, At, B0); PG8_BAR; PG8_SCHED;
            PG8_LDB(B1, 1, 1); PG8_STAGE(PG8_SB(1, 0), b3, voffB);
            PG8_BAR; PG8_WAIT_L(0); PG8_MMA(0, 1, At, B1); PG8_BAR;
            PG8_LDA(At, 1, 1); PG8_STAGE(PG8_SA(1, 0), a3, voffA);
            PG8_BAR; PG8_WAIT_L(0); PG8_MMA(1, 0, At, B0); PG8_BAR; PG8_SCHED;
            PG8_STAGE(PG8_SB(1, 1), b3 + hstep, voffB);
            PG8_WAIT_V(6); PG8_BAR; PG8_MMA(1, 1, At, B1); PG8_BAR;
            }
        }
        if constexpr (ALIGN_EPI) { if (wr == 0) PG8_BAR; }
        if constexpr (!Epi::AFTER_DRAIN) { E(acc, cur, wr, wc, fr, fq); S.done(cur); }
        if (!has_next) break;
#pragma unroll
        for (int a = 0; a < 2; ++a)
#pragma unroll
            for (int b = 0; b < 2; ++b)
#pragma unroll
                for (int m = 0; m < 4; ++m)
#pragma unroll
                    for (int n = 0; n < 2; ++n) acc[a][b][m][n] = (f32x4){0.f, 0.f, 0.f, 0.f};
        cur = nxt; cA = nA; cB = nB; ++ui;
        if constexpr (ALIGN_EPI) { if (wr == 1) PG8_BAR; }
    }
    PG8_WAIT_V(0);
    if constexpr (!ALIGN_EPI) { if (wr == 0) PG8_BAR; }
    PG8_BAR;
    if constexpr (Epi::AFTER_DRAIN) { E.fused(acc, cur, wr, wc, fr, fq, lds, wid, lane); S.done(cur); }
#undef PG8_SA
#undef PG8_SB
#undef PG8_STAGE
#undef PG8_LDA
#undef PG8_LDB
#undef PG8_MMA
#undef PG8_WAIT_V
#undef PG8_WAIT_L
#undef PG8_BAR
#undef PG8_SCHED
}
}

struct Args { const float* in[20]; float* out; unsigned char* ws; int ph_lo, ph_hi; };
struct Frame {
    LAS unsigned char* lds; volatile LAS unsigned* MISC; gu32* ctl; unsigned char* ws;
    int vcu, G;
};
#define F_TID ((int)threadIdx.x)
#define F_LANE ((int)(threadIdx.x & 63))
#define F_WAVE (__builtin_amdgcn_readfirstlane((int)(threadIdx.x >> 6)))

__device__ __forceinline__ int in_src_col(int n) {
    if (n < 640) return n;
    if (n < 2688) return n + 32;
    if (n < 2720) return n - 2688 + 640;
    if (n < 2792) return n;
    if (n < 2816) return -1;
    return n - 24;
}
struct TrDesc { const float* colptr; int ld, k0; bf16* WT; int Kd, destrow0; const float* gain; };
__device__ __forceinline__ void tr_load(const TrDesc& d, int lane, f32x4 (&v)[16]) {
    const int kr = lane >> 4;
#pragma unroll
    for (int it = 0; it < 16; ++it) { const int kk = 4 * it + kr; v[it] = (f32x4){0.f, 0.f, 0.f, 0.f}; if (d.colptr) v[it] = *(const GAS f32x4*)(d.colptr + (size_t)(d.k0 + kk) * d.ld); if (d.gain) v[it] = v[it] * d.gain[d.k0 + kk]; }
}
__device__ __forceinline__ void tr_store(const TrDesc& d, int lane, const f32x4 (&v)[16], LAS float* scr) {
    const int nq = lane & 15, kr = lane >> 4;
#pragma unroll
    for (int it = 0; it < 16; ++it) { const int kk = 4 * it + kr; LAS float* q = scr + kk * 65 + 4 * nq; q[0] = v[it].x; q[1] = v[it].y; q[2] = v[it].z; q[3] = v[it].w; }
    LDS_WAIT(); asm volatile("" ::: "memory");
    const int c = lane & 7;
#pragma unroll
    for (int j = 0; j < 8; ++j) { const int n = (lane >> 3) + 8 * j; const LAS float* q = scr + (8 * c) * 65 + n;
        v4u o; o.x = pk2(q[0 * 65], q[1 * 65]); o.y = pk2(q[2 * 65], q[3 * 65]); o.z = pk2(q[4 * 65], q[5 * 65]); o.w = pk2(q[6 * 65], q[7 * 65]);
        *(GAS v4u*)(d.WT + (size_t)(d.destrow0 + n) * d.Kd + d.k0 + 8 * c) = o; }
    LDS_WAIT(); asm volatile("" ::: "memory");
}
constexpr int CV_I0 = 16 * 76, CV_I1 = 6 * 12, CV_I2 = 4 * 16, CV_I3 = 8 * 16, CV_I4 = 8 * 16, CV_I5 = 16 * 16, CV_I6 = 32 * 16 * 8, CV_I7 = 32 * 4 * 16;
constexpr int CV_EARLY = CV_I0 + CV_I1 + CV_I2, CV_LATE = CV_I3 + CV_I4 + CV_I5 + CV_I6 + CV_I7, CV_QITEMS = CV_LATE / 16;
static_assert(CV_LATE % 16 == 0, "late conversion tiles come in queue items of 16");
__device__ __forceinline__ TrDesc conv_desc(const Args& A, unsigned char* ws, int it, int lane) {
    const int n4 = 4 * (lane & 15);
    int r = it;
    if (r < CV_I0) { const int kb = r / 76, nb = r % 76; const int col = in_src_col(64 * nb + n4);
        return TrDesc{col >= 0 ? A.in[2] + col : nullptr, NIN_SRC, 64 * kb, (bf16*)(ws + WS_WIN), 1024, 64 * nb, nullptr}; } r -= CV_I0;
    if (r < CV_I1) { const int kb = r / 12, nb = r % 12; return TrDesc{A.in[4] + 64 * nb + n4, 768, 64 * kb, (bf16*)(ws + WS_WUQ), 384, 64 * nb, A.in[3]}; } r -= CV_I1;
    if (r < CV_I2) { const int kb = r / 16, nb = r % 16; const int n = 64 * nb + n4;
        return TrDesc{n < 512 ? A.in[6] + n : A.in[7] + (n - 512), 512, 64 * kb, (bf16*)(ws + WS_WUKV), 256, 64 * nb, A.in[5]}; } r -= CV_I2;
    if (r < CV_I3) { const int kb = r / 16, nb = r % 16; return TrDesc{A.in[8] + 64 * nb + n4, 1024, 64 * kb, (bf16*)(ws + WS_WOA), 512, 64 * nb, nullptr}; } r -= CV_I3;
    if (r < CV_I4) { const int kb = r / 16, nb = r % 16; return TrDesc{A.in[9] + 64 * nb + n4, 1024, 64 * kb, (bf16*)(ws + WS_WOB), 512, 64 * nb, nullptr}; } r -= CV_I4;
    if (r < CV_I5) { const int kb = r / 16, nb = r % 16; return TrDesc{A.in[10] + 64 * nb + n4, 1024, 64 * kb, (bf16*)(ws + WS_WOUT), 1024, 64 * nb, nullptr}; } r -= CV_I5;
    if (r < CV_I6) { const int e = r / 128, rr = r % 128, kb = rr / 8, nb = rr % 8; const int n = 64 * nb + n4, pn = n >> 8, c = n & 255, col = 128 * pn + (c & 127);
        const float* src = ((c >> 7) ? A.in[17] : A.in[16]) + (size_t)e * 1024 * 256 + col;
        return TrDesc{src, 256, 64 * kb, (bf16*)(ws + WS_WGU) + (size_t)e * 512 * 1024, 1024, 64 * nb, nullptr}; } r -= CV_I6;
    { const int e = r / 64, rr = r % 64, kb = rr / 16, nb = rr % 16;
        return TrDesc{A.in[18] + (size_t)e * 256 * 1024 + 64 * nb + n4, 1024, 64 * kb, (bf16*)(ws + WS_WD) + (size_t)e * 1024 * 256, 256, 64 * nb, nullptr}; }
}
__device__ __forceinline__ void conv_tile(const Args& A, unsigned char* ws, int it, LAS float* scr, int lane) {
    const TrDesc d = conv_desc(A, ws, it, lane); f32x4 v[16]; tr_load(d, lane, v); tr_store(d, lane, v, scr);
}
__device__ __forceinline__ void conv_tile2(const Args& A, unsigned char* ws, int it0, int it1, LAS float* scr, int lane) {
    const TrDesc d0 = conv_desc(A, ws, it0, lane), d1 = conv_desc(A, ws, it1, lane); f32x4 v0[16], v1[16];
    tr_load(d0, lane, v0); tr_load(d1, lane, v1); tr_store(d0, lane, v0, scr); tr_store(d1, lane, v1, scr);
}
__device__ __forceinline__ void p0_prologue(Frame& F, const Args& A) {
    LAS float* scr = (LAS float*)(F.lds + F_WAVE * 16640);
    const int gw = F.vcu * NWAVES + F_WAVE, NGW = F.G * NWAVES, lane = F_LANE;
    unsigned char* ws = F.ws;
#ifdef CONV_IN_P0
    for (int it = gw; it < CV_EARLY + CV_LATE; it += NGW) conv_tile(A, ws, it, scr, lane);
#else
    for (int it = gw; it < CV_EARLY; it += NGW) conv_tile(A, ws, it, scr, lane);
#endif
    const float* x = A.in[0]; const float* g1 = A.in[1]; bf16* H = (bf16*)(ws + WS_H);
    for (int m0 = gw; m0 < T; m0 += 4 * NGW) {
        f32x4 v[4][4];
#pragma unroll
        for (int r = 0; r < 4; ++r) { const int m = min(m0 + r * NGW, T - 1); const GAS f32x4* xr = (const GAS f32x4*)(x + (size_t)m * D) + lane;
#pragma unroll
            for (int j = 0; j < 4; ++j) v[r][j] = xr[64 * j]; }
#pragma unroll
        for (int r = 0; r < 4; ++r) { const int m = m0 + r * NGW; float s = 0.f;
#pragma unroll
            for (int j = 0; j < 4; ++j) s += (v[r][j].x * v[r][j].x + v[r][j].y * v[r][j].y) + (v[r][j].z * v[r][j].z + v[r][j].w * v[r][j].w);
            const float rstd = 1.f / sqrtf(wave_sum(s) * (1.f / D) + EPS);
            if (m < T) { GAS v2u* o8 = (GAS v2u*)(H + (size_t)m * D) + lane;
#pragma unroll
                for (int j = 0; j < 4; ++j) { const f32x4 g = *((const GAS f32x4*)g1 + lane + 64 * j); const f32x4 y = v[r][j] * rstd * g; v2u w; w.x = pk2(y.x, y.y); w.y = pk2(y.z, y.w); o8[64 * j] = w; } } }
    }
    f32x2* rope = (f32x2*)(ws + WS_ROPE);
    for (int idx = (F.vcu * NTHR + F_TID); idx < SEQ * 16; idx += F.G * NTHR) {
        const int pos = idx >> 4, i = idx & 15;
        const double REV[16] = {0.15915494309189535, 0.0700865215877985, 0.03086376340470123, 0.013591370636193905, 0.005985185712713705, 0.002635675898667414, 0.001160663641240061, 0.0005111175045375439,
                                0.00022507907903927653, 9.911730936901935e-05, 4.364795279280289e-05, 1.9221100684944863e-05, 8.464330808241401e-06, 3.727408601915352e-06, 1.6414262627950345e-06, 7.228293068832865e-07};
        double rv = 0.0;
#pragma unroll
        for (int k = 0; k < 16; ++k) rv = (i == k) ? REV[k] : rv;
        double t = (double)pos * rv; t -= __builtin_floor(t);
        const float tf = (float)t;
        rope[idx] = (f32x2){__builtin_amdgcn_cosf(tf), __builtin_amdgcn_sinf(tf)};
    }
}

__device__ __forceinline__ void p2a_norms(Frame& F, const Args& A) {
    const int gw = F.vcu * NWAVES + F_WAVE, NGW = F.G * NWAVES, lane = F_LANE;
    bf16* CQ = (bf16*)(F.ws + WS_CQ); bf16* CKV = (bf16*)(F.ws + WS_CKV);
    const float* gq = A.in[3]; const float* gkv = A.in[5];
    for (int m = gw; m < T; m += NGW) {
        {
            GAS unsigned* p = (GAS unsigned*)(CQ + (size_t)m * 384) + lane; unsigned w[3]; float s = 0.f;
#pragma unroll
            for (int j = 0; j < 3; ++j) { w[j] = p[64 * j]; const float a = bflo(w[j]), b = bfhi(w[j]); s += a * a + b * b; }
            const float rstd = 1.f / sqrtf(wave_sum(s) * (1.f / 384.f) + EPS);
#pragma unroll
            for (int j = 0; j < 3; ++j) { const f32x2 g = *((const GAS f32x2*)gq + lane + 64 * j); p[64 * j] = pk2(bflo(w[j]) * rstd * g.x, bfhi(w[j]) * rstd * g.y); }
        }
        {
            GAS v2u* p = (GAS v2u*)(CKV + (size_t)m * 256) + lane; const v2u w = *p;
            const float a = bflo(w.x), b = bfhi(w.x), c = bflo(w.y), d = bfhi(w.y);
            const float rstd = 1.f / sqrtf(wave_sum(a * a + b * b + c * c + d * d) * (1.f / 256.f) + EPS);
            const f32x4 g = *((const GAS f32x4*)gkv + lane); v2u o; o.x = pk2(a * rstd * g.x, b * rstd * g.y); o.y = pk2(c * rstd * g.z, d * rstd * g.w); *p = o;
        }
    }
}

__device__ __forceinline__ constexpr int crow(int r, int hi) { return (r & 3) + 8 * (r >> 2) + 4 * hi; }
constexpr float ATT_THR = 8.f;
__device__ __forceinline__ float att_mask(float p, unsigned w, int bit) { int mk; unsigned r;
    asm("v_bfe_i32 %0, %1, %2, 1" : "=v"(mk) : "v"(w), "i"(bit)); r = __builtin_bit_cast(unsigned, p) & (unsigned)mk; return __builtin_bit_cast(float, r); }
struct AttnP { const bf16 *Q, *K, *K2, *V; bf16* O; const unsigned* BM; };
template <bool MLA> __device__ __forceinline__ void attn_unit(LAS unsigned char* L, int b, int h, int qb, const AttnP& P, int tid, int lane, int wave) {
    constexpr int DK = MLA ? 96 : 64, KP = DK * 2 + 16, NS = DK / 16, CPR = DK / 8;
    constexpr int QPITCH = MLA ? 768 : 512, VP = 192, KBUF = 64 * KP, VBUF = 64 * VP;
    const int r32 = lane & 31, hi = lane >> 5;
    const size_t rowb = (size_t)b * SEQ;
    const int qrow = qb * 256 + wave * 32 + r32;
    bf16x8 qf[NS];
    { const bf16* qp = P.Q + (rowb + qrow) * QPITCH + h * DK;
#pragma unroll
      for (int s = 0; s < NS; ++s) qf[s] = *(const bf16x8*)(qp + 16 * s + 8 * hi); }
    const int NT = 4 * qb + 4, my_nt = 4 * qb + (wave >> 1) + 1;
    const int kid0 = tid, kid1 = tid + NTHR;
    const int kr0 = kid0 / CPR, kc0 = kid0 % CPR, kr1 = kid1 / CPR, kc1 = kid1 % CPR; const bool has1 = MLA && (kid1 < 64 * CPR);
    const int vr = tid >> 3, vc = tid & 7;
    v4u kreg0, kreg1 = (v4u){0u, 0u, 0u, 0u}, vreg;
#define ATT_KSRC(t, kr, kc) (MLA ? ((kc) < 8 ? (const v4u*)(P.K + (rowb + 64 * (t) + (kr)) * 512 + h * 64 + 8 * (kc)) : (const v4u*)(P.K2 + (rowb + 64 * (t) + (kr)) * 32 + 8 * ((kc) - 8))) \
                                 : (const v4u*)(P.K + (rowb + 64 * (t) + (kr)) * 512 + h * 64 + 8 * (kc)))
#define ATT_LOAD(t) do { kreg0 = *ATT_KSRC(t, kr0, kc0); if (has1) kreg1 = *ATT_KSRC(t, kr1, kc1); vreg = *(const v4u*)(P.V + (rowb + 64 * (t) + vr) * 512 + h * 64 + 8 * vc); } while (0)
#define ATT_WRITE(buf) do { *(LAS v4u*)(L + (buf) * KBUF + kr0 * KP + kc0 * 16) = kreg0; if (has1) *(LAS v4u*)(L + (buf) * KBUF + kr1 * KP + kc1 * 16) = kreg1; \
                            *(LAS v4u*)(L + 2 * KBUF + (buf) * VBUF + vr * VP + vc * 16) = vreg; } while (0)
    float mhat = 0.f, l = 0.f; f32x16 o0, o1, negm;
#pragma unroll
    for (int i = 0; i < 16; ++i) { o0[i] = 0.f; o1[i] = 0.f; negm[i] = 0.f; }
    const int g16 = lane >> 4, qq = (lane & 15) >> 2, pp = lane & 3;
    const int vlane = (4 * hi + qq) * VP + (16 * (g16 & 1) + 4 * pp) * 2;
    ATT_LOAD(0); ATT_WRITE(0); __syncthreads();
    unsigned wn0 = 0xffffffffu, wn1 = 0xffffffffu;
    const unsigned* bmq = MLA ? nullptr : P.BM + (size_t)b * 256 * SEQ + qrow;
    if (!MLA) { wn0 = bmq[0]; wn1 = bmq[SEQ]; }
    for (int t = 0; t < NT; ++t) {
        const int buf = t & 1;
        unsigned w0 = wn0 >> (4 * hi), w1 = wn1 >> (4 * hi);
        if (t + 1 < NT) { ATT_LOAD(t + 1); if (!MLA) { wn0 = bmq[(size_t)(2 * t + 2) * SEQ]; wn1 = bmq[(size_t)(2 * t + 3) * SEQ]; } }
        if (t < my_nt) {
            const LAS unsigned char* Kb = L + buf * KBUF; const LAS unsigned char* Vb = L + 2 * KBUF + buf * VBUF;
            f32x16 s0, s1;
            bf16x8 ka[NS][2];
#pragma unroll
            for (int s = 0; s < NS; ++s) { ka[s][0] = *(const LAS bf16x8*)(Kb + r32 * KP + s * 32 + hi * 16); ka[s][1] = *(const LAS bf16x8*)(Kb + (32 + r32) * KP + s * 32 + hi * 16); }
            __builtin_amdgcn_sched_barrier(0);
#pragma unroll
            for (int s = 0; s < NS; ++s) {
                s0 = __builtin_amdgcn_mfma_f32_32x32x16_bf16(ka[s][0], qf[s], s == 0 ? negm : s0, 0, 0, 0);
                s1 = __builtin_amdgcn_mfma_f32_32x32x16_bf16(ka[s][1], qf[s], s == 0 ? negm : s1, 0, 0, 0);
            }
            s16x4 vf[4][4];
#pragma unroll
            for (int ks = 0; ks < 4; ++ks) { const LAS unsigned char* vp = Vb + ks * 16 * VP + vlane;
                vf[ks][0] = __builtin_bit_cast(s16x4, __builtin_amdgcn_ds_read_tr16_b64_v4i16((LAS s16x4*)(vp)));
                vf[ks][1] = __builtin_bit_cast(s16x4, __builtin_amdgcn_ds_read_tr16_b64_v4i16((LAS s16x4*)(vp + 8 * VP)));
                vf[ks][2] = __builtin_bit_cast(s16x4, __builtin_amdgcn_ds_read_tr16_b64_v4i16((LAS s16x4*)(vp + 64)));
                vf[ks][3] = __builtin_bit_cast(s16x4, __builtin_amdgcn_ds_read_tr16_b64_v4i16((LAS s16x4*)(vp + 8 * VP + 64))); }
            __builtin_amdgcn_sched_barrier(0);
            float mx = fmaxf(fmaxf(s0[0], s0[1]), s1[0]);
#pragma unroll
            for (int i = 2; i < 16; i += 2) mx = fmaxf(fmaxf(mx, s0[i]), s0[i + 1]);
#pragma unroll
            for (int i = 1; i < 15; i += 2) mx = fmaxf(fmaxf(mx, s1[i]), s1[i + 1]);
            mx = fmaxf(mx, s1[15]);
            mx = fmaxf(mx, __shfl_xor(mx, 32));
            if (t == 0 || __any(mx > ATT_THR)) {
                const float dl = (t == 0) ? mx : fmaxf(mx, 0.f), f = (t == 0) ? 1.f : __builtin_amdgcn_exp2f(-dl);
                mhat += dl; l *= f;
#pragma unroll
                for (int i = 0; i < 16; ++i) { s0[i] -= dl; s1[i] -= dl; o0[i] *= f; o1[i] *= f; negm[i] = -mhat; }
            }
            float rs = 0.f;
#pragma unroll
            for (int i = 0; i < 16; ++i) {
                float p0 = __builtin_amdgcn_exp2f(s0[i]), p1 = __builtin_amdgcn_exp2f(s1[i]);
                if (!MLA) { p0 = att_mask(p0, w0, crow(i, 0)); p1 = att_mask(p1, w1, crow(i, 0)); }
                s0[i] = p0; s1[i] = p1; rs += p0 + p1; }
            l += rs;
            bf16x8 pf[4];
#pragma unroll
            for (int ks = 0; ks < 4; ++ks) { v4u w;
#pragma unroll
                for (int j = 0; j < 4; ++j) { const float a = (ks < 2) ? s0[8 * (ks & 1) + 2 * j] : s1[8 * (ks & 1) + 2 * j], c = (ks < 2) ? s0[8 * (ks & 1) + 2 * j + 1] : s1[8 * (ks & 1) + 2 * j + 1]; w[j] = pk2(a, c); }
                pf[ks] = __builtin_bit_cast(bf16x8, w); }
#pragma unroll
            for (int ks = 0; ks < 4; ++ks) {
                const bf16x8 A0 = __builtin_shufflevector(vf[ks][0], vf[ks][1], 0, 1, 2, 3, 4, 5, 6, 7);
                const bf16x8 A1 = __builtin_shufflevector(vf[ks][2], vf[ks][3], 0, 1, 2, 3, 4, 5, 6, 7);
                o0 = __builtin_amdgcn_mfma_f32_32x32x16_bf16(A0, pf[ks], o0, 0, 0, 0);
                o1 = __builtin_amdgcn_mfma_f32_32x32x16_bf16(A1, pf[ks], o1, 0, 0, 0);
            }
        }
        if (t + 1 < NT) ATT_WRITE(buf ^ 1);
        __syncthreads();
    }
    l += __shfl_xor(l, 32);
    const float inv = 1.f / l;
    bf16* op = P.O + (rowb + qrow) * 512 + h * 64 + 4 * hi;
#pragma unroll
    for (int g = 0; g < 4; ++g) {
        v2u w; w.x = pk2(o0[4 * g] * inv, o0[4 * g + 1] * inv); w.y = pk2(o0[4 * g + 2] * inv, o0[4 * g + 3] * inv); *(v2u*)(op + 8 * g) = w;
        v2u z; z.x = pk2(o1[4 * g] * inv, o1[4 * g + 1] * inv); z.y = pk2(o1[4 * g + 2] * inv, o1[4 * g + 3] * inv); *(v2u*)(op + 32 + 8 * g) = z;
    }
#undef ATT_KSRC
#undef ATT_LOAD
#undef ATT_WRITE
}

namespace attn_body {
using bf16=__hip_bfloat16;
using bf16x8=__attribute__((ext_vector_type(8)))short;
using s16x4=__attribute__((ext_vector_type(4)))short;
using f32x16=__attribute__((ext_vector_type(16)))float;
using u32x4=__attribute__((ext_vector_type(4)))unsigned;
constexpr int BATCH=2,NHEAD=8,SEQ=8192,D=64,DM=NHEAD*D;
constexpr int NW=8,QBLK=32,QB=QBLK*NW,KVBLK=64,NQB=SEQ/QB;
constexpr int ATTN_PITCH=DM, ATTN_UNIT_ROWS=QB;
__device__ __forceinline__ int crow(int r,int hi){return (r&3)+8*(r>>2)+4*hi;}
#define SBAR() __builtin_amdgcn_sched_barrier(0)
__device__ __forceinline__ void cmask(f32x16&p0,f32x16&p1,int jb,int wid){
  if(jb>(wid>>1)){
    #pragma unroll
    for(int r=0;r<16;++r){p0[r]=-INFINITY;p1[r]=-INFINITY;} }
}
__device__ __forceinline__ float amask(float p,unsigned w,int bit){ int mk; asm("v_bfe_i32 %0, %1, %2, 1":"=v"(mk):"v"(w),"i"(bit)); return __builtin_bit_cast(float,__builtin_bit_cast(unsigned,p)&(unsigned)mk); }
__device__ __forceinline__ void glds16o(const void*sbase,unsigned voff,unsigned lds_dst){unsigned keep;
  asm volatile("s_mov_b32 %0, m0\n\ts_mov_b32 m0, %3\n\ts_nop 0\n\tglobal_load_lds_dwordx4 %1, %2\n\ts_mov_b32 m0, %0":"=&s"(keep):"v"(voff),"s"(sbase),"s"(lds_dst):"memory");}
__device__ __forceinline__ void glds4o(const void*sbase,unsigned voff,unsigned lds_dst){unsigned keep;
  asm volatile("s_mov_b32 %0, m0\n\ts_mov_b32 m0, %3\n\ts_nop 0\n\tglobal_load_lds_dword %1, %2\n\ts_mov_b32 m0, %0":"=&s"(keep):"v"(voff),"s"(sbase),"s"(lds_dst):"memory");}
__device__ __forceinline__ void glds4(const void*gsrc,unsigned lds_dst){unsigned keep;
  asm volatile("s_mov_b32 %0, m0\n\ts_mov_b32 m0, %2\n\ts_nop 0\n\tglobal_load_lds_dword %1, off\n\ts_mov_b32 m0, %0":"=&s"(keep):"v"(gsrc),"s"(lds_dst):"memory");}

constexpr int NSLOT=3, SLOTB=8192, KSLOTMAX=12288;
constexpr int LDS_K=0, LDS_V=NSLOT*KSLOTMAX, LDS_WS=LDS_V+NSLOT*SLOTB, LDS_OST=LDS_WS+NW*64*4, LDS_BM=LDS_OST+NW*4096, LDS_BYTES=LDS_BM+NW*512;
constexpr float C2=0.125f*1.4426950408889634f;
__device__ __forceinline__ void glds16(const void*gsrc,unsigned lds_dst){unsigned keep;
  asm volatile("s_mov_b32 %0, m0\n\ts_mov_b32 m0, %2\n\ts_nop 0\n\tglobal_load_lds_dwordx4 %1, off\n\ts_mov_b32 m0, %0":"=&s"(keep):"v"(gsrc),"s"(lds_dst):"memory");}
__device__ __forceinline__ float max3f(float a,float b,float c){float r;asm("v_max3_f32 %0, %1, %2, %3":"=v"(r):"v"(a),"v"(b),"v"(c));return r;}
__device__ __forceinline__ float max2f(float a,float b){float r;asm("v_max_f32_e32 %0, %1, %2":"=v"(r):"v"(a),"v"(b));return r;}
__device__ __forceinline__ float fadd_s(float a,float b){float r;asm("v_add_f32_e32 %0, %1, %2":"=v"(r):"v"(a),"v"(b));return r;}
__device__ __forceinline__ float fsub_s(float a,float b){float r;asm("v_sub_f32_e32 %0, %1, %2":"=v"(r):"v"(a),"v"(b));return r;}
typedef float f32x2_t __attribute__((ext_vector_type(2))); typedef __bf16 bf16x2_t __attribute__((ext_vector_type(2)));
__device__ __forceinline__ unsigned cvtpk_s(float lo,float hi){f32x2_t v={lo,hi};bf16x2_t b=__builtin_convertvector(v,bf16x2_t);return __builtin_bit_cast(unsigned,b);}
#define WAIT_BAR(N) asm volatile("s_waitcnt vmcnt(" #N ") lgkmcnt(0)\n\ts_barrier":::"memory")

template<int NKS> __device__ __forceinline__ void qkt(f32x16&p0,f32x16&p1,const char*Kslot,const bf16x8*qr,const f32x16&negm,int r32,int hi){
  const char*kb=Kslot+hi*1024+r32*16;
  #pragma unroll
  for(int d0=0;d0<NKS;++d0){
    const bf16x8 b0=*reinterpret_cast<const bf16x8*>(kb+d0*2048);
    const bf16x8 b1=*reinterpret_cast<const bf16x8*>(kb+d0*2048+512);
    if(d0==0){p0=__builtin_amdgcn_mfma_f32_32x32x16_bf16(b0,qr[0],negm,0,0,0);p1=__builtin_amdgcn_mfma_f32_32x32x16_bf16(b1,qr[0],negm,0,0,0);}
    else{p0=__builtin_amdgcn_mfma_f32_32x32x16_bf16(b0,qr[d0],p0,0,0,0);p1=__builtin_amdgcn_mfma_f32_32x32x16_bf16(b1,qr[d0],p1,0,0,0);}}
}
typedef __attribute__((address_space(3))) const char* lds_cptr;
typedef short v4i16_t __attribute__((ext_vector_type(4)));
__device__ __forceinline__ void kload8(bf16x8*kf,lds_cptr kp){
  kf[0]=*(const __attribute__((address_space(3))) bf16x8*)(kp);      kf[1]=*(const __attribute__((address_space(3))) bf16x8*)(kp+512);
  kf[2]=*(const __attribute__((address_space(3))) bf16x8*)(kp+2048); kf[3]=*(const __attribute__((address_space(3))) bf16x8*)(kp+2560);
  kf[4]=*(const __attribute__((address_space(3))) bf16x8*)(kp+4096); kf[5]=*(const __attribute__((address_space(3))) bf16x8*)(kp+4608);
  kf[6]=*(const __attribute__((address_space(3))) bf16x8*)(kp+6144); kf[7]=*(const __attribute__((address_space(3))) bf16x8*)(kp+6656);
}
__device__ __forceinline__ void kload2(bf16x8*kf,lds_cptr kp,int j){ kf[2*j]=*(const __attribute__((address_space(3))) bf16x8*)(kp+j*2048); kf[2*j+1]=*(const __attribute__((address_space(3))) bf16x8*)(kp+j*2048+512); }
__device__ __forceinline__ s16x4 vtr(lds_cptr p){ return __builtin_bit_cast(s16x4,__builtin_amdgcn_ds_read_tr16_b64_v4i16((__attribute__((address_space(3))) v4i16_t*)p)); }
__device__ __forceinline__ float rowmax(const f32x16&p0,const f32x16&p1){
  float a=max3f(p0[0],p0[1],p1[0]),b=max3f(p0[2],p0[3],p1[1]);a=max3f(a,p1[2],p1[3]);
  #pragma unroll
  for(int r=4;r<16;r+=4){a=max3f(a,p0[r],p0[r+1]);b=max3f(b,p0[r+2],p0[r+3]);a=max3f(a,p1[r],p1[r+1]);b=max3f(b,p1[r+2],p1[r+3]);}
  const float m=max2f(a,b);
  auto rr=__builtin_amdgcn_permlane32_swap(__float_as_uint(m),__float_as_uint(m),false,false);
  return max2f(__uint_as_float(rr[0]),__uint_as_float(rr[1]));
}
__device__ __forceinline__ void pv(f32x16*o,int vb,bf16x8 pa0,bf16x8 pa1,bf16x8 pa2,bf16x8 pa3){
  #pragma unroll
  for(int d0=0;d0<2;++d0){s16x4 lo[4],hi[4];
    #pragma unroll
    for(int ks=0;ks<4;++ks){
      asm volatile("ds_read_b64_tr_b16 %0,%1 offset:%c2":"=&v"(lo[ks]):"v"(vb),"i"(d0*4096+ks*1024):"memory");
      asm volatile("ds_read_b64_tr_b16 %0,%1 offset:%c2":"=&v"(hi[ks]):"v"(vb),"i"(d0*4096+ks*1024+512):"memory");}
    asm volatile("s_waitcnt lgkmcnt(0)":::"memory");SBAR();
    #define PK(k) (bf16x8){lo[k][0],lo[k][1],lo[k][2],lo[k][3],hi[k][0],hi[k][1],hi[k][2],hi[k][3]}
    o[d0]=__builtin_amdgcn_mfma_f32_32x32x16_bf16(pa0,PK(0),o[d0],0,0,0);
    o[d0]=__builtin_amdgcn_mfma_f32_32x32x16_bf16(pa1,PK(1),o[d0],0,0,0);
    o[d0]=__builtin_amdgcn_mfma_f32_32x32x16_bf16(pa2,PK(2),o[d0],0,0,0);
    o[d0]=__builtin_amdgcn_mfma_f32_32x32x16_bf16(pa3,PK(3),o[d0],0,0,0);
    #undef PK
  }
}

#ifndef ATTN_STORE16
#define ATTN_STORE16(p,v) (*(u32x4*)(p)=(v))
#endif
template<int THRL,bool MLA> __device__ __forceinline__ void attn_unit(int b,int h,int qb,const bf16*Q,const bf16*__restrict__ K,const bf16*__restrict__ K2,const bf16*__restrict__ V,bf16*O,const unsigned*BMg,char*shm,int tid){
  constexpr int NKS=MLA?6:4, QP=MLA?768:512, DQ=MLA?96:64;
  const int lane=tid&63,r32=lane&31,hi=lane>>5; const int wid=__builtin_amdgcn_readfirstlane(tid>>6);
  const long rowbase=(long)b*SEQ; const int q0=qb*QB;
  const bf16*Qw=Q+(rowbase+q0+wid*QBLK)*QP+h*DQ;
  const bf16*Kh=K+rowbase*DM+h*D,*Vh=V+rowbase*DM+h*D;
  const unsigned lds0=(unsigned)(uintptr_t)shm;
  float*wsf=(float*)(shm+LDS_WS)+wid*64;
  const unsigned koff=(unsigned)(lane*DM+wid*8)*2u;
  const unsigned voff=(unsigned)((16*(wid&3)+(lane>>2))*DM+(wid>>2)*32+(lane&3)*8)*2u;
  const unsigned kdst=lds0+LDS_K+wid*1024, vdst=lds0+LDS_V+wid*1024;
  const bf16*K2h=MLA?K2+rowbase*32:nullptr; const unsigned koff2=(unsigned)(lane*32+(wid&3)*8)*2u; const unsigned kdst2=lds0+LDS_K+(8+(wid&3))*1024;
  #define KO(sl) (MLA?(sl)+((sl)>>1):(sl))
  #define DMA_K(t,slot) do{ glds16o(Kh+(long)(t)*KVBLK*DM,koff,(unsigned)__builtin_amdgcn_readfirstlane(kdst+KO(slot))); \
    if constexpr(MLA) glds16o(K2h+(long)(t)*KVBLK*32,koff2,(unsigned)__builtin_amdgcn_readfirstlane(kdst2+KO(slot))); }while(0)
  #define DMA_V(t,slot) glds16o(Vh+(long)(t)*KVBLK*DM,voff,(unsigned)__builtin_amdgcn_readfirstlane(vdst+(slot)))
  const unsigned*BMb=BMg+(long)b*256*SEQ+q0+wid*QBLK; const unsigned bmoff=(unsigned)(hi*SEQ+r32)*4u; const unsigned bmdst=lds0+LDS_BM+wid*512;
  const __attribute__((address_space(3))) unsigned*bmw=(const __attribute__((address_space(3))) unsigned*)((lds_cptr)shm+LDS_BM+wid*512);
  #define DMA_BM(t) if constexpr(!MLA) glds4o(BMb+(long)(t)*2*SEQ,bmoff,(unsigned)__builtin_amdgcn_readfirstlane(bmdst+((t)&1)*256))
  #define VMW(N) asm volatile("s_waitcnt vmcnt(" #N ")":::"memory")
  #define BMWAIT(t) do{ if constexpr(!MLA){ if((t)+3<NT){VMW(5);} else if((t)+2<NT){VMW(4);} else if((t)+1<NT){VMW(3);} else {VMW(1);} } }while(0)
  const int vb0=(int)(lds0+LDS_V)+((lane>>4)&1)*32+(lane&3)*8+(4*hi+((lane&15)>>2))*64;
  const char*Kbase=shm+LDS_K; bf16x8 kf[2*NKS];
  const lds_cptr shm3=(lds_cptr)shm; const lds_cptr kp0=shm3+LDS_K+hi*1024+r32*16; const lds_cptr vp0=shm3+LDS_V+((lane>>4)&1)*32+(lane&3)*8+(4*hi+((lane&15)>>2))*64;
  const int NT=(q0+QB)/KVBLK;
  DMA_BM(0);DMA_K(0,0);DMA_V(0,0);DMA_K(1,SLOTB);
  bf16x8 qr[NKS];
  #pragma unroll
  for(int d0=0;d0<NKS;++d0)qr[d0]=*reinterpret_cast<const bf16x8*>(&Qw[(long)r32*QP+d0*16+hi*8]);
  float mhat=0.f,l_reg=0.f;f32x16 o[2];o[0]=f32x16{};o[1]=f32x16{};f32x16 negm=f32x16{};asm volatile("":"+v"(negm));
  const int qrel=wid*QBLK+r32;
  #define CMASK(P0,P1,t) do{int jb_=(t)-(NT-4); if(jb_>=0)cmask(P0,P1,jb_,wid);}while(0)
  bool resc=false;
  #define START(P0,P1) do{ const float rm=rowmax(P0,P1); resc=false; \
    { const float dl=rm; mhat=fadd_s(mhat,dl); \
      _Pragma("unroll") for(int r=0;r<16;++r){P0[r]=fsub_s(P0[r],dl);P1[r]=fsub_s(P1[r],dl);} \
      _Pragma("unroll") for(int r=0;r<16;++r)negm[r]=-mhat; asm volatile("":"+v"(negm)); } \
    _Pragma("unroll") for(int r=0;r<16;++r)P0[r]=__builtin_amdgcn_exp2f(P0[r]); }while(0)
  #define RESC() do{ if(resc){ asm volatile("s_waitcnt lgkmcnt(0)":::"memory"); \
      _Pragma("unroll") for(int d_=0;d_<2;++d_) _Pragma("unroll") for(int r=0;r<16;++r)o[d_][r]*=wsf[crow(r,hi)]; } }while(0)
  f32x16 pA0,pA1,pB0,pB1;
  int sl_prev=0,sl_cur=0,sl_next=SLOTB;
  #define ROT() do{sl_prev=sl_cur;sl_cur=sl_next;sl_next=(sl_next==(NSLOT-1)*SLOTB)?0:sl_next+SLOTB;}while(0)
  DMA_K(2,2*SLOTB);
  if constexpr(MLA){WAIT_BAR(5);}else{WAIT_BAR(3);}
  qkt<NKS>(pA0,pA1,Kbase,qr,negm,r32,hi);asm volatile("s_nop 15\n\ts_nop 7":"+v"(pA0),"+v"(pA1));CMASK(pA0,pA1,0);
  START(pA0,pA1);
  _Pragma("unroll") for(int r=0;r<16;++r)pA1[r]=__builtin_amdgcn_exp2f(pA1[r]);
  if constexpr(!MLA){ const unsigned w0_=bmw[r32]>>(4*hi), w1_=bmw[32+r32]>>(4*hi);
    _Pragma("unroll") for(int r=0;r<16;++r){pA0[r]=amask(pA0[r],w0_,(r&3)+8*(r>>2));pA1[r]=amask(pA1[r],w1_,(r&3)+8*(r>>2));} }
  WAIT_BAR(0);
  DMA_BM(1);DMA_K(3,0);DMA_V(1,SLOTB);
  ROT();
  _Pragma("unroll") for(int j=0;j<NKS;++j)kload2(kf,kp0+KO(sl_cur),j);
  WAIT_BAR(3);
  s16x4 vlo[8],vhi[8]; u32x4 pw0,pw1,pw2,pw3;
  #define PKW(P,B) cvtpk_s(P[B],P[B+1])
  #define PAF(k) __builtin_bit_cast(bf16x8,pw##k)
  #define VFR(i) (bf16x8){vlo[i][0],vlo[i][1],vlo[i][2],vlo[i][3],vhi[i][0],vhi[i][1],vhi[i][2],vhi[i][3]}
  #define PIN(x) asm volatile("":"+v"(x))
  #define MX3(a,b,c) __builtin_fmaxf(__builtin_fmaxf((a),(b)),(c))
  #define GAPA(MF,A0,A1,A2,A3,W0,W1,PW) do{ MF; sacc+=A0; sacc+=A1; sacc+=A2; sacc+=A3; PIN(sacc); W0; W1; PIN(PW); SBAR(); }while(0)
  #define EX(v) __builtin_amdgcn_exp2f(v)
  #define CR_(r) (((r)&3)+8*((r)>>2))
  #define GAPB(MF,X,B,W) do{ MF; X[B]=EX(X[B]); X[B+1]=EX(X[B+1]); X[B+2]=EX(X[B+2]); X[B+3]=EX(X[B+3]); \
    if constexpr(!MLA){ X[B]=amask(X[B],W,CR_(B)); X[B+1]=amask(X[B+1],W,CR_(B+1)); X[B+2]=amask(X[B+2],W,CR_(B+2)); X[B+3]=amask(X[B+3],W,CR_(B+3)); } PIN(X); SBAR(); }while(0)
  #define VRD(i) do{ vlo[i]=vtr(vp_+(((i)>>2)*4096+((i)&3)*1024)); vhi[i]=vtr(vp_+(((i)>>2)*4096+((i)&3)*1024+512)); }while(0)
  #define KRD(G,j) do{ if((j)<NKS){ if(G){ kload2(kf,kp0+KO(sl_next),j); SBAR(); } } }while(0)
  #define STEP(C0,C1,P0,P1,t,GK,GV,GL) do{ SBAR(); \
    const lds_cptr vp_=vp0+sl_prev; \
    VRD(0); SBAR(); float sacc=(P0[0]+P0[1]); \
    GAPA(C0=__builtin_amdgcn_mfma_f32_32x32x16_bf16(kf[0],qr[0],negm,0,0,0), P0[2],P0[3],P0[4],P0[5],     pw0[0]=PKW(P0,0), pw0[1]=PKW(P0,2), pw0); \
    VRD(4); SBAR(); GAPA(C1=__builtin_amdgcn_mfma_f32_32x32x16_bf16(kf[1],qr[0],negm,0,0,0), P0[6],P0[7],P0[8],P0[9],     pw0[2]=PKW(P0,4), pw0[3]=PKW(P0,6), pw0); \
    VRD(1); SBAR(); GAPA(C0=__builtin_amdgcn_mfma_f32_32x32x16_bf16(kf[2],qr[1],C0,0,0,0),   P0[10],P0[11],P0[12],P0[13], pw1[0]=PKW(P0,8), pw1[1]=PKW(P0,10), pw1); \
    VRD(5); SBAR(); GAPA(C1=__builtin_amdgcn_mfma_f32_32x32x16_bf16(kf[3],qr[1],C1,0,0,0),   P0[14],P0[15],P1[0],P1[1],   pw1[2]=PKW(P0,12),pw1[3]=PKW(P0,14), pw1); \
    VRD(2); SBAR(); GAPA(C0=__builtin_amdgcn_mfma_f32_32x32x16_bf16(kf[4],qr[2],C0,0,0,0),   P1[2],P1[3],P1[4],P1[5],     pw2[0]=PKW(P1,0), pw2[1]=PKW(P1,2), pw2); \
    VRD(6); SBAR(); GAPA(C1=__builtin_amdgcn_mfma_f32_32x32x16_bf16(kf[5],qr[2],C1,0,0,0),   P1[6],P1[7],P1[8],P1[9],     pw2[2]=PKW(P1,4), pw2[3]=PKW(P1,6), pw2); \
    VRD(3); SBAR(); GAPA(C0=__builtin_amdgcn_mfma_f32_32x32x16_bf16(kf[6],qr[3],C0,0,0,0),   P1[10],P1[11],P1[12],P1[13], pw3[0]=PKW(P1,8), pw3[1]=PKW(P1,10), pw3); \
    VRD(7); SBAR(); GAPA(C1=__builtin_amdgcn_mfma_f32_32x32x16_bf16(kf[7],qr[3],C1,0,0,0),   P1[14],P1[15],0.f,0.f,       pw3[2]=PKW(P1,12),pw3[3]=PKW(P1,14), pw3); \
    if constexpr(MLA){ C0=__builtin_amdgcn_mfma_f32_32x32x16_bf16(kf[8],qr[4],C0,0,0,0); C1=__builtin_amdgcn_mfma_f32_32x32x16_bf16(kf[9],qr[4],C1,0,0,0); \
      C0=__builtin_amdgcn_mfma_f32_32x32x16_bf16(kf[10],qr[5],C0,0,0,0); C1=__builtin_amdgcn_mfma_f32_32x32x16_bf16(kf[11],qr[5],C1,0,0,0); SBAR(); } \
    l_reg+=sacc; \
    if(GV){DMA_BM((t)+1);} if(GK){DMA_K((t)+3,sl_cur);} if(GV){DMA_V((t)+1,sl_next);} \
    CMASK(C0,C1,t); \
    { float a=MX3(C0[0],C0[1],C1[0]),b=MX3(C0[2],C0[3],C1[1]); a=MX3(a,C1[2],C1[3]); \
      _Pragma("unroll") for(int r=4;r<16;r+=4){a=MX3(a,C0[r],C0[r+1]);b=MX3(b,C0[r+2],C0[r+3]);a=MX3(a,C1[r],C1[r+1]);b=MX3(b,C1[r+2],C1[r+3]);} \
      float rm=__builtin_fmaxf(a,b); { auto rr=__builtin_amdgcn_permlane32_swap(__float_as_uint(rm),__float_as_uint(rm),false,false); rm=__builtin_fmaxf(__uint_as_float(rr[0]),__uint_as_float(rr[1])); } \
      resc=false; \
      if(__builtin_expect(__any(rm>(float)THRL),0)){ const float dl=__builtin_fmaxf(rm,0.f); mhat+=dl; \
        _Pragma("unroll") for(int r=0;r<16;++r){C0[r]-=dl;C1[r]-=dl;} \
        _Pragma("unroll") for(int r=0;r<16;++r)negm[r]=-mhat; asm volatile("":"+v"(negm)); \
        const float f=__builtin_amdgcn_exp2f(-dl); l_reg*=f; if(hi==0)wsf[r32]=f; resc=true; } } \
    BMWAIT(t); unsigned w0_=0u, w1_=0u; if constexpr(!MLA){ w0_=bmw[((t)&1)*64+r32]>>(4*hi); w1_=bmw[((t)&1)*64+32+r32]>>(4*hi); } \
    SBAR(); \
    GAPB(o[0]=__builtin_amdgcn_mfma_f32_32x32x16_bf16(PAF(0),VFR(0),o[0],0,0,0), C0,0,w0_); \
    KRD(GL,4); GAPB(o[1]=__builtin_amdgcn_mfma_f32_32x32x16_bf16(PAF(0),VFR(4),o[1],0,0,0), C0,4,w0_); \
    KRD(GL,0); GAPB(o[0]=__builtin_amdgcn_mfma_f32_32x32x16_bf16(PAF(1),VFR(1),o[0],0,0,0), C0,8,w0_); \
    KRD(GL,1); GAPB(o[1]=__builtin_amdgcn_mfma_f32_32x32x16_bf16(PAF(1),VFR(5),o[1],0,0,0), C0,12,w0_); \
    KRD(GL,2); GAPB(o[0]=__builtin_amdgcn_mfma_f32_32x32x16_bf16(PAF(2),VFR(2),o[0],0,0,0), C1,0,w1_); \
    KRD(GL,3); GAPB(o[1]=__builtin_amdgcn_mfma_f32_32x32x16_bf16(PAF(2),VFR(6),o[1],0,0,0), C1,4,w1_); \
    KRD(GL,5); GAPB(o[0]=__builtin_amdgcn_mfma_f32_32x32x16_bf16(PAF(3),VFR(3),o[0],0,0,0), C1,8,w1_); \
    GAPB(o[1]=__builtin_amdgcn_mfma_f32_32x32x16_bf16(PAF(3),VFR(7),o[1],0,0,0), C1,12,w1_); \
    }while(0)
  int t=1;
  #undef CMASK
  #define CMASK(P0,P1,t) do{}while(0)
  for(;t+5<NT;t+=2){
    STEP(pB0,pB1,pA0,pA1,t,true,true,true);     WAIT_BAR(3); RESC(); ROT();
    STEP(pA0,pA1,pB0,pB1,t+1,true,true,true);   WAIT_BAR(3); RESC(); ROT();
  }
  #undef CMASK
  #define CMASK(P0,P1,t) do{int jb_=(t)-(NT-4); if(jb_>=0)cmask(P0,P1,jb_,wid);}while(0)
  #define ENDW(tt) do{ if((tt)+3<NT){WAIT_BAR(3);} else if((tt)+2<NT){ if constexpr(MLA){WAIT_BAR(1);}else{WAIT_BAR(2);} } else {WAIT_BAR(0);} }while(0)
  for(;t+1<NT;t+=2){
    STEP(pB0,pB1,pA0,pA1,t,(t+3<NT),(t+1<NT),(t+1<NT));       ENDW(t);   RESC(); ROT();
    STEP(pA0,pA1,pB0,pB1,t+1,(t+4<NT),(t+2<NT),(t+2<NT));     ENDW(t+1); RESC(); ROT();
  }
  STEP(pB0,pB1,pA0,pA1,NT-1,false,false,false); RESC();
  { float sacc=pB0[0]+pB0[1]; _Pragma("unroll") for(int r=2;r<16;++r)sacc+=pB0[r]; _Pragma("unroll") for(int r=0;r<16;++r)sacc+=pB1[r]; l_reg+=sacc;
    pw0=(u32x4){PKW(pB0,0),PKW(pB0,2),PKW(pB0,4),PKW(pB0,6)};pw1=(u32x4){PKW(pB0,8),PKW(pB0,10),PKW(pB0,12),PKW(pB0,14)};pw2=(u32x4){PKW(pB1,0),PKW(pB1,2),PKW(pB1,4),PKW(pB1,6)};pw3=(u32x4){PKW(pB1,8),PKW(pB1,10),PKW(pB1,12),PKW(pB1,14)};
    SBAR(); pv(o,vb0+sl_cur,PAF(0),PAF(1),PAF(2),PAF(3)); }
  #undef PKW
  #undef PAF
  #undef VFR
  #undef PIN
  #undef MX3
  #undef GAPA
  #undef GAPB
  #undef EX
  #undef VRD
  #undef KRD
  #undef STEP
  #undef ENDW
  {auto rr=__builtin_amdgcn_permlane32_swap(__float_as_uint(l_reg),__float_as_uint(l_reg),false,false);l_reg=__uint_as_float(rr[0])+__uint_as_float(rr[1]);}
  if(hi==0)wsf[32+r32]=l_reg;asm volatile("s_waitcnt lgkmcnt(0)":::"memory");
  float rli[16];
  #pragma unroll
  for(int r=0;r<16;++r)rli[r]=__builtin_amdgcn_rcpf(wsf[32+crow(r,hi)]);
  bf16*Ow=O+(rowbase+q0+wid*QBLK)*DM+h*D;
  { bf16*stg=(bf16*)(shm+LDS_OST)+wid*2048;
    #pragma unroll
    for(int r=0;r<16;++r){const int orow=crow(r,hi);
      #pragma unroll
      for(int d0=0;d0<2;++d0)stg[orow*64+d0*32+r32]=__float2bfloat16(o[d0][r]*rli[r]);}
    asm volatile("s_waitcnt lgkmcnt(0)":::"memory");
    #pragma unroll
    for(int i=0;i<4;++i){const int row=i*8+(lane>>3),ch=lane&7; const u32x4 v=*(const u32x4*)(stg+row*64+ch*8); ATTN_STORE16(Ow+(long)row*DM+ch*8,v);} }
  asm volatile("s_waitcnt lgkmcnt(0)\n\ts_barrier":::"memory");
  #undef DMA_K
  #undef DMA_BM
  #undef KO
  #undef VMW
  #undef BMWAIT
  #undef CR_
  #undef DMA_V
  #undef CMASK
  #undef START
  #undef RESC
  #undef ROT
}
#undef SBAR
#undef WAIT_BAR
}
__device__ __forceinline__ unsigned row16_sum(unsigned x) {
    x += (unsigned)__builtin_amdgcn_update_dpp(0, (int)x, 0x128, 0xf, 0xf, false); x += (unsigned)__builtin_amdgcn_update_dpp(0, (int)x, 0x124, 0xf, 0xf, false);
    x += (unsigned)__builtin_amdgcn_update_dpp(0, (int)x, 0x122, 0xf, 0xf, false); x += (unsigned)__builtin_amdgcn_update_dpp(0, (int)x, 0x121, 0xf, 0xf, false); return x; }
__device__ __forceinline__ float row16_sumf(float x) {
    x += __builtin_bit_cast(float, __builtin_amdgcn_update_dpp(0, __builtin_bit_cast(int, x), 0x128, 0xf, 0xf, false)); x += __builtin_bit_cast(float, __builtin_amdgcn_update_dpp(0, __builtin_bit_cast(int, x), 0x124, 0xf, 0xf, false));
    x += __builtin_bit_cast(float, __builtin_amdgcn_update_dpp(0, __builtin_bit_cast(int, x), 0x122, 0xf, 0xf, false)); x += __builtin_bit_cast(float, __builtin_amdgcn_update_dpp(0, __builtin_bit_cast(int, x), 0x121, 0xf, 0xf, false)); return x; }
__device__ __forceinline__ unsigned row16_suffix(unsigned x) {
    x += (unsigned)__builtin_amdgcn_update_dpp(0, (int)x, 0x101, 0xf, 0xf, false); x += (unsigned)__builtin_amdgcn_update_dpp(0, (int)x, 0x102, 0xf, 0xf, false);
    x += (unsigned)__builtin_amdgcn_update_dpp(0, (int)x, 0x104, 0xf, 0xf, false); x += (unsigned)__builtin_amdgcn_update_dpp(0, (int)x, 0x108, 0xf, 0xf, false); return x; }
__device__ __forceinline__ unsigned half_or(unsigned x) { const auto rr = __builtin_amdgcn_permlane32_swap(x, x, false, false); return rr[0] | rr[1]; }
constexpr int CAND_CAP = 128, QIP = 1296, HS = 513, FAST_CAP = 512;
struct IdxP { const bf16 *QI, *KI; const float* WI; unsigned* BM; unsigned* dbg; };
__device__ __forceinline__ unsigned mono_key(float s) { const unsigned u = __builtin_bit_cast(unsigned, s + 0.0f); return u ^ ((unsigned)((int)u >> 31) | 0x80000000u); }
__device__ __forceinline__ void idx_scores2(const bf16x8 (&kf)[2][4], const LAS unsigned char* qlane, const float (&wq)[8], f32x16& sc0, f32x16& sc1) {
    bf16x8 qv[4], qn[4];
#pragma unroll
    for (int s = 0; s < 4; ++s) qv[s] = *(const LAS bf16x8*)(qlane + 8 * 128 + s * 32);
#pragma unroll
    for (int i = 0; i < 16; ++i) { sc0[i] = 0.f; sc1[i] = 0.f; }
    f32x16 ap0, ap1;
#pragma unroll
    for (int i = 0; i < 16; ++i) { ap0[i] = 0.f; ap1[i] = 0.f; }
#pragma unroll
    for (int n = 0; n < 10; ++n) {
        const int nh = (n + 1 < 2) ? 9 : (n + 1 - 2);
        if (n + 1 < 10) {
#pragma unroll
            for (int s = 0; s < 4; ++s) qn[s] = *(const LAS bf16x8*)(qlane + nh * 128 + s * 32); }
        f32x16 a0, a1;
        if (n < 2) {
#pragma unroll
            for (int s = 0; s < 4; ++s) { sc0 = __builtin_amdgcn_mfma_f32_32x32x16_bf16(kf[0][s], qv[s], sc0, 0, 0, 0); sc1 = __builtin_amdgcn_mfma_f32_32x32x16_bf16(kf[1][s], qv[s], sc1, 0, 0, 0); }
        } else {
#pragma unroll
            for (int i = 0; i < 16; ++i) { a0[i] = 0.f; a1[i] = 0.f; }
#pragma unroll
            for (int s = 0; s < 4; ++s) { a0 = __builtin_amdgcn_mfma_f32_32x32x16_bf16(kf[0][s], qv[s], a0, 0, 0, 0); a1 = __builtin_amdgcn_mfma_f32_32x32x16_bf16(kf[1][s], qv[s], a1, 0, 0, 0); }
        }
        if (n >= 3) {
            const float w = wq[n - 3];
#pragma unroll
            for (int i = 0; i < 16; ++i) { sc0[i] = __builtin_fmaf(w, __builtin_fabsf(ap0[i]), sc0[i]); sc1[i] = __builtin_fmaf(w, __builtin_fabsf(ap1[i]), sc1[i]); }
#pragma unroll
            for (int g = 0; g < 8; ++g) { __builtin_amdgcn_sched_group_barrier(0x008, 1, 0); __builtin_amdgcn_sched_group_barrier(0x002, 4, 0); }
        }
        if (n >= 2) { ap0 = a0; ap1 = a1; }
#pragma unroll
        for (int s = 0; s < 4; ++s) qv[s] = qn[s];
    }
    { const float w = wq[7];
#pragma unroll
      for (int i = 0; i < 16; ++i) { sc0[i] = __builtin_fmaf(w, __builtin_fabsf(ap0[i]), sc0[i]); sc1[i] = __builtin_fmaf(w, __builtin_fabsf(ap1[i]), sc1[i]); } }
#pragma unroll
    for (int i = 0; i < 16; ++i) asm volatile("" : "+v"(sc0[i]), "+v"(sc1[i]));
}
__device__ __forceinline__ void idx_item(LAS unsigned char* L, int b, int j, const IdxP& P, int tid, int lane, int wave) {
    LAS unsigned* hist = (LAS unsigned*)L;
    LAS unsigned* img = (LAS unsigned*)(L + 66048);
    LAS unsigned* st = (LAS unsigned*)(L + 98816);
    LAS unsigned* cand = hist;
    LAS unsigned char* Qs = L + 100864;
    const int r32 = lane & 31, hi = lane >> 5;
    const int q0 = 32 * j, ntile = 2 * (j / 2 + 1);
    const size_t rowb = (size_t)b * SEQ;
    if (ntile <= 8) {
        for (int idx = tid; idx < ntile * 32; idx += NTHR) P.BM[((size_t)b * 256 + (idx >> 5)) * SEQ + q0 + (idx & 31)] = 0xffffffffu;
        return;
    }
    const int npair = ntile >> 1, nsw = (npair + 63) >> 6, SP = min(npair, 8 * nsw);
    bf16x8 ksmp[2][4];
#ifdef SMP_PREFETCH
    if (wave < SP) { const bf16* kp = P.KI + (rowb + 64 * ((wave * npair) / SP) + r32) * 64 + 8 * hi;
#pragma unroll
        for (int s = 0; s < 4; ++s) { ksmp[0][s] = *(const bf16x8*)(kp + 16 * s); ksmp[1][s] = *(const bf16x8*)(kp + 32 * 64 + 16 * s); } }
#endif
    float wq[8];
    { for (int c = tid; c < 32 * 64; c += NTHR) { const int rr = c >> 6, ch = c & 63; *(LAS v4u*)(Qs + rr * QIP + ch * 16) = *(const v4u*)(P.QI + (rowb + q0 + rr) * 512 + ch * 8); }
      const float* wp = P.WI + (rowb + q0 + r32) * 8;
#pragma unroll
      for (int h = 0; h < 8; ++h) wq[h] = 0.5f * wp[h]; }
    if (tid < 32) { st[32 + tid] = 256u; st[64 + tid] = 0u; st[96 + tid] = 0u; }
    if (tid == 0) st[129] = 0u;
    __syncthreads();
    {
        const int r = tid >> 4, part = tid & 15;
        const float* wp = P.WI + (rowb + q0 + r) * 8;
        float qb[4] = {0.f, 0.f, 0.f, 0.f}; float rsum = 0.f;
#pragma unroll
        for (int h = 0; h < 8; ++h) { const float w = wp[h]; const v2u raw = *(const LAS v2u*)(Qs + r * QIP + h * 128 + part * 8);
            const float f0 = bflo(raw.x), f1 = bfhi(raw.x), f2 = bflo(raw.y), f3 = bfhi(raw.y);
            float nsq = (f0 * f0 + f1 * f1) + (f2 * f2 + f3 * f3);
            nsq = row16_sumf(nsq);
            rsum += fabsf(w) * sqrtf(nsq);
            qb[0] += 0.5f * w * f0; qb[1] += 0.5f * w * f1; qb[2] += 0.5f * w * f2; qb[3] += 0.5f * w * f3; }
        v2u hw, lw;
        { const unsigned h01 = pk2(qb[0], qb[1]), h23 = pk2(qb[2], qb[3]); hw.x = h01; hw.y = h23;
          lw.x = pk2(qb[0] - bflo(h01), qb[1] - bfhi(h01)); lw.y = pk2(qb[2] - bflo(h23), qb[3] - bfhi(h23)); }
        *(LAS v2u*)(Qs + r * QIP + 8 * 128 + part * 8) = hw; *(LAS v2u*)(Qs + r * QIP + 9 * 128 + part * 8) = lw;
        { const v2u kw = *(const v2u*)(P.KI + (rowb + r) * 64 + part * 4); const float f0 = bflo(kw.x), f1 = bfhi(kw.x), f2 = bflo(kw.y), f3 = bfhi(kw.y);
          float ksq = (f0 * f0 + f1 * f1) + (f2 * f2 + f3 * f3);
          ksq = row16_sumf(ksq);
          if (part == 0) { __hip_atomic_fetch_max(&st[129], __builtin_bit_cast(unsigned, ksq), __ATOMIC_RELAXED, __HIP_MEMORY_SCOPE_WORKGROUP); st[224 + r] = __builtin_bit_cast(unsigned, rsum); } }
    }
    __syncthreads();
    if (tid < 32) { const float R = 0.25f * sqrtf(__builtin_bit_cast(float, st[129])) * __builtin_bit_cast(float, st[224 + tid]);
        const float C = 0.125f * R;
        st[160 + tid] = (0x80000000u | __builtin_bit_cast(unsigned, R + C)) - 511u * 131072u; st[224 + tid] = __builtin_bit_cast(unsigned, C); st[tid] = 0u; st[192 + tid] = 0u;
        st[256 + tid] = __builtin_bit_cast(unsigned, R); st[288 + tid] = 511u; st[320 + tid] = 0u; }
    const LAS unsigned char* qlane = Qs + r32 * QIP + hi * 16;
    int level = 0;
#define IDX_KLOAD2(tp) { const bf16* kp = P.KI + (rowb + 64 * (tp) + r32) * 64 + 8 * hi; _Pragma("unroll") for (int s = 0; s < 4; ++s) { kn[0][s] = *(const bf16x8*)(kp + 16 * s); kn[1][s] = *(const bf16x8*)(kp + 32 * 64 + 16 * s); } }
#define IDX_SCORES2(tp) \
        bf16x8 kf[2][4]; _Pragma("unroll") for (int s = 0; s < 4; ++s) { kf[0][s] = kn[0][s]; kf[1][s] = kn[1][s]; } \
        f32x16 sc0, sc1; idx_scores2(kf, qlane, wq, sc0, sc1); \
        if ((tp) + NWAVES < npair) { IDX_KLOAD2((tp) + NWAVES) }
    bool slow;
    {
        for (int u = tid; u < 32 * HS; u += NTHR) hist[u] = 0u;
        if (tid == 0) st[130] = 0u;
        __syncthreads();
        const float Rq = __builtin_bit_cast(float, st[256 + r32]);
        {   const float s1 = 256.f / Rq; LAS unsigned* hrow = hist + r32 * HS;
            for (int i = wave; i < SP; i += NWAVES) { const int tp = (i * npair) / SP;
#ifdef SMP_PREFETCH
                bf16x8 kn[2][4]; if (i >= NWAVES) { IDX_KLOAD2(tp) }
#else
                bf16x8 kn[2][4]; IDX_KLOAD2(tp)
#endif
                bf16x8 kf[2][4];
#pragma unroll
#ifdef SMP_PREFETCH
                for (int s = 0; s < 4; ++s) { kf[0][s] = (i < NWAVES) ? ksmp[0][s] : kn[0][s]; kf[1][s] = (i < NWAVES) ? ksmp[1][s] : kn[1][s]; }
#else
                for (int s = 0; s < 4; ++s) { kf[0][s] = kn[0][s]; kf[1][s] = kn[1][s]; }
#endif
                f32x16 sc0, sc1; idx_scores2(kf, qlane, wq, sc0, sc1);
#pragma unroll
                for (int e = 0; e < 16; ++e) { const int b0 = min(max((int)__builtin_fmaf(sc0[e], s1, 256.f), 0), 511), b1 = min(max((int)__builtin_fmaf(sc1[e], s1, 256.f), 0), 511);
                    __hip_atomic_fetch_add(&hrow[b0], 1u, __ATOMIC_RELAXED, __HIP_MEMORY_SCOPE_WORKGROUP); __hip_atomic_fetch_add(&hrow[b1], 1u, __ATOMIC_RELAXED, __HIP_MEMORY_SCOPE_WORKGROUP); }
            }
        }
        __syncthreads();
        {
            const int q = tid >> 4, seg = tid & 15; const LAS unsigned* hq = hist + q * HS + seg * 32;
            unsigned segsum = 0u;
            for (int wi = 0; wi < 32; ++wi) segsum += hq[wi];
            unsigned S = segsum;
            S = row16_suffix(S);
            const unsigned above = S - segsum, total = row16_sum(segsum);
            const float f = (float)total / (float)(64 * npair), rs = 256.f * f, sg = 3.5f * sqrtf(rs * (1.f - f));
            const int rl = (int)floorf(rs - sg) - 1, rh = (int)ceilf(rs + sg) + 1;
            const unsigned tl = rl > 0 ? (unsigned)rl : 0u, th = (unsigned)rh;
            if (above < tl && tl <= above + segsum) { unsigned cum = above; int fb = 0; bool found = false;
                for (int wi = 31; wi >= 0; --wi) { const unsigned c = hq[wi]; if (!found && cum + c >= tl) { found = true; fb = wi; } if (!found) cum += c; }
                st[288 + q] = (unsigned)(32 * seg + fb); }
            if (above < th && th <= above + segsum) { unsigned cum = above; int fb = 0; bool found = false;
                for (int wi = 31; wi >= 0; --wi) { const unsigned c = hq[wi]; if (!found && cum + c >= th) { found = true; fb = wi; } if (!found) cum += c; }
                st[320 + q] = (unsigned)(32 * seg + fb); }
        }
        __syncthreads();
#ifdef REP_PASS2
        for (int rep2 = 0; rep2 < 2; ++rep2) { if (rep2) { __syncthreads(); if (tid < 32) st[96 + tid] = 0u; __syncthreads(); }
#else
        {
#endif
            const float wbin = Rq * (1.f / 256.f), fH = __builtin_fmaf((float)(st[288 + r32] + 1u), wbin, -Rq), fA = __builtin_fmaf((float)st[320 + r32], wbin, -Rq), s2 = 524287.f / (fH - fA), nfa = -fA * s2;
            bf16x8 kn[2][4]; if (wave < npair) { IDX_KLOAD2(wave) }
            for (int tp = wave; tp < npair; tp += NWAVES) {
                IDX_SCORES2(tp)
#define IDX_FAST_ELEMS(SC, T) { unsigned v = 0u, cm = 0u; \
            _Pragma("unroll") for (int i = 15; i >= 0; --i) { v = __builtin_amdgcn_alignbit(v, __builtin_bit_cast(unsigned, SC[i] - fH), 31);        \
                                                              cm = __builtin_amdgcn_alignbit(cm, __builtin_bit_cast(unsigned, SC[i] - fA), 31); } \
            cm = v & ~cm & 0xffffu; v = ~v & 0xffffu;                                                           \
            if (cm) { const unsigned pos0 = __hip_atomic_fetch_add(&st[96 + r32], (unsigned)__builtin_popcount(cm), __ATOMIC_RELAXED, __HIP_MEMORY_SCOPE_WORKGROUP);     \
                const unsigned rb = 8191u - (unsigned)(32 * (T)) - hi4; \
                _Pragma("unroll") for (int i = 0; i < 16; ++i) if (cm & (1u << i)) { const unsigned pos = min(pos0 + (unsigned)__builtin_popcount(cm & ((1u << i) - 1u)), (unsigned)FAST_CAP - 1u); \
                    cand[r32 * FAST_CAP + pos] = (min((unsigned)__builtin_fmaf(SC[i], s2, nfa), 524287u) << 13) | (rb - (unsigned)((i & 3) + 8 * (i >> 2))); } } \
            unsigned bits = (v & 0xfu) | ((v & 0xf0u) << 4) | ((v & 0xf00u) << 8) | ((v & 0xf000u) << 12);     \
            bits <<= 4 * hi; bits = half_or(bits); if (hi == 0) img[(T) * 32 + r32] = bits; }
                unsigned hi4 = 4u * (unsigned)hi; asm volatile("" : "+v"(hi4));
                IDX_FAST_ELEMS(sc0, 2 * tp)
                IDX_FAST_ELEMS(sc1, 2 * tp + 1)
#undef IDX_FAST_ELEMS
            }
        }
        __syncthreads();
        {
            const int q = tid >> 4, l16 = tid & 15; unsigned above = 0u;
            for (int t = l16; t < ntile; t += 16) above += (unsigned)__builtin_popcount(img[t * 32 + q]);
            above = row16_sum(above);
            const unsigned n = st[96 + q];
            if (l16 == 0) { if (above >= 256u || 256u - above > n || n > (unsigned)FAST_CAP) st[130] = 1u; st[32 + q] = 256u - above; }
        }
        __syncthreads();
        slow = st[130] != 0u;
#ifdef REP_SEL
        for (int rep3 = 0; rep3 < 2; ++rep3)
#endif
        if (!slow) {
            const int q = tid >> 4, l16 = tid & 15; const unsigned n = st[96 + q], need = st[32 + q];
            unsigned c[FAST_CAP / 16];
#pragma unroll
            for (int i = 0; i < FAST_CAP / 16; ++i) { const unsigned ci = (unsigned)(l16 + 16 * i); c[i] = ci < n ? cand[q * FAST_CAP + ci] : 0u; }
            unsigned Pv = 0u; bool done = false;
#pragma nounroll
            for (int bit = 31; bit >= 0; --bit) { const unsigned trial = Pv | (1u << bit); unsigned cnt = 0u;
#pragma unroll
                for (int i = 0; i < FAST_CAP / 16; ++i) cnt += (c[i] >= trial) ? 1u : 0u;
                cnt = row16_sum(cnt);
                if (!done && cnt >= need) { Pv = trial; done = (cnt == need); }
                if (__all(done)) break; }
#pragma unroll
            for (int i = 0; i < FAST_CAP / 16; ++i) if ((unsigned)(l16 + 16 * i) < n && c[i] >= Pv) { const unsigned kidx = 8191u - (c[i] & 8191u);
                __hip_atomic_fetch_or(&img[(kidx >> 5) * 32 + q], 1u << (kidx & 31), __ATOMIC_RELAXED, __HIP_MEMORY_SCOPE_WORKGROUP); }
        } else if (tid < 32) { st[32 + tid] = 256u; st[96 + tid] = 0u; }
        __syncthreads();
    }
#ifdef DIAG_SLOW
    if (slow && tid == 0) __hip_atomic_fetch_add(P.dbg, 1u, RLX_AGENT);
#endif
    if (slow) {
    for (;;) {
        ++level;
        for (int u = tid; u < 32 * HS; u += NTHR) hist[u] = 0u;
        if (tid == 0) st[128] = 0u;
        __syncthreads();
        {
            const unsigned qa = st[r32], qlen = st[192 + r32], base1 = st[160 + r32]; const float cq = __builtin_bit_cast(float, st[224 + r32]);
            const int sh = (level > 1 && qlen > 512u) ? (32 - __builtin_clz(qlen - 1u)) - 9 : 0;
            LAS unsigned* hrow = hist + r32 * HS;
            bf16x8 kn[2][4]; if (wave < npair) { IDX_KLOAD2(wave) }
            for (int tp = wave; tp < npair; tp += NWAVES) {
                IDX_SCORES2(tp)
                if (level == 1) {
#pragma unroll
                    for (int i = 0; i < 16; ++i) { const unsigned k0 = mono_key(sc0[i] + cq), k1 = mono_key(sc1[i] + cq);
                        const unsigned b0 = min((max(k0, base1) - base1) >> 17, 511u), b1 = min((max(k1, base1) - base1) >> 17, 511u);
                        __hip_atomic_fetch_add(&hrow[b0], 1u, __ATOMIC_RELAXED, __HIP_MEMORY_SCOPE_WORKGROUP); __hip_atomic_fetch_add(&hrow[b1], 1u, __ATOMIC_RELAXED, __HIP_MEMORY_SCOPE_WORKGROUP); }
                } else {
#pragma unroll
                    for (int i = 0; i < 16; ++i) { const unsigned o0 = mono_key(sc0[i] + cq) - qa, o1 = mono_key(sc1[i] + cq) - qa;
                        if (o0 < qlen) __hip_atomic_fetch_add(&hrow[o0 >> sh], 1u, __ATOMIC_RELAXED, __HIP_MEMORY_SCOPE_WORKGROUP);
                        if (o1 < qlen) __hip_atomic_fetch_add(&hrow[o1 >> sh], 1u, __ATOMIC_RELAXED, __HIP_MEMORY_SCOPE_WORKGROUP); }
                }
            }
        }
        __syncthreads();
        {
            const int q = tid >> 4, seg = tid & 15;
            unsigned segsum = 0u;
            for (int wi = 0; wi < 32; ++wi) segsum += hist[q * HS + seg * 32 + wi];
            unsigned S = segsum;
            S = row16_suffix(S);
            const unsigned above = S - segsum, need = st[32 + q];
            if (above < need && need <= above + segsum) {
                unsigned cum = above, fbin = 0u, fneed = 1u, fcnt = 0u; bool found = false;
                for (int wi = 31; wi >= 0; --wi) { const unsigned c = hist[q * HS + seg * 32 + wi];
                    if (!found && cum + c >= need) { found = true; fbin = (unsigned)wi; fneed = need - cum; fcnt = c; } if (!found) cum += c; }
                fbin += 32u * (unsigned)seg;
                unsigned na, nlen;
                if (level == 1) { const unsigned base1 = st[160 + q];
                    if (fbin == 0u) { na = 0u; nlen = base1 + 131072u; } else if (fbin == 511u) { na = base1 + 511u * 131072u; nlen = 0u - na; } else { na = base1 + fbin * 131072u; nlen = 131072u; } }
                else { const unsigned qa = st[q], qlen = st[192 + q]; const int sh = qlen > 512u ? (32 - __builtin_clz(qlen - 1u)) - 9 : 0;
                    na = qa + (fbin << sh); nlen = min(1u << sh, qlen - (fbin << sh)); }
                st[q] = na; st[192 + q] = nlen; st[32 + q] = fneed; st[64 + q] = fcnt;
                if (fcnt > (unsigned)CAND_CAP && nlen > 1u) st[128] = 1u;
            }
        }
        __syncthreads();
#ifndef MAXLVL
#define MAXLVL 8
#endif
        const bool more = (st[128] != 0u) && (level < MAXLVL);
        __syncthreads();
        if (!more) break;
    }
    {
        const unsigned qa = st[r32], qlen = st[192 + r32]; const float cq = __builtin_bit_cast(float, st[224 + r32]);
        const unsigned Hk = qa + qlen - 1u;
        unsigned hb = (Hk & 0x80000000u) ? (Hk ^ 0x80000000u) : ~Hk;
        if (hb == 0x80000000u) hb = 0x80000001u;
        const float fH = __builtin_bit_cast(float, hb);
        const unsigned ab_ = (qa & 0x80000000u) ? (qa ^ 0x80000000u) : ~qa;
        const float fA = (qa < 0x00800000u) ? -__builtin_inff() : __builtin_bit_cast(float, ab_);
        bf16x8 kn[2][4]; if (wave < npair) { IDX_KLOAD2(wave) }
        for (int tp = wave; tp < npair; tp += NWAVES) {
            IDX_SCORES2(tp)
#define IDX_COLLECT_ELEMS(SC, T) { unsigned v = 0u; _Pragma("unroll") for (int i = 15; i >= 0; --i) { const float ts = SC[i] + cq; const bool ab = ts > fH; v = v + v + (ab ? 1u : 0u); \
                if (!ab && ts >= fA) { const unsigned key = mono_key(ts); \
                    const unsigned pos = __hip_atomic_fetch_add(&st[96 + r32], 1u, __ATOMIC_RELAXED, __HIP_MEMORY_SCOPE_WORKGROUP); \
                    if (pos < (unsigned)CAND_CAP) { cand[(r32 * CAND_CAP + pos) * 2] = key; cand[(r32 * CAND_CAP + pos) * 2 + 1] = (unsigned)(32 * (T) + crow(i, hi)); } } } \
            unsigned bits = (v & 0xfu) | ((v & 0xf0u) << 4) | ((v & 0xf00u) << 8) | ((v & 0xf000u) << 12);     \
            bits <<= 4 * hi; bits = half_or(bits); if (hi == 0) img[(T) * 32 + r32] = bits; }
            IDX_COLLECT_ELEMS(sc0, 2 * tp)
            IDX_COLLECT_ELEMS(sc1, 2 * tp + 1)
#undef IDX_COLLECT_ELEMS
        }
    }
#undef IDX_SCORES2
#undef IDX_KLOAD2
    __syncthreads();
    {
        const int q = tid >> 4; const unsigned n = min(st[96 + q], (unsigned)CAND_CAP), need = st[32 + q];
        for (unsigned c = tid & 15; c < n; c += 16) { const unsigned key = cand[(q * CAND_CAP + c) * 2], idx = cand[(q * CAND_CAP + c) * 2 + 1]; unsigned rank = 0u;
            for (unsigned o = 0; o < n; ++o) { const unsigned k2 = cand[(q * CAND_CAP + o) * 2], i2 = cand[(q * CAND_CAP + o) * 2 + 1]; rank += (k2 > key || (k2 == key && i2 < idx)) ? 1u : 0u; }
            if (rank < need) __hip_atomic_fetch_or(&img[(idx >> 5) * 32 + q], 1u << (idx & 31), __ATOMIC_RELAXED, __HIP_MEMORY_SCOPE_WORKGROUP); }
    }
    }
    __syncthreads();
    for (int idx = tid; idx < ntile * 32; idx += NTHR) P.BM[((size_t)b * 256 + (idx >> 5)) * SEQ + q0 + (idx & 31)] = img[idx];
    __syncthreads();
}

__device__ __forceinline__ int wq_next(Frame& F, int cw) {
    __syncthreads();
    if (F_TID == 0) F.MISC[0] = __hip_atomic_fetch_add((unsigned*)(F.ctl + cw), 1u, RLX_AGENT);
    __syncthreads();
    return (int)F.MISC[0];
}

__device__ __forceinline__ void p5a_route(Frame& F, const Args& A) {
    const int lane = F_LANE, tid = F_TID, wave = F_WAVE;
    const float* x1 = A.out; const float* g2 = A.in[11];
    const float* wrg = A.in[12]; const float* brg = A.in[13]; const float* wre = A.in[14]; const float* bre = A.in[15];
    int* toke = (int*)(F.ws + WS_TOKE); float* tokw = (float*)(F.ws + WS_TOKW); float* rstd2 = (float*)(F.ws + WS_RSTD2);
    int* sslot = (int*)(F.ws + WS_SSLOT);
    constexpr int WST = 44, WCH = 256 * WST * 4;
    LAS float* wl = (LAS float*)F.lds;
    LAS unsigned* lcnt = (LAS unsigned*)(F.lds + 2 * WCH);
    LAS float* lgs = (LAS float*)(F.lds + 2 * WCH + 256);
    for (int i = F.vcu * NTHR + tid; i < SORT_ROWS; i += F.G * NTHR) sslot[i] = -1;
    if (tid < NEXP) lcnt[tid] = 0u;
    const int i16 = lane & 15, kq = lane >> 4, tile = wave & 3, half = wave >> 2;
    const int per = T / F.G;
    for (int t0 = F.vcu * per; t0 < (F.vcu + 1) * per; t0 += 64) {
        const float* xr = x1 + (size_t)(t0 + 16 * tile + i16) * D + 4 * kq;
        f32x4 acc0 = (f32x4){0.f, 0.f, 0.f, 0.f}, acc1 = acc0; float ss = 0.f;
        f32x4 se[4], sg; float gk[5];
#define RT_LOAD(c) do { _Pragma("unroll") for (int q = 0; q < 4; ++q) { const int f = tid + 512 * q, k = f >> 3; se[q] = *(const GAS f32x4*)(wre + (size_t)(256 * (c) + k) * 32 + 4 * (f & 7)); gk[q] = g2[256 * (c) + k]; } \
            { const int k = tid >> 1; sg = *(const GAS f32x4*)(wrg + (size_t)(256 * (c) + k) * 8 + 4 * (tid & 1)); gk[4] = g2[256 * (c) + k]; } } while (0)
#define RT_WRITE(bf) do { LAS float* wb = wl + (bf) * (WCH / 4); _Pragma("unroll") for (int q = 0; q < 4; ++q) { const int f = tid + 512 * q, k = f >> 3; *(LAS f32x4*)(wb + k * WST + 4 * (f & 7)) = se[q] * gk[q]; } \
            { const int k = tid >> 1; *(LAS f32x4*)(wb + k * WST + 32 + 4 * (tid & 1)) = sg * gk[4]; } } while (0)
        RT_LOAD(0); RT_WRITE(0); __syncthreads();
        for (int c = 0; c < 4; ++c) {
            if (c + 1 < 4) RT_LOAD(c + 1);
            const LAS float* wb = wl + (c & 1) * (WCH / 4) + 4 * kq * WST + i16 + 16 * half;
#pragma unroll 4
            for (int s = 0; s < 16; ++s) {
                const f32x4 a4 = *(const GAS f32x4*)(xr + 256 * c + 16 * s);
                if (half == 0) ss += (a4.x * a4.x + a4.y * a4.y) + (a4.z * a4.z + a4.w * a4.w);
#pragma unroll
                for (int cc = 0; cc < 4; ++cc) { const LAS float* wp = wb + (16 * s + cc) * WST;
                    acc0 = __builtin_amdgcn_mfma_f32_16x16x4f32(a4[cc], wp[0], acc0, 0, 0, 0);
                    if (half == 0) acc1 = __builtin_amdgcn_mfma_f32_16x16x4f32(a4[cc], wp[32 - (i16 & 8)], acc1, 0, 0, 0); }
            }
            if (c + 1 < 4) RT_WRITE((c + 1) & 1);
            __syncthreads();
        }
#undef RT_LOAD
#undef RT_WRITE
        LAS float* lt = lgs + tile * 640;
#pragma unroll
        for (int r = 0; r < 4; ++r) { const int tk = 4 * kq + r; lt[tk * 40 + 8 + 16 * half + i16] = acc0[r]; if (half == 0 && i16 < 8) lt[tk * 40 + i16] = acc1[r]; }
        if (half == 0) { ss += __shfl_xor(ss, 16); ss += __shfl_xor(ss, 32); if (kq == 0) lgs[2560 + 16 * tile + i16] = 1.f / sqrtf(ss * (1.f / D) + EPS); }
        __syncthreads();
        if (half == 0 && lane < 16) {
            const int m = t0 + 16 * tile + lane; const float rstd = lgs[2560 + 16 * tile + lane]; const LAS float* lg = lt + lane * 40;
            float gl[8];
#pragma unroll
            for (int k = 0; k < 8; ++k) gl[k] = lg[k] * rstd + brg[k];
            int gs = 0; float gm = gl[0];
#pragma unroll
            for (int k = 1; k < 8; ++k) if (gl[k] > gm) { gm = gl[k]; gs = k; }
            float den = 0.f;
#pragma unroll
            for (int k = 0; k < 8; ++k) den += __expf(gl[k] - gm);
            const float wgrp = 1.f / den;
            float el[4];
#pragma unroll
            for (int cc = 0; cc < 4; ++cc) el[cc] = lg[8 + 4 * gs + cc] * rstd + bre[4 * gs + cc];
            int i1 = 0; float v1 = el[0];
#pragma unroll
            for (int cc = 1; cc < 4; ++cc) if (el[cc] > v1) { v1 = el[cc]; i1 = cc; }
            int i2 = -1; float v2 = 0.f;
#pragma unroll
            for (int cc = 0; cc < 4; ++cc) if (cc != i1 && (i2 < 0 || el[cc] > v2)) { v2 = el[cc]; i2 = cc; }
            const float e2 = __expf(v2 - v1), w1 = 1.f / (1.f + e2), w2 = e2 / (1.f + e2);
            toke[2 * m] = gs * 4 + i1; toke[2 * m + 1] = gs * 4 + i2; tokw[2 * m] = w1 * wgrp; tokw[2 * m + 1] = w2 * wgrp; rstd2[m] = rstd;
            __hip_atomic_fetch_add(&lcnt[gs * 4 + i1], 1u, __ATOMIC_RELAXED, __HIP_MEMORY_SCOPE_WORKGROUP);
            __hip_atomic_fetch_add(&lcnt[gs * 4 + i2], 1u, __ATOMIC_RELAXED, __HIP_MEMORY_SCOPE_WORKGROUP);
        }
        __syncthreads();
    }
    if (tid < NEXP && lcnt[tid]) __hip_atomic_fetch_add((unsigned*)(F.ctl + CW_CNT + tid), lcnt[tid], RLX_AGENT);
}

__device__ __forceinline__ void p5a2_scatter(Frame& F, const Args& A) {
    const int lane = F_LANE, tid = F_TID;
    const float* x1 = A.out; const float* g2 = A.in[11];
    const int* toke = (const int*)(F.ws + WS_TOKE); const float* tokw = (const float*)(F.ws + WS_TOKW); const float* rstd2 = (const float*)(F.ws + WS_RSTD2);
    int* sslot = (int*)(F.ws + WS_SSLOT); float* sw = (float*)(F.ws + WS_SW); int* t2e = (int*)(F.ws + WS_T2E);
    bf16* AS = (bf16*)(F.ws + WS_ASORT);
    LAS unsigned* sh = (LAS unsigned*)F.lds;
    if (tid < NEXP) sh[256 + tid] = __hip_atomic_load((unsigned*)(F.ctl + CW_CNT + tid), RLX_AGENT);
    __syncthreads();
    if (tid == 0) { unsigned acc = 0u;
        for (int e = 0; e < NEXP; ++e) { const unsigned c = sh[256 + e]; sh[e] = acc; const unsigned nt = (c + 255u) / 256u;
            if (blockIdx.x == 0) for (unsigned i = 0; i < nt; ++i) t2e[acc / 256u + i] = e;
            acc += nt * 256u; }
        if (blockIdx.x == 0) t2e[255] = (int)(acc / 256u); }
    const int per = T / F.G;
    for (int t0 = F.vcu * per; t0 < (F.vcu + 1) * per; t0 += 64) {
        if (tid < NEXP) sh[32 + tid] = 0u;
        __syncthreads();
        int e = 0; unsigned lpos = 0u;
        if (tid < 128) { e = toke[2 * t0 + tid]; lpos = __hip_atomic_fetch_add(&sh[32 + e], 1u, __ATOMIC_RELAXED, __HIP_MEMORY_SCOPE_WORKGROUP); }
        __syncthreads();
        if (tid < NEXP) sh[64 + tid] = sh[tid] + (sh[32 + tid] ? __hip_atomic_fetch_add((unsigned*)(F.ctl + CW_FILL + tid), sh[32 + tid], RLX_AGENT) : 0u);
        __syncthreads();
        if (tid < 128) { const unsigned pos = sh[64 + e] + lpos; sh[96 + tid] = pos; sslot[pos] = 2 * t0 + tid; sw[pos] = tokw[2 * t0 + tid]; }
        __syncthreads();
        for (int tk0 = F_WAVE; tk0 < 64; tk0 += 4 * NWAVES) {
            f32x4 xv[4][4];
#pragma unroll
            for (int r = 0; r < 4; ++r) { const GAS f32x4* xr = (const GAS f32x4*)(x1 + (size_t)(t0 + tk0 + r * NWAVES) * D) + lane;
#pragma unroll
                for (int j = 0; j < 4; ++j) xv[r][j] = xr[64 * j]; }
#pragma unroll
            for (int r = 0; r < 4; ++r) { const int tk = tk0 + r * NWAVES, m = t0 + tk; const float rstd = rstd2[m];
                const unsigned p0 = sh[96 + 2 * tk], p1 = sh[96 + 2 * tk + 1];
#pragma unroll
                for (int j = 0; j < 4; ++j) { const f32x4 g = *((const GAS f32x4*)g2 + lane + 64 * j); const f32x4 y = xv[r][j] * rstd * g; v2u w; w.x = pk2(y.x, y.y); w.y = pk2(y.z, y.w);
                    *((GAS v2u*)(AS + (size_t)p0 * D) + lane + 64 * j) = w; *((GAS v2u*)(AS + (size_t)p1 * D) + lane + 64 * j) = w; } } }
        __syncthreads();
    }
}

__device__ __forceinline__ void p6_final(Frame& F, const Args& A) {
    const int gw = F.vcu * NWAVES + F_WAVE, NGW = F.G * NWAVES, lane = F_LANE;
    const float* gf = A.in[19]; float* out = A.out; const bf16* SL = (const bf16*)(F.ws + WS_SLOTS);
    for (int m0 = gw; m0 < T; m0 += 2 * NGW) {
        f32x4 v[2][4]; v2u a[2][4], c[2][4];
#pragma unroll
        for (int r = 0; r < 2; ++r) { const int m = min(m0 + r * NGW, T - 1); const GAS f32x4* xr = (const GAS f32x4*)(out + (size_t)m * D) + lane;
            const GAS v2u* s0 = (const GAS v2u*)(SL + (size_t)(2 * m) * D) + lane; const GAS v2u* s1 = (const GAS v2u*)(SL + (size_t)(2 * m + 1) * D) + lane;
#pragma unroll
            for (int j = 0; j < 4; ++j) { v[r][j] = xr[64 * j]; a[r][j] = s0[64 * j]; c[r][j] = s1[64 * j]; } }
#pragma unroll
        for (int r = 0; r < 2; ++r) { const int m = m0 + r * NGW; float s = 0.f;
#pragma unroll
            for (int j = 0; j < 4; ++j) { f32x4& w = v[r][j];
                w.x += bflo(a[r][j].x) + bflo(c[r][j].x); w.y += bfhi(a[r][j].x) + bfhi(c[r][j].x); w.z += bflo(a[r][j].y) + bflo(c[r][j].y); w.w += bfhi(a[r][j].y) + bfhi(c[r][j].y);
                s += (w.x * w.x + w.y * w.y) + (w.z * w.z + w.w * w.w); }
            const float rstd = 1.f / sqrtf(wave_sum(s) * (1.f / D) + EPS);
            if (m < T) { GAS f32x4* xo = (GAS f32x4*)(out + (size_t)m * D) + lane;
#pragma unroll
                for (int j = 0; j < 4; ++j) { const f32x4 g = *((const GAS f32x4*)gf + lane + 64 * j); xo[64 * j] = v[r][j] * rstd * g; } } }
    }
}

constexpr int NPHASE = 13;
__global__ void __launch_bounds__(NTHR, 2) mk_fwd(Args args) {
    extern __shared__ __attribute__((aligned(16))) unsigned char lds[];
    Frame F;
    F.lds = (LAS unsigned char*)lds; F.MISC = (volatile LAS unsigned*)(F.lds + MISC_OFF);
        F.G = gridDim.x; { const int bx = blockIdx.x; F.vcu = (F.G % 8 == 0) ? (bx % 8) * (F.G / 8) + bx / 8 : bx; }
    F.ws = args.ws; F.ctl = (gu32*)(args.ws + WS_CTL);
    unsigned char* ws = args.ws;
    if (F_TID < 128) F.MISC[F_TID] = 0u;
    __syncthreads();
    const bool single = (args.ph_hi - args.ph_lo) > 1;
    XcdBarrier bar; bar.bar = (unsigned*)(F.ctl + CW_BAR); bar.x = 0; bar.st = nullptr;
    if (single) bar = xcd_barrier_post((unsigned*)(F.ctl + CW_BAR), F.MISC + 8);
    const int lo = args.ph_lo, hi = args.ph_hi;
#ifdef ONLY
#define IN(k) ((k) == ONLY && lo <= (k) && (k) < hi)
#else
#define IN(k) (lo <= (k) && (k) < hi)
#endif
#ifdef TS_A
#define STAMP(k) do { if (blockIdx.x == 0 && threadIdx.x == 0) ((unsigned long long*)(ws + WS_CTL + 8192))[(k) + 1] = __builtin_amdgcn_s_memrealtime(); } while (0)
#else
#define STAMP(k) do { } while (0)
#endif
#define SEAM(k) do { if (IN((k) + 1)) xcd_barrier(bar); STAMP(k); } while (0)
    const f32x2* rope = (const f32x2*)(ws + WS_ROPE);
    bf16* GA = (bf16*)args.out; bf16* GB = (bf16*)args.out + (size_t)T * 1024;

    STAMP(-1);
    if (IN(0)) { p0_prologue(F, args);
#ifdef REP_P0
        p0_prologue(F, args);
#endif
        SEAM(0); }
    if (IN(1)) {
        pg8::Gemm g{(const bf16*)(ws + WS_H), (const bf16*)(ws + WS_WIN), T, NIN, D, 0}; pg8::StaticOrder S; S.init(T, NIN, F.G, (int)blockIdx.x);
        pg8::EpiIn E{(bf16*)(ws + WS_CQ), (bf16*)(ws + WS_CKV), (bf16*)(ws + WS_QB), (bf16*)(ws + WS_KB), (bf16*)(ws + WS_VB), (bf16*)(ws + WS_QI), (bf16*)(ws + WS_KI), (bf16*)(ws + WS_KR), GA, GB, (float*)(ws + WS_WI), rope, (float*)(ws + WS_PART)};
        pg8::gemm_phase<pg8::EpiIn, pg8::StaticOrder, true, true>(F.lds, g, S, E);
#ifdef REP_P1
        pg8::gemm_phase<pg8::EpiIn, pg8::StaticOrder, true, true>(F.lds, g, S, E);
#endif
#ifdef CONV_AT_P1
        for (;;) { const int c = wq_next(F, CW_Q2); if (c >= CV_QITEMS) break;
            int ltid = threadIdx.x; asm volatile("" : "+v"(ltid));
            const int lw = __builtin_amdgcn_readfirstlane(ltid >> 6); LAS float* scr = (LAS float*)(F.lds + lw * 16640);
            conv_tile2(args, ws, CV_EARLY + 16 * c + lw, CV_EARLY + 16 * c + 8 + lw, scr, ltid & 63); }
#endif
        SEAM(1);
    }
#ifdef P2A_OLD
    if (IN(2)) { p2a_norms(F, args); SEAM(2); }
#endif
    if (IN(3)) {
#ifdef REP_P3
      for (int rep = 0; rep < 2; ++rep) {
#else
      {
#endif
#ifndef NO3A
        { pg8::Gemm g{(const bf16*)(ws + WS_CQ), (const bf16*)(ws + WS_WUQ), T, 768, 384, 0}; pg8::StaticOrder S; S.init(T, 768, F.G, (int)blockIdx.x);
          LAS float* rsl = (LAS float*)(F.lds + 131072);
          { pg8::Unit u0; if (S.next(0, u0) && F_TID < 256) { const f32x4* pp = (const f32x4*)((const float*)(ws + WS_PART) + (size_t)(u0.pm * 256 + F_TID) * 20); const f32x4 a = pp[0], b = pp[1], c = pp[2];
              rsl[F_TID] = C2A / sqrtf(((((a[0] + a[1]) + (a[2] + a[3])) + ((b[0] + b[1]) + (b[2] + b[3]))) + ((c[0] + c[1]) + (c[2] + c[3]))) * (1.f / 384.f) + EPS); } }
          __syncthreads();
          pg8::EpiQA E{(bf16*)(ws + WS_QA), rope, rsl}; pg8::gemm_phase<pg8::EpiQA, pg8::StaticOrder, true, true>(F.lds, g, S, E); }
#endif
#ifndef NO3B
        { pg8::Gemm g{(const bf16*)(ws + WS_CKV), (const bf16*)(ws + WS_WUKV), T, 1024, 256, 0}; pg8::StaticOrder S; S.init(T, 1024, F.G, (int)blockIdx.x);
          LAS float* rsl = (LAS float*)(F.lds + 131072 + 1024);
          { pg8::Unit u0; if (S.next(0, u0) && F_TID < 256) { const f32x4* pp = (const f32x4*)((const float*)(ws + WS_PART) + (size_t)(u0.pm * 256 + F_TID) * 20 + 12); const f32x4 a = pp[0], b = pp[1];
              rsl[F_TID] = 1.f / sqrtf((((a[0] + a[1]) + (a[2] + a[3])) + ((b[0] + b[1]) + (b[2] + b[3]))) * (1.f / 256.f) + EPS); } }
          __syncthreads();
          pg8::EpiKV E{(bf16*)(ws + WS_KN), (bf16*)(ws + WS_VA), rsl}; pg8::gemm_phase<pg8::EpiKV, pg8::StaticOrder, true, true>(F.lds, g, S, E); }
#endif
      }
        SEAM(3);
    }
    if (IN(4)) {
        unsigned* rdy = (unsigned*)(F.ctl + CW_RDY);
#ifndef CONV_AT_P1
        constexpr int NCVQ = CV_QITEMS;
#else
        constexpr int NCVQ = 0;
#endif
        for (;;) { const int k = wq_next(F, CW_Q1); if (k >= 1536 + NCVQ) break;
            int ltid = threadIdx.x; asm volatile("" : "+v"(ltid));
            const int lw = __builtin_amdgcn_readfirstlane(ltid >> 6);
            if (k < 512) { const int ib = k & 1, ij = 255 - (k >> 1);
                const IdxP IP{(const bf16*)(ws + WS_QI), (const bf16*)(ws + WS_KI), (const float*)(ws + WS_WI), (unsigned*)(ws + WS_BM), (unsigned*)(F.ctl + 1024)};
                idx_item(F.lds, ib, ij, IP, ltid, ltid & 63, lw);
#ifdef REP_IDX
                __syncthreads(); idx_item(F.lds, ib, ij, IP, ltid, ltid & 63, lw);
#endif
                VM_WAIT(); __syncthreads();
                if (ltid == 0) { __builtin_amdgcn_fence(__ATOMIC_RELEASE, "agent"); VM_WAIT(); __hip_atomic_fetch_add(rdy + 64 * (ib * 32 + (ij >> 3)), 1u, RLX_AGENT); }
                continue; }
            const int j = k - 512; int a;
            if (j < 3 * NCVQ) { const int q3 = j / 3, r3 = j - 3 * q3; a = (r3 == 2) ? -1 - q3 : 2 * q3 + r3; } else a = j - NCVQ;
            if (a < 0) { const int c = -1 - a; LAS float* scr = (LAS float*)(F.lds + lw * 16640);
                conv_tile2(args, ws, CV_EARLY + 16 * c + lw, CV_EARLY + 16 * c + 8 + lw, scr, ltid & 63);
                continue; }
            { const int u = a >> 1, ub = (u & 15) >> 3, uh = u & 7, uq = 31 - (u >> 4);
                if (a & 1) { const AttnP APA{(const bf16*)(ws + WS_QA), (const bf16*)(ws + WS_KN), (const bf16*)(ws + WS_KR), (const bf16*)(ws + WS_VA), (bf16*)(ws + WS_OA), nullptr};
#ifdef MLA_OLD
                    attn_unit<true>(F.lds, ub, uh, uq, APA, ltid, ltid & 63, lw); }
#else
                    attn_body::attn_unit<8, true>(ub, uh, uq, (const attn_body::bf16*)APA.Q, (const attn_body::bf16*)APA.K, (const attn_body::bf16*)APA.K2, (const attn_body::bf16*)APA.V, (attn_body::bf16*)APA.O, nullptr, (char*)F.lds, ltid); }
#endif
                else { const AttnP APB{(const bf16*)(ws + WS_QB), (const bf16*)(ws + WS_KB), nullptr, (const bf16*)(ws + WS_VB), (bf16*)(ws + WS_OB), (const unsigned*)(ws + WS_BM)};
                    if (ltid == 0) { unsigned sp = 0u; while (__hip_atomic_load(rdy + 64 * (ub * 32 + uq), RLX_AGENT) < 8u) { __builtin_amdgcn_s_sleep(8); if (++sp > (1u << 22)) break; }
                        __builtin_amdgcn_fence(__ATOMIC_ACQUIRE, "agent"); VM_WAIT(); }
                    __syncthreads();
#ifdef DSA_OLD
                    attn_unit<false>(F.lds, ub, uh, uq, APB, ltid, ltid & 63, lw); } }
#else
                    attn_body::attn_unit<8, false>(ub, uh, uq, (const attn_body::bf16*)APB.Q, (const attn_body::bf16*)APB.K, nullptr, (const attn_body::bf16*)APB.V, (attn_body::bf16*)APB.O, APB.BM, (char*)F.lds, ltid); } }
#endif
        }
    }
    if (IN(5)) { SEAM(5); }
    if (IN(6)) {
#ifdef REP_P6
      for (int rep = 0; rep < 2; ++rep) {
#else
      {
#endif
        { pg8::Gemm g{(const bf16*)(ws + WS_OA), (const bf16*)(ws + WS_WOA), T, 1024, 512, 0}; pg8::StaticOrder S; S.init(T, 1024, F.G, (int)blockIdx.x);
          pg8::EpiY<0> E{(bf16*)(ws + WS_Y), GA}; pg8::gemm_phase<pg8::EpiY<0>, pg8::StaticOrder, true, true>(F.lds, g, S, E); }
        { pg8::Gemm g{(const bf16*)(ws + WS_OB), (const bf16*)(ws + WS_WOB), T, 1024, 512, 0}; pg8::StaticOrder S; S.init(T, 1024, F.G, (int)blockIdx.x);
          pg8::EpiY<1> E{(bf16*)(ws + WS_Y), GB}; pg8::gemm_phase<pg8::EpiY<1>, pg8::StaticOrder, true, true>(F.lds, g, S, E); }
      }
        SEAM(6);
    }
    if (IN(7)) {
        pg8::Gemm g{(const bf16*)(ws + WS_Y), (const bf16*)(ws + WS_WOUT), T, 1024, 1024, 0}; pg8::StaticOrder S; S.init(T, 1024, F.G, (int)blockIdx.x);
        pg8::EpiX1 E{args.in[0], args.out}; pg8::gemm_phase<pg8::EpiX1, pg8::StaticOrder, true, true>(F.lds, g, S, E);
#ifdef REP_P7
        pg8::gemm_phase<pg8::EpiX1, pg8::StaticOrder, true, true>(F.lds, g, S, E);
#endif
        SEAM(7);
    }
    if (IN(8)) { p5a_route(F, args); SEAM(8); }
    if (IN(9)) { p5a2_scatter(F, args); SEAM(9); }
    if (IN(10)) {
        const int* t2e = (const int*)(ws + WS_T2E); const int ntl = t2e[255];
        pg8::Gemm g{(const bf16*)(ws + WS_ASORT), (const bf16*)(ws + WS_WGU), SORT_ROWS, 512, 1024, (size_t)512 * 1024 * 2}; pg8::GroupOrder S; S.init(ntl, 2, F.G, (int)blockIdx.x, t2e);
        pg8::EpiHid E{(bf16*)(ws + WS_HID)}; pg8::gemm_phase<pg8::EpiHid, pg8::GroupOrder, true, true>(F.lds, g, S, E);
#ifdef REP_P10
        pg8::gemm_phase<pg8::EpiHid, pg8::GroupOrder, true, true>(F.lds, g, S, E);
#endif
        SEAM(10);
    }
    if (IN(11)) {
        const int* t2e = (const int*)(ws + WS_T2E); const int ntl = t2e[255];
        pg8::Gemm g{(const bf16*)(ws + WS_HID), (const bf16*)(ws + WS_WD), SORT_ROWS, 1024, 256, (size_t)1024 * 256 * 2}; pg8::GroupOrder S; S.init(ntl, 4, F.G, (int)blockIdx.x, t2e);
        pg8::EpiDown E{(bf16*)(ws + WS_SLOTS), (const int*)(ws + WS_SSLOT), (const float*)(ws + WS_SW)}; pg8::gemm_phase<pg8::EpiDown, pg8::GroupOrder, true, true>(F.lds, g, S, E);
#ifdef REP_P11
        pg8::gemm_phase<pg8::EpiDown, pg8::GroupOrder, true, true>(F.lds, g, S, E);
#endif
        SEAM(11);
    }
    if (IN(12)) { p6_final(F, args); }
#ifdef DIAG_SLOW
    if (blockIdx.x == 0 && threadIdx.x == 0) { const unsigned long long t0 = __builtin_amdgcn_s_memrealtime(), wait = 100ull * __hip_atomic_load((unsigned*)(F.ctl + 1024), RLX_AGENT);
        while (__builtin_amdgcn_s_memrealtime() - t0 < wait) __builtin_amdgcn_s_sleep(16); }
#endif
#ifdef TS_A
    if (blockIdx.x == 0 && threadIdx.x == 0) { STAMP(12); __builtin_amdgcn_s_waitcnt(0);
        const unsigned long long* tsp = (const unsigned long long*)(ws + WS_CTL + 8192);
        const unsigned long long ta = __hip_atomic_load(tsp + (TS_A) + 1, RLX_AGENT), tb = __hip_atomic_load(tsp + (TS_B) + 1, RLX_AGENT);
        const unsigned long long t0 = __builtin_amdgcn_s_memrealtime(), wait = 4ull * (tb - ta);
        while (__builtin_amdgcn_s_memrealtime() - t0 < wait) __builtin_amdgcn_s_sleep(16); }
#endif
#undef IN
#undef SEAM
}

#ifndef MK_MULTI
#define MK_MULTI 0
#endif
extern "C" void kernel_launch(void* const* d_in, const int* in_sizes, int n_in, void* d_out, int out_size, void* d_ws, size_t ws_size, hipStream_t stream) {
    static int grid = 0;
    if (grid == 0) {
        if (n_in != 20 || in_sizes[0] != T * D || out_size != T * D || ws_size < WS_END) { fprintf(stderr, "kernel_launch: unexpected shapes n_in %d in0 %d out %d ws %zu\n", n_in, n_in > 0 ? in_sizes[0] : -1, out_size, ws_size); grid = -1; return; }
        int dev = 0, cus = 0;
        if (hipGetDevice(&dev) != hipSuccess || hipDeviceGetAttribute(&cus, hipDeviceAttributeMultiprocessorCount, dev) != hipSuccess) { grid = -1; return; }
        if (hipFuncSetAttribute((const void*)mk_fwd, hipFuncAttributeMaxDynamicSharedMemorySize, LDS_BYTES) != hipSuccess) { fprintf(stderr, "kernel_launch: hipFuncSetAttribute failed\n"); grid = -1; return; }
        (void)hipGetLastError();
        grid = cus;
    }
    if (grid < 0) return;
    if (hipMemsetAsync((char*)d_ws + WS_CTL, 0, CTL_ZERO_BYTES, stream) != hipSuccess) return;
    Args a{};
    for (int i = 0; i < 20; ++i) a.in[i] = (const float*)d_in[i];
    a.out = (float*)d_out; a.ws = (unsigned char*)d_ws;
#if MK_MULTI
    for (int p = 0; p < NPHASE; ++p) { a.ph_lo = p; a.ph_hi = p + 1; hipLaunchKernelGGL(mk_fwd, dim3(grid), dim3(NTHR), LDS_BYTES, stream, a); }
#else
    a.ph_lo = 0; a.ph_hi = NPHASE;
    hipLaunchKernelGGL(mk_fwd, dim3(grid), dim3(NTHR), LDS_BYTES, stream, a);
#endif
}
```

```cpp
#include <hip/hip_runtime.h>
#include <hip/hip_bf16.h>
#include <cstdio>
#include <cstdint>

#define GAS __attribute__((address_space(1)))
#define LAS __attribute__((address_space(3)))
typedef unsigned short bf16;
typedef unsigned v4u __attribute__((ext_vector_type(4)));
typedef unsigned v2u __attribute__((ext_vector_type(2)));
typedef float f32x4 __attribute__((ext_vector_type(4)));
typedef float f32x2 __attribute__((ext_vector_type(2)));
typedef float f32x16 __attribute__((ext_vector_type(16)));
typedef short bf16x8 __attribute__((ext_vector_type(8)));
typedef short s16x4 __attribute__((ext_vector_type(4)));
typedef __bf16 bf16x2_t __attribute__((ext_vector_type(2)));
typedef GAS unsigned gu32;
#define RLX_AGENT __ATOMIC_RELAXED, __HIP_MEMORY_SCOPE_AGENT
#define LDS_WAIT() asm volatile("s_waitcnt lgkmcnt(0)" ::: "memory")
#define VM_WAIT() asm volatile("s_waitcnt vmcnt(0)" ::: "memory")

constexpr int NWAVES = 8, NTHR = NWAVES * 64;
constexpr int BATCH = 2, SEQ = 8192, D = 1024, T = BATCH * SEQ;
constexpr float EPS = 1e-6f;
constexpr int NIN = 4864, NIN_SRC = 4840;
constexpr int C_CQ = 0, C_CKV = 384, C_QB = 640, C_KB = 1152, C_VB = 1664, C_QI = 2176, C_KR = 2688, C_KI = 2720, C_WI = 2784, C_GA = 2816, C_GB = 3840;
constexpr int NEXP = 32, FF = 256;
constexpr int SORT_ROWS = 2 * T + NEXP * 256;
constexpr float LOG2E = 1.4426950408889634f;
constexpr float C2A = 0.10206207261596575f * LOG2E;
constexpr float C2B = 0.125f * LOG2E;
constexpr float WI_SCALE = 0.35355339059327373f * 0.125f;

constexpr size_t MiB = 1u << 20, KiB = 1u << 10;
constexpr size_t WS_CTL = 0, CTL_ZERO_BYTES = 1 * MiB;
constexpr size_t WS_ROPE = 1 * MiB;
constexpr size_t WS_WI = 2 * MiB;
constexpr size_t WS_TOKE = 2 * MiB + 512 * KiB;
constexpr size_t WS_TOKW = WS_TOKE + 128 * KiB;
constexpr size_t WS_RSTD2 = WS_TOKW + 128 * KiB;
constexpr size_t WS_SSLOT = 3 * MiB + 512 * KiB;
constexpr size_t WS_SW = WS_SSLOT + 192 * KiB;
constexpr size_t WS_T2E = WS_SW + 192 * KiB;
constexpr size_t WS_WIN = 4 * MiB, WS_WUQ = 14 * MiB, WS_WUKV = 15 * MiB, WS_WOA = 16 * MiB, WS_WOB = 17 * MiB, WS_WOUT = 18 * MiB, WS_WGU = 20 * MiB, WS_WD = 52 * MiB;
constexpr size_t WS_H = 68 * MiB, WS_OA = 68 * MiB, WS_OB = 84 * MiB;
constexpr size_t WS_QA = 100 * MiB, WS_KN = 124 * MiB, WS_VA = 140 * MiB, WS_Y = 100 * MiB;
constexpr size_t WS_QB = 156 * MiB, WS_KB = 172 * MiB, WS_VB = 188 * MiB;
constexpr size_t WS_CQ = 204 * MiB, WS_CKV = 216 * MiB, WS_BM = 204 * MiB;
constexpr size_t WS_QI = 224 * MiB, WS_KI = 240 * MiB, WS_KR = 242 * MiB;
constexpr size_t WS_ASORT = 68 * MiB, WS_SLOTS = 156 * MiB, WS_HID = 220 * MiB;
constexpr size_t WS_PART = 244 * MiB;
constexpr size_t WS_END = 256 * MiB;
constexpr int CW_BAR = 4096;
constexpr int CW_Q1 = 64, CW_Q2 = 128;
constexpr int CW_CNT = 256, CW_FILL = 320;
constexpr int CW_Q3 = 192, CW_HRDY = 16384;
constexpr int CW_RDY = 8192;

constexpr int LDS_BYTES = 147456;
constexpr int MISC_OFF = 147456 - 512;

__device__ __forceinline__ unsigned f2bf(float f) { unsigned u = __builtin_bit_cast(unsigned, f); return (u + 0x7fffu + ((u >> 16) & 1u)) >> 16; }
__device__ __forceinline__ unsigned pk2(float lo, float hi) { f32x2 v = {lo, hi}; bf16x2_t b = __builtin_convertvector(v, bf16x2_t); return __builtin_bit_cast(unsigned, b); }
__device__ __forceinline__ float bflo(unsigned w) { return __builtin_bit_cast(float, w << 16); }
__device__ __forceinline__ float bfhi(unsigned w) { return __builtin_bit_cast(float, w & 0xffff0000u); }

#define XB_TMO      128
#define XB_XCNT(j)  (256  + 64 * (j))
#define XB_XSUB(j)  (1280 + 64 * (j))
#define XB_XGEN(j)  (2304 + 64 * (j))
#define XB_TOP      3328
#define XB_TOPGEN   3392
#define XCD_BAR_WORDS 3456
#define XB_SPIN_CAP (1u << 22)
__device__ __forceinline__ unsigned xb_ld(unsigned* p)              { return __hip_atomic_load(p, __ATOMIC_RELAXED, __HIP_MEMORY_SCOPE_AGENT); }
__device__ __forceinline__ unsigned xb_add(unsigned* p, unsigned v) { return __hip_atomic_fetch_add(p, v, __ATOMIC_RELAXED, __HIP_MEMORY_SCOPE_AGENT); }
__device__ __forceinline__ unsigned xb_xcc_id() { return (unsigned)__builtin_amdgcn_s_getreg((3 << 11) | 20) & 0xFu; }
#define XB_SPIN(cond, bar) do { unsigned _sp = 0; while (cond) { __builtin_amdgcn_s_sleep(1); \
    if ((++_sp & 255u) == 0u) { if (xb_ld(&(bar)[XB_TMO])) break; if (_sp > XB_SPIN_CAP) { atomicAdd(&(bar)[XB_TMO], 1u); break; } } } } while (0)
struct XcdBarrier { unsigned* bar; unsigned x; volatile LAS unsigned* st; };
__device__ __forceinline__ XcdBarrier xcd_barrier_post(unsigned* bar, volatile LAS unsigned* st) {
    XcdBarrier b; b.bar = bar; b.x = xb_xcc_id(); b.st = st;
    if (threadIdx.x == 0) (void)xb_add(&bar[XB_XCNT(b.x)], 1u);
    return b;
}
__device__ __forceinline__ void xcd_barrier_complete(unsigned* bar, unsigned x, unsigned& nloc, unsigned& nx) {
    const unsigned G = gridDim.x * gridDim.y * gridDim.z;
    unsigned sum, cnt, mine, sp = 0u;
    for (;;) {
        sum = 0u; cnt = 0u; mine = 0u;
#pragma unroll
        for (unsigned j = 0; j < 16; ++j) { const unsigned c = xb_ld(&bar[XB_XCNT(j)]); sum += c; cnt += (c > 0u) ? 1u : 0u; mine = (j == x) ? c : mine; }
        if (sum == G) break;
        __builtin_amdgcn_s_sleep(1);
        if ((++sp & 255u) == 0u) { if (xb_ld(&bar[XB_TMO])) break; if (sp > XB_SPIN_CAP) { atomicAdd(&bar[XB_TMO], 1u); break; } }
    }
    nloc = mine > 0u ? mine : 1u; nx = cnt > 0u ? cnt : 1u;
}
__device__ __forceinline__ void xcd_barrier(const XcdBarrier& b) {
    asm volatile("s_waitcnt vmcnt(0)" ::: "memory");
    __syncthreads();
    if (threadIdx.x == 0) {
        unsigned* bar = b.bar;
        __builtin_amdgcn_s_waitcnt(0);
        unsigned nloc = b.st[0], nx = b.st[1];
        if (nloc == 0u) { xcd_barrier_complete(bar, b.x, nloc, nx); b.st[0] = nloc; b.st[1] = nx; }
        const unsigned old = xb_add(&bar[XB_XSUB(b.x)], 1u);
        const unsigned gen = old / nloc;
        if (old + 1u == (gen + 1u) * nloc) {
            __builtin_amdgcn_fence(__ATOMIC_RELEASE, "agent");
            asm volatile("s_waitcnt vmcnt(0)" ::: "memory");
            const unsigned og = xb_add(&bar[XB_TOP], 1u);
            const unsigned tg = og / nx;
            if (og + 1u == (tg + 1u) * nx) xb_add(&bar[XB_TOPGEN], 1u);
            else XB_SPIN(xb_ld(&bar[XB_TOPGEN]) == tg, bar);
            __builtin_amdgcn_fence(__ATOMIC_ACQUIRE, "agent");
            xb_add(&bar[XB_XGEN(b.x)], 1u);
            asm volatile("s_waitcnt vmcnt(0)" ::: "memory");
        } else {
            XB_SPIN(xb_ld(&bar[XB_XGEN(b.x)]) == gen, bar);
            __builtin_amdgcn_fence(__ATOMIC_ACQUIRE, "agent");
            asm volatile("s_waitcnt vmcnt(0)" ::: "memory");
        }
    }
    __syncthreads();
}

__device__ __forceinline__ float wave_sum(float v) {
#pragma unroll
    for (int o = 1; o < 64; o <<= 1) v += __shfl_xor(v, o);
    return v;
}

namespace pg8 {
#define PG8_LAS __attribute__((address_space(3)))
typedef unsigned short bf16_t;
typedef unsigned u32x4 __attribute__((ext_vector_type(4)));
constexpr int BM = 256, BK = 64, HALF = 128, HTB = HALF * BK * 2, STAGE_BYTES = 8 * HTB, NXCD = 8, WGM = 8;
__host__ __device__ __forceinline__ int lds_byte(int r, int c) { const int st = (r >> 4) * 2 + (c >> 5), rr = r & 15, cc = c & 31, ob = rr * 64 + cc * 2; return st * 1024 + (ob ^ (((ob >> 9) & 1) << 5)); }
__host__ __device__ __forceinline__ void stage_rc(int b, int& R, int& C) { const int st = b / 1024, sb = b % 1024, swz = sb ^ (((sb >> 9) & 1) << 5); R = (st >> 1) * 16 + swz / 64; C = (st & 1) * 32 + (swz % 64) / 2; }
__host__ __device__ __forceinline__ int perm32(int rho) { const int n = rho >> 4, i = rho & 15; return 8 * (i >> 2) + 4 * n + (i & 3); }

struct Unit { int pm, pn, e; };
struct Gemm { const bf16_t* A; const bf16_t* Bt; int M, N, K; size_t estride; };

struct StaticOrder {
    int nM, nN, nwg, G, c;
    __host__ __device__ void init(int M, int N, int G_, int c_) { nM = M / BM; nN = N / BM; nwg = nM * nN; G = G_; c = c_; }
    __host__ __device__ __forceinline__ bool next(int i, Unit& u) const {
        const long L = (long)i * G + c; if (L >= nwg) return false;
        int wgid = (int)L; { const int q = nwg / NXCD, r = nwg % NXCD, xcd = wgid % NXCD, off = wgid / NXCD; wgid = (xcd < r ? xcd * (q + 1) : r * (q + 1) + (xcd - r) * q) + off; }
        const int nig = WGM * nN, gid = wgid / nig, fm = gid * WGM, gsz = (nM - fm) < WGM ? (nM - fm) : WGM;
        u.pm = fm + ((wgid % nig) % gsz); u.pn = (wgid % nig) / gsz; u.e = 0; return true;
    }
    __device__ __forceinline__ void a_ready(const Unit&) const {}
    __device__ __forceinline__ void done(const Unit&) const {}
};
struct OneUnit {
    int pm, pn, e;
    __device__ __forceinline__ bool next(int i, Unit& u) const { if (i != 0) return false; u.pm = pm; u.pn = pn; u.e = e; return true; }
    __device__ __forceinline__ void a_ready(const Unit&) const {}
    __device__ __forceinline__ void done(const Unit&) const {}
};
struct GroupOrder {
    int nN, total, G, c; const int* t2e;
    __device__ void init(int nTiles, int nN_, int G_, int c_, const int* t2e_) { nN = nN_; total = nTiles * nN_; G = G_; c = c_; t2e = t2e_; }
    __device__ bool next(int i, Unit& u) const {
        const long L = (long)i * G + c; if (L >= total) return false;
        u.pm = (int)(L / nN); u.pn = (int)(L % nN); u.e = __builtin_amdgcn_readfirstlane(t2e[u.pm]); return true;
    }
    __device__ __forceinline__ void a_ready(const Unit&) const {}
    __device__ __forceinline__ void done(const Unit&) const {}
};

__device__ __forceinline__ void st8(bf16_t* p, f32x4 v0, f32x4 v1) { u32x4 w; w.x = pk2(v0[0], v0[1]); w.y = pk2(v0[2], v0[3]); w.z = pk2(v1[0], v1[1]); w.w = pk2(v1[2], v1[3]); *(u32x4*)p = w; }
__device__ __forceinline__ void ld8(const bf16_t* p, f32x4& v0, f32x4& v1) { const u32x4 w = *(const u32x4*)p; v0 = (f32x4){bflo(w.x), bfhi(w.x), bflo(w.y), bfhi(w.y)}; v1 = (f32x4){bflo(w.z), bfhi(w.z), bflo(w.w), bfhi(w.w)}; }

__device__ __forceinline__ void rope16(f32x4& v0, f32x4& v1, int row, int fq, const f32x2* rope) {
    const f32x2* rp = rope + (size_t)(row & (SEQ - 1)) * 16;
    f32x4 p0, p1;
#pragma unroll
    for (int e = 0; e < 4; ++e) { p0[e] = __shfl_xor(v0[e], 16); p1[e] = __shfl_xor(v1[e], 16); }
    if (fq < 2) {
        const float sg = fq == 0 ? -1.f : 1.f;
#pragma unroll
        for (int e = 0; e < 4; ++e) { const f32x2 a = rp[2 * e], b = rp[2 * (4 + e)];
            v0[e] = v0[e] * a.x + sg * p0[e] * a.y; v1[e] = v1[e] * b.x + sg * p1[e] * b.y; }
    }
}
__device__ __forceinline__ void rope32(f32x4& v0, f32x4& v1, int row, int fq, const f32x2* rope) {
    const f32x2* rp = rope + (size_t)(row & (SEQ - 1)) * 16 + 8 * (fq & 1);
    const float sg = fq < 2 ? -1.f : 1.f;
#pragma unroll
    for (int e = 0; e < 4; ++e) { const float p0 = __shfl_xor(v0[e], 32), p1 = __shfl_xor(v1[e], 32); const f32x2 a = rp[e], b = rp[4 + e];
        v0[e] = v0[e] * a.x + sg * p0 * a.y; v1[e] = v1[e] * b.x + sg * p1 * b.y; }
}
__device__ __forceinline__ float sigmoidf_(float x) { return __builtin_amdgcn_rcpf(1.f + __builtin_amdgcn_exp2f(-1.4426950408889634f * x)); }

struct EpiIn {
    static constexpr bool PERM = true, AFTER_DRAIN = false;
    bf16_t *CQ, *CKV, *QB, *KB, *VB, *QI, *KI, *KR, *GA, *GB; float* WI; const f32x2* rope; float* PART;
    __device__ __forceinline__ void operator()(const f32x4 (&acc)[2][2][4][2], const Unit& u, int wr, int wc, int fr, int fq) const {
        const int row0 = u.pm * BM + wr * 64 + fr;
#pragma unroll
        for (int bj = 0; bj < 2; ++bj) {
            const int cg = u.pn * BM + bj * HALF + wc * 32;
            bf16_t* base = nullptr; int pitch = 0, cc = 0, mode = 0; float sc = 1.f;
            if (cg < C_CKV) { base = CQ; pitch = 384; cc = cg; }
            else if (cg < C_QB) { base = CKV; pitch = 256; cc = cg - C_CKV; }
            else if (cg < C_KB) { base = QB; pitch = 512; cc = cg - C_QB; mode = ((cc >> 5) & 1) == 0 ? 1 : 0; sc = C2B; }
            else if (cg < C_VB) { base = KB; pitch = 512; cc = cg - C_KB; mode = ((cc >> 5) & 1) == 0 ? 1 : 0; }
            else if (cg < C_QI) { base = VB; pitch = 512; cc = cg - C_VB; }
            else if (cg < C_KR) { base = QI; pitch = 512; cc = cg - C_QI; mode = ((cc >> 5) & 1) == 0 ? 1 : 0; }
            else if (cg < C_KI) { base = KR; pitch = 32; cc = 0; mode = 2; }
            else if (cg < C_WI) { base = KI; pitch = 64; cc = cg - C_KI; mode = (cc == 0) ? 1 : 0; }
            else if (cg < C_GA) { mode = 4; }
            else if (cg < C_GB) { base = GA; pitch = 1024; cc = cg - C_GA; mode = 3; }
            else { base = GB; pitch = 1024; cc = cg - C_GB; mode = 3; }
#pragma unroll
            for (int ai = 0; ai < 2; ++ai)
#pragma unroll
                for (int m = 0; m < 4; ++m) {
                    const int row = row0 + ai * HALF + m * 16;
                    f32x4 v0 = acc[ai][bj][m][0], v1 = acc[ai][bj][m][1];
                    if (mode == 1) rope16(v0, v1, row, fq, rope);
                    else if (mode == 2) rope32(v0, v1, row, fq, rope);
                    else if (mode == 3) {
#pragma unroll
                        for (int e = 0; e < 4; ++e) { v0[e] = sigmoidf_(v0[e]); v1[e] = sigmoidf_(v1[e]); } }
                    if (cg < C_QB) {
                        float ss = ((v0[0] * v0[0] + v0[1] * v0[1]) + (v0[2] * v0[2] + v0[3] * v0[3])) + ((v1[0] * v1[0] + v1[1] * v1[1]) + (v1[2] * v1[2] + v1[3] * v1[3]));
                        ss += __shfl_xor(ss, 16); ss += __shfl_xor(ss, 32);
                        if (fq == 0) PART[(size_t)row * 20 + (cg >> 5)] = ss; }
                    if (mode == 4) { if (fq == 0) { *(f32x4*)(WI + (size_t)row * 8) = v0 * WI_SCALE; *(f32x4*)(WI + (size_t)row * 8 + 4) = v1 * WI_SCALE; } }
                    else { v0 = v0 * sc; v1 = v1 * sc; st8(base + (size_t)row * pitch + cc + 8 * fq, v0, v1); }
                }
        }
    }
};
struct EpiQA {
    static constexpr bool PERM = true, AFTER_DRAIN = false;
    bf16_t* QA; const f32x2* rope; const PG8_LAS float* RS;
    __device__ __forceinline__ void operator()(const f32x4 (&acc)[2][2][4][2], const Unit& u, int wr, int wc, int fr, int fq) const {
        const int row0 = u.pm * BM + wr * 64 + fr; const PG8_LAS float* rsp = RS + wr * 64 + fr;
#pragma unroll
        for (int bj = 0; bj < 2; ++bj) {
            const int cg = u.pn * BM + bj * HALF + wc * 32; const bool rot = ((cg >> 5) % 3) == 2;
#pragma unroll
            for (int ai = 0; ai < 2; ++ai)
#pragma unroll
                for (int m = 0; m < 4; ++m) {
                    const int row = row0 + ai * HALF + m * 16;
                    f32x4 v0 = acc[ai][bj][m][0], v1 = acc[ai][bj][m][1];
                    if (rot) rope32(v0, v1, row, fq, rope);
                    { const float rsv = rsp[ai * HALF + m * 16]; v0 = v0 * rsv; v1 = v1 * rsv; } st8(QA + (size_t)row * 768 + cg + 8 * fq, v0, v1);
                }
        }
    }
};
struct EpiKV {
    static constexpr bool PERM = true, AFTER_DRAIN = false;
    bf16_t *KN, *VA; const PG8_LAS float* RS;
    __device__ __forceinline__ void operator()(const f32x4 (&acc)[2][2][4][2], const Unit& u, int wr, int wc, int fr, int fq) const {
        const int row0 = u.pm * BM + wr * 64 + fr; const PG8_LAS float* rsp = RS + wr * 64 + fr;
#pragma unroll
        for (int bj = 0; bj < 2; ++bj) {
            const int cg = u.pn * BM + bj * HALF + wc * 32; bf16_t* base = cg < 512 ? KN : VA; const int cc = (cg & 511) + 8 * fq;
#pragma unroll
            for (int ai = 0; ai < 2; ++ai)
#pragma unroll
                for (int m = 0; m < 4; ++m) { const int row = row0 + ai * HALF + m * 16; const float rsv = rsp[ai * HALF + m * 16]; st8(base + (size_t)row * 512 + cc, acc[ai][bj][m][0] * rsv, acc[ai][bj][m][1] * rsv); }
        }
    }
};
template <int ADD> struct EpiY {
    static constexpr bool PERM = true, AFTER_DRAIN = false;
    bf16_t* Y; const bf16_t* Gt;
    __device__ __forceinline__ void operator()(const f32x4 (&acc)[2][2][4][2], const Unit& u, int wr, int wc, int fr, int fq) const {
        const int row0 = u.pm * BM + wr * 64 + fr;
#pragma unroll
        for (int bj = 0; bj < 2; ++bj) {
            const int c0 = u.pn * BM + bj * HALF + wc * 32 + 8 * fq;
#pragma unroll
            for (int ai = 0; ai < 2; ++ai)
#pragma unroll
                for (int m = 0; m < 4; ++m) { const size_t off = (size_t)(row0 + ai * HALF + m * 16) * 1024 + c0;
                    f32x4 g0, g1; ld8(Gt + off, g0, g1);
                    f32x4 v0 = acc[ai][bj][m][0] * g0, v1 = acc[ai][bj][m][1] * g1;
                    if (ADD) { f32x4 o0, o1; ld8(Y + off, o0, o1); v0 = v0 + o0; v1 = v1 + o1; }
                    st8(Y + off, v0, v1); }
        }
    }
};
struct EpiX1 {
    static constexpr bool PERM = false, AFTER_DRAIN = false;
    const float* X; float* O;
    __device__ __forceinline__ void operator()(const f32x4 (&acc)[2][2][4][2], const Unit& u, int wr, int wc, int fr, int fq) const {
        const int row0 = u.pm * BM + wr * 64 + fr, col0 = u.pn * BM + wc * 32 + 4 * fq;
#pragma unroll
        for (int ai = 0; ai < 2; ++ai)
#pragma unroll
            for (int m = 0; m < 4; ++m) { const size_t off = (size_t)(row0 + ai * HALF + m * 16) * 1024 + col0;
#pragma unroll
                for (int bj = 0; bj < 2; ++bj)
#pragma unroll
                    for (int n = 0; n < 2; ++n) { const f32x4 xv = *(const f32x4*)(X + off + bj * HALF + n * 16); *(f32x4*)(O + off + bj * HALF + n * 16) = xv + acc[ai][bj][m][n]; } }
    }
};
struct EpiHid {
    static constexpr bool PERM = true, AFTER_DRAIN = false;
    bf16_t* HID;
    __device__ __forceinline__ void operator()(const f32x4 (&acc)[2][2][4][2], const Unit& u, int wr, int wc, int fr, int fq) const {
        const int row0 = u.pm * BM + wr * 64 + fr, c0 = u.pn * 128 + wc * 32 + 8 * fq;
#pragma unroll
        for (int ai = 0; ai < 2; ++ai)
#pragma unroll
            for (int m = 0; m < 4; ++m) { f32x4 h0, h1;
#pragma unroll
                for (int e = 0; e < 4; ++e) { const float g0 = acc[ai][0][m][0][e], g1 = acc[ai][0][m][1][e];
                    h0[e] = g0 * sigmoidf_(g0) * acc[ai][1][m][0][e]; h1[e] = g1 * sigmoidf_(g1) * acc[ai][1][m][1][e]; }
                st8(HID + (size_t)(row0 + ai * HALF + m * 16) * 256 + c0, h0, h1); }
    }
};
struct EpiDown {
    static constexpr bool PERM = true, AFTER_DRAIN = false;
    bf16_t* SL; const int* sslot; const float* sw;
    __device__ __forceinline__ void operator()(const f32x4 (&acc)[2][2][4][2], const Unit& u, int wr, int wc, int fr, int fq) const {
        const int row0 = u.pm * BM + wr * 64 + fr;
#pragma unroll
        for (int ai = 0; ai < 2; ++ai)
#pragma unroll
            for (int m = 0; m < 4; ++m) { const int r = row0 + ai * HALF + m * 16; const int slot = sslot[r]; const float w = sw[r];
                if (slot >= 0) {
#pragma unroll
                    for (int bj = 0; bj < 2; ++bj) st8(SL + (size_t)slot * 1024 + u.pn * BM + bj * HALF + wc * 32 + 8 * fq, acc[ai][bj][m][0] * w, acc[ai][bj][m][1] * w); } }
    }
};
template <class Epi, class Sched, bool ALIGN_EPI = false, bool SP2 = false>
__device__ __forceinline__ void gemm_phase(PG8_LAS unsigned char* lds, const Gemm g, const Sched& S, const Epi& E) {
    const int tid = threadIdx.x, wid = __builtin_amdgcn_readfirstlane(tid >> 6), lane = tid & 63, wr = wid >> 2, wc = wid & 3, fr = lane & 15, fq = lane >> 4;
    const int K = g.K, nt = K / BK;
    unsigned voffA[2], voffB[2];
#pragma unroll
    for (int i = 0; i < 2; ++i) { int R, C; stage_rc(tid * 16 + i * 8192, R, C); const int Rb = Epi::PERM ? ((R & ~31) + perm32(R & 31)) : R;
        voffA[i] = (unsigned)(R * K + C) * 2u; voffB[i] = (unsigned)(Rb * K + C) * 2u; }
    const size_t kstep = (size_t)(BK * 2);
    const size_t hstep = (size_t)HALF * K * 2;
    const size_t tstep = 2 * hstep;
    const unsigned ldsw = (unsigned)wid * 1024u;
    const int aoff = lds_byte(wr * 64 + fr, fq * 8), boff = lds_byte(wc * 32 + fr, fq * 8);
#define PG8_SA(b, h) (((b) * 2 + (h)) * HTB)
#define PG8_SB(b, h) ((4 + (b) * 2 + (h)) * HTB)
#define PG8_STAGE(bufoff, gbase, voff) do { _Pragma("unroll") for (int _i = 0; _i < 2; ++_i) \
        __builtin_amdgcn_global_load_lds((const unsigned*)((const char*)(gbase) + (voff)[_i]), (PG8_LAS unsigned*)(lds + (bufoff) + ldsw + _i * 8192), 16, 0, 0); } while (0)
#define PG8_LDA(dst, b, h) do { _Pragma("unroll") for (int m = 0; m < 4; ++m) _Pragma("unroll") for (int k = 0; k < 2; ++k) dst[m][k] = *(const PG8_LAS bf16x8*)(lds + PG8_SA(b, h) + aoff + m * 2048 + k * 1024); } while (0)
#define PG8_LDB(dst, b, h) do { _Pragma("unroll") for (int n = 0; n < 2; ++n) _Pragma("unroll") for (int k = 0; k < 2; ++k) dst[n][k] = *(const PG8_LAS bf16x8*)(lds + PG8_SB(b, h) + boff + n * 2048 + k * 1024); } while (0)
#define PG8_MMA(ai, bj, At, Bt) do { __builtin_amdgcn_s_setprio(1); _Pragma("unroll") for (int m = 0; m < 4; ++m) _Pragma("unroll") for (int n = 0; n < 2; ++n) _Pragma("unroll") for (int k = 0; k < 2; ++k) \
        acc[ai][bj][m][n] = __builtin_amdgcn_mfma_f32_16x16x32_bf16(Bt[n][k], At[m][k], acc[ai][bj][m][n], 0, 0, 0); __builtin_amdgcn_s_setprio(0); } while (0)
#define PG8_WAIT_V(n) asm volatile("s_waitcnt vmcnt(" #n ")" ::: "memory")
#define PG8_WAIT_L(n) asm volatile("s_waitcnt lgkmcnt(" #n ")" ::: "memory")
#define PG8_BAR __builtin_amdgcn_s_barrier()
#define PG8_SCHED __builtin_amdgcn_sched_barrier(0)
    Unit cur, nxt; int ui = 0;
    if (!S.next(0, cur)) return;
    f32x4 acc[2][2][4][2];
#pragma unroll
    for (int a = 0; a < 2; ++a)
#pragma unroll
        for (int b = 0; b < 2; ++b)
#pragma unroll
            for (int m = 0; m < 4; ++m)
#pragma unroll
                for (int n = 0; n < 2; ++n) acc[a][b][m][n] = (f32x4){0.f, 0.f, 0.f, 0.f};
    bf16x8 At[4][2], B0[2][2], B1[2][2];
    const char* cA = (const char*)g.A + (size_t)cur.pm * tstep; const char* cB = (const char*)g.Bt + (size_t)cur.e * g.estride + (size_t)cur.pn * tstep;
    S.a_ready(cur);
    if constexpr (SP2) {
        PG8_STAGE(PG8_SB(0, 0), cB, voffB); PG8_STAGE(PG8_SB(0, 1), cB + hstep, voffB); PG8_STAGE(PG8_SA(0, 0), cA, voffA); PG8_STAGE(PG8_SA(0, 1), cA + hstep, voffA);
        if (wr == 1) PG8_BAR;
        PG8_WAIT_V(2); PG8_BAR;
        PG8_STAGE(PG8_SB(1, 0), cB + kstep, voffB); PG8_STAGE(PG8_SA(1, 0), cA + kstep, voffA); PG8_STAGE(PG8_SB(1, 1), cB + hstep + kstep, voffB);
        PG8_WAIT_V(6); PG8_BAR;
    } else {
        PG8_STAGE(PG8_SB(0, 0), cB, voffB); PG8_STAGE(PG8_SA(0, 0), cA, voffA); PG8_STAGE(PG8_SB(0, 1), cB + hstep, voffB); PG8_STAGE(PG8_SA(0, 1), cA + hstep, voffA);
        if (wr == 1) PG8_BAR;
        PG8_WAIT_V(4); PG8_BAR;
        PG8_STAGE(PG8_SB(1, 0), cB + kstep, voffB); PG8_STAGE(PG8_SA(1, 0), cA + kstep, voffA); PG8_STAGE(PG8_SB(1, 1), cB + hstep + kstep, voffB);
        PG8_WAIT_V(6); PG8_BAR;
    }
    for (;;) {
        const bool has_next = S.next(ui + 1, nxt);
        const char* nA = has_next ? (const char*)g.A + (size_t)nxt.pm * tstep : cA; const char* nB = has_next ? (const char*)g.Bt + (size_t)nxt.e * g.estride + (size_t)nxt.pn * tstep : cB;
#pragma nounroll
        for (int t = 0; t < nt; t += 2) {
            const bool last = (t == nt - 2);
            const char* a1 = cA + (size_t)(t + 1) * kstep;
            const char* a2 = last ? nA : cA + (size_t)(t + 2) * kstep; const char* b2 = last ? nB : cB + (size_t)(t + 2) * kstep;
            const char* a3 = a2 + kstep; const char* b3 = b2 + kstep;
            if (last && has_next) S.a_ready(nxt);
            if constexpr (SP2) {
            PG8_LDB(B0, 0, 0); PG8_LDB(B1, 0, 1); PG8_SCHED; PG8_LDA(At, 0, 0); PG8_STAGE(PG8_SA(1, 1), a1 + hstep, voffA);
            PG8_WAIT_V(8); PG8_WAIT_L(0); PG8_BAR; PG8_MMA(0, 0, At, B0); PG8_MMA(0, 1, At, B1); PG8_BAR; PG8_SCHED;
            PG8_LDA(At, 0, 1); PG8_STAGE(PG8_SB(0, 0), b2, voffB); PG8_STAGE(PG8_SB(0, 1), b2 + hstep, voffB); PG8_STAGE(PG8_SA(0, 0), a2, voffA);
            PG8_WAIT_V(8); PG8_WAIT_L(0); PG8_BAR; PG8_MMA(1, 0, At, B0); PG8_MMA(1, 1, At, B1); PG8_BAR; PG8_SCHED;
            PG8_LDB(B0, 1, 0); PG8_LDB(B1, 1, 1); PG8_SCHED; PG8_LDA(At, 1, 0); PG8_STAGE(PG8_SA(0, 1), a2 + hstep, voffA);
            PG8_WAIT_V(8); PG8_WAIT_L(0); PG8_BAR; PG8_MMA(0, 0, At, B0); PG8_MMA(0, 1, At, B1); PG8_BAR; PG8_SCHED;
            PG8_LDA(At, 1, 1); PG8_STAGE(PG8_SB(1, 0), b3, voffB); PG8_STAGE(PG8_SB(1, 1), b3 + hstep, voffB); PG8_STAGE(PG8_SA(1, 0), a3, voffA);
            PG8_WAIT_V(8); PG8_WAIT_L(0); PG8_BAR; PG8_MMA(1, 0, At, B0); PG8_MMA(1, 1, At, B1); PG8_BAR; PG8_SCHED;
            } else {
            PG8_LDB(B0, 0, 0); PG8_SCHED; PG8_LDA(At, 0, 0); PG8_STAGE(PG8_SA(1, 1), a1 + hstep, voffA);
            PG8_WAIT_L(8); PG8_BAR; PG8_WAIT_L(0); PG8_MMA(0, 0, At, B0); PG8_BAR; PG8_SCHED;
            PG8_LDB(B1, 0, 1); PG8_STAGE(PG8_SB(0, 0), b2, voffB);
            PG8_BAR; PG8_WAIT_L(0); PG8_MMA(0, 1, At, B1); PG8_BAR;
            PG8_LDA(At, 0, 1); PG8_STAGE(PG8_SA(0, 0), a2, voffA);
            PG8_BAR; PG8_WAIT_L(0); PG8_MMA(1, 0, At, B0); PG8_BAR; PG8_SCHED;
            PG8_STAGE(PG8_SB(0, 1), b2 + hstep, voffB);
            PG8_WAIT_V(6); PG8_BAR; PG8_MMA(1, 1, At, B1); PG8_BAR;
            PG8_LDB(B0, 1, 0); PG8_SCHED; PG8_LDA(At, 1, 0); PG8_STAGE(PG8_SA(0, 1), a2 + hstep, voffA);
            PG8_WAIT_L(8); PG8_BAR; PG8_WAIT_L(0); PG8_MMA(0, 0, At, B0); PG8_BAR; PG8_SCHED;
            PG8_LDB(B1, 1, 1); PG8_STAGE(PG8_SB(1, 0), b3, voffB);
            PG8_BAR; PG8_WAIT_L(0); PG8_MMA(0, 1, At, B1); PG8_BAR;
            PG8_LDA(At, 1, 1); PG8_STAGE(PG8_SA(1, 0), a3, voffA);
            PG8_BAR; PG8_WAIT_L(0); PG8_MMA(1, 0, At, B0); PG8_BAR; PG8_SCHED;
            PG8_STAGE(PG8_SB(1, 1), b3 + hstep, voffB);
            PG8_WAIT_V(6); PG8_BAR; PG8_MMA(1, 1, At, B1); PG8_BAR;
            }
        }
        if constexpr (ALIGN_EPI) { if (wr == 0) PG8_BAR; }
        if constexpr (!Epi::AFTER_DRAIN) { E(acc, cur, wr, wc, fr, fq); S.done(cur); }
        if (!has_next) break;
#pragma unroll
        for (int a = 0; a < 2; ++a)
#pragma unroll
            for (int b = 0; b < 2; ++b)
#pragma unroll
                for (int m = 0; m < 4; ++m)
#pragma unroll
                    for (int n = 0; n < 2; ++n) acc[a][b][m][n] = (f32x4){0.f, 0.f, 0.f, 0.f};
        cur = nxt; cA = nA; cB = nB; ++ui;
        if constexpr (ALIGN_EPI) { if (wr == 1) PG8_BAR; }
    }
    PG8_WAIT_V(0);
    if constexpr (!ALIGN_EPI) { if (wr == 0) PG8_BAR; }
    PG8_BAR;
    if constexpr (Epi::AFTER_DRAIN) { E.fused(acc, cur, wr, wc, fr, fq, lds, wid, lane); S.done(cur); }
#undef PG8_SA
#undef PG8_SB
#undef PG8_STAGE
#undef PG8_LDA
#undef PG8_LDB
#undef PG8_MMA
#undef PG8_WAIT_V
#undef PG8_WAIT_L
#undef PG8_BAR
#undef PG8_SCHED
}
}

struct Args { const float* in[20]; float* out; unsigned char* ws; int ph_lo, ph_hi; };
struct Frame {
    LAS unsigned char* lds; volatile LAS unsigned* MISC; gu32* ctl; unsigned char* ws;
    int vcu, G;
};
#define F_TID ((int)threadIdx.x)
#define F_LANE ((int)(threadIdx.x & 63))
#define F_WAVE (__builtin_amdgcn_readfirstlane((int)(threadIdx.x >> 6)))

__device__ __forceinline__ int in_src_col(int n) {
    if (n < 640) return n;
    if (n < 2688) return n + 32;
    if (n < 2720) return n - 2688 + 640;
    if (n < 2792) return n;
    if (n < 2816) return -1;
    return n - 24;
}
struct TrDesc { const float* colptr; int ld, k0; bf16* WT; int Kd, destrow0; const float* gain; };
__device__ __forceinline__ void tr_load(const TrDesc& d, int lane, f32x4 (&v)[16]) {
    const int kr = lane >> 4;
#pragma unroll
    for (int it = 0; it < 16; ++it) { const int kk = 4 * it + kr; v[it] = (f32x4){0.f, 0.f, 0.f, 0.f}; if (d.colptr) v[it] = *(const GAS f32x4*)(d.colptr + (size_t)(d.k0 + kk) * d.ld); if (d.gain) v[it] = v[it] * d.gain[d.k0 + kk]; }
}
__device__ __forceinline__ void tr_store(const TrDesc& d, int lane, const f32x4 (&v)[16], LAS float* scr) {
    const int nq = lane & 15, kr = lane >> 4;
#pragma unroll
    for (int it = 0; it < 16; ++it) { const int kk = 4 * it + kr; LAS float* q = scr + kk * 65 + 4 * nq; q[0] = v[it].x; q[1] = v[it].y; q[2] = v[it].z; q[3] = v[it].w; }
    LDS_WAIT(); asm volatile("" ::: "memory");
    const int c = lane & 7;
#pragma unroll
    for (int j = 0; j < 8; ++j) { const int n = (lane >> 3) + 8 * j; const LAS float* q = scr + (8 * c) * 65 + n;
        v4u o; o.x = pk2(q[0 * 65], q[1 * 65]); o.y = pk2(q[2 * 65], q[3 * 65]); o.z = pk2(q[4 * 65], q[5 * 65]); o.w = pk2(q[6 * 65], q[7 * 65]);
        *(GAS v4u*)(d.WT + (size_t)(d.destrow0 + n) * d.Kd + d.k0 + 8 * c) = o; }
    LDS_WAIT(); asm volatile("" ::: "memory");
}
constexpr int CV_I0 = 16 * 76, CV_I1 = 6 * 12, CV_I2 = 4 * 16, CV_I3 = 8 * 16, CV_I4 = 8 * 16, CV_I5 = 16 * 16, CV_I6 = 32 * 16 * 8, CV_I7 = 32 * 4 * 16;
constexpr int CV_EARLY = CV_I0 + CV_I1 + CV_I2, CV_LATE = CV_I3 + CV_I4 + CV_I5 + CV_I6 + CV_I7, CV_QITEMS = CV_LATE / 16;
static_assert(CV_LATE % 16 == 0, "late conversion tiles come in queue items of 16");
__device__ __forceinline__ TrDesc conv_desc(const Args& A, unsigned char* ws, int it, int lane) {
    const int n4 = 4 * (lane & 15);
    int r = it;
    if (r < CV_I0) { const int kb = r / 76, nb = r % 76; const int col = in_src_col(64 * nb + n4);
        return TrDesc{col >= 0 ? A.in[2] + col : nullptr, NIN_SRC, 64 * kb, (bf16*)(ws + WS_WIN), 1024, 64 * nb, nullptr}; } r -= CV_I0;
    if (r < CV_I1) { const int kb = r / 12, nb = r % 12; return TrDesc{A.in[4] + 64 * nb + n4, 768, 64 * kb, (bf16*)(ws + WS_WUQ), 384, 64 * nb, A.in[3]}; } r -= CV_I1;
    if (r < CV_I2) { const int kb = r / 16, nb = r % 16; const int n = 64 * nb + n4;
        return TrDesc{n < 512 ? A.in[6] + n : A.in[7] + (n - 512), 512, 64 * kb, (bf16*)(ws + WS_WUKV), 256, 64 * nb, A.in[5]}; } r -= CV_I2;
    if (r < CV_I3) { const int kb = r / 16, nb = r % 16; return TrDesc{A.in[8] + 64 * nb + n4, 1024, 64 * kb, (bf16*)(ws + WS_WOA), 512, 64 * nb, nullptr}; } r -= CV_I3;
    if (r < CV_I4) { const int kb = r / 16, nb = r % 16; return TrDesc{A.in[9] + 64 * nb + n4, 1024, 64 * kb, (bf16*)(ws + WS_WOB), 512, 64 * nb, nullptr}; } r -= CV_I4;
    if (r < CV_I5) { const int kb = r / 16, nb = r % 16; return TrDesc{A.in[10] + 64 * nb + n4, 1024, 64 * kb, (bf16*)(ws + WS_WOUT), 1024, 64 * nb, nullptr}; } r -= CV_I5;
    if (r < CV_I6) { const int e = r / 128, rr = r % 128, kb = rr / 8, nb = rr % 8; const int n = 64 * nb + n4, pn = n >> 8, c = n & 255, col = 128 * pn + (c & 127);
        const float* src = ((c >> 7) ? A.in[17] : A.in[16]) + (size_t)e * 1024 * 256 + col;
        return TrDesc{src, 256, 64 * kb, (bf16*)(ws + WS_WGU) + (size_t)e * 512 * 1024, 1024, 64 * nb, nullptr}; } r -= CV_I6;
    { const int e = r / 64, rr = r % 64, kb = rr / 16, nb = rr % 16;
        return TrDesc{A.in[18] + (size_t)e * 256 * 1024 + 64 * nb + n4, 1024, 64 * kb, (bf16*)(ws + WS_WD) + (size_t)e * 1024 * 256, 256, 64 * nb, nullptr}; }
}
__device__ __forceinline__ void conv_tile(const Args& A, unsigned char* ws, int it, LAS float* scr, int lane) {
    const TrDesc d = conv_desc(A, ws, it, lane); f32x4 v[16]; tr_load(d, lane, v); tr_store(d, lane, v, scr);
}
__device__ __forceinline__ void conv_tile2(const Args& A, unsigned char* ws, int it0, int it1, LAS float* scr, int lane) {
    const TrDesc d0 = conv_desc(A, ws, it0, lane), d1 = conv_desc(A, ws, it1, lane); f32x4 v0[16], v1[16];
    tr_load(d0, lane, v0); tr_load(d1, lane, v1); tr_store(d0, lane, v0, scr); tr_store(d1, lane, v1, scr);
}
__device__ __forceinline__ void p0_prologue(Frame& F, const Args& A) {
    LAS float* scr = (LAS float*)(F.lds + F_WAVE * 16640);
    const int gw = F.vcu * NWAVES + F_WAVE, NGW = F.G * NWAVES, lane = F_LANE;
    unsigned char* ws = F.ws;
#ifdef CONV_IN_P0
    for (int it = gw; it < CV_EARLY + CV_LATE; it += NGW) conv_tile(A, ws, it, scr, lane);
#else
    for (int it = gw; it < CV_EARLY; it += NGW) conv_tile(A, ws, it, scr, lane);
#endif
    const float* x = A.in[0]; const float* g1 = A.in[1]; bf16* H = (bf16*)(ws + WS_H);
    for (int m0 = gw; m0 < T; m0 += 4 * NGW) {
        f32x4 v[4][4];
#pragma unroll
        for (int r = 0; r < 4; ++r) { const int m = min(m0 + r * NGW, T - 1); const GAS f32x4* xr = (const GAS f32x4*)(x + (size_t)m * D) + lane;
#pragma unroll
            for (int j = 0; j < 4; ++j) v[r][j] = xr[64 * j]; }
#pragma unroll
        for (int r = 0; r < 4; ++r) { const int m = m0 + r * NGW; float s = 0.f;
#pragma unroll
            for (int j = 0; j < 4; ++j) s += (v[r][j].x * v[r][j].x + v[r][j].y * v[r][j].y) + (v[r][j].z * v[r][j].z + v[r][j].w * v[r][j].w);
            const float rstd = 1.f / sqrtf(wave_sum(s) * (1.f / D) + EPS);
            if (m < T) { GAS v2u* o8 = (GAS v2u*)(H + (size_t)m * D) + lane;
#pragma unroll
                for (int j = 0; j < 4; ++j) { const f32x4 g = *((const GAS f32x4*)g1 + lane + 64 * j); const f32x4 y = v[r][j] * rstd * g; v2u w; w.x = pk2(y.x, y.y); w.y = pk2(y.z, y.w); o8[64 * j] = w; } } }
    }
    f32x2* rope = (f32x2*)(ws + WS_ROPE);
    for (int idx = (F.vcu * NTHR + F_TID); idx < SEQ * 16; idx += F.G * NTHR) {
        const int pos = idx >> 4, i = idx & 15;
        const double REV[16] = {0.15915494309189535, 0.0700865215877985, 0.03086376340470123, 0.013591370636193905, 0.005985185712713705, 0.002635675898667414, 0.001160663641240061, 0.0005111175045375439,
                                0.00022507907903927653, 9.911730936901935e-05, 4.364795279280289e-05, 1.9221100684944863e-05, 8.464330808241401e-06, 3.727408601915352e-06, 1.6414262627950345e-06, 7.228293068832865e-07};
        double rv = 0.0;
#pragma unroll
        for (int k = 0; k < 16; ++k) rv = (i == k) ? REV[k] : rv;
        double t = (double)pos * rv; t -= __builtin_floor(t);
        const float tf = (float)t;
        rope[idx] = (f32x2){__builtin_amdgcn_cosf(tf), __builtin_amdgcn_sinf(tf)};
    }
}

__device__ __forceinline__ void p2a_norms(Frame& F, const Args& A) {
    const int gw = F.vcu * NWAVES + F_WAVE, NGW = F.G * NWAVES, lane = F_LANE;
    bf16* CQ = (bf16*)(F.ws + WS_CQ); bf16* CKV = (bf16*)(F.ws + WS_CKV);
    const float* gq = A.in[3]; const float* gkv = A.in[5];
    for (int m = gw; m < T; m += NGW) {
        {
            GAS unsigned* p = (GAS unsigned*)(CQ + (size_t)m * 384) + lane; unsigned w[3]; float s = 0.f;
#pragma unroll
            for (int j = 0; j < 3; ++j) { w[j] = p[64 * j]; const float a = bflo(w[j]), b = bfhi(w[j]); s += a * a + b * b; }
            const float rstd = 1.f / sqrtf(wave_sum(s) * (1.f / 384.f) + EPS);
#pragma unroll
            for (int j = 0; j < 3; ++j) { const f32x2 g = *((const GAS f32x2*)gq + lane + 64 * j); p[64 * j] = pk2(bflo(w[j]) * rstd * g.x, bfhi(w[j]) * rstd * g.y); }
        }
        {
            GAS v2u* p = (GAS v2u*)(CKV + (size_t)m * 256) + lane; const v2u w = *p;
            const float a = bflo(w.x), b = bfhi(w.x), c = bflo(w.y), d = bfhi(w.y);
            const float rstd = 1.f / sqrtf(wave_sum(a * a + b * b + c * c + d * d) * (1.f / 256.f) + EPS);
            const f32x4 g = *((const GAS f32x4*)gkv + lane); v2u o; o.x = pk2(a * rstd * g.x, b * rstd * g.y); o.y = pk2(c * rstd * g.z, d * rstd * g.w); *p = o;
        }
    }
}

__device__ __forceinline__ constexpr int crow(int r, int hi) { return (r & 3) + 8 * (r >> 2) + 4 * hi; }
constexpr float ATT_THR = 8.f;
__device__ __forceinline__ float att_mask(float p, unsigned w, int bit) { int mk; unsigned r;
    asm("v_bfe_i32 %0, %1, %2, 1" : "=v"(mk) : "v"(w), "i"(bit)); r = __builtin_bit_cast(unsigned, p) & (unsigned)mk; return __builtin_bit_cast(float, r); }
struct AttnP { const bf16 *Q, *K, *K2, *V; bf16* O; const unsigned* BM; };
template <bool MLA> __device__ __forceinline__ void attn_unit(LAS unsigned char* L, int b, int h, int qb, const AttnP& P, int tid, int lane, int wave) {
    constexpr int DK = MLA ? 96 : 64, KP = DK * 2 + 16, NS = DK / 16, CPR = DK / 8;
    constexpr int QPITCH = MLA ? 768 : 512, VP = 192, KBUF = 64 * KP, VBUF = 64 * VP;
    const int r32 = lane & 31, hi = lane >> 5;
    const size_t rowb = (size_t)b * SEQ;
    const int qrow = qb * 256 + wave * 32 + r32;
    bf16x8 qf[NS];
    { const bf16* qp = P.Q + (rowb + qrow) * QPITCH + h * DK;
#pragma unroll
      for (int s = 0; s < NS; ++s) qf[s] = *(const bf16x8*)(qp + 16 * s + 8 * hi); }
    const int NT = 4 * qb + 4, my_nt = 4 * qb + (wave >> 1) + 1;
    const int kid0 = tid, kid1 = tid + NTHR;
    const int kr0 = kid0 / CPR, kc0 = kid0 % CPR, kr1 = kid1 / CPR, kc1 = kid1 % CPR; const bool has1 = MLA && (kid1 < 64 * CPR);
    const int vr = tid >> 3, vc = tid & 7;
    v4u kreg0, kreg1 = (v4u){0u, 0u, 0u, 0u}, vreg;
#define ATT_KSRC(t, kr, kc) (MLA ? ((kc) < 8 ? (const v4u*)(P.K + (rowb + 64 * (t) + (kr)) * 512 + h * 64 + 8 * (kc)) : (const v4u*)(P.K2 + (rowb + 64 * (t) + (kr)) * 32 + 8 * ((kc) - 8))) \
                                 : (const v4u*)(P.K + (rowb + 64 * (t) + (kr)) * 512 + h * 64 + 8 * (kc)))
#define ATT_LOAD(t) do { kreg0 = *ATT_KSRC(t, kr0, kc0); if (has1) kreg1 = *ATT_KSRC(t, kr1, kc1); vreg = *(const v4u*)(P.V + (rowb + 64 * (t) + vr) * 512 + h * 64 + 8 * vc); } while (0)
#define ATT_WRITE(buf) do { *(LAS v4u*)(L + (buf) * KBUF + kr0 * KP + kc0 * 16) = kreg0; if (has1) *(LAS v4u*)(L + (buf) * KBUF + kr1 * KP + kc1 * 16) = kreg1; \
                            *(LAS v4u*)(L + 2 * KBUF + (buf) * VBUF + vr * VP + vc * 16) = vreg; } while (0)
    float mhat = 0.f, l = 0.f; f32x16 o0, o1, negm;
#pragma unroll
    for (int i = 0; i < 16; ++i) { o0[i] = 0.f; o1[i] = 0.f; negm[i] = 0.f; }
    const int g16 = lane >> 4, qq = (lane & 15) >> 2, pp = lane & 3;
    const int vlane = (4 * hi + qq) * VP + (16 * (g16 & 1) + 4 * pp) * 2;
    ATT_LOAD(0); ATT_WRITE(0); __syncthreads();
    unsigned wn0 = 0xffffffffu, wn1 = 0xffffffffu;
    const unsigned* bmq = MLA ? nullptr : P.BM + (size_t)b * 256 * SEQ + qrow;
    if (!MLA) { wn0 = bmq[0]; wn1 = bmq[SEQ]; }
    for (int t = 0; t < NT; ++t) {
        const int buf = t & 1;
        unsigned w0 = wn0 >> (4 * hi), w1 = wn1 >> (4 * hi);
        if (t + 1 < NT) { ATT_LOAD(t + 1); if (!MLA) { wn0 = bmq[(size_t)(2 * t + 2) * SEQ]; wn1 = bmq[(size_t)(2 * t + 3) * SEQ]; } }
        if (t < my_nt) {
            const LAS unsigned char* Kb = L + buf * KBUF; const LAS unsigned char* Vb = L + 2 * KBUF + buf * VBUF;
            f32x16 s0, s1;
            bf16x8 ka[NS][2];
#pragma unroll
            for (int s = 0; s < NS; ++s) { ka[s][0] = *(const LAS bf16x8*)(Kb + r32 * KP + s * 32 + hi * 16); ka[s][1] = *(const LAS bf16x8*)(Kb + (32 + r32) * KP + s * 32 + hi * 16); }
            __builtin_amdgcn_sched_barrier(0);
#pragma unroll
            for (int s = 0; s < NS; ++s) {
                s0 = __builtin_amdgcn_mfma_f32_32x32x16_bf16(ka[s][0], qf[s], s == 0 ? negm : s0, 0, 0, 0);
                s1 = __builtin_amdgcn_mfma_f32_32x32x16_bf16(ka[s][1], qf[s], s == 0 ? negm : s1, 0, 0, 0);
            }
            s16x4 vf[4][4];
#pragma unroll
            for (int ks = 0; ks < 4; ++ks) { const LAS unsigned char* vp = Vb + ks * 16 * VP + vlane;
                vf[ks][0] = __builtin_bit_cast(s16x4, __builtin_amdgcn_ds_read_tr16_b64_v4i16((LAS s16x4*)(vp)));
                vf[ks][1] = __builtin_bit_cast(s16x4, __builtin_amdgcn_ds_read_tr16_b64_v4i16((LAS s16x4*)(vp + 8 * VP)));
                vf[ks][2] = __builtin_bit_cast(s16x4, __builtin_amdgcn_ds_read_tr16_b64_v4i16((LAS s16x4*)(vp + 64)));
                vf[ks][3] = __builtin_bit_cast(s16x4, __builtin_amdgcn_ds_read_tr16_b64_v4i16((LAS s16x4*)(vp + 8 * VP + 64))); }
            __builtin_amdgcn_sched_barrier(0);
            float mx = fmaxf(fmaxf(s0[0], s0[1]), s1[0]);
#pragma unroll
            for (int i = 2; i < 16; i += 2) mx = fmaxf(fmaxf(mx, s0[i]), s0[i + 1]);
#pragma unroll
            for (int i = 1; i < 15; i += 2) mx = fmaxf(fmaxf(mx, s1[i]), s1[i + 1]);
            mx = fmaxf(mx, s1[15]);
            mx = fmaxf(mx, __shfl_xor(mx, 32));
            if (t == 0 || __any(mx > ATT_THR)) {
                const float dl = (t == 0) ? mx : fmaxf(mx, 0.f), f = (t == 0) ? 1.f : __builtin_amdgcn_exp2f(-dl);
                mhat += dl; l *= f;
#pragma unroll
                for (int i = 0; i < 16; ++i) { s0[i] -= dl; s1[i] -= dl; o0[i] *= f; o1[i] *= f; negm[i] = -mhat; }
            }
            float rs = 0.f;
#pragma unroll
            for (int i = 0; i < 16; ++i) {
                float p0 = __builtin_amdgcn_exp2f(s0[i]), p1 = __builtin_amdgcn_exp2f(s1[i]);
                if (!MLA) { p0 = att_mask(p0, w0, crow(i, 0)); p1 = att_mask(p1, w1, crow(i, 0)); }
                s0[i] = p0; s1[i] = p1; rs += p0 + p1; }
            l += rs;
            bf16x8 pf[4];
#pragma unroll
            for (int ks = 0; ks < 4; ++ks) { v4u w;
#pragma unroll
                for (int j = 0; j < 4; ++j) { const float a = (ks < 2) ? s0[8 * (ks & 1) + 2 * j] : s1[8 * (ks & 1) + 2 * j], c = (ks < 2) ? s0[8 * (ks & 1) + 2 * j + 1] : s1[8 * (ks & 1) + 2 * j + 1]; w[j] = pk2(a, c); }
                pf[ks] = __builtin_bit_cast(bf16x8, w); }
#pragma unroll
            for (int ks = 0; ks < 4; ++ks) {
                const bf16x8 A0 = __builtin_shufflevector(vf[ks][0], vf[ks][1], 0, 1, 2, 3, 4, 5, 6, 7);
                const bf16x8 A1 = __builtin_shufflevector(vf[ks][2], vf[ks][3], 0, 1, 2, 3, 4, 5, 6, 7);
                o0 = __builtin_amdgcn_mfma_f32_32x32x16_bf16(A0, pf[ks], o0, 0, 0, 0);
                o1 = __builtin_amdgcn_mfma_f32_32x32x16_bf16(A1, pf[ks], o1, 0, 0, 0);
            }
        }
        if (t + 1 < NT) ATT_WRITE(buf ^ 1);
        __syncthreads();
    }
    l += __shfl_xor(l, 32);
    const float inv = 1.f / l;
    bf16* op = P.O + (rowb + qrow) * 512 + h * 64 + 4 * hi;
#pragma unroll
    for (int g = 0; g < 4; ++g) {
        v2u w; w.x = pk2(o0[4 * g] * inv, o0[4 * g + 1] * inv); w.y = pk2(o0[4 * g + 2] * inv, o0[4 * g + 3] * inv); *(v2u*)(op + 8 * g) = w;
        v2u z; z.x = pk2(o1[4 * g] * inv, o1[4 * g + 1] * inv); z.y = pk2(o1[4 * g + 2] * inv, o1[4 * g + 3] * inv); *(v2u*)(op + 32 + 8 * g) = z;
    }
#undef ATT_KSRC
#undef ATT_LOAD
#undef ATT_WRITE
}

namespace attn_body {
using bf16=__hip_bfloat16;
using bf16x8=__attribute__((ext_vector_type(8)))short;
using s16x4=__attribute__((ext_vector_type(4)))short;
using f32x16=__attribute__((ext_vector_type(16)))float;
using u32x4=__attribute__((ext_vector_type(4)))unsigned;
constexpr int BATCH=2,NHEAD=8,SEQ=8192,D=64,DM=NHEAD*D;
constexpr int NW=8,QBLK=32,QB=QBLK*NW,KVBLK=64,NQB=SEQ/QB;
constexpr int ATTN_PITCH=DM, ATTN_UNIT_ROWS=QB;
__device__ __forceinline__ int crow(int r,int hi){return (r&3)+8*(r>>2)+4*hi;}
#define SBAR() __builtin_amdgcn_sched_barrier(0)
__device__ __forceinline__ void cmask(f32x16&p0,f32x16&p1,int jb,int wid){
  if(jb>(wid>>1)){
    #pragma unroll
    for(int r=0;r<16;++r){p0[r]=-INFINITY;p1[r]=-INFINITY;} }
}
__device__ __forceinline__ float amask(float p,unsigned w,int bit){ int mk; asm("v_bfe_i32 %0, %1, %2, 1":"=v"(mk):"v"(w),"i"(bit)); return __builtin_bit_cast(float,__builtin_bit_cast(unsigned,p)&(unsigned)mk); }
__device__ __forceinline__ void glds16o(const void*sbase,unsigned voff,unsigned lds_dst){unsigned keep;
  asm volatile("s_mov_b32 %0, m0\n\ts_mov_b32 m0, %3\n\ts_nop 0\n\tglobal_load_lds_dwordx4 %1, %2\n\ts_mov_b32 m0, %0":"=&s"(keep):"v"(voff),"s"(sbase),"s"(lds_dst):"memory");}
__device__ __forceinline__ void glds4o(const void*sbase,unsigned voff,unsigned lds_dst){unsigned keep;
  asm volatile("s_mov_b32 %0, m0\n\ts_mov_b32 m0, %3\n\ts_nop 0\n\tglobal_load_lds_dword %1, %2\n\ts_mov_b32 m0, %0":"=&s"(keep):"v"(voff),"s"(sbase),"s"(lds_dst):"memory");}
__device__ __forceinline__ void glds4(const void*gsrc,unsigned lds_dst){unsigned keep;
  asm volatile("s_mov_b32 %0, m0\n\ts_mov_b32 m0, %2\n\ts_nop 0\n\tglobal_load_lds_dword %1, off\n\ts_mov_b32 m0, %0":"=&s"(keep):"v"(gsrc),"s"(lds_dst):"memory");}

constexpr int NSLOT=3, SLOTB=8192, KSLOTMAX=12288;
constexpr int LDS_K=0, LDS_V=NSLOT*KSLOTMAX, LDS_WS=LDS_V+NSLOT*SLOTB, LDS_OST=LDS_WS+NW*64*4, LDS_BM=LDS_OST+NW*4096, LDS_BYTES=LDS_BM+NW*512;
constexpr float C2=0.125f*1.4426950408889634f;
__device__ __forceinline__ void glds16(const void*gsrc,unsigned lds_dst){unsigned keep;
  asm volatile("s_mov_b32 %0, m0\n\ts_mov_b32 m0, %2\n\ts_nop 0\n\tglobal_load_lds_dwordx4 %1, off\n\ts_mov_b32 m0, %0":"=&s"(keep):"v"(gsrc),"s"(lds_dst):"memory");}
__device__ __forceinline__ float max3f(float a,float b,float c){float r;asm("v_max3_f32 %0, %1, %2, %3":"=v"(r):"v"(a),"v"(b),"v"(c));return r;}
__device__ __forceinline__ float max2f(float a,float b){float r;asm("v_max_f32_e32 %0, %1, %2":"=v"(r):"v"(a),"v"(b));return r;}
__device__ __forceinline__ float fadd_s(float a,float b){float r;asm("v_add_f32_e32 %0, %1, %2":"=v"(r):"v"(a),"v"(b));return r;}
__device__ __forceinline__ float fsub_s(float a,float b){float r;asm("v_sub_f32_e32 %0, %1, %2":"=v"(r):"v"(a),"v"(b));return r;}
typedef float f32x2_t __attribute__((ext_vector_type(2))); typedef __bf16 bf16x2_t __attribute__((ext_vector_type(2)));
__device__ __forceinline__ unsigned cvtpk_s(float lo,float hi){f32x2_t v={lo,hi};bf16x2_t b=__builtin_convertvector(v,bf16x2_t);return __builtin_bit_cast(unsigned,b);}
#define WAIT_BAR(N) asm volatile("s_waitcnt vmcnt(" #N ") lgkmcnt(0)\n\ts_barrier":::"memory")

template<int NKS> __device__ __forceinline__ void qkt(f32x16&p0,f32x16&p1,const char*Kslot,const bf16x8*qr,const f32x16&negm,int r32,int hi){
  const char*kb=Kslot+hi*1024+r32*16;
  #pragma unroll
  for(int d0=0;d0<NKS;++d0){
    const bf16x8 b0=*reinterpret_cast<const bf16x8*>(kb+d0*2048);
    const bf16x8 b1=*reinterpret_cast<const bf16x8*>(kb+d0*2048+512);
    if(d0==0){p0=__builtin_amdgcn_mfma_f32_32x32x16_bf16(b0,qr[0],negm,0,0,0);p1=__builtin_amdgcn_mfma_f32_32x32x16_bf16(b1,qr[0],negm,0,0,0);}
    else{p0=__builtin_amdgcn_mfma_f32_32x32x16_bf16(b0,qr[d0],p0,0,0,0);p1=__builtin_amdgcn_mfma_f32_32x32x16_bf16(b1,qr[d0],p1,0,0,0);}}
}
typedef __attribute__((address_space(3))) const char* lds_cptr;
typedef short v4i16_t __attribute__((ext_vector_type(4)));
__device__ __forceinline__ void kload8(bf16x8*kf,lds_cptr kp){
  kf[0]=*(const __attribute__((address_space(3))) bf16x8*)(kp);      kf[1]=*(const __attribute__((address_space(3))) bf16x8*)(kp+512);
  kf[2]=*(const __attribute__((address_space(3))) bf16x8*)(kp+2048); kf[3]=*(const __attribute__((address_space(3))) bf16x8*)(kp+2560);
  kf[4]=*(const __attribute__((address_space(3))) bf16x8*)(kp+4096); kf[5]=*(const __attribute__((address_space(3))) bf16x8*)(kp+4608);
  kf[6]=*(const __attribute__((address_space(3))) bf16x8*)(kp+6144); kf[7]=*(const __attribute__((address_space(3))) bf16x8*)(kp+6656);
}
__device__ __forceinline__ void kload2(bf16x8*kf,lds_cptr kp,int j){ kf[2*j]=*(const __attribute__((address_space(3))) bf16x8*)(kp+j*2048); kf[2*j+1]=*(const __attribute__((address_space(3))) bf16x8*)(kp+j*2048+512); }
__device__ __forceinline__ s16x4 vtr(lds_cptr p){ return __builtin_bit_cast(s16x4,__builtin_amdgcn_ds_read_tr16_b64_v4i16((__attribute__((address_space(3))) v4i16_t*)p)); }
__device__ __forceinline__ float rowmax(const f32x16&p0,const f32x16&p1){
  float a=max3f(p0[0],p0[1],p1[0]),b=max3f(p0[2],p0[3],p1[1]);a=max3f(a,p1[2],p1[3]);
  #pragma unroll
  for(int r=4;r<16;r+=4){a=max3f(a,p0[r],p0[r+1]);b=max3f(b,p0[r+2],p0[r+3]);a=max3f(a,p1[r],p1[r+1]);b=max3f(b,p1[r+2],p1[r+3]);}
  const float m=max2f(a,b);
  auto rr=__builtin_amdgcn_permlane32_swap(__float_as_uint(m),__float_as_uint(m),false,false);
  return max2f(__uint_as_float(rr[0]),__uint_as_float(rr[1]));
}
__device__ __forceinline__ void pv(f32x16*o,int vb,bf16x8 pa0,bf16x8 pa1,bf16x8 pa2,bf16x8 pa3){
  #pragma unroll
  for(int d0=0;d0<2;++d0){s16x4 lo[4],hi[4];
    #pragma unroll
    for(int ks=0;ks<4;++ks){
      asm volatile("ds_read_b64_tr_b16 %0,%1 offset:%c2":"=&v"(lo[ks]):"v"(vb),"i"(d0*4096+ks*1024):"memory");
      asm volatile("ds_read_b64_tr_b16 %0,%1 offset:%c2":"=&v"(hi[ks]):"v"(vb),"i"(d0*4096+ks*1024+512):"memory");}
    asm volatile("s_waitcnt lgkmcnt(0)":::"memory");SBAR();
    #define PK(k) (bf16x8){lo[k][0],lo[k][1],lo[k][2],lo[k][3],hi[k][0],hi[k][1],hi[k][2],hi[k][3]}
    o[d0]=__builtin_amdgcn_mfma_f32_32x32x16_bf16(pa0,PK(0),o[d0],0,0,0);
    o[d0]=__builtin_amdgcn_mfma_f32_32x32x16_bf16(pa1,PK(1),o[d0],0,0,0);
    o[d0]=__builtin_amdgcn_mfma_f32_32x32x16_bf16(pa2,PK(2),o[d0],0,0,0);
    o[d0]=__builtin_amdgcn_mfma_f32_32x32x16_bf16(pa3,PK(3),o[d0],0,0,0);
    #undef PK
  }
}

#ifndef ATTN_STORE16
#define ATTN_STORE16(p,v) (*(u32x4*)(p)=(v))
#endif
template<int THRL,bool MLA> __device__ __forceinline__ void attn_unit(int b,int h,int qb,const bf16*Q,const bf16*__restrict__ K,const bf16*__restrict__ K2,const bf16*__restrict__ V,bf16*O,const unsigned*BMg,char*shm,int tid){
  constexpr int NKS=MLA?6:4, QP=MLA?768:512, DQ=MLA?96:64;
  const int lane=tid&63,r32=lane&31,hi=lane>>5; const int wid=__builtin_amdgcn_readfirstlane(tid>>6);
  const long rowbase=(long)b*SEQ; const int q0=qb*QB;
  const bf16*Qw=Q+(rowbase+q0+wid*QBLK)*QP+h*DQ;
  const bf16*Kh=K+rowbase*DM+h*D,*Vh=V+rowbase*DM+h*D;
  const unsigned lds0=(unsigned)(uintptr_t)shm;
  float*wsf=(float*)(shm+LDS_WS)+wid*64;
  const unsigned koff=(unsigned)(lane*DM+wid*8)*2u;
  const unsigned voff=(unsigned)((16*(wid&3)+(lane>>2))*DM+(wid>>2)*32+(lane&3)*8)*2u;
  const unsigned kdst=lds0+LDS_K+wid*1024, vdst=lds0+LDS_V+wid*1024;
  const bf16*K2h=MLA?K2+rowbase*32:nullptr; const unsigned koff2=(unsigned)(lane*32+(wid&3)*8)*2u; const unsigned kdst2=lds0+LDS_K+(8+(wid&3))*1024;
  #define KO(sl) (MLA?(sl)+((sl)>>1):(sl))
  #define DMA_K(t,slot) do{ glds16o(Kh+(long)(t)*KVBLK*DM,koff,(unsigned)__builtin_amdgcn_readfirstlane(kdst+KO(slot))); \
    if constexpr(MLA) glds16o(K2h+(long)(t)*KVBLK*32,koff2,(unsigned)__builtin_amdgcn_readfirstlane(kdst2+KO(slot))); }while(0)
  #define DMA_V(t,slot) glds16o(Vh+(long)(t)*KVBLK*DM,voff,(unsigned)__builtin_amdgcn_readfirstlane(vdst+(slot)))
  const unsigned*BMb=BMg+(long)b*256*SEQ+q0+wid*QBLK; const unsigned bmoff=(unsigned)(hi*SEQ+r32)*4u; const unsigned bmdst=lds0+LDS_BM+wid*512;
  const __attribute__((address_space(3))) unsigned*bmw=(const __attribute__((address_space(3))) unsigned*)((lds_cptr)shm+LDS_BM+wid*512);
  #define DMA_BM(t) if constexpr(!MLA) glds4o(BMb+(long)(t)*2*SEQ,bmoff,(unsigned)__builtin_amdgcn_readfirstlane(bmdst+((t)&1)*256))
  #define VMW(N) asm volatile("s_waitcnt vmcnt(" #N ")":::"memory")
  #define BMWAIT(t) do{ if constexpr(!MLA){ if((t)+3<NT){VMW(5);} else if((t)+2<NT){VMW(4);} else if((t)+1<NT){VMW(3);} else {VMW(1);} } }while(0)
  const int vb0=(int)(lds0+LDS_V)+((lane>>4)&1)*32+(lane&3)*8+(4*hi+((lane&15)>>2))*64;
  const char*Kbase=shm+LDS_K; bf16x8 kf[2*NKS];
  const lds_cptr shm3=(lds_cptr)shm; const lds_cptr kp0=shm3+LDS_K+hi*1024+r32*16; const lds_cptr vp0=shm3+LDS_V+((lane>>4)&1)*32+(lane&3)*8+(4*hi+((lane&15)>>2))*64;
  const int NT=(q0+QB)/KVBLK;
  DMA_BM(0);DMA_K(0,0);DMA_V(0,0);DMA_K(1,SLOTB);
  bf16x8 qr[NKS];
  #pragma unroll
  for(int d0=0;d0<NKS;++d0)qr[d0]=*reinterpret_cast<const bf16x8*>(&Qw[(long)r32*QP+d0*16+hi*8]);
  float mhat=0.f,l_reg=0.f;f32x16 o[2];o[0]=f32x16{};o[1]=f32x16{};f32x16 negm=f32x16{};asm volatile("":"+v"(negm));
  const int qrel=wid*QBLK+r32;
  #define CMASK(P0,P1,t) do{int jb_=(t)-(NT-4); if(jb_>=0)cmask(P0,P1,jb_,wid);}while(0)
  bool resc=false;
  #define START(P0,P1) do{ const float rm=rowmax(P0,P1); resc=false; \
    { const float dl=rm; mhat=fadd_s(mhat,dl); \
      _Pragma("unroll") for(int r=0;r<16;++r){P0[r]=fsub_s(P0[r],dl);P1[r]=fsub_s(P1[r],dl);} \
      _Pragma("unroll") for(int r=0;r<16;++r)negm[r]=-mhat; asm volatile("":"+v"(negm)); } \
    _Pragma("unroll") for(int r=0;r<16;++r)P0[r]=__builtin_amdgcn_exp2f(P0[r]); }while(0)
  #define RESC() do{ if(resc){ asm volatile("s_waitcnt lgkmcnt(0)":::"memory"); \
      _Pragma("unroll") for(int d_=0;d_<2;++d_) _Pragma("unroll") for(int r=0;r<16;++r)o[d_][r]*=wsf[crow(r,hi)]; } }while(0)
  f32x16 pA0,pA1,pB0,pB1;
  int sl_prev=0,sl_cur=0,sl_next=SLOTB;
  #define ROT() do{sl_prev=sl_cur;sl_cur=sl_next;sl_next=(sl_next==(NSLOT-1)*SLOTB)?0:sl_next+SLOTB;}while(0)
  DMA_K(2,2*SLOTB);
  if constexpr(MLA){WAIT_BAR(5);}else{WAIT_BAR(3);}
  qkt<NKS>(pA0,pA1,Kbase,qr,negm,r32,hi);asm volatile("s_nop 15\n\ts_nop 7":"+v"(pA0),"+v"(pA1));CMASK(pA0,pA1,0);
  START(pA0,pA1);
  _Pragma("unroll") for(int r=0;r<16;++r)pA1[r]=__builtin_amdgcn_exp2f(pA1[r]);
  if constexpr(!MLA){ const unsigned w0_=bmw[r32]>>(4*hi), w1_=bmw[32+r32]>>(4*hi);
    _Pragma("unroll") for(int r=0;r<16;++r){pA0[r]=amask(pA0[r],w0_,(r&3)+8*(r>>2));pA1[r]=amask(pA1[r],w1_,(r&3)+8*(r>>2));} }
  WAIT_BAR(0);
  DMA_BM(1);DMA_K(3,0);DMA_V(1,SLOTB);
  ROT();
  _Pragma("unroll") for(int j=0;j<NKS;++j)kload2(kf,kp0+KO(sl_cur),j);
  WAIT_BAR(3);
  s16x4 vlo[8],vhi[8]; u32x4 pw0,pw1,pw2,pw3;
  #define PKW(P,B) cvtpk_s(P[B],P[B+1])
  #define PAF(k) __builtin_bit_cast(bf16x8,pw##k)
  #define VFR(i) (bf16x8){vlo[i][0],vlo[i][1],vlo[i][2],vlo[i][3],vhi[i][0],vhi[i][1],vhi[i][2],vhi[i][3]}
  #define PIN(x) asm volatile("":"+v"(x))
  #define MX3(a,b,c) __builtin_fmaxf(__builtin_fmaxf((a),(b)),(c))
  #define GAPA(MF,A0,A1,A2,A3,W0,W1,PW) do{ MF; sacc+=A0; sacc+=A1; sacc+=A2; sacc+=A3; PIN(sacc); W0; W1; PIN(PW); SBAR(); }while(0)
  #define EX(v) __builtin_amdgcn_exp2f(v)
  #define CR_(r) (((r)&3)+8*((r)>>2))
  #define GAPB(MF,X,B,W) do{ MF; X[B]=EX(X[B]); X[B+1]=EX(X[B+1]); X[B+2]=EX(X[B+2]); X[B+3]=EX(X[B+3]); \
    if constexpr(!MLA){ X[B]=amask(X[B],W,CR_(B)); X[B+1]=amask(X[B+1],W,CR_(B+1)); X[B+2]=amask(X[B+2],W,CR_(B+2)); X[B+3]=amask(X[B+3],W,CR_(B+3)); } PIN(X); SBAR(); }while(0)
  #define VRD(i) do{ vlo[i]=vtr(vp_+(((i)>>2)*4096+((i)&3)*1024)); vhi[i]=vtr(vp_+(((i)>>2)*4096+((i)&3)*1024+512)); }while(0)
  #define KRD(G,j) do{ if((j)<NKS){ if(G){ kload2(kf,kp0+KO(sl_next),j); SBAR(); } } }while(0)
  #define STEP(C0,C1,P0,P1,t,GK,GV,GL) do{ SBAR(); \
    const lds_cptr vp_=vp0+sl_prev; \
    VRD(0); SBAR(); float sacc=(P0[0]+P0[1]); \
    GAPA(C0=__builtin_amdgcn_mfma_f32_32x32x16_bf16(kf[0],qr[0],negm,0,0,0), P0[2],P0[3],P0[4],P0[5],     pw0[0]=PKW(P0,0), pw0[1]=PKW(P0,2), pw0); \
    VRD(4); SBAR(); GAPA(C1=__builtin_amdgcn_mfma_f32_32x32x16_bf16(kf[1],qr[0],negm,0,0,0), P0[6],P0[7],P0[8],P0[9],     pw0[2]=PKW(P0,4), pw0[3]=PKW(P0,6), pw0); \
    VRD(1); SBAR(); GAPA(C0=__builtin_amdgcn_mfma_f32_32x32x16_bf16(kf[2],qr[1],C0,0,0,0),   P0[10],P0[11],P0[12],P0[13], pw1[0]=PKW(P0,8), pw1[1]=PKW(P0,10), pw1); \
    VRD(5); SBAR(); GAPA(C1=__builtin_amdgcn_mfma_f32_32x32x16_bf16(kf[3],qr[1],C1,0,0,0),   P0[14],P0[15],P1[0],P1[1],   pw1[2]=PKW(P0,12),pw1[3]=PKW(P0,14), pw1); \
    VRD(2); SBAR(); GAPA(C0=__builtin_amdgcn_mfma_f32_32x32x16_bf16(kf[4],qr[2],C0,0,0,0),   P1[2],P1[3],P1[4],P1[5],     pw2[0]=PKW(P1,0), pw2[1]=PKW(P1,2), pw2); \
    VRD(6); SBAR(); GAPA(C1=__builtin_amdgcn_mfma_f32_32x32x16_bf16(kf[5],qr[2],C1,0,0,0),   P1[6],P1[7],P1[8],P1[9],     pw2[2]=PKW(P1,4), pw2[3]=PKW(P1,6), pw2); \
    VRD(3); SBAR(); GAPA(C0=__builtin_amdgcn_mfma_f32_32x32x16_bf16(kf[6],qr[3],C0,0,0,0),   P1[10],P1[11],P1[12],P1[13], pw3[0]=PKW(P1,8), pw3[1]=PKW(P1,10), pw3); \
    VRD(7); SBAR(); GAPA(C1=__builtin_amdgcn_mfma_f32_32x32x16_bf16(kf[7],qr[3],C1,0,0,0),   P1[14],P1[15],0.f,0.f,       pw3[2]=PKW(P1,12),pw3[3]=PKW(P1,14), pw3); \
    if constexpr(MLA){ C0=__builtin_amdgcn_mfma_f32_32x32x16_bf16(kf[8],qr[4],C0,0,0,0); C1=__builtin_amdgcn_mfma_f32_32x32x16_bf16(kf[9],qr[4],C1,0,0,0); \
      C0=__builtin_amdgcn_mfma_f32_32x32x16_bf16(kf[10],qr[5],C0,0,0,0); C1=__builtin_amdgcn_mfma_f32_32x32x16_bf16(kf[11],qr[5],C1,0,0,0); SBAR(); } \
    l_reg+=sacc; \
    if(GV){DMA_BM((t)+1);} if(GK){DMA_K((t)+3,sl_cur);} if(GV){DMA_V((t)+1,sl_next);} \
    CMASK(C0,C1,t); \
    { float a=MX3(C0[0],C0[1],C1[0]),b=MX3(C0[2],C0[3],C1[1]); a=MX3(a,C1[2],C1[3]); \
      _Pragma("unroll") for(int r=4;r<16;r+=4){a=MX3(a,C0[r],C0[r+1]);b=MX3(b,C0[r+2],C0[r+3]);a=MX3(a,C1[r],C1[r+1]);b=MX3(b,C1[r+2],C1[r+3]);} \
      float rm=__builtin_fmaxf(a,b); { auto rr=__builtin_amdgcn_permlane32_swap(__float_as_uint(rm),__float_as_uint(rm),false,false); rm=__builtin_fmaxf(__uint_as_float(rr[0]),__uint_as_float(rr[1])); } \
      resc=false; \
      if(__builtin_expect(__any(rm>(float)THRL),0)){ const float dl=__builtin_fmaxf(rm,0.f); mhat+=dl; \
        _Pragma("unroll") for(int r=0;r<16;++r){C0[r]-=dl;C1[r]-=dl;} \
        _Pragma("unroll") for(int r=0;r<16;++r)negm[r]=-mhat; asm volatile("":"+v"(negm)); \
        const float f=__builtin_amdgcn_exp2f(-dl); l_reg*=f; if(hi==0)wsf[r32]=f; resc=true; } } \
    BMWAIT(t); unsigned w0_=0u, w1_=0u; if constexpr(!MLA){ w0_=bmw[((t)&1)*64+r32]>>(4*hi); w1_=bmw[((t)&1)*64+32+r32]>>(4*hi); } \
    SBAR(); \
    GAPB(o[0]=__builtin_amdgcn_mfma_f32_32x32x16_bf16(PAF(0),VFR(0),o[0],0,0,0), C0,0,w0_); \
    KRD(GL,4); GAPB(o[1]=__builtin_amdgcn_mfma_f32_32x32x16_bf16(PAF(0),VFR(4),o[1],0,0,0), C0,4,w0_); \
    KRD(GL,0); GAPB(o[0]=__builtin_amdgcn_mfma_f32_32x32x16_bf16(PAF(1),VFR(1),o[0],0,0,0), C0,8,w0_); \
    KRD(GL,1); GAPB(o[1]=__builtin_amdgcn_mfma_f32_32x32x16_bf16(PAF(1),VFR(5),o[1],0,0,0), C0,12,w0_); \
    KRD(GL,2); GAPB(o[0]=__builtin_amdgcn_mfma_f32_32x32x16_bf16(PAF(2),VFR(2),o[0],0,0,0), C1,0,w1_); \
    KRD(GL,3); GAPB(o[1]=__builtin_amdgcn_mfma_f32_32x32x16_bf16(PAF(2),VFR(6),o[1],0,0,0), C1,4,w1_); \
    KRD(GL,5); GAPB(o[0]=__builtin_amdgcn_mfma_f32_32x32x16_bf16(PAF(3),VFR(3),o[0],0,0,0), C1,8,w1_); \
    GAPB(o[1]=__builtin_amdgcn_mfma_f32_32x32x16_bf16(PAF(3),VFR(7),o[1],0,0,0), C1,12,w1_); \
    }while(0)
  int t=1;
  #undef CMASK
  #define CMASK(P0,P1,t) do{}while(0)
  for(;t+5<NT;t+=2){
    STEP(pB0,pB1,pA0,pA1,t,true,true,true);     WAIT_BAR(3); RESC(); ROT();
    STEP(pA0,pA1,pB0,pB1,t+1,true,true,true);   WAIT_BAR(3); RESC(); ROT();
  }
  #undef CMASK
  #define CMASK(P0,P1,t) do{int jb_=(t)-(NT-4); if(jb_>=0)cmask(P0,P1,jb_,wid);}while(0)
  #define ENDW(tt) do{ if((tt)+3<NT){WAIT_BAR(3);} else if((tt)+2<NT){ if constexpr(MLA){WAIT_BAR(1);}else{WAIT_BAR(2);} } else {WAIT_BAR(0);} }while(0)
  for(;t+1<NT;t+=2){
    STEP(pB0,pB1,pA0,pA1,t,(t+3<NT),(t+1<NT),(t+1<NT));       ENDW(t);   RESC(); ROT();
    STEP(pA0,pA1,pB0,pB1,t+1,(t+4<NT),(t+2<NT),(t+2<NT));     ENDW(t+1); RESC(); ROT();
  }
  STEP(pB0,pB1,pA0,pA1,NT-1,false,false,false); RESC();
  { float sacc=pB0[0]+pB0[1]; _Pragma("unroll") for(int r=2;r<16;++r)sacc+=pB0[r]; _Pragma("unroll") for(int r=0;r<16;++r)sacc+=pB1[r]; l_reg+=sacc;
    pw0=(u32x4){PKW(pB0,0),PKW(pB0,2),PKW(pB0,4),PKW(pB0,6)};pw1=(u32x4){PKW(pB0,8),PKW(pB0,10),PKW(pB0,12),PKW(pB0,14)};pw2=(u32x4){PKW(pB1,0),PKW(pB1,2),PKW(pB1,4),PKW(pB1,6)};pw3=(u32x4){PKW(pB1,8),PKW(pB1,10),PKW(pB1,12),PKW(pB1,14)};
    SBAR(); pv(o,vb0+sl_cur,PAF(0),PAF(1),PAF(2),PAF(3)); }
  #undef PKW
  #undef PAF
  #undef VFR
  #undef PIN
  #undef MX3
  #undef GAPA
  #undef GAPB
  #undef EX
  #undef VRD
  #undef KRD
  #undef STEP
  #undef ENDW
  {auto rr=__builtin_amdgcn_permlane32_swap(__float_as_uint(l_reg),__float_as_uint(l_reg),false,false);l_reg=__uint_as_float(rr[0])+__uint_as_float(rr[1]);}
  if(hi==0)wsf[32+r32]=l_reg;asm volatile("s_waitcnt lgkmcnt(0)":::"memory");
  float rli[16];
  #pragma unroll
  for(int r=0;r<16;++r)rli[r]=__builtin_amdgcn_rcpf(wsf[32+crow(r,hi)]);
  bf16*Ow=O+(rowbase+q0+wid*QBLK)*DM+h*D;
  { bf16*stg=(bf16*)(shm+LDS_OST)+wid*2048;
    #pragma unroll
    for(int r=0;r<16;++r){const int orow=crow(r,hi);
      #pragma unroll
      for(int d0=0;d0<2;++d0)stg[orow*64+d0*32+r32]=__float2bfloat16(o[d0][r]*rli[r]);}
    asm volatile("s_waitcnt lgkmcnt(0)":::"memory");
    #pragma unroll
    for(int i=0;i<4;++i){const int row=i*8+(lane>>3),ch=lane&7; const u32x4 v=*(const u32x4*)(stg+row*64+ch*8); ATTN_STORE16(Ow+(long)row*DM+ch*8,v);} }
  asm volatile("s_waitcnt lgkmcnt(0)\n\ts_barrier":::"memory");
  #undef DMA_K
  #undef DMA_BM
  #undef KO
  #undef VMW
  #undef BMWAIT
  #undef CR_
  #undef DMA_V
  #undef CMASK
  #undef START
  #undef RESC
  #undef ROT
}
#undef SBAR
#undef WAIT_BAR
}
__device__ __forceinline__ unsigned row16_sum(unsigned x) {
    x += (unsigned)__builtin_amdgcn_update_dpp(0, (int)x, 0x128, 0xf, 0xf, false); x += (unsigned)__builtin_amdgcn_update_dpp(0, (int)x, 0x124, 0xf, 0xf, false);
    x += (unsigned)__builtin_amdgcn_update_dpp(0, (int)x, 0x122, 0xf, 0xf, false); x += (unsigned)__builtin_amdgcn_update_dpp(0, (int)x, 0x121, 0xf, 0xf, false); return x; }
__device__ __forceinline__ float row16_sumf(float x) {
    x += __builtin_bit_cast(float, __builtin_amdgcn_update_dpp(0, __builtin_bit_cast(int, x), 0x128, 0xf, 0xf, false)); x += __builtin_bit_cast(float, __builtin_amdgcn_update_dpp(0, __builtin_bit_cast(int, x), 0x124, 0xf, 0xf, false));
    x += __builtin_bit_cast(float, __builtin_amdgcn_update_dpp(0, __builtin_bit_cast(int, x), 0x122, 0xf, 0xf, false)); x += __builtin_bit_cast(float, __builtin_amdgcn_update_dpp(0, __builtin_bit_cast(int, x), 0x121, 0xf, 0xf, false)); return x; }
__device__ __forceinline__ unsigned row16_suffix(unsigned x) {
    x += (unsigned)__builtin_amdgcn_update_dpp(0, (int)x, 0x101, 0xf, 0xf, false); x += (unsigned)__builtin_amdgcn_update_dpp(0, (int)x, 0x102, 0xf, 0xf, false);
    x += (unsigned)__builtin_amdgcn_update_dpp(0, (int)x, 0x104, 0xf, 0xf, false); x += (unsigned)__builtin_amdgcn_update_dpp(0, (int)x, 0x108, 0xf, 0xf, false); return x; }
__device__ __forceinline__ unsigned half_or(unsigned x) { const auto rr = __builtin_amdgcn_permlane32_swap(x, x, false, false); return rr[0] | rr[1]; }
constexpr int CAND_CAP = 128, QIP = 1296, HS = 513, FAST_CAP = 512;
struct IdxP { const bf16 *QI, *KI; const float* WI; unsigned* BM; unsigned* dbg; };
__device__ __forceinline__ unsigned mono_key(float s) { const unsigned u = __builtin_bit_cast(unsigned, s + 0.0f); return u ^ ((unsigned)((int)u >> 31) | 0x80000000u); }
__device__ __forceinline__ void idx_scores2(const bf16x8 (&kf)[2][4], const LAS unsigned char* qlane, const float (&wq)[8], f32x16& sc0, f32x16& sc1) {
    bf16x8 qv[4], qn[4];
#pragma unroll
    for (int s = 0; s < 4; ++s) qv[s] = *(const LAS bf16x8*)(qlane + 8 * 128 + s * 32);
#pragma unroll
    for (int i = 0; i < 16; ++i) { sc0[i] = 0.f; sc1[i] = 0.f; }
    f32x16 ap0, ap1;
#pragma unroll
    for (int i = 0; i < 16; ++i) { ap0[i] = 0.f; ap1[i] = 0.f; }
#pragma unroll
    for (int n = 0; n < 10; ++n) {
        const int nh = (n + 1 < 2) ? 9 : (n + 1 - 2);
        if (n + 1 < 10) {
#pragma unroll
            for (int s = 0; s < 4; ++s) qn[s] = *(const LAS bf16x8*)(qlane + nh * 128 + s * 32); }
        f32x16 a0, a1;
        if (n < 2) {
#pragma unroll
            for (int s = 0; s < 4; ++s) { sc0 = __builtin_amdgcn_mfma_f32_32x32x16_bf16(kf[0][s], qv[s], sc0, 0, 0, 0); sc1 = __builtin_amdgcn_mfma_f32_32x32x16_bf16(kf[1][s], qv[s], sc1, 0, 0, 0); }
        } else {
#pragma unroll
            for (int i = 0; i < 16; ++i) { a0[i] = 0.f; a1[i] = 0.f; }
#pragma unroll
            for (int s = 0; s < 4; ++s) { a0 = __builtin_amdgcn_mfma_f32_32x32x16_bf16(kf[0][s], qv[s], a0, 0, 0, 0); a1 = __builtin_amdgcn_mfma_f32_32x32x16_bf16(kf[1][s], qv[s], a1, 0, 0, 0); }
        }
        if (n >= 3) {
            const float w = wq[n - 3];
#pragma unroll
            for (int i = 0; i < 16; ++i) { sc0[i] = __builtin_fmaf(w, __builtin_fabsf(ap0[i]), sc0[i]); sc1[i] = __builtin_fmaf(w, __builtin_fabsf(ap1[i]), sc1[i]); }
#pragma unroll
            for (int g = 0; g < 8; ++g) { __builtin_amdgcn_sched_group_barrier(0x008, 1, 0); __builtin_amdgcn_sched_group_barrier(0x002, 4, 0); }
        }
        if (n >= 2) { ap0 = a0; ap1 = a1; }
#pragma unroll
        for (int s = 0; s < 4; ++s) qv[s] = qn[s];
    }
    { const float w = wq[7];
#pragma unroll
      for (int i = 0; i < 16; ++i) { sc0[i] = __builtin_fmaf(w, __builtin_fabsf(ap0[i]), sc0[i]); sc1[i] = __builtin_fmaf(w, __builtin_fabsf(ap1[i]), sc1[i]); } }
#pragma unroll
    for (int i = 0; i < 16; ++i) asm volatile("" : "+v"(sc0[i]), "+v"(sc1[i]));
}
__device__ __forceinline__ void idx_item(LAS unsigned char* L, int b, int j, const IdxP& P, int tid, int lane, int wave) {
    LAS unsigned* hist = (LAS unsigned*)L;
    LAS unsigned* img = (LAS unsigned*)(L + 66048);
    LAS unsigned* st = (LAS unsigned*)(L + 98816);
    LAS unsigned* cand = hist;
    LAS unsigned char* Qs = L + 100864;
    const int r32 = lane & 31, hi = lane >> 5;
    const int q0 = 32 * j, ntile = 2 * (j / 2 + 1);
    const size_t rowb = (size_t)b * SEQ;
    if (ntile <= 8) {
        for (int idx = tid; idx < ntile * 32; idx += NTHR) P.BM[((size_t)b * 256 + (idx >> 5)) * SEQ + q0 + (idx & 31)] = 0xffffffffu;
        return;
    }
    const int npair = ntile >> 1, nsw = (npair + 63) >> 6, SP = min(npair, 8 * nsw);
    bf16x8 ksmp[2][4];
#ifdef SMP_PREFETCH
    if (wave < SP) { const bf16* kp = P.KI + (rowb + 64 * ((wave * npair) / SP) + r32) * 64 + 8 * hi;
#pragma unroll
        for (int s = 0; s < 4; ++s) { ksmp[0][s] = *(const bf16x8*)(kp + 16 * s); ksmp[1][s] = *(const bf16x8*)(kp + 32 * 64 + 16 * s); } }
#endif
    float wq[8];
    { for (int c = tid; c < 32 * 64; c += NTHR) { const int rr = c >> 6, ch = c & 63; *(LAS v4u*)(Qs + rr * QIP + ch * 16) = *(const v4u*)(P.QI + (rowb + q0 + rr) * 512 + ch * 8); }
      const float* wp = P.WI + (rowb + q0 + r32) * 8;
#pragma unroll
      for (int h = 0; h < 8; ++h) wq[h] = 0.5f * wp[h]; }
    if (tid < 32) { st[32 + tid] = 256u; st[64 + tid] = 0u; st[96 + tid] = 0u; }
    if (tid == 0) st[129] = 0u;
    __syncthreads();
    {
        const int r = tid >> 4, part = tid & 15;
        const float* wp = P.WI + (rowb + q0 + r) * 8;
        float qb[4] = {0.f, 0.f, 0.f, 0.f}; float rsum = 0.f;
#pragma unroll
        for (int h = 0; h < 8; ++h) { const float w = wp[h]; const v2u raw = *(const LAS v2u*)(Qs + r * QIP + h * 128 + part * 8);
            const float f0 = bflo(raw.x), f1 = bfhi(raw.x), f2 = bflo(raw.y), f3 = bfhi(raw.y);
            float nsq = (f0 * f0 + f1 * f1) + (f2 * f2 + f3 * f3);
            nsq = row16_sumf(nsq);
            rsum += fabsf(w) * sqrtf(nsq);
            qb[0] += 0.5f * w * f0; qb[1] += 0.5f * w * f1; qb[2] += 0.5f * w * f2; qb[3] += 0.5f * w * f3; }
        v2u hw, lw;
        { const unsigned h01 = pk2(qb[0], qb[1]), h23 = pk2(qb[2], qb[3]); hw.x = h01; hw.y = h23;
          lw.x = pk2(qb[0] - bflo(h01), qb[1] - bfhi(h01)); lw.y = pk2(qb[2] - bflo(h23), qb[3] - bfhi(h23)); }
        *(LAS v2u*)(Qs + r * QIP + 8 * 128 + part * 8) = hw; *(LAS v2u*)(Qs + r * QIP + 9 * 128 + part * 8) = lw;
        { const v2u kw = *(const v2u*)(P.KI + (rowb + r) * 64 + part * 4); const float f0 = bflo(kw.x), f1 = bfhi(kw.x), f2 = bflo(kw.y), f3 = bfhi(kw.y);
          float ksq = (f0 * f0 + f1 * f1) + (f2 * f2 + f3 * f3);
          ksq = row16_sumf(ksq);
          if (part == 0) { __hip_atomic_fetch_max(&st[129], __builtin_bit_cast(unsigned, ksq), __ATOMIC_RELAXED, __HIP_MEMORY_SCOPE_WORKGROUP); st[224 + r] = __builtin_bit_cast(unsigned, rsum); } }
    }
    __syncthreads();
    if (tid < 32) { const float R = 0.25f * sqrtf(__builtin_bit_cast(float, st[129])) * __builtin_bit_cast(float, st[224 + tid]);
        const float C = 0.125f * R;
        st[160 + tid] = (0x80000000u | __builtin_bit_cast(unsigned, R + C)) - 511u * 131072u; st[224 + tid] = __builtin_bit_cast(unsigned, C); st[tid] = 0u; st[192 + tid] = 0u;
        st[256 + tid] = __builtin_bit_cast(unsigned, R); st[288 + tid] = 511u; st[320 + tid] = 0u; }
    const LAS unsigned char* qlane = Qs + r32 * QIP + hi * 16;
    int level = 0;
#define IDX_KLOAD2(tp) { const bf16* kp = P.KI + (rowb + 64 * (tp) + r32) * 64 + 8 * hi; _Pragma("unroll") for (int s = 0; s < 4; ++s) { kn[0][s] = *(const bf16x8*)(kp + 16 * s); kn[1][s] = *(const bf16x8*)(kp + 32 * 64 + 16 * s); } }
#define IDX_SCORES2(tp) \
        bf16x8 kf[2][4]; _Pragma("unroll") for (int s = 0; s < 4; ++s) { kf[0][s] = kn[0][s]; kf[1][s] = kn[1][s]; } \
        f32x16 sc0, sc1; idx_scores2(kf, qlane, wq, sc0, sc1); \
        if ((tp) + NWAVES < npair) { IDX_KLOAD2((tp) + NWAVES) }
    bool slow;
    {
        for (int u = tid; u < 32 * HS; u += NTHR) hist[u] = 0u;
        if (tid == 0) st[130] = 0u;
        __syncthreads();
        const float Rq = __builtin_bit_cast(float, st[256 + r32]);
        {   const float s1 = 256.f / Rq; LAS unsigned* hrow = hist + r32 * HS;
            for (int i = wave; i < SP; i += NWAVES) { const int tp = (i * npair) / SP;
#ifdef SMP_PREFETCH
                bf16x8 kn[2][4]; if (i >= NWAVES) { IDX_KLOAD2(tp) }
#else
                bf16x8 kn[2][4]; IDX_KLOAD2(tp)
#endif
                bf16x8 kf[2][4];
#pragma unroll
#ifdef SMP_PREFETCH
                for (int s = 0; s < 4; ++s) { kf[0][s] = (i < NWAVES) ? ksmp[0][s] : kn[0][s]; kf[1][s] = (i < NWAVES) ? ksmp[1][s] : kn[1][s]; }
#else
                for (int s = 0; s < 4; ++s) { kf[0][s] = kn[0][s]; kf[1][s] = kn[1][s]; }
#endif
                f32x16 sc0, sc1; idx_scores2(kf, qlane, wq, sc0, sc1);
#pragma unroll
                for (int e = 0; e < 16; ++e) { const int b0 = min(max((int)__builtin_fmaf(sc0[e], s1, 256.f), 0), 511), b1 = min(max((int)__builtin_fmaf(sc1[e], s1, 256.f), 0), 511);
                    __hip_atomic_fetch_add(&hrow[b0], 1u, __ATOMIC_RELAXED, __HIP_MEMORY_SCOPE_WORKGROUP); __hip_atomic_fetch_add(&hrow[b1], 1u, __ATOMIC_RELAXED, __HIP_MEMORY_SCOPE_WORKGROUP); }
            }
        }
        __syncthreads();
        {
            const int q = tid >> 4, seg = tid & 15; const LAS unsigned* hq = hist + q * HS + seg * 32;
            unsigned segsum = 0u;
            for (int wi = 0; wi < 32; ++wi) segsum += hq[wi];
            unsigned S = segsum;
            S = row16_suffix(S);
            const unsigned above = S - segsum, total = row16_sum(segsum);
            const float f = (float)total / (float)(64 * npair), rs = 256.f * f, sg = 3.5f * sqrtf(rs * (1.f - f));
            const int rl = (int)floorf(rs - sg) - 1, rh = (int)ceilf(rs + sg) + 1;
            const unsigned tl = rl > 0 ? (unsigned)rl : 0u, th = (unsigned)rh;
            if (above < tl && tl <= above + segsum) { unsigned cum = above; int fb = 0; bool found = false;
                for (int wi = 31; wi >= 0; --wi) { const unsigned c = hq[wi]; if (!found && cum + c >= tl) { found = true; fb = wi; } if (!found) cum += c; }
                st[288 + q] = (unsigned)(32 * seg + fb); }
            if (above < th && th <= above + segsum) { unsigned cum = above; int fb = 0; bool found = false;
                for (int wi = 31; wi >= 0; --wi) { const unsigned c = hq[wi]; if (!found && cum + c >= th) { found = true; fb = wi; } if (!found) cum += c; }
                st[320 + q] = (unsigned)(32 * seg + fb); }
        }
        __syncthreads();
#ifdef REP_PASS2
        for (int rep2 = 0; rep2 < 2; ++rep2) { if (rep2) { __syncthreads(); if (tid < 32) st[96 + tid] = 0u; __syncthreads(); }
#else
        {
#endif
            const float wbin = Rq * (1.f / 256.f), fH = __builtin_fmaf((float)(st[288 + r32] + 1u), wbin, -Rq), fA = __builtin_fmaf((float)st[320 + r32], wbin, -Rq), s2 = 524287.f / (fH - fA), nfa = -fA * s2;
            bf16x8 kn[2][4]; if (wave < npair) { IDX_KLOAD2(wave) }
            for (int tp = wave; tp < npair; tp += NWAVES) {
                IDX_SCORES2(tp)
#define IDX_FAST_ELEMS(SC, T) { unsigned v = 0u, cm = 0u; \
            _Pragma("unroll") for (int i = 15; i >= 0; --i) { v = __builtin_amdgcn_alignbit(v, __builtin_bit_cast(unsigned, SC[i] - fH), 31);        \
                                                              cm = __builtin_amdgcn_alignbit(cm, __builtin_bit_cast(unsigned, SC[i] - fA), 31); } \
            cm = v & ~cm & 0xffffu; v = ~v & 0xffffu;                                                           \
            if (cm) { const unsigned pos0 = __hip_atomic_fetch_add(&st[96 + r32], (unsigned)__builtin_popcount(cm), __ATOMIC_RELAXED, __HIP_MEMORY_SCOPE_WORKGROUP);     \
                const unsigned rb = 8191u - (unsigned)(32 * (T)) - hi4; \
                _Pragma("unroll") for (int i = 0; i < 16; ++i) if (cm & (1u << i)) { const unsigned pos = min(pos0 + (unsigned)__builtin_popcount(cm & ((1u << i) - 1u)), (unsigned)FAST_CAP - 1u); \
                    cand[r32 * FAST_CAP + pos] = (min((unsigned)__builtin_fmaf(SC[i], s2, nfa), 524287u) << 13) | (rb - (unsigned)((i & 3) + 8 * (i >> 2))); } } \
            unsigned bits = (v & 0xfu) | ((v & 0xf0u) << 4) | ((v & 0xf00u) << 8) | ((v & 0xf000u) << 12);     \
            bits <<= 4 * hi; bits = half_or(bits); if (hi == 0) img[(T) * 32 + r32] = bits; }
                unsigned hi4 = 4u * (unsigned)hi; asm volatile("" : "+v"(hi4));
                IDX_FAST_ELEMS(sc0, 2 * tp)
                IDX_FAST_ELEMS(sc1, 2 * tp + 1)
#undef IDX_FAST_ELEMS
            }
        }
        __syncthreads();
        {
            const int q = tid >> 4, l16 = tid & 15; unsigned above = 0u;
            for (int t = l16; t < ntile; t += 16) above += (unsigned)__builtin_popcount(img[t * 32 + q]);
            above = row16_sum(above);
            const unsigned n = st[96 + q];
            if (l16 == 0) { if (above >= 256u || 256u - above > n || n > (unsigned)FAST_CAP) st[130] = 1u; st[32 + q] = 256u - above; }
        }
        __syncthreads();
        slow = st[130] != 0u;
#ifdef REP_SEL
        for (int rep3 = 0; rep3 < 2; ++rep3)
#endif
        if (!slow) {
            const int q = tid >> 4, l16 = tid & 15; const unsigned n = st[96 + q], need = st[32 + q];
            unsigned c[FAST_CAP / 16];
#pragma unroll
            for (int i = 0; i < FAST_CAP / 16; ++i) { const unsigned ci = (unsigned)(l16 + 16 * i); c[i] = ci < n ? cand[q * FAST_CAP + ci] : 0u; }
            unsigned Pv = 0u; bool done = false;
#pragma nounroll
            for (int bit = 31; bit >= 0; --bit) { const unsigned trial = Pv | (1u << bit); unsigned cnt = 0u;
#pragma unroll
                for (int i = 0; i < FAST_CAP / 16; ++i) cnt += (c[i] >= trial) ? 1u : 0u;
                cnt = row16_sum(cnt);
                if (!done && cnt >= need) { Pv = trial; done = (cnt == need); }
                if (__all(done)) break; }
#pragma unroll
            for (int i = 0; i < FAST_CAP / 16; ++i) if ((unsigned)(l16 + 16 * i) < n && c[i] >= Pv) { const unsigned kidx = 8191u - (c[i] & 8191u);
                __hip_atomic_fetch_or(&img[(kidx >> 5) * 32 + q], 1u << (kidx & 31), __ATOMIC_RELAXED, __HIP_MEMORY_SCOPE_WORKGROUP); }
        } else if (tid < 32) { st[32 + tid] = 256u; st[96 + tid] = 0u; }
        __syncthreads();
    }
#ifdef DIAG_SLOW
    if (slow && tid == 0) __hip_atomic_fetch_add(P.dbg, 1u, RLX_AGENT);
#endif
    if (slow) {
    for (;;) {
        ++level;
        for (int u = tid; u < 32 * HS; u += NTHR) hist[u] = 0u;
        if (tid == 0) st[128] = 0u;
        __syncthreads();
        {
            const unsigned qa = st[r32], qlen = st[192 + r32], base1 = st[160 + r32]; const float cq = __builtin_bit_cast(float, st[224 + r32]);
            const int sh = (level > 1 && qlen > 512u) ? (32 - __builtin_clz(qlen - 1u)) - 9 : 0;
            LAS unsigned* hrow = hist + r32 * HS;
            bf16x8 kn[2][4]; if (wave < npair) { IDX_KLOAD2(wave) }
            for (int tp = wave; tp < npair; tp += NWAVES) {
                IDX_SCORES2(tp)
                if (level == 1) {
#pragma unroll
                    for (int i = 0; i < 16; ++i) { const unsigned k0 = mono_key(sc0[i] + cq), k1 = mono_key(sc1[i] + cq);
                        const unsigned b0 = min((max(k0, base1) - base1) >> 17, 511u), b1 = min((max(k1, base1) - base1) >> 17, 511u);
                        __hip_atomic_fetch_add(&hrow[b0], 1u, __ATOMIC_RELAXED, __HIP_MEMORY_SCOPE_WORKGROUP); __hip_atomic_fetch_add(&hrow[b1], 1u, __ATOMIC_RELAXED, __HIP_MEMORY_SCOPE_WORKGROUP); }
                } else {
#pragma unroll
                    for (int i = 0; i < 16; ++i) { const unsigned o0 = mono_key(sc0[i] + cq) - qa, o1 = mono_key(sc1[i] + cq) - qa;
                        if (o0 < qlen) __hip_atomic_fetch_add(&hrow[o0 >> sh], 1u, __ATOMIC_RELAXED, __HIP_MEMORY_SCOPE_WORKGROUP);
                        if (o1 < qlen) __hip_atomic_fetch_add(&hrow[o1 >> sh], 1u, __ATOMIC_RELAXED, __HIP_MEMORY_SCOPE_WORKGROUP); }
                }
            }
        }
        __syncthreads();
        {
            const int q = tid >> 4, seg = tid & 15;
            unsigned segsum = 0u;
            for (int wi = 0; wi < 32; ++wi) segsum += hist[q * HS + seg * 32 + wi];
            unsigned S = segsum;
            S = row16_suffix(S);
            const unsigned above = S - segsum, need = st[32 + q];
            if (above < need && need <= above + segsum) {
                unsigned cum = above, fbin = 0u, fneed = 1u, fcnt = 0u; bool found = false;
                for (int wi = 31; wi >= 0; --wi) { const unsigned c = hist[q * HS + seg * 32 + wi];
                    if (!found && cum + c >= need) { found = true; fbin = (unsigned)wi; fneed = need - cum; fcnt = c; } if (!found) cum += c; }
                fbin += 32u * (unsigned)seg;
                unsigned na, nlen;
                if (level == 1) { const unsigned base1 = st[160 + q];
                    if (fbin == 0u) { na = 0u; nlen = base1 + 131072u; } else if (fbin == 511u) { na = base1 + 511u * 131072u; nlen = 0u - na; } else { na = base1 + fbin * 131072u; nlen = 131072u; } }
                else { const unsigned qa = st[q], qlen = st[192 + q]; const int sh = qlen > 512u ? (32 - __builtin_clz(qlen - 1u)) - 9 : 0;
                    na = qa + (fbin << sh); nlen = min(1u << sh, qlen - (fbin << sh)); }
                st[q] = na; st[192 + q] = nlen; st[32 + q] = fneed; st[64 + q] = fcnt;
                if (fcnt > (unsigned)CAND_CAP && nlen > 1u) st[128] = 1u;
            }
        }
        __syncthreads();
#ifndef MAXLVL
#define MAXLVL 8
#endif
        const bool more = (st[128] != 0u) && (level < MAXLVL);
        __syncthreads();
        if (!more) break;
    }
    {
        const unsigned qa = st[r32], qlen = st[192 + r32]; const float cq = __builtin_bit_cast(float, st[224 + r32]);
        const unsigned Hk = qa + qlen - 1u;
        unsigned hb = (Hk & 0x80000000u) ? (Hk ^ 0x80000000u) : ~Hk;
        if (hb == 0x80000000u) hb = 0x80000001u;
        const float fH = __builtin_bit_cast(float, hb);
        const unsigned ab_ = (qa & 0x80000000u) ? (qa ^ 0x80000000u) : ~qa;
        const float fA = (qa < 0x00800000u) ? -__builtin_inff() : __builtin_bit_cast(float, ab_);
        bf16x8 kn[2][4]; if (wave < npair) { IDX_KLOAD2(wave) }
        for (int tp = wave; tp < npair; tp += NWAVES) {
            IDX_SCORES2(tp)
#define IDX_COLLECT_ELEMS(SC, T) { unsigned v = 0u; _Pragma("unroll") for (int i = 15; i >= 0; --i) { const float ts = SC[i] + cq; const bool ab = ts > fH; v = v + v + (ab ? 1u : 0u); \
                if (!ab && ts >= fA) { const unsigned key = mono_key(ts); \
                    const unsigned pos = __hip_atomic_fetch_add(&st[96 + r32], 1u, __ATOMIC_RELAXED, __HIP_MEMORY_SCOPE_WORKGROUP); \
                    if (pos < (unsigned)CAND_CAP) { cand[(r32 * CAND_CAP + pos) * 2] = key; cand[(r32 * CAND_CAP + pos) * 2 + 1] = (unsigned)(32 * (T) + crow(i, hi)); } } } \
            unsigned bits = (v & 0xfu) | ((v & 0xf0u) << 4) | ((v & 0xf00u) << 8) | ((v & 0xf000u) << 12);     \
            bits <<= 4 * hi; bits = half_or(bits); if (hi == 0) img[(T) * 32 + r32] = bits; }
            IDX_COLLECT_ELEMS(sc0, 2 * tp)
            IDX_COLLECT_ELEMS(sc1, 2 * tp + 1)
#undef IDX_COLLECT_ELEMS
        }
    }
#undef IDX_SCORES2
#undef IDX_KLOAD2
    __syncthreads();
    {
        const int q = tid >> 4; const unsigned n = min(st[96 + q], (unsigned)CAND_CAP), need = st[32 + q];
        for (unsigned c = tid & 15; c < n; c += 16) { const unsigned key = cand[(q * CAND_CAP + c) * 2], idx = cand[(q * CAND_CAP + c) * 2 + 1]; unsigned rank = 0u;
            for (unsigned o = 0; o < n; ++o) { const unsigned k2 = cand[(q * CAND_CAP + o) * 2], i2 = cand[(q * CAND_CAP + o) * 2 + 1]; rank += (k2 > key || (k2 == key && i2 < idx)) ? 1u : 0u; }
            if (rank < need) __hip_atomic_fetch_or(&img[(idx >> 5) * 32 + q], 1u << (idx & 31), __ATOMIC_RELAXED, __HIP_MEMORY_SCOPE_WORKGROUP); }
    }
    }
    __syncthreads();
    for (int idx = tid; idx < ntile * 32; idx += NTHR) P.BM[((size_t)b * 256 + (idx >> 5)) * SEQ + q0 + (idx & 31)] = img[idx];
    __syncthreads();
}

__device__ __forceinline__ int wq_next(Frame& F, int cw) {
    __syncthreads();
    if (F_TID == 0) F.MISC[0] = __hip_atomic_fetch_add((unsigned*)(F.ctl + cw), 1u, RLX_AGENT);
    __syncthreads();
    return (int)F.MISC[0];
}

__device__ __forceinline__ void p5a_route(Frame& F, const Args& A) {
    const int lane = F_LANE, tid = F_TID, wave = F_WAVE;
    const float* x1 = A.out; const float* g2 = A.in[11];
    const float* wrg = A.in[12]; const float* brg = A.in[13]; const float* wre = A.in[14]; const float* bre = A.in[15];
    int* toke = (int*)(F.ws + WS_TOKE); float* tokw = (float*)(F.ws + WS_TOKW); float* rstd2 = (float*)(F.ws + WS_RSTD2);
    int* sslot = (int*)(F.ws + WS_SSLOT);
    constexpr int WST = 44, WCH = 256 * WST * 4;
    LAS float* wl = (LAS float*)F.lds;
    LAS unsigned* lcnt = (LAS unsigned*)(F.lds + 2 * WCH);
    LAS float* lgs = (LAS float*)(F.lds + 2 * WCH + 256);
    for (int i = F.vcu * NTHR + tid; i < SORT_ROWS; i += F.G * NTHR) sslot[i] = -1;
    if (tid < NEXP) lcnt[tid] = 0u;
    const int i16 = lane & 15, kq = lane >> 4, tile = wave & 3, half = wave >> 2;
    const int per = T / F.G;
    for (int t0 = F.vcu * per; t0 < (F.vcu + 1) * per; t0 += 64) {
        const float* xr = x1 + (size_t)(t0 + 16 * tile + i16) * D + 4 * kq;
        f32x4 acc0 = (f32x4){0.f, 0.f, 0.f, 0.f}, acc1 = acc0; float ss = 0.f;
        f32x4 se[4], sg; float gk[5];
#define RT_LOAD(c) do { _Pragma("unroll") for (int q = 0; q < 4; ++q) { const int f = tid + 512 * q, k = f >> 3; se[q] = *(const GAS f32x4*)(wre + (size_t)(256 * (c) + k) * 32 + 4 * (f & 7)); gk[q] = g2[256 * (c) + k]; } \
            { const int k = tid >> 1; sg = *(const GAS f32x4*)(wrg + (size_t)(256 * (c) + k) * 8 + 4 * (tid & 1)); gk[4] = g2[256 * (c) + k]; } } while (0)
#define RT_WRITE(bf) do { LAS float* wb = wl + (bf) * (WCH / 4); _Pragma("unroll") for (int q = 0; q < 4; ++q) { const int f = tid + 512 * q, k = f >> 3; *(LAS f32x4*)(wb + k * WST + 4 * (f & 7)) = se[q] * gk[q]; } \
            { const int k = tid >> 1; *(LAS f32x4*)(wb + k * WST + 32 + 4 * (tid & 1)) = sg * gk[4]; } } while (0)
        RT_LOAD(0); RT_WRITE(0); __syncthreads();
        for (int c = 0; c < 4; ++c) {
            if (c + 1 < 4) RT_LOAD(c + 1);
            const LAS float* wb = wl + (c & 1) * (WCH / 4) + 4 * kq * WST + i16 + 16 * half;
#pragma unroll 4
            for (int s = 0; s < 16; ++s) {
                const f32x4 a4 = *(const GAS f32x4*)(xr + 256 * c + 16 * s);
                if (half == 0) ss += (a4.x * a4.x + a4.y * a4.y) + (a4.z * a4.z + a4.w * a4.w);
#pragma unroll
                for (int cc = 0; cc < 4; ++cc) { const LAS float* wp = wb + (16 * s + cc) * WST;
                    acc0 = __builtin_amdgcn_mfma_f32_16x16x4f32(a4[cc], wp[0], acc0, 0, 0, 0);
                    if (half == 0) acc1 = __builtin_amdgcn_mfma_f32_16x16x4f32(a4[cc], wp[32 - (i16 & 8)], acc1, 0, 0, 0); }
            }
            if (c + 1 < 4) RT_WRITE((c + 1) & 1);
            __syncthreads();
        }
#undef RT_LOAD
#undef RT_WRITE
        LAS float* lt = lgs + tile * 640;
#pragma unroll
        for (int r = 0; r < 4; ++r) { const int tk = 4 * kq + r; lt[tk * 40 + 8 + 16 * half + i16] = acc0[r]; if (half == 0 && i16 < 8) lt[tk * 40 + i16] = acc1[r]; }
        if (half == 0) { ss += __shfl_xor(ss, 16); ss += __shfl_xor(ss, 32); if (kq == 0) lgs[2560 + 16 * tile + i16] = 1.f / sqrtf(ss * (1.f / D) + EPS); }
        __syncthreads();
        if (half == 0 && lane < 16) {
            const int m = t0 + 16 * tile + lane; const float rstd = lgs[2560 + 16 * tile + lane]; const LAS float* lg = lt + lane * 40;
            float gl[8];
#pragma unroll
            for (int k = 0; k < 8; ++k) gl[k] = lg[k] * rstd + brg[k];
            int gs = 0; float gm = gl[0];
#pragma unroll
            for (int k = 1; k < 8; ++k) if (gl[k] > gm) { gm = gl[k]; gs = k; }
            float den = 0.f;
#pragma unroll
            for (int k = 0; k < 8; ++k) den += __expf(gl[k] - gm);
            const float wgrp = 1.f / den;
            float el[4];
#pragma unroll
            for (int cc = 0; cc < 4; ++cc) el[cc] = lg[8 + 4 * gs + cc] * rstd + bre[4 * gs + cc];
            int i1 = 0; float v1 = el[0];
#pragma unroll
            for (int cc = 1; cc < 4; ++cc) if (el[cc] > v1) { v1 = el[cc]; i1 = cc; }
            int i2 = -1; float v2 = 0.f;
#pragma unroll
            for (int cc = 0; cc < 4; ++cc) if (cc != i1 && (i2 < 0 || el[cc] > v2)) { v2 = el[cc]; i2 = cc; }
            const float e2 = __expf(v2 - v1), w1 = 1.f / (1.f + e2), w2 = e2 / (1.f + e2);
            toke[2 * m] = gs * 4 + i1; toke[2 * m + 1] = gs * 4 + i2; tokw[2 * m] = w1 * wgrp; tokw[2 * m + 1] = w2 * wgrp; rstd2[m] = rstd;
            __hip_atomic_fetch_add(&lcnt[gs * 4 + i1], 1u, __ATOMIC_RELAXED, __HIP_MEMORY_SCOPE_WORKGROUP);
            __hip_atomic_fetch_add(&lcnt[gs * 4 + i2], 1u, __ATOMIC_RELAXED, __HIP_MEMORY_SCOPE_WORKGROUP);
        }
        __syncthreads();
    }
    if (tid < NEXP && lcnt[tid]) __hip_atomic_fetch_add((unsigned*)(F.ctl + CW_CNT + tid), lcnt[tid], RLX_AGENT);
}

__device__ __forceinline__ void p5a2_scatter(Frame& F, const Args& A) {
    const int lane = F_LANE, tid = F_TID;
    const float* x1 = A.out; const float* g2 = A.in[11];
    const int* toke = (const int*)(F.ws + WS_TOKE); const float* tokw = (const float*)(F.ws + WS_TOKW); const float* rstd2 = (const float*)(F.ws + WS_RSTD2);
    int* sslot = (int*)(F.ws + WS_SSLOT); float* sw = (float*)(F.ws + WS_SW); int* t2e = (int*)(F.ws + WS_T2E);
    bf16* AS = (bf16*)(F.ws + WS_ASORT);
    LAS unsigned* sh = (LAS unsigned*)F.lds;
    if (tid < NEXP) sh[256 + tid] = __hip_atomic_load((unsigned*)(F.ctl + CW_CNT + tid), RLX_AGENT);
    __syncthreads();
    if (tid == 0) { unsigned acc = 0u;
        for (int e = 0; e < NEXP; ++e) { const unsigned c = sh[256 + e]; sh[e] = acc; const unsigned nt = (c + 255u) / 256u;
            if (blockIdx.x == 0) for (unsigned i = 0; i < nt; ++i) t2e[acc / 256u + i] = e;
            acc += nt * 256u; }
        if (blockIdx.x == 0) t2e[255] = (int)(acc / 256u); }
    const int per = T / F.G;
    for (int t0 = F.vcu * per; t0 < (F.vcu + 1) * per; t0 += 64) {
        if (tid < NEXP) sh[32 + tid] = 0u;
        __syncthreads();
        int e = 0; unsigned lpos = 0u;
        if (tid < 128) { e = toke[2 * t0 + tid]; lpos = __hip_atomic_fetch_add(&sh[32 + e], 1u, __ATOMIC_RELAXED, __HIP_MEMORY_SCOPE_WORKGROUP); }
        __syncthreads();
        if (tid < NEXP) sh[64 + tid] = sh[tid] + (sh[32 + tid] ? __hip_atomic_fetch_add((unsigned*)(F.ctl + CW_FILL + tid), sh[32 + tid], RLX_AGENT) : 0u);
        __syncthreads();
        if (tid < 128) { const unsigned pos = sh[64 + e] + lpos; sh[96 + tid] = pos; sslot[pos] = 2 * t0 + tid; sw[pos] = tokw[2 * t0 + tid]; }
        __syncthreads();
        for (int tk0 = F_WAVE; tk0 < 64; tk0 += 4 * NWAVES) {
            f32x4 xv[4][4];
#pragma unroll
            for (int r = 0; r < 4; ++r) { const GAS f32x4* xr = (const GAS f32x4*)(x1 + (size_t)(t0 + tk0 + r * NWAVES) * D) + lane;
#pragma unroll
                for (int j = 0; j < 4; ++j) xv[r][j] = xr[64 * j]; }
#pragma unroll
            for (int r = 0; r < 4; ++r) { const int tk = tk0 + r * NWAVES, m = t0 + tk; const float rstd = rstd2[m];
                const unsigned p0 = sh[96 + 2 * tk], p1 = sh[96 + 2 * tk + 1];
#pragma unroll
                for (int j = 0; j < 4; ++j) { const f32x4 g = *((const GAS f32x4*)g2 + lane + 64 * j); const f32x4 y = xv[r][j] * rstd * g; v2u w; w.x = pk2(y.x, y.y); w.y = pk2(y.z, y.w);
                    *((GAS v2u*)(AS + (size_t)p0 * D) + lane + 64 * j) = w; *((GAS v2u*)(AS + (size_t)p1 * D) + lane + 64 * j) = w; } } }
        __syncthreads();
    }
}

__device__ __forceinline__ void p6_final(Frame& F, const Args& A) {
    const int gw = F.vcu * NWAVES + F_WAVE, NGW = F.G * NWAVES, lane = F_LANE;
    const float* gf = A.in[19]; float* out = A.out; const bf16* SL = (const bf16*)(F.ws + WS_SLOTS);
    for (int m0 = gw; m0 < T; m0 += 2 * NGW) {
        f32x4 v[2][4]; v2u a[2][4], c[2][4];
#pragma unroll
        for (int r = 0; r < 2; ++r) { const int m = min(m0 + r * NGW, T - 1); const GAS f32x4* xr = (const GAS f32x4*)(out + (size_t)m * D) + lane;
            const GAS v2u* s0 = (const GAS v2u*)(SL + (size_t)(2 * m) * D) + lane; const GAS v2u* s1 = (const GAS v2u*)(SL + (size_t)(2 * m + 1) * D) + lane;
#pragma unroll
            for (int j = 0; j < 4; ++j) { v[r][j] = xr[64 * j]; a[r][j] = s0[64 * j]; c[r][j] = s1[64 * j]; } }
#pragma unroll
        for (int r = 0; r < 2; ++r) { const int m = m0 + r * NGW; float s = 0.f;
#pragma unroll
            for (int j = 0; j < 4; ++j) { f32x4& w = v[r][j];
                w.x += bflo(a[r][j].x) + bflo(c[r][j].x); w.y += bfhi(a[r][j].x) + bfhi(c[r][j].x); w.z += bflo(a[r][j].y) + bflo(c[r][j].y); w.w += bfhi(a[r][j].y) + bfhi(c[r][j].y);
                s += (w.x * w.x + w.y * w.y) + (w.z * w.z + w.w * w.w); }
            const float rstd = 1.f / sqrtf(wave_sum(s) * (1.f / D) + EPS);
            if (m < T) { GAS f32x4* xo = (GAS f32x4*)(out + (size_t)m * D) + lane;
#pragma unroll
                for (int j = 0; j < 4; ++j) { const f32x4 g = *((const GAS f32x4*)gf + lane + 64 * j); xo[64 * j] = v[r][j] * rstd * g; } } }
    }
}

constexpr int NPHASE = 13;
__global__ void __launch_bounds__(NTHR, 2) mk_fwd(Args args) {
    extern __shared__ __attribute__((aligned(16))) unsigned char lds[];
    Frame F;
    F.lds = (LAS unsigned char*)lds; F.MISC = (volatile LAS unsigned*)(F.lds + MISC_OFF);
        F.G = gridDim.x; { const int bx = blockIdx.x; F.vcu = (F.G % 8 == 0) ? (bx % 8) * (F.G / 8) + bx / 8 : bx; }
    F.ws = args.ws; F.ctl = (gu32*)(args.ws + WS_CTL);
    unsigned char* ws = args.ws;
    if (F_TID < 128) F.MISC[F_TID] = 0u;
    __syncthreads();
    const bool single = (args.ph_hi - args.ph_lo) > 1;
    XcdBarrier bar; bar.bar = (unsigned*)(F.ctl + CW_BAR); bar.x = 0; bar.st = nullptr;
    if (single) bar = xcd_barrier_post((unsigned*)(F.ctl + CW_BAR), F.MISC + 8);
    const int lo = args.ph_lo, hi = args.ph_hi;
#ifdef ONLY
#define IN(k) ((k) == ONLY && lo <= (k) && (k) < hi)
#else
#define IN(k) (lo <= (k) && (k) < hi)
#endif
#ifdef TS_A
#define STAMP(k) do { if (blockIdx.x == 0 && threadIdx.x == 0) ((unsigned long long*)(ws + WS_CTL + 8192))[(k) + 1] = __builtin_amdgcn_s_memrealtime(); } while (0)
#else
#define STAMP(k) do { } while (0)
#endif
#define SEAM(k) do { if (IN((k) + 1)) xcd_barrier(bar); STAMP(k); } while (0)
    const f32x2* rope = (const f32x2*)(ws + WS_ROPE);
    bf16* GA = (bf16*)args.out; bf16* GB = (bf16*)args.out + (size_t)T * 1024;

    STAMP(-1);
    if (IN(0)) { p0_prologue(F, args);
#ifdef REP_P0
        p0_prologue(F, args);
#endif
        SEAM(0); }
    if (IN(1)) {
        pg8::Gemm g{(const bf16*)(ws + WS_H), (const bf16*)(ws + WS_WIN), T, NIN, D, 0}; pg8::StaticOrder S; S.init(T, NIN, F.G, (int)blockIdx.x);
        pg8::EpiIn E{(bf16*)(ws + WS_CQ), (bf16*)(ws + WS_CKV), (bf16*)(ws + WS_QB), (bf16*)(ws + WS_KB), (bf16*)(ws + WS_VB), (bf16*)(ws + WS_QI), (bf16*)(ws + WS_KI), (bf16*)(ws + WS_KR), GA, GB, (float*)(ws + WS_WI), rope, (float*)(ws + WS_PART)};
        pg8::gemm_phase<pg8::EpiIn, pg8::StaticOrder, true, true>(F.lds, g, S, E);
#ifdef REP_P1
        pg8::gemm_phase<pg8::EpiIn, pg8::StaticOrder, true, true>(F.lds, g, S, E);
#endif
#ifdef CONV_AT_P1
        for (;;) { const int c = wq_next(F, CW_Q2); if (c >= CV_QITEMS) break;
            int ltid = threadIdx.x; asm volatile("" : "+v"(ltid));
            const int lw = __builtin_amdgcn_readfirstlane(ltid >> 6); LAS float* scr = (LAS float*)(F.lds + lw * 16640);
            conv_tile2(args, ws, CV_EARLY + 16 * c + lw, CV_EARLY + 16 * c + 8 + lw, scr, ltid & 63); }
#endif
        SEAM(1);
    }
#ifdef P2A_OLD
    if (IN(2)) { p2a_norms(F, args); SEAM(2); }
#endif
    if (IN(3)) {
#ifdef REP_P3
      for (int rep = 0; rep < 2; ++rep) {
#else
      {
#endif
#ifndef NO3A
        { pg8::Gemm g{(const bf16*)(ws + WS_CQ), (const bf16*)(ws + WS_WUQ), T, 768, 384, 0}; pg8::StaticOrder S; S.init(T, 768, F.G, (int)blockIdx.x);
          LAS float* rsl = (LAS float*)(F.lds + 131072);
          { pg8::Unit u0; if (S.next(0, u0) && F_TID < 256) { const f32x4* pp = (const f32x4*)((const float*)(ws + WS_PART) + (size_t)(u0.pm * 256 + F_TID) * 20); const f32x4 a = pp[0], b = pp[1], c = pp[2];
              rsl[F_TID] = C2A / sqrtf(((((a[0] + a[1]) + (a[2] + a[3])) + ((b[0] + b[1]) + (b[2] + b[3]))) + ((c[0] + c[1]) + (c[2] + c[3]))) * (1.f / 384.f) + EPS); } }
          __syncthreads();
          pg8::EpiQA E{(bf16*)(ws + WS_QA), rope, rsl}; pg8::gemm_phase<pg8::EpiQA, pg8::StaticOrder, true, true>(F.lds, g, S, E); }
#endif
#ifndef NO3B
        { pg8::Gemm g{(const bf16*)(ws + WS_CKV), (const bf16*)(ws + WS_WUKV), T, 1024, 256, 0}; pg8::StaticOrder S; S.init(T, 1024, F.G, (int)blockIdx.x);
          LAS float* rsl = (LAS float*)(F.lds + 131072 + 1024);
          { pg8::Unit u0; if (S.next(0, u0) && F_TID < 256) { const f32x4* pp = (const f32x4*)((const float*)(ws + WS_PART) + (size_t)(u0.pm * 256 + F_TID) * 20 + 12); const f32x4 a = pp[0], b = pp[1];
              rsl[F_TID] = 1.f / sqrtf((((a[0] + a[1]) + (a[2] + a[3])) + ((b[0] + b[1]) + (b[2] + b[3]))) * (1.f / 256.f) + EPS); } }
          __syncthreads();
          pg8::EpiKV E{(bf16*)(ws + WS_KN), (bf16*)(ws + WS_VA), rsl}; pg8::gemm_phase<pg8::EpiKV, pg8::StaticOrder, true, true>(F.lds, g, S, E); }
#endif
      }
        SEAM(3);
    }
    if (IN(4)) {
        unsigned* rdy = (unsigned*)(F.ctl + CW_RDY);
#ifndef CONV_AT_P1
        constexpr int NCVQ = CV_QITEMS;
#else
        constexpr int NCVQ = 0;
#endif
        for (;;) { const int k = wq_next(F, CW_Q1); if (k >= 1536 + NCVQ) break;
            int ltid = threadIdx.x; asm volatile("" : "+v"(ltid));
            const int lw = __builtin_amdgcn_readfirstlane(ltid >> 6);
            if (k < 512) { const int ib = k & 1, ij = 255 - (k >> 1);
                const IdxP IP{(const bf16*)(ws + WS_QI), (const bf16*)(ws + WS_KI), (const float*)(ws + WS_WI), (unsigned*)(ws + WS_BM), (unsigned*)(F.ctl + 1024)};
                idx_item(F.lds, ib, ij, IP, ltid, ltid & 63, lw);
#ifdef REP_IDX
                __syncthreads(); idx_item(F.lds, ib, ij, IP, ltid, ltid & 63, lw);
#endif
                VM_WAIT(); __syncthreads();
                if (ltid == 0) { __builtin_amdgcn_fence(__ATOMIC_RELEASE, "agent"); VM_WAIT(); __hip_atomic_fetch_add(rdy + 64 * (ib * 32 + (ij >> 3)), 1u, RLX_AGENT); }
                continue; }
            const int j = k - 512; int a;
            if (j < 3 * NCVQ) { const int q3 = j / 3, r3 = j - 3 * q3; a = (r3 == 2) ? -1 - q3 : 2 * q3 + r3; } else a = j - NCVQ;
            if (a < 0) { const int c = -1 - a; LAS float* scr = (LAS float*)(F.lds + lw * 16640);
                conv_tile2(args, ws, CV_EARLY + 16 * c + lw, CV_EARLY + 16 * c + 8 + lw, scr, ltid & 63);
                continue; }
            { const int u = a >> 1, ub = (u & 15) >> 3, uh = u & 7, uq = 31 - (u >> 4);
                if (a & 1) { const AttnP APA{(const bf16*)(ws + WS_QA), (const bf16*)(ws + WS_KN), (const bf16*)(ws + WS_KR), (const bf16*)(ws + WS_VA), (bf16*)(ws + WS_OA), nullptr};
#ifdef MLA_OLD
                    attn_unit<true>(F.lds, ub, uh, uq, APA, ltid, ltid & 63, lw); }
#else
                    attn_body::attn_unit<8, true>(ub, uh, uq, (const attn_body::bf16*)APA.Q, (const attn_body::bf16*)APA.K, (const attn_body::bf16*)APA.K2, (const attn_body::bf16*)APA.V, (attn_body::bf16*)APA.O, nullptr, (char*)F.lds, ltid); }
#endif
                else { const AttnP APB{(const bf16*)(ws + WS_QB), (const bf16*)(ws + WS_KB), nullptr, (const bf16*)(ws + WS_VB), (bf16*)(ws + WS_OB), (const unsigned*)(ws + WS_BM)};
                    if (ltid == 0) { unsigned sp = 0u; while (__hip_atomic_load(rdy + 64 * (ub * 32 + uq), RLX_AGENT) < 8u) { __builtin_amdgcn_s_sleep(8); if (++sp > (1u << 22)) break; }
                        __builtin_amdgcn_fence(__ATOMIC_ACQUIRE, "agent"); VM_WAIT(); }
                    __syncthreads();
#ifdef DSA_OLD
                    attn_unit<false>(F.lds, ub, uh, uq, APB, ltid, ltid & 63, lw); } }
#else
                    attn_body::attn_unit<8, false>(ub, uh, uq, (const attn_body::bf16*)APB.Q, (const attn_body::bf16*)APB.K, nullptr, (const attn_body::bf16*)APB.V, (attn_body::bf16*)APB.O, APB.BM, (char*)F.lds, ltid); } }
#endif
        }
    }
    if (IN(5)) { SEAM(5); }
    if (IN(6)) {
#ifdef REP_P6
      for (int rep = 0; rep < 2; ++rep) {
#else
      {
#endif
        { pg8::Gemm g{(const bf16*)(ws + WS_OA), (const bf16*)(ws + WS_WOA), T, 1024, 512, 0}; pg8::StaticOrder S; S.init(T, 1024, F.G, (int)blockIdx.x);
          pg8::EpiY<0> E{(bf16*)(ws + WS_Y), GA}; pg8::gemm_phase<pg8::EpiY<0>, pg8::StaticOrder, true, true>(F.lds, g, S, E); }
        { pg8::Gemm g{(const bf16*)(ws + WS_OB), (const bf16*)(ws + WS_WOB), T, 1024, 512, 0}; pg8::StaticOrder S; S.init(T, 1024, F.G, (int)blockIdx.x);
          pg8::EpiY<1> E{(bf16*)(ws + WS_Y), GB}; pg8::gemm_phase<pg8::EpiY<1>, pg8::StaticOrder, true, true>(F.lds, g, S, E); }
      }
        SEAM(6);
    }
    if (IN(7)) {
        pg8::Gemm g{(const bf16*)(ws + WS_Y), (const bf16*)(ws + WS_WOUT), T, 1024, 1024, 0}; pg8::StaticOrder S; S.init(T, 1024, F.G, (int)blockIdx.x);
        pg8::EpiX1 E{args.in[0], args.out}; pg8::gemm_phase<pg8::EpiX1, pg8::StaticOrder, true, true>(F.lds, g, S, E);
#ifdef REP_P7
        pg8::gemm_phase<pg8::EpiX1, pg8::StaticOrder, true, true>(F.lds, g, S, E);
#endif
        SEAM(7);
    }
    if (IN(8)) { p5a_route(F, args); SEAM(8); }
    if (IN(9)) { p5a2_scatter(F, args); SEAM(9); }
#ifdef MOE_TWO_PHASES
    if (IN(10)) {
        const int* t2e = (const int*)(ws + WS_T2E); const int ntl = t2e[255];
        pg8::Gemm g{(const bf16*)(ws + WS_ASORT), (const bf16*)(ws + WS_WGU), SORT_ROWS, 512, 1024, (size_t)512 * 1024 * 2}; pg8::GroupOrder S; S.init(ntl, 2, F.G, (int)blockIdx.x, t2e);
        pg8::EpiHid E{(bf16*)(ws + WS_HID)}; pg8::gemm_phase<pg8::EpiHid, pg8::GroupOrder, true, true>(F.lds, g, S, E);
#ifdef REP_P10
        pg8::gemm_phase<pg8::EpiHid, pg8::GroupOrder, true, true>(F.lds, g, S, E);
#endif
        SEAM(10);
    }
    if (IN(11)) {
        const int* t2e = (const int*)(ws + WS_T2E); const int ntl = t2e[255];
        pg8::Gemm g{(const bf16*)(ws + WS_HID), (const bf16*)(ws + WS_WD), SORT_ROWS, 1024, 256, (size_t)1024 * 256 * 2}; pg8::GroupOrder S; S.init(ntl, 4, F.G, (int)blockIdx.x, t2e);
        pg8::EpiDown E{(bf16*)(ws + WS_SLOTS), (const int*)(ws + WS_SSLOT), (const float*)(ws + WS_SW)}; pg8::gemm_phase<pg8::EpiDown, pg8::GroupOrder, true, true>(F.lds, g, S, E);
#ifdef REP_P11
        pg8::gemm_phase<pg8::EpiDown, pg8::GroupOrder, true, true>(F.lds, g, S, E);
#endif
        SEAM(11);
    }
#else
    if (IN(10)) {
        const int* t2e = (const int*)(ws + WS_T2E); const int ntl = t2e[255], n10 = 2 * ntl, n11 = 4 * ntl;
        unsigned* hrdy = (unsigned*)(F.ctl + CW_HRDY);
        const pg8::Gemm g10{(const bf16*)(ws + WS_ASORT), (const bf16*)(ws + WS_WGU), SORT_ROWS, 512, 1024, (size_t)512 * 1024 * 2};
        const pg8::Gemm g11{(const bf16*)(ws + WS_HID), (const bf16*)(ws + WS_WD), SORT_ROWS, 1024, 256, (size_t)1024 * 256 * 2};
        const pg8::EpiHid E10{(bf16*)(ws + WS_HID)}; const pg8::EpiDown E11{(bf16*)(ws + WS_SLOTS), (const int*)(ws + WS_SSLOT), (const float*)(ws + WS_SW)};
        for (;;) { const int k = wq_next(F, CW_Q3); if (k >= n10 + n11) break;
            if (k < n10) { const int pm = k >> 1; pg8::OneUnit S{pm, k & 1, __builtin_amdgcn_readfirstlane(t2e[pm])};
                pg8::gemm_phase<pg8::EpiHid, pg8::OneUnit, true, true>(F.lds, g10, S, E10);
                VM_WAIT(); __syncthreads();
                if (F_TID == 0) { __builtin_amdgcn_fence(__ATOMIC_RELEASE, "agent"); VM_WAIT(); __hip_atomic_fetch_add(hrdy + 64 * pm, 1u, RLX_AGENT); }
            } else { const int j = k - n10, pm = j >> 2; pg8::OneUnit S{pm, j & 3, __builtin_amdgcn_readfirstlane(t2e[pm])};
                if (F_TID == 0) { unsigned sp = 0u; while (__hip_atomic_load(hrdy + 64 * pm, RLX_AGENT) < 2u) { __builtin_amdgcn_s_sleep(8); if (++sp > (1u << 22)) break; }
                    __builtin_amdgcn_fence(__ATOMIC_ACQUIRE, "agent"); VM_WAIT(); }
                __syncthreads();
                pg8::gemm_phase<pg8::EpiDown, pg8::OneUnit, true, true>(F.lds, g11, S, E11);
            }
        }
    }
    if (IN(11)) { SEAM(11); }
#endif
    if (IN(12)) { p6_final(F, args); }
#ifdef DIAG_SLOW
    if (blockIdx.x == 0 && threadIdx.x == 0) { const unsigned long long t0 = __builtin_amdgcn_s_memrealtime(), wait = 100ull * __hip_atomic_load((unsigned*)(F.ctl + 1024), RLX_AGENT);
        while (__builtin_amdgcn_s_memrealtime() - t0 < wait) __builtin_amdgcn_s_sleep(16); }
#endif
#ifdef TS_A
    if (blockIdx.x == 0 && threadIdx.x == 0) { STAMP(12); __builtin_amdgcn_s_waitcnt(0);
        const unsigned long long* tsp = (const unsigned long long*)(ws + WS_CTL + 8192);
        const unsigned long long ta = __hip_atomic_load(tsp + (TS_A) + 1, RLX_AGENT), tb = __hip_atomic_load(tsp + (TS_B) + 1, RLX_AGENT);
        const unsigned long long t0 = __builtin_amdgcn_s_memrealtime(), wait = 4ull * (tb - ta);
        while (__builtin_amdgcn_s_memrealtime() - t0 < wait) __builtin_amdgcn_s_sleep(16); }
#endif
#undef IN
#undef SEAM
}

#ifndef MK_MULTI
#define MK_MULTI 0
#endif
extern "C" void kernel_launch(void* const* d_in, const int* in_sizes, int n_in, void* d_out, int out_size, void* d_ws, size_t ws_size, hipStream_t stream) {
    static int grid = 0;
    if (grid == 0) {
        if (n_in != 20 || in_sizes[0] != T * D || out_size != T * D || ws_size < WS_END) { fprintf(stderr, "kernel_launch: unexpected shapes n_in %d in0 %d out %d ws %zu\n", n_in, n_in > 0 ? in_sizes[0] : -1, out_size, ws_size); grid = -1; return; }
        int dev = 0, cus = 0;
        if (hipGetDevice(&dev) != hipSuccess || hipDeviceGetAttribute(&cus, hipDeviceAttributeMultiprocessorCount, dev) != hipSuccess) { grid = -1; return; }
        if (hipFuncSetAttribute((const void*)mk_fwd, hipFuncAttributeMaxDynamicSharedMemorySize, LDS_BYTES) != hipSuccess) { fprintf(stderr, "kernel_launch: hipFuncSetAttribute failed\n"); grid = -1; return; }
        (void)hipGetLastError();
        grid = cus;
    }
    if (grid < 0) return;
    if (hipMemsetAsync((char*)d_ws + WS_CTL, 0, CTL_ZERO_BYTES, stream) != hipSuccess) return;
    Args a{};
    for (int i = 0; i < 20; ++i) a.in[i] = (const float*)d_in[i];
    a.out = (float*)d_out; a.ws = (unsigned char*)d_ws;
#if MK_MULTI
    for (int p = 0; p < NPHASE; ++p) { a.ph_lo = p; a.ph_hi = p + 1; hipLaunchKernelGGL(mk_fwd, dim3(grid), dim3(NTHR), LDS_BYTES, stream, a); }
#else
    a.ph_lo = 0; a.ph_hi = NPHASE;
    hipLaunchKernelGGL(mk_fwd, dim3(grid), dim3(NTHR), LDS_BYTES, stream, a);
#endif
}
```

```cpp
#include <hip/hip_runtime.h>
#include <hip/hip_bf16.h>
#include <cstdio>
#include <cstdint>

#define GAS __attribute__((address_space(1)))
#define LAS __attribute__((address_space(3)))
typedef unsigned short bf16;
typedef unsigned v4u __attribute__((ext_vector_type(4)));
typedef unsigned v2u __attribute__((ext_vector_type(2)));
typedef float f32x4 __attribute__((ext_vector_type(4)));
typedef float f32x2 __attribute__((ext_vector_type(2)));
typedef float f32x16 __attribute__((ext_vector_type(16)));
typedef short bf16x8 __attribute__((ext_vector_type(8)));
typedef short s16x4 __attribute__((ext_vector_type(4)));
typedef __bf16 bf16x2_t __attribute__((ext_vector_type(2)));
typedef GAS unsigned gu32;
#define RLX_AGENT __ATOMIC_RELAXED, __HIP_MEMORY_SCOPE_AGENT
#define LDS_WAIT() asm volatile("s_waitcnt lgkmcnt(0)" ::: "memory")
#define VM_WAIT() asm volatile("s_waitcnt vmcnt(0)" ::: "memory")

constexpr int NWAVES = 8, NTHR = NWAVES * 64;
constexpr int BATCH = 2, SEQ = 8192, D = 1024, T = BATCH * SEQ;
constexpr float EPS = 1e-6f;
constexpr int NIN = 4864, NIN_SRC = 4840;
constexpr int C_CQ = 0, C_CKV = 384, C_QB = 640, C_KB = 1152, C_VB = 1664, C_QI = 2176, C_KR = 2688, C_KI = 2720, C_WI = 2784, C_GA = 2816, C_GB = 3840;
constexpr int NEXP = 32, FF = 256;
constexpr int SORT_ROWS = 2 * T + NEXP * 256;
constexpr float LOG2E = 1.4426950408889634f;
constexpr float C2A = 0.10206207261596575f * LOG2E;
constexpr float C2B = 0.125f * LOG2E;
constexpr float WI_SCALE = 0.35355339059327373f * 0.125f;

constexpr size_t MiB = 1u << 20, KiB = 1u << 10;
constexpr size_t WS_CTL = 0, CTL_ZERO_BYTES = 1 * MiB;
constexpr size_t WS_ROPE = 1 * MiB;
constexpr size_t WS_WI = 2 * MiB;
constexpr size_t WS_TOKE = 2 * MiB + 512 * KiB;
constexpr size_t WS_TOKW = WS_TOKE + 128 * KiB;
constexpr size_t WS_RSTD2 = WS_TOKW + 128 * KiB;
constexpr size_t WS_SSLOT = 3 * MiB + 512 * KiB;
constexpr size_t WS_SW = WS_SSLOT + 192 * KiB;
constexpr size_t WS_T2E = WS_SW + 192 * KiB;
constexpr size_t WS_WIN = 4 * MiB, WS_WUQ = 14 * MiB, WS_WUKV = 15 * MiB, WS_WOA = 16 * MiB, WS_WOB = 17 * MiB, WS_WOUT = 18 * MiB, WS_WGU = 20 * MiB, WS_WD = 52 * MiB;
constexpr size_t WS_H = 68 * MiB, WS_OA = 68 * MiB, WS_OB = 84 * MiB;
constexpr size_t WS_QA = 100 * MiB, WS_KN = 124 * MiB, WS_VA = 140 * MiB, WS_Y = 100 * MiB;
constexpr size_t WS_QB = 156 * MiB, WS_KB = 172 * MiB, WS_VB = 188 * MiB;
constexpr size_t WS_CQ = 204 * MiB, WS_CKV = 216 * MiB, WS_BM = 204 * MiB;
constexpr size_t WS_QI = 224 * MiB, WS_KI = 240 * MiB, WS_KR = 242 * MiB;
constexpr size_t WS_ASORT = 68 * MiB, WS_SLOTS = 156 * MiB, WS_HID = 220 * MiB;
constexpr size_t WS_PART = 244 * MiB;
constexpr size_t WS_END = 256 * MiB;
constexpr int CW_BAR = 4096;
constexpr int CW_Q1 = 64, CW_Q2 = 128;
constexpr int CW_CNT = 256, CW_FILL = 320;
constexpr int CW_Q3 = 192, CW_HRDY = 16384;
constexpr int CW_RDY = 8192;

constexpr int LDS_BYTES = 147456;
constexpr int MISC_OFF = 147456 - 512;

__device__ __forceinline__ unsigned f2bf(float f) { unsigned u = __builtin_bit_cast(unsigned, f); return (u + 0x7fffu + ((u >> 16) & 1u)) >> 16; }
__device__ __forceinline__ unsigned pk2(float lo, float hi) { f32x2 v = {lo, hi}; bf16x2_t b = __builtin_convertvector(v, bf16x2_t); return __builtin_bit_cast(unsigned, b); }
__device__ __forceinline__ float bflo(unsigned w) { return __builtin_bit_cast(float, w << 16); }
__device__ __forceinline__ float bfhi(unsigned w) { return __builtin_bit_cast(float, w & 0xffff0000u); }

#define XB_TMO      128
#define XB_XCNT(j)  (256  + 64 * (j))
#define XB_XSUB(j)  (1280 + 64 * (j))
#define XB_XGEN(j)  (2304 + 64 * (j))
#define XB_TOP      3328
#define XB_TOPGEN   3392
#define XCD_BAR_WORDS 3456
#define XB_SPIN_CAP (1u << 22)
__device__ __forceinline__ unsigned xb_ld(unsigned* p)              { return __hip_atomic_load(p, __ATOMIC_RELAXED, __HIP_MEMORY_SCOPE_AGENT); }
__device__ __forceinline__ unsigned xb_add(unsigned* p, unsigned v) { return __hip_atomic_fetch_add(p, v, __ATOMIC_RELAXED, __HIP_MEMORY_SCOPE_AGENT); }
__device__ __forceinline__ unsigned xb_xcc_id() { return (unsigned)__builtin_amdgcn_s_getreg((3 << 11) | 20) & 0xFu; }
#define XB_SPIN(cond, bar) do { unsigned _sp = 0; while (cond) { __builtin_amdgcn_s_sleep(1); \
    if ((++_sp & 255u) == 0u) { if (xb_ld(&(bar)[XB_TMO])) break; if (_sp > XB_SPIN_CAP) { atomicAdd(&(bar)[XB_TMO], 1u); break; } } } } while (0)
struct XcdBarrier { unsigned* bar; unsigned x; volatile LAS unsigned* st; };
__device__ __forceinline__ XcdBarrier xcd_barrier_post(unsigned* bar, volatile LAS unsigned* st) {
    XcdBarrier b; b.bar = bar; b.x = xb_xcc_id(); b.st = st;
    if (threadIdx.x == 0) (void)xb_add(&bar[XB_XCNT(b.x)], 1u);
    return b;
}
__device__ __forceinline__ void xcd_barrier_complete(unsigned* bar, unsigned x, unsigned& nloc, unsigned& nx) {
    const unsigned G = gridDim.x * gridDim.y * gridDim.z;
    unsigned sum, cnt, mine, sp = 0u;
    for (;;) {
        sum = 0u; cnt = 0u; mine = 0u;
#pragma unroll
        for (unsigned j = 0; j < 16; ++j) { const unsigned c = xb_ld(&bar[XB_XCNT(j)]); sum += c; cnt += (c > 0u) ? 1u : 0u; mine = (j == x) ? c : mine; }
        if (sum == G) break;
        __builtin_amdgcn_s_sleep(1);
        if ((++sp & 255u) == 0u) { if (xb_ld(&bar[XB_TMO])) break; if (sp > XB_SPIN_CAP) { atomicAdd(&bar[XB_TMO], 1u); break; } }
    }
    nloc = mine > 0u ? mine : 1u; nx = cnt > 0u ? cnt : 1u;
}
__device__ __forceinline__ void xcd_barrier(const XcdBarrier& b) {
    asm volatile("s_waitcnt vmcnt(0)" ::: "memory");
    __syncthreads();
    if (threadIdx.x == 0) {
        unsigned* bar = b.bar;
        __builtin_amdgcn_s_waitcnt(0);
        unsigned nloc = b.st[0], nx = b.st[1];
        if (nloc == 0u) { xcd_barrier_complete(bar, b.x, nloc, nx); b.st[0] = nloc; b.st[1] = nx; }
        const unsigned old = xb_add(&bar[XB_XSUB(b.x)], 1u);
        const unsigned gen = old / nloc;
        if (old + 1u == (gen + 1u) * nloc) {
            __builtin_amdgcn_fence(__ATOMIC_RELEASE, "agent");
            asm volatile("s_waitcnt vmcnt(0)" ::: "memory");
            const unsigned og = xb_add(&bar[XB_TOP], 1u);
            const unsigned tg = og / nx;
            if (og + 1u == (tg + 1u) * nx) xb_add(&bar[XB_TOPGEN], 1u);
            else XB_SPIN(xb_ld(&bar[XB_TOPGEN]) == tg, bar);
            __builtin_amdgcn_fence(__ATOMIC_ACQUIRE, "agent");
            xb_add(&bar[XB_XGEN(b.x)], 1u);
            asm volatile("s_waitcnt vmcnt(0)" ::: "memory");
        } else {
            XB_SPIN(xb_ld(&bar[XB_XGEN(b.x)]) == gen, bar);
            __builtin_amdgcn_fence(__ATOMIC_ACQUIRE, "agent");
            asm volatile("s_waitcnt vmcnt(0)" ::: "memory");
        }
    }
    __syncthreads();
}

__device__ __forceinline__ float wave_sum(float v) {
#pragma unroll
    for (int o = 1; o < 64; o <<= 1) v += __shfl_xor(v, o);
    return v;
}

namespace pg8 {
#define PG8_LAS __attribute__((address_space(3)))
typedef unsigned short bf16_t;
typedef unsigned u32x4 __attribute__((ext_vector_type(4)));
constexpr int BM = 256, BK = 64, HALF = 128, HTB = HALF * BK * 2, STAGE_BYTES = 8 * HTB, NXCD = 8, WGM = 8;
__host__ __device__ __forceinline__ int lds_byte(int r, int c) { const int st = (r >> 4) * 2 + (c >> 5), rr = r & 15, cc = c & 31, ob = rr * 64 + cc * 2; return st * 1024 + (ob ^ (((ob >> 9) & 1) << 5)); }
__host__ __device__ __forceinline__ void stage_rc(int b, int& R, int& C) { const int st = b / 1024, sb = b % 1024, swz = sb ^ (((sb >> 9) & 1) << 5); R = (st >> 1) * 16 + swz / 64; C = (st & 1) * 32 + (swz % 64) / 2; }
__host__ __device__ __forceinline__ int perm32(int rho) { const int n = rho >> 4, i = rho & 15; return 8 * (i >> 2) + 4 * n + (i & 3); }

struct Unit { int pm, pn, e; };
struct Gemm { const bf16_t* A; const bf16_t* Bt; int M, N, K; size_t estride; };

struct StaticOrder {
    int nM, nN, nwg, G, c;
    __host__ __device__ void init(int M, int N, int G_, int c_) { nM = M / BM; nN = N / BM; nwg = nM * nN; G = G_; c = c_; }
    __host__ __device__ __forceinline__ bool next(int i, Unit& u) const {
        const long L = (long)i * G + c; if (L >= nwg) return false;
        int wgid = (int)L; { const int q = nwg / NXCD, r = nwg % NXCD, xcd = wgid % NXCD, off = wgid / NXCD; wgid = (xcd < r ? xcd * (q + 1) : r * (q + 1) + (xcd - r) * q) + off; }
        const int nig = WGM * nN, gid = wgid / nig, fm = gid * WGM, gsz = (nM - fm) < WGM ? (nM - fm) : WGM;
        u.pm = fm + ((wgid % nig) % gsz); u.pn = (wgid % nig) / gsz; u.e = 0; return true;
    }
    __device__ __forceinline__ void a_ready(const Unit&) const {}
    __device__ __forceinline__ void done(const Unit&) const {}
};
struct OneUnit {
    int pm, pn, e;
    __device__ __forceinline__ bool next(int i, Unit& u) const { if (i != 0) return false; u.pm = pm; u.pn = pn; u.e = e; return true; }
    __device__ __forceinline__ void a_ready(const Unit&) const {}
    __device__ __forceinline__ void done(const Unit&) const {}
};
struct GroupOrder {
    int nN, total, G, c; const int* t2e;
    __device__ void init(int nTiles, int nN_, int G_, int c_, const int* t2e_) { nN = nN_; total = nTiles * nN_; G = G_; c = c_; t2e = t2e_; }
    __device__ bool next(int i, Unit& u) const {
        const long L = (long)i * G + c; if (L >= total) return false;
        u.pm = (int)(L / nN); u.pn = (int)(L % nN); u.e = __builtin_amdgcn_readfirstlane(t2e[u.pm]); return true;
    }
    __device__ __forceinline__ void a_ready(const Unit&) const {}
    __device__ __forceinline__ void done(const Unit&) const {}
};

__device__ __forceinline__ void st8(bf16_t* p, f32x4 v0, f32x4 v1) { u32x4 w; w.x = pk2(v0[0], v0[1]); w.y = pk2(v0[2], v0[3]); w.z = pk2(v1[0], v1[1]); w.w = pk2(v1[2], v1[3]); *(u32x4*)p = w; }
__device__ __forceinline__ void ld8(const bf16_t* p, f32x4& v0, f32x4& v1) { const u32x4 w = *(const u32x4*)p; v0 = (f32x4){bflo(w.x), bfhi(w.x), bflo(w.y), bfhi(w.y)}; v1 = (f32x4){bflo(w.z), bfhi(w.z), bflo(w.w), bfhi(w.w)}; }

__device__ __forceinline__ void rope16(f32x4& v0, f32x4& v1, int row, int fq, const f32x2* rope) {
    const f32x2* rp = rope + (size_t)(row & (SEQ - 1)) * 16;
    f32x4 p0, p1;
#pragma unroll
    for (int e = 0; e < 4; ++e) { p0[e] = __shfl_xor(v0[e], 16); p1[e] = __shfl_xor(v1[e], 16); }
    if (fq < 2) {
        const float sg = fq == 0 ? -1.f : 1.f;
#pragma unroll
        for (int e = 0; e < 4; ++e) { const f32x2 a = rp[2 * e], b = rp[2 * (4 + e)];
            v0[e] = v0[e] * a.x + sg * p0[e] * a.y; v1[e] = v1[e] * b.x + sg * p1[e] * b.y; }
    }
}
__device__ __forceinline__ void rope32(f32x4& v0, f32x4& v1, int row, int fq, const f32x2* rope) {
    const f32x2* rp = rope + (size_t)(row & (SEQ - 1)) * 16 + 8 * (fq & 1);
    const float sg = fq < 2 ? -1.f : 1.f;
#pragma unroll
    for (int e = 0; e < 4; ++e) { const float p0 = __shfl_xor(v0[e], 32), p1 = __shfl_xor(v1[e], 32); const f32x2 a = rp[e], b = rp[4 + e];
        v0[e] = v0[e] * a.x + sg * p0 * a.y; v1[e] = v1[e] * b.x + sg * p1 * b.y; }
}
__device__ __forceinline__ float sigmoidf_(float x) { return __builtin_amdgcn_rcpf(1.f + __builtin_amdgcn_exp2f(-1.4426950408889634f * x)); }

struct EpiIn {
    static constexpr bool PERM = true, AFTER_DRAIN = false;
    bf16_t *CQ, *CKV, *QB, *KB, *VB, *QI, *KI, *KR, *GA, *GB; float* WI; const f32x2* rope; float* PART;
    __device__ __forceinline__ void operator()(const f32x4 (&acc)[2][2][4][2], const Unit& u, int wr, int wc, int fr, int fq) const {
        const int row0 = u.pm * BM + wr * 64 + fr;
#pragma unroll
        for (int bj = 0; bj < 2; ++bj) {
            const int cg = u.pn * BM + bj * HALF + wc * 32;
            bf16_t* base = nullptr; int pitch = 0, cc = 0, mode = 0; float sc = 1.f;
            if (cg < C_CKV) { base = CQ; pitch = 384; cc = cg; }
            else if (cg < C_QB) { base = CKV; pitch = 256; cc = cg - C_CKV; }
            else if (cg < C_KB) { base = QB; pitch = 512; cc = cg - C_QB; mode = ((cc >> 5) & 1) == 0 ? 1 : 0; sc = C2B; }
            else if (cg < C_VB) { base = KB; pitch = 512; cc = cg - C_KB; mode = ((cc >> 5) & 1) == 0 ? 1 : 0; }
            else if (cg < C_QI) { base = VB; pitch = 512; cc = cg - C_VB; }
            else if (cg < C_KR) { base = QI; pitch = 512; cc = cg - C_QI; mode = ((cc >> 5) & 1) == 0 ? 1 : 0; }
            else if (cg < C_KI) { base = KR; pitch = 32; cc = 0; mode = 2; }
            else if (cg < C_WI) { base = KI; pitch = 64; cc = cg - C_KI; mode = (cc == 0) ? 1 : 0; }
            else if (cg < C_GA) { mode = 4; }
            else if (cg < C_GB) { base = GA; pitch = 1024; cc = cg - C_GA; mode = 3; }
            else { base = GB; pitch = 1024; cc = cg - C_GB; mode = 3; }
#pragma unroll
            for (int ai = 0; ai < 2; ++ai)
#pragma unroll
                for (int m = 0; m < 4; ++m) {
                    const int row = row0 + ai * HALF + m * 16;
                    f32x4 v0 = acc[ai][bj][m][0], v1 = acc[ai][bj][m][1];
                    if (mode == 1) rope16(v0, v1, row, fq, rope);
                    else if (mode == 2) rope32(v0, v1, row, fq, rope);
                    else if (mode == 3) {
#pragma unroll
                        for (int e = 0; e < 4; ++e) { v0[e] = sigmoidf_(v0[e]); v1[e] = sigmoidf_(v1[e]); } }
                    if (cg < C_QB) {
                        float ss = ((v0[0] * v0[0] + v0[1] * v0[1]) + (v0[2] * v0[2] + v0[3] * v0[3])) + ((v1[0] * v1[0] + v1[1] * v1[1]) + (v1[2] * v1[2] + v1[3] * v1[3]));
                        ss += __shfl_xor(ss, 16); ss += __shfl_xor(ss, 32);
                        if (fq == 0) PART[(size_t)row * 20 + (cg >> 5)] = ss; }
                    if (mode == 4) { if (fq == 0) { *(f32x4*)(WI + (size_t)row * 8) = v0 * WI_SCALE; *(f32x4*)(WI + (size_t)row * 8 + 4) = v1 * WI_SCALE; } }
                    else { v0 = v0 * sc; v1 = v1 * sc; st8(base + (size_t)row * pitch + cc + 8 * fq, v0, v1); }
                }
        }
    }
};
struct EpiQA {
    static constexpr bool PERM = true, AFTER_DRAIN = false;
    bf16_t* QA; const f32x2* rope; const PG8_LAS float* RS;
    __device__ __forceinline__ void operator()(const f32x4 (&acc)[2][2][4][2], const Unit& u, int wr, int wc, int fr, int fq) const {
        const int row0 = u.pm * BM + wr * 64 + fr; const PG8_LAS float* rsp = RS + wr * 64 + fr;
#pragma unroll
        for (int bj = 0; bj < 2; ++bj) {
            const int cg = u.pn * BM + bj * HALF + wc * 32; const bool rot = ((cg >> 5) % 3) == 2;
#pragma unroll
            for (int ai = 0; ai < 2; ++ai)
#pragma unroll
                for (int m = 0; m < 4; ++m) {
                    const int row = row0 + ai * HALF + m * 16;
                    f32x4 v0 = acc[ai][bj][m][0], v1 = acc[ai][bj][m][1];
                    if (rot) rope32(v0, v1, row, fq, rope);
                    { const float rsv = rsp[ai * HALF + m * 16]; v0 = v0 * rsv; v1 = v1 * rsv; } st8(QA + (size_t)row * 768 + cg + 8 * fq, v0, v1);
                }
        }
    }
};
struct EpiKV {
    static constexpr bool PERM = true, AFTER_DRAIN = false;
    bf16_t *KN, *VA; const PG8_LAS float* RS;
    __device__ __forceinline__ void operator()(const f32x4 (&acc)[2][2][4][2], const Unit& u, int wr, int wc, int fr, int fq) const {
        const int row0 = u.pm * BM + wr * 64 + fr; const PG8_LAS float* rsp = RS + wr * 64 + fr;
#pragma unroll
        for (int bj = 0; bj < 2; ++bj) {
            const int cg = u.pn * BM + bj * HALF + wc * 32; bf16_t* base = cg < 512 ? KN : VA; const int cc = (cg & 511) + 8 * fq;
#pragma unroll
            for (int ai = 0; ai < 2; ++ai)
#pragma unroll
                for (int m = 0; m < 4; ++m) { const int row = row0 + ai * HALF + m * 16; const float rsv = rsp[ai * HALF + m * 16]; st8(base + (size_t)row * 512 + cc, acc[ai][bj][m][0] * rsv, acc[ai][bj][m][1] * rsv); }
        }
    }
};
template <int ADD> struct EpiY {
    static constexpr bool PERM = true, AFTER_DRAIN = false;
    bf16_t* Y; const bf16_t* Gt;
    __device__ __forceinline__ void operator()(const f32x4 (&acc)[2][2][4][2], const Unit& u, int wr, int wc, int fr, int fq) const {
        const int row0 = u.pm * BM + wr * 64 + fr;
#pragma unroll
        for (int bj = 0; bj < 2; ++bj) {
            const int c0 = u.pn * BM + bj * HALF + wc * 32 + 8 * fq;
#pragma unroll
            for (int ai = 0; ai < 2; ++ai)
#pragma unroll
                for (int m = 0; m < 4; ++m) { const size_t off = (size_t)(row0 + ai * HALF + m * 16) * 1024 + c0;
                    f32x4 g0, g1; ld8(Gt + off, g0, g1);
                    f32x4 v0 = acc[ai][bj][m][0] * g0, v1 = acc[ai][bj][m][1] * g1;
                    if (ADD) { f32x4 o0, o1; ld8(Y + off, o0, o1); v0 = v0 + o0; v1 = v1 + o1; }
                    st8(Y + off, v0, v1); }
        }
    }
};
struct EpiX1 {
    static constexpr bool PERM = false, AFTER_DRAIN = false;
    const float* X; float* O;
    __device__ __forceinline__ void operator()(const f32x4 (&acc)[2][2][4][2], const Unit& u, int wr, int wc, int fr, int fq) const {
        const int row0 = u.pm * BM + wr * 64 + fr, col0 = u.pn * BM + wc * 32 + 4 * fq;
#pragma unroll
        for (int ai = 0; ai < 2; ++ai)
#pragma unroll
            for (int m = 0; m < 4; ++m) { const size_t off = (size_t)(row0 + ai * HALF + m * 16) * 1024 + col0;
#pragma unroll
                for (int bj = 0; bj < 2; ++bj)
#pragma unroll
                    for (int n = 0; n < 2; ++n) { const f32x4 xv = *(const f32x4*)(X + off + bj * HALF + n * 16); *(f32x4*)(O + off + bj * HALF + n * 16) = xv + acc[ai][bj][m][n]; } }
    }
};
struct EpiHid {
    static constexpr bool PERM = true, AFTER_DRAIN = false;
    bf16_t* HID;
    __device__ __forceinline__ void operator()(const f32x4 (&acc)[2][2][4][2], const Unit& u, int wr, int wc, int fr, int fq) const {
        const int row0 = u.pm * BM + wr * 64 + fr, c0 = u.pn * 128 + wc * 32 + 8 * fq;
#pragma unroll
        for (int ai = 0; ai < 2; ++ai)
#pragma unroll
            for (int m = 0; m < 4; ++m) { f32x4 h0, h1;
#pragma unroll
                for (int e = 0; e < 4; ++e) { const float g0 = acc[ai][0][m][0][e], g1 = acc[ai][0][m][1][e];
                    h0[e] = g0 * sigmoidf_(g0) * acc[ai][1][m][0][e]; h1[e] = g1 * sigmoidf_(g1) * acc[ai][1][m][1][e]; }
                st8(HID + (size_t)(row0 + ai * HALF + m * 16) * 256 + c0, h0, h1); }
    }
};
struct EpiDown {
    static constexpr bool PERM = true, AFTER_DRAIN = false;
    bf16_t* SL; const int* sslot; const float* sw;
    __device__ __forceinline__ void operator()(const f32x4 (&acc)[2][2][4][2], const Unit& u, int wr, int wc, int fr, int fq) const {
        const int row0 = u.pm * BM + wr * 64 + fr;
#pragma unroll
        for (int ai = 0; ai < 2; ++ai)
#pragma unroll
            for (int m = 0; m < 4; ++m) { const int r = row0 + ai * HALF + m * 16; const int slot = sslot[r]; const float w = sw[r];
                if (slot >= 0) {
#pragma unroll
                    for (int bj = 0; bj < 2; ++bj) st8(SL + (size_t)slot * 1024 + u.pn * BM + bj * HALF + wc * 32 + 8 * fq, acc[ai][bj][m][0] * w, acc[ai][bj][m][1] * w); } }
    }
};
template <class Epi, class Sched, bool ALIGN_EPI = false, bool SP2 = false>
__device__ __forceinline__ void gemm_phase(PG8_LAS unsigned char* lds, const Gemm g, const Sched& S, const Epi& E) {
    const int tid = threadIdx.x, wid = __builtin_amdgcn_readfirstlane(tid >> 6), lane = tid & 63, wr = wid >> 2, wc = wid & 3, fr = lane & 15, fq = lane >> 4;
    const int K = g.K, nt = K / BK;
    unsigned voffA[2], voffB[2];
#pragma unroll
    for (int i = 0; i < 2; ++i) { int R, C; stage_rc(tid * 16 + i * 8192, R, C); const int Rb = Epi::PERM ? ((R & ~31) + perm32(R & 31)) : R;
        voffA[i] = (unsigned)(R * K + C) * 2u; voffB[i] = (unsigned)(Rb * K + C) * 2u; }
    const size_t kstep = (size_t)(BK * 2);
    const size_t hstep = (size_t)HALF * K * 2;
    const size_t tstep = 2 * hstep;
    const unsigned ldsw = (unsigned)wid * 1024u;
    const int aoff = lds_byte(wr * 64 + fr, fq * 8), boff = lds_byte(wc * 32 + fr, fq * 8);
#define PG8_SA(b, h) (((b) * 2 + (h)) * HTB)
#define PG8_SB(b, h) ((4 + (b) * 2 + (h)) * HTB)
#define PG8_STAGE(bufoff, gbase, voff) do { _Pragma("unroll") for (int _i = 0; _i < 2; ++_i) \
        __builtin_amdgcn_global_load_lds((const unsigned*)((const char*)(gbase) + (voff)[_i]), (PG8_LAS unsigned*)(lds + (bufoff) + ldsw + _i * 8192), 16, 0, 0); } while (0)
#define PG8_LDA(dst, b, h) do { _Pragma("unroll") for (int m = 0; m < 4; ++m) _Pragma("unroll") for (int k = 0; k < 2; ++k) dst[m][k] = *(const PG8_LAS bf16x8*)(lds + PG8_SA(b, h) + aoff + m * 2048 + k * 1024); } while (0)
#define PG8_LDB(dst, b, h) do { _Pragma("unroll") for (int n = 0; n < 2; ++n) _Pragma("unroll") for (int k = 0; k < 2; ++k) dst[n][k] = *(const PG8_LAS bf16x8*)(lds + PG8_SB(b, h) + boff + n * 2048 + k * 1024); } while (0)
#define PG8_MMA(ai, bj, At, Bt) do { __builtin_amdgcn_s_setprio(1); _Pragma("unroll") for (int m = 0; m < 4; ++m) _Pragma("unroll") for (int n = 0; n < 2; ++n) _Pragma("unroll") for (int k = 0; k < 2; ++k) \
        acc[ai][bj][m][n] = __builtin_amdgcn_mfma_f32_16x16x32_bf16(Bt[n][k], At[m][k], acc[ai][bj][m][n], 0, 0, 0); __builtin_amdgcn_s_setprio(0); } while (0)
#define PG8_WAIT_V(n) asm volatile("s_waitcnt vmcnt(" #n ")" ::: "memory")
#define PG8_WAIT_L(n) asm volatile("s_waitcnt lgkmcnt(" #n ")" ::: "memory")
#define PG8_BAR __builtin_amdgcn_s_barrier()
#define PG8_SCHED __builtin_amdgcn_sched_barrier(0)
    Unit cur, nxt; int ui = 0;
    if (!S.next(0, cur)) return;
    f32x4 acc[2][2][4][2];
#pragma unroll
    for (int a = 0; a < 2; ++a)
#pragma unroll
        for (int b = 0; b < 2; ++b)
#pragma unroll
            for (int m = 0; m < 4; ++m)
#pragma unroll
                for (int n = 0; n < 2; ++n) acc[a][b][m][n] = (f32x4){0.f, 0.f, 0.f, 0.f};
    bf16x8 At[4][2], B0[2][2], B1[2][2];
    const char* cA = (const char*)g.A + (size_t)cur.pm * tstep; const char* cB = (const char*)g.Bt + (size_t)cur.e * g.estride + (size_t)cur.pn * tstep;
    S.a_ready(cur);
    if constexpr (SP2) {
        PG8_STAGE(PG8_SB(0, 0), cB, voffB); PG8_STAGE(PG8_SB(0, 1), cB + hstep, voffB); PG8_STAGE(PG8_SA(0, 0), cA, voffA); PG8_STAGE(PG8_SA(0, 1), cA + hstep, voffA);
        if (wr == 1) PG8_BAR;
        PG8_WAIT_V(2); PG8_BAR;
        PG8_STAGE(PG8_SB(1, 0), cB + kstep, voffB); PG8_STAGE(PG8_SA(1, 0), cA + kstep, voffA); PG8_STAGE(PG8_SB(1, 1), cB + hstep + kstep, voffB);
        PG8_WAIT_V(6); PG8_BAR;
    } else {
        PG8_STAGE(PG8_SB(0, 0), cB, voffB); PG8_STAGE(PG8_SA(0, 0), cA, voffA); PG8_STAGE(PG8_SB(0, 1), cB + hstep, voffB); PG8_STAGE(PG8_SA(0, 1), cA + hstep, voffA);
        if (wr == 1) PG8_BAR;
        PG8_WAIT_V(4); PG8_BAR;
        PG8_STAGE(PG8_SB(1, 0), cB + kstep, voffB); PG8_STAGE(PG8_SA(1, 0), cA + kstep, voffA); PG8_STAGE(PG8_SB(1, 1), cB + hstep + kstep, voffB);
        PG8_WAIT_V(6); PG8_BAR;
    }
    for (;;) {
        const bool has_next = S.next(ui + 1, nxt);
        const char* nA = has_next ? (const char*)g.A + (size_t)nxt.pm * tstep : cA; const char* nB = has_next ? (const char*)g.Bt + (size_t)nxt.e * g.estride + (size_t)nxt.pn * tstep : cB;
#pragma nounroll
        for (int t = 0; t < nt; t += 2) {
            const bool last = (t == nt - 2);
            const char* a1 = cA + (size_t)(t + 1) * kstep;
            const char* a2 = last ? nA : cA + (size_t)(t + 2) * kstep; const char* b2 = last ? nB : cB + (size_t)(t + 2) * kstep;
            const char* a3 = a2 + kstep; const char* b3 = b2 + kstep;
            if (last && has_next) S.a_ready(nxt);
            if constexpr (SP2) {
            PG8_LDB(B0, 0, 0); PG8_LDB(B1, 0, 1); PG8_SCHED; PG8_LDA(At, 0, 0); PG8_STAGE(PG8_SA(1, 1), a1 + hstep, voffA);
            PG8_WAIT_V(8); PG8_WAIT_L(0); PG8_BAR; PG8_MMA(0, 0, At, B0); PG8_MMA(0, 1, At, B1); PG8_BAR; PG8_SCHED;
            PG8_LDA(At, 0, 1); PG8_STAGE(PG8_SB(0, 0), b2, voffB); PG8_STAGE(PG8_SB(0, 1), b2 + hstep, voffB); PG8_STAGE(PG8_SA(0, 0), a2, voffA);
            PG8_WAIT_V(8); PG8_WAIT_L(0); PG8_BAR; PG8_MMA(1, 0, At, B0); PG8_MMA(1, 1, At, B1); PG8_BAR; PG8_SCHED;
            PG8_LDB(B0, 1, 0); PG8_LDB(B1, 1, 1); PG8_SCHED; PG8_LDA(At, 1, 0); PG8_STAGE(PG8_SA(0, 1), a2 + hstep, voffA);
            PG8_WAIT_V(8); PG8_WAIT_L(0); PG8_BAR; PG8_MMA(0, 0, At, B0); PG8_MMA(0, 1, At, B1); PG8_BAR; PG8_SCHED;
            PG8_LDA(At, 1, 1); PG8_STAGE(PG8_SB(1, 0), b3, voffB); PG8_STAGE(PG8_SB(1, 1), b3 + hstep, voffB); PG8_STAGE(PG8_SA(1, 0), a3, voffA);
            PG8_WAIT_V(8); PG8_WAIT_L(0); PG8_BAR; PG8_MMA(1, 0, At, B0); PG8_MMA(1, 1, At, B1); PG8_BAR; PG8_SCHED;
            } else {
            PG8_LDB(B0, 0, 0); PG8_SCHED; PG8_LDA(At, 0, 0); PG8_STAGE(PG8_SA(1, 1), a1 + hstep, voffA);
            PG8_WAIT_L(8); PG8_BAR; PG8_WAIT_L(0); PG8_MMA(0, 0, At, B0); PG8_BAR; PG8_SCHED;
            PG8_LDB(B1, 0, 1); PG8_STAGE(PG8_SB(0, 0), b2, voffB);
            PG8_BAR; PG8_WAIT_L(0); PG8_MMA(0, 1, At, B1); PG8_BAR;
            PG8_LDA(At, 0, 1); PG8_STAGE(PG8_SA(0, 0), a2, voffA);
            PG8_BAR; PG8_WAIT_L(0); PG8_MMA(1, 0, At, B0); PG8_BAR; PG8_SCHED;
            PG8_STAGE(PG8_SB(0, 1), b2 + hstep, voffB);
            PG8_WAIT_V(6); PG8_BAR; PG8_MMA(1, 1, At, B1); PG8_BAR;
            PG8_LDB(B0, 1, 0); PG8_SCHED; PG8_LDA(At, 1, 0); PG8_STAGE(PG8_SA(0, 1), a2 + hstep, voffA);
            PG8_WAIT_L(8); PG8_BAR; PG8_WAIT_L(0); PG8_MMA(0, 0, At, B0); PG8_BAR; PG8_SCHED;
            PG8_LDB(B1, 1, 1); PG8_STAGE(PG8_SB(1, 0), b3, voffB);
            PG8_BAR; PG8_WAIT_L(0); PG8_MMA(0, 1, At, B1); PG8_BAR;
            PG8_LDA(At, 1, 1); PG8_STAGE(PG8_SA(1, 0), a3, voffA);
            PG8_BAR; PG8_WAIT_L(0); PG8_MMA(1, 0, At, B0); PG8_BAR; PG8_SCHED;
            PG8_STAGE(PG8_SB(1, 1), b3 + hstep, voffB);
            PG8_WAIT_V(6); PG8_BAR; PG8_MMA(1, 1, At, B1); PG8_BAR;
            }
        }
        if constexpr (ALIGN_EPI) { if (wr == 0) PG8_BAR; }
        if constexpr (!Epi::AFTER_DRAIN) { E(acc, cur, wr, wc, fr, fq); S.done(cur); }
        if (!has_next) break;
#pragma unroll
        for (int a = 0; a < 2; ++a)
#pragma unroll
            for (int b = 0; b < 2; ++b)
#pragma unroll
                for (int m = 0; m < 4; ++m)
#pragma unroll
                    for (int n = 0; n < 2; ++n) acc[a][b][m][n] = (f32x4){0.f, 0.f, 0.f, 0.f};
        cur = nxt; cA = nA; cB = nB; ++ui;
        if constexpr (ALIGN_EPI) { if (wr == 1) PG8_BAR; }
    }
    PG8_WAIT_V(0);
    if constexpr (!ALIGN_EPI) { if (wr == 0) PG8_BAR; }
    PG8_BAR;
    if constexpr (Epi::AFTER_DRAIN) { E.fused(acc, cur, wr, wc, fr, fq, lds, wid, lane); S.done(cur); }
#undef PG8_SA
#undef PG8_SB
#undef PG8_STAGE
#undef PG8_LDA
#undef PG8_LDB
#undef PG8_MMA
#undef PG8_WAIT_V
#undef PG8_WAIT_L
#undef PG8_BAR
#undef PG8_SCHED
}
}

struct Args { const float* in[20]; float* out; unsigned char* ws; int ph_lo, ph_hi; };
struct Frame {
    LAS unsigned char* lds; volatile LAS unsigned* MISC; gu32* ctl; unsigned char* ws;
    int vcu, G;
};
#define F_TID ((int)threadIdx.x)
#define F_LANE ((int)(threadIdx.x & 63))
#define F_WAVE (__builtin_amdgcn_readfirstlane((int)(threadIdx.x >> 6)))

__device__ __forceinline__ int in_src_col(int n) {
    if (n < 640) return n;
    if (n < 2688) return n + 32;
    if (n < 2720) return n - 2688 + 640;
    if (n < 2792) return n;
    if (n < 2816) return -1;
    return n - 24;
}
struct TrDesc { const float* colptr; int ld, k0; bf16* WT; int Kd, destrow0; const float* gain; };
__device__ __forceinline__ void tr_load(const TrDesc& d, int lane, f32x4 (&v)[16]) {
    const int kr = lane >> 4;
#pragma unroll
    for (int it = 0; it < 16; ++it) { const int kk = 4 * it + kr; v[it] = (f32x4){0.f, 0.f, 0.f, 0.f}; if (d.colptr) v[it] = *(const GAS f32x4*)(d.colptr + (size_t)(d.k0 + kk) * d.ld); if (d.gain) v[it] = v[it] * d.gain[d.k0 + kk]; }
}
__device__ __forceinline__ void tr_store(const TrDesc& d, int lane, const f32x4 (&v)[16], LAS float* scr) {
    const int nq = lane & 15, kr = lane >> 4;
#pragma unroll
    for (int it = 0; it < 16; ++it) { const int kk = 4 * it + kr; LAS float* q = scr + kk * 65 + 4 * nq; q[0] = v[it].x; q[1] = v[it].y; q[2] = v[it].z; q[3] = v[it].w; }
    LDS_WAIT(); asm volatile("" ::: "memory");
    const int c = lane & 7;
#pragma unroll
    for (int j = 0; j < 8; ++j) { const int n = (lane >> 3) + 8 * j; const LAS float* q = scr + (8 * c) * 65 + n;
        v4u o; o.x = pk2(q[0 * 65], q[1 * 65]); o.y = pk2(q[2 * 65], q[3 * 65]); o.z = pk2(q[4 * 65], q[5 * 65]); o.w = pk2(q[6 * 65], q[7 * 65]);
        *(GAS v4u*)(d.WT + (size_t)(d.destrow0 + n) * d.Kd + d.k0 + 8 * c) = o; }
    LDS_WAIT(); asm volatile("" ::: "memory");
}
constexpr int CV_I0 = 16 * 76, CV_I1 = 6 * 12, CV_I2 = 4 * 16, CV_I3 = 8 * 16, CV_I4 = 8 * 16, CV_I5 = 16 * 16, CV_I6 = 32 * 16 * 8, CV_I7 = 32 * 4 * 16;
constexpr int CV_EARLY = CV_I0 + CV_I1 + CV_I2, CV_LATE = CV_I3 + CV_I4 + CV_I5 + CV_I6 + CV_I7, CV_QITEMS = CV_LATE / 16;
static_assert(CV_LATE % 16 == 0, "late conversion tiles come in queue items of 16");
__device__ __forceinline__ TrDesc conv_desc(const Args& A, unsigned char* ws, int it, int lane) {
    const int n4 = 4 * (lane & 15);
    int r = it;
    if (r < CV_I0) { const int kb = r / 76, nb = r % 76; const int col = in_src_col(64 * nb + n4);
        return TrDesc{col >= 0 ? A.in[2] + col : nullptr, NIN_SRC, 64 * kb, (bf16*)(ws + WS_WIN), 1024, 64 * nb, nullptr}; } r -= CV_I0;
    if (r < CV_I1) { const int kb = r / 12, nb = r % 12; return TrDesc{A.in[4] + 64 * nb + n4, 768, 64 * kb, (bf16*)(ws + WS_WUQ), 384, 64 * nb, A.in[3]}; } r -= CV_I1;
    if (r < CV_I2) { const int kb = r / 16, nb = r % 16; const int n = 64 * nb + n4;
        return TrDesc{n < 512 ? A.in[6] + n : A.in[7] + (n - 512), 512, 64 * kb, (bf16*)(ws + WS_WUKV), 256, 64 * nb, A.in[5]}; } r -= CV_I2;
    if (r < CV_I3) { const int kb = r / 16, nb = r % 16; return TrDesc{A.in[8] + 64 * nb + n4, 1024, 64 * kb, (bf16*)(ws + WS_WOA), 512, 64 * nb, nullptr}; } r -= CV_I3;
    if (r < CV_I4) { const int kb = r / 16, nb = r % 16; return TrDesc{A.in[9] + 64 * nb + n4, 1024, 64 * kb, (bf16*)(ws + WS_WOB), 512, 64 * nb, nullptr}; } r -= CV_I4;
    if (r < CV_I5) { const int kb = r / 16, nb = r % 16; return TrDesc{A.in[10] + 64 * nb + n4, 1024, 64 * kb, (bf16*)(ws + WS_WOUT), 1024, 64 * nb, nullptr}; } r -= CV_I5;
    if (r < CV_I6) { const int e = r / 128, rr = r % 128, kb = rr / 8, nb = rr % 8; const int n = 64 * nb + n4, pn = n >> 8, c = n & 255, col = 128 * pn + (c & 127);
        const float* src = ((c >> 7) ? A.in[17] : A.in[16]) + (size_t)e * 1024 * 256 + col;
        return TrDesc{src, 256, 64 * kb, (bf16*)(ws + WS_WGU) + (size_t)e * 512 * 1024, 1024, 64 * nb, nullptr}; } r -= CV_I6;
    { const int e = r / 64, rr = r % 64, kb = rr / 16, nb = rr % 16;
        return TrDesc{A.in[18] + (size_t)e * 256 * 1024 + 64 * nb + n4, 1024, 64 * kb, (bf16*)(ws + WS_WD) + (size_t)e * 1024 * 256, 256, 64 * nb, nullptr}; }
}
__device__ __forceinline__ void conv_tile(const Args& A, unsigned char* ws, int it, LAS float* scr, int lane) {
    const TrDesc d = conv_desc(A, ws, it, lane); f32x4 v[16]; tr_load(d, lane, v); tr_store(d, lane, v, scr);
}
__device__ __forceinline__ void conv_tile2(const Args& A, unsigned char* ws, int it0, int it1, LAS float* scr, int lane) {
    const TrDesc d0 = conv_desc(A, ws, it0, lane), d1 = conv_desc(A, ws, it1, lane); f32x4 v0[16], v1[16];
    tr_load(d0, lane, v0); tr_load(d1, lane, v1); tr_store(d0, lane, v0, scr); tr_store(d1, lane, v1, scr);
}
__device__ __forceinline__ void p0_prologue(Frame& F, const Args& A) {
    LAS float* scr = (LAS float*)(F.lds + F_WAVE * 16640);
    const int gw = F.vcu * NWAVES + F_WAVE, NGW = F.G * NWAVES, lane = F_LANE;
    unsigned char* ws = F.ws;
#ifdef CONV_IN_P0
    for (int it = gw; it < CV_EARLY + CV_LATE; it += NGW) conv_tile(A, ws, it, scr, lane);
#else
    for (int it = gw; it < CV_EARLY; it += NGW) conv_tile(A, ws, it, scr, lane);
#endif
    const float* x = A.in[0]; const float* g1 = A.in[1]; bf16* H = (bf16*)(ws + WS_H);
    for (int m0 = gw; m0 < T; m0 += 4 * NGW) {
        f32x4 v[4][4];
#pragma unroll
        for (int r = 0; r < 4; ++r) { const int m = min(m0 + r * NGW, T - 1); const GAS f32x4* xr = (const GAS f32x4*)(x + (size_t)m * D) + lane;
#pragma unroll
            for (int j = 0; j < 4; ++j) v[r][j] = xr[64 * j]; }
#pragma unroll
        for (int r = 0; r < 4; ++r) { const int m = m0 + r * NGW; float s = 0.f;
#pragma unroll
            for (int j = 0; j < 4; ++j) s += (v[r][j].x * v[r][j].x + v[r][j].y * v[r][j].y) + (v[r][j].z * v[r][j].z + v[r][j].w * v[r][j].w);
            const float rstd = 1.f / sqrtf(wave_sum(s) * (1.f / D) + EPS);
            if (m < T) { GAS v2u* o8 = (GAS v2u*)(H + (size_t)m * D) + lane;
#pragma unroll
                for (int j = 0; j < 4; ++j) { const f32x4 g = *((const GAS f32x4*)g1 + lane + 64 * j); const f32x4 y = v[r][j] * rstd * g; v2u w; w.x = pk2(y.x, y.y); w.y = pk2(y.z, y.w); o8[64 * j] = w; } } }
    }
    f32x2* rope = (f32x2*)(ws + WS_ROPE);
    for (int idx = (F.vcu * NTHR + F_TID); idx < SEQ * 16; idx += F.G * NTHR) {
        const int pos = idx >> 4, i = idx & 15;
        const double REV[16] = {0.15915494309189535, 0.0700865215877985, 0.03086376340470123, 0.013591370636193905, 0.005985185712713705, 0.002635675898667414, 0.001160663641240061, 0.0005111175045375439,
                                0.00022507907903927653, 9.911730936901935e-05, 4.364795279280289e-05, 1.9221100684944863e-05, 8.464330808241401e-06, 3.727408601915352e-06, 1.6414262627950345e-06, 7.228293068832865e-07};
        double rv = 0.0;
#pragma unroll
        for (int k = 0; k < 16; ++k) rv = (i == k) ? REV[k] : rv;
        double t = (double)pos * rv; t -= __builtin_floor(t);
        const float tf = (float)t;
        rope[idx] = (f32x2){__builtin_amdgcn_cosf(tf), __builtin_amdgcn_sinf(tf)};
    }
}

__device__ __forceinline__ void p2a_norms(Frame& F, const Args& A) {
    const int gw = F.vcu * NWAVES + F_WAVE, NGW = F.G * NWAVES, lane = F_LANE;
    bf16* CQ = (bf16*)(F.ws + WS_CQ); bf16* CKV = (bf16*)(F.ws + WS_CKV);
    const float* gq = A.in[3]; const float* gkv = A.in[5];
    for (int m = gw; m < T; m += NGW) {
        {
            GAS unsigned* p = (GAS unsigned*)(CQ + (size_t)m * 384) + lane; unsigned w[3]; float s = 0.f;
#pragma unroll
            for (int j = 0; j < 3; ++j) { w[j] = p[64 * j]; const float a = bflo(w[j]), b = bfhi(w[j]); s += a * a + b * b; }
            const float rstd = 1.f / sqrtf(wave_sum(s) * (1.f / 384.f) + EPS);
#pragma unroll
            for (int j = 0; j < 3; ++j) { const f32x2 g = *((const GAS f32x2*)gq + lane + 64 * j); p[64 * j] = pk2(bflo(w[j]) * rstd * g.x, bfhi(w[j]) * rstd * g.y); }
        }
        {
            GAS v2u* p = (GAS v2u*)(CKV + (size_t)m * 256) + lane; const v2u w = *p;
            const float a = bflo(w.x), b = bfhi(w.x), c = bflo(w.y), d = bfhi(w.y);
            const float rstd = 1.f / sqrtf(wave_sum(a * a + b * b + c * c + d * d) * (1.f / 256.f) + EPS);
            const f32x4 g = *((const GAS f32x4*)gkv + lane); v2u o; o.x = pk2(a * rstd * g.x, b * rstd * g.y); o.y = pk2(c * rstd * g.z, d * rstd * g.w); *p = o;
        }
    }
}

__device__ __forceinline__ constexpr int crow(int r, int hi) { return (r & 3) + 8 * (r >> 2) + 4 * hi; }
constexpr float ATT_THR = 8.f;
__device__ __forceinline__ float att_mask(float p, unsigned w, int bit) { int mk; unsigned r;
    asm("v_bfe_i32 %0, %1, %2, 1" : "=v"(mk) : "v"(w), "i"(bit)); r = __builtin_bit_cast(unsigned, p) & (unsigned)mk; return __builtin_bit_cast(float, r); }
struct AttnP { const bf16 *Q, *K, *K2, *V; bf16* O; const unsigned* BM; };
template <bool MLA> __device__ __forceinline__ void attn_unit(LAS unsigned char* L, int b, int h, int qb, const AttnP& P, int tid, int lane, int wave) {
    constexpr int DK = MLA ? 96 : 64, KP = DK * 2 + 16, NS = DK / 16, CPR = DK / 8;
    constexpr int QPITCH = MLA ? 768 : 512, VP = 192, KBUF = 64 * KP, VBUF = 64 * VP;
    const int r32 = lane & 31, hi = lane >> 5;
    const size_t rowb = (size_t)b * SEQ;
    const int qrow = qb * 256 + wave * 32 + r32;
    bf16x8 qf[NS];
    { const bf16* qp = P.Q + (rowb + qrow) * QPITCH + h * DK;
#pragma unroll
      for (int s = 0; s < NS; ++s) qf[s] = *(const bf16x8*)(qp + 16 * s + 8 * hi); }
    const int NT = 4 * qb + 4, my_nt = 4 * qb + (wave >> 1) + 1;
    const int kid0 = tid, kid1 = tid + NTHR;
    const int kr0 = kid0 / CPR, kc0 = kid0 % CPR, kr1 = kid1 / CPR, kc1 = kid1 % CPR; const bool has1 = MLA && (kid1 < 64 * CPR);
    const int vr = tid >> 3, vc = tid & 7;
    v4u kreg0, kreg1 = (v4u){0u, 0u, 0u, 0u}, vreg;
#define ATT_KSRC(t, kr, kc) (MLA ? ((kc) < 8 ? (const v4u*)(P.K + (rowb + 64 * (t) + (kr)) * 512 + h * 64 + 8 * (kc)) : (const v4u*)(P.K2 + (rowb + 64 * (t) + (kr)) * 32 + 8 * ((kc) - 8))) \
                                 : (const v4u*)(P.K + (rowb + 64 * (t) + (kr)) * 512 + h * 64 + 8 * (kc)))
#define ATT_LOAD(t) do { kreg0 = *ATT_KSRC(t, kr0, kc0); if (has1) kreg1 = *ATT_KSRC(t, kr1, kc1); vreg = *(const v4u*)(P.V + (rowb + 64 * (t) + vr) * 512 + h * 64 + 8 * vc); } while (0)
#define ATT_WRITE(buf) do { *(LAS v4u*)(L + (buf) * KBUF + kr0 * KP + kc0 * 16) = kreg0; if (has1) *(LAS v4u*)(L + (buf) * KBUF + kr1 * KP + kc1 * 16) = kreg1; \
                            *(LAS v4u*)(L + 2 * KBUF + (buf) * VBUF + vr * VP + vc * 16) = vreg; } while (0)
    float mhat = 0.f, l = 0.f; f32x16 o0, o1, negm;
#pragma unroll
    for (int i = 0; i < 16; ++i) { o0[i] = 0.f; o1[i] = 0.f; negm[i] = 0.f; }
    const int g16 = lane >> 4, qq = (lane & 15) >> 2, pp = lane & 3;
    const int vlane = (4 * hi + qq) * VP + (16 * (g16 & 1) + 4 * pp) * 2;
    ATT_LOAD(0); ATT_WRITE(0); __syncthreads();
    unsigned wn0 = 0xffffffffu, wn1 = 0xffffffffu;
    const unsigned* bmq = MLA ? nullptr : P.BM + (size_t)b * 256 * SEQ + qrow;
    if (!MLA) { wn0 = bmq[0]; wn1 = bmq[SEQ]; }
    for (int t = 0; t < NT; ++t) {
        const int buf = t & 1;
        unsigned w0 = wn0 >> (4 * hi), w1 = wn1 >> (4 * hi);
        if (t + 1 < NT) { ATT_LOAD(t + 1); if (!MLA) { wn0 = bmq[(size_t)(2 * t + 2) * SEQ]; wn1 = bmq[(size_t)(2 * t + 3) * SEQ]; } }
        if (t < my_nt) {
            const LAS unsigned char* Kb = L + buf * KBUF; const LAS unsigned char* Vb = L + 2 * KBUF + buf * VBUF;
            f32x16 s0, s1;
            bf16x8 ka[NS][2];
#pragma unroll
            for (int s = 0; s < NS; ++s) { ka[s][0] = *(const LAS bf16x8*)(Kb + r32 * KP + s * 32 + hi * 16); ka[s][1] = *(const LAS bf16x8*)(Kb + (32 + r32) * KP + s * 32 + hi * 16); }
            __builtin_amdgcn_sched_barrier(0);
#pragma unroll
            for (int s = 0; s < NS; ++s) {
                s0 = __builtin_amdgcn_mfma_f32_32x32x16_bf16(ka[s][0], qf[s], s == 0 ? negm : s0, 0, 0, 0);
                s1 = __builtin_amdgcn_mfma_f32_32x32x16_bf16(ka[s][1], qf[s], s == 0 ? negm : s1, 0, 0, 0);
            }
            s16x4 vf[4][4];
#pragma unroll
            for (int ks = 0; ks < 4; ++ks) { const LAS unsigned char* vp = Vb + ks * 16 * VP + vlane;
                vf[ks][0] = __builtin_bit_cast(s16x4, __builtin_amdgcn_ds_read_tr16_b64_v4i16((LAS s16x4*)(vp)));
                vf[ks][1] = __builtin_bit_cast(s16x4, __builtin_amdgcn_ds_read_tr16_b64_v4i16((LAS s16x4*)(vp + 8 * VP)));
                vf[ks][2] = __builtin_bit_cast(s16x4, __builtin_amdgcn_ds_read_tr16_b64_v4i16((LAS s16x4*)(vp + 64)));
                vf[ks][3] = __builtin_bit_cast(s16x4, __builtin_amdgcn_ds_read_tr16_b64_v4i16((LAS s16x4*)(vp + 8 * VP + 64))); }
            __builtin_amdgcn_sched_barrier(0);
            float mx = fmaxf(fmaxf(s0[0], s0[1]), s1[0]);
#pragma unroll
            for (int i = 2; i < 16; i += 2) mx = fmaxf(fmaxf(mx, s0[i]), s0[i + 1]);
#pragma unroll
            for (int i = 1; i < 15; i += 2) mx = fmaxf(fmaxf(mx, s1[i]), s1[i + 1]);
            mx = fmaxf(mx, s1[15]);
            mx = fmaxf(mx, __shfl_xor(mx, 32));
            if (t == 0 || __any(mx > ATT_THR)) {
                const float dl = (t == 0) ? mx : fmaxf(mx, 0.f), f = (t == 0) ? 1.f : __builtin_amdgcn_exp2f(-dl);
                mhat += dl; l *= f;
#pragma unroll
                for (int i = 0; i < 16; ++i) { s0[i] -= dl; s1[i] -= dl; o0[i] *= f; o1[i] *= f; negm[i] = -mhat; }
            }
            float rs = 0.f;
#pragma unroll
            for (int i = 0; i < 16; ++i) {
                float p0 = __builtin_amdgcn_exp2f(s0[i]), p1 = __builtin_amdgcn_exp2f(s1[i]);
                if (!MLA) { p0 = att_mask(p0, w0, crow(i, 0)); p1 = att_mask(p1, w1, crow(i, 0)); }
                s0[i] = p0; s1[i] = p1; rs += p0 + p1; }
            l += rs;
            bf16x8 pf[4];
#pragma unroll
            for (int ks = 0; ks < 4; ++ks) { v4u w;
#pragma unroll
                for (int j = 0; j < 4; ++j) { const float a = (ks < 2) ? s0[8 * (ks & 1) + 2 * j] : s1[8 * (ks & 1) + 2 * j], c = (ks < 2) ? s0[8 * (ks & 1) + 2 * j + 1] : s1[8 * (ks & 1) + 2 * j + 1]; w[j] = pk2(a, c); }
                pf[ks] = __builtin_bit_cast(bf16x8, w); }
#pragma unroll
            for (int ks = 0; ks < 4; ++ks) {
                const bf16x8 A0 = __builtin_shufflevector(vf[ks][0], vf[ks][1], 0, 1, 2, 3, 4, 5, 6, 7);
                const bf16x8 A1 = __builtin_shufflevector(vf[ks][2], vf[ks][3], 0, 1, 2, 3, 4, 5, 6, 7);
                o0 = __builtin_amdgcn_mfma_f32_32x32x16_bf16(A0, pf[ks], o0, 0, 0, 0);
                o1 = __builtin_amdgcn_mfma_f32_32x32x16_bf16(A1, pf[ks], o1, 0, 0, 0);
            }
        }
        if (t + 1 < NT) ATT_WRITE(buf ^ 1);
        __syncthreads();
    }
    l += __shfl_xor(l, 32);
    const float inv = 1.f / l;
    bf16* op = P.O + (rowb + qrow) * 512 + h * 64 + 4 * hi;
#pragma unroll
    for (int g = 0; g < 4; ++g) {
        v2u w; w.x = pk2(o0[4 * g] * inv, o0[4 * g + 1] * inv); w.y = pk2(o0[4 * g + 2] * inv, o0[4 * g + 3] * inv); *(v2u*)(op + 8 * g) = w;
        v2u z; z.x = pk2(o1[4 * g] * inv, o1[4 * g + 1] * inv); z.y = pk2(o1[4 * g + 2] * inv, o1[4 * g + 3] * inv); *(v2u*)(op + 32 + 8 * g) = z;
    }
#undef ATT_KSRC
#undef ATT_LOAD
#undef ATT_WRITE
}

namespace attn_body {
using bf16=__hip_bfloat16;
using bf16x8=__attribute__((ext_vector_type(8)))short;
using s16x4=__attribute__((ext_vector_type(4)))short;
using f32x16=__attribute__((ext_vector_type(16)))float;
using u32x4=__attribute__((ext_vector_type(4)))unsigned;
constexpr int BATCH=2,NHEAD=8,SEQ=8192,D=64,DM=NHEAD*D;
constexpr int NW=8,QBLK=32,QB=QBLK*NW,KVBLK=64,NQB=SEQ/QB;
constexpr int ATTN_PITCH=DM, ATTN_UNIT_ROWS=QB;
__device__ __forceinline__ int crow(int r,int hi){return (r&3)+8*(r>>2)+4*hi;}
#define SBAR() __builtin_amdgcn_sched_barrier(0)
__device__ __forceinline__ void cmask(f32x16&p0,f32x16&p1,int jb,int wid){
  if(jb>(wid>>1)){
    #pragma unroll
    for(int r=0;r<16;++r){p0[r]=-INFINITY;p1[r]=-INFINITY;} }
}
__device__ __forceinline__ float amask(float p,unsigned w,int bit){ int mk; asm("v_bfe_i32 %0, %1, %2, 1":"=v"(mk):"v"(w),"i"(bit)); return __builtin_bit_cast(float,__builtin_bit_cast(unsigned,p)&(unsigned)mk); }
__device__ __forceinline__ void glds16o(const void*sbase,unsigned voff,unsigned lds_dst){unsigned keep;
  asm volatile("s_mov_b32 %0, m0\n\ts_mov_b32 m0, %3\n\ts_nop 0\n\tglobal_load_lds_dwordx4 %1, %2\n\ts_mov_b32 m0, %0":"=&s"(keep):"v"(voff),"s"(sbase),"s"(lds_dst):"memory");}
__device__ __forceinline__ void glds4o(const void*sbase,unsigned voff,unsigned lds_dst){unsigned keep;
  asm volatile("s_mov_b32 %0, m0\n\ts_mov_b32 m0, %3\n\ts_nop 0\n\tglobal_load_lds_dword %1, %2\n\ts_mov_b32 m0, %0":"=&s"(keep):"v"(voff),"s"(sbase),"s"(lds_dst):"memory");}
__device__ __forceinline__ void glds4(const void*gsrc,unsigned lds_dst){unsigned keep;
  asm volatile("s_mov_b32 %0, m0\n\ts_mov_b32 m0, %2\n\ts_nop 0\n\tglobal_load_lds_dword %1, off\n\ts_mov_b32 m0, %0":"=&s"(keep):"v"(gsrc),"s"(lds_dst):"memory");}

constexpr int NSLOT=3, SLOTB=8192, KSLOTMAX=12288;
constexpr int LDS_K=0, LDS_V=NSLOT*KSLOTMAX, LDS_WS=LDS_V+NSLOT*SLOTB, LDS_OST=LDS_WS+NW*64*4, LDS_BM=LDS_OST+NW*4096, LDS_BYTES=LDS_BM+NW*512;
constexpr float C2=0.125f*1.4426950408889634f;
__device__ __forceinline__ void glds16(const void*gsrc,unsigned lds_dst){unsigned keep;
  asm volatile("s_mov_b32 %0, m0\n\ts_mov_b32 m0, %2\n\ts_nop 0\n\tglobal_load_lds_dwordx4 %1, off\n\ts_mov_b32 m0, %0":"=&s"(keep):"v"(gsrc),"s"(lds_dst):"memory");}
__device__ __forceinline__ float max3f(float a,float b,float c){float r;asm("v_max3_f32 %0, %1, %2, %3":"=v"(r):"v"(a),"v"(b),"v"(c));return r;}
__device__ __forceinline__ float max2f(float a,float b){float r;asm("v_max_f32_e32 %0, %1, %2":"=v"(r):"v"(a),"v"(b));return r;}
__device__ __forceinline__ float fadd_s(float a,float b){float r;asm("v_add_f32_e32 %0, %1, %2":"=v"(r):"v"(a),"v"(b));return r;}
__device__ __forceinline__ float fsub_s(float a,float b){float r;asm("v_sub_f32_e32 %0, %1, %2":"=v"(r):"v"(a),"v"(b));return r;}
typedef float f32x2_t __attribute__((ext_vector_type(2))); typedef __bf16 bf16x2_t __attribute__((ext_vector_type(2)));
__device__ __forceinline__ unsigned cvtpk_s(float lo,float hi){f32x2_t v={lo,hi};bf16x2_t b=__builtin_convertvector(v,bf16x2_t);return __builtin_bit_cast(unsigned,b);}
#define WAIT_BAR(N) asm volatile("s_waitcnt vmcnt(" #N ") lgkmcnt(0)\n\ts_barrier":::"memory")

template<int NKS> __device__ __forceinline__ void qkt(f32x16&p0,f32x16&p1,const char*Kslot,const bf16x8*qr,const f32x16&negm,int r32,int hi){
  const char*kb=Kslot+hi*1024+r32*16;
  #pragma unroll
  for(int d0=0;d0<NKS;++d0){
    const bf16x8 b0=*reinterpret_cast<const bf16x8*>(kb+d0*2048);
    const bf16x8 b1=*reinterpret_cast<const bf16x8*>(kb+d0*2048+512);
    if(d0==0){p0=__builtin_amdgcn_mfma_f32_32x32x16_bf16(b0,qr[0],negm,0,0,0);p1=__builtin_amdgcn_mfma_f32_32x32x16_bf16(b1,qr[0],negm,0,0,0);}
    else{p0=__builtin_amdgcn_mfma_f32_32x32x16_bf16(b0,qr[d0],p0,0,0,0);p1=__builtin_amdgcn_mfma_f32_32x32x16_bf16(b1,qr[d0],p1,0,0,0);}}
}
typedef __attribute__((address_space(3))) const char* lds_cptr;
typedef short v4i16_t __attribute__((ext_vector_type(4)));
__device__ __forceinline__ void kload8(bf16x8*kf,lds_cptr kp){
  kf[0]=*(const __attribute__((address_space(3))) bf16x8*)(kp);      kf[1]=*(const __attribute__((address_space(3))) bf16x8*)(kp+512);
  kf[2]=*(const __attribute__((address_space(3))) bf16x8*)(kp+2048); kf[3]=*(const __attribute__((address_space(3))) bf16x8*)(kp+2560);
  kf[4]=*(const __attribute__((address_space(3))) bf16x8*)(kp+4096); kf[5]=*(const __attribute__((address_space(3))) bf16x8*)(kp+4608);
  kf[6]=*(const __attribute__((address_space(3))) bf16x8*)(kp+6144); kf[7]=*(const __attribute__((address_space(3))) bf16x8*)(kp+6656);
}
__device__ __forceinline__ void kload2(bf16x8*kf,lds_cptr kp,int j){ kf[2*j]=*(const __attribute__((address_space(3))) bf16x8*)(kp+j*2048); kf[2*j+1]=*(const __attribute__((address_space(3))) bf16x8*)(kp+j*2048+512); }
__device__ __forceinline__ s16x4 vtr(lds_cptr p){ return __builtin_bit_cast(s16x4,__builtin_amdgcn_ds_read_tr16_b64_v4i16((__attribute__((address_space(3))) v4i16_t*)p)); }
__device__ __forceinline__ float rowmax(const f32x16&p0,const f32x16&p1){
  float a=max3f(p0[0],p0[1],p1[0]),b=max3f(p0[2],p0[3],p1[1]);a=max3f(a,p1[2],p1[3]);
  #pragma unroll
  for(int r=4;r<16;r+=4){a=max3f(a,p0[r],p0[r+1]);b=max3f(b,p0[r+2],p0[r+3]);a=max3f(a,p1[r],p1[r+1]);b=max3f(b,p1[r+2],p1[r+3]);}
  const float m=max2f(a,b);
  auto rr=__builtin_amdgcn_permlane32_swap(__float_as_uint(m),__float_as_uint(m),false,false);
  return max2f(__uint_as_float(rr[0]),__uint_as_float(rr[1]));
}
__device__ __forceinline__ void pv(f32x16*o,int vb,bf16x8 pa0,bf16x8 pa1,bf16x8 pa2,bf16x8 pa3){
  #pragma unroll
  for(int d0=0;d0<2;++d0){s16x4 lo[4],hi[4];
    #pragma unroll
    for(int ks=0;ks<4;++ks){
      asm volatile("ds_read_b64_tr_b16 %0,%1 offset:%c2":"=&v"(lo[ks]):"v"(vb),"i"(d0*4096+ks*1024):"memory");
      asm volatile("ds_read_b64_tr_b16 %0,%1 offset:%c2":"=&v"(hi[ks]):"v"(vb),"i"(d0*4096+ks*1024+512):"memory");}
    asm volatile("s_waitcnt lgkmcnt(0)":::"memory");SBAR();
    #define PK(k) (bf16x8){lo[k][0],lo[k][1],lo[k][2],lo[k][3],hi[k][0],hi[k][1],hi[k][2],hi[k][3]}
    o[d0]=__builtin_amdgcn_mfma_f32_32x32x16_bf16(pa0,PK(0),o[d0],0,0,0);
    o[d0]=__builtin_amdgcn_mfma_f32_32x32x16_bf16(pa1,PK(1),o[d0],0,0,0);
    o[d0]=__builtin_amdgcn_mfma_f32_32x32x16_bf16(pa2,PK(2),o[d0],0,0,0);
    o[d0]=__builtin_amdgcn_mfma_f32_32x32x16_bf16(pa3,PK(3),o[d0],0,0,0);
    #undef PK
  }
}

#ifndef ATTN_STORE16
#define ATTN_STORE16(p,v) (*(u32x4*)(p)=(v))
#endif
template<int THRL,bool MLA> __device__ __forceinline__ void attn_unit(int b,int h,int qb,const bf16*Q,const bf16*__restrict__ K,const bf16*__restrict__ K2,const bf16*__restrict__ V,bf16*O,const unsigned*BMg,char*shm,int tid){
  constexpr int NKS=MLA?6:4, QP=MLA?768:512, DQ=MLA?96:64;
  const int lane=tid&63,r32=lane&31,hi=lane>>5; const int wid=__builtin_amdgcn_readfirstlane(tid>>6);
  const long rowbase=(long)b*SEQ; const int q0=qb*QB;
  const bf16*Qw=Q+(rowbase+q0+wid*QBLK)*QP+h*DQ;
  const bf16*Kh=K+rowbase*DM+h*D,*Vh=V+rowbase*DM+h*D;
  const unsigned lds0=(unsigned)(uintptr_t)shm;
  float*wsf=(float*)(shm+LDS_WS)+wid*64;
  const unsigned koff=(unsigned)(lane*DM+wid*8)*2u;
  const unsigned voff=(unsigned)((16*(wid&3)+(lane>>2))*DM+(wid>>2)*32+(lane&3)*8)*2u;
  const unsigned kdst=lds0+LDS_K+wid*1024, vdst=lds0+LDS_V+wid*1024;
  const bf16*K2h=MLA?K2+rowbase*32:nullptr; const unsigned koff2=(unsigned)(lane*32+(wid&3)*8)*2u; const unsigned kdst2=lds0+LDS_K+(8+(wid&3))*1024;
  #define KO(sl) (MLA?(sl)+((sl)>>1):(sl))
  #define DMA_K(t,slot) do{ glds16o(Kh+(long)(t)*KVBLK*DM,koff,(unsigned)__builtin_amdgcn_readfirstlane(kdst+KO(slot))); \
    if constexpr(MLA) glds16o(K2h+(long)(t)*KVBLK*32,koff2,(unsigned)__builtin_amdgcn_readfirstlane(kdst2+KO(slot))); }while(0)
  #define DMA_V(t,slot) glds16o(Vh+(long)(t)*KVBLK*DM,voff,(unsigned)__builtin_amdgcn_readfirstlane(vdst+(slot)))
  const unsigned*BMb=BMg+(long)b*256*SEQ+q0+wid*QBLK; const unsigned bmoff=(unsigned)(hi*SEQ+r32)*4u; const unsigned bmdst=lds0+LDS_BM+wid*512;
  const __attribute__((address_space(3))) unsigned*bmw=(const __attribute__((address_space(3))) unsigned*)((lds_cptr)shm+LDS_BM+wid*512);
  #define DMA_BM(t) if constexpr(!MLA) glds4o(BMb+(long)(t)*2*SEQ,bmoff,(unsigned)__builtin_amdgcn_readfirstlane(bmdst+((t)&1)*256))
  #define VMW(N) asm volatile("s_waitcnt vmcnt(" #N ")":::"memory")
  #define BMWAIT(t) do{ if constexpr(!MLA){ if((t)+3<NT){VMW(5);} else if((t)+2<NT){VMW(4);} else if((t)+1<NT){VMW(3);} else {VMW(1);} } }while(0)
  const int vb0=(int)(lds0+LDS_V)+((lane>>4)&1)*32+(lane&3)*8+(4*hi+((lane&15)>>2))*64;
  const char*Kbase=shm+LDS_K; bf16x8 kf[2*NKS];
  const lds_cptr shm3=(lds_cptr)shm; const lds_cptr kp0=shm3+LDS_K+hi*1024+r32*16; const lds_cptr vp0=shm3+LDS_V+((lane>>4)&1)*32+(lane&3)*8+(4*hi+((lane&15)>>2))*64;
  const int NT=(q0+QB)/KVBLK;
  DMA_BM(0);DMA_K(0,0);DMA_V(0,0);DMA_K(1,SLOTB);
  bf16x8 qr[NKS];
  #pragma unroll
  for(int d0=0;d0<NKS;++d0)qr[d0]=*reinterpret_cast<const bf16x8*>(&Qw[(long)r32*QP+d0*16+hi*8]);
  float mhat=0.f,l_reg=0.f;f32x16 o[2];o[0]=f32x16{};o[1]=f32x16{};f32x16 negm=f32x16{};asm volatile("":"+v"(negm));
  const int qrel=wid*QBLK+r32;
  #define CMASK(P0,P1,t) do{int jb_=(t)-(NT-4); if(jb_>=0)cmask(P0,P1,jb_,wid);}while(0)
  bool resc=false;
  #define START(P0,P1) do{ const float rm=rowmax(P0,P1); resc=false; \
    { const float dl=rm; mhat=fadd_s(mhat,dl); \
      _Pragma("unroll") for(int r=0;r<16;++r){P0[r]=fsub_s(P0[r],dl);P1[r]=fsub_s(P1[r],dl);} \
      _Pragma("unroll") for(int r=0;r<16;++r)negm[r]=-mhat; asm volatile("":"+v"(negm)); } \
    _Pragma("unroll") for(int r=0;r<16;++r)P0[r]=__builtin_amdgcn_exp2f(P0[r]); }while(0)
  #define RESC() do{ if(resc){ asm volatile("s_waitcnt lgkmcnt(0)":::"memory"); \
      _Pragma("unroll") for(int d_=0;d_<2;++d_) _Pragma("unroll") for(int r=0;r<16;++r)o[d_][r]*=wsf[crow(r,hi)]; } }while(0)
  f32x16 pA0,pA1,pB0,pB1;
  int sl_prev=0,sl_cur=0,sl_next=SLOTB;
  #define ROT() do{sl_prev=sl_cur;sl_cur=sl_next;sl_next=(sl_next==(NSLOT-1)*SLOTB)?0:sl_next+SLOTB;}while(0)
  DMA_K(2,2*SLOTB);
  if constexpr(MLA){WAIT_BAR(5);}else{WAIT_BAR(3);}
  qkt<NKS>(pA0,pA1,Kbase,qr,negm,r32,hi);asm volatile("s_nop 15\n\ts_nop 7":"+v"(pA0),"+v"(pA1));CMASK(pA0,pA1,0);
  START(pA0,pA1);
  _Pragma("unroll") for(int r=0;r<16;++r)pA1[r]=__builtin_amdgcn_exp2f(pA1[r]);
  if constexpr(!MLA){ const unsigned w0_=bmw[r32]>>(4*hi), w1_=bmw[32+r32]>>(4*hi);
    _Pragma("unroll") for(int r=0;r<16;++r){pA0[r]=amask(pA0[r],w0_,(r&3)+8*(r>>2));pA1[r]=amask(pA1[r],w1_,(r&3)+8*(r>>2));} }
  WAIT_BAR(0);
  DMA_BM(1);DMA_K(3,0);DMA_V(1,SLOTB);
  ROT();
  _Pragma("unroll") for(int j=0;j<NKS;++j)kload2(kf,kp0+KO(sl_cur),j);
  WAIT_BAR(3);
  s16x4 vlo[8],vhi[8]; u32x4 pw0,pw1,pw2,pw3;
  #define PKW(P,B) cvtpk_s(P[B],P[B+1])
  #define PAF(k) __builtin_bit_cast(bf16x8,pw##k)
  #define VFR(i) (bf16x8){vlo[i][0],vlo[i][1],vlo[i][2],vlo[i][3],vhi[i][0],vhi[i][1],vhi[i][2],vhi[i][3]}
  #define PIN(x) asm volatile("":"+v"(x))
  #define MX3(a,b,c) __builtin_fmaxf(__builtin_fmaxf((a),(b)),(c))
  #define GAPA(MF,A0,A1,A2,A3,W0,W1,PW) do{ MF; sacc+=A0; sacc+=A1; sacc+=A2; sacc+=A3; PIN(sacc); W0; W1; PIN(PW); SBAR(); }while(0)
  #define EX(v) __builtin_amdgcn_exp2f(v)
  #define CR_(r) (((r)&3)+8*((r)>>2))
  #define GAPB(MF,X,B,W) do{ MF; X[B]=EX(X[B]); X[B+1]=EX(X[B+1]); X[B+2]=EX(X[B+2]); X[B+3]=EX(X[B+3]); \
    if constexpr(!MLA){ X[B]=amask(X[B],W,CR_(B)); X[B+1]=amask(X[B+1],W,CR_(B+1)); X[B+2]=amask(X[B+2],W,CR_(B+2)); X[B+3]=amask(X[B+3],W,CR_(B+3)); } PIN(X); SBAR(); }while(0)
  #define VRD(i) do{ vlo[i]=vtr(vp_+(((i)>>2)*4096+((i)&3)*1024)); vhi[i]=vtr(vp_+(((i)>>2)*4096+((i)&3)*1024+512)); }while(0)
  #define KRD(G,j) do{ if((j)<NKS){ if(G){ kload2(kf,kp0+KO(sl_next),j); SBAR(); } } }while(0)
  #define STEP(C0,C1,P0,P1,t,GK,GV,GL) do{ SBAR(); \
    const lds_cptr vp_=vp0+sl_prev; \
    VRD(0); SBAR(); float sacc=(P0[0]+P0[1]); \
    GAPA(C0=__builtin_amdgcn_mfma_f32_32x32x16_bf16(kf[0],qr[0],negm,0,0,0), P0[2],P0[3],P0[4],P0[5],     pw0[0]=PKW(P0,0), pw0[1]=PKW(P0,2), pw0); \
    VRD(4); SBAR(); GAPA(C1=__builtin_amdgcn_mfma_f32_32x32x16_bf16(kf[1],qr[0],negm,0,0,0), P0[6],P0[7],P0[8],P0[9],     pw0[2]=PKW(P0,4), pw0[3]=PKW(P0,6), pw0); \
    VRD(1); SBAR(); GAPA(C0=__builtin_amdgcn_mfma_f32_32x32x16_bf16(kf[2],qr[1],C0,0,0,0),   P0[10],P0[11],P0[12],P0[13], pw1[0]=PKW(P0,8), pw1[1]=PKW(P0,10), pw1); \
    VRD(5); SBAR(); GAPA(C1=__builtin_amdgcn_mfma_f32_32x32x16_bf16(kf[3],qr[1],C1,0,0,0),   P0[14],P0[15],P1[0],P1[1],   pw1[2]=PKW(P0,12),pw1[3]=PKW(P0,14), pw1); \
    VRD(2); SBAR(); GAPA(C0=__builtin_amdgcn_mfma_f32_32x32x16_bf16(kf[4],qr[2],C0,0,0,0),   P1[2],P1[3],P1[4],P1[5],     pw2[0]=PKW(P1,0), pw2[1]=PKW(P1,2), pw2); \
    VRD(6); SBAR(); GAPA(C1=__builtin_amdgcn_mfma_f32_32x32x16_bf16(kf[5],qr[2],C1,0,0,0),   P1[6],P1[7],P1[8],P1[9],     pw2[2]=PKW(P1,4), pw2[3]=PKW(P1,6), pw2); \
    VRD(3); SBAR(); GAPA(C0=__builtin_amdgcn_mfma_f32_32x32x16_bf16(kf[6],qr[3],C0,0,0,0),   P1[10],P1[11],P1[12],P1[13], pw3[0]=PKW(P1,8), pw3[1]=PKW(P1,10), pw3); \
    VRD(7); SBAR(); GAPA(C1=__builtin_amdgcn_mfma_f32_32x32x16_bf16(kf[7],qr[3],C1,0,0,0),   P1[14],P1[15],0.f,0.f,       pw3[2]=PKW(P1,12),pw3[3]=PKW(P1,14), pw3); \
    if constexpr(MLA){ C0=__builtin_amdgcn_mfma_f32_32x32x16_bf16(kf[8],qr[4],C0,0,0,0); C1=__builtin_amdgcn_mfma_f32_32x32x16_bf16(kf[9],qr[4],C1,0,0,0); \
      C0=__builtin_amdgcn_mfma_f32_32x32x16_bf16(kf[10],qr[5],C0,0,0,0); C1=__builtin_amdgcn_mfma_f32_32x32x16_bf16(kf[11],qr[5],C1,0,0,0); SBAR(); } \
    l_reg+=sacc; \
    if(GV){DMA_BM((t)+1);} if(GK){DMA_K((t)+3,sl_cur);} if(GV){DMA_V((t)+1,sl_next);} \
    CMASK(C0,C1,t); \
    { float a=MX3(C0[0],C0[1],C1[0]),b=MX3(C0[2],C0[3],C1[1]); a=MX3(a,C1[2],C1[3]); \
      _Pragma("unroll") for(int r=4;r<16;r+=4){a=MX3(a,C0[r],C0[r+1]);b=MX3(b,C0[r+2],C0[r+3]);a=MX3(a,C1[r],C1[r+1]);b=MX3(b,C1[r+2],C1[r+3]);} \
      float rm=__builtin_fmaxf(a,b); { auto rr=__builtin_amdgcn_permlane32_swap(__float_as_uint(rm),__float_as_uint(rm),false,false); rm=__builtin_fmaxf(__uint_as_float(rr[0]),__uint_as_float(rr[1])); } \
      resc=false; \
      if(__builtin_expect(__any(rm>(float)THRL),0)){ const float dl=__builtin_fmaxf(rm,0.f); mhat+=dl; \
        _Pragma("unroll") for(int r=0;r<16;++r){C0[r]-=dl;C1[r]-=dl;} \
        _Pragma("unroll") for(int r=0;r<16;++r)negm[r]=-mhat; asm volatile("":"+v"(negm)); \
        const float f=__builtin_amdgcn_exp2f(-dl); l_reg*=f; if(hi==0)wsf[r32]=f; resc=true; } } \
    BMWAIT(t); unsigned w0_=0u, w1_=0u; if constexpr(!MLA){ w0_=bmw[((t)&1)*64+r32]>>(4*hi); w1_=bmw[((t)&1)*64+32+r32]>>(4*hi); } \
    SBAR(); \
    GAPB(o[0]=__builtin_amdgcn_mfma_f32_32x32x16_bf16(PAF(0),VFR(0),o[0],0,0,0), C0,0,w0_); \
    KRD(GL,4); GAPB(o[1]=__builtin_amdgcn_mfma_f32_32x32x16_bf16(PAF(0),VFR(4),o[1],0,0,0), C0,4,w0_); \
    KRD(GL,0); GAPB(o[0]=__builtin_amdgcn_mfma_f32_32x32x16_bf16(PAF(1),VFR(1),o[0],0,0,0), C0,8,w0_); \
    KRD(GL,1); GAPB(o[1]=__builtin_amdgcn_mfma_f32_32x32x16_bf16(PAF(1),VFR(5),o[1],0,0,0), C0,12,w0_); \
    KRD(GL,2); GAPB(o[0]=__builtin_amdgcn_mfma_f32_32x32x16_bf16(PAF(2),VFR(2),o[0],0,0,0), C1,0,w1_); \
    KRD(GL,3); GAPB(o[1]=__builtin_amdgcn_mfma_f32_32x32x16_bf16(PAF(2),VFR(6),o[1],0,0,0), C1,4,w1_); \
    KRD(GL,5); GAPB(o[0]=__builtin_amdgcn_mfma_f32_32x32x16_bf16(PAF(3),VFR(3),o[0],0,0,0), C1,8,w1_); \
    GAPB(o[1]=__builtin_amdgcn_mfma_f32_32x32x16_bf16(PAF(3),VFR(7),o[1],0,0,0), C1,12,w1_); \
    }while(0)
  int t=1;
  #undef CMASK
  #define CMASK(P0,P1,t) do{}while(0)
  for(;t+5<NT;t+=2){
    STEP(pB0,pB1,pA0,pA1,t,true,true,true);     WAIT_BAR(3); RESC(); ROT();
    STEP(pA0,pA1,pB0,pB1,t+1,true,true,true);   WAIT_BAR(3); RESC(); ROT();
  }
  #undef CMASK
  #define CMASK(P0,P1,t) do{int jb_=(t)-(NT-4); if(jb_>=0)cmask(P0,P1,jb_,wid);}while(0)
  #define ENDW(tt) do{ if((tt)+3<NT){WAIT_BAR(3);} else if((tt)+2<NT){ if constexpr(MLA){WAIT_BAR(1);}else{WAIT_BAR(2);} } else {WAIT_BAR(0);} }while(0)
  for(;t+1<NT;t+=2){
    STEP(pB0,pB1,pA0,pA1,t,(t+3<NT),(t+1<NT),(t+1<NT));       ENDW(t);   RESC(); ROT();
    STEP(pA0,pA1,pB0,pB1,t+1,(t+4<NT),(t+2<NT),(t+2<NT));     ENDW(t+1); RESC(); ROT();
  }
  STEP(pB0,pB1,pA0,pA1,NT-1,false,false,false); RESC();
  { float sacc=pB0[0]+pB0[1]; _Pragma("unroll") for(int r=2;r<16;++r)sacc+=pB0[r]; _Pragma("unroll") for(int r=0;r<16;++r)sacc+=pB1[r]; l_reg+=sacc;
    pw0=(u32x4){PKW(pB0,0),PKW(pB0,2),PKW(pB0,4),PKW(pB0,6)};pw1=(u32x4){PKW(pB0,8),PKW(pB0,10),PKW(pB0,12),PKW(pB0,14)};pw2=(u32x4){PKW(pB1,0),PKW(pB1,2),PKW(pB1,4),PKW(pB1,6)};pw3=(u32x4){PKW(pB1,8),PKW(pB1,10),PKW(pB1,12),PKW(pB1,14)};
    SBAR(); pv(o,vb0+sl_cur,PAF(0),PAF(1),PAF(2),PAF(3)); }
  #undef PKW
  #undef PAF
  #undef VFR
  #undef PIN
  #undef MX3
  #undef GAPA
  #undef GAPB
  #undef EX
  #undef VRD
  #undef KRD
  #undef STEP
  #undef ENDW
  {auto rr=__builtin_amdgcn_permlane32_swap(__float_as_uint(l_reg),__float_as_uint(l_reg),false,false);l_reg=__uint_as_float(rr[0])+__uint_as_float(rr[1]);}
  if(hi==0)wsf[32+r32]=l_reg;asm volatile("s_waitcnt lgkmcnt(0)":::"memory");
  float rli[16];
  #pragma unroll
  for(int r=0;r<16;++r)rli[r]=__builtin_amdgcn_rcpf(wsf[32+crow(r,hi)]);
  bf16*Ow=O+(rowbase+q0+wid*QBLK)*DM+h*D;
  { bf16*stg=(bf16*)(shm+LDS_OST)+wid*2048;
    #pragma unroll
    for(int r=0;r<16;++r){const int orow=crow(r,hi);
      #pragma unroll
      for(int d0=0;d0<2;++d0)stg[orow*64+d0*32+r32]=__float2bfloat16(o[d0][r]*rli[r]);}
    asm volatile("s_waitcnt lgkmcnt(0)":::"memory");
    #pragma unroll
    for(int i=0;i<4;++i){const int row=i*8+(lane>>3),ch=lane&7; const u32x4 v=*(const u32x4*)(stg+row*64+ch*8); ATTN_STORE16(Ow+(long)row*DM+ch*8,v);} }
  asm volatile("s_waitcnt lgkmcnt(0)\n\ts_barrier":::"memory");
  #undef DMA_K
  #undef DMA_BM
  #undef KO
  #undef VMW
  #undef BMWAIT
  #undef CR_
  #undef DMA_V
  #undef CMASK
  #undef START
  #undef RESC
  #undef ROT
}
#undef SBAR
#undef WAIT_BAR
}
__device__ __forceinline__ unsigned row16_sum(unsigned x) {
    x += (unsigned)__builtin_amdgcn_update_dpp(0, (int)x, 0x128, 0xf, 0xf, false); x += (unsigned)__builtin_amdgcn_update_dpp(0, (int)x, 0x124, 0xf, 0xf, false);
    x += (unsigned)__builtin_amdgcn_update_dpp(0, (int)x, 0x122, 0xf, 0xf, false); x += (unsigned)__builtin_amdgcn_update_dpp(0, (int)x, 0x121, 0xf, 0xf, false); return x; }
__device__ __forceinline__ float row16_sumf(float x) {
    x += __builtin_bit_cast(float, __builtin_amdgcn_update_dpp(0, __builtin_bit_cast(int, x), 0x128, 0xf, 0xf, false)); x += __builtin_bit_cast(float, __builtin_amdgcn_update_dpp(0, __builtin_bit_cast(int, x), 0x124, 0xf, 0xf, false));
    x += __builtin_bit_cast(float, __builtin_amdgcn_update_dpp(0, __builtin_bit_cast(int, x), 0x122, 0xf, 0xf, false)); x += __builtin_bit_cast(float, __builtin_amdgcn_update_dpp(0, __builtin_bit_cast(int, x), 0x121, 0xf, 0xf, false)); return x; }
__device__ __forceinline__ unsigned row16_suffix(unsigned x) {
    x += (unsigned)__builtin_amdgcn_update_dpp(0, (int)x, 0x101, 0xf, 0xf, false); x += (unsigned)__builtin_amdgcn_update_dpp(0, (int)x, 0x102, 0xf, 0xf, false);
    x += (unsigned)__builtin_amdgcn_update_dpp(0, (int)x, 0x104, 0xf, 0xf, false); x += (unsigned)__builtin_amdgcn_update_dpp(0, (int)x, 0x108, 0xf, 0xf, false); return x; }
__device__ __forceinline__ unsigned half_or(unsigned x) { const auto rr = __builtin_amdgcn_permlane32_swap(x, x, false, false); return rr[0] | rr[1]; }
constexpr int CAND_CAP = 128, QIP = 1296, HS = 513, FAST_CAP = 512;
struct IdxP { const bf16 *QI, *KI; const float* WI; unsigned* BM; unsigned* dbg; };
__device__ __forceinline__ unsigned mono_key(float s) { const unsigned u = __builtin_bit_cast(unsigned, s + 0.0f); return u ^ ((unsigned)((int)u >> 31) | 0x80000000u); }
__device__ __forceinline__ void idx_scores2(const bf16x8 (&kf)[2][4], const LAS unsigned char* qlane, const float (&wq)[8], f32x16& sc0, f32x16& sc1) {
    bf16x8 qv[4], qn[4];
#pragma unroll
    for (int s = 0; s < 4; ++s) qv[s] = *(const LAS bf16x8*)(qlane + 8 * 128 + s * 32);
#pragma unroll
    for (int i = 0; i < 16; ++i) { sc0[i] = 0.f; sc1[i] = 0.f; }
    f32x16 ap0, ap1;
#pragma unroll
    for (int i = 0; i < 16; ++i) { ap0[i] = 0.f; ap1[i] = 0.f; }
#pragma unroll
    for (int n = 0; n < 10; ++n) {
        const int nh = (n + 1 < 2) ? 9 : (n + 1 - 2);
        if (n + 1 < 10) {
#pragma unroll
            for (int s = 0; s < 4; ++s) qn[s] = *(const LAS bf16x8*)(qlane + nh * 128 + s * 32); }
        f32x16 a0, a1;
        if (n < 2) {
#pragma unroll
            for (int s = 0; s < 4; ++s) { sc0 = __builtin_amdgcn_mfma_f32_32x32x16_bf16(kf[0][s], qv[s], sc0, 0, 0, 0); sc1 = __builtin_amdgcn_mfma_f32_32x32x16_bf16(kf[1][s], qv[s], sc1, 0, 0, 0); }
        } else {
#pragma unroll
            for (int i = 0; i < 16; ++i) { a0[i] = 0.f; a1[i] = 0.f; }
#pragma unroll
            for (int s = 0; s < 4; ++s) { a0 = __builtin_amdgcn_mfma_f32_32x32x16_bf16(kf[0][s], qv[s], a0, 0, 0, 0); a1 = __builtin_amdgcn_mfma_f32_32x32x16_bf16(kf[1][s], qv[s], a1, 0, 0, 0); }
        }
        if (n >= 3) {
            const float w = wq[n - 3];
#pragma unroll
            for (int i = 0; i < 16; ++i) { sc0[i] = __builtin_fmaf(w, __builtin_fabsf(ap0[i]), sc0[i]); sc1[i] = __builtin_fmaf(w, __builtin_fabsf(ap1[i]), sc1[i]); }
#pragma unroll
            for (int g = 0; g < 8; ++g) { __builtin_amdgcn_sched_group_barrier(0x008, 1, 0); __builtin_amdgcn_sched_group_barrier(0x002, 4, 0); }
        }
        if (n >= 2) { ap0 = a0; ap1 = a1; }
#pragma unroll
        for (int s = 0; s < 4; ++s) qv[s] = qn[s];
    }
    { const float w = wq[7];
#pragma unroll
      for (int i = 0; i < 16; ++i) { sc0[i] = __builtin_fmaf(w, __builtin_fabsf(ap0[i]), sc0[i]); sc1[i] = __builtin_fmaf(w, __builtin_fabsf(ap1[i]), sc1[i]); } }
#pragma unroll
    for (int i = 0; i < 16; ++i) asm volatile("" : "+v"(sc0[i]), "+v"(sc1[i]));
}
__device__ __forceinline__ void idx_item(LAS unsigned char* L, int b, int j, const IdxP& P, int tid, int lane, int wave) {
    LAS unsigned* hist = (LAS unsigned*)L;
    LAS unsigned* img = (LAS unsigned*)(L + 66048);
    LAS unsigned* st = (LAS unsigned*)(L + 98816);
    LAS unsigned* cand = hist;
    LAS unsigned char* Qs = L + 100864;
    const int r32 = lane & 31, hi = lane >> 5;
    const int q0 = 32 * j, ntile = 2 * (j / 2 + 1);
    const size_t rowb = (size_t)b * SEQ;
    if (ntile <= 8) {
        for (int idx = tid; idx < ntile * 32; idx += NTHR) P.BM[((size_t)b * 256 + (idx >> 5)) * SEQ + q0 + (idx & 31)] = 0xffffffffu;
        return;
    }
    const int npair = ntile >> 1, nsw = (npair + 63) >> 6, SP = min(npair, 8 * nsw);
    bf16x8 ksmp[2][4];
#ifdef SMP_PREFETCH
    if (wave < SP) { const bf16* kp = P.KI + (rowb + 64 * ((wave * npair) / SP) + r32) * 64 + 8 * hi;
#pragma unroll
        for (int s = 0; s < 4; ++s) { ksmp[0][s] = *(const bf16x8*)(kp + 16 * s); ksmp[1][s] = *(const bf16x8*)(kp + 32 * 64 + 16 * s); } }
#endif
    float wq[8];
    { for (int c = tid; c < 32 * 64; c += NTHR) { const int rr = c >> 6, ch = c & 63; *(LAS v4u*)(Qs + rr * QIP + ch * 16) = *(const v4u*)(P.QI + (rowb + q0 + rr) * 512 + ch * 8); }
      const float* wp = P.WI + (rowb + q0 + r32) * 8;
#pragma unroll
      for (int h = 0; h < 8; ++h) wq[h] = 0.5f * wp[h]; }
    if (tid < 32) { st[32 + tid] = 256u; st[64 + tid] = 0u; st[96 + tid] = 0u; }
    if (tid == 0) st[129] = 0u;
    __syncthreads();
    {
        const int r = tid >> 4, part = tid & 15;
        const float* wp = P.WI + (rowb + q0 + r) * 8;
        float qb[4] = {0.f, 0.f, 0.f, 0.f}; float rsum = 0.f;
#pragma unroll
        for (int h = 0; h < 8; ++h) { const float w = wp[h]; const v2u raw = *(const LAS v2u*)(Qs + r * QIP + h * 128 + part * 8);
            const float f0 = bflo(raw.x), f1 = bfhi(raw.x), f2 = bflo(raw.y), f3 = bfhi(raw.y);
            float nsq = (f0 * f0 + f1 * f1) + (f2 * f2 + f3 * f3);
            nsq = row16_sumf(nsq);
            rsum += fabsf(w) * sqrtf(nsq);
            qb[0] += 0.5f * w * f0; qb[1] += 0.5f * w * f1; qb[2] += 0.5f * w * f2; qb[3] += 0.5f * w * f3; }
        v2u hw, lw;
        { const unsigned h01 = pk2(qb[0], qb[1]), h23 = pk2(qb[2], qb[3]); hw.x = h01; hw.y = h23;
          lw.x = pk2(qb[0] - bflo(h01), qb[1] - bfhi(h01)); lw.y = pk2(qb[2] - bflo(h23), qb[3] - bfhi(h23)); }
        *(LAS v2u*)(Qs + r * QIP + 8 * 128 + part * 8) = hw; *(LAS v2u*)(Qs + r * QIP + 9 * 128 + part * 8) = lw;
        { const v2u kw = *(const v2u*)(P.KI + (rowb + r) * 64 + part * 4); const float f0 = bflo(kw.x), f1 = bfhi(kw.x), f2 = bflo(kw.y), f3 = bfhi(kw.y);
          float ksq = (f0 * f0 + f1 * f1) + (f2 * f2 + f3 * f3);
          ksq = row16_sumf(ksq);
          if (part == 0) { __hip_atomic_fetch_max(&st[129], __builtin_bit_cast(unsigned, ksq), __ATOMIC_RELAXED, __HIP_MEMORY_SCOPE_WORKGROUP); st[224 + r] = __builtin_bit_cast(unsigned, rsum); } }
    }
    __syncthreads();
    if (tid < 32) { const float R = 0.25f * sqrtf(__builtin_bit_cast(float, st[129])) * __builtin_bit_cast(float, st[224 + tid]);
        const float C = 0.125f * R;
        st[160 + tid] = (0x80000000u | __builtin_bit_cast(unsigned, R + C)) - 511u * 131072u; st[224 + tid] = __builtin_bit_cast(unsigned, C); st[tid] = 0u; st[192 + tid] = 0u;
        st[256 + tid] = __builtin_bit_cast(unsigned, R); st[288 + tid] = 511u; st[320 + tid] = 0u; }
    const LAS unsigned char* qlane = Qs + r32 * QIP + hi * 16;
    int level = 0;
#define IDX_KLOAD2(tp) { const bf16* kp = P.KI + (rowb + 64 * (tp) + r32) * 64 + 8 * hi; _Pragma("unroll") for (int s = 0; s < 4; ++s) { kn[0][s] = *(const bf16x8*)(kp + 16 * s); kn[1][s] = *(const bf16x8*)(kp + 32 * 64 + 16 * s); } }
#define IDX_SCORES2(tp) \
        bf16x8 kf[2][4]; _Pragma("unroll") for (int s = 0; s < 4; ++s) { kf[0][s] = kn[0][s]; kf[1][s] = kn[1][s]; } \
        f32x16 sc0, sc1; idx_scores2(kf, qlane, wq, sc0, sc1); \
        if ((tp) + NWAVES < npair) { IDX_KLOAD2((tp) + NWAVES) }
    bool slow;
    {
        for (int u = tid; u < 32 * HS; u += NTHR) hist[u] = 0u;
        if (tid == 0) st[130] = 0u;
        __syncthreads();
        const float Rq = __builtin_bit_cast(float, st[256 + r32]);
        {   const float s1 = 256.f / Rq; LAS unsigned* hrow = hist + r32 * HS;
            for (int i = wave; i < SP; i += NWAVES) { const int tp = (i * npair) / SP;
#ifdef SMP_PREFETCH
                bf16x8 kn[2][4]; if (i >= NWAVES) { IDX_KLOAD2(tp) }
#else
                bf16x8 kn[2][4]; IDX_KLOAD2(tp)
#endif
                bf16x8 kf[2][4];
#pragma unroll
#ifdef SMP_PREFETCH
                for (int s = 0; s < 4; ++s) { kf[0][s] = (i < NWAVES) ? ksmp[0][s] : kn[0][s]; kf[1][s] = (i < NWAVES) ? ksmp[1][s] : kn[1][s]; }
#else
                for (int s = 0; s < 4; ++s) { kf[0][s] = kn[0][s]; kf[1][s] = kn[1][s]; }
#endif
                f32x16 sc0, sc1; idx_scores2(kf, qlane, wq, sc0, sc1);
#pragma unroll
                for (int e = 0; e < 16; ++e) { const int b0 = min(max((int)__builtin_fmaf(sc0[e], s1, 256.f), 0), 511), b1 = min(max((int)__builtin_fmaf(sc1[e], s1, 256.f), 0), 511);
                    __hip_atomic_fetch_add(&hrow[b0], 1u, __ATOMIC_RELAXED, __HIP_MEMORY_SCOPE_WORKGROUP); __hip_atomic_fetch_add(&hrow[b1], 1u, __ATOMIC_RELAXED, __HIP_MEMORY_SCOPE_WORKGROUP); }
            }
        }
        __syncthreads();
        {
            const int q = tid >> 4, seg = tid & 15; const LAS unsigned* hq = hist + q * HS + seg * 32;
            unsigned segsum = 0u;
            for (int wi = 0; wi < 32; ++wi) segsum += hq[wi];
            unsigned S = segsum;
            S = row16_suffix(S);
            const unsigned above = S - segsum, total = row16_sum(segsum);
            const float f = (float)total / (float)(64 * npair), rs = 256.f * f, sg = 3.5f * sqrtf(rs * (1.f - f));
            const int rl = (int)floorf(rs - sg) - 1, rh = (int)ceilf(rs + sg) + 1;
            const unsigned tl = rl > 0 ? (unsigned)rl : 0u, th = (unsigned)rh;
            if (above < tl && tl <= above + segsum) { unsigned cum = above; int fb = 0; bool found = false;
                for (int wi = 31; wi >= 0; --wi) { const unsigned c = hq[wi]; if (!found && cum + c >= tl) { found = true; fb = wi; } if (!found) cum += c; }
                st[288 + q] = (unsigned)(32 * seg + fb); }
            if (above < th && th <= above + segsum) { unsigned cum = above; int fb = 0; bool found = false;
                for (int wi = 31; wi >= 0; --wi) { const unsigned c = hq[wi]; if (!found && cum + c >= th) { found = true; fb = wi; } if (!found) cum += c; }
                st[320 + q] = (unsigned)(32 * seg + fb); }
        }
        __syncthreads();
#ifdef REP_PASS2
        for (int rep2 = 0; rep2 < 2; ++rep2) { if (rep2) { __syncthreads(); if (tid < 32) st[96 + tid] = 0u; __syncthreads(); }
#else
        {
#endif
            const float wbin = Rq * (1.f / 256.f), fH = __builtin_fmaf((float)(st[288 + r32] + 1u), wbin, -Rq), fA = __builtin_fmaf((float)st[320 + r32], wbin, -Rq), s2 = 524287.f / (fH - fA), nfa = -fA * s2;
            bf16x8 kn[2][4]; if (wave < npair) { IDX_KLOAD2(wave) }
            for (int tp = wave; tp < npair; tp += NWAVES) {
                IDX_SCORES2(tp)
#define IDX_FAST_ELEMS(SC, T) { unsigned v = 0u, cm = 0u; \
            _Pragma("unroll") for (int i = 15; i >= 0; --i) { v = __builtin_amdgcn_alignbit(v, __builtin_bit_cast(unsigned, SC[i] - fH), 31);        \
                                                              cm = __builtin_amdgcn_alignbit(cm, __builtin_bit_cast(unsigned, SC[i] - fA), 31); } \
            cm = v & ~cm & 0xffffu; v = ~v & 0xffffu;                                                           \
            if (cm) { const unsigned pos0 = __hip_atomic_fetch_add(&st[96 + r32], (unsigned)__builtin_popcount(cm), __ATOMIC_RELAXED, __HIP_MEMORY_SCOPE_WORKGROUP);     \
                const unsigned rb = 8191u - (unsigned)(32 * (T)) - hi4; \
                _Pragma("unroll") for (int i = 0; i < 16; ++i) if (cm & (1u << i)) { const unsigned pos = min(pos0 + (unsigned)__builtin_popcount(cm & ((1u << i) - 1u)), (unsigned)FAST_CAP - 1u); \
                    cand[r32 * FAST_CAP + pos] = (min((unsigned)__builtin_fmaf(SC[i], s2, nfa), 524287u) << 13) | (rb - (unsigned)((i & 3) + 8 * (i >> 2))); } } \
            unsigned bits = (v & 0xfu) | ((v & 0xf0u) << 4) | ((v & 0xf00u) << 8) | ((v & 0xf000u) << 12);     \
            bits <<= 4 * hi; bits = half_or(bits); if (hi == 0) img[(T) * 32 + r32] = bits; }
                unsigned hi4 = 4u * (unsigned)hi; asm volatile("" : "+v"(hi4));
                IDX_FAST_ELEMS(sc0, 2 * tp)
                IDX_FAST_ELEMS(sc1, 2 * tp + 1)
#undef IDX_FAST_ELEMS
            }
        }
        __syncthreads();
        {
            const int q = tid >> 4, l16 = tid & 15; unsigned above = 0u;
            for (int t = l16; t < ntile; t += 16) above += (unsigned)__builtin_popcount(img[t * 32 + q]);
            above = row16_sum(above);
            const unsigned n = st[96 + q];
            if (l16 == 0) { if (above >= 256u || 256u - above > n || n > (unsigned)FAST_CAP) st[130] = 1u; st[32 + q] = 256u - above; }
        }
        __syncthreads();
        slow = st[130] != 0u;
#ifdef REP_SEL
        for (int rep3 = 0; rep3 < 2; ++rep3)
#endif
        if (!slow) {
            const int q = tid >> 4, l16 = tid & 15; const unsigned n = st[96 + q], need = st[32 + q];
            unsigned c[FAST_CAP / 16];
#pragma unroll
            for (int i = 0; i < FAST_CAP / 16; ++i) { const unsigned ci = (unsigned)(l16 + 16 * i); c[i] = ci < n ? cand[q * FAST_CAP + ci] : 0u; }
            unsigned Pv = 0u; bool done = false;
#pragma nounroll
            for (int bit = 31; bit >= 0; --bit) { const unsigned trial = Pv | (1u << bit); unsigned cnt = 0u;
#pragma unroll
                for (int i = 0; i < FAST_CAP / 16; ++i) cnt += (c[i] >= trial) ? 1u : 0u;
                cnt = row16_sum(cnt);
                if (!done && cnt >= need) { Pv = trial; done = (cnt == need); }
                if (__all(done)) break; }
#pragma unroll
            for (int i = 0; i < FAST_CAP / 16; ++i) if ((unsigned)(l16 + 16 * i) < n && c[i] >= Pv) { const unsigned kidx = 8191u - (c[i] & 8191u);
                __hip_atomic_fetch_or(&img[(kidx >> 5) * 32 + q], 1u << (kidx & 31), __ATOMIC_RELAXED, __HIP_MEMORY_SCOPE_WORKGROUP); }
        } else if (tid < 32) { st[32 + tid] = 256u; st[96 + tid] = 0u; }
        __syncthreads();
    }
#ifdef DIAG_SLOW
    if (slow && tid == 0) __hip_atomic_fetch_add(P.dbg, 1u, RLX_AGENT);
#endif
    if (slow) {
    for (;;) {
        ++level;
        for (int u = tid; u < 32 * HS; u += NTHR) hist[u] = 0u;
        if (tid == 0) st[128] = 0u;
        __syncthreads();
        {
            const unsigned qa = st[r32], qlen = st[192 + r32], base1 = st[160 + r32]; const float cq = __builtin_bit_cast(float, st[224 + r32]);
            const int sh = (level > 1 && qlen > 512u) ? (32 - __builtin_clz(qlen - 1u)) - 9 : 0;
            LAS unsigned* hrow = hist + r32 * HS;
            bf16x8 kn[2][4]; if (wave < npair) { IDX_KLOAD2(wave) }
            for (int tp = wave; tp < npair; tp += NWAVES) {
                IDX_SCORES2(tp)
                if (level == 1) {
#pragma unroll
                    for (int i = 0; i < 16; ++i) { const unsigned k0 = mono_key(sc0[i] + cq), k1 = mono_key(sc1[i] + cq);
                        const unsigned b0 = min((max(k0, base1) - base1) >> 17, 511u), b1 = min((max(k1, base1) - base1) >> 17, 511u);
                        __hip_atomic_fetch_add(&hrow[b0], 1u, __ATOMIC_RELAXED, __HIP_MEMORY_SCOPE_WORKGROUP); __hip_atomic_fetch_add(&hrow[b1], 1u, __ATOMIC_RELAXED, __HIP_MEMORY_SCOPE_WORKGROUP); }
                } else {
#pragma unroll
                    for (int i = 0; i < 16; ++i) { const unsigned o0 = mono_key(sc0[i] + cq) - qa, o1 = mono_key(sc1[i] + cq) - qa;
                        if (o0 < qlen) __hip_atomic_fetch_add(&hrow[o0 >> sh], 1u, __ATOMIC_RELAXED, __HIP_MEMORY_SCOPE_WORKGROUP);
                        if (o1 < qlen) __hip_atomic_fetch_add(&hrow[o1 >> sh], 1u, __ATOMIC_RELAXED, __HIP_MEMORY_SCOPE_WORKGROUP); }
                }
            }
        }
        __syncthreads();
        {
            const int q = tid >> 4, seg = tid & 15;
            unsigned segsum = 0u;
            for (int wi = 0; wi < 32; ++wi) segsum += hist[q * HS + seg * 32 + wi];
            unsigned S = segsum;
            S = row16_suffix(S);
            const unsigned above = S - segsum, need = st[32 + q];
            if (above < need && need <= above + segsum) {
                unsigned cum = above, fbin = 0u, fneed = 1u, fcnt = 0u; bool found = false;
                for (int wi = 31; wi >= 0; --wi) { const unsigned c = hist[q * HS + seg * 32 + wi];
                    if (!found && cum + c >= need) { found = true; fbin = (unsigned)wi; fneed = need - cum; fcnt = c; } if (!found) cum += c; }
                fbin += 32u * (unsigned)seg;
                unsigned na, nlen;
                if (level == 1) { const unsigned base1 = st[160 + q];
                    if (fbin == 0u) { na = 0u; nlen = base1 + 131072u; } else if (fbin == 511u) { na = base1 + 511u * 131072u; nlen = 0u - na; } else { na = base1 + fbin * 131072u; nlen = 131072u; } }
                else { const unsigned qa = st[q], qlen = st[192 + q]; const int sh = qlen > 512u ? (32 - __builtin_clz(qlen - 1u)) - 9 : 0;
                    na = qa + (fbin << sh); nlen = min(1u << sh, qlen - (fbin << sh)); }
                st[q] = na; st[192 + q] = nlen; st[32 + q] = fneed; st[64 + q] = fcnt;
                if (fcnt > (unsigned)CAND_CAP && nlen > 1u) st[128] = 1u;
            }
        }
        __syncthreads();
#ifndef MAXLVL
#define MAXLVL 8
#endif
        const bool more = (st[128] != 0u) && (level < MAXLVL);
        __syncthreads();
        if (!more) break;
    }
    {
        const unsigned qa = st[r32], qlen = st[192 + r32]; const float cq = __builtin_bit_cast(float, st[224 + r32]);
        const unsigned Hk = qa + qlen - 1u;
        unsigned hb = (Hk & 0x80000000u) ? (Hk ^ 0x80000000u) : ~Hk;
        if (hb == 0x80000000u) hb = 0x80000001u;
        const float fH = __builtin_bit_cast(float, hb);
        const unsigned ab_ = (qa & 0x80000000u) ? (qa ^ 0x80000000u) : ~qa;
        const float fA = (qa < 0x00800000u) ? -__builtin_inff() : __builtin_bit_cast(float, ab_);
        bf16x8 kn[2][4]; if (wave < npair) { IDX_KLOAD2(wave) }
        for (int tp = wave; tp < npair; tp += NWAVES) {
            IDX_SCORES2(tp)
#define IDX_COLLECT_ELEMS(SC, T) { unsigned v = 0u; _Pragma("unroll") for (int i = 15; i >= 0; --i) { const float ts = SC[i] + cq; const bool ab = ts > fH; v = v + v + (ab ? 1u : 0u); \
                if (!ab && ts >= fA) { const unsigned key = mono_key(ts); \
                    const unsigned pos = __hip_atomic_fetch_add(&st[96 + r32], 1u, __ATOMIC_RELAXED, __HIP_MEMORY_SCOPE_WORKGROUP); \
                    if (pos < (unsigned)CAND_CAP) { cand[(r32 * CAND_CAP + pos) * 2] = key; cand[(r32 * CAND_CAP + pos) * 2 + 1] = (unsigned)(32 * (T) + crow(i, hi)); } } } \
            unsigned bits = (v & 0xfu) | ((v & 0xf0u) << 4) | ((v & 0xf00u) << 8) | ((v & 0xf000u) << 12);     \
            bits <<= 4 * hi; bits = half_or(bits); if (hi == 0) img[(T) * 32 + r32] = bits; }
            IDX_COLLECT_ELEMS(sc0, 2 * tp)
            IDX_COLLECT_ELEMS(sc1, 2 * tp + 1)
#undef IDX_COLLECT_ELEMS
        }
    }
#undef IDX_SCORES2
#undef IDX_KLOAD2
    __syncthreads();
    {
        const int q = tid >> 4; const unsigned n = min(st[96 + q], (unsigned)CAND_CAP), need = st[32 + q];
        for (unsigned c = tid & 15; c < n; c += 16) { const unsigned key = cand[(q * CAND_CAP + c) * 2], idx = cand[(q * CAND_CAP + c) * 2 + 1]; unsigned rank = 0u;
            for (unsigned o = 0; o < n; ++o) { const unsigned k2 = cand[(q * CAND_CAP + o) * 2], i2 = cand[(q * CAND_CAP + o) * 2 + 1]; rank += (k2 > key || (k2 == key && i2 < idx)) ? 1u : 0u; }
            if (rank < need) __hip_atomic_fetch_or(&img[(idx >> 5) * 32 + q], 1u << (idx & 31), __ATOMIC_RELAXED, __HIP_MEMORY_SCOPE_WORKGROUP); }
    }
    }
    __syncthreads();
    for (int idx = tid; idx < ntile * 32; idx += NTHR) P.BM[((size_t)b * 256 + (idx >> 5)) * SEQ + q0 + (idx & 31)] = img[idx];
    __syncthreads();
}

__device__ __forceinline__ int wq_next(Frame& F, int cw) {
    __syncthreads();
    if (F_TID == 0) F.MISC[0] = __hip_atomic_fetch_add((unsigned*)(F.ctl + cw), 1u, RLX_AGENT);
    __syncthreads();
    return (int)F.MISC[0];
}

__device__ __forceinline__ void p5a_route(Frame& F, const Args& A) {
    const int lane = F_LANE, tid = F_TID, wave = F_WAVE;
    const float* x1 = A.out; const float* g2 = A.in[11];
    const float* wrg = A.in[12]; const float* brg = A.in[13]; const float* wre = A.in[14]; const float* bre = A.in[15];
    int* toke = (int*)(F.ws + WS_TOKE); float* tokw = (float*)(F.ws + WS_TOKW); float* rstd2 = (float*)(F.ws + WS_RSTD2);
    int* sslot = (int*)(F.ws + WS_SSLOT);
    constexpr int WST = 44, WCH = 256 * WST * 4;
    LAS float* wl = (LAS float*)F.lds;
    LAS unsigned* lcnt = (LAS unsigned*)(F.lds + 2 * WCH);
    LAS float* lgs = (LAS float*)(F.lds + 2 * WCH + 256);
    for (int i = F.vcu * NTHR + tid; i < SORT_ROWS; i += F.G * NTHR) sslot[i] = -1;
    if (tid < NEXP) lcnt[tid] = 0u;
    const int i16 = lane & 15, kq = lane >> 4, tile = wave & 3, half = wave >> 2;
    const int per = T / F.G;
    for (int t0 = F.vcu * per; t0 < (F.vcu + 1) * per; t0 += 64) {
        const float* xr = x1 + (size_t)(t0 + 16 * tile + i16) * D + 4 * kq;
        f32x4 acc0 = (f32x4){0.f, 0.f, 0.f, 0.f}, acc1 = acc0; float ss = 0.f;
        f32x4 se[4], sg; float gk[5];
#define RT_LOAD(c) do { _Pragma("unroll") for (int q = 0; q < 4; ++q) { const int f = tid + 512 * q, k = f >> 3; se[q] = *(const GAS f32x4*)(wre + (size_t)(256 * (c) + k) * 32 + 4 * (f & 7)); gk[q] = g2[256 * (c) + k]; } \
            { const int k = tid >> 1; sg = *(const GAS f32x4*)(wrg + (size_t)(256 * (c) + k) * 8 + 4 * (tid & 1)); gk[4] = g2[256 * (c) + k]; } } while (0)
#define RT_WRITE(bf) do { LAS float* wb = wl + (bf) * (WCH / 4); _Pragma("unroll") for (int q = 0; q < 4; ++q) { const int f = tid + 512 * q, k = f >> 3; *(LAS f32x4*)(wb + k * WST + 4 * (f & 7)) = se[q] * gk[q]; } \
            { const int k = tid >> 1; *(LAS f32x4*)(wb + k * WST + 32 + 4 * (tid & 1)) = sg * gk[4]; } } while (0)
        f32x4 xa[16];
#pragma unroll
        for (int s = 0; s < 16; ++s) xa[s] = *(const GAS f32x4*)(xr + 16 * s);
        RT_LOAD(0); RT_WRITE(0); __syncthreads();
#pragma unroll
        for (int c = 0; c < 4; ++c) {
            if (c + 1 < 4) RT_LOAD(c + 1);
            const LAS float* wb = wl + (c & 1) * (WCH / 4) + 4 * kq * WST + i16 + 16 * half;
#pragma unroll
            for (int s = 0; s < 16; ++s) {
                const f32x4 a4 = xa[s];
                if (half == 0) ss += (a4.x * a4.x + a4.y * a4.y) + (a4.z * a4.z + a4.w * a4.w);
#pragma unroll
                for (int cc = 0; cc < 4; ++cc) { const LAS float* wp = wb + (16 * s + cc) * WST;
                    acc0 = __builtin_amdgcn_mfma_f32_16x16x4f32(a4[cc], wp[0], acc0, 0, 0, 0);
                    if (half == 0) acc1 = __builtin_amdgcn_mfma_f32_16x16x4f32(a4[cc], wp[32 - (i16 & 8)], acc1, 0, 0, 0); }
            }
            if (c + 1 < 4) {
#pragma unroll
                for (int s = 0; s < 16; ++s) xa[s] = *(const GAS f32x4*)(xr + 256 * (c + 1) + 16 * s);
                RT_WRITE((c + 1) & 1); }
            __syncthreads();
        }
#undef RT_LOAD
#undef RT_WRITE
        LAS float* lt = lgs + tile * 640;
#pragma unroll
        for (int r = 0; r < 4; ++r) { const int tk = 4 * kq + r; lt[tk * 40 + 8 + 16 * half + i16] = acc0[r]; if (half == 0 && i16 < 8) lt[tk * 40 + i16] = acc1[r]; }
        if (half == 0) { ss += __shfl_xor(ss, 16); ss += __shfl_xor(ss, 32); if (kq == 0) lgs[2560 + 16 * tile + i16] = 1.f / sqrtf(ss * (1.f / D) + EPS); }
        __syncthreads();
        if (half == 0 && lane < 16) {
            const int m = t0 + 16 * tile + lane; const float rstd = lgs[2560 + 16 * tile + lane]; const LAS float* lg = lt + lane * 40;
            float gl[8];
#pragma unroll
            for (int k = 0; k < 8; ++k) gl[k] = lg[k] * rstd + brg[k];
            int gs = 0; float gm = gl[0];
#pragma unroll
            for (int k = 1; k < 8; ++k) if (gl[k] > gm) { gm = gl[k]; gs = k; }
            float den = 0.f;
#pragma unroll
            for (int k = 0; k < 8; ++k) den += __expf(gl[k] - gm);
            const float wgrp = 1.f / den;
            float el[4];
#pragma unroll
            for (int cc = 0; cc < 4; ++cc) el[cc] = lg[8 + 4 * gs + cc] * rstd + bre[4 * gs + cc];
            int i1 = 0; float v1 = el[0];
#pragma unroll
            for (int cc = 1; cc < 4; ++cc) if (el[cc] > v1) { v1 = el[cc]; i1 = cc; }
            int i2 = -1; float v2 = 0.f;
#pragma unroll
            for (int cc = 0; cc < 4; ++cc) if (cc != i1 && (i2 < 0 || el[cc] > v2)) { v2 = el[cc]; i2 = cc; }
            const float e2 = __expf(v2 - v1), w1 = 1.f / (1.f + e2), w2 = e2 / (1.f + e2);
            toke[2 * m] = gs * 4 + i1; toke[2 * m + 1] = gs * 4 + i2; tokw[2 * m] = w1 * wgrp; tokw[2 * m + 1] = w2 * wgrp; rstd2[m] = rstd;
            __hip_atomic_fetch_add(&lcnt[gs * 4 + i1], 1u, __ATOMIC_RELAXED, __HIP_MEMORY_SCOPE_WORKGROUP);
            __hip_atomic_fetch_add(&lcnt[gs * 4 + i2], 1u, __ATOMIC_RELAXED, __HIP_MEMORY_SCOPE_WORKGROUP);
        }
        __syncthreads();
    }
    if (tid < NEXP && lcnt[tid]) __hip_atomic_fetch_add((unsigned*)(F.ctl + CW_CNT + tid), lcnt[tid], RLX_AGENT);
}

__device__ __forceinline__ void p5a2_scatter(Frame& F, const Args& A) {
    const int lane = F_LANE, tid = F_TID;
    const float* x1 = A.out; const float* g2 = A.in[11];
    const int* toke = (const int*)(F.ws + WS_TOKE); const float* tokw = (const float*)(F.ws + WS_TOKW); const float* rstd2 = (const float*)(F.ws + WS_RSTD2);
    int* sslot = (int*)(F.ws + WS_SSLOT); float* sw = (float*)(F.ws + WS_SW); int* t2e = (int*)(F.ws + WS_T2E);
    bf16* AS = (bf16*)(F.ws + WS_ASORT);
    LAS unsigned* sh = (LAS unsigned*)F.lds;
    if (tid < NEXP) sh[256 + tid] = __hip_atomic_load((unsigned*)(F.ctl + CW_CNT + tid), RLX_AGENT);
    __syncthreads();
    if (tid == 0) { unsigned acc = 0u;
        for (int e = 0; e < NEXP; ++e) { const unsigned c = sh[256 + e]; sh[e] = acc; const unsigned nt = (c + 255u) / 256u;
            if (blockIdx.x == 0) for (unsigned i = 0; i < nt; ++i) t2e[acc / 256u + i] = e;
            acc += nt * 256u; }
        if (blockIdx.x == 0) t2e[255] = (int)(acc / 256u); }
    const int per = T / F.G;
    for (int t0 = F.vcu * per; t0 < (F.vcu + 1) * per; t0 += 64) {
        if (tid < NEXP) sh[32 + tid] = 0u;
        __syncthreads();
        int e = 0; unsigned lpos = 0u;
        if (tid < 128) { e = toke[2 * t0 + tid]; lpos = __hip_atomic_fetch_add(&sh[32 + e], 1u, __ATOMIC_RELAXED, __HIP_MEMORY_SCOPE_WORKGROUP); }
        __syncthreads();
        if (tid < NEXP) sh[64 + tid] = sh[tid] + (sh[32 + tid] ? __hip_atomic_fetch_add((unsigned*)(F.ctl + CW_FILL + tid), sh[32 + tid], RLX_AGENT) : 0u);
        __syncthreads();
        if (tid < 128) { const unsigned pos = sh[64 + e] + lpos; sh[96 + tid] = pos; sslot[pos] = 2 * t0 + tid; sw[pos] = tokw[2 * t0 + tid]; }
        __syncthreads();
        for (int tk0 = F_WAVE; tk0 < 64; tk0 += 4 * NWAVES) {
            f32x4 xv[4][4];
#pragma unroll
            for (int r = 0; r < 4; ++r) { const GAS f32x4* xr = (const GAS f32x4*)(x1 + (size_t)(t0 + tk0 + r * NWAVES) * D) + lane;
#pragma unroll
                for (int j = 0; j < 4; ++j) xv[r][j] = xr[64 * j]; }
#pragma unroll
            for (int r = 0; r < 4; ++r) { const int tk = tk0 + r * NWAVES, m = t0 + tk; const float rstd = rstd2[m];
                const unsigned p0 = sh[96 + 2 * tk], p1 = sh[96 + 2 * tk + 1];
#pragma unroll
                for (int j = 0; j < 4; ++j) { const f32x4 g = *((const GAS f32x4*)g2 + lane + 64 * j); const f32x4 y = xv[r][j] * rstd * g; v2u w; w.x = pk2(y.x, y.y); w.y = pk2(y.z, y.w);
                    *((GAS v2u*)(AS + (size_t)p0 * D) + lane + 64 * j) = w; *((GAS v2u*)(AS + (size_t)p1 * D) + lane + 64 * j) = w; } } }
        __syncthreads();
    }
}

__device__ __forceinline__ void p6_final(Frame& F, const Args& A) {
    const int gw = F.vcu * NWAVES + F_WAVE, NGW = F.G * NWAVES, lane = F_LANE;
    const float* gf = A.in[19]; float* out = A.out; const bf16* SL = (const bf16*)(F.ws + WS_SLOTS);
    for (int m0 = gw; m0 < T; m0 += 2 * NGW) {
        f32x4 v[2][4]; v2u a[2][4], c[2][4];
#pragma unroll
        for (int r = 0; r < 2; ++r) { const int m = min(m0 + r * NGW, T - 1); const GAS f32x4* xr = (const GAS f32x4*)(out + (size_t)m * D) + lane;
            const GAS v2u* s0 = (const GAS v2u*)(SL + (size_t)(2 * m) * D) + lane; const GAS v2u* s1 = (const GAS v2u*)(SL + (size_t)(2 * m + 1) * D) + lane;
#pragma unroll
            for (int j = 0; j < 4; ++j) { v[r][j] = xr[64 * j]; a[r][j] = s0[64 * j]; c[r][j] = s1[64 * j]; } }
#pragma unroll
        for (int r = 0; r < 2; ++r) { const int m = m0 + r * NGW; float s = 0.f;
#pragma unroll
            for (int j = 0; j < 4; ++j) { f32x4& w = v[r][j];
                w.x += bflo(a[r][j].x) + bflo(c[r][j].x); w.y += bfhi(a[r][j].x) + bfhi(c[r][j].x); w.z += bflo(a[r][j].y) + bflo(c[r][j].y); w.w += bfhi(a[r][j].y) + bfhi(c[r][j].y);
                s += (w.x * w.x + w.y * w.y) + (w.z * w.z + w.w * w.w); }
            const float rstd = 1.f / sqrtf(wave_sum(s) * (1.f / D) + EPS);
            if (m < T) { GAS f32x4* xo = (GAS f32x4*)(out + (size_t)m * D) + lane;
#pragma unroll
                for (int j = 0; j < 4; ++j) { const f32x4 g = *((const GAS f32x4*)gf + lane + 64 * j); xo[64 * j] = v[r][j] * rstd * g; } } }
    }
}

constexpr int NPHASE = 13;
__global__ void __launch_bounds__(NTHR, 2) mk_fwd(Args args) {
    extern __shared__ __attribute__((aligned(16))) unsigned char lds[];
    Frame F;
    F.lds = (LAS unsigned char*)lds; F.MISC = (volatile LAS unsigned*)(F.lds + MISC_OFF);
        F.G = gridDim.x; { const int bx = blockIdx.x; F.vcu = (F.G % 8 == 0) ? (bx % 8) * (F.G / 8) + bx / 8 : bx; }
    F.ws = args.ws; F.ctl = (gu32*)(args.ws + WS_CTL);
    unsigned char* ws = args.ws;
    if (F_TID < 128) F.MISC[F_TID] = 0u;
    __syncthreads();
    const bool single = (args.ph_hi - args.ph_lo) > 1;
    XcdBarrier bar; bar.bar = (unsigned*)(F.ctl + CW_BAR); bar.x = 0; bar.st = nullptr;
    if (single) bar = xcd_barrier_post((unsigned*)(F.ctl + CW_BAR), F.MISC + 8);
    const int lo = args.ph_lo, hi = args.ph_hi;
#ifdef ONLY
#define IN(k) ((k) == ONLY && lo <= (k) && (k) < hi)
#else
#define IN(k) (lo <= (k) && (k) < hi)
#endif
#ifdef TS_A
#define STAMP(k) do { if (blockIdx.x == 0 && threadIdx.x == 0) ((unsigned long long*)(ws + WS_CTL + 8192))[(k) + 1] = __builtin_amdgcn_s_memrealtime(); } while (0)
#else
#define STAMP(k) do { } while (0)
#endif
#define SEAM(k) do { if (IN((k) + 1)) xcd_barrier(bar); STAMP(k); } while (0)
    const f32x2* rope = (const f32x2*)(ws + WS_ROPE);
    bf16* GA = (bf16*)args.out; bf16* GB = (bf16*)args.out + (size_t)T * 1024;

    STAMP(-1);
    if (IN(0)) { p0_prologue(F, args);
#ifdef REP_P0
        p0_prologue(F, args);
#endif
        SEAM(0); }
    if (IN(1)) {
        pg8::Gemm g{(const bf16*)(ws + WS_H), (const bf16*)(ws + WS_WIN), T, NIN, D, 0}; pg8::StaticOrder S; S.init(T, NIN, F.G, (int)blockIdx.x);
        pg8::EpiIn E{(bf16*)(ws + WS_CQ), (bf16*)(ws + WS_CKV), (bf16*)(ws + WS_QB), (bf16*)(ws + WS_KB), (bf16*)(ws + WS_VB), (bf16*)(ws + WS_QI), (bf16*)(ws + WS_KI), (bf16*)(ws + WS_KR), GA, GB, (float*)(ws + WS_WI), rope, (float*)(ws + WS_PART)};
        pg8::gemm_phase<pg8::EpiIn, pg8::StaticOrder, true, true>(F.lds, g, S, E);
#ifdef REP_P1
        pg8::gemm_phase<pg8::EpiIn, pg8::StaticOrder, true, true>(F.lds, g, S, E);
#endif
#ifdef CONV_AT_P1
        for (;;) { const int c = wq_next(F, CW_Q2); if (c >= CV_QITEMS) break;
            int ltid = threadIdx.x; asm volatile("" : "+v"(ltid));
            const int lw = __builtin_amdgcn_readfirstlane(ltid >> 6); LAS float* scr = (LAS float*)(F.lds + lw * 16640);
            conv_tile2(args, ws, CV_EARLY + 16 * c + lw, CV_EARLY + 16 * c + 8 + lw, scr, ltid & 63); }
#endif
        SEAM(1);
    }
#ifdef P2A_OLD
    if (IN(2)) { p2a_norms(F, args); SEAM(2); }
#endif
    if (IN(3)) {
#ifdef REP_P3
      for (int rep = 0; rep < 2; ++rep) {
#else
      {
#endif
#ifndef NO3A
        { pg8::Gemm g{(const bf16*)(ws + WS_CQ), (const bf16*)(ws + WS_WUQ), T, 768, 384, 0}; pg8::StaticOrder S; S.init(T, 768, F.G, (int)blockIdx.x);
          LAS float* rsl = (LAS float*)(F.lds + 131072);
          { pg8::Unit u0; if (S.next(0, u0) && F_TID < 256) { const f32x4* pp = (const f32x4*)((const float*)(ws + WS_PART) + (size_t)(u0.pm * 256 + F_TID) * 20); const f32x4 a = pp[0], b = pp[1], c = pp[2];
              rsl[F_TID] = C2A / sqrtf(((((a[0] + a[1]) + (a[2] + a[3])) + ((b[0] + b[1]) + (b[2] + b[3]))) + ((c[0] + c[1]) + (c[2] + c[3]))) * (1.f / 384.f) + EPS); } }
          __syncthreads();
          pg8::EpiQA E{(bf16*)(ws + WS_QA), rope, rsl}; pg8::gemm_phase<pg8::EpiQA, pg8::StaticOrder, true, true>(F.lds, g, S, E); }
#endif
#ifndef NO3B
        { pg8::Gemm g{(const bf16*)(ws + WS_CKV), (const bf16*)(ws + WS_WUKV), T, 1024, 256, 0}; pg8::StaticOrder S; S.init(T, 1024, F.G, (int)blockIdx.x);
          LAS float* rsl = (LAS float*)(F.lds + 131072 + 1024);
          { pg8::Unit u0; if (S.next(0, u0) && F_TID < 256) { const f32x4* pp = (const f32x4*)((const float*)(ws + WS_PART) + (size_t)(u0.pm * 256 + F_TID) * 20 + 12); const f32x4 a = pp[0], b = pp[1];
              rsl[F_TID] = 1.f / sqrtf((((a[0] + a[1]) + (a[2] + a[3])) + ((b[0] + b[1]) + (b[2] + b[3]))) * (1.f / 256.f) + EPS); } }
          __syncthreads();
          pg8::EpiKV E{(bf16*)(ws + WS_KN), (bf16*)(ws + WS_VA), rsl}; pg8::gemm_phase<pg8::EpiKV, pg8::StaticOrder, true, true>(F.lds, g, S, E); }
#endif
      }
        SEAM(3);
    }
    if (IN(4)) {
        unsigned* rdy = (unsigned*)(F.ctl + CW_RDY);
#ifndef CONV_AT_P1
        constexpr int NCVQ = CV_QITEMS;
#else
        constexpr int NCVQ = 0;
#endif
        for (;;) { const int k = wq_next(F, CW_Q1); if (k >= 1536 + NCVQ) break;
            int ltid = threadIdx.x; asm volatile("" : "+v"(ltid));
            const int lw = __builtin_amdgcn_readfirstlane(ltid >> 6);
            if (k < 512) { const int ib = k & 1, ij = 255 - (k >> 1);
                const IdxP IP{(const bf16*)(ws + WS_QI), (const bf16*)(ws + WS_KI), (const float*)(ws + WS_WI), (unsigned*)(ws + WS_BM), (unsigned*)(F.ctl + 1024)};
                idx_item(F.lds, ib, ij, IP, ltid, ltid & 63, lw);
#ifdef REP_IDX
                __syncthreads(); idx_item(F.lds, ib, ij, IP, ltid, ltid & 63, lw);
#endif
                VM_WAIT(); __syncthreads();
                if (ltid == 0) { __builtin_amdgcn_fence(__ATOMIC_RELEASE, "agent"); VM_WAIT(); __hip_atomic_fetch_add(rdy + 64 * (ib * 32 + (ij >> 3)), 1u, RLX_AGENT); }
                continue; }
            const int j = k - 512; int a;
            if (j < 3 * NCVQ) { const int q3 = j / 3, r3 = j - 3 * q3; a = (r3 == 2) ? -1 - q3 : 2 * q3 + r3; } else a = j - NCVQ;
            if (a < 0) { const int c = -1 - a; LAS float* scr = (LAS float*)(F.lds + lw * 16640);
                conv_tile2(args, ws, CV_EARLY + 16 * c + lw, CV_EARLY + 16 * c + 8 + lw, scr, ltid & 63);
                continue; }
            { const int u = a >> 1, ub = (u & 15) >> 3, uh = u & 7, uq = 31 - (u >> 4);
                if (a & 1) { const AttnP APA{(const bf16*)(ws + WS_QA), (const bf16*)(ws + WS_KN), (const bf16*)(ws + WS_KR), (const bf16*)(ws + WS_VA), (bf16*)(ws + WS_OA), nullptr};
#ifdef MLA_OLD
                    attn_unit<true>(F.lds, ub, uh, uq, APA, ltid, ltid & 63, lw); }
#else
                    attn_body::attn_unit<8, true>(ub, uh, uq, (const attn_body::bf16*)APA.Q, (const attn_body::bf16*)APA.K, (const attn_body::bf16*)APA.K2, (const attn_body::bf16*)APA.V, (attn_body::bf16*)APA.O, nullptr, (char*)F.lds, ltid); }
#endif
                else { const AttnP APB{(const bf16*)(ws + WS_QB), (const bf16*)(ws + WS_KB), nullptr, (const bf16*)(ws + WS_VB), (bf16*)(ws + WS_OB), (const unsigned*)(ws + WS_BM)};
                    if (ltid == 0) { unsigned sp = 0u; while (__hip_atomic_load(rdy + 64 * (ub * 32 + uq), RLX_AGENT) < 8u) { __builtin_amdgcn_s_sleep(8); if (++sp > (1u << 22)) break; }
                        __builtin_amdgcn_fence(__ATOMIC_ACQUIRE, "agent"); VM_WAIT(); }
                    __syncthreads();
#ifdef DSA_OLD
                    attn_unit<false>(F.lds, ub, uh, uq, APB, ltid, ltid & 63, lw); } }
#else
                    attn_body::attn_unit<8, false>(ub, uh, uq, (const attn_body::bf16*)APB.Q, (const attn_body::bf16*)APB.K, nullptr, (const attn_body::bf16*)APB.V, (attn_body::bf16*)APB.O, APB.BM, (char*)F.lds, ltid); } }
#endif
        }
    }
    if (IN(5)) { SEAM(5); }
    if (IN(6)) {
#ifdef REP_P6
      for (int rep = 0; rep < 2; ++rep) {
#else
      {
#endif
        { pg8::Gemm g{(const bf16*)(ws + WS_OA), (const bf16*)(ws + WS_WOA), T, 1024, 512, 0}; pg8::StaticOrder S; S.init(T, 1024, F.G, (int)blockIdx.x);
          pg8::EpiY<0> E{(bf16*)(ws + WS_Y), GA}; pg8::gemm_phase<pg8::EpiY<0>, pg8::StaticOrder, true, true>(F.lds, g, S, E); }
        { pg8::Gemm g{(const bf16*)(ws + WS_OB), (const bf16*)(ws + WS_WOB), T, 1024, 512, 0}; pg8::StaticOrder S; S.init(T, 1024, F.G, (int)blockIdx.x);
          pg8::EpiY<1> E{(bf16*)(ws + WS_Y), GB}; pg8::gemm_phase<pg8::EpiY<1>, pg8::StaticOrder, true, true>(F.lds, g, S, E); }
      }
        SEAM(6);
    }
    if (IN(7)) {
        pg8::Gemm g{(const bf16*)(ws + WS_Y), (const bf16*)(ws + WS_WOUT), T, 1024, 1024, 0}; pg8::StaticOrder S; S.init(T, 1024, F.G, (int)blockIdx.x);
        pg8::EpiX1 E{args.in[0], args.out}; pg8::gemm_phase<pg8::EpiX1, pg8::StaticOrder, true, true>(F.lds, g, S, E);
#ifdef REP_P7
        pg8::gemm_phase<pg8::EpiX1, pg8::StaticOrder, true, true>(F.lds, g, S, E);
#endif
        SEAM(7);
    }
    if (IN(8)) { p5a_route(F, args); SEAM(8); }
    if (IN(9)) { p5a2_scatter(F, args); SEAM(9); }
#ifdef MOE_TWO_PHASES
    if (IN(10)) {
        const int* t2e = (const int*)(ws + WS_T2E); const int ntl = t2e[255];
        pg8::Gemm g{(const bf16*)(ws + WS_ASORT), (const bf16*)(ws + WS_WGU), SORT_ROWS, 512, 1024, (size_t)512 * 1024 * 2}; pg8::GroupOrder S; S.init(ntl, 2, F.G, (int)blockIdx.x, t2e);
        pg8::EpiHid E{(bf16*)(ws + WS_HID)}; pg8::gemm_phase<pg8::EpiHid, pg8::GroupOrder, true, true>(F.lds, g, S, E);
#ifdef REP_P10
        pg8::gemm_phase<pg8::EpiHid, pg8::GroupOrder, true, true>(F.lds, g, S, E);
#endif
        SEAM(10);
    }
    if (IN(11)) {
        const int* t2e = (const int*)(ws + WS_T2E); const int ntl = t2e[255];
        pg8::Gemm g{(const bf16*)(ws + WS_HID), (const bf16*)(ws + WS_WD), SORT_ROWS, 1024, 256, (size_t)1024 * 256 * 2}; pg8::GroupOrder S; S.init(ntl, 4, F.G, (int)blockIdx.x, t2e);
        pg8::EpiDown E{(bf16*)(ws + WS_SLOTS), (const int*)(ws + WS_SSLOT), (const float*)(ws + WS_SW)}; pg8::gemm_phase<pg8::EpiDown, pg8::GroupOrder, true, true>(F.lds, g, S, E);
#ifdef REP_P11
        pg8::gemm_phase<pg8::EpiDown, pg8::GroupOrder, true, true>(F.lds, g, S, E);
#endif
        SEAM(11);
    }
#else
    if (IN(10)) {
        const int* t2e = (const int*)(ws + WS_T2E); const int ntl = t2e[255], n10 = 2 * ntl, n11 = 4 * ntl;
        unsigned* hrdy = (unsigned*)(F.ctl + CW_HRDY);
        const pg8::Gemm g10{(const bf16*)(ws + WS_ASORT), (const bf16*)(ws + WS_WGU), SORT_ROWS, 512, 1024, (size_t)512 * 1024 * 2};
        const pg8::Gemm g11{(const bf16*)(ws + WS_HID), (const bf16*)(ws + WS_WD), SORT_ROWS, 1024, 256, (size_t)1024 * 256 * 2};
        const pg8::EpiHid E10{(bf16*)(ws + WS_HID)}; const pg8::EpiDown E11{(bf16*)(ws + WS_SLOTS), (const int*)(ws + WS_SSLOT), (const float*)(ws + WS_SW)};
        for (;;) { const int k = wq_next(F, CW_Q3); if (k >= n10 + n11) break;
            if (k < n10) { const int pm = k >> 1; pg8::OneUnit S{pm, k & 1, __builtin_amdgcn_readfirstlane(t2e[pm])};
                pg8::gemm_phase<pg8::EpiHid, pg8::OneUnit, true, true>(F.lds, g10, S, E10);
                VM_WAIT(); __syncthreads();
                if (F_TID == 0) { __builtin_amdgcn_fence(__ATOMIC_RELEASE, "agent"); VM_WAIT(); __hip_atomic_fetch_add(hrdy + 64 * pm, 1u, RLX_AGENT); }
            } else { const int j = k - n10, pm = j >> 2; pg8::OneUnit S{pm, j & 3, __builtin_amdgcn_readfirstlane(t2e[pm])};
                if (F_TID == 0) { unsigned sp = 0u; while (__hip_atomic_load(hrdy + 64 * pm, RLX_AGENT) < 2u) { __builtin_amdgcn_s_sleep(8); if (++sp > (1u << 22)) break; }
                    __builtin_amdgcn_fence(__ATOMIC_ACQUIRE, "agent"); VM_WAIT(); }
                __syncthreads();
                pg8::gemm_phase<pg8::EpiDown, pg8::OneUnit, true, true>(F.lds, g11, S, E11);
            }
        }
    }
    if (IN(11)) { SEAM(11); }
#endif
    if (IN(12)) { p6_final(F, args); }
#ifdef DIAG_SLOW
    if (blockIdx.x == 0 && threadIdx.x == 0) { const unsigned long long t0 = __builtin_amdgcn_s_memrealtime(), wait = 100ull * __hip_atomic_load((unsigned*)(F.ctl + 1024), RLX_AGENT);
        while (__builtin_amdgcn_s_memrealtime() - t0 < wait) __builtin_amdgcn_s_sleep(16); }
#endif
#ifdef TS_A
    if (blockIdx.x == 0 && threadIdx.x == 0) { STAMP(12); __builtin_amdgcn_s_waitcnt(0);
        const unsigned long long* tsp = (const unsigned long long*)(ws + WS_CTL + 8192);
        const unsigned long long ta = __hip_atomic_load(tsp + (TS_A) + 1, RLX_AGENT), tb = __hip_atomic_load(tsp + (TS_B) + 1, RLX_AGENT);
        const unsigned long long t0 = __builtin_amdgcn_s_memrealtime(), wait = 4ull * (tb - ta);
        while (__builtin_amdgcn_s_memrealtime() - t0 < wait) __builtin_amdgcn_s_sleep(16); }
#endif
#undef IN
#undef SEAM
}

#ifndef MK_MULTI
#define MK_MULTI 0
#endif
extern "C" void kernel_launch(void* const* d_in, const int* in_sizes, int n_in, void* d_out, int out_size, void* d_ws, size_t ws_size, hipStream_t stream) {
    static int grid = 0;
    if (grid == 0) {
        if (n_in != 20 || in_sizes[0] != T * D || out_size != T * D || ws_size < WS_END) { fprintf(stderr, "kernel_launch: unexpected shapes n_in %d in0 %d out %d ws %zu\n", n_in, n_in > 0 ? in_sizes[0] : -1, out_size, ws_size); grid = -1; return; }
        int dev = 0, cus = 0;
        if (hipGetDevice(&dev) != hipSuccess || hipDeviceGetAttribute(&cus, hipDeviceAttributeMultiprocessorCount, dev) != hipSuccess) { grid = -1; return; }
        if (hipFuncSetAttribute((const void*)mk_fwd, hipFuncAttributeMaxDynamicSharedMemorySize, LDS_BYTES) != hipSuccess) { fprintf(stderr, "kernel_launch: hipFuncSetAttribute failed\n"); grid = -1; return; }
        (void)hipGetLastError();
        grid = cus;
    }
    if (grid < 0) return;
    if (hipMemsetAsync((char*)d_ws + WS_CTL, 0, CTL_ZERO_BYTES, stream) != hipSuccess) return;
    Args a{};
    for (int i = 0; i < 20; ++i) a.in[i] = (const float*)d_in[i];
    a.out = (float*)d_out; a.ws = (unsigned char*)d_ws;
#if MK_MULTI
    for (int p = 0; p < NPHASE; ++p) { a.ph_lo = p; a.ph_hi = p + 1; hipLaunchKernelGGL(mk_fwd, dim3(grid), dim3(NTHR), LDS_BYTES, stream, a); }
#else
    a.ph_lo = 0; a.ph_hi = NPHASE;
    hipLaunchKernelGGL(mk_fwd, dim3(grid), dim3(NTHR), LDS_BYTES, stream, a);
#endif
}
```

```cpp
#include <hip/hip_runtime.h>
#include <hip/hip_bf16.h>
#include <cstdio>
#include <cstdint>

#define GAS __attribute__((address_space(1)))
#define LAS __attribute__((address_space(3)))
typedef unsigned short bf16;
typedef unsigned v4u __attribute__((ext_vector_type(4)));
typedef unsigned v2u __attribute__((ext_vector_type(2)));
typedef float f32x4 __attribute__((ext_vector_type(4)));
typedef float f32x2 __attribute__((ext_vector_type(2)));
typedef float f32x16 __attribute__((ext_vector_type(16)));
typedef short bf16x8 __attribute__((ext_vector_type(8)));
typedef short s16x4 __attribute__((ext_vector_type(4)));
typedef __bf16 bf16x2_t __attribute__((ext_vector_type(2)));
typedef GAS unsigned gu32;
#define RLX_AGENT __ATOMIC_RELAXED, __HIP_MEMORY_SCOPE_AGENT
#define LDS_WAIT() asm volatile("s_waitcnt lgkmcnt(0)" ::: "memory")
#define VM_WAIT() asm volatile("s_waitcnt vmcnt(0)" ::: "memory")

constexpr int NWAVES = 8, NTHR = NWAVES * 64;
constexpr int BATCH = 2, SEQ = 8192, D = 1024, T = BATCH * SEQ;
constexpr float EPS = 1e-6f;
constexpr int NIN = 4864, NIN_SRC = 4840;
constexpr int C_CQ = 0, C_CKV = 384, C_QB = 640, C_KB = 1152, C_VB = 1664, C_QI = 2176, C_KR = 2688, C_KI = 2720, C_WI = 2784, C_GA = 2816, C_GB = 3840;
constexpr int NEXP = 32, FF = 256;
constexpr int SORT_ROWS = 2 * T + NEXP * 256;
constexpr float LOG2E = 1.4426950408889634f;
constexpr float C2A = 0.10206207261596575f * LOG2E;
constexpr float C2B = 0.125f * LOG2E;
constexpr float WI_SCALE = 0.35355339059327373f * 0.125f;

constexpr size_t MiB = 1u << 20, KiB = 1u << 10;
constexpr size_t WS_CTL = 0, CTL_ZERO_BYTES = 1 * MiB;
constexpr size_t WS_ROPE = 1 * MiB;
constexpr size_t WS_WI = 2 * MiB;
constexpr size_t WS_TOKE = 2 * MiB + 512 * KiB;
constexpr size_t WS_TOKW = WS_TOKE + 128 * KiB;
constexpr size_t WS_RSTD2 = WS_TOKW + 128 * KiB;
constexpr size_t WS_SSLOT = 3 * MiB + 512 * KiB;
constexpr size_t WS_SW = WS_SSLOT + 192 * KiB;
constexpr size_t WS_T2E = WS_SW + 192 * KiB;
constexpr size_t WS_WIN = 4 * MiB, WS_WUQ = 14 * MiB, WS_WUKV = 15 * MiB, WS_WOA = 16 * MiB, WS_WOB = 17 * MiB, WS_WOUT = 18 * MiB, WS_WGU = 20 * MiB, WS_WD = 52 * MiB;
constexpr size_t WS_H = 68 * MiB, WS_OA = 68 * MiB, WS_OB = 84 * MiB;
constexpr size_t WS_QA = 100 * MiB, WS_KN = 124 * MiB, WS_VA = 140 * MiB, WS_Y = 100 * MiB;
constexpr size_t WS_QB = 156 * MiB, WS_KB = 172 * MiB, WS_VB = 188 * MiB;
constexpr size_t WS_CQ = 204 * MiB, WS_CKV = 216 * MiB, WS_BM = 204 * MiB;
constexpr size_t WS_QI = 224 * MiB, WS_KI = 240 * MiB, WS_KR = 242 * MiB;
constexpr size_t WS_ASORT = 68 * MiB, WS_SLOTS = 156 * MiB, WS_HID = 220 * MiB;
constexpr size_t WS_PART = 244 * MiB;
constexpr size_t WS_END = 256 * MiB;
constexpr int CW_BAR = 4096;
constexpr int CW_Q1 = 64, CW_Q2 = 128;
constexpr int CW_CNT = 256, CW_FILL = 320;
constexpr int CW_Q3 = 192, CW_HRDY = 16384;
constexpr int CW_RDY = 8192;

constexpr int LDS_BYTES = 147456;
constexpr int MISC_OFF = 147456 - 512;

__device__ __forceinline__ unsigned f2bf(float f) { unsigned u = __builtin_bit_cast(unsigned, f); return (u + 0x7fffu + ((u >> 16) & 1u)) >> 16; }
__device__ __forceinline__ unsigned pk2(float lo, float hi) { f32x2 v = {lo, hi}; bf16x2_t b = __builtin_convertvector(v, bf16x2_t); return __builtin_bit_cast(unsigned, b); }
__device__ __forceinline__ float bflo(unsigned w) { return __builtin_bit_cast(float, w << 16); }
__device__ __forceinline__ float bfhi(unsigned w) { return __builtin_bit_cast(float, w & 0xffff0000u); }

#define XB_TMO      128
#define XB_XCNT(j)  (256  + 64 * (j))
#define XB_XSUB(j)  (1280 + 64 * (j))
#define XB_XGEN(j)  (2304 + 64 * (j))
#define XB_TOP      3328
#define XB_TOPGEN   3392
#define XCD_BAR_WORDS 3456
#define XB_SPIN_CAP (1u << 22)
__device__ __forceinline__ unsigned xb_ld(unsigned* p)              { return __hip_atomic_load(p, __ATOMIC_RELAXED, __HIP_MEMORY_SCOPE_AGENT); }
__device__ __forceinline__ unsigned xb_add(unsigned* p, unsigned v) { return __hip_atomic_fetch_add(p, v, __ATOMIC_RELAXED, __HIP_MEMORY_SCOPE_AGENT); }
__device__ __forceinline__ unsigned xb_xcc_id() { return (unsigned)__builtin_amdgcn_s_getreg((3 << 11) | 20) & 0xFu; }
#define XB_SPIN(cond, bar) do { unsigned _sp = 0; while (cond) { __builtin_amdgcn_s_sleep(1); \
    if ((++_sp & 255u) == 0u) { if (xb_ld(&(bar)[XB_TMO])) break; if (_sp > XB_SPIN_CAP) { atomicAdd(&(bar)[XB_TMO], 1u); break; } } } } while (0)
struct XcdBarrier { unsigned* bar; unsigned x; volatile LAS unsigned* st; };
__device__ __forceinline__ XcdBarrier xcd_barrier_post(unsigned* bar, volatile LAS unsigned* st) {
    XcdBarrier b; b.bar = bar; b.x = xb_xcc_id(); b.st = st;
    if (threadIdx.x == 0) (void)xb_add(&bar[XB_XCNT(b.x)], 1u);
    return b;
}
__device__ __forceinline__ void xcd_barrier_complete(unsigned* bar, unsigned x, unsigned& nloc, unsigned& nx) {
    const unsigned G = gridDim.x * gridDim.y * gridDim.z;
    unsigned sum, cnt, mine, sp = 0u;
    for (;;) {
        sum = 0u; cnt = 0u; mine = 0u;
#pragma unroll
        for (unsigned j = 0; j < 16; ++j) { const unsigned c = xb_ld(&bar[XB_XCNT(j)]); sum += c; cnt += (c > 0u) ? 1u : 0u; mine = (j == x) ? c : mine; }
        if (sum == G) break;
        __builtin_amdgcn_s_sleep(1);
        if ((++sp & 255u) == 0u) { if (xb_ld(&bar[XB_TMO])) break; if (sp > XB_SPIN_CAP) { atomicAdd(&bar[XB_TMO], 1u); break; } }
    }
    nloc = mine > 0u ? mine : 1u; nx = cnt > 0u ? cnt : 1u;
}
__device__ __forceinline__ void xcd_barrier(const XcdBarrier& b) {
    asm volatile("s_waitcnt vmcnt(0)" ::: "memory");
    __syncthreads();
    if (threadIdx.x == 0) {
        unsigned* bar = b.bar;
        __builtin_amdgcn_s_waitcnt(0);
        unsigned nloc = b.st[0], nx = b.st[1];
        if (nloc == 0u) { xcd_barrier_complete(bar, b.x, nloc, nx); b.st[0] = nloc; b.st[1] = nx; }
        const unsigned old = xb_add(&bar[XB_XSUB(b.x)], 1u);
        const unsigned gen = old / nloc;
        if (old + 1u == (gen + 1u) * nloc) {
            __builtin_amdgcn_fence(__ATOMIC_RELEASE, "agent");
            asm volatile("s_waitcnt vmcnt(0)" ::: "memory");
            const unsigned og = xb_add(&bar[XB_TOP], 1u);
            const unsigned tg = og / nx;
            if (og + 1u == (tg + 1u) * nx) xb_add(&bar[XB_TOPGEN], 1u);
            else XB_SPIN(xb_ld(&bar[XB_TOPGEN]) == tg, bar);
            __builtin_amdgcn_fence(__ATOMIC_ACQUIRE, "agent");
            xb_add(&bar[XB_XGEN(b.x)], 1u);
            asm volatile("s_waitcnt vmcnt(0)" ::: "memory");
        } else {
            XB_SPIN(xb_ld(&bar[XB_XGEN(b.x)]) == gen, bar);
            __builtin_amdgcn_fence(__ATOMIC_ACQUIRE, "agent");
            asm volatile("s_waitcnt vmcnt(0)" ::: "memory");
        }
    }
    __syncthreads();
}

__device__ __forceinline__ float wave_sum(float v) {
#pragma unroll
    for (int o = 1; o < 64; o <<= 1) v += __shfl_xor(v, o);
    return v;
}

namespace pg8 {
#define PG8_LAS __attribute__((address_space(3)))
typedef unsigned short bf16_t;
typedef unsigned u32x4 __attribute__((ext_vector_type(4)));
constexpr int BM = 256, BK = 64, HALF = 128, HTB = HALF * BK * 2, STAGE_BYTES = 8 * HTB, NXCD = 8, WGM = 8;
__host__ __device__ __forceinline__ int lds_byte(int r, int c) { const int st = (r >> 4) * 2 + (c >> 5), rr = r & 15, cc = c & 31, ob = rr * 64 + cc * 2; return st * 1024 + (ob ^ (((ob >> 9) & 1) << 5)); }
__host__ __device__ __forceinline__ void stage_rc(int b, int& R, int& C) { const int st = b / 1024, sb = b % 1024, swz = sb ^ (((sb >> 9) & 1) << 5); R = (st >> 1) * 16 + swz / 64; C = (st & 1) * 32 + (swz % 64) / 2; }
__host__ __device__ __forceinline__ int perm32(int rho) { const int n = rho >> 4, i = rho & 15; return 8 * (i >> 2) + 4 * n + (i & 3); }

struct Unit { int pm, pn, e; };
struct Gemm { const bf16_t* A; const bf16_t* Bt; int M, N, K; size_t estride, astride; };
template <class E, class = void> struct epi_chain { static constexpr bool v = false; };
template <class E> struct epi_chain<E, decltype((void)E::CHAIN)> { static constexpr bool v = E::CHAIN; };

struct StaticOrder {
    int nM, nN, nwg, G, c;
    __host__ __device__ void init(int M, int N, int G_, int c_) { nM = M / BM; nN = N / BM; nwg = nM * nN; G = G_; c = c_; }
    __host__ __device__ __forceinline__ bool next(int i, Unit& u) const {
        const long L = (long)i * G + c; if (L >= nwg) return false;
        int wgid = (int)L; { const int q = nwg / NXCD, r = nwg % NXCD, xcd = wgid % NXCD, off = wgid / NXCD; wgid = (xcd < r ? xcd * (q + 1) : r * (q + 1) + (xcd - r) * q) + off; }
        const int nig = WGM * nN, gid = wgid / nig, fm = gid * WGM, gsz = (nM - fm) < WGM ? (nM - fm) : WGM;
        u.pm = fm + ((wgid % nig) % gsz); u.pn = (wgid % nig) / gsz; u.e = 0; return true;
    }
    __device__ __forceinline__ void a_ready(const Unit&) const {}
    __device__ __forceinline__ void done(const Unit&) const {}
};
struct PairOrder {
    StaticOrder S0;
    __device__ __forceinline__ bool next(int i, Unit& u) const { Unit t; if (i >= 2 || !S0.next(0, t)) return false; u.pm = t.pm; u.pn = t.pn; u.e = i; return true; }
    __device__ __forceinline__ void a_ready(const Unit&) const {}
    __device__ __forceinline__ void done(const Unit&) const {}
};
struct OneUnit {
    int pm, pn, e;
    __device__ __forceinline__ bool next(int i, Unit& u) const { if (i != 0) return false; u.pm = pm; u.pn = pn; u.e = e; return true; }
    __device__ __forceinline__ void a_ready(const Unit&) const {}
    __device__ __forceinline__ void done(const Unit&) const {}
};
struct GroupOrder {
    int nN, total, G, c; const int* t2e;
    __device__ void init(int nTiles, int nN_, int G_, int c_, const int* t2e_) { nN = nN_; total = nTiles * nN_; G = G_; c = c_; t2e = t2e_; }
    __device__ bool next(int i, Unit& u) const {
        const long L = (long)i * G + c; if (L >= total) return false;
        u.pm = (int)(L / nN); u.pn = (int)(L % nN); u.e = __builtin_amdgcn_readfirstlane(t2e[u.pm]); return true;
    }
    __device__ __forceinline__ void a_ready(const Unit&) const {}
    __device__ __forceinline__ void done(const Unit&) const {}
};

__device__ __forceinline__ void st8(bf16_t* p, f32x4 v0, f32x4 v1) { u32x4 w; w.x = pk2(v0[0], v0[1]); w.y = pk2(v0[2], v0[3]); w.z = pk2(v1[0], v1[1]); w.w = pk2(v1[2], v1[3]); *(u32x4*)p = w; }
__device__ __forceinline__ void ld8(const bf16_t* p, f32x4& v0, f32x4& v1) { const u32x4 w = *(const u32x4*)p; v0 = (f32x4){bflo(w.x), bfhi(w.x), bflo(w.y), bfhi(w.y)}; v1 = (f32x4){bflo(w.z), bfhi(w.z), bflo(w.w), bfhi(w.w)}; }

__device__ __forceinline__ void rope16(f32x4& v0, f32x4& v1, int row, int fq, const f32x2* rope) {
    const f32x2* rp = rope + (size_t)(row & (SEQ - 1)) * 16;
    f32x4 p0, p1;
#pragma unroll
    for (int e = 0; e < 4; ++e) { p0[e] = __shfl_xor(v0[e], 16); p1[e] = __shfl_xor(v1[e], 16); }
    if (fq < 2) {
        const float sg = fq == 0 ? -1.f : 1.f;
#pragma unroll
        for (int e = 0; e < 4; ++e) { const f32x2 a = rp[2 * e], b = rp[2 * (4 + e)];
            v0[e] = v0[e] * a.x + sg * p0[e] * a.y; v1[e] = v1[e] * b.x + sg * p1[e] * b.y; }
    }
}
__device__ __forceinline__ void rope32(f32x4& v0, f32x4& v1, int row, int fq, const f32x2* rope) {
    const f32x2* rp = rope + (size_t)(row & (SEQ - 1)) * 16 + 8 * (fq & 1);
    const float sg = fq < 2 ? -1.f : 1.f;
#pragma unroll
    for (int e = 0; e < 4; ++e) { const float p0 = __shfl_xor(v0[e], 32), p1 = __shfl_xor(v1[e], 32); const f32x2 a = rp[e], b = rp[4 + e];
        v0[e] = v0[e] * a.x + sg * p0 * a.y; v1[e] = v1[e] * b.x + sg * p1 * b.y; }
}
__device__ __forceinline__ float sigmoidf_(float x) { return __builtin_amdgcn_rcpf(1.f + __builtin_amdgcn_exp2f(-1.4426950408889634f * x)); }

struct EpiIn {
    static constexpr bool PERM = true, AFTER_DRAIN = false;
    bf16_t *CQ, *CKV, *QB, *KB, *VB, *QI, *KI, *KR, *GA, *GB; float* WI; const f32x2* rope; float* PART;
    __device__ __forceinline__ void operator()(const f32x4 (&acc)[2][2][4][2], const Unit& u, int wr, int wc, int fr, int fq) const {
        const int row0 = u.pm * BM + wr * 64 + fr;
#pragma unroll
        for (int bj = 0; bj < 2; ++bj) {
            const int cg = u.pn * BM + bj * HALF + wc * 32;
            bf16_t* base = nullptr; int pitch = 0, cc = 0, mode = 0; float sc = 1.f;
            if (cg < C_CKV) { base = CQ; pitch = 384; cc = cg; }
            else if (cg < C_QB) { base = CKV; pitch = 256; cc = cg - C_CKV; }
            else if (cg < C_KB) { base = QB; pitch = 512; cc = cg - C_QB; mode = ((cc >> 5) & 1) == 0 ? 1 : 0; sc = C2B; }
            else if (cg < C_VB) { base = KB; pitch = 512; cc = cg - C_KB; mode = ((cc >> 5) & 1) == 0 ? 1 : 0; }
            else if (cg < C_QI) { base = VB; pitch = 512; cc = cg - C_VB; }
            else if (cg < C_KR) { base = QI; pitch = 512; cc = cg - C_QI; mode = ((cc >> 5) & 1) == 0 ? 1 : 0; }
            else if (cg < C_KI) { base = KR; pitch = 32; cc = 0; mode = 2; }
            else if (cg < C_WI) { base = KI; pitch = 64; cc = cg - C_KI; mode = (cc == 0) ? 1 : 0; }
            else if (cg < C_GA) { mode = 4; }
            else if (cg < C_GB) { base = GA; pitch = 1024; cc = cg - C_GA; mode = 3; }
            else { base = GB; pitch = 1024; cc = cg - C_GB; mode = 3; }
#pragma unroll
            for (int ai = 0; ai < 2; ++ai)
#pragma unroll
                for (int m = 0; m < 4; ++m) {
                    const int row = row0 + ai * HALF + m * 16;
                    f32x4 v0 = acc[ai][bj][m][0], v1 = acc[ai][bj][m][1];
                    if (mode == 1) rope16(v0, v1, row, fq, rope);
                    else if (mode == 2) rope32(v0, v1, row, fq, rope);
                    else if (mode == 3) {
#pragma unroll
                        for (int e = 0; e < 4; ++e) { v0[e] = sigmoidf_(v0[e]); v1[e] = sigmoidf_(v1[e]); } }
                    if (cg < C_QB) {
                        float ss = ((v0[0] * v0[0] + v0[1] * v0[1]) + (v0[2] * v0[2] + v0[3] * v0[3])) + ((v1[0] * v1[0] + v1[1] * v1[1]) + (v1[2] * v1[2] + v1[3] * v1[3]));
                        ss += __shfl_xor(ss, 16); ss += __shfl_xor(ss, 32);
                        if (fq == 0) PART[(size_t)row * 20 + (cg >> 5)] = ss; }
                    if (mode == 4) { if (fq == 0) { *(f32x4*)(WI + (size_t)row * 8) = v0 * WI_SCALE; *(f32x4*)(WI + (size_t)row * 8 + 4) = v1 * WI_SCALE; } }
                    else { v0 = v0 * sc; v1 = v1 * sc; st8(base + (size_t)row * pitch + cc + 8 * fq, v0, v1); }
                }
        }
    }
};
struct EpiQA {
    static constexpr bool PERM = true, AFTER_DRAIN = false;
    bf16_t* QA; const f32x2* rope; const PG8_LAS float* RS;
    __device__ __forceinline__ void operator()(const f32x4 (&acc)[2][2][4][2], const Unit& u, int wr, int wc, int fr, int fq) const {
        const int row0 = u.pm * BM + wr * 64 + fr; const PG8_LAS float* rsp = RS + wr * 64 + fr;
#pragma unroll
        for (int bj = 0; bj < 2; ++bj) {
            const int cg = u.pn * BM + bj * HALF + wc * 32; const bool rot = ((cg >> 5) % 3) == 2;
#pragma unroll
            for (int ai = 0; ai < 2; ++ai)
#pragma unroll
                for (int m = 0; m < 4; ++m) {
                    const int row = row0 + ai * HALF + m * 16;
                    f32x4 v0 = acc[ai][bj][m][0], v1 = acc[ai][bj][m][1];
                    if (rot) rope32(v0, v1, row, fq, rope);
                    { const float rsv = rsp[ai * HALF + m * 16]; v0 = v0 * rsv; v1 = v1 * rsv; } st8(QA + (size_t)row * 768 + cg + 8 * fq, v0, v1);
                }
        }
    }
};
struct EpiKV {
    static constexpr bool PERM = true, AFTER_DRAIN = false;
    bf16_t *KN, *VA; const PG8_LAS float* RS;
    __device__ __forceinline__ void operator()(const f32x4 (&acc)[2][2][4][2], const Unit& u, int wr, int wc, int fr, int fq) const {
        const int row0 = u.pm * BM + wr * 64 + fr; const PG8_LAS float* rsp = RS + wr * 64 + fr;
#pragma unroll
        for (int bj = 0; bj < 2; ++bj) {
            const int cg = u.pn * BM + bj * HALF + wc * 32; bf16_t* base = cg < 512 ? KN : VA; const int cc = (cg & 511) + 8 * fq;
#pragma unroll
            for (int ai = 0; ai < 2; ++ai)
#pragma unroll
                for (int m = 0; m < 4; ++m) { const int row = row0 + ai * HALF + m * 16; const float rsv = rsp[ai * HALF + m * 16]; st8(base + (size_t)row * 512 + cc, acc[ai][bj][m][0] * rsv, acc[ai][bj][m][1] * rsv); }
        }
    }
};
template <int ADD> struct EpiY {
    static constexpr bool PERM = true, AFTER_DRAIN = false;
    bf16_t* Y; const bf16_t* Gt;
    __device__ __forceinline__ void operator()(const f32x4 (&acc)[2][2][4][2], const Unit& u, int wr, int wc, int fr, int fq) const {
        const int row0 = u.pm * BM + wr * 64 + fr;
#pragma unroll
        for (int bj = 0; bj < 2; ++bj) {
            const int c0 = u.pn * BM + bj * HALF + wc * 32 + 8 * fq;
#pragma unroll
            for (int ai = 0; ai < 2; ++ai)
#pragma unroll
                for (int m = 0; m < 4; ++m) { const size_t off = (size_t)(row0 + ai * HALF + m * 16) * 1024 + c0;
                    f32x4 g0, g1; ld8(Gt + off, g0, g1);
                    f32x4 v0 = acc[ai][bj][m][0] * g0, v1 = acc[ai][bj][m][1] * g1;
                    if (ADD) { f32x4 o0, o1; ld8(Y + off, o0, o1); v0 = v0 + o0; v1 = v1 + o1; }
                    st8(Y + off, v0, v1); }
        }
    }
};
struct EpiYC {
    static constexpr bool PERM = true, AFTER_DRAIN = false, CHAIN = true;
    bf16_t* Y; const bf16_t *Ga, *Gb;
    __device__ __forceinline__ void operator()(f32x4 (&acc)[2][2][4][2], const Unit& u, int wr, int wc, int fr, int fq) const {
        const int row0 = u.pm * BM + wr * 64 + fr;
#pragma unroll
        for (int bj = 0; bj < 2; ++bj) {
            const int c0 = u.pn * BM + bj * HALF + wc * 32 + 8 * fq;
#pragma unroll
            for (int ai = 0; ai < 2; ++ai)
#pragma unroll
                for (int m = 0; m < 4; ++m) { const size_t off = (size_t)(row0 + ai * HALF + m * 16) * 1024 + c0;
                    f32x4 b0, b1; ld8(Gb + off, b0, b1);
#pragma unroll
                    for (int e = 0; e < 4; ++e) { b0[e] = fmaxf(b0[e], 1e-30f); b1[e] = fmaxf(b1[e], 1e-30f); }
                    if (u.e == 0) { f32x4 a0, a1; ld8(Ga + off, a0, a1);
#pragma unroll
                        for (int e = 0; e < 4; ++e) { acc[ai][bj][m][0][e] *= a0[e] * __builtin_amdgcn_rcpf(b0[e]); acc[ai][bj][m][1][e] *= a1[e] * __builtin_amdgcn_rcpf(b1[e]); } }
                    else st8(Y + off, acc[ai][bj][m][0] * b0, acc[ai][bj][m][1] * b1); }
        }
    }
};
struct EpiX1 {
    static constexpr bool PERM = false, AFTER_DRAIN = false;
    const float* X; float* O;
    __device__ __forceinline__ void operator()(const f32x4 (&acc)[2][2][4][2], const Unit& u, int wr, int wc, int fr, int fq) const {
        const int row0 = u.pm * BM + wr * 64 + fr, col0 = u.pn * BM + wc * 32 + 4 * fq;
#pragma unroll
        for (int ai = 0; ai < 2; ++ai)
#pragma unroll
            for (int m = 0; m < 4; ++m) { const size_t off = (size_t)(row0 + ai * HALF + m * 16) * 1024 + col0;
#pragma unroll
                for (int bj = 0; bj < 2; ++bj)
#pragma unroll
                    for (int n = 0; n < 2; ++n) { const f32x4 xv = *(const f32x4*)(X + off + bj * HALF + n * 16); *(f32x4*)(O + off + bj * HALF + n * 16) = xv + acc[ai][bj][m][n]; } }
    }
};
struct EpiHid {
    static constexpr bool PERM = true, AFTER_DRAIN = false;
    bf16_t* HID;
    __device__ __forceinline__ void operator()(const f32x4 (&acc)[2][2][4][2], const Unit& u, int wr, int wc, int fr, int fq) const {
        const int row0 = u.pm * BM + wr * 64 + fr, c0 = u.pn * 128 + wc * 32 + 8 * fq;
#pragma unroll
        for (int ai = 0; ai < 2; ++ai)
#pragma unroll
            for (int m = 0; m < 4; ++m) { f32x4 h0, h1;
#pragma unroll
                for (int e = 0; e < 4; ++e) { const float g0 = acc[ai][0][m][0][e], g1 = acc[ai][0][m][1][e];
                    h0[e] = g0 * sigmoidf_(g0) * acc[ai][1][m][0][e]; h1[e] = g1 * sigmoidf_(g1) * acc[ai][1][m][1][e]; }
                st8(HID + (size_t)(row0 + ai * HALF + m * 16) * 256 + c0, h0, h1); }
    }
};
struct EpiDown {
    static constexpr bool PERM = true, AFTER_DRAIN = false;
    bf16_t* SL; const int* sslot; const float* sw;
    __device__ __forceinline__ void operator()(const f32x4 (&acc)[2][2][4][2], const Unit& u, int wr, int wc, int fr, int fq) const {
        const int row0 = u.pm * BM + wr * 64 + fr;
#pragma unroll
        for (int ai = 0; ai < 2; ++ai)
#pragma unroll
            for (int m = 0; m < 4; ++m) { const int r = row0 + ai * HALF + m * 16; const int slot = sslot[r]; const float w = sw[r];
                if (slot >= 0) {
#pragma unroll
                    for (int bj = 0; bj < 2; ++bj) st8(SL + (size_t)slot * 1024 + u.pn * BM + bj * HALF + wc * 32 + 8 * fq, acc[ai][bj][m][0] * w, acc[ai][bj][m][1] * w); } }
    }
};
template <class Epi, class Sched, bool ALIGN_EPI = false, bool SP2 = false>
__device__ __forceinline__ void gemm_phase(PG8_LAS unsigned char* lds, const Gemm g, const Sched& S, const Epi& E) {
    const int tid = threadIdx.x, wid = __builtin_amdgcn_readfirstlane(tid >> 6), lane = tid & 63, wr = wid >> 2, wc = wid & 3, fr = lane & 15, fq = lane >> 4;
    const int K = g.K, nt = K / BK;
    unsigned voffA[2], voffB[2];
#pragma unroll
    for (int i = 0; i < 2; ++i) { int R, C; stage_rc(tid * 16 + i * 8192, R, C); const int Rb = Epi::PERM ? ((R & ~31) + perm32(R & 31)) : R;
        voffA[i] = (unsigned)(R * K + C) * 2u; voffB[i] = (unsigned)(Rb * K + C) * 2u; }
    const size_t kstep = (size_t)(BK * 2);
    const size_t hstep = (size_t)HALF * K * 2;
    const size_t tstep = 2 * hstep;
    const unsigned ldsw = (unsigned)wid * 1024u;
    const int aoff = lds_byte(wr * 64 + fr, fq * 8), boff = lds_byte(wc * 32 + fr, fq * 8);
#define PG8_SA(b, h) (((b) * 2 + (h)) * HTB)
#define PG8_SB(b, h) ((4 + (b) * 2 + (h)) * HTB)
#define PG8_STAGE(bufoff, gbase, voff) do { _Pragma("unroll") for (int _i = 0; _i < 2; ++_i) \
        __builtin_amdgcn_global_load_lds((const unsigned*)((const char*)(gbase) + (voff)[_i]), (PG8_LAS unsigned*)(lds + (bufoff) + ldsw + _i * 8192), 16, 0, 0); } while (0)
#define PG8_LDA(dst, b, h) do { _Pragma("unroll") for (int m = 0; m < 4; ++m) _Pragma("unroll") for (int k = 0; k < 2; ++k) dst[m][k] = *(const PG8_LAS bf16x8*)(lds + PG8_SA(b, h) + aoff + m * 2048 + k * 1024); } while (0)
#define PG8_LDB(dst, b, h) do { _Pragma("unroll") for (int n = 0; n < 2; ++n) _Pragma("unroll") for (int k = 0; k < 2; ++k) dst[n][k] = *(const PG8_LAS bf16x8*)(lds + PG8_SB(b, h) + boff + n * 2048 + k * 1024); } while (0)
#define PG8_MMA(ai, bj, At, Bt) do { __builtin_amdgcn_s_setprio(1); _Pragma("unroll") for (int m = 0; m < 4; ++m) _Pragma("unroll") for (int n = 0; n < 2; ++n) _Pragma("unroll") for (int k = 0; k < 2; ++k) \
        acc[ai][bj][m][n] = __builtin_amdgcn_mfma_f32_16x16x32_bf16(Bt[n][k], At[m][k], acc[ai][bj][m][n], 0, 0, 0); __builtin_amdgcn_s_setprio(0); } while (0)
#define PG8_WAIT_V(n) asm volatile("s_waitcnt vmcnt(" #n ")" ::: "memory")
#define PG8_WAIT_L(n) asm volatile("s_waitcnt lgkmcnt(" #n ")" ::: "memory")
#define PG8_BAR __builtin_amdgcn_s_barrier()
#define PG8_SCHED __builtin_amdgcn_sched_barrier(0)
    Unit cur, nxt; int ui = 0;
    if (!S.next(0, cur)) return;
    f32x4 acc[2][2][4][2];
#pragma unroll
    for (int a = 0; a < 2; ++a)
#pragma unroll
        for (int b = 0; b < 2; ++b)
#pragma unroll
            for (int m = 0; m < 4; ++m)
#pragma unroll
                for (int n = 0; n < 2; ++n) acc[a][b][m][n] = (f32x4){0.f, 0.f, 0.f, 0.f};
    bf16x8 At[4][2], B0[2][2], B1[2][2];
    const char* cA = (const char*)g.A + (size_t)cur.e * g.astride + (size_t)cur.pm * tstep; const char* cB = (const char*)g.Bt + (size_t)cur.e * g.estride + (size_t)cur.pn * tstep;
    S.a_ready(cur);
    if constexpr (SP2) {
        PG8_STAGE(PG8_SB(0, 0), cB, voffB); PG8_STAGE(PG8_SB(0, 1), cB + hstep, voffB); PG8_STAGE(PG8_SA(0, 0), cA, voffA); PG8_STAGE(PG8_SA(0, 1), cA + hstep, voffA);
        if (wr == 1) PG8_BAR;
        PG8_WAIT_V(2); PG8_BAR;
        PG8_STAGE(PG8_SB(1, 0), cB + kstep, voffB); PG8_STAGE(PG8_SA(1, 0), cA + kstep, voffA); PG8_STAGE(PG8_SB(1, 1), cB + hstep + kstep, voffB);
        PG8_WAIT_V(6); PG8_BAR;
    } else {
        PG8_STAGE(PG8_SB(0, 0), cB, voffB); PG8_STAGE(PG8_SA(0, 0), cA, voffA); PG8_STAGE(PG8_SB(0, 1), cB + hstep, voffB); PG8_STAGE(PG8_SA(0, 1), cA + hstep, voffA);
        if (wr == 1) PG8_BAR;
        PG8_WAIT_V(4); PG8_BAR;
        PG8_STAGE(PG8_SB(1, 0), cB + kstep, voffB); PG8_STAGE(PG8_SA(1, 0), cA + kstep, voffA); PG8_STAGE(PG8_SB(1, 1), cB + hstep + kstep, voffB);
        PG8_WAIT_V(6); PG8_BAR;
    }
    for (;;) {
        const bool has_next = S.next(ui + 1, nxt);
        const char* nA = has_next ? (const char*)g.A + (size_t)nxt.e * g.astride + (size_t)nxt.pm * tstep : cA; const char* nB = has_next ? (const char*)g.Bt + (size_t)nxt.e * g.estride + (size_t)nxt.pn * tstep : cB;
#pragma nounroll
        for (int t = 0; t < nt; t += 2) {
            const bool last = (t == nt - 2);
            const char* a1 = cA + (size_t)(t + 1) * kstep;
            const char* a2 = last ? nA : cA + (size_t)(t + 2) * kstep; const char* b2 = last ? nB : cB + (size_t)(t + 2) * kstep;
            const char* a3 = a2 + kstep; const char* b3 = b2 + kstep;
            if (last && has_next) S.a_ready(nxt);
            if constexpr (SP2) {
            PG8_LDB(B0, 0, 0); PG8_LDB(B1, 0, 1); PG8_SCHED; PG8_LDA(At, 0, 0); PG8_STAGE(PG8_SA(1, 1), a1 + hstep, voffA);
            PG8_WAIT_V(8); PG8_WAIT_L(0); PG8_BAR; PG8_MMA(0, 0, At, B0); PG8_MMA(0, 1, At, B1); PG8_BAR; PG8_SCHED;
            PG8_LDA(At, 0, 1); PG8_STAGE(PG8_SB(0, 0), b2, voffB); PG8_STAGE(PG8_SB(0, 1), b2 + hstep, voffB); PG8_STAGE(PG8_SA(0, 0), a2, voffA);
            PG8_WAIT_V(8); PG8_WAIT_L(0); PG8_BAR; PG8_MMA(1, 0, At, B0); PG8_MMA(1, 1, At, B1); PG8_BAR; PG8_SCHED;
            PG8_LDB(B0, 1, 0); PG8_LDB(B1, 1, 1); PG8_SCHED; PG8_LDA(At, 1, 0); PG8_STAGE(PG8_SA(0, 1), a2 + hstep, voffA);
            PG8_WAIT_V(8); PG8_WAIT_L(0); PG8_BAR; PG8_MMA(0, 0, At, B0); PG8_MMA(0, 1, At, B1); PG8_BAR; PG8_SCHED;
            PG8_LDA(At, 1, 1); PG8_STAGE(PG8_SB(1, 0), b3, voffB); PG8_STAGE(PG8_SB(1, 1), b3 + hstep, voffB); PG8_STAGE(PG8_SA(1, 0), a3, voffA);
            PG8_WAIT_V(8); PG8_WAIT_L(0); PG8_BAR; PG8_MMA(1, 0, At, B0); PG8_MMA(1, 1, At, B1); PG8_BAR; PG8_SCHED;
            } else {
            PG8_LDB(B0, 0, 0); PG8_SCHED; PG8_LDA(At, 0, 0); PG8_STAGE(PG8_SA(1, 1), a1 + hstep, voffA);
            PG8_WAIT_L(8); PG8_BAR; PG8_WAIT_L(0); PG8_MMA(0, 0, At, B0); PG8_BAR; PG8_SCHED;
            PG8_LDB(B1, 0, 1); PG8_STAGE(PG8_SB(0, 0), b2, voffB);
            PG8_BAR; PG8_WAIT_L(0); PG8_MMA(0, 1, At, B1); PG8_BAR;
            PG8_LDA(At, 0, 1); PG8_STAGE(PG8_SA(0, 0), a2, voffA);
            PG8_BAR; PG8_WAIT_L(0); PG8_MMA(1, 0, At, B0); PG8_BAR; PG8_SCHED;
            PG8_STAGE(PG8_SB(0, 1), b2 + hstep, voffB);
            PG8_WAIT_V(6); PG8_BAR; PG8_MMA(1, 1, At, B1); PG8_BAR;
            PG8_LDB(B0, 1, 0); PG8_SCHED; PG8_LDA(At, 1, 0); PG8_STAGE(PG8_SA(0, 1), a2 + hstep, voffA);
            PG8_WAIT_L(8); PG8_BAR; PG8_WAIT_L(0); PG8_MMA(0, 0, At, B0); PG8_BAR; PG8_SCHED;
            PG8_LDB(B1, 1, 1); PG8_STAGE(PG8_SB(1, 0), b3, voffB);
            PG8_BAR; PG8_WAIT_L(0); PG8_MMA(0, 1, At, B1); PG8_BAR;
            PG8_LDA(At, 1, 1); PG8_STAGE(PG8_SA(1, 0), a3, voffA);
            PG8_BAR; PG8_WAIT_L(0); PG8_MMA(1, 0, At, B0); PG8_BAR; PG8_SCHED;
            PG8_STAGE(PG8_SB(1, 1), b3 + hstep, voffB);
            PG8_WAIT_V(6); PG8_BAR; PG8_MMA(1, 1, At, B1); PG8_BAR;
            }
        }
        if constexpr (ALIGN_EPI) { if (wr == 0) PG8_BAR; }
        if constexpr (!Epi::AFTER_DRAIN) { E(acc, cur, wr, wc, fr, fq); S.done(cur); }
        if (!has_next) break;
        if (!(epi_chain<Epi>::v && cur.e == 0)) {
#pragma unroll
        for (int a = 0; a < 2; ++a)
#pragma unroll
            for (int b = 0; b < 2; ++b)
#pragma unroll
                for (int m = 0; m < 4; ++m)
#pragma unroll
                    for (int n = 0; n < 2; ++n) acc[a][b][m][n] = (f32x4){0.f, 0.f, 0.f, 0.f};
        }
        cur = nxt; cA = nA; cB = nB; ++ui;
        if constexpr (ALIGN_EPI) { if (wr == 1) PG8_BAR; }
    }
    PG8_WAIT_V(0);
    if constexpr (!ALIGN_EPI) { if (wr == 0) PG8_BAR; }
    PG8_BAR;
    if constexpr (Epi::AFTER_DRAIN) { E.fused(acc, cur, wr, wc, fr, fq, lds, wid, lane); S.done(cur); }
#undef PG8_SA
#undef PG8_SB
#undef PG8_STAGE
#undef PG8_LDA
#undef PG8_LDB
#undef PG8_MMA
#undef PG8_WAIT_V
#undef PG8_WAIT_L
#undef PG8_BAR
#undef PG8_SCHED
}
}

struct Args { const float* in[20]; float* out; unsigned char* ws; int ph_lo, ph_hi; };
struct Frame {
    LAS unsigned char* lds; volatile LAS unsigned* MISC; gu32* ctl; unsigned char* ws;
    int vcu, G;
};
#define F_TID ((int)threadIdx.x)
#define F_LANE ((int)(threadIdx.x & 63))
#define F_WAVE (__builtin_amdgcn_readfirstlane((int)(threadIdx.x >> 6)))

__device__ __forceinline__ int in_src_col(int n) {
    if (n < 640) return n;
    if (n < 2688) return n + 32;
    if (n < 2720) return n - 2688 + 640;
    if (n < 2792) return n;
    if (n < 2816) return -1;
    return n - 24;
}
struct TrDesc { const float* colptr; int ld, k0; bf16* WT; int Kd, destrow0; const float* gain; };
__device__ __forceinline__ void tr_load(const TrDesc& d, int lane, f32x4 (&v)[16]) {
    const int kr = lane >> 4;
#pragma unroll
    for (int it = 0; it < 16; ++it) { const int kk = 4 * it + kr; v[it] = (f32x4){0.f, 0.f, 0.f, 0.f}; if (d.colptr) v[it] = *(const GAS f32x4*)(d.colptr + (size_t)(d.k0 + kk) * d.ld); if (d.gain) v[it] = v[it] * d.gain[d.k0 + kk]; }
}
__device__ __forceinline__ void tr_store(const TrDesc& d, int lane, const f32x4 (&v)[16], LAS float* scr) {
    const int nq = lane & 15, kr = lane >> 4;
#pragma unroll
    for (int it = 0; it < 16; ++it) { const int kk = 4 * it + kr; LAS float* q = scr + kk * 65 + 4 * nq; q[0] = v[it].x; q[1] = v[it].y; q[2] = v[it].z; q[3] = v[it].w; }
    LDS_WAIT(); asm volatile("" ::: "memory");
    const int c = lane & 7;
#pragma unroll
    for (int j = 0; j < 8; ++j) { const int n = (lane >> 3) + 8 * j; const LAS float* q = scr + (8 * c) * 65 + n;
        v4u o; o.x = pk2(q[0 * 65], q[1 * 65]); o.y = pk2(q[2 * 65], q[3 * 65]); o.z = pk2(q[4 * 65], q[5 * 65]); o.w = pk2(q[6 * 65], q[7 * 65]);
        *(GAS v4u*)(d.WT + (size_t)(d.destrow0 + n) * d.Kd + d.k0 + 8 * c) = o; }
    LDS_WAIT(); asm volatile("" ::: "memory");
}
constexpr int CV_I0 = 16 * 76, CV_I1 = 6 * 12, CV_I2 = 4 * 16, CV_I3 = 8 * 16, CV_I4 = 8 * 16, CV_I5 = 16 * 16, CV_I6 = 32 * 16 * 8, CV_I7 = 32 * 4 * 16;
constexpr int CV_EARLY = CV_I0 + CV_I1 + CV_I2, CV_LATE = CV_I3 + CV_I4 + CV_I5 + CV_I6 + CV_I7, CV_QITEMS = CV_LATE / 16;
static_assert(CV_LATE % 16 == 0, "late conversion tiles come in queue items of 16");
__device__ __forceinline__ TrDesc conv_desc(const Args& A, unsigned char* ws, int it, int lane) {
    const int n4 = 4 * (lane & 15);
    int r = it;
    if (r < CV_I0) { const int kb = r / 76, nb = r % 76; const int col = in_src_col(64 * nb + n4);
        return TrDesc{col >= 0 ? A.in[2] + col : nullptr, NIN_SRC, 64 * kb, (bf16*)(ws + WS_WIN), 1024, 64 * nb, nullptr}; } r -= CV_I0;
    if (r < CV_I1) { const int kb = r / 12, nb = r % 12; return TrDesc{A.in[4] + 64 * nb + n4, 768, 64 * kb, (bf16*)(ws + WS_WUQ), 384, 64 * nb, A.in[3]}; } r -= CV_I1;
    if (r < CV_I2) { const int kb = r / 16, nb = r % 16; const int n = 64 * nb + n4;
        return TrDesc{n < 512 ? A.in[6] + n : A.in[7] + (n - 512), 512, 64 * kb, (bf16*)(ws + WS_WUKV), 256, 64 * nb, A.in[5]}; } r -= CV_I2;
    if (r < CV_I3) { const int kb = r / 16, nb = r % 16; return TrDesc{A.in[8] + 64 * nb + n4, 1024, 64 * kb, (bf16*)(ws + WS_WOA), 512, 64 * nb, nullptr}; } r -= CV_I3;
    if (r < CV_I4) { const int kb = r / 16, nb = r % 16; return TrDesc{A.in[9] + 64 * nb + n4, 1024, 64 * kb, (bf16*)(ws + WS_WOB), 512, 64 * nb, nullptr}; } r -= CV_I4;
    if (r < CV_I5) { const int kb = r / 16, nb = r % 16; return TrDesc{A.in[10] + 64 * nb + n4, 1024, 64 * kb, (bf16*)(ws + WS_WOUT), 1024, 64 * nb, nullptr}; } r -= CV_I5;
    if (r < CV_I6) { const int e = r / 128, rr = r % 128, kb = rr / 8, nb = rr % 8; const int n = 64 * nb + n4, pn = n >> 8, c = n & 255, col = 128 * pn + (c & 127);
        const float* src = ((c >> 7) ? A.in[17] : A.in[16]) + (size_t)e * 1024 * 256 + col;
        return TrDesc{src, 256, 64 * kb, (bf16*)(ws + WS_WGU) + (size_t)e * 512 * 1024, 1024, 64 * nb, nullptr}; } r -= CV_I6;
    { const int e = r / 64, rr = r % 64, kb = rr / 16, nb = rr % 16;
        return TrDesc{A.in[18] + (size_t)e * 256 * 1024 + 64 * nb + n4, 1024, 64 * kb, (bf16*)(ws + WS_WD) + (size_t)e * 1024 * 256, 256, 64 * nb, nullptr}; }
}
__device__ __forceinline__ void conv_tile(const Args& A, unsigned char* ws, int it, LAS float* scr, int lane) {
    const TrDesc d = conv_desc(A, ws, it, lane); f32x4 v[16]; tr_load(d, lane, v); tr_store(d, lane, v, scr);
}
__device__ __forceinline__ void conv_tile2(const Args& A, unsigned char* ws, int it0, int it1, LAS float* scr, int lane) {
    const TrDesc d0 = conv_desc(A, ws, it0, lane), d1 = conv_desc(A, ws, it1, lane); f32x4 v0[16], v1[16];
    tr_load(d0, lane, v0); tr_load(d1, lane, v1); tr_store(d0, lane, v0, scr); tr_store(d1, lane, v1, scr);
}
__device__ __forceinline__ void p0_prologue(Frame& F, const Args& A) {
    LAS float* scr = (LAS float*)(F.lds + F_WAVE * 16640);
    const int gw = F.vcu * NWAVES + F_WAVE, NGW = F.G * NWAVES, lane = F_LANE;
    unsigned char* ws = F.ws;
#ifdef CONV_IN_P0
    for (int it = gw; it < CV_EARLY + CV_LATE; it += NGW) conv_tile(A, ws, it, scr, lane);
#else
    for (int it = gw; it < CV_EARLY; it += NGW) conv_tile(A, ws, it, scr, lane);
#endif
    const float* x = A.in[0]; const float* g1 = A.in[1]; bf16* H = (bf16*)(ws + WS_H);
    for (int m0 = gw; m0 < T; m0 += 4 * NGW) {
        f32x4 v[4][4];
#pragma unroll
        for (int r = 0; r < 4; ++r) { const int m = min(m0 + r * NGW, T - 1); const GAS f32x4* xr = (const GAS f32x4*)(x + (size_t)m * D) + lane;
#pragma unroll
            for (int j = 0; j < 4; ++j) v[r][j] = xr[64 * j]; }
#pragma unroll
        for (int r = 0; r < 4; ++r) { const int m = m0 + r * NGW; float s = 0.f;
#pragma unroll
            for (int j = 0; j < 4; ++j) s += (v[r][j].x * v[r][j].x + v[r][j].y * v[r][j].y) + (v[r][j].z * v[r][j].z + v[r][j].w * v[r][j].w);
            const float rstd = 1.f / sqrtf(wave_sum(s) * (1.f / D) + EPS);
            if (m < T) { GAS v2u* o8 = (GAS v2u*)(H + (size_t)m * D) + lane;
#pragma unroll
                for (int j = 0; j < 4; ++j) { const f32x4 g = *((const GAS f32x4*)g1 + lane + 64 * j); const f32x4 y = v[r][j] * rstd * g; v2u w; w.x = pk2(y.x, y.y); w.y = pk2(y.z, y.w); o8[64 * j] = w; } } }
    }
    f32x2* rope = (f32x2*)(ws + WS_ROPE);
    for (int idx = (F.vcu * NTHR + F_TID); idx < SEQ * 16; idx += F.G * NTHR) {
        const int pos = idx >> 4, i = idx & 15;
        const double REV[16] = {0.15915494309189535, 0.0700865215877985, 0.03086376340470123, 0.013591370636193905, 0.005985185712713705, 0.002635675898667414, 0.001160663641240061, 0.0005111175045375439,
                                0.00022507907903927653, 9.911730936901935e-05, 4.364795279280289e-05, 1.9221100684944863e-05, 8.464330808241401e-06, 3.727408601915352e-06, 1.6414262627950345e-06, 7.228293068832865e-07};
        double rv = 0.0;
#pragma unroll
        for (int k = 0; k < 16; ++k) rv = (i == k) ? REV[k] : rv;
        double t = (double)pos * rv; t -= __builtin_floor(t);
        const float tf = (float)t;
        rope[idx] = (f32x2){__builtin_amdgcn_cosf(tf), __builtin_amdgcn_sinf(tf)};
    }
}

__device__ __forceinline__ void p2a_norms(Frame& F, const Args& A) {
    const int gw = F.vcu * NWAVES + F_WAVE, NGW = F.G * NWAVES, lane = F_LANE;
    bf16* CQ = (bf16*)(F.ws + WS_CQ); bf16* CKV = (bf16*)(F.ws + WS_CKV);
    const float* gq = A.in[3]; const float* gkv = A.in[5];
    for (int m = gw; m < T; m += NGW) {
        {
            GAS unsigned* p = (GAS unsigned*)(CQ + (size_t)m * 384) + lane; unsigned w[3]; float s = 0.f;
#pragma unroll
            for (int j = 0; j < 3; ++j) { w[j] = p[64 * j]; const float a = bflo(w[j]), b = bfhi(w[j]); s += a * a + b * b; }
            const float rstd = 1.f / sqrtf(wave_sum(s) * (1.f / 384.f) + EPS);
#pragma unroll
            for (int j = 0; j < 3; ++j) { const f32x2 g = *((const GAS f32x2*)gq + lane + 64 * j); p[64 * j] = pk2(bflo(w[j]) * rstd * g.x, bfhi(w[j]) * rstd * g.y); }
        }
        {
            GAS v2u* p = (GAS v2u*)(CKV + (size_t)m * 256) + lane; const v2u w = *p;
            const float a = bflo(w.x), b = bfhi(w.x), c = bflo(w.y), d = bfhi(w.y);
            const float rstd = 1.f / sqrtf(wave_sum(a * a + b * b + c * c + d * d) * (1.f / 256.f) + EPS);
            const f32x4 g = *((const GAS f32x4*)gkv + lane); v2u o; o.x = pk2(a * rstd * g.x, b * rstd * g.y); o.y = pk2(c * rstd * g.z, d * rstd * g.w); *p = o;
        }
    }
}

__device__ __forceinline__ constexpr int crow(int r, int hi) { return (r & 3) + 8 * (r >> 2) + 4 * hi; }
constexpr float ATT_THR = 8.f;
__device__ __forceinline__ float att_mask(float p, unsigned w, int bit) { int mk; unsigned r;
    asm("v_bfe_i32 %0, %1, %2, 1" : "=v"(mk) : "v"(w), "i"(bit)); r = __builtin_bit_cast(unsigned, p) & (unsigned)mk; return __builtin_bit_cast(float, r); }
struct AttnP { const bf16 *Q, *K, *K2, *V; bf16* O; const unsigned* BM; };
template <bool MLA> __device__ __forceinline__ void attn_unit(LAS unsigned char* L, int b, int h, int qb, const AttnP& P, int tid, int lane, int wave) {
    constexpr int DK = MLA ? 96 : 64, KP = DK * 2 + 16, NS = DK / 16, CPR = DK / 8;
    constexpr int QPITCH = MLA ? 768 : 512, VP = 192, KBUF = 64 * KP, VBUF = 64 * VP;
    const int r32 = lane & 31, hi = lane >> 5;
    const size_t rowb = (size_t)b * SEQ;
    const int qrow = qb * 256 + wave * 32 + r32;
    bf16x8 qf[NS];
    { const bf16* qp = P.Q + (rowb + qrow) * QPITCH + h * DK;
#pragma unroll
      for (int s = 0; s < NS; ++s) qf[s] = *(const bf16x8*)(qp + 16 * s + 8 * hi); }
    const int NT = 4 * qb + 4, my_nt = 4 * qb + (wave >> 1) + 1;
    const int kid0 = tid, kid1 = tid + NTHR;
    const int kr0 = kid0 / CPR, kc0 = kid0 % CPR, kr1 = kid1 / CPR, kc1 = kid1 % CPR; const bool has1 = MLA && (kid1 < 64 * CPR);
    const int vr = tid >> 3, vc = tid & 7;
    v4u kreg0, kreg1 = (v4u){0u, 0u, 0u, 0u}, vreg;
#define ATT_KSRC(t, kr, kc) (MLA ? ((kc) < 8 ? (const v4u*)(P.K + (rowb + 64 * (t) + (kr)) * 512 + h * 64 + 8 * (kc)) : (const v4u*)(P.K2 + (rowb + 64 * (t) + (kr)) * 32 + 8 * ((kc) - 8))) \
                                 : (const v4u*)(P.K + (rowb + 64 * (t) + (kr)) * 512 + h * 64 + 8 * (kc)))
#define ATT_LOAD(t) do { kreg0 = *ATT_KSRC(t, kr0, kc0); if (has1) kreg1 = *ATT_KSRC(t, kr1, kc1); vreg = *(const v4u*)(P.V + (rowb + 64 * (t) + vr) * 512 + h * 64 + 8 * vc); } while (0)
#define ATT_WRITE(buf) do { *(LAS v4u*)(L + (buf) * KBUF + kr0 * KP + kc0 * 16) = kreg0; if (has1) *(LAS v4u*)(L + (buf) * KBUF + kr1 * KP + kc1 * 16) = kreg1; \
                            *(LAS v4u*)(L + 2 * KBUF + (buf) * VBUF + vr * VP + vc * 16) = vreg; } while (0)
    float mhat = 0.f, l = 0.f; f32x16 o0, o1, negm;
#pragma unroll
    for (int i = 0; i < 16; ++i) { o0[i] = 0.f; o1[i] = 0.f; negm[i] = 0.f; }
    const int g16 = lane >> 4, qq = (lane & 15) >> 2, pp = lane & 3;
    const int vlane = (4 * hi + qq) * VP + (16 * (g16 & 1) + 4 * pp) * 2;
    ATT_LOAD(0); ATT_WRITE(0); __syncthreads();
    unsigned wn0 = 0xffffffffu, wn1 = 0xffffffffu;
    const unsigned* bmq = MLA ? nullptr : P.BM + (size_t)b * 256 * SEQ + qrow;
    if (!MLA) { wn0 = bmq[0]; wn1 = bmq[SEQ]; }
    for (int t = 0; t < NT; ++t) {
        const int buf = t & 1;
        unsigned w0 = wn0 >> (4 * hi), w1 = wn1 >> (4 * hi);
        if (t + 1 < NT) { ATT_LOAD(t + 1); if (!MLA) { wn0 = bmq[(size_t)(2 * t + 2) * SEQ]; wn1 = bmq[(size_t)(2 * t + 3) * SEQ]; } }
        if (t < my_nt) {
            const LAS unsigned char* Kb = L + buf * KBUF; const LAS unsigned char* Vb = L + 2 * KBUF + buf * VBUF;
            f32x16 s0, s1;
            bf16x8 ka[NS][2];
#pragma unroll
            for (int s = 0; s < NS; ++s) { ka[s][0] = *(const LAS bf16x8*)(Kb + r32 * KP + s * 32 + hi * 16); ka[s][1] = *(const LAS bf16x8*)(Kb + (32 + r32) * KP + s * 32 + hi * 16); }
            __builtin_amdgcn_sched_barrier(0);
#pragma unroll
            for (int s = 0; s < NS; ++s) {
                s0 = __builtin_amdgcn_mfma_f32_32x32x16_bf16(ka[s][0], qf[s], s == 0 ? negm : s0, 0, 0, 0);
                s1 = __builtin_amdgcn_mfma_f32_32x32x16_bf16(ka[s][1], qf[s], s == 0 ? negm : s1, 0, 0, 0);
            }
            s16x4 vf[4][4];
#pragma unroll
            for (int ks = 0; ks < 4; ++ks) { const LAS unsigned char* vp = Vb + ks * 16 * VP + vlane;
                vf[ks][0] = __builtin_bit_cast(s16x4, __builtin_amdgcn_ds_read_tr16_b64_v4i16((LAS s16x4*)(vp)));
                vf[ks][1] = __builtin_bit_cast(s16x4, __builtin_amdgcn_ds_read_tr16_b64_v4i16((LAS s16x4*)(vp + 8 * VP)));
                vf[ks][2] = __builtin_bit_cast(s16x4, __builtin_amdgcn_ds_read_tr16_b64_v4i16((LAS s16x4*)(vp + 64)));
                vf[ks][3] = __builtin_bit_cast(s16x4, __builtin_amdgcn_ds_read_tr16_b64_v4i16((LAS s16x4*)(vp + 8 * VP + 64))); }
            __builtin_amdgcn_sched_barrier(0);
            float mx = fmaxf(fmaxf(s0[0], s0[1]), s1[0]);
#pragma unroll
            for (int i = 2; i < 16; i += 2) mx = fmaxf(fmaxf(mx, s0[i]), s0[i + 1]);
#pragma unroll
            for (int i = 1; i < 15; i += 2) mx = fmaxf(fmaxf(mx, s1[i]), s1[i + 1]);
            mx = fmaxf(mx, s1[15]);
            mx = fmaxf(mx, __shfl_xor(mx, 32));
            if (t == 0 || __any(mx > ATT_THR)) {
                const float dl = (t == 0) ? mx : fmaxf(mx, 0.f), f = (t == 0) ? 1.f : __builtin_amdgcn_exp2f(-dl);
                mhat += dl; l *= f;
#pragma unroll
                for (int i = 0; i < 16; ++i) { s0[i] -= dl; s1[i] -= dl; o0[i] *= f; o1[i] *= f; negm[i] = -mhat; }
            }
            float rs = 0.f;
#pragma unroll
            for (int i = 0; i < 16; ++i) {
                float p0 = __builtin_amdgcn_exp2f(s0[i]), p1 = __builtin_amdgcn_exp2f(s1[i]);
                if (!MLA) { p0 = att_mask(p0, w0, crow(i, 0)); p1 = att_mask(p1, w1, crow(i, 0)); }
                s0[i] = p0; s1[i] = p1; rs += p0 + p1; }
            l += rs;
            bf16x8 pf[4];
#pragma unroll
            for (int ks = 0; ks < 4; ++ks) { v4u w;
#pragma unroll
                for (int j = 0; j < 4; ++j) { const float a = (ks < 2) ? s0[8 * (ks & 1) + 2 * j] : s1[8 * (ks & 1) + 2 * j], c = (ks < 2) ? s0[8 * (ks & 1) + 2 * j + 1] : s1[8 * (ks & 1) + 2 * j + 1]; w[j] = pk2(a, c); }
                pf[ks] = __builtin_bit_cast(bf16x8, w); }
#pragma unroll
            for (int ks = 0; ks < 4; ++ks) {
                const bf16x8 A0 = __builtin_shufflevector(vf[ks][0], vf[ks][1], 0, 1, 2, 3, 4, 5, 6, 7);
                const bf16x8 A1 = __builtin_shufflevector(vf[ks][2], vf[ks][3], 0, 1, 2, 3, 4, 5, 6, 7);
                o0 = __builtin_amdgcn_mfma_f32_32x32x16_bf16(A0, pf[ks], o0, 0, 0, 0);
                o1 = __builtin_amdgcn_mfma_f32_32x32x16_bf16(A1, pf[ks], o1, 0, 0, 0);
            }
        }
        if (t + 1 < NT) ATT_WRITE(buf ^ 1);
        __syncthreads();
    }
    l += __shfl_xor(l, 32);
    const float inv = 1.f / l;
    bf16* op = P.O + (rowb + qrow) * 512 + h * 64 + 4 * hi;
#pragma unroll
    for (int g = 0; g < 4; ++g) {
        v2u w; w.x = pk2(o0[4 * g] * inv, o0[4 * g + 1] * inv); w.y = pk2(o0[4 * g + 2] * inv, o0[4 * g + 3] * inv); *(v2u*)(op + 8 * g) = w;
        v2u z; z.x = pk2(o1[4 * g] * inv, o1[4 * g + 1] * inv); z.y = pk2(o1[4 * g + 2] * inv, o1[4 * g + 3] * inv); *(v2u*)(op + 32 + 8 * g) = z;
    }
#undef ATT_KSRC
#undef ATT_LOAD
#undef ATT_WRITE
}

namespace attn_body {
using bf16=__hip_bfloat16;
using bf16x8=__attribute__((ext_vector_type(8)))short;
using s16x4=__attribute__((ext_vector_type(4)))short;
using f32x16=__attribute__((ext_vector_type(16)))float;
using u32x4=__attribute__((ext_vector_type(4)))unsigned;
constexpr int BATCH=2,NHEAD=8,SEQ=8192,D=64,DM=NHEAD*D;
constexpr int NW=8,QBLK=32,QB=QBLK*NW,KVBLK=64,NQB=SEQ/QB;
constexpr int ATTN_PITCH=DM, ATTN_UNIT_ROWS=QB;
__device__ __forceinline__ int crow(int r,int hi){return (r&3)+8*(r>>2)+4*hi;}
#define SBAR() __builtin_amdgcn_sched_barrier(0)
__device__ __forceinline__ void cmask(f32x16&p0,f32x16&p1,int jb,int wid){
  if(jb>(wid>>1)){
    #pragma unroll
    for(int r=0;r<16;++r){p0[r]=-INFINITY;p1[r]=-INFINITY;} }
}
__device__ __forceinline__ float amask(float p,unsigned w,int bit){ int mk; asm("v_bfe_i32 %0, %1, %2, 1":"=v"(mk):"v"(w),"i"(bit)); return __builtin_bit_cast(float,__builtin_bit_cast(unsigned,p)&(unsigned)mk); }
__device__ __forceinline__ void glds16o(const void*sbase,unsigned voff,unsigned lds_dst){unsigned keep;
  asm volatile("s_mov_b32 %0, m0\n\ts_mov_b32 m0, %3\n\ts_nop 0\n\tglobal_load_lds_dwordx4 %1, %2\n\ts_mov_b32 m0, %0":"=&s"(keep):"v"(voff),"s"(sbase),"s"(lds_dst):"memory");}
__device__ __forceinline__ void glds4o(const void*sbase,unsigned voff,unsigned lds_dst){unsigned keep;
  asm volatile("s_mov_b32 %0, m0\n\ts_mov_b32 m0, %3\n\ts_nop 0\n\tglobal_load_lds_dword %1, %2\n\ts_mov_b32 m0, %0":"=&s"(keep):"v"(voff),"s"(sbase),"s"(lds_dst):"memory");}
__device__ __forceinline__ void glds4(const void*gsrc,unsigned lds_dst){unsigned keep;
  asm volatile("s_mov_b32 %0, m0\n\ts_mov_b32 m0, %2\n\ts_nop 0\n\tglobal_load_lds_dword %1, off\n\ts_mov_b32 m0, %0":"=&s"(keep):"v"(gsrc),"s"(lds_dst):"memory");}

constexpr int NSLOT=3, SLOTB=8192, KSLOTMAX=12288;
constexpr int LDS_K=0, LDS_V=NSLOT*KSLOTMAX, LDS_WS=LDS_V+NSLOT*SLOTB, LDS_OST=LDS_WS+NW*64*4, LDS_BM=LDS_OST+NW*4096, LDS_BYTES=LDS_BM+NW*512;
constexpr float C2=0.125f*1.4426950408889634f;
__device__ __forceinline__ void glds16(const void*gsrc,unsigned lds_dst){unsigned keep;
  asm volatile("s_mov_b32 %0, m0\n\ts_mov_b32 m0, %2\n\ts_nop 0\n\tglobal_load_lds_dwordx4 %1, off\n\ts_mov_b32 m0, %0":"=&s"(keep):"v"(gsrc),"s"(lds_dst):"memory");}
__device__ __forceinline__ float max3f(float a,float b,float c){float r;asm("v_max3_f32 %0, %1, %2, %3":"=v"(r):"v"(a),"v"(b),"v"(c));return r;}
__device__ __forceinline__ float max2f(float a,float b){float r;asm("v_max_f32_e32 %0, %1, %2":"=v"(r):"v"(a),"v"(b));return r;}
__device__ __forceinline__ float fadd_s(float a,float b){float r;asm("v_add_f32_e32 %0, %1, %2":"=v"(r):"v"(a),"v"(b));return r;}
__device__ __forceinline__ float fsub_s(float a,float b){float r;asm("v_sub_f32_e32 %0, %1, %2":"=v"(r):"v"(a),"v"(b));return r;}
typedef float f32x2_t __attribute__((ext_vector_type(2))); typedef __bf16 bf16x2_t __attribute__((ext_vector_type(2)));
__device__ __forceinline__ unsigned cvtpk_s(float lo,float hi){f32x2_t v={lo,hi};bf16x2_t b=__builtin_convertvector(v,bf16x2_t);return __builtin_bit_cast(unsigned,b);}
#define WAIT_BAR(N) asm volatile("s_waitcnt vmcnt(" #N ") lgkmcnt(0)\n\ts_barrier":::"memory")

template<int NKS> __device__ __forceinline__ void qkt(f32x16&p0,f32x16&p1,const char*Kslot,const bf16x8*qr,const f32x16&negm,int r32,int hi){
  const char*kb=Kslot+hi*1024+r32*16;
  #pragma unroll
  for(int d0=0;d0<NKS;++d0){
    const bf16x8 b0=*reinterpret_cast<const bf16x8*>(kb+d0*2048);
    const bf16x8 b1=*reinterpret_cast<const bf16x8*>(kb+d0*2048+512);
    if(d0==0){p0=__builtin_amdgcn_mfma_f32_32x32x16_bf16(b0,qr[0],negm,0,0,0);p1=__builtin_amdgcn_mfma_f32_32x32x16_bf16(b1,qr[0],negm,0,0,0);}
    else{p0=__builtin_amdgcn_mfma_f32_32x32x16_bf16(b0,qr[d0],p0,0,0,0);p1=__builtin_amdgcn_mfma_f32_32x32x16_bf16(b1,qr[d0],p1,0,0,0);}}
}
typedef __attribute__((address_space(3))) const char* lds_cptr;
typedef short v4i16_t __attribute__((ext_vector_type(4)));
__device__ __forceinline__ void kload8(bf16x8*kf,lds_cptr kp){
  kf[0]=*(const __attribute__((address_space(3))) bf16x8*)(kp);      kf[1]=*(const __attribute__((address_space(3))) bf16x8*)(kp+512);
  kf[2]=*(const __attribute__((address_space(3))) bf16x8*)(kp+2048); kf[3]=*(const __attribute__((address_space(3))) bf16x8*)(kp+2560);
  kf[4]=*(const __attribute__((address_space(3))) bf16x8*)(kp+4096); kf[5]=*(const __attribute__((address_space(3))) bf16x8*)(kp+4608);
  kf[6]=*(const __attribute__((address_space(3))) bf16x8*)(kp+6144); kf[7]=*(const __attribute__((address_space(3))) bf16x8*)(kp+6656);
}
__device__ __forceinline__ void kload2(bf16x8*kf,lds_cptr kp,int j){ kf[2*j]=*(const __attribute__((address_space(3))) bf16x8*)(kp+j*2048); kf[2*j+1]=*(const __attribute__((address_space(3))) bf16x8*)(kp+j*2048+512); }
__device__ __forceinline__ s16x4 vtr(lds_cptr p){ return __builtin_bit_cast(s16x4,__builtin_amdgcn_ds_read_tr16_b64_v4i16((__attribute__((address_space(3))) v4i16_t*)p)); }
__device__ __forceinline__ float rowmax(const f32x16&p0,const f32x16&p1){
  float a=max3f(p0[0],p0[1],p1[0]),b=max3f(p0[2],p0[3],p1[1]);a=max3f(a,p1[2],p1[3]);
  #pragma unroll
  for(int r=4;r<16;r+=4){a=max3f(a,p0[r],p0[r+1]);b=max3f(b,p0[r+2],p0[r+3]);a=max3f(a,p1[r],p1[r+1]);b=max3f(b,p1[r+2],p1[r+3]);}
  const float m=max2f(a,b);
  auto rr=__builtin_amdgcn_permlane32_swap(__float_as_uint(m),__float_as_uint(m),false,false);
  return max2f(__uint_as_float(rr[0]),__uint_as_float(rr[1]));
}
__device__ __forceinline__ void pv(f32x16*o,int vb,bf16x8 pa0,bf16x8 pa1,bf16x8 pa2,bf16x8 pa3){
  #pragma unroll
  for(int d0=0;d0<2;++d0){s16x4 lo[4],hi[4];
    #pragma unroll
    for(int ks=0;ks<4;++ks){
      asm volatile("ds_read_b64_tr_b16 %0,%1 offset:%c2":"=&v"(lo[ks]):"v"(vb),"i"(d0*4096+ks*1024):"memory");
      asm volatile("ds_read_b64_tr_b16 %0,%1 offset:%c2":"=&v"(hi[ks]):"v"(vb),"i"(d0*4096+ks*1024+512):"memory");}
    asm volatile("s_waitcnt lgkmcnt(0)":::"memory");SBAR();
    #define PK(k) (bf16x8){lo[k][0],lo[k][1],lo[k][2],lo[k][3],hi[k][0],hi[k][1],hi[k][2],hi[k][3]}
    o[d0]=__builtin_amdgcn_mfma_f32_32x32x16_bf16(pa0,PK(0),o[d0],0,0,0);
    o[d0]=__builtin_amdgcn_mfma_f32_32x32x16_bf16(pa1,PK(1),o[d0],0,0,0);
    o[d0]=__builtin_amdgcn_mfma_f32_32x32x16_bf16(pa2,PK(2),o[d0],0,0,0);
    o[d0]=__builtin_amdgcn_mfma_f32_32x32x16_bf16(pa3,PK(3),o[d0],0,0,0);
    #undef PK
  }
}

#ifndef ATTN_STORE16
#define ATTN_STORE16(p,v) (*(u32x4*)(p)=(v))
#endif
template<int THRL,bool MLA> __device__ __forceinline__ void attn_unit(int b,int h,int qb,const bf16*Q,const bf16*__restrict__ K,const bf16*__restrict__ K2,const bf16*__restrict__ V,bf16*O,const unsigned*BMg,char*shm,int tid){
  constexpr int NKS=MLA?6:4, QP=MLA?768:512, DQ=MLA?96:64;
  const int lane=tid&63,r32=lane&31,hi=lane>>5; const int wid=__builtin_amdgcn_readfirstlane(tid>>6);
  const long rowbase=(long)b*SEQ; const int q0=qb*QB;
  const bf16*Qw=Q+(rowbase+q0+wid*QBLK)*QP+h*DQ;
  const bf16*Kh=K+rowbase*DM+h*D,*Vh=V+rowbase*DM+h*D;
  const unsigned lds0=(unsigned)(uintptr_t)shm;
  float*wsf=(float*)(shm+LDS_WS)+wid*64;
  const unsigned koff=(unsigned)(lane*DM+wid*8)*2u;
  const unsigned voff=(unsigned)((16*(wid&3)+(lane>>2))*DM+(wid>>2)*32+(lane&3)*8)*2u;
  const unsigned kdst=lds0+LDS_K+wid*1024, vdst=lds0+LDS_V+wid*1024;
  const bf16*K2h=MLA?K2+rowbase*32:nullptr; const unsigned koff2=(unsigned)(lane*32+(wid&3)*8)*2u; const unsigned kdst2=lds0+LDS_K+(8+(wid&3))*1024;
  #define KO(sl) (MLA?(sl)+((sl)>>1):(sl))
  #define DMA_K(t,slot) do{ glds16o(Kh+(long)(t)*KVBLK*DM,koff,(unsigned)__builtin_amdgcn_readfirstlane(kdst+KO(slot))); \
    if constexpr(MLA) glds16o(K2h+(long)(t)*KVBLK*32,koff2,(unsigned)__builtin_amdgcn_readfirstlane(kdst2+KO(slot))); }while(0)
  #define DMA_V(t,slot) glds16o(Vh+(long)(t)*KVBLK*DM,voff,(unsigned)__builtin_amdgcn_readfirstlane(vdst+(slot)))
  const unsigned*BMb=BMg+(long)b*256*SEQ+q0+wid*QBLK; const unsigned bmoff=(unsigned)(hi*SEQ+r32)*4u; const unsigned bmdst=lds0+LDS_BM+wid*512;
  const __attribute__((address_space(3))) unsigned*bmw=(const __attribute__((address_space(3))) unsigned*)((lds_cptr)shm+LDS_BM+wid*512);
  #define DMA_BM(t) if constexpr(!MLA) glds4o(BMb+(long)(t)*2*SEQ,bmoff,(unsigned)__builtin_amdgcn_readfirstlane(bmdst+((t)&1)*256))
  #define VMW(N) asm volatile("s_waitcnt vmcnt(" #N ")":::"memory")
  #define BMWAIT(t) do{ if constexpr(!MLA){ if((t)+3<NT){VMW(5);} else if((t)+2<NT){VMW(4);} else if((t)+1<NT){VMW(3);} else {VMW(1);} } }while(0)
  const int vb0=(int)(lds0+LDS_V)+((lane>>4)&1)*32+(lane&3)*8+(4*hi+((lane&15)>>2))*64;
  const char*Kbase=shm+LDS_K; bf16x8 kf[2*NKS];
  const lds_cptr shm3=(lds_cptr)shm; const lds_cptr kp0=shm3+LDS_K+hi*1024+r32*16; const lds_cptr vp0=shm3+LDS_V+((lane>>4)&1)*32+(lane&3)*8+(4*hi+((lane&15)>>2))*64;
  const int NT=(q0+QB)/KVBLK;
  DMA_BM(0);DMA_K(0,0);DMA_V(0,0);DMA_K(1,SLOTB);
  bf16x8 qr[NKS];
  #pragma unroll
  for(int d0=0;d0<NKS;++d0)qr[d0]=*reinterpret_cast<const bf16x8*>(&Qw[(long)r32*QP+d0*16+hi*8]);
  float mhat=0.f,l_reg=0.f;f32x16 o[2];o[0]=f32x16{};o[1]=f32x16{};f32x16 negm=f32x16{};asm volatile("":"+v"(negm));
  const int qrel=wid*QBLK+r32;
  #define CMASK(P0,P1,t) do{int jb_=(t)-(NT-4); if(jb_>=0)cmask(P0,P1,jb_,wid);}while(0)
  bool resc=false;
  #define START(P0,P1) do{ const float rm=rowmax(P0,P1); resc=false; \
    { const float dl=rm; mhat=fadd_s(mhat,dl); \
      _Pragma("unroll") for(int r=0;r<16;++r){P0[r]=fsub_s(P0[r],dl);P1[r]=fsub_s(P1[r],dl);} \
      _Pragma("unroll") for(int r=0;r<16;++r)negm[r]=-mhat; asm volatile("":"+v"(negm)); } \
    _Pragma("unroll") for(int r=0;r<16;++r)P0[r]=__builtin_amdgcn_exp2f(P0[r]); }while(0)
  #define RESC() do{ if(resc){ asm volatile("s_waitcnt lgkmcnt(0)":::"memory"); \
      _Pragma("unroll") for(int d_=0;d_<2;++d_) _Pragma("unroll") for(int r=0;r<16;++r)o[d_][r]*=wsf[crow(r,hi)]; } }while(0)
  f32x16 pA0,pA1,pB0,pB1;
  int sl_prev=0,sl_cur=0,sl_next=SLOTB;
  #define ROT() do{sl_prev=sl_cur;sl_cur=sl_next;sl_next=(sl_next==(NSLOT-1)*SLOTB)?0:sl_next+SLOTB;}while(0)
  DMA_K(2,2*SLOTB);
  if constexpr(MLA){WAIT_BAR(5);}else{WAIT_BAR(3);}
  qkt<NKS>(pA0,pA1,Kbase,qr,negm,r32,hi);asm volatile("s_nop 15\n\ts_nop 7":"+v"(pA0),"+v"(pA1));CMASK(pA0,pA1,0);
  START(pA0,pA1);
  _Pragma("unroll") for(int r=0;r<16;++r)pA1[r]=__builtin_amdgcn_exp2f(pA1[r]);
  if constexpr(!MLA){ const unsigned w0_=bmw[r32]>>(4*hi), w1_=bmw[32+r32]>>(4*hi);
    _Pragma("unroll") for(int r=0;r<16;++r){pA0[r]=amask(pA0[r],w0_,(r&3)+8*(r>>2));pA1[r]=amask(pA1[r],w1_,(r&3)+8*(r>>2));} }
  WAIT_BAR(0);
  DMA_BM(1);DMA_K(3,0);DMA_V(1,SLOTB);
  ROT();
  _Pragma("unroll") for(int j=0;j<NKS;++j)kload2(kf,kp0+KO(sl_cur),j);
  WAIT_BAR(3);
  s16x4 vlo[8],vhi[8]; u32x4 pw0,pw1,pw2,pw3;
  #define PKW(P,B) cvtpk_s(P[B],P[B+1])
  #define PAF(k) __builtin_bit_cast(bf16x8,pw##k)
  #define VFR(i) (bf16x8){vlo[i][0],vlo[i][1],vlo[i][2],vlo[i][3],vhi[i][0],vhi[i][1],vhi[i][2],vhi[i][3]}
  #define PIN(x) asm volatile("":"+v"(x))
  #define MX3(a,b,c) __builtin_fmaxf(__builtin_fmaxf((a),(b)),(c))
  #define GAPA(MF,A0,A1,A2,A3,W0,W1,PW) do{ MF; sacc+=A0; sacc+=A1; sacc+=A2; sacc+=A3; PIN(sacc); W0; W1; PIN(PW); SBAR(); }while(0)
  #define EX(v) __builtin_amdgcn_exp2f(v)
  #define CR_(r) (((r)&3)+8*((r)>>2))
  #define GAPB(MF,X,B,W) do{ MF; X[B]=EX(X[B]); X[B+1]=EX(X[B+1]); X[B+2]=EX(X[B+2]); X[B+3]=EX(X[B+3]); \
    if constexpr(!MLA){ X[B]=amask(X[B],W,CR_(B)); X[B+1]=amask(X[B+1],W,CR_(B+1)); X[B+2]=amask(X[B+2],W,CR_(B+2)); X[B+3]=amask(X[B+3],W,CR_(B+3)); } PIN(X); SBAR(); }while(0)
  #define VRD(i) do{ vlo[i]=vtr(vp_+(((i)>>2)*4096+((i)&3)*1024)); vhi[i]=vtr(vp_+(((i)>>2)*4096+((i)&3)*1024+512)); }while(0)
  #define KRD(G,j) do{ if((j)<NKS){ if(G){ kload2(kf,kp0+KO(sl_next),j); SBAR(); } } }while(0)
  #define STEP(C0,C1,P0,P1,t,GK,GV,GL) do{ SBAR(); \
    const lds_cptr vp_=vp0+sl_prev; \
    VRD(0); SBAR(); float sacc=(P0[0]+P0[1]); \
    GAPA(C0=__builtin_amdgcn_mfma_f32_32x32x16_bf16(kf[0],qr[0],negm,0,0,0), P0[2],P0[3],P0[4],P0[5],     pw0[0]=PKW(P0,0), pw0[1]=PKW(P0,2), pw0); \
    VRD(4); SBAR(); GAPA(C1=__builtin_amdgcn_mfma_f32_32x32x16_bf16(kf[1],qr[0],negm,0,0,0), P0[6],P0[7],P0[8],P0[9],     pw0[2]=PKW(P0,4), pw0[3]=PKW(P0,6), pw0); \
    VRD(1); SBAR(); GAPA(C0=__builtin_amdgcn_mfma_f32_32x32x16_bf16(kf[2],qr[1],C0,0,0,0),   P0[10],P0[11],P0[12],P0[13], pw1[0]=PKW(P0,8), pw1[1]=PKW(P0,10), pw1); \
    VRD(5); SBAR(); GAPA(C1=__builtin_amdgcn_mfma_f32_32x32x16_bf16(kf[3],qr[1],C1,0,0,0),   P0[14],P0[15],P1[0],P1[1],   pw1[2]=PKW(P0,12),pw1[3]=PKW(P0,14), pw1); \
    VRD(2); SBAR(); GAPA(C0=__builtin_amdgcn_mfma_f32_32x32x16_bf16(kf[4],qr[2],C0,0,0,0),   P1[2],P1[3],P1[4],P1[5],     pw2[0]=PKW(P1,0), pw2[1]=PKW(P1,2), pw2); \
    VRD(6); SBAR(); GAPA(C1=__builtin_amdgcn_mfma_f32_32x32x16_bf16(kf[5],qr[2],C1,0,0,0),   P1[6],P1[7],P1[8],P1[9],     pw2[2]=PKW(P1,4), pw2[3]=PKW(P1,6), pw2); \
    VRD(3); SBAR(); GAPA(C0=__builtin_amdgcn_mfma_f32_32x32x16_bf16(kf[6],qr[3],C0,0,0,0),   P1[10],P1[11],P1[12],P1[13], pw3[0]=PKW(P1,8), pw3[1]=PKW(P1,10), pw3); \
    VRD(7); SBAR(); GAPA(C1=__builtin_amdgcn_mfma_f32_32x32x16_bf16(kf[7],qr[3],C1,0,0,0),   P1[14],P1[15],0.f,0.f,       pw3[2]=PKW(P1,12),pw3[3]=PKW(P1,14), pw3); \
    if constexpr(MLA){ C0=__builtin_amdgcn_mfma_f32_32x32x16_bf16(kf[8],qr[4],C0,0,0,0); C1=__builtin_amdgcn_mfma_f32_32x32x16_bf16(kf[9],qr[4],C1,0,0,0); \
      C0=__builtin_amdgcn_mfma_f32_32x32x16_bf16(kf[10],qr[5],C0,0,0,0); C1=__builtin_amdgcn_mfma_f32_32x32x16_bf16(kf[11],qr[5],C1,0,0,0); SBAR(); } \
    l_reg+=sacc; \
    if(GV){DMA_BM((t)+1);} if(GK){DMA_K((t)+3,sl_cur);} if(GV){DMA_V((t)+1,sl_next);} \
    CMASK(C0,C1,t); \
    { float a=MX3(C0[0],C0[1],C1[0]),b=MX3(C0[2],C0[3],C1[1]); a=MX3(a,C1[2],C1[3]); \
      _Pragma("unroll") for(int r=4;r<16;r+=4){a=MX3(a,C0[r],C0[r+1]);b=MX3(b,C0[r+2],C0[r+3]);a=MX3(a,C1[r],C1[r+1]);b=MX3(b,C1[r+2],C1[r+3]);} \
      float rm=__builtin_fmaxf(a,b); { auto rr=__builtin_amdgcn_permlane32_swap(__float_as_uint(rm),__float_as_uint(rm),false,false); rm=__builtin_fmaxf(__uint_as_float(rr[0]),__uint_as_float(rr[1])); } \
      resc=false; \
      if(__builtin_expect(__any(rm>(float)THRL),0)){ const float dl=__builtin_fmaxf(rm,0.f); mhat+=dl; \
        _Pragma("unroll") for(int r=0;r<16;++r){C0[r]-=dl;C1[r]-=dl;} \
        _Pragma("unroll") for(int r=0;r<16;++r)negm[r]=-mhat; asm volatile("":"+v"(negm)); \
        const float f=__builtin_amdgcn_exp2f(-dl); l_reg*=f; if(hi==0)wsf[r32]=f; resc=true; } } \
    BMWAIT(t); unsigned w0_=0u, w1_=0u; if constexpr(!MLA){ w0_=bmw[((t)&1)*64+r32]>>(4*hi); w1_=bmw[((t)&1)*64+32+r32]>>(4*hi); } \
    SBAR(); \
    GAPB(o[0]=__builtin_amdgcn_mfma_f32_32x32x16_bf16(PAF(0),VFR(0),o[0],0,0,0), C0,0,w0_); \
    KRD(GL,4); GAPB(o[1]=__builtin_amdgcn_mfma_f32_32x32x16_bf16(PAF(0),VFR(4),o[1],0,0,0), C0,4,w0_); \
    KRD(GL,0); GAPB(o[0]=__builtin_amdgcn_mfma_f32_32x32x16_bf16(PAF(1),VFR(1),o[0],0,0,0), C0,8,w0_); \
    KRD(GL,1); GAPB(o[1]=__builtin_amdgcn_mfma_f32_32x32x16_bf16(PAF(1),VFR(5),o[1],0,0,0), C0,12,w0_); \
    KRD(GL,2); GAPB(o[0]=__builtin_amdgcn_mfma_f32_32x32x16_bf16(PAF(2),VFR(2),o[0],0,0,0), C1,0,w1_); \
    KRD(GL,3); GAPB(o[1]=__builtin_amdgcn_mfma_f32_32x32x16_bf16(PAF(2),VFR(6),o[1],0,0,0), C1,4,w1_); \
    KRD(GL,5); GAPB(o[0]=__builtin_amdgcn_mfma_f32_32x32x16_bf16(PAF(3),VFR(3),o[0],0,0,0), C1,8,w1_); \
    GAPB(o[1]=__builtin_amdgcn_mfma_f32_32x32x16_bf16(PAF(3),VFR(7),o[1],0,0,0), C1,12,w1_); \
    }while(0)
  int t=1;
  #undef CMASK
  #define CMASK(P0,P1,t) do{}while(0)
  for(;t+5<NT;t+=2){
    STEP(pB0,pB1,pA0,pA1,t,true,true,true);     WAIT_BAR(3); RESC(); ROT();
    STEP(pA0,pA1,pB0,pB1,t+1,true,true,true);   WAIT_BAR(3); RESC(); ROT();
  }
  #undef CMASK
  #define CMASK(P0,P1,t) do{int jb_=(t)-(NT-4); if(jb_>=0)cmask(P0,P1,jb_,wid);}while(0)
  #define ENDW(tt) do{ if((tt)+3<NT){WAIT_BAR(3);} else if((tt)+2<NT){ if constexpr(MLA){WAIT_BAR(1);}else{WAIT_BAR(2);} } else {WAIT_BAR(0);} }while(0)
  for(;t+1<NT;t+=2){
    STEP(pB0,pB1,pA0,pA1,t,(t+3<NT),(t+1<NT),(t+1<NT));       ENDW(t);   RESC(); ROT();
    STEP(pA0,pA1,pB0,pB1,t+1,(t+4<NT),(t+2<NT),(t+2<NT));     ENDW(t+1); RESC(); ROT();
  }
  STEP(pB0,pB1,pA0,pA1,NT-1,false,false,false); RESC();
  { float sacc=pB0[0]+pB0[1]; _Pragma("unroll") for(int r=2;r<16;++r)sacc+=pB0[r]; _Pragma("unroll") for(int r=0;r<16;++r)sacc+=pB1[r]; l_reg+=sacc;
    pw0=(u32x4){PKW(pB0,0),PKW(pB0,2),PKW(pB0,4),PKW(pB0,6)};pw1=(u32x4){PKW(pB0,8),PKW(pB0,10),PKW(pB0,12),PKW(pB0,14)};pw2=(u32x4){PKW(pB1,0),PKW(pB1,2),PKW(pB1,4),PKW(pB1,6)};pw3=(u32x4){PKW(pB1,8),PKW(pB1,10),PKW(pB1,12),PKW(pB1,14)};
    SBAR(); pv(o,vb0+sl_cur,PAF(0),PAF(1),PAF(2),PAF(3)); }
  #undef PKW
  #undef PAF
  #undef VFR
  #undef PIN
  #undef MX3
  #undef GAPA
  #undef GAPB
  #undef EX
  #undef VRD
  #undef KRD
  #undef STEP
  #undef ENDW
  {auto rr=__builtin_amdgcn_permlane32_swap(__float_as_uint(l_reg),__float_as_uint(l_reg),false,false);l_reg=__uint_as_float(rr[0])+__uint_as_float(rr[1]);}
  if(hi==0)wsf[32+r32]=l_reg;asm volatile("s_waitcnt lgkmcnt(0)":::"memory");
  float rli[16];
  #pragma unroll
  for(int r=0;r<16;++r)rli[r]=__builtin_amdgcn_rcpf(wsf[32+crow(r,hi)]);
  bf16*Ow=O+(rowbase+q0+wid*QBLK)*DM+h*D;
  { bf16*stg=(bf16*)(shm+LDS_OST)+wid*2048;
    #pragma unroll
    for(int r=0;r<16;++r){const int orow=crow(r,hi);
      #pragma unroll
      for(int d0=0;d0<2;++d0)stg[orow*64+d0*32+r32]=__float2bfloat16(o[d0][r]*rli[r]);}
    asm volatile("s_waitcnt lgkmcnt(0)":::"memory");
    #pragma unroll
    for(int i=0;i<4;++i){const int row=i*8+(lane>>3),ch=lane&7; const u32x4 v=*(const u32x4*)(stg+row*64+ch*8); ATTN_STORE16(Ow+(long)row*DM+ch*8,v);} }
  asm volatile("s_waitcnt lgkmcnt(0)\n\ts_barrier":::"memory");
  #undef DMA_K
  #undef DMA_BM
  #undef KO
  #undef VMW
  #undef BMWAIT
  #undef CR_
  #undef DMA_V
  #undef CMASK
  #undef START
  #undef RESC
  #undef ROT
}
#undef SBAR
#undef WAIT_BAR
}
__device__ __forceinline__ unsigned row16_sum(unsigned x) {
    x += (unsigned)__builtin_amdgcn_update_dpp(0, (int)x, 0x128, 0xf, 0xf, false); x += (unsigned)__builtin_amdgcn_update_dpp(0, (int)x, 0x124, 0xf, 0xf, false);
    x += (unsigned)__builtin_amdgcn_update_dpp(0, (int)x, 0x122, 0xf, 0xf, false); x += (unsigned)__builtin_amdgcn_update_dpp(0, (int)x, 0x121, 0xf, 0xf, false); return x; }
__device__ __forceinline__ float row16_sumf(float x) {
    x += __builtin_bit_cast(float, __builtin_amdgcn_update_dpp(0, __builtin_bit_cast(int, x), 0x128, 0xf, 0xf, false)); x += __builtin_bit_cast(float, __builtin_amdgcn_update_dpp(0, __builtin_bit_cast(int, x), 0x124, 0xf, 0xf, false));
    x += __builtin_bit_cast(float, __builtin_amdgcn_update_dpp(0, __builtin_bit_cast(int, x), 0x122, 0xf, 0xf, false)); x += __builtin_bit_cast(float, __builtin_amdgcn_update_dpp(0, __builtin_bit_cast(int, x), 0x121, 0xf, 0xf, false)); return x; }
__device__ __forceinline__ unsigned row16_suffix(unsigned x) {
    x += (unsigned)__builtin_amdgcn_update_dpp(0, (int)x, 0x101, 0xf, 0xf, false); x += (unsigned)__builtin_amdgcn_update_dpp(0, (int)x, 0x102, 0xf, 0xf, false);
    x += (unsigned)__builtin_amdgcn_update_dpp(0, (int)x, 0x104, 0xf, 0xf, false); x += (unsigned)__builtin_amdgcn_update_dpp(0, (int)x, 0x108, 0xf, 0xf, false); return x; }
__device__ __forceinline__ unsigned half_or(unsigned x) { const auto rr = __builtin_amdgcn_permlane32_swap(x, x, false, false); return rr[0] | rr[1]; }
constexpr int CAND_CAP = 128, QIP = 1296, HS = 513, FAST_CAP = 512;
struct IdxP { const bf16 *QI, *KI; const float* WI; unsigned* BM; unsigned* dbg; };
__device__ __forceinline__ unsigned mono_key(float s) { const unsigned u = __builtin_bit_cast(unsigned, s + 0.0f); return u ^ ((unsigned)((int)u >> 31) | 0x80000000u); }
__device__ __forceinline__ void idx_scores2(const bf16x8 (&kf)[2][4], const LAS unsigned char* qlane, const float (&wq)[8], f32x16& sc0, f32x16& sc1) {
    bf16x8 qv[4], qn[4];
#pragma unroll
    for (int s = 0; s < 4; ++s) qv[s] = *(const LAS bf16x8*)(qlane + 8 * 128 + s * 32);
#pragma unroll
    for (int i = 0; i < 16; ++i) { sc0[i] = 0.f; sc1[i] = 0.f; }
    f32x16 ap0, ap1;
#pragma unroll
    for (int i = 0; i < 16; ++i) { ap0[i] = 0.f; ap1[i] = 0.f; }
#pragma unroll
    for (int n = 0; n < 10; ++n) {
        const int nh = (n + 1 < 2) ? 9 : (n + 1 - 2);
        if (n + 1 < 10) {
#pragma unroll
            for (int s = 0; s < 4; ++s) qn[s] = *(const LAS bf16x8*)(qlane + nh * 128 + s * 32); }
        f32x16 a0, a1;
        if (n < 2) {
#pragma unroll
            for (int s = 0; s < 4; ++s) { sc0 = __builtin_amdgcn_mfma_f32_32x32x16_bf16(kf[0][s], qv[s], sc0, 0, 0, 0); sc1 = __builtin_amdgcn_mfma_f32_32x32x16_bf16(kf[1][s], qv[s], sc1, 0, 0, 0); }
        } else {
#pragma unroll
            for (int i = 0; i < 16; ++i) { a0[i] = 0.f; a1[i] = 0.f; }
#pragma unroll
            for (int s = 0; s < 4; ++s) { a0 = __builtin_amdgcn_mfma_f32_32x32x16_bf16(kf[0][s], qv[s], a0, 0, 0, 0); a1 = __builtin_amdgcn_mfma_f32_32x32x16_bf16(kf[1][s], qv[s], a1, 0, 0, 0); }
        }
        if (n >= 3) {
            const float w = wq[n - 3];
#pragma unroll
            for (int i = 0; i < 16; ++i) { sc0[i] = __builtin_fmaf(w, __builtin_fabsf(ap0[i]), sc0[i]); sc1[i] = __builtin_fmaf(w, __builtin_fabsf(ap1[i]), sc1[i]); }
#pragma unroll
            for (int g = 0; g < 8; ++g) { __builtin_amdgcn_sched_group_barrier(0x008, 1, 0); __builtin_amdgcn_sched_group_barrier(0x002, 4, 0); }
        }
        if (n >= 2) { ap0 = a0; ap1 = a1; }
#pragma unroll
        for (int s = 0; s < 4; ++s) qv[s] = qn[s];
    }
    { const float w = wq[7];
#pragma unroll
      for (int i = 0; i < 16; ++i) { sc0[i] = __builtin_fmaf(w, __builtin_fabsf(ap0[i]), sc0[i]); sc1[i] = __builtin_fmaf(w, __builtin_fabsf(ap1[i]), sc1[i]); } }
#pragma unroll
    for (int i = 0; i < 16; ++i) asm volatile("" : "+v"(sc0[i]), "+v"(sc1[i]));
}
__device__ __forceinline__ void idx_item(LAS unsigned char* L, int b, int j, const IdxP& P, int tid, int lane, int wave) {
    LAS unsigned* hist = (LAS unsigned*)L;
    LAS unsigned* img = (LAS unsigned*)(L + 66048);
    LAS unsigned* st = (LAS unsigned*)(L + 98816);
    LAS unsigned* cand = hist;
    LAS unsigned char* Qs = L + 100864;
    const int r32 = lane & 31, hi = lane >> 5;
    const int q0 = 32 * j, ntile = 2 * (j / 2 + 1);
    const size_t rowb = (size_t)b * SEQ;
    if (ntile <= 8) {
        for (int idx = tid; idx < ntile * 32; idx += NTHR) P.BM[((size_t)b * 256 + (idx >> 5)) * SEQ + q0 + (idx & 31)] = 0xffffffffu;
        return;
    }
    const int npair = ntile >> 1, nsw = (npair + 63) >> 6, SP = min(npair, 8 * nsw);
    bf16x8 ksmp[2][4];
#ifdef SMP_PREFETCH
    if (wave < SP) { const bf16* kp = P.KI + (rowb + 64 * ((wave * npair) / SP) + r32) * 64 + 8 * hi;
#pragma unroll
        for (int s = 0; s < 4; ++s) { ksmp[0][s] = *(const bf16x8*)(kp + 16 * s); ksmp[1][s] = *(const bf16x8*)(kp + 32 * 64 + 16 * s); } }
#endif
    float wq[8];
    { for (int c = tid; c < 32 * 64; c += NTHR) { const int rr = c >> 6, ch = c & 63; *(LAS v4u*)(Qs + rr * QIP + ch * 16) = *(const v4u*)(P.QI + (rowb + q0 + rr) * 512 + ch * 8); }
      const float* wp = P.WI + (rowb + q0 + r32) * 8;
#pragma unroll
      for (int h = 0; h < 8; ++h) wq[h] = 0.5f * wp[h]; }
    if (tid < 32) { st[32 + tid] = 256u; st[64 + tid] = 0u; st[96 + tid] = 0u; }
    if (tid == 0) st[129] = 0u;
    __syncthreads();
    {
        const int r = tid >> 4, part = tid & 15;
        const float* wp = P.WI + (rowb + q0 + r) * 8;
        float qb[4] = {0.f, 0.f, 0.f, 0.f}; float rsum = 0.f;
#pragma unroll
        for (int h = 0; h < 8; ++h) { const float w = wp[h]; const v2u raw = *(const LAS v2u*)(Qs + r * QIP + h * 128 + part * 8);
            const float f0 = bflo(raw.x), f1 = bfhi(raw.x), f2 = bflo(raw.y), f3 = bfhi(raw.y);
            float nsq = (f0 * f0 + f1 * f1) + (f2 * f2 + f3 * f3);
            nsq = row16_sumf(nsq);
            rsum += fabsf(w) * sqrtf(nsq);
            qb[0] += 0.5f * w * f0; qb[1] += 0.5f * w * f1; qb[2] += 0.5f * w * f2; qb[3] += 0.5f * w * f3; }
        v2u hw, lw;
        { const unsigned h01 = pk2(qb[0], qb[1]), h23 = pk2(qb[2], qb[3]); hw.x = h01; hw.y = h23;
          lw.x = pk2(qb[0] - bflo(h01), qb[1] - bfhi(h01)); lw.y = pk2(qb[2] - bflo(h23), qb[3] - bfhi(h23)); }
        *(LAS v2u*)(Qs + r * QIP + 8 * 128 + part * 8) = hw; *(LAS v2u*)(Qs + r * QIP + 9 * 128 + part * 8) = lw;
        { const v2u kw = *(const v2u*)(P.KI + (rowb + r) * 64 + part * 4); const float f0 = bflo(kw.x), f1 = bfhi(kw.x), f2 = bflo(kw.y), f3 = bfhi(kw.y);
          float ksq = (f0 * f0 + f1 * f1) + (f2 * f2 + f3 * f3);
          ksq = row16_sumf(ksq);
          if (part == 0) { __hip_atomic_fetch_max(&st[129], __builtin_bit_cast(unsigned, ksq), __ATOMIC_RELAXED, __HIP_MEMORY_SCOPE_WORKGROUP); st[224 + r] = __builtin_bit_cast(unsigned, rsum); } }
    }
    __syncthreads();
    if (tid < 32) { const float R = 0.25f * sqrtf(__builtin_bit_cast(float, st[129])) * __builtin_bit_cast(float, st[224 + tid]);
        const float C = 0.125f * R;
        st[160 + tid] = (0x80000000u | __builtin_bit_cast(unsigned, R + C)) - 511u * 131072u; st[224 + tid] = __builtin_bit_cast(unsigned, C); st[tid] = 0u; st[192 + tid] = 0u;
        st[256 + tid] = __builtin_bit_cast(unsigned, R); st[288 + tid] = 511u; st[320 + tid] = 0u; }
    const LAS unsigned char* qlane = Qs + r32 * QIP + hi * 16;
    int level = 0;
#define IDX_KLOAD2(tp) { const bf16* kp = P.KI + (rowb + 64 * (tp) + r32) * 64 + 8 * hi; _Pragma("unroll") for (int s = 0; s < 4; ++s) { kn[0][s] = *(const bf16x8*)(kp + 16 * s); kn[1][s] = *(const bf16x8*)(kp + 32 * 64 + 16 * s); } }
#define IDX_SCORES2(tp) \
        bf16x8 kf[2][4]; _Pragma("unroll") for (int s = 0; s < 4; ++s) { kf[0][s] = kn[0][s]; kf[1][s] = kn[1][s]; } \
        f32x16 sc0, sc1; idx_scores2(kf, qlane, wq, sc0, sc1); \
        if ((tp) + NWAVES < npair) { IDX_KLOAD2((tp) + NWAVES) }
    bool slow;
    {
        for (int u = tid; u < 32 * HS; u += NTHR) hist[u] = 0u;
        if (tid == 0) st[130] = 0u;
        __syncthreads();
        const float Rq = __builtin_bit_cast(float, st[256 + r32]);
        {   const float s1 = 256.f / Rq; LAS unsigned* hrow = hist + r32 * HS;
            for (int i = wave; i < SP; i += NWAVES) { const int tp = (i * npair) / SP;
#ifdef SMP_PREFETCH
                bf16x8 kn[2][4]; if (i >= NWAVES) { IDX_KLOAD2(tp) }
#else
                bf16x8 kn[2][4]; IDX_KLOAD2(tp)
#endif
                bf16x8 kf[2][4];
#pragma unroll
#ifdef SMP_PREFETCH
                for (int s = 0; s < 4; ++s) { kf[0][s] = (i < NWAVES) ? ksmp[0][s] : kn[0][s]; kf[1][s] = (i < NWAVES) ? ksmp[1][s] : kn[1][s]; }
#else
                for (int s = 0; s < 4; ++s) { kf[0][s] = kn[0][s]; kf[1][s] = kn[1][s]; }
#endif
                f32x16 sc0, sc1; idx_scores2(kf, qlane, wq, sc0, sc1);
#pragma unroll
                for (int e = 0; e < 16; ++e) { const int b0 = min(max((int)__builtin_fmaf(sc0[e], s1, 256.f), 0), 511), b1 = min(max((int)__builtin_fmaf(sc1[e], s1, 256.f), 0), 511);
                    __hip_atomic_fetch_add(&hrow[b0], 1u, __ATOMIC_RELAXED, __HIP_MEMORY_SCOPE_WORKGROUP); __hip_atomic_fetch_add(&hrow[b1], 1u, __ATOMIC_RELAXED, __HIP_MEMORY_SCOPE_WORKGROUP); }
            }
        }
        __syncthreads();
        {
            const int q = tid >> 4, seg = tid & 15; const LAS unsigned* hq = hist + q * HS + seg * 32;
            unsigned segsum = 0u;
            for (int wi = 0; wi < 32; ++wi) segsum += hq[wi];
            unsigned S = segsum;
            S = row16_suffix(S);
            const unsigned above = S - segsum, total = row16_sum(segsum);
            const float f = (float)total / (float)(64 * npair), rs = 256.f * f, sg = 3.5f * sqrtf(rs * (1.f - f));
            const int rl = (int)floorf(rs - sg) - 1, rh = (int)ceilf(rs + sg) + 1;
            const unsigned tl = rl > 0 ? (unsigned)rl : 0u, th = (unsigned)rh;
            if (above < tl && tl <= above + segsum) { unsigned cum = above; int fb = 0; bool found = false;
                for (int wi = 31; wi >= 0; --wi) { const unsigned c = hq[wi]; if (!found && cum + c >= tl) { found = true; fb = wi; } if (!found) cum += c; }
                st[288 + q] = (unsigned)(32 * seg + fb); }
            if (above < th && th <= above + segsum) { unsigned cum = above; int fb = 0; bool found = false;
                for (int wi = 31; wi >= 0; --wi) { const unsigned c = hq[wi]; if (!found && cum + c >= th) { found = true; fb = wi; } if (!found) cum += c; }
                st[320 + q] = (unsigned)(32 * seg + fb); }
        }
        __syncthreads();
#ifdef REP_PASS2
        for (int rep2 = 0; rep2 < 2; ++rep2) { if (rep2) { __syncthreads(); if (tid < 32) st[96 + tid] = 0u; __syncthreads(); }
#else
        {
#endif
            const float wbin = Rq * (1.f / 256.f), fH = __builtin_fmaf((float)(st[288 + r32] + 1u), wbin, -Rq), fA = __builtin_fmaf((float)st[320 + r32], wbin, -Rq), s2 = 524287.f / (fH - fA), nfa = -fA * s2;
            bf16x8 kn[2][4]; if (wave < npair) { IDX_KLOAD2(wave) }
            for (int tp = wave; tp < npair; tp += NWAVES) {
                IDX_SCORES2(tp)
#define IDX_FAST_ELEMS(SC, T) { unsigned v = 0u, cm = 0u; \
            _Pragma("unroll") for (int i = 15; i >= 0; --i) { v = __builtin_amdgcn_alignbit(v, __builtin_bit_cast(unsigned, SC[i] - fH), 31);        \
                                                              cm = __builtin_amdgcn_alignbit(cm, __builtin_bit_cast(unsigned, SC[i] - fA), 31); } \
            cm = v & ~cm & 0xffffu; v = ~v & 0xffffu;                                                           \
            if (cm) { const unsigned pos0 = __hip_atomic_fetch_add(&st[96 + r32], (unsigned)__builtin_popcount(cm), __ATOMIC_RELAXED, __HIP_MEMORY_SCOPE_WORKGROUP);     \
                const unsigned rb = 8191u - (unsigned)(32 * (T)) - hi4; \
                _Pragma("unroll") for (int i = 0; i < 16; ++i) if (cm & (1u << i)) { const unsigned pos = min(pos0 + (unsigned)__builtin_popcount(cm & ((1u << i) - 1u)), (unsigned)FAST_CAP - 1u); \
                    cand[r32 * FAST_CAP + pos] = (min((unsigned)__builtin_fmaf(SC[i], s2, nfa), 524287u) << 13) | (rb - (unsigned)((i & 3) + 8 * (i >> 2))); } } \
            unsigned bits = (v & 0xfu) | ((v & 0xf0u) << 4) | ((v & 0xf00u) << 8) | ((v & 0xf000u) << 12);     \
            bits <<= 4 * hi; bits = half_or(bits); if (hi == 0) img[(T) * 32 + r32] = bits; }
                unsigned hi4 = 4u * (unsigned)hi; asm volatile("" : "+v"(hi4));
                IDX_FAST_ELEMS(sc0, 2 * tp)
                IDX_FAST_ELEMS(sc1, 2 * tp + 1)
#undef IDX_FAST_ELEMS
            }
        }
        __syncthreads();
        {
            const int q = tid >> 4, l16 = tid & 15; unsigned above = 0u;
            for (int t = l16; t < ntile; t += 16) above += (unsigned)__builtin_popcount(img[t * 32 + q]);
            above = row16_sum(above);
            const unsigned n = st[96 + q];
            if (l16 == 0) { if (above >= 256u || 256u - above > n || n > (unsigned)FAST_CAP) st[130] = 1u; st[32 + q] = 256u - above; }
        }
        __syncthreads();
        slow = st[130] != 0u;
#ifdef REP_SEL
        for (int rep3 = 0; rep3 < 2; ++rep3)
#endif
        if (!slow) {
            const int q = tid >> 4, l16 = tid & 15; const unsigned n = st[96 + q], need = st[32 + q];
            unsigned c[FAST_CAP / 16];
#pragma unroll
            for (int i = 0; i < FAST_CAP / 16; ++i) { const unsigned ci = (unsigned)(l16 + 16 * i); c[i] = ci < n ? cand[q * FAST_CAP + ci] : 0u; }
            unsigned Pv = 0u; bool done = false;
#pragma nounroll
            for (int bit = 31; bit >= 0; --bit) { const unsigned trial = Pv | (1u << bit); unsigned cnt = 0u;
#pragma unroll
                for (int i = 0; i < FAST_CAP / 16; ++i) cnt += (c[i] >= trial) ? 1u : 0u;
                cnt = row16_sum(cnt);
                if (!done && cnt >= need) { Pv = trial; done = (cnt == need); }
                if (__all(done)) break; }
#pragma unroll
            for (int i = 0; i < FAST_CAP / 16; ++i) if ((unsigned)(l16 + 16 * i) < n && c[i] >= Pv) { const unsigned kidx = 8191u - (c[i] & 8191u);
                __hip_atomic_fetch_or(&img[(kidx >> 5) * 32 + q], 1u << (kidx & 31), __ATOMIC_RELAXED, __HIP_MEMORY_SCOPE_WORKGROUP); }
        } else if (tid < 32) { st[32 + tid] = 256u; st[96 + tid] = 0u; }
        __syncthreads();
    }
#ifdef DIAG_SLOW
    if (slow && tid == 0) __hip_atomic_fetch_add(P.dbg, 1u, RLX_AGENT);
#endif
    if (slow) {
    for (;;) {
        ++level;
        for (int u = tid; u < 32 * HS; u += NTHR) hist[u] = 0u;
        if (tid == 0) st[128] = 0u;
        __syncthreads();
        {
            const unsigned qa = st[r32], qlen = st[192 + r32], base1 = st[160 + r32]; const float cq = __builtin_bit_cast(float, st[224 + r32]);
            const int sh = (level > 1 && qlen > 512u) ? (32 - __builtin_clz(qlen - 1u)) - 9 : 0;
            LAS unsigned* hrow = hist + r32 * HS;
            bf16x8 kn[2][4]; if (wave < npair) { IDX_KLOAD2(wave) }
            for (int tp = wave; tp < npair; tp += NWAVES) {
                IDX_SCORES2(tp)
                if (level == 1) {
#pragma unroll
                    for (int i = 0; i < 16; ++i) { const unsigned k0 = mono_key(sc0[i] + cq), k1 = mono_key(sc1[i] + cq);
                        const unsigned b0 = min((max(k0, base1) - base1) >> 17, 511u), b1 = min((max(k1, base1) - base1) >> 17, 511u);
                        __hip_atomic_fetch_add(&hrow[b0], 1u, __ATOMIC_RELAXED, __HIP_MEMORY_SCOPE_WORKGROUP); __hip_atomic_fetch_add(&hrow[b1], 1u, __ATOMIC_RELAXED, __HIP_MEMORY_SCOPE_WORKGROUP); }
                } else {
#pragma unroll
                    for (int i = 0; i < 16; ++i) { const unsigned o0 = mono_key(sc0[i] + cq) - qa, o1 = mono_key(sc1[i] + cq) - qa;
                        if (o0 < qlen) __hip_atomic_fetch_add(&hrow[o0 >> sh], 1u, __ATOMIC_RELAXED, __HIP_MEMORY_SCOPE_WORKGROUP);
                        if (o1 < qlen) __hip_atomic_fetch_add(&hrow[o1 >> sh], 1u, __ATOMIC_RELAXED, __HIP_MEMORY_SCOPE_WORKGROUP); }
                }
            }
        }
        __syncthreads();
        {
            const int q = tid >> 4, seg = tid & 15;
            unsigned segsum = 0u;
            for (int wi = 0; wi < 32; ++wi) segsum += hist[q * HS + seg * 32 + wi];
            unsigned S = segsum;
            S = row16_suffix(S);
            const unsigned above = S - segsum, need = st[32 + q];
            if (above < need && need <= above + segsum) {
                unsigned cum = above, fbin = 0u, fneed = 1u, fcnt = 0u; bool found = false;
                for (int wi = 31; wi >= 0; --wi) { const unsigned c = hist[q * HS + seg * 32 + wi];
                    if (!found && cum + c >= need) { found = true; fbin = (unsigned)wi; fneed = need - cum; fcnt = c; } if (!found) cum += c; }
                fbin += 32u * (unsigned)seg;
                unsigned na, nlen;
                if (level == 1) { const unsigned base1 = st[160 + q];
                    if (fbin == 0u) { na = 0u; nlen = base1 + 131072u; } else if (fbin == 511u) { na = base1 + 511u * 131072u; nlen = 0u - na; } else { na = base1 + fbin * 131072u; nlen = 131072u; } }
                else { const unsigned qa = st[q], qlen = st[192 + q]; const int sh = qlen > 512u ? (32 - __builtin_clz(qlen - 1u)) - 9 : 0;
                    na = qa + (fbin << sh); nlen = min(1u << sh, qlen - (fbin << sh)); }
                st[q] = na; st[192 + q] = nlen; st[32 + q] = fneed; st[64 + q] = fcnt;
                if (fcnt > (unsigned)CAND_CAP && nlen > 1u) st[128] = 1u;
            }
        }
        __syncthreads();
#ifndef MAXLVL
#define MAXLVL 8
#endif
        const bool more = (st[128] != 0u) && (level < MAXLVL);
        __syncthreads();
        if (!more) break;
    }
    {
        const unsigned qa = st[r32], qlen = st[192 + r32]; const float cq = __builtin_bit_cast(float, st[224 + r32]);
        const unsigned Hk = qa + qlen - 1u;
        unsigned hb = (Hk & 0x80000000u) ? (Hk ^ 0x80000000u) : ~Hk;
        if (hb == 0x80000000u) hb = 0x80000001u;
        const float fH = __builtin_bit_cast(float, hb);
        const unsigned ab_ = (qa & 0x80000000u) ? (qa ^ 0x80000000u) : ~qa;
        const float fA = (qa < 0x00800000u) ? -__builtin_inff() : __builtin_bit_cast(float, ab_);
        bf16x8 kn[2][4]; if (wave < npair) { IDX_KLOAD2(wave) }
        for (int tp = wave; tp < npair; tp += NWAVES) {
            IDX_SCORES2(tp)
#define IDX_COLLECT_ELEMS(SC, T) { unsigned v = 0u; _Pragma("unroll") for (int i = 15; i >= 0; --i) { const float ts = SC[i] + cq; const bool ab = ts > fH; v = v + v + (ab ? 1u : 0u); \
                if (!ab && ts >= fA) { const unsigned key = mono_key(ts); \
                    const unsigned pos = __hip_atomic_fetch_add(&st[96 + r32], 1u, __ATOMIC_RELAXED, __HIP_MEMORY_SCOPE_WORKGROUP); \
                    if (pos < (unsigned)CAND_CAP) { cand[(r32 * CAND_CAP + pos) * 2] = key; cand[(r32 * CAND_CAP + pos) * 2 + 1] = (unsigned)(32 * (T) + crow(i, hi)); } } } \
            unsigned bits = (v & 0xfu) | ((v & 0xf0u) << 4) | ((v & 0xf00u) << 8) | ((v & 0xf000u) << 12);     \
            bits <<= 4 * hi; bits = half_or(bits); if (hi == 0) img[(T) * 32 + r32] = bits; }
            IDX_COLLECT_ELEMS(sc0, 2 * tp)
            IDX_COLLECT_ELEMS(sc1, 2 * tp + 1)
#undef IDX_COLLECT_ELEMS
        }
    }
#undef IDX_SCORES2
#undef IDX_KLOAD2
    __syncthreads();
    {
        const int q = tid >> 4; const unsigned n = min(st[96 + q], (unsigned)CAND_CAP), need = st[32 + q];
        for (unsigned c = tid & 15; c < n; c += 16) { const unsigned key = cand[(q * CAND_CAP + c) * 2], idx = cand[(q * CAND_CAP + c) * 2 + 1]; unsigned rank = 0u;
            for (unsigned o = 0; o < n; ++o) { const unsigned k2 = cand[(q * CAND_CAP + o) * 2], i2 = cand[(q * CAND_CAP + o) * 2 + 1]; rank += (k2 > key || (k2 == key && i2 < idx)) ? 1u : 0u; }
            if (rank < need) __hip_atomic_fetch_or(&img[(idx >> 5) * 32 + q], 1u << (idx & 31), __ATOMIC_RELAXED, __HIP_MEMORY_SCOPE_WORKGROUP); }
    }
    }
    __syncthreads();
    for (int idx = tid; idx < ntile * 32; idx += NTHR) P.BM[((size_t)b * 256 + (idx >> 5)) * SEQ + q0 + (idx & 31)] = img[idx];
    __syncthreads();
}

__device__ __forceinline__ int wq_next(Frame& F, int cw) {
    __syncthreads();
    if (F_TID == 0) F.MISC[0] = __hip_atomic_fetch_add((unsigned*)(F.ctl + cw), 1u, RLX_AGENT);
    __syncthreads();
    return (int)F.MISC[0];
}

__device__ __forceinline__ void p5a_route(Frame& F, const Args& A) {
    const int lane = F_LANE, tid = F_TID, wave = F_WAVE;
    const float* x1 = A.out; const float* g2 = A.in[11];
    const float* wrg = A.in[12]; const float* brg = A.in[13]; const float* wre = A.in[14]; const float* bre = A.in[15];
    int* toke = (int*)(F.ws + WS_TOKE); float* tokw = (float*)(F.ws + WS_TOKW); float* rstd2 = (float*)(F.ws + WS_RSTD2);
    int* sslot = (int*)(F.ws + WS_SSLOT);
    constexpr int WST = 44, WCH = 256 * WST * 4;
    LAS float* wl = (LAS float*)F.lds;
    LAS unsigned* lcnt = (LAS unsigned*)(F.lds + 2 * WCH);
    LAS float* lgs = (LAS float*)(F.lds + 2 * WCH + 256);
    for (int i = F.vcu * NTHR + tid; i < SORT_ROWS; i += F.G * NTHR) sslot[i] = -1;
    if (tid < NEXP) lcnt[tid] = 0u;
    const int i16 = lane & 15, kq = lane >> 4, tile = wave & 3, half = wave >> 2;
    const int per = T / F.G;
    for (int t0 = F.vcu * per; t0 < (F.vcu + 1) * per; t0 += 64) {
        const float* xr = x1 + (size_t)(t0 + 16 * tile + i16) * D + 4 * kq;
        f32x4 acc0 = (f32x4){0.f, 0.f, 0.f, 0.f}, acc1 = acc0; float ss = 0.f;
        f32x4 se[4], sg; float gk[5];
#define RT_LOAD(c) do { _Pragma("unroll") for (int q = 0; q < 4; ++q) { const int f = tid + 512 * q, k = f >> 3; se[q] = *(const GAS f32x4*)(wre + (size_t)(256 * (c) + k) * 32 + 4 * (f & 7)); gk[q] = g2[256 * (c) + k]; } \
            { const int k = tid >> 1; sg = *(const GAS f32x4*)(wrg + (size_t)(256 * (c) + k) * 8 + 4 * (tid & 1)); gk[4] = g2[256 * (c) + k]; } } while (0)
#define RT_WRITE(bf) do { LAS float* wb = wl + (bf) * (WCH / 4); _Pragma("unroll") for (int q = 0; q < 4; ++q) { const int f = tid + 512 * q, k = f >> 3; *(LAS f32x4*)(wb + k * WST + 4 * (f & 7)) = se[q] * gk[q]; } \
            { const int k = tid >> 1; *(LAS f32x4*)(wb + k * WST + 32 + 4 * (tid & 1)) = sg * gk[4]; } } while (0)
        f32x4 xa[16];
#pragma unroll
        for (int s = 0; s < 16; ++s) xa[s] = *(const GAS f32x4*)(xr + 16 * s);
        RT_LOAD(0); RT_WRITE(0); __syncthreads();
#pragma unroll
        for (int c = 0; c < 4; ++c) {
            if (c + 1 < 4) RT_LOAD(c + 1);
            const LAS float* wb = wl + (c & 1) * (WCH / 4) + 4 * kq * WST + i16 + 16 * half;
#pragma unroll
            for (int s = 0; s < 16; ++s) {
                const f32x4 a4 = xa[s];
                if (half == 0) ss += (a4.x * a4.x + a4.y * a4.y) + (a4.z * a4.z + a4.w * a4.w);
#pragma unroll
                for (int cc = 0; cc < 4; ++cc) { const LAS float* wp = wb + (16 * s + cc) * WST;
                    acc0 = __builtin_amdgcn_mfma_f32_16x16x4f32(a4[cc], wp[0], acc0, 0, 0, 0);
                    if (half == 0) acc1 = __builtin_amdgcn_mfma_f32_16x16x4f32(a4[cc], wp[32 - (i16 & 8)], acc1, 0, 0, 0); }
            }
            if (c + 1 < 4) {
#pragma unroll
                for (int s = 0; s < 16; ++s) xa[s] = *(const GAS f32x4*)(xr + 256 * (c + 1) + 16 * s);
                RT_WRITE((c + 1) & 1); }
            __syncthreads();
        }
#undef RT_LOAD
#undef RT_WRITE
        LAS float* lt = lgs + tile * 640;
#pragma unroll
        for (int r = 0; r < 4; ++r) { const int tk = 4 * kq + r; lt[tk * 40 + 8 + 16 * half + i16] = acc0[r]; if (half == 0 && i16 < 8) lt[tk * 40 + i16] = acc1[r]; }
        if (half == 0) { ss += __shfl_xor(ss, 16); ss += __shfl_xor(ss, 32); if (kq == 0) lgs[2560 + 16 * tile + i16] = 1.f / sqrtf(ss * (1.f / D) + EPS); }
        __syncthreads();
        if (half == 0 && lane < 16) {
            const int m = t0 + 16 * tile + lane; const float rstd = lgs[2560 + 16 * tile + lane]; const LAS float* lg = lt + lane * 40;
            float gl[8];
#pragma unroll
            for (int k = 0; k < 8; ++k) gl[k] = lg[k] * rstd + brg[k];
            int gs = 0; float gm = gl[0];
#pragma unroll
            for (int k = 1; k < 8; ++k) if (gl[k] > gm) { gm = gl[k]; gs = k; }
            float den = 0.f;
#pragma unroll
            for (int k = 0; k < 8; ++k) den += __expf(gl[k] - gm);
            const float wgrp = 1.f / den;
            float el[4];
#pragma unroll
            for (int cc = 0; cc < 4; ++cc) el[cc] = lg[8 + 4 * gs + cc] * rstd + bre[4 * gs + cc];
            int i1 = 0; float v1 = el[0];
#pragma unroll
            for (int cc = 1; cc < 4; ++cc) if (el[cc] > v1) { v1 = el[cc]; i1 = cc; }
            int i2 = -1; float v2 = 0.f;
#pragma unroll
            for (int cc = 0; cc < 4; ++cc) if (cc != i1 && (i2 < 0 || el[cc] > v2)) { v2 = el[cc]; i2 = cc; }
            const float e2 = __expf(v2 - v1), w1 = 1.f / (1.f + e2), w2 = e2 / (1.f + e2);
            toke[2 * m] = gs * 4 + i1; toke[2 * m + 1] = gs * 4 + i2; tokw[2 * m] = w1 * wgrp; tokw[2 * m + 1] = w2 * wgrp; rstd2[m] = rstd;
            __hip_atomic_fetch_add(&lcnt[gs * 4 + i1], 1u, __ATOMIC_RELAXED, __HIP_MEMORY_SCOPE_WORKGROUP);
            __hip_atomic_fetch_add(&lcnt[gs * 4 + i2], 1u, __ATOMIC_RELAXED, __HIP_MEMORY_SCOPE_WORKGROUP);
        }
        __syncthreads();
    }
    if (tid < NEXP && lcnt[tid]) __hip_atomic_fetch_add((unsigned*)(F.ctl + CW_CNT + tid), lcnt[tid], RLX_AGENT);
}

__device__ __forceinline__ void p5a2_scatter(Frame& F, const Args& A) {
    const int lane = F_LANE, tid = F_TID;
    const float* x1 = A.out; const float* g2 = A.in[11];
    const int* toke = (const int*)(F.ws + WS_TOKE); const float* tokw = (const float*)(F.ws + WS_TOKW); const float* rstd2 = (const float*)(F.ws + WS_RSTD2);
    int* sslot = (int*)(F.ws + WS_SSLOT); float* sw = (float*)(F.ws + WS_SW); int* t2e = (int*)(F.ws + WS_T2E);
    bf16* AS = (bf16*)(F.ws + WS_ASORT);
    LAS unsigned* sh = (LAS unsigned*)F.lds;
    if (tid < NEXP) sh[256 + tid] = __hip_atomic_load((unsigned*)(F.ctl + CW_CNT + tid), RLX_AGENT);
    __syncthreads();
    if (tid == 0) { unsigned acc = 0u;
        for (int e = 0; e < NEXP; ++e) { const unsigned c = sh[256 + e]; sh[e] = acc; const unsigned nt = (c + 255u) / 256u;
            if (blockIdx.x == 0) for (unsigned i = 0; i < nt; ++i) t2e[acc / 256u + i] = e;
            acc += nt * 256u; }
        if (blockIdx.x == 0) t2e[255] = (int)(acc / 256u); }
    const int per = T / F.G;
    for (int t0 = F.vcu * per; t0 < (F.vcu + 1) * per; t0 += 64) {
        if (tid < NEXP) sh[32 + tid] = 0u;
        __syncthreads();
        int e = 0; unsigned lpos = 0u;
        if (tid < 128) { e = toke[2 * t0 + tid]; lpos = __hip_atomic_fetch_add(&sh[32 + e], 1u, __ATOMIC_RELAXED, __HIP_MEMORY_SCOPE_WORKGROUP); }
        __syncthreads();
        if (tid < NEXP) sh[64 + tid] = sh[tid] + (sh[32 + tid] ? __hip_atomic_fetch_add((unsigned*)(F.ctl + CW_FILL + tid), sh[32 + tid], RLX_AGENT) : 0u);
        __syncthreads();
        if (tid < 128) { const unsigned pos = sh[64 + e] + lpos; sh[96 + tid] = pos; sslot[pos] = 2 * t0 + tid; sw[pos] = tokw[2 * t0 + tid]; }
        __syncthreads();
        for (int tk0 = F_WAVE; tk0 < 64; tk0 += 4 * NWAVES) {
            f32x4 xv[4][4];
#pragma unroll
            for (int r = 0; r < 4; ++r) { const GAS f32x4* xr = (const GAS f32x4*)(x1 + (size_t)(t0 + tk0 + r * NWAVES) * D) + lane;
#pragma unroll
                for (int j = 0; j < 4; ++j) xv[r][j] = xr[64 * j]; }
#pragma unroll
            for (int r = 0; r < 4; ++r) { const int tk = tk0 + r * NWAVES, m = t0 + tk; const float rstd = rstd2[m];
                const unsigned p0 = sh[96 + 2 * tk], p1 = sh[96 + 2 * tk + 1];
#pragma unroll
                for (int j = 0; j < 4; ++j) { const f32x4 g = *((const GAS f32x4*)g2 + lane + 64 * j); const f32x4 y = xv[r][j] * rstd * g; v2u w; w.x = pk2(y.x, y.y); w.y = pk2(y.z, y.w);
                    *((GAS v2u*)(AS + (size_t)p0 * D) + lane + 64 * j) = w; *((GAS v2u*)(AS + (size_t)p1 * D) + lane + 64 * j) = w; } } }
        __syncthreads();
    }
}

__device__ __forceinline__ void p6_final(Frame& F, const Args& A) {
    const int gw = F.vcu * NWAVES + F_WAVE, NGW = F.G * NWAVES, lane = F_LANE;
    const float* gf = A.in[19]; float* out = A.out; const bf16* SL = (const bf16*)(F.ws + WS_SLOTS);
    for (int m0 = gw; m0 < T; m0 += 2 * NGW) {
        f32x4 v[2][4]; v2u a[2][4], c[2][4];
#pragma unroll
        for (int r = 0; r < 2; ++r) { const int m = min(m0 + r * NGW, T - 1); const GAS f32x4* xr = (const GAS f32x4*)(out + (size_t)m * D) + lane;
            const GAS v2u* s0 = (const GAS v2u*)(SL + (size_t)(2 * m) * D) + lane; const GAS v2u* s1 = (const GAS v2u*)(SL + (size_t)(2 * m + 1) * D) + lane;
#pragma unroll
            for (int j = 0; j < 4; ++j) { v[r][j] = xr[64 * j]; a[r][j] = s0[64 * j]; c[r][j] = s1[64 * j]; } }
#pragma unroll
        for (int r = 0; r < 2; ++r) { const int m = m0 + r * NGW; float s = 0.f;
#pragma unroll
            for (int j = 0; j < 4; ++j) { f32x4& w = v[r][j];
                w.x += bflo(a[r][j].x) + bflo(c[r][j].x); w.y += bfhi(a[r][j].x) + bfhi(c[r][j].x); w.z += bflo(a[r][j].y) + bflo(c[r][j].y); w.w += bfhi(a[r][j].y) + bfhi(c[r][j].y);
                s += (w.x * w.x + w.y * w.y) + (w.z * w.z + w.w * w.w); }
            const float rstd = 1.f / sqrtf(wave_sum(s) * (1.f / D) + EPS);
            if (m < T) { GAS f32x4* xo = (GAS f32x4*)(out + (size_t)m * D) + lane;
#pragma unroll
                for (int j = 0; j < 4; ++j) { const f32x4 g = *((const GAS f32x4*)gf + lane + 64 * j); xo[64 * j] = v[r][j] * rstd * g; } } }
    }
}

constexpr int NPHASE = 13;
__global__ void __launch_bounds__(NTHR, 2) mk_fwd(Args args) {
    extern __shared__ __attribute__((aligned(16))) unsigned char lds[];
    Frame F;
    F.lds = (LAS unsigned char*)lds; F.MISC = (volatile LAS unsigned*)(F.lds + MISC_OFF);
        F.G = gridDim.x; { const int bx = blockIdx.x; F.vcu = (F.G % 8 == 0) ? (bx % 8) * (F.G / 8) + bx / 8 : bx; }
    F.ws = args.ws; F.ctl = (gu32*)(args.ws + WS_CTL);
    unsigned char* ws = args.ws;
    if (F_TID < 128) F.MISC[F_TID] = 0u;
    __syncthreads();
    const bool single = (args.ph_hi - args.ph_lo) > 1;
    XcdBarrier bar; bar.bar = (unsigned*)(F.ctl + CW_BAR); bar.x = 0; bar.st = nullptr;
    if (single) bar = xcd_barrier_post((unsigned*)(F.ctl + CW_BAR), F.MISC + 8);
    const int lo = args.ph_lo, hi = args.ph_hi;
#ifdef ONLY
#define IN(k) ((k) == ONLY && lo <= (k) && (k) < hi)
#else
#define IN(k) (lo <= (k) && (k) < hi)
#endif
#ifdef TS_A
#define STAMP(k) do { if (blockIdx.x == 0 && threadIdx.x == 0) ((unsigned long long*)(ws + WS_CTL + 8192))[(k) + 1] = __builtin_amdgcn_s_memrealtime(); } while (0)
#else
#define STAMP(k) do { } while (0)
#endif
#define SEAM(k) do { if (IN((k) + 1)) xcd_barrier(bar); STAMP(k); } while (0)
    const f32x2* rope = (const f32x2*)(ws + WS_ROPE);
    bf16* GA = (bf16*)args.out; bf16* GB = (bf16*)args.out + (size_t)T * 1024;

    STAMP(-1);
    if (IN(0)) { p0_prologue(F, args);
#ifdef REP_P0
        p0_prologue(F, args);
#endif
        SEAM(0); }
    if (IN(1)) {
        pg8::Gemm g{(const bf16*)(ws + WS_H), (const bf16*)(ws + WS_WIN), T, NIN, D, 0}; pg8::StaticOrder S; S.init(T, NIN, F.G, (int)blockIdx.x);
        pg8::EpiIn E{(bf16*)(ws + WS_CQ), (bf16*)(ws + WS_CKV), (bf16*)(ws + WS_QB), (bf16*)(ws + WS_KB), (bf16*)(ws + WS_VB), (bf16*)(ws + WS_QI), (bf16*)(ws + WS_KI), (bf16*)(ws + WS_KR), GA, GB, (float*)(ws + WS_WI), rope, (float*)(ws + WS_PART)};
        pg8::gemm_phase<pg8::EpiIn, pg8::StaticOrder, true, true>(F.lds, g, S, E);
#ifdef REP_P1
        pg8::gemm_phase<pg8::EpiIn, pg8::StaticOrder, true, true>(F.lds, g, S, E);
#endif
#ifdef CONV_AT_P1
        for (;;) { const int c = wq_next(F, CW_Q2); if (c >= CV_QITEMS) break;
            int ltid = threadIdx.x; asm volatile("" : "+v"(ltid));
            const int lw = __builtin_amdgcn_readfirstlane(ltid >> 6); LAS float* scr = (LAS float*)(F.lds + lw * 16640);
            conv_tile2(args, ws, CV_EARLY + 16 * c + lw, CV_EARLY + 16 * c + 8 + lw, scr, ltid & 63); }
#endif
        SEAM(1);
    }
#ifdef P2A_OLD
    if (IN(2)) { p2a_norms(F, args); SEAM(2); }
#endif
    if (IN(3)) {
#ifdef REP_P3
      for (int rep = 0; rep < 2; ++rep) {
#else
      {
#endif
#ifndef NO3A
        { pg8::Gemm g{(const bf16*)(ws + WS_CQ), (const bf16*)(ws + WS_WUQ), T, 768, 384, 0}; pg8::StaticOrder S; S.init(T, 768, F.G, (int)blockIdx.x);
          LAS float* rsl = (LAS float*)(F.lds + 131072);
          { pg8::Unit u0; if (S.next(0, u0) && F_TID < 256) { const f32x4* pp = (const f32x4*)((const float*)(ws + WS_PART) + (size_t)(u0.pm * 256 + F_TID) * 20); const f32x4 a = pp[0], b = pp[1], c = pp[2];
              rsl[F_TID] = C2A / sqrtf(((((a[0] + a[1]) + (a[2] + a[3])) + ((b[0] + b[1]) + (b[2] + b[3]))) + ((c[0] + c[1]) + (c[2] + c[3]))) * (1.f / 384.f) + EPS); } }
          __syncthreads();
          pg8::EpiQA E{(bf16*)(ws + WS_QA), rope, rsl}; pg8::gemm_phase<pg8::EpiQA, pg8::StaticOrder, true, true>(F.lds, g, S, E); }
#endif
#ifndef NO3B
        { pg8::Gemm g{(const bf16*)(ws + WS_CKV), (const bf16*)(ws + WS_WUKV), T, 1024, 256, 0}; pg8::StaticOrder S; S.init(T, 1024, F.G, (int)blockIdx.x);
          LAS float* rsl = (LAS float*)(F.lds + 131072 + 1024);
          { pg8::Unit u0; if (S.next(0, u0) && F_TID < 256) { const f32x4* pp = (const f32x4*)((const float*)(ws + WS_PART) + (size_t)(u0.pm * 256 + F_TID) * 20 + 12); const f32x4 a = pp[0], b = pp[1];
              rsl[F_TID] = 1.f / sqrtf((((a[0] + a[1]) + (a[2] + a[3])) + ((b[0] + b[1]) + (b[2] + b[3]))) * (1.f / 256.f) + EPS); } }
          __syncthreads();
          pg8::EpiKV E{(bf16*)(ws + WS_KN), (bf16*)(ws + WS_VA), rsl}; pg8::gemm_phase<pg8::EpiKV, pg8::StaticOrder, true, true>(F.lds, g, S, E); }
#endif
      }
        SEAM(3);
    }
    if (IN(4)) {
        unsigned* rdy = (unsigned*)(F.ctl + CW_RDY);
#ifndef CONV_AT_P1
        constexpr int NCVQ = CV_QITEMS;
#else
        constexpr int NCVQ = 0;
#endif
        for (;;) { const int k = wq_next(F, CW_Q1); if (k >= 1536 + NCVQ) break;
            int ltid = threadIdx.x; asm volatile("" : "+v"(ltid));
            const int lw = __builtin_amdgcn_readfirstlane(ltid >> 6);
            if (k < 512) { const int ib = k & 1, ij = 255 - (k >> 1);
                const IdxP IP{(const bf16*)(ws + WS_QI), (const bf16*)(ws + WS_KI), (const float*)(ws + WS_WI), (unsigned*)(ws + WS_BM), (unsigned*)(F.ctl + 1024)};
                idx_item(F.lds, ib, ij, IP, ltid, ltid & 63, lw);
#ifdef REP_IDX
                __syncthreads(); idx_item(F.lds, ib, ij, IP, ltid, ltid & 63, lw);
#endif
                VM_WAIT(); __syncthreads();
                if (ltid == 0) { __builtin_amdgcn_fence(__ATOMIC_RELEASE, "agent"); VM_WAIT(); __hip_atomic_fetch_add(rdy + 64 * (ib * 32 + (ij >> 3)), 1u, RLX_AGENT); }
                continue; }
            const int j = k - 512; int a;
            if (j < 3 * NCVQ) { const int q3 = j / 3, r3 = j - 3 * q3; a = (r3 == 2) ? -1 - q3 : 2 * q3 + r3; } else a = j - NCVQ;
            if (a < 0) { const int c = -1 - a; LAS float* scr = (LAS float*)(F.lds + lw * 16640);
                conv_tile2(args, ws, CV_EARLY + 16 * c + lw, CV_EARLY + 16 * c + 8 + lw, scr, ltid & 63);
                continue; }
            { const int u = a >> 1, ub = (u & 15) >> 3, uh = u & 7, uq = 31 - (u >> 4);
                if (a & 1) { const AttnP APA{(const bf16*)(ws + WS_QA), (const bf16*)(ws + WS_KN), (const bf16*)(ws + WS_KR), (const bf16*)(ws + WS_VA), (bf16*)(ws + WS_OA), nullptr};
#ifdef MLA_OLD
                    attn_unit<true>(F.lds, ub, uh, uq, APA, ltid, ltid & 63, lw); }
#else
                    attn_body::attn_unit<8, true>(ub, uh, uq, (const attn_body::bf16*)APA.Q, (const attn_body::bf16*)APA.K, (const attn_body::bf16*)APA.K2, (const attn_body::bf16*)APA.V, (attn_body::bf16*)APA.O, nullptr, (char*)F.lds, ltid); }
#endif
                else { const AttnP APB{(const bf16*)(ws + WS_QB), (const bf16*)(ws + WS_KB), nullptr, (const bf16*)(ws + WS_VB), (bf16*)(ws + WS_OB), (const unsigned*)(ws + WS_BM)};
                    if (ltid == 0) { unsigned sp = 0u; while (__hip_atomic_load(rdy + 64 * (ub * 32 + uq), RLX_AGENT) < 8u) { __builtin_amdgcn_s_sleep(8); if (++sp > (1u << 22)) break; }
                        __builtin_amdgcn_fence(__ATOMIC_ACQUIRE, "agent"); VM_WAIT(); }
                    __syncthreads();
#ifdef DSA_OLD
                    attn_unit<false>(F.lds, ub, uh, uq, APB, ltid, ltid & 63, lw); } }
#else
                    attn_body::attn_unit<8, false>(ub, uh, uq, (const attn_body::bf16*)APB.Q, (const attn_body::bf16*)APB.K, nullptr, (const attn_body::bf16*)APB.V, (attn_body::bf16*)APB.O, APB.BM, (char*)F.lds, ltid); } }
#endif
        }
    }
    if (IN(5)) { SEAM(5); }
#ifdef Y_TWO_GEMMS
    if (IN(6)) {
#ifdef REP_P6
      for (int rep = 0; rep < 2; ++rep) {
#else
      {
#endif
        { pg8::Gemm g{(const bf16*)(ws + WS_OA), (const bf16*)(ws + WS_WOA), T, 1024, 512, 0}; pg8::StaticOrder S; S.init(T, 1024, F.G, (int)blockIdx.x);
          pg8::EpiY<0> E{(bf16*)(ws + WS_Y), GA}; pg8::gemm_phase<pg8::EpiY<0>, pg8::StaticOrder, true, true>(F.lds, g, S, E); }
        { pg8::Gemm g{(const bf16*)(ws + WS_OB), (const bf16*)(ws + WS_WOB), T, 1024, 512, 0}; pg8::StaticOrder S; S.init(T, 1024, F.G, (int)blockIdx.x);
          pg8::EpiY<1> E{(bf16*)(ws + WS_Y), GB}; pg8::gemm_phase<pg8::EpiY<1>, pg8::StaticOrder, true, true>(F.lds, g, S, E); }
      }
        SEAM(6);
    }
#else
    if (IN(6)) {
        pg8::Gemm g{(const bf16*)(ws + WS_OA), (const bf16*)(ws + WS_WOA), T, 1024, 512, WS_WOB - WS_WOA, WS_OB - WS_OA};
        pg8::PairOrder S; S.S0.init(T, 1024, F.G, (int)blockIdx.x);
        pg8::EpiYC E{(bf16*)(ws + WS_Y), GA, GB}; pg8::gemm_phase<pg8::EpiYC, pg8::PairOrder, true, true>(F.lds, g, S, E);
        SEAM(6);
    }
#endif
    if (IN(7)) {
        pg8::Gemm g{(const bf16*)(ws + WS_Y), (const bf16*)(ws + WS_WOUT), T, 1024, 1024, 0}; pg8::StaticOrder S; S.init(T, 1024, F.G, (int)blockIdx.x);
        pg8::EpiX1 E{args.in[0], args.out}; pg8::gemm_phase<pg8::EpiX1, pg8::StaticOrder, true, true>(F.lds, g, S, E);
#ifdef REP_P7
        pg8::gemm_phase<pg8::EpiX1, pg8::StaticOrder, true, true>(F.lds, g, S, E);
#endif
        SEAM(7);
    }
    if (IN(8)) { p5a_route(F, args); SEAM(8); }
    if (IN(9)) { p5a2_scatter(F, args); SEAM(9); }
#ifdef MOE_TWO_PHASES
    if (IN(10)) {
        const int* t2e = (const int*)(ws + WS_T2E); const int ntl = t2e[255];
        pg8::Gemm g{(const bf16*)(ws + WS_ASORT), (const bf16*)(ws + WS_WGU), SORT_ROWS, 512, 1024, (size_t)512 * 1024 * 2}; pg8::GroupOrder S; S.init(ntl, 2, F.G, (int)blockIdx.x, t2e);
        pg8::EpiHid E{(bf16*)(ws + WS_HID)}; pg8::gemm_phase<pg8::EpiHid, pg8::GroupOrder, true, true>(F.lds, g, S, E);
#ifdef REP_P10
        pg8::gemm_phase<pg8::EpiHid, pg8::GroupOrder, true, true>(F.lds, g, S, E);
#endif
        SEAM(10);
    }
    if (IN(11)) {
        const int* t2e = (const int*)(ws + WS_T2E); const int ntl = t2e[255];
        pg8::Gemm g{(const bf16*)(ws + WS_HID), (const bf16*)(ws + WS_WD), SORT_ROWS, 1024, 256, (size_t)1024 * 256 * 2}; pg8::GroupOrder S; S.init(ntl, 4, F.G, (int)blockIdx.x, t2e);
        pg8::EpiDown E{(bf16*)(ws + WS_SLOTS), (const int*)(ws + WS_SSLOT), (const float*)(ws + WS_SW)}; pg8::gemm_phase<pg8::EpiDown, pg8::GroupOrder, true, true>(F.lds, g, S, E);
#ifdef REP_P11
        pg8::gemm_phase<pg8::EpiDown, pg8::GroupOrder, true, true>(F.lds, g, S, E);
#endif
        SEAM(11);
    }
#else
    if (IN(10)) {
        const int* t2e = (const int*)(ws + WS_T2E); const int ntl = t2e[255], n10 = 2 * ntl, n11 = 4 * ntl;
        unsigned* hrdy = (unsigned*)(F.ctl + CW_HRDY);
        const pg8::Gemm g10{(const bf16*)(ws + WS_ASORT), (const bf16*)(ws + WS_WGU), SORT_ROWS, 512, 1024, (size_t)512 * 1024 * 2};
        const pg8::Gemm g11{(const bf16*)(ws + WS_HID), (const bf16*)(ws + WS_WD), SORT_ROWS, 1024, 256, (size_t)1024 * 256 * 2};
        const pg8::EpiHid E10{(bf16*)(ws + WS_HID)}; const pg8::EpiDown E11{(bf16*)(ws + WS_SLOTS), (const int*)(ws + WS_SSLOT), (const float*)(ws + WS_SW)};
        for (;;) { const int k = wq_next(F, CW_Q3); if (k >= n10 + n11) break;
            if (k < n10) { const int pm = k >> 1; pg8::OneUnit S{pm, k & 1, __builtin_amdgcn_readfirstlane(t2e[pm])};
                pg8::gemm_phase<pg8::EpiHid, pg8::OneUnit, true, true>(F.lds, g10, S, E10);
                VM_WAIT(); __syncthreads();
                if (F_TID == 0) { __builtin_amdgcn_fence(__ATOMIC_RELEASE, "agent"); VM_WAIT(); __hip_atomic_fetch_add(hrdy + 64 * pm, 1u, RLX_AGENT); }
            } else { const int j = k - n10, pm = j >> 2; pg8::OneUnit S{pm, j & 3, __builtin_amdgcn_readfirstlane(t2e[pm])};
                if (F_TID == 0) { unsigned sp = 0u; while (__hip_atomic_load(hrdy + 64 * pm, RLX_AGENT) < 2u) { __builtin_amdgcn_s_sleep(8); if (++sp > (1u << 22)) break; }
                    __builtin_amdgcn_fence(__ATOMIC_ACQUIRE, "agent"); VM_WAIT(); }
                __syncthreads();
                pg8::gemm_phase<pg8::EpiDown, pg8::OneUnit, true, true>(F.lds, g11, S, E11);
            }
        }
    }
    if (IN(11)) { SEAM(11); }
#endif
    if (IN(12)) { p6_final(F, args); }
#ifdef DIAG_SLOW
    if (blockIdx.x == 0 && threadIdx.x == 0) { const unsigned long long t0 = __builtin_amdgcn_s_memrealtime(), wait = 100ull * __hip_atomic_load((unsigned*)(F.ctl + 1024), RLX_AGENT);
        while (__builtin_amdgcn_s_memrealtime() - t0 < wait) __builtin_amdgcn_s_sleep(16); }
#endif
#ifdef TS_A
    if (blockIdx.x == 0 && threadIdx.x == 0) { STAMP(12); __builtin_amdgcn_s_waitcnt(0);
        const unsigned long long* tsp = (const unsigned long long*)(ws + WS_CTL + 8192);
        const unsigned long long ta = __hip_atomic_load(tsp + (TS_A) + 1, RLX_AGENT), tb = __hip_atomic_load(tsp + (TS_B) + 1, RLX_AGENT);
        const unsigned long long t0 = __builtin_amdgcn_s_memrealtime(), wait = 4ull * (tb - ta);
        while (__builtin_amdgcn_s_memrealtime() - t0 < wait) __builtin_amdgcn_s_sleep(16); }
#endif
#undef IN
#undef SEAM
}

#ifndef MK_MULTI
#define MK_MULTI 0
#endif
extern "C" void kernel_launch(void* const* d_in, const int* in_sizes, int n_in, void* d_out, int out_size, void* d_ws, size_t ws_size, hipStream_t stream) {
    static int grid = 0;
    if (grid == 0) {
        if (n_in != 20 || in_sizes[0] != T * D || out_size != T * D || ws_size < WS_END) { fprintf(stderr, "kernel_launch: unexpected shapes n_in %d in0 %d out %d ws %zu\n", n_in, n_in > 0 ? in_sizes[0] : -1, out_size, ws_size); grid = -1; return; }
        int dev = 0, cus = 0;
        if (hipGetDevice(&dev) != hipSuccess || hipDeviceGetAttribute(&cus, hipDeviceAttributeMultiprocessorCount, dev) != hipSuccess) { grid = -1; return; }
        if (hipFuncSetAttribute((const void*)mk_fwd, hipFuncAttributeMaxDynamicSharedMemorySize, LDS_BYTES) != hipSuccess) { fprintf(stderr, "kernel_launch: hipFuncSetAttribute failed\n"); grid = -1; return; }
        (void)hipGetLastError();
        grid = cus;
    }
    if (grid < 0) return;
    if (hipMemsetAsync((char*)d_ws + WS_CTL, 0, CTL_ZERO_BYTES, stream) != hipSuccess) return;
    Args a{};
    for (int i = 0; i < 20; ++i) a.in[i] = (const float*)d_in[i];
    a.out = (float*)d_out; a.ws = (unsigned char*)d_ws;
#if MK_MULTI
    for (int p = 0; p < NPHASE; ++p) { a.ph_lo = p; a.ph_hi = p + 1; hipLaunchKernelGGL(mk_fwd, dim3(grid), dim3(NTHR), LDS_BYTES, stream, a); }
#else
    a.ph_lo = 0; a.ph_hi = NPHASE;
    hipLaunchKernelGGL(mk_fwd, dim3(grid), dim3(NTHR), LDS_BYTES, stream, a);
#endif
}
```

```cpp
#include <hip/hip_runtime.h>
#include <hip/hip_bf16.h>
#include <cstdio>
#include <cstdint>

#define GAS __attribute__((address_space(1)))
#define LAS __attribute__((address_space(3)))
typedef unsigned short bf16;
typedef unsigned v4u __attribute__((ext_vector_type(4)));
typedef unsigned v2u __attribute__((ext_vector_type(2)));
typedef float f32x4 __attribute__((ext_vector_type(4)));
typedef float f32x2 __attribute__((ext_vector_type(2)));
typedef float f32x16 __attribute__((ext_vector_type(16)));
typedef short bf16x8 __attribute__((ext_vector_type(8)));
typedef short s16x4 __attribute__((ext_vector_type(4)));
typedef __bf16 bf16x2_t __attribute__((ext_vector_type(2)));
typedef GAS unsigned gu32;
#define RLX_AGENT __ATOMIC_RELAXED, __HIP_MEMORY_SCOPE_AGENT
#define LDS_WAIT() asm volatile("s_waitcnt lgkmcnt(0)" ::: "memory")
#define VM_WAIT() asm volatile("s_waitcnt vmcnt(0)" ::: "memory")

constexpr int NWAVES = 8, NTHR = NWAVES * 64;
constexpr int BATCH = 2, SEQ = 8192, D = 1024, T = BATCH * SEQ;
constexpr float EPS = 1e-6f;
constexpr int NIN = 4864, NIN_SRC = 4840;
constexpr int C_CQ = 0, C_CKV = 384, C_QB = 640, C_KB = 1152, C_VB = 1664, C_QI = 2176, C_KR = 2688, C_KI = 2720, C_WI = 2784, C_GA = 2816, C_GB = 3840;
constexpr int NEXP = 32, FF = 256;
constexpr int SORT_ROWS = 2 * T + NEXP * 256;
constexpr float LOG2E = 1.4426950408889634f;
constexpr float C2A = 0.10206207261596575f * LOG2E;
constexpr float C2B = 0.125f * LOG2E;
constexpr float WI_SCALE = 0.35355339059327373f * 0.125f;

constexpr size_t MiB = 1u << 20, KiB = 1u << 10;
constexpr size_t WS_CTL = 0, CTL_ZERO_BYTES = 128 * KiB;
constexpr size_t WS_ROPE = 1 * MiB;
constexpr size_t WS_WI = 2 * MiB;
constexpr size_t WS_TOKE = 2 * MiB + 512 * KiB;
constexpr size_t WS_TOKW = WS_TOKE + 128 * KiB;
constexpr size_t WS_RSTD2 = WS_TOKW + 128 * KiB;
constexpr size_t WS_SSLOT = 3 * MiB + 512 * KiB;
constexpr size_t WS_SW = WS_SSLOT + 192 * KiB;
constexpr size_t WS_T2E = WS_SW + 192 * KiB;
constexpr size_t WS_WIN = 4 * MiB, WS_WUQ = 14 * MiB, WS_WUKV = 15 * MiB, WS_WOA = 16 * MiB, WS_WOB = 17 * MiB, WS_WOUT = 18 * MiB, WS_WGU = 20 * MiB, WS_WD = 52 * MiB;
constexpr size_t WS_H = 68 * MiB, WS_OA = 68 * MiB, WS_OB = 84 * MiB;
constexpr size_t WS_QA = 100 * MiB, WS_KN = 124 * MiB, WS_VA = 140 * MiB, WS_Y = 100 * MiB;
constexpr size_t WS_QB = 156 * MiB, WS_KB = 172 * MiB, WS_VB = 188 * MiB;
constexpr size_t WS_CQ = 204 * MiB, WS_CKV = 216 * MiB, WS_BM = 204 * MiB;
constexpr size_t WS_QI = 224 * MiB, WS_KI = 240 * MiB, WS_KR = 242 * MiB;
constexpr size_t WS_ASORT = 68 * MiB, WS_SLOTS = 156 * MiB, WS_HID = 220 * MiB;
constexpr size_t WS_PART = 244 * MiB;
constexpr size_t WS_END = 256 * MiB;
constexpr int CW_BAR = 4096;
constexpr int CW_Q1 = 64, CW_Q2 = 128;
constexpr int CW_CNT = 256, CW_FILL = 320;
constexpr int CW_Q3 = 192, CW_HRDY = 16384;
constexpr int CW_RDY = 8192;

constexpr int LDS_BYTES = 147456;
constexpr int MISC_OFF = 147456 - 512;

__device__ __forceinline__ unsigned f2bf(float f) { unsigned u = __builtin_bit_cast(unsigned, f); return (u + 0x7fffu + ((u >> 16) & 1u)) >> 16; }
__device__ __forceinline__ unsigned pk2(float lo, float hi) { f32x2 v = {lo, hi}; bf16x2_t b = __builtin_convertvector(v, bf16x2_t); return __builtin_bit_cast(unsigned, b); }
__device__ __forceinline__ float bflo(unsigned w) { return __builtin_bit_cast(float, w << 16); }
__device__ __forceinline__ float bfhi(unsigned w) { return __builtin_bit_cast(float, w & 0xffff0000u); }

#define XB_TMO      128
#define XB_XCNT(j)  (256  + 64 * (j))
#define XB_XSUB(j)  (1280 + 64 * (j))
#define XB_XGEN(j)  (2304 + 64 * (j))
#define XB_TOP      3328
#define XB_TOPGEN   3392
#define XCD_BAR_WORDS 3456
#define XB_SPIN_CAP (1u << 22)
__device__ __forceinline__ unsigned xb_ld(unsigned* p)              { return __hip_atomic_load(p, __ATOMIC_RELAXED, __HIP_MEMORY_SCOPE_AGENT); }
__device__ __forceinline__ unsigned xb_add(unsigned* p, unsigned v) { return __hip_atomic_fetch_add(p, v, __ATOMIC_RELAXED, __HIP_MEMORY_SCOPE_AGENT); }
__device__ __forceinline__ unsigned xb_xcc_id() { return (unsigned)__builtin_amdgcn_s_getreg((3 << 11) | 20) & 0xFu; }
#define XB_SPIN(cond, bar) do { unsigned _sp = 0; while (cond) { __builtin_amdgcn_s_sleep(1); \
    if ((++_sp & 255u) == 0u) { if (xb_ld(&(bar)[XB_TMO])) break; if (_sp > XB_SPIN_CAP) { atomicAdd(&(bar)[XB_TMO], 1u); break; } } } } while (0)
struct XcdBarrier { unsigned* bar; unsigned x; volatile LAS unsigned* st; };
__device__ __forceinline__ XcdBarrier xcd_barrier_post(unsigned* bar, volatile LAS unsigned* st) {
    XcdBarrier b; b.bar = bar; b.x = xb_xcc_id(); b.st = st;
    if (threadIdx.x == 0) (void)xb_add(&bar[XB_XCNT(b.x)], 1u);
    return b;
}
__device__ __forceinline__ void xcd_barrier_complete(unsigned* bar, unsigned x, unsigned& nloc, unsigned& nx) {
    const unsigned G = gridDim.x * gridDim.y * gridDim.z;
    unsigned sum, cnt, mine, sp = 0u;
    for (;;) {
        sum = 0u; cnt = 0u; mine = 0u;
#pragma unroll
        for (unsigned j = 0; j < 16; ++j) { const unsigned c = xb_ld(&bar[XB_XCNT(j)]); sum += c; cnt += (c > 0u) ? 1u : 0u; mine = (j == x) ? c : mine; }
        if (sum == G) break;
        __builtin_amdgcn_s_sleep(1);
        if ((++sp & 255u) == 0u) { if (xb_ld(&bar[XB_TMO])) break; if (sp > XB_SPIN_CAP) { atomicAdd(&bar[XB_TMO], 1u); break; } }
    }
    nloc = mine > 0u ? mine : 1u; nx = cnt > 0u ? cnt : 1u;
}
__device__ __forceinline__ void xcd_barrier(const XcdBarrier& b) {
    asm volatile("s_waitcnt vmcnt(0)" ::: "memory");
    __syncthreads();
    if (threadIdx.x == 0) {
        unsigned* bar = b.bar;
        __builtin_amdgcn_s_waitcnt(0);
        unsigned nloc = b.st[0], nx = b.st[1];
        if (nloc == 0u) { xcd_barrier_complete(bar, b.x, nloc, nx); b.st[0] = nloc; b.st[1] = nx; }
        const unsigned old = xb_add(&bar[XB_XSUB(b.x)], 1u);
        const unsigned gen = old / nloc;
        if (old + 1u == (gen + 1u) * nloc) {
            __builtin_amdgcn_fence(__ATOMIC_RELEASE, "agent");
            asm volatile("s_waitcnt vmcnt(0)" ::: "memory");
            const unsigned og = xb_add(&bar[XB_TOP], 1u);
            const unsigned tg = og / nx;
            if (og + 1u == (tg + 1u) * nx) xb_add(&bar[XB_TOPGEN], 1u);
            else XB_SPIN(xb_ld(&bar[XB_TOPGEN]) == tg, bar);
            __builtin_amdgcn_fence(__ATOMIC_ACQUIRE, "agent");
            xb_add(&bar[XB_XGEN(b.x)], 1u);
            asm volatile("s_waitcnt vmcnt(0)" ::: "memory");
        } else {
            XB_SPIN(xb_ld(&bar[XB_XGEN(b.x)]) == gen, bar);
            __builtin_amdgcn_fence(__ATOMIC_ACQUIRE, "agent");
            asm volatile("s_waitcnt vmcnt(0)" ::: "memory");
        }
    }
    __syncthreads();
}

__device__ __forceinline__ float wave_sum(float v) {
#pragma unroll
    for (int o = 1; o < 64; o <<= 1) v += __shfl_xor(v, o);
    return v;
}

namespace pg8 {
#define PG8_LAS __attribute__((address_space(3)))
typedef unsigned short bf16_t;
typedef unsigned u32x4 __attribute__((ext_vector_type(4)));
constexpr int BM = 256, BK = 64, HALF = 128, HTB = HALF * BK * 2, STAGE_BYTES = 8 * HTB, NXCD = 8, WGM = 8;
__host__ __device__ __forceinline__ int lds_byte(int r, int c) { const int st = (r >> 4) * 2 + (c >> 5), rr = r & 15, cc = c & 31, ob = rr * 64 + cc * 2; return st * 1024 + (ob ^ (((ob >> 9) & 1) << 5)); }
__host__ __device__ __forceinline__ void stage_rc(int b, int& R, int& C) { const int st = b / 1024, sb = b % 1024, swz = sb ^ (((sb >> 9) & 1) << 5); R = (st >> 1) * 16 + swz / 64; C = (st & 1) * 32 + (swz % 64) / 2; }
__host__ __device__ __forceinline__ int perm32(int rho) { const int n = rho >> 4, i = rho & 15; return 8 * (i >> 2) + 4 * n + (i & 3); }

struct Unit { int pm, pn, e; };
struct Gemm { const bf16_t* A; const bf16_t* Bt; int M, N, K; size_t estride, astride; };
template <class E, class = void> struct epi_chain { static constexpr bool v = false; };
template <class E> struct epi_chain<E, decltype((void)E::CHAIN)> { static constexpr bool v = E::CHAIN; };

struct StaticOrder {
    int nM, nN, nwg, G, c;
    __host__ __device__ void init(int M, int N, int G_, int c_) { nM = M / BM; nN = N / BM; nwg = nM * nN; G = G_; c = c_; }
    __host__ __device__ __forceinline__ bool next(int i, Unit& u) const {
        const long L = (long)i * G + c; if (L >= nwg) return false;
        int wgid = (int)L; { const int q = nwg / NXCD, r = nwg % NXCD, xcd = wgid % NXCD, off = wgid / NXCD; wgid = (xcd < r ? xcd * (q + 1) : r * (q + 1) + (xcd - r) * q) + off; }
        const int nig = WGM * nN, gid = wgid / nig, fm = gid * WGM, gsz = (nM - fm) < WGM ? (nM - fm) : WGM;
        u.pm = fm + ((wgid % nig) % gsz); u.pn = (wgid % nig) / gsz; u.e = 0; return true;
    }
    __device__ __forceinline__ void a_ready(const Unit&) const {}
    __device__ __forceinline__ void done(const Unit&) const {}
};
struct PairOrder {
    StaticOrder S0;
    __device__ __forceinline__ bool next(int i, Unit& u) const { Unit t; if (i >= 2 || !S0.next(0, t)) return false; u.pm = t.pm; u.pn = t.pn; u.e = i; return true; }
    __device__ __forceinline__ void a_ready(const Unit&) const {}
    __device__ __forceinline__ void done(const Unit&) const {}
};
struct OneUnit {
    int pm, pn, e;
    __device__ __forceinline__ bool next(int i, Unit& u) const { if (i != 0) return false; u.pm = pm; u.pn = pn; u.e = e; return true; }
    __device__ __forceinline__ void a_ready(const Unit&) const {}
    __device__ __forceinline__ void done(const Unit&) const {}
};
struct GroupOrder {
    int nN, total, G, c; const int* t2e;
    __device__ void init(int nTiles, int nN_, int G_, int c_, const int* t2e_) { nN = nN_; total = nTiles * nN_; G = G_; c = c_; t2e = t2e_; }
    __device__ bool next(int i, Unit& u) const {
        const long L = (long)i * G + c; if (L >= total) return false;
        u.pm = (int)(L / nN); u.pn = (int)(L % nN); u.e = __builtin_amdgcn_readfirstlane(t2e[u.pm]); return true;
    }
    __device__ __forceinline__ void a_ready(const Unit&) const {}
    __device__ __forceinline__ void done(const Unit&) const {}
};

__device__ __forceinline__ void st8(bf16_t* p, f32x4 v0, f32x4 v1) { u32x4 w; w.x = pk2(v0[0], v0[1]); w.y = pk2(v0[2], v0[3]); w.z = pk2(v1[0], v1[1]); w.w = pk2(v1[2], v1[3]); *(u32x4*)p = w; }
__device__ __forceinline__ void ld8(const bf16_t* p, f32x4& v0, f32x4& v1) { const u32x4 w = *(const u32x4*)p; v0 = (f32x4){bflo(w.x), bfhi(w.x), bflo(w.y), bfhi(w.y)}; v1 = (f32x4){bflo(w.z), bfhi(w.z), bflo(w.w), bfhi(w.w)}; }

__device__ __forceinline__ void rope16(f32x4& v0, f32x4& v1, int row, int fq, const f32x2* rope) {
    const f32x2* rp = rope + (size_t)(row & (SEQ - 1)) * 16;
    f32x4 p0, p1;
#pragma unroll
    for (int e = 0; e < 4; ++e) { p0[e] = __shfl_xor(v0[e], 16); p1[e] = __shfl_xor(v1[e], 16); }
    if (fq < 2) {
        const float sg = fq == 0 ? -1.f : 1.f;
#pragma unroll
        for (int e = 0; e < 4; ++e) { const f32x2 a = rp[2 * e], b = rp[2 * (4 + e)];
            v0[e] = v0[e] * a.x + sg * p0[e] * a.y; v1[e] = v1[e] * b.x + sg * p1[e] * b.y; }
    }
}
__device__ __forceinline__ void rope32(f32x4& v0, f32x4& v1, int row, int fq, const f32x2* rope) {
    const f32x2* rp = rope + (size_t)(row & (SEQ - 1)) * 16 + 8 * (fq & 1);
    const float sg = fq < 2 ? -1.f : 1.f;
#pragma unroll
    for (int e = 0; e < 4; ++e) { const float p0 = __shfl_xor(v0[e], 32), p1 = __shfl_xor(v1[e], 32); const f32x2 a = rp[e], b = rp[4 + e];
        v0[e] = v0[e] * a.x + sg * p0 * a.y; v1[e] = v1[e] * b.x + sg * p1 * b.y; }
}
__device__ __forceinline__ float sigmoidf_(float x) { return __builtin_amdgcn_rcpf(1.f + __builtin_amdgcn_exp2f(-1.4426950408889634f * x)); }

struct EpiIn {
    static constexpr bool PERM = true, AFTER_DRAIN = false;
    bf16_t *CQ, *CKV, *QB, *KB, *VB, *QI, *KI, *KR, *GA, *GB; float* WI; const f32x2* rope; float* PART;
    __device__ __forceinline__ void operator()(const f32x4 (&acc)[2][2][4][2], const Unit& u, int wr, int wc, int fr, int fq) const {
        const int row0 = u.pm * BM + wr * 64 + fr;
#pragma unroll
        for (int bj = 0; bj < 2; ++bj) {
            const int cg = u.pn * BM + bj * HALF + wc * 32;
            bf16_t* base = nullptr; int pitch = 0, cc = 0, mode = 0; float sc = 1.f;
            if (cg < C_CKV) { base = CQ; pitch = 384; cc = cg; }
            else if (cg < C_QB) { base = CKV; pitch = 256; cc = cg - C_CKV; }
            else if (cg < C_KB) { base = QB; pitch = 512; cc = cg - C_QB; mode = ((cc >> 5) & 1) == 0 ? 1 : 0; sc = C2B; }
            else if (cg < C_VB) { base = KB; pitch = 512; cc = cg - C_KB; mode = ((cc >> 5) & 1) == 0 ? 1 : 0; }
            else if (cg < C_QI) { base = VB; pitch = 512; cc = cg - C_VB; }
            else if (cg < C_KR) { base = QI; pitch = 512; cc = cg - C_QI; mode = ((cc >> 5) & 1) == 0 ? 1 : 0; }
            else if (cg < C_KI) { base = KR; pitch = 32; cc = 0; mode = 2; }
            else if (cg < C_WI) { base = KI; pitch = 64; cc = cg - C_KI; mode = (cc == 0) ? 1 : 0; }
            else if (cg < C_GA) { mode = 4; }
            else if (cg < C_GB) { base = GA; pitch = 1024; cc = cg - C_GA; mode = 3; }
            else { base = GB; pitch = 1024; cc = cg - C_GB; mode = 3; }
#pragma unroll
            for (int ai = 0; ai < 2; ++ai)
#pragma unroll
                for (int m = 0; m < 4; ++m) {
                    const int row = row0 + ai * HALF + m * 16;
                    f32x4 v0 = acc[ai][bj][m][0], v1 = acc[ai][bj][m][1];
                    if (mode == 1) rope16(v0, v1, row, fq, rope);
                    else if (mode == 2) rope32(v0, v1, row, fq, rope);
                    else if (mode == 3) {
#pragma unroll
                        for (int e = 0; e < 4; ++e) { v0[e] = sigmoidf_(v0[e]); v1[e] = sigmoidf_(v1[e]); } }
                    if (cg < C_QB) {
                        float ss = ((v0[0] * v0[0] + v0[1] * v0[1]) + (v0[2] * v0[2] + v0[3] * v0[3])) + ((v1[0] * v1[0] + v1[1] * v1[1]) + (v1[2] * v1[2] + v1[3] * v1[3]));
                        ss += __shfl_xor(ss, 16); ss += __shfl_xor(ss, 32);
                        if (fq == 0) PART[(size_t)row * 20 + (cg >> 5)] = ss; }
                    if (mode == 4) { if (fq == 0) { *(f32x4*)(WI + (size_t)row * 8) = v0 * WI_SCALE; *(f32x4*)(WI + (size_t)row * 8 + 4) = v1 * WI_SCALE; } }
                    else { v0 = v0 * sc; v1 = v1 * sc; st8(base + (size_t)row * pitch + cc + 8 * fq, v0, v1); }
                }
        }
    }
};
struct EpiQA {
    static constexpr bool PERM = true, AFTER_DRAIN = false;
    bf16_t* QA; const f32x2* rope; const PG8_LAS float* RS;
    __device__ __forceinline__ void operator()(const f32x4 (&acc)[2][2][4][2], const Unit& u, int wr, int wc, int fr, int fq) const {
        const int row0 = u.pm * BM + wr * 64 + fr; const PG8_LAS float* rsp = RS + wr * 64 + fr;
#pragma unroll
        for (int bj = 0; bj < 2; ++bj) {
            const int cg = u.pn * BM + bj * HALF + wc * 32; const bool rot = ((cg >> 5) % 3) == 2;
#pragma unroll
            for (int ai = 0; ai < 2; ++ai)
#pragma unroll
                for (int m = 0; m < 4; ++m) {
                    const int row = row0 + ai * HALF + m * 16;
                    f32x4 v0 = acc[ai][bj][m][0], v1 = acc[ai][bj][m][1];
                    if (rot) rope32(v0, v1, row, fq, rope);
                    { const float rsv = rsp[ai * HALF + m * 16]; v0 = v0 * rsv; v1 = v1 * rsv; } st8(QA + (size_t)row * 768 + cg + 8 * fq, v0, v1);
                }
        }
    }
};
struct EpiKV {
    static constexpr bool PERM = true, AFTER_DRAIN = false;
    bf16_t *KN, *VA; const PG8_LAS float* RS;
    __device__ __forceinline__ void operator()(const f32x4 (&acc)[2][2][4][2], const Unit& u, int wr, int wc, int fr, int fq) const {
        const int row0 = u.pm * BM + wr * 64 + fr; const PG8_LAS float* rsp = RS + wr * 64 + fr;
#pragma unroll
        for (int bj = 0; bj < 2; ++bj) {
            const int cg = u.pn * BM + bj * HALF + wc * 32; bf16_t* base = cg < 512 ? KN : VA; const int cc = (cg & 511) + 8 * fq;
#pragma unroll
            for (int ai = 0; ai < 2; ++ai)
#pragma unroll
                for (int m = 0; m < 4; ++m) { const int row = row0 + ai * HALF + m * 16; const float rsv = rsp[ai * HALF + m * 16]; st8(base + (size_t)row * 512 + cc, acc[ai][bj][m][0] * rsv, acc[ai][bj][m][1] * rsv); }
        }
    }
};
template <int ADD> struct EpiY {
    static constexpr bool PERM = true, AFTER_DRAIN = false;
    bf16_t* Y; const bf16_t* Gt;
    __device__ __forceinline__ void operator()(const f32x4 (&acc)[2][2][4][2], const Unit& u, int wr, int wc, int fr, int fq) const {
        const int row0 = u.pm * BM + wr * 64 + fr;
#pragma unroll
        for (int bj = 0; bj < 2; ++bj) {
            const int c0 = u.pn * BM + bj * HALF + wc * 32 + 8 * fq;
#pragma unroll
            for (int ai = 0; ai < 2; ++ai)
#pragma unroll
                for (int m = 0; m < 4; ++m) { const size_t off = (size_t)(row0 + ai * HALF + m * 16) * 1024 + c0;
                    f32x4 g0, g1; ld8(Gt + off, g0, g1);
                    f32x4 v0 = acc[ai][bj][m][0] * g0, v1 = acc[ai][bj][m][1] * g1;
                    if (ADD) { f32x4 o0, o1; ld8(Y + off, o0, o1); v0 = v0 + o0; v1 = v1 + o1; }
                    st8(Y + off, v0, v1); }
        }
    }
};
struct EpiYC {
    static constexpr bool PERM = true, AFTER_DRAIN = false, CHAIN = true;
    bf16_t* Y; const bf16_t *Ga, *Gb;
    __device__ __forceinline__ void operator()(f32x4 (&acc)[2][2][4][2], const Unit& u, int wr, int wc, int fr, int fq) const {
        const int row0 = u.pm * BM + wr * 64 + fr;
#pragma unroll
        for (int bj = 0; bj < 2; ++bj) {
            const int c0 = u.pn * BM + bj * HALF + wc * 32 + 8 * fq;
#pragma unroll
            for (int ai = 0; ai < 2; ++ai)
#pragma unroll
                for (int m = 0; m < 4; ++m) { const size_t off = (size_t)(row0 + ai * HALF + m * 16) * 1024 + c0;
                    f32x4 b0, b1; ld8(Gb + off, b0, b1);
#pragma unroll
                    for (int e = 0; e < 4; ++e) { b0[e] = fmaxf(b0[e], 1e-30f); b1[e] = fmaxf(b1[e], 1e-30f); }
                    if (u.e == 0) { f32x4 a0, a1; ld8(Ga + off, a0, a1);
#pragma unroll
                        for (int e = 0; e < 4; ++e) { acc[ai][bj][m][0][e] *= a0[e] * __builtin_amdgcn_rcpf(b0[e]); acc[ai][bj][m][1][e] *= a1[e] * __builtin_amdgcn_rcpf(b1[e]); } }
                    else st8(Y + off, acc[ai][bj][m][0] * b0, acc[ai][bj][m][1] * b1); }
        }
    }
};
struct EpiX1 {
    static constexpr bool PERM = false, AFTER_DRAIN = false;
    const float* X; float* O;
    __device__ __forceinline__ void operator()(const f32x4 (&acc)[2][2][4][2], const Unit& u, int wr, int wc, int fr, int fq) const {
        const int row0 = u.pm * BM + wr * 64 + fr, col0 = u.pn * BM + wc * 32 + 4 * fq;
#pragma unroll
        for (int ai = 0; ai < 2; ++ai)
#pragma unroll
            for (int m = 0; m < 4; ++m) { const size_t off = (size_t)(row0 + ai * HALF + m * 16) * 1024 + col0;
#pragma unroll
                for (int bj = 0; bj < 2; ++bj)
#pragma unroll
                    for (int n = 0; n < 2; ++n) { const f32x4 xv = *(const f32x4*)(X + off + bj * HALF + n * 16); *(f32x4*)(O + off + bj * HALF + n * 16) = xv + acc[ai][bj][m][n]; } }
    }
};
struct EpiHid {
    static constexpr bool PERM = true, AFTER_DRAIN = false;
    bf16_t* HID;
    __device__ __forceinline__ void operator()(const f32x4 (&acc)[2][2][4][2], const Unit& u, int wr, int wc, int fr, int fq) const {
        const int row0 = u.pm * BM + wr * 64 + fr, c0 = u.pn * 128 + wc * 32 + 8 * fq;
#pragma unroll
        for (int ai = 0; ai < 2; ++ai)
#pragma unroll
            for (int m = 0; m < 4; ++m) { f32x4 h0, h1;
#pragma unroll
                for (int e = 0; e < 4; ++e) { const float g0 = acc[ai][0][m][0][e], g1 = acc[ai][0][m][1][e];
                    h0[e] = g0 * sigmoidf_(g0) * acc[ai][1][m][0][e]; h1[e] = g1 * sigmoidf_(g1) * acc[ai][1][m][1][e]; }
                st8(HID + (size_t)(row0 + ai * HALF + m * 16) * 256 + c0, h0, h1); }
    }
};
struct EpiDown {
    static constexpr bool PERM = true, AFTER_DRAIN = false;
    bf16_t* SL; const int* sslot; const float* sw;
    __device__ __forceinline__ void operator()(const f32x4 (&acc)[2][2][4][2], const Unit& u, int wr, int wc, int fr, int fq) const {
        const int row0 = u.pm * BM + wr * 64 + fr;
#pragma unroll
        for (int ai = 0; ai < 2; ++ai)
#pragma unroll
            for (int m = 0; m < 4; ++m) { const int r = row0 + ai * HALF + m * 16; const int slot = sslot[r]; const float w = sw[r];
                if (slot >= 0) {
#pragma unroll
                    for (int bj = 0; bj < 2; ++bj) st8(SL + (size_t)slot * 1024 + u.pn * BM + bj * HALF + wc * 32 + 8 * fq, acc[ai][bj][m][0] * w, acc[ai][bj][m][1] * w); } }
    }
};
template <class Epi, class Sched, bool ALIGN_EPI = false, bool SP2 = false>
__device__ __forceinline__ void gemm_phase(PG8_LAS unsigned char* lds, const Gemm g, const Sched& S, const Epi& E) {
    const int tid = threadIdx.x, wid = __builtin_amdgcn_readfirstlane(tid >> 6), lane = tid & 63, wr = wid >> 2, wc = wid & 3, fr = lane & 15, fq = lane >> 4;
    const int K = g.K, nt = K / BK;
    unsigned voffA[2], voffB[2];
#pragma unroll
    for (int i = 0; i < 2; ++i) { int R, C; stage_rc(tid * 16 + i * 8192, R, C); const int Rb = Epi::PERM ? ((R & ~31) + perm32(R & 31)) : R;
        voffA[i] = (unsigned)(R * K + C) * 2u; voffB[i] = (unsigned)(Rb * K + C) * 2u; }
    const size_t kstep = (size_t)(BK * 2);
    const size_t hstep = (size_t)HALF * K * 2;
    const size_t tstep = 2 * hstep;
    const unsigned ldsw = (unsigned)wid * 1024u;
    const int aoff = lds_byte(wr * 64 + fr, fq * 8), boff = lds_byte(wc * 32 + fr, fq * 8);
#define PG8_SA(b, h) (((b) * 2 + (h)) * HTB)
#define PG8_SB(b, h) ((4 + (b) * 2 + (h)) * HTB)
#define PG8_STAGE(bufoff, gbase, voff) do { _Pragma("unroll") for (int _i = 0; _i < 2; ++_i) \
        __builtin_amdgcn_global_load_lds((const unsigned*)((const char*)(gbase) + (voff)[_i]), (PG8_LAS unsigned*)(lds + (bufoff) + ldsw + _i * 8192), 16, 0, 0); } while (0)
#define PG8_LDA(dst, b, h) do { _Pragma("unroll") for (int m = 0; m < 4; ++m) _Pragma("unroll") for (int k = 0; k < 2; ++k) dst[m][k] = *(const PG8_LAS bf16x8*)(lds + PG8_SA(b, h) + aoff + m * 2048 + k * 1024); } while (0)
#define PG8_LDB(dst, b, h) do { _Pragma("unroll") for (int n = 0; n < 2; ++n) _Pragma("unroll") for (int k = 0; k < 2; ++k) dst[n][k] = *(const PG8_LAS bf16x8*)(lds + PG8_SB(b, h) + boff + n * 2048 + k * 1024); } while (0)
#define PG8_MMA(ai, bj, At, Bt) do { __builtin_amdgcn_s_setprio(1); _Pragma("unroll") for (int m = 0; m < 4; ++m) _Pragma("unroll") for (int n = 0; n < 2; ++n) _Pragma("unroll") for (int k = 0; k < 2; ++k) \
        acc[ai][bj][m][n] = __builtin_amdgcn_mfma_f32_16x16x32_bf16(Bt[n][k], At[m][k], acc[ai][bj][m][n], 0, 0, 0); __builtin_amdgcn_s_setprio(0); } while (0)
#define PG8_WAIT_V(n) asm volatile("s_waitcnt vmcnt(" #n ")" ::: "memory")
#define PG8_WAIT_L(n) asm volatile("s_waitcnt lgkmcnt(" #n ")" ::: "memory")
#define PG8_BAR __builtin_amdgcn_s_barrier()
#define PG8_SCHED __builtin_amdgcn_sched_barrier(0)
    Unit cur, nxt; int ui = 0;
    if (!S.next(0, cur)) return;
    f32x4 acc[2][2][4][2];
#pragma unroll
    for (int a = 0; a < 2; ++a)
#pragma unroll
        for (int b = 0; b < 2; ++b)
#pragma unroll
            for (int m = 0; m < 4; ++m)
#pragma unroll
                for (int n = 0; n < 2; ++n) acc[a][b][m][n] = (f32x4){0.f, 0.f, 0.f, 0.f};
    bf16x8 At[4][2], B0[2][2], B1[2][2];
    const char* cA = (const char*)g.A + (size_t)cur.e * g.astride + (size_t)cur.pm * tstep; const char* cB = (const char*)g.Bt + (size_t)cur.e * g.estride + (size_t)cur.pn * tstep;
    S.a_ready(cur);
    if constexpr (SP2) {
        PG8_STAGE(PG8_SB(0, 0), cB, voffB); PG8_STAGE(PG8_SB(0, 1), cB + hstep, voffB); PG8_STAGE(PG8_SA(0, 0), cA, voffA); PG8_STAGE(PG8_SA(0, 1), cA + hstep, voffA);
        if (wr == 1) PG8_BAR;
        PG8_WAIT_V(2); PG8_BAR;
        PG8_STAGE(PG8_SB(1, 0), cB + kstep, voffB); PG8_STAGE(PG8_SA(1, 0), cA + kstep, voffA); PG8_STAGE(PG8_SB(1, 1), cB + hstep + kstep, voffB);
        PG8_WAIT_V(6); PG8_BAR;
    } else {
        PG8_STAGE(PG8_SB(0, 0), cB, voffB); PG8_STAGE(PG8_SA(0, 0), cA, voffA); PG8_STAGE(PG8_SB(0, 1), cB + hstep, voffB); PG8_STAGE(PG8_SA(0, 1), cA + hstep, voffA);
        if (wr == 1) PG8_BAR;
        PG8_WAIT_V(4); PG8_BAR;
        PG8_STAGE(PG8_SB(1, 0), cB + kstep, voffB); PG8_STAGE(PG8_SA(1, 0), cA + kstep, voffA); PG8_STAGE(PG8_SB(1, 1), cB + hstep + kstep, voffB);
        PG8_WAIT_V(6); PG8_BAR;
    }
    for (;;) {
        const bool has_next = S.next(ui + 1, nxt);
        const char* nA = has_next ? (const char*)g.A + (size_t)nxt.e * g.astride + (size_t)nxt.pm * tstep : cA; const char* nB = has_next ? (const char*)g.Bt + (size_t)nxt.e * g.estride + (size_t)nxt.pn * tstep : cB;
#pragma nounroll
        for (int t = 0; t < nt; t += 2) {
            const bool last = (t == nt - 2);
            const char* a1 = cA + (size_t)(t + 1) * kstep;
            const char* a2 = last ? nA : cA + (size_t)(t + 2) * kstep; const char* b2 = last ? nB : cB + (size_t)(t + 2) * kstep;
            const char* a3 = a2 + kstep; const char* b3 = b2 + kstep;
            if (last && has_next) S.a_ready(nxt);
            if constexpr (SP2) {
            PG8_LDB(B0, 0, 0); PG8_LDB(B1, 0, 1); PG8_SCHED; PG8_LDA(At, 0, 0); PG8_STAGE(PG8_SA(1, 1), a1 + hstep, voffA);
            PG8_WAIT_V(8); PG8_WAIT_L(0); PG8_BAR; PG8_MMA(0, 0, At, B0); PG8_MMA(0, 1, At, B1); PG8_BAR; PG8_SCHED;
            PG8_LDA(At, 0, 1); PG8_STAGE(PG8_SB(0, 0), b2, voffB); PG8_STAGE(PG8_SB(0, 1), b2 + hstep, voffB); PG8_STAGE(PG8_SA(0, 0), a2, voffA);
            PG8_WAIT_V(8); PG8_WAIT_L(0); PG8_BAR; PG8_MMA(1, 0, At, B0); PG8_MMA(1, 1, At, B1); PG8_BAR; PG8_SCHED;
            PG8_LDB(B0, 1, 0); PG8_LDB(B1, 1, 1); PG8_SCHED; PG8_LDA(At, 1, 0); PG8_STAGE(PG8_SA(0, 1), a2 + hstep, voffA);
            PG8_WAIT_V(8); PG8_WAIT_L(0); PG8_BAR; PG8_MMA(0, 0, At, B0); PG8_MMA(0, 1, At, B1); PG8_BAR; PG8_SCHED;
            PG8_LDA(At, 1, 1); PG8_STAGE(PG8_SB(1, 0), b3, voffB); PG8_STAGE(PG8_SB(1, 1), b3 + hstep, voffB); PG8_STAGE(PG8_SA(1, 0), a3, voffA);
            PG8_WAIT_V(8); PG8_WAIT_L(0); PG8_BAR; PG8_MMA(1, 0, At, B0); PG8_MMA(1, 1, At, B1); PG8_BAR; PG8_SCHED;
            } else {
            PG8_LDB(B0, 0, 0); PG8_SCHED; PG8_LDA(At, 0, 0); PG8_STAGE(PG8_SA(1, 1), a1 + hstep, voffA);
            PG8_WAIT_L(8); PG8_BAR; PG8_WAIT_L(0); PG8_MMA(0, 0, At, B0); PG8_BAR; PG8_SCHED;
            PG8_LDB(B1, 0, 1); PG8_STAGE(PG8_SB(0, 0), b2, voffB);
            PG8_BAR; PG8_WAIT_L(0); PG8_MMA(0, 1, At, B1); PG8_BAR;
            PG8_LDA(At, 0, 1); PG8_STAGE(PG8_SA(0, 0), a2, voffA);
            PG8_BAR; PG8_WAIT_L(0); PG8_MMA(1, 0, At, B0); PG8_BAR; PG8_SCHED;
            PG8_STAGE(PG8_SB(0, 1), b2 + hstep, voffB);
            PG8_WAIT_V(6); PG8_BAR; PG8_MMA(1, 1, At, B1); PG8_BAR;
            PG8_LDB(B0, 1, 0); PG8_SCHED; PG8_LDA(At, 1, 0); PG8_STAGE(PG8_SA(0, 1), a2 + hstep, voffA);
            PG8_WAIT_L(8); PG8_BAR; PG8_WAIT_L(0); PG8_MMA(0, 0, At, B0); PG8_BAR; PG8_SCHED;
            PG8_LDB(B1, 1, 1); PG8_STAGE(PG8_SB(1, 0), b3, voffB);
            PG8_BAR; PG8_WAIT_L(0); PG8_MMA(0, 1, At, B1); PG8_BAR;
            PG8_LDA(At, 1, 1); PG8_STAGE(PG8_SA(1, 0), a3, voffA);
            PG8_BAR; PG8_WAIT_L(0); PG8_MMA(1, 0, At, B0); PG8_BAR; PG8_SCHED;
            PG8_STAGE(PG8_SB(1, 1), b3 + hstep, voffB);
            PG8_WAIT_V(6); PG8_BAR; PG8_MMA(1, 1, At, B1); PG8_BAR;
            }
        }
        if constexpr (ALIGN_EPI) { if (wr == 0) PG8_BAR; }
        if constexpr (!Epi::AFTER_DRAIN) { E(acc, cur, wr, wc, fr, fq); S.done(cur); }
        if (!has_next) break;
        if (!(epi_chain<Epi>::v && cur.e == 0)) {
#pragma unroll
        for (int a = 0; a < 2; ++a)
#pragma unroll
            for (int b = 0; b < 2; ++b)
#pragma unroll
                for (int m = 0; m < 4; ++m)
#pragma unroll
                    for (int n = 0; n < 2; ++n) acc[a][b][m][n] = (f32x4){0.f, 0.f, 0.f, 0.f};
        }
        cur = nxt; cA = nA; cB = nB; ++ui;
        if constexpr (ALIGN_EPI) { if (wr == 1) PG8_BAR; }
    }
    PG8_WAIT_V(0);
    if constexpr (!ALIGN_EPI) { if (wr == 0) PG8_BAR; }
    PG8_BAR;
    if constexpr (Epi::AFTER_DRAIN) { E.fused(acc, cur, wr, wc, fr, fq, lds, wid, lane); S.done(cur); }
#undef PG8_SA
#undef PG8_SB
#undef PG8_STAGE
#undef PG8_LDA
#undef PG8_LDB
#undef PG8_MMA
#undef PG8_WAIT_V
#undef PG8_WAIT_L
#undef PG8_BAR
#undef PG8_SCHED
}
}

struct Args { const float* in[20]; float* out; unsigned char* ws; int ph_lo, ph_hi; };
struct Frame {
    LAS unsigned char* lds; volatile LAS unsigned* MISC; gu32* ctl; unsigned char* ws;
    int vcu, G;
};
#define F_TID ((int)threadIdx.x)
#define F_LANE ((int)(threadIdx.x & 63))
#define F_WAVE (__builtin_amdgcn_readfirstlane((int)(threadIdx.x >> 6)))

__device__ __forceinline__ int in_src_col(int n) {
    if (n < 640) return n;
    if (n < 2688) return n + 32;
    if (n < 2720) return n - 2688 + 640;
    if (n < 2792) return n;
    if (n < 2816) return -1;
    return n - 24;
}
struct TrDesc { const float* colptr; int ld, k0; bf16* WT; int Kd, destrow0; const float* gain; };
__device__ __forceinline__ void tr_load(const TrDesc& d, int lane, f32x4 (&v)[16]) {
    const int kr = lane >> 4;
#pragma unroll
    for (int it = 0; it < 16; ++it) { const int kk = 4 * it + kr; v[it] = (f32x4){0.f, 0.f, 0.f, 0.f}; if (d.colptr) v[it] = *(const GAS f32x4*)(d.colptr + (size_t)(d.k0 + kk) * d.ld); if (d.gain) v[it] = v[it] * d.gain[d.k0 + kk]; }
}
__device__ __forceinline__ void tr_store(const TrDesc& d, int lane, const f32x4 (&v)[16], LAS float* scr) {
    const int nq = lane & 15, kr = lane >> 4;
#pragma unroll
    for (int it = 0; it < 16; ++it) { const int kk = 4 * it + kr; LAS float* q = scr + kk * 65 + 4 * nq; q[0] = v[it].x; q[1] = v[it].y; q[2] = v[it].z; q[3] = v[it].w; }
    LDS_WAIT(); asm volatile("" ::: "memory");
    const int c = lane & 7;
#pragma unroll
    for (int j = 0; j < 8; ++j) { const int n = (lane >> 3) + 8 * j; const LAS float* q = scr + (8 * c) * 65 + n;
        v4u o; o.x = pk2(q[0 * 65], q[1 * 65]); o.y = pk2(q[2 * 65], q[3 * 65]); o.z = pk2(q[4 * 65], q[5 * 65]); o.w = pk2(q[6 * 65], q[7 * 65]);
        *(GAS v4u*)(d.WT + (size_t)(d.destrow0 + n) * d.Kd + d.k0 + 8 * c) = o; }
    LDS_WAIT(); asm volatile("" ::: "memory");
}
constexpr int CV_I0 = 16 * 76, CV_I1 = 6 * 12, CV_I2 = 4 * 16, CV_I3 = 8 * 16, CV_I4 = 8 * 16, CV_I5 = 16 * 16, CV_I6 = 32 * 16 * 8, CV_I7 = 32 * 4 * 16;
constexpr int CV_EARLY = CV_I0 + CV_I1 + CV_I2, CV_LATE = CV_I3 + CV_I4 + CV_I5 + CV_I6 + CV_I7, CV_QITEMS = CV_LATE / 16;
static_assert(CV_LATE % 16 == 0, "late conversion tiles come in queue items of 16");
__device__ __forceinline__ TrDesc conv_desc(const Args& A, unsigned char* ws, int it, int lane) {
    const int n4 = 4 * (lane & 15);
    int r = it;
    if (r < CV_I0) { const int kb = r / 76, nb = r % 76; const int col = in_src_col(64 * nb + n4);
        return TrDesc{col >= 0 ? A.in[2] + col : nullptr, NIN_SRC, 64 * kb, (bf16*)(ws + WS_WIN), 1024, 64 * nb, nullptr}; } r -= CV_I0;
    if (r < CV_I1) { const int kb = r / 12, nb = r % 12; return TrDesc{A.in[4] + 64 * nb + n4, 768, 64 * kb, (bf16*)(ws + WS_WUQ), 384, 64 * nb, A.in[3]}; } r -= CV_I1;
    if (r < CV_I2) { const int kb = r / 16, nb = r % 16; const int n = 64 * nb + n4;
        return TrDesc{n < 512 ? A.in[6] + n : A.in[7] + (n - 512), 512, 64 * kb, (bf16*)(ws + WS_WUKV), 256, 64 * nb, A.in[5]}; } r -= CV_I2;
    if (r < CV_I3) { const int kb = r / 16, nb = r % 16; return TrDesc{A.in[8] + 64 * nb + n4, 1024, 64 * kb, (bf16*)(ws + WS_WOA), 512, 64 * nb, nullptr}; } r -= CV_I3;
    if (r < CV_I4) { const int kb = r / 16, nb = r % 16; return TrDesc{A.in[9] + 64 * nb + n4, 1024, 64 * kb, (bf16*)(ws + WS_WOB), 512, 64 * nb, nullptr}; } r -= CV_I4;
    if (r < CV_I5) { const int kb = r / 16, nb = r % 16; return TrDesc{A.in[10] + 64 * nb + n4, 1024, 64 * kb, (bf16*)(ws + WS_WOUT), 1024, 64 * nb, nullptr}; } r -= CV_I5;
    if (r < CV_I6) { const int e = r / 128, rr = r % 128, kb = rr / 8, nb = rr % 8; const int n = 64 * nb + n4, pn = n >> 8, c = n & 255, col = 128 * pn + (c & 127);
        const float* src = ((c >> 7) ? A.in[17] : A.in[16]) + (size_t)e * 1024 * 256 + col;
        return TrDesc{src, 256, 64 * kb, (bf16*)(ws + WS_WGU) + (size_t)e * 512 * 1024, 1024, 64 * nb, nullptr}; } r -= CV_I6;
    { const int e = r / 64, rr = r % 64, kb = rr / 16, nb = rr % 16;
        return TrDesc{A.in[18] + (size_t)e * 256 * 1024 + 64 * nb + n4, 1024, 64 * kb, (bf16*)(ws + WS_WD) + (size_t)e * 1024 * 256, 256, 64 * nb, nullptr}; }
}
__device__ __forceinline__ void conv_tile(const Args& A, unsigned char* ws, int it, LAS float* scr, int lane) {
    const TrDesc d = conv_desc(A, ws, it, lane); f32x4 v[16]; tr_load(d, lane, v); tr_store(d, lane, v, scr);
}
__device__ __forceinline__ void conv_tile2(const Args& A, unsigned char* ws, int it0, int it1, LAS float* scr, int lane) {
    const TrDesc d0 = conv_desc(A, ws, it0, lane), d1 = conv_desc(A, ws, it1, lane); f32x4 v0[16], v1[16];
    tr_load(d0, lane, v0); tr_load(d1, lane, v1); tr_store(d0, lane, v0, scr); tr_store(d1, lane, v1, scr);
}
__device__ __forceinline__ void p0_prologue(Frame& F, const Args& A) {
    LAS float* scr = (LAS float*)(F.lds + F_WAVE * 16640);
    const int gw = F.vcu * NWAVES + F_WAVE, NGW = F.G * NWAVES, lane = F_LANE;
    unsigned char* ws = F.ws;
#ifdef CONV_IN_P0
    for (int it = gw; it < CV_EARLY + CV_LATE; it += NGW) conv_tile(A, ws, it, scr, lane);
#else
    for (int it = gw; it < CV_EARLY; it += NGW) conv_tile(A, ws, it, scr, lane);
#endif
    const float* x = A.in[0]; const float* g1 = A.in[1]; bf16* H = (bf16*)(ws + WS_H);
    for (int m0 = gw; m0 < T; m0 += 4 * NGW) {
        f32x4 v[4][4];
#pragma unroll
        for (int r = 0; r < 4; ++r) { const int m = min(m0 + r * NGW, T - 1); const GAS f32x4* xr = (const GAS f32x4*)(x + (size_t)m * D) + lane;
#pragma unroll
            for (int j = 0; j < 4; ++j) v[r][j] = xr[64 * j]; }
#pragma unroll
        for (int r = 0; r < 4; ++r) { const int m = m0 + r * NGW; float s = 0.f;
#pragma unroll
            for (int j = 0; j < 4; ++j) s += (v[r][j].x * v[r][j].x + v[r][j].y * v[r][j].y) + (v[r][j].z * v[r][j].z + v[r][j].w * v[r][j].w);
            const float rstd = 1.f / sqrtf(wave_sum(s) * (1.f / D) + EPS);
            if (m < T) { GAS v2u* o8 = (GAS v2u*)(H + (size_t)m * D) + lane;
#pragma unroll
                for (int j = 0; j < 4; ++j) { const f32x4 g = *((const GAS f32x4*)g1 + lane + 64 * j); const f32x4 y = v[r][j] * rstd * g; v2u w; w.x = pk2(y.x, y.y); w.y = pk2(y.z, y.w); o8[64 * j] = w; } } }
    }
    f32x2* rope = (f32x2*)(ws + WS_ROPE);
    for (int idx = (F.vcu * NTHR + F_TID); idx < SEQ * 16; idx += F.G * NTHR) {
        const int pos = idx >> 4, i = idx & 15;
        const double REV[16] = {0.15915494309189535, 0.0700865215877985, 0.03086376340470123, 0.013591370636193905, 0.005985185712713705, 0.002635675898667414, 0.001160663641240061, 0.0005111175045375439,
                                0.00022507907903927653, 9.911730936901935e-05, 4.364795279280289e-05, 1.9221100684944863e-05, 8.464330808241401e-06, 3.727408601915352e-06, 1.6414262627950345e-06, 7.228293068832865e-07};
        double rv = 0.0;
#pragma unroll
        for (int k = 0; k < 16; ++k) rv = (i == k) ? REV[k] : rv;
        double t = (double)pos * rv; t -= __builtin_floor(t);
        const float tf = (float)t;
        rope[idx] = (f32x2){__builtin_amdgcn_cosf(tf), __builtin_amdgcn_sinf(tf)};
    }
}

__device__ __forceinline__ void p2a_norms(Frame& F, const Args& A) {
    const int gw = F.vcu * NWAVES + F_WAVE, NGW = F.G * NWAVES, lane = F_LANE;
    bf16* CQ = (bf16*)(F.ws + WS_CQ); bf16* CKV = (bf16*)(F.ws + WS_CKV);
    const float* gq = A.in[3]; const float* gkv = A.in[5];
    for (int m = gw; m < T; m += NGW) {
        {
            GAS unsigned* p = (GAS unsigned*)(CQ + (size_t)m * 384) + lane; unsigned w[3]; float s = 0.f;
#pragma unroll
            for (int j = 0; j < 3; ++j) { w[j] = p[64 * j]; const float a = bflo(w[j]), b = bfhi(w[j]); s += a * a + b * b; }
            const float rstd = 1.f / sqrtf(wave_sum(s) * (1.f / 384.f) + EPS);
#pragma unroll
            for (int j = 0; j < 3; ++j) { const f32x2 g = *((const GAS f32x2*)gq + lane + 64 * j); p[64 * j] = pk2(bflo(w[j]) * rstd * g.x, bfhi(w[j]) * rstd * g.y); }
        }
        {
            GAS v2u* p = (GAS v2u*)(CKV + (size_t)m * 256) + lane; const v2u w = *p;
            const float a = bflo(w.x), b = bfhi(w.x), c = bflo(w.y), d = bfhi(w.y);
            const float rstd = 1.f / sqrtf(wave_sum(a * a + b * b + c * c + d * d) * (1.f / 256.f) + EPS);
            const f32x4 g = *((const GAS f32x4*)gkv + lane); v2u o; o.x = pk2(a * rstd * g.x, b * rstd * g.y); o.y = pk2(c * rstd * g.z, d * rstd * g.w); *p = o;
        }
    }
}

__device__ __forceinline__ constexpr int crow(int r, int hi) { return (r & 3) + 8 * (r >> 2) + 4 * hi; }
constexpr float ATT_THR = 8.f;
__device__ __forceinline__ float att_mask(float p, unsigned w, int bit) { int mk; unsigned r;
    asm("v_bfe_i32 %0, %1, %2, 1" : "=v"(mk) : "v"(w), "i"(bit)); r = __builtin_bit_cast(unsigned, p) & (unsigned)mk; return __builtin_bit_cast(float, r); }
struct AttnP { const bf16 *Q, *K, *K2, *V; bf16* O; const unsigned* BM; };
template <bool MLA> __device__ __forceinline__ void attn_unit(LAS unsigned char* L, int b, int h, int qb, const AttnP& P, int tid, int lane, int wave) {
    constexpr int DK = MLA ? 96 : 64, KP = DK * 2 + 16, NS = DK / 16, CPR = DK / 8;
    constexpr int QPITCH = MLA ? 768 : 512, VP = 192, KBUF = 64 * KP, VBUF = 64 * VP;
    const int r32 = lane & 31, hi = lane >> 5;
    const size_t rowb = (size_t)b * SEQ;
    const int qrow = qb * 256 + wave * 32 + r32;
    bf16x8 qf[NS];
    { const bf16* qp = P.Q + (rowb + qrow) * QPITCH + h * DK;
#pragma unroll
      for (int s = 0; s < NS; ++s) qf[s] = *(const bf16x8*)(qp + 16 * s + 8 * hi); }
    const int NT = 4 * qb + 4, my_nt = 4 * qb + (wave >> 1) + 1;
    const int kid0 = tid, kid1 = tid + NTHR;
    const int kr0 = kid0 / CPR, kc0 = kid0 % CPR, kr1 = kid1 / CPR, kc1 = kid1 % CPR; const bool has1 = MLA && (kid1 < 64 * CPR);
    const int vr = tid >> 3, vc = tid & 7;
    v4u kreg0, kreg1 = (v4u){0u, 0u, 0u, 0u}, vreg;
#define ATT_KSRC(t, kr, kc) (MLA ? ((kc) < 8 ? (const v4u*)(P.K + (rowb + 64 * (t) + (kr)) * 512 + h * 64 + 8 * (kc)) : (const v4u*)(P.K2 + (rowb + 64 * (t) + (kr)) * 32 + 8 * ((kc) - 8))) \
                                 : (const v4u*)(P.K + (rowb + 64 * (t) + (kr)) * 512 + h * 64 + 8 * (kc)))
#define ATT_LOAD(t) do { kreg0 = *ATT_KSRC(t, kr0, kc0); if (has1) kreg1 = *ATT_KSRC(t, kr1, kc1); vreg = *(const v4u*)(P.V + (rowb + 64 * (t) + vr) * 512 + h * 64 + 8 * vc); } while (0)
#define ATT_WRITE(buf) do { *(LAS v4u*)(L + (buf) * KBUF + kr0 * KP + kc0 * 16) = kreg0; if (has1) *(LAS v4u*)(L + (buf) * KBUF + kr1 * KP + kc1 * 16) = kreg1; \
                            *(LAS v4u*)(L + 2 * KBUF + (buf) * VBUF + vr * VP + vc * 16) = vreg; } while (0)
    float mhat = 0.f, l = 0.f; f32x16 o0, o1, negm;
#pragma unroll
    for (int i = 0; i < 16; ++i) { o0[i] = 0.f; o1[i] = 0.f; negm[i] = 0.f; }
    const int g16 = lane >> 4, qq = (lane & 15) >> 2, pp = lane & 3;
    const int vlane = (4 * hi + qq) * VP + (16 * (g16 & 1) + 4 * pp) * 2;
    ATT_LOAD(0); ATT_WRITE(0); __syncthreads();
    unsigned wn0 = 0xffffffffu, wn1 = 0xffffffffu;
    const unsigned* bmq = MLA ? nullptr : P.BM + (size_t)b * 256 * SEQ + qrow;
    if (!MLA) { wn0 = bmq[0]; wn1 = bmq[SEQ]; }
    for (int t = 0; t < NT; ++t) {
        const int buf = t & 1;
        unsigned w0 = wn0 >> (4 * hi), w1 = wn1 >> (4 * hi);
        if (t + 1 < NT) { ATT_LOAD(t + 1); if (!MLA) { wn0 = bmq[(size_t)(2 * t + 2) * SEQ]; wn1 = bmq[(size_t)(2 * t + 3) * SEQ]; } }
        if (t < my_nt) {
            const LAS unsigned char* Kb = L + buf * KBUF; const LAS unsigned char* Vb = L + 2 * KBUF + buf * VBUF;
            f32x16 s0, s1;
            bf16x8 ka[NS][2];
#pragma unroll
            for (int s = 0; s < NS; ++s) { ka[s][0] = *(const LAS bf16x8*)(Kb + r32 * KP + s * 32 + hi * 16); ka[s][1] = *(const LAS bf16x8*)(Kb + (32 + r32) * KP + s * 32 + hi * 16); }
            __builtin_amdgcn_sched_barrier(0);
#pragma unroll
            for (int s = 0; s < NS; ++s) {
                s0 = __builtin_amdgcn_mfma_f32_32x32x16_bf16(ka[s][0], qf[s], s == 0 ? negm : s0, 0, 0, 0);
                s1 = __builtin_amdgcn_mfma_f32_32x32x16_bf16(ka[s][1], qf[s], s == 0 ? negm : s1, 0, 0, 0);
            }
            s16x4 vf[4][4];
#pragma unroll
            for (int ks = 0; ks < 4; ++ks) { const LAS unsigned char* vp = Vb + ks * 16 * VP + vlane;
                vf[ks][0] = __builtin_bit_cast(s16x4, __builtin_amdgcn_ds_read_tr16_b64_v4i16((LAS s16x4*)(vp)));
                vf[ks][1] = __builtin_bit_cast(s16x4, __builtin_amdgcn_ds_read_tr16_b64_v4i16((LAS s16x4*)(vp + 8 * VP)));
                vf[ks][2] = __builtin_bit_cast(s16x4, __builtin_amdgcn_ds_read_tr16_b64_v4i16((LAS s16x4*)(vp + 64)));
                vf[ks][3] = __builtin_bit_cast(s16x4, __builtin_amdgcn_ds_read_tr16_b64_v4i16((LAS s16x4*)(vp + 8 * VP + 64))); }
            __builtin_amdgcn_sched_barrier(0);
            float mx = fmaxf(fmaxf(s0[0], s0[1]), s1[0]);
#pragma unroll
            for (int i = 2; i < 16; i += 2) mx = fmaxf(fmaxf(mx, s0[i]), s0[i + 1]);
#pragma unroll
            for (int i = 1; i < 15; i += 2) mx = fmaxf(fmaxf(mx, s1[i]), s1[i + 1]);
            mx = fmaxf(mx, s1[15]);
            mx = fmaxf(mx, __shfl_xor(mx, 32));
            if (t == 0 || __any(mx > ATT_THR)) {
                const float dl = (t == 0) ? mx : fmaxf(mx, 0.f), f = (t == 0) ? 1.f : __builtin_amdgcn_exp2f(-dl);
                mhat += dl; l *= f;
#pragma unroll
                for (int i = 0; i < 16; ++i) { s0[i] -= dl; s1[i] -= dl; o0[i] *= f; o1[i] *= f; negm[i] = -mhat; }
            }
            float rs = 0.f;
#pragma unroll
            for (int i = 0; i < 16; ++i) {
                float p0 = __builtin_amdgcn_exp2f(s0[i]), p1 = __builtin_amdgcn_exp2f(s1[i]);
                if (!MLA) { p0 = att_mask(p0, w0, crow(i, 0)); p1 = att_mask(p1, w1, crow(i, 0)); }
                s0[i] = p0; s1[i] = p1; rs += p0 + p1; }
            l += rs;
            bf16x8 pf[4];
#pragma unroll
            for (int ks = 0; ks < 4; ++ks) { v4u w;
#pragma unroll
                for (int j = 0; j < 4; ++j) { const float a = (ks < 2) ? s0[8 * (ks & 1) + 2 * j] : s1[8 * (ks & 1) + 2 * j], c = (ks < 2) ? s0[8 * (ks & 1) + 2 * j + 1] : s1[8 * (ks & 1) + 2 * j + 1]; w[j] = pk2(a, c); }
                pf[ks] = __builtin_bit_cast(bf16x8, w); }
#pragma unroll
            for (int ks = 0; ks < 4; ++ks) {
                const bf16x8 A0 = __builtin_shufflevector(vf[ks][0], vf[ks][1], 0, 1, 2, 3, 4, 5, 6, 7);
                const bf16x8 A1 = __builtin_shufflevector(vf[ks][2], vf[ks][3], 0, 1, 2, 3, 4, 5, 6, 7);
                o0 = __builtin_amdgcn_mfma_f32_32x32x16_bf16(A0, pf[ks], o0, 0, 0, 0);
                o1 = __builtin_amdgcn_mfma_f32_32x32x16_bf16(A1, pf[ks], o1, 0, 0, 0);
            }
        }
        if (t + 1 < NT) ATT_WRITE(buf ^ 1);
        __syncthreads();
    }
    l += __shfl_xor(l, 32);
    const float inv = 1.f / l;
    bf16* op = P.O + (rowb + qrow) * 512 + h * 64 + 4 * hi;
#pragma unroll
    for (int g = 0; g < 4; ++g) {
        v2u w; w.x = pk2(o0[4 * g] * inv, o0[4 * g + 1] * inv); w.y = pk2(o0[4 * g + 2] * inv, o0[4 * g + 3] * inv); *(v2u*)(op + 8 * g) = w;
        v2u z; z.x = pk2(o1[4 * g] * inv, o1[4 * g + 1] * inv); z.y = pk2(o1[4 * g + 2] * inv, o1[4 * g + 3] * inv); *(v2u*)(op + 32 + 8 * g) = z;
    }
#undef ATT_KSRC
#undef ATT_LOAD
#undef ATT_WRITE
}

namespace attn_body {
using bf16=__hip_bfloat16;
using bf16x8=__attribute__((ext_vector_type(8)))short;
using s16x4=__attribute__((ext_vector_type(4)))short;
using f32x16=__attribute__((ext_vector_type(16)))float;
using u32x4=__attribute__((ext_vector_type(4)))unsigned;
constexpr int BATCH=2,NHEAD=8,SEQ=8192,D=64,DM=NHEAD*D;
constexpr int NW=8,QBLK=32,QB=QBLK*NW,KVBLK=64,NQB=SEQ/QB;
constexpr int ATTN_PITCH=DM, ATTN_UNIT_ROWS=QB;
__device__ __forceinline__ int crow(int r,int hi){return (r&3)+8*(r>>2)+4*hi;}
#define SBAR() __builtin_amdgcn_sched_barrier(0)
__device__ __forceinline__ void cmask(f32x16&p0,f32x16&p1,int jb,int wid){
  if(jb>(wid>>1)){
    #pragma unroll
    for(int r=0;r<16;++r){p0[r]=-INFINITY;p1[r]=-INFINITY;} }
}
__device__ __forceinline__ float amask(float p,unsigned w,int bit){ int mk; asm("v_bfe_i32 %0, %1, %2, 1":"=v"(mk):"v"(w),"i"(bit)); return __builtin_bit_cast(float,__builtin_bit_cast(unsigned,p)&(unsigned)mk); }
__device__ __forceinline__ void glds16o(const void*sbase,unsigned voff,unsigned lds_dst){unsigned keep;
  asm volatile("s_mov_b32 %0, m0\n\ts_mov_b32 m0, %3\n\ts_nop 0\n\tglobal_load_lds_dwordx4 %1, %2\n\ts_mov_b32 m0, %0":"=&s"(keep):"v"(voff),"s"(sbase),"s"(lds_dst):"memory");}
__device__ __forceinline__ void glds4o(const void*sbase,unsigned voff,unsigned lds_dst){unsigned keep;
  asm volatile("s_mov_b32 %0, m0\n\ts_mov_b32 m0, %3\n\ts_nop 0\n\tglobal_load_lds_dword %1, %2\n\ts_mov_b32 m0, %0":"=&s"(keep):"v"(voff),"s"(sbase),"s"(lds_dst):"memory");}
__device__ __forceinline__ void glds4(const void*gsrc,unsigned lds_dst){unsigned keep;
  asm volatile("s_mov_b32 %0, m0\n\ts_mov_b32 m0, %2\n\ts_nop 0\n\tglobal_load_lds_dword %1, off\n\ts_mov_b32 m0, %0":"=&s"(keep):"v"(gsrc),"s"(lds_dst):"memory");}

constexpr int NSLOT=3, SLOTB=8192, KSLOTMAX=12288;
constexpr int LDS_K=0, LDS_V=NSLOT*KSLOTMAX, LDS_WS=LDS_V+NSLOT*SLOTB, LDS_OST=LDS_WS+NW*64*4, LDS_BM=LDS_OST+NW*4096, LDS_BYTES=LDS_BM+NW*512;
constexpr float C2=0.125f*1.4426950408889634f;
__device__ __forceinline__ void glds16(const void*gsrc,unsigned lds_dst){unsigned keep;
  asm volatile("s_mov_b32 %0, m0\n\ts_mov_b32 m0, %2\n\ts_nop 0\n\tglobal_load_lds_dwordx4 %1, off\n\ts_mov_b32 m0, %0":"=&s"(keep):"v"(gsrc),"s"(lds_dst):"memory");}
__device__ __forceinline__ float max3f(float a,float b,float c){float r;asm("v_max3_f32 %0, %1, %2, %3":"=v"(r):"v"(a),"v"(b),"v"(c));return r;}
__device__ __forceinline__ float max2f(float a,float b){float r;asm("v_max_f32_e32 %0, %1, %2":"=v"(r):"v"(a),"v"(b));return r;}
__device__ __forceinline__ float fadd_s(float a,float b){float r;asm("v_add_f32_e32 %0, %1, %2":"=v"(r):"v"(a),"v"(b));return r;}
__device__ __forceinline__ float fsub_s(float a,float b){float r;asm("v_sub_f32_e32 %0, %1, %2":"=v"(r):"v"(a),"v"(b));return r;}
typedef float f32x2_t __attribute__((ext_vector_type(2))); typedef __bf16 bf16x2_t __attribute__((ext_vector_type(2)));
__device__ __forceinline__ unsigned cvtpk_s(float lo,float hi){f32x2_t v={lo,hi};bf16x2_t b=__builtin_convertvector(v,bf16x2_t);return __builtin_bit_cast(unsigned,b);}
#define WAIT_BAR(N) asm volatile("s_waitcnt vmcnt(" #N ") lgkmcnt(0)\n\ts_barrier":::"memory")

template<int NKS> __device__ __forceinline__ void qkt(f32x16&p0,f32x16&p1,const char*Kslot,const bf16x8*qr,const f32x16&negm,int r32,int hi){
  const char*kb=Kslot+hi*1024+r32*16;
  #pragma unroll
  for(int d0=0;d0<NKS;++d0){
    const bf16x8 b0=*reinterpret_cast<const bf16x8*>(kb+d0*2048);
    const bf16x8 b1=*reinterpret_cast<const bf16x8*>(kb+d0*2048+512);
    if(d0==0){p0=__builtin_amdgcn_mfma_f32_32x32x16_bf16(b0,qr[0],negm,0,0,0);p1=__builtin_amdgcn_mfma_f32_32x32x16_bf16(b1,qr[0],negm,0,0,0);}
    else{p0=__builtin_amdgcn_mfma_f32_32x32x16_bf16(b0,qr[d0],p0,0,0,0);p1=__builtin_amdgcn_mfma_f32_32x32x16_bf16(b1,qr[d0],p1,0,0,0);}}
}
typedef __attribute__((address_space(3))) const char* lds_cptr;
typedef short v4i16_t __attribute__((ext_vector_type(4)));
__device__ __forceinline__ void kload8(bf16x8*kf,lds_cptr kp){
  kf[0]=*(const __attribute__((address_space(3))) bf16x8*)(kp);      kf[1]=*(const __attribute__((address_space(3))) bf16x8*)(kp+512);
  kf[2]=*(const __attribute__((address_space(3))) bf16x8*)(kp+2048); kf[3]=*(const __attribute__((address_space(3))) bf16x8*)(kp+2560);
  kf[4]=*(const __attribute__((address_space(3))) bf16x8*)(kp+4096); kf[5]=*(const __attribute__((address_space(3))) bf16x8*)(kp+4608);
  kf[6]=*(const __attribute__((address_space(3))) bf16x8*)(kp+6144); kf[7]=*(const __attribute__((address_space(3))) bf16x8*)(kp+6656);
}
__device__ __forceinline__ void kload2(bf16x8*kf,lds_cptr kp,int j){ kf[2*j]=*(const __attribute__((address_space(3))) bf16x8*)(kp+j*2048); kf[2*j+1]=*(const __attribute__((address_space(3))) bf16x8*)(kp+j*2048+512); }
__device__ __forceinline__ s16x4 vtr(lds_cptr p){ return __builtin_bit_cast(s16x4,__builtin_amdgcn_ds_read_tr16_b64_v4i16((__attribute__((address_space(3))) v4i16_t*)p)); }
__device__ __forceinline__ float rowmax(const f32x16&p0,const f32x16&p1){
  float a=max3f(p0[0],p0[1],p1[0]),b=max3f(p0[2],p0[3],p1[1]);a=max3f(a,p1[2],p1[3]);
  #pragma unroll
  for(int r=4;r<16;r+=4){a=max3f(a,p0[r],p0[r+1]);b=max3f(b,p0[r+2],p0[r+3]);a=max3f(a,p1[r],p1[r+1]);b=max3f(b,p1[r+2],p1[r+3]);}
  const float m=max2f(a,b);
  auto rr=__builtin_amdgcn_permlane32_swap(__float_as_uint(m),__float_as_uint(m),false,false);
  return max2f(__uint_as_float(rr[0]),__uint_as_float(rr[1]));
}
__device__ __forceinline__ void pv(f32x16*o,int vb,bf16x8 pa0,bf16x8 pa1,bf16x8 pa2,bf16x8 pa3){
  #pragma unroll
  for(int d0=0;d0<2;++d0){s16x4 lo[4],hi[4];
    #pragma unroll
    for(int ks=0;ks<4;++ks){
      asm volatile("ds_read_b64_tr_b16 %0,%1 offset:%c2":"=&v"(lo[ks]):"v"(vb),"i"(d0*4096+ks*1024):"memory");
      asm volatile("ds_read_b64_tr_b16 %0,%1 offset:%c2":"=&v"(hi[ks]):"v"(vb),"i"(d0*4096+ks*1024+512):"memory");}
    asm volatile("s_waitcnt lgkmcnt(0)":::"memory");SBAR();
    #define PK(k) (bf16x8){lo[k][0],lo[k][1],lo[k][2],lo[k][3],hi[k][0],hi[k][1],hi[k][2],hi[k][3]}
    o[d0]=__builtin_amdgcn_mfma_f32_32x32x16_bf16(pa0,PK(0),o[d0],0,0,0);
    o[d0]=__builtin_amdgcn_mfma_f32_32x32x16_bf16(pa1,PK(1),o[d0],0,0,0);
    o[d0]=__builtin_amdgcn_mfma_f32_32x32x16_bf16(pa2,PK(2),o[d0],0,0,0);
    o[d0]=__builtin_amdgcn_mfma_f32_32x32x16_bf16(pa3,PK(3),o[d0],0,0,0);
    #undef PK
  }
}

#ifndef ATTN_STORE16
#define ATTN_STORE16(p,v) (*(u32x4*)(p)=(v))
#endif
template<int THRL,bool MLA> __device__ __forceinline__ void attn_unit(int b,int h,int qb,const bf16*Q,const bf16*__restrict__ K,const bf16*__restrict__ K2,const bf16*__restrict__ V,bf16*O,const unsigned*BMg,char*shm,int tid){
  constexpr int NKS=MLA?6:4, QP=MLA?768:512, DQ=MLA?96:64;
  const int lane=tid&63,r32=lane&31,hi=lane>>5; const int wid=__builtin_amdgcn_readfirstlane(tid>>6);
  const long rowbase=(long)b*SEQ; const int q0=qb*QB;
  const bf16*Qw=Q+(rowbase+q0+wid*QBLK)*QP+h*DQ;
  const bf16*Kh=K+rowbase*DM+h*D,*Vh=V+rowbase*DM+h*D;
  const unsigned lds0=(unsigned)(uintptr_t)shm;
  float*wsf=(float*)(shm+LDS_WS)+wid*64;
  const unsigned koff=(unsigned)(lane*DM+wid*8)*2u;
  const unsigned voff=(unsigned)((16*(wid&3)+(lane>>2))*DM+(wid>>2)*32+(lane&3)*8)*2u;
  const unsigned kdst=lds0+LDS_K+wid*1024, vdst=lds0+LDS_V+wid*1024;
  const bf16*K2h=MLA?K2+rowbase*32:nullptr; const unsigned koff2=(unsigned)(lane*32+(wid&3)*8)*2u; const unsigned kdst2=lds0+LDS_K+(8+(wid&3))*1024;
  #define KO(sl) (MLA?(sl)+((sl)>>1):(sl))
  #define DMA_K(t,slot) do{ glds16o(Kh+(long)(t)*KVBLK*DM,koff,(unsigned)__builtin_amdgcn_readfirstlane(kdst+KO(slot))); \
    if constexpr(MLA) glds16o(K2h+(long)(t)*KVBLK*32,koff2,(unsigned)__builtin_amdgcn_readfirstlane(kdst2+KO(slot))); }while(0)
  #define DMA_V(t,slot) glds16o(Vh+(long)(t)*KVBLK*DM,voff,(unsigned)__builtin_amdgcn_readfirstlane(vdst+(slot)))
  const unsigned*BMb=BMg+(long)b*256*SEQ+q0+wid*QBLK; const unsigned bmoff=(unsigned)(hi*SEQ+r32)*4u; const unsigned bmdst=lds0+LDS_BM+wid*512;
  const __attribute__((address_space(3))) unsigned*bmw=(const __attribute__((address_space(3))) unsigned*)((lds_cptr)shm+LDS_BM+wid*512);
  #define DMA_BM(t) if constexpr(!MLA) glds4o(BMb+(long)(t)*2*SEQ,bmoff,(unsigned)__builtin_amdgcn_readfirstlane(bmdst+((t)&1)*256))
  #define VMW(N) asm volatile("s_waitcnt vmcnt(" #N ")":::"memory")
  #define BMWAIT(t) do{ if constexpr(!MLA){ if((t)+3<NT){VMW(5);} else if((t)+2<NT){VMW(4);} else if((t)+1<NT){VMW(3);} else {VMW(1);} } }while(0)
  const int vb0=(int)(lds0+LDS_V)+((lane>>4)&1)*32+(lane&3)*8+(4*hi+((lane&15)>>2))*64;
  const char*Kbase=shm+LDS_K; bf16x8 kf[2*NKS];
  const lds_cptr shm3=(lds_cptr)shm; const lds_cptr kp0=shm3+LDS_K+hi*1024+r32*16; const lds_cptr vp0=shm3+LDS_V+((lane>>4)&1)*32+(lane&3)*8+(4*hi+((lane&15)>>2))*64;
  const int NT=(q0+QB)/KVBLK;
  DMA_BM(0);DMA_K(0,0);DMA_V(0,0);DMA_K(1,SLOTB);
  bf16x8 qr[NKS];
  #pragma unroll
  for(int d0=0;d0<NKS;++d0)qr[d0]=*reinterpret_cast<const bf16x8*>(&Qw[(long)r32*QP+d0*16+hi*8]);
  float mhat=0.f,l_reg=0.f;f32x16 o[2];o[0]=f32x16{};o[1]=f32x16{};f32x16 negm=f32x16{};asm volatile("":"+v"(negm));
  const int qrel=wid*QBLK+r32;
  #define CMASK(P0,P1,t) do{int jb_=(t)-(NT-4); if(jb_>=0)cmask(P0,P1,jb_,wid);}while(0)
  bool resc=false;
  #define START(P0,P1) do{ const float rm=rowmax(P0,P1); resc=false; \
    { const float dl=rm; mhat=fadd_s(mhat,dl); \
      _Pragma("unroll") for(int r=0;r<16;++r){P0[r]=fsub_s(P0[r],dl);P1[r]=fsub_s(P1[r],dl);} \
      _Pragma("unroll") for(int r=0;r<16;++r)negm[r]=-mhat; asm volatile("":"+v"(negm)); } \
    _Pragma("unroll") for(int r=0;r<16;++r)P0[r]=__builtin_amdgcn_exp2f(P0[r]); }while(0)
  #define RESC() do{ if(resc){ asm volatile("s_waitcnt lgkmcnt(0)":::"memory"); \
      _Pragma("unroll") for(int d_=0;d_<2;++d_) _Pragma("unroll") for(int r=0;r<16;++r)o[d_][r]*=wsf[crow(r,hi)]; } }while(0)
  f32x16 pA0,pA1,pB0,pB1;
  int sl_prev=0,sl_cur=0,sl_next=SLOTB;
  #define ROT() do{sl_prev=sl_cur;sl_cur=sl_next;sl_next=(sl_next==(NSLOT-1)*SLOTB)?0:sl_next+SLOTB;}while(0)
  DMA_K(2,2*SLOTB);
  if constexpr(MLA){WAIT_BAR(5);}else{WAIT_BAR(3);}
  qkt<NKS>(pA0,pA1,Kbase,qr,negm,r32,hi);asm volatile("s_nop 15\n\ts_nop 7":"+v"(pA0),"+v"(pA1));CMASK(pA0,pA1,0);
  START(pA0,pA1);
  _Pragma("unroll") for(int r=0;r<16;++r)pA1[r]=__builtin_amdgcn_exp2f(pA1[r]);
  if constexpr(!MLA){ const unsigned w0_=bmw[r32]>>(4*hi), w1_=bmw[32+r32]>>(4*hi);
    _Pragma("unroll") for(int r=0;r<16;++r){pA0[r]=amask(pA0[r],w0_,(r&3)+8*(r>>2));pA1[r]=amask(pA1[r],w1_,(r&3)+8*(r>>2));} }
  WAIT_BAR(0);
  DMA_BM(1);DMA_K(3,0);DMA_V(1,SLOTB);
  ROT();
  _Pragma("unroll") for(int j=0;j<NKS;++j)kload2(kf,kp0+KO(sl_cur),j);
  WAIT_BAR(3);
  s16x4 vlo[8],vhi[8]; u32x4 pw0,pw1,pw2,pw3;
  #define PKW(P,B) cvtpk_s(P[B],P[B+1])
  #define PAF(k) __builtin_bit_cast(bf16x8,pw##k)
  #define VFR(i) (bf16x8){vlo[i][0],vlo[i][1],vlo[i][2],vlo[i][3],vhi[i][0],vhi[i][1],vhi[i][2],vhi[i][3]}
  #define PIN(x) asm volatile("":"+v"(x))
  #define MX3(a,b,c) __builtin_fmaxf(__builtin_fmaxf((a),(b)),(c))
  #define GAPA(MF,A0,A1,A2,A3,W0,W1,PW) do{ MF; sacc+=A0; sacc+=A1; sacc+=A2; sacc+=A3; PIN(sacc); W0; W1; PIN(PW); SBAR(); }while(0)
  #define EX(v) __builtin_amdgcn_exp2f(v)
  #define CR_(r) (((r)&3)+8*((r)>>2))
  #define GAPB(MF,X,B,W) do{ MF; X[B]=EX(X[B]); X[B+1]=EX(X[B+1]); X[B+2]=EX(X[B+2]); X[B+3]=EX(X[B+3]); \
    if constexpr(!MLA){ X[B]=amask(X[B],W,CR_(B)); X[B+1]=amask(X[B+1],W,CR_(B+1)); X[B+2]=amask(X[B+2],W,CR_(B+2)); X[B+3]=amask(X[B+3],W,CR_(B+3)); } PIN(X); SBAR(); }while(0)
  #define VRD(i) do{ vlo[i]=vtr(vp_+(((i)>>2)*4096+((i)&3)*1024)); vhi[i]=vtr(vp_+(((i)>>2)*4096+((i)&3)*1024+512)); }while(0)
  #define KRD(G,j) do{ if((j)<NKS){ if(G){ kload2(kf,kp0+KO(sl_next),j); SBAR(); } } }while(0)
  #define STEP(C0,C1,P0,P1,t,GK,GV,GL) do{ SBAR(); \
    const lds_cptr vp_=vp0+sl_prev; \
    VRD(0); SBAR(); float sacc=(P0[0]+P0[1]); \
    GAPA(C0=__builtin_amdgcn_mfma_f32_32x32x16_bf16(kf[0],qr[0],negm,0,0,0), P0[2],P0[3],P0[4],P0[5],     pw0[0]=PKW(P0,0), pw0[1]=PKW(P0,2), pw0); \
    VRD(4); SBAR(); GAPA(C1=__builtin_amdgcn_mfma_f32_32x32x16_bf16(kf[1],qr[0],negm,0,0,0), P0[6],P0[7],P0[8],P0[9],     pw0[2]=PKW(P0,4), pw0[3]=PKW(P0,6), pw0); \
    VRD(1); SBAR(); GAPA(C0=__builtin_amdgcn_mfma_f32_32x32x16_bf16(kf[2],qr[1],C0,0,0,0),   P0[10],P0[11],P0[12],P0[13], pw1[0]=PKW(P0,8), pw1[1]=PKW(P0,10), pw1); \
    VRD(5); SBAR(); GAPA(C1=__builtin_amdgcn_mfma_f32_32x32x16_bf16(kf[3],qr[1],C1,0,0,0),   P0[14],P0[15],P1[0],P1[1],   pw1[2]=PKW(P0,12),pw1[3]=PKW(P0,14), pw1); \
    VRD(2); SBAR(); GAPA(C0=__builtin_amdgcn_mfma_f32_32x32x16_bf16(kf[4],qr[2],C0,0,0,0),   P1[2],P1[3],P1[4],P1[5],     pw2[0]=PKW(P1,0), pw2[1]=PKW(P1,2), pw2); \
    VRD(6); SBAR(); GAPA(C1=__builtin_amdgcn_mfma_f32_32x32x16_bf16(kf[5],qr[2],C1,0,0,0),   P1[6],P1[7],P1[8],P1[9],     pw2[2]=PKW(P1,4), pw2[3]=PKW(P1,6), pw2); \
    VRD(3); SBAR(); GAPA(C0=__builtin_amdgcn_mfma_f32_32x32x16_bf16(kf[6],qr[3],C0,0,0,0),   P1[10],P1[11],P1[12],P1[13], pw3[0]=PKW(P1,8), pw3[1]=PKW(P1,10), pw3); \
    VRD(7); SBAR(); GAPA(C1=__builtin_amdgcn_mfma_f32_32x32x16_bf16(kf[7],qr[3],C1,0,0,0),   P1[14],P1[15],0.f,0.f,       pw3[2]=PKW(P1,12),pw3[3]=PKW(P1,14), pw3); \
    if constexpr(MLA){ C0=__builtin_amdgcn_mfma_f32_32x32x16_bf16(kf[8],qr[4],C0,0,0,0); C1=__builtin_amdgcn_mfma_f32_32x32x16_bf16(kf[9],qr[4],C1,0,0,0); \
      C0=__builtin_amdgcn_mfma_f32_32x32x16_bf16(kf[10],qr[5],C0,0,0,0); C1=__builtin_amdgcn_mfma_f32_32x32x16_bf16(kf[11],qr[5],C1,0,0,0); SBAR(); } \
    l_reg+=sacc; \
    if(GV){DMA_BM((t)+1);} if(GK){DMA_K((t)+3,sl_cur);} if(GV){DMA_V((t)+1,sl_next);} \
    CMASK(C0,C1,t); \
    { float a=MX3(C0[0],C0[1],C1[0]),b=MX3(C0[2],C0[3],C1[1]); a=MX3(a,C1[2],C1[3]); \
      _Pragma("unroll") for(int r=4;r<16;r+=4){a=MX3(a,C0[r],C0[r+1]);b=MX3(b,C0[r+2],C0[r+3]);a=MX3(a,C1[r],C1[r+1]);b=MX3(b,C1[r+2],C1[r+3]);} \
      float rm=__builtin_fmaxf(a,b); { auto rr=__builtin_amdgcn_permlane32_swap(__float_as_uint(rm),__float_as_uint(rm),false,false); rm=__builtin_fmaxf(__uint_as_float(rr[0]),__uint_as_float(rr[1])); } \
      resc=false; \
      if(__builtin_expect(__any(rm>(float)THRL),0)){ const float dl=__builtin_fmaxf(rm,0.f); mhat+=dl; \
        _Pragma("unroll") for(int r=0;r<16;++r){C0[r]-=dl;C1[r]-=dl;} \
        _Pragma("unroll") for(int r=0;r<16;++r)negm[r]=-mhat; asm volatile("":"+v"(negm)); \
        const float f=__builtin_amdgcn_exp2f(-dl); l_reg*=f; if(hi==0)wsf[r32]=f; resc=true; } } \
    BMWAIT(t); unsigned w0_=0u, w1_=0u; if constexpr(!MLA){ w0_=bmw[((t)&1)*64+r32]>>(4*hi); w1_=bmw[((t)&1)*64+32+r32]>>(4*hi); } \
    SBAR(); \
    GAPB(o[0]=__builtin_amdgcn_mfma_f32_32x32x16_bf16(PAF(0),VFR(0),o[0],0,0,0), C0,0,w0_); \
    KRD(GL,4); GAPB(o[1]=__builtin_amdgcn_mfma_f32_32x32x16_bf16(PAF(0),VFR(4),o[1],0,0,0), C0,4,w0_); \
    KRD(GL,0); GAPB(o[0]=__builtin_amdgcn_mfma_f32_32x32x16_bf16(PAF(1),VFR(1),o[0],0,0,0), C0,8,w0_); \
    KRD(GL,1); GAPB(o[1]=__builtin_amdgcn_mfma_f32_32x32x16_bf16(PAF(1),VFR(5),o[1],0,0,0), C0,12,w0_); \
    KRD(GL,2); GAPB(o[0]=__builtin_amdgcn_mfma_f32_32x32x16_bf16(PAF(2),VFR(2),o[0],0,0,0), C1,0,w1_); \
    KRD(GL,3); GAPB(o[1]=__builtin_amdgcn_mfma_f32_32x32x16_bf16(PAF(2),VFR(6),o[1],0,0,0), C1,4,w1_); \
    KRD(GL,5); GAPB(o[0]=__builtin_amdgcn_mfma_f32_32x32x16_bf16(PAF(3),VFR(3),o[0],0,0,0), C1,8,w1_); \
    GAPB(o[1]=__builtin_amdgcn_mfma_f32_32x32x16_bf16(PAF(3),VFR(7),o[1],0,0,0), C1,12,w1_); \
    }while(0)
  int t=1;
  #undef CMASK
  #define CMASK(P0,P1,t) do{}while(0)
  for(;t+5<NT;t+=2){
    STEP(pB0,pB1,pA0,pA1,t,true,true,true);     WAIT_BAR(3); RESC(); ROT();
    STEP(pA0,pA1,pB0,pB1,t+1,true,true,true);   WAIT_BAR(3); RESC(); ROT();
  }
  #undef CMASK
  #define CMASK(P0,P1,t) do{int jb_=(t)-(NT-4); if(jb_>=0)cmask(P0,P1,jb_,wid);}while(0)
  #define ENDW(tt) do{ if((tt)+3<NT){WAIT_BAR(3);} else if((tt)+2<NT){ if constexpr(MLA){WAIT_BAR(1);}else{WAIT_BAR(2);} } else {WAIT_BAR(0);} }while(0)
  for(;t+1<NT;t+=2){
    STEP(pB0,pB1,pA0,pA1,t,(t+3<NT),(t+1<NT),(t+1<NT));       ENDW(t);   RESC(); ROT();
    STEP(pA0,pA1,pB0,pB1,t+1,(t+4<NT),(t+2<NT),(t+2<NT));     ENDW(t+1); RESC(); ROT();
  }
  STEP(pB0,pB1,pA0,pA1,NT-1,false,false,false); RESC();
  { float sacc=pB0[0]+pB0[1]; _Pragma("unroll") for(int r=2;r<16;++r)sacc+=pB0[r]; _Pragma("unroll") for(int r=0;r<16;++r)sacc+=pB1[r]; l_reg+=sacc;
    pw0=(u32x4){PKW(pB0,0),PKW(pB0,2),PKW(pB0,4),PKW(pB0,6)};pw1=(u32x4){PKW(pB0,8),PKW(pB0,10),PKW(pB0,12),PKW(pB0,14)};pw2=(u32x4){PKW(pB1,0),PKW(pB1,2),PKW(pB1,4),PKW(pB1,6)};pw3=(u32x4){PKW(pB1,8),PKW(pB1,10),PKW(pB1,12),PKW(pB1,14)};
    SBAR(); pv(o,vb0+sl_cur,PAF(0),PAF(1),PAF(2),PAF(3)); }
  #undef PKW
  #undef PAF
  #undef VFR
  #undef PIN
  #undef MX3
  #undef GAPA
  #undef GAPB
  #undef EX
  #undef VRD
  #undef KRD
  #undef STEP
  #undef ENDW
  {auto rr=__builtin_amdgcn_permlane32_swap(__float_as_uint(l_reg),__float_as_uint(l_reg),false,false);l_reg=__uint_as_float(rr[0])+__uint_as_float(rr[1]);}
  if(hi==0)wsf[32+r32]=l_reg;asm volatile("s_waitcnt lgkmcnt(0)":::"memory");
  float rli[16];
  #pragma unroll
  for(int r=0;r<16;++r)rli[r]=__builtin_amdgcn_rcpf(wsf[32+crow(r,hi)]);
  bf16*Ow=O+(rowbase+q0+wid*QBLK)*DM+h*D;
  { bf16*stg=(bf16*)(shm+LDS_OST)+wid*2048;
    #pragma unroll
    for(int r=0;r<16;++r){const int orow=crow(r,hi);
      #pragma unroll
      for(int d0=0;d0<2;++d0)stg[orow*64+d0*32+r32]=__float2bfloat16(o[d0][r]*rli[r]);}
    asm volatile("s_waitcnt lgkmcnt(0)":::"memory");
    #pragma unroll
    for(int i=0;i<4;++i){const int row=i*8+(lane>>3),ch=lane&7; const u32x4 v=*(const u32x4*)(stg+row*64+ch*8); ATTN_STORE16(Ow+(long)row*DM+ch*8,v);} }
  asm volatile("s_waitcnt lgkmcnt(0)\n\ts_barrier":::"memory");
  #undef DMA_K
  #undef DMA_BM
  #undef KO
  #undef VMW
  #undef BMWAIT
  #undef CR_
  #undef DMA_V
  #undef CMASK
  #undef START
  #undef RESC
  #undef ROT
}
#undef SBAR
#undef WAIT_BAR
}
__device__ __forceinline__ unsigned row16_sum(unsigned x) {
    x += (unsigned)__builtin_amdgcn_update_dpp(0, (int)x, 0x128, 0xf, 0xf, false); x += (unsigned)__builtin_amdgcn_update_dpp(0, (int)x, 0x124, 0xf, 0xf, false);
    x += (unsigned)__builtin_amdgcn_update_dpp(0, (int)x, 0x122, 0xf, 0xf, false); x += (unsigned)__builtin_amdgcn_update_dpp(0, (int)x, 0x121, 0xf, 0xf, false); return x; }
__device__ __forceinline__ float row16_sumf(float x) {
    x += __builtin_bit_cast(float, __builtin_amdgcn_update_dpp(0, __builtin_bit_cast(int, x), 0x128, 0xf, 0xf, false)); x += __builtin_bit_cast(float, __builtin_amdgcn_update_dpp(0, __builtin_bit_cast(int, x), 0x124, 0xf, 0xf, false));
    x += __builtin_bit_cast(float, __builtin_amdgcn_update_dpp(0, __builtin_bit_cast(int, x), 0x122, 0xf, 0xf, false)); x += __builtin_bit_cast(float, __builtin_amdgcn_update_dpp(0, __builtin_bit_cast(int, x), 0x121, 0xf, 0xf, false)); return x; }
__device__ __forceinline__ unsigned row16_suffix(unsigned x) {
    x += (unsigned)__builtin_amdgcn_update_dpp(0, (int)x, 0x101, 0xf, 0xf, false); x += (unsigned)__builtin_amdgcn_update_dpp(0, (int)x, 0x102, 0xf, 0xf, false);
    x += (unsigned)__builtin_amdgcn_update_dpp(0, (int)x, 0x104, 0xf, 0xf, false); x += (unsigned)__builtin_amdgcn_update_dpp(0, (int)x, 0x108, 0xf, 0xf, false); return x; }
__device__ __forceinline__ unsigned half_or(unsigned x) { const auto rr = __builtin_amdgcn_permlane32_swap(x, x, false, false); return rr[0] | rr[1]; }
constexpr int CAND_CAP = 128, QIP = 1296, HS = 513, FAST_CAP = 512;
struct IdxP { const bf16 *QI, *KI; const float* WI; unsigned* BM; unsigned* dbg; };
__device__ __forceinline__ unsigned mono_key(float s) { const unsigned u = __builtin_bit_cast(unsigned, s + 0.0f); return u ^ ((unsigned)((int)u >> 31) | 0x80000000u); }
__device__ __forceinline__ void idx_scores2(const bf16x8 (&kf)[2][4], const LAS unsigned char* qlane, const float (&wq)[8], f32x16& sc0, f32x16& sc1) {
    bf16x8 qv[4], qn[4];
#pragma unroll
    for (int s = 0; s < 4; ++s) qv[s] = *(const LAS bf16x8*)(qlane + 8 * 128 + s * 32);
#pragma unroll
    for (int i = 0; i < 16; ++i) { sc0[i] = 0.f; sc1[i] = 0.f; }
    f32x16 ap0, ap1;
#pragma unroll
    for (int i = 0; i < 16; ++i) { ap0[i] = 0.f; ap1[i] = 0.f; }
#pragma unroll
    for (int n = 0; n < 10; ++n) {
        const int nh = (n + 1 < 2) ? 9 : (n + 1 - 2);
        if (n + 1 < 10) {
#pragma unroll
            for (int s = 0; s < 4; ++s) qn[s] = *(const LAS bf16x8*)(qlane + nh * 128 + s * 32); }
        f32x16 a0, a1;
        if (n < 2) {
#pragma unroll
            for (int s = 0; s < 4; ++s) { sc0 = __builtin_amdgcn_mfma_f32_32x32x16_bf16(kf[0][s], qv[s], sc0, 0, 0, 0); sc1 = __builtin_amdgcn_mfma_f32_32x32x16_bf16(kf[1][s], qv[s], sc1, 0, 0, 0); }
        } else {
#pragma unroll
            for (int i = 0; i < 16; ++i) { a0[i] = 0.f; a1[i] = 0.f; }
#pragma unroll
            for (int s = 0; s < 4; ++s) { a0 = __builtin_amdgcn_mfma_f32_32x32x16_bf16(kf[0][s], qv[s], a0, 0, 0, 0); a1 = __builtin_amdgcn_mfma_f32_32x32x16_bf16(kf[1][s], qv[s], a1, 0, 0, 0); }
        }
        if (n >= 3) {
            const float w = wq[n - 3];
#pragma unroll
            for (int i = 0; i < 16; ++i) { sc0[i] = __builtin_fmaf(w, __builtin_fabsf(ap0[i]), sc0[i]); sc1[i] = __builtin_fmaf(w, __builtin_fabsf(ap1[i]), sc1[i]); }
#pragma unroll
            for (int g = 0; g < 8; ++g) { __builtin_amdgcn_sched_group_barrier(0x008, 1, 0); __builtin_amdgcn_sched_group_barrier(0x002, 4, 0); }
        }
        if (n >= 2) { ap0 = a0; ap1 = a1; }
#pragma unroll
        for (int s = 0; s < 4; ++s) qv[s] = qn[s];
    }
    { const float w = wq[7];
#pragma unroll
      for (int i = 0; i < 16; ++i) { sc0[i] = __builtin_fmaf(w, __builtin_fabsf(ap0[i]), sc0[i]); sc1[i] = __builtin_fmaf(w, __builtin_fabsf(ap1[i]), sc1[i]); } }
#pragma unroll
    for (int i = 0; i < 16; ++i) asm volatile("" : "+v"(sc0[i]), "+v"(sc1[i]));
}
__device__ __forceinline__ void idx_item(LAS unsigned char* L, int b, int j, const IdxP& P, int tid, int lane, int wave) {
    LAS unsigned* hist = (LAS unsigned*)L;
    LAS unsigned* img = (LAS unsigned*)(L + 66048);
    LAS unsigned* st = (LAS unsigned*)(L + 98816);
    LAS unsigned* cand = hist;
    LAS unsigned char* Qs = L + 100864;
    const int r32 = lane & 31, hi = lane >> 5;
    const int q0 = 32 * j, ntile = 2 * (j / 2 + 1);
    const size_t rowb = (size_t)b * SEQ;
    if (ntile <= 8) {
        for (int idx = tid; idx < ntile * 32; idx += NTHR) P.BM[((size_t)b * 256 + (idx >> 5)) * SEQ + q0 + (idx & 31)] = 0xffffffffu;
        return;
    }
    const int npair = ntile >> 1, nsw = (npair + 63) >> 6, SP = min(npair, 8 * nsw);
    bf16x8 ksmp[2][4];
#ifdef SMP_PREFETCH
    if (wave < SP) { const bf16* kp = P.KI + (rowb + 64 * ((wave * npair) / SP) + r32) * 64 + 8 * hi;
#pragma unroll
        for (int s = 0; s < 4; ++s) { ksmp[0][s] = *(const bf16x8*)(kp + 16 * s); ksmp[1][s] = *(const bf16x8*)(kp + 32 * 64 + 16 * s); } }
#endif
    float wq[8];
    { for (int c = tid; c < 32 * 64; c += NTHR) { const int rr = c >> 6, ch = c & 63; *(LAS v4u*)(Qs + rr * QIP + ch * 16) = *(const v4u*)(P.QI + (rowb + q0 + rr) * 512 + ch * 8); }
      const float* wp = P.WI + (rowb + q0 + r32) * 8;
#pragma unroll
      for (int h = 0; h < 8; ++h) wq[h] = 0.5f * wp[h]; }
    if (tid < 32) { st[32 + tid] = 256u; st[64 + tid] = 0u; st[96 + tid] = 0u; }
    if (tid == 0) st[129] = 0u;
    __syncthreads();
    {
        const int r = tid >> 4, part = tid & 15;
        const float* wp = P.WI + (rowb + q0 + r) * 8;
        float qb[4] = {0.f, 0.f, 0.f, 0.f}; float rsum = 0.f;
#pragma unroll
        for (int h = 0; h < 8; ++h) { const float w = wp[h]; const v2u raw = *(const LAS v2u*)(Qs + r * QIP + h * 128 + part * 8);
            const float f0 = bflo(raw.x), f1 = bfhi(raw.x), f2 = bflo(raw.y), f3 = bfhi(raw.y);
            float nsq = (f0 * f0 + f1 * f1) + (f2 * f2 + f3 * f3);
            nsq = row16_sumf(nsq);
            rsum += fabsf(w) * sqrtf(nsq);
            qb[0] += 0.5f * w * f0; qb[1] += 0.5f * w * f1; qb[2] += 0.5f * w * f2; qb[3] += 0.5f * w * f3; }
        v2u hw, lw;
        { const unsigned h01 = pk2(qb[0], qb[1]), h23 = pk2(qb[2], qb[3]); hw.x = h01; hw.y = h23;
          lw.x = pk2(qb[0] - bflo(h01), qb[1] - bfhi(h01)); lw.y = pk2(qb[2] - bflo(h23), qb[3] - bfhi(h23)); }
        *(LAS v2u*)(Qs + r * QIP + 8 * 128 + part * 8) = hw; *(LAS v2u*)(Qs + r * QIP + 9 * 128 + part * 8) = lw;
        { const v2u kw = *(const v2u*)(P.KI + (rowb + r) * 64 + part * 4); const float f0 = bflo(kw.x), f1 = bfhi(kw.x), f2 = bflo(kw.y), f3 = bfhi(kw.y);
          float ksq = (f0 * f0 + f1 * f1) + (f2 * f2 + f3 * f3);
          ksq = row16_sumf(ksq);
          if (part == 0) { __hip_atomic_fetch_max(&st[129], __builtin_bit_cast(unsigned, ksq), __ATOMIC_RELAXED, __HIP_MEMORY_SCOPE_WORKGROUP); st[224 + r] = __builtin_bit_cast(unsigned, rsum); } }
    }
    __syncthreads();
    if (tid < 32) { const float R = 0.25f * sqrtf(__builtin_bit_cast(float, st[129])) * __builtin_bit_cast(float, st[224 + tid]);
        const float C = 0.125f * R;
        st[160 + tid] = (0x80000000u | __builtin_bit_cast(unsigned, R + C)) - 511u * 131072u; st[224 + tid] = __builtin_bit_cast(unsigned, C); st[tid] = 0u; st[192 + tid] = 0u;
        st[256 + tid] = __builtin_bit_cast(unsigned, R); st[288 + tid] = 511u; st[320 + tid] = 0u; }
    const LAS unsigned char* qlane = Qs + r32 * QIP + hi * 16;
    int level = 0;
#define IDX_KLOAD2(tp) { const bf16* kp = P.KI + (rowb + 64 * (tp) + r32) * 64 + 8 * hi; _Pragma("unroll") for (int s = 0; s < 4; ++s) { kn[0][s] = *(const bf16x8*)(kp + 16 * s); kn[1][s] = *(const bf16x8*)(kp + 32 * 64 + 16 * s); } }
#define IDX_SCORES2(tp) \
        bf16x8 kf[2][4]; _Pragma("unroll") for (int s = 0; s < 4; ++s) { kf[0][s] = kn[0][s]; kf[1][s] = kn[1][s]; } \
        f32x16 sc0, sc1; idx_scores2(kf, qlane, wq, sc0, sc1); \
        if ((tp) + NWAVES < npair) { IDX_KLOAD2((tp) + NWAVES) }
    bool slow;
    {
        for (int u = tid; u < 32 * HS; u += NTHR) hist[u] = 0u;
        if (tid == 0) st[130] = 0u;
        __syncthreads();
        const float Rq = __builtin_bit_cast(float, st[256 + r32]);
        {   const float s1 = 256.f / Rq; LAS unsigned* hrow = hist + r32 * HS;
            for (int i = wave; i < SP; i += NWAVES) { const int tp = (i * npair) / SP;
#ifdef SMP_PREFETCH
                bf16x8 kn[2][4]; if (i >= NWAVES) { IDX_KLOAD2(tp) }
#else
                bf16x8 kn[2][4]; IDX_KLOAD2(tp)
#endif
                bf16x8 kf[2][4];
#pragma unroll
#ifdef SMP_PREFETCH
                for (int s = 0; s < 4; ++s) { kf[0][s] = (i < NWAVES) ? ksmp[0][s] : kn[0][s]; kf[1][s] = (i < NWAVES) ? ksmp[1][s] : kn[1][s]; }
#else
                for (int s = 0; s < 4; ++s) { kf[0][s] = kn[0][s]; kf[1][s] = kn[1][s]; }
#endif
                f32x16 sc0, sc1; idx_scores2(kf, qlane, wq, sc0, sc1);
#pragma unroll
                for (int e = 0; e < 16; ++e) { const int b0 = min(max((int)__builtin_fmaf(sc0[e], s1, 256.f), 0), 511), b1 = min(max((int)__builtin_fmaf(sc1[e], s1, 256.f), 0), 511);
                    __hip_atomic_fetch_add(&hrow[b0], 1u, __ATOMIC_RELAXED, __HIP_MEMORY_SCOPE_WORKGROUP); __hip_atomic_fetch_add(&hrow[b1], 1u, __ATOMIC_RELAXED, __HIP_MEMORY_SCOPE_WORKGROUP); }
            }
        }
        __syncthreads();
        {
            const int q = tid >> 4, seg = tid & 15; const LAS unsigned* hq = hist + q * HS + seg * 32;
            unsigned segsum = 0u;
            for (int wi = 0; wi < 32; ++wi) segsum += hq[wi];
            unsigned S = segsum;
            S = row16_suffix(S);
            const unsigned above = S - segsum, total = row16_sum(segsum);
            const float f = (float)total / (float)(64 * npair), rs = 256.f * f, sg = 3.5f * sqrtf(rs * (1.f - f));
            const int rl = (int)floorf(rs - sg) - 1, rh = (int)ceilf(rs + sg) + 1;
            const unsigned tl = rl > 0 ? (unsigned)rl : 0u, th = (unsigned)rh;
            if (above < tl && tl <= above + segsum) { unsigned cum = above; int fb = 0; bool found = false;
                for (int wi = 31; wi >= 0; --wi) { const unsigned c = hq[wi]; if (!found && cum + c >= tl) { found = true; fb = wi; } if (!found) cum += c; }
                st[288 + q] = (unsigned)(32 * seg + fb); }
            if (above < th && th <= above + segsum) { unsigned cum = above; int fb = 0; bool found = false;
                for (int wi = 31; wi >= 0; --wi) { const unsigned c = hq[wi]; if (!found && cum + c >= th) { found = true; fb = wi; } if (!found) cum += c; }
                st[320 + q] = (unsigned)(32 * seg + fb); }
        }
        __syncthreads();
#ifdef REP_PASS2
        for (int rep2 = 0; rep2 < 2; ++rep2) { if (rep2) { __syncthreads(); if (tid < 32) st[96 + tid] = 0u; __syncthreads(); }
#else
        {
#endif
            const float wbin = Rq * (1.f / 256.f), fH = __builtin_fmaf((float)(st[288 + r32] + 1u), wbin, -Rq), fA = __builtin_fmaf((float)st[320 + r32], wbin, -Rq), s2 = 524287.f / (fH - fA), nfa = -fA * s2;
            bf16x8 kn[2][4]; if (wave < npair) { IDX_KLOAD2(wave) }
            for (int tp = wave; tp < npair; tp += NWAVES) {
                IDX_SCORES2(tp)
#define IDX_FAST_ELEMS(SC, T) { unsigned v = 0u, cm = 0u; \
            _Pragma("unroll") for (int i = 15; i >= 0; --i) { v = __builtin_amdgcn_alignbit(v, __builtin_bit_cast(unsigned, SC[i] - fH), 31);        \
                                                              cm = __builtin_amdgcn_alignbit(cm, __builtin_bit_cast(unsigned, SC[i] - fA), 31); } \
            cm = v & ~cm & 0xffffu; v = ~v & 0xffffu;                                                           \
            if (cm) { const unsigned pos0 = __hip_atomic_fetch_add(&st[96 + r32], (unsigned)__builtin_popcount(cm), __ATOMIC_RELAXED, __HIP_MEMORY_SCOPE_WORKGROUP);     \
                const unsigned rb = 8191u - (unsigned)(32 * (T)) - hi4; \
                _Pragma("unroll") for (int i = 0; i < 16; ++i) if (cm & (1u << i)) { const unsigned pos = min(pos0 + (unsigned)__builtin_popcount(cm & ((1u << i) - 1u)), (unsigned)FAST_CAP - 1u); \
                    cand[r32 * FAST_CAP + pos] = (min((unsigned)__builtin_fmaf(SC[i], s2, nfa), 524287u) << 13) | (rb - (unsigned)((i & 3) + 8 * (i >> 2))); } } \
            unsigned bits = (v & 0xfu) | ((v & 0xf0u) << 4) | ((v & 0xf00u) << 8) | ((v & 0xf000u) << 12);     \
            bits <<= 4 * hi; bits = half_or(bits); if (hi == 0) img[(T) * 32 + r32] = bits; }
                unsigned hi4 = 4u * (unsigned)hi; asm volatile("" : "+v"(hi4));
                IDX_FAST_ELEMS(sc0, 2 * tp)
                IDX_FAST_ELEMS(sc1, 2 * tp + 1)
#undef IDX_FAST_ELEMS
            }
        }
        __syncthreads();
        {
            const int q = tid >> 4, l16 = tid & 15; unsigned above = 0u;
            for (int t = l16; t < ntile; t += 16) above += (unsigned)__builtin_popcount(img[t * 32 + q]);
            above = row16_sum(above);
            const unsigned n = st[96 + q];
            if (l16 == 0) { if (above >= 256u || 256u - above > n || n > (unsigned)FAST_CAP) st[130] = 1u; st[32 + q] = 256u - above; }
        }
        __syncthreads();
        slow = st[130] != 0u;
#ifdef REP_SEL
        for (int rep3 = 0; rep3 < 2; ++rep3)
#endif
        if (!slow) {
            const int q = tid >> 4, l16 = tid & 15; const unsigned n = st[96 + q], need = st[32 + q];
            unsigned c[FAST_CAP / 16];
#pragma unroll
            for (int i = 0; i < FAST_CAP / 16; ++i) { const unsigned ci = (unsigned)(l16 + 16 * i); c[i] = ci < n ? cand[q * FAST_CAP + ci] : 0u; }
            LAS unsigned* h2 = (LAS unsigned*)Qs + q * 256;
#pragma unroll
            for (int i = 0; i < 4; ++i) *(LAS v4u*)(h2 + 16 * l16 + 4 * i) = (v4u){0u, 0u, 0u, 0u};
#pragma unroll
            for (int i = 0; i < FAST_CAP / 16; ++i) if ((unsigned)(l16 + 16 * i) < n) __hip_atomic_fetch_add(&h2[c[i] >> 24], 1u, __ATOMIC_RELAXED, __HIP_MEMORY_SCOPE_WORKGROUP);
            { unsigned hb[16], ssum = 0u;
#pragma unroll
              for (int i = 0; i < 4; ++i) { const v4u t4 = *(const LAS v4u*)(h2 + 16 * l16 + 4 * i); hb[4 * i] = t4.x; hb[4 * i + 1] = t4.y; hb[4 * i + 2] = t4.z; hb[4 * i + 3] = t4.w; ssum += (t4.x + t4.y) + (t4.z + t4.w); }
              const unsigned habove = row16_suffix(ssum) - ssum;
              if (habove < need && need <= habove + ssum) { unsigned cum = habove, fb = 0u; bool found = false;
#pragma unroll
                  for (int j = 15; j >= 0; --j) { if (!found && cum + hb[j] >= need) { found = true; fb = (unsigned)j; } if (!found) cum += hb[j]; }
                  st[352 + q] = 16u * (unsigned)l16 + fb; } }
            unsigned Pv = st[352 + q] << 24; bool done = false;
#pragma nounroll
            for (int bit = 23; bit >= 0; --bit) { const unsigned trial = Pv | (1u << bit); unsigned cnt = 0u;
#pragma unroll
                for (int i = 0; i < FAST_CAP / 16; ++i) cnt += (c[i] >= trial) ? 1u : 0u;
                cnt = row16_sum(cnt);
                if (!done && cnt >= need) { Pv = trial; done = (cnt == need); }
                if (__all(done)) break; }
#pragma unroll
            for (int i = 0; i < FAST_CAP / 16; ++i) if ((unsigned)(l16 + 16 * i) < n && c[i] >= Pv) { const unsigned kidx = 8191u - (c[i] & 8191u);
                __hip_atomic_fetch_or(&img[(kidx >> 5) * 32 + q], 1u << (kidx & 31), __ATOMIC_RELAXED, __HIP_MEMORY_SCOPE_WORKGROUP); }
        } else if (tid < 32) { st[32 + tid] = 256u; st[96 + tid] = 0u; }
        __syncthreads();
    }
#ifdef DIAG_SLOW
    if (slow && tid == 0) __hip_atomic_fetch_add(P.dbg, 1u, RLX_AGENT);
#endif
    if (slow) {
    for (;;) {
        ++level;
        for (int u = tid; u < 32 * HS; u += NTHR) hist[u] = 0u;
        if (tid == 0) st[128] = 0u;
        __syncthreads();
        {
            const unsigned qa = st[r32], qlen = st[192 + r32], base1 = st[160 + r32]; const float cq = __builtin_bit_cast(float, st[224 + r32]);
            const int sh = (level > 1 && qlen > 512u) ? (32 - __builtin_clz(qlen - 1u)) - 9 : 0;
            LAS unsigned* hrow = hist + r32 * HS;
            bf16x8 kn[2][4]; if (wave < npair) { IDX_KLOAD2(wave) }
            for (int tp = wave; tp < npair; tp += NWAVES) {
                IDX_SCORES2(tp)
                if (level == 1) {
#pragma unroll
                    for (int i = 0; i < 16; ++i) { const unsigned k0 = mono_key(sc0[i] + cq), k1 = mono_key(sc1[i] + cq);
                        const unsigned b0 = min((max(k0, base1) - base1) >> 17, 511u), b1 = min((max(k1, base1) - base1) >> 17, 511u);
                        __hip_atomic_fetch_add(&hrow[b0], 1u, __ATOMIC_RELAXED, __HIP_MEMORY_SCOPE_WORKGROUP); __hip_atomic_fetch_add(&hrow[b1], 1u, __ATOMIC_RELAXED, __HIP_MEMORY_SCOPE_WORKGROUP); }
                } else {
#pragma unroll
                    for (int i = 0; i < 16; ++i) { const unsigned o0 = mono_key(sc0[i] + cq) - qa, o1 = mono_key(sc1[i] + cq) - qa;
                        if (o0 < qlen) __hip_atomic_fetch_add(&hrow[o0 >> sh], 1u, __ATOMIC_RELAXED, __HIP_MEMORY_SCOPE_WORKGROUP);
                        if (o1 < qlen) __hip_atomic_fetch_add(&hrow[o1 >> sh], 1u, __ATOMIC_RELAXED, __HIP_MEMORY_SCOPE_WORKGROUP); }
                }
            }
        }
        __syncthreads();
        {
            const int q = tid >> 4, seg = tid & 15;
            unsigned segsum = 0u;
            for (int wi = 0; wi < 32; ++wi) segsum += hist[q * HS + seg * 32 + wi];
            unsigned S = segsum;
            S = row16_suffix(S);
            const unsigned above = S - segsum, need = st[32 + q];
            if (above < need && need <= above + segsum) {
                unsigned cum = above, fbin = 0u, fneed = 1u, fcnt = 0u; bool found = false;
                for (int wi = 31; wi >= 0; --wi) { const unsigned c = hist[q * HS + seg * 32 + wi];
                    if (!found && cum + c >= need) { found = true; fbin = (unsigned)wi; fneed = need - cum; fcnt = c; } if (!found) cum += c; }
                fbin += 32u * (unsigned)seg;
                unsigned na, nlen;
                if (level == 1) { const unsigned base1 = st[160 + q];
                    if (fbin == 0u) { na = 0u; nlen = base1 + 131072u; } else if (fbin == 511u) { na = base1 + 511u * 131072u; nlen = 0u - na; } else { na = base1 + fbin * 131072u; nlen = 131072u; } }
                else { const unsigned qa = st[q], qlen = st[192 + q]; const int sh = qlen > 512u ? (32 - __builtin_clz(qlen - 1u)) - 9 : 0;
                    na = qa + (fbin << sh); nlen = min(1u << sh, qlen - (fbin << sh)); }
                st[q] = na; st[192 + q] = nlen; st[32 + q] = fneed; st[64 + q] = fcnt;
                if (fcnt > (unsigned)CAND_CAP && nlen > 1u) st[128] = 1u;
            }
        }
        __syncthreads();
#ifndef MAXLVL
#define MAXLVL 8
#endif
        const bool more = (st[128] != 0u) && (level < MAXLVL);
        __syncthreads();
        if (!more) break;
    }
    {
        const unsigned qa = st[r32], qlen = st[192 + r32]; const float cq = __builtin_bit_cast(float, st[224 + r32]);
        const unsigned Hk = qa + qlen - 1u;
        unsigned hb = (Hk & 0x80000000u) ? (Hk ^ 0x80000000u) : ~Hk;
        if (hb == 0x80000000u) hb = 0x80000001u;
        const float fH = __builtin_bit_cast(float, hb);
        const unsigned ab_ = (qa & 0x80000000u) ? (qa ^ 0x80000000u) : ~qa;
        const float fA = (qa < 0x00800000u) ? -__builtin_inff() : __builtin_bit_cast(float, ab_);
        bf16x8 kn[2][4]; if (wave < npair) { IDX_KLOAD2(wave) }
        for (int tp = wave; tp < npair; tp += NWAVES) {
            IDX_SCORES2(tp)
#define IDX_COLLECT_ELEMS(SC, T) { unsigned v = 0u; _Pragma("unroll") for (int i = 15; i >= 0; --i) { const float ts = SC[i] + cq; const bool ab = ts > fH; v = v + v + (ab ? 1u : 0u); \
                if (!ab && ts >= fA) { const unsigned key = mono_key(ts); \
                    const unsigned pos = __hip_atomic_fetch_add(&st[96 + r32], 1u, __ATOMIC_RELAXED, __HIP_MEMORY_SCOPE_WORKGROUP); \
                    if (pos < (unsigned)CAND_CAP) { cand[(r32 * CAND_CAP + pos) * 2] = key; cand[(r32 * CAND_CAP + pos) * 2 + 1] = (unsigned)(32 * (T) + crow(i, hi)); } } } \
            unsigned bits = (v & 0xfu) | ((v & 0xf0u) << 4) | ((v & 0xf00u) << 8) | ((v & 0xf000u) << 12);     \
            bits <<= 4 * hi; bits = half_or(bits); if (hi == 0) img[(T) * 32 + r32] = bits; }
            IDX_COLLECT_ELEMS(sc0, 2 * tp)
            IDX_COLLECT_ELEMS(sc1, 2 * tp + 1)
#undef IDX_COLLECT_ELEMS
        }
    }
#undef IDX_SCORES2
#undef IDX_KLOAD2
    __syncthreads();
    {
        const int q = tid >> 4; const unsigned n = min(st[96 + q], (unsigned)CAND_CAP), need = st[32 + q];
        for (unsigned c = tid & 15; c < n; c += 16) { const unsigned key = cand[(q * CAND_CAP + c) * 2], idx = cand[(q * CAND_CAP + c) * 2 + 1]; unsigned rank = 0u;
            for (unsigned o = 0; o < n; ++o) { const unsigned k2 = cand[(q * CAND_CAP + o) * 2], i2 = cand[(q * CAND_CAP + o) * 2 + 1]; rank += (k2 > key || (k2 == key && i2 < idx)) ? 1u : 0u; }
            if (rank < need) __hip_atomic_fetch_or(&img[(idx >> 5) * 32 + q], 1u << (idx & 31), __ATOMIC_RELAXED, __HIP_MEMORY_SCOPE_WORKGROUP); }
    }
    }
    __syncthreads();
    for (int idx = tid; idx < ntile * 32; idx += NTHR) P.BM[((size_t)b * 256 + (idx >> 5)) * SEQ + q0 + (idx & 31)] = img[idx];
    __syncthreads();
}

__device__ __forceinline__ int wq_next(Frame& F, int cw) {
    __syncthreads();
    if (F_TID == 0) F.MISC[0] = __hip_atomic_fetch_add((unsigned*)(F.ctl + cw), 1u, RLX_AGENT);
    __syncthreads();
    return (int)F.MISC[0];
}

__device__ __forceinline__ void p5a_route(Frame& F, const Args& A) {
    const int lane = F_LANE, tid = F_TID, wave = F_WAVE;
    const float* x1 = A.out; const float* g2 = A.in[11];
    const float* wrg = A.in[12]; const float* brg = A.in[13]; const float* wre = A.in[14]; const float* bre = A.in[15];
    int* toke = (int*)(F.ws + WS_TOKE); float* tokw = (float*)(F.ws + WS_TOKW); float* rstd2 = (float*)(F.ws + WS_RSTD2);
    int* sslot = (int*)(F.ws + WS_SSLOT);
    constexpr int WST = 44, WCH = 256 * WST * 4;
    LAS float* wl = (LAS float*)F.lds;
    LAS unsigned* lcnt = (LAS unsigned*)(F.lds + 2 * WCH);
    LAS float* lgs = (LAS float*)(F.lds + 2 * WCH + 256);
    for (int i = F.vcu * NTHR + tid; i < SORT_ROWS; i += F.G * NTHR) sslot[i] = -1;
    if (tid < NEXP) lcnt[tid] = 0u;
    const int i16 = lane & 15, kq = lane >> 4, tile = wave & 3, half = wave >> 2;
    const int per = T / F.G;
    for (int t0 = F.vcu * per; t0 < (F.vcu + 1) * per; t0 += 64) {
        const float* xr = x1 + (size_t)(t0 + 16 * tile + i16) * D + 4 * kq;
        f32x4 acc0 = (f32x4){0.f, 0.f, 0.f, 0.f}, acc1 = acc0; float ss = 0.f;
        f32x4 se[4], sg; float gk[5];
#define RT_LOAD(c) do { _Pragma("unroll") for (int q = 0; q < 4; ++q) { const int f = tid + 512 * q, k = f >> 3; se[q] = *(const GAS f32x4*)(wre + (size_t)(256 * (c) + k) * 32 + 4 * (f & 7)); gk[q] = g2[256 * (c) + k]; } \
            { const int k = tid >> 1; sg = *(const GAS f32x4*)(wrg + (size_t)(256 * (c) + k) * 8 + 4 * (tid & 1)); gk[4] = g2[256 * (c) + k]; } } while (0)
#define RT_WRITE(bf) do { LAS float* wb = wl + (bf) * (WCH / 4); _Pragma("unroll") for (int q = 0; q < 4; ++q) { const int f = tid + 512 * q, k = f >> 3; *(LAS f32x4*)(wb + k * WST + 4 * (f & 7)) = se[q] * gk[q]; } \
            { const int k = tid >> 1; *(LAS f32x4*)(wb + k * WST + 32 + 4 * (tid & 1)) = sg * gk[4]; } } while (0)
        f32x4 xa[16];
#pragma unroll
        for (int s = 0; s < 16; ++s) xa[s] = *(const GAS f32x4*)(xr + 16 * s);
        RT_LOAD(0); RT_WRITE(0); __syncthreads();
#pragma unroll
        for (int c = 0; c < 4; ++c) {
            if (c + 1 < 4) RT_LOAD(c + 1);
            const LAS float* wb = wl + (c & 1) * (WCH / 4) + 4 * kq * WST + i16 + 16 * half;
#pragma unroll
            for (int s = 0; s < 16; ++s) {
                const f32x4 a4 = xa[s];
                if (half == 0) ss += (a4.x * a4.x + a4.y * a4.y) + (a4.z * a4.z + a4.w * a4.w);
#pragma unroll
                for (int cc = 0; cc < 4; ++cc) { const LAS float* wp = wb + (16 * s + cc) * WST;
                    acc0 = __builtin_amdgcn_mfma_f32_16x16x4f32(a4[cc], wp[0], acc0, 0, 0, 0);
                    if (half == 0) acc1 = __builtin_amdgcn_mfma_f32_16x16x4f32(a4[cc], wp[32 - (i16 & 8)], acc1, 0, 0, 0); }
            }
            if (c + 1 < 4) {
#pragma unroll
                for (int s = 0; s < 16; ++s) xa[s] = *(const GAS f32x4*)(xr + 256 * (c + 1) + 16 * s);
                RT_WRITE((c + 1) & 1); }
            __syncthreads();
        }
#undef RT_LOAD
#undef RT_WRITE
        LAS float* lt = lgs + tile * 640;
#pragma unroll
        for (int r = 0; r < 4; ++r) { const int tk = 4 * kq + r; lt[tk * 40 + 8 + 16 * half + i16] = acc0[r]; if (half == 0 && i16 < 8) lt[tk * 40 + i16] = acc1[r]; }
        if (half == 0) { ss += __shfl_xor(ss, 16); ss += __shfl_xor(ss, 32); if (kq == 0) lgs[2560 + 16 * tile + i16] = 1.f / sqrtf(ss * (1.f / D) + EPS); }
        __syncthreads();
        if (half == 0 && lane < 16) {
            const int m = t0 + 16 * tile + lane; const float rstd = lgs[2560 + 16 * tile + lane]; const LAS float* lg = lt + lane * 40;
            float gl[8];
#pragma unroll
            for (int k = 0; k < 8; ++k) gl[k] = lg[k] * rstd + brg[k];
            int gs = 0; float gm = gl[0];
#pragma unroll
            for (int k = 1; k < 8; ++k) if (gl[k] > gm) { gm = gl[k]; gs = k; }
            float den = 0.f;
#pragma unroll
            for (int k = 0; k < 8; ++k) den += __expf(gl[k] - gm);
            const float wgrp = 1.f / den;
            float el[4];
#pragma unroll
            for (int cc = 0; cc < 4; ++cc) el[cc] = lg[8 + 4 * gs + cc] * rstd + bre[4 * gs + cc];
            int i1 = 0; float v1 = el[0];
#pragma unroll
            for (int cc = 1; cc < 4; ++cc) if (el[cc] > v1) { v1 = el[cc]; i1 = cc; }
            int i2 = -1; float v2 = 0.f;
#pragma unroll
            for (int cc = 0; cc < 4; ++cc) if (cc != i1 && (i2 < 0 || el[cc] > v2)) { v2 = el[cc]; i2 = cc; }
            const float e2 = __expf(v2 - v1), w1 = 1.f / (1.f + e2), w2 = e2 / (1.f + e2);
            toke[2 * m] = gs * 4 + i1; toke[2 * m + 1] = gs * 4 + i2; tokw[2 * m] = w1 * wgrp; tokw[2 * m + 1] = w2 * wgrp; rstd2[m] = rstd;
            __hip_atomic_fetch_add(&lcnt[gs * 4 + i1], 1u, __ATOMIC_RELAXED, __HIP_MEMORY_SCOPE_WORKGROUP);
            __hip_atomic_fetch_add(&lcnt[gs * 4 + i2], 1u, __ATOMIC_RELAXED, __HIP_MEMORY_SCOPE_WORKGROUP);
        }
        __syncthreads();
    }
    if (tid < NEXP && lcnt[tid]) __hip_atomic_fetch_add((unsigned*)(F.ctl + CW_CNT + tid), lcnt[tid], RLX_AGENT);
}

__device__ __forceinline__ void p5a2_scatter(Frame& F, const Args& A) {
    const int lane = F_LANE, tid = F_TID;
    const float* x1 = A.out; const float* g2 = A.in[11];
    const int* toke = (const int*)(F.ws + WS_TOKE); const float* tokw = (const float*)(F.ws + WS_TOKW); const float* rstd2 = (const float*)(F.ws + WS_RSTD2);
    int* sslot = (int*)(F.ws + WS_SSLOT); float* sw = (float*)(F.ws + WS_SW); int* t2e = (int*)(F.ws + WS_T2E);
    bf16* AS = (bf16*)(F.ws + WS_ASORT);
    LAS unsigned* sh = (LAS unsigned*)F.lds;
    if (tid < NEXP) sh[256 + tid] = __hip_atomic_load((unsigned*)(F.ctl + CW_CNT + tid), RLX_AGENT);
    __syncthreads();
    if (tid == 0) { unsigned acc = 0u;
        for (int e = 0; e < NEXP; ++e) { const unsigned c = sh[256 + e]; sh[e] = acc; const unsigned nt = (c + 255u) / 256u;
            if (blockIdx.x == 0) for (unsigned i = 0; i < nt; ++i) t2e[acc / 256u + i] = e;
            acc += nt * 256u; }
        if (blockIdx.x == 0) t2e[255] = (int)(acc / 256u); }
    const int per = T / F.G;
    for (int t0 = F.vcu * per; t0 < (F.vcu + 1) * per; t0 += 64) {
        if (tid < NEXP) sh[32 + tid] = 0u;
        __syncthreads();
        int e = 0; unsigned lpos = 0u;
        if (tid < 128) { e = toke[2 * t0 + tid]; lpos = __hip_atomic_fetch_add(&sh[32 + e], 1u, __ATOMIC_RELAXED, __HIP_MEMORY_SCOPE_WORKGROUP); }
        __syncthreads();
        if (tid < NEXP) sh[64 + tid] = sh[tid] + (sh[32 + tid] ? __hip_atomic_fetch_add((unsigned*)(F.ctl + CW_FILL + tid), sh[32 + tid], RLX_AGENT) : 0u);
        __syncthreads();
        if (tid < 128) { const unsigned pos = sh[64 + e] + lpos; sh[96 + tid] = pos; sslot[pos] = 2 * t0 + tid; sw[pos] = tokw[2 * t0 + tid]; }
        __syncthreads();
        for (int tk0 = F_WAVE; tk0 < 64; tk0 += 4 * NWAVES) {
            f32x4 xv[4][4];
#pragma unroll
            for (int r = 0; r < 4; ++r) { const GAS f32x4* xr = (const GAS f32x4*)(x1 + (size_t)(t0 + tk0 + r * NWAVES) * D) + lane;
#pragma unroll
                for (int j = 0; j < 4; ++j) xv[r][j] = xr[64 * j]; }
#pragma unroll
            for (int r = 0; r < 4; ++r) { const int tk = tk0 + r * NWAVES, m = t0 + tk; const float rstd = rstd2[m];
                const unsigned p0 = sh[96 + 2 * tk], p1 = sh[96 + 2 * tk + 1];
#pragma unroll
                for (int j = 0; j < 4; ++j) { const f32x4 g = *((const GAS f32x4*)g2 + lane + 64 * j); const f32x4 y = xv[r][j] * rstd * g; v2u w; w.x = pk2(y.x, y.y); w.y = pk2(y.z, y.w);
                    *((GAS v2u*)(AS + (size_t)p0 * D) + lane + 64 * j) = w; *((GAS v2u*)(AS + (size_t)p1 * D) + lane + 64 * j) = w; } } }
        __syncthreads();
    }
}

__device__ __forceinline__ void p6_final(Frame& F, const Args& A) {
    const int gw = F.vcu * NWAVES + F_WAVE, NGW = F.G * NWAVES, lane = F_LANE;
    const float* gf = A.in[19]; float* out = A.out; const bf16* SL = (const bf16*)(F.ws + WS_SLOTS);
    for (int m0 = gw; m0 < T; m0 += 2 * NGW) {
        f32x4 v[2][4]; v2u a[2][4], c[2][4];
#pragma unroll
        for (int r = 0; r < 2; ++r) { const int m = min(m0 + r * NGW, T - 1); const GAS f32x4* xr = (const GAS f32x4*)(out + (size_t)m * D) + lane;
            const GAS v2u* s0 = (const GAS v2u*)(SL + (size_t)(2 * m) * D) + lane; const GAS v2u* s1 = (const GAS v2u*)(SL + (size_t)(2 * m + 1) * D) + lane;
#pragma unroll
            for (int j = 0; j < 4; ++j) { v[r][j] = xr[64 * j]; a[r][j] = s0[64 * j]; c[r][j] = s1[64 * j]; } }
#pragma unroll
        for (int r = 0; r < 2; ++r) { const int m = m0 + r * NGW; float s = 0.f;
#pragma unroll
            for (int j = 0; j < 4; ++j) { f32x4& w = v[r][j];
                w.x += bflo(a[r][j].x) + bflo(c[r][j].x); w.y += bfhi(a[r][j].x) + bfhi(c[r][j].x); w.z += bflo(a[r][j].y) + bflo(c[r][j].y); w.w += bfhi(a[r][j].y) + bfhi(c[r][j].y);
                s += (w.x * w.x + w.y * w.y) + (w.z * w.z + w.w * w.w); }
            const float rstd = 1.f / sqrtf(wave_sum(s) * (1.f / D) + EPS);
            if (m < T) { GAS f32x4* xo = (GAS f32x4*)(out + (size_t)m * D) + lane;
#pragma unroll
                for (int j = 0; j < 4; ++j) { const f32x4 g = *((const GAS f32x4*)gf + lane + 64 * j); xo[64 * j] = v[r][j] * rstd * g; } } }
    }
}

constexpr int NPHASE = 13;
__global__ void __launch_bounds__(NTHR, 2) mk_fwd(Args args) {
    extern __shared__ __attribute__((aligned(16))) unsigned char lds[];
    Frame F;
    F.lds = (LAS unsigned char*)lds; F.MISC = (volatile LAS unsigned*)(F.lds + MISC_OFF);
        F.G = gridDim.x; { const int bx = blockIdx.x; F.vcu = (F.G % 8 == 0) ? (bx % 8) * (F.G / 8) + bx / 8 : bx; }
    F.ws = args.ws; F.ctl = (gu32*)(args.ws + WS_CTL);
    unsigned char* ws = args.ws;
    if (F_TID < 128) F.MISC[F_TID] = 0u;
    __syncthreads();
    const bool single = (args.ph_hi - args.ph_lo) > 1;
    XcdBarrier bar; bar.bar = (unsigned*)(F.ctl + CW_BAR); bar.x = 0; bar.st = nullptr;
    if (single) bar = xcd_barrier_post((unsigned*)(F.ctl + CW_BAR), F.MISC + 8);
    const int lo = args.ph_lo, hi = args.ph_hi;
#ifdef ONLY
#define IN(k) ((k) == ONLY && lo <= (k) && (k) < hi)
#else
#define IN(k) (lo <= (k) && (k) < hi)
#endif
#ifdef TS_A
#define STAMP(k) do { if (blockIdx.x == 0 && threadIdx.x == 0) ((unsigned long long*)(ws + WS_CTL + 8192))[(k) + 1] = __builtin_amdgcn_s_memrealtime(); } while (0)
#else
#define STAMP(k) do { } while (0)
#endif
#define SEAM(k) do { if (IN((k) + 1)) xcd_barrier(bar); STAMP(k); } while (0)
    const f32x2* rope = (const f32x2*)(ws + WS_ROPE);
    bf16* GA = (bf16*)args.out; bf16* GB = (bf16*)args.out + (size_t)T * 1024;

    STAMP(-1);
    if (IN(0)) { p0_prologue(F, args);
#ifdef REP_P0
        p0_prologue(F, args);
#endif
        SEAM(0); }
    if (IN(1)) {
        pg8::Gemm g{(const bf16*)(ws + WS_H), (const bf16*)(ws + WS_WIN), T, NIN, D, 0}; pg8::StaticOrder S; S.init(T, NIN, F.G, (int)blockIdx.x);
        pg8::EpiIn E{(bf16*)(ws + WS_CQ), (bf16*)(ws + WS_CKV), (bf16*)(ws + WS_QB), (bf16*)(ws + WS_KB), (bf16*)(ws + WS_VB), (bf16*)(ws + WS_QI), (bf16*)(ws + WS_KI), (bf16*)(ws + WS_KR), GA, GB, (float*)(ws + WS_WI), rope, (float*)(ws + WS_PART)};
        pg8::gemm_phase<pg8::EpiIn, pg8::StaticOrder, true, true>(F.lds, g, S, E);
#ifdef REP_P1
        pg8::gemm_phase<pg8::EpiIn, pg8::StaticOrder, true, true>(F.lds, g, S, E);
#endif
#ifdef CONV_AT_P1
        for (;;) { const int c = wq_next(F, CW_Q2); if (c >= CV_QITEMS) break;
            int ltid = threadIdx.x; asm volatile("" : "+v"(ltid));
            const int lw = __builtin_amdgcn_readfirstlane(ltid >> 6); LAS float* scr = (LAS float*)(F.lds + lw * 16640);
            conv_tile2(args, ws, CV_EARLY + 16 * c + lw, CV_EARLY + 16 * c + 8 + lw, scr, ltid & 63); }
#endif
        SEAM(1);
    }
#ifdef P2A_OLD
    if (IN(2)) { p2a_norms(F, args); SEAM(2); }
#endif
    if (IN(3)) {
#ifdef REP_P3
      for (int rep = 0; rep < 2; ++rep) {
#else
      {
#endif
#ifndef NO3A
        { pg8::Gemm g{(const bf16*)(ws + WS_CQ), (const bf16*)(ws + WS_WUQ), T, 768, 384, 0}; pg8::StaticOrder S; S.init(T, 768, F.G, (int)blockIdx.x);
          LAS float* rsl = (LAS float*)(F.lds + 131072);
          { pg8::Unit u0; if (S.next(0, u0) && F_TID < 256) { const f32x4* pp = (const f32x4*)((const float*)(ws + WS_PART) + (size_t)(u0.pm * 256 + F_TID) * 20); const f32x4 a = pp[0], b = pp[1], c = pp[2];
              rsl[F_TID] = C2A / sqrtf(((((a[0] + a[1]) + (a[2] + a[3])) + ((b[0] + b[1]) + (b[2] + b[3]))) + ((c[0] + c[1]) + (c[2] + c[3]))) * (1.f / 384.f) + EPS); } }
          __syncthreads();
          pg8::EpiQA E{(bf16*)(ws + WS_QA), rope, rsl}; pg8::gemm_phase<pg8::EpiQA, pg8::StaticOrder, true, true>(F.lds, g, S, E); }
#endif
#ifndef NO3B
        { pg8::Gemm g{(const bf16*)(ws + WS_CKV), (const bf16*)(ws + WS_WUKV), T, 1024, 256, 0}; pg8::StaticOrder S; S.init(T, 1024, F.G, (int)blockIdx.x);
          LAS float* rsl = (LAS float*)(F.lds + 131072 + 1024);
          { pg8::Unit u0; if (S.next(0, u0) && F_TID < 256) { const f32x4* pp = (const f32x4*)((const float*)(ws + WS_PART) + (size_t)(u0.pm * 256 + F_TID) * 20 + 12); const f32x4 a = pp[0], b = pp[1];
              rsl[F_TID] = 1.f / sqrtf((((a[0] + a[1]) + (a[2] + a[3])) + ((b[0] + b[1]) + (b[2] + b[3]))) * (1.f / 256.f) + EPS); } }
          __syncthreads();
          pg8::EpiKV E{(bf16*)(ws + WS_KN), (bf16*)(ws + WS_VA), rsl}; pg8::gemm_phase<pg8::EpiKV, pg8::StaticOrder, true, true>(F.lds, g, S, E); }
#endif
      }
        SEAM(3);
    }
    if (IN(4)) {
        unsigned* rdy = (unsigned*)(F.ctl + CW_RDY);
#ifndef CONV_AT_P1
        constexpr int NCVQ = CV_QITEMS;
#else
        constexpr int NCVQ = 0;
#endif
        for (;;) { const int k = wq_next(F, CW_Q1); if (k >= 1536 + NCVQ) break;
            int ltid = threadIdx.x; asm volatile("" : "+v"(ltid));
            const int lw = __builtin_amdgcn_readfirstlane(ltid >> 6);
            if (k < 512) { const int ib = k & 1, ij = 255 - (k >> 1);
                const IdxP IP{(const bf16*)(ws + WS_QI), (const bf16*)(ws + WS_KI), (const float*)(ws + WS_WI), (unsigned*)(ws + WS_BM), (unsigned*)(F.ctl + 1024)};
                idx_item(F.lds, ib, ij, IP, ltid, ltid & 63, lw);
#ifdef REP_IDX
                __syncthreads(); idx_item(F.lds, ib, ij, IP, ltid, ltid & 63, lw);
#endif
                VM_WAIT(); __syncthreads();
                if (ltid == 0) { __builtin_amdgcn_fence(__ATOMIC_RELEASE, "agent"); VM_WAIT(); __hip_atomic_fetch_add(rdy + 64 * (ib * 32 + (ij >> 3)), 1u, RLX_AGENT); }
                continue; }
            const int j = k - 512; int a;
            if (j < 3 * NCVQ) { const int q3 = j / 3, r3 = j - 3 * q3; a = (r3 == 2) ? -1 - q3 : 2 * q3 + r3; } else a = j - NCVQ;
            if (a < 0) { const int c = -1 - a; LAS float* scr = (LAS float*)(F.lds + lw * 16640);
                conv_tile2(args, ws, CV_EARLY + 16 * c + lw, CV_EARLY + 16 * c + 8 + lw, scr, ltid & 63);
                continue; }
            { const int u = a >> 1, ub = (u & 15) >> 3, uh = u & 7, uq = 31 - (u >> 4);
                if (a & 1) { const AttnP APA{(const bf16*)(ws + WS_QA), (const bf16*)(ws + WS_KN), (const bf16*)(ws + WS_KR), (const bf16*)(ws + WS_VA), (bf16*)(ws + WS_OA), nullptr};
#ifdef MLA_OLD
                    attn_unit<true>(F.lds, ub, uh, uq, APA, ltid, ltid & 63, lw); }
#else
                    attn_body::attn_unit<8, true>(ub, uh, uq, (const attn_body::bf16*)APA.Q, (const attn_body::bf16*)APA.K, (const attn_body::bf16*)APA.K2, (const attn_body::bf16*)APA.V, (attn_body::bf16*)APA.O, nullptr, (char*)F.lds, ltid); }
#endif
                else { const AttnP APB{(const bf16*)(ws + WS_QB), (const bf16*)(ws + WS_KB), nullptr, (const bf16*)(ws + WS_VB), (bf16*)(ws + WS_OB), (const unsigned*)(ws + WS_BM)};
                    if (ltid == 0) { unsigned sp = 0u; while (__hip_atomic_load(rdy + 64 * (ub * 32 + uq), RLX_AGENT) < 8u) { __builtin_amdgcn_s_sleep(8); if (++sp > (1u << 22)) break; }
                        __builtin_amdgcn_fence(__ATOMIC_ACQUIRE, "agent"); VM_WAIT(); }
                    __syncthreads();
#ifdef DSA_OLD
                    attn_unit<false>(F.lds, ub, uh, uq, APB, ltid, ltid & 63, lw); } }
#else
                    attn_body::attn_unit<8, false>(ub, uh, uq, (const attn_body::bf16*)APB.Q, (const attn_body::bf16*)APB.K, nullptr, (const attn_body::bf16*)APB.V, (attn_body::bf16*)APB.O, APB.BM, (char*)F.lds, ltid); } }
#endif
        }
    }
    if (IN(5)) { SEAM(5); }
#ifdef Y_TWO_GEMMS
    if (IN(6)) {
#ifdef REP_P6
      for (int rep = 0; rep < 2; ++rep) {
#else
      {
#endif
        { pg8::Gemm g{(const bf16*)(ws + WS_OA), (const bf16*)(ws + WS_WOA), T, 1024, 512, 0}; pg8::StaticOrder S; S.init(T, 1024, F.G, (int)blockIdx.x);
          pg8::EpiY<0> E{(bf16*)(ws + WS_Y), GA}; pg8::gemm_phase<pg8::EpiY<0>, pg8::StaticOrder, true, true>(F.lds, g, S, E); }
        { pg8::Gemm g{(const bf16*)(ws + WS_OB), (const bf16*)(ws + WS_WOB), T, 1024, 512, 0}; pg8::StaticOrder S; S.init(T, 1024, F.G, (int)blockIdx.x);
          pg8::EpiY<1> E{(bf16*)(ws + WS_Y), GB}; pg8::gemm_phase<pg8::EpiY<1>, pg8::StaticOrder, true, true>(F.lds, g, S, E); }
      }
        SEAM(6);
    }
#else
    if (IN(6)) {
        pg8::Gemm g{(const bf16*)(ws + WS_OA), (const bf16*)(ws + WS_WOA), T, 1024, 512, WS_WOB - WS_WOA, WS_OB - WS_OA};
        pg8::PairOrder S; S.S0.init(T, 1024, F.G, (int)blockIdx.x);
        pg8::EpiYC E{(bf16*)(ws + WS_Y), GA, GB}; pg8::gemm_phase<pg8::EpiYC, pg8::PairOrder, true, true>(F.lds, g, S, E);
        SEAM(6);
    }
#endif
    if (IN(7)) {
        pg8::Gemm g{(const bf16*)(ws + WS_Y), (const bf16*)(ws + WS_WOUT), T, 1024, 1024, 0}; pg8::StaticOrder S; S.init(T, 1024, F.G, (int)blockIdx.x);
        pg8::EpiX1 E{args.in[0], args.out}; pg8::gemm_phase<pg8::EpiX1, pg8::StaticOrder, true, true>(F.lds, g, S, E);
#ifdef REP_P7
        pg8::gemm_phase<pg8::EpiX1, pg8::StaticOrder, true, true>(F.lds, g, S, E);
#endif
        SEAM(7);
    }
    if (IN(8)) { p5a_route(F, args); SEAM(8); }
    if (IN(9)) { p5a2_scatter(F, args); SEAM(9); }
#ifdef MOE_TWO_PHASES
    if (IN(10)) {
        const int* t2e = (const int*)(ws + WS_T2E); const int ntl = t2e[255];
        pg8::Gemm g{(const bf16*)(ws + WS_ASORT), (const bf16*)(ws + WS_WGU), SORT_ROWS, 512, 1024, (size_t)512 * 1024 * 2}; pg8::GroupOrder S; S.init(ntl, 2, F.G, (int)blockIdx.x, t2e);
        pg8::EpiHid E{(bf16*)(ws + WS_HID)}; pg8::gemm_phase<pg8::EpiHid, pg8::GroupOrder, true, true>(F.lds, g, S, E);
#ifdef REP_P10
        pg8::gemm_phase<pg8::EpiHid, pg8::GroupOrder, true, true>(F.lds, g, S, E);
#endif
        SEAM(10);
    }
    if (IN(11)) {
        const int* t2e = (const int*)(ws + WS_T2E); const int ntl = t2e[255];
        pg8::Gemm g{(const bf16*)(ws + WS_HID), (const bf16*)(ws + WS_WD), SORT_ROWS, 1024, 256, (size_t)1024 * 256 * 2}; pg8::GroupOrder S; S.init(ntl, 4, F.G, (int)blockIdx.x, t2e);
        pg8::EpiDown E{(bf16*)(ws + WS_SLOTS), (const int*)(ws + WS_SSLOT), (const float*)(ws + WS_SW)}; pg8::gemm_phase<pg8::EpiDown, pg8::GroupOrder, true, true>(F.lds, g, S, E);
#ifdef REP_P11
        pg8::gemm_phase<pg8::EpiDown, pg8::GroupOrder, true, true>(F.lds, g, S, E);
#endif
        SEAM(11);
    }
#else
    if (IN(10)) {
        const int* t2e = (const int*)(ws + WS_T2E); const int ntl = t2e[255], n10 = 2 * ntl, n11 = 4 * ntl;
        unsigned* hrdy = (unsigned*)(F.ctl + CW_HRDY);
        const pg8::Gemm g10{(const bf16*)(ws + WS_ASORT), (const bf16*)(ws + WS_WGU), SORT_ROWS, 512, 1024, (size_t)512 * 1024 * 2};
        const pg8::Gemm g11{(const bf16*)(ws + WS_HID), (const bf16*)(ws + WS_WD), SORT_ROWS, 1024, 256, (size_t)1024 * 256 * 2};
        const pg8::EpiHid E10{(bf16*)(ws + WS_HID)}; const pg8::EpiDown E11{(bf16*)(ws + WS_SLOTS), (const int*)(ws + WS_SSLOT), (const float*)(ws + WS_SW)};
        for (;;) { const int k = wq_next(F, CW_Q3); if (k >= n10 + n11) break;
            if (k < n10) { const int pm = k >> 1; pg8::OneUnit S{pm, k & 1, __builtin_amdgcn_readfirstlane(t2e[pm])};
                pg8::gemm_phase<pg8::EpiHid, pg8::OneUnit, true, true>(F.lds, g10, S, E10);
                VM_WAIT(); __syncthreads();
                if (F_TID == 0) { __builtin_amdgcn_fence(__ATOMIC_RELEASE, "agent"); VM_WAIT(); __hip_atomic_fetch_add(hrdy + 64 * pm, 1u, RLX_AGENT); }
            } else { const int j = k - n10, pm = j >> 2; pg8::OneUnit S{pm, j & 3, __builtin_amdgcn_readfirstlane(t2e[pm])};
                if (F_TID == 0) { unsigned sp = 0u; while (__hip_atomic_load(hrdy + 64 * pm, RLX_AGENT) < 2u) { __builtin_amdgcn_s_sleep(8); if (++sp > (1u << 22)) break; }
                    __builtin_amdgcn_fence(__ATOMIC_ACQUIRE, "agent"); VM_WAIT(); }
                __syncthreads();
                pg8::gemm_phase<pg8::EpiDown, pg8::OneUnit, true, true>(F.lds, g11, S, E11);
            }
        }
    }
    if (IN(11)) { SEAM(11); }
#endif
    if (IN(12)) { p6_final(F, args); }
#ifdef DIAG_SLOW
    if (blockIdx.x == 0 && threadIdx.x == 0) { const unsigned long long t0 = __builtin_amdgcn_s_memrealtime(), wait = 100ull * __hip_atomic_load((unsigned*)(F.ctl + 1024), RLX_AGENT);
        while (__builtin_amdgcn_s_memrealtime() - t0 < wait) __builtin_amdgcn_s_sleep(16); }
#endif
#ifdef TS_A
    if (blockIdx.x == 0 && threadIdx.x == 0) { STAMP(12); __builtin_amdgcn_s_waitcnt(0);
        const unsigned long long* tsp = (const unsigned long long*)(ws + WS_CTL + 8192);
        const unsigned long long ta = __hip_atomic_load(tsp + (TS_A) + 1, RLX_AGENT), tb = __hip_atomic_load(tsp + (TS_B) + 1, RLX_AGENT);
        const unsigned long long t0 = __builtin_amdgcn_s_memrealtime(), wait = 4ull * (tb - ta);
        while (__builtin_amdgcn_s_memrealtime() - t0 < wait) __builtin_amdgcn_s_sleep(16); }
#endif
#undef IN
#undef SEAM
}

#ifndef MK_MULTI
#define MK_MULTI 0
#endif
extern "C" void kernel_launch(void* const* d_in, const int* in_sizes, int n_in, void* d_out, int out_size, void* d_ws, size_t ws_size, hipStream_t stream) {
    static int grid = 0;
    if (grid == 0) {
        if (n_in != 20 || in_sizes[0] != T * D || out_size != T * D || ws_size < WS_END) { fprintf(stderr, "kernel_launch: unexpected shapes n_in %d in0 %d out %d ws %zu\n", n_in, n_in > 0 ? in_sizes[0] : -1, out_size, ws_size); grid = -1; return; }
        int dev = 0, cus = 0;
        if (hipGetDevice(&dev) != hipSuccess || hipDeviceGetAttribute(&cus, hipDeviceAttributeMultiprocessorCount, dev) != hipSuccess) { grid = -1; return; }
        if (hipFuncSetAttribute((const void*)mk_fwd, hipFuncAttributeMaxDynamicSharedMemorySize, LDS_BYTES) != hipSuccess) { fprintf(stderr, "kernel_launch: hipFuncSetAttribute failed\n"); grid = -1; return; }
        (void)hipGetLastError();
        grid = cus;
    }
    if (grid < 0) return;
    if (hipMemsetAsync((char*)d_ws + WS_CTL, 0, CTL_ZERO_BYTES, stream) != hipSuccess) return;
    Args a{};
    for (int i = 0; i < 20; ++i) a.in[i] = (const float*)d_in[i];
    a.out = (float*)d_out; a.ws = (unsigned char*)d_ws;
#if MK_MULTI
    for (int p = 0; p < NPHASE; ++p) { a.ph_lo = p; a.ph_hi = p + 1; hipLaunchKernelGGL(mk_fwd, dim3(grid), dim3(NTHR), LDS_BYTES, stream, a); }
#else
    a.ph_lo = 0; a.ph_hi = NPHASE;
    hipLaunchKernelGGL(mk_fwd, dim3(grid), dim3(NTHR), LDS_BYTES, stream, a);
#endif
}
```

```cpp
#include <hip/hip_runtime.h>
#include <hip/hip_bf16.h>
#include <cstdio>
#include <cstdint>

#define GAS __attribute__((address_space(1)))
#define LAS __attribute__((address_space(3)))
typedef unsigned short bf16;
typedef unsigned v4u __attribute__((ext_vector_type(4)));
typedef unsigned v2u __attribute__((ext_vector_type(2)));
typedef float f32x4 __attribute__((ext_vector_type(4)));
typedef float f32x2 __attribute__((ext_vector_type(2)));
typedef float f32x16 __attribute__((ext_vector_type(16)));
typedef short bf16x8 __attribute__((ext_vector_type(8)));
typedef short s16x4 __attribute__((ext_vector_type(4)));
typedef __bf16 bf16x2_t __attribute__((ext_vector_type(2)));
typedef GAS unsigned gu32;
#define RLX_AGENT __ATOMIC_RELAXED, __HIP_MEMORY_SCOPE_AGENT
#define LDS_WAIT() asm volatile("s_waitcnt lgkmcnt(0)" ::: "memory")
#define VM_WAIT() asm volatile("s_waitcnt vmcnt(0)" ::: "memory")

constexpr int NWAVES = 8, NTHR = NWAVES * 64;
constexpr int BATCH = 2, SEQ = 8192, D = 1024, T = BATCH * SEQ;
constexpr float EPS = 1e-6f;
constexpr int NIN = 4864, NIN_SRC = 4840;
constexpr int C_CQ = 0, C_CKV = 384, C_QB = 640, C_KB = 1152, C_VB = 1664, C_QI = 2176, C_KR = 2688, C_KI = 2720, C_WI = 2784, C_GA = 2816, C_GB = 3840;
constexpr int NEXP = 32, FF = 256;
constexpr int SORT_ROWS = 2 * T + NEXP * 256;
constexpr float LOG2E = 1.4426950408889634f;
constexpr float C2A = 0.10206207261596575f * LOG2E;
constexpr float C2B = 0.125f * LOG2E;
constexpr float WI_SCALE = 0.35355339059327373f * 0.125f;

constexpr size_t MiB = 1u << 20, KiB = 1u << 10;
constexpr size_t WS_CTL = 0, CTL_ZERO_BYTES = 128 * KiB;
constexpr size_t WS_ROPE = 1 * MiB;
constexpr size_t WS_WI = 2 * MiB;
constexpr size_t WS_TOKE = 2 * MiB + 512 * KiB;
constexpr size_t WS_TOKW = WS_TOKE + 128 * KiB;
constexpr size_t WS_RSTD2 = WS_TOKW + 128 * KiB;
constexpr size_t WS_SSLOT = 3 * MiB + 512 * KiB;
constexpr size_t WS_SW = WS_SSLOT + 192 * KiB;
constexpr size_t WS_T2E = WS_SW + 192 * KiB;
constexpr size_t WS_WIN = 4 * MiB, WS_WUQ = 14 * MiB, WS_WUKV = 15 * MiB, WS_WOA = 16 * MiB, WS_WOB = 17 * MiB, WS_WOUT = 18 * MiB, WS_WGU = 20 * MiB, WS_WD = 52 * MiB;
constexpr size_t WS_H = 68 * MiB, WS_OA = 68 * MiB, WS_OB = 84 * MiB;
constexpr size_t WS_QA = 100 * MiB, WS_KN = 124 * MiB, WS_VA = 140 * MiB, WS_Y = 100 * MiB;
constexpr size_t WS_QB = 156 * MiB, WS_KB = 172 * MiB, WS_VB = 188 * MiB;
constexpr size_t WS_CQ = 204 * MiB, WS_CKV = 216 * MiB, WS_BM = 204 * MiB;
constexpr size_t WS_QI = 224 * MiB, WS_KI = 240 * MiB, WS_KR = 242 * MiB;
constexpr size_t WS_ASORT = 68 * MiB, WS_SLOTS = 100 * MiB, WS_HID = 220 * MiB;
constexpr size_t WS_PART = 244 * MiB;
constexpr size_t WS_X1B = 172 * MiB;
constexpr size_t WS_WRT = 246 * MiB + 512 * KiB;
constexpr size_t WS_TOKIDX = 246 * MiB, WS_SRSTD = 246 * MiB + 256 * KiB;
constexpr size_t WS_END = 256 * MiB;
constexpr int CW_BAR = 4096;
constexpr int CW_Q1 = 64, CW_Q2 = 128;
constexpr int CW_CNT = 256, CW_FILL = 320;
constexpr int CW_QP3 = 28672, CW_GP1 = 28672 + 512;
constexpr int CW_YRDY = 30720;
constexpr int CW_Q3 = 192, CW_HRDY = 16384;
constexpr int CW_RDY = 8192;

constexpr int LDS_BYTES = 147456;
constexpr int MISC_OFF = 147456 - 512;

__device__ __forceinline__ unsigned f2bf(float f) { unsigned u = __builtin_bit_cast(unsigned, f); return (u + 0x7fffu + ((u >> 16) & 1u)) >> 16; }
__device__ __forceinline__ unsigned pk2(float lo, float hi) { f32x2 v = {lo, hi}; bf16x2_t b = __builtin_convertvector(v, bf16x2_t); return __builtin_bit_cast(unsigned, b); }
__device__ __forceinline__ float bflo(unsigned w) { return __builtin_bit_cast(float, w << 16); }
__device__ __forceinline__ float bfhi(unsigned w) { return __builtin_bit_cast(float, w & 0xffff0000u); }

#define XB_TMO      128
#define XB_XCNT(j)  (256  + 64 * (j))
#define XB_XSUB(j)  (1280 + 64 * (j))
#define XB_XGEN(j)  (2304 + 64 * (j))
#define XB_TOP      3328
#define XB_TOPGEN   3392
#define XCD_BAR_WORDS 3456
#define XB_SPIN_CAP (1u << 22)
__device__ __forceinline__ unsigned xb_ld(unsigned* p)              { return __hip_atomic_load(p, __ATOMIC_RELAXED, __HIP_MEMORY_SCOPE_AGENT); }
__device__ __forceinline__ unsigned xb_add(unsigned* p, unsigned v) { return __hip_atomic_fetch_add(p, v, __ATOMIC_RELAXED, __HIP_MEMORY_SCOPE_AGENT); }
__device__ __forceinline__ unsigned xb_xcc_id() { return (unsigned)__builtin_amdgcn_s_getreg((3 << 11) | 20) & 0xFu; }
#define XB_SPIN(cond, bar) do { unsigned _sp = 0; while (cond) { __builtin_amdgcn_s_sleep(1); \
    if ((++_sp & 255u) == 0u) { if (xb_ld(&(bar)[XB_TMO])) break; if (_sp > XB_SPIN_CAP) { atomicAdd(&(bar)[XB_TMO], 1u); break; } } } } while (0)
struct XcdBarrier { unsigned* bar; unsigned x; volatile LAS unsigned* st; };
__device__ __forceinline__ XcdBarrier xcd_barrier_post(unsigned* bar, volatile LAS unsigned* st) {
    XcdBarrier b; b.bar = bar; b.x = xb_xcc_id(); b.st = st;
    if (threadIdx.x == 0) (void)xb_add(&bar[XB_XCNT(b.x)], 1u);
    return b;
}
__device__ __forceinline__ void xcd_barrier_complete(unsigned* bar, unsigned x, unsigned& nloc, unsigned& nx) {
    const unsigned G = gridDim.x * gridDim.y * gridDim.z;
    unsigned sum, cnt, mine, sp = 0u;
    for (;;) {
        sum = 0u; cnt = 0u; mine = 0u;
#pragma unroll
        for (unsigned j = 0; j < 16; ++j) { const unsigned c = xb_ld(&bar[XB_XCNT(j)]); sum += c; cnt += (c > 0u) ? 1u : 0u; mine = (j == x) ? c : mine; }
        if (sum == G) break;
        __builtin_amdgcn_s_sleep(1);
        if ((++sp & 255u) == 0u) { if (xb_ld(&bar[XB_TMO])) break; if (sp > XB_SPIN_CAP) { atomicAdd(&bar[XB_TMO], 1u); break; } }
    }
    nloc = mine > 0u ? mine : 1u; nx = cnt > 0u ? cnt : 1u;
}
__device__ __forceinline__ void xcd_barrier(const XcdBarrier& b) {
    asm volatile("s_waitcnt vmcnt(0)" ::: "memory");
    __syncthreads();
    if (threadIdx.x == 0) {
        unsigned* bar = b.bar;
        __builtin_amdgcn_s_waitcnt(0);
        unsigned nloc = b.st[0], nx = b.st[1];
        if (nloc == 0u) { xcd_barrier_complete(bar, b.x, nloc, nx); b.st[0] = nloc; b.st[1] = nx; }
        const unsigned old = xb_add(&bar[XB_XSUB(b.x)], 1u);
        const unsigned gen = old / nloc;
        if (old + 1u == (gen + 1u) * nloc) {
            __builtin_amdgcn_fence(__ATOMIC_RELEASE, "agent");
            asm volatile("s_waitcnt vmcnt(0)" ::: "memory");
            const unsigned og = xb_add(&bar[XB_TOP], 1u);
            const unsigned tg = og / nx;
            if (og + 1u == (tg + 1u) * nx) xb_add(&bar[XB_TOPGEN], 1u);
            else XB_SPIN(xb_ld(&bar[XB_TOPGEN]) == tg, bar);
            __builtin_amdgcn_fence(__ATOMIC_ACQUIRE, "agent");
            xb_add(&bar[XB_XGEN(b.x)], 1u);
            asm volatile("s_waitcnt vmcnt(0)" ::: "memory");
        } else {
            XB_SPIN(xb_ld(&bar[XB_XGEN(b.x)]) == gen, bar);
            __builtin_amdgcn_fence(__ATOMIC_ACQUIRE, "agent");
            asm volatile("s_waitcnt vmcnt(0)" ::: "memory");
        }
    }
    __syncthreads();
}

__device__ __forceinline__ float wave_sum(float v) {
#pragma unroll
    for (int o = 1; o < 64; o <<= 1) v += __shfl_xor(v, o);
    return v;
}

namespace pg8 {
#define PG8_LAS __attribute__((address_space(3)))
typedef unsigned short bf16_t;
typedef unsigned u32x4 __attribute__((ext_vector_type(4)));
constexpr int BM = 256, BK = 64, HALF = 128, HTB = HALF * BK * 2, STAGE_BYTES = 8 * HTB, NXCD = 8, WGM = 8;
__host__ __device__ __forceinline__ int lds_byte(int r, int c) { const int st = (r >> 4) * 2 + (c >> 5), rr = r & 15, cc = c & 31, ob = rr * 64 + cc * 2; return st * 1024 + (ob ^ (((ob >> 9) & 1) << 5)); }
__host__ __device__ __forceinline__ void stage_rc(int b, int& R, int& C) { const int st = b / 1024, sb = b % 1024, swz = sb ^ (((sb >> 9) & 1) << 5); R = (st >> 1) * 16 + swz / 64; C = (st & 1) * 32 + (swz % 64) / 2; }
__host__ __device__ __forceinline__ int perm32(int rho) { const int n = rho >> 4, i = rho & 15; return 8 * (i >> 2) + 4 * n + (i & 3); }

struct Unit { int pm, pn, e; };
struct Gemm { const bf16_t* A; const bf16_t* Bt; int M, N, K; size_t estride, astride; const int* tvalid; };
template <class E, class = void> struct epi_chain { static constexpr bool v = false; };
template <class E> struct epi_chain<E, decltype((void)E::CHAIN)> { static constexpr bool v = E::CHAIN; };

struct StaticOrder {
    int nM, nN, nwg, G, c;
    __host__ __device__ void init(int M, int N, int G_, int c_) { nM = M / BM; nN = N / BM; nwg = nM * nN; G = G_; c = c_; }
    __host__ __device__ __forceinline__ bool next(int i, Unit& u) const {
        const long L = (long)i * G + c; if (L >= nwg) return false;
        int wgid = (int)L; { const int q = nwg / NXCD, r = nwg % NXCD, xcd = wgid % NXCD, off = wgid / NXCD; wgid = (xcd < r ? xcd * (q + 1) : r * (q + 1) + (xcd - r) * q) + off; }
        const int nig = WGM * nN, gid = wgid / nig, fm = gid * WGM, gsz = (nM - fm) < WGM ? (nM - fm) : WGM;
        u.pm = fm + ((wgid % nig) % gsz); u.pn = (wgid % nig) / gsz; u.e = 0; return true;
    }
    __device__ __forceinline__ void a_ready(const Unit&) const {}
    __device__ __forceinline__ void done(const Unit&) const {}
};
struct PairOrder {
    StaticOrder S0; unsigned* cnt;
    __device__ __forceinline__ bool next(int i, Unit& u) const { Unit t; if (i >= 2 || !S0.next(0, t)) return false; u.pm = t.pm; u.pn = t.pn; u.e = i; return true; }
    __device__ __forceinline__ void a_ready(const Unit&) const {}
    __device__ __forceinline__ void done(const Unit& u) const {
        if (cnt != nullptr && u.e == 1) { asm volatile("s_waitcnt vmcnt(0)" ::: "memory"); __builtin_amdgcn_s_barrier();
            if (threadIdx.x == 0) { __builtin_amdgcn_fence(__ATOMIC_RELEASE, "agent"); asm volatile("s_waitcnt vmcnt(0)" ::: "memory"); __hip_atomic_fetch_add(cnt + 16 * u.pm, 1u, __ATOMIC_RELAXED, __HIP_MEMORY_SCOPE_AGENT); } }
    }
};
struct OneUnit {
    int pm, pn, e;
    __device__ __forceinline__ bool next(int i, Unit& u) const { if (i != 0) return false; u.pm = pm; u.pn = pn; u.e = e; return true; }
    __device__ __forceinline__ void a_ready(const Unit&) const {}
    __device__ __forceinline__ void done(const Unit&) const {}
};
struct StaticOrderSig {
    StaticOrder S0; unsigned* cnt;
    __device__ __forceinline__ bool next(int i, Unit& u) const { return S0.next(i, u); }
    __device__ __forceinline__ void a_ready(const Unit&) const {}
    __device__ __forceinline__ void done(const Unit& u) const {
        if (cnt != nullptr && u.pn < 4) { asm volatile("s_waitcnt vmcnt(0)" ::: "memory"); __builtin_amdgcn_s_barrier();
            if (threadIdx.x == 0) { __builtin_amdgcn_fence(__ATOMIC_RELEASE, "agent"); asm volatile("s_waitcnt vmcnt(0)" ::: "memory"); __hip_atomic_fetch_add(cnt, 1u, __ATOMIC_RELAXED, __HIP_MEMORY_SCOPE_AGENT); } }
    }
};
struct StaticOrderWait {
    StaticOrder S0; const unsigned* rdy; unsigned need;
    __device__ __forceinline__ bool next(int i, Unit& u) const { return S0.next(i, u); }
    __device__ __forceinline__ void a_ready(const Unit& u) const {
        if (rdy != nullptr) { if (threadIdx.x == 0) { unsigned sp = 0u; while (__hip_atomic_load(rdy + 16 * u.pm, __ATOMIC_RELAXED, __HIP_MEMORY_SCOPE_AGENT) < need) { __builtin_amdgcn_s_sleep(2); if (++sp > (1u << 24)) break; }
                __builtin_amdgcn_fence(__ATOMIC_ACQUIRE, "agent"); asm volatile("s_waitcnt vmcnt(0)" ::: "memory"); }
            __syncthreads(); }
    }
    __device__ __forceinline__ void done(const Unit&) const {}
};
struct GroupOrder {
    int nN, total, G, c; const int* t2e;
    __device__ void init(int nTiles, int nN_, int G_, int c_, const int* t2e_) { nN = nN_; total = nTiles * nN_; G = G_; c = c_; t2e = t2e_; }
    __device__ bool next(int i, Unit& u) const {
        const long L = (long)i * G + c; if (L >= total) return false;
        u.pm = (int)(L / nN); u.pn = (int)(L % nN); u.e = __builtin_amdgcn_readfirstlane(t2e[u.pm]); return true;
    }
    __device__ __forceinline__ void a_ready(const Unit&) const {}
    __device__ __forceinline__ void done(const Unit&) const {}
};

__device__ __forceinline__ void st8(bf16_t* p, f32x4 v0, f32x4 v1) { u32x4 w; w.x = pk2(v0[0], v0[1]); w.y = pk2(v0[2], v0[3]); w.z = pk2(v1[0], v1[1]); w.w = pk2(v1[2], v1[3]); *(u32x4*)p = w; }
__device__ __forceinline__ void ld8(const bf16_t* p, f32x4& v0, f32x4& v1) { const u32x4 w = *(const u32x4*)p; v0 = (f32x4){bflo(w.x), bfhi(w.x), bflo(w.y), bfhi(w.y)}; v1 = (f32x4){bflo(w.z), bfhi(w.z), bflo(w.w), bfhi(w.w)}; }

__device__ __forceinline__ void rope16(f32x4& v0, f32x4& v1, int row, int fq, const f32x2* rope) {
    const f32x2* rp = rope + (size_t)(row & (SEQ - 1)) * 16;
    f32x4 p0, p1;
#pragma unroll
    for (int e = 0; e < 4; ++e) { p0[e] = __shfl_xor(v0[e], 16); p1[e] = __shfl_xor(v1[e], 16); }
    if (fq < 2) {
        const float sg = fq == 0 ? -1.f : 1.f;
#pragma unroll
        for (int e = 0; e < 4; ++e) { const f32x2 a = rp[2 * e], b = rp[2 * (4 + e)];
            v0[e] = v0[e] * a.x + sg * p0[e] * a.y; v1[e] = v1[e] * b.x + sg * p1[e] * b.y; }
    }
}
__device__ __forceinline__ void rope32(f32x4& v0, f32x4& v1, int row, int fq, const f32x2* rope) {
    const f32x2* rp = rope + (size_t)(row & (SEQ - 1)) * 16 + 8 * (fq & 1);
    const float sg = fq < 2 ? -1.f : 1.f;
#pragma unroll
    for (int e = 0; e < 4; ++e) { const float p0 = __shfl_xor(v0[e], 32), p1 = __shfl_xor(v1[e], 32); const f32x2 a = rp[e], b = rp[4 + e];
        v0[e] = v0[e] * a.x + sg * p0 * a.y; v1[e] = v1[e] * b.x + sg * p1 * b.y; }
}
__device__ __forceinline__ float sigmoidf_(float x) { return __builtin_amdgcn_rcpf(1.f + __builtin_amdgcn_exp2f(-1.4426950408889634f * x)); }

struct EpiIn {
    static constexpr bool PERM = true, AFTER_DRAIN = false;
    bf16_t *CQ, *CKV, *QB, *KB, *VB, *QI, *KI, *KR, *GA, *GB; float* WI; const f32x2* rope; float* PART;
    __device__ __forceinline__ void operator()(const f32x4 (&acc)[2][2][4][2], const Unit& u, int wr, int wc, int fr, int fq) const {
        const int row0 = u.pm * BM + wr * 64 + fr;
#pragma unroll
        for (int bj = 0; bj < 2; ++bj) {
            const int cg = u.pn * BM + bj * HALF + wc * 32;
            bf16_t* base = nullptr; int pitch = 0, cc = 0, mode = 0; float sc = 1.f;
            if (cg < C_CKV) { base = CQ; pitch = 384; cc = cg; }
            else if (cg < C_QB) { base = CKV; pitch = 256; cc = cg - C_CKV; }
            else if (cg < C_KB) { base = QB; pitch = 512; cc = cg - C_QB; mode = ((cc >> 5) & 1) == 0 ? 1 : 0; sc = C2B; }
            else if (cg < C_VB) { base = KB; pitch = 512; cc = cg - C_KB; mode = ((cc >> 5) & 1) == 0 ? 1 : 0; }
            else if (cg < C_QI) { base = VB; pitch = 512; cc = cg - C_VB; }
            else if (cg < C_KR) { base = QI; pitch = 512; cc = cg - C_QI; mode = ((cc >> 5) & 1) == 0 ? 1 : 0; }
            else if (cg < C_KI) { base = KR; pitch = 32; cc = 0; mode = 2; }
            else if (cg < C_WI) { base = KI; pitch = 64; cc = cg - C_KI; mode = (cc == 0) ? 1 : 0; }
            else if (cg < C_GA) { mode = 4; }
            else if (cg < C_GB) { base = GA; pitch = 1024; cc = cg - C_GA; mode = 3; }
            else { base = GB; pitch = 1024; cc = cg - C_GB; mode = 3; }
#pragma unroll
            for (int ai = 0; ai < 2; ++ai)
#pragma unroll
                for (int m = 0; m < 4; ++m) {
                    const int row = row0 + ai * HALF + m * 16;
                    f32x4 v0 = acc[ai][bj][m][0], v1 = acc[ai][bj][m][1];
                    if (mode == 1) rope16(v0, v1, row, fq, rope);
                    else if (mode == 2) rope32(v0, v1, row, fq, rope);
                    else if (mode == 3) {
#pragma unroll
                        for (int e = 0; e < 4; ++e) { v0[e] = sigmoidf_(v0[e]); v1[e] = sigmoidf_(v1[e]); } }
                    if (cg < C_QB) {
                        float ss = ((v0[0] * v0[0] + v0[1] * v0[1]) + (v0[2] * v0[2] + v0[3] * v0[3])) + ((v1[0] * v1[0] + v1[1] * v1[1]) + (v1[2] * v1[2] + v1[3] * v1[3]));
                        ss += __shfl_xor(ss, 16); ss += __shfl_xor(ss, 32);
                        if (fq == 0) PART[(size_t)row * 20 + (cg >> 5)] = ss; }
                    if (mode == 4) { if (fq == 0) { *(f32x4*)(WI + (size_t)row * 8) = v0 * WI_SCALE; *(f32x4*)(WI + (size_t)row * 8 + 4) = v1 * WI_SCALE; } }
                    else { v0 = v0 * sc; v1 = v1 * sc; st8(base + (size_t)row * pitch + cc + 8 * fq, v0, v1); }
                }
        }
    }
};
struct EpiQA {
    static constexpr bool PERM = true, AFTER_DRAIN = false;
    bf16_t* QA; const f32x2* rope; const PG8_LAS float* RS;
    __device__ __forceinline__ void operator()(const f32x4 (&acc)[2][2][4][2], const Unit& u, int wr, int wc, int fr, int fq) const {
        const int row0 = u.pm * BM + wr * 64 + fr; const PG8_LAS float* rsp = RS + wr * 64 + fr;
#pragma unroll
        for (int bj = 0; bj < 2; ++bj) {
            const int cg = u.pn * BM + bj * HALF + wc * 32; const bool rot = ((cg >> 5) % 3) == 2;
#pragma unroll
            for (int ai = 0; ai < 2; ++ai)
#pragma unroll
                for (int m = 0; m < 4; ++m) {
                    const int row = row0 + ai * HALF + m * 16;
                    f32x4 v0 = acc[ai][bj][m][0], v1 = acc[ai][bj][m][1];
                    if (rot) rope32(v0, v1, row, fq, rope);
                    { const float rsv = rsp[ai * HALF + m * 16]; v0 = v0 * rsv; v1 = v1 * rsv; } st8(QA + (size_t)row * 768 + cg + 8 * fq, v0, v1);
                }
        }
    }
};
struct EpiKV {
    static constexpr bool PERM = true, AFTER_DRAIN = false;
    bf16_t *KN, *VA; const PG8_LAS float* RS;
    __device__ __forceinline__ void operator()(const f32x4 (&acc)[2][2][4][2], const Unit& u, int wr, int wc, int fr, int fq) const {
        const int row0 = u.pm * BM + wr * 64 + fr; const PG8_LAS float* rsp = RS + wr * 64 + fr;
#pragma unroll
        for (int bj = 0; bj < 2; ++bj) {
            const int cg = u.pn * BM + bj * HALF + wc * 32; bf16_t* base = cg < 512 ? KN : VA; const int cc = (cg & 511) + 8 * fq;
#pragma unroll
            for (int ai = 0; ai < 2; ++ai)
#pragma unroll
                for (int m = 0; m < 4; ++m) { const int row = row0 + ai * HALF + m * 16; const float rsv = rsp[ai * HALF + m * 16]; st8(base + (size_t)row * 512 + cc, acc[ai][bj][m][0] * rsv, acc[ai][bj][m][1] * rsv); }
        }
    }
};
template <int ADD> struct EpiY {
    static constexpr bool PERM = true, AFTER_DRAIN = false;
    bf16_t* Y; const bf16_t* Gt;
    __device__ __forceinline__ void operator()(const f32x4 (&acc)[2][2][4][2], const Unit& u, int wr, int wc, int fr, int fq) const {
        const int row0 = u.pm * BM + wr * 64 + fr;
#pragma unroll
        for (int bj = 0; bj < 2; ++bj) {
            const int c0 = u.pn * BM + bj * HALF + wc * 32 + 8 * fq;
#pragma unroll
            for (int ai = 0; ai < 2; ++ai)
#pragma unroll
                for (int m = 0; m < 4; ++m) { const size_t off = (size_t)(row0 + ai * HALF + m * 16) * 1024 + c0;
                    f32x4 g0, g1; ld8(Gt + off, g0, g1);
                    f32x4 v0 = acc[ai][bj][m][0] * g0, v1 = acc[ai][bj][m][1] * g1;
                    if (ADD) { f32x4 o0, o1; ld8(Y + off, o0, o1); v0 = v0 + o0; v1 = v1 + o1; }
                    st8(Y + off, v0, v1); }
        }
    }
};
struct EpiYC {
    static constexpr bool PERM = true, AFTER_DRAIN = false, CHAIN = true;
    bf16_t* Y; const bf16_t *Ga, *Gb;
    __device__ __forceinline__ size_t offs(const Unit& u, int row0, int wc, int fq, int it) const { const int bj = it >> 3, ai = (it >> 2) & 1, m = it & 3;
        return (size_t)(row0 + ai * HALF + m * 16) * 1024 + u.pn * BM + bj * HALF + wc * 32 + 8 * fq; }
    __device__ __forceinline__ void operator()(f32x4 (&acc)[2][2][4][2], const Unit& u, int wr, int wc, int fr, int fq) const {
        const int row0 = u.pm * BM + wr * 64 + fr;
        if (u.e == 0) {
#pragma unroll
            for (int it = 0; it < 16; ++it) { const int bj = it >> 3, ai = (it >> 2) & 1, m = it & 3; const size_t off = offs(u, row0, wc, fq, it);
                f32x4 b0, b1, a0, a1; ld8(Gb + off, b0, b1); ld8(Ga + off, a0, a1);
#pragma unroll
                for (int e = 0; e < 4; ++e) { acc[ai][bj][m][0][e] *= a0[e] * __builtin_amdgcn_rcpf(fmaxf(b0[e], 1e-30f)); acc[ai][bj][m][1][e] *= a1[e] * __builtin_amdgcn_rcpf(fmaxf(b1[e], 1e-30f)); } }
        } else {
            size_t off = offs(u, row0, wc, fq, 0); u32x4 gw = *(const u32x4*)(Gb + off);
#pragma unroll
            for (int it = 0; it < 16; ++it) { const int bj = it >> 3, ai = (it >> 2) & 1, m = it & 3; const size_t o = off; const u32x4 w = gw;
                if (it + 1 < 16) { off = offs(u, row0, wc, fq, it + 1); gw = *(const u32x4*)(Gb + off); }
                f32x4 b0 = (f32x4){bflo(w.x), bfhi(w.x), bflo(w.y), bfhi(w.y)}, b1 = (f32x4){bflo(w.z), bfhi(w.z), bflo(w.w), bfhi(w.w)};
#pragma unroll
                for (int e = 0; e < 4; ++e) { b0[e] = fmaxf(b0[e], 1e-30f); b1[e] = fmaxf(b1[e], 1e-30f); }
                st8(Y + o, acc[ai][bj][m][0] * b0, acc[ai][bj][m][1] * b1); }
        }
    }
};
struct EpiX1 {
    static constexpr bool PERM = true, AFTER_DRAIN = false;
    const float* X; float* O; bf16_t* XB;
    __device__ __forceinline__ size_t offs(const Unit& u, int row0, int wc, int fq, int it) const { const int ai = it >> 3, m = (it >> 1) & 3, bj = it & 1;
        return (size_t)(row0 + ai * HALF + m * 16) * 1024 + u.pn * BM + bj * HALF + wc * 32 + 8 * fq; }
    __device__ __forceinline__ void operator()(const f32x4 (&acc)[2][2][4][2], const Unit& u, int wr, int wc, int fr, int fq) const {
        const int row0 = u.pm * BM + wr * 64 + fr;
        size_t off = offs(u, row0, wc, fq, 0); f32x4 xa = *(const f32x4*)(X + off), xb = *(const f32x4*)(X + off + 4);
#pragma unroll
        for (int it = 0; it < 16; ++it) { const int ai = it >> 3, m = (it >> 1) & 3, bj = it & 1;
            const f32x4 v0 = xa + acc[ai][bj][m][0], v1 = xb + acc[ai][bj][m][1]; const size_t o = off;
            if (it + 1 < 16) { off = offs(u, row0, wc, fq, it + 1); xa = *(const f32x4*)(X + off); xb = *(const f32x4*)(X + off + 4); }
            st8(XB + o, v0, v1); }
    }
};


struct EpiHid {
    static constexpr bool PERM = true, AFTER_DRAIN = false;
    bf16_t* HID; const float* SR;
    __device__ __forceinline__ void operator()(const f32x4 (&acc)[2][2][4][2], const Unit& u, int wr, int wc, int fr, int fq) const {
        const int row0 = u.pm * BM + wr * 64 + fr, c0 = u.pn * 128 + wc * 32 + 8 * fq;
        float rsv[8];
#pragma unroll
        for (int i = 0; i < 8; ++i) rsv[i] = SR[row0 + (i >> 2) * HALF + (i & 3) * 16];
#pragma unroll
        for (int ai = 0; ai < 2; ++ai)
#pragma unroll
            for (int m = 0; m < 4; ++m) { f32x4 h0, h1; const float rs = rsv[4 * ai + m];
#pragma unroll
                for (int e = 0; e < 4; ++e) { const float g0 = acc[ai][0][m][0][e] * rs, g1 = acc[ai][0][m][1][e] * rs;
                    h0[e] = g0 * sigmoidf_(g0) * (acc[ai][1][m][0][e] * rs); h1[e] = g1 * sigmoidf_(g1) * (acc[ai][1][m][1][e] * rs); }
                st8(HID + (size_t)(row0 + ai * HALF + m * 16) * 256 + c0, h0, h1); }
    }
};
struct EpiDown {
    static constexpr bool PERM = true, AFTER_DRAIN = false;
    bf16_t* SL; const int* sslot; const float* sw;
    __device__ __forceinline__ void operator()(const f32x4 (&acc)[2][2][4][2], const Unit& u, int wr, int wc, int fr, int fq) const {
        const int row0 = u.pm * BM + wr * 64 + fr;
        int slots[8]; float ws_[8];
#pragma unroll
        for (int i = 0; i < 8; ++i) { const int r = row0 + (i >> 2) * HALF + (i & 3) * 16; slots[i] = sslot[r]; ws_[i] = sw[r]; }
#pragma unroll
        for (int ai = 0; ai < 2; ++ai)
#pragma unroll
            for (int m = 0; m < 4; ++m) { const int slot = slots[4 * ai + m]; const float w = ws_[4 * ai + m];
                if (slot >= 0) {
#pragma unroll
                    for (int bj = 0; bj < 2; ++bj) st8(SL + (size_t)slot * 1024 + u.pn * BM + bj * HALF + wc * 32 + 8 * fq, acc[ai][bj][m][0] * w, acc[ai][bj][m][1] * w); } }
    }
};
template <class Epi, class Sched, bool ALIGN_EPI = false, bool SP2 = false, bool GATHER = false>
__device__ __forceinline__ void gemm_phase(PG8_LAS unsigned char* lds, const Gemm g, const Sched& S, const Epi& E, const int* gidx = nullptr) {
    const int tid = threadIdx.x, wid = __builtin_amdgcn_readfirstlane(tid >> 6), lane = tid & 63, wr = wid >> 2, wc = wid & 3, fr = lane & 15, fq = lane >> 4;
    const int K = g.K, nt = K / BK;
    unsigned voffA[2], voffA1[2] = {0u, 0u}, voffB[2];
#pragma unroll
    for (int i = 0; i < 2; ++i) { int R, C; stage_rc(tid * 16 + i * 8192, R, C); const int Rb = Epi::PERM ? ((R & ~31) + perm32(R & 31)) : R;
        voffA[i] = (unsigned)(R * K + C) * 2u; voffB[i] = (unsigned)(Rb * K + C) * 2u; }
    const size_t kstep = (size_t)(BK * 2);
    const size_t hstep = (size_t)HALF * K * 2;
    const size_t tstep = 2 * hstep, ahstep = GATHER ? 0 : hstep;
    const unsigned ldsw = (unsigned)wid * 1024u;
    const int aoff = lds_byte(wr * 64 + fr, fq * 8), boff = lds_byte(wc * 32 + fr, fq * 8);
#define PG8_SA(b, h) (((b) * 2 + (h)) * HTB)
#define PG8_SB(b, h) ((4 + (b) * 2 + (h)) * HTB)
#define PG8_STAGE(bufoff, gbase, voff) do { _Pragma("unroll") for (int _i = 0; _i < 2; ++_i) \
        __builtin_amdgcn_global_load_lds((const unsigned*)((const char*)(gbase) + (voff)[_i]), (PG8_LAS unsigned*)(lds + (bufoff) + ldsw + _i * 8192), 16, 0, 0); } while (0)
#define PG8_LDA(dst, b, h) do { _Pragma("unroll") for (int m = 0; m < 4; ++m) _Pragma("unroll") for (int k = 0; k < 2; ++k) dst[m][k] = *(const PG8_LAS bf16x8*)(lds + PG8_SA(b, h) + aoff + m * 2048 + k * 1024); } while (0)
#define PG8_LDB(dst, b, h) do { _Pragma("unroll") for (int n = 0; n < 2; ++n) _Pragma("unroll") for (int k = 0; k < 2; ++k) dst[n][k] = *(const PG8_LAS bf16x8*)(lds + PG8_SB(b, h) + boff + n * 2048 + k * 1024); } while (0)
#define PG8_MMA(ai, bj, At, Bt) do { __builtin_amdgcn_s_setprio(1); _Pragma("unroll") for (int m = 0; m < 4; ++m) _Pragma("unroll") for (int n = 0; n < 2; ++n) _Pragma("unroll") for (int k = 0; k < 2; ++k) \
        acc[ai][bj][m][n] = __builtin_amdgcn_mfma_f32_16x16x32_bf16(Bt[n][k], At[m][k], acc[ai][bj][m][n], 0, 0, 0); __builtin_amdgcn_s_setprio(0); } while (0)
#define PG8_WAIT_V(n) asm volatile("s_waitcnt vmcnt(" #n ")" ::: "memory")
#define PG8_WAIT_L(n) asm volatile("s_waitcnt lgkmcnt(" #n ")" ::: "memory")
#define PG8_BAR __builtin_amdgcn_s_barrier()
#define PG8_SCHED __builtin_amdgcn_sched_barrier(0)
    Unit cur, nxt; int ui = 0;
    if (!S.next(0, cur)) return;
    f32x4 acc[2][2][4][2];
#pragma unroll
    for (int a = 0; a < 2; ++a)
#pragma unroll
        for (int b = 0; b < 2; ++b)
#pragma unroll
            for (int m = 0; m < 4; ++m)
#pragma unroll
                for (int n = 0; n < 2; ++n) acc[a][b][m][n] = (f32x4){0.f, 0.f, 0.f, 0.f};
    bf16x8 At[4][2], B0[2][2], B1[2][2];
    if constexpr (GATHER) {
#pragma unroll
        for (int i = 0; i < 2; ++i) { int R, C; stage_rc(tid * 16 + i * 8192, R, C);
            voffA[i] = (unsigned)(gidx[cur.pm * BM + R] * K + C) * 2u; voffA1[i] = (unsigned)(gidx[cur.pm * BM + HALF + R] * K + C) * 2u; } }
    const char* cA = (const char*)g.A + (size_t)cur.e * g.astride + (GATHER ? (size_t)0 : (size_t)cur.pm * tstep); const char* cB = (const char*)g.Bt + (size_t)cur.e * g.estride + (size_t)cur.pn * tstep;
    bool skip1 = g.tvalid != nullptr && __builtin_amdgcn_readfirstlane(g.tvalid[cur.pm]) <= HALF;
    if constexpr (!SP2) S.a_ready(cur);
    if constexpr (SP2) {
        PG8_STAGE(PG8_SB(0, 0), cB, voffB); PG8_STAGE(PG8_SB(0, 1), cB + hstep, voffB); S.a_ready(cur);
        PG8_STAGE(PG8_SA(0, 0), cA, voffA); PG8_STAGE(PG8_SA(0, 1), cA + ahstep, (GATHER ? voffA1 : voffA));
        if (wr == 1) PG8_BAR;
        PG8_WAIT_V(2); PG8_BAR;
        PG8_STAGE(PG8_SB(1, 0), cB + kstep, voffB); PG8_STAGE(PG8_SA(1, 0), cA + kstep, voffA); PG8_STAGE(PG8_SB(1, 1), cB + hstep + kstep, voffB);
        PG8_WAIT_V(6); PG8_BAR;
    } else {
        PG8_STAGE(PG8_SB(0, 0), cB, voffB); PG8_STAGE(PG8_SA(0, 0), cA, voffA); PG8_STAGE(PG8_SB(0, 1), cB + hstep, voffB); PG8_STAGE(PG8_SA(0, 1), cA + ahstep, (GATHER ? voffA1 : voffA));
        if (wr == 1) PG8_BAR;
        PG8_WAIT_V(4); PG8_BAR;
        PG8_STAGE(PG8_SB(1, 0), cB + kstep, voffB); PG8_STAGE(PG8_SA(1, 0), cA + kstep, voffA); PG8_STAGE(PG8_SB(1, 1), cB + hstep + kstep, voffB);
        PG8_WAIT_V(6); PG8_BAR;
    }
    for (;;) {
        const bool has_next = S.next(ui + 1, nxt);
        const char* nA = has_next ? (const char*)g.A + (size_t)nxt.e * g.astride + (size_t)nxt.pm * tstep : cA; const char* nB = has_next ? (const char*)g.Bt + (size_t)nxt.e * g.estride + (size_t)nxt.pn * tstep : cB;
#pragma nounroll
        for (int t = 0; t < nt; t += 2) {
            const bool last = (t == nt - 2);
            const char* a1 = cA + (size_t)(t + 1) * kstep;
            const char* a2 = last ? nA : cA + (size_t)(t + 2) * kstep; const char* b2 = last ? nB : cB + (size_t)(t + 2) * kstep;
            const char* a3 = a2 + kstep; const char* b3 = b2 + kstep;
            if (last && has_next) S.a_ready(nxt);
            if constexpr (SP2) {
            PG8_LDB(B0, 0, 0); PG8_LDB(B1, 0, 1); PG8_SCHED; PG8_LDA(At, 0, 0); PG8_STAGE(PG8_SA(1, 1), a1 + ahstep, (GATHER ? voffA1 : voffA));
            PG8_WAIT_V(8); PG8_WAIT_L(0); PG8_BAR; PG8_MMA(0, 0, At, B0); PG8_MMA(0, 1, At, B1); PG8_BAR; PG8_SCHED;
            if (!skip1) PG8_LDA(At, 0, 1); PG8_STAGE(PG8_SB(0, 0), b2, voffB); PG8_STAGE(PG8_SB(0, 1), b2 + hstep, voffB); PG8_STAGE(PG8_SA(0, 0), a2, voffA);
            PG8_WAIT_V(8); PG8_WAIT_L(0); PG8_BAR; if (!skip1) { PG8_MMA(1, 0, At, B0); PG8_MMA(1, 1, At, B1); } PG8_BAR; PG8_SCHED;
            PG8_LDB(B0, 1, 0); PG8_LDB(B1, 1, 1); PG8_SCHED; PG8_LDA(At, 1, 0); PG8_STAGE(PG8_SA(0, 1), a2 + ahstep, (GATHER ? voffA1 : voffA));
            PG8_WAIT_V(8); PG8_WAIT_L(0); PG8_BAR; PG8_MMA(0, 0, At, B0); PG8_MMA(0, 1, At, B1); PG8_BAR; PG8_SCHED;
            if (!skip1) PG8_LDA(At, 1, 1); PG8_STAGE(PG8_SB(1, 0), b3, voffB); PG8_STAGE(PG8_SB(1, 1), b3 + hstep, voffB); PG8_STAGE(PG8_SA(1, 0), a3, voffA);
            PG8_WAIT_V(8); PG8_WAIT_L(0); PG8_BAR; if (!skip1) { PG8_MMA(1, 0, At, B0); PG8_MMA(1, 1, At, B1); } PG8_BAR; PG8_SCHED;
            } else {
            PG8_LDB(B0, 0, 0); PG8_SCHED; PG8_LDA(At, 0, 0); PG8_STAGE(PG8_SA(1, 1), a1 + ahstep, (GATHER ? voffA1 : voffA));
            PG8_WAIT_L(8); PG8_BAR; PG8_WAIT_L(0); PG8_MMA(0, 0, At, B0); PG8_BAR; PG8_SCHED;
            PG8_LDB(B1, 0, 1); PG8_STAGE(PG8_SB(0, 0), b2, voffB);
            PG8_BAR; PG8_WAIT_L(0); PG8_MMA(0, 1, At, B1); PG8_BAR;
            PG8_LDA(At, 0, 1); PG8_STAGE(PG8_SA(0, 0), a2, voffA);
            PG8_BAR; PG8_WAIT_L(0); PG8_MMA(1, 0, At, B0); PG8_BAR; PG8_SCHED;
            PG8_STAGE(PG8_SB(0, 1), b2 + hstep, voffB);
            PG8_WAIT_V(6); PG8_BAR; PG8_MMA(1, 1, At, B1); PG8_BAR;
            PG8_LDB(B0, 1, 0); PG8_SCHED; PG8_LDA(At, 1, 0); PG8_STAGE(PG8_SA(0, 1), a2 + ahstep, (GATHER ? voffA1 : voffA));
            PG8_WAIT_L(8); PG8_BAR; PG8_WAIT_L(0); PG8_MMA(0, 0, At, B0); PG8_BAR; PG8_SCHED;
            PG8_LDB(B1, 1, 1); PG8_STAGE(PG8_SB(1, 0), b3, voffB);
            PG8_BAR; PG8_WAIT_L(0); PG8_MMA(0, 1, At, B1); PG8_BAR;
            PG8_LDA(At, 1, 1); PG8_STAGE(PG8_SA(1, 0), a3, voffA);
            PG8_BAR; PG8_WAIT_L(0); PG8_MMA(1, 0, At, B0); PG8_BAR; PG8_SCHED;
            PG8_STAGE(PG8_SB(1, 1), b3 + hstep, voffB);
            PG8_WAIT_V(6); PG8_BAR; PG8_MMA(1, 1, At, B1); PG8_BAR;
            }
        }
        if constexpr (ALIGN_EPI) { if (wr == 0) PG8_BAR; }
        if constexpr (!Epi::AFTER_DRAIN) { E(acc, cur, wr, wc, fr, fq); S.done(cur); }
        if (!has_next) break;
        if (!(epi_chain<Epi>::v && cur.e == 0)) {
#pragma unroll
        for (int a = 0; a < 2; ++a)
#pragma unroll
            for (int b = 0; b < 2; ++b)
#pragma unroll
                for (int m = 0; m < 4; ++m)
#pragma unroll
                    for (int n = 0; n < 2; ++n) acc[a][b][m][n] = (f32x4){0.f, 0.f, 0.f, 0.f};
        }
        cur = nxt; cA = nA; cB = nB; ++ui; skip1 = g.tvalid != nullptr && __builtin_amdgcn_readfirstlane(g.tvalid[cur.pm]) <= HALF;
        if constexpr (ALIGN_EPI) { if (wr == 1) PG8_BAR; }
    }
    PG8_WAIT_V(0);
    if constexpr (!ALIGN_EPI) { if (wr == 0) PG8_BAR; }
    PG8_BAR;
    if constexpr (Epi::AFTER_DRAIN) { E.fused(acc, cur, wr, wc, fr, fq, lds, wid, lane); S.done(cur); }
#undef PG8_SA
#undef PG8_SB
#undef PG8_STAGE
#undef PG8_LDA
#undef PG8_LDB
#undef PG8_MMA
#undef PG8_WAIT_V
#undef PG8_WAIT_L
#undef PG8_BAR
#undef PG8_SCHED
}
}

struct Args { const float* in[20]; float* out; unsigned char* ws; int ph_lo, ph_hi; };
struct Frame {
    LAS unsigned char* lds; volatile LAS unsigned* MISC; gu32* ctl; unsigned char* ws;
    int vcu, G;
};
#define F_TID ((int)threadIdx.x)
#define F_LANE ((int)(threadIdx.x & 63))
#define F_WAVE (__builtin_amdgcn_readfirstlane((int)(threadIdx.x >> 6)))

__device__ __forceinline__ int in_src_col(int n) {
    if (n < 640) return n;
    if (n < 2688) return n + 32;
    if (n < 2720) return n - 2688 + 640;
    if (n < 2792) return n;
    if (n < 2816) return -1;
    return n - 24;
}
struct TrDesc { const float* colptr; int ld, k0; bf16* WT; int Kd, destrow0; const float* gain; };
__device__ __forceinline__ void tr_load(const TrDesc& d, int lane, f32x4 (&v)[16]) {
    const int kr = lane >> 4;
#pragma unroll
    for (int it = 0; it < 16; ++it) { const int kk = 4 * it + kr; v[it] = (f32x4){0.f, 0.f, 0.f, 0.f}; if (d.colptr) v[it] = *(const GAS f32x4*)(d.colptr + (size_t)(d.k0 + kk) * d.ld); if (d.gain) v[it] = v[it] * d.gain[d.k0 + kk]; }
}
__device__ __forceinline__ void tr_store(const TrDesc& d, int lane, const f32x4 (&v)[16], LAS float* scr) {
    const int nq = lane & 15, kr = lane >> 4;
#pragma unroll
    for (int it = 0; it < 16; ++it) { const int kk = 4 * it + kr; LAS float* q = scr + kk * 65 + 4 * nq; q[0] = v[it].x; q[1] = v[it].y; q[2] = v[it].z; q[3] = v[it].w; }
    LDS_WAIT(); asm volatile("" ::: "memory");
    const int c = lane & 7;
#pragma unroll
    for (int j = 0; j < 8; ++j) { const int n = (lane >> 3) + 8 * j; const LAS float* q = scr + (8 * c) * 65 + n;
        v4u o; o.x = pk2(q[0 * 65], q[1 * 65]); o.y = pk2(q[2 * 65], q[3 * 65]); o.z = pk2(q[4 * 65], q[5 * 65]); o.w = pk2(q[6 * 65], q[7 * 65]);
        *(GAS v4u*)(d.WT + (size_t)(d.destrow0 + n) * d.Kd + d.k0 + 8 * c) = o; }
    LDS_WAIT(); asm volatile("" ::: "memory");
}
constexpr int CV_I0 = 16 * 76, CV_I1 = 6 * 12, CV_I2 = 4 * 16, CV_I3 = 8 * 16, CV_I4 = 8 * 16, CV_I5 = 16 * 16, CV_I6 = 32 * 16 * 8, CV_I7 = 32 * 4 * 16;
constexpr int CV_EARLY = CV_I0 + CV_I1 + CV_I2, CV_LATE = CV_I3 + CV_I4 + CV_I5 + CV_I6 + CV_I7, CV_QITEMS = CV_LATE / 16;
static_assert(CV_LATE % 16 == 0, "late conversion tiles come in queue items of 16");
__device__ __forceinline__ TrDesc conv_desc(const Args& A, unsigned char* ws, int it, int lane) {
    const int n4 = 4 * (lane & 15);
    int r = it;
    if (r < CV_I0) { const int kb = r / 76, nb = r % 76; const int col = in_src_col(64 * nb + n4);
        return TrDesc{col >= 0 ? A.in[2] + col : nullptr, NIN_SRC, 64 * kb, (bf16*)(ws + WS_WIN), 1024, 64 * nb, nullptr}; } r -= CV_I0;
    if (r < CV_I1) { const int kb = r / 12, nb = r % 12; return TrDesc{A.in[4] + 64 * nb + n4, 768, 64 * kb, (bf16*)(ws + WS_WUQ), 384, 64 * nb, A.in[3]}; } r -= CV_I1;
    if (r < CV_I2) { const int kb = r / 16, nb = r % 16; const int n = 64 * nb + n4;
        return TrDesc{n < 512 ? A.in[6] + n : A.in[7] + (n - 512), 512, 64 * kb, (bf16*)(ws + WS_WUKV), 256, 64 * nb, A.in[5]}; } r -= CV_I2;
    if (r < CV_I3) { const int kb = r / 16, nb = r % 16; return TrDesc{A.in[8] + 64 * nb + n4, 1024, 64 * kb, (bf16*)(ws + WS_WOA), 512, 64 * nb, nullptr}; } r -= CV_I3;
    if (r < CV_I4) { const int kb = r / 16, nb = r % 16; return TrDesc{A.in[9] + 64 * nb + n4, 1024, 64 * kb, (bf16*)(ws + WS_WOB), 512, 64 * nb, nullptr}; } r -= CV_I4;
    if (r < CV_I5) { const int kb = r / 16, nb = r % 16; return TrDesc{A.in[10] + 64 * nb + n4, 1024, 64 * kb, (bf16*)(ws + WS_WOUT), 1024, 64 * nb, nullptr}; } r -= CV_I5;
    if (r < CV_I6) { const int e = r / 128, rr = r % 128, kb = rr / 8, nb = rr % 8; const int n = 64 * nb + n4, pn = n >> 8, c = n & 255, col = 128 * pn + (c & 127);
        const float* src = ((c >> 7) ? A.in[17] : A.in[16]) + (size_t)e * 1024 * 256 + col;
        return TrDesc{src, 256, 64 * kb, (bf16*)(ws + WS_WGU) + (size_t)e * 512 * 1024, 1024, 64 * nb, A.in[11]}; } r -= CV_I6;
    { const int e = r / 64, rr = r % 64, kb = rr / 16, nb = rr % 16;
        return TrDesc{A.in[18] + (size_t)e * 256 * 1024 + 64 * nb + n4, 1024, 64 * kb, (bf16*)(ws + WS_WD) + (size_t)e * 1024 * 256, 256, 64 * nb, nullptr}; }
}
__device__ __forceinline__ void conv_tile(const Args& A, unsigned char* ws, int it, LAS float* scr, int lane) {
    const TrDesc d = conv_desc(A, ws, it, lane); f32x4 v[16]; tr_load(d, lane, v); tr_store(d, lane, v, scr);
}
__device__ __forceinline__ void conv_tile2(const Args& A, unsigned char* ws, int it0, int it1, LAS float* scr, int lane) {
    const TrDesc d0 = conv_desc(A, ws, it0, lane), d1 = conv_desc(A, ws, it1, lane); f32x4 v0[16], v1[16];
    tr_load(d0, lane, v0); tr_load(d1, lane, v1); tr_store(d0, lane, v0, scr); tr_store(d1, lane, v1, scr);
}
__device__ __forceinline__ void p0_prologue(Frame& F, const Args& A) {
    LAS float* scr = (LAS float*)(F.lds + F_WAVE * 16640);
    const int gw = F.vcu * NWAVES + F_WAVE, NGW = F.G * NWAVES, lane = F_LANE;
    unsigned char* ws = F.ws;
#ifdef CONV_IN_P0
    for (int it = gw; it < CV_EARLY + CV_LATE; it += NGW) conv_tile(A, ws, it, scr, lane);
#else
    for (int it = gw; it < CV_EARLY; it += NGW) conv_tile(A, ws, it, scr, lane);
#endif
    const float* x = A.in[0]; const float* g1 = A.in[1]; bf16* H = (bf16*)(ws + WS_H);
    for (int m0 = gw; m0 < T; m0 += 4 * NGW) {
        f32x4 v[4][4];
#pragma unroll
        for (int r = 0; r < 4; ++r) { const int m = min(m0 + r * NGW, T - 1); const GAS f32x4* xr = (const GAS f32x4*)(x + (size_t)m * D) + lane;
#pragma unroll
            for (int j = 0; j < 4; ++j) v[r][j] = xr[64 * j]; }
#pragma unroll
        for (int r = 0; r < 4; ++r) { const int m = m0 + r * NGW; float s = 0.f;
#pragma unroll
            for (int j = 0; j < 4; ++j) s += (v[r][j].x * v[r][j].x + v[r][j].y * v[r][j].y) + (v[r][j].z * v[r][j].z + v[r][j].w * v[r][j].w);
            const float rstd = 1.f / sqrtf(wave_sum(s) * (1.f / D) + EPS);
            if (m < T) { GAS v2u* o8 = (GAS v2u*)(H + (size_t)m * D) + lane;
#pragma unroll
                for (int j = 0; j < 4; ++j) { const f32x4 g = *((const GAS f32x4*)g1 + lane + 64 * j); const f32x4 y = v[r][j] * rstd * g; v2u w; w.x = pk2(y.x, y.y); w.y = pk2(y.z, y.w); o8[64 * j] = w; } } }
    }
    { float* wrt = (float*)(ws + WS_WRT); const float* g2 = A.in[11];
      for (int idx = F.vcu * NTHR + F_TID; idx < 40 * 1024; idx += F.G * NTHR) { const int col = idx >> 10, k = idx & 1023;
          wrt[idx] = (col < 32 ? A.in[14][(size_t)k * 32 + col] : A.in[12][(size_t)k * 8 + (col - 32)]) * g2[k]; } }
    f32x2* rope = (f32x2*)(ws + WS_ROPE);
    for (int idx = (F.vcu * NTHR + F_TID); idx < SEQ * 16; idx += F.G * NTHR) {
        const int pos = idx >> 4, i = idx & 15;
        const double REV[16] = {0.15915494309189535, 0.0700865215877985, 0.03086376340470123, 0.013591370636193905, 0.005985185712713705, 0.002635675898667414, 0.001160663641240061, 0.0005111175045375439,
                                0.00022507907903927653, 9.911730936901935e-05, 4.364795279280289e-05, 1.9221100684944863e-05, 8.464330808241401e-06, 3.727408601915352e-06, 1.6414262627950345e-06, 7.228293068832865e-07};
        double rv = 0.0;
#pragma unroll
        for (int k = 0; k < 16; ++k) rv = (i == k) ? REV[k] : rv;
        double t = (double)pos * rv; t -= __builtin_floor(t);
        const float tf = (float)t;
        rope[idx] = (f32x2){__builtin_amdgcn_cosf(tf), __builtin_amdgcn_sinf(tf)};
    }
}

__device__ __forceinline__ void p2a_norms(Frame& F, const Args& A) {
    const int gw = F.vcu * NWAVES + F_WAVE, NGW = F.G * NWAVES, lane = F_LANE;
    bf16* CQ = (bf16*)(F.ws + WS_CQ); bf16* CKV = (bf16*)(F.ws + WS_CKV);
    const float* gq = A.in[3]; const float* gkv = A.in[5];
    for (int m = gw; m < T; m += NGW) {
        {
            GAS unsigned* p = (GAS unsigned*)(CQ + (size_t)m * 384) + lane; unsigned w[3]; float s = 0.f;
#pragma unroll
            for (int j = 0; j < 3; ++j) { w[j] = p[64 * j]; const float a = bflo(w[j]), b = bfhi(w[j]); s += a * a + b * b; }
            const float rstd = 1.f / sqrtf(wave_sum(s) * (1.f / 384.f) + EPS);
#pragma unroll
            for (int j = 0; j < 3; ++j) { const f32x2 g = *((const GAS f32x2*)gq + lane + 64 * j); p[64 * j] = pk2(bflo(w[j]) * rstd * g.x, bfhi(w[j]) * rstd * g.y); }
        }
        {
            GAS v2u* p = (GAS v2u*)(CKV + (size_t)m * 256) + lane; const v2u w = *p;
            const float a = bflo(w.x), b = bfhi(w.x), c = bflo(w.y), d = bfhi(w.y);
            const float rstd = 1.f / sqrtf(wave_sum(a * a + b * b + c * c + d * d) * (1.f / 256.f) + EPS);
            const f32x4 g = *((const GAS f32x4*)gkv + lane); v2u o; o.x = pk2(a * rstd * g.x, b * rstd * g.y); o.y = pk2(c * rstd * g.z, d * rstd * g.w); *p = o;
        }
    }
}

__device__ __forceinline__ constexpr int crow(int r, int hi) { return (r & 3) + 8 * (r >> 2) + 4 * hi; }
constexpr float ATT_THR = 8.f;
__device__ __forceinline__ float att_mask(float p, unsigned w, int bit) { int mk; unsigned r;
    asm("v_bfe_i32 %0, %1, %2, 1" : "=v"(mk) : "v"(w), "i"(bit)); r = __builtin_bit_cast(unsigned, p) & (unsigned)mk; return __builtin_bit_cast(float, r); }
struct AttnP { const bf16 *Q, *K, *K2, *V; bf16* O; const unsigned* BM; };
template <bool MLA> __device__ __forceinline__ void attn_unit(LAS unsigned char* L, int b, int h, int qb, const AttnP& P, int tid, int lane, int wave) {
    constexpr int DK = MLA ? 96 : 64, KP = DK * 2 + 16, NS = DK / 16, CPR = DK / 8;
    constexpr int QPITCH = MLA ? 768 : 512, VP = 192, KBUF = 64 * KP, VBUF = 64 * VP;
    const int r32 = lane & 31, hi = lane >> 5;
    const size_t rowb = (size_t)b * SEQ;
    const int qrow = qb * 256 + wave * 32 + r32;
    bf16x8 qf[NS];
    { const bf16* qp = P.Q + (rowb + qrow) * QPITCH + h * DK;
#pragma unroll
      for (int s = 0; s < NS; ++s) qf[s] = *(const bf16x8*)(qp + 16 * s + 8 * hi); }
    const int NT = 4 * qb + 4, my_nt = 4 * qb + (wave >> 1) + 1;
    const int kid0 = tid, kid1 = tid + NTHR;
    const int kr0 = kid0 / CPR, kc0 = kid0 % CPR, kr1 = kid1 / CPR, kc1 = kid1 % CPR; const bool has1 = MLA && (kid1 < 64 * CPR);
    const int vr = tid >> 3, vc = tid & 7;
    v4u kreg0, kreg1 = (v4u){0u, 0u, 0u, 0u}, vreg;
#define ATT_KSRC(t, kr, kc) (MLA ? ((kc) < 8 ? (const v4u*)(P.K + (rowb + 64 * (t) + (kr)) * 512 + h * 64 + 8 * (kc)) : (const v4u*)(P.K2 + (rowb + 64 * (t) + (kr)) * 32 + 8 * ((kc) - 8))) \
                                 : (const v4u*)(P.K + (rowb + 64 * (t) + (kr)) * 512 + h * 64 + 8 * (kc)))
#define ATT_LOAD(t) do { kreg0 = *ATT_KSRC(t, kr0, kc0); if (has1) kreg1 = *ATT_KSRC(t, kr1, kc1); vreg = *(const v4u*)(P.V + (rowb + 64 * (t) + vr) * 512 + h * 64 + 8 * vc); } while (0)
#define ATT_WRITE(buf) do { *(LAS v4u*)(L + (buf) * KBUF + kr0 * KP + kc0 * 16) = kreg0; if (has1) *(LAS v4u*)(L + (buf) * KBUF + kr1 * KP + kc1 * 16) = kreg1; \
                            *(LAS v4u*)(L + 2 * KBUF + (buf) * VBUF + vr * VP + vc * 16) = vreg; } while (0)
    float mhat = 0.f, l = 0.f; f32x16 o0, o1, negm;
#pragma unroll
    for (int i = 0; i < 16; ++i) { o0[i] = 0.f; o1[i] = 0.f; negm[i] = 0.f; }
    const int g16 = lane >> 4, qq = (lane & 15) >> 2, pp = lane & 3;
    const int vlane = (4 * hi + qq) * VP + (16 * (g16 & 1) + 4 * pp) * 2;
    ATT_LOAD(0); ATT_WRITE(0); __syncthreads();
    unsigned wn0 = 0xffffffffu, wn1 = 0xffffffffu;
    const unsigned* bmq = MLA ? nullptr : P.BM + (size_t)b * 256 * SEQ + qrow;
    if (!MLA) { wn0 = bmq[0]; wn1 = bmq[SEQ]; }
    for (int t = 0; t < NT; ++t) {
        const int buf = t & 1;
        unsigned w0 = wn0 >> (4 * hi), w1 = wn1 >> (4 * hi);
        if (t + 1 < NT) { ATT_LOAD(t + 1); if (!MLA) { wn0 = bmq[(size_t)(2 * t + 2) * SEQ]; wn1 = bmq[(size_t)(2 * t + 3) * SEQ]; } }
        if (t < my_nt) {
            const LAS unsigned char* Kb = L + buf * KBUF; const LAS unsigned char* Vb = L + 2 * KBUF + buf * VBUF;
            f32x16 s0, s1;
            bf16x8 ka[NS][2];
#pragma unroll
            for (int s = 0; s < NS; ++s) { ka[s][0] = *(const LAS bf16x8*)(Kb + r32 * KP + s * 32 + hi * 16); ka[s][1] = *(const LAS bf16x8*)(Kb + (32 + r32) * KP + s * 32 + hi * 16); }
            __builtin_amdgcn_sched_barrier(0);
#pragma unroll
            for (int s = 0; s < NS; ++s) {
                s0 = __builtin_amdgcn_mfma_f32_32x32x16_bf16(ka[s][0], qf[s], s == 0 ? negm : s0, 0, 0, 0);
                s1 = __builtin_amdgcn_mfma_f32_32x32x16_bf16(ka[s][1], qf[s], s == 0 ? negm : s1, 0, 0, 0);
            }
            s16x4 vf[4][4];
#pragma unroll
            for (int ks = 0; ks < 4; ++ks) { const LAS unsigned char* vp = Vb + ks * 16 * VP + vlane;
                vf[ks][0] = __builtin_bit_cast(s16x4, __builtin_amdgcn_ds_read_tr16_b64_v4i16((LAS s16x4*)(vp)));
                vf[ks][1] = __builtin_bit_cast(s16x4, __builtin_amdgcn_ds_read_tr16_b64_v4i16((LAS s16x4*)(vp + 8 * VP)));
                vf[ks][2] = __builtin_bit_cast(s16x4, __builtin_amdgcn_ds_read_tr16_b64_v4i16((LAS s16x4*)(vp + 64)));
                vf[ks][3] = __builtin_bit_cast(s16x4, __builtin_amdgcn_ds_read_tr16_b64_v4i16((LAS s16x4*)(vp + 8 * VP + 64))); }
            __builtin_amdgcn_sched_barrier(0);
            float mx = fmaxf(fmaxf(s0[0], s0[1]), s1[0]);
#pragma unroll
            for (int i = 2; i < 16; i += 2) mx = fmaxf(fmaxf(mx, s0[i]), s0[i + 1]);
#pragma unroll
            for (int i = 1; i < 15; i += 2) mx = fmaxf(fmaxf(mx, s1[i]), s1[i + 1]);
            mx = fmaxf(mx, s1[15]);
            mx = fmaxf(mx, __shfl_xor(mx, 32));
            if (t == 0 || __any(mx > ATT_THR)) {
                const float dl = (t == 0) ? mx : fmaxf(mx, 0.f), f = (t == 0) ? 1.f : __builtin_amdgcn_exp2f(-dl);
                mhat += dl; l *= f;
#pragma unroll
                for (int i = 0; i < 16; ++i) { s0[i] -= dl; s1[i] -= dl; o0[i] *= f; o1[i] *= f; negm[i] = -mhat; }
            }
            float rs = 0.f;
#pragma unroll
            for (int i = 0; i < 16; ++i) {
                float p0 = __builtin_amdgcn_exp2f(s0[i]), p1 = __builtin_amdgcn_exp2f(s1[i]);
                if (!MLA) { p0 = att_mask(p0, w0, crow(i, 0)); p1 = att_mask(p1, w1, crow(i, 0)); }
                s0[i] = p0; s1[i] = p1; rs += p0 + p1; }
            l += rs;
            bf16x8 pf[4];
#pragma unroll
            for (int ks = 0; ks < 4; ++ks) { v4u w;
#pragma unroll
                for (int j = 0; j < 4; ++j) { const float a = (ks < 2) ? s0[8 * (ks & 1) + 2 * j] : s1[8 * (ks & 1) + 2 * j], c = (ks < 2) ? s0[8 * (ks & 1) + 2 * j + 1] : s1[8 * (ks & 1) + 2 * j + 1]; w[j] = pk2(a, c); }
                pf[ks] = __builtin_bit_cast(bf16x8, w); }
#pragma unroll
            for (int ks = 0; ks < 4; ++ks) {
                const bf16x8 A0 = __builtin_shufflevector(vf[ks][0], vf[ks][1], 0, 1, 2, 3, 4, 5, 6, 7);
                const bf16x8 A1 = __builtin_shufflevector(vf[ks][2], vf[ks][3], 0, 1, 2, 3, 4, 5, 6, 7);
                o0 = __builtin_amdgcn_mfma_f32_32x32x16_bf16(A0, pf[ks], o0, 0, 0, 0);
                o1 = __builtin_amdgcn_mfma_f32_32x32x16_bf16(A1, pf[ks], o1, 0, 0, 0);
            }
        }
        if (t + 1 < NT) ATT_WRITE(buf ^ 1);
        __syncthreads();
    }
    l += __shfl_xor(l, 32);
    const float inv = 1.f / l;
    bf16* op = P.O + (rowb + qrow) * 512 + h * 64 + 4 * hi;
#pragma unroll
    for (int g = 0; g < 4; ++g) {
        v2u w; w.x = pk2(o0[4 * g] * inv, o0[4 * g + 1] * inv); w.y = pk2(o0[4 * g + 2] * inv, o0[4 * g + 3] * inv); *(v2u*)(op + 8 * g) = w;
        v2u z; z.x = pk2(o1[4 * g] * inv, o1[4 * g + 1] * inv); z.y = pk2(o1[4 * g + 2] * inv, o1[4 * g + 3] * inv); *(v2u*)(op + 32 + 8 * g) = z;
    }
#undef ATT_KSRC
#undef ATT_LOAD
#undef ATT_WRITE
}

namespace attn_body {
using bf16=__hip_bfloat16;
using bf16x8=__attribute__((ext_vector_type(8)))short;
using s16x4=__attribute__((ext_vector_type(4)))short;
using f32x16=__attribute__((ext_vector_type(16)))float;
using u32x4=__attribute__((ext_vector_type(4)))unsigned;
constexpr int BATCH=2,NHEAD=8,SEQ=8192,D=64,DM=NHEAD*D;
constexpr int NW=8,QBLK=32,QB=QBLK*NW,KVBLK=64,NQB=SEQ/QB;
constexpr int ATTN_PITCH=DM, ATTN_UNIT_ROWS=QB;
__device__ __forceinline__ int crow(int r,int hi){return (r&3)+8*(r>>2)+4*hi;}
#define SBAR() __builtin_amdgcn_sched_barrier(0)
__device__ __forceinline__ void cmask(f32x16&p0,f32x16&p1,int jb,int wid){
  if(jb>(wid>>1)){
    #pragma unroll
    for(int r=0;r<16;++r){p0[r]=-INFINITY;p1[r]=-INFINITY;} }
}
__device__ __forceinline__ float amask(float p,unsigned w,int bit){ int mk; asm("v_bfe_i32 %0, %1, %2, 1":"=v"(mk):"v"(w),"i"(bit)); return __builtin_bit_cast(float,__builtin_bit_cast(unsigned,p)&(unsigned)mk); }
__device__ __forceinline__ void glds16o(const void*sbase,unsigned voff,unsigned lds_dst){unsigned keep;
  asm volatile("s_mov_b32 %0, m0\n\ts_mov_b32 m0, %3\n\ts_nop 0\n\tglobal_load_lds_dwordx4 %1, %2\n\ts_mov_b32 m0, %0":"=&s"(keep):"v"(voff),"s"(sbase),"s"(lds_dst):"memory");}
__device__ __forceinline__ void glds4o(const void*sbase,unsigned voff,unsigned lds_dst){unsigned keep;
  asm volatile("s_mov_b32 %0, m0\n\ts_mov_b32 m0, %3\n\ts_nop 0\n\tglobal_load_lds_dword %1, %2\n\ts_mov_b32 m0, %0":"=&s"(keep):"v"(voff),"s"(sbase),"s"(lds_dst):"memory");}
__device__ __forceinline__ void glds4(const void*gsrc,unsigned lds_dst){unsigned keep;
  asm volatile("s_mov_b32 %0, m0\n\ts_mov_b32 m0, %2\n\ts_nop 0\n\tglobal_load_lds_dword %1, off\n\ts_mov_b32 m0, %0":"=&s"(keep):"v"(gsrc),"s"(lds_dst):"memory");}

constexpr int NSLOT=3, SLOTB=8192, KSLOTMAX=12288;
constexpr int LDS_K=0, LDS_V=NSLOT*KSLOTMAX, LDS_WS=LDS_V+NSLOT*SLOTB, LDS_OST=LDS_WS+NW*64*4, LDS_BM=LDS_OST+NW*4096, LDS_BYTES=LDS_BM+NW*512;
constexpr float C2=0.125f*1.4426950408889634f;
__device__ __forceinline__ void glds16(const void*gsrc,unsigned lds_dst){unsigned keep;
  asm volatile("s_mov_b32 %0, m0\n\ts_mov_b32 m0, %2\n\ts_nop 0\n\tglobal_load_lds_dwordx4 %1, off\n\ts_mov_b32 m0, %0":"=&s"(keep):"v"(gsrc),"s"(lds_dst):"memory");}
__device__ __forceinline__ float max3f(float a,float b,float c){float r;asm("v_max3_f32 %0, %1, %2, %3":"=v"(r):"v"(a),"v"(b),"v"(c));return r;}
__device__ __forceinline__ float max2f(float a,float b){float r;asm("v_max_f32_e32 %0, %1, %2":"=v"(r):"v"(a),"v"(b));return r;}
__device__ __forceinline__ float fadd_s(float a,float b){float r;asm("v_add_f32_e32 %0, %1, %2":"=v"(r):"v"(a),"v"(b));return r;}
__device__ __forceinline__ float fsub_s(float a,float b){float r;asm("v_sub_f32_e32 %0, %1, %2":"=v"(r):"v"(a),"v"(b));return r;}
typedef float f32x2_t __attribute__((ext_vector_type(2))); typedef __bf16 bf16x2_t __attribute__((ext_vector_type(2)));
__device__ __forceinline__ unsigned cvtpk_s(float lo,float hi){f32x2_t v={lo,hi};bf16x2_t b=__builtin_convertvector(v,bf16x2_t);return __builtin_bit_cast(unsigned,b);}
#define WAIT_BAR(N) asm volatile("s_waitcnt vmcnt(" #N ") lgkmcnt(0)\n\ts_barrier":::"memory")

template<int NKS> __device__ __forceinline__ void qkt(f32x16&p0,f32x16&p1,const char*Kslot,const bf16x8*qr,const f32x16&negm,int r32,int hi){
  const char*kb=Kslot+hi*1024+r32*16;
  #pragma unroll
  for(int d0=0;d0<NKS;++d0){
    const bf16x8 b0=*reinterpret_cast<const bf16x8*>(kb+d0*2048);
    const bf16x8 b1=*reinterpret_cast<const bf16x8*>(kb+d0*2048+512);
    if(d0==0){p0=__builtin_amdgcn_mfma_f32_32x32x16_bf16(b0,qr[0],negm,0,0,0);p1=__builtin_amdgcn_mfma_f32_32x32x16_bf16(b1,qr[0],negm,0,0,0);}
    else{p0=__builtin_amdgcn_mfma_f32_32x32x16_bf16(b0,qr[d0],p0,0,0,0);p1=__builtin_amdgcn_mfma_f32_32x32x16_bf16(b1,qr[d0],p1,0,0,0);}}
}
typedef __attribute__((address_space(3))) const char* lds_cptr;
typedef short v4i16_t __attribute__((ext_vector_type(4)));
__device__ __forceinline__ void kload8(bf16x8*kf,lds_cptr kp){
  kf[0]=*(const __attribute__((address_space(3))) bf16x8*)(kp);      kf[1]=*(const __attribute__((address_space(3))) bf16x8*)(kp+512);
  kf[2]=*(const __attribute__((address_space(3))) bf16x8*)(kp+2048); kf[3]=*(const __attribute__((address_space(3))) bf16x8*)(kp+2560);
  kf[4]=*(const __attribute__((address_space(3))) bf16x8*)(kp+4096); kf[5]=*(const __attribute__((address_space(3))) bf16x8*)(kp+4608);
  kf[6]=*(const __attribute__((address_space(3))) bf16x8*)(kp+6144); kf[7]=*(const __attribute__((address_space(3))) bf16x8*)(kp+6656);
}
__device__ __forceinline__ void kload2(bf16x8*kf,lds_cptr kp,int j){ kf[2*j]=*(const __attribute__((address_space(3))) bf16x8*)(kp+j*2048); kf[2*j+1]=*(const __attribute__((address_space(3))) bf16x8*)(kp+j*2048+512); }
__device__ __forceinline__ s16x4 vtr(lds_cptr p){ return __builtin_bit_cast(s16x4,__builtin_amdgcn_ds_read_tr16_b64_v4i16((__attribute__((address_space(3))) v4i16_t*)p)); }
__device__ __forceinline__ float rowmax(const f32x16&p0,const f32x16&p1){
  float a=max3f(p0[0],p0[1],p1[0]),b=max3f(p0[2],p0[3],p1[1]);a=max3f(a,p1[2],p1[3]);
  #pragma unroll
  for(int r=4;r<16;r+=4){a=max3f(a,p0[r],p0[r+1]);b=max3f(b,p0[r+2],p0[r+3]);a=max3f(a,p1[r],p1[r+1]);b=max3f(b,p1[r+2],p1[r+3]);}
  const float m=max2f(a,b);
  auto rr=__builtin_amdgcn_permlane32_swap(__float_as_uint(m),__float_as_uint(m),false,false);
  return max2f(__uint_as_float(rr[0]),__uint_as_float(rr[1]));
}
__device__ __forceinline__ void pv(f32x16*o,int vb,bf16x8 pa0,bf16x8 pa1,bf16x8 pa2,bf16x8 pa3){
  #pragma unroll
  for(int d0=0;d0<2;++d0){s16x4 lo[4],hi[4];
    #pragma unroll
    for(int ks=0;ks<4;++ks){
      asm volatile("ds_read_b64_tr_b16 %0,%1 offset:%c2":"=&v"(lo[ks]):"v"(vb),"i"(d0*4096+ks*1024):"memory");
      asm volatile("ds_read_b64_tr_b16 %0,%1 offset:%c2":"=&v"(hi[ks]):"v"(vb),"i"(d0*4096+ks*1024+512):"memory");}
    asm volatile("s_waitcnt lgkmcnt(0)":::"memory");SBAR();
    #define PK(k) (bf16x8){lo[k][0],lo[k][1],lo[k][2],lo[k][3],hi[k][0],hi[k][1],hi[k][2],hi[k][3]}
    o[d0]=__builtin_amdgcn_mfma_f32_32x32x16_bf16(pa0,PK(0),o[d0],0,0,0);
    o[d0]=__builtin_amdgcn_mfma_f32_32x32x16_bf16(pa1,PK(1),o[d0],0,0,0);
    o[d0]=__builtin_amdgcn_mfma_f32_32x32x16_bf16(pa2,PK(2),o[d0],0,0,0);
    o[d0]=__builtin_amdgcn_mfma_f32_32x32x16_bf16(pa3,PK(3),o[d0],0,0,0);
    #undef PK
  }
}

#ifndef ATTN_STORE16
#define ATTN_STORE16(p,v) (*(u32x4*)(p)=(v))
#endif
template<int THRL,bool MLA> __device__ __forceinline__ void attn_unit(int b,int h,int qb,const bf16*Q,const bf16*__restrict__ K,const bf16*__restrict__ K2,const bf16*__restrict__ V,bf16*O,const unsigned*BMg,char*shm,int tid){
  constexpr int NKS=MLA?6:4, QP=MLA?768:512, DQ=MLA?96:64;
  const int lane=tid&63,r32=lane&31,hi=lane>>5; const int wid=__builtin_amdgcn_readfirstlane(tid>>6);
  const long rowbase=(long)b*SEQ; const int q0=qb*QB;
  const bf16*Qw=Q+(rowbase+q0+wid*QBLK)*QP+h*DQ;
  const bf16*Kh=K+rowbase*DM+h*D,*Vh=V+rowbase*DM+h*D;
  const unsigned lds0=(unsigned)(uintptr_t)shm;
  float*wsf=(float*)(shm+LDS_WS)+wid*64;
  const unsigned koff=(unsigned)(lane*DM+wid*8)*2u;
  const unsigned voff=(unsigned)((16*(wid&3)+(lane>>2))*DM+(wid>>2)*32+(lane&3)*8)*2u;
  const unsigned kdst=lds0+LDS_K+wid*1024, vdst=lds0+LDS_V+wid*1024;
  const bf16*K2h=MLA?K2+rowbase*32:nullptr; const unsigned koff2=(unsigned)(lane*32+(wid&3)*8)*2u; const unsigned kdst2=lds0+LDS_K+(8+(wid&3))*1024;
  #define KO(sl) (MLA?(sl)+((sl)>>1):(sl))
  #define DMA_K(t,slot) do{ glds16o(Kh+(long)(t)*KVBLK*DM,koff,(unsigned)__builtin_amdgcn_readfirstlane(kdst+KO(slot))); \
    if constexpr(MLA) glds16o(K2h+(long)(t)*KVBLK*32,koff2,(unsigned)__builtin_amdgcn_readfirstlane(kdst2+KO(slot))); }while(0)
  #define DMA_V(t,slot) glds16o(Vh+(long)(t)*KVBLK*DM,voff,(unsigned)__builtin_amdgcn_readfirstlane(vdst+(slot)))
  const unsigned*BMb=BMg+(long)b*256*SEQ+q0+wid*QBLK; const unsigned bmoff=(unsigned)(hi*SEQ+r32)*4u; const unsigned bmdst=lds0+LDS_BM+wid*512;
  const __attribute__((address_space(3))) unsigned*bmw=(const __attribute__((address_space(3))) unsigned*)((lds_cptr)shm+LDS_BM+wid*512);
  #define DMA_BM(t) if constexpr(!MLA) glds4o(BMb+(long)(t)*2*SEQ,bmoff,(unsigned)__builtin_amdgcn_readfirstlane(bmdst+((t)&1)*256))
  #define VMW(N) asm volatile("s_waitcnt vmcnt(" #N ")":::"memory")
  #define BMWAIT(t) do{ if constexpr(!MLA){ if((t)+3<NT){VMW(5);} else if((t)+2<NT){VMW(4);} else if((t)+1<NT){VMW(3);} else {VMW(1);} } }while(0)
  const int vb0=(int)(lds0+LDS_V)+((lane>>4)&1)*32+(lane&3)*8+(4*hi+((lane&15)>>2))*64;
  const char*Kbase=shm+LDS_K; bf16x8 kf[2*NKS];
  const lds_cptr shm3=(lds_cptr)shm; const lds_cptr kp0=shm3+LDS_K+hi*1024+r32*16; const lds_cptr vp0=shm3+LDS_V+((lane>>4)&1)*32+(lane&3)*8+(4*hi+((lane&15)>>2))*64;
  const int NT=(q0+QB)/KVBLK;
  DMA_BM(0);DMA_K(0,0);DMA_V(0,0);DMA_K(1,SLOTB);
  bf16x8 qr[NKS];
  #pragma unroll
  for(int d0=0;d0<NKS;++d0)qr[d0]=*reinterpret_cast<const bf16x8*>(&Qw[(long)r32*QP+d0*16+hi*8]);
  float mhat=0.f,l_reg=0.f;f32x16 o[2];o[0]=f32x16{};o[1]=f32x16{};f32x16 negm=f32x16{};asm volatile("":"+v"(negm));
  const int qrel=wid*QBLK+r32;
  #define CMASK(P0,P1,t) do{int jb_=(t)-(NT-4); if(jb_>=0)cmask(P0,P1,jb_,wid);}while(0)
  bool resc=false;
  #define START(P0,P1) do{ const float rm=rowmax(P0,P1); resc=false; \
    { const float dl=rm; mhat=fadd_s(mhat,dl); \
      _Pragma("unroll") for(int r=0;r<16;++r){P0[r]=fsub_s(P0[r],dl);P1[r]=fsub_s(P1[r],dl);} \
      _Pragma("unroll") for(int r=0;r<16;++r)negm[r]=-mhat; asm volatile("":"+v"(negm)); } \
    _Pragma("unroll") for(int r=0;r<16;++r)P0[r]=__builtin_amdgcn_exp2f(P0[r]); }while(0)
  #define RESC() do{ if(resc){ asm volatile("s_waitcnt lgkmcnt(0)":::"memory"); \
      _Pragma("unroll") for(int d_=0;d_<2;++d_) _Pragma("unroll") for(int r=0;r<16;++r)o[d_][r]*=wsf[crow(r,hi)]; } }while(0)
  f32x16 pA0,pA1,pB0,pB1;
  int sl_prev=0,sl_cur=0,sl_next=SLOTB;
  #define ROT() do{sl_prev=sl_cur;sl_cur=sl_next;sl_next=(sl_next==(NSLOT-1)*SLOTB)?0:sl_next+SLOTB;}while(0)
  DMA_K(2,2*SLOTB);
  if constexpr(MLA){WAIT_BAR(5);}else{WAIT_BAR(3);}
  qkt<NKS>(pA0,pA1,Kbase,qr,negm,r32,hi);asm volatile("s_nop 15\n\ts_nop 7":"+v"(pA0),"+v"(pA1));CMASK(pA0,pA1,0);
  START(pA0,pA1);
  _Pragma("unroll") for(int r=0;r<16;++r)pA1[r]=__builtin_amdgcn_exp2f(pA1[r]);
  if constexpr(!MLA){ const unsigned w0_=bmw[r32]>>(4*hi), w1_=bmw[32+r32]>>(4*hi);
    _Pragma("unroll") for(int r=0;r<16;++r){pA0[r]=amask(pA0[r],w0_,(r&3)+8*(r>>2));pA1[r]=amask(pA1[r],w1_,(r&3)+8*(r>>2));} }
  WAIT_BAR(0);
  DMA_BM(1);DMA_K(3,0);DMA_V(1,SLOTB);
  ROT();
  _Pragma("unroll") for(int j=0;j<NKS;++j)kload2(kf,kp0+KO(sl_cur),j);
  WAIT_BAR(3);
  s16x4 vlo[8],vhi[8]; u32x4 pw0,pw1,pw2,pw3;
  #define PKW(P,B) cvtpk_s(P[B],P[B+1])
  #define PAF(k) __builtin_bit_cast(bf16x8,pw##k)
  #define VFR(i) (bf16x8){vlo[i][0],vlo[i][1],vlo[i][2],vlo[i][3],vhi[i][0],vhi[i][1],vhi[i][2],vhi[i][3]}
  #define PIN(x) asm volatile("":"+v"(x))
  #define MX3(a,b,c) __builtin_fmaxf(__builtin_fmaxf((a),(b)),(c))
  #define GAPA(MF,A0,A1,A2,A3,W0,W1,PW) do{ MF; sacc+=A0; sacc+=A1; sacc+=A2; sacc+=A3; PIN(sacc); W0; W1; PIN(PW); SBAR(); }while(0)
  #define EX(v) __builtin_amdgcn_exp2f(v)
  #define CR_(r) (((r)&3)+8*((r)>>2))
  #define GAPB(MF,X,B,W) do{ MF; X[B]=EX(X[B]); X[B+1]=EX(X[B+1]); X[B+2]=EX(X[B+2]); X[B+3]=EX(X[B+3]); \
    if constexpr(!MLA){ X[B]=amask(X[B],W,CR_(B)); X[B+1]=amask(X[B+1],W,CR_(B+1)); X[B+2]=amask(X[B+2],W,CR_(B+2)); X[B+3]=amask(X[B+3],W,CR_(B+3)); } PIN(X); SBAR(); }while(0)
  #define VRD(i) do{ vlo[i]=vtr(vp_+(((i)>>2)*4096+((i)&3)*1024)); vhi[i]=vtr(vp_+(((i)>>2)*4096+((i)&3)*1024+512)); }while(0)
  #define KRD(G,j) do{ if((j)<NKS){ if(G){ kload2(kf,kp0+KO(sl_next),j); SBAR(); } } }while(0)
  #define STEP(C0,C1,P0,P1,t,GK,GV,GL) do{ SBAR(); \
    const lds_cptr vp_=vp0+sl_prev; \
    VRD(0); SBAR(); float sacc=(P0[0]+P0[1]); \
    GAPA(C0=__builtin_amdgcn_mfma_f32_32x32x16_bf16(kf[0],qr[0],negm,0,0,0), P0[2],P0[3],P0[4],P0[5],     pw0[0]=PKW(P0,0), pw0[1]=PKW(P0,2), pw0); \
    VRD(4); SBAR(); GAPA(C1=__builtin_amdgcn_mfma_f32_32x32x16_bf16(kf[1],qr[0],negm,0,0,0), P0[6],P0[7],P0[8],P0[9],     pw0[2]=PKW(P0,4), pw0[3]=PKW(P0,6), pw0); \
    VRD(1); SBAR(); GAPA(C0=__builtin_amdgcn_mfma_f32_32x32x16_bf16(kf[2],qr[1],C0,0,0,0),   P0[10],P0[11],P0[12],P0[13], pw1[0]=PKW(P0,8), pw1[1]=PKW(P0,10), pw1); \
    VRD(5); SBAR(); GAPA(C1=__builtin_amdgcn_mfma_f32_32x32x16_bf16(kf[3],qr[1],C1,0,0,0),   P0[14],P0[15],P1[0],P1[1],   pw1[2]=PKW(P0,12),pw1[3]=PKW(P0,14), pw1); \
    VRD(2); SBAR(); GAPA(C0=__builtin_amdgcn_mfma_f32_32x32x16_bf16(kf[4],qr[2],C0,0,0,0),   P1[2],P1[3],P1[4],P1[5],     pw2[0]=PKW(P1,0), pw2[1]=PKW(P1,2), pw2); \
    VRD(6); SBAR(); GAPA(C1=__builtin_amdgcn_mfma_f32_32x32x16_bf16(kf[5],qr[2],C1,0,0,0),   P1[6],P1[7],P1[8],P1[9],     pw2[2]=PKW(P1,4), pw2[3]=PKW(P1,6), pw2); \
    VRD(3); SBAR(); GAPA(C0=__builtin_amdgcn_mfma_f32_32x32x16_bf16(kf[6],qr[3],C0,0,0,0),   P1[10],P1[11],P1[12],P1[13], pw3[0]=PKW(P1,8), pw3[1]=PKW(P1,10), pw3); \
    VRD(7); SBAR(); GAPA(C1=__builtin_amdgcn_mfma_f32_32x32x16_bf16(kf[7],qr[3],C1,0,0,0),   P1[14],P1[15],0.f,0.f,       pw3[2]=PKW(P1,12),pw3[3]=PKW(P1,14), pw3); \
    if constexpr(MLA){ C0=__builtin_amdgcn_mfma_f32_32x32x16_bf16(kf[8],qr[4],C0,0,0,0); C1=__builtin_amdgcn_mfma_f32_32x32x16_bf16(kf[9],qr[4],C1,0,0,0); \
      C0=__builtin_amdgcn_mfma_f32_32x32x16_bf16(kf[10],qr[5],C0,0,0,0); C1=__builtin_amdgcn_mfma_f32_32x32x16_bf16(kf[11],qr[5],C1,0,0,0); SBAR(); } \
    l_reg+=sacc; \
    if(GV){DMA_BM((t)+1);} if(GK){DMA_K((t)+3,sl_cur);} if(GV){DMA_V((t)+1,sl_next);} \
    CMASK(C0,C1,t); \
    { float a=MX3(C0[0],C0[1],C1[0]),b=MX3(C0[2],C0[3],C1[1]); a=MX3(a,C1[2],C1[3]); \
      _Pragma("unroll") for(int r=4;r<16;r+=4){a=MX3(a,C0[r],C0[r+1]);b=MX3(b,C0[r+2],C0[r+3]);a=MX3(a,C1[r],C1[r+1]);b=MX3(b,C1[r+2],C1[r+3]);} \
      float rm=__builtin_fmaxf(a,b); { auto rr=__builtin_amdgcn_permlane32_swap(__float_as_uint(rm),__float_as_uint(rm),false,false); rm=__builtin_fmaxf(__uint_as_float(rr[0]),__uint_as_float(rr[1])); } \
      resc=false; \
      if(__builtin_expect(__any(rm>(float)THRL),0)){ const float dl=__builtin_fmaxf(rm,0.f); mhat+=dl; \
        _Pragma("unroll") for(int r=0;r<16;++r){C0[r]-=dl;C1[r]-=dl;} \
        _Pragma("unroll") for(int r=0;r<16;++r)negm[r]=-mhat; asm volatile("":"+v"(negm)); \
        const float f=__builtin_amdgcn_exp2f(-dl); l_reg*=f; if(hi==0)wsf[r32]=f; resc=true; } } \
    BMWAIT(t); unsigned w0_=0u, w1_=0u; if constexpr(!MLA){ w0_=bmw[((t)&1)*64+r32]>>(4*hi); w1_=bmw[((t)&1)*64+32+r32]>>(4*hi); } \
    SBAR(); \
    GAPB(o[0]=__builtin_amdgcn_mfma_f32_32x32x16_bf16(PAF(0),VFR(0),o[0],0,0,0), C0,0,w0_); \
    KRD(GL,4); GAPB(o[1]=__builtin_amdgcn_mfma_f32_32x32x16_bf16(PAF(0),VFR(4),o[1],0,0,0), C0,4,w0_); \
    KRD(GL,0); GAPB(o[0]=__builtin_amdgcn_mfma_f32_32x32x16_bf16(PAF(1),VFR(1),o[0],0,0,0), C0,8,w0_); \
    KRD(GL,1); GAPB(o[1]=__builtin_amdgcn_mfma_f32_32x32x16_bf16(PAF(1),VFR(5),o[1],0,0,0), C0,12,w0_); \
    KRD(GL,2); GAPB(o[0]=__builtin_amdgcn_mfma_f32_32x32x16_bf16(PAF(2),VFR(2),o[0],0,0,0), C1,0,w1_); \
    KRD(GL,3); GAPB(o[1]=__builtin_amdgcn_mfma_f32_32x32x16_bf16(PAF(2),VFR(6),o[1],0,0,0), C1,4,w1_); \
    KRD(GL,5); GAPB(o[0]=__builtin_amdgcn_mfma_f32_32x32x16_bf16(PAF(3),VFR(3),o[0],0,0,0), C1,8,w1_); \
    GAPB(o[1]=__builtin_amdgcn_mfma_f32_32x32x16_bf16(PAF(3),VFR(7),o[1],0,0,0), C1,12,w1_); \
    }while(0)
  int t=1;
  #undef CMASK
  #define CMASK(P0,P1,t) do{}while(0)
  for(;t+5<NT;t+=2){
    STEP(pB0,pB1,pA0,pA1,t,true,true,true);     WAIT_BAR(3); RESC(); ROT();
    STEP(pA0,pA1,pB0,pB1,t+1,true,true,true);   WAIT_BAR(3); RESC(); ROT();
  }
  #undef CMASK
  #define CMASK(P0,P1,t) do{int jb_=(t)-(NT-4); if(jb_>=0)cmask(P0,P1,jb_,wid);}while(0)
  #define ENDW(tt) do{ if((tt)+3<NT){WAIT_BAR(3);} else if((tt)+2<NT){ if constexpr(MLA){WAIT_BAR(1);}else{WAIT_BAR(2);} } else {WAIT_BAR(0);} }while(0)
  for(;t+1<NT;t+=2){
    STEP(pB0,pB1,pA0,pA1,t,(t+3<NT),(t+1<NT),(t+1<NT));       ENDW(t);   RESC(); ROT();
    STEP(pA0,pA1,pB0,pB1,t+1,(t+4<NT),(t+2<NT),(t+2<NT));     ENDW(t+1); RESC(); ROT();
  }
  STEP(pB0,pB1,pA0,pA1,NT-1,false,false,false); RESC();
  { float sacc=pB0[0]+pB0[1]; _Pragma("unroll") for(int r=2;r<16;++r)sacc+=pB0[r]; _Pragma("unroll") for(int r=0;r<16;++r)sacc+=pB1[r]; l_reg+=sacc;
    pw0=(u32x4){PKW(pB0,0),PKW(pB0,2),PKW(pB0,4),PKW(pB0,6)};pw1=(u32x4){PKW(pB0,8),PKW(pB0,10),PKW(pB0,12),PKW(pB0,14)};pw2=(u32x4){PKW(pB1,0),PKW(pB1,2),PKW(pB1,4),PKW(pB1,6)};pw3=(u32x4){PKW(pB1,8),PKW(pB1,10),PKW(pB1,12),PKW(pB1,14)};
    SBAR(); pv(o,vb0+sl_cur,PAF(0),PAF(1),PAF(2),PAF(3)); }
  #undef PKW
  #undef PAF
  #undef VFR
  #undef PIN
  #undef MX3
  #undef GAPA
  #undef GAPB
  #undef EX
  #undef VRD
  #undef KRD
  #undef STEP
  #undef ENDW
  {auto rr=__builtin_amdgcn_permlane32_swap(__float_as_uint(l_reg),__float_as_uint(l_reg),false,false);l_reg=__uint_as_float(rr[0])+__uint_as_float(rr[1]);}
  if(hi==0)wsf[32+r32]=l_reg;asm volatile("s_waitcnt lgkmcnt(0)":::"memory");
  float rli[16];
  #pragma unroll
  for(int r=0;r<16;++r)rli[r]=__builtin_amdgcn_rcpf(wsf[32+crow(r,hi)]);
  bf16*Ow=O+(rowbase+q0+wid*QBLK)*DM+h*D;
  { bf16*stg=(bf16*)(shm+LDS_OST)+wid*2048;
    #pragma unroll
    for(int r=0;r<16;++r){const int orow=crow(r,hi);
      #pragma unroll
      for(int d0=0;d0<2;++d0)stg[orow*64+d0*32+r32]=__float2bfloat16(o[d0][r]*rli[r]);}
    asm volatile("s_waitcnt lgkmcnt(0)":::"memory");
    #pragma unroll
    for(int i=0;i<4;++i){const int row=i*8+(lane>>3),ch=lane&7; const u32x4 v=*(const u32x4*)(stg+row*64+ch*8); ATTN_STORE16(Ow+(long)row*DM+ch*8,v);} }
  asm volatile("s_waitcnt lgkmcnt(0)\n\ts_barrier":::"memory");
  #undef DMA_K
  #undef DMA_BM
  #undef KO
  #undef VMW
  #undef BMWAIT
  #undef CR_
  #undef DMA_V
  #undef CMASK
  #undef START
  #undef RESC
  #undef ROT
}
#undef SBAR
#undef WAIT_BAR
}
__device__ __forceinline__ unsigned row16_sum(unsigned x) {
    x += (unsigned)__builtin_amdgcn_update_dpp(0, (int)x, 0x128, 0xf, 0xf, false); x += (unsigned)__builtin_amdgcn_update_dpp(0, (int)x, 0x124, 0xf, 0xf, false);
    x += (unsigned)__builtin_amdgcn_update_dpp(0, (int)x, 0x122, 0xf, 0xf, false); x += (unsigned)__builtin_amdgcn_update_dpp(0, (int)x, 0x121, 0xf, 0xf, false); return x; }
__device__ __forceinline__ float row16_sumf(float x) {
    x += __builtin_bit_cast(float, __builtin_amdgcn_update_dpp(0, __builtin_bit_cast(int, x), 0x128, 0xf, 0xf, false)); x += __builtin_bit_cast(float, __builtin_amdgcn_update_dpp(0, __builtin_bit_cast(int, x), 0x124, 0xf, 0xf, false));
    x += __builtin_bit_cast(float, __builtin_amdgcn_update_dpp(0, __builtin_bit_cast(int, x), 0x122, 0xf, 0xf, false)); x += __builtin_bit_cast(float, __builtin_amdgcn_update_dpp(0, __builtin_bit_cast(int, x), 0x121, 0xf, 0xf, false)); return x; }
__device__ __forceinline__ unsigned row16_suffix(unsigned x) {
    x += (unsigned)__builtin_amdgcn_update_dpp(0, (int)x, 0x101, 0xf, 0xf, false); x += (unsigned)__builtin_amdgcn_update_dpp(0, (int)x, 0x102, 0xf, 0xf, false);
    x += (unsigned)__builtin_amdgcn_update_dpp(0, (int)x, 0x104, 0xf, 0xf, false); x += (unsigned)__builtin_amdgcn_update_dpp(0, (int)x, 0x108, 0xf, 0xf, false); return x; }
__device__ __forceinline__ unsigned half_or(unsigned x) { const auto rr = __builtin_amdgcn_permlane32_swap(x, x, false, false); return rr[0] | rr[1]; }
constexpr int CAND_CAP = 128, QIP = 1296, HS = 513, FAST_CAP = 512;
struct IdxP { const bf16 *QI, *KI; const float* WI; unsigned* BM; unsigned* dbg; };
__device__ __forceinline__ unsigned mono_key(float s) { const unsigned u = __builtin_bit_cast(unsigned, s + 0.0f); return u ^ ((unsigned)((int)u >> 31) | 0x80000000u); }
__device__ __forceinline__ void idx_scores2(const bf16x8 (&kf)[2][4], const LAS unsigned char* qlane, const float (&wq)[8], f32x16& sc0, f32x16& sc1) {
    bf16x8 qv[4], qn[4];
#pragma unroll
    for (int s = 0; s < 4; ++s) qv[s] = *(const LAS bf16x8*)(qlane + 8 * 128 + s * 32);
#pragma unroll
    for (int i = 0; i < 16; ++i) { sc0[i] = 0.f; sc1[i] = 0.f; }
    f32x16 ap0, ap1;
#pragma unroll
    for (int i = 0; i < 16; ++i) { ap0[i] = 0.f; ap1[i] = 0.f; }
#pragma unroll
    for (int n = 0; n < 10; ++n) {
        const int nh = (n + 1 < 2) ? 9 : (n + 1 - 2);
        if (n + 1 < 10) {
#pragma unroll
            for (int s = 0; s < 4; ++s) qn[s] = *(const LAS bf16x8*)(qlane + nh * 128 + s * 32); }
        __builtin_amdgcn_sched_barrier(0);
        f32x16 a0, a1;
        if (n < 2) {
#pragma unroll
            for (int s = 0; s < 4; ++s) { sc0 = __builtin_amdgcn_mfma_f32_32x32x16_bf16(kf[0][s], qv[s], sc0, 0, 0, 0); sc1 = __builtin_amdgcn_mfma_f32_32x32x16_bf16(kf[1][s], qv[s], sc1, 0, 0, 0); }
        } else {
#pragma unroll
            for (int i = 0; i < 16; ++i) { a0[i] = 0.f; a1[i] = 0.f; }
#pragma unroll
            for (int s = 0; s < 4; ++s) { a0 = __builtin_amdgcn_mfma_f32_32x32x16_bf16(kf[0][s], qv[s], a0, 0, 0, 0); a1 = __builtin_amdgcn_mfma_f32_32x32x16_bf16(kf[1][s], qv[s], a1, 0, 0, 0); }
        }
        if (n >= 3) {
            const float w = wq[n - 3];
#pragma unroll
            for (int i = 0; i < 16; ++i) { sc0[i] = __builtin_fmaf(w, __builtin_fabsf(ap0[i]), sc0[i]); sc1[i] = __builtin_fmaf(w, __builtin_fabsf(ap1[i]), sc1[i]); }
#pragma unroll
            for (int g = 0; g < 8; ++g) { __builtin_amdgcn_sched_group_barrier(0x008, 1, 0); __builtin_amdgcn_sched_group_barrier(0x002, 4, 0); }
        }
        if (n >= 2) { ap0 = a0; ap1 = a1; }
#pragma unroll
        for (int s = 0; s < 4; ++s) qv[s] = qn[s];
    }
    { const float w = wq[7];
#pragma unroll
      for (int i = 0; i < 16; ++i) { sc0[i] = __builtin_fmaf(w, __builtin_fabsf(ap0[i]), sc0[i]); sc1[i] = __builtin_fmaf(w, __builtin_fabsf(ap1[i]), sc1[i]); } }
#pragma unroll
    for (int i = 0; i < 16; ++i) asm volatile("" : "+v"(sc0[i]), "+v"(sc1[i]));
}
__device__ __forceinline__ void idx_item(LAS unsigned char* L, int b, int j, const IdxP& P, int tid, int lane, int wave) {
    LAS unsigned* hist = (LAS unsigned*)L;
    LAS unsigned* img = (LAS unsigned*)(L + 66048);
    LAS unsigned* st = (LAS unsigned*)(L + 98816);
    LAS unsigned* cand = hist;
    LAS unsigned char* Qs = L + 100864;
    const int r32 = lane & 31, hi = lane >> 5;
    const int q0 = 32 * j, ntile = 2 * (j / 2 + 1);
    const size_t rowb = (size_t)b * SEQ;
    if (ntile <= 8) {
        for (int idx = tid; idx < ntile * 32; idx += NTHR) P.BM[((size_t)b * 256 + (idx >> 5)) * SEQ + q0 + (idx & 31)] = 0xffffffffu;
        return;
    }
    const int npair = ntile >> 1, nsw = (npair + 63) >> 6, SP = min(npair, 8 * nsw);
    bf16x8 ksmp[2][4];
#ifdef SMP_PREFETCH
    if (wave < SP) { const bf16* kp = P.KI + (rowb + 64 * ((wave * npair) / SP) + r32) * 64 + 8 * hi;
#pragma unroll
        for (int s = 0; s < 4; ++s) { ksmp[0][s] = *(const bf16x8*)(kp + 16 * s); ksmp[1][s] = *(const bf16x8*)(kp + 32 * 64 + 16 * s); } }
#endif
    float wq[8];
    { for (int c = tid; c < 32 * 64; c += NTHR) { const int rr = c >> 6, ch = c & 63; *(LAS v4u*)(Qs + rr * QIP + ch * 16) = *(const v4u*)(P.QI + (rowb + q0 + rr) * 512 + ch * 8); }
      const float* wp = P.WI + (rowb + q0 + r32) * 8;
#pragma unroll
      for (int h = 0; h < 8; ++h) wq[h] = 0.5f * wp[h]; }
    if (tid < 32) { st[32 + tid] = 256u; st[64 + tid] = 0u; st[96 + tid] = 0u; }
    if (tid == 0) st[129] = 0u;
    __syncthreads();
    {
        const int r = tid >> 4, part = tid & 15;
        const float* wp = P.WI + (rowb + q0 + r) * 8;
        float qb[4] = {0.f, 0.f, 0.f, 0.f}; float rsum = 0.f;
#pragma unroll
        for (int h = 0; h < 8; ++h) { const float w = wp[h]; const v2u raw = *(const LAS v2u*)(Qs + r * QIP + h * 128 + part * 8);
            const float f0 = bflo(raw.x), f1 = bfhi(raw.x), f2 = bflo(raw.y), f3 = bfhi(raw.y);
            float nsq = (f0 * f0 + f1 * f1) + (f2 * f2 + f3 * f3);
            nsq = row16_sumf(nsq);
            rsum += fabsf(w) * sqrtf(nsq);
            qb[0] += 0.5f * w * f0; qb[1] += 0.5f * w * f1; qb[2] += 0.5f * w * f2; qb[3] += 0.5f * w * f3; }
        v2u hw, lw;
        { const unsigned h01 = pk2(qb[0], qb[1]), h23 = pk2(qb[2], qb[3]); hw.x = h01; hw.y = h23;
          lw.x = pk2(qb[0] - bflo(h01), qb[1] - bfhi(h01)); lw.y = pk2(qb[2] - bflo(h23), qb[3] - bfhi(h23)); }
        *(LAS v2u*)(Qs + r * QIP + 8 * 128 + part * 8) = hw; *(LAS v2u*)(Qs + r * QIP + 9 * 128 + part * 8) = lw;
        { const v2u kw = *(const v2u*)(P.KI + (rowb + r) * 64 + part * 4); const float f0 = bflo(kw.x), f1 = bfhi(kw.x), f2 = bflo(kw.y), f3 = bfhi(kw.y);
          float ksq = (f0 * f0 + f1 * f1) + (f2 * f2 + f3 * f3);
          ksq = row16_sumf(ksq);
          if (part == 0) { __hip_atomic_fetch_max(&st[129], __builtin_bit_cast(unsigned, ksq), __ATOMIC_RELAXED, __HIP_MEMORY_SCOPE_WORKGROUP); st[224 + r] = __builtin_bit_cast(unsigned, rsum); } }
    }
    __syncthreads();
    if (tid < 32) { const float R = 0.25f * sqrtf(__builtin_bit_cast(float, st[129])) * __builtin_bit_cast(float, st[224 + tid]);
        const float C = 0.125f * R;
        st[160 + tid] = (0x80000000u | __builtin_bit_cast(unsigned, R + C)) - 511u * 131072u; st[224 + tid] = __builtin_bit_cast(unsigned, C); st[tid] = 0u; st[192 + tid] = 0u;
        st[256 + tid] = __builtin_bit_cast(unsigned, R); st[288 + tid] = 511u; st[320 + tid] = 0u; }
    const LAS unsigned char* qlane = Qs + r32 * QIP + hi * 16;
    int level = 0;
#define IDX_KLOAD2(tp) { const bf16* kp = P.KI + (rowb + 64 * (tp) + r32) * 64 + 8 * hi; _Pragma("unroll") for (int s = 0; s < 4; ++s) { kn[0][s] = *(const bf16x8*)(kp + 16 * s); kn[1][s] = *(const bf16x8*)(kp + 32 * 64 + 16 * s); } }
#define IDX_SCORES2(tp) \
        bf16x8 kf[2][4]; _Pragma("unroll") for (int s = 0; s < 4; ++s) { kf[0][s] = kn[0][s]; kf[1][s] = kn[1][s]; } \
        f32x16 sc0, sc1; idx_scores2(kf, qlane, wq, sc0, sc1); \
        if ((tp) + NWAVES < npair) { IDX_KLOAD2((tp) + NWAVES) }
    bool slow;
    {
        for (int u = tid; u < 32 * HS; u += NTHR) hist[u] = 0u;
        if (tid == 0) st[130] = 0u;
        __syncthreads();
        const float Rq = __builtin_bit_cast(float, st[256 + r32]);
        {   const float s1 = 256.f / Rq; LAS unsigned* hrow = hist + r32 * HS;
            for (int i = wave; i < SP; i += NWAVES) { const int tp = (i * npair) / SP;
#ifdef SMP_PREFETCH
                bf16x8 kn[2][4]; if (i >= NWAVES) { IDX_KLOAD2(tp) }
#else
                bf16x8 kn[2][4]; IDX_KLOAD2(tp)
#endif
                bf16x8 kf[2][4];
#pragma unroll
#ifdef SMP_PREFETCH
                for (int s = 0; s < 4; ++s) { kf[0][s] = (i < NWAVES) ? ksmp[0][s] : kn[0][s]; kf[1][s] = (i < NWAVES) ? ksmp[1][s] : kn[1][s]; }
#else
                for (int s = 0; s < 4; ++s) { kf[0][s] = kn[0][s]; kf[1][s] = kn[1][s]; }
#endif
                f32x16 sc0, sc1; idx_scores2(kf, qlane, wq, sc0, sc1);
#pragma unroll
                for (int e = 0; e < 16; ++e) { const int b0 = min(max((int)__builtin_fmaf(sc0[e], s1, 256.f), 0), 511), b1 = min(max((int)__builtin_fmaf(sc1[e], s1, 256.f), 0), 511);
                    __hip_atomic_fetch_add(&hrow[b0], 1u, __ATOMIC_RELAXED, __HIP_MEMORY_SCOPE_WORKGROUP); __hip_atomic_fetch_add(&hrow[b1], 1u, __ATOMIC_RELAXED, __HIP_MEMORY_SCOPE_WORKGROUP); }
            }
        }
        __syncthreads();
        {
            const int q = tid >> 4, seg = tid & 15; const LAS unsigned* hq = hist + q * HS + seg * 32;
            unsigned segsum = 0u;
            for (int wi = 0; wi < 32; ++wi) segsum += hq[wi];
            unsigned S = segsum;
            S = row16_suffix(S);
            const unsigned above = S - segsum, total = row16_sum(segsum);
            const float f = (float)total / (float)(64 * npair), rs = 256.f * f, sg = 3.5f * sqrtf(rs * (1.f - f));
            const int rl = (int)floorf(rs - sg) - 1, rh = (int)ceilf(rs + sg) + 1;
            const unsigned tl = rl > 0 ? (unsigned)rl : 0u, th = (unsigned)rh;
            if (above < tl && tl <= above + segsum) { unsigned cum = above; int fb = 0; bool found = false;
                for (int wi = 31; wi >= 0; --wi) { const unsigned c = hq[wi]; if (!found && cum + c >= tl) { found = true; fb = wi; } if (!found) cum += c; }
                st[288 + q] = (unsigned)(32 * seg + fb); }
            if (above < th && th <= above + segsum) { unsigned cum = above; int fb = 0; bool found = false;
                for (int wi = 31; wi >= 0; --wi) { const unsigned c = hq[wi]; if (!found && cum + c >= th) { found = true; fb = wi; } if (!found) cum += c; }
                st[320 + q] = (unsigned)(32 * seg + fb); }
        }
        __syncthreads();
#ifdef REP_PASS2
        for (int rep2 = 0; rep2 < 2; ++rep2) { if (rep2) { __syncthreads(); if (tid < 32) st[96 + tid] = 0u; __syncthreads(); }
#else
        {
#endif
            const float wbin = Rq * (1.f / 256.f), fH = __builtin_fmaf((float)(st[288 + r32] + 1u), wbin, -Rq), fA = __builtin_fmaf((float)st[320 + r32], wbin, -Rq), s2 = 524287.f / (fH - fA), nfa = -fA * s2;
            bf16x8 kn[2][4]; if (wave < npair) { IDX_KLOAD2(wave) }
            for (int tp = wave; tp < npair; tp += NWAVES) {
                IDX_SCORES2(tp)
#define IDX_FAST_ELEMS(SC, T) { unsigned v = 0u, cm = 0u; \
            _Pragma("unroll") for (int i = 15; i >= 0; --i) { v = __builtin_amdgcn_alignbit(v, __builtin_bit_cast(unsigned, SC[i] - fH), 31);        \
                                                              cm = __builtin_amdgcn_alignbit(cm, __builtin_bit_cast(unsigned, SC[i] - fA), 31); } \
            cm = v & ~cm & 0xffffu; v = ~v & 0xffffu;                                                           \
            if (cm) { const unsigned pos0 = __hip_atomic_fetch_add(&st[96 + r32], (unsigned)__builtin_popcount(cm), __ATOMIC_RELAXED, __HIP_MEMORY_SCOPE_WORKGROUP);     \
                const unsigned rb = 8191u - (unsigned)(32 * (T)) - hi4; \
                _Pragma("unroll") for (int i = 0; i < 16; ++i) if (cm & (1u << i)) { const unsigned pos = min(pos0 + (unsigned)__builtin_popcount(cm & ((1u << i) - 1u)), (unsigned)FAST_CAP - 1u); \
                    cand[r32 * FAST_CAP + pos] = (min((unsigned)__builtin_fmaf(SC[i], s2, nfa), 524287u) << 13) | (rb - (unsigned)((i & 3) + 8 * (i >> 2))); } } \
            unsigned bits = (v & 0xfu) | ((v & 0xf0u) << 4) | ((v & 0xf00u) << 8) | ((v & 0xf000u) << 12);     \
            bits <<= 4 * hi; bits = half_or(bits); if (hi == 0) img[(T) * 32 + r32] = bits; }
                unsigned hi4 = 4u * (unsigned)hi; asm volatile("" : "+v"(hi4));
                IDX_FAST_ELEMS(sc0, 2 * tp)
                IDX_FAST_ELEMS(sc1, 2 * tp + 1)
#undef IDX_FAST_ELEMS
            }
        }
        __syncthreads();
        {
            const int q = tid >> 4, l16 = tid & 15; unsigned above = 0u;
            for (int t = l16; t < ntile; t += 16) above += (unsigned)__builtin_popcount(img[t * 32 + q]);
            above = row16_sum(above);
            const unsigned n = st[96 + q];
            if (l16 == 0) { if (above >= 256u || 256u - above > n || n > (unsigned)FAST_CAP) st[130] = 1u; st[32 + q] = 256u - above; }
        }
        __syncthreads();
        slow = st[130] != 0u;
#ifdef REP_SEL
        for (int rep3 = 0; rep3 < 2; ++rep3)
#endif
        if (!slow) {
            const int q = tid >> 4, l16 = tid & 15; const unsigned n = st[96 + q], need = st[32 + q];
            unsigned c[FAST_CAP / 16];
#pragma unroll
            for (int i = 0; i < FAST_CAP / 16; ++i) { const unsigned ci = (unsigned)(l16 + 16 * i); c[i] = ci < n ? cand[q * FAST_CAP + ci] : 0u; }
            LAS unsigned* h2 = (LAS unsigned*)Qs + q * 256;
#pragma unroll
            for (int i = 0; i < 4; ++i) *(LAS v4u*)(h2 + 16 * l16 + 4 * i) = (v4u){0u, 0u, 0u, 0u};
#pragma unroll
            for (int i = 0; i < FAST_CAP / 16; ++i) if ((unsigned)(l16 + 16 * i) < n) __hip_atomic_fetch_add(&h2[c[i] >> 24], 1u, __ATOMIC_RELAXED, __HIP_MEMORY_SCOPE_WORKGROUP);
            { unsigned hb[16], ssum = 0u;
#pragma unroll
              for (int i = 0; i < 4; ++i) { const v4u t4 = *(const LAS v4u*)(h2 + 16 * l16 + 4 * i); hb[4 * i] = t4.x; hb[4 * i + 1] = t4.y; hb[4 * i + 2] = t4.z; hb[4 * i + 3] = t4.w; ssum += (t4.x + t4.y) + (t4.z + t4.w); }
              const unsigned habove = row16_suffix(ssum) - ssum;
              if (habove < need && need <= habove + ssum) { unsigned cum = habove, fb = 0u; bool found = false;
#pragma unroll
                  for (int j = 15; j >= 0; --j) { if (!found && cum + hb[j] >= need) { found = true; fb = (unsigned)j; } if (!found) cum += hb[j]; }
                  st[352 + q] = 16u * (unsigned)l16 + fb; } }
            unsigned Pv = st[352 + q] << 24; bool done = false;
#pragma nounroll
            for (int bit = 23; bit >= 0; --bit) { const unsigned trial = Pv | (1u << bit); unsigned cnt = 0u;
#pragma unroll
                for (int i = 0; i < FAST_CAP / 16; ++i) cnt += (c[i] >= trial) ? 1u : 0u;
                cnt = row16_sum(cnt);
                if (!done && cnt >= need) { Pv = trial; done = (cnt == need); }
                if (__all(done)) break; }
#pragma unroll
            for (int i = 0; i < FAST_CAP / 16; ++i) if ((unsigned)(l16 + 16 * i) < n && c[i] >= Pv) { const unsigned kidx = 8191u - (c[i] & 8191u);
                __hip_atomic_fetch_or(&img[(kidx >> 5) * 32 + q], 1u << (kidx & 31), __ATOMIC_RELAXED, __HIP_MEMORY_SCOPE_WORKGROUP); }
        } else if (tid < 32) { st[32 + tid] = 256u; st[96 + tid] = 0u; }
        __syncthreads();
    }
#ifdef DIAG_SLOW
    if (slow && tid == 0) __hip_atomic_fetch_add(P.dbg, 1u, RLX_AGENT);
#endif
    if (slow) {
    for (;;) {
        ++level;
        for (int u = tid; u < 32 * HS; u += NTHR) hist[u] = 0u;
        if (tid == 0) st[128] = 0u;
        __syncthreads();
        {
            const unsigned qa = st[r32], qlen = st[192 + r32], base1 = st[160 + r32]; const float cq = __builtin_bit_cast(float, st[224 + r32]);
            const int sh = (level > 1 && qlen > 512u) ? (32 - __builtin_clz(qlen - 1u)) - 9 : 0;
            LAS unsigned* hrow = hist + r32 * HS;
            bf16x8 kn[2][4]; if (wave < npair) { IDX_KLOAD2(wave) }
            for (int tp = wave; tp < npair; tp += NWAVES) {
                IDX_SCORES2(tp)
                if (level == 1) {
#pragma unroll
                    for (int i = 0; i < 16; ++i) { const unsigned k0 = mono_key(sc0[i] + cq), k1 = mono_key(sc1[i] + cq);
                        const unsigned b0 = min((max(k0, base1) - base1) >> 17, 511u), b1 = min((max(k1, base1) - base1) >> 17, 511u);
                        __hip_atomic_fetch_add(&hrow[b0], 1u, __ATOMIC_RELAXED, __HIP_MEMORY_SCOPE_WORKGROUP); __hip_atomic_fetch_add(&hrow[b1], 1u, __ATOMIC_RELAXED, __HIP_MEMORY_SCOPE_WORKGROUP); }
                } else {
#pragma unroll
                    for (int i = 0; i < 16; ++i) { const unsigned o0 = mono_key(sc0[i] + cq) - qa, o1 = mono_key(sc1[i] + cq) - qa;
                        if (o0 < qlen) __hip_atomic_fetch_add(&hrow[o0 >> sh], 1u, __ATOMIC_RELAXED, __HIP_MEMORY_SCOPE_WORKGROUP);
                        if (o1 < qlen) __hip_atomic_fetch_add(&hrow[o1 >> sh], 1u, __ATOMIC_RELAXED, __HIP_MEMORY_SCOPE_WORKGROUP); }
                }
            }
        }
        __syncthreads();
        {
            const int q = tid >> 4, seg = tid & 15;
            unsigned segsum = 0u;
            for (int wi = 0; wi < 32; ++wi) segsum += hist[q * HS + seg * 32 + wi];
            unsigned S = segsum;
            S = row16_suffix(S);
            const unsigned above = S - segsum, need = st[32 + q];
            if (above < need && need <= above + segsum) {
                unsigned cum = above, fbin = 0u, fneed = 1u, fcnt = 0u; bool found = false;
                for (int wi = 31; wi >= 0; --wi) { const unsigned c = hist[q * HS + seg * 32 + wi];
                    if (!found && cum + c >= need) { found = true; fbin = (unsigned)wi; fneed = need - cum; fcnt = c; } if (!found) cum += c; }
                fbin += 32u * (unsigned)seg;
                unsigned na, nlen;
                if (level == 1) { const unsigned base1 = st[160 + q];
                    if (fbin == 0u) { na = 0u; nlen = base1 + 131072u; } else if (fbin == 511u) { na = base1 + 511u * 131072u; nlen = 0u - na; } else { na = base1 + fbin * 131072u; nlen = 131072u; } }
                else { const unsigned qa = st[q], qlen = st[192 + q]; const int sh = qlen > 512u ? (32 - __builtin_clz(qlen - 1u)) - 9 : 0;
                    na = qa + (fbin << sh); nlen = min(1u << sh, qlen - (fbin << sh)); }
                st[q] = na; st[192 + q] = nlen; st[32 + q] = fneed; st[64 + q] = fcnt;
                if (fcnt > (unsigned)CAND_CAP && nlen > 1u) st[128] = 1u;
            }
        }
        __syncthreads();
#ifndef MAXLVL
#define MAXLVL 8
#endif
        const bool more = (st[128] != 0u) && (level < MAXLVL);
        __syncthreads();
        if (!more) break;
    }
    {
        const unsigned qa = st[r32], qlen = st[192 + r32]; const float cq = __builtin_bit_cast(float, st[224 + r32]);
        const unsigned Hk = qa + qlen - 1u;
        unsigned hb = (Hk & 0x80000000u) ? (Hk ^ 0x80000000u) : ~Hk;
        if (hb == 0x80000000u) hb = 0x80000001u;
        const float fH = __builtin_bit_cast(float, hb);
        const unsigned ab_ = (qa & 0x80000000u) ? (qa ^ 0x80000000u) : ~qa;
        const float fA = (qa < 0x00800000u) ? -__builtin_inff() : __builtin_bit_cast(float, ab_);
        bf16x8 kn[2][4]; if (wave < npair) { IDX_KLOAD2(wave) }
        for (int tp = wave; tp < npair; tp += NWAVES) {
            IDX_SCORES2(tp)
#define IDX_COLLECT_ELEMS(SC, T) { unsigned v = 0u; _Pragma("unroll") for (int i = 15; i >= 0; --i) { const float ts = SC[i] + cq; const bool ab = ts > fH; v = v + v + (ab ? 1u : 0u); \
                if (!ab && ts >= fA) { const unsigned key = mono_key(ts); \
                    const unsigned pos = __hip_atomic_fetch_add(&st[96 + r32], 1u, __ATOMIC_RELAXED, __HIP_MEMORY_SCOPE_WORKGROUP); \
                    if (pos < (unsigned)CAND_CAP) { cand[(r32 * CAND_CAP + pos) * 2] = key; cand[(r32 * CAND_CAP + pos) * 2 + 1] = (unsigned)(32 * (T) + crow(i, hi)); } } } \
            unsigned bits = (v & 0xfu) | ((v & 0xf0u) << 4) | ((v & 0xf00u) << 8) | ((v & 0xf000u) << 12);     \
            bits <<= 4 * hi; bits = half_or(bits); if (hi == 0) img[(T) * 32 + r32] = bits; }
            IDX_COLLECT_ELEMS(sc0, 2 * tp)
            IDX_COLLECT_ELEMS(sc1, 2 * tp + 1)
#undef IDX_COLLECT_ELEMS
        }
    }
#undef IDX_SCORES2
#undef IDX_KLOAD2
    __syncthreads();
    {
        const int q = tid >> 4; const unsigned n = min(st[96 + q], (unsigned)CAND_CAP), need = st[32 + q];
        for (unsigned c = tid & 15; c < n; c += 16) { const unsigned key = cand[(q * CAND_CAP + c) * 2], idx = cand[(q * CAND_CAP + c) * 2 + 1]; unsigned rank = 0u;
            for (unsigned o = 0; o < n; ++o) { const unsigned k2 = cand[(q * CAND_CAP + o) * 2], i2 = cand[(q * CAND_CAP + o) * 2 + 1]; rank += (k2 > key || (k2 == key && i2 < idx)) ? 1u : 0u; }
            if (rank < need) __hip_atomic_fetch_or(&img[(idx >> 5) * 32 + q], 1u << (idx & 31), __ATOMIC_RELAXED, __HIP_MEMORY_SCOPE_WORKGROUP); }
    }
    }
    __syncthreads();
    for (int idx = tid; idx < ntile * 32; idx += NTHR) P.BM[((size_t)b * 256 + (idx >> 5)) * SEQ + q0 + (idx & 31)] = img[idx];
    __syncthreads();
}

__device__ __forceinline__ int wq_next(Frame& F, int cw) {
    __syncthreads();
    if (F_TID == 0) F.MISC[0] = __hip_atomic_fetch_add((unsigned*)(F.ctl + cw), 1u, RLX_AGENT);
    __syncthreads();
    return (int)F.MISC[0];
}

constexpr int KEEP_OFF = 40 * 260 * 4 + 64 * 260 * 4 + 16384;
static_assert(KEEP_OFF + 128 <= MISC_OFF, "keep area below MISC");
__device__ __forceinline__ void p5a_route(Frame& F, const Args& A) {
    const int lane = F_LANE, tid = F_TID, wave = F_WAVE;
    const float* x1 = A.out; const float* g2 = A.in[11];
    const float* wrg = A.in[12]; const float* brg = A.in[13]; const float* wre = A.in[14]; const float* bre = A.in[15];
    int* toke = (int*)(F.ws + WS_TOKE); float* tokw = (float*)(F.ws + WS_TOKW); float* rstd2 = (float*)(F.ws + WS_RSTD2);
    int* sslot = (int*)(F.ws + WS_SSLOT);
    constexpr int KP = 260, WCH = 40 * KP * 4;
    constexpr int XCH = 64 * KP * 4;
    LAS float* wl = (LAS float*)F.lds;
    LAS float* xs = (LAS float*)(F.lds + WCH);
    LAS unsigned* lcnt = (LAS unsigned*)(F.lds + WCH + XCH);
    LAS float* lgs = (LAS float*)(F.lds + WCH + XCH + 256);
    { int* tokidx = (int*)(F.ws + WS_TOKIDX); float* srstd = (float*)(F.ws + WS_SRSTD);
      for (int i = F.vcu * NTHR + tid; i < SORT_ROWS; i += F.G * NTHR) { sslot[i] = -1; tokidx[i] = 0; srstd[i] = 0.f; } }
    if (tid < NEXP) lcnt[tid] = 0u;
    const int i16 = lane & 15, kq = lane >> 4, tile = wave & 3, half = wave >> 2;
    const int per = T / F.G;
    for (int t0 = F.vcu * per; t0 < (F.vcu + 1) * per; t0 += 64) {
        const bf16* xg0 = (const bf16*)(F.ws + WS_X1B) + (size_t)(t0 + 8 * wave) * D + 4 * lane;
        const LAS float* ap = xs + (16 * tile + i16) * KP + 4 * kq;
        f32x4 acc0 = (f32x4){0.f, 0.f, 0.f, 0.f}, acc1 = acc0; float ss = 0.f;
        f32x4 se[5]; const float* wrt = (const float*)(F.ws + WS_WRT);
#define RT_LOAD(c) do { _Pragma("unroll") for (int q = 0; q < 5; ++q) { const int f = tid + 512 * q; se[q] = *(const GAS f32x4*)(wrt + (size_t)(f >> 6) * 1024 + 256 * (c) + 4 * (f & 63)); } } while (0)
#define RT_WRITE(bf) do { _Pragma("unroll") for (int q = 0; q < 5; ++q) { const int f = tid + 512 * q; *(LAS f32x4*)(wl + (f >> 6) * KP + 4 * (f & 63)) = se[q]; } } while (0)
        v2u xg[8];
#define RT_XLOAD(c) do { _Pragma("unroll") for (int j = 0; j < 8; ++j) xg[j] = *(const GAS v2u*)(xg0 + (size_t)j * D + 256 * (c)); } while (0)
#define RT_XWRITE() do { _Pragma("unroll") for (int j = 0; j < 8; ++j) *(LAS f32x4*)(xs + (8 * wave + j) * KP + 4 * lane) = (f32x4){bflo(xg[j].x), bfhi(xg[j].x), bflo(xg[j].y), bfhi(xg[j].y)}; } while (0)
        RT_XLOAD(0); RT_LOAD(0); RT_XWRITE(); RT_WRITE(0); __syncthreads();
#pragma unroll
        for (int c = 0; c < 4; ++c) {
            if (c + 1 < 4) { RT_XLOAD(c + 1); RT_LOAD(c + 1); }
            const LAS float* b0p = wl + (i16 + 16 * half) * KP + 4 * kq;
            const LAS float* b1p = wl + (32 + (i16 & 7)) * KP + 4 * kq;
            if (half == 0) {
#pragma unroll
                for (int s = 0; s < 16; ++s) { const f32x4 a4 = *(const LAS f32x4*)(ap + 16 * s), b0 = *(const LAS f32x4*)(b0p + 16 * s), b1 = *(const LAS f32x4*)(b1p + 16 * s);
                    ss += (a4.x * a4.x + a4.y * a4.y) + (a4.z * a4.z + a4.w * a4.w);
#pragma unroll
                    for (int cc = 0; cc < 4; ++cc) { acc0 = __builtin_amdgcn_mfma_f32_16x16x4f32(a4[cc], b0[cc], acc0, 0, 0, 0); acc1 = __builtin_amdgcn_mfma_f32_16x16x4f32(a4[cc], b1[cc], acc1, 0, 0, 0); } }
            } else {
#pragma unroll
                for (int s = 0; s < 16; ++s) { const f32x4 a4 = *(const LAS f32x4*)(ap + 16 * s), b0 = *(const LAS f32x4*)(b0p + 16 * s);
                    acc0 = __builtin_amdgcn_mfma_f32_16x16x4f32(a4[0], b0[0], acc0, 0, 0, 0); acc1 = __builtin_amdgcn_mfma_f32_16x16x4f32(a4[1], b0[1], acc1, 0, 0, 0);
                    acc0 = __builtin_amdgcn_mfma_f32_16x16x4f32(a4[2], b0[2], acc0, 0, 0, 0); acc1 = __builtin_amdgcn_mfma_f32_16x16x4f32(a4[3], b0[3], acc1, 0, 0, 0); }
            }
            __syncthreads();
            if (c + 1 < 4) { RT_XWRITE(); RT_WRITE(0); }
            __syncthreads();
        }
#undef RT_XLOAD
#undef RT_XWRITE
#undef RT_LOAD
#undef RT_WRITE
        if (half != 0) acc0 = acc0 + acc1;
        LAS float* lt = lgs + tile * 640;
#pragma unroll
        for (int r = 0; r < 4; ++r) { const int tk = 4 * kq + r; lt[tk * 40 + 8 + 16 * half + i16] = acc0[r]; if (half == 0 && i16 < 8) lt[tk * 40 + i16] = acc1[r]; }
        if (half == 0) { ss += __shfl_xor(ss, 16); ss += __shfl_xor(ss, 32); if (kq == 0) lgs[2560 + 16 * tile + i16] = 1.f / sqrtf(ss * (1.f / D) + EPS); }
        __syncthreads();
        if (half == 0 && lane < 16) {
            const int m = t0 + 16 * tile + lane; const float rstd = lgs[2560 + 16 * tile + lane]; const LAS float* lg = lt + lane * 40;
            float gl[8];
#pragma unroll
            for (int k = 0; k < 8; ++k) gl[k] = lg[k] * rstd + brg[k];
            int gs = 0; float gm = gl[0];
#pragma unroll
            for (int k = 1; k < 8; ++k) if (gl[k] > gm) { gm = gl[k]; gs = k; }
            float den = 0.f;
#pragma unroll
            for (int k = 0; k < 8; ++k) den += __expf(gl[k] - gm);
            const float wgrp = 1.f / den;
            float el[4];
#pragma unroll
            for (int cc = 0; cc < 4; ++cc) el[cc] = lg[8 + 4 * gs + cc] * rstd + bre[4 * gs + cc];
            int i1 = 0; float v1 = el[0];
#pragma unroll
            for (int cc = 1; cc < 4; ++cc) if (el[cc] > v1) { v1 = el[cc]; i1 = cc; }
            int i2 = -1; float v2 = 0.f;
#pragma unroll
            for (int cc = 0; cc < 4; ++cc) if (cc != i1 && (i2 < 0 || el[cc] > v2)) { v2 = el[cc]; i2 = cc; }
            const float e2 = __expf(v2 - v1), w1 = 1.f / (1.f + e2), w2 = e2 / (1.f + e2);
            toke[2 * m] = gs * 4 + i1; toke[2 * m + 1] = gs * 4 + i2; tokw[2 * m] = w1 * wgrp; tokw[2 * m + 1] = w2 * wgrp; rstd2[m] = rstd;
            __hip_atomic_fetch_add(&lcnt[gs * 4 + i1], 1u, __ATOMIC_RELAXED, __HIP_MEMORY_SCOPE_WORKGROUP);
            __hip_atomic_fetch_add(&lcnt[gs * 4 + i2], 1u, __ATOMIC_RELAXED, __HIP_MEMORY_SCOPE_WORKGROUP);
        }
        __syncthreads();
    }
    if (tid < NEXP) ((LAS unsigned*)(F.lds + KEEP_OFF))[tid] = lcnt[tid] ? __hip_atomic_fetch_add((unsigned*)(F.ctl + CW_CNT + tid), lcnt[tid], RLX_AGENT) : 0u;
}

__device__ __forceinline__ void p5a2_scatter(Frame& F, const Args& A) {
    const int lane = F_LANE, tid = F_TID;
    const float* x1 = A.out; const float* g2 = A.in[11];
    const int* toke = (const int*)(F.ws + WS_TOKE); const float* tokw = (const float*)(F.ws + WS_TOKW); const float* rstd2 = (const float*)(F.ws + WS_RSTD2);
    int* sslot = (int*)(F.ws + WS_SSLOT); float* sw = (float*)(F.ws + WS_SW); int* t2e = (int*)(F.ws + WS_T2E);
    bf16* AS = (bf16*)(F.ws + WS_ASORT);
    LAS unsigned* sh = (LAS unsigned*)F.lds;
    if (tid < NEXP) sh[256 + tid] = __hip_atomic_load((unsigned*)(F.ctl + CW_CNT + tid), RLX_AGENT);
    __syncthreads();
    if (tid == 0) { unsigned acc = 0u;
        for (int e = 0; e < NEXP; ++e) { const unsigned c = sh[256 + e]; sh[e] = acc; const unsigned nt = (c + 255u) / 256u;
            if (blockIdx.x == 0) for (unsigned i = 0; i < nt; ++i) { t2e[acc / 256u + i] = e; t2e[256 + acc / 256u + i] = (int)min(256u, c - 256u * i); }
            acc += nt * 256u; }
        if (blockIdx.x == 0) t2e[255] = (int)(acc / 256u); }
    const int per = T / F.G;
    for (int t0 = F.vcu * per; t0 < (F.vcu + 1) * per; t0 += 64) {
        if (tid < NEXP) sh[32 + tid] = 0u;
        __syncthreads();
        int e = 0; unsigned lpos = 0u;
        if (tid < 128) { e = toke[2 * t0 + tid]; lpos = __hip_atomic_fetch_add(&sh[32 + e], 1u, __ATOMIC_RELAXED, __HIP_MEMORY_SCOPE_WORKGROUP); }
        __syncthreads();
        if (tid < NEXP) { LAS unsigned* keep = (LAS unsigned*)(F.lds + KEEP_OFF); const unsigned k0 = keep[tid]; sh[64 + tid] = sh[tid] + k0; keep[tid] = k0 + sh[32 + tid]; }
        __syncthreads();
        if (tid < 128) { const unsigned pos = sh[64 + e] + lpos; sh[96 + tid] = pos; sslot[pos] = 2 * t0 + tid; sw[pos] = tokw[2 * t0 + tid];
            ((int*)(F.ws + WS_TOKIDX))[pos] = t0 + (tid >> 1); ((float*)(F.ws + WS_SRSTD))[pos] = rstd2[t0 + (tid >> 1)]; }
        __syncthreads();
        __syncthreads();
    }
}

__device__ __forceinline__ void p6_final(Frame& F, const Args& A) {
    const int gw = F.vcu * NWAVES + F_WAVE, NGW = F.G * NWAVES, lane = F_LANE;
    const float* gf = A.in[19]; float* out = A.out; const bf16* SL = (const bf16*)(F.ws + WS_SLOTS); const bf16* XB = (const bf16*)(F.ws + WS_X1B);
    for (int m0 = gw; m0 < T; m0 += 2 * NGW) {
        f32x4 v[2][4]; v2u xw[2][4], a[2][4], c[2][4];
#pragma unroll
        for (int r = 0; r < 2; ++r) { const int m = min(m0 + r * NGW, T - 1); const GAS v2u* xr = (const GAS v2u*)(XB + (size_t)m * D) + lane;
            const GAS v2u* s0 = (const GAS v2u*)(SL + (size_t)(2 * m) * D) + lane; const GAS v2u* s1 = (const GAS v2u*)(SL + (size_t)(2 * m + 1) * D) + lane;
#pragma unroll
            for (int j = 0; j < 4; ++j) { xw[r][j] = xr[64 * j]; a[r][j] = s0[64 * j]; c[r][j] = s1[64 * j]; } }
#pragma unroll
        for (int r = 0; r < 2; ++r) { const int m = m0 + r * NGW; float s = 0.f;
#pragma unroll
            for (int j = 0; j < 4; ++j) { f32x4& w = v[r][j]; w = (f32x4){bflo(xw[r][j].x), bfhi(xw[r][j].x), bflo(xw[r][j].y), bfhi(xw[r][j].y)};
                w.x += bflo(a[r][j].x) + bflo(c[r][j].x); w.y += bfhi(a[r][j].x) + bfhi(c[r][j].x); w.z += bflo(a[r][j].y) + bflo(c[r][j].y); w.w += bfhi(a[r][j].y) + bfhi(c[r][j].y);
                s += (w.x * w.x + w.y * w.y) + (w.z * w.z + w.w * w.w); }
            const float rstd = 1.f / sqrtf(wave_sum(s) * (1.f / D) + EPS);
            if (m < T) { GAS f32x4* xo = (GAS f32x4*)(out + (size_t)m * D) + lane;
#pragma unroll
                for (int j = 0; j < 4; ++j) { const f32x4 g = *((const GAS f32x4*)gf + lane + 64 * j); xo[64 * j] = v[r][j] * rstd * g; } } }
    }
}

constexpr int NPHASE = 13;
__global__ void __launch_bounds__(NTHR, 2) mk_fwd(Args args) {
    extern __shared__ __attribute__((aligned(16))) unsigned char lds[];
    Frame F;
    F.lds = (LAS unsigned char*)lds; F.MISC = (volatile LAS unsigned*)(F.lds + MISC_OFF);
        F.G = gridDim.x; { const int bx = blockIdx.x; F.vcu = (F.G % 8 == 0) ? (bx % 8) * (F.G / 8) + bx / 8 : bx; }
    F.ws = args.ws; F.ctl = (gu32*)(args.ws + WS_CTL);
    unsigned char* ws = args.ws;
    if (F_TID < 128) F.MISC[F_TID] = 0u;
    __syncthreads();
    const bool single = (args.ph_hi - args.ph_lo) > 1;
    XcdBarrier bar; bar.bar = (unsigned*)(F.ctl + CW_BAR); bar.x = 0; bar.st = nullptr;
    if (single) bar = xcd_barrier_post((unsigned*)(F.ctl + CW_BAR), F.MISC + 8);
    const int lo = args.ph_lo, hi = args.ph_hi;
#ifdef ONLY
#define IN(k) ((k) == ONLY && lo <= (k) && (k) < hi)
#else
#define IN(k) (lo <= (k) && (k) < hi)
#endif
#ifdef TS_A
#define STAMP(k) do { if (blockIdx.x == 0 && threadIdx.x == 0) ((unsigned long long*)(ws + WS_CTL + 8192))[(k) + 1] = __builtin_amdgcn_s_memrealtime(); } while (0)
#else
#define STAMP(k) do { } while (0)
#endif
#define SEAM(k) do { if (IN((k) + 1)) xcd_barrier(bar); STAMP(k); } while (0)
    const f32x2* rope = (const f32x2*)(ws + WS_ROPE);
    bf16* GA = (bf16*)args.out; bf16* GB = (bf16*)args.out + (size_t)T * 1024;

    STAMP(-1);
    if (IN(0)) { p0_prologue(F, args);
#ifdef REP_P0
        p0_prologue(F, args);
#endif
        SEAM(0); }
    if (IN(1)) {
        pg8::Gemm g{(const bf16*)(ws + WS_H), (const bf16*)(ws + WS_WIN), T, NIN, D, 0}; pg8::StaticOrderSig S; S.S0.init(T, NIN, F.G, (int)blockIdx.x);
        const bool p3q = (F.G == 256); const int gx = (int)(blockIdx.x & 7u); unsigned* gp1 = (unsigned*)(F.ctl + CW_GP1 + 64 * gx); S.cnt = p3q ? gp1 : nullptr;
        pg8::EpiIn E{(bf16*)(ws + WS_CQ), (bf16*)(ws + WS_CKV), (bf16*)(ws + WS_QB), (bf16*)(ws + WS_KB), (bf16*)(ws + WS_VB), (bf16*)(ws + WS_QI), (bf16*)(ws + WS_KI), (bf16*)(ws + WS_KR), GA, GB, (float*)(ws + WS_WI), rope, (float*)(ws + WS_PART)};
        pg8::gemm_phase<pg8::EpiIn, pg8::StaticOrderSig, true, true>(F.lds, g, S, E);
        if (p3q) {
            if (F_TID == 0) { unsigned sp = 0u; while (__hip_atomic_load(gp1, RLX_AGENT) < 32u) { __builtin_amdgcn_s_sleep(8); if (++sp > (1u << 22)) break; }
                __builtin_amdgcn_fence(__ATOMIC_ACQUIRE, "agent"); VM_WAIT(); }
            __syncthreads();
            const pg8::Gemm ga{(const bf16*)(ws + WS_CQ), (const bf16*)(ws + WS_WUQ), T, 768, 384, 0}; const pg8::Gemm gb{(const bf16*)(ws + WS_CKV), (const bf16*)(ws + WS_WUKV), T, 1024, 256, 0};
            LAS float* rsl = (LAS float*)(F.lds + 131072);
            for (;;) { const int j = wq_next(F, CW_QP3 + 64 * gx); if (j >= 56) break;
                if (j < 24) { const int pm = 8 * gx + (j & 7);
                    if (F_TID < 256) { const f32x4* pp = (const f32x4*)((const float*)(ws + WS_PART) + (size_t)(pm * 256 + F_TID) * 20); const f32x4 a = pp[0], b = pp[1], c = pp[2];
                        rsl[F_TID] = C2A / sqrtf(((((a[0] + a[1]) + (a[2] + a[3])) + ((b[0] + b[1]) + (b[2] + b[3]))) + ((c[0] + c[1]) + (c[2] + c[3]))) * (1.f / 384.f) + EPS); }
                    __syncthreads();
                    pg8::OneUnit S1{pm, j >> 3, 0}; pg8::EpiQA E1{(bf16*)(ws + WS_QA), rope, rsl}; pg8::gemm_phase<pg8::EpiQA, pg8::OneUnit, true, true>(F.lds, ga, S1, E1);
                } else { const int jj = j - 24, pm = 8 * gx + (jj & 7);
                    if (F_TID < 256) { const f32x4* pp = (const f32x4*)((const float*)(ws + WS_PART) + (size_t)(pm * 256 + F_TID) * 20 + 12); const f32x4 a = pp[0], b = pp[1];
                        rsl[F_TID] = 1.f / sqrtf((((a[0] + a[1]) + (a[2] + a[3])) + ((b[0] + b[1]) + (b[2] + b[3]))) * (1.f / 256.f) + EPS); }
                    __syncthreads();
                    pg8::OneUnit S1{pm, jj >> 3, 0}; pg8::EpiKV E1{(bf16*)(ws + WS_KN), (bf16*)(ws + WS_VA), rsl}; pg8::gemm_phase<pg8::EpiKV, pg8::OneUnit, true, true>(F.lds, gb, S1, E1);
                }
            }
        }
#ifdef CONV_AT_P1
        for (;;) { const int c = wq_next(F, CW_Q2); if (c >= CV_QITEMS) break;
            int ltid = threadIdx.x; asm volatile("" : "+v"(ltid));
            const int lw = __builtin_amdgcn_readfirstlane(ltid >> 6); LAS float* scr = (LAS float*)(F.lds + lw * 16640);
            conv_tile2(args, ws, CV_EARLY + 16 * c + lw, CV_EARLY + 16 * c + 8 + lw, scr, ltid & 63); }
#endif
        if (!p3q) SEAM(1);
    }
#ifdef P2A_OLD
    if (IN(2)) { p2a_norms(F, args); SEAM(2); }
#endif
    if (IN(3)) {
      if (F.G != 256)
#ifdef REP_P3
      for (int rep = 0; rep < 2; ++rep) {
#else
      {
#endif
#ifndef NO3A
        { pg8::Gemm g{(const bf16*)(ws + WS_CQ), (const bf16*)(ws + WS_WUQ), T, 768, 384, 0}; pg8::StaticOrder S; S.init(T, 768, F.G, (int)blockIdx.x);
          LAS float* rsl = (LAS float*)(F.lds + 131072);
          { pg8::Unit u0; if (S.next(0, u0) && F_TID < 256) { const f32x4* pp = (const f32x4*)((const float*)(ws + WS_PART) + (size_t)(u0.pm * 256 + F_TID) * 20); const f32x4 a = pp[0], b = pp[1], c = pp[2];
              rsl[F_TID] = C2A / sqrtf(((((a[0] + a[1]) + (a[2] + a[3])) + ((b[0] + b[1]) + (b[2] + b[3]))) + ((c[0] + c[1]) + (c[2] + c[3]))) * (1.f / 384.f) + EPS); } }
          __syncthreads();
          pg8::EpiQA E{(bf16*)(ws + WS_QA), rope, rsl}; pg8::gemm_phase<pg8::EpiQA, pg8::StaticOrder, true, true>(F.lds, g, S, E); }
#endif
#ifndef NO3B
        { pg8::Gemm g{(const bf16*)(ws + WS_CKV), (const bf16*)(ws + WS_WUKV), T, 1024, 256, 0}; pg8::StaticOrder S; S.init(T, 1024, F.G, (int)blockIdx.x);
          LAS float* rsl = (LAS float*)(F.lds + 131072 + 1024);
          { pg8::Unit u0; if (S.next(0, u0) && F_TID < 256) { const f32x4* pp = (const f32x4*)((const float*)(ws + WS_PART) + (size_t)(u0.pm * 256 + F_TID) * 20 + 12); const f32x4 a = pp[0], b = pp[1];
              rsl[F_TID] = 1.f / sqrtf((((a[0] + a[1]) + (a[2] + a[3])) + ((b[0] + b[1]) + (b[2] + b[3]))) * (1.f / 256.f) + EPS); } }
          __syncthreads();
          pg8::EpiKV E{(bf16*)(ws + WS_KN), (bf16*)(ws + WS_VA), rsl}; pg8::gemm_phase<pg8::EpiKV, pg8::StaticOrder, true, true>(F.lds, g, S, E); }
#endif
      }
        SEAM(3);
    }
    if (IN(4)) {
        unsigned* rdy = (unsigned*)(F.ctl + CW_RDY);
#ifndef CONV_AT_P1
        constexpr int NCVQ = CV_QITEMS;
#else
        constexpr int NCVQ = 0;
#endif
        const int q1off = (F.G <= 512) ? F.G : 0; bool first1 = q1off != 0;
        for (;;) { int k; if (first1) { k = (int)blockIdx.x; first1 = false; } else k = q1off + wq_next(F, CW_Q1);
            if (k >= 1536 + NCVQ) break;
            int ltid = threadIdx.x; asm volatile("" : "+v"(ltid));
            const int lw = __builtin_amdgcn_readfirstlane(ltid >> 6);
            if (k < 512) { const int ib = k & 1, ij = 255 - (k >> 1);
                const IdxP IP{(const bf16*)(ws + WS_QI), (const bf16*)(ws + WS_KI), (const float*)(ws + WS_WI), (unsigned*)(ws + WS_BM), (unsigned*)(F.ctl + 1024)};
                idx_item(F.lds, ib, ij, IP, ltid, ltid & 63, lw);
#ifdef REP_IDX
                __syncthreads(); idx_item(F.lds, ib, ij, IP, ltid, ltid & 63, lw);
#endif
                VM_WAIT(); __syncthreads();
                if (ltid == 0) { __builtin_amdgcn_fence(__ATOMIC_RELEASE, "agent"); VM_WAIT(); __hip_atomic_fetch_add(rdy + 64 * (ib * 32 + (ij >> 3)), 1u, RLX_AGENT); }
                continue; }
            const int j = k - 512; int a;
            if (j < 3 * NCVQ) { const int q3 = j / 3, r3 = j - 3 * q3; a = (r3 == 2) ? -1 - q3 : 2 * q3 + r3; } else a = j - NCVQ;
            if (a < 0) { const int c = -1 - a; LAS float* scr = (LAS float*)(F.lds + lw * 16640);
                conv_tile2(args, ws, CV_EARLY + 16 * c + lw, CV_EARLY + 16 * c + 8 + lw, scr, ltid & 63);
                continue; }
            { const int u = a >> 1, ub = (u & 15) >> 3, uh = u & 7, uq = 31 - (u >> 4);
                if (a & 1) { const AttnP APA{(const bf16*)(ws + WS_QA), (const bf16*)(ws + WS_KN), (const bf16*)(ws + WS_KR), (const bf16*)(ws + WS_VA), (bf16*)(ws + WS_OA), nullptr};
#ifdef MLA_OLD
                    attn_unit<true>(F.lds, ub, uh, uq, APA, ltid, ltid & 63, lw); }
#else
                    attn_body::attn_unit<8, true>(ub, uh, uq, (const attn_body::bf16*)APA.Q, (const attn_body::bf16*)APA.K, (const attn_body::bf16*)APA.K2, (const attn_body::bf16*)APA.V, (attn_body::bf16*)APA.O, nullptr, (char*)F.lds, ltid); }
#endif
                else { const AttnP APB{(const bf16*)(ws + WS_QB), (const bf16*)(ws + WS_KB), nullptr, (const bf16*)(ws + WS_VB), (bf16*)(ws + WS_OB), (const unsigned*)(ws + WS_BM)};
                    if (ltid == 0) { unsigned sp = 0u; while (__hip_atomic_load(rdy + 64 * (ub * 32 + uq), RLX_AGENT) < 8u) { __builtin_amdgcn_s_sleep(8); if (++sp > (1u << 22)) break; }
                        __builtin_amdgcn_fence(__ATOMIC_ACQUIRE, "agent"); VM_WAIT(); }
                    __syncthreads();
#ifdef DSA_OLD
                    attn_unit<false>(F.lds, ub, uh, uq, APB, ltid, ltid & 63, lw); } }
#else
                    attn_body::attn_unit<8, false>(ub, uh, uq, (const attn_body::bf16*)APB.Q, (const attn_body::bf16*)APB.K, nullptr, (const attn_body::bf16*)APB.V, (attn_body::bf16*)APB.O, APB.BM, (char*)F.lds, ltid); } }
#endif
        }
    }
    if (IN(5)) { SEAM(5); }
#ifdef Y_TWO_GEMMS
    if (IN(6)) {
#ifdef REP_P6
      for (int rep = 0; rep < 2; ++rep) {
#else
      {
#endif
        { pg8::Gemm g{(const bf16*)(ws + WS_OA), (const bf16*)(ws + WS_WOA), T, 1024, 512, 0}; pg8::StaticOrder S; S.init(T, 1024, F.G, (int)blockIdx.x);
          pg8::EpiY<0> E{(bf16*)(ws + WS_Y), GA}; pg8::gemm_phase<pg8::EpiY<0>, pg8::StaticOrder, true, true>(F.lds, g, S, E); }
        { pg8::Gemm g{(const bf16*)(ws + WS_OB), (const bf16*)(ws + WS_WOB), T, 1024, 512, 0}; pg8::StaticOrder S; S.init(T, 1024, F.G, (int)blockIdx.x);
          pg8::EpiY<1> E{(bf16*)(ws + WS_Y), GB}; pg8::gemm_phase<pg8::EpiY<1>, pg8::StaticOrder, true, true>(F.lds, g, S, E); }
      }
        SEAM(6);
    }
#else
    if (IN(6)) {
        pg8::Gemm g{(const bf16*)(ws + WS_OA), (const bf16*)(ws + WS_WOA), T, 1024, 512, WS_WOB - WS_WOA, WS_OB - WS_OA};
        pg8::PairOrder S; S.S0.init(T, 1024, F.G, (int)blockIdx.x); S.cnt = (F.G == 256) ? (unsigned*)(F.ctl + CW_YRDY) : nullptr;
        pg8::EpiYC E{(bf16*)(ws + WS_Y), GA, GB}; pg8::gemm_phase<pg8::EpiYC, pg8::PairOrder, true, true>(F.lds, g, S, E);
        if (F.G != 256) SEAM(6);
    }
#endif
    if (IN(7)) {
        pg8::Gemm g{(const bf16*)(ws + WS_Y), (const bf16*)(ws + WS_WOUT), T, 1024, 1024, 0}; pg8::StaticOrderWait S; S.S0.init(T, 1024, F.G, (int)blockIdx.x);
        S.rdy = (F.G == 256) ? (const unsigned*)(F.ctl + CW_YRDY) : nullptr; S.need = 4u;
        pg8::EpiX1 E{args.in[0], args.out, (bf16*)(ws + WS_X1B)}; pg8::gemm_phase<pg8::EpiX1, pg8::StaticOrderWait, true, true>(F.lds, g, S, E);
#ifdef REP_P7
        pg8::gemm_phase<pg8::EpiX1, pg8::StaticOrder, true, true>(F.lds, g, S, E);
#endif
        SEAM(7);
    }
    if (IN(8)) { p5a_route(F, args); SEAM(8); }
    if (IN(9)) { p5a2_scatter(F, args); SEAM(9); }
#ifdef MOE_TWO_PHASES
    if (IN(10)) {
        const int* t2e = (const int*)(ws + WS_T2E); const int ntl = t2e[255];
        pg8::Gemm g{(const bf16*)(ws + WS_ASORT), (const bf16*)(ws + WS_WGU), SORT_ROWS, 512, 1024, (size_t)512 * 1024 * 2}; pg8::GroupOrder S; S.init(ntl, 2, F.G, (int)blockIdx.x, t2e);
        pg8::EpiHid E{(bf16*)(ws + WS_HID), (const float*)(ws + WS_SRSTD)}; pg8::gemm_phase<pg8::EpiHid, pg8::GroupOrder, true, true>(F.lds, g, S, E);
#ifdef REP_P10
        pg8::gemm_phase<pg8::EpiHid, pg8::GroupOrder, true, true>(F.lds, g, S, E);
#endif
        SEAM(10);
    }
    if (IN(11)) {
        const int* t2e = (const int*)(ws + WS_T2E); const int ntl = t2e[255];
        pg8::Gemm g{(const bf16*)(ws + WS_HID), (const bf16*)(ws + WS_WD), SORT_ROWS, 1024, 256, (size_t)1024 * 256 * 2}; pg8::GroupOrder S; S.init(ntl, 4, F.G, (int)blockIdx.x, t2e);
        pg8::EpiDown E{(bf16*)(ws + WS_SLOTS), (const int*)(ws + WS_SSLOT), (const float*)(ws + WS_SW)}; pg8::gemm_phase<pg8::EpiDown, pg8::GroupOrder, true, true>(F.lds, g, S, E);
#ifdef REP_P11
        pg8::gemm_phase<pg8::EpiDown, pg8::GroupOrder, true, true>(F.lds, g, S, E);
#endif
        SEAM(11);
    }
#else
    if (IN(10)) {
        const int* t2e = (const int*)(ws + WS_T2E); const int ntl = t2e[255], n10 = 2 * ntl, n11 = 4 * ntl;
        unsigned* hrdy = (unsigned*)(F.ctl + CW_HRDY);
        const pg8::Gemm g10{(const bf16*)(ws + WS_X1B), (const bf16*)(ws + WS_WGU), SORT_ROWS, 512, 1024, (size_t)512 * 1024 * 2, 0, t2e + 256};
        const pg8::Gemm g11{(const bf16*)(ws + WS_HID), (const bf16*)(ws + WS_WD), SORT_ROWS, 1024, 256, (size_t)1024 * 256 * 2, 0, t2e + 256};
        const pg8::EpiHid E10{(bf16*)(ws + WS_HID), (const float*)(ws + WS_SRSTD)}; const pg8::EpiDown E11{(bf16*)(ws + WS_SLOTS), (const int*)(ws + WS_SSLOT), (const float*)(ws + WS_SW)};
        const int qoff = (F.G == 256 && n10 >= 256) ? 256 : 0; bool first = qoff != 0;
        for (;;) { int k; if (first) { k = (int)((blockIdx.x & 7u) * 32u + (blockIdx.x >> 3)); first = false; } else k = qoff + wq_next(F, CW_Q3);
            if (k >= n10 + n11) break;
            if (k < n10) { const int pm = k >> 1; pg8::OneUnit S{pm, k & 1, __builtin_amdgcn_readfirstlane(t2e[pm])};
                pg8::gemm_phase<pg8::EpiHid, pg8::OneUnit, true, true, true>(F.lds, g10, S, E10, (const int*)(ws + WS_TOKIDX));
                VM_WAIT(); __syncthreads();
                if (F_TID == 0) { __builtin_amdgcn_fence(__ATOMIC_RELEASE, "agent"); VM_WAIT(); __hip_atomic_fetch_add(hrdy + 64 * pm, 1u, RLX_AGENT); }
            } else { const int j = k - n10, pm = j >> 2; pg8::OneUnit S{pm, j & 3, __builtin_amdgcn_readfirstlane(t2e[pm])};
                if (F_TID == 0) { unsigned sp = 0u; while (__hip_atomic_load(hrdy + 64 * pm, RLX_AGENT) < 2u) { __builtin_amdgcn_s_sleep(8); if (++sp > (1u << 22)) break; }
                    __builtin_amdgcn_fence(__ATOMIC_ACQUIRE, "agent"); VM_WAIT(); }
                __syncthreads();
                pg8::gemm_phase<pg8::EpiDown, pg8::OneUnit, true, true>(F.lds, g11, S, E11);
            }
        }
    }
    if (IN(11)) { SEAM(11); }
#endif
    if (IN(12)) { p6_final(F, args); }
#ifdef DIAG_SLOW
    if (blockIdx.x == 0 && threadIdx.x == 0) { const unsigned long long t0 = __builtin_amdgcn_s_memrealtime(), wait = 100ull * __hip_atomic_load((unsigned*)(F.ctl + 1024), RLX_AGENT);
        while (__builtin_amdgcn_s_memrealtime() - t0 < wait) __builtin_amdgcn_s_sleep(16); }
#endif
#ifdef TS_A
    if (blockIdx.x == 0 && threadIdx.x == 0) { STAMP(12); __builtin_amdgcn_s_waitcnt(0);
        const unsigned long long* tsp = (const unsigned long long*)(ws + WS_CTL + 8192);
        const unsigned long long ta = __hip_atomic_load(tsp + (TS_A) + 1, RLX_AGENT), tb = __hip_atomic_load(tsp + (TS_B) + 1, RLX_AGENT);
        const unsigned long long t0 = __builtin_amdgcn_s_memrealtime(), wait = 4ull * (tb - ta);
        while (__builtin_amdgcn_s_memrealtime() - t0 < wait) __builtin_amdgcn_s_sleep(16); }
#endif
#undef IN
#undef SEAM
}

#ifndef MK_MULTI
#define MK_MULTI 0
#endif
extern "C" void kernel_launch(void* const* d_in, const int* in_sizes, int n_in, void* d_out, int out_size, void* d_ws, size_t ws_size, hipStream_t stream) {
    static int grid = 0;
    if (grid == 0) {
        if (n_in != 20 || in_sizes[0] != T * D || out_size != T * D || ws_size < WS_END) { fprintf(stderr, "kernel_launch: unexpected shapes n_in %d in0 %d out %d ws %zu\n", n_in, n_in > 0 ? in_sizes[0] : -1, out_size, ws_size); grid = -1; return; }
        int dev = 0, cus = 0;
        if (hipGetDevice(&dev) != hipSuccess || hipDeviceGetAttribute(&cus, hipDeviceAttributeMultiprocessorCount, dev) != hipSuccess) { grid = -1; return; }
        if (hipFuncSetAttribute((const void*)mk_fwd, hipFuncAttributeMaxDynamicSharedMemorySize, LDS_BYTES) != hipSuccess) { fprintf(stderr, "kernel_launch: hipFuncSetAttribute failed\n"); grid = -1; return; }
        (void)hipGetLastError();
        grid = cus;
    }
    if (grid < 0) return;
    if (hipMemsetAsync((char*)d_ws + WS_CTL, 0, CTL_ZERO_BYTES, stream) != hipSuccess) return;
    Args a{};
    for (int i = 0; i < 20; ++i) a.in[i] = (const float*)d_in[i];
    a.out = (float*)d_out; a.ws = (unsigned char*)d_ws;
#if MK_MULTI
    for (int p = 0; p < NPHASE; ++p) { a.ph_lo = p; a.ph_hi = p + 1; hipLaunchKernelGGL(mk_fwd, dim3(grid), dim3(NTHR), LDS_BYTES, stream, a); }
#else
    a.ph_lo = 0; a.ph_hi = NPHASE;
    hipLaunchKernelGGL(mk_fwd, dim3(grid), dim3(NTHR), LDS_BYTES, stream, a);
#endif
}
```
